# Optimizing an MI355X kernel written in HIP

```python
import math
import jax
import jax.numpy as jnp
from jax import lax
import numpy as np

D_MODEL = 1024
BATCH = 4
SEQ = 4096
DEPTH = 4
DEC_BATCH = 32
DEC_SEQ = 8
PAST_LEN = 8192
PAGE_SIZE = 128

N_A_LAYERS = DEPTH // 2
N_B_LAYERS = DEPTH - N_A_LAYERS
CONV_W = 3
D_FF = 2816
N_HEADS = 16
HEAD_DIM = D_MODEL // N_HEADS
N_KV = 4
HPG = N_HEADS // N_KV
ROPE_DIM = HEAD_DIM // 4
ROPE_THETA = 500000.0
L_CMP = 32
L_SEL = 64
N_SEL = 16
WINDOW = 512
CMP_HIDDEN = 4 * HEAD_DIM
Q_BLOCK = 64
N_KV_ENTRIES = 4
N_WIN_ENTRIES = 2
EPS = 1e-6
NEG = -1e30
TINY = 1e-30
FORCE_SCORE = 1e4
POS_PAD = -(1 << 30)

kernel_name = "yoco_shortconv_nsa_macaron_step"


def rmsnorm(x, g):
    xf = x.astype(jnp.float32)
    y = xf * lax.rsqrt(jnp.mean(xf * xf, axis=-1, keepdims=True) + EPS)
    return (y * g.astype(jnp.float32)).astype(x.dtype)


def swiglu(x, w_in, w_out):
    g, u = jnp.split(x @ w_in, 2, axis=-1)
    return (jax.nn.silu(g) * u) @ w_out


def partial_rope(x, pos):
    half = ROPE_DIM // 2
    inv_freq = ROPE_THETA ** (-jnp.arange(half, dtype=jnp.float32) / half)
    ang = pos.astype(jnp.float32)[:, None] * inv_freq[None, :]
    cos = jnp.cos(ang)[:, None, :]
    sin = jnp.sin(ang)[:, None, :]
    xr = x[..., :ROPE_DIM].astype(jnp.float32)
    x1, x2 = xr[..., :half], xr[..., half:]
    rot = jnp.concatenate([x1 * cos - x2 * sin, x2 * cos + x1 * sin], axis=-1).astype(x.dtype)
    return jnp.concatenate([rot, x[..., ROPE_DIM:]], axis=-1)


def masked_softmax(s, mask):
    m = jnp.max(jnp.where(mask, s, NEG), axis=-1, keepdims=True)
    e = jnp.exp(jnp.where(mask, s - m, NEG))
    return e / jnp.maximum(jnp.sum(e, axis=-1, keepdims=True), TINY)


def short_conv(hn, prev, w_in, w_conv, w_out):
    t = hn.shape[1]
    b_gate, c_gate, xh = jnp.split(hn @ w_in, 3, axis=-1)
    u = c_gate * xh
    up = jnp.concatenate([prev.astype(u.dtype), u], axis=1)
    conv = w_conv[0] * up[:, 0:t]
    for j in range(1, CONV_W):
        conv = conv + w_conv[j] * up[:, j:j + t]
    return (b_gate * conv) @ w_out, up[:, t:]


def shared_kv_rows(h, pos, kv_norm, w_kv, k_norm):
    n, t, _ = h.shape
    p = (rmsnorm(h, kv_norm) @ w_kv).reshape(n, t, 6, N_KV, HEAD_DIM)
    k_sel = partial_rope(rmsnorm(p[:, :, 2], k_norm[1]), pos)
    k_win = partial_rope(rmsnorm(p[:, :, 4], k_norm[2]), pos)
    kv_rows = jnp.stack([p[:, :, 0], p[:, :, 1], k_sel, p[:, :, 3]], axis=2)
    win_rows = jnp.stack([k_win, p[:, :, 5]], axis=2)
    return kv_rows, win_rows


def compress_blocks(kv_full, k_norm_c, cmp_pe, cmp_w1, cmp_w2):
    n, t_pad = kv_full.shape[:2]
    nbc = t_pad // L_CMP
    rows = kv_full[:, :, :2].reshape(n, nbc, L_CMP, 2, N_KV, HEAD_DIM)
    rows = rows + jnp.swapaxes(cmp_pe, 0, 1)[:, :, None, :].astype(rows.dtype)
    hid = jax.nn.gelu(jnp.einsum('nclegd,eldf->ncegf', rows, cmp_w1))
    out = jnp.einsum('ncegf,efd->ncegd', hid, cmp_w2)
    return rmsnorm(out[:, :, 0], k_norm_c), out[:, :, 1]


def build_shared(h, pos, kv_past, win_prev, win_prev_pos, w):
    n, t, _ = h.shape
    kv_rows, win_rows = shared_kv_rows(h, pos, w['kv_norm'], w['w_kv'], w['k_norm'])
    total = kv_past.shape[1] + t
    t_pad = -(-total // L_SEL) * L_SEL
    kv_full = jnp.concatenate([kv_past.astype(kv_rows.dtype), kv_rows,
                               jnp.zeros((n, t_pad - total) + kv_rows.shape[2:], kv_rows.dtype)], axis=1)
    k_c, v_c = compress_blocks(kv_full, w['k_norm'][0], w['cmp_pe'], w['cmp_w1'], w['cmp_w2'])
    pad = WINDOW - win_prev.shape[1]
    win_all = jnp.concatenate([jnp.zeros((n, pad) + win_rows.shape[2:], win_rows.dtype),
                               win_prev.astype(win_rows.dtype), win_rows], axis=1)
    win_pos = jnp.concatenate([jnp.full((pad,), POS_PAD, jnp.int32), win_prev_pos, pos])
    new_win = win_all[:, win_all.shape[1] - min(WINDOW, total):]
    shared = (k_c, v_c, kv_full[:, :, 2], kv_full[:, :, 3], win_all[:, :, 0], win_all[:, :, 1], win_pos)
    return shared, kv_rows, new_win


def nsa_mixer(hn, q_pos, shared, w_qg, q_norm, w_o):
    k_c, v_c, k_sel, v_sel, win_k, win_v, win_pos = shared
    n, tq, _ = hn.shape
    hd = N_HEADS * HEAD_DIM
    qg = hn @ w_qg
    q = rmsnorm(qg[..., :hd].reshape(n, tq, N_HEADS, HEAD_DIM), q_norm)
    q_rot = partial_rope(q, q_pos)
    gates = jax.nn.sigmoid(qg[..., hd:].astype(jnp.float32)).reshape(n, tq, N_KV, HPG, 3)
    qb = math.gcd(Q_BLOCK, tq)
    nqb = tq // qb
    nbc = k_c.shape[1]
    nbs = k_sel.shape[1] // L_SEL
    n_sel = min(N_SEL, nbs)
    scale = HEAD_DIM ** -0.5

    def blockify(a):
        return jnp.swapaxes(a.reshape((n, nqb, qb) + a.shape[2:]), 0, 1)

    xs = (blockify(q.reshape(n, tq, N_KV, HPG, HEAD_DIM)), blockify(q_rot.reshape(n, tq, N_KV, HPG, HEAD_DIM)),
          blockify(gates), q_pos.reshape(nqb, qb), jnp.arange(nqb, dtype=jnp.int32) * qb)
    n_idx = jnp.arange(n)[:, None, None, None]
    g_idx = jnp.arange(N_KV)[None, None, :, None]
    cmp_end = (jnp.arange(nbc) + 1) * L_CMP - 1
    blk = jnp.arange(nbs)
    sel_off = jnp.arange(L_SEL)

    def block(args):
        qc, qr, gt, pos, j0 = args
        s = jnp.einsum('nqghd,ncgd->nqghc', qc, k_c).astype(jnp.float32) * scale
        vis = (cmp_end[None, :] <= pos[:, None])[None, :, None, None, :]
        p_c = masked_softmax(s, vis)
        o_c = jnp.einsum('nqghc,ncgd->nqghd', p_c.astype(v_c.dtype), v_c)
        imp = p_c.sum(axis=3).reshape(n, qb, N_KV, nbs, L_SEL // L_CMP).sum(-1)
        cur = (pos // L_SEL)[:, None]
        forced = ((blk == 0) | (blk == cur) | (blk == cur - 1))[None, :, None, :]
        valid = (blk * L_SEL <= pos[:, None])[None, :, None, :]
        score = jnp.where(valid, jnp.where(forced, FORCE_SCORE, imp), NEG)
        _, idx = lax.top_k(score, n_sel)
        tok = (idx[..., None] * L_SEL + sel_off).reshape(n, qb, N_KV, n_sel * L_SEL)
        ks = k_sel[n_idx, tok, g_idx]
        vs = v_sel[n_idx, tok, g_idx]
        s = jnp.einsum('nqghd,nqgsd->nqghs', qr, ks).astype(jnp.float32) * scale
        vis = (tok <= pos[None, :, None, None])[:, :, :, None, :]
        o_s = jnp.einsum('nqghs,nqgsd->nqghd', masked_softmax(s, vis).astype(vs.dtype), vs)
        kw = lax.dynamic_slice_in_dim(win_k, j0, WINDOW + qb, axis=1)
        vw = lax.dynamic_slice_in_dim(win_v, j0, WINDOW + qb, axis=1)
        pw = lax.dynamic_slice_in_dim(win_pos, j0, WINDOW + qb)
        d = pos[:, None] - pw[None, :]
        vis = ((d >= 0) & (d <= WINDOW))[None, :, None, None, :]
        s = jnp.einsum('nqghd,nkgd->nqghk', qr, kw).astype(jnp.float32) * scale
        o_w = jnp.einsum('nqghk,nkgd->nqghd', masked_softmax(s, vis).astype(vw.dtype), vw)
        o = gt[..., 0:1] * o_c.astype(jnp.float32) + gt[..., 1:2] * o_s.astype(jnp.float32) \
            + gt[..., 2:3] * o_w.astype(jnp.float32)
        return o.astype(qc.dtype)

    o = lax.map(block, xs)
    o = jnp.swapaxes(o, 0, 1).reshape(n, tq, hd)
    return o @ w_o


def trunk(x, pos, conv_prev, kv_past, win_prev, win_prev_pos, w):
    h = x
    conv_states = []
    shared = None
    kv_rows = None
    new_win = None
    for layer in range(DEPTH):
        h = h + 0.5 * swiglu(rmsnorm(h, w['ffn_a_norm'][layer]), w['ffn_a_w_in'][layer], w['ffn_a_w_out'][layer])
        hn = rmsnorm(h, w['mix_norm'][layer])
        if layer < N_A_LAYERS:
            y, st = short_conv(hn, conv_prev[layer], w['conv_w_in'][layer], w['conv_w'][layer], w['conv_w_out'][layer])
            conv_states.append(st)
        else:
            b = layer - N_A_LAYERS
            y = nsa_mixer(hn, pos, shared, w['nsa_w_qg'][b], w['nsa_q_norm'][b], w['nsa_w_o'][b])
        h = h + y
        h = h + 0.5 * swiglu(rmsnorm(h, w['ffn_b_norm'][layer]), w['ffn_b_w_in'][layer], w['ffn_b_w_out'][layer])
        if layer == N_A_LAYERS - 1:
            shared, kv_rows, new_win = build_shared(h, pos, kv_past, win_prev, win_prev_pos, w)
    return h, kv_rows, new_win, jnp.stack(conv_states)


def setup_inputs(seed: int = 0) -> dict:
    key = jax.random.key(seed)
    ks = jax.random.split(key, 32)
    f32 = jnp.float32

    def nrm(k, shape, scale):
        return jax.random.normal(k, shape, f32) * scale

    def gain(k, shape):
        return 1.0 + 0.01 * jax.random.normal(k, shape, f32)

    n_pages = PAST_LEN // PAGE_SIZE
    n_pool = (DEC_BATCH * n_pages * 5) // 4
    wb = min(WINDOW, PAST_LEN)
    hd = N_HEADS * HEAD_DIM
    page_table = jax.random.permutation(ks[5], n_pool)[:DEC_BATCH * n_pages].reshape(DEC_BATCH, n_pages).astype(jnp.int32)
    return {
        'x_prompt': nrm(ks[0], (BATCH, SEQ, D_MODEL), 1.0),
        'x_sample': nrm(ks[1], (DEC_BATCH, DEC_SEQ, D_MODEL), 1.0),
        'cache_kv': nrm(ks[2], (n_pool, PAGE_SIZE, N_KV_ENTRIES, N_KV, HEAD_DIM), 1.0),
        'cache_win': nrm(ks[3], (DEC_BATCH, wb, N_WIN_ENTRIES, N_KV, HEAD_DIM), 1.0),
        'state_conv': nrm(ks[4], (N_A_LAYERS, DEC_BATCH, CONV_W - 1, D_MODEL), 1.0),
        'page_table': page_table,
        'ffn_a_norm': gain(ks[6], (DEPTH, D_MODEL)),
        'ffn_a_w_in': nrm(ks[7], (DEPTH, D_MODEL, 2 * D_FF), D_MODEL ** -0.5),
        'ffn_a_w_out': nrm(ks[8], (DEPTH, D_FF, D_MODEL), D_FF ** -0.5),
        'mix_norm': gain(ks[9], (DEPTH, D_MODEL)),
        'ffn_b_norm': gain(ks[10], (DEPTH, D_MODEL)),
        'ffn_b_w_in': nrm(ks[11], (DEPTH, D_MODEL, 2 * D_FF), D_MODEL ** -0.5),
        'ffn_b_w_out': nrm(ks[12], (DEPTH, D_FF, D_MODEL), D_FF ** -0.5),
        'conv_w_in': nrm(ks[13], (N_A_LAYERS, D_MODEL, 3 * D_MODEL), D_MODEL ** -0.5),
        'conv_w': nrm(ks[14], (N_A_LAYERS, CONV_W, D_MODEL), CONV_W ** -0.5),
        'conv_w_out': nrm(ks[15], (N_A_LAYERS, D_MODEL, D_MODEL), D_MODEL ** -0.5),
        'kv_norm': gain(ks[16], (D_MODEL,)),
        'w_kv': nrm(ks[17], (D_MODEL, 6 * N_KV * HEAD_DIM), D_MODEL ** -0.5),
        'k_norm': gain(ks[18], (3, HEAD_DIM)),
        'cmp_pe': nrm(ks[19], (2, L_CMP, HEAD_DIM), 0.1),
        'cmp_w1': nrm(ks[20], (2, L_CMP, HEAD_DIM, CMP_HIDDEN), (L_CMP * HEAD_DIM) ** -0.5),
        'cmp_w2': nrm(ks[21], (2, CMP_HIDDEN, HEAD_DIM), CMP_HIDDEN ** -0.5),
        'nsa_w_qg': nrm(ks[22], (N_B_LAYERS, D_MODEL, hd + 3 * N_HEADS), D_MODEL ** -0.5),
        'nsa_q_norm': gain(ks[23], (N_B_LAYERS, HEAD_DIM)),
        'nsa_w_o': nrm(ks[24], (N_B_LAYERS, hd, D_MODEL), hd ** -0.5),
    }


def reference(x_prompt, x_sample, cache_kv, cache_win, state_conv, page_table,
              ffn_a_norm, ffn_a_w_in, ffn_a_w_out, mix_norm, ffn_b_norm, ffn_b_w_in, ffn_b_w_out,
              conv_w_in, conv_w, conv_w_out, kv_norm, w_kv, k_norm, cmp_pe, cmp_w1, cmp_w2,
              nsa_w_qg, nsa_q_norm, nsa_w_o):
    w = dict(ffn_a_norm=ffn_a_norm, ffn_a_w_in=ffn_a_w_in, ffn_a_w_out=ffn_a_w_out, mix_norm=mix_norm,
             ffn_b_norm=ffn_b_norm, ffn_b_w_in=ffn_b_w_in, ffn_b_w_out=ffn_b_w_out,
             conv_w_in=conv_w_in, conv_w=conv_w, conv_w_out=conv_w_out, kv_norm=kv_norm, w_kv=w_kv,
             k_norm=k_norm, cmp_pe=cmp_pe, cmp_w1=cmp_w1, cmp_w2=cmp_w2,
             nsa_w_qg=nsa_w_qg, nsa_q_norm=nsa_q_norm, nsa_w_o=nsa_w_o)
    bp, tp, _ = x_prompt.shape
    bs, ts, _ = x_sample.shape
    dt = x_prompt.dtype
    past_len = page_table.shape[1] * cache_kv.shape[1]
    y_prompt, kv_prompt, win_prompt, conv_prompt = trunk(
        x_prompt, jnp.arange(tp, dtype=jnp.int32),
        jnp.zeros((N_A_LAYERS, bp, CONV_W - 1, D_MODEL), dt),
        jnp.zeros((bp, 0, N_KV_ENTRIES, N_KV, HEAD_DIM), dt),
        jnp.zeros((bp, 0, N_WIN_ENTRIES, N_KV, HEAD_DIM), dt),
        jnp.zeros((0,), jnp.int32), w)
    kv_past = cache_kv[page_table].reshape(bs, past_len, N_KV_ENTRIES, N_KV, HEAD_DIM)
    wb = cache_win.shape[1]
    y_sample, kv_sample, win_sample, conv_sample = trunk(
        x_sample, past_len + jnp.arange(ts, dtype=jnp.int32), state_conv, kv_past, cache_win,
        past_len - wb + jnp.arange(wb, dtype=jnp.int32), w)
    return (y_prompt, y_sample, kv_prompt, kv_sample, win_prompt, win_sample, conv_prompt, conv_sample)
```

```cpp
#ifdef CPU_TEST
#include "shim.h"
#else
#include <hip/hip_runtime.h>
#define LAUNCH(k, g, b, stream, ...) hipLaunchKernelGGL(k, dim3(g), dim3(b), 0, stream, __VA_ARGS__)
#endif
#include <cstdint>
#include <cstddef>
#include <cmath>

#ifdef CFG_SMALL
constexpr int D_MODEL = 256, BATCH = 1, SEQ = 2048, DEPTH = 4, DEC_BATCH = 2, DEC_SEQ = 8, PAST_LEN = 2048, PAGE_SIZE = 128, D_FF = 192, N_HEADS = 4, N_KV = 2;
#else
constexpr int D_MODEL = 1024, BATCH = 4, SEQ = 4096, DEPTH = 4, DEC_BATCH = 32, DEC_SEQ = 8, PAST_LEN = 8192, PAGE_SIZE = 128, D_FF = 2816, N_HEADS = 16, N_KV = 4;
#endif
constexpr int N_A = DEPTH / 2, N_B = DEPTH - N_A, HD = 64, HPG = N_HEADS / N_KV, L_CMP = 32, L_SEL = 64, N_SEL = 16, WINDOW = 512, CMP_HID = 4 * HD;
constexpr int MP = BATCH * SEQ, MS = DEC_BATCH * DEC_SEQ, MT = MP + MS, NSEQ = BATCH + DEC_BATCH;
constexpr int N_PAGES = PAST_LEN / PAGE_SIZE;
constexpr int KVW = 6 * N_KV * HD;
constexpr int QGW = N_HEADS * HD + 3 * N_HEADS;
constexpr int HDM = N_HEADS * HD;
constexpr int TPAD_S = ((PAST_LEN + DEC_SEQ + L_SEL - 1) / L_SEL) * L_SEL;
constexpr int NBC_P = SEQ / L_CMP, NBC_S = TPAD_S / L_CMP, NBC_MAX = NBC_S > NBC_P ? NBC_S : NBC_P;
constexpr int NBS_P = SEQ / L_SEL, NBS_S = TPAD_S / L_SEL, NBS_MAX = NBS_S > NBS_P ? NBS_S : NBS_P;
constexpr float EPS = 1e-6f, NEGF = -1e30f, TINYF = 1e-30f, FORCE_SCORE = 1e4f;
__device__ static const float INV_FREQ[8] = {1.0f, 0.1939227432012558f, 0.03760603070259094f, 0.007292664609849453f, 0.0014142135623842478f, 0.00027424818836152554f, 5.3182957344688475e-05f, 1.0313385246263351e-05f};

constexpr size_t O_YP = 0, O_YS = O_YP + (size_t)MP * D_MODEL, O_KVP = O_YS + (size_t)MS * D_MODEL, O_KVS = O_KVP + (size_t)MP * 4 * N_KV * HD,
                 O_WP = O_KVS + (size_t)MS * 4 * N_KV * HD, O_WS = O_WP + (size_t)BATCH * WINDOW * 2 * N_KV * HD, O_CP = O_WS + (size_t)DEC_BATCH * WINDOW * 2 * N_KV * HD,
                 O_CS = O_CP + (size_t)N_A * BATCH * 2 * D_MODEL, O_END = O_CS + (size_t)N_A * DEC_BATCH * 2 * D_MODEL;

struct RowInfo { int seq, t, pos; };
__device__ __host__ inline RowInfo row_info(int m) {
    RowInfo r;
    if (m < MP) { r.seq = m / SEQ; r.t = m % SEQ; r.pos = r.t; }
    else { const int q = m - MP; r.seq = BATCH + q / DEC_SEQ; r.t = q % DEC_SEQ; r.pos = PAST_LEN + r.t; }
    return r;
}
__device__ __host__ inline int seq_row0(int seq) { return seq < BATCH ? seq * SEQ : MP + (seq - BATCH) * DEC_SEQ; }
__device__ __host__ inline int seq_pos0(int seq) { return seq < BATCH ? 0 : PAST_LEN; }
__device__ __host__ inline int seq_len(int seq) { return seq < BATCH ? SEQ : DEC_SEQ; }

__global__ void k_copy(const float* a, float* b, size_t n) {
    size_t i = (size_t)blockIdx.x * blockDim.x + threadIdx.x;
    if (i < n) b[i] = a[i];
}
__global__ void k_rmsnorm(const float* x, const float* g, float* y, int rows, int d) {
    int m = blockIdx.x * blockDim.x + threadIdx.x;
    if (m >= rows) return;
    const float* xr = x + (size_t)m * d; float s = 0.f;
    for (int i = 0; i < d; ++i) s += xr[i] * xr[i];
    const float r = 1.0f / sqrtf(s / d + EPS);
    float* yr = y + (size_t)m * d;
    for (int i = 0; i < d; ++i) yr[i] = xr[i] * r * g[i];
}
__global__ void k_gemm(const float* A, int lda, const float* W, float* C, int M, int N, int K) {
    const int tx = threadIdx.x % 16, ty = threadIdx.x / 16;
    const int c0 = blockIdx.x * 64 + tx * 4, r0 = blockIdx.y * 64 + ty * 4;
    if (c0 >= N || r0 >= M) return;
    float acc[4][4];
    for (int i = 0; i < 4; ++i) for (int j = 0; j < 4; ++j) acc[i][j] = 0.f;
    const int nr = (M - r0) < 4 ? (M - r0) : 4;
    for (int k = 0; k < K; k += 4) {
        float a[4][4], w[4][4];
        for (int i = 0; i < 4; ++i) for (int kk = 0; kk < 4; ++kk) a[i][kk] = (i < nr) ? A[(size_t)(r0 + i) * lda + k + kk] : 0.f;
        for (int kk = 0; kk < 4; ++kk) for (int j = 0; j < 4; ++j) w[kk][j] = W[(size_t)(k + kk) * N + c0 + j];
        for (int i = 0; i < 4; ++i) for (int kk = 0; kk < 4; ++kk) for (int j = 0; j < 4; ++j) acc[i][j] += a[i][kk] * w[kk][j];
    }
    for (int i = 0; i < nr; ++i) for (int j = 0; j < 4; ++j) C[(size_t)(r0 + i) * N + c0 + j] = acc[i][j];
}
__global__ void k_swiglu(const float* t1, float* act, int rows, int dff) {
    size_t i = (size_t)blockIdx.x * blockDim.x + threadIdx.x;
    if (i >= (size_t)rows * dff) return;
    const int m = (int)(i / dff), j = (int)(i % dff);
    const float g = t1[(size_t)m * 2 * dff + j], u = t1[(size_t)m * 2 * dff + dff + j];
    act[i] = g / (1.0f + expf(-g)) * u;
}
__global__ void k_axpy(float* h, const float* y, float coef, size_t n) {
    size_t i = (size_t)blockIdx.x * blockDim.x + threadIdx.x;
    if (i < n) h[i] += coef * y[i];
}
__global__ void k_conv(const float* t1, const float* state  , const float* wc  , float* z, float* out, int layer) {
    size_t i = (size_t)blockIdx.x * blockDim.x + threadIdx.x;
    if (i >= (size_t)MT * D_MODEL) return;
    const int m = (int)(i / D_MODEL), ch = (int)(i % D_MODEL);
    const RowInfo ri = row_info(m);
    const float* r = t1 + (size_t)m * 3 * D_MODEL;
    const float b = r[ch], u0 = r[D_MODEL + ch] * r[2 * D_MODEL + ch];
    float u1, u2;
    if (ri.t >= 1) { const float* p = r - 3 * D_MODEL; u1 = p[D_MODEL + ch] * p[2 * D_MODEL + ch]; }
    else u1 = (ri.seq < BATCH) ? 0.f : state[((size_t)(ri.seq - BATCH) * 2 + 1) * D_MODEL + ch];
    if (ri.t >= 2) { const float* p = r - 6 * D_MODEL; u2 = p[D_MODEL + ch] * p[2 * D_MODEL + ch]; }
    else if (ri.seq < BATCH) u2 = 0.f;
    else u2 = (ri.t == 1) ? state[((size_t)(ri.seq - BATCH) * 2 + 1) * D_MODEL + ch] : state[((size_t)(ri.seq - BATCH) * 2 + 0) * D_MODEL + ch];
    z[i] = b * (wc[ch] * u2 + wc[D_MODEL + ch] * u1 + wc[2 * D_MODEL + ch] * u0);
    const int L = seq_len(ri.seq);
    if (ri.t >= L - 2) {
        const int j = ri.t - (L - 2);
        if (ri.seq < BATCH) out[O_CP + (((size_t)layer * BATCH + ri.seq) * 2 + j) * D_MODEL + ch] = u0;
        else out[O_CS + (((size_t)layer * DEC_BATCH + (ri.seq - BATCH)) * 2 + j) * D_MODEL + ch] = u0;
    }
}
__device__ inline void head_norm(float* v, const float* g) {
    float s = 0.f; for (int d = 0; d < HD; ++d) s += v[d] * v[d];
    const float r = 1.0f / sqrtf(s / HD + EPS);
    for (int d = 0; d < HD; ++d) v[d] = v[d] * r * g[d];
}
__device__ inline void rope_cs(float ang, float& c, float& s) {
    const double r = (double)ang * 0.15915494309189535; const float fr = (float)(r - rint(r));
#ifdef CPU_TEST
    c = (float)cos(6.283185307179586 * (double)fr); s = (float)sin(6.283185307179586 * (double)fr);
#else
    c = __builtin_amdgcn_cosf(fr); s = __builtin_amdgcn_sinf(fr);
#endif
}
__device__ inline void head_rope(float* v, int pos) {
    for (int i = 0; i < 8; ++i) {
        const float ang = (float)pos * INV_FREQ[i]; float c, s; rope_cs(ang, c, s);
        const float x1 = v[i], x2 = v[8 + i];
        v[i] = x1 * c - x2 * s; v[8 + i] = x2 * c + x1 * s;
    }
}
__global__ void __launch_bounds__(64) k_kvprep(const float* p, const float* k_norm  , float* out, float* winrows) {
    int i = blockIdx.x * blockDim.x + threadIdx.x;
    if (i >= MT * 6 * N_KV) return;
    const int m = i / (6 * N_KV), e = (i / N_KV) % 6, g = i % N_KV;
    const RowInfo ri = row_info(m);
    float v[HD];
    for (int d = 0; d < HD; ++d) v[d] = p[(size_t)m * KVW + (e * N_KV + g) * HD + d];
    if (e == 2) { head_norm(v, k_norm + HD); head_rope(v, ri.pos); }
    if (e == 4) { head_norm(v, k_norm + 2 * HD); head_rope(v, ri.pos); }
    if (e < 4) {
        float* o = (ri.seq < BATCH) ? out + O_KVP + (((size_t)m * 4 + e) * N_KV + g) * HD : out + O_KVS + (((size_t)(m - MP) * 4 + e) * N_KV + g) * HD;
        for (int d = 0; d < HD; ++d) o[d] = v[d];
    } else {
        const int we = e - 4;
        float* w = winrows + (((size_t)m * 2 + we) * N_KV + g) * HD;
        for (int d = 0; d < HD; ++d) w[d] = v[d];
        if (ri.seq < BATCH) { if (ri.t >= SEQ - WINDOW) { float* o = out + O_WP + ((((size_t)ri.seq * WINDOW + (ri.t - (SEQ - WINDOW))) * 2 + we) * N_KV + g) * HD; for (int d = 0; d < HD; ++d) o[d] = v[d]; } }
        else { float* o = out + O_WS + ((((size_t)(ri.seq - BATCH) * WINDOW + (WINDOW - DEC_SEQ + ri.t)) * 2 + we) * N_KV + g) * HD; for (int d = 0; d < HD; ++d) o[d] = v[d]; }
    }
}
__global__ void k_wincopy(const float* cache_win, float* out) {
    size_t i = (size_t)blockIdx.x * blockDim.x + threadIdx.x;
    const size_t per = (size_t)(WINDOW - DEC_SEQ) * 2 * N_KV * HD;
    if (i >= (size_t)DEC_BATCH * per) return;
    const size_t b = i / per, r = i % per;
    out[O_WS + b * WINDOW * 2 * N_KV * HD + r] = cache_win[b * WINDOW * 2 * N_KV * HD + (size_t)DEC_SEQ * 2 * N_KV * HD + r];
}
struct KvSrc { const float* cache_kv; const int* page_table; const float* out; };
__device__ inline const float* kv_full_ptr(const KvSrc& S, int seq, int tok, int e, int g) {
    if (seq < BATCH) return S.out + O_KVP + ((((size_t)seq * SEQ + tok) * 4 + e) * N_KV + g) * HD;
    const int b = seq - BATCH;
    if (tok < PAST_LEN) { const int page = S.page_table[b * N_PAGES + tok / PAGE_SIZE]; return S.cache_kv + ((((size_t)page * PAGE_SIZE + tok % PAGE_SIZE) * 4 + e) * N_KV + g) * HD; }
    if (tok < PAST_LEN + DEC_SEQ) return S.out + O_KVS + ((((size_t)b * DEC_SEQ + (tok - PAST_LEN)) * 4 + e) * N_KV + g) * HD;
    return nullptr;
}
__device__ inline int seq_nbc(int seq) { return seq < BATCH ? NBC_P : NBC_S; }
__global__ void k_cmp_hid(KvSrc S, const float* pe  , const float* w1  , float* hid) {
    size_t i = (size_t)blockIdx.x * blockDim.x + threadIdx.x;
    if (i >= (size_t)NSEQ * NBC_MAX * 2 * N_KV * CMP_HID) return;
    const int f = (int)(i % CMP_HID), g = (int)((i / CMP_HID) % N_KV), e = (int)((i / ((size_t)CMP_HID * N_KV)) % 2), c = (int)((i / ((size_t)CMP_HID * N_KV * 2)) % NBC_MAX), seq = (int)(i / ((size_t)CMP_HID * N_KV * 2 * NBC_MAX));
    if (c >= seq_nbc(seq)) return;
    float s = 0.f;
    for (int l = 0; l < L_CMP; ++l) {
        const float* r = kv_full_ptr(S, seq, c * L_CMP + l, e, g);
        const float* w = w1 + (((size_t)e * L_CMP + l) * HD) * CMP_HID + f; const float* pp = pe + ((size_t)e * L_CMP + l) * HD;
        for (int d = 0; d < HD; ++d) s += ((r ? r[d] : 0.f) + pp[d]) * w[(size_t)d * CMP_HID];
    }
    const float x = s; const float t = tanhf(0.7978845608028654f * (x + 0.044715f * x * x * x));
    hid[i] = 0.5f * x * (1.0f + t);
}
__global__ void __launch_bounds__(64) k_cmp_out(const float* hid, const float* w2  , const float* k_norm0, float* kc, float* vc) {
    int i = blockIdx.x * blockDim.x + threadIdx.x;
    if (i >= NSEQ * NBC_MAX * 2 * N_KV) return;
    const int g = i % N_KV, e = (i / N_KV) % 2, c = (i / (2 * N_KV)) % NBC_MAX, seq = i / (2 * N_KV * NBC_MAX);
    if (c >= seq_nbc(seq)) return;
    const float* hr = hid + (size_t)i * CMP_HID;
    float v[HD];
    for (int d = 0; d < HD; ++d) { float s = 0.f; for (int f = 0; f < CMP_HID; ++f) s += hr[f] * w2[((size_t)e * CMP_HID + f) * HD + d]; v[d] = s; }
    if (e == 0) head_norm(v, k_norm0);
    float* o = (e == 0 ? kc : vc) + (((size_t)seq * NBC_MAX + c) * N_KV + g) * HD;
    for (int d = 0; d < HD; ++d) o[d] = v[d];
}
__global__ void __launch_bounds__(64) k_qprep(const float* qg, const float* q_norm, float* qn, float* qr, float* gates) {
    int i = blockIdx.x * blockDim.x + threadIdx.x;
    if (i >= MT * N_HEADS) return;
    const int m = i / N_HEADS, hh = i % N_HEADS;
    const RowInfo ri = row_info(m);
    float v[HD];
    for (int d = 0; d < HD; ++d) v[d] = qg[(size_t)m * QGW + hh * HD + d];
    head_norm(v, q_norm);
    for (int d = 0; d < HD; ++d) qn[(size_t)m * HDM + hh * HD + d] = v[d];
    head_rope(v, ri.pos);
    for (int d = 0; d < HD; ++d) qr[(size_t)m * HDM + hh * HD + d] = v[d];
    for (int j = 0; j < 3; ++j) { const float x = qg[(size_t)m * QGW + HDM + hh * 3 + j]; gates[(size_t)m * 3 * N_HEADS + hh * 3 + j] = 1.0f / (1.0f + expf(-x)); }
}
__global__ void __launch_bounds__(64) k_attn_cmp(const float* qn, const float* kc, const float* vc, float* pbuf, float* oc) {
    int i = blockIdx.x * blockDim.x + threadIdx.x;
    if (i >= MT * N_HEADS) return;
    const int m = i / N_HEADS, hh = i % N_HEADS, g = hh / HPG;
    const RowInfo ri = row_info(m);
    const int nbc = seq_nbc(ri.seq);
    const float* q = qn + (size_t)m * HDM + hh * HD;
    float* p = pbuf + (size_t)i * NBC_MAX;
    float mx = NEGF;
    for (int c = 0; c < nbc; ++c) {
        const bool vis = (c + 1) * L_CMP - 1 <= ri.pos;
        float s = 0.f; const float* k = kc + (((size_t)ri.seq * NBC_MAX + c) * N_KV + g) * HD;
        for (int d = 0; d < HD; ++d) s += q[d] * k[d];
        s *= 0.125f; p[c] = s; if (vis && s > mx) mx = s;
    }
    float sum = 0.f;
    for (int c = 0; c < nbc; ++c) { const bool vis = (c + 1) * L_CMP - 1 <= ri.pos; const float e = vis ? expf(p[c] - mx) : 0.f; p[c] = e; sum += e; }
    const float inv = 1.0f / fmaxf(sum, TINYF);
    float o[HD]; for (int d = 0; d < HD; ++d) o[d] = 0.f;
    for (int c = 0; c < nbc; ++c) { p[c] *= inv; if (p[c] != 0.f) { const float* v = vc + (((size_t)ri.seq * NBC_MAX + c) * N_KV + g) * HD; for (int d = 0; d < HD; ++d) o[d] += p[c] * v[d]; } }
    for (int d = 0; d < HD; ++d) oc[(size_t)m * HDM + hh * HD + d] = o[d];
}
__global__ void __launch_bounds__(64) k_topk(const float* pbuf, int* sel, float* scorebuf  ) {
    int i = blockIdx.x * blockDim.x + threadIdx.x;
    if (i >= MT * N_KV) return;
    const int m = i / N_KV, g = i % N_KV;
    const RowInfo ri = row_info(m);
    const int nbs = ri.seq < BATCH ? NBS_P : NBS_S, cur = ri.pos / L_SEL;
    float* score = scorebuf + (size_t)i * NBS_MAX;
    for (int b = 0; b < nbs; ++b) {
        float imp = 0.f;
        for (int h = 0; h < HPG; ++h) { const float* p = pbuf + ((size_t)m * N_HEADS + g * HPG + h) * NBC_MAX; imp += p[2 * b]; }
        float imp2 = 0.f;
        for (int h = 0; h < HPG; ++h) { const float* p = pbuf + ((size_t)m * N_HEADS + g * HPG + h) * NBC_MAX; imp2 += p[2 * b + 1]; }
        const bool forced = (b == 0) || (b == cur) || (b == cur - 1), valid = b * L_SEL <= ri.pos;
        score[b] = valid ? (forced ? FORCE_SCORE : imp + imp2) : NEGF;
    }
    const int nsel = N_SEL < nbs ? N_SEL : nbs;
    for (int j = 0; j < N_SEL; ++j) {
        if (j >= nsel) { sel[(size_t)i * N_SEL + j] = -1; continue; }
        int best = -1; float bv = 0.f;
        for (int b = 0; b < nbs; ++b) if (score[b] > -3e38f && (best < 0 || score[b] > bv)) { best = b; bv = score[b]; }
        sel[(size_t)i * N_SEL + j] = best; score[best] = -3.4e38f;
    }
}
__global__ void __launch_bounds__(64) k_attn_sel(KvSrc S, const float* qr, const int* sel, float* os) {
    int i = blockIdx.x * blockDim.x + threadIdx.x;
    if (i >= MT * N_HEADS) return;
    const int m = i / N_HEADS, hh = i % N_HEADS, g = hh / HPG;
    const RowInfo ri = row_info(m);
    const float* q = qr + (size_t)m * HDM + hh * HD;
    const int* sl = sel + ((size_t)m * N_KV + g) * N_SEL;
    float mx = NEGF;
    for (int j = 0; j < N_SEL; ++j) { const int b = sl[j]; if (b < 0) continue;
        for (int t = 0; t < L_SEL; ++t) { const int tok = b * L_SEL + t; if (tok > ri.pos) continue;
            const float* k = kv_full_ptr(S, ri.seq, tok, 2, g); float s = 0.f; if (k) for (int d = 0; d < HD; ++d) s += q[d] * k[d];
            s *= 0.125f; if (s > mx) mx = s; } }
    float sum = 0.f, o[HD]; for (int d = 0; d < HD; ++d) o[d] = 0.f;
    for (int j = 0; j < N_SEL; ++j) { const int b = sl[j]; if (b < 0) continue;
        for (int t = 0; t < L_SEL; ++t) { const int tok = b * L_SEL + t; if (tok > ri.pos) continue;
            const float* k = kv_full_ptr(S, ri.seq, tok, 2, g); float s = 0.f; if (k) for (int d = 0; d < HD; ++d) s += q[d] * k[d];
            const float e = expf(s * 0.125f - mx); sum += e;
            const float* v = kv_full_ptr(S, ri.seq, tok, 3, g); if (v) for (int d = 0; d < HD; ++d) o[d] += e * v[d]; } }
    const float inv = 1.0f / fmaxf(sum, TINYF);
    for (int d = 0; d < HD; ++d) os[(size_t)m * HDM + hh * HD + d] = o[d] * inv;
}
__device__ inline const float* win_ptr(const float* cache_win, const float* winrows, int seq, int kp) {
    if (seq < BATCH) return kp >= 0 ? winrows + (size_t)(seq * SEQ + kp) * 2 * N_KV * HD : nullptr;
    const int b = seq - BATCH;
    if (kp >= PAST_LEN) return winrows + (size_t)(MP + b * DEC_SEQ + (kp - PAST_LEN)) * 2 * N_KV * HD;
    const int j = kp - (PAST_LEN - WINDOW);
    return j >= 0 ? cache_win + ((size_t)b * WINDOW + j) * 2 * N_KV * HD : nullptr;
}
__global__ void __launch_bounds__(64) k_attn_win(const float* cache_win, const float* winrows, const float* qr, const float* gates, const float* oc, const float* os, float* o_out) {
    int i = blockIdx.x * blockDim.x + threadIdx.x;
    if (i >= MT * N_HEADS) return;
    const int m = i / N_HEADS, hh = i % N_HEADS, g = hh / HPG;
    const RowInfo ri = row_info(m);
    const float* q = qr + (size_t)m * HDM + hh * HD;
    float mx = NEGF;
    for (int kp = ri.pos - WINDOW; kp <= ri.pos; ++kp) { const float* r = win_ptr(cache_win, winrows, ri.seq, kp); if (!r) continue;
        const float* k = r + (0 * N_KV + g) * HD; float s = 0.f; for (int d = 0; d < HD; ++d) s += q[d] * k[d]; s *= 0.125f; if (s > mx) mx = s; }
    float sum = 0.f, o[HD]; for (int d = 0; d < HD; ++d) o[d] = 0.f;
    for (int kp = ri.pos - WINDOW; kp <= ri.pos; ++kp) { const float* r = win_ptr(cache_win, winrows, ri.seq, kp); if (!r) continue;
        const float* k = r + (0 * N_KV + g) * HD; float s = 0.f; for (int d = 0; d < HD; ++d) s += q[d] * k[d];
        const float e = expf(s * 0.125f - mx); sum += e; const float* v = r + (1 * N_KV + g) * HD; for (int d = 0; d < HD; ++d) o[d] += e * v[d]; }
    const float inv = 1.0f / fmaxf(sum, TINYF);
    const float* gt = gates + (size_t)m * 3 * N_HEADS + hh * 3;
    for (int d = 0; d < HD; ++d) { const size_t x = (size_t)m * HDM + hh * HD + d; o_out[x] = gt[0] * oc[x] + gt[1] * os[x] + gt[2] * o[d] * inv; }
}

static inline unsigned cdiv(size_t a, size_t b) { return (unsigned)((a + b - 1) / b); }
extern "C" void kernel_launch(void* const* d_in, const int* in_sizes, int n_in, void* d_out, int out_size, void* d_ws, size_t ws_size, hipStream_t stream) {
    const float* x_prompt = (const float*)d_in[0]; const float* x_sample = (const float*)d_in[1]; const float* cache_kv = (const float*)d_in[2];
    const float* cache_win = (const float*)d_in[3]; const float* state_conv = (const float*)d_in[4]; const int* page_table = (const int*)d_in[5];
    const float* ffn_a_norm = (const float*)d_in[6]; const float* ffn_a_w_in = (const float*)d_in[7]; const float* ffn_a_w_out = (const float*)d_in[8];
    const float* mix_norm = (const float*)d_in[9]; const float* ffn_b_norm = (const float*)d_in[10]; const float* ffn_b_w_in = (const float*)d_in[11];
    const float* ffn_b_w_out = (const float*)d_in[12]; const float* conv_w_in = (const float*)d_in[13]; const float* conv_w = (const float*)d_in[14];
    const float* conv_w_out = (const float*)d_in[15]; const float* kv_norm = (const float*)d_in[16]; const float* w_kv = (const float*)d_in[17];
    const float* k_norm = (const float*)d_in[18]; const float* cmp_pe = (const float*)d_in[19]; const float* cmp_w1 = (const float*)d_in[20];
    const float* cmp_w2 = (const float*)d_in[21]; const float* nsa_w_qg = (const float*)d_in[22]; const float* nsa_q_norm = (const float*)d_in[23];
    const float* nsa_w_o = (const float*)d_in[24];
    float* out = (float*)d_out;
    float* ws = (float*)d_ws; size_t off = 0;
    auto take = [&](size_t n) { float* p = ws + off; off += (n + 63) / 64 * 64; return p; };
    float* h = take((size_t)MT * D_MODEL); float* xn = take((size_t)MT * D_MODEL);
    float* t1 = take((size_t)MT * 2 * D_FF > (size_t)MT * 3 * D_MODEL ? (size_t)MT * 2 * D_FF : (size_t)MT * 3 * D_MODEL);
    float* act = take((size_t)MT * (D_FF > D_MODEL ? D_FF : D_MODEL)); float* t2 = take((size_t)MT * D_MODEL);
    float* winrows = take((size_t)MT * 2 * N_KV * HD); float* hid = take((size_t)NSEQ * NBC_MAX * 2 * N_KV * CMP_HID);
    float* kc = take((size_t)NSEQ * NBC_MAX * N_KV * HD); float* vc = take((size_t)NSEQ * NBC_MAX * N_KV * HD);
    float* qn = take((size_t)MT * HDM); float* qr = take((size_t)MT * HDM); float* gates = take((size_t)MT * 3 * N_HEADS);
    float* pbuf = take((size_t)MT * N_HEADS * NBC_MAX); float* oc = take((size_t)MT * HDM); float* os = take((size_t)MT * HDM);
    int* sel = (int*)take((size_t)MT * N_KV * N_SEL); float* scorebuf = take((size_t)MT * N_KV * NBS_MAX);
    const KvSrc S{cache_kv, page_table, out};
    const size_t nh = (size_t)MT * D_MODEL;
    LAUNCH(k_copy, cdiv((size_t)MP * D_MODEL, 256), 256, stream, x_prompt, h, (size_t)MP * D_MODEL);
    LAUNCH(k_copy, cdiv((size_t)MS * D_MODEL, 256), 256, stream, x_sample, h + (size_t)MP * D_MODEL, (size_t)MS * D_MODEL);
    auto gemm = [&](const float* A, int lda, const float* W, float* C, int M, int N, int K) { LAUNCH(k_gemm, dim3(cdiv(N, 64), cdiv(M, 64)), 256, stream, A, lda, W, C, M, N, K); };
    auto ffn = [&](const float* norm, const float* w_in, const float* w_out) {
        LAUNCH(k_rmsnorm, cdiv(MT, 64), 64, stream, (const float*)h, norm, xn, MT, D_MODEL);
        gemm(xn, D_MODEL, w_in, t1, MT, 2 * D_FF, D_MODEL);
        LAUNCH(k_swiglu, cdiv((size_t)MT * D_FF, 256), 256, stream, (const float*)t1, act, MT, D_FF);
        gemm(act, D_FF, w_out, t2, MT, D_MODEL, D_FF);
        LAUNCH(k_axpy, cdiv(nh, 256), 256, stream, h, (const float*)t2, 0.5f, nh);
    };
    for (int layer = 0; layer < DEPTH; ++layer) {
        ffn(ffn_a_norm + (size_t)layer * D_MODEL, ffn_a_w_in + (size_t)layer * D_MODEL * 2 * D_FF, ffn_a_w_out + (size_t)layer * D_FF * D_MODEL);
        LAUNCH(k_rmsnorm, cdiv(MT, 64), 64, stream, (const float*)h, mix_norm + (size_t)layer * D_MODEL, xn, MT, D_MODEL);
        if (layer < N_A) {
            gemm(xn, D_MODEL, conv_w_in + (size_t)layer * D_MODEL * 3 * D_MODEL, t1, MT, 3 * D_MODEL, D_MODEL);
            LAUNCH(k_conv, cdiv(nh, 256), 256, stream, (const float*)t1, state_conv + (size_t)layer * DEC_BATCH * 2 * D_MODEL, conv_w + (size_t)layer * 3 * D_MODEL, act, out, layer);
            gemm(act, D_MODEL, conv_w_out + (size_t)layer * D_MODEL * D_MODEL, t2, MT, D_MODEL, D_MODEL);
        } else {
            const int b = layer - N_A;
            gemm(xn, D_MODEL, nsa_w_qg + (size_t)b * D_MODEL * QGW, t1, MT, QGW, D_MODEL);
            LAUNCH(k_qprep, cdiv((size_t)MT * N_HEADS, 64), 64, stream, (const float*)t1, nsa_q_norm + (size_t)b * HD, qn, qr, gates);
            LAUNCH(k_attn_cmp, cdiv((size_t)MT * N_HEADS, 64), 64, stream, (const float*)qn, (const float*)kc, (const float*)vc, pbuf, oc);
            LAUNCH(k_topk, cdiv((size_t)MT * N_KV, 64), 64, stream, (const float*)pbuf, sel, scorebuf);
            LAUNCH(k_attn_sel, cdiv((size_t)MT * N_HEADS, 64), 64, stream, S, (const float*)qr, (const int*)sel, os);
            LAUNCH(k_attn_win, cdiv((size_t)MT * N_HEADS, 64), 64, stream, cache_win, (const float*)winrows, (const float*)qr, (const float*)gates, (const float*)oc, (const float*)os, act);
            gemm(act, HDM, nsa_w_o + (size_t)b * HDM * D_MODEL, t2, MT, D_MODEL, HDM);
        }
        LAUNCH(k_axpy, cdiv(nh, 256), 256, stream, h, (const float*)t2, 1.0f, nh);
        ffn(ffn_b_norm + (size_t)layer * D_MODEL, ffn_b_w_in + (size_t)layer * D_MODEL * 2 * D_FF, ffn_b_w_out + (size_t)layer * D_FF * D_MODEL);
        if (layer == N_A - 1) {
            LAUNCH(k_rmsnorm, cdiv(MT, 64), 64, stream, (const float*)h, kv_norm, xn, MT, D_MODEL);
            gemm(xn, D_MODEL, w_kv, t1, MT, KVW, D_MODEL);
            LAUNCH(k_kvprep, cdiv((size_t)MT * 6 * N_KV, 64), 64, stream, (const float*)t1, k_norm, out, winrows);
            LAUNCH(k_wincopy, cdiv((size_t)DEC_BATCH * (WINDOW - DEC_SEQ) * 2 * N_KV * HD, 256), 256, stream, cache_win, out);
            LAUNCH(k_cmp_hid, cdiv((size_t)NSEQ * NBC_MAX * 2 * N_KV * CMP_HID, 256), 256, stream, S, cmp_pe, cmp_w1, hid);
            LAUNCH(k_cmp_out, cdiv((size_t)NSEQ * NBC_MAX * 2 * N_KV, 64), 64, stream, (const float*)hid, cmp_w2, k_norm, kc, vc);
        }
    }
    LAUNCH(k_copy, cdiv((size_t)MP * D_MODEL, 256), 256, stream, (const float*)h, out + O_YP, (size_t)MP * D_MODEL);
    LAUNCH(k_copy, cdiv((size_t)MS * D_MODEL, 256), 256, stream, (const float*)(h + (size_t)MP * D_MODEL), out + O_YS, (size_t)MS * D_MODEL);
}
```

```cpp
#ifdef CPU_TEST
#include "shim.h"
#else
#include <hip/hip_runtime.h>
#endif
#include <cstdint>
#include <cstddef>
#include <cmath>

#ifdef CFG_SMALL
constexpr int D_MODEL = 256, BATCH = 1, SEQ = 2048, DEPTH = 4, DEC_BATCH = 2, DEC_SEQ = 8, PAST_LEN = 2048, PAGE_SIZE = 128, D_FF = 192, N_HEADS = 4, N_KV = 2;
#else
constexpr int D_MODEL = 1024, BATCH = 4, SEQ = 4096, DEPTH = 4, DEC_BATCH = 32, DEC_SEQ = 8, PAST_LEN = 8192, PAGE_SIZE = 128, D_FF = 2816, N_HEADS = 16, N_KV = 4;
#endif
constexpr int N_A = DEPTH / 2, N_B = DEPTH - N_A, HD = 64, HPG = N_HEADS / N_KV, L_CMP = 32, L_SEL = 64, N_SEL = 16, WINDOW = 512, CMP_HID = 4 * HD;
constexpr int MP = BATCH * SEQ, MS = DEC_BATCH * DEC_SEQ, MT = MP + MS, NSEQ = BATCH + DEC_BATCH;
constexpr int N_PAGES = PAST_LEN / PAGE_SIZE;
constexpr int KVW = 6 * N_KV * HD;
constexpr int QGW = N_HEADS * HD + 3 * N_HEADS;
constexpr int HDM = N_HEADS * HD;
constexpr int TPAD_S = ((PAST_LEN + DEC_SEQ + L_SEL - 1) / L_SEL) * L_SEL;
constexpr int NBC_P = SEQ / L_CMP, NBC_S = TPAD_S / L_CMP, NBC_MAX = NBC_S > NBC_P ? NBC_S : NBC_P;
constexpr int NBS_P = SEQ / L_SEL, NBS_S = TPAD_S / L_SEL, NBS_MAX = NBS_S > NBS_P ? NBS_S : NBS_P;
constexpr float EPS = 1e-6f, NEGF = -1e30f, TINYF = 1e-30f, FORCE_SCORE = 1e4f;
__device__ static const float INV_FREQ[8] = {1.0f, 0.1939227432012558f, 0.03760603070259094f, 0.007292664609849453f, 0.0014142135623842478f, 0.00027424818836152554f, 5.3182957344688475e-05f, 1.0313385246263351e-05f};

constexpr size_t O_YP = 0, O_YS = O_YP + (size_t)MP * D_MODEL, O_KVP = O_YS + (size_t)MS * D_MODEL, O_KVS = O_KVP + (size_t)MP * 4 * N_KV * HD,
                 O_WP = O_KVS + (size_t)MS * 4 * N_KV * HD, O_WS = O_WP + (size_t)BATCH * WINDOW * 2 * N_KV * HD, O_CP = O_WS + (size_t)DEC_BATCH * WINDOW * 2 * N_KV * HD,
                 O_CS = O_CP + (size_t)N_A * BATCH * 2 * D_MODEL, O_END = O_CS + (size_t)N_A * DEC_BATCH * 2 * D_MODEL;

struct RowInfo { int seq, t, pos; };
__device__ __host__ inline RowInfo row_info(int m) {
    RowInfo r;
    if (m < MP) { r.seq = m / SEQ; r.t = m % SEQ; r.pos = r.t; }
    else { const int q = m - MP; r.seq = BATCH + q / DEC_SEQ; r.t = q % DEC_SEQ; r.pos = PAST_LEN + r.t; }
    return r;
}
__device__ __host__ inline int seq_row0(int seq) { return seq < BATCH ? seq * SEQ : MP + (seq - BATCH) * DEC_SEQ; }
__device__ __host__ inline int seq_pos0(int seq) { return seq < BATCH ? 0 : PAST_LEN; }
__device__ __host__ inline int seq_len(int seq) { return seq < BATCH ? SEQ : DEC_SEQ; }

__device__ inline void copy_item(size_t i_, const float* a, float* b, size_t n) {
    const size_t i = i_;
    if (i < n) b[i] = a[i];
}
__device__ inline void rmsnorm_item(size_t i_, const float* x, const float* g, float* y, int rows, int d) {
    const int m = (int)i_;
    if (m >= rows) return;
    const float* xr = x + (size_t)m * d; float s = 0.f;
    for (int i = 0; i < d; ++i) s += xr[i] * xr[i];
    const float r = 1.0f / sqrtf(s / d + EPS);
    float* yr = y + (size_t)m * d;
    for (int i = 0; i < d; ++i) yr[i] = xr[i] * r * g[i];
}
__device__ inline void gemm_item(size_t i_, const float* A, int lda, const float* W, float* C, int M, int N, int K) {
    const int nbx = (N + 63) / 64; const int vb = (int)(i_ / 256), t_ = (int)(i_ % 256), tx = t_ % 16, ty = t_ / 16;
    const int c0 = (vb % nbx) * 64 + tx * 4, r0 = (vb / nbx) * 64 + ty * 4;
    if (c0 >= N || r0 >= M) return;
    float acc[4][4];
    for (int i = 0; i < 4; ++i) for (int j = 0; j < 4; ++j) acc[i][j] = 0.f;
    const int nr = (M - r0) < 4 ? (M - r0) : 4;
    for (int k = 0; k < K; k += 4) {
        float a[4][4], w[4][4];
        for (int i = 0; i < 4; ++i) for (int kk = 0; kk < 4; ++kk) a[i][kk] = (i < nr) ? A[(size_t)(r0 + i) * lda + k + kk] : 0.f;
        for (int kk = 0; kk < 4; ++kk) for (int j = 0; j < 4; ++j) w[kk][j] = W[(size_t)(k + kk) * N + c0 + j];
        for (int i = 0; i < 4; ++i) for (int kk = 0; kk < 4; ++kk) for (int j = 0; j < 4; ++j) acc[i][j] += a[i][kk] * w[kk][j];
    }
    for (int i = 0; i < nr; ++i) for (int j = 0; j < 4; ++j) C[(size_t)(r0 + i) * N + c0 + j] = acc[i][j];
}
__device__ inline void swiglu_item(size_t i_, const float* t1, float* act, int rows, int dff) {
    const size_t i = i_;
    if (i >= (size_t)rows * dff) return;
    const int m = (int)(i / dff), j = (int)(i % dff);
    const float g = t1[(size_t)m * 2 * dff + j], u = t1[(size_t)m * 2 * dff + dff + j];
    act[i] = g / (1.0f + expf(-g)) * u;
}
__device__ inline void axpy_item(size_t i_, float* h, const float* y, float coef, size_t n) {
    const size_t i = i_;
    if (i < n) h[i] += coef * y[i];
}
__device__ inline void conv_item(size_t i_, const float* t1, const float* state  , const float* wc  , float* z, float* out, int layer) {
    const size_t i = i_;
    if (i >= (size_t)MT * D_MODEL) return;
    const int m = (int)(i / D_MODEL), ch = (int)(i % D_MODEL);
    const RowInfo ri = row_info(m);
    const float* r = t1 + (size_t)m * 3 * D_MODEL;
    const float b = r[ch], u0 = r[D_MODEL + ch] * r[2 * D_MODEL + ch];
    float u1, u2;
    if (ri.t >= 1) { const float* p = r - 3 * D_MODEL; u1 = p[D_MODEL + ch] * p[2 * D_MODEL + ch]; }
    else u1 = (ri.seq < BATCH) ? 0.f : state[((size_t)(ri.seq - BATCH) * 2 + 1) * D_MODEL + ch];
    if (ri.t >= 2) { const float* p = r - 6 * D_MODEL; u2 = p[D_MODEL + ch] * p[2 * D_MODEL + ch]; }
    else if (ri.seq < BATCH) u2 = 0.f;
    else u2 = (ri.t == 1) ? state[((size_t)(ri.seq - BATCH) * 2 + 1) * D_MODEL + ch] : state[((size_t)(ri.seq - BATCH) * 2 + 0) * D_MODEL + ch];
    z[i] = b * (wc[ch] * u2 + wc[D_MODEL + ch] * u1 + wc[2 * D_MODEL + ch] * u0);
    const int L = seq_len(ri.seq);
    if (ri.t >= L - 2) {
        const int j = ri.t - (L - 2);
        if (ri.seq < BATCH) out[O_CP + (((size_t)layer * BATCH + ri.seq) * 2 + j) * D_MODEL + ch] = u0;
        else out[O_CS + (((size_t)layer * DEC_BATCH + (ri.seq - BATCH)) * 2 + j) * D_MODEL + ch] = u0;
    }
}
__device__ inline void head_norm(float* v, const float* g) {
    float s = 0.f; for (int d = 0; d < HD; ++d) s += v[d] * v[d];
    const float r = 1.0f / sqrtf(s / HD + EPS);
    for (int d = 0; d < HD; ++d) v[d] = v[d] * r * g[d];
}
__device__ inline void rope_cs(float ang, float& c, float& s) {
    const double r = (double)ang * 0.15915494309189535; const float fr = (float)(r - rint(r));
#ifdef CPU_TEST
    c = (float)cos(6.283185307179586 * (double)fr); s = (float)sin(6.283185307179586 * (double)fr);
#else
    c = __builtin_amdgcn_cosf(fr); s = __builtin_amdgcn_sinf(fr);
#endif
}
__device__ inline void head_rope(float* v, int pos) {
    for (int i = 0; i < 8; ++i) {
        const float ang = (float)pos * INV_FREQ[i]; float c, s; rope_cs(ang, c, s);
        const float x1 = v[i], x2 = v[8 + i];
        v[i] = x1 * c - x2 * s; v[8 + i] = x2 * c + x1 * s;
    }
}
__device__ inline void kvprep_item(size_t i_, const float* p, const float* k_norm  , float* out, float* winrows) {
    const int i = (int)i_;
    if (i >= MT * 6 * N_KV) return;
    const int m = i / (6 * N_KV), e = (i / N_KV) % 6, g = i % N_KV;
    const RowInfo ri = row_info(m);
    float v[HD];
    for (int d = 0; d < HD; ++d) v[d] = p[(size_t)m * KVW + (e * N_KV + g) * HD + d];
    if (e == 2) { head_norm(v, k_norm + HD); head_rope(v, ri.pos); }
    if (e == 4) { head_norm(v, k_norm + 2 * HD); head_rope(v, ri.pos); }
    if (e < 4) {
        float* o = (ri.seq < BATCH) ? out + O_KVP + (((size_t)m * 4 + e) * N_KV + g) * HD : out + O_KVS + (((size_t)(m - MP) * 4 + e) * N_KV + g) * HD;
        for (int d = 0; d < HD; ++d) o[d] = v[d];
    } else {
        const int we = e - 4;
        float* w = winrows + (((size_t)m * 2 + we) * N_KV + g) * HD;
        for (int d = 0; d < HD; ++d) w[d] = v[d];
        if (ri.seq < BATCH) { if (ri.t >= SEQ - WINDOW) { float* o = out + O_WP + ((((size_t)ri.seq * WINDOW + (ri.t - (SEQ - WINDOW))) * 2 + we) * N_KV + g) * HD; for (int d = 0; d < HD; ++d) o[d] = v[d]; } }
        else { float* o = out + O_WS + ((((size_t)(ri.seq - BATCH) * WINDOW + (WINDOW - DEC_SEQ + ri.t)) * 2 + we) * N_KV + g) * HD; for (int d = 0; d < HD; ++d) o[d] = v[d]; }
    }
}
__device__ inline void wincopy_item(size_t i_, const float* cache_win, float* out) {
    const size_t i = i_;
    const size_t per = (size_t)(WINDOW - DEC_SEQ) * 2 * N_KV * HD;
    if (i >= (size_t)DEC_BATCH * per) return;
    const size_t b = i / per, r = i % per;
    out[O_WS + b * WINDOW * 2 * N_KV * HD + r] = cache_win[b * WINDOW * 2 * N_KV * HD + (size_t)DEC_SEQ * 2 * N_KV * HD + r];
}
struct KvSrc { const float* cache_kv; const int* page_table; const float* out; };
__device__ inline const float* kv_full_ptr(const KvSrc& S, int seq, int tok, int e, int g) {
    if (seq < BATCH) return S.out + O_KVP + ((((size_t)seq * SEQ + tok) * 4 + e) * N_KV + g) * HD;
    const int b = seq - BATCH;
    if (tok < PAST_LEN) { const int page = S.page_table[b * N_PAGES + tok / PAGE_SIZE]; return S.cache_kv + ((((size_t)page * PAGE_SIZE + tok % PAGE_SIZE) * 4 + e) * N_KV + g) * HD; }
    if (tok < PAST_LEN + DEC_SEQ) return S.out + O_KVS + ((((size_t)b * DEC_SEQ + (tok - PAST_LEN)) * 4 + e) * N_KV + g) * HD;
    return nullptr;
}
__device__ inline int seq_nbc(int seq) { return seq < BATCH ? NBC_P : NBC_S; }
__device__ inline void cmp_hid_item(size_t i_, KvSrc S, const float* pe  , const float* w1  , float* hid) {
    const size_t i = i_;
    if (i >= (size_t)NSEQ * NBC_MAX * 2 * N_KV * CMP_HID) return;
    const int f = (int)(i % CMP_HID), g = (int)((i / CMP_HID) % N_KV), e = (int)((i / ((size_t)CMP_HID * N_KV)) % 2), c = (int)((i / ((size_t)CMP_HID * N_KV * 2)) % NBC_MAX), seq = (int)(i / ((size_t)CMP_HID * N_KV * 2 * NBC_MAX));
    if (c >= seq_nbc(seq)) return;
    float s = 0.f;
    for (int l = 0; l < L_CMP; ++l) {
        const float* r = kv_full_ptr(S, seq, c * L_CMP + l, e, g);
        const float* w = w1 + (((size_t)e * L_CMP + l) * HD) * CMP_HID + f; const float* pp = pe + ((size_t)e * L_CMP + l) * HD;
        for (int d = 0; d < HD; ++d) s += ((r ? r[d] : 0.f) + pp[d]) * w[(size_t)d * CMP_HID];
    }
    const float x = s; const float t = tanhf(0.7978845608028654f * (x + 0.044715f * x * x * x));
    hid[i] = 0.5f * x * (1.0f + t);
}
__device__ inline void cmp_out_item(size_t i_, const float* hid, const float* w2  , const float* k_norm0, float* kc, float* vc) {
    const int i = (int)i_;
    if (i >= NSEQ * NBC_MAX * 2 * N_KV) return;
    const int g = i % N_KV, e = (i / N_KV) % 2, c = (i / (2 * N_KV)) % NBC_MAX, seq = i / (2 * N_KV * NBC_MAX);
    if (c >= seq_nbc(seq)) return;
    const float* hr = hid + (size_t)i * CMP_HID;
    float v[HD];
    for (int d = 0; d < HD; ++d) { float s = 0.f; for (int f = 0; f < CMP_HID; ++f) s += hr[f] * w2[((size_t)e * CMP_HID + f) * HD + d]; v[d] = s; }
    if (e == 0) head_norm(v, k_norm0);
    float* o = (e == 0 ? kc : vc) + (((size_t)seq * NBC_MAX + c) * N_KV + g) * HD;
    for (int d = 0; d < HD; ++d) o[d] = v[d];
}
__device__ inline void qprep_item(size_t i_, const float* qg, const float* q_norm, float* qn, float* qr, float* gates) {
    const int i = (int)i_;
    if (i >= MT * N_HEADS) return;
    const int m = i / N_HEADS, hh = i % N_HEADS;
    const RowInfo ri = row_info(m);
    float v[HD];
    for (int d = 0; d < HD; ++d) v[d] = qg[(size_t)m * QGW + hh * HD + d];
    head_norm(v, q_norm);
    for (int d = 0; d < HD; ++d) qn[(size_t)m * HDM + hh * HD + d] = v[d];
    head_rope(v, ri.pos);
    for (int d = 0; d < HD; ++d) qr[(size_t)m * HDM + hh * HD + d] = v[d];
    for (int j = 0; j < 3; ++j) { const float x = qg[(size_t)m * QGW + HDM + hh * 3 + j]; gates[(size_t)m * 3 * N_HEADS + hh * 3 + j] = 1.0f / (1.0f + expf(-x)); }
}
__device__ inline void attn_cmp_item(size_t i_, const float* qn, const float* kc, const float* vc, float* pbuf, float* oc) {
    const int i = (int)i_;
    if (i >= MT * N_HEADS) return;
    const int m = i / N_HEADS, hh = i % N_HEADS, g = hh / HPG;
    const RowInfo ri = row_info(m);
    const int nbc = seq_nbc(ri.seq);
    const float* q = qn + (size_t)m * HDM + hh * HD;
    float* p = pbuf + (size_t)i * NBC_MAX;
    float mx = NEGF;
    for (int c = 0; c < nbc; ++c) {
        const bool vis = (c + 1) * L_CMP - 1 <= ri.pos;
        float s = 0.f; const float* k = kc + (((size_t)ri.seq * NBC_MAX + c) * N_KV + g) * HD;
        for (int d = 0; d < HD; ++d) s += q[d] * k[d];
        s *= 0.125f; p[c] = s; if (vis && s > mx) mx = s;
    }
    float sum = 0.f;
    for (int c = 0; c < nbc; ++c) { const bool vis = (c + 1) * L_CMP - 1 <= ri.pos; const float e = vis ? expf(p[c] - mx) : 0.f; p[c] = e; sum += e; }
    const float inv = 1.0f / fmaxf(sum, TINYF);
    float o[HD]; for (int d = 0; d < HD; ++d) o[d] = 0.f;
    for (int c = 0; c < nbc; ++c) { p[c] *= inv; if (p[c] != 0.f) { const float* v = vc + (((size_t)ri.seq * NBC_MAX + c) * N_KV + g) * HD; for (int d = 0; d < HD; ++d) o[d] += p[c] * v[d]; } }
    for (int d = 0; d < HD; ++d) oc[(size_t)m * HDM + hh * HD + d] = o[d];
}
__device__ inline void topk_item(size_t i_, const float* pbuf, int* sel, float* scorebuf  ) {
    const int i = (int)i_;
    if (i >= MT * N_KV) return;
    const int m = i / N_KV, g = i % N_KV;
    const RowInfo ri = row_info(m);
    const int nbs = ri.seq < BATCH ? NBS_P : NBS_S, cur = ri.pos / L_SEL;
    float* score = scorebuf + (size_t)i * NBS_MAX;
    for (int b = 0; b < nbs; ++b) {
        float imp = 0.f;
        for (int h = 0; h < HPG; ++h) { const float* p = pbuf + ((size_t)m * N_HEADS + g * HPG + h) * NBC_MAX; imp += p[2 * b]; }
        float imp2 = 0.f;
        for (int h = 0; h < HPG; ++h) { const float* p = pbuf + ((size_t)m * N_HEADS + g * HPG + h) * NBC_MAX; imp2 += p[2 * b + 1]; }
        const bool forced = (b == 0) || (b == cur) || (b == cur - 1), valid = b * L_SEL <= ri.pos;
        score[b] = valid ? (forced ? FORCE_SCORE : imp + imp2) : NEGF;
    }
    const int nsel = N_SEL < nbs ? N_SEL : nbs;
    for (int j = 0; j < N_SEL; ++j) {
        if (j >= nsel) { sel[(size_t)i * N_SEL + j] = -1; continue; }
        int best = -1; float bv = 0.f;
        for (int b = 0; b < nbs; ++b) if (score[b] > -3e38f && (best < 0 || score[b] > bv)) { best = b; bv = score[b]; }
        sel[(size_t)i * N_SEL + j] = best; score[best] = -3.4e38f;
    }
}
__device__ inline void attn_sel_item(size_t i_, KvSrc S, const float* qr, const int* sel, float* os) {
    const int i = (int)i_;
    if (i >= MT * N_HEADS) return;
    const int m = i / N_HEADS, hh = i % N_HEADS, g = hh / HPG;
    const RowInfo ri = row_info(m);
    const float* q = qr + (size_t)m * HDM + hh * HD;
    const int* sl = sel + ((size_t)m * N_KV + g) * N_SEL;
    float mx = NEGF;
    for (int j = 0; j < N_SEL; ++j) { const int b = sl[j]; if (b < 0) continue;
        for (int t = 0; t < L_SEL; ++t) { const int tok = b * L_SEL + t; if (tok > ri.pos) continue;
            const float* k = kv_full_ptr(S, ri.seq, tok, 2, g); float s = 0.f; if (k) for (int d = 0; d < HD; ++d) s += q[d] * k[d];
            s *= 0.125f; if (s > mx) mx = s; } }
    float sum = 0.f, o[HD]; for (int d = 0; d < HD; ++d) o[d] = 0.f;
    for (int j = 0; j < N_SEL; ++j) { const int b = sl[j]; if (b < 0) continue;
        for (int t = 0; t < L_SEL; ++t) { const int tok = b * L_SEL + t; if (tok > ri.pos) continue;
            const float* k = kv_full_ptr(S, ri.seq, tok, 2, g); float s = 0.f; if (k) for (int d = 0; d < HD; ++d) s += q[d] * k[d];
            const float e = expf(s * 0.125f - mx); sum += e;
            const float* v = kv_full_ptr(S, ri.seq, tok, 3, g); if (v) for (int d = 0; d < HD; ++d) o[d] += e * v[d]; } }
    const float inv = 1.0f / fmaxf(sum, TINYF);
    for (int d = 0; d < HD; ++d) os[(size_t)m * HDM + hh * HD + d] = o[d] * inv;
}
__device__ inline const float* win_ptr(const float* cache_win, const float* winrows, int seq, int kp) {
    if (seq < BATCH) return kp >= 0 ? winrows + (size_t)(seq * SEQ + kp) * 2 * N_KV * HD : nullptr;
    const int b = seq - BATCH;
    if (kp >= PAST_LEN) return winrows + (size_t)(MP + b * DEC_SEQ + (kp - PAST_LEN)) * 2 * N_KV * HD;
    const int j = kp - (PAST_LEN - WINDOW);
    return j >= 0 ? cache_win + ((size_t)b * WINDOW + j) * 2 * N_KV * HD : nullptr;
}
__device__ inline void attn_win_item(size_t i_, const float* cache_win, const float* winrows, const float* qr, const float* gates, const float* oc, const float* os, float* o_out) {
    const int i = (int)i_;
    if (i >= MT * N_HEADS) return;
    const int m = i / N_HEADS, hh = i % N_HEADS, g = hh / HPG;
    const RowInfo ri = row_info(m);
    const float* q = qr + (size_t)m * HDM + hh * HD;
    float mx = NEGF;
    for (int kp = ri.pos - WINDOW; kp <= ri.pos; ++kp) { const float* r = win_ptr(cache_win, winrows, ri.seq, kp); if (!r) continue;
        const float* k = r + (0 * N_KV + g) * HD; float s = 0.f; for (int d = 0; d < HD; ++d) s += q[d] * k[d]; s *= 0.125f; if (s > mx) mx = s; }
    float sum = 0.f, o[HD]; for (int d = 0; d < HD; ++d) o[d] = 0.f;
    for (int kp = ri.pos - WINDOW; kp <= ri.pos; ++kp) { const float* r = win_ptr(cache_win, winrows, ri.seq, kp); if (!r) continue;
        const float* k = r + (0 * N_KV + g) * HD; float s = 0.f; for (int d = 0; d < HD; ++d) s += q[d] * k[d];
        const float e = expf(s * 0.125f - mx); sum += e; const float* v = r + (1 * N_KV + g) * HD; for (int d = 0; d < HD; ++d) o[d] += e * v[d]; }
    const float inv = 1.0f / fmaxf(sum, TINYF);
    const float* gt = gates + (size_t)m * 3 * N_HEADS + hh * 3;
    for (int d = 0; d < HD; ++d) { const size_t x = (size_t)m * HDM + hh * HD + d; o_out[x] = gt[0] * oc[x] + gt[1] * os[x] + gt[2] * o[d] * inv; }
}


constexpr int NTHREADS = 512;
#ifndef CPU_TEST
#define LAS __attribute__((address_space(3)))
#define XB_TMO      128
#define XB_XCNT(j)  (256  + 64 * (j))
#define XB_XSUB(j)  (1280 + 64 * (j))
#define XB_XGEN(j)  (2304 + 64 * (j))
#define XB_TOP      3328
#define XB_TOPGEN   3392
#define XCD_BAR_WORDS 3456
#define XB_SPIN_CAP (1u << 25)
__device__ __forceinline__ unsigned xb_ld(unsigned* p)              { return __hip_atomic_load(p, __ATOMIC_RELAXED, __HIP_MEMORY_SCOPE_AGENT); }
__device__ __forceinline__ unsigned xb_add(unsigned* p, unsigned v) { return __hip_atomic_fetch_add(p, v, __ATOMIC_RELAXED, __HIP_MEMORY_SCOPE_AGENT); }
__device__ __forceinline__ unsigned xb_xcc_id() { return (unsigned)__builtin_amdgcn_s_getreg((3 << 11) | 20) & 0xFu; }
#define XB_SPIN(cond, bar) do { unsigned _sp = 0; while (cond) { __builtin_amdgcn_s_sleep(1); \
    if ((++_sp & 255u) == 0u) { if (xb_ld(&(bar)[XB_TMO])) break; if (_sp > XB_SPIN_CAP) { atomicAdd(&(bar)[XB_TMO], 1u); break; } } } } while (0)
struct XcdBarrier { unsigned* bar; unsigned x; volatile LAS unsigned* st; };
__device__ __forceinline__ XcdBarrier xcd_barrier_post(unsigned* bar, volatile LAS unsigned* st) {
    XcdBarrier b; b.bar = bar; b.x = xb_xcc_id(); b.st = st;
    if (threadIdx.x == 0) (void)xb_add(&bar[XB_XCNT(b.x)], 1u);
    return b;
}
__device__ __forceinline__ void xcd_barrier_complete(unsigned* bar, unsigned x, unsigned& nloc, unsigned& nx) {
    const unsigned G = gridDim.x * gridDim.y * gridDim.z;
    unsigned sum, cnt, mine, sp = 0u;
    for (;;) {
        sum = 0u; cnt = 0u; mine = 0u;
#pragma unroll
        for (unsigned j = 0; j < 16; ++j) { const unsigned c = xb_ld(&bar[XB_XCNT(j)]); sum += c; cnt += (c > 0u) ? 1u : 0u; mine = (j == x) ? c : mine; }
        if (sum == G) break;
        __builtin_amdgcn_s_sleep(1);
        if ((++sp & 255u) == 0u) { if (xb_ld(&bar[XB_TMO])) break; if (sp > XB_SPIN_CAP) { atomicAdd(&bar[XB_TMO], 1u); break; } }
    }
    nloc = mine > 0u ? mine : 1u; nx = cnt > 0u ? cnt : 1u;
}
__device__ __forceinline__ void xcd_barrier(const XcdBarrier& b) {
    asm volatile("s_waitcnt vmcnt(0)" ::: "memory");
    __syncthreads();
    if (threadIdx.x == 0) {
        unsigned* bar = b.bar; unsigned bx = xb_xcc_id(); asm volatile("" : "+s"(bx));
        __builtin_amdgcn_s_waitcnt(0);
        unsigned nloc = b.st[0], nx = b.st[1];
        if (nloc == 0u) { xcd_barrier_complete(bar, bx, nloc, nx); b.st[0] = nloc; b.st[1] = nx; }
        const unsigned old = xb_add(&bar[XB_XSUB(bx)], 1u);
        const unsigned gen = old / nloc;
        if (old + 1u == (gen + 1u) * nloc) {
            __builtin_amdgcn_fence(__ATOMIC_RELEASE, "agent");
            asm volatile("s_waitcnt vmcnt(0)" ::: "memory");
            const unsigned og = xb_add(&bar[XB_TOP], 1u);
            const unsigned tg = og / nx;
            if (og + 1u == (tg + 1u) * nx) xb_add(&bar[XB_TOPGEN], 1u);
            else XB_SPIN(xb_ld(&bar[XB_TOPGEN]) == tg, bar);
            __builtin_amdgcn_fence(__ATOMIC_ACQUIRE, "agent");
            xb_add(&bar[XB_XGEN(bx)], 1u);
            asm volatile("s_waitcnt vmcnt(0)" ::: "memory");
        } else {
            XB_SPIN(xb_ld(&bar[XB_XGEN(bx)]) == gen, bar);
            __builtin_amdgcn_fence(__ATOMIC_ACQUIRE, "agent");
            asm volatile("s_waitcnt vmcnt(0)" ::: "memory");
        }
    }
    __syncthreads();
}
__device__ __forceinline__ size_t opaque_gtid() { unsigned t = blockIdx.x * NTHREADS + threadIdx.x; asm volatile("" : "+v"(t)); return (size_t)t; }
#define ITEM_LOOP(total) for (size_t i = opaque_gtid(); i < (size_t)(total); i += (size_t)gridDim.x * NTHREADS)
#define GRID_SYNC() xcd_barrier(bar)
#else
#define ITEM_LOOP(total) _Pragma("omp parallel for schedule(dynamic, 256)") for (long long i = 0; i < (long long)(total); ++i)
#define GRID_SYNC() do {} while (0)
#endif

struct Params {
    const float *x_prompt, *x_sample, *cache_kv, *cache_win, *state_conv; const int* page_table;
    const float *ffn_a_norm, *ffn_a_w_in, *ffn_a_w_out, *mix_norm, *ffn_b_norm, *ffn_b_w_in, *ffn_b_w_out, *conv_w_in, *conv_w, *conv_w_out, *kv_norm, *w_kv, *k_norm,
                *cmp_pe, *cmp_w1, *cmp_w2, *nsa_w_qg, *nsa_q_norm, *nsa_w_o;
    float* out; unsigned char* ws; unsigned* bar;
};
struct WsMap { size_t h, xn, t1, act, t2, winrows, hid, kc, vc, qn, qr, gates, pbuf, oc, os, sel, scorebuf, end; };
__host__ __device__ inline WsMap ws_map() {
    WsMap w; size_t off = 4096 * 4;
    auto take = [&](size_t n) { size_t p = off; off += (n + 63) / 64 * 64; return p; };
    w.h = take((size_t)MT * D_MODEL); w.xn = take((size_t)MT * D_MODEL);
    w.t1 = take((size_t)MT * 2 * D_FF > (size_t)MT * 3 * D_MODEL ? (size_t)MT * 2 * D_FF : (size_t)MT * 3 * D_MODEL);
    w.act = take((size_t)MT * (D_FF > D_MODEL ? D_FF : D_MODEL)); w.t2 = take((size_t)MT * D_MODEL);
    w.winrows = take((size_t)MT * 2 * N_KV * HD); w.hid = take((size_t)NSEQ * NBC_MAX * 2 * N_KV * CMP_HID);
    w.kc = take((size_t)NSEQ * NBC_MAX * N_KV * HD); w.vc = take((size_t)NSEQ * NBC_MAX * N_KV * HD);
    w.qn = take((size_t)MT * HDM); w.qr = take((size_t)MT * HDM); w.gates = take((size_t)MT * 3 * N_HEADS);
    w.pbuf = take((size_t)MT * N_HEADS * NBC_MAX); w.oc = take((size_t)MT * HDM); w.os = take((size_t)MT * HDM);
    w.sel = take((size_t)MT * N_KV * N_SEL); w.scorebuf = take((size_t)MT * N_KV * NBS_MAX); w.end = off;
    return w;
}

#ifndef CPU_TEST
__global__ void __launch_bounds__(NTHREADS, 2) mega(Params P)
#else
void mega(Params P)
#endif
{
#ifndef CPU_TEST
    extern __shared__ __attribute__((aligned(16))) unsigned char lds[];
    if (threadIdx.x < 4) ((LAS unsigned*)lds)[threadIdx.x] = 0u;
    __syncthreads();
    XcdBarrier bar = xcd_barrier_post(P.bar, (volatile LAS unsigned*)lds);
#endif
    const WsMap W = ws_map();
    float* ws = (float*)P.ws; float* out = P.out;
    float* h = ws + W.h; float* xn = ws + W.xn; float* t1 = ws + W.t1; float* act = ws + W.act; float* t2 = ws + W.t2; float* winrows = ws + W.winrows;
    float* hid = ws + W.hid; float* kc = ws + W.kc; float* vc = ws + W.vc; float* qn = ws + W.qn; float* qr = ws + W.qr; float* gates = ws + W.gates;
    float* pbuf = ws + W.pbuf; float* oc = ws + W.oc; float* os = ws + W.os; int* sel = (int*)(ws + W.sel); float* scorebuf = ws + W.scorebuf;
    const KvSrc S{P.cache_kv, P.page_table, out};
    const size_t nh = (size_t)MT * D_MODEL;
    ITEM_LOOP((size_t)MP * D_MODEL) copy_item(i, P.x_prompt, h, (size_t)MP * D_MODEL);
    ITEM_LOOP((size_t)MS * D_MODEL) copy_item(i, P.x_sample, h + (size_t)MP * D_MODEL, (size_t)MS * D_MODEL);
    GRID_SYNC();
#define GEMM(A, lda, Wm, C, M, N, K) do { ITEM_LOOP((size_t)(((N) + 63) / 64) * (((M) + 63) / 64) * 256) gemm_item(i, A, lda, Wm, C, M, N, K); GRID_SYNC(); } while (0)
#define FFN(norm, w_in, w_out) do { \
        ITEM_LOOP(MT) rmsnorm_item(i, h, norm, xn, MT, D_MODEL); GRID_SYNC(); \
        GEMM(xn, D_MODEL, w_in, t1, MT, 2 * D_FF, D_MODEL); \
        ITEM_LOOP((size_t)MT * D_FF) swiglu_item(i, t1, act, MT, D_FF); GRID_SYNC(); \
        GEMM(act, D_FF, w_out, t2, MT, D_MODEL, D_FF); \
        ITEM_LOOP(nh) axpy_item(i, h, t2, 0.5f, nh); GRID_SYNC(); } while (0)
#pragma unroll
    for (int layer = 0; layer < DEPTH; ++layer) {
        FFN(P.ffn_a_norm + (size_t)layer * D_MODEL, P.ffn_a_w_in + (size_t)layer * D_MODEL * 2 * D_FF, P.ffn_a_w_out + (size_t)layer * D_FF * D_MODEL);
        ITEM_LOOP(MT) rmsnorm_item(i, h, P.mix_norm + (size_t)layer * D_MODEL, xn, MT, D_MODEL); GRID_SYNC();
        if (layer < N_A) {
            GEMM(xn, D_MODEL, P.conv_w_in + (size_t)layer * D_MODEL * 3 * D_MODEL, t1, MT, 3 * D_MODEL, D_MODEL);
            ITEM_LOOP(nh) conv_item(i, t1, P.state_conv + (size_t)layer * DEC_BATCH * 2 * D_MODEL, P.conv_w + (size_t)layer * 3 * D_MODEL, act, out, layer); GRID_SYNC();
            GEMM(act, D_MODEL, P.conv_w_out + (size_t)layer * D_MODEL * D_MODEL, t2, MT, D_MODEL, D_MODEL);
        } else {
            const int b = layer - N_A;
            GEMM(xn, D_MODEL, P.nsa_w_qg + (size_t)b * D_MODEL * QGW, t1, MT, QGW, D_MODEL);
            ITEM_LOOP((size_t)MT * N_HEADS) qprep_item(i, t1, P.nsa_q_norm + (size_t)b * HD, qn, qr, gates); GRID_SYNC();
            ITEM_LOOP((size_t)MT * N_HEADS) attn_cmp_item(i, qn, kc, vc, pbuf, oc); GRID_SYNC();
            ITEM_LOOP((size_t)MT * N_KV) topk_item(i, pbuf, sel, scorebuf); GRID_SYNC();
            ITEM_LOOP((size_t)MT * N_HEADS) attn_sel_item(i, S, qr, sel, os); GRID_SYNC();
            ITEM_LOOP((size_t)MT * N_HEADS) attn_win_item(i, P.cache_win, winrows, qr, gates, oc, os, act); GRID_SYNC();
            GEMM(act, HDM, P.nsa_w_o + (size_t)b * HDM * D_MODEL, t2, MT, D_MODEL, HDM);
        }
        ITEM_LOOP(nh) axpy_item(i, h, t2, 1.0f, nh); GRID_SYNC();
        FFN(P.ffn_b_norm + (size_t)layer * D_MODEL, P.ffn_b_w_in + (size_t)layer * D_MODEL * 2 * D_FF, P.ffn_b_w_out + (size_t)layer * D_FF * D_MODEL);
        if (layer == N_A - 1) {
            ITEM_LOOP(MT) rmsnorm_item(i, h, P.kv_norm, xn, MT, D_MODEL); GRID_SYNC();
            GEMM(xn, D_MODEL, P.w_kv, t1, MT, KVW, D_MODEL);
            ITEM_LOOP((size_t)MT * 6 * N_KV) kvprep_item(i, t1, P.k_norm, out, winrows);
            ITEM_LOOP((size_t)DEC_BATCH * (WINDOW - DEC_SEQ) * 2 * N_KV * HD) wincopy_item(i, P.cache_win, out);
            GRID_SYNC();
            ITEM_LOOP((size_t)NSEQ * NBC_MAX * 2 * N_KV * CMP_HID) cmp_hid_item(i, S, P.cmp_pe, P.cmp_w1, hid); GRID_SYNC();
            ITEM_LOOP((size_t)NSEQ * NBC_MAX * 2 * N_KV) cmp_out_item(i, hid, P.cmp_w2, P.k_norm, kc, vc); GRID_SYNC();
        }
    }
    ITEM_LOOP((size_t)MP * D_MODEL) copy_item(i, h, out + O_YP, (size_t)MP * D_MODEL);
    ITEM_LOOP((size_t)MS * D_MODEL) copy_item(i, h + (size_t)MP * D_MODEL, out + O_YS, (size_t)MS * D_MODEL);
}

extern "C" void kernel_launch(void* const* d_in, const int* in_sizes, int n_in, void* d_out, int out_size, void* d_ws, size_t ws_size, hipStream_t stream) {
    Params P{};
    P.x_prompt = (const float*)d_in[0]; P.x_sample = (const float*)d_in[1]; P.cache_kv = (const float*)d_in[2]; P.cache_win = (const float*)d_in[3];
    P.state_conv = (const float*)d_in[4]; P.page_table = (const int*)d_in[5]; P.ffn_a_norm = (const float*)d_in[6]; P.ffn_a_w_in = (const float*)d_in[7];
    P.ffn_a_w_out = (const float*)d_in[8]; P.mix_norm = (const float*)d_in[9]; P.ffn_b_norm = (const float*)d_in[10]; P.ffn_b_w_in = (const float*)d_in[11];
    P.ffn_b_w_out = (const float*)d_in[12]; P.conv_w_in = (const float*)d_in[13]; P.conv_w = (const float*)d_in[14]; P.conv_w_out = (const float*)d_in[15];
    P.kv_norm = (const float*)d_in[16]; P.w_kv = (const float*)d_in[17]; P.k_norm = (const float*)d_in[18]; P.cmp_pe = (const float*)d_in[19];
    P.cmp_w1 = (const float*)d_in[20]; P.cmp_w2 = (const float*)d_in[21]; P.nsa_w_qg = (const float*)d_in[22]; P.nsa_q_norm = (const float*)d_in[23];
    P.nsa_w_o = (const float*)d_in[24];
    P.out = (float*)d_out; P.ws = (unsigned char*)d_ws; P.bar = (unsigned*)d_ws;
#ifndef CPU_TEST
    constexpr int LDS_BYTES = 147456;
    static int grid = 0;
    if (grid == 0) {
        int dev = 0, cus = 0, per_cu = 0;
        hipGetDevice(&dev); hipDeviceGetAttribute(&cus, hipDeviceAttributeMultiprocessorCount, dev);
        hipFuncSetAttribute((const void*)mega, hipFuncAttributeMaxDynamicSharedMemorySize, LDS_BYTES);
        hipOccupancyMaxActiveBlocksPerMultiprocessor(&per_cu, (const void*)mega, NTHREADS, LDS_BYTES);
        (void)hipGetLastError();
        grid = cus * (per_cu < 1 ? 1 : 1);
    }
    hipMemsetAsync(d_ws, 0, 65536, stream);
    hipLaunchKernelGGL(mega, dim3(grid), dim3(NTHREADS), LDS_BYTES, stream, P);
#else
    mega(P);
#endif
}
```

```cpp
#ifdef CPU_TEST
#include "shim.h"
#else
#include <hip/hip_runtime.h>
#endif
#include <cstdint>
#include <cstddef>
#include <cmath>
#include <cstring>

#ifdef CFG_SMALL
constexpr int D_MODEL = 256, BATCH = 1, SEQ = 2048, DEPTH = 4, DEC_BATCH = 2, DEC_SEQ = 8, PAST_LEN = 2048, PAGE_SIZE = 128, D_FF = 256, N_HEADS = 4, N_KV = 2;
#else
constexpr int D_MODEL = 1024, BATCH = 4, SEQ = 4096, DEPTH = 4, DEC_BATCH = 32, DEC_SEQ = 8, PAST_LEN = 8192, PAGE_SIZE = 128, D_FF = 2816, N_HEADS = 16, N_KV = 4;
#endif
constexpr int N_A = DEPTH / 2, N_B = DEPTH - N_A, HD = 64, HPG = N_HEADS / N_KV, L_CMP = 32, L_SEL = 64, N_SEL = 16, WINDOW = 512, CMP_HID = 4 * HD;
constexpr int MP = BATCH * SEQ, MS = DEC_BATCH * DEC_SEQ, MT = MP + MS, NSEQ = BATCH + DEC_BATCH;
constexpr int N_PAGES = PAST_LEN / PAGE_SIZE;
constexpr int KVW = 6 * N_KV * HD;
constexpr int QGW = N_HEADS * HD + 3 * N_HEADS;
constexpr int HDM = N_HEADS * HD;
constexpr int TPAD_S = ((PAST_LEN + DEC_SEQ + L_SEL - 1) / L_SEL) * L_SEL;
constexpr int NBC_P = SEQ / L_CMP, NBC_S = TPAD_S / L_CMP, NBC_MAX = NBC_S > NBC_P ? NBC_S : NBC_P;
constexpr int NBS_P = SEQ / L_SEL, NBS_S = TPAD_S / L_SEL, NBS_MAX = NBS_S > NBS_P ? NBS_S : NBS_P;
constexpr float EPS = 1e-6f, NEGF = -1e30f, TINYF = 1e-30f, FORCE_SCORE = 1e4f;
__device__ static const float INV_FREQ[8] = {1.0f, 0.1939227432012558f, 0.03760603070259094f, 0.007292664609849453f, 0.0014142135623842478f, 0.00027424818836152554f, 5.3182957344688475e-05f, 1.0313385246263351e-05f};

constexpr size_t O_YP = 0, O_YS = O_YP + (size_t)MP * D_MODEL, O_KVP = O_YS + (size_t)MS * D_MODEL, O_KVS = O_KVP + (size_t)MP * 4 * N_KV * HD,
                 O_WP = O_KVS + (size_t)MS * 4 * N_KV * HD, O_WS = O_WP + (size_t)BATCH * WINDOW * 2 * N_KV * HD, O_CP = O_WS + (size_t)DEC_BATCH * WINDOW * 2 * N_KV * HD,
                 O_CS = O_CP + (size_t)N_A * BATCH * 2 * D_MODEL, O_END = O_CS + (size_t)N_A * DEC_BATCH * 2 * D_MODEL;

struct RowInfo { int seq, t, pos; };
__device__ __host__ inline RowInfo row_info(int m) {
    RowInfo r;
    if (m < MP) { r.seq = m / SEQ; r.t = m % SEQ; r.pos = r.t; }
    else { const int q = m - MP; r.seq = BATCH + q / DEC_SEQ; r.t = q % DEC_SEQ; r.pos = PAST_LEN + r.t; }
    return r;
}
__device__ __host__ inline int seq_row0(int seq) { return seq < BATCH ? seq * SEQ : MP + (seq - BATCH) * DEC_SEQ; }
__device__ __host__ inline int seq_pos0(int seq) { return seq < BATCH ? 0 : PAST_LEN; }
__device__ __host__ inline int seq_len(int seq) { return seq < BATCH ? SEQ : DEC_SEQ; }

__device__ inline void copy_item(size_t i_, const float* a, float* b, size_t n) {
    const size_t i = i_;
    if (i < n) b[i] = a[i];
}
__device__ inline void rmsnorm_item(size_t i_, const float* x, const float* g, float* y, int rows, int d) {
    const int m = (int)i_;
    if (m >= rows) return;
    const float* xr = x + (size_t)m * d; float s = 0.f;
    for (int i = 0; i < d; ++i) s += xr[i] * xr[i];
    const float r = 1.0f / sqrtf(s / d + EPS);
    float* yr = y + (size_t)m * d;
    for (int i = 0; i < d; ++i) yr[i] = xr[i] * r * g[i];
}
__device__ inline void gemm_item(size_t i_, const float* A, int lda, const float* W, float* C, int M, int N, int K) {
    const int nbx = (N + 63) / 64; const int vb = (int)(i_ / 256), t_ = (int)(i_ % 256), tx = t_ % 16, ty = t_ / 16;
    const int c0 = (vb % nbx) * 64 + tx * 4, r0 = (vb / nbx) * 64 + ty * 4;
    if (c0 >= N || r0 >= M) return;
    float acc[4][4];
    for (int i = 0; i < 4; ++i) for (int j = 0; j < 4; ++j) acc[i][j] = 0.f;
    const int nr = (M - r0) < 4 ? (M - r0) : 4;
    for (int k = 0; k < K; k += 4) {
        float a[4][4], w[4][4];
        for (int i = 0; i < 4; ++i) for (int kk = 0; kk < 4; ++kk) a[i][kk] = (i < nr) ? A[(size_t)(r0 + i) * lda + k + kk] : 0.f;
        for (int kk = 0; kk < 4; ++kk) for (int j = 0; j < 4; ++j) w[kk][j] = W[(size_t)(k + kk) * N + c0 + j];
        for (int i = 0; i < 4; ++i) for (int kk = 0; kk < 4; ++kk) for (int j = 0; j < 4; ++j) acc[i][j] += a[i][kk] * w[kk][j];
    }
    for (int i = 0; i < nr; ++i) for (int j = 0; j < 4; ++j) C[(size_t)(r0 + i) * N + c0 + j] = acc[i][j];
}
__device__ inline void swiglu_item(size_t i_, const float* t1, float* act, int rows, int dff) {
    const size_t i = i_;
    if (i >= (size_t)rows * dff) return;
    const int m = (int)(i / dff), j = (int)(i % dff);
    const float g = t1[(size_t)m * 2 * dff + j], u = t1[(size_t)m * 2 * dff + dff + j];
    act[i] = g / (1.0f + expf(-g)) * u;
}
__device__ inline void axpy_item(size_t i_, float* h, const float* y, float coef, size_t n) {
    const size_t i = i_;
    if (i < n) h[i] += coef * y[i];
}
__device__ inline void conv_item(size_t i_, const float* t1, const float* state  , const float* wc  , float* z, float* out, int layer) {
    const size_t i = i_;
    if (i >= (size_t)MT * D_MODEL) return;
    const int m = (int)(i / D_MODEL), ch = (int)(i % D_MODEL);
    const RowInfo ri = row_info(m);
    const float* r = t1 + (size_t)m * 3 * D_MODEL;
    const float b = r[ch], u0 = r[D_MODEL + ch] * r[2 * D_MODEL + ch];
    float u1, u2;
    if (ri.t >= 1) { const float* p = r - 3 * D_MODEL; u1 = p[D_MODEL + ch] * p[2 * D_MODEL + ch]; }
    else u1 = (ri.seq < BATCH) ? 0.f : state[((size_t)(ri.seq - BATCH) * 2 + 1) * D_MODEL + ch];
    if (ri.t >= 2) { const float* p = r - 6 * D_MODEL; u2 = p[D_MODEL + ch] * p[2 * D_MODEL + ch]; }
    else if (ri.seq < BATCH) u2 = 0.f;
    else u2 = (ri.t == 1) ? state[((size_t)(ri.seq - BATCH) * 2 + 1) * D_MODEL + ch] : state[((size_t)(ri.seq - BATCH) * 2 + 0) * D_MODEL + ch];
    z[i] = b * (wc[ch] * u2 + wc[D_MODEL + ch] * u1 + wc[2 * D_MODEL + ch] * u0);
    const int L = seq_len(ri.seq);
    if (ri.t >= L - 2) {
        const int j = ri.t - (L - 2);
        if (ri.seq < BATCH) out[O_CP + (((size_t)layer * BATCH + ri.seq) * 2 + j) * D_MODEL + ch] = u0;
        else out[O_CS + (((size_t)layer * DEC_BATCH + (ri.seq - BATCH)) * 2 + j) * D_MODEL + ch] = u0;
    }
}
__device__ inline void head_norm(float* v, const float* g) {
    float s = 0.f; for (int d = 0; d < HD; ++d) s += v[d] * v[d];
    const float r = 1.0f / sqrtf(s / HD + EPS);
    for (int d = 0; d < HD; ++d) v[d] = v[d] * r * g[d];
}
__device__ inline void rope_cs(float ang, float& c, float& s) {
    const double r = (double)ang * 0.15915494309189535; const float fr = (float)(r - rint(r));
#ifdef CPU_TEST
    c = (float)cos(6.283185307179586 * (double)fr); s = (float)sin(6.283185307179586 * (double)fr);
#else
    c = __builtin_amdgcn_cosf(fr); s = __builtin_amdgcn_sinf(fr);
#endif
}
__device__ inline void head_rope(float* v, int pos) {
    for (int i = 0; i < 8; ++i) {
        const float ang = (float)pos * INV_FREQ[i]; float c, s; rope_cs(ang, c, s);
        const float x1 = v[i], x2 = v[8 + i];
        v[i] = x1 * c - x2 * s; v[8 + i] = x2 * c + x1 * s;
    }
}
__device__ inline void kvprep_item(size_t i_, const float* p, const float* k_norm  , float* out, float* winrows) {
    const int i = (int)i_;
    if (i >= MT * 6 * N_KV) return;
    const int m = i / (6 * N_KV), e = (i / N_KV) % 6, g = i % N_KV;
    const RowInfo ri = row_info(m);
    float v[HD];
    for (int d = 0; d < HD; ++d) v[d] = p[(size_t)m * KVW + (e * N_KV + g) * HD + d];
    if (e == 2) { head_norm(v, k_norm + HD); head_rope(v, ri.pos); }
    if (e == 4) { head_norm(v, k_norm + 2 * HD); head_rope(v, ri.pos); }
    if (e < 4) {
        float* o = (ri.seq < BATCH) ? out + O_KVP + (((size_t)m * 4 + e) * N_KV + g) * HD : out + O_KVS + (((size_t)(m - MP) * 4 + e) * N_KV + g) * HD;
        for (int d = 0; d < HD; ++d) o[d] = v[d];
    } else {
        const int we = e - 4;
        float* w = winrows + (((size_t)m * 2 + we) * N_KV + g) * HD;
        for (int d = 0; d < HD; ++d) w[d] = v[d];
        if (ri.seq < BATCH) { if (ri.t >= SEQ - WINDOW) { float* o = out + O_WP + ((((size_t)ri.seq * WINDOW + (ri.t - (SEQ - WINDOW))) * 2 + we) * N_KV + g) * HD; for (int d = 0; d < HD; ++d) o[d] = v[d]; } }
        else { float* o = out + O_WS + ((((size_t)(ri.seq - BATCH) * WINDOW + (WINDOW - DEC_SEQ + ri.t)) * 2 + we) * N_KV + g) * HD; for (int d = 0; d < HD; ++d) o[d] = v[d]; }
    }
}
__device__ inline void wincopy_item(size_t i_, const float* cache_win, float* out) {
    const size_t i = i_;
    const size_t per = (size_t)(WINDOW - DEC_SEQ) * 2 * N_KV * HD;
    if (i >= (size_t)DEC_BATCH * per) return;
    const size_t b = i / per, r = i % per;
    out[O_WS + b * WINDOW * 2 * N_KV * HD + r] = cache_win[b * WINDOW * 2 * N_KV * HD + (size_t)DEC_SEQ * 2 * N_KV * HD + r];
}
struct KvSrc { const float* cache_kv; const int* page_table; const float* out; };
__device__ inline const float* kv_full_ptr(const KvSrc& S, int seq, int tok, int e, int g) {
    if (seq < BATCH) return S.out + O_KVP + ((((size_t)seq * SEQ + tok) * 4 + e) * N_KV + g) * HD;
    const int b = seq - BATCH;
    if (tok < PAST_LEN) { const int page = S.page_table[b * N_PAGES + tok / PAGE_SIZE]; return S.cache_kv + ((((size_t)page * PAGE_SIZE + tok % PAGE_SIZE) * 4 + e) * N_KV + g) * HD; }
    if (tok < PAST_LEN + DEC_SEQ) return S.out + O_KVS + ((((size_t)b * DEC_SEQ + (tok - PAST_LEN)) * 4 + e) * N_KV + g) * HD;
    return nullptr;
}
__device__ inline int seq_nbc(int seq) { return seq < BATCH ? NBC_P : NBC_S; }
__device__ inline void cmp_hid_item(size_t i_, KvSrc S, const float* pe  , const float* w1  , float* hid) {
    const size_t i = i_;
    if (i >= (size_t)NSEQ * NBC_MAX * 2 * N_KV * CMP_HID) return;
    const int f = (int)(i % CMP_HID), g = (int)((i / CMP_HID) % N_KV), e = (int)((i / ((size_t)CMP_HID * N_KV)) % 2), c = (int)((i / ((size_t)CMP_HID * N_KV * 2)) % NBC_MAX), seq = (int)(i / ((size_t)CMP_HID * N_KV * 2 * NBC_MAX));
    if (c >= seq_nbc(seq)) return;
    float s = 0.f;
    for (int l = 0; l < L_CMP; ++l) {
        const float* r = kv_full_ptr(S, seq, c * L_CMP + l, e, g);
        const float* w = w1 + (((size_t)e * L_CMP + l) * HD) * CMP_HID + f; const float* pp = pe + ((size_t)e * L_CMP + l) * HD;
        for (int d = 0; d < HD; ++d) s += ((r ? r[d] : 0.f) + pp[d]) * w[(size_t)d * CMP_HID];
    }
    const float x = s; const float t = tanhf(0.7978845608028654f * (x + 0.044715f * x * x * x));
    hid[i] = 0.5f * x * (1.0f + t);
}
__device__ inline void cmp_out_item(size_t i_, const float* hid, const float* w2  , const float* k_norm0, float* kc, float* vc) {
    const int i = (int)i_;
    if (i >= NSEQ * NBC_MAX * 2 * N_KV) return;
    const int g = i % N_KV, e = (i / N_KV) % 2, c = (i / (2 * N_KV)) % NBC_MAX, seq = i / (2 * N_KV * NBC_MAX);
    if (c >= seq_nbc(seq)) return;
    const float* hr = hid + (size_t)i * CMP_HID;
    float v[HD];
    for (int d = 0; d < HD; ++d) { float s = 0.f; for (int f = 0; f < CMP_HID; ++f) s += hr[f] * w2[((size_t)e * CMP_HID + f) * HD + d]; v[d] = s; }
    if (e == 0) head_norm(v, k_norm0);
    float* o = (e == 0 ? kc : vc) + (((size_t)seq * NBC_MAX + c) * N_KV + g) * HD;
    for (int d = 0; d < HD; ++d) o[d] = v[d];
}
__device__ inline void qprep_item(size_t i_, const float* qg, const float* q_norm, float* qn, float* qr, float* gates) {
    const int i = (int)i_;
    if (i >= MT * N_HEADS) return;
    const int m = i / N_HEADS, hh = i % N_HEADS;
    const RowInfo ri = row_info(m);
    float v[HD];
    for (int d = 0; d < HD; ++d) v[d] = qg[(size_t)m * QGW + hh * HD + d];
    head_norm(v, q_norm);
    for (int d = 0; d < HD; ++d) qn[(size_t)m * HDM + hh * HD + d] = v[d];
    head_rope(v, ri.pos);
    for (int d = 0; d < HD; ++d) qr[(size_t)m * HDM + hh * HD + d] = v[d];
    for (int j = 0; j < 3; ++j) { const float x = qg[(size_t)m * QGW + HDM + hh * 3 + j]; gates[(size_t)m * 3 * N_HEADS + hh * 3 + j] = 1.0f / (1.0f + expf(-x)); }
}
__device__ inline void attn_cmp_item(size_t i_, const float* qn, const float* kc, const float* vc, float* pbuf, float* oc) {
    const int i = (int)i_;
    if (i >= MT * N_HEADS) return;
    const int m = i / N_HEADS, hh = i % N_HEADS, g = hh / HPG;
    const RowInfo ri = row_info(m);
    const int nbc = seq_nbc(ri.seq);
    const float* q = qn + (size_t)m * HDM + hh * HD;
    float* p = pbuf + (size_t)i * NBC_MAX;
    float mx = NEGF;
    for (int c = 0; c < nbc; ++c) {
        const bool vis = (c + 1) * L_CMP - 1 <= ri.pos;
        float s = 0.f; const float* k = kc + (((size_t)ri.seq * NBC_MAX + c) * N_KV + g) * HD;
        for (int d = 0; d < HD; ++d) s += q[d] * k[d];
        s *= 0.125f; p[c] = s; if (vis && s > mx) mx = s;
    }
    float sum = 0.f;
    for (int c = 0; c < nbc; ++c) { const bool vis = (c + 1) * L_CMP - 1 <= ri.pos; const float e = vis ? expf(p[c] - mx) : 0.f; p[c] = e; sum += e; }
    const float inv = 1.0f / fmaxf(sum, TINYF);
    float o[HD]; for (int d = 0; d < HD; ++d) o[d] = 0.f;
    for (int c = 0; c < nbc; ++c) { p[c] *= inv; if (p[c] != 0.f) { const float* v = vc + (((size_t)ri.seq * NBC_MAX + c) * N_KV + g) * HD; for (int d = 0; d < HD; ++d) o[d] += p[c] * v[d]; } }
    for (int d = 0; d < HD; ++d) oc[(size_t)m * HDM + hh * HD + d] = o[d];
}
__device__ inline void topk_item(size_t i_, const float* pbuf, int* sel, float* scorebuf  ) {
    const int i = (int)i_;
    if (i >= MT * N_KV) return;
    const int m = i / N_KV, g = i % N_KV;
    const RowInfo ri = row_info(m);
    const int nbs = ri.seq < BATCH ? NBS_P : NBS_S, cur = ri.pos / L_SEL;
    float* score = scorebuf + (size_t)i * NBS_MAX;
    for (int b = 0; b < nbs; ++b) {
        float imp = 0.f;
        for (int h = 0; h < HPG; ++h) { const float* p = pbuf + ((size_t)m * N_HEADS + g * HPG + h) * NBC_MAX; imp += p[2 * b]; }
        float imp2 = 0.f;
        for (int h = 0; h < HPG; ++h) { const float* p = pbuf + ((size_t)m * N_HEADS + g * HPG + h) * NBC_MAX; imp2 += p[2 * b + 1]; }
        const bool forced = (b == 0) || (b == cur) || (b == cur - 1), valid = b * L_SEL <= ri.pos;
        score[b] = valid ? (forced ? FORCE_SCORE : imp + imp2) : NEGF;
    }
    const int nsel = N_SEL < nbs ? N_SEL : nbs;
    for (int j = 0; j < N_SEL; ++j) {
        if (j >= nsel) { sel[(size_t)i * N_SEL + j] = -1; continue; }
        int best = -1; float bv = 0.f;
        for (int b = 0; b < nbs; ++b) if (score[b] > -3e38f && (best < 0 || score[b] > bv)) { best = b; bv = score[b]; }
        sel[(size_t)i * N_SEL + j] = best; score[best] = -3.4e38f;
    }
}
__device__ inline void attn_sel_item(size_t i_, KvSrc S, const float* qr, const int* sel, float* os) {
    const int i = (int)i_;
    if (i >= MT * N_HEADS) return;
    const int m = i / N_HEADS, hh = i % N_HEADS, g = hh / HPG;
    const RowInfo ri = row_info(m);
    const float* q = qr + (size_t)m * HDM + hh * HD;
    const int* sl = sel + ((size_t)m * N_KV + g) * N_SEL;
    float mx = NEGF;
    for (int j = 0; j < N_SEL; ++j) { const int b = sl[j]; if (b < 0) continue;
        for (int t = 0; t < L_SEL; ++t) { const int tok = b * L_SEL + t; if (tok > ri.pos) continue;
            const float* k = kv_full_ptr(S, ri.seq, tok, 2, g); float s = 0.f; if (k) for (int d = 0; d < HD; ++d) s += q[d] * k[d];
            s *= 0.125f; if (s > mx) mx = s; } }
    float sum = 0.f, o[HD]; for (int d = 0; d < HD; ++d) o[d] = 0.f;
    for (int j = 0; j < N_SEL; ++j) { const int b = sl[j]; if (b < 0) continue;
        for (int t = 0; t < L_SEL; ++t) { const int tok = b * L_SEL + t; if (tok > ri.pos) continue;
            const float* k = kv_full_ptr(S, ri.seq, tok, 2, g); float s = 0.f; if (k) for (int d = 0; d < HD; ++d) s += q[d] * k[d];
            const float e = expf(s * 0.125f - mx); sum += e;
            const float* v = kv_full_ptr(S, ri.seq, tok, 3, g); if (v) for (int d = 0; d < HD; ++d) o[d] += e * v[d]; } }
    const float inv = 1.0f / fmaxf(sum, TINYF);
    for (int d = 0; d < HD; ++d) os[(size_t)m * HDM + hh * HD + d] = o[d] * inv;
}
__device__ inline const float* win_ptr(const float* cache_win, const float* winrows, int seq, int kp) {
    if (seq < BATCH) return kp >= 0 ? winrows + (size_t)(seq * SEQ + kp) * 2 * N_KV * HD : nullptr;
    const int b = seq - BATCH;
    if (kp >= PAST_LEN) return winrows + (size_t)(MP + b * DEC_SEQ + (kp - PAST_LEN)) * 2 * N_KV * HD;
    const int j = kp - (PAST_LEN - WINDOW);
    return j >= 0 ? cache_win + ((size_t)b * WINDOW + j) * 2 * N_KV * HD : nullptr;
}
__device__ inline void attn_win_item(size_t i_, const float* cache_win, const float* winrows, const float* qr, const float* gates, const float* oc, const float* os, float* o_out) {
    const int i = (int)i_;
    if (i >= MT * N_HEADS) return;
    const int m = i / N_HEADS, hh = i % N_HEADS, g = hh / HPG;
    const RowInfo ri = row_info(m);
    const float* q = qr + (size_t)m * HDM + hh * HD;
    float mx = NEGF;
    for (int kp = ri.pos - WINDOW; kp <= ri.pos; ++kp) { const float* r = win_ptr(cache_win, winrows, ri.seq, kp); if (!r) continue;
        const float* k = r + (0 * N_KV + g) * HD; float s = 0.f; for (int d = 0; d < HD; ++d) s += q[d] * k[d]; s *= 0.125f; if (s > mx) mx = s; }
    float sum = 0.f, o[HD]; for (int d = 0; d < HD; ++d) o[d] = 0.f;
    for (int kp = ri.pos - WINDOW; kp <= ri.pos; ++kp) { const float* r = win_ptr(cache_win, winrows, ri.seq, kp); if (!r) continue;
        const float* k = r + (0 * N_KV + g) * HD; float s = 0.f; for (int d = 0; d < HD; ++d) s += q[d] * k[d];
        const float e = expf(s * 0.125f - mx); sum += e; const float* v = r + (1 * N_KV + g) * HD; for (int d = 0; d < HD; ++d) o[d] += e * v[d]; }
    const float inv = 1.0f / fmaxf(sum, TINYF);
    const float* gt = gates + (size_t)m * 3 * N_HEADS + hh * 3;
    for (int d = 0; d < HD; ++d) { const size_t x = (size_t)m * HDM + hh * HD + d; o_out[x] = gt[0] * oc[x] + gt[1] * os[x] + gt[2] * o[d] * inv; }
}


#ifndef CPU_TEST
__device__ __forceinline__ unsigned lane_id_v() { unsigned l; asm volatile("v_mbcnt_lo_u32_b32 %0, -1, 0\n\tv_mbcnt_hi_u32_b32 %0, -1, %0" : "=v"(l)); return l; }
#endif
constexpr int NTHREADS = 512;
typedef unsigned short bf16_t;
__host__ __device__ inline bf16_t f2bf(float f) { unsigned u; memcpy(&u, &f, 4); u = (u + 0x7fffu + ((u >> 16) & 1u)) >> 16; return (bf16_t)u; }
__host__ __device__ inline float bf2f(bf16_t b) { unsigned u = (unsigned)b << 16; float f; memcpy(&f, &u, 4); return f; }
constexpr int NRSS = 3 * DEPTH + 1;
constexpr int NPOS = SEQ + DEC_SEQ;
constexpr int QGP = ((QGW + 255) / 256) * 256;
__host__ __device__ inline int pos_index(int pos) { return pos < SEQ ? pos : SEQ + (pos - PAST_LEN); }

struct WsMap {
    size_t ctl, rss, rope, h, hb, act, xn, t2, actf, ub, bb, zb, t1, qn, qr, gates, ob, winrows, hid, kc, vc, pbuf, oc, os, sel, scorebuf,
           w_ain, w_aout, w_bin, w_bout, w_cin, w_cout, w_qg, w_o, w_kv, end;
};
constexpr size_t al256(size_t b) { return (b + 255) / 256 * 256; }
constexpr size_t smax(size_t a, size_t b) { return a > b ? a : b; }
constexpr WsMap make_ws_map() {
    WsMap w{}; size_t off = 0;
#define TAKE(f, bytes) w.f = off; off += al256(bytes)
    TAKE(ctl, 65536); TAKE(rss, (size_t)NRSS * MT * 4);
    TAKE(rope, (size_t)NPOS * 16 * 4);
    TAKE(h, (size_t)MT * D_MODEL * 4); TAKE(hb, (size_t)MT * D_MODEL * 2); TAKE(act, (size_t)MT * D_FF * 2);
    TAKE(xn, (size_t)MT * D_MODEL * 4); TAKE(t2, (size_t)MT * D_MODEL * 4); TAKE(actf, (size_t)MT * D_MODEL * 4);
    TAKE(ub, (size_t)MT * D_MODEL * 2); TAKE(bb, (size_t)MT * D_MODEL * 2); TAKE(zb, (size_t)MT * D_MODEL * 2);
    TAKE(t1, smax((size_t)MT * 3 * D_MODEL * 4, (size_t)MT * KVW * 4));
    TAKE(qn, (size_t)MT * HDM * 4); TAKE(qr, (size_t)MT * HDM * 4); TAKE(gates, (size_t)MT * 3 * N_HEADS * 4); TAKE(ob, (size_t)MT * HDM * 2);
    TAKE(winrows, (size_t)MT * 2 * N_KV * HD * 4); TAKE(hid, (size_t)NSEQ * NBC_MAX * 2 * N_KV * CMP_HID * 4);
    TAKE(kc, (size_t)NSEQ * NBC_MAX * N_KV * HD * 4); TAKE(vc, (size_t)NSEQ * NBC_MAX * N_KV * HD * 4);
    TAKE(pbuf, (size_t)MT * N_HEADS * NBC_MAX * 4); TAKE(oc, (size_t)MT * HDM * 4); TAKE(os, (size_t)MT * HDM * 4);
    TAKE(sel, (size_t)MT * N_KV * N_SEL * 4); TAKE(scorebuf, (size_t)MT * N_KV * NBS_MAX * 4);
    TAKE(w_ain, (size_t)DEPTH * 2 * D_FF * D_MODEL * 2); TAKE(w_aout, (size_t)DEPTH * D_MODEL * D_FF * 2);
    TAKE(w_bin, (size_t)DEPTH * 2 * D_FF * D_MODEL * 2); TAKE(w_bout, (size_t)DEPTH * D_MODEL * D_FF * 2);
    TAKE(w_cin, (size_t)N_A * 3 * D_MODEL * D_MODEL * 2); TAKE(w_cout, (size_t)N_A * D_MODEL * D_MODEL * 2);
    TAKE(w_qg, (size_t)N_B * QGP * D_MODEL * 2); TAKE(w_o, (size_t)N_B * D_MODEL * HDM * 2); TAKE(w_kv, (size_t)KVW * D_MODEL * 2);
#undef TAKE
    w.end = off; return w;
}
constexpr WsMap WSM = make_ws_map();
constexpr size_t WS_ZERO_BYTES = 65536 + (((size_t)NRSS * MT * 4 + 255) / 256 * 256);

enum { CM_PLAIN = 0, CM_PAIR = 1, CM_CONV = 2, CM_HEADS = 3 };
__host__ __device__ inline int colmap(int kind, int n, int aux) {
    const int pn = n / 256, c = n % 256;
    if (kind == CM_PLAIN) return n;
    if (kind == CM_PAIR) return (c >= 128 ? aux : 0) + pn * 128 + (c % 128);
    if (kind == CM_CONV) { if (n < 2 * D_MODEL) return (c >= 128 ? 2 * D_MODEL : D_MODEL) + pn * 128 + (c % 128); return n - 2 * D_MODEL; }
    if (n < aux * 64) { const int bj = c / 128, wc = (c % 128) / 32, r = c % 32; return (pn * 4 + wc) * 64 + 32 * bj + r; }
    return n;
}
__device__ inline void wconv_item(size_t i_, const float* src, int Nsrc, const float* gain, bf16_t* dst, int Nd, int K, int kind, int aux) {
    const int n = (int)(i_ % Nd), kb = (int)(i_ / Nd);
    const int col = colmap(kind, n, aux);
    bf16_t* d = dst + (size_t)n * K + (size_t)kb * 64;
    if (col < 0 || col >= Nsrc) { for (int k = 0; k < 64; ++k) d[k] = 0; return; }
    const float* s = src + (size_t)kb * 64 * Nsrc + col;
#pragma unroll 8
    for (int k = 0; k < 64; k += 2) {
        const float g0 = gain ? gain[kb * 64 + k] : 1.f, g1 = gain ? gain[kb * 64 + k + 1] : 1.f;
        const unsigned lo = f2bf(s[(size_t)k * Nsrc] * g0), hi = f2bf(s[(size_t)(k + 1) * Nsrc] * g1);
        *(unsigned*)(d + k) = lo | (hi << 16);
    }
}
__device__ inline void rope_item(size_t i_, float* rope) {
    const int pi = (int)(i_ / 8), f = (int)(i_ % 8);
    const int pos = pi < SEQ ? pi : PAST_LEN + (pi - SEQ);
    float c, s; rope_cs((float)pos * INV_FREQ[f], c, s);
    rope[pi * 16 + f] = c; rope[pi * 16 + 8 + f] = s;
}
__device__ inline void hinit_item(size_t i_, const float* xp, const float* xs, float* h, bf16_t* hb, float* rss0) {
    const int m = (int)i_; const float* x = m < MP ? xp + (size_t)m * D_MODEL : xs + (size_t)(m - MP) * D_MODEL;
    float s = 0.f;
    for (int k = 0; k < D_MODEL; ++k) { const float v = x[k]; s += v * v; h[(size_t)m * D_MODEL + k] = v; hb[(size_t)m * D_MODEL + k] = f2bf(v); }
    rss0[m] = s;
}
__device__ inline void hupd_item(size_t i_, float* h, const float* y, float coef, bf16_t* hb, float* rss) {
    const int m = (int)i_; float s = 0.f;
    for (int k = 0; k < D_MODEL; ++k) { const float v = h[(size_t)m * D_MODEL + k] + coef * y[(size_t)m * D_MODEL + k]; s += v * v; h[(size_t)m * D_MODEL + k] = v; hb[(size_t)m * D_MODEL + k] = f2bf(v); }
    rss[m] = s;
}
__device__ inline float dot_bf(const bf16_t* a, const bf16_t* b, int K) { float s = 0.f; for (int k = 0; k < K; ++k) s += bf2f(a[k]) * bf2f(b[k]); return s; }
__device__ inline float silu_f(float g) { return g / (1.0f + expf(-g)); }
__device__ inline void ref_ffn_in_item(size_t i_, const bf16_t* hb, const float* rss, const bf16_t* Bt, bf16_t* act) {
    const int m = (int)(i_ / D_FF), j = (int)(i_ % D_FF);
    const float rs = 1.0f / sqrtf(rss[m] / D_MODEL + EPS);
    const int ng = (j / 128) * 256 + (j % 128);
    const float g = rs * dot_bf(hb + (size_t)m * D_MODEL, Bt + (size_t)ng * D_MODEL, D_MODEL), u = rs * dot_bf(hb + (size_t)m * D_MODEL, Bt + (size_t)(ng + 128) * D_MODEL, D_MODEL);
    act[i_] = f2bf(silu_f(g) * u);
}
__device__ inline void ref_resid_row_item(size_t i_, const bf16_t* A, int K, const bf16_t* Bt, float coef, float* h, bf16_t* hb, float* rss_next, float* yout) {
    const int m = (int)i_; float s = 0.f;
    for (int c = 0; c < D_MODEL; ++c) {
        const float v = h[(size_t)m * D_MODEL + c] + coef * dot_bf(A + (size_t)m * K, Bt + (size_t)c * K, K);
        if (yout) { yout[(size_t)m * D_MODEL + c] = v; } else { h[(size_t)m * D_MODEL + c] = v; hb[(size_t)m * D_MODEL + c] = f2bf(v); s += v * v; }
    }
    if (!yout) rss_next[m] = s;
}
#ifndef CPU_TEST
#define LAS __attribute__((address_space(3)))
#define XB_TMO      128
#define XB_XCNT(j)  (256  + 64 * (j))
#define XB_XSUB(j)  (1280 + 64 * (j))
#define XB_XGEN(j)  (2304 + 64 * (j))
#define XB_TOP      3328
#define XB_TOPGEN   3392
#define XCD_BAR_WORDS 3456
#define XB_SPIN_CAP (1u << 25)
typedef __attribute__((address_space(1))) unsigned GU;
__device__ __forceinline__ unsigned xb_ld(GU* p)              { return __hip_atomic_load(p, __ATOMIC_RELAXED, __HIP_MEMORY_SCOPE_AGENT); }
__device__ __forceinline__ unsigned xb_add(GU* p, unsigned v) { return __hip_atomic_fetch_add(p, v, __ATOMIC_RELAXED, __HIP_MEMORY_SCOPE_AGENT); }
__device__ __forceinline__ unsigned xb_xcc_id() { return (unsigned)__builtin_amdgcn_s_getreg((3 << 11) | 20) & 0xFu; }
#define XB_SPIN(cond, bar) do { unsigned _sp = 0; while (cond) { __builtin_amdgcn_s_sleep(1); \
    if ((++_sp & 255u) == 0u) { if (xb_ld(&(bar)[XB_TMO])) break; if (_sp > XB_SPIN_CAP) { (void)xb_add(&(bar)[XB_TMO], 1u); break; } } } } while (0)
struct XcdBarrier { GU* bar; unsigned x; volatile LAS unsigned* st; };
__device__ __forceinline__ XcdBarrier xcd_barrier_post(GU* bar, volatile LAS unsigned* st, const bool leader_thread) {
    XcdBarrier b; b.bar = bar; b.x = xb_xcc_id(); b.st = st;
    if (leader_thread) (void)xb_add(&bar[XB_XCNT(b.x)], 1u);
    return b;
}
__device__ __forceinline__ void xcd_barrier_complete(GU* bar, unsigned x, unsigned& nloc, unsigned& nx) {
    const unsigned G = gridDim.x * gridDim.y * gridDim.z;
    unsigned sum, cnt, mine, sp = 0u;
    for (;;) {
        sum = 0u; cnt = 0u; mine = 0u;
#pragma unroll
        for (unsigned j = 0; j < 16; ++j) { const unsigned c = xb_ld(&bar[XB_XCNT(j)]); sum += c; cnt += (c > 0u) ? 1u : 0u; mine = (j == x) ? c : mine; }
        if (sum == G) break;
        __builtin_amdgcn_s_sleep(1);
        if ((++sp & 255u) == 0u) { if (xb_ld(&bar[XB_TMO])) break; if (sp > XB_SPIN_CAP) { (void)xb_add(&bar[XB_TMO], 1u); break; } }
    }
    nloc = mine > 0u ? mine : 1u; nx = cnt > 0u ? cnt : 1u;
}
__device__ __forceinline__ void xcd_barrier(const XcdBarrier& b, const bool leader_thread) {
    asm volatile("s_waitcnt vmcnt(0)" ::: "memory");
    __syncthreads();
    if (leader_thread) {
        GU* bar = b.bar; unsigned bx = xb_xcc_id(); asm volatile("" : "+s"(bx));
        __builtin_amdgcn_s_waitcnt(0);
        unsigned nloc = b.st[0], nx = b.st[1];
        if (nloc == 0u) { xcd_barrier_complete(bar, bx, nloc, nx); b.st[0] = nloc; b.st[1] = nx; }
        const unsigned old = xb_add(&bar[XB_XSUB(bx)], 1u);
        const unsigned gen = old / nloc;
        if (old + 1u == (gen + 1u) * nloc) {
            __builtin_amdgcn_fence(__ATOMIC_RELEASE, "agent");
            asm volatile("s_waitcnt vmcnt(0)" ::: "memory");
            const unsigned og = xb_add(&bar[XB_TOP], 1u);
            const unsigned tg = og / nx;
            if (og + 1u == (tg + 1u) * nx) xb_add(&bar[XB_TOPGEN], 1u);
            else XB_SPIN(xb_ld(&bar[XB_TOPGEN]) == tg, bar);
            __builtin_amdgcn_fence(__ATOMIC_ACQUIRE, "agent");
            xb_add(&bar[XB_XGEN(bx)], 1u);
            asm volatile("s_waitcnt vmcnt(0)" ::: "memory");
        } else {
            XB_SPIN(xb_ld(&bar[XB_XGEN(bx)]) == gen, bar);
            __builtin_amdgcn_fence(__ATOMIC_ACQUIRE, "agent");
            asm volatile("s_waitcnt vmcnt(0)" ::: "memory");
        }
    }
    __syncthreads();
}

namespace pg8 {
#define PG8_LAS __attribute__((address_space(3)))
typedef unsigned short bf16_t;
typedef short bf16x8 __attribute__((ext_vector_type(8)));
typedef float f32x4 __attribute__((ext_vector_type(4)));
typedef unsigned u32x4 __attribute__((ext_vector_type(4)));
constexpr int BM = 256, BK = 64, HALF = 128, HTB = HALF * BK * 2  , STAGE_BYTES = 8 * HTB, NXCD = 8, WGM = 8;

__host__ __device__ __forceinline__ int lds_byte(int r, int c) { const int st = (r >> 4) * 2 + (c >> 5), rr = r & 15, cc = c & 31, ob = rr * 64 + cc * 2; return st * 1024 + (ob ^ (((ob >> 9) & 1) << 5)); }
__host__ __device__ __forceinline__ void stage_rc(int b, int& R, int& C) { const int st = b / 1024, sb = b % 1024, swz = sb ^ (((sb >> 9) & 1) << 5); R = (st >> 1) * 16 + swz / 64; C = (st & 1) * 32 + (swz % 64) / 2; }
__host__ __device__ __forceinline__ int perm32(int rho) { const int n = rho >> 4, i = rho & 15; return 8 * (i >> 2) + 4 * n + (i & 3); }

struct Unit { int pm, pn; };
struct Gemm { const bf16_t* A; const bf16_t* Bt; int M, N, K; };

struct StaticOrder {
    int nM, nN, nwg, G, c;
    __host__ __device__ void init(int M, int N, int G_, int c_) { nM = M / BM; nN = N / BM; nwg = nM * nN; G = G_; c = c_; }
    __host__ __device__ bool next(int i, Unit& u) const {
        const long L = (long)i * G + c; if (L >= nwg) return false;
        int wgid = (int)L; { const int q = nwg / NXCD, r = nwg % NXCD, xcd = wgid % NXCD, off = wgid / NXCD; wgid = (xcd < r ? xcd * (q + 1) : r * (q + 1) + (xcd - r) * q) + off; }
        const int nig = WGM * nN, gid = wgid / nig, fm = gid * WGM, gsz = (nM - fm) < WGM ? (nM - fm) : WGM;
        u.pm = fm + ((wgid % nig) % gsz); u.pn = (wgid % nig) / gsz; return true;
    }
    __device__ __forceinline__ void a_ready(const Unit&) const {}
    __device__ __forceinline__ void done(const Unit&) const {}
};

__device__ __forceinline__ unsigned cvt_pk_bf16(float lo, float hi) { unsigned r; asm volatile("v_cvt_pk_bf16_f32 %0, %1, %2" : "=v"(r) : "v"(lo), "v"(hi)); return r; }
template <class Epi, class Sched, bool ALIGN_EPI = false, bool SP2 = false>
__device__ __forceinline__ void gemm_phase(int wave_id_, PG8_LAS unsigned char* lds, const Gemm g, const Sched& S, const Epi& E) {
    int wid = wave_id_, lane = (int)lane_id_v(); asm volatile("" : "+s"(wid));
    const int tid = wid * 64 + lane, wr = wid >> 2, wc = wid & 3, fr = lane & 15, fq = lane >> 4;
    const int K = g.K, nt = K / BK;
    unsigned voffA[2], voffB[2];
#pragma unroll
    for (int i = 0; i < 2; ++i) { int R, C; stage_rc(tid * 16 + i * 8192, R, C); const int Rb = Epi::PERM ? ((R & ~31) + perm32(R & 31)) : R;
        voffA[i] = (unsigned)(R * K + C) * 2u; voffB[i] = (unsigned)(Rb * K + C) * 2u; }
    const size_t kstep = (size_t)(BK * 2);
    const size_t hstep = (size_t)HALF * K * 2;
    const size_t tstep = 2 * hstep;
    const unsigned ldsw = (unsigned)wid * 1024u;
    const int aoff = lds_byte(wr * 64 + fr, fq * 8), boff = lds_byte(wc * 32 + fr, fq * 8);
#define PG8_SA(b, h) (((b) * 2 + (h)) * HTB)
#define PG8_SB(b, h) ((4 + (b) * 2 + (h)) * HTB)
#define PG8_STAGE(bufoff, gbase, voff) do { _Pragma("unroll") for (int _i = 0; _i < 2; ++_i) \
        __builtin_amdgcn_global_load_lds((const unsigned*)((const char*)(gbase) + (voff)[_i]), (PG8_LAS unsigned*)(lds + (bufoff) + ldsw + _i * 8192), 16, 0, 0); } while (0)
#define PG8_LDA(dst, b, h) do { _Pragma("unroll") for (int m = 0; m < 4; ++m) _Pragma("unroll") for (int k = 0; k < 2; ++k) dst[m][k] = *(const PG8_LAS bf16x8*)(lds + PG8_SA(b, h) + aoff + m * 2048 + k * 1024); } while (0)
#define PG8_LDB(dst, b, h) do { _Pragma("unroll") for (int n = 0; n < 2; ++n) _Pragma("unroll") for (int k = 0; k < 2; ++k) dst[n][k] = *(const PG8_LAS bf16x8*)(lds + PG8_SB(b, h) + boff + n * 2048 + k * 1024); } while (0)
#define PG8_MMA(ai, bj, At, Bt) do { __builtin_amdgcn_s_setprio(1); _Pragma("unroll") for (int m = 0; m < 4; ++m) _Pragma("unroll") for (int n = 0; n < 2; ++n) _Pragma("unroll") for (int k = 0; k < 2; ++k) \
        acc[ai][bj][m][n] = __builtin_amdgcn_mfma_f32_16x16x32_bf16(Bt[n][k], At[m][k], acc[ai][bj][m][n], 0, 0, 0); __builtin_amdgcn_s_setprio(0); } while (0)
#define PG8_WAIT_V(n) asm volatile("s_waitcnt vmcnt(" #n ")" ::: "memory")
#define PG8_WAIT_L(n) asm volatile("s_waitcnt lgkmcnt(" #n ")" ::: "memory")
#define PG8_BAR __builtin_amdgcn_s_barrier()
#define PG8_SCHED __builtin_amdgcn_sched_barrier(0)
    Unit cur, nxt; int ui = 0;
    if (!S.next(0, cur)) return;
    f32x4 acc[2][2][4][2];
#pragma unroll
    for (int a = 0; a < 2; ++a)
#pragma unroll
        for (int b = 0; b < 2; ++b)
#pragma unroll
            for (int m = 0; m < 4; ++m)
#pragma unroll
                for (int n = 0; n < 2; ++n) acc[a][b][m][n] = (f32x4){0.f, 0.f, 0.f, 0.f};
    bf16x8 At[4][2], B0[2][2], B1[2][2];
    const char* cA = (const char*)g.A + (size_t)cur.pm * tstep; const char* cB = (const char*)g.Bt + (size_t)cur.pn * tstep;
    S.a_ready(cur);
    if constexpr (SP2) {
        PG8_STAGE(PG8_SB(0, 0), cB, voffB); PG8_STAGE(PG8_SB(0, 1), cB + hstep, voffB); PG8_STAGE(PG8_SA(0, 0), cA, voffA); PG8_STAGE(PG8_SA(0, 1), cA + hstep, voffA);
        if (wr == 1) PG8_BAR;
        PG8_WAIT_V(2); PG8_BAR;
        PG8_STAGE(PG8_SB(1, 0), cB + kstep, voffB); PG8_STAGE(PG8_SA(1, 0), cA + kstep, voffA); PG8_STAGE(PG8_SB(1, 1), cB + hstep + kstep, voffB);
        PG8_WAIT_V(6); PG8_BAR;
    } else {
        PG8_STAGE(PG8_SB(0, 0), cB, voffB); PG8_STAGE(PG8_SA(0, 0), cA, voffA); PG8_STAGE(PG8_SB(0, 1), cB + hstep, voffB); PG8_STAGE(PG8_SA(0, 1), cA + hstep, voffA);
        if (wr == 1) PG8_BAR;
        PG8_WAIT_V(4); PG8_BAR;
        PG8_STAGE(PG8_SB(1, 0), cB + kstep, voffB); PG8_STAGE(PG8_SA(1, 0), cA + kstep, voffA); PG8_STAGE(PG8_SB(1, 1), cB + hstep + kstep, voffB);
        PG8_WAIT_V(6); PG8_BAR;
    }
    for (;;) {
        const bool has_next = S.next(ui + 1, nxt);
        const char* nA = has_next ? (const char*)g.A + (size_t)nxt.pm * tstep : cA; const char* nB = has_next ? (const char*)g.Bt + (size_t)nxt.pn * tstep : cB;
        for (int t = 0; t < nt; t += 2) {
            const bool last = (t == nt - 2);
            const char* a1 = cA + (size_t)(t + 1) * kstep;
            const char* a2 = last ? nA : cA + (size_t)(t + 2) * kstep; const char* b2 = last ? nB : cB + (size_t)(t + 2) * kstep;
            const char* a3 = a2 + kstep; const char* b3 = b2 + kstep;
            if (last && has_next) S.a_ready(nxt);
            if constexpr (SP2) {
            PG8_LDB(B0, 0, 0); PG8_LDB(B1, 0, 1); PG8_SCHED; PG8_LDA(At, 0, 0); PG8_STAGE(PG8_SA(1, 1), a1 + hstep, voffA);
            PG8_WAIT_V(8); PG8_WAIT_L(0); PG8_BAR; PG8_MMA(0, 0, At, B0); PG8_MMA(0, 1, At, B1); PG8_BAR; PG8_SCHED;
            PG8_LDA(At, 0, 1); PG8_STAGE(PG8_SB(0, 0), b2, voffB); PG8_STAGE(PG8_SB(0, 1), b2 + hstep, voffB); PG8_STAGE(PG8_SA(0, 0), a2, voffA);
            PG8_WAIT_V(8); PG8_WAIT_L(0); PG8_BAR; PG8_MMA(1, 0, At, B0); PG8_MMA(1, 1, At, B1); PG8_BAR; PG8_SCHED;
            PG8_LDB(B0, 1, 0); PG8_LDB(B1, 1, 1); PG8_SCHED; PG8_LDA(At, 1, 0); PG8_STAGE(PG8_SA(0, 1), a2 + hstep, voffA);
            PG8_WAIT_V(8); PG8_WAIT_L(0); PG8_BAR; PG8_MMA(0, 0, At, B0); PG8_MMA(0, 1, At, B1); PG8_BAR; PG8_SCHED;
            PG8_LDA(At, 1, 1); PG8_STAGE(PG8_SB(1, 0), b3, voffB); PG8_STAGE(PG8_SB(1, 1), b3 + hstep, voffB); PG8_STAGE(PG8_SA(1, 0), a3, voffA);
            PG8_WAIT_V(8); PG8_WAIT_L(0); PG8_BAR; PG8_MMA(1, 0, At, B0); PG8_MMA(1, 1, At, B1); PG8_BAR; PG8_SCHED;
            } else {
            PG8_LDB(B0, 0, 0); PG8_SCHED; PG8_LDA(At, 0, 0); PG8_STAGE(PG8_SA(1, 1), a1 + hstep, voffA);
            PG8_WAIT_L(8); PG8_BAR; PG8_WAIT_L(0); PG8_MMA(0, 0, At, B0); PG8_BAR; PG8_SCHED;
            PG8_LDB(B1, 0, 1); PG8_STAGE(PG8_SB(0, 0), b2, voffB);
            PG8_BAR; PG8_WAIT_L(0); PG8_MMA(0, 1, At, B1); PG8_BAR;
            PG8_LDA(At, 0, 1); PG8_STAGE(PG8_SA(0, 0), a2, voffA);
            PG8_BAR; PG8_WAIT_L(0); PG8_MMA(1, 0, At, B0); PG8_BAR; PG8_SCHED;
            PG8_STAGE(PG8_SB(0, 1), b2 + hstep, voffB);
            PG8_WAIT_V(6); PG8_BAR; PG8_MMA(1, 1, At, B1); PG8_BAR;
            PG8_LDB(B0, 1, 0); PG8_SCHED; PG8_LDA(At, 1, 0); PG8_STAGE(PG8_SA(0, 1), a2 + hstep, voffA);
            PG8_WAIT_L(8); PG8_BAR; PG8_WAIT_L(0); PG8_MMA(0, 0, At, B0); PG8_BAR; PG8_SCHED;
            PG8_LDB(B1, 1, 1); PG8_STAGE(PG8_SB(1, 0), b3, voffB);
            PG8_BAR; PG8_WAIT_L(0); PG8_MMA(0, 1, At, B1); PG8_BAR;
            PG8_LDA(At, 1, 1); PG8_STAGE(PG8_SA(1, 0), a3, voffA);
            PG8_BAR; PG8_WAIT_L(0); PG8_MMA(1, 0, At, B0); PG8_BAR; PG8_SCHED;
            PG8_STAGE(PG8_SB(1, 1), b3 + hstep, voffB);
            PG8_WAIT_V(6); PG8_BAR; PG8_MMA(1, 1, At, B1); PG8_BAR;
            }
        }
        if constexpr (ALIGN_EPI) { if (wr == 0) PG8_BAR; }
        if constexpr (!Epi::AFTER_DRAIN) { E(acc, cur, wr, wc, fr, fq); S.done(cur); }
        if (!has_next) break;
#pragma unroll
        for (int a = 0; a < 2; ++a)
#pragma unroll
            for (int b = 0; b < 2; ++b)
#pragma unroll
                for (int m = 0; m < 4; ++m)
#pragma unroll
                    for (int n = 0; n < 2; ++n) acc[a][b][m][n] = (f32x4){0.f, 0.f, 0.f, 0.f};
        cur = nxt; cA = nA; cB = nB; ++ui;
        if constexpr (ALIGN_EPI) { if (wr == 1) PG8_BAR; }
    }
    PG8_WAIT_V(0);
    if constexpr (!ALIGN_EPI) { if (wr == 0) PG8_BAR; }
    PG8_BAR;
    if constexpr (Epi::AFTER_DRAIN) { E.fused(acc, cur, wr, wc, fr, fq, lds, wid, lane); S.done(cur); }
#undef PG8_SA
#undef PG8_SB
#undef PG8_STAGE
#undef PG8_LDA
#undef PG8_LDB
#undef PG8_MMA
#undef PG8_WAIT_V
#undef PG8_WAIT_L
#undef PG8_BAR
#undef PG8_SCHED
}
}

namespace pg8 {
__device__ __forceinline__ float fast_silu(float g) { return g * __builtin_amdgcn_rcpf(1.0f + __expf(-g)); }
__device__ __forceinline__ float row_rs(const float* rss, int row) { return rsqrtf(rss[row] * (1.0f / D_MODEL) + EPS); }
struct EpiSwiglu {
    static constexpr bool PERM = true, AFTER_DRAIN = false;
    bf16_t* act; const float* rss;
    __device__ __forceinline__ void operator()(const f32x4 (&acc)[2][2][4][2], const Unit& u, int wr, int wc, int fr, int fq) const {
        const int row0 = u.pm * BM + wr * 64 + fr, col0 = u.pn * 128 + wc * 32 + 8 * fq;
#pragma unroll
        for (int ai = 0; ai < 2; ++ai)
#pragma unroll
            for (int m = 0; m < 4; ++m) {
                const int row = row0 + ai * HALF + m * 16; const float rs = row_rs(rss, row);
                float a[8];
#pragma unroll
                for (int n = 0; n < 2; ++n)
#pragma unroll
                    for (int i = 0; i < 4; ++i) a[n * 4 + i] = fast_silu(acc[ai][0][m][n][i] * rs) * (acc[ai][1][m][n][i] * rs);
                u32x4 w; w.x = cvt_pk_bf16(a[0], a[1]); w.y = cvt_pk_bf16(a[2], a[3]); w.z = cvt_pk_bf16(a[4], a[5]); w.w = cvt_pk_bf16(a[6], a[7]);
                *(u32x4*)(act + (size_t)row * D_FF + col0) = w;
            }
    }
};
struct EpiResid {
    static constexpr bool PERM = false, AFTER_DRAIN = false;
    float* h; bf16_t* hb; float* rss_next; float* yout; float coef;
    __device__ __forceinline__ void operator()(const f32x4 (&acc)[2][2][4][2], const Unit& u, int wr, int wc, int fr, int fq) const {
        const int row0 = u.pm * BM + wr * 64 + fr, col0 = u.pn * BM + wc * 32 + 4 * fq;
#pragma unroll
        for (int ai = 0; ai < 2; ++ai)
#pragma unroll
            for (int m = 0; m < 4; ++m) {
                const int row = row0 + ai * HALF + m * 16; float s = 0.f;
                float* hr = h + (size_t)row * D_MODEL + col0;
#pragma unroll
                for (int bj = 0; bj < 2; ++bj)
#pragma unroll
                    for (int n = 0; n < 2; ++n) {
                        const int co = bj * HALF + n * 16;
                        const f32x4 v = *(const f32x4*)(hr + co) + acc[ai][bj][m][n] * coef;
                        if (yout) { *(f32x4*)(yout + (size_t)row * D_MODEL + col0 + co) = v; }
                        else {
                            *(f32x4*)(hr + co) = v;
                            typedef unsigned u32x2 __attribute__((ext_vector_type(2)));
                            u32x2 w; w.x = cvt_pk_bf16(v[0], v[1]); w.y = cvt_pk_bf16(v[2], v[3]);
                            *(u32x2*)(hb + (size_t)row * D_MODEL + col0 + co) = w;
                            s += (v[0] * v[0] + v[1] * v[1]) + (v[2] * v[2] + v[3] * v[3]);
                        }
                    }
                if (!yout) { s += __shfl_xor(s, 16); s += __shfl_xor(s, 32); if (fq == 0) (void)__hip_atomic_fetch_add(rss_next + row, s, __ATOMIC_RELAXED, __HIP_MEMORY_SCOPE_AGENT); }
            }
    }
};
}
#endif

#ifndef CPU_TEST
__device__ __forceinline__ size_t opaque_gtid(int wave) { int w = wave; asm volatile("" : "+s"(w)); unsigned t = blockIdx.x * NTHREADS + w * 64 + lane_id_v(); return (size_t)t; }
#define ITEM_LOOP(total) for (size_t i = opaque_gtid(wave_id); i < (size_t)(total); i += (size_t)gridDim.x * NTHREADS)
#else
#define ITEM_LOOP(total) _Pragma("omp parallel for schedule(dynamic, 64)") for (long long i = 0; i < (long long)(total); ++i)
#endif

struct Params {
    const float *x_prompt, *x_sample, *cache_kv, *cache_win, *state_conv; const int* page_table;
    const float *ffn_a_norm, *ffn_a_w_in, *ffn_a_w_out, *mix_norm, *ffn_b_norm, *ffn_b_w_in, *ffn_b_w_out, *conv_w_in, *conv_w, *conv_w_out, *kv_norm, *w_kv, *k_norm,
                *cmp_pe, *cmp_w1, *cmp_w2, *nsa_w_qg, *nsa_q_norm, *nsa_w_o;
    float* out; unsigned char* ws;
};
constexpr int LDS_RING = 131072, LDS_BAR_OFF = LDS_RING + 352, LDS_BYTES = 147456;

#ifndef CPU_TEST
__device__ __forceinline__ const Params& kparams() {
#if defined(__HIP_DEVICE_COMPILE__)
    const void* p = (const void*)__builtin_amdgcn_kernarg_segment_ptr(); asm volatile("" : "+s"(p)); return *(const Params*)p;
#else
    return *(const Params*)nullptr;
#endif
}
#define KP const Params& P = kparams()
#define GRID_SYNC() do { XcdBarrier bar_; bar_.bar = (GU*)kparams().ws + 1024; bar_.x = 0; bar_.st = (volatile LAS unsigned*)(lds + LDS_BAR_OFF); xcd_barrier(bar_, wave_id == 0 && lane_id_v() == 0u); } while (0)
__global__ void __launch_bounds__(NTHREADS, 2) mega(Params P_unused)
#else
static Params g_params;
#define KP const Params& P = g_params
#define GRID_SYNC() do {} while (0)
void mega(Params P_unused)
#endif
{
#ifndef CPU_TEST
    extern __shared__ __attribute__((aligned(16))) unsigned char lds[];
    const int wave_id = __builtin_amdgcn_readfirstlane((int)(threadIdx.x >> 6));
    if (threadIdx.x < 4) ((LAS unsigned*)(lds + LDS_BAR_OFF))[threadIdx.x] = 0u;
    __syncthreads();
    (void)xcd_barrier_post((GU*)kparams().ws + 1024, (volatile LAS unsigned*)(lds + LDS_BAR_OFF), threadIdx.x == 0);
#define RING ((PG8_LAS unsigned char*)lds)
#else
    g_params = P_unused;
#endif
#define WS_F(f) ((float*)(P.ws + WSM.f))
#define WS_B(f) ((bf16_t*)(P.ws + WSM.f))
#define KVSRC KvSrc{P.cache_kv, P.page_table, P.out}
    for (int L = 0; L < DEPTH; ++L) {
        KP;
        ITEM_LOOP((size_t)2 * D_FF * (D_MODEL / 64)) wconv_item(i, P.ffn_a_w_in + (size_t)L * D_MODEL * 2 * D_FF, 2 * D_FF, P.ffn_a_norm + (size_t)L * D_MODEL, WS_B(w_ain) + (size_t)L * 2 * D_FF * D_MODEL, 2 * D_FF, D_MODEL, CM_PAIR, D_FF);
        ITEM_LOOP((size_t)D_MODEL * (D_FF / 64)) wconv_item(i, P.ffn_a_w_out + (size_t)L * D_FF * D_MODEL, D_MODEL, nullptr, WS_B(w_aout) + (size_t)L * D_MODEL * D_FF, D_MODEL, D_FF, CM_PLAIN, 0);
        ITEM_LOOP((size_t)2 * D_FF * (D_MODEL / 64)) wconv_item(i, P.ffn_b_w_in + (size_t)L * D_MODEL * 2 * D_FF, 2 * D_FF, P.ffn_b_norm + (size_t)L * D_MODEL, WS_B(w_bin) + (size_t)L * 2 * D_FF * D_MODEL, 2 * D_FF, D_MODEL, CM_PAIR, D_FF);
        ITEM_LOOP((size_t)D_MODEL * (D_FF / 64)) wconv_item(i, P.ffn_b_w_out + (size_t)L * D_FF * D_MODEL, D_MODEL, nullptr, WS_B(w_bout) + (size_t)L * D_MODEL * D_FF, D_MODEL, D_FF, CM_PLAIN, 0);
    }
    { KP; ITEM_LOOP((size_t)NPOS * 8) rope_item(i, WS_F(rope)); }
    { KP; ITEM_LOOP(MT) hinit_item(i, P.x_prompt, P.x_sample, WS_F(h), WS_B(hb), WS_F(rss)); }
    GRID_SYNC();

#ifndef CPU_TEST
#define FFN_OPT(wi, wo, v_in, last) do { \
        { KP; pg8::Gemm g{WS_B(hb), WS_B(wi) + (size_t)layer * 2 * D_FF * D_MODEL, MT, 2 * D_FF, D_MODEL}; pg8::StaticOrder So; So.init(MT, 2 * D_FF, (int)gridDim.x, (int)blockIdx.x); \
          pg8::EpiSwiglu E{WS_B(act), WS_F(rss) + (size_t)(v_in) * MT}; pg8::gemm_phase<pg8::EpiSwiglu, pg8::StaticOrder, true, true>(wave_id, RING, g, So, E); } \
        GRID_SYNC(); \
        { KP; pg8::Gemm g{WS_B(act), WS_B(wo) + (size_t)layer * D_MODEL * D_FF, MT, D_MODEL, D_FF}; pg8::StaticOrder So; So.init(MT, D_MODEL, (int)gridDim.x, (int)blockIdx.x); \
          pg8::EpiResid E{WS_F(h), WS_B(hb), WS_F(rss) + (size_t)((v_in) + 1) * MT, (last) ? P.out + O_YP : nullptr, 0.5f}; pg8::gemm_phase<pg8::EpiResid, pg8::StaticOrder, true, true>(wave_id, RING, g, So, E); } \
        GRID_SYNC(); } while (0)
#else
#define FFN_OPT(wi, wo, v_in, last) do { KP; \
        ITEM_LOOP((size_t)MT * D_FF) ref_ffn_in_item(i, WS_B(hb), WS_F(rss) + (size_t)(v_in) * MT, WS_B(wi) + (size_t)layer * 2 * D_FF * D_MODEL, WS_B(act)); \
        ITEM_LOOP(MT) ref_resid_row_item(i, WS_B(act), D_FF, WS_B(wo) + (size_t)layer * D_MODEL * D_FF, 0.5f, WS_F(h), WS_B(hb), WS_F(rss) + (size_t)((v_in) + 1) * MT, (last) ? P.out + O_YP : nullptr); } while (0)
#endif
#define GEMM(A, lda, Wm, C, M, N, K) do { { KP; ITEM_LOOP((size_t)(((N) + 63) / 64) * (((M) + 63) / 64) * 256) gemm_item(i, A, lda, Wm, C, M, N, K); } GRID_SYNC(); } while (0)
#define PH(total, call) do { { KP; ITEM_LOOP(total) call; } GRID_SYNC(); } while (0)
    const size_t nh = (size_t)MT * D_MODEL;
    for (int layer = 0; layer < DEPTH; ++layer) {
        FFN_OPT(w_ain, w_aout, 3 * layer, false);
        PH(MT, rmsnorm_item(i, WS_F(h), P.mix_norm + (size_t)layer * D_MODEL, WS_F(xn), MT, D_MODEL));
        if (layer < N_A) {
            GEMM(WS_F(xn), D_MODEL, P.conv_w_in + (size_t)layer * D_MODEL * 3 * D_MODEL, WS_F(t1), MT, 3 * D_MODEL, D_MODEL);
            PH(nh, conv_item(i, WS_F(t1), P.state_conv + (size_t)layer * DEC_BATCH * 2 * D_MODEL, P.conv_w + (size_t)layer * 3 * D_MODEL, WS_F(actf), P.out, layer));
            GEMM(WS_F(actf), D_MODEL, P.conv_w_out + (size_t)layer * D_MODEL * D_MODEL, WS_F(t2), MT, D_MODEL, D_MODEL);
        } else {
            const int b = layer - N_A;
            GEMM(WS_F(xn), D_MODEL, P.nsa_w_qg + (size_t)b * D_MODEL * QGW, WS_F(t1), MT, QGW, D_MODEL);
            PH((size_t)MT * N_HEADS, qprep_item(i, WS_F(t1), P.nsa_q_norm + (size_t)b * HD, WS_F(qn), WS_F(qr), WS_F(gates)));
            PH((size_t)MT * N_HEADS, attn_cmp_item(i, WS_F(qn), WS_F(kc), WS_F(vc), WS_F(pbuf), WS_F(oc)));
            PH((size_t)MT * N_KV, topk_item(i, WS_F(pbuf), (int*)WS_F(sel), WS_F(scorebuf)));
            PH((size_t)MT * N_HEADS, attn_sel_item(i, KVSRC, WS_F(qr), (const int*)WS_F(sel), WS_F(os)));
            PH((size_t)MT * N_HEADS, attn_win_item(i, P.cache_win, WS_F(winrows), WS_F(qr), WS_F(gates), WS_F(oc), WS_F(os), WS_F(actf)));
            GEMM(WS_F(actf), HDM, P.nsa_w_o + (size_t)b * HDM * D_MODEL, WS_F(t2), MT, D_MODEL, HDM);
        }
        PH(MT, hupd_item(i, WS_F(h), WS_F(t2), 1.0f, WS_B(hb), WS_F(rss) + (size_t)(3 * layer + 2) * MT));
        FFN_OPT(w_bin, w_bout, 3 * layer + 2, layer == DEPTH - 1);
        if (layer == N_A - 1) {
            PH(MT, rmsnorm_item(i, WS_F(h), P.kv_norm, WS_F(xn), MT, D_MODEL));
            GEMM(WS_F(xn), D_MODEL, P.w_kv, WS_F(t1), MT, KVW, D_MODEL);
            { KP; ITEM_LOOP((size_t)MT * 6 * N_KV) kvprep_item(i, WS_F(t1), P.k_norm, P.out, WS_F(winrows)); }
            PH((size_t)DEC_BATCH * (WINDOW - DEC_SEQ) * 2 * N_KV * HD, wincopy_item(i, P.cache_win, P.out));
            PH((size_t)NSEQ * NBC_MAX * 2 * N_KV * CMP_HID, cmp_hid_item(i, KVSRC, P.cmp_pe, P.cmp_w1, WS_F(hid)));
            PH((size_t)NSEQ * NBC_MAX * 2 * N_KV, cmp_out_item(i, WS_F(hid), P.cmp_w2, P.k_norm, WS_F(kc), WS_F(vc)));
        }
    }
}

extern "C" void kernel_launch(void* const* d_in, const int* in_sizes, int n_in, void* d_out, int out_size, void* d_ws, size_t ws_size, hipStream_t stream) {
    Params P{};
    P.x_prompt = (const float*)d_in[0]; P.x_sample = (const float*)d_in[1]; P.cache_kv = (const float*)d_in[2]; P.cache_win = (const float*)d_in[3];
    P.state_conv = (const float*)d_in[4]; P.page_table = (const int*)d_in[5]; P.ffn_a_norm = (const float*)d_in[6]; P.ffn_a_w_in = (const float*)d_in[7];
    P.ffn_a_w_out = (const float*)d_in[8]; P.mix_norm = (const float*)d_in[9]; P.ffn_b_norm = (const float*)d_in[10]; P.ffn_b_w_in = (const float*)d_in[11];
    P.ffn_b_w_out = (const float*)d_in[12]; P.conv_w_in = (const float*)d_in[13]; P.conv_w = (const float*)d_in[14]; P.conv_w_out = (const float*)d_in[15];
    P.kv_norm = (const float*)d_in[16]; P.w_kv = (const float*)d_in[17]; P.k_norm = (const float*)d_in[18]; P.cmp_pe = (const float*)d_in[19];
    P.cmp_w1 = (const float*)d_in[20]; P.cmp_w2 = (const float*)d_in[21]; P.nsa_w_qg = (const float*)d_in[22]; P.nsa_q_norm = (const float*)d_in[23];
    P.nsa_w_o = (const float*)d_in[24];
    P.out = (float*)d_out; P.ws = (unsigned char*)d_ws;
#ifndef CPU_TEST
    static int grid = 0;
    if (grid == 0) {
        int dev = 0, cus = 0, per_cu = 0;
        hipGetDevice(&dev); hipDeviceGetAttribute(&cus, hipDeviceAttributeMultiprocessorCount, dev);
        hipFuncSetAttribute((const void*)mega, hipFuncAttributeMaxDynamicSharedMemorySize, LDS_BYTES);
        hipOccupancyMaxActiveBlocksPerMultiprocessor(&per_cu, (const void*)mega, NTHREADS, LDS_BYTES);
        (void)hipGetLastError();
        grid = cus;
    }
    hipMemsetAsync(d_ws, 0, WS_ZERO_BYTES, stream);
    hipLaunchKernelGGL(mega, dim3(grid), dim3(NTHREADS), LDS_BYTES, stream, P);
#else
    memset(d_ws, 0, WS_ZERO_BYTES);
    mega(P);
#endif
}
```

```cpp
#ifdef CPU_TEST
#include "shim.h"
#else
#include <hip/hip_runtime.h>
#endif
#include <cstdint>
#include <cstddef>
#include <cmath>
#include <cstring>
typedef unsigned short bf16_t;
#ifndef CPU_TEST
#define HOSTDEV __host__ __device__
#else
#define HOSTDEV
#endif
HOSTDEV inline bf16_t f2bf(float f) { unsigned u; memcpy(&u, &f, 4); u = (u + 0x7fffu + ((u >> 16) & 1u)) >> 16; return (bf16_t)u; }
HOSTDEV inline float bf2f(bf16_t b) { unsigned u = (unsigned)b << 16; float f; memcpy(&f, &u, 4); return f; }

#ifdef CFG_SMALL
constexpr int D_MODEL = 256, BATCH = 1, SEQ = 2048, DEPTH = 4, DEC_BATCH = 2, DEC_SEQ = 8, PAST_LEN = 2048, PAGE_SIZE = 128, D_FF = 256, N_HEADS = 4, N_KV = 2;
#else
constexpr int D_MODEL = 1024, BATCH = 4, SEQ = 4096, DEPTH = 4, DEC_BATCH = 32, DEC_SEQ = 8, PAST_LEN = 8192, PAGE_SIZE = 128, D_FF = 2816, N_HEADS = 16, N_KV = 4;
#endif
constexpr int N_A = DEPTH / 2, N_B = DEPTH - N_A, HD = 64, HPG = N_HEADS / N_KV, L_CMP = 32, L_SEL = 64, N_SEL = 16, WINDOW = 512, CMP_HID = 4 * HD;
constexpr int MP = BATCH * SEQ, MS = DEC_BATCH * DEC_SEQ, MT = MP + MS, NSEQ = BATCH + DEC_BATCH;
constexpr int N_PAGES = PAST_LEN / PAGE_SIZE;
constexpr int KVW = 6 * N_KV * HD;
constexpr int QGW = N_HEADS * HD + 3 * N_HEADS;
constexpr int HDM = N_HEADS * HD;
constexpr int TPAD_S = ((PAST_LEN + DEC_SEQ + L_SEL - 1) / L_SEL) * L_SEL;
constexpr int NBC_P = SEQ / L_CMP, NBC_S = TPAD_S / L_CMP, NBC_MAX = NBC_S > NBC_P ? NBC_S : NBC_P;
constexpr int NBS_P = SEQ / L_SEL, NBS_S = TPAD_S / L_SEL, NBS_MAX = NBS_S > NBS_P ? NBS_S : NBS_P;
constexpr float EPS = 1e-6f, NEGF = -1e30f, TINYF = 1e-30f, FORCE_SCORE = 1e4f;
__device__ static const float INV_FREQ[8] = {1.0f, 0.1939227432012558f, 0.03760603070259094f, 0.007292664609849453f, 0.0014142135623842478f, 0.00027424818836152554f, 5.3182957344688475e-05f, 1.0313385246263351e-05f};

constexpr size_t O_YP = 0, O_YS = O_YP + (size_t)MP * D_MODEL, O_KVP = O_YS + (size_t)MS * D_MODEL, O_KVS = O_KVP + (size_t)MP * 4 * N_KV * HD,
                 O_WP = O_KVS + (size_t)MS * 4 * N_KV * HD, O_WS = O_WP + (size_t)BATCH * WINDOW * 2 * N_KV * HD, O_CP = O_WS + (size_t)DEC_BATCH * WINDOW * 2 * N_KV * HD,
                 O_CS = O_CP + (size_t)N_A * BATCH * 2 * D_MODEL, O_END = O_CS + (size_t)N_A * DEC_BATCH * 2 * D_MODEL;

struct RowInfo { int seq, t, pos; };
__device__ __host__ inline RowInfo row_info(int m) {
    RowInfo r;
    if (m < MP) { r.seq = m / SEQ; r.t = m % SEQ; r.pos = r.t; }
    else { const int q = m - MP; r.seq = BATCH + q / DEC_SEQ; r.t = q % DEC_SEQ; r.pos = PAST_LEN + r.t; }
    return r;
}
__device__ __host__ inline int seq_row0(int seq) { return seq < BATCH ? seq * SEQ : MP + (seq - BATCH) * DEC_SEQ; }
__device__ __host__ inline int seq_pos0(int seq) { return seq < BATCH ? 0 : PAST_LEN; }
__device__ __host__ inline int seq_len(int seq) { return seq < BATCH ? SEQ : DEC_SEQ; }

__device__ inline void copy_item(size_t i_, const float* a, float* b, size_t n) {
    const size_t i = i_;
    if (i < n) b[i] = a[i];
}
__device__ inline void rmsnorm_item(size_t i_, const float* x, const float* g, float* y, int rows, int d) {
    const int m = (int)i_;
    if (m >= rows) return;
    const float* xr = x + (size_t)m * d; float s = 0.f;
    for (int i = 0; i < d; ++i) s += xr[i] * xr[i];
    const float r = 1.0f / sqrtf(s / d + EPS);
    float* yr = y + (size_t)m * d;
    for (int i = 0; i < d; ++i) yr[i] = xr[i] * r * g[i];
}
__device__ inline void gemm_item(size_t i_, const float* A, int lda, const float* W, float* C, int M, int N, int K) {
    const int nbx = (N + 63) / 64; const int vb = (int)(i_ / 256), t_ = (int)(i_ % 256), tx = t_ % 16, ty = t_ / 16;
    const int c0 = (vb % nbx) * 64 + tx * 4, r0 = (vb / nbx) * 64 + ty * 4;
    if (c0 >= N || r0 >= M) return;
    float acc[4][4];
    for (int i = 0; i < 4; ++i) for (int j = 0; j < 4; ++j) acc[i][j] = 0.f;
    const int nr = (M - r0) < 4 ? (M - r0) : 4;
    for (int k = 0; k < K; k += 4) {
        float a[4][4], w[4][4];
        for (int i = 0; i < 4; ++i) for (int kk = 0; kk < 4; ++kk) a[i][kk] = (i < nr) ? A[(size_t)(r0 + i) * lda + k + kk] : 0.f;
        for (int kk = 0; kk < 4; ++kk) for (int j = 0; j < 4; ++j) w[kk][j] = W[(size_t)(k + kk) * N + c0 + j];
        for (int i = 0; i < 4; ++i) for (int kk = 0; kk < 4; ++kk) for (int j = 0; j < 4; ++j) acc[i][j] += a[i][kk] * w[kk][j];
    }
    for (int i = 0; i < nr; ++i) for (int j = 0; j < 4; ++j) C[(size_t)(r0 + i) * N + c0 + j] = acc[i][j];
}
__device__ inline void swiglu_item(size_t i_, const float* t1, float* act, int rows, int dff) {
    const size_t i = i_;
    if (i >= (size_t)rows * dff) return;
    const int m = (int)(i / dff), j = (int)(i % dff);
    const float g = t1[(size_t)m * 2 * dff + j], u = t1[(size_t)m * 2 * dff + dff + j];
    act[i] = g / (1.0f + expf(-g)) * u;
}
__device__ inline void axpy_item(size_t i_, float* h, const float* y, float coef, size_t n) {
    const size_t i = i_;
    if (i < n) h[i] += coef * y[i];
}
__device__ inline void conv_item(size_t i_, const float* t1, const float* state  , const float* wc  , float* z, float* out, int layer) {
    const size_t i = i_;
    if (i >= (size_t)MT * D_MODEL) return;
    const int m = (int)(i / D_MODEL), ch = (int)(i % D_MODEL);
    const RowInfo ri = row_info(m);
    const float* r = t1 + (size_t)m * 3 * D_MODEL;
    const float b = r[ch], u0 = r[D_MODEL + ch] * r[2 * D_MODEL + ch];
    float u1, u2;
    if (ri.t >= 1) { const float* p = r - 3 * D_MODEL; u1 = p[D_MODEL + ch] * p[2 * D_MODEL + ch]; }
    else u1 = (ri.seq < BATCH) ? 0.f : state[((size_t)(ri.seq - BATCH) * 2 + 1) * D_MODEL + ch];
    if (ri.t >= 2) { const float* p = r - 6 * D_MODEL; u2 = p[D_MODEL + ch] * p[2 * D_MODEL + ch]; }
    else if (ri.seq < BATCH) u2 = 0.f;
    else u2 = (ri.t == 1) ? state[((size_t)(ri.seq - BATCH) * 2 + 1) * D_MODEL + ch] : state[((size_t)(ri.seq - BATCH) * 2 + 0) * D_MODEL + ch];
    z[i] = b * (wc[ch] * u2 + wc[D_MODEL + ch] * u1 + wc[2 * D_MODEL + ch] * u0);
    const int L = seq_len(ri.seq);
    if (ri.t >= L - 2) {
        const int j = ri.t - (L - 2);
        if (ri.seq < BATCH) out[O_CP + (((size_t)layer * BATCH + ri.seq) * 2 + j) * D_MODEL + ch] = u0;
        else out[O_CS + (((size_t)layer * DEC_BATCH + (ri.seq - BATCH)) * 2 + j) * D_MODEL + ch] = u0;
    }
}
__device__ inline void head_norm(float* v, const float* g) {
    float s = 0.f; for (int d = 0; d < HD; ++d) s += v[d] * v[d];
    const float r = 1.0f / sqrtf(s / HD + EPS);
    for (int d = 0; d < HD; ++d) v[d] = v[d] * r * g[d];
}
__device__ inline void rope_cs(float ang, float& c, float& s) {
    const double r = (double)ang * 0.15915494309189535; const float fr = (float)(r - rint(r));
#ifdef CPU_TEST
    c = (float)cos(6.283185307179586 * (double)fr); s = (float)sin(6.283185307179586 * (double)fr);
#else
    c = __builtin_amdgcn_cosf(fr); s = __builtin_amdgcn_sinf(fr);
#endif
}
__device__ inline void head_rope(float* v, int pos) {
    for (int i = 0; i < 8; ++i) {
        const float ang = (float)pos * INV_FREQ[i]; float c, s; rope_cs(ang, c, s);
        const float x1 = v[i], x2 = v[8 + i];
        v[i] = x1 * c - x2 * s; v[8 + i] = x2 * c + x1 * s;
    }
}
__device__ inline void kvprep_item(size_t i_, const float* p, const float* k_norm  , float* out, float* winrows) {
    const int i = (int)i_;
    if (i >= MT * 6 * N_KV) return;
    const int m = i / (6 * N_KV), e = (i / N_KV) % 6, g = i % N_KV;
    const RowInfo ri = row_info(m);
    float v[HD];
    for (int d = 0; d < HD; ++d) v[d] = p[(size_t)m * KVW + (e * N_KV + g) * HD + d];
    if (e == 2) { head_norm(v, k_norm + HD); head_rope(v, ri.pos); }
    if (e == 4) { head_norm(v, k_norm + 2 * HD); head_rope(v, ri.pos); }
    if (e < 4) {
        float* o = (ri.seq < BATCH) ? out + O_KVP + (((size_t)m * 4 + e) * N_KV + g) * HD : out + O_KVS + (((size_t)(m - MP) * 4 + e) * N_KV + g) * HD;
        for (int d = 0; d < HD; ++d) o[d] = v[d];
    } else {
        const int we = e - 4;
        float* w = winrows + (((size_t)m * 2 + we) * N_KV + g) * HD;
        for (int d = 0; d < HD; ++d) w[d] = v[d];
        if (ri.seq < BATCH) { if (ri.t >= SEQ - WINDOW) { float* o = out + O_WP + ((((size_t)ri.seq * WINDOW + (ri.t - (SEQ - WINDOW))) * 2 + we) * N_KV + g) * HD; for (int d = 0; d < HD; ++d) o[d] = v[d]; } }
        else { float* o = out + O_WS + ((((size_t)(ri.seq - BATCH) * WINDOW + (WINDOW - DEC_SEQ + ri.t)) * 2 + we) * N_KV + g) * HD; for (int d = 0; d < HD; ++d) o[d] = v[d]; }
    }
}
__device__ inline void wincopy_item(size_t i_, const float* cache_win, float* out) {
    const size_t i = i_;
    const size_t per = (size_t)(WINDOW - DEC_SEQ) * 2 * N_KV * HD;
    if (i >= (size_t)DEC_BATCH * per) return;
    const size_t b = i / per, r = i % per;
    out[O_WS + b * WINDOW * 2 * N_KV * HD + r] = cache_win[b * WINDOW * 2 * N_KV * HD + (size_t)DEC_SEQ * 2 * N_KV * HD + r];
}
struct KvSrc { const float* cache_kv; const int* page_table; const float* out; };
__device__ inline const float* kv_full_ptr(const KvSrc& S, int seq, int tok, int e, int g) {
    if (seq < BATCH) return S.out + O_KVP + ((((size_t)seq * SEQ + tok) * 4 + e) * N_KV + g) * HD;
    const int b = seq - BATCH;
    if (tok < PAST_LEN) { const int page = S.page_table[b * N_PAGES + tok / PAGE_SIZE]; return S.cache_kv + ((((size_t)page * PAGE_SIZE + tok % PAGE_SIZE) * 4 + e) * N_KV + g) * HD; }
    if (tok < PAST_LEN + DEC_SEQ) return S.out + O_KVS + ((((size_t)b * DEC_SEQ + (tok - PAST_LEN)) * 4 + e) * N_KV + g) * HD;
    return nullptr;
}
__device__ inline int seq_nbc(int seq) { return seq < BATCH ? NBC_P : NBC_S; }
__device__ inline void cmp_hid_item(size_t i_, KvSrc S, const float* pe  , const float* w1  , float* hid) {
    const size_t i = i_;
    if (i >= (size_t)NSEQ * NBC_MAX * 2 * N_KV * CMP_HID) return;
    const int f = (int)(i % CMP_HID), g = (int)((i / CMP_HID) % N_KV), e = (int)((i / ((size_t)CMP_HID * N_KV)) % 2), c = (int)((i / ((size_t)CMP_HID * N_KV * 2)) % NBC_MAX), seq = (int)(i / ((size_t)CMP_HID * N_KV * 2 * NBC_MAX));
    if (c >= seq_nbc(seq)) return;
    float s = 0.f;
    for (int l = 0; l < L_CMP; ++l) {
        const float* r = kv_full_ptr(S, seq, c * L_CMP + l, e, g);
        const float* w = w1 + (((size_t)e * L_CMP + l) * HD) * CMP_HID + f; const float* pp = pe + ((size_t)e * L_CMP + l) * HD;
        for (int d = 0; d < HD; ++d) s += ((r ? r[d] : 0.f) + pp[d]) * w[(size_t)d * CMP_HID];
    }
    const float x = s; const float t = tanhf(0.7978845608028654f * (x + 0.044715f * x * x * x));
    hid[i] = 0.5f * x * (1.0f + t);
}
__device__ inline void cmp_out_item(size_t i_, const float* hid, const float* w2  , const float* k_norm0, float* kc, float* vc) {
    const int i = (int)i_;
    if (i >= NSEQ * NBC_MAX * 2 * N_KV) return;
    const int g = i % N_KV, e = (i / N_KV) % 2, c = (i / (2 * N_KV)) % NBC_MAX, seq = i / (2 * N_KV * NBC_MAX);
    if (c >= seq_nbc(seq)) return;
    const float* hr = hid + (size_t)i * CMP_HID;
    float v[HD];
    for (int d = 0; d < HD; ++d) { float s = 0.f; for (int f = 0; f < CMP_HID; ++f) s += hr[f] * w2[((size_t)e * CMP_HID + f) * HD + d]; v[d] = s; }
    if (e == 0) head_norm(v, k_norm0);
    float* o = (e == 0 ? kc : vc) + (((size_t)seq * NBC_MAX + c) * N_KV + g) * HD;
    for (int d = 0; d < HD; ++d) o[d] = v[d];
}
__device__ inline void qprep_item(size_t i_, const float* qg, const float* q_norm, float* qn, float* qr, float* gates) {
    const int i = (int)i_;
    if (i >= MT * N_HEADS) return;
    const int m = i / N_HEADS, hh = i % N_HEADS;
    const RowInfo ri = row_info(m);
    float v[HD];
    for (int d = 0; d < HD; ++d) v[d] = qg[(size_t)m * QGW + hh * HD + d];
    head_norm(v, q_norm);
    for (int d = 0; d < HD; ++d) qn[(size_t)m * HDM + hh * HD + d] = v[d];
    head_rope(v, ri.pos);
    for (int d = 0; d < HD; ++d) qr[(size_t)m * HDM + hh * HD + d] = v[d];
    for (int j = 0; j < 3; ++j) { const float x = qg[(size_t)m * QGW + HDM + hh * 3 + j]; gates[(size_t)m * 3 * N_HEADS + hh * 3 + j] = 1.0f / (1.0f + expf(-x)); }
}
__device__ inline void attn_cmp_item(size_t i_, const float* qn, const float* kc, const float* vc, float* pbuf, float* oc) {
    const int i = (int)i_;
    if (i >= MT * N_HEADS) return;
    const int m = i / N_HEADS, hh = i % N_HEADS, g = hh / HPG;
    const RowInfo ri = row_info(m);
    const int nbc = seq_nbc(ri.seq);
    const float* q = qn + (size_t)m * HDM + hh * HD;
    float* p = pbuf + (size_t)i * NBC_MAX;
    float mx = NEGF;
    for (int c = 0; c < nbc; ++c) {
        const bool vis = (c + 1) * L_CMP - 1 <= ri.pos;
        float s = 0.f; const float* k = kc + (((size_t)ri.seq * NBC_MAX + c) * N_KV + g) * HD;
        for (int d = 0; d < HD; ++d) s += q[d] * k[d];
        s *= 0.125f; p[c] = s; if (vis && s > mx) mx = s;
    }
    float sum = 0.f;
    for (int c = 0; c < nbc; ++c) { const bool vis = (c + 1) * L_CMP - 1 <= ri.pos; const float e = vis ? expf(p[c] - mx) : 0.f; p[c] = e; sum += e; }
    const float inv = 1.0f / fmaxf(sum, TINYF);
    float o[HD]; for (int d = 0; d < HD; ++d) o[d] = 0.f;
    for (int c = 0; c < nbc; ++c) { p[c] *= inv; if (p[c] != 0.f) { const float* v = vc + (((size_t)ri.seq * NBC_MAX + c) * N_KV + g) * HD; for (int d = 0; d < HD; ++d) o[d] += p[c] * v[d]; } }
    for (int d = 0; d < HD; ++d) oc[(size_t)m * HDM + hh * HD + d] = o[d];
}
__device__ inline void topk_item(size_t i_, const float* pbuf, int* sel, float* scorebuf  ) {
    const int i = (int)i_;
    if (i >= MT * N_KV) return;
    const int m = i / N_KV, g = i % N_KV;
    const RowInfo ri = row_info(m);
    const int nbs = ri.seq < BATCH ? NBS_P : NBS_S, cur = ri.pos / L_SEL;
    float* score = scorebuf + (size_t)i * NBS_MAX;
    for (int b = 0; b < nbs; ++b) {
        float imp = 0.f;
        for (int h = 0; h < HPG; ++h) { const float* p = pbuf + ((size_t)m * N_HEADS + g * HPG + h) * NBC_MAX; imp += p[2 * b]; }
        float imp2 = 0.f;
        for (int h = 0; h < HPG; ++h) { const float* p = pbuf + ((size_t)m * N_HEADS + g * HPG + h) * NBC_MAX; imp2 += p[2 * b + 1]; }
        const bool forced = (b == 0) || (b == cur) || (b == cur - 1), valid = b * L_SEL <= ri.pos;
        score[b] = valid ? (forced ? FORCE_SCORE : imp + imp2) : NEGF;
    }
    const int nsel = N_SEL < nbs ? N_SEL : nbs;
    for (int j = 0; j < N_SEL; ++j) {
        if (j >= nsel) { sel[(size_t)i * N_SEL + j] = -1; continue; }
        int best = -1; float bv = 0.f;
        for (int b = 0; b < nbs; ++b) if (score[b] > -3e38f && (best < 0 || score[b] > bv)) { best = b; bv = score[b]; }
        sel[(size_t)i * N_SEL + j] = best; score[best] = -3.4e38f;
    }
}
__device__ inline void attn_sel_item(size_t i_, KvSrc S, const float* qr, const int* sel, float* os) {
    const int i = (int)i_;
    if (i >= MT * N_HEADS) return;
    const int m = i / N_HEADS, hh = i % N_HEADS, g = hh / HPG;
    const RowInfo ri = row_info(m);
    const float* q = qr + (size_t)m * HDM + hh * HD;
    const int* sl = sel + ((size_t)m * N_KV + g) * N_SEL;
    float mx = NEGF;
    for (int j = 0; j < N_SEL; ++j) { const int b = sl[j]; if (b < 0) continue;
        for (int t = 0; t < L_SEL; ++t) { const int tok = b * L_SEL + t; if (tok > ri.pos) continue;
            const float* k = kv_full_ptr(S, ri.seq, tok, 2, g); float s = 0.f; if (k) for (int d = 0; d < HD; ++d) s += q[d] * k[d];
            s *= 0.125f; if (s > mx) mx = s; } }
    float sum = 0.f, o[HD]; for (int d = 0; d < HD; ++d) o[d] = 0.f;
    for (int j = 0; j < N_SEL; ++j) { const int b = sl[j]; if (b < 0) continue;
        for (int t = 0; t < L_SEL; ++t) { const int tok = b * L_SEL + t; if (tok > ri.pos) continue;
            const float* k = kv_full_ptr(S, ri.seq, tok, 2, g); float s = 0.f; if (k) for (int d = 0; d < HD; ++d) s += q[d] * k[d];
            const float e = expf(s * 0.125f - mx); sum += e;
            const float* v = kv_full_ptr(S, ri.seq, tok, 3, g); if (v) for (int d = 0; d < HD; ++d) o[d] += e * v[d]; } }
    const float inv = 1.0f / fmaxf(sum, TINYF);
    for (int d = 0; d < HD; ++d) os[(size_t)m * HDM + hh * HD + d] = o[d] * inv;
}
__device__ inline const float* win_ptr(const float* cache_win, const float* winrows, int seq, int kp) {
    if (seq < BATCH) return kp >= 0 ? winrows + (size_t)(seq * SEQ + kp) * 2 * N_KV * HD : nullptr;
    const int b = seq - BATCH;
    if (kp >= PAST_LEN) return winrows + (size_t)(MP + b * DEC_SEQ + (kp - PAST_LEN)) * 2 * N_KV * HD;
    const int j = kp - (PAST_LEN - WINDOW);
    return j >= 0 ? cache_win + ((size_t)b * WINDOW + j) * 2 * N_KV * HD : nullptr;
}
__device__ inline void attn_win_item(size_t i_, const float* cache_win, const float* winrows, const float* qr, const float* gates, const float* oc, const float* os, bf16_t* o_out) {
    const int i = (int)i_;
    if (i >= MT * N_HEADS) return;
    const int m = i / N_HEADS, hh = i % N_HEADS, g = hh / HPG;
    const RowInfo ri = row_info(m);
    const float* q = qr + (size_t)m * HDM + hh * HD;
    float mx = NEGF;
    for (int kp = ri.pos - WINDOW; kp <= ri.pos; ++kp) { const float* r = win_ptr(cache_win, winrows, ri.seq, kp); if (!r) continue;
        const float* k = r + (0 * N_KV + g) * HD; float s = 0.f; for (int d = 0; d < HD; ++d) s += q[d] * k[d]; s *= 0.125f; if (s > mx) mx = s; }
    float sum = 0.f, o[HD]; for (int d = 0; d < HD; ++d) o[d] = 0.f;
    for (int kp = ri.pos - WINDOW; kp <= ri.pos; ++kp) { const float* r = win_ptr(cache_win, winrows, ri.seq, kp); if (!r) continue;
        const float* k = r + (0 * N_KV + g) * HD; float s = 0.f; for (int d = 0; d < HD; ++d) s += q[d] * k[d];
        const float e = expf(s * 0.125f - mx); sum += e; const float* v = r + (1 * N_KV + g) * HD; for (int d = 0; d < HD; ++d) o[d] += e * v[d]; }
    const float inv = 1.0f / fmaxf(sum, TINYF);
    const float* gt = gates + (size_t)m * 3 * N_HEADS + hh * 3;
    for (int d = 0; d < HD; ++d) { const size_t x = (size_t)m * HDM + hh * HD + d; o_out[x] = f2bf(gt[0] * oc[x] + gt[1] * os[x] + gt[2] * o[d] * inv); }
}


#ifndef CPU_TEST
__device__ __forceinline__ unsigned lane_id_v() { unsigned l; asm volatile("v_mbcnt_lo_u32_b32 %0, -1, 0\n\tv_mbcnt_hi_u32_b32 %0, -1, %0" : "=v"(l)); return l; }
#endif
constexpr int NTHREADS = 512;
__host__ __device__ inline bf16_t f2bf_(float f) { unsigned u; memcpy(&u, &f, 4); u = (u + 0x7fffu + ((u >> 16) & 1u)) >> 16; return (bf16_t)u; }
__host__ __device__ inline float bf2f_(bf16_t b) { unsigned u = (unsigned)b << 16; float f; memcpy(&f, &u, 4); return f; }
constexpr int NRSS = 3 * DEPTH + 1;
constexpr int NPOS = SEQ + DEC_SEQ;
constexpr int QGP = ((QGW + 255) / 256) * 256;
__host__ __device__ inline int pos_index(int pos) { return pos < SEQ ? pos : SEQ + (pos - PAST_LEN); }

struct WsMap {
    size_t ctl, rss, rope, h, hb, act, xn, t2, actf, ub, bb, zb, t1, qn, qr, gates, ob, winrows, hid, kc, vc, pbuf, oc, os, sel, scorebuf,
           w_ain, w_aout, w_bin, w_bout, w_cin, w_cout, w_qg, w_o, w_kv, end;
};
constexpr size_t al256(size_t b) { return (b + 255) / 256 * 256; }
constexpr size_t smax(size_t a, size_t b) { return a > b ? a : b; }
constexpr WsMap make_ws_map() {
    WsMap w{}; size_t off = 0;
#define TAKE(f, bytes) w.f = off; off += al256(bytes)
    TAKE(ctl, 65536); TAKE(rss, (size_t)NRSS * MT * 4);
    TAKE(rope, (size_t)NPOS * 16 * 4);
    TAKE(h, (size_t)MT * D_MODEL * 4); TAKE(hb, (size_t)MT * D_MODEL * 2); TAKE(act, (size_t)MT * D_FF * 2);
    TAKE(xn, (size_t)MT * D_MODEL * 4); TAKE(t2, (size_t)MT * D_MODEL * 4); TAKE(actf, (size_t)MT * D_MODEL * 4);
    TAKE(ub, (size_t)MT * D_MODEL * 2); TAKE(bb, (size_t)MT * D_MODEL * 2); TAKE(zb, (size_t)MT * D_MODEL * 2);
    TAKE(t1, smax((size_t)MT * 3 * D_MODEL * 4, (size_t)MT * KVW * 4));
    TAKE(qn, (size_t)MT * HDM * 4); TAKE(qr, (size_t)MT * HDM * 4); TAKE(gates, (size_t)MT * 3 * N_HEADS * 4); TAKE(ob, (size_t)MT * HDM * 2);
    TAKE(winrows, (size_t)MT * 2 * N_KV * HD * 4); TAKE(hid, (size_t)NSEQ * NBC_MAX * 2 * N_KV * CMP_HID * 4);
    TAKE(kc, (size_t)NSEQ * NBC_MAX * N_KV * HD * 4); TAKE(vc, (size_t)NSEQ * NBC_MAX * N_KV * HD * 4);
    TAKE(pbuf, (size_t)MT * N_HEADS * NBC_MAX * 4); TAKE(oc, (size_t)MT * HDM * 4); TAKE(os, (size_t)MT * HDM * 4);
    TAKE(sel, (size_t)MT * N_KV * N_SEL * 4); TAKE(scorebuf, (size_t)MT * N_KV * NBS_MAX * 4);
    TAKE(w_ain, (size_t)DEPTH * 2 * D_FF * D_MODEL * 2); TAKE(w_aout, (size_t)DEPTH * D_MODEL * D_FF * 2);
    TAKE(w_bin, (size_t)DEPTH * 2 * D_FF * D_MODEL * 2); TAKE(w_bout, (size_t)DEPTH * D_MODEL * D_FF * 2);
    TAKE(w_cin, (size_t)N_A * 3 * D_MODEL * D_MODEL * 2); TAKE(w_cout, (size_t)N_A * D_MODEL * D_MODEL * 2);
    TAKE(w_qg, (size_t)N_B * QGP * D_MODEL * 2); TAKE(w_o, (size_t)N_B * D_MODEL * HDM * 2); TAKE(w_kv, (size_t)KVW * D_MODEL * 2);
#undef TAKE
    w.end = off; return w;
}
constexpr WsMap WSM = make_ws_map();
constexpr size_t WS_ZERO_BYTES = 65536 + (((size_t)NRSS * MT * 4 + 255) / 256 * 256);

enum { CM_PLAIN = 0, CM_PAIR = 1, CM_CONV = 2, CM_HEADS = 3 };
__host__ __device__ inline int colmap(int kind, int n, int aux) {
    const int pn = n / 256, c = n % 256;
    if (kind == CM_PLAIN) return n;
    if (kind == CM_PAIR) return (c >= 128 ? aux : 0) + pn * 128 + (c % 128);
    if (kind == CM_CONV) { if (n < 2 * D_MODEL) return (c >= 128 ? 2 * D_MODEL : D_MODEL) + pn * 128 + (c % 128); return n - 2 * D_MODEL; }
    if (n < aux * 64) { const int bj = c / 128, wc = (c % 128) / 32, r = c % 32; return (pn * 4 + wc) * 64 + 32 * bj + r; }
    return n;
}
__device__ inline void wconv_item(size_t i_, const float* src, int Nsrc, const float* gain, bf16_t* dst, int Nd, int K, int kind, int aux) {
    const int n = (int)(i_ % Nd), kb = (int)(i_ / Nd);
    const int col = colmap(kind, n, aux);
    bf16_t* d = dst + (size_t)n * K + (size_t)kb * 64;
    if (col < 0 || col >= Nsrc) { for (int k = 0; k < 64; ++k) d[k] = 0; return; }
    const float* s = src + (size_t)kb * 64 * Nsrc + col;
#pragma unroll 8
    for (int k = 0; k < 64; k += 2) {
        const float g0 = gain ? gain[kb * 64 + k] : 1.f, g1 = gain ? gain[kb * 64 + k + 1] : 1.f;
        const unsigned lo = f2bf(s[(size_t)k * Nsrc] * g0), hi = f2bf(s[(size_t)(k + 1) * Nsrc] * g1);
        *(unsigned*)(d + k) = lo | (hi << 16);
    }
}
__device__ inline void rope_item(size_t i_, float* rope) {
    const int pi = (int)(i_ / 8), f = (int)(i_ % 8);
    const int pos = pi < SEQ ? pi : PAST_LEN + (pi - SEQ);
    float c, s; rope_cs((float)pos * INV_FREQ[f], c, s);
    rope[pi * 16 + f] = c; rope[pi * 16 + 8 + f] = s;
}
__device__ inline void hinit_item(size_t i_, const float* xp, const float* xs, float* h, bf16_t* hb, float* rss0) {
    const int m = (int)i_; const float* x = m < MP ? xp + (size_t)m * D_MODEL : xs + (size_t)(m - MP) * D_MODEL;
    float s = 0.f;
    for (int k = 0; k < D_MODEL; ++k) { const float v = x[k]; s += v * v; h[(size_t)m * D_MODEL + k] = v; hb[(size_t)m * D_MODEL + k] = f2bf(v); }
    rss0[m] = s;
}
__device__ inline void hupd_item(size_t i_, float* h, const float* y, float coef, bf16_t* hb, float* rss) {
    const int m = (int)i_; float s = 0.f;
    for (int k = 0; k < D_MODEL; ++k) { const float v = h[(size_t)m * D_MODEL + k] + coef * y[(size_t)m * D_MODEL + k]; s += v * v; h[(size_t)m * D_MODEL + k] = v; hb[(size_t)m * D_MODEL + k] = f2bf(v); }
    rss[m] = s;
}
__device__ inline float dot_bf(const bf16_t* a, const bf16_t* b, int K) { float s = 0.f; for (int k = 0; k < K; ++k) s += bf2f(a[k]) * bf2f(b[k]); return s; }
__device__ inline float silu_f(float g) { return g / (1.0f + expf(-g)); }
__device__ inline void ref_ffn_in_item(size_t i_, const bf16_t* hb, const float* rss, const bf16_t* Bt, bf16_t* act) {
    const int m = (int)(i_ / D_FF), j = (int)(i_ % D_FF);
    const float rs = 1.0f / sqrtf(rss[m] / D_MODEL + EPS);
    const int ng = (j / 128) * 256 + (j % 128);
    const float g = rs * dot_bf(hb + (size_t)m * D_MODEL, Bt + (size_t)ng * D_MODEL, D_MODEL), u = rs * dot_bf(hb + (size_t)m * D_MODEL, Bt + (size_t)(ng + 128) * D_MODEL, D_MODEL);
    act[i_] = f2bf(silu_f(g) * u);
}
__device__ inline void ref_resid_row_item(size_t i_, const bf16_t* A, int K, const bf16_t* Bt, float coef, float* h, bf16_t* hb, float* rss_next, float* yout) {
    const int m = (int)i_; float s = 0.f;
    for (int c = 0; c < D_MODEL; ++c) {
        const float v = h[(size_t)m * D_MODEL + c] + coef * dot_bf(A + (size_t)m * K, Bt + (size_t)c * K, K);
        if (yout) { yout[(size_t)m * D_MODEL + c] = v; } else { h[(size_t)m * D_MODEL + c] = v; hb[(size_t)m * D_MODEL + c] = f2bf(v); s += v * v; }
    }
    if (!yout) rss_next[m] = s;
}
__host__ __device__ inline int heads_row(int hidx, int d) { return (hidx / 4) * 256 + 128 * (d / 32) + 32 * (hidx % 4) + (d % 32); }
__device__ inline void conv_state_store(float* out, int layer, int m, int ch, float u) {
    const RowInfo ri = row_info(m); const int L = seq_len(ri.seq);
    if (ri.t >= L - 2) { const int j = ri.t - (L - 2);
        if (ri.seq < BATCH) out[O_CP + (((size_t)layer * BATCH + ri.seq) * 2 + j) * D_MODEL + ch] = u;
        else out[O_CS + (((size_t)layer * DEC_BATCH + (ri.seq - BATCH)) * 2 + j) * D_MODEL + ch] = u; }
}
__device__ inline void ref_conv_in_item(size_t i_, const bf16_t* hb, const float* rss, const bf16_t* Bt, bf16_t* ub, bf16_t* bb, float* out, int layer) {
    const int m = (int)(i_ / D_MODEL), j = (int)(i_ % D_MODEL);
    const float rs = 1.0f / sqrtf(rss[m] / D_MODEL + EPS); const bf16_t* a = hb + (size_t)m * D_MODEL;
    const int nc = (j / 128) * 256 + (j % 128);
    const float c = rs * dot_bf(a, Bt + (size_t)nc * D_MODEL, D_MODEL), x = rs * dot_bf(a, Bt + (size_t)(nc + 128) * D_MODEL, D_MODEL), b = rs * dot_bf(a, Bt + (size_t)(2 * D_MODEL + j) * D_MODEL, D_MODEL);
    const float u = c * x; ub[i_] = f2bf(u); bb[i_] = f2bf(b); conv_state_store(out, layer, m, j, u);
}
__device__ inline void conv_thin_item(size_t i_, const bf16_t* ub, const bf16_t* bb, const float* state  , const float* wc  , bf16_t* zb) {
    const int m = (int)(i_ / D_MODEL), ch = (int)(i_ % D_MODEL);
    const RowInfo ri = row_info(m);
    const float u0 = bf2f(ub[i_]);
    float u1, u2;
    if (ri.t >= 1) u1 = bf2f(ub[i_ - D_MODEL]); else u1 = (ri.seq < BATCH) ? 0.f : state[((size_t)(ri.seq - BATCH) * 2 + 1) * D_MODEL + ch];
    if (ri.t >= 2) u2 = bf2f(ub[i_ - 2 * D_MODEL]); else if (ri.seq < BATCH) u2 = 0.f;
    else u2 = (ri.t == 1) ? state[((size_t)(ri.seq - BATCH) * 2 + 1) * D_MODEL + ch] : state[((size_t)(ri.seq - BATCH) * 2 + 0) * D_MODEL + ch];
    zb[i_] = f2bf(bf2f(bb[i_]) * (wc[ch] * u2 + wc[D_MODEL + ch] * u1 + wc[2 * D_MODEL + ch] * u0));
}
__device__ inline void ref_qg_item(size_t i_, const bf16_t* hb, const float* rss, const bf16_t* Bt, const float* q_norm, const float* rope, float* qn, float* qr) {
    const int m = (int)(i_ / N_HEADS), hh = (int)(i_ % N_HEADS);
    const float rs = 1.0f / sqrtf(rss[m] / D_MODEL + EPS); const bf16_t* a = hb + (size_t)m * D_MODEL;
    float v[HD]; for (int d = 0; d < HD; ++d) v[d] = rs * dot_bf(a, Bt + (size_t)heads_row(hh, d) * D_MODEL, D_MODEL);
    head_norm(v, q_norm);
    for (int d = 0; d < HD; ++d) qn[(size_t)m * HDM + hh * HD + d] = v[d];
    const float* rt = rope + (size_t)pos_index(row_info(m).pos) * 16;
    for (int f = 0; f < 8; ++f) { const float x1 = v[f], x2 = v[8 + f]; v[f] = x1 * rt[f] - x2 * rt[8 + f]; v[8 + f] = x2 * rt[f] + x1 * rt[8 + f]; }
    for (int d = 0; d < HD; ++d) qr[(size_t)m * HDM + hh * HD + d] = v[d];
}
__device__ inline void ref_gates_item(size_t i_, const bf16_t* hb, const float* rss, const bf16_t* Bt, float* gates) {
    const int m = (int)(i_ / (3 * N_HEADS)), j = (int)(i_ % (3 * N_HEADS));
    const float rs = 1.0f / sqrtf(rss[m] / D_MODEL + EPS);
    const float x = rs * dot_bf(hb + (size_t)m * D_MODEL, Bt + (size_t)(HDM + j) * D_MODEL, D_MODEL);
    gates[i_] = 1.0f / (1.0f + expf(-x));
}
__device__ inline void kv_store(float* out, float* winrows, int m, int e, int g, int d, float v) {
    const RowInfo ri = row_info(m);
    if (e < 4) { if (ri.seq < BATCH) out[O_KVP + (((size_t)m * 4 + e) * N_KV + g) * HD + d] = v; else out[O_KVS + (((size_t)(m - MP) * 4 + e) * N_KV + g) * HD + d] = v; }
    else { const int we = e - 4;
        winrows[(((size_t)m * 2 + we) * N_KV + g) * HD + d] = v;
        if (ri.seq < BATCH) { if (ri.t >= SEQ - WINDOW) out[O_WP + ((((size_t)ri.seq * WINDOW + (ri.t - (SEQ - WINDOW))) * 2 + we) * N_KV + g) * HD + d] = v; }
        else out[O_WS + ((((size_t)(ri.seq - BATCH) * WINDOW + (WINDOW - DEC_SEQ + ri.t)) * 2 + we) * N_KV + g) * HD + d] = v; }
}
__device__ inline void ref_kv_item(size_t i_, const bf16_t* hb, const float* rss, const bf16_t* Bt, const float* k_norm, const float* rope, float* out, float* winrows) {
    const int m = (int)(i_ / (6 * N_KV)), hidx = (int)(i_ % (6 * N_KV)), e = hidx / N_KV, g = hidx % N_KV;
    const float rs = 1.0f / sqrtf(rss[m] / D_MODEL + EPS); const bf16_t* a = hb + (size_t)m * D_MODEL;
    float v[HD]; for (int d = 0; d < HD; ++d) v[d] = rs * dot_bf(a, Bt + (size_t)heads_row(hidx, d) * D_MODEL, D_MODEL);
    if (e == 2 || e == 4) { head_norm(v, k_norm + (e == 2 ? 1 : 2) * HD);
        const float* rt = rope + (size_t)pos_index(row_info(m).pos) * 16;
        for (int f = 0; f < 8; ++f) { const float x1 = v[f], x2 = v[8 + f]; v[f] = x1 * rt[f] - x2 * rt[8 + f]; v[8 + f] = x2 * rt[f] + x1 * rt[8 + f]; } }
    for (int d = 0; d < HD; ++d) kv_store(out, winrows, m, e, g, d, v[d]);
}
#ifndef CPU_TEST
#define LAS __attribute__((address_space(3)))
#define XB_TMO      128
#define XB_XCNT(j)  (256  + 64 * (j))
#define XB_XSUB(j)  (1280 + 64 * (j))
#define XB_XGEN(j)  (2304 + 64 * (j))
#define XB_TOP      3328
#define XB_TOPGEN   3392
#define XCD_BAR_WORDS 3456
#define XB_SPIN_CAP (1u << 25)
typedef __attribute__((address_space(1))) unsigned GU;
__device__ __forceinline__ unsigned xb_ld(GU* p)              { return __hip_atomic_load(p, __ATOMIC_RELAXED, __HIP_MEMORY_SCOPE_AGENT); }
__device__ __forceinline__ unsigned xb_add(GU* p, unsigned v) { return __hip_atomic_fetch_add(p, v, __ATOMIC_RELAXED, __HIP_MEMORY_SCOPE_AGENT); }
__device__ __forceinline__ unsigned xb_xcc_id() { return (unsigned)__builtin_amdgcn_s_getreg((3 << 11) | 20) & 0xFu; }
#define XB_SPIN(cond, bar) do { unsigned _sp = 0; while (cond) { __builtin_amdgcn_s_sleep(1); \
    if ((++_sp & 255u) == 0u) { if (xb_ld(&(bar)[XB_TMO])) break; if (_sp > XB_SPIN_CAP) { (void)xb_add(&(bar)[XB_TMO], 1u); break; } } } } while (0)
struct XcdBarrier { GU* bar; unsigned x; volatile LAS unsigned* st; };
__device__ __forceinline__ XcdBarrier xcd_barrier_post(GU* bar, volatile LAS unsigned* st, const bool leader_thread) {
    XcdBarrier b; b.bar = bar; b.x = xb_xcc_id(); b.st = st;
    if (leader_thread) (void)xb_add(&bar[XB_XCNT(b.x)], 1u);
    return b;
}
__device__ __forceinline__ void xcd_barrier_complete(GU* bar, unsigned x, unsigned& nloc, unsigned& nx) {
    const unsigned G = gridDim.x * gridDim.y * gridDim.z;
    unsigned sum, cnt, mine, sp = 0u;
    for (;;) {
        sum = 0u; cnt = 0u; mine = 0u;
#pragma unroll
        for (unsigned j = 0; j < 16; ++j) { const unsigned c = xb_ld(&bar[XB_XCNT(j)]); sum += c; cnt += (c > 0u) ? 1u : 0u; mine = (j == x) ? c : mine; }
        if (sum == G) break;
        __builtin_amdgcn_s_sleep(1);
        if ((++sp & 255u) == 0u) { if (xb_ld(&bar[XB_TMO])) break; if (sp > XB_SPIN_CAP) { (void)xb_add(&bar[XB_TMO], 1u); break; } }
    }
    nloc = mine > 0u ? mine : 1u; nx = cnt > 0u ? cnt : 1u;
}
__device__ __forceinline__ void xcd_barrier(const XcdBarrier& b, const bool leader_thread) {
    asm volatile("s_waitcnt vmcnt(0)" ::: "memory");
    __syncthreads();
    if (leader_thread) {
        GU* bar = b.bar; unsigned bx = xb_xcc_id(); asm volatile("" : "+s"(bx));
        __builtin_amdgcn_s_waitcnt(0);
        unsigned nloc = b.st[0], nx = b.st[1];
        if (nloc == 0u) { xcd_barrier_complete(bar, bx, nloc, nx); b.st[0] = nloc; b.st[1] = nx; }
        const unsigned old = xb_add(&bar[XB_XSUB(bx)], 1u);
        const unsigned gen = old / nloc;
        if (old + 1u == (gen + 1u) * nloc) {
            __builtin_amdgcn_fence(__ATOMIC_RELEASE, "agent");
            asm volatile("s_waitcnt vmcnt(0)" ::: "memory");
            const unsigned og = xb_add(&bar[XB_TOP], 1u);
            const unsigned tg = og / nx;
            if (og + 1u == (tg + 1u) * nx) xb_add(&bar[XB_TOPGEN], 1u);
            else XB_SPIN(xb_ld(&bar[XB_TOPGEN]) == tg, bar);
            __builtin_amdgcn_fence(__ATOMIC_ACQUIRE, "agent");
            xb_add(&bar[XB_XGEN(bx)], 1u);
            asm volatile("s_waitcnt vmcnt(0)" ::: "memory");
        } else {
            XB_SPIN(xb_ld(&bar[XB_XGEN(bx)]) == gen, bar);
            __builtin_amdgcn_fence(__ATOMIC_ACQUIRE, "agent");
            asm volatile("s_waitcnt vmcnt(0)" ::: "memory");
        }
    }
    __syncthreads();
}

namespace pg8 {
#define PG8_LAS __attribute__((address_space(3)))
typedef unsigned short bf16_t;
typedef short bf16x8 __attribute__((ext_vector_type(8)));
typedef float f32x4 __attribute__((ext_vector_type(4)));
typedef unsigned u32x4 __attribute__((ext_vector_type(4)));
constexpr int BM = 256, BK = 64, HALF = 128, HTB = HALF * BK * 2  , STAGE_BYTES = 8 * HTB, NXCD = 8, WGM = 8;

__host__ __device__ __forceinline__ int lds_byte(int r, int c) { const int st = (r >> 4) * 2 + (c >> 5), rr = r & 15, cc = c & 31, ob = rr * 64 + cc * 2; return st * 1024 + (ob ^ (((ob >> 9) & 1) << 5)); }
__host__ __device__ __forceinline__ void stage_rc(int b, int& R, int& C) { const int st = b / 1024, sb = b % 1024, swz = sb ^ (((sb >> 9) & 1) << 5); R = (st >> 1) * 16 + swz / 64; C = (st & 1) * 32 + (swz % 64) / 2; }
__host__ __device__ __forceinline__ int perm32(int rho) { const int n = rho >> 4, i = rho & 15; return 8 * (i >> 2) + 4 * n + (i & 3); }

struct Unit { int pm, pn; };
struct Gemm { const bf16_t* A; const bf16_t* Bt; int M, N, K; };

struct StaticOrder {
    int nM, nN, nwg, G, c;
    __host__ __device__ void init(int M, int N, int G_, int c_) { nM = M / BM; nN = N / BM; nwg = nM * nN; G = G_; c = c_; }
    __host__ __device__ bool next(int i, Unit& u) const {
        const long L = (long)i * G + c; if (L >= nwg) return false;
        int wgid = (int)L; { const int q = nwg / NXCD, r = nwg % NXCD, xcd = wgid % NXCD, off = wgid / NXCD; wgid = (xcd < r ? xcd * (q + 1) : r * (q + 1) + (xcd - r) * q) + off; }
        const int nig = WGM * nN, gid = wgid / nig, fm = gid * WGM, gsz = (nM - fm) < WGM ? (nM - fm) : WGM;
        u.pm = fm + ((wgid % nig) % gsz); u.pn = (wgid % nig) / gsz; return true;
    }
    __device__ __forceinline__ void a_ready(const Unit&) const {}
    __device__ __forceinline__ void done(const Unit&) const {}
};

__device__ __forceinline__ unsigned cvt_pk_bf16(float lo, float hi) { unsigned r; asm volatile("v_cvt_pk_bf16_f32 %0, %1, %2" : "=v"(r) : "v"(lo), "v"(hi)); return r; }
template <class Epi, class Sched, bool ALIGN_EPI = false, bool SP2 = false>
__device__ __forceinline__ void gemm_phase(int wave_id_, PG8_LAS unsigned char* lds, const Gemm g, const Sched& S, const Epi& E) {
    int wid = wave_id_, lane = (int)lane_id_v(); asm volatile("" : "+s"(wid));
    const int tid = wid * 64 + lane, wr = wid >> 2, wc = wid & 3, fr = lane & 15, fq = lane >> 4;
    const int K = g.K, nt = K / BK;
    unsigned voffA[2], voffB[2];
#pragma unroll
    for (int i = 0; i < 2; ++i) { int R, C; stage_rc(tid * 16 + i * 8192, R, C); const int Rb = Epi::PERM ? ((R & ~31) + perm32(R & 31)) : R;
        voffA[i] = (unsigned)(R * K + C) * 2u; voffB[i] = (unsigned)(Rb * K + C) * 2u; }
    const size_t kstep = (size_t)(BK * 2);
    const size_t hstep = (size_t)HALF * K * 2;
    const size_t tstep = 2 * hstep;
    const unsigned ldsw = (unsigned)wid * 1024u;
    const int aoff = lds_byte(wr * 64 + fr, fq * 8), boff = lds_byte(wc * 32 + fr, fq * 8);
#define PG8_SA(b, h) (((b) * 2 + (h)) * HTB)
#define PG8_SB(b, h) ((4 + (b) * 2 + (h)) * HTB)
#define PG8_STAGE(bufoff, gbase, voff) do { _Pragma("unroll") for (int _i = 0; _i < 2; ++_i) \
        __builtin_amdgcn_global_load_lds((const unsigned*)((const char*)(gbase) + (voff)[_i]), (PG8_LAS unsigned*)(lds + (bufoff) + ldsw + _i * 8192), 16, 0, 0); } while (0)
#define PG8_LDA(dst, b, h) do { _Pragma("unroll") for (int m = 0; m < 4; ++m) _Pragma("unroll") for (int k = 0; k < 2; ++k) dst[m][k] = *(const PG8_LAS bf16x8*)(lds + PG8_SA(b, h) + aoff + m * 2048 + k * 1024); } while (0)
#define PG8_LDB(dst, b, h) do { _Pragma("unroll") for (int n = 0; n < 2; ++n) _Pragma("unroll") for (int k = 0; k < 2; ++k) dst[n][k] = *(const PG8_LAS bf16x8*)(lds + PG8_SB(b, h) + boff + n * 2048 + k * 1024); } while (0)
#define PG8_MMA(ai, bj, At, Bt) do { __builtin_amdgcn_s_setprio(1); _Pragma("unroll") for (int m = 0; m < 4; ++m) _Pragma("unroll") for (int n = 0; n < 2; ++n) _Pragma("unroll") for (int k = 0; k < 2; ++k) \
        acc[ai][bj][m][n] = __builtin_amdgcn_mfma_f32_16x16x32_bf16(Bt[n][k], At[m][k], acc[ai][bj][m][n], 0, 0, 0); __builtin_amdgcn_s_setprio(0); } while (0)
#define PG8_WAIT_V(n) asm volatile("s_waitcnt vmcnt(" #n ")" ::: "memory")
#define PG8_WAIT_L(n) asm volatile("s_waitcnt lgkmcnt(" #n ")" ::: "memory")
#define PG8_BAR __builtin_amdgcn_s_barrier()
#define PG8_SCHED __builtin_amdgcn_sched_barrier(0)
    Unit cur, nxt; int ui = 0;
    if (!S.next(0, cur)) return;
    f32x4 acc[2][2][4][2];
#pragma unroll
    for (int a = 0; a < 2; ++a)
#pragma unroll
        for (int b = 0; b < 2; ++b)
#pragma unroll
            for (int m = 0; m < 4; ++m)
#pragma unroll
                for (int n = 0; n < 2; ++n) acc[a][b][m][n] = (f32x4){0.f, 0.f, 0.f, 0.f};
    bf16x8 At[4][2], B0[2][2], B1[2][2];
    const char* cA = (const char*)g.A + (size_t)cur.pm * tstep; const char* cB = (const char*)g.Bt + (size_t)cur.pn * tstep;
    S.a_ready(cur);
    if constexpr (SP2) {
        PG8_STAGE(PG8_SB(0, 0), cB, voffB); PG8_STAGE(PG8_SB(0, 1), cB + hstep, voffB); PG8_STAGE(PG8_SA(0, 0), cA, voffA); PG8_STAGE(PG8_SA(0, 1), cA + hstep, voffA);
        if (wr == 1) PG8_BAR;
        PG8_WAIT_V(2); PG8_BAR;
        PG8_STAGE(PG8_SB(1, 0), cB + kstep, voffB); PG8_STAGE(PG8_SA(1, 0), cA + kstep, voffA); PG8_STAGE(PG8_SB(1, 1), cB + hstep + kstep, voffB);
        PG8_WAIT_V(6); PG8_BAR;
    } else {
        PG8_STAGE(PG8_SB(0, 0), cB, voffB); PG8_STAGE(PG8_SA(0, 0), cA, voffA); PG8_STAGE(PG8_SB(0, 1), cB + hstep, voffB); PG8_STAGE(PG8_SA(0, 1), cA + hstep, voffA);
        if (wr == 1) PG8_BAR;
        PG8_WAIT_V(4); PG8_BAR;
        PG8_STAGE(PG8_SB(1, 0), cB + kstep, voffB); PG8_STAGE(PG8_SA(1, 0), cA + kstep, voffA); PG8_STAGE(PG8_SB(1, 1), cB + hstep + kstep, voffB);
        PG8_WAIT_V(6); PG8_BAR;
    }
    for (;;) {
        const bool has_next = S.next(ui + 1, nxt);
        const char* nA = has_next ? (const char*)g.A + (size_t)nxt.pm * tstep : cA; const char* nB = has_next ? (const char*)g.Bt + (size_t)nxt.pn * tstep : cB;
        for (int t = 0; t < nt; t += 2) {
            const bool last = (t == nt - 2);
            const char* a1 = cA + (size_t)(t + 1) * kstep;
            const char* a2 = last ? nA : cA + (size_t)(t + 2) * kstep; const char* b2 = last ? nB : cB + (size_t)(t + 2) * kstep;
            const char* a3 = a2 + kstep; const char* b3 = b2 + kstep;
            if (last && has_next) S.a_ready(nxt);
            if constexpr (SP2) {
            PG8_LDB(B0, 0, 0); PG8_LDB(B1, 0, 1); PG8_SCHED; PG8_LDA(At, 0, 0); PG8_STAGE(PG8_SA(1, 1), a1 + hstep, voffA);
            PG8_WAIT_V(8); PG8_WAIT_L(0); PG8_BAR; PG8_MMA(0, 0, At, B0); PG8_MMA(0, 1, At, B1); PG8_BAR; PG8_SCHED;
            PG8_LDA(At, 0, 1); PG8_STAGE(PG8_SB(0, 0), b2, voffB); PG8_STAGE(PG8_SB(0, 1), b2 + hstep, voffB); PG8_STAGE(PG8_SA(0, 0), a2, voffA);
            PG8_WAIT_V(8); PG8_WAIT_L(0); PG8_BAR; PG8_MMA(1, 0, At, B0); PG8_MMA(1, 1, At, B1); PG8_BAR; PG8_SCHED;
            PG8_LDB(B0, 1, 0); PG8_LDB(B1, 1, 1); PG8_SCHED; PG8_LDA(At, 1, 0); PG8_STAGE(PG8_SA(0, 1), a2 + hstep, voffA);
            PG8_WAIT_V(8); PG8_WAIT_L(0); PG8_BAR; PG8_MMA(0, 0, At, B0); PG8_MMA(0, 1, At, B1); PG8_BAR; PG8_SCHED;
            PG8_LDA(At, 1, 1); PG8_STAGE(PG8_SB(1, 0), b3, voffB); PG8_STAGE(PG8_SB(1, 1), b3 + hstep, voffB); PG8_STAGE(PG8_SA(1, 0), a3, voffA);
            PG8_WAIT_V(8); PG8_WAIT_L(0); PG8_BAR; PG8_MMA(1, 0, At, B0); PG8_MMA(1, 1, At, B1); PG8_BAR; PG8_SCHED;
            } else {
            PG8_LDB(B0, 0, 0); PG8_SCHED; PG8_LDA(At, 0, 0); PG8_STAGE(PG8_SA(1, 1), a1 + hstep, voffA);
            PG8_WAIT_L(8); PG8_BAR; PG8_WAIT_L(0); PG8_MMA(0, 0, At, B0); PG8_BAR; PG8_SCHED;
            PG8_LDB(B1, 0, 1); PG8_STAGE(PG8_SB(0, 0), b2, voffB);
            PG8_BAR; PG8_WAIT_L(0); PG8_MMA(0, 1, At, B1); PG8_BAR;
            PG8_LDA(At, 0, 1); PG8_STAGE(PG8_SA(0, 0), a2, voffA);
            PG8_BAR; PG8_WAIT_L(0); PG8_MMA(1, 0, At, B0); PG8_BAR; PG8_SCHED;
            PG8_STAGE(PG8_SB(0, 1), b2 + hstep, voffB);
            PG8_WAIT_V(6); PG8_BAR; PG8_MMA(1, 1, At, B1); PG8_BAR;
            PG8_LDB(B0, 1, 0); PG8_SCHED; PG8_LDA(At, 1, 0); PG8_STAGE(PG8_SA(0, 1), a2 + hstep, voffA);
            PG8_WAIT_L(8); PG8_BAR; PG8_WAIT_L(0); PG8_MMA(0, 0, At, B0); PG8_BAR; PG8_SCHED;
            PG8_LDB(B1, 1, 1); PG8_STAGE(PG8_SB(1, 0), b3, voffB);
            PG8_BAR; PG8_WAIT_L(0); PG8_MMA(0, 1, At, B1); PG8_BAR;
            PG8_LDA(At, 1, 1); PG8_STAGE(PG8_SA(1, 0), a3, voffA);
            PG8_BAR; PG8_WAIT_L(0); PG8_MMA(1, 0, At, B0); PG8_BAR; PG8_SCHED;
            PG8_STAGE(PG8_SB(1, 1), b3 + hstep, voffB);
            PG8_WAIT_V(6); PG8_BAR; PG8_MMA(1, 1, At, B1); PG8_BAR;
            }
        }
        if constexpr (ALIGN_EPI) { if (wr == 0) PG8_BAR; }
        if constexpr (!Epi::AFTER_DRAIN) { E(acc, cur, wr, wc, fr, fq); S.done(cur); }
        if (!has_next) break;
#pragma unroll
        for (int a = 0; a < 2; ++a)
#pragma unroll
            for (int b = 0; b < 2; ++b)
#pragma unroll
                for (int m = 0; m < 4; ++m)
#pragma unroll
                    for (int n = 0; n < 2; ++n) acc[a][b][m][n] = (f32x4){0.f, 0.f, 0.f, 0.f};
        cur = nxt; cA = nA; cB = nB; ++ui;
        if constexpr (ALIGN_EPI) { if (wr == 1) PG8_BAR; }
    }
    PG8_WAIT_V(0);
    if constexpr (!ALIGN_EPI) { if (wr == 0) PG8_BAR; }
    PG8_BAR;
    if constexpr (Epi::AFTER_DRAIN) { E.fused(acc, cur, wr, wc, fr, fq, lds, wid, lane); S.done(cur); }
#undef PG8_SA
#undef PG8_SB
#undef PG8_STAGE
#undef PG8_LDA
#undef PG8_LDB
#undef PG8_MMA
#undef PG8_WAIT_V
#undef PG8_WAIT_L
#undef PG8_BAR
#undef PG8_SCHED
}
}

namespace pg8 {
__device__ __forceinline__ float fast_silu(float g) { return g * __builtin_amdgcn_rcpf(1.0f + __expf(-g)); }
__device__ __forceinline__ float row_rs(const float* rss, int row) { return rsqrtf(rss[row] * (1.0f / D_MODEL) + EPS); }
struct EpiSwiglu {
    static constexpr bool PERM = true, AFTER_DRAIN = false;
    bf16_t* act; const float* rss;
    __device__ __forceinline__ void operator()(const f32x4 (&acc)[2][2][4][2], const Unit& u, int wr, int wc, int fr, int fq) const {
        const int row0 = u.pm * BM + wr * 64 + fr, col0 = u.pn * 128 + wc * 32 + 8 * fq;
#pragma unroll
        for (int ai = 0; ai < 2; ++ai)
#pragma unroll
            for (int m = 0; m < 4; ++m) {
                const int row = row0 + ai * HALF + m * 16; const float rs = row_rs(rss, row);
                float a[8];
#pragma unroll
                for (int n = 0; n < 2; ++n)
#pragma unroll
                    for (int i = 0; i < 4; ++i) a[n * 4 + i] = fast_silu(acc[ai][0][m][n][i] * rs) * (acc[ai][1][m][n][i] * rs);
                u32x4 w; w.x = cvt_pk_bf16(a[0], a[1]); w.y = cvt_pk_bf16(a[2], a[3]); w.z = cvt_pk_bf16(a[4], a[5]); w.w = cvt_pk_bf16(a[6], a[7]);
                *(u32x4*)(act + (size_t)row * D_FF + col0) = w;
            }
    }
};
struct EpiResid {
    static constexpr bool PERM = false, AFTER_DRAIN = false;
    float* h; bf16_t* hb; float* rss_next; float* yout; float coef;
    __device__ __forceinline__ void operator()(const f32x4 (&acc)[2][2][4][2], const Unit& u, int wr, int wc, int fr, int fq) const {
        const int row0 = u.pm * BM + wr * 64 + fr, col0 = u.pn * BM + wc * 32 + 4 * fq;
#pragma unroll
        for (int ai = 0; ai < 2; ++ai)
#pragma unroll
            for (int m = 0; m < 4; ++m) {
                const int row = row0 + ai * HALF + m * 16; float s = 0.f;
                float* hr = h + (size_t)row * D_MODEL + col0;
#pragma unroll
                for (int bj = 0; bj < 2; ++bj)
#pragma unroll
                    for (int n = 0; n < 2; ++n) {
                        const int co = bj * HALF + n * 16;
                        const f32x4 v = *(const f32x4*)(hr + co) + acc[ai][bj][m][n] * coef;
                        if (yout) { *(f32x4*)(yout + (size_t)row * D_MODEL + col0 + co) = v; }
                        else {
                            *(f32x4*)(hr + co) = v;
                            typedef unsigned u32x2 __attribute__((ext_vector_type(2)));
                            u32x2 w; w.x = cvt_pk_bf16(v[0], v[1]); w.y = cvt_pk_bf16(v[2], v[3]);
                            *(u32x2*)(hb + (size_t)row * D_MODEL + col0 + co) = w;
                            s += (v[0] * v[0] + v[1] * v[1]) + (v[2] * v[2] + v[3] * v[3]);
                        }
                    }
                if (!yout) { s += __shfl_xor(s, 16); s += __shfl_xor(s, 32); if (fq == 0) (void)__hip_atomic_fetch_add(rss_next + row, s, __ATOMIC_RELAXED, __HIP_MEMORY_SCOPE_AGENT); }
            }
    }
};
}
namespace pg8 {
__device__ __forceinline__ float sum4(f32x4 v) { return (v[0] * v[0] + v[1] * v[1]) + (v[2] * v[2] + v[3] * v[3]); }
struct EpiConvIn {
    static constexpr bool PERM = true, AFTER_DRAIN = false;
    bf16_t* ub; bf16_t* bb; const float* rss; float* out; int layer;
    __device__ __forceinline__ void operator()(const f32x4 (&acc)[2][2][4][2], const Unit& u, int wr, int wc, int fr, int fq) const {
        const int row0 = u.pm * BM + wr * 64 + fr;
        const bool pair = u.pn < D_MODEL / 128;
#pragma unroll
        for (int ai = 0; ai < 2; ++ai)
#pragma unroll
            for (int m = 0; m < 4; ++m) {
                const int row = row0 + ai * HALF + m * 16; const float rs = row_rs(rss, row);
                if (pair) {
                    const int col0 = u.pn * 128 + wc * 32 + 8 * fq; float a[8];
#pragma unroll
                    for (int n = 0; n < 2; ++n)
#pragma unroll
                        for (int i = 0; i < 4; ++i) a[n * 4 + i] = (acc[ai][0][m][n][i] * rs) * (acc[ai][1][m][n][i] * rs);
                    u32x4 w; w.x = cvt_pk_bf16(a[0], a[1]); w.y = cvt_pk_bf16(a[2], a[3]); w.z = cvt_pk_bf16(a[4], a[5]); w.w = cvt_pk_bf16(a[6], a[7]);
                    *(u32x4*)(ub + (size_t)row * D_MODEL + col0) = w;
                    const RowInfo ri = row_info(row); const int jj = ri.t - (seq_len(ri.seq) - 2);
                    if (jj >= 0) {
                        float* cs = (ri.seq < BATCH) ? out + O_CP + (((size_t)layer * BATCH + ri.seq) * 2 + jj) * D_MODEL + col0 : out + O_CS + (((size_t)layer * DEC_BATCH + (ri.seq - BATCH)) * 2 + jj) * D_MODEL + col0;
                        *(f32x4*)(cs) = (f32x4){a[0], a[1], a[2], a[3]}; *(f32x4*)(cs + 4) = (f32x4){a[4], a[5], a[6], a[7]};
                    }
                } else {
#pragma unroll
                    for (int bj = 0; bj < 2; ++bj) {
                        const int col0 = (u.pn - D_MODEL / 128) * 256 + bj * HALF + wc * 32 + 8 * fq;
                        const f32x4 v0 = acc[ai][bj][m][0] * rs, v1 = acc[ai][bj][m][1] * rs;
                        u32x4 w; w.x = cvt_pk_bf16(v0[0], v0[1]); w.y = cvt_pk_bf16(v0[2], v0[3]); w.z = cvt_pk_bf16(v1[0], v1[1]); w.w = cvt_pk_bf16(v1[2], v1[3]);
                        *(u32x4*)(bb + (size_t)row * D_MODEL + col0) = w;
                    }
                }
                asm volatile("" ::: "memory");
            }
    }
};
__device__ __forceinline__ void head_norm_rope(f32x4 (&v)[2][2], const float* gain, const float* rt  , int fq, bool do_norm, bool do_rope, f32x4 (&rot0)[2]) {
    if (do_norm) {
        float ss = (sum4(v[0][0]) + sum4(v[0][1])) + (sum4(v[1][0]) + sum4(v[1][1]));
        ss += __shfl_xor(ss, 16); ss += __shfl_xor(ss, 32);
        const float r = rsqrtf(ss * (1.0f / HD) + EPS);
#pragma unroll
        for (int bj = 0; bj < 2; ++bj)
#pragma unroll
            for (int n = 0; n < 2; ++n) { const f32x4 g = *(const f32x4*)(gain + 32 * bj + 8 * fq + 4 * n); v[bj][n] = v[bj][n] * r * g; }
    }
    rot0[0] = v[0][0]; rot0[1] = v[0][1];
    if (do_rope) {
#pragma unroll
        for (int n = 0; n < 2; ++n) {
            f32x4 p;
#pragma unroll
            for (int i = 0; i < 4; ++i) p[i] = __shfl_xor(v[0][n][i], 16);
            const f32x4 c = *(const f32x4*)(rt + 4 * n), s = *(const f32x4*)(rt + 8 + 4 * n);
            if (fq == 0) rot0[n] = v[0][n] * c - p * s; else if (fq == 1) rot0[n] = v[0][n] * c + p * s;
        }
    }
}
struct EpiQG {
    static constexpr bool PERM = true, AFTER_DRAIN = false;
    float* qn; float* qr; float* gates; const float* rss; const float* q_norm; const float* rope;
    __device__ __forceinline__ void operator()(const f32x4 (&acc)[2][2][4][2], const Unit& u, int wr, int wc, int fr, int fq) const {
        const int row0 = u.pm * BM + wr * 64 + fr;
#pragma unroll
        for (int ai = 0; ai < 2; ++ai)
#pragma unroll
            for (int m = 0; m < 4; ++m) {
                const int row = row0 + ai * HALF + m * 16; const float rs = row_rs(rss, row);
                if (u.pn < N_HEADS / 4) {
                    const int hh = u.pn * 4 + wc;
                    f32x4 v[2][2] = {{acc[ai][0][m][0] * rs, acc[ai][0][m][1] * rs}, {acc[ai][1][m][0] * rs, acc[ai][1][m][1] * rs}}; f32x4 rot0[2];
                    head_norm_rope(v, q_norm, rope + (size_t)pos_index(row_info(row).pos) * 16, fq, true, true, rot0);
                    float* qnp = qn + (size_t)row * HDM + hh * HD + 8 * fq; float* qrp = qr + (size_t)row * HDM + hh * HD + 8 * fq;
                    *(f32x4*)(qnp) = v[0][0]; *(f32x4*)(qnp + 4) = v[0][1]; *(f32x4*)(qnp + 32) = v[1][0]; *(f32x4*)(qnp + 36) = v[1][1];
                    *(f32x4*)(qrp) = rot0[0]; *(f32x4*)(qrp + 4) = rot0[1]; *(f32x4*)(qrp + 32) = v[1][0]; *(f32x4*)(qrp + 36) = v[1][1];
                } else {
                    const int c0 = wc * 32 + 8 * fq;
#pragma unroll
                    for (int n = 0; n < 2; ++n)
#pragma unroll
                        for (int i = 0; i < 4; ++i) { const int c = c0 + 4 * n + i; if (c < 3 * N_HEADS) gates[(size_t)row * 3 * N_HEADS + c] = __builtin_amdgcn_rcpf(1.0f + __expf(-(acc[ai][0][m][n][i] * rs))); }
                }
                asm volatile("" ::: "memory");
            }
    }
};
struct EpiKV {
    static constexpr bool PERM = true, AFTER_DRAIN = false;
    float* out; float* winrows; const float* rss; const float* k_norm; const float* rope;
    __device__ __forceinline__ void operator()(const f32x4 (&acc)[2][2][4][2], const Unit& u, int wr, int wc, int fr, int fq) const {
        const int row0 = u.pm * BM + wr * 64 + fr;
        const int hidx = u.pn * 4 + wc, e = hidx / N_KV, g = hidx % N_KV; const bool nr = (e == 2 || e == 4);
#pragma unroll
        for (int ai = 0; ai < 2; ++ai)
#pragma unroll
            for (int m = 0; m < 4; ++m) {
                const int row = row0 + ai * HALF + m * 16; const float rs = row_rs(rss, row);
                const RowInfo ri = row_info(row);
                f32x4 v[2][2] = {{acc[ai][0][m][0] * rs, acc[ai][0][m][1] * rs}, {acc[ai][1][m][0] * rs, acc[ai][1][m][1] * rs}}; f32x4 rot0[2];
                head_norm_rope(v, k_norm + (e == 2 ? 1 : 2) * HD, rope + (size_t)pos_index(ri.pos) * 16, fq, nr, nr, rot0);
                float* d0; float* d1 = nullptr;
                if (e < 4) d0 = (ri.seq < BATCH) ? out + O_KVP + (((size_t)row * 4 + e) * N_KV + g) * HD : out + O_KVS + (((size_t)(row - MP) * 4 + e) * N_KV + g) * HD;
                else { const int we = e - 4; d0 = winrows + (((size_t)row * 2 + we) * N_KV + g) * HD;
                    if (ri.seq < BATCH) { if (ri.t >= SEQ - WINDOW) d1 = out + O_WP + ((((size_t)ri.seq * WINDOW + (ri.t - (SEQ - WINDOW))) * 2 + we) * N_KV + g) * HD; }
                    else d1 = out + O_WS + ((((size_t)(ri.seq - BATCH) * WINDOW + (WINDOW - DEC_SEQ + ri.t)) * 2 + we) * N_KV + g) * HD; }
                d0 += 8 * fq; *(f32x4*)(d0) = rot0[0]; *(f32x4*)(d0 + 4) = rot0[1]; *(f32x4*)(d0 + 32) = v[1][0]; *(f32x4*)(d0 + 36) = v[1][1];
                if (d1) { d1 += 8 * fq; *(f32x4*)(d1) = rot0[0]; *(f32x4*)(d1 + 4) = rot0[1]; *(f32x4*)(d1 + 32) = v[1][0]; *(f32x4*)(d1 + 36) = v[1][1]; }
                asm volatile("" ::: "memory");
            }
    }
};
}
#endif

#ifndef CPU_TEST
__device__ __forceinline__ size_t opaque_gtid(int wave) { int w = wave; asm volatile("" : "+s"(w)); unsigned t = blockIdx.x * NTHREADS + w * 64 + lane_id_v(); return (size_t)t; }
#define ITEM_LOOP(total) for (size_t i = opaque_gtid(wave_id); i < (size_t)(total); i += (size_t)gridDim.x * NTHREADS)
#else
#define ITEM_LOOP(total) _Pragma("omp parallel for schedule(dynamic, 64)") for (long long i = 0; i < (long long)(total); ++i)
#endif

struct Params {
    const float *x_prompt, *x_sample, *cache_kv, *cache_win, *state_conv; const int* page_table;
    const float *ffn_a_norm, *ffn_a_w_in, *ffn_a_w_out, *mix_norm, *ffn_b_norm, *ffn_b_w_in, *ffn_b_w_out, *conv_w_in, *conv_w, *conv_w_out, *kv_norm, *w_kv, *k_norm,
                *cmp_pe, *cmp_w1, *cmp_w2, *nsa_w_qg, *nsa_q_norm, *nsa_w_o;
    float* out; unsigned char* ws;
};
constexpr int LDS_RING = 131072, LDS_BAR_OFF = LDS_RING + 352, LDS_BYTES = 147456;

#ifndef CPU_TEST
typedef const __attribute__((address_space(4))) Params* KParamsPtr;
__device__ __forceinline__ KParamsPtr kparams_ptr() {
#if defined(__HIP_DEVICE_COMPILE__)
    KParamsPtr p = (KParamsPtr)__builtin_amdgcn_kernarg_segment_ptr(); asm volatile("" : "+s"(p)); return p;
#else
    return nullptr;
#endif
}
__device__ __forceinline__ Params load_params() {
#if defined(__HIP_DEVICE_COMPILE__)
    return *kparams_ptr();
#else
    return Params{};
#endif
}
__device__ __forceinline__ unsigned char* load_ws() {
#if defined(__HIP_DEVICE_COMPILE__)
    return kparams_ptr()->ws;
#else
    return nullptr;
#endif
}
#define KP const Params P = load_params()
__device__ __forceinline__ int opaque_s(int v) { asm volatile("" : "+s"(v)); return v; }
#define GRID_SYNC() do { XcdBarrier bar_; bar_.bar = (GU*)load_ws() + 1024; bar_.x = 0; bar_.st = (volatile LAS unsigned*)(lds + LDS_BAR_OFF); xcd_barrier(bar_, wave_id == 0 && lane_id_v() == 0u); } while (0)
__global__ void __launch_bounds__(NTHREADS, 2) mega(Params P_unused)
#else
static Params g_params;
#define KP const Params& P = g_params
#define GRID_SYNC() do {} while (0)
void mega(Params P_unused)
#endif
{
#ifndef CPU_TEST
    extern __shared__ __attribute__((aligned(16))) unsigned char lds[];
    const int wave_id = __builtin_amdgcn_readfirstlane((int)(threadIdx.x >> 6));
    if (threadIdx.x < 4) ((LAS unsigned*)(lds + LDS_BAR_OFF))[threadIdx.x] = 0u;
    __syncthreads();
    (void)xcd_barrier_post((GU*)load_ws() + 1024, (volatile LAS unsigned*)(lds + LDS_BAR_OFF), threadIdx.x == 0);
#define RING ((PG8_LAS unsigned char*)lds)
#else
    g_params = P_unused;
#endif
#define WS_F(f) ((float*)(P.ws + WSM.f))
#define WS_B(f) ((bf16_t*)(P.ws + WSM.f))
#define KVSRC KvSrc{P.cache_kv, P.page_table, P.out}
    for (int L = 0; L < DEPTH; ++L) {
        KP;
        ITEM_LOOP((size_t)2 * D_FF * (D_MODEL / 64)) wconv_item(i, P.ffn_a_w_in + (size_t)L * D_MODEL * 2 * D_FF, 2 * D_FF, P.ffn_a_norm + (size_t)L * D_MODEL, WS_B(w_ain) + (size_t)L * 2 * D_FF * D_MODEL, 2 * D_FF, D_MODEL, CM_PAIR, D_FF);
        ITEM_LOOP((size_t)D_MODEL * (D_FF / 64)) wconv_item(i, P.ffn_a_w_out + (size_t)L * D_FF * D_MODEL, D_MODEL, nullptr, WS_B(w_aout) + (size_t)L * D_MODEL * D_FF, D_MODEL, D_FF, CM_PLAIN, 0);
        ITEM_LOOP((size_t)2 * D_FF * (D_MODEL / 64)) wconv_item(i, P.ffn_b_w_in + (size_t)L * D_MODEL * 2 * D_FF, 2 * D_FF, P.ffn_b_norm + (size_t)L * D_MODEL, WS_B(w_bin) + (size_t)L * 2 * D_FF * D_MODEL, 2 * D_FF, D_MODEL, CM_PAIR, D_FF);
        ITEM_LOOP((size_t)D_MODEL * (D_FF / 64)) wconv_item(i, P.ffn_b_w_out + (size_t)L * D_FF * D_MODEL, D_MODEL, nullptr, WS_B(w_bout) + (size_t)L * D_MODEL * D_FF, D_MODEL, D_FF, CM_PLAIN, 0);
    }
    for (int L = 0; L < N_A; ++L) {
        KP;
        ITEM_LOOP((size_t)3 * D_MODEL * (D_MODEL / 64)) wconv_item(i, P.conv_w_in + (size_t)L * D_MODEL * 3 * D_MODEL, 3 * D_MODEL, P.mix_norm + (size_t)L * D_MODEL, WS_B(w_cin) + (size_t)L * 3 * D_MODEL * D_MODEL, 3 * D_MODEL, D_MODEL, CM_CONV, 0);
        ITEM_LOOP((size_t)D_MODEL * (D_MODEL / 64)) wconv_item(i, P.conv_w_out + (size_t)L * D_MODEL * D_MODEL, D_MODEL, nullptr, WS_B(w_cout) + (size_t)L * D_MODEL * D_MODEL, D_MODEL, D_MODEL, CM_PLAIN, 0);
    }
    for (int b = 0; b < N_B; ++b) {
        KP;
        ITEM_LOOP((size_t)QGP * (D_MODEL / 64)) wconv_item(i, P.nsa_w_qg + (size_t)b * D_MODEL * QGW, QGW, P.mix_norm + (size_t)(N_A + b) * D_MODEL, WS_B(w_qg) + (size_t)b * QGP * D_MODEL, QGP, D_MODEL, CM_HEADS, N_HEADS);
        ITEM_LOOP((size_t)D_MODEL * (HDM / 64)) wconv_item(i, P.nsa_w_o + (size_t)b * HDM * D_MODEL, D_MODEL, nullptr, WS_B(w_o) + (size_t)b * D_MODEL * HDM, D_MODEL, HDM, CM_PLAIN, 0);
    }
    { KP; ITEM_LOOP((size_t)KVW * (D_MODEL / 64)) wconv_item(i, P.w_kv, KVW, P.kv_norm, WS_B(w_kv), KVW, D_MODEL, CM_HEADS, 6 * N_KV); }
    { KP; ITEM_LOOP((size_t)NPOS * 8) rope_item(i, WS_F(rope)); }
    { KP; ITEM_LOOP(MT) hinit_item(i, P.x_prompt, P.x_sample, WS_F(h), WS_B(hb), WS_F(rss)); }
    GRID_SYNC();

#ifndef CPU_TEST
#define FFN_OPT(wi, wo, v_in, last) do { \
        { KP; pg8::Gemm g{WS_B(hb), WS_B(wi) + (size_t)layer * 2 * D_FF * D_MODEL, MT, 2 * D_FF, D_MODEL}; pg8::StaticOrder So; So.init(MT, 2 * D_FF, opaque_s((int)gridDim.x), opaque_s((int)blockIdx.x)); \
          pg8::EpiSwiglu E{WS_B(act), WS_F(rss) + (size_t)(v_in) * MT}; pg8::gemm_phase<pg8::EpiSwiglu, pg8::StaticOrder, true, true>(wave_id, RING, g, So, E); } \
        GRID_SYNC(); \
        { KP; pg8::Gemm g{WS_B(act), WS_B(wo) + (size_t)layer * D_MODEL * D_FF, MT, D_MODEL, D_FF}; pg8::StaticOrder So; So.init(MT, D_MODEL, opaque_s((int)gridDim.x), opaque_s((int)blockIdx.x)); \
          pg8::EpiResid E{WS_F(h), WS_B(hb), WS_F(rss) + (size_t)((v_in) + 1) * MT, (last) ? P.out + O_YP : nullptr, 0.5f}; pg8::gemm_phase<pg8::EpiResid, pg8::StaticOrder, true, true>(wave_id, RING, g, So, E); } \
        GRID_SYNC(); } while (0)
#else
#define FFN_OPT(wi, wo, v_in, last) do { KP; \
        ITEM_LOOP((size_t)MT * D_FF) ref_ffn_in_item(i, WS_B(hb), WS_F(rss) + (size_t)(v_in) * MT, WS_B(wi) + (size_t)layer * 2 * D_FF * D_MODEL, WS_B(act)); \
        ITEM_LOOP(MT) ref_resid_row_item(i, WS_B(act), D_FF, WS_B(wo) + (size_t)layer * D_MODEL * D_FF, 0.5f, WS_F(h), WS_B(hb), WS_F(rss) + (size_t)((v_in) + 1) * MT, (last) ? P.out + O_YP : nullptr); } while (0)
#endif
#define PH(total, call) do { { KP; ITEM_LOOP(total) call; } GRID_SYNC(); } while (0)
#ifndef CPU_TEST
#define GEMM_PH(EpiT, Aptr, Btptr, Nn, Kk, ...) do { { KP; pg8::Gemm g{Aptr, Btptr, MT, Nn, Kk}; pg8::StaticOrder So; So.init(MT, Nn, opaque_s((int)gridDim.x), opaque_s((int)blockIdx.x)); \
        pg8::EpiT E{__VA_ARGS__}; pg8::gemm_phase<pg8::EpiT, pg8::StaticOrder, true, true>(wave_id, RING, g, So, E); } GRID_SYNC(); } while (0)
#endif
    for (int layer = 0; layer < DEPTH; ++layer) {
        FFN_OPT(w_ain, w_aout, 3 * layer, false);
        const int v1 = 3 * layer + 1;
        if (layer < N_A) {
#ifndef CPU_TEST
            GEMM_PH(EpiConvIn, WS_B(hb), WS_B(w_cin) + (size_t)layer * 3 * D_MODEL * D_MODEL, 3 * D_MODEL, D_MODEL, WS_B(ub), WS_B(bb), WS_F(rss) + (size_t)v1 * MT, P.out, layer);
#else
            PH((size_t)MT * D_MODEL, ref_conv_in_item(i, WS_B(hb), WS_F(rss) + (size_t)v1 * MT, WS_B(w_cin) + (size_t)layer * 3 * D_MODEL * D_MODEL, WS_B(ub), WS_B(bb), P.out, layer));
#endif
            PH((size_t)MT * D_MODEL, conv_thin_item(i, WS_B(ub), WS_B(bb), P.state_conv + (size_t)layer * DEC_BATCH * 2 * D_MODEL, P.conv_w + (size_t)layer * 3 * D_MODEL, WS_B(zb)));
#ifndef CPU_TEST
            GEMM_PH(EpiResid, WS_B(zb), WS_B(w_cout) + (size_t)layer * D_MODEL * D_MODEL, D_MODEL, D_MODEL, WS_F(h), WS_B(hb), WS_F(rss) + (size_t)(v1 + 1) * MT, nullptr, 1.0f);
#else
            PH(MT, ref_resid_row_item(i, WS_B(zb), D_MODEL, WS_B(w_cout) + (size_t)layer * D_MODEL * D_MODEL, 1.0f, WS_F(h), WS_B(hb), WS_F(rss) + (size_t)(v1 + 1) * MT, nullptr));
#endif
        } else {
            const int b = layer - N_A;
#ifndef CPU_TEST
            GEMM_PH(EpiQG, WS_B(hb), WS_B(w_qg) + (size_t)b * QGP * D_MODEL, QGP, D_MODEL, WS_F(qn), WS_F(qr), WS_F(gates), WS_F(rss) + (size_t)v1 * MT, P.nsa_q_norm + (size_t)b * HD, WS_F(rope));
#else
            { KP; ITEM_LOOP((size_t)MT * N_HEADS) ref_qg_item(i, WS_B(hb), WS_F(rss) + (size_t)v1 * MT, WS_B(w_qg) + (size_t)b * QGP * D_MODEL, P.nsa_q_norm + (size_t)b * HD, WS_F(rope), WS_F(qn), WS_F(qr)); }
            PH((size_t)MT * 3 * N_HEADS, ref_gates_item(i, WS_B(hb), WS_F(rss) + (size_t)v1 * MT, WS_B(w_qg) + (size_t)b * QGP * D_MODEL, WS_F(gates)));
#endif
            PH((size_t)MT * N_HEADS, attn_cmp_item(i, WS_F(qn), WS_F(kc), WS_F(vc), WS_F(pbuf), WS_F(oc)));
            PH((size_t)MT * N_KV, topk_item(i, WS_F(pbuf), (int*)WS_F(sel), WS_F(scorebuf)));
            PH((size_t)MT * N_HEADS, attn_sel_item(i, KVSRC, WS_F(qr), (const int*)WS_F(sel), WS_F(os)));
            PH((size_t)MT * N_HEADS, attn_win_item(i, P.cache_win, WS_F(winrows), WS_F(qr), WS_F(gates), WS_F(oc), WS_F(os), WS_B(ob)));
#ifndef CPU_TEST
            GEMM_PH(EpiResid, WS_B(ob), WS_B(w_o) + (size_t)b * D_MODEL * HDM, D_MODEL, HDM, WS_F(h), WS_B(hb), WS_F(rss) + (size_t)(v1 + 1) * MT, nullptr, 1.0f);
#else
            PH(MT, ref_resid_row_item(i, WS_B(ob), HDM, WS_B(w_o) + (size_t)b * D_MODEL * HDM, 1.0f, WS_F(h), WS_B(hb), WS_F(rss) + (size_t)(v1 + 1) * MT, nullptr));
#endif
        }
        FFN_OPT(w_bin, w_bout, 3 * layer + 2, layer == DEPTH - 1);
        if (layer == N_A - 1) {
            const int v3 = 3 * layer + 3;
#ifndef CPU_TEST
            { KP; pg8::Gemm g{WS_B(hb), WS_B(w_kv), MT, KVW, D_MODEL}; pg8::StaticOrder So; So.init(MT, KVW, opaque_s((int)gridDim.x), opaque_s((int)blockIdx.x));
              pg8::EpiKV E{P.out, WS_F(winrows), WS_F(rss) + (size_t)v3 * MT, P.k_norm, WS_F(rope)}; pg8::gemm_phase<pg8::EpiKV, pg8::StaticOrder, true, true>(wave_id, RING, g, So, E); }
#else
            { KP; ITEM_LOOP((size_t)MT * 6 * N_KV) ref_kv_item(i, WS_B(hb), WS_F(rss) + (size_t)v3 * MT, WS_B(w_kv), P.k_norm, WS_F(rope), P.out, WS_F(winrows)); }
#endif
            PH((size_t)DEC_BATCH * (WINDOW - DEC_SEQ) * 2 * N_KV * HD, wincopy_item(i, P.cache_win, P.out));
            PH((size_t)NSEQ * NBC_MAX * 2 * N_KV * CMP_HID, cmp_hid_item(i, KVSRC, P.cmp_pe, P.cmp_w1, WS_F(hid)));
            PH((size_t)NSEQ * NBC_MAX * 2 * N_KV, cmp_out_item(i, WS_F(hid), P.cmp_w2, P.k_norm, WS_F(kc), WS_F(vc)));
        }
    }
}

extern "C" void kernel_launch(void* const* d_in, const int* in_sizes, int n_in, void* d_out, int out_size, void* d_ws, size_t ws_size, hipStream_t stream) {
    Params P{};
    P.x_prompt = (const float*)d_in[0]; P.x_sample = (const float*)d_in[1]; P.cache_kv = (const float*)d_in[2]; P.cache_win = (const float*)d_in[3];
    P.state_conv = (const float*)d_in[4]; P.page_table = (const int*)d_in[5]; P.ffn_a_norm = (const float*)d_in[6]; P.ffn_a_w_in = (const float*)d_in[7];
    P.ffn_a_w_out = (const float*)d_in[8]; P.mix_norm = (const float*)d_in[9]; P.ffn_b_norm = (const float*)d_in[10]; P.ffn_b_w_in = (const float*)d_in[11];
    P.ffn_b_w_out = (const float*)d_in[12]; P.conv_w_in = (const float*)d_in[13]; P.conv_w = (const float*)d_in[14]; P.conv_w_out = (const float*)d_in[15];
    P.kv_norm = (const float*)d_in[16]; P.w_kv = (const float*)d_in[17]; P.k_norm = (const float*)d_in[18]; P.cmp_pe = (const float*)d_in[19];
    P.cmp_w1 = (const float*)d_in[20]; P.cmp_w2 = (const float*)d_in[21]; P.nsa_w_qg = (const float*)d_in[22]; P.nsa_q_norm = (const float*)d_in[23];
    P.nsa_w_o = (const float*)d_in[24];
    P.out = (float*)d_out; P.ws = (unsigned char*)d_ws;
#ifndef CPU_TEST
    static int grid = 0;
    if (grid == 0) {
        int dev = 0, cus = 0, per_cu = 0;
        hipGetDevice(&dev); hipDeviceGetAttribute(&cus, hipDeviceAttributeMultiprocessorCount, dev);
        hipFuncSetAttribute((const void*)mega, hipFuncAttributeMaxDynamicSharedMemorySize, LDS_BYTES);
        hipOccupancyMaxActiveBlocksPerMultiprocessor(&per_cu, (const void*)mega, NTHREADS, LDS_BYTES);
        (void)hipGetLastError();
        grid = cus;
    }
    hipMemsetAsync(d_ws, 0, WS_ZERO_BYTES, stream);
    hipLaunchKernelGGL(mega, dim3(grid), dim3(NTHREADS), LDS_BYTES, stream, P);
#else
    memset(d_ws, 0, WS_ZERO_BYTES);
    mega(P);
#endif
}
```

```cpp
#ifdef CPU_TEST
#include "shim.h"
#else
#include <hip/hip_runtime.h>
#endif
#include <cstdint>
#include <cstddef>
#include <cmath>
#include <cstring>
typedef unsigned short bf16_t;
#ifndef CPU_TEST
#define HOSTDEV __host__ __device__
#else
#define HOSTDEV
#endif
HOSTDEV inline bf16_t f2bf(float f) { unsigned u; memcpy(&u, &f, 4); u = (u + 0x7fffu + ((u >> 16) & 1u)) >> 16; return (bf16_t)u; }
HOSTDEV inline float bf2f(bf16_t b) { unsigned u = (unsigned)b << 16; float f; memcpy(&f, &u, 4); return f; }

#ifdef CFG_SMALL
constexpr int D_MODEL = 256, BATCH = 1, SEQ = 2048, DEPTH = 4, DEC_BATCH = 2, DEC_SEQ = 8, PAST_LEN = 2048, PAGE_SIZE = 128, D_FF = 256, N_HEADS = 4, N_KV = 2;
#else
constexpr int D_MODEL = 1024, BATCH = 4, SEQ = 4096, DEPTH = 4, DEC_BATCH = 32, DEC_SEQ = 8, PAST_LEN = 8192, PAGE_SIZE = 128, D_FF = 2816, N_HEADS = 16, N_KV = 4;
#endif
constexpr int N_A = DEPTH / 2, N_B = DEPTH - N_A, HD = 64, HPG = N_HEADS / N_KV, L_CMP = 32, L_SEL = 64, N_SEL = 16, WINDOW = 512, CMP_HID = 4 * HD;
constexpr int MP = BATCH * SEQ, MS = DEC_BATCH * DEC_SEQ, MT = MP + MS, NSEQ = BATCH + DEC_BATCH;
constexpr int N_PAGES = PAST_LEN / PAGE_SIZE;
constexpr int KVW = 6 * N_KV * HD;
constexpr int QGW = N_HEADS * HD + 3 * N_HEADS;
constexpr int HDM = N_HEADS * HD;
constexpr int TPAD_S = ((PAST_LEN + DEC_SEQ + L_SEL - 1) / L_SEL) * L_SEL;
constexpr int NBC_P = SEQ / L_CMP, NBC_S = TPAD_S / L_CMP, NBC_MAX = NBC_S > NBC_P ? NBC_S : NBC_P;
constexpr int NBS_P = SEQ / L_SEL, NBS_S = TPAD_S / L_SEL, NBS_MAX = NBS_S > NBS_P ? NBS_S : NBS_P;
constexpr float EPS = 1e-6f, NEGF = -1e30f, TINYF = 1e-30f, FORCE_SCORE = 1e4f;
__device__ static const float INV_FREQ[8] = {1.0f, 0.1939227432012558f, 0.03760603070259094f, 0.007292664609849453f, 0.0014142135623842478f, 0.00027424818836152554f, 5.3182957344688475e-05f, 1.0313385246263351e-05f};

constexpr size_t O_YP = 0, O_YS = O_YP + (size_t)MP * D_MODEL, O_KVP = O_YS + (size_t)MS * D_MODEL, O_KVS = O_KVP + (size_t)MP * 4 * N_KV * HD,
                 O_WP = O_KVS + (size_t)MS * 4 * N_KV * HD, O_WS = O_WP + (size_t)BATCH * WINDOW * 2 * N_KV * HD, O_CP = O_WS + (size_t)DEC_BATCH * WINDOW * 2 * N_KV * HD,
                 O_CS = O_CP + (size_t)N_A * BATCH * 2 * D_MODEL, O_END = O_CS + (size_t)N_A * DEC_BATCH * 2 * D_MODEL;

struct RowInfo { int seq, t, pos; };
__device__ __host__ inline RowInfo row_info(int m) {
    RowInfo r;
    if (m < MP) { r.seq = m / SEQ; r.t = m % SEQ; r.pos = r.t; }
    else { const int q = m - MP; r.seq = BATCH + q / DEC_SEQ; r.t = q % DEC_SEQ; r.pos = PAST_LEN + r.t; }
    return r;
}
__device__ __host__ inline int seq_row0(int seq) { return seq < BATCH ? seq * SEQ : MP + (seq - BATCH) * DEC_SEQ; }
__device__ __host__ inline int seq_pos0(int seq) { return seq < BATCH ? 0 : PAST_LEN; }
__device__ __host__ inline int seq_len(int seq) { return seq < BATCH ? SEQ : DEC_SEQ; }

__device__ inline void copy_item(size_t i_, const float* a, float* b, size_t n) {
    const size_t i = i_;
    if (i < n) b[i] = a[i];
}
__device__ inline void rmsnorm_item(size_t i_, const float* x, const float* g, float* y, int rows, int d) {
    const int m = (int)i_;
    if (m >= rows) return;
    const float* xr = x + (size_t)m * d; float s = 0.f;
    for (int i = 0; i < d; ++i) s += xr[i] * xr[i];
    const float r = 1.0f / sqrtf(s / d + EPS);
    float* yr = y + (size_t)m * d;
    for (int i = 0; i < d; ++i) yr[i] = xr[i] * r * g[i];
}
__device__ inline void gemm_item(size_t i_, const float* A, int lda, const float* W, float* C, int M, int N, int K) {
    const int nbx = (N + 63) / 64; const int vb = (int)(i_ / 256), t_ = (int)(i_ % 256), tx = t_ % 16, ty = t_ / 16;
    const int c0 = (vb % nbx) * 64 + tx * 4, r0 = (vb / nbx) * 64 + ty * 4;
    if (c0 >= N || r0 >= M) return;
    float acc[4][4];
    for (int i = 0; i < 4; ++i) for (int j = 0; j < 4; ++j) acc[i][j] = 0.f;
    const int nr = (M - r0) < 4 ? (M - r0) : 4;
    for (int k = 0; k < K; k += 4) {
        float a[4][4], w[4][4];
        for (int i = 0; i < 4; ++i) for (int kk = 0; kk < 4; ++kk) a[i][kk] = (i < nr) ? A[(size_t)(r0 + i) * lda + k + kk] : 0.f;
        for (int kk = 0; kk < 4; ++kk) for (int j = 0; j < 4; ++j) w[kk][j] = W[(size_t)(k + kk) * N + c0 + j];
        for (int i = 0; i < 4; ++i) for (int kk = 0; kk < 4; ++kk) for (int j = 0; j < 4; ++j) acc[i][j] += a[i][kk] * w[kk][j];
    }
    for (int i = 0; i < nr; ++i) for (int j = 0; j < 4; ++j) C[(size_t)(r0 + i) * N + c0 + j] = acc[i][j];
}
__device__ inline void swiglu_item(size_t i_, const float* t1, float* act, int rows, int dff) {
    const size_t i = i_;
    if (i >= (size_t)rows * dff) return;
    const int m = (int)(i / dff), j = (int)(i % dff);
    const float g = t1[(size_t)m * 2 * dff + j], u = t1[(size_t)m * 2 * dff + dff + j];
    act[i] = g / (1.0f + expf(-g)) * u;
}
__device__ inline void axpy_item(size_t i_, float* h, const float* y, float coef, size_t n) {
    const size_t i = i_;
    if (i < n) h[i] += coef * y[i];
}
__device__ inline void conv_item(size_t i_, const float* t1, const float* state  , const float* wc  , float* z, float* out, int layer) {
    const size_t i = i_;
    if (i >= (size_t)MT * D_MODEL) return;
    const int m = (int)(i / D_MODEL), ch = (int)(i % D_MODEL);
    const RowInfo ri = row_info(m);
    const float* r = t1 + (size_t)m * 3 * D_MODEL;
    const float b = r[ch], u0 = r[D_MODEL + ch] * r[2 * D_MODEL + ch];
    float u1, u2;
    if (ri.t >= 1) { const float* p = r - 3 * D_MODEL; u1 = p[D_MODEL + ch] * p[2 * D_MODEL + ch]; }
    else u1 = (ri.seq < BATCH) ? 0.f : state[((size_t)(ri.seq - BATCH) * 2 + 1) * D_MODEL + ch];
    if (ri.t >= 2) { const float* p = r - 6 * D_MODEL; u2 = p[D_MODEL + ch] * p[2 * D_MODEL + ch]; }
    else if (ri.seq < BATCH) u2 = 0.f;
    else u2 = (ri.t == 1) ? state[((size_t)(ri.seq - BATCH) * 2 + 1) * D_MODEL + ch] : state[((size_t)(ri.seq - BATCH) * 2 + 0) * D_MODEL + ch];
    z[i] = b * (wc[ch] * u2 + wc[D_MODEL + ch] * u1 + wc[2 * D_MODEL + ch] * u0);
    const int L = seq_len(ri.seq);
    if (ri.t >= L - 2) {
        const int j = ri.t - (L - 2);
        if (ri.seq < BATCH) out[O_CP + (((size_t)layer * BATCH + ri.seq) * 2 + j) * D_MODEL + ch] = u0;
        else out[O_CS + (((size_t)layer * DEC_BATCH + (ri.seq - BATCH)) * 2 + j) * D_MODEL + ch] = u0;
    }
}
__device__ inline void head_norm(float* v, const float* g) {
    float s = 0.f; for (int d = 0; d < HD; ++d) s += v[d] * v[d];
    const float r = 1.0f / sqrtf(s / HD + EPS);
    for (int d = 0; d < HD; ++d) v[d] = v[d] * r * g[d];
}
__device__ inline void rope_cs(float ang, float& c, float& s) {
    const double r = (double)ang * 0.15915494309189535; const float fr = (float)(r - rint(r));
#ifdef CPU_TEST
    c = (float)cos(6.283185307179586 * (double)fr); s = (float)sin(6.283185307179586 * (double)fr);
#else
    c = __builtin_amdgcn_cosf(fr); s = __builtin_amdgcn_sinf(fr);
#endif
}
__device__ inline void head_rope(float* v, int pos) {
    for (int i = 0; i < 8; ++i) {
        const float ang = (float)pos * INV_FREQ[i]; float c, s; rope_cs(ang, c, s);
        const float x1 = v[i], x2 = v[8 + i];
        v[i] = x1 * c - x2 * s; v[8 + i] = x2 * c + x1 * s;
    }
}
__device__ inline void kvprep_item(size_t i_, const float* p, const float* k_norm  , float* out, float* winrows) {
    const int i = (int)i_;
    if (i >= MT * 6 * N_KV) return;
    const int m = i / (6 * N_KV), e = (i / N_KV) % 6, g = i % N_KV;
    const RowInfo ri = row_info(m);
    float v[HD];
    for (int d = 0; d < HD; ++d) v[d] = p[(size_t)m * KVW + (e * N_KV + g) * HD + d];
    if (e == 2) { head_norm(v, k_norm + HD); head_rope(v, ri.pos); }
    if (e == 4) { head_norm(v, k_norm + 2 * HD); head_rope(v, ri.pos); }
    if (e < 4) {
        float* o = (ri.seq < BATCH) ? out + O_KVP + (((size_t)m * 4 + e) * N_KV + g) * HD : out + O_KVS + (((size_t)(m - MP) * 4 + e) * N_KV + g) * HD;
        for (int d = 0; d < HD; ++d) o[d] = v[d];
    } else {
        const int we = e - 4;
        float* w = winrows + (((size_t)m * 2 + we) * N_KV + g) * HD;
        for (int d = 0; d < HD; ++d) w[d] = v[d];
        if (ri.seq < BATCH) { if (ri.t >= SEQ - WINDOW) { float* o = out + O_WP + ((((size_t)ri.seq * WINDOW + (ri.t - (SEQ - WINDOW))) * 2 + we) * N_KV + g) * HD; for (int d = 0; d < HD; ++d) o[d] = v[d]; } }
        else { float* o = out + O_WS + ((((size_t)(ri.seq - BATCH) * WINDOW + (WINDOW - DEC_SEQ + ri.t)) * 2 + we) * N_KV + g) * HD; for (int d = 0; d < HD; ++d) o[d] = v[d]; }
    }
}
__device__ inline void wincopy_item(size_t i_, const float* cache_win, float* out) {
    const size_t i = i_;
    const size_t per = (size_t)(WINDOW - DEC_SEQ) * 2 * N_KV * HD;
    if (i >= (size_t)DEC_BATCH * per) return;
    const size_t b = i / per, r = i % per;
    out[O_WS + b * WINDOW * 2 * N_KV * HD + r] = cache_win[b * WINDOW * 2 * N_KV * HD + (size_t)DEC_SEQ * 2 * N_KV * HD + r];
}
struct KvSrc { const float* cache_kv; const int* page_table; const float* out; };
__device__ inline const float* kv_full_ptr(const KvSrc& S, int seq, int tok, int e, int g) {
    if (seq < BATCH) return S.out + O_KVP + ((((size_t)seq * SEQ + tok) * 4 + e) * N_KV + g) * HD;
    const int b = seq - BATCH;
    if (tok < PAST_LEN) { const int page = S.page_table[b * N_PAGES + tok / PAGE_SIZE]; return S.cache_kv + ((((size_t)page * PAGE_SIZE + tok % PAGE_SIZE) * 4 + e) * N_KV + g) * HD; }
    if (tok < PAST_LEN + DEC_SEQ) return S.out + O_KVS + ((((size_t)b * DEC_SEQ + (tok - PAST_LEN)) * 4 + e) * N_KV + g) * HD;
    return nullptr;
}
__device__ inline int seq_nbc(int seq) { return seq < BATCH ? NBC_P : NBC_S; }
__device__ inline void cmp_hid_item(size_t i_, KvSrc S, const float* pe  , const float* w1  , float* hid) {
    const size_t i = i_;
    if (i >= (size_t)NSEQ * NBC_MAX * 2 * N_KV * CMP_HID) return;
    const int f = (int)(i % CMP_HID), g = (int)((i / CMP_HID) % N_KV), e = (int)((i / ((size_t)CMP_HID * N_KV)) % 2), c = (int)((i / ((size_t)CMP_HID * N_KV * 2)) % NBC_MAX), seq = (int)(i / ((size_t)CMP_HID * N_KV * 2 * NBC_MAX));
    if (c >= seq_nbc(seq)) return;
    float s = 0.f;
    for (int l = 0; l < L_CMP; ++l) {
        const float* r = kv_full_ptr(S, seq, c * L_CMP + l, e, g);
        const float* w = w1 + (((size_t)e * L_CMP + l) * HD) * CMP_HID + f; const float* pp = pe + ((size_t)e * L_CMP + l) * HD;
        for (int d = 0; d < HD; ++d) s += ((r ? r[d] : 0.f) + pp[d]) * w[(size_t)d * CMP_HID];
    }
    const float x = s; const float t = tanhf(0.7978845608028654f * (x + 0.044715f * x * x * x));
    hid[i] = 0.5f * x * (1.0f + t);
}
__device__ inline void cmp_out_item(size_t i_, const float* hid, const float* w2  , const float* k_norm0, float* kc, float* vc) {
    const int i = (int)i_;
    if (i >= NSEQ * NBC_MAX * 2 * N_KV) return;
    const int g = i % N_KV, e = (i / N_KV) % 2, c = (i / (2 * N_KV)) % NBC_MAX, seq = i / (2 * N_KV * NBC_MAX);
    if (c >= seq_nbc(seq)) return;
    const float* hr = hid + (size_t)i * CMP_HID;
    float v[HD];
    for (int d = 0; d < HD; ++d) { float s = 0.f; for (int f = 0; f < CMP_HID; ++f) s += hr[f] * w2[((size_t)e * CMP_HID + f) * HD + d]; v[d] = s; }
    if (e == 0) head_norm(v, k_norm0);
    float* o = (e == 0 ? kc : vc) + (((size_t)seq * NBC_MAX + c) * N_KV + g) * HD;
    for (int d = 0; d < HD; ++d) o[d] = v[d];
}
__device__ inline void qprep_item(size_t i_, const float* qg, const float* q_norm, float* qn, float* qr, float* gates) {
    const int i = (int)i_;
    if (i >= MT * N_HEADS) return;
    const int m = i / N_HEADS, hh = i % N_HEADS;
    const RowInfo ri = row_info(m);
    float v[HD];
    for (int d = 0; d < HD; ++d) v[d] = qg[(size_t)m * QGW + hh * HD + d];
    head_norm(v, q_norm);
    for (int d = 0; d < HD; ++d) qn[(size_t)m * HDM + hh * HD + d] = v[d];
    head_rope(v, ri.pos);
    for (int d = 0; d < HD; ++d) qr[(size_t)m * HDM + hh * HD + d] = v[d];
    for (int j = 0; j < 3; ++j) { const float x = qg[(size_t)m * QGW + HDM + hh * 3 + j]; gates[(size_t)m * 3 * N_HEADS + hh * 3 + j] = 1.0f / (1.0f + expf(-x)); }
}
__device__ inline void attn_cmp_item(size_t i_, const float* qn, const float* kc, const float* vc, float* pbuf, float* oc) {
    const int i = (int)i_;
    if (i >= MT * N_HEADS) return;
    const int m = i / N_HEADS, hh = i % N_HEADS, g = hh / HPG;
    const RowInfo ri = row_info(m);
    const int nbc = seq_nbc(ri.seq);
    const float* q = qn + (size_t)m * HDM + hh * HD;
    float* p = pbuf + (size_t)i * NBC_MAX;
    float mx = NEGF;
    for (int c = 0; c < nbc; ++c) {
        const bool vis = (c + 1) * L_CMP - 1 <= ri.pos;
        float s = 0.f; const float* k = kc + (((size_t)ri.seq * NBC_MAX + c) * N_KV + g) * HD;
        for (int d = 0; d < HD; ++d) s += q[d] * k[d];
        s *= 0.125f; p[c] = s; if (vis && s > mx) mx = s;
    }
    float sum = 0.f;
    for (int c = 0; c < nbc; ++c) { const bool vis = (c + 1) * L_CMP - 1 <= ri.pos; const float e = vis ? expf(p[c] - mx) : 0.f; p[c] = e; sum += e; }
    const float inv = 1.0f / fmaxf(sum, TINYF);
    float o[HD]; for (int d = 0; d < HD; ++d) o[d] = 0.f;
    for (int c = 0; c < nbc; ++c) { p[c] *= inv; if (p[c] != 0.f) { const float* v = vc + (((size_t)ri.seq * NBC_MAX + c) * N_KV + g) * HD; for (int d = 0; d < HD; ++d) o[d] += p[c] * v[d]; } }
    for (int d = 0; d < HD; ++d) oc[(size_t)m * HDM + hh * HD + d] = o[d];
}
__device__ inline void topk_item(size_t i_, const float* pbuf, int* sel, float* scorebuf  ) {
    const int i = (int)i_;
    if (i >= MT * N_KV) return;
    const int m = i / N_KV, g = i % N_KV;
    const RowInfo ri = row_info(m);
    const int nbs = ri.seq < BATCH ? NBS_P : NBS_S, cur = ri.pos / L_SEL;
    float* score = scorebuf + (size_t)i * NBS_MAX;
    for (int b = 0; b < nbs; ++b) {
        float imp = 0.f;
        for (int h = 0; h < HPG; ++h) { const float* p = pbuf + ((size_t)m * N_HEADS + g * HPG + h) * NBC_MAX; imp += p[2 * b]; }
        float imp2 = 0.f;
        for (int h = 0; h < HPG; ++h) { const float* p = pbuf + ((size_t)m * N_HEADS + g * HPG + h) * NBC_MAX; imp2 += p[2 * b + 1]; }
        const bool forced = (b == 0) || (b == cur) || (b == cur - 1), valid = b * L_SEL <= ri.pos;
        score[b] = valid ? (forced ? FORCE_SCORE : imp + imp2) : NEGF;
    }
    const int nsel = N_SEL < nbs ? N_SEL : nbs;
    for (int j = 0; j < N_SEL; ++j) {
        if (j >= nsel) { sel[(size_t)i * N_SEL + j] = -1; continue; }
        int best = -1; float bv = 0.f;
        for (int b = 0; b < nbs; ++b) if (score[b] > -3e38f && (best < 0 || score[b] > bv)) { best = b; bv = score[b]; }
        sel[(size_t)i * N_SEL + j] = best; score[best] = -3.4e38f;
    }
}
__device__ inline void attn_sel_item(size_t i_, KvSrc S, const float* qr, const int* sel, float* os) {
    const int i = (int)i_;
    if (i >= MT * N_HEADS) return;
    const int m = i / N_HEADS, hh = i % N_HEADS, g = hh / HPG;
    const RowInfo ri = row_info(m);
    const float* q = qr + (size_t)m * HDM + hh * HD;
    const int* sl = sel + ((size_t)m * N_KV + g) * N_SEL;
    float mx = NEGF;
    for (int j = 0; j < N_SEL; ++j) { const int b = sl[j]; if (b < 0) continue;
        for (int t = 0; t < L_SEL; ++t) { const int tok = b * L_SEL + t; if (tok > ri.pos) continue;
            const float* k = kv_full_ptr(S, ri.seq, tok, 2, g); float s = 0.f; if (k) for (int d = 0; d < HD; ++d) s += q[d] * k[d];
            s *= 0.125f; if (s > mx) mx = s; } }
    float sum = 0.f, o[HD]; for (int d = 0; d < HD; ++d) o[d] = 0.f;
    for (int j = 0; j < N_SEL; ++j) { const int b = sl[j]; if (b < 0) continue;
        for (int t = 0; t < L_SEL; ++t) { const int tok = b * L_SEL + t; if (tok > ri.pos) continue;
            const float* k = kv_full_ptr(S, ri.seq, tok, 2, g); float s = 0.f; if (k) for (int d = 0; d < HD; ++d) s += q[d] * k[d];
            const float e = expf(s * 0.125f - mx); sum += e;
            const float* v = kv_full_ptr(S, ri.seq, tok, 3, g); if (v) for (int d = 0; d < HD; ++d) o[d] += e * v[d]; } }
    const float inv = 1.0f / fmaxf(sum, TINYF);
    for (int d = 0; d < HD; ++d) os[(size_t)m * HDM + hh * HD + d] = o[d] * inv;
}
__device__ inline const float* win_ptr(const float* cache_win, const float* winrows, int seq, int kp) {
    if (seq < BATCH) return kp >= 0 ? winrows + (size_t)(seq * SEQ + kp) * 2 * N_KV * HD : nullptr;
    const int b = seq - BATCH;
    if (kp >= PAST_LEN) return winrows + (size_t)(MP + b * DEC_SEQ + (kp - PAST_LEN)) * 2 * N_KV * HD;
    const int j = kp - (PAST_LEN - WINDOW);
    return j >= 0 ? cache_win + ((size_t)b * WINDOW + j) * 2 * N_KV * HD : nullptr;
}
__device__ inline void attn_win_item(size_t i_, const float* cache_win, const float* winrows, const float* qr, const float* gates, const float* oc, const float* os, bf16_t* o_out) {
    const int i = (int)i_;
    if (i >= MT * N_HEADS) return;
    const int m = i / N_HEADS, hh = i % N_HEADS, g = hh / HPG;
    const RowInfo ri = row_info(m);
    const float* q = qr + (size_t)m * HDM + hh * HD;
    float mx = NEGF;
    for (int kp = ri.pos - WINDOW; kp <= ri.pos; ++kp) { const float* r = win_ptr(cache_win, winrows, ri.seq, kp); if (!r) continue;
        const float* k = r + (0 * N_KV + g) * HD; float s = 0.f; for (int d = 0; d < HD; ++d) s += q[d] * k[d]; s *= 0.125f; if (s > mx) mx = s; }
    float sum = 0.f, o[HD]; for (int d = 0; d < HD; ++d) o[d] = 0.f;
    for (int kp = ri.pos - WINDOW; kp <= ri.pos; ++kp) { const float* r = win_ptr(cache_win, winrows, ri.seq, kp); if (!r) continue;
        const float* k = r + (0 * N_KV + g) * HD; float s = 0.f; for (int d = 0; d < HD; ++d) s += q[d] * k[d];
        const float e = expf(s * 0.125f - mx); sum += e; const float* v = r + (1 * N_KV + g) * HD; for (int d = 0; d < HD; ++d) o[d] += e * v[d]; }
    const float inv = 1.0f / fmaxf(sum, TINYF);
    const float* gt = gates + (size_t)m * 3 * N_HEADS + hh * 3;
    for (int d = 0; d < HD; ++d) { const size_t x = (size_t)m * HDM + hh * HD + d; o_out[x] = f2bf(gt[0] * oc[x] + gt[1] * os[x] + gt[2] * o[d] * inv); }
}


#ifndef CPU_TEST
__device__ __forceinline__ unsigned lane_id_v() { unsigned l; asm volatile("v_mbcnt_lo_u32_b32 %0, -1, 0\n\tv_mbcnt_hi_u32_b32 %0, -1, %0" : "=v"(l)); return l; }
#endif
constexpr int NTHREADS = 512;
__host__ __device__ inline bf16_t f2bf_(float f) { unsigned u; memcpy(&u, &f, 4); u = (u + 0x7fffu + ((u >> 16) & 1u)) >> 16; return (bf16_t)u; }
__host__ __device__ inline float bf2f_(bf16_t b) { unsigned u = (unsigned)b << 16; float f; memcpy(&f, &u, 4); return f; }
constexpr int NRSS = 3 * DEPTH + 1;
constexpr int NPOS = SEQ + DEC_SEQ;
constexpr int QGP = ((QGW + 255) / 256) * 256;
__host__ __device__ inline int pos_index(int pos) { return pos < SEQ ? pos : SEQ + (pos - PAST_LEN); }

constexpr size_t IMG_SEQ_BYTES = (size_t)BATCH * N_KV * (SEQ / 64) * 8192, IMG_CMP_BYTES = (size_t)BATCH * N_KV * (NBC_P / 64 > 0 ? NBC_P / 64 : 1) * 8192;
struct WsMap {
    size_t ctl, rss, rope, h, hb, act, xn, t2, actf, ub, bb, zb, t1, qn, qr, gates, ob, winrows, hid, kc, vc, pbuf, oc, os, sel, scorebuf,
           w_ain, w_aout, w_bin, w_bout, w_cin, w_cout, w_qg, w_o, w_kv, qnb, qrb, ksel, vsel, kwin, vwin, kci, vci, acs, hids, acp, hidp, w1t, end;
};
constexpr size_t al256(size_t b) { return (b + 255) / 256 * 256; }
constexpr size_t smax(size_t a, size_t b) { return a > b ? a : b; }
constexpr WsMap make_ws_map() {
    WsMap w{}; size_t off = 0;
#define TAKE(f, bytes) w.f = off; off += al256(bytes)
    TAKE(ctl, 65536); TAKE(rss, (size_t)NRSS * MT * 4);
    TAKE(rope, (size_t)NPOS * 16 * 4);
    TAKE(h, (size_t)MT * D_MODEL * 4); TAKE(hb, (size_t)MT * D_MODEL * 2); TAKE(act, (size_t)MT * D_FF * 2);
    TAKE(xn, (size_t)MT * D_MODEL * 4); TAKE(t2, (size_t)MT * D_MODEL * 4); TAKE(actf, (size_t)MT * D_MODEL * 4);
    TAKE(ub, (size_t)MT * D_MODEL * 2); TAKE(bb, (size_t)MT * D_MODEL * 2); TAKE(zb, (size_t)MT * D_MODEL * 2);
    TAKE(t1, smax((size_t)MT * 3 * D_MODEL * 4, (size_t)MT * KVW * 4));
    TAKE(qn, (size_t)MT * HDM * 4); TAKE(qr, (size_t)MT * HDM * 4); TAKE(gates, (size_t)MT * 3 * N_HEADS * 4); TAKE(ob, (size_t)MT * HDM * 2);
    TAKE(winrows, (size_t)MT * 2 * N_KV * HD * 4); TAKE(hid, (size_t)NSEQ * NBC_MAX * 2 * N_KV * CMP_HID * 4);
    TAKE(kc, (size_t)NSEQ * NBC_MAX * N_KV * HD * 4); TAKE(vc, (size_t)NSEQ * NBC_MAX * N_KV * HD * 4);
    TAKE(pbuf, (size_t)MT * N_HEADS * NBC_MAX * 4); TAKE(oc, (size_t)MT * HDM * 4); TAKE(os, (size_t)MT * HDM * 4);
    TAKE(sel, (size_t)MT * N_KV * N_SEL * 4); TAKE(scorebuf, (size_t)MT * N_KV * NBS_MAX * 4);
    TAKE(w_ain, (size_t)DEPTH * 2 * D_FF * D_MODEL * 2); TAKE(w_aout, (size_t)DEPTH * D_MODEL * D_FF * 2);
    TAKE(w_bin, (size_t)DEPTH * 2 * D_FF * D_MODEL * 2); TAKE(w_bout, (size_t)DEPTH * D_MODEL * D_FF * 2);
    TAKE(w_cin, (size_t)N_A * 3 * D_MODEL * D_MODEL * 2); TAKE(w_cout, (size_t)N_A * D_MODEL * D_MODEL * 2);
    TAKE(w_qg, (size_t)N_B * QGP * D_MODEL * 2); TAKE(w_o, (size_t)N_B * D_MODEL * HDM * 2); TAKE(w_kv, (size_t)KVW * D_MODEL * 2);
    TAKE(qnb, (size_t)MT * HDM * 2); TAKE(qrb, (size_t)MT * HDM * 2); TAKE(ksel, IMG_SEQ_BYTES); TAKE(vsel, IMG_SEQ_BYTES); TAKE(kwin, IMG_SEQ_BYTES); TAKE(vwin, IMG_SEQ_BYTES); TAKE(kci, IMG_CMP_BYTES); TAKE(vci, IMG_CMP_BYTES);
    TAKE(acs, (size_t)2 * DEC_BATCH * (PAST_LEN / L_CMP) * N_KV * L_CMP * HD * 2); TAKE(hids, (size_t)2 * DEC_BATCH * (PAST_LEN / L_CMP) * N_KV * CMP_HID * 2);
    TAKE(acp, (size_t)2 * BATCH * NBC_P * N_KV * L_CMP * HD * 2); TAKE(hidp, (size_t)2 * BATCH * NBC_P * N_KV * CMP_HID * 2); TAKE(w1t, (size_t)2 * CMP_HID * L_CMP * HD * 2);
#undef TAKE
    w.end = off; return w;
}
constexpr WsMap WSM = make_ws_map();
constexpr size_t WS_ZERO_BYTES = 65536 + (((size_t)NRSS * MT * 4 + 255) / 256 * 256);

enum { CM_PLAIN = 0, CM_PAIR = 1, CM_CONV = 2, CM_HEADS = 3 };
__host__ __device__ inline int colmap(int kind, int n, int aux) {
    const int pn = n / 256, c = n % 256;
    if (kind == CM_PLAIN) return n;
    if (kind == CM_PAIR) return (c >= 128 ? aux : 0) + pn * 128 + (c % 128);
    if (kind == CM_CONV) { if (n < 2 * D_MODEL) return (c >= 128 ? 2 * D_MODEL : D_MODEL) + pn * 128 + (c % 128); return n - 2 * D_MODEL; }
    if (n < aux * 64) { const int bj = c / 128, wc = (c % 128) / 32, r = c % 32; return (pn * 4 + wc) * 64 + 32 * bj + r; }
    return n;
}
__device__ inline void wconv_item(size_t i_, const float* src, int Nsrc, const float* gain, bf16_t* dst, int Nd, int K, int kind, int aux) {
    const int n = (int)(i_ % Nd), kb = (int)(i_ / Nd);
    const int col = colmap(kind, n, aux);
    bf16_t* d = dst + (size_t)n * K + (size_t)kb * 64;
    if (col < 0 || col >= Nsrc) { for (int k = 0; k < 64; ++k) d[k] = 0; return; }
    const float* s = src + (size_t)kb * 64 * Nsrc + col;
#pragma unroll 8
    for (int k = 0; k < 64; k += 2) {
        const float g0 = gain ? gain[kb * 64 + k] : 1.f, g1 = gain ? gain[kb * 64 + k + 1] : 1.f;
        const unsigned lo = f2bf(s[(size_t)k * Nsrc] * g0), hi = f2bf(s[(size_t)(k + 1) * Nsrc] * g1);
        *(unsigned*)(d + k) = lo | (hi << 16);
    }
}
__device__ inline void rope_item(size_t i_, float* rope) {
    const int pi = (int)(i_ / 8), f = (int)(i_ % 8);
    const int pos = pi < SEQ ? pi : PAST_LEN + (pi - SEQ);
    float c, s; rope_cs((float)pos * INV_FREQ[f], c, s);
    rope[pi * 16 + f] = c; rope[pi * 16 + 8 + f] = s;
}
__device__ inline void hinit_item(size_t i_, const float* xp, const float* xs, float* h, bf16_t* hb, float* rss0) {
    const int m = (int)i_; const float* x = m < MP ? xp + (size_t)m * D_MODEL : xs + (size_t)(m - MP) * D_MODEL;
    float s = 0.f;
    for (int k = 0; k < D_MODEL; ++k) { const float v = x[k]; s += v * v; h[(size_t)m * D_MODEL + k] = v; hb[(size_t)m * D_MODEL + k] = f2bf(v); }
    rss0[m] = s;
}
__device__ inline void hupd_item(size_t i_, float* h, const float* y, float coef, bf16_t* hb, float* rss) {
    const int m = (int)i_; float s = 0.f;
    for (int k = 0; k < D_MODEL; ++k) { const float v = h[(size_t)m * D_MODEL + k] + coef * y[(size_t)m * D_MODEL + k]; s += v * v; h[(size_t)m * D_MODEL + k] = v; hb[(size_t)m * D_MODEL + k] = f2bf(v); }
    rss[m] = s;
}
__device__ inline float dot_bf(const bf16_t* a, const bf16_t* b, int K) { float s = 0.f; for (int k = 0; k < K; ++k) s += bf2f(a[k]) * bf2f(b[k]); return s; }
__device__ inline float silu_f(float g) { return g / (1.0f + expf(-g)); }
__device__ inline void ref_ffn_in_item(size_t i_, const bf16_t* hb, const float* rss, const bf16_t* Bt, bf16_t* act) {
    const int m = (int)(i_ / D_FF), j = (int)(i_ % D_FF);
    const float rs = 1.0f / sqrtf(rss[m] / D_MODEL + EPS);
    const int ng = (j / 128) * 256 + (j % 128);
    const float g = rs * dot_bf(hb + (size_t)m * D_MODEL, Bt + (size_t)ng * D_MODEL, D_MODEL), u = rs * dot_bf(hb + (size_t)m * D_MODEL, Bt + (size_t)(ng + 128) * D_MODEL, D_MODEL);
    act[i_] = f2bf(silu_f(g) * u);
}
__device__ inline void ref_resid_row_item(size_t i_, const bf16_t* A, int K, const bf16_t* Bt, float coef, float* h, bf16_t* hb, float* rss_next, float* yout) {
    const int m = (int)i_; float s = 0.f;
    for (int c = 0; c < D_MODEL; ++c) {
        const float v = h[(size_t)m * D_MODEL + c] + coef * dot_bf(A + (size_t)m * K, Bt + (size_t)c * K, K);
        if (yout) { yout[(size_t)m * D_MODEL + c] = v; } else { h[(size_t)m * D_MODEL + c] = v; hb[(size_t)m * D_MODEL + c] = f2bf(v); s += v * v; }
    }
    if (!yout) rss_next[m] = s;
}

constexpr float QSCALE_F = 0.125f * 1.4426950408889634f;
__device__ inline void qconv_item(size_t i_, const float* qn, const float* qr, bf16_t* qnb, bf16_t* qrb) { qnb[i_] = f2bf(qn[i_] * QSCALE_F); qrb[i_] = f2bf(qr[i_] * QSCALE_F); }
__host__ __device__ inline size_t kimg_off(int kv, int d0) { return (size_t)(d0 >> 3) * 1024 + (size_t)kv * 16; }
__host__ __device__ inline size_t vimg_off(int kv, int d0) { return (size_t)(d0 >> 5) * 4096 + (size_t)(kv >> 3) * 512 + (size_t)(kv & 7) * 64 + (size_t)((d0 & 31) >> 3) * 16; }
__device__ inline void put_chunk(unsigned char* dst, const float* src) { bf16_t* d = (bf16_t*)dst; for (int k = 0; k < 8; ++k) d[k] = f2bf(src[k]); }
__device__ inline void kvimg_item(size_t i_, const float* out, const float* winrows, unsigned char* ksel, unsigned char* vsel, unsigned char* kwin, unsigned char* vwin) {
    const int c = (int)(i_ % 8), t = (int)((i_ / 8) % SEQ), g = (int)((i_ / (8 * (size_t)SEQ)) % N_KV), n = (int)(i_ / (8 * (size_t)SEQ * N_KV));
    const size_t base = (((size_t)n * N_KV + g) * (SEQ / 64) + t / 64) * 8192; const int kv = t % 64, d0 = 8 * c; const size_t m = (size_t)n * SEQ + t;
    put_chunk(ksel + base + kimg_off(kv, d0), out + O_KVP + ((m * 4 + 2) * N_KV + g) * HD + d0);
    put_chunk(vsel + base + vimg_off(kv, d0), out + O_KVP + ((m * 4 + 3) * N_KV + g) * HD + d0);
    put_chunk(kwin + base + kimg_off(kv, d0), winrows + ((m * 2 + 0) * N_KV + g) * HD + d0);
    put_chunk(vwin + base + vimg_off(kv, d0), winrows + ((m * 2 + 1) * N_KV + g) * HD + d0);
}
__device__ inline void kcimg_item(size_t i_, const float* kc, const float* vc, unsigned char* kci, unsigned char* vci) {
    const int c = (int)(i_ % 8), cb = (int)((i_ / 8) % NBC_P), g = (int)((i_ / (8 * (size_t)NBC_P)) % N_KV), n = (int)(i_ / (8 * (size_t)NBC_P * N_KV));
    const size_t base = (((size_t)n * N_KV + g) * (NBC_P / 64) + cb / 64) * 8192; const int kv = cb % 64, d0 = 8 * c;
    put_chunk(kci + base + kimg_off(kv, d0), kc + (((size_t)n * NBC_MAX + cb) * N_KV + g) * HD + d0);
    put_chunk(vci + base + vimg_off(kv, d0), vc + (((size_t)n * NBC_MAX + cb) * N_KV + g) * HD + d0);
}

constexpr int NBC_PAST = PAST_LEN / L_CMP;
constexpr int RS_CMP = DEC_BATCH * NBC_PAST * N_KV, RP_CMP = BATCH * NBC_P * N_KV;
__device__ inline void acmp_sample_item(size_t i_, const float* cache_kv, const int* page_table, const float* pe, bf16_t* A) {
    const int c8 = (int)(i_ % 8), l = (int)((i_ / 8) % L_CMP); const size_t rr = i_ / (8 * L_CMP); const int r = (int)(rr % RS_CMP), e = (int)(rr / RS_CMP);
    const int g = r % N_KV, c = (r / N_KV) % NBC_PAST, b = r / (N_KV * NBC_PAST), tok = c * L_CMP + l;
    const int page = page_table[b * N_PAGES + tok / PAGE_SIZE];
    const float* src = cache_kv + ((((size_t)page * PAGE_SIZE + tok % PAGE_SIZE) * 4 + e) * N_KV + g) * HD + 8 * c8; const float* pp = pe + ((size_t)e * L_CMP + l) * HD + 8 * c8;
    bf16_t* d = A + ((size_t)e * RS_CMP + r) * (L_CMP * HD) + l * HD + 8 * c8;
    for (int k = 0; k < 8; ++k) d[k] = f2bf(src[k] + pp[k]);
}
__device__ inline void acmp_prompt_item(size_t i_, const float* out, const float* pe, bf16_t* A) {
    const int c8 = (int)(i_ % 8), l = (int)((i_ / 8) % L_CMP); const size_t rr = i_ / (8 * L_CMP); const int r = (int)(rr % RP_CMP), e = (int)(rr / RP_CMP);
    const int g = r % N_KV, c = (r / N_KV) % NBC_P, n = r / (N_KV * NBC_P), tok = c * L_CMP + l;
    const float* src = out + O_KVP + ((((size_t)n * SEQ + tok) * 4 + e) * N_KV + g) * HD + 8 * c8; const float* pp = pe + ((size_t)e * L_CMP + l) * HD + 8 * c8;
    bf16_t* d = A + ((size_t)e * RP_CMP + r) * (L_CMP * HD) + l * HD + 8 * c8;
    for (int k = 0; k < 8; ++k) d[k] = f2bf(src[k] + pp[k]);
}
__device__ inline void cmp_out_b_item(size_t i_, const bf16_t* hid, int R, int nbc, int seq0, const float* w2, const float* k_norm0, float* kc, float* vc) {
    const int r = (int)(i_ % R), e = (int)(i_ / R); const int g = r % N_KV, c = (r / N_KV) % nbc, sq = r / (N_KV * nbc);
    const bf16_t* hr = hid + ((size_t)e * R + r) * CMP_HID;
    float v[HD];
    for (int d = 0; d < HD; ++d) v[d] = 0.f;
    for (int f = 0; f < CMP_HID; ++f) { const float hf = bf2f(hr[f]); const float* w = w2 + ((size_t)e * CMP_HID + f) * HD; for (int d = 0; d < HD; ++d) v[d] += hf * w[d]; }
    if (e == 0) head_norm(v, k_norm0);
    float* o = (e == 0 ? kc : vc) + (((size_t)(seq0 + sq) * NBC_MAX + c) * N_KV + g) * HD;
    for (int d = 0; d < HD; ++d) o[d] = v[d];
}
__host__ __device__ inline int heads_row(int hidx, int d) { return (hidx / 4) * 256 + 128 * (d / 32) + 32 * (hidx % 4) + (d % 32); }
__device__ inline void conv_state_store(float* out, int layer, int m, int ch, float u) {
    const RowInfo ri = row_info(m); const int L = seq_len(ri.seq);
    if (ri.t >= L - 2) { const int j = ri.t - (L - 2);
        if (ri.seq < BATCH) out[O_CP + (((size_t)layer * BATCH + ri.seq) * 2 + j) * D_MODEL + ch] = u;
        else out[O_CS + (((size_t)layer * DEC_BATCH + (ri.seq - BATCH)) * 2 + j) * D_MODEL + ch] = u; }
}
__device__ inline void ref_conv_in_item(size_t i_, const bf16_t* hb, const float* rss, const bf16_t* Bt, bf16_t* ub, bf16_t* bb, float* out, int layer) {
    const int m = (int)(i_ / D_MODEL), j = (int)(i_ % D_MODEL);
    const float rs = 1.0f / sqrtf(rss[m] / D_MODEL + EPS); const bf16_t* a = hb + (size_t)m * D_MODEL;
    const int nc = (j / 128) * 256 + (j % 128);
    const float c = rs * dot_bf(a, Bt + (size_t)nc * D_MODEL, D_MODEL), x = rs * dot_bf(a, Bt + (size_t)(nc + 128) * D_MODEL, D_MODEL), b = rs * dot_bf(a, Bt + (size_t)(2 * D_MODEL + j) * D_MODEL, D_MODEL);
    const float u = c * x; ub[i_] = f2bf(u); bb[i_] = f2bf(b); conv_state_store(out, layer, m, j, u);
}
__device__ inline void conv_thin_item(size_t i_, const bf16_t* ub, const bf16_t* bb, const float* state  , const float* wc  , bf16_t* zb) {
    const int m = (int)(i_ / D_MODEL), ch = (int)(i_ % D_MODEL);
    const RowInfo ri = row_info(m);
    const float u0 = bf2f(ub[i_]);
    float u1, u2;
    if (ri.t >= 1) u1 = bf2f(ub[i_ - D_MODEL]); else u1 = (ri.seq < BATCH) ? 0.f : state[((size_t)(ri.seq - BATCH) * 2 + 1) * D_MODEL + ch];
    if (ri.t >= 2) u2 = bf2f(ub[i_ - 2 * D_MODEL]); else if (ri.seq < BATCH) u2 = 0.f;
    else u2 = (ri.t == 1) ? state[((size_t)(ri.seq - BATCH) * 2 + 1) * D_MODEL + ch] : state[((size_t)(ri.seq - BATCH) * 2 + 0) * D_MODEL + ch];
    zb[i_] = f2bf(bf2f(bb[i_]) * (wc[ch] * u2 + wc[D_MODEL + ch] * u1 + wc[2 * D_MODEL + ch] * u0));
}
__device__ inline void ref_qg_item(size_t i_, const bf16_t* hb, const float* rss, const bf16_t* Bt, const float* q_norm, const float* rope, float* qn, float* qr) {
    const int m = (int)(i_ / N_HEADS), hh = (int)(i_ % N_HEADS);
    const float rs = 1.0f / sqrtf(rss[m] / D_MODEL + EPS); const bf16_t* a = hb + (size_t)m * D_MODEL;
    float v[HD]; for (int d = 0; d < HD; ++d) v[d] = rs * dot_bf(a, Bt + (size_t)heads_row(hh, d) * D_MODEL, D_MODEL);
    head_norm(v, q_norm);
    for (int d = 0; d < HD; ++d) qn[(size_t)m * HDM + hh * HD + d] = v[d];
    const float* rt = rope + (size_t)pos_index(row_info(m).pos) * 16;
    for (int f = 0; f < 8; ++f) { const float x1 = v[f], x2 = v[8 + f]; v[f] = x1 * rt[f] - x2 * rt[8 + f]; v[8 + f] = x2 * rt[f] + x1 * rt[8 + f]; }
    for (int d = 0; d < HD; ++d) qr[(size_t)m * HDM + hh * HD + d] = v[d];
}
__device__ inline void ref_gates_item(size_t i_, const bf16_t* hb, const float* rss, const bf16_t* Bt, float* gates) {
    const int m = (int)(i_ / (3 * N_HEADS)), j = (int)(i_ % (3 * N_HEADS));
    const float rs = 1.0f / sqrtf(rss[m] / D_MODEL + EPS);
    const float x = rs * dot_bf(hb + (size_t)m * D_MODEL, Bt + (size_t)(HDM + j) * D_MODEL, D_MODEL);
    gates[i_] = 1.0f / (1.0f + expf(-x));
}
__device__ inline void kv_store(float* out, float* winrows, int m, int e, int g, int d, float v) {
    const RowInfo ri = row_info(m);
    if (e < 4) { if (ri.seq < BATCH) out[O_KVP + (((size_t)m * 4 + e) * N_KV + g) * HD + d] = v; else out[O_KVS + (((size_t)(m - MP) * 4 + e) * N_KV + g) * HD + d] = v; }
    else { const int we = e - 4;
        winrows[(((size_t)m * 2 + we) * N_KV + g) * HD + d] = v;
        if (ri.seq < BATCH) { if (ri.t >= SEQ - WINDOW) out[O_WP + ((((size_t)ri.seq * WINDOW + (ri.t - (SEQ - WINDOW))) * 2 + we) * N_KV + g) * HD + d] = v; }
        else out[O_WS + ((((size_t)(ri.seq - BATCH) * WINDOW + (WINDOW - DEC_SEQ + ri.t)) * 2 + we) * N_KV + g) * HD + d] = v; }
}
__device__ inline void ref_kv_item(size_t i_, const bf16_t* hb, const float* rss, const bf16_t* Bt, const float* k_norm, const float* rope, float* out, float* winrows) {
    const int m = (int)(i_ / (6 * N_KV)), hidx = (int)(i_ % (6 * N_KV)), e = hidx / N_KV, g = hidx % N_KV;
    const float rs = 1.0f / sqrtf(rss[m] / D_MODEL + EPS); const bf16_t* a = hb + (size_t)m * D_MODEL;
    float v[HD]; for (int d = 0; d < HD; ++d) v[d] = rs * dot_bf(a, Bt + (size_t)heads_row(hidx, d) * D_MODEL, D_MODEL);
    if (e == 2 || e == 4) { head_norm(v, k_norm + (e == 2 ? 1 : 2) * HD);
        const float* rt = rope + (size_t)pos_index(row_info(m).pos) * 16;
        for (int f = 0; f < 8; ++f) { const float x1 = v[f], x2 = v[8 + f]; v[f] = x1 * rt[f] - x2 * rt[8 + f]; v[8 + f] = x2 * rt[f] + x1 * rt[8 + f]; } }
    for (int d = 0; d < HD; ++d) kv_store(out, winrows, m, e, g, d, v[d]);
}
#ifndef CPU_TEST
#define LAS __attribute__((address_space(3)))
#define XB_TMO      128
#define XB_XCNT(j)  (256  + 64 * (j))
#define XB_XSUB(j)  (1280 + 64 * (j))
#define XB_XGEN(j)  (2304 + 64 * (j))
#define XB_TOP      3328
#define XB_TOPGEN   3392
#define XCD_BAR_WORDS 3456
#define XB_SPIN_CAP (1u << 25)
typedef __attribute__((address_space(1))) unsigned GU;
__device__ __forceinline__ unsigned xb_ld(GU* p)              { return __hip_atomic_load(p, __ATOMIC_RELAXED, __HIP_MEMORY_SCOPE_AGENT); }
__device__ __forceinline__ unsigned xb_add(GU* p, unsigned v) { return __hip_atomic_fetch_add(p, v, __ATOMIC_RELAXED, __HIP_MEMORY_SCOPE_AGENT); }
__device__ __forceinline__ unsigned xb_xcc_id() { return (unsigned)__builtin_amdgcn_s_getreg((3 << 11) | 20) & 0xFu; }
#define XB_SPIN(cond, bar) do { unsigned _sp = 0; while (cond) { __builtin_amdgcn_s_sleep(1); \
    if ((++_sp & 255u) == 0u) { if (xb_ld(&(bar)[XB_TMO])) break; if (_sp > XB_SPIN_CAP) { (void)xb_add(&(bar)[XB_TMO], 1u); break; } } } } while (0)
struct XcdBarrier { GU* bar; unsigned x; volatile LAS unsigned* st; };
__device__ __forceinline__ XcdBarrier xcd_barrier_post(GU* bar, volatile LAS unsigned* st, const bool leader_thread) {
    XcdBarrier b; b.bar = bar; b.x = xb_xcc_id(); b.st = st;
    if (leader_thread) (void)xb_add(&bar[XB_XCNT(b.x)], 1u);
    return b;
}
__device__ __forceinline__ void xcd_barrier_complete(GU* bar, unsigned x, unsigned& nloc, unsigned& nx) {
    const unsigned G = gridDim.x * gridDim.y * gridDim.z;
    unsigned sum, cnt, mine, sp = 0u;
    for (;;) {
        sum = 0u; cnt = 0u; mine = 0u;
#pragma unroll
        for (unsigned j = 0; j < 16; ++j) { const unsigned c = xb_ld(&bar[XB_XCNT(j)]); sum += c; cnt += (c > 0u) ? 1u : 0u; mine = (j == x) ? c : mine; }
        if (sum == G) break;
        __builtin_amdgcn_s_sleep(1);
        if ((++sp & 255u) == 0u) { if (xb_ld(&bar[XB_TMO])) break; if (sp > XB_SPIN_CAP) { (void)xb_add(&bar[XB_TMO], 1u); break; } }
    }
    nloc = mine > 0u ? mine : 1u; nx = cnt > 0u ? cnt : 1u;
}
__device__ __forceinline__ void xcd_barrier(const XcdBarrier& b, const bool leader_thread) {
    asm volatile("s_waitcnt vmcnt(0)" ::: "memory");
    __syncthreads();
    if (leader_thread) {
        GU* bar = b.bar; unsigned bx = xb_xcc_id(); asm volatile("" : "+s"(bx));
        __builtin_amdgcn_s_waitcnt(0);
        unsigned nloc = b.st[0], nx = b.st[1];
        if (nloc == 0u) { xcd_barrier_complete(bar, bx, nloc, nx); b.st[0] = nloc; b.st[1] = nx; }
        const unsigned old = xb_add(&bar[XB_XSUB(bx)], 1u);
        const unsigned gen = old / nloc;
        if (old + 1u == (gen + 1u) * nloc) {
            __builtin_amdgcn_fence(__ATOMIC_RELEASE, "agent");
            asm volatile("s_waitcnt vmcnt(0)" ::: "memory");
            const unsigned og = xb_add(&bar[XB_TOP], 1u);
            const unsigned tg = og / nx;
            if (og + 1u == (tg + 1u) * nx) xb_add(&bar[XB_TOPGEN], 1u);
            else XB_SPIN(xb_ld(&bar[XB_TOPGEN]) == tg, bar);
            __builtin_amdgcn_fence(__ATOMIC_ACQUIRE, "agent");
            xb_add(&bar[XB_XGEN(bx)], 1u);
            asm volatile("s_waitcnt vmcnt(0)" ::: "memory");
        } else {
            XB_SPIN(xb_ld(&bar[XB_XGEN(bx)]) == gen, bar);
            __builtin_amdgcn_fence(__ATOMIC_ACQUIRE, "agent");
            asm volatile("s_waitcnt vmcnt(0)" ::: "memory");
        }
    }
    __syncthreads();
}

namespace pg8 {
#define PG8_LAS __attribute__((address_space(3)))
typedef unsigned short bf16_t;
typedef short bf16x8 __attribute__((ext_vector_type(8)));
typedef float f32x4 __attribute__((ext_vector_type(4)));
typedef unsigned u32x4 __attribute__((ext_vector_type(4)));
constexpr int BM = 256, BK = 64, HALF = 128, HTB = HALF * BK * 2  , STAGE_BYTES = 8 * HTB, NXCD = 8, WGM = 8;

__host__ __device__ __forceinline__ int lds_byte(int r, int c) { const int st = (r >> 4) * 2 + (c >> 5), rr = r & 15, cc = c & 31, ob = rr * 64 + cc * 2; return st * 1024 + (ob ^ (((ob >> 9) & 1) << 5)); }
__host__ __device__ __forceinline__ void stage_rc(int b, int& R, int& C) { const int st = b / 1024, sb = b % 1024, swz = sb ^ (((sb >> 9) & 1) << 5); R = (st >> 1) * 16 + swz / 64; C = (st & 1) * 32 + (swz % 64) / 2; }
__host__ __device__ __forceinline__ int perm32(int rho) { const int n = rho >> 4, i = rho & 15; return 8 * (i >> 2) + 4 * n + (i & 3); }

struct Unit { int pm, pn; };
struct Gemm { const bf16_t* A; const bf16_t* Bt; int M, N, K; };

struct StaticOrder {
    int nM, nN, nwg, G, c;
    __host__ __device__ void init(int M, int N, int G_, int c_) { nM = M / BM; nN = N / BM; nwg = nM * nN; G = G_; c = c_; }
    __host__ __device__ bool next(int i, Unit& u) const {
        const long L = (long)i * G + c; if (L >= nwg) return false;
        int wgid = (int)L; { const int q = nwg / NXCD, r = nwg % NXCD, xcd = wgid % NXCD, off = wgid / NXCD; wgid = (xcd < r ? xcd * (q + 1) : r * (q + 1) + (xcd - r) * q) + off; }
        const int nig = WGM * nN, gid = wgid / nig, fm = gid * WGM, gsz = (nM - fm) < WGM ? (nM - fm) : WGM;
        u.pm = fm + ((wgid % nig) % gsz); u.pn = (wgid % nig) / gsz; return true;
    }
    __device__ __forceinline__ void a_ready(const Unit&) const {}
    __device__ __forceinline__ void done(const Unit&) const {}
};

__device__ __forceinline__ unsigned cvt_pk_bf16(float lo, float hi) { unsigned r; asm volatile("v_cvt_pk_bf16_f32 %0, %1, %2" : "=v"(r) : "v"(lo), "v"(hi)); return r; }
template <class Epi, class Sched, bool ALIGN_EPI = false, bool SP2 = false>
__device__ __forceinline__ void gemm_phase(int wave_id_, PG8_LAS unsigned char* lds, const Gemm g, const Sched& S, const Epi& E) {
    int wid = wave_id_, lane = (int)lane_id_v(); asm volatile("" : "+s"(wid));
    const int tid = wid * 64 + lane, wr = wid >> 2, wc = wid & 3, fr = lane & 15, fq = lane >> 4;
    const int K = g.K, nt = K / BK;
    unsigned voffA[2], voffB[2];
#pragma unroll
    for (int i = 0; i < 2; ++i) { int R, C; stage_rc(tid * 16 + i * 8192, R, C); const int Rb = Epi::PERM ? ((R & ~31) + perm32(R & 31)) : R;
        voffA[i] = (unsigned)(R * K + C) * 2u; voffB[i] = (unsigned)(Rb * K + C) * 2u; }
    const size_t kstep = (size_t)(BK * 2);
    const size_t hstep = (size_t)HALF * K * 2;
    const size_t tstep = 2 * hstep;
    const unsigned ldsw = (unsigned)wid * 1024u;
    const int aoff = lds_byte(wr * 64 + fr, fq * 8), boff = lds_byte(wc * 32 + fr, fq * 8);
#define PG8_SA(b, h) (((b) * 2 + (h)) * HTB)
#define PG8_SB(b, h) ((4 + (b) * 2 + (h)) * HTB)
#define PG8_STAGE(bufoff, gbase, voff) do { _Pragma("unroll") for (int _i = 0; _i < 2; ++_i) \
        __builtin_amdgcn_global_load_lds((const unsigned*)((const char*)(gbase) + (voff)[_i]), (PG8_LAS unsigned*)(lds + (bufoff) + ldsw + _i * 8192), 16, 0, 0); } while (0)
#define PG8_LDA(dst, b, h) do { _Pragma("unroll") for (int m = 0; m < 4; ++m) _Pragma("unroll") for (int k = 0; k < 2; ++k) dst[m][k] = *(const PG8_LAS bf16x8*)(lds + PG8_SA(b, h) + aoff + m * 2048 + k * 1024); } while (0)
#define PG8_LDB(dst, b, h) do { _Pragma("unroll") for (int n = 0; n < 2; ++n) _Pragma("unroll") for (int k = 0; k < 2; ++k) dst[n][k] = *(const PG8_LAS bf16x8*)(lds + PG8_SB(b, h) + boff + n * 2048 + k * 1024); } while (0)
#define PG8_MMA(ai, bj, At, Bt) do { __builtin_amdgcn_s_setprio(1); _Pragma("unroll") for (int m = 0; m < 4; ++m) _Pragma("unroll") for (int n = 0; n < 2; ++n) _Pragma("unroll") for (int k = 0; k < 2; ++k) \
        acc[ai][bj][m][n] = __builtin_amdgcn_mfma_f32_16x16x32_bf16(Bt[n][k], At[m][k], acc[ai][bj][m][n], 0, 0, 0); __builtin_amdgcn_s_setprio(0); } while (0)
#define PG8_WAIT_V(n) asm volatile("s_waitcnt vmcnt(" #n ")" ::: "memory")
#define PG8_WAIT_L(n) asm volatile("s_waitcnt lgkmcnt(" #n ")" ::: "memory")
#define PG8_BAR __builtin_amdgcn_s_barrier()
#define PG8_SCHED __builtin_amdgcn_sched_barrier(0)
    Unit cur, nxt; int ui = 0;
    if (!S.next(0, cur)) return;
    f32x4 acc[2][2][4][2];
#pragma unroll
    for (int a = 0; a < 2; ++a)
#pragma unroll
        for (int b = 0; b < 2; ++b)
#pragma unroll
            for (int m = 0; m < 4; ++m)
#pragma unroll
                for (int n = 0; n < 2; ++n) acc[a][b][m][n] = (f32x4){0.f, 0.f, 0.f, 0.f};
    bf16x8 At[4][2], B0[2][2], B1[2][2];
    const char* cA = (const char*)g.A + (size_t)cur.pm * tstep; const char* cB = (const char*)g.Bt + (size_t)cur.pn * tstep;
    S.a_ready(cur);
    if constexpr (SP2) {
        PG8_STAGE(PG8_SB(0, 0), cB, voffB); PG8_STAGE(PG8_SB(0, 1), cB + hstep, voffB); PG8_STAGE(PG8_SA(0, 0), cA, voffA); PG8_STAGE(PG8_SA(0, 1), cA + hstep, voffA);
        if (wr == 1) PG8_BAR;
        PG8_WAIT_V(2); PG8_BAR;
        PG8_STAGE(PG8_SB(1, 0), cB + kstep, voffB); PG8_STAGE(PG8_SA(1, 0), cA + kstep, voffA); PG8_STAGE(PG8_SB(1, 1), cB + hstep + kstep, voffB);
        PG8_WAIT_V(6); PG8_BAR;
    } else {
        PG8_STAGE(PG8_SB(0, 0), cB, voffB); PG8_STAGE(PG8_SA(0, 0), cA, voffA); PG8_STAGE(PG8_SB(0, 1), cB + hstep, voffB); PG8_STAGE(PG8_SA(0, 1), cA + hstep, voffA);
        if (wr == 1) PG8_BAR;
        PG8_WAIT_V(4); PG8_BAR;
        PG8_STAGE(PG8_SB(1, 0), cB + kstep, voffB); PG8_STAGE(PG8_SA(1, 0), cA + kstep, voffA); PG8_STAGE(PG8_SB(1, 1), cB + hstep + kstep, voffB);
        PG8_WAIT_V(6); PG8_BAR;
    }
    for (;;) {
        const bool has_next = S.next(ui + 1, nxt);
        const char* nA = has_next ? (const char*)g.A + (size_t)nxt.pm * tstep : cA; const char* nB = has_next ? (const char*)g.Bt + (size_t)nxt.pn * tstep : cB;
        for (int t = 0; t < nt; t += 2) {
            const bool last = (t == nt - 2);
            const char* a1 = cA + (size_t)(t + 1) * kstep;
            const char* a2 = last ? nA : cA + (size_t)(t + 2) * kstep; const char* b2 = last ? nB : cB + (size_t)(t + 2) * kstep;
            const char* a3 = a2 + kstep; const char* b3 = b2 + kstep;
            if (last && has_next) S.a_ready(nxt);
            if constexpr (SP2) {
            PG8_LDB(B0, 0, 0); PG8_LDB(B1, 0, 1); PG8_SCHED; PG8_LDA(At, 0, 0); PG8_STAGE(PG8_SA(1, 1), a1 + hstep, voffA);
            PG8_WAIT_V(8); PG8_WAIT_L(0); PG8_BAR; PG8_MMA(0, 0, At, B0); PG8_MMA(0, 1, At, B1); PG8_BAR; PG8_SCHED;
            PG8_LDA(At, 0, 1); PG8_STAGE(PG8_SB(0, 0), b2, voffB); PG8_STAGE(PG8_SB(0, 1), b2 + hstep, voffB); PG8_STAGE(PG8_SA(0, 0), a2, voffA);
            PG8_WAIT_V(8); PG8_WAIT_L(0); PG8_BAR; PG8_MMA(1, 0, At, B0); PG8_MMA(1, 1, At, B1); PG8_BAR; PG8_SCHED;
            PG8_LDB(B0, 1, 0); PG8_LDB(B1, 1, 1); PG8_SCHED; PG8_LDA(At, 1, 0); PG8_STAGE(PG8_SA(0, 1), a2 + hstep, voffA);
            PG8_WAIT_V(8); PG8_WAIT_L(0); PG8_BAR; PG8_MMA(0, 0, At, B0); PG8_MMA(0, 1, At, B1); PG8_BAR; PG8_SCHED;
            PG8_LDA(At, 1, 1); PG8_STAGE(PG8_SB(1, 0), b3, voffB); PG8_STAGE(PG8_SB(1, 1), b3 + hstep, voffB); PG8_STAGE(PG8_SA(1, 0), a3, voffA);
            PG8_WAIT_V(8); PG8_WAIT_L(0); PG8_BAR; PG8_MMA(1, 0, At, B0); PG8_MMA(1, 1, At, B1); PG8_BAR; PG8_SCHED;
            } else {
            PG8_LDB(B0, 0, 0); PG8_SCHED; PG8_LDA(At, 0, 0); PG8_STAGE(PG8_SA(1, 1), a1 + hstep, voffA);
            PG8_WAIT_L(8); PG8_BAR; PG8_WAIT_L(0); PG8_MMA(0, 0, At, B0); PG8_BAR; PG8_SCHED;
            PG8_LDB(B1, 0, 1); PG8_STAGE(PG8_SB(0, 0), b2, voffB);
            PG8_BAR; PG8_WAIT_L(0); PG8_MMA(0, 1, At, B1); PG8_BAR;
            PG8_LDA(At, 0, 1); PG8_STAGE(PG8_SA(0, 0), a2, voffA);
            PG8_BAR; PG8_WAIT_L(0); PG8_MMA(1, 0, At, B0); PG8_BAR; PG8_SCHED;
            PG8_STAGE(PG8_SB(0, 1), b2 + hstep, voffB);
            PG8_WAIT_V(6); PG8_BAR; PG8_MMA(1, 1, At, B1); PG8_BAR;
            PG8_LDB(B0, 1, 0); PG8_SCHED; PG8_LDA(At, 1, 0); PG8_STAGE(PG8_SA(0, 1), a2 + hstep, voffA);
            PG8_WAIT_L(8); PG8_BAR; PG8_WAIT_L(0); PG8_MMA(0, 0, At, B0); PG8_BAR; PG8_SCHED;
            PG8_LDB(B1, 1, 1); PG8_STAGE(PG8_SB(1, 0), b3, voffB);
            PG8_BAR; PG8_WAIT_L(0); PG8_MMA(0, 1, At, B1); PG8_BAR;
            PG8_LDA(At, 1, 1); PG8_STAGE(PG8_SA(1, 0), a3, voffA);
            PG8_BAR; PG8_WAIT_L(0); PG8_MMA(1, 0, At, B0); PG8_BAR; PG8_SCHED;
            PG8_STAGE(PG8_SB(1, 1), b3 + hstep, voffB);
            PG8_WAIT_V(6); PG8_BAR; PG8_MMA(1, 1, At, B1); PG8_BAR;
            }
        }
        if constexpr (ALIGN_EPI) { if (wr == 0) PG8_BAR; }
        if constexpr (!Epi::AFTER_DRAIN) { E(acc, cur, wr, wc, fr, fq); S.done(cur); }
        if (!has_next) break;
#pragma unroll
        for (int a = 0; a < 2; ++a)
#pragma unroll
            for (int b = 0; b < 2; ++b)
#pragma unroll
                for (int m = 0; m < 4; ++m)
#pragma unroll
                    for (int n = 0; n < 2; ++n) acc[a][b][m][n] = (f32x4){0.f, 0.f, 0.f, 0.f};
        cur = nxt; cA = nA; cB = nB; ++ui;
        if constexpr (ALIGN_EPI) { if (wr == 1) PG8_BAR; }
    }
    PG8_WAIT_V(0);
    if constexpr (!ALIGN_EPI) { if (wr == 0) PG8_BAR; }
    PG8_BAR;
    if constexpr (Epi::AFTER_DRAIN) { E.fused(acc, cur, wr, wc, fr, fq, lds, wid, lane); S.done(cur); }
#undef PG8_SA
#undef PG8_SB
#undef PG8_STAGE
#undef PG8_LDA
#undef PG8_LDB
#undef PG8_MMA
#undef PG8_WAIT_V
#undef PG8_WAIT_L
#undef PG8_BAR
#undef PG8_SCHED
}
}

namespace pg8 {
__device__ __forceinline__ float fast_silu(float g) { return g * __builtin_amdgcn_rcpf(1.0f + __expf(-g)); }
__device__ __forceinline__ float row_rs(const float* rss, int row) { return rsqrtf(rss[row] * (1.0f / D_MODEL) + EPS); }
struct EpiSwiglu {
    static constexpr bool PERM = true, AFTER_DRAIN = false;
    bf16_t* act; const float* rss;
    __device__ __forceinline__ void operator()(const f32x4 (&acc)[2][2][4][2], const Unit& u, int wr, int wc, int fr, int fq) const {
        const int row0 = u.pm * BM + wr * 64 + fr, col0 = u.pn * 128 + wc * 32 + 8 * fq;
#pragma unroll
        for (int ai = 0; ai < 2; ++ai)
#pragma unroll
            for (int m = 0; m < 4; ++m) {
                const int row = row0 + ai * HALF + m * 16; const float rs = row_rs(rss, row);
                float a[8];
#pragma unroll
                for (int n = 0; n < 2; ++n)
#pragma unroll
                    for (int i = 0; i < 4; ++i) a[n * 4 + i] = fast_silu(acc[ai][0][m][n][i] * rs) * (acc[ai][1][m][n][i] * rs);
                u32x4 w; w.x = cvt_pk_bf16(a[0], a[1]); w.y = cvt_pk_bf16(a[2], a[3]); w.z = cvt_pk_bf16(a[4], a[5]); w.w = cvt_pk_bf16(a[6], a[7]);
                *(u32x4*)(act + (size_t)row * D_FF + col0) = w;
            }
    }
};
struct EpiResid {
    static constexpr bool PERM = false, AFTER_DRAIN = false;
    float* h; bf16_t* hb; float* rss_next; float* yout; float coef;
    __device__ __forceinline__ void operator()(const f32x4 (&acc)[2][2][4][2], const Unit& u, int wr, int wc, int fr, int fq) const {
        const int row0 = u.pm * BM + wr * 64 + fr, col0 = u.pn * BM + wc * 32 + 4 * fq;
#pragma unroll
        for (int ai = 0; ai < 2; ++ai)
#pragma unroll
            for (int m = 0; m < 4; ++m) {
                const int row = row0 + ai * HALF + m * 16; float s = 0.f;
                float* hr = h + (size_t)row * D_MODEL + col0;
#pragma unroll
                for (int bj = 0; bj < 2; ++bj)
#pragma unroll
                    for (int n = 0; n < 2; ++n) {
                        const int co = bj * HALF + n * 16;
                        const f32x4 v = *(const f32x4*)(hr + co) + acc[ai][bj][m][n] * coef;
                        if (yout) { *(f32x4*)(yout + (size_t)row * D_MODEL + col0 + co) = v; }
                        else {
                            *(f32x4*)(hr + co) = v;
                            typedef unsigned u32x2 __attribute__((ext_vector_type(2)));
                            u32x2 w; w.x = cvt_pk_bf16(v[0], v[1]); w.y = cvt_pk_bf16(v[2], v[3]);
                            *(u32x2*)(hb + (size_t)row * D_MODEL + col0 + co) = w;
                            s += (v[0] * v[0] + v[1] * v[1]) + (v[2] * v[2] + v[3] * v[3]);
                        }
                    }
                if (!yout) { s += __shfl_xor(s, 16); s += __shfl_xor(s, 32); if (fq == 0) (void)__hip_atomic_fetch_add(rss_next + row, s, __ATOMIC_RELAXED, __HIP_MEMORY_SCOPE_AGENT); }
            }
    }
};
}
namespace pg8 {
__device__ __forceinline__ float sum4(f32x4 v) { return (v[0] * v[0] + v[1] * v[1]) + (v[2] * v[2] + v[3] * v[3]); }
struct EpiConvIn {
    static constexpr bool PERM = true, AFTER_DRAIN = false;
    bf16_t* ub; bf16_t* bb; const float* rss; float* out; int layer;
    __device__ __forceinline__ void operator()(const f32x4 (&acc)[2][2][4][2], const Unit& u, int wr, int wc, int fr, int fq) const {
        const int row0 = u.pm * BM + wr * 64 + fr;
        const bool pair = u.pn < D_MODEL / 128;
#pragma unroll
        for (int ai = 0; ai < 2; ++ai)
#pragma unroll
            for (int m = 0; m < 4; ++m) {
                const int row = row0 + ai * HALF + m * 16; const float rs = row_rs(rss, row);
                if (pair) {
                    const int col0 = u.pn * 128 + wc * 32 + 8 * fq; float a[8];
#pragma unroll
                    for (int n = 0; n < 2; ++n)
#pragma unroll
                        for (int i = 0; i < 4; ++i) a[n * 4 + i] = (acc[ai][0][m][n][i] * rs) * (acc[ai][1][m][n][i] * rs);
                    u32x4 w; w.x = cvt_pk_bf16(a[0], a[1]); w.y = cvt_pk_bf16(a[2], a[3]); w.z = cvt_pk_bf16(a[4], a[5]); w.w = cvt_pk_bf16(a[6], a[7]);
                    *(u32x4*)(ub + (size_t)row * D_MODEL + col0) = w;
                    const RowInfo ri = row_info(row); const int jj = ri.t - (seq_len(ri.seq) - 2);
                    if (jj >= 0) {
                        float* cs = (ri.seq < BATCH) ? out + O_CP + (((size_t)layer * BATCH + ri.seq) * 2 + jj) * D_MODEL + col0 : out + O_CS + (((size_t)layer * DEC_BATCH + (ri.seq - BATCH)) * 2 + jj) * D_MODEL + col0;
                        *(f32x4*)(cs) = (f32x4){a[0], a[1], a[2], a[3]}; *(f32x4*)(cs + 4) = (f32x4){a[4], a[5], a[6], a[7]};
                    }
                } else {
#pragma unroll
                    for (int bj = 0; bj < 2; ++bj) {
                        const int col0 = (u.pn - D_MODEL / 128) * 256 + bj * HALF + wc * 32 + 8 * fq;
                        const f32x4 v0 = acc[ai][bj][m][0] * rs, v1 = acc[ai][bj][m][1] * rs;
                        u32x4 w; w.x = cvt_pk_bf16(v0[0], v0[1]); w.y = cvt_pk_bf16(v0[2], v0[3]); w.z = cvt_pk_bf16(v1[0], v1[1]); w.w = cvt_pk_bf16(v1[2], v1[3]);
                        *(u32x4*)(bb + (size_t)row * D_MODEL + col0) = w;
                    }
                }
                asm volatile("" ::: "memory");
            }
    }
};
__device__ __forceinline__ void head_norm_rope(f32x4 (&v)[2][2], const float* gain, const float* rt  , int fq, bool do_norm, bool do_rope, f32x4 (&rot0)[2]) {
    if (do_norm) {
        float ss = (sum4(v[0][0]) + sum4(v[0][1])) + (sum4(v[1][0]) + sum4(v[1][1]));
        ss += __shfl_xor(ss, 16); ss += __shfl_xor(ss, 32);
        const float r = rsqrtf(ss * (1.0f / HD) + EPS);
#pragma unroll
        for (int bj = 0; bj < 2; ++bj)
#pragma unroll
            for (int n = 0; n < 2; ++n) { const f32x4 g = *(const f32x4*)(gain + 32 * bj + 8 * fq + 4 * n); v[bj][n] = v[bj][n] * r * g; }
    }
    rot0[0] = v[0][0]; rot0[1] = v[0][1];
    if (do_rope) {
#pragma unroll
        for (int n = 0; n < 2; ++n) {
            f32x4 p;
#pragma unroll
            for (int i = 0; i < 4; ++i) p[i] = __shfl_xor(v[0][n][i], 16);
            const f32x4 c = *(const f32x4*)(rt + 4 * n), s = *(const f32x4*)(rt + 8 + 4 * n);
            if (fq == 0) rot0[n] = v[0][n] * c - p * s; else if (fq == 1) rot0[n] = v[0][n] * c + p * s;
        }
    }
}
struct EpiQG {
    static constexpr bool PERM = true, AFTER_DRAIN = false;
    float* qn; float* qr; float* gates; const float* rss; const float* q_norm; const float* rope;
    __device__ __forceinline__ void operator()(const f32x4 (&acc)[2][2][4][2], const Unit& u, int wr, int wc, int fr, int fq) const {
        const int row0 = u.pm * BM + wr * 64 + fr;
#pragma unroll
        for (int ai = 0; ai < 2; ++ai)
#pragma unroll
            for (int m = 0; m < 4; ++m) {
                const int row = row0 + ai * HALF + m * 16; const float rs = row_rs(rss, row);
                if (u.pn < N_HEADS / 4) {
                    const int hh = u.pn * 4 + wc;
                    f32x4 v[2][2] = {{acc[ai][0][m][0] * rs, acc[ai][0][m][1] * rs}, {acc[ai][1][m][0] * rs, acc[ai][1][m][1] * rs}}; f32x4 rot0[2];
                    head_norm_rope(v, q_norm, rope + (size_t)pos_index(row_info(row).pos) * 16, fq, true, true, rot0);
                    float* qnp = qn + (size_t)row * HDM + hh * HD + 8 * fq; float* qrp = qr + (size_t)row * HDM + hh * HD + 8 * fq;
                    *(f32x4*)(qnp) = v[0][0]; *(f32x4*)(qnp + 4) = v[0][1]; *(f32x4*)(qnp + 32) = v[1][0]; *(f32x4*)(qnp + 36) = v[1][1];
                    *(f32x4*)(qrp) = rot0[0]; *(f32x4*)(qrp + 4) = rot0[1]; *(f32x4*)(qrp + 32) = v[1][0]; *(f32x4*)(qrp + 36) = v[1][1];
                } else {
                    const int c0 = wc * 32 + 8 * fq;
#pragma unroll
                    for (int n = 0; n < 2; ++n)
#pragma unroll
                        for (int i = 0; i < 4; ++i) { const int c = c0 + 4 * n + i; if (c < 3 * N_HEADS) gates[(size_t)row * 3 * N_HEADS + c] = __builtin_amdgcn_rcpf(1.0f + __expf(-(acc[ai][0][m][n][i] * rs))); }
                }
                asm volatile("" ::: "memory");
            }
    }
};
struct EpiKV {
    static constexpr bool PERM = true, AFTER_DRAIN = false;
    float* out; float* winrows; const float* rss; const float* k_norm; const float* rope;
    __device__ __forceinline__ void operator()(const f32x4 (&acc)[2][2][4][2], const Unit& u, int wr, int wc, int fr, int fq) const {
        const int row0 = u.pm * BM + wr * 64 + fr;
        const int hidx = u.pn * 4 + wc, e = hidx / N_KV, g = hidx % N_KV; const bool nr = (e == 2 || e == 4);
#pragma unroll
        for (int ai = 0; ai < 2; ++ai)
#pragma unroll
            for (int m = 0; m < 4; ++m) {
                const int row = row0 + ai * HALF + m * 16; const float rs = row_rs(rss, row);
                const RowInfo ri = row_info(row);
                f32x4 v[2][2] = {{acc[ai][0][m][0] * rs, acc[ai][0][m][1] * rs}, {acc[ai][1][m][0] * rs, acc[ai][1][m][1] * rs}}; f32x4 rot0[2];
                head_norm_rope(v, k_norm + (e == 2 ? 1 : 2) * HD, rope + (size_t)pos_index(ri.pos) * 16, fq, nr, nr, rot0);
                float* d0; float* d1 = nullptr;
                if (e < 4) d0 = (ri.seq < BATCH) ? out + O_KVP + (((size_t)row * 4 + e) * N_KV + g) * HD : out + O_KVS + (((size_t)(row - MP) * 4 + e) * N_KV + g) * HD;
                else { const int we = e - 4; d0 = winrows + (((size_t)row * 2 + we) * N_KV + g) * HD;
                    if (ri.seq < BATCH) { if (ri.t >= SEQ - WINDOW) d1 = out + O_WP + ((((size_t)ri.seq * WINDOW + (ri.t - (SEQ - WINDOW))) * 2 + we) * N_KV + g) * HD; }
                    else d1 = out + O_WS + ((((size_t)(ri.seq - BATCH) * WINDOW + (WINDOW - DEC_SEQ + ri.t)) * 2 + we) * N_KV + g) * HD; }
                d0 += 8 * fq; *(f32x4*)(d0) = rot0[0]; *(f32x4*)(d0 + 4) = rot0[1]; *(f32x4*)(d0 + 32) = v[1][0]; *(f32x4*)(d0 + 36) = v[1][1];
                if (d1) { d1 += 8 * fq; *(f32x4*)(d1) = rot0[0]; *(f32x4*)(d1 + 4) = rot0[1]; *(f32x4*)(d1 + 32) = v[1][0]; *(f32x4*)(d1 + 36) = v[1][1]; }
                asm volatile("" ::: "memory");
            }
    }
};
}

namespace pg8 {
struct EpiGelu {
    static constexpr bool PERM = true, AFTER_DRAIN = false;
    bf16_t* hid;
    __device__ __forceinline__ void operator()(const f32x4 (&acc)[2][2][4][2], const Unit& u, int wr, int wc, int fr, int fq) const {
        const int row0 = u.pm * BM + wr * 64 + fr;
#pragma unroll
        for (int ai = 0; ai < 2; ++ai)
#pragma unroll
            for (int m = 0; m < 4; ++m) {
                const int row = row0 + ai * HALF + m * 16;
#pragma unroll
                for (int bj = 0; bj < 2; ++bj) {
                    float a[8];
#pragma unroll
                    for (int n = 0; n < 2; ++n)
#pragma unroll
                        for (int i = 0; i < 4; ++i) { const float x = acc[ai][bj][m][n][i]; a[n * 4 + i] = x * __builtin_amdgcn_rcpf(1.0f + __expf(-1.5957691216057308f * (x + 0.044715f * x * x * x))); }
                    u32x4 w; w.x = cvt_pk_bf16(a[0], a[1]); w.y = cvt_pk_bf16(a[2], a[3]); w.z = cvt_pk_bf16(a[4], a[5]); w.w = cvt_pk_bf16(a[6], a[7]);
                    *(u32x4*)(hid + (size_t)row * CMP_HID + bj * HALF + wc * 32 + 8 * fq) = w;
                }
            }
    }
};
struct CmpOrder {
    int nunits, per_e, G, c;
    __device__ bool next(int i, Unit& u) const { const int L = i * G + c; if (L >= nunits) return false; u.pm = L; u.pn = L / per_e; return true; }
    __device__ __forceinline__ void a_ready(const Unit&) const {}
    __device__ __forceinline__ void done(const Unit&) const {}
};
}
namespace att {
typedef short bf16x8 __attribute__((ext_vector_type(8)));
typedef short s16x4 __attribute__((ext_vector_type(4)));
typedef float f32x16 __attribute__((ext_vector_type(16)));
typedef __attribute__((address_space(3))) unsigned char* ldsp;
constexpr int TILE_B = 8192;
constexpr int L_KB = 0, L_VB = 2 * TILE_B, L_IMP = 4 * TILE_B, L_SELM = L_IMP + 64 * 64 * 4, L_END = L_SELM + 64 * 8;
constexpr float NEGB = -1e30f;
constexpr float QSCALE = 0.125f * 1.4426950408889634f;
__device__ __forceinline__ int crow(int r, int hi) { return (r & 3) + 8 * (r >> 2) + 4 * hi; }
__device__ __forceinline__ void glds16(const void* gsrc, unsigned lds_dst) { unsigned keep;
    asm volatile("s_mov_b32 %0, m0\n\ts_mov_b32 m0, %2\n\ts_nop 0\n\tglobal_load_lds_dwordx4 %1, off\n\ts_mov_b32 m0, %0" : "=&s"(keep) : "v"(gsrc), "s"(lds_dst) : "memory"); }
__device__ __forceinline__ unsigned cvtpk(float lo, float hi) { unsigned r; asm volatile("v_cvt_pk_bf16_f32 %0, %1, %2" : "=v"(r) : "v"(lo), "v"(hi)); return r; }
__device__ __forceinline__ float halfmax(float m) { auto rr = __builtin_amdgcn_permlane32_swap(__float_as_uint(m), __float_as_uint(m), false, false); return fmaxf(__uint_as_float(rr[0]), __uint_as_float(rr[1])); }
__device__ __forceinline__ float halfsum(float m) { auto rr = __builtin_amdgcn_permlane32_swap(__float_as_uint(m), __float_as_uint(m), false, false); return __uint_as_float(rr[0]) + __uint_as_float(rr[1]); }
__device__ __forceinline__ s16x4 vtr(ldsp p) { typedef short v4i16_t __attribute__((ext_vector_type(4))); return __builtin_bit_cast(s16x4, __builtin_amdgcn_ds_read_tr16_b64_v4i16((__attribute__((address_space(3))) v4i16_t*)p)); }
#define ATT_BAR_L() asm volatile("s_waitcnt lgkmcnt(0)\n\ts_barrier" ::: "memory")
#define ATT_WAIT_BAR(N) asm volatile("s_waitcnt vmcnt(" #N ") lgkmcnt(0)\n\ts_barrier" ::: "memory")
__device__ __forceinline__ void dma_tile(const unsigned char* img, unsigned lds_dst, int wid, int lane) { glds16(img + wid * 1024 + lane * 16, (unsigned)__builtin_amdgcn_readfirstlane(lds_dst + wid * 1024)); }
__device__ __forceinline__ void qk(f32x16& p0, f32x16& p1, ldsp kbuf, const bf16x8 (&qf)[4], float cinit, int r32, int hi) {
    f32x16 c;
#pragma unroll
    for (int r = 0; r < 16; ++r) c[r] = cinit;
    p0 = c; p1 = c;
#pragma unroll
    for (int s = 0; s < 4; ++s) {
        const bf16x8 k0 = *(const __attribute__((address_space(3))) bf16x8*)(kbuf + (2 * s + hi) * 1024 + r32 * 16);
        const bf16x8 k1 = *(const __attribute__((address_space(3))) bf16x8*)(kbuf + (2 * s + hi) * 1024 + r32 * 16 + 512);
        p0 = __builtin_amdgcn_mfma_f32_32x32x16_bf16(k0, qf[s], p0, 0, 0, 0);
        p1 = __builtin_amdgcn_mfma_f32_32x32x16_bf16(k1, qf[s], p1, 0, 0, 0);
    }
}
__device__ __forceinline__ void pv(f32x16 (&o)[2], ldsp vbuf, const f32x16& p0, const f32x16& p1, int lane, int hi) {
    unsigned pk[4][4];
#pragma unroll
    for (int k = 0; k < 4; ++k) { pk[0][k] = cvtpk(p0[2 * k], p0[2 * k + 1]); pk[1][k] = cvtpk(p0[8 + 2 * k], p0[9 + 2 * k]); pk[2][k] = cvtpk(p1[2 * k], p1[2 * k + 1]); pk[3][k] = cvtpk(p1[8 + 2 * k], p1[9 + 2 * k]); }
    const int vp0 = ((lane >> 4) & 1) * 32 + (lane & 3) * 8 + (4 * hi + ((lane & 15) >> 2)) * 64;
#pragma unroll
    for (int d0 = 0; d0 < 2; ++d0)
#pragma unroll
        for (int s = 0; s < 4; ++s) {
            const s16x4 lo = vtr(vbuf + d0 * 4096 + s * 1024 + vp0), hh = vtr(vbuf + d0 * 4096 + s * 1024 + 512 + vp0);
            const bf16x8 vf = (bf16x8){lo[0], lo[1], lo[2], lo[3], hh[0], hh[1], hh[2], hh[3]};
            typedef unsigned u32x4 __attribute__((ext_vector_type(4)));
            const u32x4 pw = (u32x4){pk[s][0], pk[s][1], pk[s][2], pk[s][3]};
            o[d0] = __builtin_amdgcn_mfma_f32_32x32x16_bf16(vf, __builtin_bit_cast(bf16x8, pw), o[d0], 0, 0, 0);
        }
}
struct Run { float m, l; f32x16 o[2]; };
template <bool EMASK> __device__ __forceinline__ void tile_step(Run& R, ldsp kbuf, ldsp vbuf, const bf16x8 (&qf)[4], float cinit, int lo_b_, int hi_b_, int lane, int r32, int hi) {
    int lo_b = lo_b_ - 4 * hi, hi_b = hi_b_ - 4 * hi;
    if (EMASK) asm volatile("" : "+v"(lo_b), "+v"(hi_b));
    f32x16 p0, p1; qk(p0, p1, kbuf, qf, cinit, r32, hi);
    if (EMASK) {
#pragma unroll
        for (int r = 0; r < 16; ++r) { const int kc_ = (r & 3) + 8 * (r >> 2); if (kc_ < lo_b || kc_ > hi_b) p0[r] = NEGB; if (kc_ + 32 < lo_b || kc_ + 32 > hi_b) p1[r] = NEGB; }
    }
    float rm = fmaxf(p0[0], p1[0]);
#pragma unroll
    for (int r = 1; r < 16; ++r) rm = fmaxf(rm, fmaxf(p0[r], p1[r]));
    rm = halfmax(rm);
    const float mn = fmaxf(R.m, rm), alpha = __builtin_amdgcn_exp2f(R.m - mn);
    R.m = mn; R.l *= alpha;
#pragma unroll
    for (int r = 0; r < 16; ++r) { R.o[0][r] *= alpha; R.o[1][r] *= alpha; }
    float ls = 0.f;
#pragma unroll
    for (int r = 0; r < 16; ++r) {
        float e0 = __builtin_amdgcn_exp2f(p0[r] - mn), e1 = __builtin_amdgcn_exp2f(p1[r] - mn);
        if (EMASK) { const int kc_ = (r & 3) + 8 * (r >> 2); if (kc_ < lo_b || kc_ > hi_b) e0 = 0.f; if (kc_ + 32 < lo_b || kc_ + 32 > hi_b) e1 = 0.f; }
        p0[r] = e0; p1[r] = e1; ls += e0 + e1;
    }
    R.l += ls;
    pv(R.o, vbuf, p0, p1, lane, hi);
}
struct Tensors {
    const bf16_t* qn; const bf16_t* qr;
    const unsigned char* ksel; const unsigned char* vsel; const unsigned char* kwin; const unsigned char* vwin;
    const unsigned char* kc; const unsigned char* vc;
    const float* gates; bf16_t* ob;
};
template <bool SEL> __device__ __forceinline__ void branch(Run& R, const unsigned char* kimg, const unsigned char* vimg, int t0, int t1, int jdiag, unsigned long long selm, int iq,
                                                           const bf16x8 (&qf)[4], unsigned lds0, ldsp lds, int wid, int lane, int r32, int hi) {
    R.m = NEGB; R.l = 0.f;
#pragma unroll
    for (int r = 0; r < 16; ++r) { R.o[0][r] = 0.f; R.o[1][r] = 0.f; }
    dma_tile(kimg + (size_t)t0 * TILE_B, lds0 + L_KB, wid, lane); dma_tile(vimg + (size_t)t0 * TILE_B, lds0 + L_VB, wid, lane);
    for (int t = t0; t <= t1; ++t) {
        const int b = (t - t0) & 1;
        if (t < t1) { dma_tile(kimg + (size_t)(t + 1) * TILE_B, lds0 + L_KB + (b ^ 1) * TILE_B, wid, lane); dma_tile(vimg + (size_t)(t + 1) * TILE_B, lds0 + L_VB + (b ^ 1) * TILE_B, wid, lane); ATT_WAIT_BAR(2); }
        else ATT_WAIT_BAR(0);
        const float cinit = (!SEL || ((selm >> t) & 1ull)) ? 0.f : NEGB;
        const bool lowm = !SEL && (t == jdiag - 8);
        if (t == jdiag || lowm) tile_step<true>(R, lds + L_KB + b * TILE_B, lds + L_VB + b * TILE_B, qf, cinit, lowm ? iq : 0, (t == jdiag) ? iq : 63, lane, r32, hi);
        else tile_step<false>(R, lds + L_KB + b * TILE_B, lds + L_VB + b * TILE_B, qf, cinit, 0, 63, lane, r32, hi);
        ATT_BAR_L();
    }
}
__device__ __forceinline__ void load_q(bf16x8 (&qf)[4], const bf16_t* qrow, int hi) {
#pragma unroll
    for (int s = 0; s < 4; ++s) qf[s] = *(const bf16x8*)(qrow + 16 * s + 8 * hi);
}
__device__ __forceinline__ void unit(const Tensors& T, int n, int j, int g, ldsp lds, unsigned lds0, int wid, int lane) {
    const int r32 = lane & 31, hi = lane >> 5, ql = r32 >> 2, hq = r32 & 3, iq = 8 * wid + ql;
    const int row = n * SEQ + 64 * j + iq, head = g * HPG + hq, pos = 64 * j + iq;
    const size_t img_ng = ((size_t)n * N_KV + g);
    f32x16 oacc[2];
#pragma unroll
    for (int r = 0; r < 16; ++r) { oacc[0][r] = 0.f; oacc[1][r] = 0.f; }
    const float* gt = T.gates + (size_t)row * 3 * N_HEADS + head * 3;
    const float g_c = gt[0], g_s = gt[1], g_w = gt[2];
    bf16x8 qf[4];
    unsigned long long selm;
    {
        load_q(qf, T.qn + (size_t)row * HDM + head * HD, hi);
        const int ntc = (2 * j + 2 + 63) / 64;
        const unsigned char* kci = T.kc + img_ng * (NBC_P / 64) * TILE_B; const unsigned char* vci = T.vc + img_ng * (NBC_P / 64) * TILE_B;
        dma_tile(kci, lds0 + L_KB, wid, lane); dma_tile(vci, lds0 + L_VB, wid, lane);
        if (ntc > 1) { dma_tile(kci + TILE_B, lds0 + L_KB + TILE_B, wid, lane); dma_tile(vci + TILE_B, lds0 + L_VB + TILE_B, wid, lane); }
        ATT_WAIT_BAR(0);
        int cmax = ((pos + 1) >> 5) - 1 - 4 * hi;
        asm volatile("" : "+v"(cmax));
        f32x16 s0, s1, s2, s3;
        qk(s0, s1, lds + L_KB, qf, 0.f, r32, hi);
        if (ntc > 1) qk(s2, s3, lds + L_KB + TILE_B, qf, 0.f, r32, hi);
        else {
#pragma unroll
            for (int r = 0; r < 16; ++r) { s2[r] = NEGB; s3[r] = NEGB; }
        }
        float mx = NEGB;
#pragma unroll
        for (int r = 0; r < 16; ++r) { const int kv = (r & 3) + 8 * (r >> 2);
            if (kv > cmax) s0[r] = NEGB; if (kv + 32 > cmax) s1[r] = NEGB; if (kv + 64 > cmax) s2[r] = NEGB; if (kv + 96 > cmax) s3[r] = NEGB;
            mx = fmaxf(fmaxf(mx, fmaxf(s0[r], s1[r])), fmaxf(s2[r], s3[r])); }
        mx = halfmax(mx);
        float ls = 0.f;
#pragma unroll
        for (int r = 0; r < 16; ++r) { const int kv = (r & 3) + 8 * (r >> 2);
            s0[r] = (kv > cmax) ? 0.f : __builtin_amdgcn_exp2f(s0[r] - mx); s1[r] = (kv + 32 > cmax) ? 0.f : __builtin_amdgcn_exp2f(s1[r] - mx);
            s2[r] = (kv + 64 > cmax) ? 0.f : __builtin_amdgcn_exp2f(s2[r] - mx); s3[r] = (kv + 96 > cmax) ? 0.f : __builtin_amdgcn_exp2f(s3[r] - mx);
            ls += (s0[r] + s1[r]) + (s2[r] + s3[r]); }
        ls = halfsum(ls);
        const float inv = 1.0f / fmaxf(ls, 1e-30f);
#pragma unroll
        for (int r = 0; r < 16; ++r) { s0[r] *= inv; s1[r] *= inv; s2[r] *= inv; s3[r] *= inv; }
        __attribute__((address_space(3))) float* imp = (__attribute__((address_space(3))) float*)(lds + L_IMP) + iq * 64;
#pragma unroll
        for (int r = 0; r < 16; r += 2) { const int bl = crow(r, hi) >> 1;
            float v0 = s0[r] + s0[r + 1], v1 = s1[r] + s1[r + 1], v2 = s2[r] + s2[r + 1], v3 = s3[r] + s3[r + 1];
            v0 += __shfl_xor(v0, 1); v0 += __shfl_xor(v0, 2); v1 += __shfl_xor(v1, 1); v1 += __shfl_xor(v1, 2);
            v2 += __shfl_xor(v2, 1); v2 += __shfl_xor(v2, 2); v3 += __shfl_xor(v3, 1); v3 += __shfl_xor(v3, 2);
            if (hq == 0) { imp[bl] = v0; imp[16 + bl] = v1; imp[32 + bl] = v2; imp[48 + bl] = v3; } }
        Run Rc;
#pragma unroll
        for (int r = 0; r < 16; ++r) { Rc.o[0][r] = 0.f; Rc.o[1][r] = 0.f; }
        pv(Rc.o, lds + L_VB, s0, s1, lane, hi);
        if (ntc > 1) pv(Rc.o, lds + L_VB + TILE_B, s2, s3, lane, hi);
#pragma unroll
        for (int r = 0; r < 16; ++r) { oacc[0][r] += g_c * Rc.o[0][r]; oacc[1][r] += g_c * Rc.o[1][r]; }
        asm volatile("s_waitcnt lgkmcnt(0)" ::: "memory");
        __attribute__((address_space(3))) unsigned long long* selw = (__attribute__((address_space(3))) unsigned long long*)(lds + L_SELM);
        for (int qq = 0; qq < 8; ++qq) {
            const float v = ((__attribute__((address_space(3))) float*)(lds + L_IMP))[(8 * wid + qq) * 64 + lane];
            const bool valid = lane <= j, forced = (lane == 0) || (lane == j) || (lane == j - 1);
            const unsigned key = valid ? (forced ? 0x7f000000u : __float_as_uint(v) + 1u) : 0u;
            unsigned long long m;
            if (j + 1 <= N_SEL) m = __ballot(valid);
            else {
                unsigned Tt = 0u;
                for (int bit = 30; bit >= 0; --bit) { const unsigned cand = Tt | (1u << bit); if (__popcll(__ballot(key >= cand)) >= N_SEL) Tt = cand; }
                const unsigned long long gtm = __ballot(key > Tt), eqm = __ballot(key == Tt);
                const int need = N_SEL - __popcll(gtm);
                const bool pick = (key == Tt) && (__popcll(eqm & ((1ull << lane) - 1ull)) < need);
                m = gtm | __ballot(pick);
            }
            if (lane == 0) selw[8 * wid + qq] = m;
        }
        asm volatile("s_waitcnt lgkmcnt(0)" ::: "memory");
        selm = selw[iq];
        ATT_WAIT_BAR(0);
    }
    load_q(qf, T.qr + (size_t)row * HDM + head * HD, hi);
    {
        Run R; branch<true>(R, T.ksel + img_ng * (SEQ / 64) * TILE_B, T.vsel + img_ng * (SEQ / 64) * TILE_B, 0, j, j, selm, iq, qf, lds0, lds, wid, lane, r32, hi);
        const float sc = g_s / fmaxf(halfsum(R.l), 1e-30f);
#pragma unroll
        for (int r = 0; r < 16; ++r) { oacc[0][r] += sc * R.o[0][r]; oacc[1][r] += sc * R.o[1][r]; }
    }
    {
        Run R; branch<false>(R, T.kwin + img_ng * (SEQ / 64) * TILE_B, T.vwin + img_ng * (SEQ / 64) * TILE_B, j > 8 ? j - 8 : 0, j, j, 0ull, iq, qf, lds0, lds, wid, lane, r32, hi);
        const float sc = g_w / fmaxf(halfsum(R.l), 1e-30f);
#pragma unroll
        for (int r = 0; r < 16; ++r) { oacc[0][r] += sc * R.o[0][r]; oacc[1][r] += sc * R.o[1][r]; }
    }
    bf16_t* orow = T.ob + (size_t)row * HDM + head * HD;
#pragma unroll
    for (int d0 = 0; d0 < 2; ++d0)
#pragma unroll
        for (int rr = 0; rr < 4; ++rr) { typedef unsigned u32x2 __attribute__((ext_vector_type(2)));
            u32x2 w; w.x = cvtpk(oacc[d0][4 * rr], oacc[d0][4 * rr + 1]); w.y = cvtpk(oacc[d0][4 * rr + 2], oacc[d0][4 * rr + 3]);
            *(u32x2*)(orow + 32 * d0 + 8 * rr + 4 * hi) = w; }
}
__device__ __forceinline__ void phase(const Tensors& T, ldsp lds, int wid, int lane, int cu, int ncu) {
    const unsigned lds0 = (unsigned)(uintptr_t)lds;
    constexpr int NQB = SEQ / 64, NGRP = NQB / 4;
    for (int c = cu; c < BATCH * N_KV * NGRP; c += ncu) {
        const int ng = c / NGRP, s = c % NGRP, n = ng / N_KV, g = ng % N_KV;
        for (int k = 0; k < 4; ++k) { const int j = (k == 0) ? s : (k == 1) ? NQB / 2 - 1 - s : (k == 2) ? NQB / 2 + s : NQB - 1 - s; unit(T, n, j, g, lds, lds0, wid, lane); }
    }
}
}
#endif

#ifndef CPU_TEST
__device__ __forceinline__ size_t opaque_gtid(int wave) { int w = wave; asm volatile("" : "+s"(w)); unsigned t = blockIdx.x * NTHREADS + w * 64 + lane_id_v(); return (size_t)t; }
#define ITEM_LOOP(total) for (size_t i = opaque_gtid(wave_id); i < (size_t)(total); i += (size_t)gridDim.x * NTHREADS)
#else
#define ITEM_LOOP(total) _Pragma("omp parallel for schedule(dynamic, 64)") for (long long i = 0; i < (long long)(total); ++i)
#endif

struct Params {
    const float *x_prompt, *x_sample, *cache_kv, *cache_win, *state_conv; const int* page_table;
    const float *ffn_a_norm, *ffn_a_w_in, *ffn_a_w_out, *mix_norm, *ffn_b_norm, *ffn_b_w_in, *ffn_b_w_out, *conv_w_in, *conv_w, *conv_w_out, *kv_norm, *w_kv, *k_norm,
                *cmp_pe, *cmp_w1, *cmp_w2, *nsa_w_qg, *nsa_q_norm, *nsa_w_o;
    float* out; unsigned char* ws;
};
constexpr int LDS_RING = 131072, LDS_BAR_OFF = LDS_RING + 352, LDS_BYTES = 147456;

#ifndef CPU_TEST
typedef const __attribute__((address_space(4))) Params* KParamsPtr;
__device__ __forceinline__ KParamsPtr kparams_ptr() {
#if defined(__HIP_DEVICE_COMPILE__)
    KParamsPtr p = (KParamsPtr)__builtin_amdgcn_kernarg_segment_ptr(); asm volatile("" : "+s"(p)); return p;
#else
    return nullptr;
#endif
}
__device__ __forceinline__ Params load_params() {
#if defined(__HIP_DEVICE_COMPILE__)
    return *kparams_ptr();
#else
    return Params{};
#endif
}
__device__ __forceinline__ unsigned char* load_ws() {
#if defined(__HIP_DEVICE_COMPILE__)
    return kparams_ptr()->ws;
#else
    return nullptr;
#endif
}
#define KP const Params P = load_params()
__device__ __forceinline__ int opaque_s(int v) { asm volatile("" : "+s"(v)); return v; }
#define GRID_SYNC() do { XcdBarrier bar_; bar_.bar = (GU*)load_ws() + 1024; bar_.x = 0; bar_.st = (volatile LAS unsigned*)(lds + LDS_BAR_OFF); xcd_barrier(bar_, wave_id == 0 && lane_id_v() == 0u); } while (0)
__global__ void __launch_bounds__(NTHREADS, 2) mega(Params P_unused)
#else
static Params g_params;
#define KP const Params& P = g_params
#define GRID_SYNC() do {} while (0)
void mega(Params P_unused)
#endif
{
#ifndef CPU_TEST
    extern __shared__ __attribute__((aligned(16))) unsigned char lds[];
    const int wave_id = __builtin_amdgcn_readfirstlane((int)(threadIdx.x >> 6));
    if (threadIdx.x < 4) ((LAS unsigned*)(lds + LDS_BAR_OFF))[threadIdx.x] = 0u;
    __syncthreads();
    (void)xcd_barrier_post((GU*)load_ws() + 1024, (volatile LAS unsigned*)(lds + LDS_BAR_OFF), threadIdx.x == 0);
#define RING ((PG8_LAS unsigned char*)lds)
#else
    g_params = P_unused;
#endif
#define WS_F(f) ((float*)(P.ws + WSM.f))
#define WS_B(f) ((bf16_t*)(P.ws + WSM.f))
#define KVSRC KvSrc{P.cache_kv, P.page_table, P.out}
#define PH(total, call) do { { KP; ITEM_LOOP(total) call; } GRID_SYNC(); } while (0)
    for (int L = 0; L < DEPTH; ++L) {
        KP;
        ITEM_LOOP((size_t)2 * D_FF * (D_MODEL / 64)) wconv_item(i, P.ffn_a_w_in + (size_t)L * D_MODEL * 2 * D_FF, 2 * D_FF, P.ffn_a_norm + (size_t)L * D_MODEL, WS_B(w_ain) + (size_t)L * 2 * D_FF * D_MODEL, 2 * D_FF, D_MODEL, CM_PAIR, D_FF);
        ITEM_LOOP((size_t)D_MODEL * (D_FF / 64)) wconv_item(i, P.ffn_a_w_out + (size_t)L * D_FF * D_MODEL, D_MODEL, nullptr, WS_B(w_aout) + (size_t)L * D_MODEL * D_FF, D_MODEL, D_FF, CM_PLAIN, 0);
        ITEM_LOOP((size_t)2 * D_FF * (D_MODEL / 64)) wconv_item(i, P.ffn_b_w_in + (size_t)L * D_MODEL * 2 * D_FF, 2 * D_FF, P.ffn_b_norm + (size_t)L * D_MODEL, WS_B(w_bin) + (size_t)L * 2 * D_FF * D_MODEL, 2 * D_FF, D_MODEL, CM_PAIR, D_FF);
        ITEM_LOOP((size_t)D_MODEL * (D_FF / 64)) wconv_item(i, P.ffn_b_w_out + (size_t)L * D_FF * D_MODEL, D_MODEL, nullptr, WS_B(w_bout) + (size_t)L * D_MODEL * D_FF, D_MODEL, D_FF, CM_PLAIN, 0);
    }
    for (int L = 0; L < N_A; ++L) {
        KP;
        ITEM_LOOP((size_t)3 * D_MODEL * (D_MODEL / 64)) wconv_item(i, P.conv_w_in + (size_t)L * D_MODEL * 3 * D_MODEL, 3 * D_MODEL, P.mix_norm + (size_t)L * D_MODEL, WS_B(w_cin) + (size_t)L * 3 * D_MODEL * D_MODEL, 3 * D_MODEL, D_MODEL, CM_CONV, 0);
        ITEM_LOOP((size_t)D_MODEL * (D_MODEL / 64)) wconv_item(i, P.conv_w_out + (size_t)L * D_MODEL * D_MODEL, D_MODEL, nullptr, WS_B(w_cout) + (size_t)L * D_MODEL * D_MODEL, D_MODEL, D_MODEL, CM_PLAIN, 0);
    }
    for (int b = 0; b < N_B; ++b) {
        KP;
        ITEM_LOOP((size_t)QGP * (D_MODEL / 64)) wconv_item(i, P.nsa_w_qg + (size_t)b * D_MODEL * QGW, QGW, P.mix_norm + (size_t)(N_A + b) * D_MODEL, WS_B(w_qg) + (size_t)b * QGP * D_MODEL, QGP, D_MODEL, CM_HEADS, N_HEADS);
        ITEM_LOOP((size_t)D_MODEL * (HDM / 64)) wconv_item(i, P.nsa_w_o + (size_t)b * HDM * D_MODEL, D_MODEL, nullptr, WS_B(w_o) + (size_t)b * D_MODEL * HDM, D_MODEL, HDM, CM_PLAIN, 0);
    }
    { KP; ITEM_LOOP((size_t)KVW * (D_MODEL / 64)) wconv_item(i, P.w_kv, KVW, P.kv_norm, WS_B(w_kv), KVW, D_MODEL, CM_HEADS, 6 * N_KV); }
    { KP; ITEM_LOOP((size_t)NPOS * 8) rope_item(i, WS_F(rope)); }
    { KP; ITEM_LOOP(MT) hinit_item(i, P.x_prompt, P.x_sample, WS_F(h), WS_B(hb), WS_F(rss)); }
#ifndef CPU_TEST
    for (int e = 0; e < 2; ++e) { KP; ITEM_LOOP((size_t)CMP_HID * (L_CMP * HD / 64)) wconv_item(i, P.cmp_w1 + (size_t)e * L_CMP * HD * CMP_HID, CMP_HID, nullptr, WS_B(w1t) + (size_t)e * CMP_HID * L_CMP * HD, CMP_HID, L_CMP * HD, CM_PLAIN, 0); }
    { KP; ITEM_LOOP((size_t)2 * RS_CMP * L_CMP * 8) acmp_sample_item(i, P.cache_kv, P.page_table, P.cmp_pe, WS_B(acs)); }
#endif
    GRID_SYNC();
#ifndef CPU_TEST
    { KP; pg8::Gemm g{WS_B(acs), WS_B(w1t), 2 * RS_CMP, 2 * CMP_HID, L_CMP * HD}; pg8::CmpOrder So{2 * RS_CMP / 256, RS_CMP / 256, opaque_s((int)gridDim.x), opaque_s((int)blockIdx.x)};
      pg8::EpiGelu E{WS_B(hids)}; pg8::gemm_phase<pg8::EpiGelu, pg8::CmpOrder, true, true>(wave_id, RING, g, So, E); }
    GRID_SYNC();
    PH((size_t)2 * RS_CMP, cmp_out_b_item(i, WS_B(hids), RS_CMP, NBC_PAST, BATCH, P.cmp_w2, P.k_norm, WS_F(kc), WS_F(vc)));
#endif

#ifndef CPU_TEST
#define FFN_OPT(wi, wo, v_in, last) do { \
        { KP; pg8::Gemm g{WS_B(hb), WS_B(wi) + (size_t)layer * 2 * D_FF * D_MODEL, MT, 2 * D_FF, D_MODEL}; pg8::StaticOrder So; So.init(MT, 2 * D_FF, opaque_s((int)gridDim.x), opaque_s((int)blockIdx.x)); \
          pg8::EpiSwiglu E{WS_B(act), WS_F(rss) + (size_t)(v_in) * MT}; pg8::gemm_phase<pg8::EpiSwiglu, pg8::StaticOrder, true, true>(wave_id, RING, g, So, E); } \
        GRID_SYNC(); \
        { KP; pg8::Gemm g{WS_B(act), WS_B(wo) + (size_t)layer * D_MODEL * D_FF, MT, D_MODEL, D_FF}; pg8::StaticOrder So; So.init(MT, D_MODEL, opaque_s((int)gridDim.x), opaque_s((int)blockIdx.x)); \
          pg8::EpiResid E{WS_F(h), WS_B(hb), WS_F(rss) + (size_t)((v_in) + 1) * MT, (last) ? P.out + O_YP : nullptr, 0.5f}; pg8::gemm_phase<pg8::EpiResid, pg8::StaticOrder, true, true>(wave_id, RING, g, So, E); } \
        GRID_SYNC(); } while (0)
#else
#define FFN_OPT(wi, wo, v_in, last) do { KP; \
        ITEM_LOOP((size_t)MT * D_FF) ref_ffn_in_item(i, WS_B(hb), WS_F(rss) + (size_t)(v_in) * MT, WS_B(wi) + (size_t)layer * 2 * D_FF * D_MODEL, WS_B(act)); \
        ITEM_LOOP(MT) ref_resid_row_item(i, WS_B(act), D_FF, WS_B(wo) + (size_t)layer * D_MODEL * D_FF, 0.5f, WS_F(h), WS_B(hb), WS_F(rss) + (size_t)((v_in) + 1) * MT, (last) ? P.out + O_YP : nullptr); } while (0)
#endif
#ifndef CPU_TEST
#define GEMM_PH(EpiT, Aptr, Btptr, Nn, Kk, ...) do { { KP; pg8::Gemm g{Aptr, Btptr, MT, Nn, Kk}; pg8::StaticOrder So; So.init(MT, Nn, opaque_s((int)gridDim.x), opaque_s((int)blockIdx.x)); \
        pg8::EpiT E{__VA_ARGS__}; pg8::gemm_phase<pg8::EpiT, pg8::StaticOrder, true, true>(wave_id, RING, g, So, E); } GRID_SYNC(); } while (0)
#endif
    for (int layer = 0; layer < DEPTH; ++layer) {
        FFN_OPT(w_ain, w_aout, 3 * layer, false);
        const int v1 = 3 * layer + 1;
        if (layer < N_A) {
#ifndef CPU_TEST
            GEMM_PH(EpiConvIn, WS_B(hb), WS_B(w_cin) + (size_t)layer * 3 * D_MODEL * D_MODEL, 3 * D_MODEL, D_MODEL, WS_B(ub), WS_B(bb), WS_F(rss) + (size_t)v1 * MT, P.out, layer);
#else
            PH((size_t)MT * D_MODEL, ref_conv_in_item(i, WS_B(hb), WS_F(rss) + (size_t)v1 * MT, WS_B(w_cin) + (size_t)layer * 3 * D_MODEL * D_MODEL, WS_B(ub), WS_B(bb), P.out, layer));
#endif
            PH((size_t)MT * D_MODEL, conv_thin_item(i, WS_B(ub), WS_B(bb), P.state_conv + (size_t)layer * DEC_BATCH * 2 * D_MODEL, P.conv_w + (size_t)layer * 3 * D_MODEL, WS_B(zb)));
#ifndef CPU_TEST
            GEMM_PH(EpiResid, WS_B(zb), WS_B(w_cout) + (size_t)layer * D_MODEL * D_MODEL, D_MODEL, D_MODEL, WS_F(h), WS_B(hb), WS_F(rss) + (size_t)(v1 + 1) * MT, nullptr, 1.0f);
#else
            PH(MT, ref_resid_row_item(i, WS_B(zb), D_MODEL, WS_B(w_cout) + (size_t)layer * D_MODEL * D_MODEL, 1.0f, WS_F(h), WS_B(hb), WS_F(rss) + (size_t)(v1 + 1) * MT, nullptr));
#endif
        } else {
            const int b = layer - N_A;
#ifndef CPU_TEST
            GEMM_PH(EpiQG, WS_B(hb), WS_B(w_qg) + (size_t)b * QGP * D_MODEL, QGP, D_MODEL, WS_F(qn), WS_F(qr), WS_F(gates), WS_F(rss) + (size_t)v1 * MT, P.nsa_q_norm + (size_t)b * HD, WS_F(rope));
#else
            { KP; ITEM_LOOP((size_t)MT * N_HEADS) ref_qg_item(i, WS_B(hb), WS_F(rss) + (size_t)v1 * MT, WS_B(w_qg) + (size_t)b * QGP * D_MODEL, P.nsa_q_norm + (size_t)b * HD, WS_F(rope), WS_F(qn), WS_F(qr)); }
            PH((size_t)MT * 3 * N_HEADS, ref_gates_item(i, WS_B(hb), WS_F(rss) + (size_t)v1 * MT, WS_B(w_qg) + (size_t)b * QGP * D_MODEL, WS_F(gates)));
#endif
#ifndef CPU_TEST
            { KP; ITEM_LOOP((size_t)MS * N_HEADS) attn_cmp_item(i + (size_t)MP * N_HEADS, WS_F(qn), WS_F(kc), WS_F(vc), WS_F(pbuf), WS_F(oc)); }
            PH((size_t)MT * HDM, qconv_item(i, WS_F(qn), WS_F(qr), WS_B(qnb), WS_B(qrb)));
            { KP; ITEM_LOOP((size_t)MS * N_KV) topk_item(i + (size_t)MP * N_KV, WS_F(pbuf), (int*)WS_F(sel), WS_F(scorebuf)); }
            { KP; att::Tensors T{WS_B(qnb), WS_B(qrb), P.ws + WSM.ksel, P.ws + WSM.vsel, P.ws + WSM.kwin, P.ws + WSM.vwin, P.ws + WSM.kci, P.ws + WSM.vci, WS_F(gates), WS_B(ob)};
              int wv = wave_id; asm volatile("" : "+s"(wv));
              att::phase(T, (att::ldsp)lds, wv, (int)lane_id_v(), opaque_s((int)blockIdx.x), opaque_s((int)gridDim.x)); }
            GRID_SYNC();
            PH((size_t)MS * N_HEADS, attn_sel_item(i + (size_t)MP * N_HEADS, KVSRC, WS_F(qr), (const int*)WS_F(sel), WS_F(os)));
            PH((size_t)MS * N_HEADS, attn_win_item(i + (size_t)MP * N_HEADS, P.cache_win, WS_F(winrows), WS_F(qr), WS_F(gates), WS_F(oc), WS_F(os), WS_B(ob)));
#else
            PH((size_t)MT * N_HEADS, attn_cmp_item(i, WS_F(qn), WS_F(kc), WS_F(vc), WS_F(pbuf), WS_F(oc)));
            PH((size_t)MT * N_KV, topk_item(i, WS_F(pbuf), (int*)WS_F(sel), WS_F(scorebuf)));
            PH((size_t)MT * N_HEADS, attn_sel_item(i, KVSRC, WS_F(qr), (const int*)WS_F(sel), WS_F(os)));
            PH((size_t)MT * N_HEADS, attn_win_item(i, P.cache_win, WS_F(winrows), WS_F(qr), WS_F(gates), WS_F(oc), WS_F(os), WS_B(ob)));
#endif
#ifndef CPU_TEST
            GEMM_PH(EpiResid, WS_B(ob), WS_B(w_o) + (size_t)b * D_MODEL * HDM, D_MODEL, HDM, WS_F(h), WS_B(hb), WS_F(rss) + (size_t)(v1 + 1) * MT, nullptr, 1.0f);
#else
            PH(MT, ref_resid_row_item(i, WS_B(ob), HDM, WS_B(w_o) + (size_t)b * D_MODEL * HDM, 1.0f, WS_F(h), WS_B(hb), WS_F(rss) + (size_t)(v1 + 1) * MT, nullptr));
#endif
        }
        FFN_OPT(w_bin, w_bout, 3 * layer + 2, layer == DEPTH - 1);
        if (layer == N_A - 1) {
            const int v3 = 3 * layer + 3;
#ifndef CPU_TEST
            { KP; pg8::Gemm g{WS_B(hb), WS_B(w_kv), MT, KVW, D_MODEL}; pg8::StaticOrder So; So.init(MT, KVW, opaque_s((int)gridDim.x), opaque_s((int)blockIdx.x));
              pg8::EpiKV E{P.out, WS_F(winrows), WS_F(rss) + (size_t)v3 * MT, P.k_norm, WS_F(rope)}; pg8::gemm_phase<pg8::EpiKV, pg8::StaticOrder, true, true>(wave_id, RING, g, So, E); }
#else
            { KP; ITEM_LOOP((size_t)MT * 6 * N_KV) ref_kv_item(i, WS_B(hb), WS_F(rss) + (size_t)v3 * MT, WS_B(w_kv), P.k_norm, WS_F(rope), P.out, WS_F(winrows)); }
#endif
            PH((size_t)DEC_BATCH * (WINDOW - DEC_SEQ) * 2 * N_KV * HD, wincopy_item(i, P.cache_win, P.out));
#ifdef CPU_TEST
            PH((size_t)NSEQ * NBC_MAX * 2 * N_KV * CMP_HID, cmp_hid_item(i, KVSRC, P.cmp_pe, P.cmp_w1, WS_F(hid)));
            PH((size_t)NSEQ * NBC_MAX * 2 * N_KV, cmp_out_item(i, WS_F(hid), P.cmp_w2, P.k_norm, WS_F(kc), WS_F(vc)));
#else
            PH((size_t)2 * RP_CMP * L_CMP * 8, acmp_prompt_item(i, P.out, P.cmp_pe, WS_B(acp)));
            { KP; pg8::Gemm g{WS_B(acp), WS_B(w1t), 2 * RP_CMP, 2 * CMP_HID, L_CMP * HD}; pg8::CmpOrder So{2 * RP_CMP / 256, RP_CMP / 256, opaque_s((int)gridDim.x), opaque_s((int)blockIdx.x)};
              pg8::EpiGelu E{WS_B(hidp)}; pg8::gemm_phase<pg8::EpiGelu, pg8::CmpOrder, true, true>(wave_id, RING, g, So, E); }
            GRID_SYNC();
            PH((size_t)2 * RP_CMP, cmp_out_b_item(i, WS_B(hidp), RP_CMP, NBC_P, 0, P.cmp_w2, P.k_norm, WS_F(kc), WS_F(vc)));
            { KP; ITEM_LOOP((size_t)BATCH * N_KV * SEQ * 8) kvimg_item(i, P.out, WS_F(winrows), P.ws + WSM.ksel, P.ws + WSM.vsel, P.ws + WSM.kwin, P.ws + WSM.vwin); }
            PH((size_t)BATCH * N_KV * NBC_P * 8, kcimg_item(i, WS_F(kc), WS_F(vc), P.ws + WSM.kci, P.ws + WSM.vci));
#endif
        }
    }
}

extern "C" void kernel_launch(void* const* d_in, const int* in_sizes, int n_in, void* d_out, int out_size, void* d_ws, size_t ws_size, hipStream_t stream) {
    Params P{};
    P.x_prompt = (const float*)d_in[0]; P.x_sample = (const float*)d_in[1]; P.cache_kv = (const float*)d_in[2]; P.cache_win = (const float*)d_in[3];
    P.state_conv = (const float*)d_in[4]; P.page_table = (const int*)d_in[5]; P.ffn_a_norm = (const float*)d_in[6]; P.ffn_a_w_in = (const float*)d_in[7];
    P.ffn_a_w_out = (const float*)d_in[8]; P.mix_norm = (const float*)d_in[9]; P.ffn_b_norm = (const float*)d_in[10]; P.ffn_b_w_in = (const float*)d_in[11];
    P.ffn_b_w_out = (const float*)d_in[12]; P.conv_w_in = (const float*)d_in[13]; P.conv_w = (const float*)d_in[14]; P.conv_w_out = (const float*)d_in[15];
    P.kv_norm = (const float*)d_in[16]; P.w_kv = (const float*)d_in[17]; P.k_norm = (const float*)d_in[18]; P.cmp_pe = (const float*)d_in[19];
    P.cmp_w1 = (const float*)d_in[20]; P.cmp_w2 = (const float*)d_in[21]; P.nsa_w_qg = (const float*)d_in[22]; P.nsa_q_norm = (const float*)d_in[23];
    P.nsa_w_o = (const float*)d_in[24];
    P.out = (float*)d_out; P.ws = (unsigned char*)d_ws;
#ifndef CPU_TEST
    static int grid = 0;
    if (grid == 0) {
        int dev = 0, cus = 0, per_cu = 0;
        hipGetDevice(&dev); hipDeviceGetAttribute(&cus, hipDeviceAttributeMultiprocessorCount, dev);
        hipFuncSetAttribute((const void*)mega, hipFuncAttributeMaxDynamicSharedMemorySize, LDS_BYTES);
        hipOccupancyMaxActiveBlocksPerMultiprocessor(&per_cu, (const void*)mega, NTHREADS, LDS_BYTES);
        (void)hipGetLastError();
        grid = cus;
    }
    hipMemsetAsync(d_ws, 0, WS_ZERO_BYTES, stream);
    hipLaunchKernelGGL(mega, dim3(grid), dim3(NTHREADS), LDS_BYTES, stream, P);
#else
    memset(d_ws, 0, WS_ZERO_BYTES);
    mega(P);
#endif
}
```

```cpp
#ifdef CPU_TEST
#include "shim.h"
#else
#include <hip/hip_runtime.h>
#endif
#include <cstdint>
#include <cstddef>
#include <cmath>
#include <cstring>
typedef unsigned short bf16_t;
#ifndef CPU_TEST
#define HOSTDEV __host__ __device__
#else
#define HOSTDEV
#endif
HOSTDEV inline bf16_t f2bf(float f) { unsigned u; memcpy(&u, &f, 4); u = (u + 0x7fffu + ((u >> 16) & 1u)) >> 16; return (bf16_t)u; }
HOSTDEV inline float bf2f(bf16_t b) { unsigned u = (unsigned)b << 16; float f; memcpy(&f, &u, 4); return f; }

#ifdef CFG_SMALL
constexpr int D_MODEL = 256, BATCH = 1, SEQ = 2048, DEPTH = 4, DEC_BATCH = 2, DEC_SEQ = 8, PAST_LEN = 2048, PAGE_SIZE = 128, D_FF = 256, N_HEADS = 4, N_KV = 2;
#else
constexpr int D_MODEL = 1024, BATCH = 4, SEQ = 4096, DEPTH = 4, DEC_BATCH = 32, DEC_SEQ = 8, PAST_LEN = 8192, PAGE_SIZE = 128, D_FF = 2816, N_HEADS = 16, N_KV = 4;
#endif
constexpr int N_A = DEPTH / 2, N_B = DEPTH - N_A, HD = 64, HPG = N_HEADS / N_KV, L_CMP = 32, L_SEL = 64, N_SEL = 16, WINDOW = 512, CMP_HID = 4 * HD;
constexpr int MP = BATCH * SEQ, MS = DEC_BATCH * DEC_SEQ, MT = MP + MS, NSEQ = BATCH + DEC_BATCH;
constexpr int N_PAGES = PAST_LEN / PAGE_SIZE;
constexpr int KVW = 6 * N_KV * HD;
constexpr int QGW = N_HEADS * HD + 3 * N_HEADS;
constexpr int HDM = N_HEADS * HD;
constexpr int TPAD_S = ((PAST_LEN + DEC_SEQ + L_SEL - 1) / L_SEL) * L_SEL;
constexpr int NBC_P = SEQ / L_CMP, NBC_S = TPAD_S / L_CMP, NBC_MAX = NBC_S > NBC_P ? NBC_S : NBC_P;
constexpr int NBS_P = SEQ / L_SEL, NBS_S = TPAD_S / L_SEL, NBS_MAX = NBS_S > NBS_P ? NBS_S : NBS_P;
constexpr float EPS = 1e-6f, NEGF = -1e30f, TINYF = 1e-30f, FORCE_SCORE = 1e4f;
__device__ static const float INV_FREQ[8] = {1.0f, 0.1939227432012558f, 0.03760603070259094f, 0.007292664609849453f, 0.0014142135623842478f, 0.00027424818836152554f, 5.3182957344688475e-05f, 1.0313385246263351e-05f};

constexpr size_t O_YP = 0, O_YS = O_YP + (size_t)MP * D_MODEL, O_KVP = O_YS + (size_t)MS * D_MODEL, O_KVS = O_KVP + (size_t)MP * 4 * N_KV * HD,
                 O_WP = O_KVS + (size_t)MS * 4 * N_KV * HD, O_WS = O_WP + (size_t)BATCH * WINDOW * 2 * N_KV * HD, O_CP = O_WS + (size_t)DEC_BATCH * WINDOW * 2 * N_KV * HD,
                 O_CS = O_CP + (size_t)N_A * BATCH * 2 * D_MODEL, O_END = O_CS + (size_t)N_A * DEC_BATCH * 2 * D_MODEL;

struct RowInfo { int seq, t, pos; };
__device__ __host__ inline RowInfo row_info(int m) {
    RowInfo r;
    if (m < MP) { r.seq = m / SEQ; r.t = m % SEQ; r.pos = r.t; }
    else { const int q = m - MP; r.seq = BATCH + q / DEC_SEQ; r.t = q % DEC_SEQ; r.pos = PAST_LEN + r.t; }
    return r;
}
__device__ __host__ inline int seq_row0(int seq) { return seq < BATCH ? seq * SEQ : MP + (seq - BATCH) * DEC_SEQ; }
__device__ __host__ inline int seq_pos0(int seq) { return seq < BATCH ? 0 : PAST_LEN; }
__device__ __host__ inline int seq_len(int seq) { return seq < BATCH ? SEQ : DEC_SEQ; }

__device__ inline void copy_item(size_t i_, const float* a, float* b, size_t n) {
    const size_t i = i_;
    if (i < n) b[i] = a[i];
}
__device__ inline void rmsnorm_item(size_t i_, const float* x, const float* g, float* y, int rows, int d) {
    const int m = (int)i_;
    if (m >= rows) return;
    const float* xr = x + (size_t)m * d; float s = 0.f;
    for (int i = 0; i < d; ++i) s += xr[i] * xr[i];
    const float r = 1.0f / sqrtf(s / d + EPS);
    float* yr = y + (size_t)m * d;
    for (int i = 0; i < d; ++i) yr[i] = xr[i] * r * g[i];
}
__device__ inline void gemm_item(size_t i_, const float* A, int lda, const float* W, float* C, int M, int N, int K) {
    const int nbx = (N + 63) / 64; const int vb = (int)(i_ / 256), t_ = (int)(i_ % 256), tx = t_ % 16, ty = t_ / 16;
    const int c0 = (vb % nbx) * 64 + tx * 4, r0 = (vb / nbx) * 64 + ty * 4;
    if (c0 >= N || r0 >= M) return;
    float acc[4][4];
    for (int i = 0; i < 4; ++i) for (int j = 0; j < 4; ++j) acc[i][j] = 0.f;
    const int nr = (M - r0) < 4 ? (M - r0) : 4;
    for (int k = 0; k < K; k += 4) {
        float a[4][4], w[4][4];
        for (int i = 0; i < 4; ++i) for (int kk = 0; kk < 4; ++kk) a[i][kk] = (i < nr) ? A[(size_t)(r0 + i) * lda + k + kk] : 0.f;
        for (int kk = 0; kk < 4; ++kk) for (int j = 0; j < 4; ++j) w[kk][j] = W[(size_t)(k + kk) * N + c0 + j];
        for (int i = 0; i < 4; ++i) for (int kk = 0; kk < 4; ++kk) for (int j = 0; j < 4; ++j) acc[i][j] += a[i][kk] * w[kk][j];
    }
    for (int i = 0; i < nr; ++i) for (int j = 0; j < 4; ++j) C[(size_t)(r0 + i) * N + c0 + j] = acc[i][j];
}
__device__ inline void swiglu_item(size_t i_, const float* t1, float* act, int rows, int dff) {
    const size_t i = i_;
    if (i >= (size_t)rows * dff) return;
    const int m = (int)(i / dff), j = (int)(i % dff);
    const float g = t1[(size_t)m * 2 * dff + j], u = t1[(size_t)m * 2 * dff + dff + j];
    act[i] = g / (1.0f + expf(-g)) * u;
}
__device__ inline void axpy_item(size_t i_, float* h, const float* y, float coef, size_t n) {
    const size_t i = i_;
    if (i < n) h[i] += coef * y[i];
}
__device__ inline void conv_item(size_t i_, const float* t1, const float* state  , const float* wc  , float* z, float* out, int layer) {
    const size_t i = i_;
    if (i >= (size_t)MT * D_MODEL) return;
    const int m = (int)(i / D_MODEL), ch = (int)(i % D_MODEL);
    const RowInfo ri = row_info(m);
    const float* r = t1 + (size_t)m * 3 * D_MODEL;
    const float b = r[ch], u0 = r[D_MODEL + ch] * r[2 * D_MODEL + ch];
    float u1, u2;
    if (ri.t >= 1) { const float* p = r - 3 * D_MODEL; u1 = p[D_MODEL + ch] * p[2 * D_MODEL + ch]; }
    else u1 = (ri.seq < BATCH) ? 0.f : state[((size_t)(ri.seq - BATCH) * 2 + 1) * D_MODEL + ch];
    if (ri.t >= 2) { const float* p = r - 6 * D_MODEL; u2 = p[D_MODEL + ch] * p[2 * D_MODEL + ch]; }
    else if (ri.seq < BATCH) u2 = 0.f;
    else u2 = (ri.t == 1) ? state[((size_t)(ri.seq - BATCH) * 2 + 1) * D_MODEL + ch] : state[((size_t)(ri.seq - BATCH) * 2 + 0) * D_MODEL + ch];
    z[i] = b * (wc[ch] * u2 + wc[D_MODEL + ch] * u1 + wc[2 * D_MODEL + ch] * u0);
    const int L = seq_len(ri.seq);
    if (ri.t >= L - 2) {
        const int j = ri.t - (L - 2);
        if (ri.seq < BATCH) out[O_CP + (((size_t)layer * BATCH + ri.seq) * 2 + j) * D_MODEL + ch] = u0;
        else out[O_CS + (((size_t)layer * DEC_BATCH + (ri.seq - BATCH)) * 2 + j) * D_MODEL + ch] = u0;
    }
}
__device__ inline void head_norm(float* v, const float* g) {
    float s = 0.f; for (int d = 0; d < HD; ++d) s += v[d] * v[d];
    const float r = 1.0f / sqrtf(s / HD + EPS);
    for (int d = 0; d < HD; ++d) v[d] = v[d] * r * g[d];
}
__device__ inline void rope_cs(float ang, float& c, float& s) {
    const double r = (double)ang * 0.15915494309189535; const float fr = (float)(r - rint(r));
#ifdef CPU_TEST
    c = (float)cos(6.283185307179586 * (double)fr); s = (float)sin(6.283185307179586 * (double)fr);
#else
    c = __builtin_amdgcn_cosf(fr); s = __builtin_amdgcn_sinf(fr);
#endif
}
__device__ inline void head_rope(float* v, int pos) {
    for (int i = 0; i < 8; ++i) {
        const float ang = (float)pos * INV_FREQ[i]; float c, s; rope_cs(ang, c, s);
        const float x1 = v[i], x2 = v[8 + i];
        v[i] = x1 * c - x2 * s; v[8 + i] = x2 * c + x1 * s;
    }
}
__device__ inline void kvprep_item(size_t i_, const float* p, const float* k_norm  , float* out, float* winrows) {
    const int i = (int)i_;
    if (i >= MT * 6 * N_KV) return;
    const int m = i / (6 * N_KV), e = (i / N_KV) % 6, g = i % N_KV;
    const RowInfo ri = row_info(m);
    float v[HD];
    for (int d = 0; d < HD; ++d) v[d] = p[(size_t)m * KVW + (e * N_KV + g) * HD + d];
    if (e == 2) { head_norm(v, k_norm + HD); head_rope(v, ri.pos); }
    if (e == 4) { head_norm(v, k_norm + 2 * HD); head_rope(v, ri.pos); }
    if (e < 4) {
        float* o = (ri.seq < BATCH) ? out + O_KVP + (((size_t)m * 4 + e) * N_KV + g) * HD : out + O_KVS + (((size_t)(m - MP) * 4 + e) * N_KV + g) * HD;
        for (int d = 0; d < HD; ++d) o[d] = v[d];
    } else {
        const int we = e - 4;
        float* w = winrows + (((size_t)m * 2 + we) * N_KV + g) * HD;
        for (int d = 0; d < HD; ++d) w[d] = v[d];
        if (ri.seq < BATCH) { if (ri.t >= SEQ - WINDOW) { float* o = out + O_WP + ((((size_t)ri.seq * WINDOW + (ri.t - (SEQ - WINDOW))) * 2 + we) * N_KV + g) * HD; for (int d = 0; d < HD; ++d) o[d] = v[d]; } }
        else { float* o = out + O_WS + ((((size_t)(ri.seq - BATCH) * WINDOW + (WINDOW - DEC_SEQ + ri.t)) * 2 + we) * N_KV + g) * HD; for (int d = 0; d < HD; ++d) o[d] = v[d]; }
    }
}
__device__ inline void wincopy_item(size_t i_, const float* cache_win, float* out) {
    const size_t i = i_;
    const size_t per = (size_t)(WINDOW - DEC_SEQ) * 2 * N_KV * HD;
    if (i >= (size_t)DEC_BATCH * per) return;
    const size_t b = i / per, r = i % per;
    out[O_WS + b * WINDOW * 2 * N_KV * HD + r] = cache_win[b * WINDOW * 2 * N_KV * HD + (size_t)DEC_SEQ * 2 * N_KV * HD + r];
}
struct KvSrc { const float* cache_kv; const int* page_table; const float* out; };
__device__ inline const float* kv_full_ptr(const KvSrc& S, int seq, int tok, int e, int g) {
    if (seq < BATCH) return S.out + O_KVP + ((((size_t)seq * SEQ + tok) * 4 + e) * N_KV + g) * HD;
    const int b = seq - BATCH;
    if (tok < PAST_LEN) { const int page = S.page_table[b * N_PAGES + tok / PAGE_SIZE]; return S.cache_kv + ((((size_t)page * PAGE_SIZE + tok % PAGE_SIZE) * 4 + e) * N_KV + g) * HD; }
    if (tok < PAST_LEN + DEC_SEQ) return S.out + O_KVS + ((((size_t)b * DEC_SEQ + (tok - PAST_LEN)) * 4 + e) * N_KV + g) * HD;
    return nullptr;
}
__device__ inline int seq_nbc(int seq) { return seq < BATCH ? NBC_P : NBC_S; }
__device__ inline void cmp_hid_item(size_t i_, KvSrc S, const float* pe  , const float* w1  , float* hid) {
    const size_t i = i_;
    if (i >= (size_t)NSEQ * NBC_MAX * 2 * N_KV * CMP_HID) return;
    const int f = (int)(i % CMP_HID), g = (int)((i / CMP_HID) % N_KV), e = (int)((i / ((size_t)CMP_HID * N_KV)) % 2), c = (int)((i / ((size_t)CMP_HID * N_KV * 2)) % NBC_MAX), seq = (int)(i / ((size_t)CMP_HID * N_KV * 2 * NBC_MAX));
    if (c >= seq_nbc(seq)) return;
    float s = 0.f;
    for (int l = 0; l < L_CMP; ++l) {
        const float* r = kv_full_ptr(S, seq, c * L_CMP + l, e, g);
        const float* w = w1 + (((size_t)e * L_CMP + l) * HD) * CMP_HID + f; const float* pp = pe + ((size_t)e * L_CMP + l) * HD;
        for (int d = 0; d < HD; ++d) s += ((r ? r[d] : 0.f) + pp[d]) * w[(size_t)d * CMP_HID];
    }
    const float x = s; const float t = tanhf(0.7978845608028654f * (x + 0.044715f * x * x * x));
    hid[i] = 0.5f * x * (1.0f + t);
}
__device__ inline void cmp_out_item(size_t i_, const float* hid, const float* w2  , const float* k_norm0, float* kc, float* vc) {
    const int i = (int)i_;
    if (i >= NSEQ * NBC_MAX * 2 * N_KV) return;
    const int g = i % N_KV, e = (i / N_KV) % 2, c = (i / (2 * N_KV)) % NBC_MAX, seq = i / (2 * N_KV * NBC_MAX);
    if (c >= seq_nbc(seq)) return;
    const float* hr = hid + (size_t)i * CMP_HID;
    float v[HD];
    for (int d = 0; d < HD; ++d) { float s = 0.f; for (int f = 0; f < CMP_HID; ++f) s += hr[f] * w2[((size_t)e * CMP_HID + f) * HD + d]; v[d] = s; }
    if (e == 0) head_norm(v, k_norm0);
    float* o = (e == 0 ? kc : vc) + (((size_t)seq * NBC_MAX + c) * N_KV + g) * HD;
    for (int d = 0; d < HD; ++d) o[d] = v[d];
}
__device__ inline void qprep_item(size_t i_, const float* qg, const float* q_norm, float* qn, float* qr, float* gates) {
    const int i = (int)i_;
    if (i >= MT * N_HEADS) return;
    const int m = i / N_HEADS, hh = i % N_HEADS;
    const RowInfo ri = row_info(m);
    float v[HD];
    for (int d = 0; d < HD; ++d) v[d] = qg[(size_t)m * QGW + hh * HD + d];
    head_norm(v, q_norm);
    for (int d = 0; d < HD; ++d) qn[(size_t)m * HDM + hh * HD + d] = v[d];
    head_rope(v, ri.pos);
    for (int d = 0; d < HD; ++d) qr[(size_t)m * HDM + hh * HD + d] = v[d];
    for (int j = 0; j < 3; ++j) { const float x = qg[(size_t)m * QGW + HDM + hh * 3 + j]; gates[(size_t)m * 3 * N_HEADS + hh * 3 + j] = 1.0f / (1.0f + expf(-x)); }
}
__device__ inline void attn_cmp_item(size_t i_, const float* qn, const float* kc, const float* vc, float* pbuf, float* oc) {
    const int i = (int)i_;
    if (i >= MT * N_HEADS) return;
    const int m = i / N_HEADS, hh = i % N_HEADS, g = hh / HPG;
    const RowInfo ri = row_info(m);
    const int nbc = seq_nbc(ri.seq);
    const float* q = qn + (size_t)m * HDM + hh * HD;
    float* p = pbuf + (size_t)i * NBC_MAX;
    float mx = NEGF;
    for (int c = 0; c < nbc; ++c) {
        const bool vis = (c + 1) * L_CMP - 1 <= ri.pos;
        float s = 0.f; const float* k = kc + (((size_t)ri.seq * NBC_MAX + c) * N_KV + g) * HD;
        for (int d = 0; d < HD; ++d) s += q[d] * k[d];
        s *= 0.125f; p[c] = s; if (vis && s > mx) mx = s;
    }
    float sum = 0.f;
    for (int c = 0; c < nbc; ++c) { const bool vis = (c + 1) * L_CMP - 1 <= ri.pos; const float e = vis ? expf(p[c] - mx) : 0.f; p[c] = e; sum += e; }
    const float inv = 1.0f / fmaxf(sum, TINYF);
    float o[HD]; for (int d = 0; d < HD; ++d) o[d] = 0.f;
    for (int c = 0; c < nbc; ++c) { p[c] *= inv; if (p[c] != 0.f) { const float* v = vc + (((size_t)ri.seq * NBC_MAX + c) * N_KV + g) * HD; for (int d = 0; d < HD; ++d) o[d] += p[c] * v[d]; } }
    for (int d = 0; d < HD; ++d) oc[(size_t)m * HDM + hh * HD + d] = o[d];
}
__device__ inline void topk_item(size_t i_, const float* pbuf, int* sel, float* scorebuf  ) {
    const int i = (int)i_;
    if (i >= MT * N_KV) return;
    const int m = i / N_KV, g = i % N_KV;
    const RowInfo ri = row_info(m);
    const int nbs = ri.seq < BATCH ? NBS_P : NBS_S, cur = ri.pos / L_SEL;
    float* score = scorebuf + (size_t)i * NBS_MAX;
    for (int b = 0; b < nbs; ++b) {
        float imp = 0.f;
        for (int h = 0; h < HPG; ++h) { const float* p = pbuf + ((size_t)m * N_HEADS + g * HPG + h) * NBC_MAX; imp += p[2 * b]; }
        float imp2 = 0.f;
        for (int h = 0; h < HPG; ++h) { const float* p = pbuf + ((size_t)m * N_HEADS + g * HPG + h) * NBC_MAX; imp2 += p[2 * b + 1]; }
        const bool forced = (b == 0) || (b == cur) || (b == cur - 1), valid = b * L_SEL <= ri.pos;
        score[b] = valid ? (forced ? FORCE_SCORE : imp + imp2) : NEGF;
    }
    const int nsel = N_SEL < nbs ? N_SEL : nbs;
    for (int j = 0; j < N_SEL; ++j) {
        if (j >= nsel) { sel[(size_t)i * N_SEL + j] = -1; continue; }
        int best = -1; float bv = 0.f;
        for (int b = 0; b < nbs; ++b) if (score[b] > -3e38f && (best < 0 || score[b] > bv)) { best = b; bv = score[b]; }
        sel[(size_t)i * N_SEL + j] = best; score[best] = -3.4e38f;
    }
}
__device__ inline void attn_sel_item(size_t i_, KvSrc S, const float* qr, const int* sel, float* os) {
    const int i = (int)i_;
    if (i >= MT * N_HEADS) return;
    const int m = i / N_HEADS, hh = i % N_HEADS, g = hh / HPG;
    const RowInfo ri = row_info(m);
    const float* q = qr + (size_t)m * HDM + hh * HD;
    const int* sl = sel + ((size_t)m * N_KV + g) * N_SEL;
    float mx = NEGF;
    for (int j = 0; j < N_SEL; ++j) { const int b = sl[j]; if (b < 0) continue;
        for (int t = 0; t < L_SEL; ++t) { const int tok = b * L_SEL + t; if (tok > ri.pos) continue;
            const float* k = kv_full_ptr(S, ri.seq, tok, 2, g); float s = 0.f; if (k) for (int d = 0; d < HD; ++d) s += q[d] * k[d];
            s *= 0.125f; if (s > mx) mx = s; } }
    float sum = 0.f, o[HD]; for (int d = 0; d < HD; ++d) o[d] = 0.f;
    for (int j = 0; j < N_SEL; ++j) { const int b = sl[j]; if (b < 0) continue;
        for (int t = 0; t < L_SEL; ++t) { const int tok = b * L_SEL + t; if (tok > ri.pos) continue;
            const float* k = kv_full_ptr(S, ri.seq, tok, 2, g); float s = 0.f; if (k) for (int d = 0; d < HD; ++d) s += q[d] * k[d];
            const float e = expf(s * 0.125f - mx); sum += e;
            const float* v = kv_full_ptr(S, ri.seq, tok, 3, g); if (v) for (int d = 0; d < HD; ++d) o[d] += e * v[d]; } }
    const float inv = 1.0f / fmaxf(sum, TINYF);
    for (int d = 0; d < HD; ++d) os[(size_t)m * HDM + hh * HD + d] = o[d] * inv;
}
__device__ inline const float* win_ptr(const float* cache_win, const float* winrows, int seq, int kp) {
    if (seq < BATCH) return kp >= 0 ? winrows + (size_t)(seq * SEQ + kp) * 2 * N_KV * HD : nullptr;
    const int b = seq - BATCH;
    if (kp >= PAST_LEN) return winrows + (size_t)(MP + b * DEC_SEQ + (kp - PAST_LEN)) * 2 * N_KV * HD;
    const int j = kp - (PAST_LEN - WINDOW);
    return j >= 0 ? cache_win + ((size_t)b * WINDOW + j) * 2 * N_KV * HD : nullptr;
}
__device__ inline void attn_win_item(size_t i_, const float* cache_win, const float* winrows, const float* qr, const float* gates, const float* oc, const float* os, bf16_t* o_out) {
    const int i = (int)i_;
    if (i >= MT * N_HEADS) return;
    const int m = i / N_HEADS, hh = i % N_HEADS, g = hh / HPG;
    const RowInfo ri = row_info(m);
    const float* q = qr + (size_t)m * HDM + hh * HD;
    float mx = NEGF;
    for (int kp = ri.pos - WINDOW; kp <= ri.pos; ++kp) { const float* r = win_ptr(cache_win, winrows, ri.seq, kp); if (!r) continue;
        const float* k = r + (0 * N_KV + g) * HD; float s = 0.f; for (int d = 0; d < HD; ++d) s += q[d] * k[d]; s *= 0.125f; if (s > mx) mx = s; }
    float sum = 0.f, o[HD]; for (int d = 0; d < HD; ++d) o[d] = 0.f;
    for (int kp = ri.pos - WINDOW; kp <= ri.pos; ++kp) { const float* r = win_ptr(cache_win, winrows, ri.seq, kp); if (!r) continue;
        const float* k = r + (0 * N_KV + g) * HD; float s = 0.f; for (int d = 0; d < HD; ++d) s += q[d] * k[d];
        const float e = expf(s * 0.125f - mx); sum += e; const float* v = r + (1 * N_KV + g) * HD; for (int d = 0; d < HD; ++d) o[d] += e * v[d]; }
    const float inv = 1.0f / fmaxf(sum, TINYF);
    const float* gt = gates + (size_t)m * 3 * N_HEADS + hh * 3;
    for (int d = 0; d < HD; ++d) { const size_t x = (size_t)m * HDM + hh * HD + d; o_out[x] = f2bf(gt[0] * oc[x] + gt[1] * os[x] + gt[2] * o[d] * inv); }
}


#ifndef CPU_TEST
__device__ __forceinline__ unsigned lane_id_v() { unsigned l; asm volatile("v_mbcnt_lo_u32_b32 %0, -1, 0\n\tv_mbcnt_hi_u32_b32 %0, -1, %0" : "=v"(l)); return l; }
#endif
constexpr int NTHREADS = 512;
__host__ __device__ inline bf16_t f2bf_(float f) { unsigned u; memcpy(&u, &f, 4); u = (u + 0x7fffu + ((u >> 16) & 1u)) >> 16; return (bf16_t)u; }
__host__ __device__ inline float bf2f_(bf16_t b) { unsigned u = (unsigned)b << 16; float f; memcpy(&f, &u, 4); return f; }
constexpr int NRSS = 3 * DEPTH + 1;
constexpr int NPOS = SEQ + DEC_SEQ;
constexpr int QGP = ((QGW + 255) / 256) * 256;
__host__ __device__ inline int pos_index(int pos) { return pos < SEQ ? pos : SEQ + (pos - PAST_LEN); }

constexpr size_t IMG_SEQ_BYTES = (size_t)BATCH * N_KV * (SEQ / 64) * 8192, IMG_CMP_BYTES = (size_t)BATCH * N_KV * (NBC_P / 64 > 0 ? NBC_P / 64 : 1) * 8192;
struct WsMap {
    size_t ctl, rss, rope, h, hb, act, xn, t2, actf, ub, bb, zb, t1, qn, qr, gates, ob, winrows, hid, kc, vc, pbuf, oc, os, sel, scorebuf,
           w_ain, w_aout, w_bin, w_bout, w_cin, w_cout, w_qg, w_o, w_kv, qnb, qrb, ksel, vsel, kwin, vwin, kci, vci, acs, hids, acp, hidp, w1t, end;
};
constexpr size_t al256(size_t b) { return (b + 255) / 256 * 256; }
constexpr size_t smax(size_t a, size_t b) { return a > b ? a : b; }
constexpr WsMap make_ws_map() {
    WsMap w{}; size_t off = 0;
#define TAKE(f, bytes) w.f = off; off += al256(bytes)
    TAKE(ctl, 65536); TAKE(rss, (size_t)NRSS * MT * 4);
    TAKE(rope, (size_t)NPOS * 16 * 4);
    TAKE(h, (size_t)MT * D_MODEL * 4); TAKE(hb, (size_t)MT * D_MODEL * 2); TAKE(act, (size_t)MT * D_FF * 2);
    TAKE(xn, (size_t)MT * D_MODEL * 4); TAKE(t2, (size_t)MT * D_MODEL * 4); TAKE(actf, (size_t)MT * D_MODEL * 4);
    TAKE(ub, (size_t)MT * D_MODEL * 2); TAKE(bb, (size_t)MT * D_MODEL * 2); TAKE(zb, (size_t)MT * D_MODEL * 2);
    TAKE(t1, smax((size_t)MT * 3 * D_MODEL * 4, (size_t)MT * KVW * 4));
    TAKE(qn, (size_t)MT * HDM * 4); TAKE(qr, (size_t)MT * HDM * 4); TAKE(gates, (size_t)MT * 3 * N_HEADS * 4); TAKE(ob, (size_t)MT * HDM * 2);
    TAKE(winrows, (size_t)MT * 2 * N_KV * HD * 4); TAKE(hid, (size_t)NSEQ * NBC_MAX * 2 * N_KV * CMP_HID * 4);
    TAKE(kc, (size_t)NSEQ * NBC_MAX * N_KV * HD * 4); TAKE(vc, (size_t)NSEQ * NBC_MAX * N_KV * HD * 4);
    TAKE(pbuf, (size_t)MT * N_HEADS * NBC_MAX * 4); TAKE(oc, (size_t)MT * HDM * 4); TAKE(os, (size_t)MT * HDM * 4);
    TAKE(sel, (size_t)MT * N_KV * N_SEL * 4); TAKE(scorebuf, (size_t)MT * N_KV * NBS_MAX * 4);
    TAKE(w_ain, (size_t)DEPTH * 2 * D_FF * D_MODEL * 2); TAKE(w_aout, (size_t)DEPTH * D_MODEL * D_FF * 2);
    TAKE(w_bin, (size_t)DEPTH * 2 * D_FF * D_MODEL * 2); TAKE(w_bout, (size_t)DEPTH * D_MODEL * D_FF * 2);
    TAKE(w_cin, (size_t)N_A * 3 * D_MODEL * D_MODEL * 2); TAKE(w_cout, (size_t)N_A * D_MODEL * D_MODEL * 2);
    TAKE(w_qg, (size_t)N_B * QGP * D_MODEL * 2); TAKE(w_o, (size_t)N_B * D_MODEL * HDM * 2); TAKE(w_kv, (size_t)KVW * D_MODEL * 2);
    TAKE(qnb, (size_t)MT * HDM * 2); TAKE(qrb, (size_t)MT * HDM * 2); TAKE(ksel, IMG_SEQ_BYTES); TAKE(vsel, IMG_SEQ_BYTES); TAKE(kwin, IMG_SEQ_BYTES); TAKE(vwin, IMG_SEQ_BYTES); TAKE(kci, IMG_CMP_BYTES); TAKE(vci, IMG_CMP_BYTES);
    TAKE(acs, (size_t)2 * DEC_BATCH * (PAST_LEN / L_CMP) * N_KV * L_CMP * HD * 2); TAKE(hids, (size_t)2 * DEC_BATCH * (PAST_LEN / L_CMP) * N_KV * CMP_HID * 2);
    TAKE(acp, (size_t)2 * BATCH * NBC_P * N_KV * L_CMP * HD * 2); TAKE(hidp, (size_t)2 * BATCH * NBC_P * N_KV * CMP_HID * 2); TAKE(w1t, (size_t)2 * CMP_HID * L_CMP * HD * 2);
#undef TAKE
    w.end = off; return w;
}
constexpr WsMap WSM = make_ws_map();
constexpr size_t WS_ZERO_BYTES = 65536 + (((size_t)NRSS * MT * 4 + 255) / 256 * 256);

enum { CM_PLAIN = 0, CM_PAIR = 1, CM_CONV = 2, CM_HEADS = 3 };
__host__ __device__ inline int colmap(int kind, int n, int aux) {
    const int pn = n / 256, c = n % 256;
    if (kind == CM_PLAIN) return n;
    if (kind == CM_PAIR) return (c >= 128 ? aux : 0) + pn * 128 + (c % 128);
    if (kind == CM_CONV) { if (n < 2 * D_MODEL) return (c >= 128 ? 2 * D_MODEL : D_MODEL) + pn * 128 + (c % 128); return n - 2 * D_MODEL; }
    if (n < aux * 64) { const int bj = c / 128, wc = (c % 128) / 32, r = c % 32; return (pn * 4 + wc) * 64 + 32 * bj + r; }
    return n;
}
__device__ inline void wconv_item(size_t i_, const float* src, int Nsrc, const float* gain, bf16_t* dst, int Nd, int K, int kind, int aux) {
    const int n = (int)(i_ % Nd), kb = (int)(i_ / Nd);
    const int col = colmap(kind, n, aux);
    bf16_t* d = dst + (size_t)n * K + (size_t)kb * 64;
    if (col < 0 || col >= Nsrc) { for (int k = 0; k < 64; ++k) d[k] = 0; return; }
    const float* s = src + (size_t)kb * 64 * Nsrc + col;
#pragma unroll 8
    for (int k = 0; k < 64; k += 2) {
        const float g0 = gain ? gain[kb * 64 + k] : 1.f, g1 = gain ? gain[kb * 64 + k + 1] : 1.f;
        const unsigned lo = f2bf(s[(size_t)k * Nsrc] * g0), hi = f2bf(s[(size_t)(k + 1) * Nsrc] * g1);
        *(unsigned*)(d + k) = lo | (hi << 16);
    }
}
__device__ inline void rope_item(size_t i_, float* rope) {
    const int pi = (int)(i_ / 8), f = (int)(i_ % 8);
    const int pos = pi < SEQ ? pi : PAST_LEN + (pi - SEQ);
    float c, s; rope_cs((float)pos * INV_FREQ[f], c, s);
    rope[pi * 16 + f] = c; rope[pi * 16 + 8 + f] = s;
}
__device__ inline void hinit_item(size_t i_, const float* xp, const float* xs, float* h, bf16_t* hb, float* rss0) {
    const int m = (int)i_; const float* x = m < MP ? xp + (size_t)m * D_MODEL : xs + (size_t)(m - MP) * D_MODEL;
    float s = 0.f;
    for (int k = 0; k < D_MODEL; ++k) { const float v = x[k]; s += v * v; h[(size_t)m * D_MODEL + k] = v; hb[(size_t)m * D_MODEL + k] = f2bf(v); }
    rss0[m] = s;
}
__device__ inline void hupd_item(size_t i_, float* h, const float* y, float coef, bf16_t* hb, float* rss) {
    const int m = (int)i_; float s = 0.f;
    for (int k = 0; k < D_MODEL; ++k) { const float v = h[(size_t)m * D_MODEL + k] + coef * y[(size_t)m * D_MODEL + k]; s += v * v; h[(size_t)m * D_MODEL + k] = v; hb[(size_t)m * D_MODEL + k] = f2bf(v); }
    rss[m] = s;
}
__device__ inline float dot_bf(const bf16_t* a, const bf16_t* b, int K) { float s = 0.f; for (int k = 0; k < K; ++k) s += bf2f(a[k]) * bf2f(b[k]); return s; }
__device__ inline float silu_f(float g) { return g / (1.0f + expf(-g)); }
__device__ inline void ref_ffn_in_item(size_t i_, const bf16_t* hb, const float* rss, const bf16_t* Bt, bf16_t* act) {
    const int m = (int)(i_ / D_FF), j = (int)(i_ % D_FF);
    const float rs = 1.0f / sqrtf(rss[m] / D_MODEL + EPS);
    const int ng = (j / 128) * 256 + (j % 128);
    const float g = rs * dot_bf(hb + (size_t)m * D_MODEL, Bt + (size_t)ng * D_MODEL, D_MODEL), u = rs * dot_bf(hb + (size_t)m * D_MODEL, Bt + (size_t)(ng + 128) * D_MODEL, D_MODEL);
    act[i_] = f2bf(silu_f(g) * u);
}
__device__ inline void ref_resid_row_item(size_t i_, const bf16_t* A, int K, const bf16_t* Bt, float coef, float* h, bf16_t* hb, float* rss_next, float* yout) {
    const int m = (int)i_; float s = 0.f;
    for (int c = 0; c < D_MODEL; ++c) {
        const float v = h[(size_t)m * D_MODEL + c] + coef * dot_bf(A + (size_t)m * K, Bt + (size_t)c * K, K);
        if (yout) { yout[(size_t)m * D_MODEL + c] = v; } else { h[(size_t)m * D_MODEL + c] = v; hb[(size_t)m * D_MODEL + c] = f2bf(v); s += v * v; }
    }
    if (!yout) rss_next[m] = s;
}

constexpr float QSCALE_F = 0.125f * 1.4426950408889634f;
__device__ inline void qconv_item(size_t i_, const float* qn, const float* qr, bf16_t* qnb, bf16_t* qrb) { qnb[i_] = f2bf(qn[i_] * QSCALE_F); qrb[i_] = f2bf(qr[i_] * QSCALE_F); }
__host__ __device__ inline size_t kimg_off(int kv, int d0) { return (size_t)(d0 >> 3) * 1024 + (size_t)kv * 16; }
__host__ __device__ inline size_t vimg_off(int kv, int d0) { return (size_t)(d0 >> 5) * 4096 + (size_t)(kv >> 3) * 512 + (size_t)(kv & 7) * 64 + (size_t)((d0 & 31) >> 3) * 16; }
__device__ inline void put_chunk(unsigned char* dst, const float* src) { bf16_t* d = (bf16_t*)dst; for (int k = 0; k < 8; ++k) d[k] = f2bf(src[k]); }
__device__ inline void kvimg_item(size_t i_, const float* out, const float* winrows, unsigned char* ksel, unsigned char* vsel, unsigned char* kwin, unsigned char* vwin) {
    const int c = (int)(i_ % 8), t = (int)((i_ / 8) % SEQ), g = (int)((i_ / (8 * (size_t)SEQ)) % N_KV), n = (int)(i_ / (8 * (size_t)SEQ * N_KV));
    const size_t base = (((size_t)n * N_KV + g) * (SEQ / 64) + t / 64) * 8192; const int kv = t % 64, d0 = 8 * c; const size_t m = (size_t)n * SEQ + t;
    put_chunk(ksel + base + kimg_off(kv, d0), out + O_KVP + ((m * 4 + 2) * N_KV + g) * HD + d0);
    put_chunk(vsel + base + vimg_off(kv, d0), out + O_KVP + ((m * 4 + 3) * N_KV + g) * HD + d0);
    put_chunk(kwin + base + kimg_off(kv, d0), winrows + ((m * 2 + 0) * N_KV + g) * HD + d0);
    put_chunk(vwin + base + vimg_off(kv, d0), winrows + ((m * 2 + 1) * N_KV + g) * HD + d0);
}
__device__ inline void kcimg_item(size_t i_, const float* kc, const float* vc, unsigned char* kci, unsigned char* vci) {
    const int c = (int)(i_ % 8), cb = (int)((i_ / 8) % NBC_P), g = (int)((i_ / (8 * (size_t)NBC_P)) % N_KV), n = (int)(i_ / (8 * (size_t)NBC_P * N_KV));
    const size_t base = (((size_t)n * N_KV + g) * (NBC_P / 64) + cb / 64) * 8192; const int kv = cb % 64, d0 = 8 * c;
    put_chunk(kci + base + kimg_off(kv, d0), kc + (((size_t)n * NBC_MAX + cb) * N_KV + g) * HD + d0);
    put_chunk(vci + base + vimg_off(kv, d0), vc + (((size_t)n * NBC_MAX + cb) * N_KV + g) * HD + d0);
}

constexpr int NBC_PAST = PAST_LEN / L_CMP;
constexpr int RS_CMP = DEC_BATCH * NBC_PAST * N_KV, RP_CMP = BATCH * NBC_P * N_KV;
__device__ inline void acmp_sample_item(size_t i_, const float* cache_kv, const int* page_table, const float* pe, bf16_t* A) {
    const int c8 = (int)(i_ % 8), l = (int)((i_ / 8) % L_CMP); const size_t rr = i_ / (8 * L_CMP); const int r = (int)(rr % RS_CMP), e = (int)(rr / RS_CMP);
    const int g = r % N_KV, c = (r / N_KV) % NBC_PAST, b = r / (N_KV * NBC_PAST), tok = c * L_CMP + l;
    const int page = page_table[b * N_PAGES + tok / PAGE_SIZE];
    const float* src = cache_kv + ((((size_t)page * PAGE_SIZE + tok % PAGE_SIZE) * 4 + e) * N_KV + g) * HD + 8 * c8; const float* pp = pe + ((size_t)e * L_CMP + l) * HD + 8 * c8;
    bf16_t* d = A + ((size_t)e * RS_CMP + r) * (L_CMP * HD) + l * HD + 8 * c8;
    for (int k = 0; k < 8; ++k) d[k] = f2bf(src[k] + pp[k]);
}
__device__ inline void acmp_prompt_item(size_t i_, const float* out, const float* pe, bf16_t* A) {
    const int c8 = (int)(i_ % 8), l = (int)((i_ / 8) % L_CMP); const size_t rr = i_ / (8 * L_CMP); const int r = (int)(rr % RP_CMP), e = (int)(rr / RP_CMP);
    const int g = r % N_KV, c = (r / N_KV) % NBC_P, n = r / (N_KV * NBC_P), tok = c * L_CMP + l;
    const float* src = out + O_KVP + ((((size_t)n * SEQ + tok) * 4 + e) * N_KV + g) * HD + 8 * c8; const float* pp = pe + ((size_t)e * L_CMP + l) * HD + 8 * c8;
    bf16_t* d = A + ((size_t)e * RP_CMP + r) * (L_CMP * HD) + l * HD + 8 * c8;
    for (int k = 0; k < 8; ++k) d[k] = f2bf(src[k] + pp[k]);
}
__device__ inline void cmp_out_b_item(size_t i_, const bf16_t* hid, int R, int nbc, int seq0, const float* w2, const float* k_norm0, float* kc, float* vc) {
    const int r = (int)(i_ % R), e = (int)(i_ / R); const int g = r % N_KV, c = (r / N_KV) % nbc, sq = r / (N_KV * nbc);
    const bf16_t* hr = hid + ((size_t)e * R + r) * CMP_HID;
    float v[HD];
    for (int d = 0; d < HD; ++d) v[d] = 0.f;
    for (int f = 0; f < CMP_HID; ++f) { const float hf = bf2f(hr[f]); const float* w = w2 + ((size_t)e * CMP_HID + f) * HD; for (int d = 0; d < HD; ++d) v[d] += hf * w[d]; }
    if (e == 0) head_norm(v, k_norm0);
    float* o = (e == 0 ? kc : vc) + (((size_t)(seq0 + sq) * NBC_MAX + c) * N_KV + g) * HD;
    for (int d = 0; d < HD; ++d) o[d] = v[d];
}
__host__ __device__ inline int heads_row(int hidx, int d) { return (hidx / 4) * 256 + 128 * (d / 32) + 32 * (hidx % 4) + (d % 32); }
__device__ inline void conv_state_store(float* out, int layer, int m, int ch, float u) {
    const RowInfo ri = row_info(m); const int L = seq_len(ri.seq);
    if (ri.t >= L - 2) { const int j = ri.t - (L - 2);
        if (ri.seq < BATCH) out[O_CP + (((size_t)layer * BATCH + ri.seq) * 2 + j) * D_MODEL + ch] = u;
        else out[O_CS + (((size_t)layer * DEC_BATCH + (ri.seq - BATCH)) * 2 + j) * D_MODEL + ch] = u; }
}
__device__ inline void ref_conv_in_item(size_t i_, const bf16_t* hb, const float* rss, const bf16_t* Bt, bf16_t* ub, bf16_t* bb, float* out, int layer) {
    const int m = (int)(i_ / D_MODEL), j = (int)(i_ % D_MODEL);
    const float rs = 1.0f / sqrtf(rss[m] / D_MODEL + EPS); const bf16_t* a = hb + (size_t)m * D_MODEL;
    const int nc = (j / 128) * 256 + (j % 128);
    const float c = rs * dot_bf(a, Bt + (size_t)nc * D_MODEL, D_MODEL), x = rs * dot_bf(a, Bt + (size_t)(nc + 128) * D_MODEL, D_MODEL), b = rs * dot_bf(a, Bt + (size_t)(2 * D_MODEL + j) * D_MODEL, D_MODEL);
    const float u = c * x; ub[i_] = f2bf(u); bb[i_] = f2bf(b); conv_state_store(out, layer, m, j, u);
}
__device__ inline void conv_thin_item(size_t i_, const bf16_t* ub, const bf16_t* bb, const float* state  , const float* wc  , bf16_t* zb) {
    const int m = (int)(i_ / D_MODEL), ch = (int)(i_ % D_MODEL);
    const RowInfo ri = row_info(m);
    const float u0 = bf2f(ub[i_]);
    float u1, u2;
    if (ri.t >= 1) u1 = bf2f(ub[i_ - D_MODEL]); else u1 = (ri.seq < BATCH) ? 0.f : state[((size_t)(ri.seq - BATCH) * 2 + 1) * D_MODEL + ch];
    if (ri.t >= 2) u2 = bf2f(ub[i_ - 2 * D_MODEL]); else if (ri.seq < BATCH) u2 = 0.f;
    else u2 = (ri.t == 1) ? state[((size_t)(ri.seq - BATCH) * 2 + 1) * D_MODEL + ch] : state[((size_t)(ri.seq - BATCH) * 2 + 0) * D_MODEL + ch];
    zb[i_] = f2bf(bf2f(bb[i_]) * (wc[ch] * u2 + wc[D_MODEL + ch] * u1 + wc[2 * D_MODEL + ch] * u0));
}
__device__ inline void ref_qg_item(size_t i_, const bf16_t* hb, const float* rss, const bf16_t* Bt, const float* q_norm, const float* rope, float* qn, float* qr) {
    const int m = (int)(i_ / N_HEADS), hh = (int)(i_ % N_HEADS);
    const float rs = 1.0f / sqrtf(rss[m] / D_MODEL + EPS); const bf16_t* a = hb + (size_t)m * D_MODEL;
    float v[HD]; for (int d = 0; d < HD; ++d) v[d] = rs * dot_bf(a, Bt + (size_t)heads_row(hh, d) * D_MODEL, D_MODEL);
    head_norm(v, q_norm);
    for (int d = 0; d < HD; ++d) qn[(size_t)m * HDM + hh * HD + d] = v[d];
    const float* rt = rope + (size_t)pos_index(row_info(m).pos) * 16;
    for (int f = 0; f < 8; ++f) { const float x1 = v[f], x2 = v[8 + f]; v[f] = x1 * rt[f] - x2 * rt[8 + f]; v[8 + f] = x2 * rt[f] + x1 * rt[8 + f]; }
    for (int d = 0; d < HD; ++d) qr[(size_t)m * HDM + hh * HD + d] = v[d];
}
__device__ inline void ref_gates_item(size_t i_, const bf16_t* hb, const float* rss, const bf16_t* Bt, float* gates) {
    const int m = (int)(i_ / (3 * N_HEADS)), j = (int)(i_ % (3 * N_HEADS));
    const float rs = 1.0f / sqrtf(rss[m] / D_MODEL + EPS);
    const float x = rs * dot_bf(hb + (size_t)m * D_MODEL, Bt + (size_t)(HDM + j) * D_MODEL, D_MODEL);
    gates[i_] = 1.0f / (1.0f + expf(-x));
}
__device__ inline void kv_store(float* out, float* winrows, int m, int e, int g, int d, float v) {
    const RowInfo ri = row_info(m);
    if (e < 4) { if (ri.seq < BATCH) out[O_KVP + (((size_t)m * 4 + e) * N_KV + g) * HD + d] = v; else out[O_KVS + (((size_t)(m - MP) * 4 + e) * N_KV + g) * HD + d] = v; }
    else { const int we = e - 4;
        winrows[(((size_t)m * 2 + we) * N_KV + g) * HD + d] = v;
        if (ri.seq < BATCH) { if (ri.t >= SEQ - WINDOW) out[O_WP + ((((size_t)ri.seq * WINDOW + (ri.t - (SEQ - WINDOW))) * 2 + we) * N_KV + g) * HD + d] = v; }
        else out[O_WS + ((((size_t)(ri.seq - BATCH) * WINDOW + (WINDOW - DEC_SEQ + ri.t)) * 2 + we) * N_KV + g) * HD + d] = v; }
}
__device__ inline void ref_kv_item(size_t i_, const bf16_t* hb, const float* rss, const bf16_t* Bt, const float* k_norm, const float* rope, float* out, float* winrows) {
    const int m = (int)(i_ / (6 * N_KV)), hidx = (int)(i_ % (6 * N_KV)), e = hidx / N_KV, g = hidx % N_KV;
    const float rs = 1.0f / sqrtf(rss[m] / D_MODEL + EPS); const bf16_t* a = hb + (size_t)m * D_MODEL;
    float v[HD]; for (int d = 0; d < HD; ++d) v[d] = rs * dot_bf(a, Bt + (size_t)heads_row(hidx, d) * D_MODEL, D_MODEL);
    if (e == 2 || e == 4) { head_norm(v, k_norm + (e == 2 ? 1 : 2) * HD);
        const float* rt = rope + (size_t)pos_index(row_info(m).pos) * 16;
        for (int f = 0; f < 8; ++f) { const float x1 = v[f], x2 = v[8 + f]; v[f] = x1 * rt[f] - x2 * rt[8 + f]; v[8 + f] = x2 * rt[f] + x1 * rt[8 + f]; } }
    for (int d = 0; d < HD; ++d) kv_store(out, winrows, m, e, g, d, v[d]);
}
#ifndef CPU_TEST
#define LAS __attribute__((address_space(3)))
#define XB_TMO      128
#define XB_XCNT(j)  (256  + 64 * (j))
#define XB_XSUB(j)  (1280 + 64 * (j))
#define XB_XGEN(j)  (2304 + 64 * (j))
#define XB_TOP      3328
#define XB_TOPGEN   3392
#define XCD_BAR_WORDS 3456
#define XB_SPIN_CAP (1u << 25)
typedef __attribute__((address_space(1))) unsigned GU;
__device__ __forceinline__ unsigned xb_ld(GU* p)              { return __hip_atomic_load(p, __ATOMIC_RELAXED, __HIP_MEMORY_SCOPE_AGENT); }
__device__ __forceinline__ unsigned xb_add(GU* p, unsigned v) { return __hip_atomic_fetch_add(p, v, __ATOMIC_RELAXED, __HIP_MEMORY_SCOPE_AGENT); }
__device__ __forceinline__ unsigned xb_xcc_id() { return (unsigned)__builtin_amdgcn_s_getreg((3 << 11) | 20) & 0xFu; }
#define XB_SPIN(cond, bar) do { unsigned _sp = 0; while (cond) { __builtin_amdgcn_s_sleep(1); \
    if ((++_sp & 255u) == 0u) { if (xb_ld(&(bar)[XB_TMO])) break; if (_sp > XB_SPIN_CAP) { (void)xb_add(&(bar)[XB_TMO], 1u); break; } } } } while (0)
struct XcdBarrier { GU* bar; unsigned x; volatile LAS unsigned* st; };
__device__ __forceinline__ XcdBarrier xcd_barrier_post(GU* bar, volatile LAS unsigned* st, const bool leader_thread) {
    XcdBarrier b; b.bar = bar; b.x = xb_xcc_id(); b.st = st;
    if (leader_thread) (void)xb_add(&bar[XB_XCNT(b.x)], 1u);
    return b;
}
__device__ __forceinline__ void xcd_barrier_complete(GU* bar, unsigned x, unsigned& nloc, unsigned& nx) {
    const unsigned G = gridDim.x * gridDim.y * gridDim.z;
    unsigned sum, cnt, mine, sp = 0u;
    for (;;) {
        sum = 0u; cnt = 0u; mine = 0u;
#pragma unroll
        for (unsigned j = 0; j < 16; ++j) { const unsigned c = xb_ld(&bar[XB_XCNT(j)]); sum += c; cnt += (c > 0u) ? 1u : 0u; mine = (j == x) ? c : mine; }
        if (sum == G) break;
        __builtin_amdgcn_s_sleep(1);
        if ((++sp & 255u) == 0u) { if (xb_ld(&bar[XB_TMO])) break; if (sp > XB_SPIN_CAP) { (void)xb_add(&bar[XB_TMO], 1u); break; } }
    }
    nloc = mine > 0u ? mine : 1u; nx = cnt > 0u ? cnt : 1u;
}
__device__ __forceinline__ void xcd_barrier(const XcdBarrier& b, const bool leader_thread) {
    asm volatile("s_waitcnt vmcnt(0)" ::: "memory");
    __syncthreads();
    if (leader_thread) {
        GU* bar = b.bar; unsigned bx = xb_xcc_id(); asm volatile("" : "+s"(bx));
        __builtin_amdgcn_s_waitcnt(0);
        unsigned nloc = b.st[0], nx = b.st[1];
        if (nloc == 0u) { xcd_barrier_complete(bar, bx, nloc, nx); b.st[0] = nloc; b.st[1] = nx; }
        const unsigned old = xb_add(&bar[XB_XSUB(bx)], 1u);
        const unsigned gen = old / nloc;
        if (old + 1u == (gen + 1u) * nloc) {
            __builtin_amdgcn_fence(__ATOMIC_RELEASE, "agent");
            asm volatile("s_waitcnt vmcnt(0)" ::: "memory");
            const unsigned og = xb_add(&bar[XB_TOP], 1u);
            const unsigned tg = og / nx;
            if (og + 1u == (tg + 1u) * nx) xb_add(&bar[XB_TOPGEN], 1u);
            else XB_SPIN(xb_ld(&bar[XB_TOPGEN]) == tg, bar);
            __builtin_amdgcn_fence(__ATOMIC_ACQUIRE, "agent");
            xb_add(&bar[XB_XGEN(bx)], 1u);
            asm volatile("s_waitcnt vmcnt(0)" ::: "memory");
        } else {
            XB_SPIN(xb_ld(&bar[XB_XGEN(bx)]) == gen, bar);
            __builtin_amdgcn_fence(__ATOMIC_ACQUIRE, "agent");
            asm volatile("s_waitcnt vmcnt(0)" ::: "memory");
        }
    }
    __syncthreads();
}

namespace pg8 {
#define PG8_LAS __attribute__((address_space(3)))
typedef unsigned short bf16_t;
typedef short bf16x8 __attribute__((ext_vector_type(8)));
typedef float f32x4 __attribute__((ext_vector_type(4)));
typedef unsigned u32x4 __attribute__((ext_vector_type(4)));
constexpr int BM = 256, BK = 64, HALF = 128, HTB = HALF * BK * 2  , STAGE_BYTES = 8 * HTB, NXCD = 8, WGM = 8;

__host__ __device__ __forceinline__ int lds_byte(int r, int c) { const int st = (r >> 4) * 2 + (c >> 5), rr = r & 15, cc = c & 31, ob = rr * 64 + cc * 2; return st * 1024 + (ob ^ (((ob >> 9) & 1) << 5)); }
__host__ __device__ __forceinline__ void stage_rc(int b, int& R, int& C) { const int st = b / 1024, sb = b % 1024, swz = sb ^ (((sb >> 9) & 1) << 5); R = (st >> 1) * 16 + swz / 64; C = (st & 1) * 32 + (swz % 64) / 2; }
__host__ __device__ __forceinline__ int perm32(int rho) { const int n = rho >> 4, i = rho & 15; return 8 * (i >> 2) + 4 * n + (i & 3); }

struct Unit { int pm, pn; };
struct Gemm { const bf16_t* A; const bf16_t* Bt; int M, N, K; };

struct StaticOrder {
    int nM, nN, nwg, G, c;
    __host__ __device__ void init(int M, int N, int G_, int c_) { nM = M / BM; nN = N / BM; nwg = nM * nN; G = G_; c = c_; }
    __host__ __device__ bool next(int i, Unit& u) const {
        const long L = (long)i * G + c; if (L >= nwg) return false;
        int wgid = (int)L; { const int q = nwg / NXCD, r = nwg % NXCD, xcd = wgid % NXCD, off = wgid / NXCD; wgid = (xcd < r ? xcd * (q + 1) : r * (q + 1) + (xcd - r) * q) + off; }
        const int nig = WGM * nN, gid = wgid / nig, fm = gid * WGM, gsz = (nM - fm) < WGM ? (nM - fm) : WGM;
        u.pm = fm + ((wgid % nig) % gsz); u.pn = (wgid % nig) / gsz; return true;
    }
    __device__ __forceinline__ void a_ready(const Unit&) const {}
    __device__ __forceinline__ void done(const Unit&) const {}
};

__device__ __forceinline__ unsigned cvt_pk_bf16(float lo, float hi) { unsigned r; asm volatile("v_cvt_pk_bf16_f32 %0, %1, %2" : "=v"(r) : "v"(lo), "v"(hi)); return r; }
template <class Epi, class Sched, bool ALIGN_EPI = false, bool SP2 = false>
__device__ __forceinline__ void gemm_phase(int wave_id_, PG8_LAS unsigned char* lds, const Gemm g, const Sched& S, const Epi& E) {
    int wid = wave_id_, lane = (int)lane_id_v(); asm volatile("" : "+s"(wid));
    const int tid = wid * 64 + lane, wr = wid >> 2, wc = wid & 3, fr = lane & 15, fq = lane >> 4;
    const int K = g.K, nt = K / BK;
    unsigned voffA[2], voffB[2];
#pragma unroll
    for (int i = 0; i < 2; ++i) { int R, C; stage_rc(tid * 16 + i * 8192, R, C); const int Rb = Epi::PERM ? ((R & ~31) + perm32(R & 31)) : R;
        voffA[i] = (unsigned)(R * K + C) * 2u; voffB[i] = (unsigned)(Rb * K + C) * 2u; }
    const size_t kstep = (size_t)(BK * 2);
    const size_t hstep = (size_t)HALF * K * 2;
    const size_t tstep = 2 * hstep;
    const unsigned ldsw = (unsigned)wid * 1024u;
    const int aoff = lds_byte(wr * 64 + fr, fq * 8), boff = lds_byte(wc * 32 + fr, fq * 8);
#define PG8_SA(b, h) (((b) * 2 + (h)) * HTB)
#define PG8_SB(b, h) ((4 + (b) * 2 + (h)) * HTB)
#define PG8_STAGE(bufoff, gbase, voff) do { _Pragma("unroll") for (int _i = 0; _i < 2; ++_i) \
        __builtin_amdgcn_global_load_lds((const unsigned*)((const char*)(gbase) + (voff)[_i]), (PG8_LAS unsigned*)(lds + (bufoff) + ldsw + _i * 8192), 16, 0, 0); } while (0)
#define PG8_LDA(dst, b, h) do { _Pragma("unroll") for (int m = 0; m < 4; ++m) _Pragma("unroll") for (int k = 0; k < 2; ++k) dst[m][k] = *(const PG8_LAS bf16x8*)(lds + PG8_SA(b, h) + aoff + m * 2048 + k * 1024); } while (0)
#define PG8_LDB(dst, b, h) do { _Pragma("unroll") for (int n = 0; n < 2; ++n) _Pragma("unroll") for (int k = 0; k < 2; ++k) dst[n][k] = *(const PG8_LAS bf16x8*)(lds + PG8_SB(b, h) + boff + n * 2048 + k * 1024); } while (0)
#define PG8_MMA(ai, bj, At, Bt) do { __builtin_amdgcn_s_setprio(1); _Pragma("unroll") for (int m = 0; m < 4; ++m) _Pragma("unroll") for (int n = 0; n < 2; ++n) _Pragma("unroll") for (int k = 0; k < 2; ++k) \
        acc[ai][bj][m][n] = __builtin_amdgcn_mfma_f32_16x16x32_bf16(Bt[n][k], At[m][k], acc[ai][bj][m][n], 0, 0, 0); __builtin_amdgcn_s_setprio(0); } while (0)
#define PG8_WAIT_V(n) asm volatile("s_waitcnt vmcnt(" #n ")" ::: "memory")
#define PG8_WAIT_L(n) asm volatile("s_waitcnt lgkmcnt(" #n ")" ::: "memory")
#define PG8_BAR __builtin_amdgcn_s_barrier()
#define PG8_SCHED __builtin_amdgcn_sched_barrier(0)
    Unit cur, nxt; int ui = 0;
    if (!S.next(0, cur)) return;
    f32x4 acc[2][2][4][2];
#pragma unroll
    for (int a = 0; a < 2; ++a)
#pragma unroll
        for (int b = 0; b < 2; ++b)
#pragma unroll
            for (int m = 0; m < 4; ++m)
#pragma unroll
                for (int n = 0; n < 2; ++n) acc[a][b][m][n] = (f32x4){0.f, 0.f, 0.f, 0.f};
    bf16x8 At[4][2], B0[2][2], B1[2][2];
    const char* cA = (const char*)g.A + (size_t)cur.pm * tstep; const char* cB = (const char*)g.Bt + (size_t)cur.pn * tstep;
    S.a_ready(cur);
    if constexpr (SP2) {
        PG8_STAGE(PG8_SB(0, 0), cB, voffB); PG8_STAGE(PG8_SB(0, 1), cB + hstep, voffB); PG8_STAGE(PG8_SA(0, 0), cA, voffA); PG8_STAGE(PG8_SA(0, 1), cA + hstep, voffA);
        if (wr == 1) PG8_BAR;
        PG8_WAIT_V(2); PG8_BAR;
        PG8_STAGE(PG8_SB(1, 0), cB + kstep, voffB); PG8_STAGE(PG8_SA(1, 0), cA + kstep, voffA); PG8_STAGE(PG8_SB(1, 1), cB + hstep + kstep, voffB);
        PG8_WAIT_V(6); PG8_BAR;
    } else {
        PG8_STAGE(PG8_SB(0, 0), cB, voffB); PG8_STAGE(PG8_SA(0, 0), cA, voffA); PG8_STAGE(PG8_SB(0, 1), cB + hstep, voffB); PG8_STAGE(PG8_SA(0, 1), cA + hstep, voffA);
        if (wr == 1) PG8_BAR;
        PG8_WAIT_V(4); PG8_BAR;
        PG8_STAGE(PG8_SB(1, 0), cB + kstep, voffB); PG8_STAGE(PG8_SA(1, 0), cA + kstep, voffA); PG8_STAGE(PG8_SB(1, 1), cB + hstep + kstep, voffB);
        PG8_WAIT_V(6); PG8_BAR;
    }
    for (;;) {
        const bool has_next = S.next(ui + 1, nxt);
        const char* nA = has_next ? (const char*)g.A + (size_t)nxt.pm * tstep : cA; const char* nB = has_next ? (const char*)g.Bt + (size_t)nxt.pn * tstep : cB;
        for (int t = 0; t < nt; t += 2) {
            const bool last = (t == nt - 2);
            const char* a1 = cA + (size_t)(t + 1) * kstep;
            const char* a2 = last ? nA : cA + (size_t)(t + 2) * kstep; const char* b2 = last ? nB : cB + (size_t)(t + 2) * kstep;
            const char* a3 = a2 + kstep; const char* b3 = b2 + kstep;
            if (last && has_next) S.a_ready(nxt);
            if constexpr (SP2) {
            PG8_LDB(B0, 0, 0); PG8_LDB(B1, 0, 1); PG8_SCHED; PG8_LDA(At, 0, 0); PG8_STAGE(PG8_SA(1, 1), a1 + hstep, voffA);
            PG8_WAIT_V(8); PG8_WAIT_L(0); PG8_BAR; PG8_MMA(0, 0, At, B0); PG8_MMA(0, 1, At, B1); PG8_BAR; PG8_SCHED;
            PG8_LDA(At, 0, 1); PG8_STAGE(PG8_SB(0, 0), b2, voffB); PG8_STAGE(PG8_SB(0, 1), b2 + hstep, voffB); PG8_STAGE(PG8_SA(0, 0), a2, voffA);
            PG8_WAIT_V(8); PG8_WAIT_L(0); PG8_BAR; PG8_MMA(1, 0, At, B0); PG8_MMA(1, 1, At, B1); PG8_BAR; PG8_SCHED;
            PG8_LDB(B0, 1, 0); PG8_LDB(B1, 1, 1); PG8_SCHED; PG8_LDA(At, 1, 0); PG8_STAGE(PG8_SA(0, 1), a2 + hstep, voffA);
            PG8_WAIT_V(8); PG8_WAIT_L(0); PG8_BAR; PG8_MMA(0, 0, At, B0); PG8_MMA(0, 1, At, B1); PG8_BAR; PG8_SCHED;
            PG8_LDA(At, 1, 1); PG8_STAGE(PG8_SB(1, 0), b3, voffB); PG8_STAGE(PG8_SB(1, 1), b3 + hstep, voffB); PG8_STAGE(PG8_SA(1, 0), a3, voffA);
            PG8_WAIT_V(8); PG8_WAIT_L(0); PG8_BAR; PG8_MMA(1, 0, At, B0); PG8_MMA(1, 1, At, B1); PG8_BAR; PG8_SCHED;
            } else {
            PG8_LDB(B0, 0, 0); PG8_SCHED; PG8_LDA(At, 0, 0); PG8_STAGE(PG8_SA(1, 1), a1 + hstep, voffA);
            PG8_WAIT_L(8); PG8_BAR; PG8_WAIT_L(0); PG8_MMA(0, 0, At, B0); PG8_BAR; PG8_SCHED;
            PG8_LDB(B1, 0, 1); PG8_STAGE(PG8_SB(0, 0), b2, voffB);
            PG8_BAR; PG8_WAIT_L(0); PG8_MMA(0, 1, At, B1); PG8_BAR;
            PG8_LDA(At, 0, 1); PG8_STAGE(PG8_SA(0, 0), a2, voffA);
            PG8_BAR; PG8_WAIT_L(0); PG8_MMA(1, 0, At, B0); PG8_BAR; PG8_SCHED;
            PG8_STAGE(PG8_SB(0, 1), b2 + hstep, voffB);
            PG8_WAIT_V(6); PG8_BAR; PG8_MMA(1, 1, At, B1); PG8_BAR;
            PG8_LDB(B0, 1, 0); PG8_SCHED; PG8_LDA(At, 1, 0); PG8_STAGE(PG8_SA(0, 1), a2 + hstep, voffA);
            PG8_WAIT_L(8); PG8_BAR; PG8_WAIT_L(0); PG8_MMA(0, 0, At, B0); PG8_BAR; PG8_SCHED;
            PG8_LDB(B1, 1, 1); PG8_STAGE(PG8_SB(1, 0), b3, voffB);
            PG8_BAR; PG8_WAIT_L(0); PG8_MMA(0, 1, At, B1); PG8_BAR;
            PG8_LDA(At, 1, 1); PG8_STAGE(PG8_SA(1, 0), a3, voffA);
            PG8_BAR; PG8_WAIT_L(0); PG8_MMA(1, 0, At, B0); PG8_BAR; PG8_SCHED;
            PG8_STAGE(PG8_SB(1, 1), b3 + hstep, voffB);
            PG8_WAIT_V(6); PG8_BAR; PG8_MMA(1, 1, At, B1); PG8_BAR;
            }
        }
        if constexpr (ALIGN_EPI) { if (wr == 0) PG8_BAR; }
        if constexpr (!Epi::AFTER_DRAIN) { E(acc, cur, wr, wc, fr, fq); S.done(cur); }
        if (!has_next) break;
#pragma unroll
        for (int a = 0; a < 2; ++a)
#pragma unroll
            for (int b = 0; b < 2; ++b)
#pragma unroll
                for (int m = 0; m < 4; ++m)
#pragma unroll
                    for (int n = 0; n < 2; ++n) acc[a][b][m][n] = (f32x4){0.f, 0.f, 0.f, 0.f};
        cur = nxt; cA = nA; cB = nB; ++ui;
        if constexpr (ALIGN_EPI) { if (wr == 1) PG8_BAR; }
    }
    PG8_WAIT_V(0);
    if constexpr (!ALIGN_EPI) { if (wr == 0) PG8_BAR; }
    PG8_BAR;
    if constexpr (Epi::AFTER_DRAIN) { E.fused(acc, cur, wr, wc, fr, fq, lds, wid, lane); S.done(cur); }
#undef PG8_SA
#undef PG8_SB
#undef PG8_STAGE
#undef PG8_LDA
#undef PG8_LDB
#undef PG8_MMA
#undef PG8_WAIT_V
#undef PG8_WAIT_L
#undef PG8_BAR
#undef PG8_SCHED
}
}

namespace pg8 {
__device__ __forceinline__ float fast_silu(float g) { return g * __builtin_amdgcn_rcpf(1.0f + __expf(-g)); }
__device__ __forceinline__ float row_rs(const float* rss, int row) { return rsqrtf(rss[row] * (1.0f / D_MODEL) + EPS); }
struct EpiSwiglu {
    static constexpr bool PERM = true, AFTER_DRAIN = false;
    bf16_t* act; const float* rss;
    __device__ __forceinline__ void operator()(const f32x4 (&acc)[2][2][4][2], const Unit& u, int wr, int wc, int fr, int fq) const {
        const int row0 = u.pm * BM + wr * 64 + fr, col0 = u.pn * 128 + wc * 32 + 8 * fq;
#pragma unroll
        for (int ai = 0; ai < 2; ++ai)
#pragma unroll
            for (int m = 0; m < 4; ++m) {
                const int row = row0 + ai * HALF + m * 16; const float rs = row_rs(rss, row);
                float a[8];
#pragma unroll
                for (int n = 0; n < 2; ++n)
#pragma unroll
                    for (int i = 0; i < 4; ++i) a[n * 4 + i] = fast_silu(acc[ai][0][m][n][i] * rs) * (acc[ai][1][m][n][i] * rs);
                u32x4 w; w.x = cvt_pk_bf16(a[0], a[1]); w.y = cvt_pk_bf16(a[2], a[3]); w.z = cvt_pk_bf16(a[4], a[5]); w.w = cvt_pk_bf16(a[6], a[7]);
                *(u32x4*)(act + (size_t)row * D_FF + col0) = w;
            }
    }
};
struct EpiResid {
    static constexpr bool PERM = false, AFTER_DRAIN = false;
    float* h; bf16_t* hb; float* rss_next; float* yout; float coef;
    __device__ __forceinline__ void operator()(const f32x4 (&acc)[2][2][4][2], const Unit& u, int wr, int wc, int fr, int fq) const {
        const int row0 = u.pm * BM + wr * 64 + fr, col0 = u.pn * BM + wc * 32 + 4 * fq;
#pragma unroll
        for (int ai = 0; ai < 2; ++ai)
#pragma unroll
            for (int m = 0; m < 4; ++m) {
                const int row = row0 + ai * HALF + m * 16; float s = 0.f;
                float* hr = h + (size_t)row * D_MODEL + col0;
#pragma unroll
                for (int bj = 0; bj < 2; ++bj)
#pragma unroll
                    for (int n = 0; n < 2; ++n) {
                        const int co = bj * HALF + n * 16;
                        const f32x4 v = *(const f32x4*)(hr + co) + acc[ai][bj][m][n] * coef;
                        if (yout) { *(f32x4*)(yout + (size_t)row * D_MODEL + col0 + co) = v; }
                        else {
                            *(f32x4*)(hr + co) = v;
                            typedef unsigned u32x2 __attribute__((ext_vector_type(2)));
                            u32x2 w; w.x = cvt_pk_bf16(v[0], v[1]); w.y = cvt_pk_bf16(v[2], v[3]);
                            *(u32x2*)(hb + (size_t)row * D_MODEL + col0 + co) = w;
                            s += (v[0] * v[0] + v[1] * v[1]) + (v[2] * v[2] + v[3] * v[3]);
                        }
                    }
                if (!yout) { s += __shfl_xor(s, 16); s += __shfl_xor(s, 32); if (fq == 0) (void)__hip_atomic_fetch_add(rss_next + row, s, __ATOMIC_RELAXED, __HIP_MEMORY_SCOPE_AGENT); }
            }
    }
};
}
namespace pg8 {
__device__ __forceinline__ float sum4(f32x4 v) { return (v[0] * v[0] + v[1] * v[1]) + (v[2] * v[2] + v[3] * v[3]); }
struct EpiConvIn {
    static constexpr bool PERM = true, AFTER_DRAIN = false;
    bf16_t* ub; bf16_t* bb; const float* rss; float* out; int layer;
    __device__ __forceinline__ void operator()(const f32x4 (&acc)[2][2][4][2], const Unit& u, int wr, int wc, int fr, int fq) const {
        const int row0 = u.pm * BM + wr * 64 + fr;
        const bool pair = u.pn < D_MODEL / 128;
#pragma unroll
        for (int ai = 0; ai < 2; ++ai)
#pragma unroll
            for (int m = 0; m < 4; ++m) {
                const int row = row0 + ai * HALF + m * 16; const float rs = row_rs(rss, row);
                if (pair) {
                    const int col0 = u.pn * 128 + wc * 32 + 8 * fq; float a[8];
#pragma unroll
                    for (int n = 0; n < 2; ++n)
#pragma unroll
                        for (int i = 0; i < 4; ++i) a[n * 4 + i] = (acc[ai][0][m][n][i] * rs) * (acc[ai][1][m][n][i] * rs);
                    u32x4 w; w.x = cvt_pk_bf16(a[0], a[1]); w.y = cvt_pk_bf16(a[2], a[3]); w.z = cvt_pk_bf16(a[4], a[5]); w.w = cvt_pk_bf16(a[6], a[7]);
                    *(u32x4*)(ub + (size_t)row * D_MODEL + col0) = w;
                    const RowInfo ri = row_info(row); const int jj = ri.t - (seq_len(ri.seq) - 2);
                    if (jj >= 0) {
                        float* cs = (ri.seq < BATCH) ? out + O_CP + (((size_t)layer * BATCH + ri.seq) * 2 + jj) * D_MODEL + col0 : out + O_CS + (((size_t)layer * DEC_BATCH + (ri.seq - BATCH)) * 2 + jj) * D_MODEL + col0;
                        *(f32x4*)(cs) = (f32x4){a[0], a[1], a[2], a[3]}; *(f32x4*)(cs + 4) = (f32x4){a[4], a[5], a[6], a[7]};
                    }
                } else {
#pragma unroll
                    for (int bj = 0; bj < 2; ++bj) {
                        const int col0 = (u.pn - D_MODEL / 128) * 256 + bj * HALF + wc * 32 + 8 * fq;
                        const f32x4 v0 = acc[ai][bj][m][0] * rs, v1 = acc[ai][bj][m][1] * rs;
                        u32x4 w; w.x = cvt_pk_bf16(v0[0], v0[1]); w.y = cvt_pk_bf16(v0[2], v0[3]); w.z = cvt_pk_bf16(v1[0], v1[1]); w.w = cvt_pk_bf16(v1[2], v1[3]);
                        *(u32x4*)(bb + (size_t)row * D_MODEL + col0) = w;
                    }
                }
                asm volatile("" ::: "memory");
            }
    }
};
__device__ __forceinline__ void head_norm_rope(f32x4 (&v)[2][2], const float* gain, const float* rt  , int fq, bool do_norm, bool do_rope, f32x4 (&rot0)[2]) {
    if (do_norm) {
        float ss = (sum4(v[0][0]) + sum4(v[0][1])) + (sum4(v[1][0]) + sum4(v[1][1]));
        ss += __shfl_xor(ss, 16); ss += __shfl_xor(ss, 32);
        const float r = rsqrtf(ss * (1.0f / HD) + EPS);
#pragma unroll
        for (int bj = 0; bj < 2; ++bj)
#pragma unroll
            for (int n = 0; n < 2; ++n) { const f32x4 g = *(const f32x4*)(gain + 32 * bj + 8 * fq + 4 * n); v[bj][n] = v[bj][n] * r * g; }
    }
    rot0[0] = v[0][0]; rot0[1] = v[0][1];
    if (do_rope) {
#pragma unroll
        for (int n = 0; n < 2; ++n) {
            f32x4 p;
#pragma unroll
            for (int i = 0; i < 4; ++i) p[i] = __shfl_xor(v[0][n][i], 16);
            const f32x4 c = *(const f32x4*)(rt + 4 * n), s = *(const f32x4*)(rt + 8 + 4 * n);
            if (fq == 0) rot0[n] = v[0][n] * c - p * s; else if (fq == 1) rot0[n] = v[0][n] * c + p * s;
        }
    }
}
struct EpiQG {
    static constexpr bool PERM = true, AFTER_DRAIN = false;
    float* qn; float* qr; float* gates; const float* rss; const float* q_norm; const float* rope;
    __device__ __forceinline__ void operator()(const f32x4 (&acc)[2][2][4][2], const Unit& u, int wr, int wc, int fr, int fq) const {
        const int row0 = u.pm * BM + wr * 64 + fr;
#pragma unroll
        for (int ai = 0; ai < 2; ++ai)
#pragma unroll
            for (int m = 0; m < 4; ++m) {
                const int row = row0 + ai * HALF + m * 16; const float rs = row_rs(rss, row);
                if (u.pn < N_HEADS / 4) {
                    const int hh = u.pn * 4 + wc;
                    f32x4 v[2][2] = {{acc[ai][0][m][0] * rs, acc[ai][0][m][1] * rs}, {acc[ai][1][m][0] * rs, acc[ai][1][m][1] * rs}}; f32x4 rot0[2];
                    head_norm_rope(v, q_norm, rope + (size_t)pos_index(row_info(row).pos) * 16, fq, true, true, rot0);
                    float* qnp = qn + (size_t)row * HDM + hh * HD + 8 * fq; float* qrp = qr + (size_t)row * HDM + hh * HD + 8 * fq;
                    *(f32x4*)(qnp) = v[0][0]; *(f32x4*)(qnp + 4) = v[0][1]; *(f32x4*)(qnp + 32) = v[1][0]; *(f32x4*)(qnp + 36) = v[1][1];
                    *(f32x4*)(qrp) = rot0[0]; *(f32x4*)(qrp + 4) = rot0[1]; *(f32x4*)(qrp + 32) = v[1][0]; *(f32x4*)(qrp + 36) = v[1][1];
                } else {
                    const int c0 = wc * 32 + 8 * fq;
#pragma unroll
                    for (int n = 0; n < 2; ++n)
#pragma unroll
                        for (int i = 0; i < 4; ++i) { const int c = c0 + 4 * n + i; if (c < 3 * N_HEADS) gates[(size_t)row * 3 * N_HEADS + c] = __builtin_amdgcn_rcpf(1.0f + __expf(-(acc[ai][0][m][n][i] * rs))); }
                }
                asm volatile("" ::: "memory");
            }
    }
};
struct EpiKV {
    static constexpr bool PERM = true, AFTER_DRAIN = false;
    float* out; float* winrows; const float* rss; const float* k_norm; const float* rope;
    __device__ __forceinline__ void operator()(const f32x4 (&acc)[2][2][4][2], const Unit& u, int wr, int wc, int fr, int fq) const {
        const int row0 = u.pm * BM + wr * 64 + fr;
        const int hidx = u.pn * 4 + wc, e = hidx / N_KV, g = hidx % N_KV; const bool nr = (e == 2 || e == 4);
#pragma unroll
        for (int ai = 0; ai < 2; ++ai)
#pragma unroll
            for (int m = 0; m < 4; ++m) {
                const int row = row0 + ai * HALF + m * 16; const float rs = row_rs(rss, row);
                const RowInfo ri = row_info(row);
                f32x4 v[2][2] = {{acc[ai][0][m][0] * rs, acc[ai][0][m][1] * rs}, {acc[ai][1][m][0] * rs, acc[ai][1][m][1] * rs}}; f32x4 rot0[2];
                head_norm_rope(v, k_norm + (e == 2 ? 1 : 2) * HD, rope + (size_t)pos_index(ri.pos) * 16, fq, nr, nr, rot0);
                float* d0; float* d1 = nullptr;
                if (e < 4) d0 = (ri.seq < BATCH) ? out + O_KVP + (((size_t)row * 4 + e) * N_KV + g) * HD : out + O_KVS + (((size_t)(row - MP) * 4 + e) * N_KV + g) * HD;
                else { const int we = e - 4; d0 = winrows + (((size_t)row * 2 + we) * N_KV + g) * HD;
                    if (ri.seq < BATCH) { if (ri.t >= SEQ - WINDOW) d1 = out + O_WP + ((((size_t)ri.seq * WINDOW + (ri.t - (SEQ - WINDOW))) * 2 + we) * N_KV + g) * HD; }
                    else d1 = out + O_WS + ((((size_t)(ri.seq - BATCH) * WINDOW + (WINDOW - DEC_SEQ + ri.t)) * 2 + we) * N_KV + g) * HD; }
                d0 += 8 * fq; *(f32x4*)(d0) = rot0[0]; *(f32x4*)(d0 + 4) = rot0[1]; *(f32x4*)(d0 + 32) = v[1][0]; *(f32x4*)(d0 + 36) = v[1][1];
                if (d1) { d1 += 8 * fq; *(f32x4*)(d1) = rot0[0]; *(f32x4*)(d1 + 4) = rot0[1]; *(f32x4*)(d1 + 32) = v[1][0]; *(f32x4*)(d1 + 36) = v[1][1]; }
                asm volatile("" ::: "memory");
            }
    }
};
}

namespace pg8 {
struct EpiGelu {
    static constexpr bool PERM = true, AFTER_DRAIN = false;
    bf16_t* hid;
    __device__ __forceinline__ void operator()(const f32x4 (&acc)[2][2][4][2], const Unit& u, int wr, int wc, int fr, int fq) const {
        const int row0 = u.pm * BM + wr * 64 + fr;
#pragma unroll
        for (int ai = 0; ai < 2; ++ai)
#pragma unroll
            for (int m = 0; m < 4; ++m) {
                const int row = row0 + ai * HALF + m * 16;
#pragma unroll
                for (int bj = 0; bj < 2; ++bj) {
                    float a[8];
#pragma unroll
                    for (int n = 0; n < 2; ++n)
#pragma unroll
                        for (int i = 0; i < 4; ++i) { const float x = acc[ai][bj][m][n][i]; a[n * 4 + i] = x * __builtin_amdgcn_rcpf(1.0f + __expf(-1.5957691216057308f * (x + 0.044715f * x * x * x))); }
                    u32x4 w; w.x = cvt_pk_bf16(a[0], a[1]); w.y = cvt_pk_bf16(a[2], a[3]); w.z = cvt_pk_bf16(a[4], a[5]); w.w = cvt_pk_bf16(a[6], a[7]);
                    *(u32x4*)(hid + (size_t)row * CMP_HID + bj * HALF + wc * 32 + 8 * fq) = w;
                }
            }
    }
};
struct CmpOrder {
    int nunits, per_e, G, c;
    __device__ bool next(int i, Unit& u) const { const int L = i * G + c; if (L >= nunits) return false; u.pm = L; u.pn = L / per_e; return true; }
    __device__ __forceinline__ void a_ready(const Unit&) const {}
    __device__ __forceinline__ void done(const Unit&) const {}
};
}
constexpr int LDS_RING_C = 131072;
namespace att {
typedef short bf16x8 __attribute__((ext_vector_type(8)));
typedef short s16x4 __attribute__((ext_vector_type(4)));
typedef float f32x16 __attribute__((ext_vector_type(16)));
typedef __attribute__((address_space(3))) unsigned char* ldsp;
constexpr int TILE_B = 8192;
constexpr int L_KB = 0, L_VB = 2 * TILE_B, L_IMP = 4 * TILE_B, L_SELM = L_IMP + 64 * 64 * 4, L_END = L_SELM + 64 * 8;
constexpr float NEGB = -1e30f;
constexpr float QSCALE = 0.125f * 1.4426950408889634f;
__device__ __forceinline__ int crow(int r, int hi) { return (r & 3) + 8 * (r >> 2) + 4 * hi; }
__device__ __forceinline__ void glds16(const void* gsrc, unsigned lds_dst) { unsigned keep;
    asm volatile("s_mov_b32 %0, m0\n\ts_mov_b32 m0, %2\n\ts_nop 0\n\tglobal_load_lds_dwordx4 %1, off\n\ts_mov_b32 m0, %0" : "=&s"(keep) : "v"(gsrc), "s"(lds_dst) : "memory"); }
__device__ __forceinline__ unsigned cvtpk(float lo, float hi) { unsigned r; asm volatile("v_cvt_pk_bf16_f32 %0, %1, %2" : "=v"(r) : "v"(lo), "v"(hi)); return r; }
__device__ __forceinline__ float halfmax(float m) { auto rr = __builtin_amdgcn_permlane32_swap(__float_as_uint(m), __float_as_uint(m), false, false); return fmaxf(__uint_as_float(rr[0]), __uint_as_float(rr[1])); }
__device__ __forceinline__ float halfsum(float m) { auto rr = __builtin_amdgcn_permlane32_swap(__float_as_uint(m), __float_as_uint(m), false, false); return __uint_as_float(rr[0]) + __uint_as_float(rr[1]); }
__device__ __forceinline__ s16x4 vtr(ldsp p) { typedef short v4i16_t __attribute__((ext_vector_type(4))); return __builtin_bit_cast(s16x4, __builtin_amdgcn_ds_read_tr16_b64_v4i16((__attribute__((address_space(3))) v4i16_t*)p)); }
#define ATT_BAR_L() asm volatile("s_waitcnt lgkmcnt(0)\n\ts_barrier" ::: "memory")
#define ATT_WAIT_BAR(N) asm volatile("s_waitcnt vmcnt(" #N ") lgkmcnt(0)\n\ts_barrier" ::: "memory")
__device__ __forceinline__ void dma_tile(const unsigned char* img, unsigned lds_dst, int wid, int lane) { glds16(img + wid * 1024 + lane * 16, (unsigned)__builtin_amdgcn_readfirstlane(lds_dst + wid * 1024)); }
__device__ __forceinline__ void qk(f32x16& p0, f32x16& p1, ldsp kbuf, const bf16x8 (&qf)[4], float cinit, int r32, int hi) {
    f32x16 c;
#pragma unroll
    for (int r = 0; r < 16; ++r) c[r] = cinit;
    p0 = c; p1 = c;
#pragma unroll
    for (int s = 0; s < 4; ++s) {
        const bf16x8 k0 = *(const __attribute__((address_space(3))) bf16x8*)(kbuf + (2 * s + hi) * 1024 + r32 * 16);
        const bf16x8 k1 = *(const __attribute__((address_space(3))) bf16x8*)(kbuf + (2 * s + hi) * 1024 + r32 * 16 + 512);
        p0 = __builtin_amdgcn_mfma_f32_32x32x16_bf16(k0, qf[s], p0, 0, 0, 0);
        p1 = __builtin_amdgcn_mfma_f32_32x32x16_bf16(k1, qf[s], p1, 0, 0, 0);
    }
}
__device__ __forceinline__ void pv(f32x16 (&o)[2], ldsp vbuf, const f32x16& p0, const f32x16& p1, int lane, int hi) {
    unsigned pk[4][4];
#pragma unroll
    for (int k = 0; k < 4; ++k) { pk[0][k] = cvtpk(p0[2 * k], p0[2 * k + 1]); pk[1][k] = cvtpk(p0[8 + 2 * k], p0[9 + 2 * k]); pk[2][k] = cvtpk(p1[2 * k], p1[2 * k + 1]); pk[3][k] = cvtpk(p1[8 + 2 * k], p1[9 + 2 * k]); }
    const int vp0 = ((lane >> 4) & 1) * 32 + (lane & 3) * 8 + (4 * hi + ((lane & 15) >> 2)) * 64;
#pragma unroll
    for (int d0 = 0; d0 < 2; ++d0)
#pragma unroll
        for (int s = 0; s < 4; ++s) {
            const s16x4 lo = vtr(vbuf + d0 * 4096 + s * 1024 + vp0), hh = vtr(vbuf + d0 * 4096 + s * 1024 + 512 + vp0);
            const bf16x8 vf = (bf16x8){lo[0], lo[1], lo[2], lo[3], hh[0], hh[1], hh[2], hh[3]};
            typedef unsigned u32x4 __attribute__((ext_vector_type(4)));
            const u32x4 pw = (u32x4){pk[s][0], pk[s][1], pk[s][2], pk[s][3]};
            o[d0] = __builtin_amdgcn_mfma_f32_32x32x16_bf16(vf, __builtin_bit_cast(bf16x8, pw), o[d0], 0, 0, 0);
        }
}
struct Run { float m, l; f32x16 o[2]; };
template <bool EMASK> __device__ __forceinline__ void tile_step(Run& R, ldsp kbuf, ldsp vbuf, const bf16x8 (&qf)[4], float cinit, int lo_b_, int hi_b_, int lane, int r32, int hi) {
    int lo_b = lo_b_ - 4 * hi, hi_b = hi_b_ - 4 * hi;
    if (EMASK) asm volatile("" : "+v"(lo_b), "+v"(hi_b));
    f32x16 p0, p1; qk(p0, p1, kbuf, qf, cinit, r32, hi);
    if (EMASK) {
#pragma unroll
        for (int r = 0; r < 16; ++r) { const int kc_ = (r & 3) + 8 * (r >> 2); if (kc_ < lo_b || kc_ > hi_b) p0[r] = NEGB; if (kc_ + 32 < lo_b || kc_ + 32 > hi_b) p1[r] = NEGB; }
    }
    float rm = fmaxf(p0[0], p1[0]);
#pragma unroll
    for (int r = 1; r < 16; ++r) rm = fmaxf(rm, fmaxf(p0[r], p1[r]));
    rm = halfmax(rm);
    const float mn = fmaxf(R.m, rm), alpha = __builtin_amdgcn_exp2f(R.m - mn);
    R.m = mn; R.l *= alpha;
#pragma unroll
    for (int r = 0; r < 16; ++r) { R.o[0][r] *= alpha; R.o[1][r] *= alpha; }
    float ls = 0.f;
#pragma unroll
    for (int r = 0; r < 16; ++r) {
        float e0 = __builtin_amdgcn_exp2f(p0[r] - mn), e1 = __builtin_amdgcn_exp2f(p1[r] - mn);
        if (EMASK) { const int kc_ = (r & 3) + 8 * (r >> 2); if (kc_ < lo_b || kc_ > hi_b) e0 = 0.f; if (kc_ + 32 < lo_b || kc_ + 32 > hi_b) e1 = 0.f; }
        p0[r] = e0; p1[r] = e1; ls += e0 + e1;
    }
    R.l += ls;
    pv(R.o, vbuf, p0, p1, lane, hi);
}
struct Tensors {
    const bf16_t* qn; const bf16_t* qr;
    const unsigned char* ksel; const unsigned char* vsel; const unsigned char* kwin; const unsigned char* vwin;
    const unsigned char* kc; const unsigned char* vc;
    const float* gates; bf16_t* ob;
};
template <bool SEL> __device__ __forceinline__ void branch(Run& R, const unsigned char* kimg, const unsigned char* vimg, int t0, int t1, int jdiag, unsigned long long selm, int iq,
                                                           const bf16x8 (&qf)[4], unsigned lds0, ldsp lds, int wid, int lane, int r32, int hi) {
    R.m = NEGB; R.l = 0.f;
#pragma unroll
    for (int r = 0; r < 16; ++r) { R.o[0][r] = 0.f; R.o[1][r] = 0.f; }
    dma_tile(kimg + (size_t)t0 * TILE_B, lds0 + L_KB, wid, lane); dma_tile(vimg + (size_t)t0 * TILE_B, lds0 + L_VB, wid, lane);
    for (int t = t0; t <= t1; ++t) {
        const int b = (t - t0) & 1;
        if (t < t1) { dma_tile(kimg + (size_t)(t + 1) * TILE_B, lds0 + L_KB + (b ^ 1) * TILE_B, wid, lane); dma_tile(vimg + (size_t)(t + 1) * TILE_B, lds0 + L_VB + (b ^ 1) * TILE_B, wid, lane); ATT_WAIT_BAR(2); }
        else ATT_WAIT_BAR(0);
        const float cinit = (!SEL || ((selm >> t) & 1ull)) ? 0.f : NEGB;
        const bool lowm = !SEL && (t == jdiag - 8);
        if (t == jdiag || lowm) tile_step<true>(R, lds + L_KB + b * TILE_B, lds + L_VB + b * TILE_B, qf, cinit, lowm ? iq : 0, (t == jdiag) ? iq : 63, lane, r32, hi);
        else tile_step<false>(R, lds + L_KB + b * TILE_B, lds + L_VB + b * TILE_B, qf, cinit, 0, 63, lane, r32, hi);
        ATT_BAR_L();
    }
}
__device__ __forceinline__ void load_q(bf16x8 (&qf)[4], const bf16_t* qrow, int hi) {
#pragma unroll
    for (int s = 0; s < 4; ++s) qf[s] = *(const bf16x8*)(qrow + 16 * s + 8 * hi);
}
__device__ __forceinline__ void unit(const Tensors& T, int n, int j, int g, ldsp lds, unsigned lds0, int wid, int lane) {
    const int r32 = lane & 31, hi = lane >> 5, ql = r32 >> 2, hq = r32 & 3, iq = 8 * wid + ql;
    const int row = n * SEQ + 64 * j + iq, head = g * HPG + hq, pos = 64 * j + iq;
    const size_t img_ng = ((size_t)n * N_KV + g);
    f32x16 oacc[2];
#pragma unroll
    for (int r = 0; r < 16; ++r) { oacc[0][r] = 0.f; oacc[1][r] = 0.f; }
    const float* gt = T.gates + (size_t)row * 3 * N_HEADS + head * 3;
    const float g_c = gt[0], g_s = gt[1], g_w = gt[2];
    bf16x8 qf[4];
    unsigned long long selm;
    {
        load_q(qf, T.qn + (size_t)row * HDM + head * HD, hi);
        const int ntc = (2 * j + 2 + 63) / 64;
        const unsigned char* kci = T.kc + img_ng * (NBC_P / 64) * TILE_B; const unsigned char* vci = T.vc + img_ng * (NBC_P / 64) * TILE_B;
        dma_tile(kci, lds0 + L_KB, wid, lane); dma_tile(vci, lds0 + L_VB, wid, lane);
        if (ntc > 1) { dma_tile(kci + TILE_B, lds0 + L_KB + TILE_B, wid, lane); dma_tile(vci + TILE_B, lds0 + L_VB + TILE_B, wid, lane); }
        ATT_WAIT_BAR(0);
        int cmax = ((pos + 1) >> 5) - 1 - 4 * hi;
        asm volatile("" : "+v"(cmax));
        f32x16 s0, s1, s2, s3;
        qk(s0, s1, lds + L_KB, qf, 0.f, r32, hi);
        if (ntc > 1) qk(s2, s3, lds + L_KB + TILE_B, qf, 0.f, r32, hi);
        else {
#pragma unroll
            for (int r = 0; r < 16; ++r) { s2[r] = NEGB; s3[r] = NEGB; }
        }
        float mx = NEGB;
#pragma unroll
        for (int r = 0; r < 16; ++r) { const int kv = (r & 3) + 8 * (r >> 2);
            if (kv > cmax) s0[r] = NEGB; if (kv + 32 > cmax) s1[r] = NEGB; if (kv + 64 > cmax) s2[r] = NEGB; if (kv + 96 > cmax) s3[r] = NEGB;
            mx = fmaxf(fmaxf(mx, fmaxf(s0[r], s1[r])), fmaxf(s2[r], s3[r])); }
        mx = halfmax(mx);
        float ls = 0.f;
#pragma unroll
        for (int r = 0; r < 16; ++r) { const int kv = (r & 3) + 8 * (r >> 2);
            s0[r] = (kv > cmax) ? 0.f : __builtin_amdgcn_exp2f(s0[r] - mx); s1[r] = (kv + 32 > cmax) ? 0.f : __builtin_amdgcn_exp2f(s1[r] - mx);
            s2[r] = (kv + 64 > cmax) ? 0.f : __builtin_amdgcn_exp2f(s2[r] - mx); s3[r] = (kv + 96 > cmax) ? 0.f : __builtin_amdgcn_exp2f(s3[r] - mx);
            ls += (s0[r] + s1[r]) + (s2[r] + s3[r]); }
        ls = halfsum(ls);
        const float inv = 1.0f / fmaxf(ls, 1e-30f);
#pragma unroll
        for (int r = 0; r < 16; ++r) { s0[r] *= inv; s1[r] *= inv; s2[r] *= inv; s3[r] *= inv; }
        __attribute__((address_space(3))) float* imp = (__attribute__((address_space(3))) float*)(lds + L_IMP) + iq * 64;
#pragma unroll
        for (int r = 0; r < 16; r += 2) { const int bl = crow(r, hi) >> 1;
            float v0 = s0[r] + s0[r + 1], v1 = s1[r] + s1[r + 1], v2 = s2[r] + s2[r + 1], v3 = s3[r] + s3[r + 1];
            v0 += __shfl_xor(v0, 1); v0 += __shfl_xor(v0, 2); v1 += __shfl_xor(v1, 1); v1 += __shfl_xor(v1, 2);
            v2 += __shfl_xor(v2, 1); v2 += __shfl_xor(v2, 2); v3 += __shfl_xor(v3, 1); v3 += __shfl_xor(v3, 2);
            if (hq == 0) { imp[bl] = v0; imp[16 + bl] = v1; imp[32 + bl] = v2; imp[48 + bl] = v3; } }
        Run Rc;
#pragma unroll
        for (int r = 0; r < 16; ++r) { Rc.o[0][r] = 0.f; Rc.o[1][r] = 0.f; }
        pv(Rc.o, lds + L_VB, s0, s1, lane, hi);
        if (ntc > 1) pv(Rc.o, lds + L_VB + TILE_B, s2, s3, lane, hi);
#pragma unroll
        for (int r = 0; r < 16; ++r) { oacc[0][r] += g_c * Rc.o[0][r]; oacc[1][r] += g_c * Rc.o[1][r]; }
        asm volatile("s_waitcnt lgkmcnt(0)" ::: "memory");
        __attribute__((address_space(3))) unsigned long long* selw = (__attribute__((address_space(3))) unsigned long long*)(lds + L_SELM);
        for (int qq = 0; qq < 8; ++qq) {
            const float v = ((__attribute__((address_space(3))) float*)(lds + L_IMP))[(8 * wid + qq) * 64 + lane];
            const bool valid = lane <= j, forced = (lane == 0) || (lane == j) || (lane == j - 1);
            const unsigned key = valid ? (forced ? 0x7f000000u : __float_as_uint(v) + 1u) : 0u;
            unsigned long long m;
            if (j + 1 <= N_SEL) m = __ballot(valid);
            else {
                unsigned Tt = 0u;
                for (int bit = 30; bit >= 0; --bit) { const unsigned cand = Tt | (1u << bit); if (__popcll(__ballot(key >= cand)) >= N_SEL) Tt = cand; }
                const unsigned long long gtm = __ballot(key > Tt), eqm = __ballot(key == Tt);
                const int need = N_SEL - __popcll(gtm);
                const bool pick = (key == Tt) && (__popcll(eqm & ((1ull << lane) - 1ull)) < need);
                m = gtm | __ballot(pick);
            }
            if (lane == 0) selw[8 * wid + qq] = m;
        }
        asm volatile("s_waitcnt lgkmcnt(0)" ::: "memory");
        selm = selw[iq];
        ATT_WAIT_BAR(0);
    }
    load_q(qf, T.qr + (size_t)row * HDM + head * HD, hi);
    {
        Run R; branch<true>(R, T.ksel + img_ng * (SEQ / 64) * TILE_B, T.vsel + img_ng * (SEQ / 64) * TILE_B, 0, j, j, selm, iq, qf, lds0, lds, wid, lane, r32, hi);
        const float sc = g_s / fmaxf(halfsum(R.l), 1e-30f);
#pragma unroll
        for (int r = 0; r < 16; ++r) { oacc[0][r] += sc * R.o[0][r]; oacc[1][r] += sc * R.o[1][r]; }
    }
    {
        Run R; branch<false>(R, T.kwin + img_ng * (SEQ / 64) * TILE_B, T.vwin + img_ng * (SEQ / 64) * TILE_B, j > 8 ? j - 8 : 0, j, j, 0ull, iq, qf, lds0, lds, wid, lane, r32, hi);
        const float sc = g_w / fmaxf(halfsum(R.l), 1e-30f);
#pragma unroll
        for (int r = 0; r < 16; ++r) { oacc[0][r] += sc * R.o[0][r]; oacc[1][r] += sc * R.o[1][r]; }
    }
    bf16_t* orow = T.ob + (size_t)row * HDM + head * HD;
#pragma unroll
    for (int d0 = 0; d0 < 2; ++d0)
#pragma unroll
        for (int rr = 0; rr < 4; ++rr) { typedef unsigned u32x2 __attribute__((ext_vector_type(2)));
            u32x2 w; w.x = cvtpk(oacc[d0][4 * rr], oacc[d0][4 * rr + 1]); w.y = cvtpk(oacc[d0][4 * rr + 2], oacc[d0][4 * rr + 3]);
            *(u32x2*)(orow + 32 * d0 + 8 * rr + 4 * hi) = w; }
}
__device__ __forceinline__ void phase(const Tensors& T, ldsp lds, int wid, int lane, int cu, int ncu) {
    const unsigned lds0 = (unsigned)(uintptr_t)lds;
    constexpr int NQB = SEQ / 64, NGRP = NQB / 4;
    for (int c = cu; c < BATCH * N_KV * NGRP; c += ncu) {
        const int ng = c / NGRP, s = c % NGRP, n = ng / N_KV, g = ng % N_KV;
        for (int k = 0; k < 4; ++k) { const int j = (k == 0) ? s : (k == 1) ? NQB / 2 - 1 - s : (k == 2) ? NQB / 2 + s : NQB - 1 - s; unit(T, n, j, g, lds, lds0, wid, lane); }
    }
}
}
namespace att {
constexpr int S_STAGE = 16384;
constexpr int S_XM = LDS_RING_C + 1024, S_XL = S_XM + 1024, S_IMP = S_XL + 1024, S_SELM = S_IMP + 8 * 128 * 4, S_END = S_SELM + 8 * 2 * 8;
struct STensors {
    const bf16_t* qn; const bf16_t* qr; const float* kc; const float* vc; const float* cache_kv; const int* page_table; const float* cache_win; const float* out; const float* winrows;
    const float* gates; bf16_t* ob;
};
typedef float f32x4_t __attribute__((ext_vector_type(4)));
__device__ __forceinline__ void stage_kv(ldsp kimg, ldsp vimg, const float* ksrc, const float* vsrc, int stride, int nrows, int lane) {
    typedef unsigned u32x4 __attribute__((ext_vector_type(4)));
    const int c = lane & 7;
#pragma unroll 1
    for (int ib = 0; ib < 8; ib += 4)
#pragma unroll
    for (int it = ib; it < ib + 4; ++it) {
        const int row = 8 * it + (lane >> 3);
        f32x4_t k0 = {0.f, 0.f, 0.f, 0.f}, k1 = k0, v0 = k0, v1 = k0;
        if (row < nrows) { const float* kp = ksrc + (size_t)row * stride + 8 * c; const float* vp = vsrc + (size_t)row * stride + 8 * c;
            k0 = *(const f32x4_t*)kp; k1 = *(const f32x4_t*)(kp + 4); v0 = *(const f32x4_t*)vp; v1 = *(const f32x4_t*)(vp + 4); }
        u32x4 kw, vw; kw.x = cvtpk(k0[0], k0[1]); kw.y = cvtpk(k0[2], k0[3]); kw.z = cvtpk(k1[0], k1[1]); kw.w = cvtpk(k1[2], k1[3]);
        vw.x = cvtpk(v0[0], v0[1]); vw.y = cvtpk(v0[2], v0[3]); vw.z = cvtpk(v1[0], v1[1]); vw.w = cvtpk(v1[2], v1[3]);
        *(__attribute__((address_space(3))) u32x4*)(kimg + c * 1024 + row * 16) = kw;
        *(__attribute__((address_space(3))) u32x4*)(vimg + (c >> 2) * 4096 + (row >> 3) * 512 + (row & 7) * 64 + (c & 3) * 16) = vw;
    }
    asm volatile("s_waitcnt lgkmcnt(0)" ::: "memory");
}
#define ATT_BAR_ALL() asm volatile("s_waitcnt vmcnt(0) lgkmcnt(0)\n\ts_barrier" ::: "memory")
__device__ __forceinline__ float merge_stats(ldsp lds, float m_own, float l_own_half, int wid, int r32, int hi) {
    __attribute__((address_space(3))) float* xm = (__attribute__((address_space(3))) float*)(lds + S_XM); __attribute__((address_space(3))) float* xl = (__attribute__((address_space(3))) float*)(lds + S_XL);
    const float l_own = halfsum(l_own_half);
    if (hi == 0) { xm[wid * 32 + r32] = m_own; xl[wid * 32 + r32] = l_own; }
    ATT_BAR_ALL();
    float M = NEGB;
#pragma unroll
    for (int w = 0; w < 8; ++w) M = fmaxf(M, xm[w * 32 + r32]);
    float L = 0.f;
#pragma unroll
    for (int w = 0; w < 8; ++w) L += __builtin_amdgcn_exp2f(xm[w * 32 + r32] - M) * xl[w * 32 + r32];
    const float wgt = __builtin_amdgcn_exp2f(m_own - M) / fmaxf(L, 1e-30f);
    ATT_BAR_ALL();
    return wgt;
}
__device__ __forceinline__ void sample_unit(const STensors& T, int b, int g, ldsp lds, int wid, int lane) {
    const int r32 = lane & 31, hi = lane >> 5, ql = r32 >> 2, hq = r32 & 3;
    const int row = MP + b * DEC_SEQ + ql, head = g * HPG + hq, seq = BATCH + b;
    ldsp kimg = lds + wid * S_STAGE, vimg = kimg + TILE_B;
    f32x16 oacc[2];
#pragma unroll
    for (int r = 0; r < 16; ++r) { oacc[0][r] = 0.f; oacc[1][r] = 0.f; }
    const float* gt = T.gates + (size_t)row * 3 * N_HEADS + head * 3;
    const float g_c = gt[0], g_s = gt[1], g_w = gt[2];
    bf16x8 qf[4];
    __attribute__((address_space(3))) float* xm = (__attribute__((address_space(3))) float*)(lds + S_XM); __attribute__((address_space(3))) float* xl = (__attribute__((address_space(3))) float*)(lds + S_XL);
    __attribute__((address_space(3))) float* imp = (__attribute__((address_space(3))) float*)(lds + S_IMP);
    __attribute__((address_space(3))) unsigned long long* selw = (__attribute__((address_space(3))) unsigned long long*)(lds + S_SELM);
    {
        load_q(qf, T.qn + (size_t)row * HDM + head * HD, hi);
        constexpr int NTC = NBC_PAST / 64;
        f32x16 p0, p1; const bool mine = wid < NTC;
        float rm = NEGB;
        if (mine) {
            const float* kcp = T.kc + (((size_t)seq * NBC_MAX + 64 * wid) * N_KV + g) * HD; const float* vcp = T.vc + (((size_t)seq * NBC_MAX + 64 * wid) * N_KV + g) * HD;
            stage_kv(kimg, vimg, kcp, vcp, N_KV * HD, 64, lane);
            qk(p0, p1, kimg, qf, 0.f, r32, hi);
#pragma unroll
            for (int r = 0; r < 16; ++r) rm = fmaxf(rm, fmaxf(p0[r], p1[r]));
            rm = halfmax(rm);
        }
        if (hi == 0) xm[wid * 32 + r32] = rm;
        ATT_BAR_ALL();
        float M = NEGB;
#pragma unroll
        for (int w = 0; w < 8; ++w) M = fmaxf(M, xm[w * 32 + r32]);
        float ls = 0.f;
        if (mine) {
#pragma unroll
            for (int r = 0; r < 16; ++r) { p0[r] = __builtin_amdgcn_exp2f(p0[r] - M); p1[r] = __builtin_amdgcn_exp2f(p1[r] - M); ls += p0[r] + p1[r]; }
            ls = halfsum(ls);
        }
        if (hi == 0) xl[wid * 32 + r32] = ls;
        ATT_BAR_ALL();
        float L = 0.f;
#pragma unroll
        for (int w = 0; w < 8; ++w) L += xl[w * 32 + r32];
        const float inv = 1.0f / fmaxf(L, 1e-30f);
        if (mine) {
#pragma unroll
            for (int r = 0; r < 16; ++r) { p0[r] *= inv; p1[r] *= inv; }
#pragma unroll
            for (int r = 0; r < 16; r += 2) { const int bl = crow(r, hi) >> 1;
                float v0 = p0[r] + p0[r + 1], v1 = p1[r] + p1[r + 1];
                v0 += __shfl_xor(v0, 1); v0 += __shfl_xor(v0, 2); v1 += __shfl_xor(v1, 1); v1 += __shfl_xor(v1, 2);
                if (hq == 0) { imp[ql * 128 + 32 * wid + bl] = v0; imp[ql * 128 + 32 * wid + 16 + bl] = v1; } }
            Run Rc;
#pragma unroll
            for (int r = 0; r < 16; ++r) { Rc.o[0][r] = 0.f; Rc.o[1][r] = 0.f; }
            pv(Rc.o, vimg, p0, p1, lane, hi);
#pragma unroll
            for (int r = 0; r < 16; ++r) { oacc[0][r] += g_c * Rc.o[0][r]; oacc[1][r] += g_c * Rc.o[1][r]; }
        }
        ATT_BAR_ALL();
    }
    {
        constexpr int NCAND = NBS_S - 1;
        const float v0 = imp[wid * 128 + lane], v1 = imp[wid * 128 + 64 + lane];
        const unsigned key0 = (lane == 0) ? 0x7f000000u : __float_as_uint(v0) + 1u;
        const unsigned key1 = (lane + 64 == NCAND - 1) ? 0x7f000000u : __float_as_uint(v1) + 1u;
        unsigned Tt = 0u;
        for (int bit = 30; bit >= 0; --bit) { const unsigned cand = Tt | (1u << bit); if (__popcll(__ballot(key0 >= cand)) + __popcll(__ballot(key1 >= cand)) >= N_SEL - 1) Tt = cand; }
        const unsigned long long gt0 = __ballot(key0 > Tt), gt1 = __ballot(key1 > Tt), eq0 = __ballot(key0 == Tt), eq1 = __ballot(key1 == Tt);
        const int need = (N_SEL - 1) - __popcll(gt0) - __popcll(gt1);
        const unsigned long long below = (1ull << lane) - 1ull;
        const bool pick0 = (key0 == Tt) && (__popcll(eq0 & below) < need);
        const bool pick1 = (key1 == Tt) && (__popcll(eq0) + __popcll(eq1 & below) < need);
        const unsigned long long m0 = gt0 | __ballot(pick0), m1 = gt1 | __ballot(pick1);
        if (lane == 0) { selw[wid * 2] = m0; selw[wid * 2 + 1] = m1; }
        ATT_BAR_ALL();
    }
    load_q(qf, T.qr + (size_t)row * HDM + head * HD, hi);
    {
        unsigned long long U0 = 0ull, U1 = 0ull;
#pragma unroll
        for (int q = 0; q < 8; ++q) { U0 |= selw[q * 2]; U1 |= selw[q * 2 + 1]; }
        U0 = __builtin_amdgcn_readfirstlane((unsigned)U0) | ((unsigned long long)__builtin_amdgcn_readfirstlane((unsigned)(U0 >> 32)) << 32);
        U1 = __builtin_amdgcn_readfirstlane((unsigned)U1) | ((unsigned long long)__builtin_amdgcn_readfirstlane((unsigned)(U1 >> 32)) << 32);
        const unsigned long long my0 = selw[ql * 2], my1 = selw[ql * 2 + 1];
        Run R; R.m = NEGB; R.l = 0.f;
#pragma unroll
        for (int r = 0; r < 16; ++r) { R.o[0][r] = 0.f; R.o[1][r] = 0.f; }
        int idx = 0;
        for (int half = 0; half < 2; ++half) {
            unsigned long long U = half ? U1 : U0;
            while (U) {
                const int bit = __builtin_ctzll(U); U &= U - 1ull;
                if ((idx++ & 7) != wid) continue;
                const int blk = 64 * half + bit;
                const int page = T.page_table[b * N_PAGES + (blk * L_SEL) / PAGE_SIZE];
                const float* base = T.cache_kv + (((size_t)page * PAGE_SIZE + (blk * L_SEL) % PAGE_SIZE) * 4) * N_KV * HD + g * HD;
                stage_kv(kimg, vimg, base + 2 * N_KV * HD, base + 3 * N_KV * HD, 4 * N_KV * HD, 64, lane);
                const bool selected = ((half ? my1 : my0) >> bit) & 1ull;
                tile_step<false>(R, kimg, vimg, qf, selected ? 0.f : NEGB, 0, 63, lane, r32, hi);
            }
        }
        if ((idx & 7) == wid) {
            const float* base = T.out + O_KVS + (((size_t)b * DEC_SEQ) * 4) * N_KV * HD + g * HD;
            stage_kv(kimg, vimg, base + 2 * N_KV * HD, base + 3 * N_KV * HD, 4 * N_KV * HD, DEC_SEQ, lane);
            tile_step<true>(R, kimg, vimg, qf, 0.f, 0, ql, lane, r32, hi);
        }
        const float wgt = merge_stats(lds, R.m, R.l, wid, r32, hi) * g_s;
#pragma unroll
        for (int r = 0; r < 16; ++r) { oacc[0][r] += wgt * R.o[0][r]; oacc[1][r] += wgt * R.o[1][r]; }
    }
    {
        Run R; R.m = NEGB; R.l = 0.f;
#pragma unroll
        for (int r = 0; r < 16; ++r) { R.o[0][r] = 0.f; R.o[1][r] = 0.f; }
        for (int t = wid; t < WINDOW / 64; t += 8) {
            const float* base = T.cache_win + (((size_t)b * WINDOW + 64 * t) * 2) * N_KV * HD + g * HD;
            stage_kv(kimg, vimg, base, base + N_KV * HD, 2 * N_KV * HD, 64, lane);
            if (t == 0) tile_step<true>(R, kimg, vimg, qf, 0.f, ql, 63, lane, r32, hi); else tile_step<false>(R, kimg, vimg, qf, 0.f, 0, 63, lane, r32, hi);
        }
        if (wid == 0) {
            const float* base = T.winrows + (((size_t)(MP + b * DEC_SEQ)) * 2) * N_KV * HD + g * HD;
            stage_kv(kimg, vimg, base, base + N_KV * HD, 2 * N_KV * HD, DEC_SEQ, lane);
            tile_step<true>(R, kimg, vimg, qf, 0.f, 0, ql, lane, r32, hi);
        }
        const float wgt = merge_stats(lds, R.m, R.l, wid, r32, hi) * g_w;
#pragma unroll
        for (int r = 0; r < 16; ++r) { oacc[0][r] += wgt * R.o[0][r]; oacc[1][r] += wgt * R.o[1][r]; }
    }
    {
        __attribute__((address_space(3))) float* mine = (__attribute__((address_space(3))) float*)(lds + wid * S_STAGE);
#pragma unroll
        for (int d0 = 0; d0 < 2; ++d0)
#pragma unroll
            for (int rr = 0; rr < 4; ++rr) *(__attribute__((address_space(3))) f32x4_t*)(mine + r32 * 64 + 32 * d0 + 8 * rr + 4 * hi) = (f32x4_t){oacc[d0][4 * rr], oacc[d0][4 * rr + 1], oacc[d0][4 * rr + 2], oacc[d0][4 * rr + 3]};
        ATT_BAR_ALL();
        const int tid = wid * 64 + lane, orow = tid >> 4, oc4 = (tid & 15) * 4;
        f32x4_t s = {0.f, 0.f, 0.f, 0.f};
#pragma unroll
        for (int w = 0; w < 8; ++w) s += *(const __attribute__((address_space(3))) f32x4_t*)((__attribute__((address_space(3))) float*)(lds + w * S_STAGE) + orow * 64 + oc4);
        typedef unsigned u32x2 __attribute__((ext_vector_type(2)));
        u32x2 wv; wv.x = cvtpk(s[0], s[1]); wv.y = cvtpk(s[2], s[3]);
        const int oq = orow >> 2, oh = orow & 3;
        *(u32x2*)(T.ob + (size_t)(MP + b * DEC_SEQ + oq) * HDM + (g * HPG + oh) * HD + oc4) = wv;
        ATT_BAR_ALL();
    }
}
__device__ __forceinline__ void sample_phase(const STensors& T, ldsp lds, int wid, int lane, int cu, int ncu) {
    for (int c = cu; c < DEC_BATCH * N_KV; c += ncu) sample_unit(T, c / N_KV, c % N_KV, lds, wid, lane);
}
}
#endif

#ifndef CPU_TEST
__device__ __forceinline__ size_t opaque_gtid(int wave) { int w = wave; asm volatile("" : "+s"(w)); unsigned t = blockIdx.x * NTHREADS + w * 64 + lane_id_v(); return (size_t)t; }
#define ITEM_LOOP(total) for (size_t i = opaque_gtid(wave_id); i < (size_t)(total); i += (size_t)gridDim.x * NTHREADS)
#else
#define ITEM_LOOP(total) _Pragma("omp parallel for schedule(dynamic, 64)") for (long long i = 0; i < (long long)(total); ++i)
#endif

struct Params {
    const float *x_prompt, *x_sample, *cache_kv, *cache_win, *state_conv; const int* page_table;
    const float *ffn_a_norm, *ffn_a_w_in, *ffn_a_w_out, *mix_norm, *ffn_b_norm, *ffn_b_w_in, *ffn_b_w_out, *conv_w_in, *conv_w, *conv_w_out, *kv_norm, *w_kv, *k_norm,
                *cmp_pe, *cmp_w1, *cmp_w2, *nsa_w_qg, *nsa_q_norm, *nsa_w_o;
    float* out; unsigned char* ws;
};
constexpr int LDS_RING = 131072, LDS_BAR_OFF = LDS_RING + 352, LDS_BYTES = 147456;

#ifndef CPU_TEST
typedef const __attribute__((address_space(4))) Params* KParamsPtr;
__device__ __forceinline__ KParamsPtr kparams_ptr() {
#if defined(__HIP_DEVICE_COMPILE__)
    KParamsPtr p = (KParamsPtr)__builtin_amdgcn_kernarg_segment_ptr(); asm volatile("" : "+s"(p)); return p;
#else
    return nullptr;
#endif
}
__device__ __forceinline__ Params load_params() {
#if defined(__HIP_DEVICE_COMPILE__)
    return *kparams_ptr();
#else
    return Params{};
#endif
}
__device__ __forceinline__ unsigned char* load_ws() {
#if defined(__HIP_DEVICE_COMPILE__)
    return kparams_ptr()->ws;
#else
    return nullptr;
#endif
}
#define KP const Params P = load_params()
__device__ __forceinline__ int opaque_s(int v) { asm volatile("" : "+s"(v)); return v; }
#define GRID_SYNC() do { XcdBarrier bar_; bar_.bar = (GU*)load_ws() + 1024; bar_.x = 0; bar_.st = (volatile LAS unsigned*)(lds + LDS_BAR_OFF); xcd_barrier(bar_, wave_id == 0 && lane_id_v() == 0u); } while (0)
__global__ void __launch_bounds__(NTHREADS, 2) mega(Params P_unused)
#else
static Params g_params;
#define KP const Params& P = g_params
#define GRID_SYNC() do {} while (0)
void mega(Params P_unused)
#endif
{
#ifndef CPU_TEST
    extern __shared__ __attribute__((aligned(16))) unsigned char lds[];
    const int wave_id = __builtin_amdgcn_readfirstlane((int)(threadIdx.x >> 6));
    if (threadIdx.x < 4) ((LAS unsigned*)(lds + LDS_BAR_OFF))[threadIdx.x] = 0u;
    __syncthreads();
    (void)xcd_barrier_post((GU*)load_ws() + 1024, (volatile LAS unsigned*)(lds + LDS_BAR_OFF), threadIdx.x == 0);
#define RING ((PG8_LAS unsigned char*)lds)
#else
    g_params = P_unused;
#endif
#define WS_F(f) ((float*)(P.ws + WSM.f))
#define WS_B(f) ((bf16_t*)(P.ws + WSM.f))
#define KVSRC KvSrc{P.cache_kv, P.page_table, P.out}
#define PH(total, call) do { { KP; ITEM_LOOP(total) call; } GRID_SYNC(); } while (0)
    for (int L = 0; L < DEPTH; ++L) {
        KP;
        ITEM_LOOP((size_t)2 * D_FF * (D_MODEL / 64)) wconv_item(i, P.ffn_a_w_in + (size_t)L * D_MODEL * 2 * D_FF, 2 * D_FF, P.ffn_a_norm + (size_t)L * D_MODEL, WS_B(w_ain) + (size_t)L * 2 * D_FF * D_MODEL, 2 * D_FF, D_MODEL, CM_PAIR, D_FF);
        ITEM_LOOP((size_t)D_MODEL * (D_FF / 64)) wconv_item(i, P.ffn_a_w_out + (size_t)L * D_FF * D_MODEL, D_MODEL, nullptr, WS_B(w_aout) + (size_t)L * D_MODEL * D_FF, D_MODEL, D_FF, CM_PLAIN, 0);
        ITEM_LOOP((size_t)2 * D_FF * (D_MODEL / 64)) wconv_item(i, P.ffn_b_w_in + (size_t)L * D_MODEL * 2 * D_FF, 2 * D_FF, P.ffn_b_norm + (size_t)L * D_MODEL, WS_B(w_bin) + (size_t)L * 2 * D_FF * D_MODEL, 2 * D_FF, D_MODEL, CM_PAIR, D_FF);
        ITEM_LOOP((size_t)D_MODEL * (D_FF / 64)) wconv_item(i, P.ffn_b_w_out + (size_t)L * D_FF * D_MODEL, D_MODEL, nullptr, WS_B(w_bout) + (size_t)L * D_MODEL * D_FF, D_MODEL, D_FF, CM_PLAIN, 0);
    }
    for (int L = 0; L < N_A; ++L) {
        KP;
        ITEM_LOOP((size_t)3 * D_MODEL * (D_MODEL / 64)) wconv_item(i, P.conv_w_in + (size_t)L * D_MODEL * 3 * D_MODEL, 3 * D_MODEL, P.mix_norm + (size_t)L * D_MODEL, WS_B(w_cin) + (size_t)L * 3 * D_MODEL * D_MODEL, 3 * D_MODEL, D_MODEL, CM_CONV, 0);
        ITEM_LOOP((size_t)D_MODEL * (D_MODEL / 64)) wconv_item(i, P.conv_w_out + (size_t)L * D_MODEL * D_MODEL, D_MODEL, nullptr, WS_B(w_cout) + (size_t)L * D_MODEL * D_MODEL, D_MODEL, D_MODEL, CM_PLAIN, 0);
    }
    for (int b = 0; b < N_B; ++b) {
        KP;
        ITEM_LOOP((size_t)QGP * (D_MODEL / 64)) wconv_item(i, P.nsa_w_qg + (size_t)b * D_MODEL * QGW, QGW, P.mix_norm + (size_t)(N_A + b) * D_MODEL, WS_B(w_qg) + (size_t)b * QGP * D_MODEL, QGP, D_MODEL, CM_HEADS, N_HEADS);
        ITEM_LOOP((size_t)D_MODEL * (HDM / 64)) wconv_item(i, P.nsa_w_o + (size_t)b * HDM * D_MODEL, D_MODEL, nullptr, WS_B(w_o) + (size_t)b * D_MODEL * HDM, D_MODEL, HDM, CM_PLAIN, 0);
    }
    { KP; ITEM_LOOP((size_t)KVW * (D_MODEL / 64)) wconv_item(i, P.w_kv, KVW, P.kv_norm, WS_B(w_kv), KVW, D_MODEL, CM_HEADS, 6 * N_KV); }
    { KP; ITEM_LOOP((size_t)NPOS * 8) rope_item(i, WS_F(rope)); }
    { KP; ITEM_LOOP(MT) hinit_item(i, P.x_prompt, P.x_sample, WS_F(h), WS_B(hb), WS_F(rss)); }
#ifndef CPU_TEST
    for (int e = 0; e < 2; ++e) { KP; ITEM_LOOP((size_t)CMP_HID * (L_CMP * HD / 64)) wconv_item(i, P.cmp_w1 + (size_t)e * L_CMP * HD * CMP_HID, CMP_HID, nullptr, WS_B(w1t) + (size_t)e * CMP_HID * L_CMP * HD, CMP_HID, L_CMP * HD, CM_PLAIN, 0); }
    { KP; ITEM_LOOP((size_t)2 * RS_CMP * L_CMP * 8) acmp_sample_item(i, P.cache_kv, P.page_table, P.cmp_pe, WS_B(acs)); }
#endif
    GRID_SYNC();
#ifndef CPU_TEST
    { KP; pg8::Gemm g{WS_B(acs), WS_B(w1t), 2 * RS_CMP, 2 * CMP_HID, L_CMP * HD}; pg8::CmpOrder So{2 * RS_CMP / 256, RS_CMP / 256, opaque_s((int)gridDim.x), opaque_s((int)blockIdx.x)};
      pg8::EpiGelu E{WS_B(hids)}; pg8::gemm_phase<pg8::EpiGelu, pg8::CmpOrder, true, true>(wave_id, RING, g, So, E); }
    GRID_SYNC();
    PH((size_t)2 * RS_CMP, cmp_out_b_item(i, WS_B(hids), RS_CMP, NBC_PAST, BATCH, P.cmp_w2, P.k_norm, WS_F(kc), WS_F(vc)));
#endif

#ifndef CPU_TEST
#define FFN_OPT(wi, wo, v_in, last) do { \
        { KP; pg8::Gemm g{WS_B(hb), WS_B(wi) + (size_t)layer * 2 * D_FF * D_MODEL, MT, 2 * D_FF, D_MODEL}; pg8::StaticOrder So; So.init(MT, 2 * D_FF, opaque_s((int)gridDim.x), opaque_s((int)blockIdx.x)); \
          pg8::EpiSwiglu E{WS_B(act), WS_F(rss) + (size_t)(v_in) * MT}; pg8::gemm_phase<pg8::EpiSwiglu, pg8::StaticOrder, true, true>(wave_id, RING, g, So, E); } \
        GRID_SYNC(); \
        { KP; pg8::Gemm g{WS_B(act), WS_B(wo) + (size_t)layer * D_MODEL * D_FF, MT, D_MODEL, D_FF}; pg8::StaticOrder So; So.init(MT, D_MODEL, opaque_s((int)gridDim.x), opaque_s((int)blockIdx.x)); \
          pg8::EpiResid E{WS_F(h), WS_B(hb), WS_F(rss) + (size_t)((v_in) + 1) * MT, (last) ? P.out + O_YP : nullptr, 0.5f}; pg8::gemm_phase<pg8::EpiResid, pg8::StaticOrder, true, true>(wave_id, RING, g, So, E); } \
        GRID_SYNC(); } while (0)
#else
#define FFN_OPT(wi, wo, v_in, last) do { KP; \
        ITEM_LOOP((size_t)MT * D_FF) ref_ffn_in_item(i, WS_B(hb), WS_F(rss) + (size_t)(v_in) * MT, WS_B(wi) + (size_t)layer * 2 * D_FF * D_MODEL, WS_B(act)); \
        ITEM_LOOP(MT) ref_resid_row_item(i, WS_B(act), D_FF, WS_B(wo) + (size_t)layer * D_MODEL * D_FF, 0.5f, WS_F(h), WS_B(hb), WS_F(rss) + (size_t)((v_in) + 1) * MT, (last) ? P.out + O_YP : nullptr); } while (0)
#endif
#ifndef CPU_TEST
#define GEMM_PH(EpiT, Aptr, Btptr, Nn, Kk, ...) do { { KP; pg8::Gemm g{Aptr, Btptr, MT, Nn, Kk}; pg8::StaticOrder So; So.init(MT, Nn, opaque_s((int)gridDim.x), opaque_s((int)blockIdx.x)); \
        pg8::EpiT E{__VA_ARGS__}; pg8::gemm_phase<pg8::EpiT, pg8::StaticOrder, true, true>(wave_id, RING, g, So, E); } GRID_SYNC(); } while (0)
#endif
    for (int layer = 0; layer < DEPTH; ++layer) {
        FFN_OPT(w_ain, w_aout, 3 * layer, false);
        const int v1 = 3 * layer + 1;
        if (layer < N_A) {
#ifndef CPU_TEST
            GEMM_PH(EpiConvIn, WS_B(hb), WS_B(w_cin) + (size_t)layer * 3 * D_MODEL * D_MODEL, 3 * D_MODEL, D_MODEL, WS_B(ub), WS_B(bb), WS_F(rss) + (size_t)v1 * MT, P.out, layer);
#else
            PH((size_t)MT * D_MODEL, ref_conv_in_item(i, WS_B(hb), WS_F(rss) + (size_t)v1 * MT, WS_B(w_cin) + (size_t)layer * 3 * D_MODEL * D_MODEL, WS_B(ub), WS_B(bb), P.out, layer));
#endif
            PH((size_t)MT * D_MODEL, conv_thin_item(i, WS_B(ub), WS_B(bb), P.state_conv + (size_t)layer * DEC_BATCH * 2 * D_MODEL, P.conv_w + (size_t)layer * 3 * D_MODEL, WS_B(zb)));
#ifndef CPU_TEST
            GEMM_PH(EpiResid, WS_B(zb), WS_B(w_cout) + (size_t)layer * D_MODEL * D_MODEL, D_MODEL, D_MODEL, WS_F(h), WS_B(hb), WS_F(rss) + (size_t)(v1 + 1) * MT, nullptr, 1.0f);
#else
            PH(MT, ref_resid_row_item(i, WS_B(zb), D_MODEL, WS_B(w_cout) + (size_t)layer * D_MODEL * D_MODEL, 1.0f, WS_F(h), WS_B(hb), WS_F(rss) + (size_t)(v1 + 1) * MT, nullptr));
#endif
        } else {
            const int b = layer - N_A;
#ifndef CPU_TEST
            GEMM_PH(EpiQG, WS_B(hb), WS_B(w_qg) + (size_t)b * QGP * D_MODEL, QGP, D_MODEL, WS_F(qn), WS_F(qr), WS_F(gates), WS_F(rss) + (size_t)v1 * MT, P.nsa_q_norm + (size_t)b * HD, WS_F(rope));
#else
            { KP; ITEM_LOOP((size_t)MT * N_HEADS) ref_qg_item(i, WS_B(hb), WS_F(rss) + (size_t)v1 * MT, WS_B(w_qg) + (size_t)b * QGP * D_MODEL, P.nsa_q_norm + (size_t)b * HD, WS_F(rope), WS_F(qn), WS_F(qr)); }
            PH((size_t)MT * 3 * N_HEADS, ref_gates_item(i, WS_B(hb), WS_F(rss) + (size_t)v1 * MT, WS_B(w_qg) + (size_t)b * QGP * D_MODEL, WS_F(gates)));
#endif
#ifndef CPU_TEST
            PH((size_t)MT * HDM, qconv_item(i, WS_F(qn), WS_F(qr), WS_B(qnb), WS_B(qrb)));
            { KP; att::Tensors T{WS_B(qnb), WS_B(qrb), P.ws + WSM.ksel, P.ws + WSM.vsel, P.ws + WSM.kwin, P.ws + WSM.vwin, P.ws + WSM.kci, P.ws + WSM.vci, WS_F(gates), WS_B(ob)};
              int wv = wave_id; asm volatile("" : "+s"(wv));
              att::phase(T, (att::ldsp)lds, wv, (int)lane_id_v(), opaque_s((int)blockIdx.x), opaque_s((int)gridDim.x)); }
            { KP; att::STensors T{WS_B(qnb), WS_B(qrb), WS_F(kc), WS_F(vc), P.cache_kv, P.page_table, P.cache_win, P.out, WS_F(winrows), WS_F(gates), WS_B(ob)};
              int wv = wave_id; asm volatile("" : "+s"(wv));
              att::sample_phase(T, (att::ldsp)lds, wv, (int)lane_id_v(), opaque_s((int)blockIdx.x), opaque_s((int)gridDim.x)); }
            GRID_SYNC();
#else
            PH((size_t)MT * N_HEADS, attn_cmp_item(i, WS_F(qn), WS_F(kc), WS_F(vc), WS_F(pbuf), WS_F(oc)));
            PH((size_t)MT * N_KV, topk_item(i, WS_F(pbuf), (int*)WS_F(sel), WS_F(scorebuf)));
            PH((size_t)MT * N_HEADS, attn_sel_item(i, KVSRC, WS_F(qr), (const int*)WS_F(sel), WS_F(os)));
            PH((size_t)MT * N_HEADS, attn_win_item(i, P.cache_win, WS_F(winrows), WS_F(qr), WS_F(gates), WS_F(oc), WS_F(os), WS_B(ob)));
#endif
#ifndef CPU_TEST
            GEMM_PH(EpiResid, WS_B(ob), WS_B(w_o) + (size_t)b * D_MODEL * HDM, D_MODEL, HDM, WS_F(h), WS_B(hb), WS_F(rss) + (size_t)(v1 + 1) * MT, nullptr, 1.0f);
#else
            PH(MT, ref_resid_row_item(i, WS_B(ob), HDM, WS_B(w_o) + (size_t)b * D_MODEL * HDM, 1.0f, WS_F(h), WS_B(hb), WS_F(rss) + (size_t)(v1 + 1) * MT, nullptr));
#endif
        }
        FFN_OPT(w_bin, w_bout, 3 * layer + 2, layer == DEPTH - 1);
        if (layer == N_A - 1) {
            const int v3 = 3 * layer + 3;
#ifndef CPU_TEST
            { KP; pg8::Gemm g{WS_B(hb), WS_B(w_kv), MT, KVW, D_MODEL}; pg8::StaticOrder So; So.init(MT, KVW, opaque_s((int)gridDim.x), opaque_s((int)blockIdx.x));
              pg8::EpiKV E{P.out, WS_F(winrows), WS_F(rss) + (size_t)v3 * MT, P.k_norm, WS_F(rope)}; pg8::gemm_phase<pg8::EpiKV, pg8::StaticOrder, true, true>(wave_id, RING, g, So, E); }
#else
            { KP; ITEM_LOOP((size_t)MT * 6 * N_KV) ref_kv_item(i, WS_B(hb), WS_F(rss) + (size_t)v3 * MT, WS_B(w_kv), P.k_norm, WS_F(rope), P.out, WS_F(winrows)); }
#endif
            PH((size_t)DEC_BATCH * (WINDOW - DEC_SEQ) * 2 * N_KV * HD, wincopy_item(i, P.cache_win, P.out));
#ifdef CPU_TEST
            PH((size_t)NSEQ * NBC_MAX * 2 * N_KV * CMP_HID, cmp_hid_item(i, KVSRC, P.cmp_pe, P.cmp_w1, WS_F(hid)));
            PH((size_t)NSEQ * NBC_MAX * 2 * N_KV, cmp_out_item(i, WS_F(hid), P.cmp_w2, P.k_norm, WS_F(kc), WS_F(vc)));
#else
            PH((size_t)2 * RP_CMP * L_CMP * 8, acmp_prompt_item(i, P.out, P.cmp_pe, WS_B(acp)));
            { KP; pg8::Gemm g{WS_B(acp), WS_B(w1t), 2 * RP_CMP, 2 * CMP_HID, L_CMP * HD}; pg8::CmpOrder So{2 * RP_CMP / 256, RP_CMP / 256, opaque_s((int)gridDim.x), opaque_s((int)blockIdx.x)};
              pg8::EpiGelu E{WS_B(hidp)}; pg8::gemm_phase<pg8::EpiGelu, pg8::CmpOrder, true, true>(wave_id, RING, g, So, E); }
            GRID_SYNC();
            PH((size_t)2 * RP_CMP, cmp_out_b_item(i, WS_B(hidp), RP_CMP, NBC_P, 0, P.cmp_w2, P.k_norm, WS_F(kc), WS_F(vc)));
            { KP; ITEM_LOOP((size_t)BATCH * N_KV * SEQ * 8) kvimg_item(i, P.out, WS_F(winrows), P.ws + WSM.ksel, P.ws + WSM.vsel, P.ws + WSM.kwin, P.ws + WSM.vwin); }
            PH((size_t)BATCH * N_KV * NBC_P * 8, kcimg_item(i, WS_F(kc), WS_F(vc), P.ws + WSM.kci, P.ws + WSM.vci));
#endif
        }
    }
}

extern "C" void kernel_launch(void* const* d_in, const int* in_sizes, int n_in, void* d_out, int out_size, void* d_ws, size_t ws_size, hipStream_t stream) {
    Params P{};
    P.x_prompt = (const float*)d_in[0]; P.x_sample = (const float*)d_in[1]; P.cache_kv = (const float*)d_in[2]; P.cache_win = (const float*)d_in[3];
    P.state_conv = (const float*)d_in[4]; P.page_table = (const int*)d_in[5]; P.ffn_a_norm = (const float*)d_in[6]; P.ffn_a_w_in = (const float*)d_in[7];
    P.ffn_a_w_out = (const float*)d_in[8]; P.mix_norm = (const float*)d_in[9]; P.ffn_b_norm = (const float*)d_in[10]; P.ffn_b_w_in = (const float*)d_in[11];
    P.ffn_b_w_out = (const float*)d_in[12]; P.conv_w_in = (const float*)d_in[13]; P.conv_w = (const float*)d_in[14]; P.conv_w_out = (const float*)d_in[15];
    P.kv_norm = (const float*)d_in[16]; P.w_kv = (const float*)d_in[17]; P.k_norm = (const float*)d_in[18]; P.cmp_pe = (const float*)d_in[19];
    P.cmp_w1 = (const float*)d_in[20]; P.cmp_w2 = (const float*)d_in[21]; P.nsa_w_qg = (const float*)d_in[22]; P.nsa_q_norm = (const float*)d_in[23];
    P.nsa_w_o = (const float*)d_in[24];
    P.out = (float*)d_out; P.ws = (unsigned char*)d_ws;
#ifndef CPU_TEST
    static int grid = 0;
    if (grid == 0) {
        int dev = 0, cus = 0, per_cu = 0;
        hipGetDevice(&dev); hipDeviceGetAttribute(&cus, hipDeviceAttributeMultiprocessorCount, dev);
        hipFuncSetAttribute((const void*)mega, hipFuncAttributeMaxDynamicSharedMemorySize, LDS_BYTES);
        hipOccupancyMaxActiveBlocksPerMultiprocessor(&per_cu, (const void*)mega, NTHREADS, LDS_BYTES);
        (void)hipGetLastError();
        grid = cus;
    }
    hipMemsetAsync(d_ws, 0, WS_ZERO_BYTES, stream);
    hipLaunchKernelGGL(mega, dim3(grid), dim3(NTHREADS), LDS_BYTES, stream, P);
#else
    memset(d_ws, 0, WS_ZERO_BYTES);
    mega(P);
#endif
}
```

```cpp
#ifdef CPU_TEST
#include "shim.h"
#else
#include <hip/hip_runtime.h>
#endif
#include <cstdint>
#include <cstddef>
#include <cmath>
#include <cstring>
typedef unsigned short bf16_t;
#ifndef CPU_TEST
#define HOSTDEV __host__ __device__
#else
#define HOSTDEV
#endif
HOSTDEV inline bf16_t f2bf(float f) { unsigned u; memcpy(&u, &f, 4); u = (u + 0x7fffu + ((u >> 16) & 1u)) >> 16; return (bf16_t)u; }
HOSTDEV inline float bf2f(bf16_t b) { unsigned u = (unsigned)b << 16; float f; memcpy(&f, &u, 4); return f; }

#ifdef CFG_SMALL
constexpr int D_MODEL = 256, BATCH = 1, SEQ = 2048, DEPTH = 4, DEC_BATCH = 2, DEC_SEQ = 8, PAST_LEN = 2048, PAGE_SIZE = 128, D_FF = 256, N_HEADS = 4, N_KV = 2;
#else
constexpr int D_MODEL = 1024, BATCH = 4, SEQ = 4096, DEPTH = 4, DEC_BATCH = 32, DEC_SEQ = 8, PAST_LEN = 8192, PAGE_SIZE = 128, D_FF = 2816, N_HEADS = 16, N_KV = 4;
#endif
constexpr int N_A = DEPTH / 2, N_B = DEPTH - N_A, HD = 64, HPG = N_HEADS / N_KV, L_CMP = 32, L_SEL = 64, N_SEL = 16, WINDOW = 512, CMP_HID = 4 * HD;
constexpr int MP = BATCH * SEQ, MS = DEC_BATCH * DEC_SEQ, MT = MP + MS, NSEQ = BATCH + DEC_BATCH;
constexpr int N_PAGES = PAST_LEN / PAGE_SIZE;
constexpr int KVW = 6 * N_KV * HD;
constexpr int QGW = N_HEADS * HD + 3 * N_HEADS;
constexpr int HDM = N_HEADS * HD;
constexpr int TPAD_S = ((PAST_LEN + DEC_SEQ + L_SEL - 1) / L_SEL) * L_SEL;
constexpr int NBC_P = SEQ / L_CMP, NBC_S = TPAD_S / L_CMP, NBC_MAX = NBC_S > NBC_P ? NBC_S : NBC_P;
constexpr int NBS_P = SEQ / L_SEL, NBS_S = TPAD_S / L_SEL, NBS_MAX = NBS_S > NBS_P ? NBS_S : NBS_P;
constexpr float EPS = 1e-6f, NEGF = -1e30f, TINYF = 1e-30f, FORCE_SCORE = 1e4f;
__device__ static const float INV_FREQ[8] = {1.0f, 0.1939227432012558f, 0.03760603070259094f, 0.007292664609849453f, 0.0014142135623842478f, 0.00027424818836152554f, 5.3182957344688475e-05f, 1.0313385246263351e-05f};

constexpr size_t O_YP = 0, O_YS = O_YP + (size_t)MP * D_MODEL, O_KVP = O_YS + (size_t)MS * D_MODEL, O_KVS = O_KVP + (size_t)MP * 4 * N_KV * HD,
                 O_WP = O_KVS + (size_t)MS * 4 * N_KV * HD, O_WS = O_WP + (size_t)BATCH * WINDOW * 2 * N_KV * HD, O_CP = O_WS + (size_t)DEC_BATCH * WINDOW * 2 * N_KV * HD,
                 O_CS = O_CP + (size_t)N_A * BATCH * 2 * D_MODEL, O_END = O_CS + (size_t)N_A * DEC_BATCH * 2 * D_MODEL;

struct RowInfo { int seq, t, pos; };
__device__ __host__ inline RowInfo row_info(int m) {
    RowInfo r;
    if (m < MP) { r.seq = m / SEQ; r.t = m % SEQ; r.pos = r.t; }
    else { const int q = m - MP; r.seq = BATCH + q / DEC_SEQ; r.t = q % DEC_SEQ; r.pos = PAST_LEN + r.t; }
    return r;
}
__device__ __host__ inline int seq_row0(int seq) { return seq < BATCH ? seq * SEQ : MP + (seq - BATCH) * DEC_SEQ; }
__device__ __host__ inline int seq_pos0(int seq) { return seq < BATCH ? 0 : PAST_LEN; }
__device__ __host__ inline int seq_len(int seq) { return seq < BATCH ? SEQ : DEC_SEQ; }

__device__ inline void copy_item(size_t i_, const float* a, float* b, size_t n) {
    const size_t i = i_;
    if (i < n) b[i] = a[i];
}
__device__ inline void rmsnorm_item(size_t i_, const float* x, const float* g, float* y, int rows, int d) {
    const int m = (int)i_;
    if (m >= rows) return;
    const float* xr = x + (size_t)m * d; float s = 0.f;
    for (int i = 0; i < d; ++i) s += xr[i] * xr[i];
    const float r = 1.0f / sqrtf(s / d + EPS);
    float* yr = y + (size_t)m * d;
    for (int i = 0; i < d; ++i) yr[i] = xr[i] * r * g[i];
}
__device__ inline void gemm_item(size_t i_, const float* A, int lda, const float* W, float* C, int M, int N, int K) {
    const int nbx = (N + 63) / 64; const int vb = (int)(i_ / 256), t_ = (int)(i_ % 256), tx = t_ % 16, ty = t_ / 16;
    const int c0 = (vb % nbx) * 64 + tx * 4, r0 = (vb / nbx) * 64 + ty * 4;
    if (c0 >= N || r0 >= M) return;
    float acc[4][4];
    for (int i = 0; i < 4; ++i) for (int j = 0; j < 4; ++j) acc[i][j] = 0.f;
    const int nr = (M - r0) < 4 ? (M - r0) : 4;
    for (int k = 0; k < K; k += 4) {
        float a[4][4], w[4][4];
        for (int i = 0; i < 4; ++i) for (int kk = 0; kk < 4; ++kk) a[i][kk] = (i < nr) ? A[(size_t)(r0 + i) * lda + k + kk] : 0.f;
        for (int kk = 0; kk < 4; ++kk) for (int j = 0; j < 4; ++j) w[kk][j] = W[(size_t)(k + kk) * N + c0 + j];
        for (int i = 0; i < 4; ++i) for (int kk = 0; kk < 4; ++kk) for (int j = 0; j < 4; ++j) acc[i][j] += a[i][kk] * w[kk][j];
    }
    for (int i = 0; i < nr; ++i) for (int j = 0; j < 4; ++j) C[(size_t)(r0 + i) * N + c0 + j] = acc[i][j];
}
__device__ inline void swiglu_item(size_t i_, const float* t1, float* act, int rows, int dff) {
    const size_t i = i_;
    if (i >= (size_t)rows * dff) return;
    const int m = (int)(i / dff), j = (int)(i % dff);
    const float g = t1[(size_t)m * 2 * dff + j], u = t1[(size_t)m * 2 * dff + dff + j];
    act[i] = g / (1.0f + expf(-g)) * u;
}
__device__ inline void axpy_item(size_t i_, float* h, const float* y, float coef, size_t n) {
    const size_t i = i_;
    if (i < n) h[i] += coef * y[i];
}
__device__ inline void conv_item(size_t i_, const float* t1, const float* state  , const float* wc  , float* z, float* out, int layer) {
    const size_t i = i_;
    if (i >= (size_t)MT * D_MODEL) return;
    const int m = (int)(i / D_MODEL), ch = (int)(i % D_MODEL);
    const RowInfo ri = row_info(m);
    const float* r = t1 + (size_t)m * 3 * D_MODEL;
    const float b = r[ch], u0 = r[D_MODEL + ch] * r[2 * D_MODEL + ch];
    float u1, u2;
    if (ri.t >= 1) { const float* p = r - 3 * D_MODEL; u1 = p[D_MODEL + ch] * p[2 * D_MODEL + ch]; }
    else u1 = (ri.seq < BATCH) ? 0.f : state[((size_t)(ri.seq - BATCH) * 2 + 1) * D_MODEL + ch];
    if (ri.t >= 2) { const float* p = r - 6 * D_MODEL; u2 = p[D_MODEL + ch] * p[2 * D_MODEL + ch]; }
    else if (ri.seq < BATCH) u2 = 0.f;
    else u2 = (ri.t == 1) ? state[((size_t)(ri.seq - BATCH) * 2 + 1) * D_MODEL + ch] : state[((size_t)(ri.seq - BATCH) * 2 + 0) * D_MODEL + ch];
    z[i] = b * (wc[ch] * u2 + wc[D_MODEL + ch] * u1 + wc[2 * D_MODEL + ch] * u0);
    const int L = seq_len(ri.seq);
    if (ri.t >= L - 2) {
        const int j = ri.t - (L - 2);
        if (ri.seq < BATCH) out[O_CP + (((size_t)layer * BATCH + ri.seq) * 2 + j) * D_MODEL + ch] = u0;
        else out[O_CS + (((size_t)layer * DEC_BATCH + (ri.seq - BATCH)) * 2 + j) * D_MODEL + ch] = u0;
    }
}
__device__ inline void head_norm(float* v, const float* g) {
    float s = 0.f; for (int d = 0; d < HD; ++d) s += v[d] * v[d];
    const float r = 1.0f / sqrtf(s / HD + EPS);
    for (int d = 0; d < HD; ++d) v[d] = v[d] * r * g[d];
}
__device__ inline void rope_cs(float ang, float& c, float& s) {
    const double r = (double)ang * 0.15915494309189535; const float fr = (float)(r - rint(r));
#ifdef CPU_TEST
    c = (float)cos(6.283185307179586 * (double)fr); s = (float)sin(6.283185307179586 * (double)fr);
#else
    c = __builtin_amdgcn_cosf(fr); s = __builtin_amdgcn_sinf(fr);
#endif
}
__device__ inline void head_rope(float* v, int pos) {
    for (int i = 0; i < 8; ++i) {
        const float ang = (float)pos * INV_FREQ[i]; float c, s; rope_cs(ang, c, s);
        const float x1 = v[i], x2 = v[8 + i];
        v[i] = x1 * c - x2 * s; v[8 + i] = x2 * c + x1 * s;
    }
}
__device__ inline void kvprep_item(size_t i_, const float* p, const float* k_norm  , float* out, float* winrows) {
    const int i = (int)i_;
    if (i >= MT * 6 * N_KV) return;
    const int m = i / (6 * N_KV), e = (i / N_KV) % 6, g = i % N_KV;
    const RowInfo ri = row_info(m);
    float v[HD];
    for (int d = 0; d < HD; ++d) v[d] = p[(size_t)m * KVW + (e * N_KV + g) * HD + d];
    if (e == 2) { head_norm(v, k_norm + HD); head_rope(v, ri.pos); }
    if (e == 4) { head_norm(v, k_norm + 2 * HD); head_rope(v, ri.pos); }
    if (e < 4) {
        float* o = (ri.seq < BATCH) ? out + O_KVP + (((size_t)m * 4 + e) * N_KV + g) * HD : out + O_KVS + (((size_t)(m - MP) * 4 + e) * N_KV + g) * HD;
        for (int d = 0; d < HD; ++d) o[d] = v[d];
    } else {
        const int we = e - 4;
        float* w = winrows + (((size_t)m * 2 + we) * N_KV + g) * HD;
        for (int d = 0; d < HD; ++d) w[d] = v[d];
        if (ri.seq < BATCH) { if (ri.t >= SEQ - WINDOW) { float* o = out + O_WP + ((((size_t)ri.seq * WINDOW + (ri.t - (SEQ - WINDOW))) * 2 + we) * N_KV + g) * HD; for (int d = 0; d < HD; ++d) o[d] = v[d]; } }
        else { float* o = out + O_WS + ((((size_t)(ri.seq - BATCH) * WINDOW + (WINDOW - DEC_SEQ + ri.t)) * 2 + we) * N_KV + g) * HD; for (int d = 0; d < HD; ++d) o[d] = v[d]; }
    }
}
__device__ inline void wincopy_item(size_t i_, const float* cache_win, float* out) {
    const size_t i = i_;
    const size_t per = (size_t)(WINDOW - DEC_SEQ) * 2 * N_KV * HD;
    if (i >= (size_t)DEC_BATCH * per) return;
    const size_t b = i / per, r = i % per;
    out[O_WS + b * WINDOW * 2 * N_KV * HD + r] = cache_win[b * WINDOW * 2 * N_KV * HD + (size_t)DEC_SEQ * 2 * N_KV * HD + r];
}
struct KvSrc { const float* cache_kv; const int* page_table; const float* out; };
__device__ inline const float* kv_full_ptr(const KvSrc& S, int seq, int tok, int e, int g) {
    if (seq < BATCH) return S.out + O_KVP + ((((size_t)seq * SEQ + tok) * 4 + e) * N_KV + g) * HD;
    const int b = seq - BATCH;
    if (tok < PAST_LEN) { const int page = S.page_table[b * N_PAGES + tok / PAGE_SIZE]; return S.cache_kv + ((((size_t)page * PAGE_SIZE + tok % PAGE_SIZE) * 4 + e) * N_KV + g) * HD; }
    if (tok < PAST_LEN + DEC_SEQ) return S.out + O_KVS + ((((size_t)b * DEC_SEQ + (tok - PAST_LEN)) * 4 + e) * N_KV + g) * HD;
    return nullptr;
}
__device__ inline int seq_nbc(int seq) { return seq < BATCH ? NBC_P : NBC_S; }
__device__ inline void cmp_hid_item(size_t i_, KvSrc S, const float* pe  , const float* w1  , float* hid) {
    const size_t i = i_;
    if (i >= (size_t)NSEQ * NBC_MAX * 2 * N_KV * CMP_HID) return;
    const int f = (int)(i % CMP_HID), g = (int)((i / CMP_HID) % N_KV), e = (int)((i / ((size_t)CMP_HID * N_KV)) % 2), c = (int)((i / ((size_t)CMP_HID * N_KV * 2)) % NBC_MAX), seq = (int)(i / ((size_t)CMP_HID * N_KV * 2 * NBC_MAX));
    if (c >= seq_nbc(seq)) return;
    float s = 0.f;
    for (int l = 0; l < L_CMP; ++l) {
        const float* r = kv_full_ptr(S, seq, c * L_CMP + l, e, g);
        const float* w = w1 + (((size_t)e * L_CMP + l) * HD) * CMP_HID + f; const float* pp = pe + ((size_t)e * L_CMP + l) * HD;
        for (int d = 0; d < HD; ++d) s += ((r ? r[d] : 0.f) + pp[d]) * w[(size_t)d * CMP_HID];
    }
    const float x = s; const float t = tanhf(0.7978845608028654f * (x + 0.044715f * x * x * x));
    hid[i] = 0.5f * x * (1.0f + t);
}
__device__ inline void cmp_out_item(size_t i_, const float* hid, const float* w2  , const float* k_norm0, float* kc, float* vc) {
    const int i = (int)i_;
    if (i >= NSEQ * NBC_MAX * 2 * N_KV) return;
    const int g = i % N_KV, e = (i / N_KV) % 2, c = (i / (2 * N_KV)) % NBC_MAX, seq = i / (2 * N_KV * NBC_MAX);
    if (c >= seq_nbc(seq)) return;
    const float* hr = hid + (size_t)i * CMP_HID;
    float v[HD];
    for (int d = 0; d < HD; ++d) { float s = 0.f; for (int f = 0; f < CMP_HID; ++f) s += hr[f] * w2[((size_t)e * CMP_HID + f) * HD + d]; v[d] = s; }
    if (e == 0) head_norm(v, k_norm0);
    float* o = (e == 0 ? kc : vc) + (((size_t)seq * NBC_MAX + c) * N_KV + g) * HD;
    for (int d = 0; d < HD; ++d) o[d] = v[d];
}
__device__ inline void qprep_item(size_t i_, const float* qg, const float* q_norm, float* qn, float* qr, float* gates) {
    const int i = (int)i_;
    if (i >= MT * N_HEADS) return;
    const int m = i / N_HEADS, hh = i % N_HEADS;
    const RowInfo ri = row_info(m);
    float v[HD];
    for (int d = 0; d < HD; ++d) v[d] = qg[(size_t)m * QGW + hh * HD + d];
    head_norm(v, q_norm);
    for (int d = 0; d < HD; ++d) qn[(size_t)m * HDM + hh * HD + d] = v[d];
    head_rope(v, ri.pos);
    for (int d = 0; d < HD; ++d) qr[(size_t)m * HDM + hh * HD + d] = v[d];
    for (int j = 0; j < 3; ++j) { const float x = qg[(size_t)m * QGW + HDM + hh * 3 + j]; gates[(size_t)m * 3 * N_HEADS + hh * 3 + j] = 1.0f / (1.0f + expf(-x)); }
}
__device__ inline void attn_cmp_item(size_t i_, const float* qn, const float* kc, const float* vc, float* pbuf, float* oc) {
    const int i = (int)i_;
    if (i >= MT * N_HEADS) return;
    const int m = i / N_HEADS, hh = i % N_HEADS, g = hh / HPG;
    const RowInfo ri = row_info(m);
    const int nbc = seq_nbc(ri.seq);
    const float* q = qn + (size_t)m * HDM + hh * HD;
    float* p = pbuf + (size_t)i * NBC_MAX;
    float mx = NEGF;
    for (int c = 0; c < nbc; ++c) {
        const bool vis = (c + 1) * L_CMP - 1 <= ri.pos;
        float s = 0.f; const float* k = kc + (((size_t)ri.seq * NBC_MAX + c) * N_KV + g) * HD;
        for (int d = 0; d < HD; ++d) s += q[d] * k[d];
        s *= 0.125f; p[c] = s; if (vis && s > mx) mx = s;
    }
    float sum = 0.f;
    for (int c = 0; c < nbc; ++c) { const bool vis = (c + 1) * L_CMP - 1 <= ri.pos; const float e = vis ? expf(p[c] - mx) : 0.f; p[c] = e; sum += e; }
    const float inv = 1.0f / fmaxf(sum, TINYF);
    float o[HD]; for (int d = 0; d < HD; ++d) o[d] = 0.f;
    for (int c = 0; c < nbc; ++c) { p[c] *= inv; if (p[c] != 0.f) { const float* v = vc + (((size_t)ri.seq * NBC_MAX + c) * N_KV + g) * HD; for (int d = 0; d < HD; ++d) o[d] += p[c] * v[d]; } }
    for (int d = 0; d < HD; ++d) oc[(size_t)m * HDM + hh * HD + d] = o[d];
}
__device__ inline void topk_item(size_t i_, const float* pbuf, int* sel, float* scorebuf  ) {
    const int i = (int)i_;
    if (i >= MT * N_KV) return;
    const int m = i / N_KV, g = i % N_KV;
    const RowInfo ri = row_info(m);
    const int nbs = ri.seq < BATCH ? NBS_P : NBS_S, cur = ri.pos / L_SEL;
    float* score = scorebuf + (size_t)i * NBS_MAX;
    for (int b = 0; b < nbs; ++b) {
        float imp = 0.f;
        for (int h = 0; h < HPG; ++h) { const float* p = pbuf + ((size_t)m * N_HEADS + g * HPG + h) * NBC_MAX; imp += p[2 * b]; }
        float imp2 = 0.f;
        for (int h = 0; h < HPG; ++h) { const float* p = pbuf + ((size_t)m * N_HEADS + g * HPG + h) * NBC_MAX; imp2 += p[2 * b + 1]; }
        const bool forced = (b == 0) || (b == cur) || (b == cur - 1), valid = b * L_SEL <= ri.pos;
        score[b] = valid ? (forced ? FORCE_SCORE : imp + imp2) : NEGF;
    }
    const int nsel = N_SEL < nbs ? N_SEL : nbs;
    for (int j = 0; j < N_SEL; ++j) {
        if (j >= nsel) { sel[(size_t)i * N_SEL + j] = -1; continue; }
        int best = -1; float bv = 0.f;
        for (int b = 0; b < nbs; ++b) if (score[b] > -3e38f && (best < 0 || score[b] > bv)) { best = b; bv = score[b]; }
        sel[(size_t)i * N_SEL + j] = best; score[best] = -3.4e38f;
    }
}
__device__ inline void attn_sel_item(size_t i_, KvSrc S, const float* qr, const int* sel, float* os) {
    const int i = (int)i_;
    if (i >= MT * N_HEADS) return;
    const int m = i / N_HEADS, hh = i % N_HEADS, g = hh / HPG;
    const RowInfo ri = row_info(m);
    const float* q = qr + (size_t)m * HDM + hh * HD;
    const int* sl = sel + ((size_t)m * N_KV + g) * N_SEL;
    float mx = NEGF;
    for (int j = 0; j < N_SEL; ++j) { const int b = sl[j]; if (b < 0) continue;
        for (int t = 0; t < L_SEL; ++t) { const int tok = b * L_SEL + t; if (tok > ri.pos) continue;
            const float* k = kv_full_ptr(S, ri.seq, tok, 2, g); float s = 0.f; if (k) for (int d = 0; d < HD; ++d) s += q[d] * k[d];
            s *= 0.125f; if (s > mx) mx = s; } }
    float sum = 0.f, o[HD]; for (int d = 0; d < HD; ++d) o[d] = 0.f;
    for (int j = 0; j < N_SEL; ++j) { const int b = sl[j]; if (b < 0) continue;
        for (int t = 0; t < L_SEL; ++t) { const int tok = b * L_SEL + t; if (tok > ri.pos) continue;
            const float* k = kv_full_ptr(S, ri.seq, tok, 2, g); float s = 0.f; if (k) for (int d = 0; d < HD; ++d) s += q[d] * k[d];
            const float e = expf(s * 0.125f - mx); sum += e;
            const float* v = kv_full_ptr(S, ri.seq, tok, 3, g); if (v) for (int d = 0; d < HD; ++d) o[d] += e * v[d]; } }
    const float inv = 1.0f / fmaxf(sum, TINYF);
    for (int d = 0; d < HD; ++d) os[(size_t)m * HDM + hh * HD + d] = o[d] * inv;
}
__device__ inline const float* win_ptr(const float* cache_win, const float* winrows, int seq, int kp) {
    if (seq < BATCH) return kp >= 0 ? winrows + (size_t)(seq * SEQ + kp) * 2 * N_KV * HD : nullptr;
    const int b = seq - BATCH;
    if (kp >= PAST_LEN) return winrows + (size_t)(MP + b * DEC_SEQ + (kp - PAST_LEN)) * 2 * N_KV * HD;
    const int j = kp - (PAST_LEN - WINDOW);
    return j >= 0 ? cache_win + ((size_t)b * WINDOW + j) * 2 * N_KV * HD : nullptr;
}
__device__ inline void attn_win_item(size_t i_, const float* cache_win, const float* winrows, const float* qr, const float* gates, const float* oc, const float* os, bf16_t* o_out) {
    const int i = (int)i_;
    if (i >= MT * N_HEADS) return;
    const int m = i / N_HEADS, hh = i % N_HEADS, g = hh / HPG;
    const RowInfo ri = row_info(m);
    const float* q = qr + (size_t)m * HDM + hh * HD;
    float mx = NEGF;
    for (int kp = ri.pos - WINDOW; kp <= ri.pos; ++kp) { const float* r = win_ptr(cache_win, winrows, ri.seq, kp); if (!r) continue;
        const float* k = r + (0 * N_KV + g) * HD; float s = 0.f; for (int d = 0; d < HD; ++d) s += q[d] * k[d]; s *= 0.125f; if (s > mx) mx = s; }
    float sum = 0.f, o[HD]; for (int d = 0; d < HD; ++d) o[d] = 0.f;
    for (int kp = ri.pos - WINDOW; kp <= ri.pos; ++kp) { const float* r = win_ptr(cache_win, winrows, ri.seq, kp); if (!r) continue;
        const float* k = r + (0 * N_KV + g) * HD; float s = 0.f; for (int d = 0; d < HD; ++d) s += q[d] * k[d];
        const float e = expf(s * 0.125f - mx); sum += e; const float* v = r + (1 * N_KV + g) * HD; for (int d = 0; d < HD; ++d) o[d] += e * v[d]; }
    const float inv = 1.0f / fmaxf(sum, TINYF);
    const float* gt = gates + (size_t)m * 3 * N_HEADS + hh * 3;
    for (int d = 0; d < HD; ++d) { const size_t x = (size_t)m * HDM + hh * HD + d; o_out[x] = f2bf(gt[0] * oc[x] + gt[1] * os[x] + gt[2] * o[d] * inv); }
}


#ifndef CPU_TEST
__device__ __forceinline__ unsigned lane_id_v() { unsigned l; asm volatile("v_mbcnt_lo_u32_b32 %0, -1, 0\n\tv_mbcnt_hi_u32_b32 %0, -1, %0" : "=v"(l)); return l; }
#endif
constexpr int NTHREADS = 512;
__host__ __device__ inline bf16_t f2bf_(float f) { unsigned u; memcpy(&u, &f, 4); u = (u + 0x7fffu + ((u >> 16) & 1u)) >> 16; return (bf16_t)u; }
__host__ __device__ inline float bf2f_(bf16_t b) { unsigned u = (unsigned)b << 16; float f; memcpy(&f, &u, 4); return f; }
constexpr int NRSS = 3 * DEPTH + 1;
constexpr int NPOS = SEQ + DEC_SEQ;
constexpr int QGP = ((QGW + 255) / 256) * 256;
__host__ __device__ inline int pos_index(int pos) { return pos < SEQ ? pos : SEQ + (pos - PAST_LEN); }

constexpr size_t IMG_SEQ_BYTES = (size_t)BATCH * N_KV * (SEQ / 64) * 8192, IMG_CMP_BYTES = (size_t)BATCH * N_KV * (NBC_P / 64 > 0 ? NBC_P / 64 : 1) * 8192;
struct WsMap {
    size_t ctl, rss, rope, h, hb, act, xn, t2, actf, ub, bb, zb, t1, qn, qr, gates, ob, winrows, hid, kc, vc, pbuf, oc, os, sel, scorebuf,
           w_ain, w_aout, w_bin, w_bout, w_cin, w_cout, w_qg, w_o, w_kv, qnb, qrb, ksel, vsel, kwin, vwin, kci, vci, acs, hids, acp, hidp, w1t, end;
};
constexpr size_t al256(size_t b) { return (b + 255) / 256 * 256; }
constexpr size_t smax(size_t a, size_t b) { return a > b ? a : b; }
constexpr WsMap make_ws_map() {
    WsMap w{}; size_t off = 0;
#define TAKE(f, bytes) w.f = off; off += al256(bytes)
    TAKE(ctl, 65536); TAKE(rss, (size_t)NRSS * MT * 4);
    TAKE(rope, (size_t)NPOS * 16 * 4);
    TAKE(h, (size_t)MT * D_MODEL * 4); TAKE(hb, (size_t)MT * D_MODEL * 2); TAKE(act, (size_t)MT * D_FF * 2);
    TAKE(xn, (size_t)MT * D_MODEL * 4); TAKE(t2, (size_t)MT * D_MODEL * 4); TAKE(actf, (size_t)MT * D_MODEL * 4);
    TAKE(ub, (size_t)MT * D_MODEL * 2); TAKE(bb, (size_t)MT * D_MODEL * 2); TAKE(zb, (size_t)MT * D_MODEL * 2);
    TAKE(t1, smax((size_t)MT * 3 * D_MODEL * 4, (size_t)MT * KVW * 4));
    TAKE(qn, (size_t)MT * HDM * 4); TAKE(qr, (size_t)MT * HDM * 4); TAKE(gates, (size_t)MT * 3 * N_HEADS * 4); TAKE(ob, (size_t)MT * HDM * 2);
    TAKE(winrows, (size_t)MT * 2 * N_KV * HD * 4); TAKE(hid, (size_t)NSEQ * NBC_MAX * 2 * N_KV * CMP_HID * 4);
    TAKE(kc, (size_t)NSEQ * NBC_MAX * N_KV * HD * 4); TAKE(vc, (size_t)NSEQ * NBC_MAX * N_KV * HD * 4);
    TAKE(pbuf, (size_t)MT * N_HEADS * NBC_MAX * 4); TAKE(oc, (size_t)MT * HDM * 4); TAKE(os, (size_t)MT * HDM * 4);
    TAKE(sel, (size_t)MT * N_KV * N_SEL * 4); TAKE(scorebuf, (size_t)MT * N_KV * NBS_MAX * 4);
    TAKE(w_ain, (size_t)DEPTH * 2 * D_FF * D_MODEL * 2); TAKE(w_aout, (size_t)DEPTH * D_MODEL * D_FF * 2);
    TAKE(w_bin, (size_t)DEPTH * 2 * D_FF * D_MODEL * 2); TAKE(w_bout, (size_t)DEPTH * D_MODEL * D_FF * 2);
    TAKE(w_cin, (size_t)N_A * 3 * D_MODEL * D_MODEL * 2); TAKE(w_cout, (size_t)N_A * D_MODEL * D_MODEL * 2);
    TAKE(w_qg, (size_t)N_B * QGP * D_MODEL * 2); TAKE(w_o, (size_t)N_B * D_MODEL * HDM * 2); TAKE(w_kv, (size_t)KVW * D_MODEL * 2);
    TAKE(qnb, (size_t)MT * HDM * 2); TAKE(qrb, (size_t)MT * HDM * 2); TAKE(ksel, IMG_SEQ_BYTES); TAKE(vsel, IMG_SEQ_BYTES); TAKE(kwin, IMG_SEQ_BYTES); TAKE(vwin, IMG_SEQ_BYTES); TAKE(kci, IMG_CMP_BYTES); TAKE(vci, IMG_CMP_BYTES);
    TAKE(acs, (size_t)2 * DEC_BATCH * (PAST_LEN / L_CMP) * N_KV * L_CMP * HD * 2); TAKE(hids, (size_t)2 * DEC_BATCH * (PAST_LEN / L_CMP) * N_KV * CMP_HID * 2);
    TAKE(acp, (size_t)2 * BATCH * NBC_P * N_KV * L_CMP * HD * 2); TAKE(hidp, (size_t)2 * BATCH * NBC_P * N_KV * CMP_HID * 2); TAKE(w1t, (size_t)2 * CMP_HID * L_CMP * HD * 2);
#undef TAKE
    w.end = off; return w;
}
constexpr WsMap WSM = make_ws_map();
constexpr size_t WS_ZERO_BYTES = 65536 + (((size_t)NRSS * MT * 4 + 255) / 256 * 256);

enum { CM_PLAIN = 0, CM_PAIR = 1, CM_CONV = 2, CM_HEADS = 3 };
__host__ __device__ inline int colmap(int kind, int n, int aux) {
    const int pn = n / 256, c = n % 256;
    if (kind == CM_PLAIN) return n;
    if (kind == CM_PAIR) return (c >= 128 ? aux : 0) + pn * 128 + (c % 128);
    if (kind == CM_CONV) { if (n < 2 * D_MODEL) return (c >= 128 ? 2 * D_MODEL : D_MODEL) + pn * 128 + (c % 128); return n - 2 * D_MODEL; }
    if (n < aux * 64) { const int bj = c / 128, wc = (c % 128) / 32, r = c % 32; return (pn * 4 + wc) * 64 + 32 * bj + r; }
    return n;
}
__device__ inline void wconv_item(size_t i_, const float* src, int Nsrc, const float* gain, bf16_t* dst, int Nd, int K, int kind, int aux) {
    const int n = (int)(i_ % Nd), kb = (int)(i_ / Nd);
    const int col = colmap(kind, n, aux);
    bf16_t* d = dst + (size_t)n * K + (size_t)kb * 64;
    if (col < 0 || col >= Nsrc) { for (int k = 0; k < 64; ++k) d[k] = 0; return; }
    const float* s = src + (size_t)kb * 64 * Nsrc + col;
#pragma unroll 8
    for (int k = 0; k < 64; k += 2) {
        const float g0 = gain ? gain[kb * 64 + k] : 1.f, g1 = gain ? gain[kb * 64 + k + 1] : 1.f;
        const unsigned lo = f2bf(s[(size_t)k * Nsrc] * g0), hi = f2bf(s[(size_t)(k + 1) * Nsrc] * g1);
        *(unsigned*)(d + k) = lo | (hi << 16);
    }
}
__device__ inline void rope_item(size_t i_, float* rope) {
    const int pi = (int)(i_ / 8), f = (int)(i_ % 8);
    const int pos = pi < SEQ ? pi : PAST_LEN + (pi - SEQ);
    float c, s; rope_cs((float)pos * INV_FREQ[f], c, s);
    rope[pi * 16 + f] = c; rope[pi * 16 + 8 + f] = s;
}
__device__ inline void hinit_item(size_t i_, const float* xp, const float* xs, float* h, bf16_t* hb, float* rss0) {
    const int m = (int)i_; const float* x = m < MP ? xp + (size_t)m * D_MODEL : xs + (size_t)(m - MP) * D_MODEL;
    float s = 0.f;
    for (int k = 0; k < D_MODEL; ++k) { const float v = x[k]; s += v * v; h[(size_t)m * D_MODEL + k] = v; hb[(size_t)m * D_MODEL + k] = f2bf(v); }
    rss0[m] = s;
}
__device__ inline void hupd_item(size_t i_, float* h, const float* y, float coef, bf16_t* hb, float* rss) {
    const int m = (int)i_; float s = 0.f;
    for (int k = 0; k < D_MODEL; ++k) { const float v = h[(size_t)m * D_MODEL + k] + coef * y[(size_t)m * D_MODEL + k]; s += v * v; h[(size_t)m * D_MODEL + k] = v; hb[(size_t)m * D_MODEL + k] = f2bf(v); }
    rss[m] = s;
}
__device__ inline float dot_bf(const bf16_t* a, const bf16_t* b, int K) { float s = 0.f; for (int k = 0; k < K; ++k) s += bf2f(a[k]) * bf2f(b[k]); return s; }
__device__ inline float silu_f(float g) { return g / (1.0f + expf(-g)); }
__device__ inline void ref_ffn_in_item(size_t i_, const bf16_t* hb, const float* rss, const bf16_t* Bt, bf16_t* act) {
    const int m = (int)(i_ / D_FF), j = (int)(i_ % D_FF);
    const float rs = 1.0f / sqrtf(rss[m] / D_MODEL + EPS);
    const int ng = (j / 128) * 256 + (j % 128);
    const float g = rs * dot_bf(hb + (size_t)m * D_MODEL, Bt + (size_t)ng * D_MODEL, D_MODEL), u = rs * dot_bf(hb + (size_t)m * D_MODEL, Bt + (size_t)(ng + 128) * D_MODEL, D_MODEL);
    act[i_] = f2bf(silu_f(g) * u);
}
__device__ inline void ref_resid_row_item(size_t i_, const bf16_t* A, int K, const bf16_t* Bt, float coef, float* h, bf16_t* hb, float* rss_next, float* yout) {
    const int m = (int)i_; float s = 0.f;
    for (int c = 0; c < D_MODEL; ++c) {
        const float v = h[(size_t)m * D_MODEL + c] + coef * dot_bf(A + (size_t)m * K, Bt + (size_t)c * K, K);
        if (yout) { yout[(size_t)m * D_MODEL + c] = v; } else { h[(size_t)m * D_MODEL + c] = v; hb[(size_t)m * D_MODEL + c] = f2bf(v); s += v * v; }
    }
    if (!yout) rss_next[m] = s;
}

constexpr float QSCALE_F = 0.125f * 1.4426950408889634f;
__device__ inline void qconv_item(size_t i_, const float* qn, const float* qr, bf16_t* qnb, bf16_t* qrb) { qnb[i_] = f2bf(qn[i_] * QSCALE_F); qrb[i_] = f2bf(qr[i_] * QSCALE_F); }
__host__ __device__ inline size_t kimg_off(int kv, int d0) { return (size_t)(d0 >> 3) * 1024 + (size_t)kv * 16; }
__host__ __device__ inline size_t vimg_off(int kv, int d0) { return (size_t)(d0 >> 5) * 4096 + (size_t)(kv >> 3) * 512 + (size_t)(kv & 7) * 64 + (size_t)((d0 & 31) >> 3) * 16; }
__device__ inline void put_chunk(unsigned char* dst, const float* src) { bf16_t* d = (bf16_t*)dst; for (int k = 0; k < 8; ++k) d[k] = f2bf(src[k]); }
__device__ inline void kvimg_item(size_t i_, const float* out, const float* winrows, unsigned char* ksel, unsigned char* vsel, unsigned char* kwin, unsigned char* vwin) {
    const int c = (int)(i_ % 8), t = (int)((i_ / 8) % SEQ), g = (int)((i_ / (8 * (size_t)SEQ)) % N_KV), n = (int)(i_ / (8 * (size_t)SEQ * N_KV));
    const size_t base = (((size_t)n * N_KV + g) * (SEQ / 64) + t / 64) * 8192; const int kv = t % 64, d0 = 8 * c; const size_t m = (size_t)n * SEQ + t;
    put_chunk(ksel + base + kimg_off(kv, d0), out + O_KVP + ((m * 4 + 2) * N_KV + g) * HD + d0);
    put_chunk(vsel + base + vimg_off(kv, d0), out + O_KVP + ((m * 4 + 3) * N_KV + g) * HD + d0);
    put_chunk(kwin + base + kimg_off(kv, d0), winrows + ((m * 2 + 0) * N_KV + g) * HD + d0);
    put_chunk(vwin + base + vimg_off(kv, d0), winrows + ((m * 2 + 1) * N_KV + g) * HD + d0);
}
__device__ inline void kcimg_item(size_t i_, const float* kc, const float* vc, unsigned char* kci, unsigned char* vci) {
    const int c = (int)(i_ % 8), cb = (int)((i_ / 8) % NBC_P), g = (int)((i_ / (8 * (size_t)NBC_P)) % N_KV), n = (int)(i_ / (8 * (size_t)NBC_P * N_KV));
    const size_t base = (((size_t)n * N_KV + g) * (NBC_P / 64) + cb / 64) * 8192; const int kv = cb % 64, d0 = 8 * c;
    put_chunk(kci + base + kimg_off(kv, d0), kc + (((size_t)n * NBC_MAX + cb) * N_KV + g) * HD + d0);
    put_chunk(vci + base + vimg_off(kv, d0), vc + (((size_t)n * NBC_MAX + cb) * N_KV + g) * HD + d0);
}

constexpr int NBC_PAST = PAST_LEN / L_CMP;
constexpr int RS_CMP = DEC_BATCH * NBC_PAST * N_KV, RP_CMP = BATCH * NBC_P * N_KV;
__device__ inline void acmp_sample_item(size_t i_, const float* cache_kv, const int* page_table, const float* pe, bf16_t* A) {
    const int c8 = (int)(i_ % 8), l = (int)((i_ / 8) % L_CMP); const size_t rr = i_ / (8 * L_CMP); const int r = (int)(rr % RS_CMP), e = (int)(rr / RS_CMP);
    const int g = r % N_KV, c = (r / N_KV) % NBC_PAST, b = r / (N_KV * NBC_PAST), tok = c * L_CMP + l;
    const int page = page_table[b * N_PAGES + tok / PAGE_SIZE];
    const float* src = cache_kv + ((((size_t)page * PAGE_SIZE + tok % PAGE_SIZE) * 4 + e) * N_KV + g) * HD + 8 * c8; const float* pp = pe + ((size_t)e * L_CMP + l) * HD + 8 * c8;
    bf16_t* d = A + ((size_t)e * RS_CMP + r) * (L_CMP * HD) + l * HD + 8 * c8;
    for (int k = 0; k < 8; ++k) d[k] = f2bf(src[k] + pp[k]);
}
__device__ inline void acmp_prompt_item(size_t i_, const float* out, const float* pe, bf16_t* A) {
    const int c8 = (int)(i_ % 8), l = (int)((i_ / 8) % L_CMP); const size_t rr = i_ / (8 * L_CMP); const int r = (int)(rr % RP_CMP), e = (int)(rr / RP_CMP);
    const int g = r % N_KV, c = (r / N_KV) % NBC_P, n = r / (N_KV * NBC_P), tok = c * L_CMP + l;
    const float* src = out + O_KVP + ((((size_t)n * SEQ + tok) * 4 + e) * N_KV + g) * HD + 8 * c8; const float* pp = pe + ((size_t)e * L_CMP + l) * HD + 8 * c8;
    bf16_t* d = A + ((size_t)e * RP_CMP + r) * (L_CMP * HD) + l * HD + 8 * c8;
    for (int k = 0; k < 8; ++k) d[k] = f2bf(src[k] + pp[k]);
}
__device__ inline void cmp_out_b_item(size_t i_, const bf16_t* hid, int R, int nbc, int seq0, const float* w2, const float* k_norm0, float* kc, float* vc) {
    const int r = (int)(i_ % R), e = (int)(i_ / R); const int g = r % N_KV, c = (r / N_KV) % nbc, sq = r / (N_KV * nbc);
    const bf16_t* hr = hid + ((size_t)e * R + r) * CMP_HID;
    float v[HD];
    for (int d = 0; d < HD; ++d) v[d] = 0.f;
    for (int f = 0; f < CMP_HID; ++f) { const float hf = bf2f(hr[f]); const float* w = w2 + ((size_t)e * CMP_HID + f) * HD; for (int d = 0; d < HD; ++d) v[d] += hf * w[d]; }
    if (e == 0) head_norm(v, k_norm0);
    float* o = (e == 0 ? kc : vc) + (((size_t)(seq0 + sq) * NBC_MAX + c) * N_KV + g) * HD;
    for (int d = 0; d < HD; ++d) o[d] = v[d];
}
__host__ __device__ inline int heads_row(int hidx, int d) { return (hidx / 4) * 256 + 128 * (d / 32) + 32 * (hidx % 4) + (d % 32); }
__device__ inline void conv_state_store(float* out, int layer, int m, int ch, float u) {
    const RowInfo ri = row_info(m); const int L = seq_len(ri.seq);
    if (ri.t >= L - 2) { const int j = ri.t - (L - 2);
        if (ri.seq < BATCH) out[O_CP + (((size_t)layer * BATCH + ri.seq) * 2 + j) * D_MODEL + ch] = u;
        else out[O_CS + (((size_t)layer * DEC_BATCH + (ri.seq - BATCH)) * 2 + j) * D_MODEL + ch] = u; }
}
__device__ inline void ref_conv_in_item(size_t i_, const bf16_t* hb, const float* rss, const bf16_t* Bt, bf16_t* ub, bf16_t* bb, float* out, int layer) {
    const int m = (int)(i_ / D_MODEL), j = (int)(i_ % D_MODEL);
    const float rs = 1.0f / sqrtf(rss[m] / D_MODEL + EPS); const bf16_t* a = hb + (size_t)m * D_MODEL;
    const int nc = (j / 128) * 256 + (j % 128);
    const float c = rs * dot_bf(a, Bt + (size_t)nc * D_MODEL, D_MODEL), x = rs * dot_bf(a, Bt + (size_t)(nc + 128) * D_MODEL, D_MODEL), b = rs * dot_bf(a, Bt + (size_t)(2 * D_MODEL + j) * D_MODEL, D_MODEL);
    const float u = c * x; ub[i_] = f2bf(u); bb[i_] = f2bf(b); conv_state_store(out, layer, m, j, u);
}
__device__ inline void conv_thin_item(size_t i_, const bf16_t* ub, const bf16_t* bb, const float* state  , const float* wc  , bf16_t* zb) {
    const int m = (int)(i_ / D_MODEL), ch = (int)(i_ % D_MODEL);
    const RowInfo ri = row_info(m);
    const float u0 = bf2f(ub[i_]);
    float u1, u2;
    if (ri.t >= 1) u1 = bf2f(ub[i_ - D_MODEL]); else u1 = (ri.seq < BATCH) ? 0.f : state[((size_t)(ri.seq - BATCH) * 2 + 1) * D_MODEL + ch];
    if (ri.t >= 2) u2 = bf2f(ub[i_ - 2 * D_MODEL]); else if (ri.seq < BATCH) u2 = 0.f;
    else u2 = (ri.t == 1) ? state[((size_t)(ri.seq - BATCH) * 2 + 1) * D_MODEL + ch] : state[((size_t)(ri.seq - BATCH) * 2 + 0) * D_MODEL + ch];
    zb[i_] = f2bf(bf2f(bb[i_]) * (wc[ch] * u2 + wc[D_MODEL + ch] * u1 + wc[2 * D_MODEL + ch] * u0));
}
__device__ inline void ref_qg_item(size_t i_, const bf16_t* hb, const float* rss, const bf16_t* Bt, const float* q_norm, const float* rope, float* qn, float* qr) {
    const int m = (int)(i_ / N_HEADS), hh = (int)(i_ % N_HEADS);
    const float rs = 1.0f / sqrtf(rss[m] / D_MODEL + EPS); const bf16_t* a = hb + (size_t)m * D_MODEL;
    float v[HD]; for (int d = 0; d < HD; ++d) v[d] = rs * dot_bf(a, Bt + (size_t)heads_row(hh, d) * D_MODEL, D_MODEL);
    head_norm(v, q_norm);
    for (int d = 0; d < HD; ++d) qn[(size_t)m * HDM + hh * HD + d] = v[d];
    const float* rt = rope + (size_t)pos_index(row_info(m).pos) * 16;
    for (int f = 0; f < 8; ++f) { const float x1 = v[f], x2 = v[8 + f]; v[f] = x1 * rt[f] - x2 * rt[8 + f]; v[8 + f] = x2 * rt[f] + x1 * rt[8 + f]; }
    for (int d = 0; d < HD; ++d) qr[(size_t)m * HDM + hh * HD + d] = v[d];
}
__device__ inline void ref_gates_item(size_t i_, const bf16_t* hb, const float* rss, const bf16_t* Bt, float* gates) {
    const int m = (int)(i_ / (3 * N_HEADS)), j = (int)(i_ % (3 * N_HEADS));
    const float rs = 1.0f / sqrtf(rss[m] / D_MODEL + EPS);
    const float x = rs * dot_bf(hb + (size_t)m * D_MODEL, Bt + (size_t)(HDM + j) * D_MODEL, D_MODEL);
    gates[i_] = 1.0f / (1.0f + expf(-x));
}
__device__ inline void kv_store(float* out, float* winrows, int m, int e, int g, int d, float v) {
    const RowInfo ri = row_info(m);
    if (e < 4) { if (ri.seq < BATCH) out[O_KVP + (((size_t)m * 4 + e) * N_KV + g) * HD + d] = v; else out[O_KVS + (((size_t)(m - MP) * 4 + e) * N_KV + g) * HD + d] = v; }
    else { const int we = e - 4;
        winrows[(((size_t)m * 2 + we) * N_KV + g) * HD + d] = v;
        if (ri.seq < BATCH) { if (ri.t >= SEQ - WINDOW) out[O_WP + ((((size_t)ri.seq * WINDOW + (ri.t - (SEQ - WINDOW))) * 2 + we) * N_KV + g) * HD + d] = v; }
        else out[O_WS + ((((size_t)(ri.seq - BATCH) * WINDOW + (WINDOW - DEC_SEQ + ri.t)) * 2 + we) * N_KV + g) * HD + d] = v; }
}
__device__ inline void ref_kv_item(size_t i_, const bf16_t* hb, const float* rss, const bf16_t* Bt, const float* k_norm, const float* rope, float* out, float* winrows) {
    const int m = (int)(i_ / (6 * N_KV)), hidx = (int)(i_ % (6 * N_KV)), e = hidx / N_KV, g = hidx % N_KV;
    const float rs = 1.0f / sqrtf(rss[m] / D_MODEL + EPS); const bf16_t* a = hb + (size_t)m * D_MODEL;
    float v[HD]; for (int d = 0; d < HD; ++d) v[d] = rs * dot_bf(a, Bt + (size_t)heads_row(hidx, d) * D_MODEL, D_MODEL);
    if (e == 2 || e == 4) { head_norm(v, k_norm + (e == 2 ? 1 : 2) * HD);
        const float* rt = rope + (size_t)pos_index(row_info(m).pos) * 16;
        for (int f = 0; f < 8; ++f) { const float x1 = v[f], x2 = v[8 + f]; v[f] = x1 * rt[f] - x2 * rt[8 + f]; v[8 + f] = x2 * rt[f] + x1 * rt[8 + f]; } }
    for (int d = 0; d < HD; ++d) kv_store(out, winrows, m, e, g, d, v[d]);
}
#ifndef CPU_TEST
#define LAS __attribute__((address_space(3)))
#define XB_TMO      128
#define XB_XCNT(j)  (256  + 64 * (j))
#define XB_XSUB(j)  (1280 + 64 * (j))
#define XB_XGEN(j)  (2304 + 64 * (j))
#define XB_TOP      3328
#define XB_TOPGEN   3392
#define XCD_BAR_WORDS 3456
#define XB_SPIN_CAP (1u << 25)
typedef __attribute__((address_space(1))) unsigned GU;
__device__ __forceinline__ unsigned xb_ld(GU* p)              { return __hip_atomic_load(p, __ATOMIC_RELAXED, __HIP_MEMORY_SCOPE_AGENT); }
__device__ __forceinline__ unsigned xb_add(GU* p, unsigned v) { return __hip_atomic_fetch_add(p, v, __ATOMIC_RELAXED, __HIP_MEMORY_SCOPE_AGENT); }
__device__ __forceinline__ unsigned xb_xcc_id() { return (unsigned)__builtin_amdgcn_s_getreg((3 << 11) | 20) & 0xFu; }
#define XB_SPIN(cond, bar) do { unsigned _sp = 0; while (cond) { __builtin_amdgcn_s_sleep(1); \
    if ((++_sp & 255u) == 0u) { if (xb_ld(&(bar)[XB_TMO])) break; if (_sp > XB_SPIN_CAP) { (void)xb_add(&(bar)[XB_TMO], 1u); break; } } } } while (0)
struct XcdBarrier { GU* bar; unsigned x; volatile LAS unsigned* st; };
__device__ __forceinline__ XcdBarrier xcd_barrier_post(GU* bar, volatile LAS unsigned* st, const bool leader_thread) {
    XcdBarrier b; b.bar = bar; b.x = xb_xcc_id(); b.st = st;
    if (leader_thread) (void)xb_add(&bar[XB_XCNT(b.x)], 1u);
    return b;
}
__device__ __forceinline__ void xcd_barrier_complete(GU* bar, unsigned x, unsigned& nloc, unsigned& nx) {
    const unsigned G = gridDim.x * gridDim.y * gridDim.z;
    unsigned sum, cnt, mine, sp = 0u;
    for (;;) {
        sum = 0u; cnt = 0u; mine = 0u;
#pragma unroll
        for (unsigned j = 0; j < 16; ++j) { const unsigned c = xb_ld(&bar[XB_XCNT(j)]); sum += c; cnt += (c > 0u) ? 1u : 0u; mine = (j == x) ? c : mine; }
        if (sum == G) break;
        __builtin_amdgcn_s_sleep(1);
        if ((++sp & 255u) == 0u) { if (xb_ld(&bar[XB_TMO])) break; if (sp > XB_SPIN_CAP) { (void)xb_add(&bar[XB_TMO], 1u); break; } }
    }
    nloc = mine > 0u ? mine : 1u; nx = cnt > 0u ? cnt : 1u;
}
__device__ __forceinline__ void xcd_barrier(const XcdBarrier& b, const bool leader_thread) {
    asm volatile("s_waitcnt vmcnt(0)" ::: "memory");
    __syncthreads();
    if (leader_thread) {
        GU* bar = b.bar; unsigned bx = xb_xcc_id(); asm volatile("" : "+s"(bx));
        __builtin_amdgcn_s_waitcnt(0);
        unsigned nloc = b.st[0], nx = b.st[1];
        if (nloc == 0u) { xcd_barrier_complete(bar, bx, nloc, nx); b.st[0] = nloc; b.st[1] = nx; }
        const unsigned old = xb_add(&bar[XB_XSUB(bx)], 1u);
        const unsigned gen = old / nloc;
        if (old + 1u == (gen + 1u) * nloc) {
            __builtin_amdgcn_fence(__ATOMIC_RELEASE, "agent");
            asm volatile("s_waitcnt vmcnt(0)" ::: "memory");
            const unsigned og = xb_add(&bar[XB_TOP], 1u);
            const unsigned tg = og / nx;
            if (og + 1u == (tg + 1u) * nx) xb_add(&bar[XB_TOPGEN], 1u);
            else XB_SPIN(xb_ld(&bar[XB_TOPGEN]) == tg, bar);
            __builtin_amdgcn_fence(__ATOMIC_ACQUIRE, "agent");
            xb_add(&bar[XB_XGEN(bx)], 1u);
            asm volatile("s_waitcnt vmcnt(0)" ::: "memory");
        } else {
            XB_SPIN(xb_ld(&bar[XB_XGEN(bx)]) == gen, bar);
            __builtin_amdgcn_fence(__ATOMIC_ACQUIRE, "agent");
            asm volatile("s_waitcnt vmcnt(0)" ::: "memory");
        }
    }
    __syncthreads();
}

namespace pg8 {
#define PG8_LAS __attribute__((address_space(3)))
typedef unsigned short bf16_t;
typedef short bf16x8 __attribute__((ext_vector_type(8)));
typedef float f32x4 __attribute__((ext_vector_type(4)));
typedef unsigned u32x4 __attribute__((ext_vector_type(4)));
constexpr int BM = 256, BK = 64, HALF = 128, HTB = HALF * BK * 2  , STAGE_BYTES = 8 * HTB, NXCD = 8, WGM = 8;

__host__ __device__ __forceinline__ int lds_byte(int r, int c) { const int st = (r >> 4) * 2 + (c >> 5), rr = r & 15, cc = c & 31, ob = rr * 64 + cc * 2; return st * 1024 + (ob ^ (((ob >> 9) & 1) << 5)); }
__host__ __device__ __forceinline__ void stage_rc(int b, int& R, int& C) { const int st = b / 1024, sb = b % 1024, swz = sb ^ (((sb >> 9) & 1) << 5); R = (st >> 1) * 16 + swz / 64; C = (st & 1) * 32 + (swz % 64) / 2; }
__host__ __device__ __forceinline__ int perm32(int rho) { const int n = rho >> 4, i = rho & 15; return 8 * (i >> 2) + 4 * n + (i & 3); }

struct Unit { int pm, pn; };
struct Gemm { const bf16_t* A; const bf16_t* Bt; int M, N, K; };

struct StaticOrder {
    int nM, nN, nwg, G, c;
    __host__ __device__ void init(int M, int N, int G_, int c_) { nM = M / BM; nN = N / BM; nwg = nM * nN; G = G_; c = c_; }
    __host__ __device__ bool next(int i, Unit& u) const {
        const long L = (long)i * G + c; if (L >= nwg) return false;
        int wgid = (int)L; { const int q = nwg / NXCD, r = nwg % NXCD, xcd = wgid % NXCD, off = wgid / NXCD; wgid = (xcd < r ? xcd * (q + 1) : r * (q + 1) + (xcd - r) * q) + off; }
        const int nig = WGM * nN, gid = wgid / nig, fm = gid * WGM, gsz = (nM - fm) < WGM ? (nM - fm) : WGM;
        u.pm = fm + ((wgid % nig) % gsz); u.pn = (wgid % nig) / gsz; return true;
    }
    __device__ __forceinline__ void a_ready(const Unit&) const {}
    __device__ __forceinline__ void done(const Unit&) const {}
};

__device__ __forceinline__ unsigned cvt_pk_bf16(float lo, float hi) { unsigned r; asm volatile("v_cvt_pk_bf16_f32 %0, %1, %2" : "=v"(r) : "v"(lo), "v"(hi)); return r; }
template <class Epi, class Sched, bool ALIGN_EPI = false, bool SP2 = false>
__device__ __forceinline__ void gemm_phase(int wave_id_, PG8_LAS unsigned char* lds, const Gemm g, const Sched& S, const Epi& E) {
    int wid = wave_id_, lane = (int)lane_id_v(); asm volatile("" : "+s"(wid));
    const int tid = wid * 64 + lane, wr = wid >> 2, wc = wid & 3, fr = lane & 15, fq = lane >> 4;
    const int K = g.K, nt = K / BK;
    unsigned voffA[2], voffB[2];
#pragma unroll
    for (int i = 0; i < 2; ++i) { int R, C; stage_rc(tid * 16 + i * 8192, R, C); const int Rb = Epi::PERM ? ((R & ~31) + perm32(R & 31)) : R;
        voffA[i] = (unsigned)(R * K + C) * 2u; voffB[i] = (unsigned)(Rb * K + C) * 2u; }
    const size_t kstep = (size_t)(BK * 2);
    const size_t hstep = (size_t)HALF * K * 2;
    const size_t tstep = 2 * hstep;
    const unsigned ldsw = (unsigned)wid * 1024u;
    const int aoff = lds_byte(wr * 64 + fr, fq * 8), boff = lds_byte(wc * 32 + fr, fq * 8);
#define PG8_SA(b, h) (((b) * 2 + (h)) * HTB)
#define PG8_SB(b, h) ((4 + (b) * 2 + (h)) * HTB)
#define PG8_STAGE(bufoff, gbase, voff) do { _Pragma("unroll") for (int _i = 0; _i < 2; ++_i) \
        __builtin_amdgcn_global_load_lds((const unsigned*)((const char*)(gbase) + (voff)[_i]), (PG8_LAS unsigned*)(lds + (bufoff) + ldsw + _i * 8192), 16, 0, 0); } while (0)
#define PG8_LDA(dst, b, h) do { _Pragma("unroll") for (int m = 0; m < 4; ++m) _Pragma("unroll") for (int k = 0; k < 2; ++k) dst[m][k] = *(const PG8_LAS bf16x8*)(lds + PG8_SA(b, h) + aoff + m * 2048 + k * 1024); } while (0)
#define PG8_LDB(dst, b, h) do { _Pragma("unroll") for (int n = 0; n < 2; ++n) _Pragma("unroll") for (int k = 0; k < 2; ++k) dst[n][k] = *(const PG8_LAS bf16x8*)(lds + PG8_SB(b, h) + boff + n * 2048 + k * 1024); } while (0)
#define PG8_MMA(ai, bj, At, Bt) do { __builtin_amdgcn_s_setprio(1); _Pragma("unroll") for (int m = 0; m < 4; ++m) _Pragma("unroll") for (int n = 0; n < 2; ++n) _Pragma("unroll") for (int k = 0; k < 2; ++k) \
        acc[ai][bj][m][n] = __builtin_amdgcn_mfma_f32_16x16x32_bf16(Bt[n][k], At[m][k], acc[ai][bj][m][n], 0, 0, 0); __builtin_amdgcn_s_setprio(0); } while (0)
#define PG8_WAIT_V(n) asm volatile("s_waitcnt vmcnt(" #n ")" ::: "memory")
#define PG8_WAIT_L(n) asm volatile("s_waitcnt lgkmcnt(" #n ")" ::: "memory")
#define PG8_BAR __builtin_amdgcn_s_barrier()
#define PG8_SCHED __builtin_amdgcn_sched_barrier(0)
    Unit cur, nxt; int ui = 0;
    if (!S.next(0, cur)) return;
    f32x4 acc[2][2][4][2];
#pragma unroll
    for (int a = 0; a < 2; ++a)
#pragma unroll
        for (int b = 0; b < 2; ++b)
#pragma unroll
            for (int m = 0; m < 4; ++m)
#pragma unroll
                for (int n = 0; n < 2; ++n) acc[a][b][m][n] = (f32x4){0.f, 0.f, 0.f, 0.f};
    bf16x8 At[4][2], B0[2][2], B1[2][2];
    const char* cA = (const char*)g.A + (size_t)cur.pm * tstep; const char* cB = (const char*)g.Bt + (size_t)cur.pn * tstep;
    S.a_ready(cur);
    if constexpr (SP2) {
        PG8_STAGE(PG8_SB(0, 0), cB, voffB); PG8_STAGE(PG8_SB(0, 1), cB + hstep, voffB); PG8_STAGE(PG8_SA(0, 0), cA, voffA); PG8_STAGE(PG8_SA(0, 1), cA + hstep, voffA);
        if (wr == 1) PG8_BAR;
        PG8_WAIT_V(2); PG8_BAR;
        PG8_STAGE(PG8_SB(1, 0), cB + kstep, voffB); PG8_STAGE(PG8_SA(1, 0), cA + kstep, voffA); PG8_STAGE(PG8_SB(1, 1), cB + hstep + kstep, voffB);
        PG8_WAIT_V(6); PG8_BAR;
    } else {
        PG8_STAGE(PG8_SB(0, 0), cB, voffB); PG8_STAGE(PG8_SA(0, 0), cA, voffA); PG8_STAGE(PG8_SB(0, 1), cB + hstep, voffB); PG8_STAGE(PG8_SA(0, 1), cA + hstep, voffA);
        if (wr == 1) PG8_BAR;
        PG8_WAIT_V(4); PG8_BAR;
        PG8_STAGE(PG8_SB(1, 0), cB + kstep, voffB); PG8_STAGE(PG8_SA(1, 0), cA + kstep, voffA); PG8_STAGE(PG8_SB(1, 1), cB + hstep + kstep, voffB);
        PG8_WAIT_V(6); PG8_BAR;
    }
    for (;;) {
        const bool has_next = S.next(ui + 1, nxt);
        const char* nA = has_next ? (const char*)g.A + (size_t)nxt.pm * tstep : cA; const char* nB = has_next ? (const char*)g.Bt + (size_t)nxt.pn * tstep : cB;
        for (int t = 0; t < nt; t += 2) {
            const bool last = (t == nt - 2);
            const char* a1 = cA + (size_t)(t + 1) * kstep;
            const char* a2 = last ? nA : cA + (size_t)(t + 2) * kstep; const char* b2 = last ? nB : cB + (size_t)(t + 2) * kstep;
            const char* a3 = a2 + kstep; const char* b3 = b2 + kstep;
            if (last && has_next) S.a_ready(nxt);
            if constexpr (SP2) {
            PG8_LDB(B0, 0, 0); PG8_LDB(B1, 0, 1); PG8_SCHED; PG8_LDA(At, 0, 0); PG8_STAGE(PG8_SA(1, 1), a1 + hstep, voffA);
            PG8_WAIT_V(8); PG8_WAIT_L(0); PG8_BAR; PG8_MMA(0, 0, At, B0); PG8_MMA(0, 1, At, B1); PG8_BAR; PG8_SCHED;
            PG8_LDA(At, 0, 1); PG8_STAGE(PG8_SB(0, 0), b2, voffB); PG8_STAGE(PG8_SB(0, 1), b2 + hstep, voffB); PG8_STAGE(PG8_SA(0, 0), a2, voffA);
            PG8_WAIT_V(8); PG8_WAIT_L(0); PG8_BAR; PG8_MMA(1, 0, At, B0); PG8_MMA(1, 1, At, B1); PG8_BAR; PG8_SCHED;
            PG8_LDB(B0, 1, 0); PG8_LDB(B1, 1, 1); PG8_SCHED; PG8_LDA(At, 1, 0); PG8_STAGE(PG8_SA(0, 1), a2 + hstep, voffA);
            PG8_WAIT_V(8); PG8_WAIT_L(0); PG8_BAR; PG8_MMA(0, 0, At, B0); PG8_MMA(0, 1, At, B1); PG8_BAR; PG8_SCHED;
            PG8_LDA(At, 1, 1); PG8_STAGE(PG8_SB(1, 0), b3, voffB); PG8_STAGE(PG8_SB(1, 1), b3 + hstep, voffB); PG8_STAGE(PG8_SA(1, 0), a3, voffA);
            PG8_WAIT_V(8); PG8_WAIT_L(0); PG8_BAR; PG8_MMA(1, 0, At, B0); PG8_MMA(1, 1, At, B1); PG8_BAR; PG8_SCHED;
            } else {
            PG8_LDB(B0, 0, 0); PG8_SCHED; PG8_LDA(At, 0, 0); PG8_STAGE(PG8_SA(1, 1), a1 + hstep, voffA);
            PG8_WAIT_L(8); PG8_BAR; PG8_WAIT_L(0); PG8_MMA(0, 0, At, B0); PG8_BAR; PG8_SCHED;
            PG8_LDB(B1, 0, 1); PG8_STAGE(PG8_SB(0, 0), b2, voffB);
            PG8_BAR; PG8_WAIT_L(0); PG8_MMA(0, 1, At, B1); PG8_BAR;
            PG8_LDA(At, 0, 1); PG8_STAGE(PG8_SA(0, 0), a2, voffA);
            PG8_BAR; PG8_WAIT_L(0); PG8_MMA(1, 0, At, B0); PG8_BAR; PG8_SCHED;
            PG8_STAGE(PG8_SB(0, 1), b2 + hstep, voffB);
            PG8_WAIT_V(6); PG8_BAR; PG8_MMA(1, 1, At, B1); PG8_BAR;
            PG8_LDB(B0, 1, 0); PG8_SCHED; PG8_LDA(At, 1, 0); PG8_STAGE(PG8_SA(0, 1), a2 + hstep, voffA);
            PG8_WAIT_L(8); PG8_BAR; PG8_WAIT_L(0); PG8_MMA(0, 0, At, B0); PG8_BAR; PG8_SCHED;
            PG8_LDB(B1, 1, 1); PG8_STAGE(PG8_SB(1, 0), b3, voffB);
            PG8_BAR; PG8_WAIT_L(0); PG8_MMA(0, 1, At, B1); PG8_BAR;
            PG8_LDA(At, 1, 1); PG8_STAGE(PG8_SA(1, 0), a3, voffA);
            PG8_BAR; PG8_WAIT_L(0); PG8_MMA(1, 0, At, B0); PG8_BAR; PG8_SCHED;
            PG8_STAGE(PG8_SB(1, 1), b3 + hstep, voffB);
            PG8_WAIT_V(6); PG8_BAR; PG8_MMA(1, 1, At, B1); PG8_BAR;
            }
        }
        if constexpr (ALIGN_EPI) { if (wr == 0) PG8_BAR; }
        if constexpr (!Epi::AFTER_DRAIN) { E(acc, cur, wr, wc, fr, fq); S.done(cur); }
        if (!has_next) break;
#pragma unroll
        for (int a = 0; a < 2; ++a)
#pragma unroll
            for (int b = 0; b < 2; ++b)
#pragma unroll
                for (int m = 0; m < 4; ++m)
#pragma unroll
                    for (int n = 0; n < 2; ++n) acc[a][b][m][n] = (f32x4){0.f, 0.f, 0.f, 0.f};
        cur = nxt; cA = nA; cB = nB; ++ui;
        if constexpr (ALIGN_EPI) { if (wr == 1) PG8_BAR; }
    }
    PG8_WAIT_V(0);
    if constexpr (!ALIGN_EPI) { if (wr == 0) PG8_BAR; }
    PG8_BAR;
    if constexpr (Epi::AFTER_DRAIN) { E.fused(acc, cur, wr, wc, fr, fq, lds, wid, lane); S.done(cur); }
#undef PG8_SA
#undef PG8_SB
#undef PG8_STAGE
#undef PG8_LDA
#undef PG8_LDB
#undef PG8_MMA
#undef PG8_WAIT_V
#undef PG8_WAIT_L
#undef PG8_BAR
#undef PG8_SCHED
}
}

namespace pg8 {
__device__ __forceinline__ float fast_silu(float g) { return g * __builtin_amdgcn_rcpf(1.0f + __expf(-g)); }
__device__ __forceinline__ float row_rs(const float* rss, int row) { return rsqrtf(rss[row] * (1.0f / D_MODEL) + EPS); }
struct EpiSwiglu {
    static constexpr bool PERM = true, AFTER_DRAIN = false;
    bf16_t* act; const float* rss;
    __device__ __forceinline__ void operator()(const f32x4 (&acc)[2][2][4][2], const Unit& u, int wr, int wc, int fr, int fq) const {
        const int row0 = u.pm * BM + wr * 64 + fr, col0 = u.pn * 128 + wc * 32 + 8 * fq;
#pragma unroll
        for (int ai = 0; ai < 2; ++ai)
#pragma unroll
            for (int m = 0; m < 4; ++m) {
                const int row = row0 + ai * HALF + m * 16; const float rs = row_rs(rss, row);
                float a[8];
#pragma unroll
                for (int n = 0; n < 2; ++n)
#pragma unroll
                    for (int i = 0; i < 4; ++i) a[n * 4 + i] = fast_silu(acc[ai][0][m][n][i] * rs) * (acc[ai][1][m][n][i] * rs);
                u32x4 w; w.x = cvt_pk_bf16(a[0], a[1]); w.y = cvt_pk_bf16(a[2], a[3]); w.z = cvt_pk_bf16(a[4], a[5]); w.w = cvt_pk_bf16(a[6], a[7]);
                *(u32x4*)(act + (size_t)row * D_FF + col0) = w;
            }
    }
};
struct EpiResid {
    static constexpr bool PERM = false, AFTER_DRAIN = false;
    float* h; bf16_t* hb; float* rss_next; float* yout; float coef;
    __device__ __forceinline__ void operator()(const f32x4 (&acc)[2][2][4][2], const Unit& u, int wr, int wc, int fr, int fq) const {
        const int row0 = u.pm * BM + wr * 64 + fr, col0 = u.pn * BM + wc * 32 + 4 * fq;
#pragma unroll
        for (int ai = 0; ai < 2; ++ai)
#pragma unroll
            for (int m = 0; m < 4; ++m) {
                const int row = row0 + ai * HALF + m * 16; float s = 0.f;
                float* hr = h + (size_t)row * D_MODEL + col0;
#pragma unroll
                for (int bj = 0; bj < 2; ++bj)
#pragma unroll
                    for (int n = 0; n < 2; ++n) {
                        const int co = bj * HALF + n * 16;
                        const f32x4 v = *(const f32x4*)(hr + co) + acc[ai][bj][m][n] * coef;
                        if (yout) { *(f32x4*)(yout + (size_t)row * D_MODEL + col0 + co) = v; }
                        else {
                            *(f32x4*)(hr + co) = v;
                            typedef unsigned u32x2 __attribute__((ext_vector_type(2)));
                            u32x2 w; w.x = cvt_pk_bf16(v[0], v[1]); w.y = cvt_pk_bf16(v[2], v[3]);
                            *(u32x2*)(hb + (size_t)row * D_MODEL + col0 + co) = w;
                            s += (v[0] * v[0] + v[1] * v[1]) + (v[2] * v[2] + v[3] * v[3]);
                        }
                    }
                if (!yout) { s += __shfl_xor(s, 16); s += __shfl_xor(s, 32); if (fq == 0) (void)__hip_atomic_fetch_add(rss_next + row, s, __ATOMIC_RELAXED, __HIP_MEMORY_SCOPE_AGENT); }
            }
    }
};
}
namespace pg8 {
__device__ __forceinline__ float sum4(f32x4 v) { return (v[0] * v[0] + v[1] * v[1]) + (v[2] * v[2] + v[3] * v[3]); }
struct EpiConvIn {
    static constexpr bool PERM = true, AFTER_DRAIN = false;
    bf16_t* ub; bf16_t* bb; const float* rss; float* out; int layer;
    __device__ __forceinline__ void operator()(const f32x4 (&acc)[2][2][4][2], const Unit& u, int wr, int wc, int fr, int fq) const {
        const int row0 = u.pm * BM + wr * 64 + fr;
        const bool pair = u.pn < D_MODEL / 128;
#pragma unroll
        for (int ai = 0; ai < 2; ++ai)
#pragma unroll
            for (int m = 0; m < 4; ++m) {
                const int row = row0 + ai * HALF + m * 16; const float rs = row_rs(rss, row);
                if (pair) {
                    const int col0 = u.pn * 128 + wc * 32 + 8 * fq; float a[8];
#pragma unroll
                    for (int n = 0; n < 2; ++n)
#pragma unroll
                        for (int i = 0; i < 4; ++i) a[n * 4 + i] = (acc[ai][0][m][n][i] * rs) * (acc[ai][1][m][n][i] * rs);
                    u32x4 w; w.x = cvt_pk_bf16(a[0], a[1]); w.y = cvt_pk_bf16(a[2], a[3]); w.z = cvt_pk_bf16(a[4], a[5]); w.w = cvt_pk_bf16(a[6], a[7]);
                    *(u32x4*)(ub + (size_t)row * D_MODEL + col0) = w;
                    const RowInfo ri = row_info(row); const int jj = ri.t - (seq_len(ri.seq) - 2);
                    if (jj >= 0) {
                        float* cs = (ri.seq < BATCH) ? out + O_CP + (((size_t)layer * BATCH + ri.seq) * 2 + jj) * D_MODEL + col0 : out + O_CS + (((size_t)layer * DEC_BATCH + (ri.seq - BATCH)) * 2 + jj) * D_MODEL + col0;
                        *(f32x4*)(cs) = (f32x4){a[0], a[1], a[2], a[3]}; *(f32x4*)(cs + 4) = (f32x4){a[4], a[5], a[6], a[7]};
                    }
                } else {
#pragma unroll
                    for (int bj = 0; bj < 2; ++bj) {
                        const int col0 = (u.pn - D_MODEL / 128) * 256 + bj * HALF + wc * 32 + 8 * fq;
                        const f32x4 v0 = acc[ai][bj][m][0] * rs, v1 = acc[ai][bj][m][1] * rs;
                        u32x4 w; w.x = cvt_pk_bf16(v0[0], v0[1]); w.y = cvt_pk_bf16(v0[2], v0[3]); w.z = cvt_pk_bf16(v1[0], v1[1]); w.w = cvt_pk_bf16(v1[2], v1[3]);
                        *(u32x4*)(bb + (size_t)row * D_MODEL + col0) = w;
                    }
                }
                asm volatile("" ::: "memory");
            }
    }
};
__device__ __forceinline__ void head_norm_rope(f32x4 (&v)[2][2], const float* gain, const float* rt  , int fq, bool do_norm, bool do_rope, f32x4 (&rot0)[2]) {
    if (do_norm) {
        float ss = (sum4(v[0][0]) + sum4(v[0][1])) + (sum4(v[1][0]) + sum4(v[1][1]));
        ss += __shfl_xor(ss, 16); ss += __shfl_xor(ss, 32);
        const float r = rsqrtf(ss * (1.0f / HD) + EPS);
#pragma unroll
        for (int bj = 0; bj < 2; ++bj)
#pragma unroll
            for (int n = 0; n < 2; ++n) { const f32x4 g = *(const f32x4*)(gain + 32 * bj + 8 * fq + 4 * n); v[bj][n] = v[bj][n] * r * g; }
    }
    rot0[0] = v[0][0]; rot0[1] = v[0][1];
    if (do_rope) {
#pragma unroll
        for (int n = 0; n < 2; ++n) {
            f32x4 p;
#pragma unroll
            for (int i = 0; i < 4; ++i) p[i] = __shfl_xor(v[0][n][i], 16);
            const f32x4 c = *(const f32x4*)(rt + 4 * n), s = *(const f32x4*)(rt + 8 + 4 * n);
            if (fq == 0) rot0[n] = v[0][n] * c - p * s; else if (fq == 1) rot0[n] = v[0][n] * c + p * s;
        }
    }
}
struct EpiQG {
    static constexpr bool PERM = true, AFTER_DRAIN = false;
    float* qn; float* qr; float* gates; const float* rss; const float* q_norm; const float* rope;
    __device__ __forceinline__ void operator()(const f32x4 (&acc)[2][2][4][2], const Unit& u, int wr, int wc, int fr, int fq) const {
        const int row0 = u.pm * BM + wr * 64 + fr;
#pragma unroll
        for (int ai = 0; ai < 2; ++ai)
#pragma unroll
            for (int m = 0; m < 4; ++m) {
                const int row = row0 + ai * HALF + m * 16; const float rs = row_rs(rss, row);
                if (u.pn < N_HEADS / 4) {
                    const int hh = u.pn * 4 + wc;
                    f32x4 v[2][2] = {{acc[ai][0][m][0] * rs, acc[ai][0][m][1] * rs}, {acc[ai][1][m][0] * rs, acc[ai][1][m][1] * rs}}; f32x4 rot0[2];
                    head_norm_rope(v, q_norm, rope + (size_t)pos_index(row_info(row).pos) * 16, fq, true, true, rot0);
                    float* qnp = qn + (size_t)row * HDM + hh * HD + 8 * fq; float* qrp = qr + (size_t)row * HDM + hh * HD + 8 * fq;
                    *(f32x4*)(qnp) = v[0][0]; *(f32x4*)(qnp + 4) = v[0][1]; *(f32x4*)(qnp + 32) = v[1][0]; *(f32x4*)(qnp + 36) = v[1][1];
                    *(f32x4*)(qrp) = rot0[0]; *(f32x4*)(qrp + 4) = rot0[1]; *(f32x4*)(qrp + 32) = v[1][0]; *(f32x4*)(qrp + 36) = v[1][1];
                } else {
                    const int c0 = wc * 32 + 8 * fq;
#pragma unroll
                    for (int n = 0; n < 2; ++n)
#pragma unroll
                        for (int i = 0; i < 4; ++i) { const int c = c0 + 4 * n + i; if (c < 3 * N_HEADS) gates[(size_t)row * 3 * N_HEADS + c] = __builtin_amdgcn_rcpf(1.0f + __expf(-(acc[ai][0][m][n][i] * rs))); }
                }
                asm volatile("" ::: "memory");
            }
    }
};
struct EpiKV {
    static constexpr bool PERM = true, AFTER_DRAIN = false;
    float* out; float* winrows; const float* rss; const float* k_norm; const float* rope;
    __device__ __forceinline__ void operator()(const f32x4 (&acc)[2][2][4][2], const Unit& u, int wr, int wc, int fr, int fq) const {
        const int row0 = u.pm * BM + wr * 64 + fr;
        const int hidx = u.pn * 4 + wc, e = hidx / N_KV, g = hidx % N_KV; const bool nr = (e == 2 || e == 4);
#pragma unroll
        for (int ai = 0; ai < 2; ++ai)
#pragma unroll
            for (int m = 0; m < 4; ++m) {
                const int row = row0 + ai * HALF + m * 16; const float rs = row_rs(rss, row);
                const RowInfo ri = row_info(row);
                f32x4 v[2][2] = {{acc[ai][0][m][0] * rs, acc[ai][0][m][1] * rs}, {acc[ai][1][m][0] * rs, acc[ai][1][m][1] * rs}}; f32x4 rot0[2];
                head_norm_rope(v, k_norm + (e == 2 ? 1 : 2) * HD, rope + (size_t)pos_index(ri.pos) * 16, fq, nr, nr, rot0);
                float* d0; float* d1 = nullptr;
                if (e < 4) d0 = (ri.seq < BATCH) ? out + O_KVP + (((size_t)row * 4 + e) * N_KV + g) * HD : out + O_KVS + (((size_t)(row - MP) * 4 + e) * N_KV + g) * HD;
                else { const int we = e - 4; d0 = winrows + (((size_t)row * 2 + we) * N_KV + g) * HD;
                    if (ri.seq < BATCH) { if (ri.t >= SEQ - WINDOW) d1 = out + O_WP + ((((size_t)ri.seq * WINDOW + (ri.t - (SEQ - WINDOW))) * 2 + we) * N_KV + g) * HD; }
                    else d1 = out + O_WS + ((((size_t)(ri.seq - BATCH) * WINDOW + (WINDOW - DEC_SEQ + ri.t)) * 2 + we) * N_KV + g) * HD; }
                d0 += 8 * fq; *(f32x4*)(d0) = rot0[0]; *(f32x4*)(d0 + 4) = rot0[1]; *(f32x4*)(d0 + 32) = v[1][0]; *(f32x4*)(d0 + 36) = v[1][1];
                if (d1) { d1 += 8 * fq; *(f32x4*)(d1) = rot0[0]; *(f32x4*)(d1 + 4) = rot0[1]; *(f32x4*)(d1 + 32) = v[1][0]; *(f32x4*)(d1 + 36) = v[1][1]; }
                asm volatile("" ::: "memory");
            }
    }
};
}

namespace pg8 {
struct EpiGelu {
    static constexpr bool PERM = true, AFTER_DRAIN = false;
    bf16_t* hid;
    __device__ __forceinline__ void operator()(const f32x4 (&acc)[2][2][4][2], const Unit& u, int wr, int wc, int fr, int fq) const {
        const int row0 = u.pm * BM + wr * 64 + fr;
#pragma unroll
        for (int ai = 0; ai < 2; ++ai)
#pragma unroll
            for (int m = 0; m < 4; ++m) {
                const int row = row0 + ai * HALF + m * 16;
#pragma unroll
                for (int bj = 0; bj < 2; ++bj) {
                    float a[8];
#pragma unroll
                    for (int n = 0; n < 2; ++n)
#pragma unroll
                        for (int i = 0; i < 4; ++i) { const float x = acc[ai][bj][m][n][i]; a[n * 4 + i] = x * __builtin_amdgcn_rcpf(1.0f + __expf(-1.5957691216057308f * (x + 0.044715f * x * x * x))); }
                    u32x4 w; w.x = cvt_pk_bf16(a[0], a[1]); w.y = cvt_pk_bf16(a[2], a[3]); w.z = cvt_pk_bf16(a[4], a[5]); w.w = cvt_pk_bf16(a[6], a[7]);
                    *(u32x4*)(hid + (size_t)row * CMP_HID + bj * HALF + wc * 32 + 8 * fq) = w;
                }
            }
    }
};
struct CmpOrder {
    int nunits, per_e, G, c;
    __device__ bool next(int i, Unit& u) const { const int L = i * G + c; if (L >= nunits) return false; u.pm = L; u.pn = L / per_e; return true; }
    __device__ __forceinline__ void a_ready(const Unit&) const {}
    __device__ __forceinline__ void done(const Unit&) const {}
};
}
constexpr int LDS_RING_C = 131072;
namespace att {
typedef short bf16x8 __attribute__((ext_vector_type(8)));
typedef short s16x4 __attribute__((ext_vector_type(4)));
typedef float f32x16 __attribute__((ext_vector_type(16)));
typedef __attribute__((address_space(3))) unsigned char* ldsp;
constexpr int TILE_B = 8192;
constexpr int L_KB = 0, L_VB = 2 * TILE_B, L_IMP = 4 * TILE_B, L_SELM = L_IMP + 64 * 64 * 4, L_END = L_SELM + 64 * 8;
constexpr float NEGB = -1e30f;
constexpr float QSCALE = 0.125f * 1.4426950408889634f;
__device__ __forceinline__ int crow(int r, int hi) { return (r & 3) + 8 * (r >> 2) + 4 * hi; }
__device__ __forceinline__ void glds16(const void* gsrc, unsigned lds_dst) { unsigned keep;
    asm volatile("s_mov_b32 %0, m0\n\ts_mov_b32 m0, %2\n\ts_nop 0\n\tglobal_load_lds_dwordx4 %1, off\n\ts_mov_b32 m0, %0" : "=&s"(keep) : "v"(gsrc), "s"(lds_dst) : "memory"); }
__device__ __forceinline__ unsigned cvtpk(float lo, float hi) { unsigned r; asm volatile("v_cvt_pk_bf16_f32 %0, %1, %2" : "=v"(r) : "v"(lo), "v"(hi)); return r; }
__device__ __forceinline__ float halfmax(float m) { auto rr = __builtin_amdgcn_permlane32_swap(__float_as_uint(m), __float_as_uint(m), false, false); return fmaxf(__uint_as_float(rr[0]), __uint_as_float(rr[1])); }
__device__ __forceinline__ float halfsum(float m) { auto rr = __builtin_amdgcn_permlane32_swap(__float_as_uint(m), __float_as_uint(m), false, false); return __uint_as_float(rr[0]) + __uint_as_float(rr[1]); }
__device__ __forceinline__ s16x4 vtr(ldsp p) { typedef short v4i16_t __attribute__((ext_vector_type(4))); return __builtin_bit_cast(s16x4, __builtin_amdgcn_ds_read_tr16_b64_v4i16((__attribute__((address_space(3))) v4i16_t*)p)); }
#define ATT_BAR_L() asm volatile("s_waitcnt lgkmcnt(0)\n\ts_barrier" ::: "memory")
#define ATT_WAIT_BAR(N) asm volatile("s_waitcnt vmcnt(" #N ") lgkmcnt(0)\n\ts_barrier" ::: "memory")
__device__ __forceinline__ void dma_tile(const unsigned char* img, unsigned lds_dst, int wid, int lane) { glds16(img + wid * 1024 + lane * 16, (unsigned)__builtin_amdgcn_readfirstlane(lds_dst + wid * 1024)); }
__device__ __forceinline__ void qk(f32x16& p0, f32x16& p1, ldsp kbuf, const bf16x8 (&qf)[4], float cinit, int r32, int hi) {
    f32x16 c;
#pragma unroll
    for (int r = 0; r < 16; ++r) c[r] = cinit;
    p0 = c; p1 = c;
#pragma unroll
    for (int s = 0; s < 4; ++s) {
        const bf16x8 k0 = *(const __attribute__((address_space(3))) bf16x8*)(kbuf + (2 * s + hi) * 1024 + r32 * 16);
        const bf16x8 k1 = *(const __attribute__((address_space(3))) bf16x8*)(kbuf + (2 * s + hi) * 1024 + r32 * 16 + 512);
        p0 = __builtin_amdgcn_mfma_f32_32x32x16_bf16(k0, qf[s], p0, 0, 0, 0);
        p1 = __builtin_amdgcn_mfma_f32_32x32x16_bf16(k1, qf[s], p1, 0, 0, 0);
    }
}
__device__ __forceinline__ void pv(f32x16 (&o)[2], ldsp vbuf, const f32x16& p0, const f32x16& p1, int lane, int hi) {
    unsigned pk[4][4];
#pragma unroll
    for (int k = 0; k < 4; ++k) { pk[0][k] = cvtpk(p0[2 * k], p0[2 * k + 1]); pk[1][k] = cvtpk(p0[8 + 2 * k], p0[9 + 2 * k]); pk[2][k] = cvtpk(p1[2 * k], p1[2 * k + 1]); pk[3][k] = cvtpk(p1[8 + 2 * k], p1[9 + 2 * k]); }
    const int vp0 = ((lane >> 4) & 1) * 32 + (lane & 3) * 8 + (4 * hi + ((lane & 15) >> 2)) * 64;
#pragma unroll
    for (int d0 = 0; d0 < 2; ++d0)
#pragma unroll
        for (int s = 0; s < 4; ++s) {
            const s16x4 lo = vtr(vbuf + d0 * 4096 + s * 1024 + vp0), hh = vtr(vbuf + d0 * 4096 + s * 1024 + 512 + vp0);
            const bf16x8 vf = (bf16x8){lo[0], lo[1], lo[2], lo[3], hh[0], hh[1], hh[2], hh[3]};
            typedef unsigned u32x4 __attribute__((ext_vector_type(4)));
            const u32x4 pw = (u32x4){pk[s][0], pk[s][1], pk[s][2], pk[s][3]};
            o[d0] = __builtin_amdgcn_mfma_f32_32x32x16_bf16(vf, __builtin_bit_cast(bf16x8, pw), o[d0], 0, 0, 0);
        }
}
struct Run { float m, l; f32x16 o[2]; };
template <bool EMASK> __device__ __forceinline__ void tile_step(Run& R, ldsp kbuf, ldsp vbuf, const bf16x8 (&qf)[4], float cinit, int lo_b_, int hi_b_, int lane, int r32, int hi) {
    int lo_b = lo_b_ - 4 * hi, hi_b = hi_b_ - 4 * hi;
    if (EMASK) asm volatile("" : "+v"(lo_b), "+v"(hi_b));
    f32x16 p0, p1; qk(p0, p1, kbuf, qf, cinit, r32, hi);
    if (EMASK) {
#pragma unroll
        for (int r = 0; r < 16; ++r) { const int kc_ = (r & 3) + 8 * (r >> 2); if (kc_ < lo_b || kc_ > hi_b) p0[r] = NEGB; if (kc_ + 32 < lo_b || kc_ + 32 > hi_b) p1[r] = NEGB; }
    }
    float rm = fmaxf(p0[0], p1[0]);
#pragma unroll
    for (int r = 1; r < 16; ++r) rm = fmaxf(rm, fmaxf(p0[r], p1[r]));
    rm = halfmax(rm);
    const float mn = fmaxf(R.m, rm), alpha = __builtin_amdgcn_exp2f(R.m - mn);
    R.m = mn; R.l *= alpha;
#pragma unroll
    for (int r = 0; r < 16; ++r) { R.o[0][r] *= alpha; R.o[1][r] *= alpha; }
    float ls = 0.f;
#pragma unroll
    for (int r = 0; r < 16; ++r) {
        float e0 = __builtin_amdgcn_exp2f(p0[r] - mn), e1 = __builtin_amdgcn_exp2f(p1[r] - mn);
        if (EMASK) { const int kc_ = (r & 3) + 8 * (r >> 2); if (kc_ < lo_b || kc_ > hi_b) e0 = 0.f; if (kc_ + 32 < lo_b || kc_ + 32 > hi_b) e1 = 0.f; }
        p0[r] = e0; p1[r] = e1; ls += e0 + e1;
    }
    R.l += ls;
    pv(R.o, vbuf, p0, p1, lane, hi);
}
struct Tensors {
    const bf16_t* qn; const bf16_t* qr;
    const unsigned char* ksel; const unsigned char* vsel; const unsigned char* kwin; const unsigned char* vwin;
    const unsigned char* kc; const unsigned char* vc;
    const float* gates; bf16_t* ob;
};
template <bool SEL> __device__ __forceinline__ void branch(Run& R, const unsigned char* kimg, const unsigned char* vimg, int t0, int t1, int jdiag, unsigned long long selm, int iq,
                                                           const bf16x8 (&qf)[4], unsigned lds0, ldsp lds, int wid, int lane, int r32, int hi) {
    R.m = NEGB; R.l = 0.f;
#pragma unroll
    for (int r = 0; r < 16; ++r) { R.o[0][r] = 0.f; R.o[1][r] = 0.f; }
    dma_tile(kimg + (size_t)t0 * TILE_B, lds0 + L_KB, wid, lane); dma_tile(vimg + (size_t)t0 * TILE_B, lds0 + L_VB, wid, lane);
    for (int t = t0; t <= t1; ++t) {
        const int b = (t - t0) & 1;
        if (t < t1) { dma_tile(kimg + (size_t)(t + 1) * TILE_B, lds0 + L_KB + (b ^ 1) * TILE_B, wid, lane); dma_tile(vimg + (size_t)(t + 1) * TILE_B, lds0 + L_VB + (b ^ 1) * TILE_B, wid, lane); ATT_WAIT_BAR(2); }
        else ATT_WAIT_BAR(0);
        const float cinit = (!SEL || ((selm >> t) & 1ull)) ? 0.f : NEGB;
        const bool lowm = !SEL && (t == jdiag - 8);
        if (t == jdiag || lowm) tile_step<true>(R, lds + L_KB + b * TILE_B, lds + L_VB + b * TILE_B, qf, cinit, lowm ? iq : 0, (t == jdiag) ? iq : 63, lane, r32, hi);
        else tile_step<false>(R, lds + L_KB + b * TILE_B, lds + L_VB + b * TILE_B, qf, cinit, 0, 63, lane, r32, hi);
        ATT_BAR_L();
    }
}
__device__ __forceinline__ void load_q(bf16x8 (&qf)[4], const bf16_t* qrow, int hi) {
#pragma unroll
    for (int s = 0; s < 4; ++s) qf[s] = *(const bf16x8*)(qrow + 16 * s + 8 * hi);
}
__device__ __forceinline__ void unit(const Tensors& T, int n, int j, int g, ldsp lds, unsigned lds0, int wid, int lane) {
    const int r32 = lane & 31, hi = lane >> 5, ql = r32 >> 2, hq = r32 & 3, iq = 8 * wid + ql;
    const int row = n * SEQ + 64 * j + iq, head = g * HPG + hq, pos = 64 * j + iq;
    const size_t img_ng = ((size_t)n * N_KV + g);
    f32x16 oacc[2];
#pragma unroll
    for (int r = 0; r < 16; ++r) { oacc[0][r] = 0.f; oacc[1][r] = 0.f; }
    const float* gt = T.gates + (size_t)row * 3 * N_HEADS + head * 3;
    const float g_c = gt[0], g_s = gt[1], g_w = gt[2];
    bf16x8 qf[4];
    unsigned long long selm;
    {
        load_q(qf, T.qn + (size_t)row * HDM + head * HD, hi);
        const int ntc = (2 * j + 2 + 63) / 64;
        const unsigned char* kci = T.kc + img_ng * (NBC_P / 64) * TILE_B; const unsigned char* vci = T.vc + img_ng * (NBC_P / 64) * TILE_B;
        dma_tile(kci, lds0 + L_KB, wid, lane); dma_tile(vci, lds0 + L_VB, wid, lane);
        if (ntc > 1) { dma_tile(kci + TILE_B, lds0 + L_KB + TILE_B, wid, lane); dma_tile(vci + TILE_B, lds0 + L_VB + TILE_B, wid, lane); }
        ATT_WAIT_BAR(0);
        int cmax = ((pos + 1) >> 5) - 1 - 4 * hi;
        asm volatile("" : "+v"(cmax));
        f32x16 s0, s1, s2, s3;
        qk(s0, s1, lds + L_KB, qf, 0.f, r32, hi);
        if (ntc > 1) qk(s2, s3, lds + L_KB + TILE_B, qf, 0.f, r32, hi);
        else {
#pragma unroll
            for (int r = 0; r < 16; ++r) { s2[r] = NEGB; s3[r] = NEGB; }
        }
        float mx = NEGB;
#pragma unroll
        for (int r = 0; r < 16; ++r) { const int kv = (r & 3) + 8 * (r >> 2);
            if (kv > cmax) s0[r] = NEGB; if (kv + 32 > cmax) s1[r] = NEGB; if (kv + 64 > cmax) s2[r] = NEGB; if (kv + 96 > cmax) s3[r] = NEGB;
            mx = fmaxf(fmaxf(mx, fmaxf(s0[r], s1[r])), fmaxf(s2[r], s3[r])); }
        mx = halfmax(mx);
        float ls = 0.f;
#pragma unroll
        for (int r = 0; r < 16; ++r) { const int kv = (r & 3) + 8 * (r >> 2);
            s0[r] = (kv > cmax) ? 0.f : __builtin_amdgcn_exp2f(s0[r] - mx); s1[r] = (kv + 32 > cmax) ? 0.f : __builtin_amdgcn_exp2f(s1[r] - mx);
            s2[r] = (kv + 64 > cmax) ? 0.f : __builtin_amdgcn_exp2f(s2[r] - mx); s3[r] = (kv + 96 > cmax) ? 0.f : __builtin_amdgcn_exp2f(s3[r] - mx);
            ls += (s0[r] + s1[r]) + (s2[r] + s3[r]); }
        ls = halfsum(ls);
        const float inv = 1.0f / fmaxf(ls, 1e-30f);
#pragma unroll
        for (int r = 0; r < 16; ++r) { s0[r] *= inv; s1[r] *= inv; s2[r] *= inv; s3[r] *= inv; }
        __attribute__((address_space(3))) float* imp = (__attribute__((address_space(3))) float*)(lds + L_IMP) + iq * 64;
#pragma unroll
        for (int r = 0; r < 16; r += 2) { const int bl = crow(r, hi) >> 1;
            float v0 = s0[r] + s0[r + 1], v1 = s1[r] + s1[r + 1], v2 = s2[r] + s2[r + 1], v3 = s3[r] + s3[r + 1];
            v0 += __shfl_xor(v0, 1); v0 += __shfl_xor(v0, 2); v1 += __shfl_xor(v1, 1); v1 += __shfl_xor(v1, 2);
            v2 += __shfl_xor(v2, 1); v2 += __shfl_xor(v2, 2); v3 += __shfl_xor(v3, 1); v3 += __shfl_xor(v3, 2);
            if (hq == 0) { imp[bl] = v0; imp[16 + bl] = v1; imp[32 + bl] = v2; imp[48 + bl] = v3; } }
        Run Rc;
#pragma unroll
        for (int r = 0; r < 16; ++r) { Rc.o[0][r] = 0.f; Rc.o[1][r] = 0.f; }
        pv(Rc.o, lds + L_VB, s0, s1, lane, hi);
        if (ntc > 1) pv(Rc.o, lds + L_VB + TILE_B, s2, s3, lane, hi);
#pragma unroll
        for (int r = 0; r < 16; ++r) { oacc[0][r] += g_c * Rc.o[0][r]; oacc[1][r] += g_c * Rc.o[1][r]; }
        asm volatile("s_waitcnt lgkmcnt(0)" ::: "memory");
        __attribute__((address_space(3))) unsigned long long* selw = (__attribute__((address_space(3))) unsigned long long*)(lds + L_SELM);
        for (int qq = 0; qq < 8; ++qq) {
            const float v = ((__attribute__((address_space(3))) float*)(lds + L_IMP))[(8 * wid + qq) * 64 + lane];
            const bool valid = lane <= j, forced = (lane == 0) || (lane == j) || (lane == j - 1);
            const unsigned key = valid ? (forced ? 0x7f000000u : __float_as_uint(v) + 1u) : 0u;
            unsigned long long m;
            if (j + 1 <= N_SEL) m = __ballot(valid);
            else {
                unsigned Tt = 0u;
                for (int bit = 30; bit >= 0; --bit) { const unsigned cand = Tt | (1u << bit); if (__popcll(__ballot(key >= cand)) >= N_SEL) Tt = cand; }
                const unsigned long long gtm = __ballot(key > Tt), eqm = __ballot(key == Tt);
                const int need = N_SEL - __popcll(gtm);
                const bool pick = (key == Tt) && (__popcll(eqm & ((1ull << lane) - 1ull)) < need);
                m = gtm | __ballot(pick);
            }
            if (lane == 0) selw[8 * wid + qq] = m;
        }
        asm volatile("s_waitcnt lgkmcnt(0)" ::: "memory");
        selm = selw[iq];
        ATT_WAIT_BAR(0);
    }
    load_q(qf, T.qr + (size_t)row * HDM + head * HD, hi);
    {
        Run R; branch<true>(R, T.ksel + img_ng * (SEQ / 64) * TILE_B, T.vsel + img_ng * (SEQ / 64) * TILE_B, 0, j, j, selm, iq, qf, lds0, lds, wid, lane, r32, hi);
        const float sc = g_s / fmaxf(halfsum(R.l), 1e-30f);
#pragma unroll
        for (int r = 0; r < 16; ++r) { oacc[0][r] += sc * R.o[0][r]; oacc[1][r] += sc * R.o[1][r]; }
    }
    {
        Run R; branch<false>(R, T.kwin + img_ng * (SEQ / 64) * TILE_B, T.vwin + img_ng * (SEQ / 64) * TILE_B, j > 8 ? j - 8 : 0, j, j, 0ull, iq, qf, lds0, lds, wid, lane, r32, hi);
        const float sc = g_w / fmaxf(halfsum(R.l), 1e-30f);
#pragma unroll
        for (int r = 0; r < 16; ++r) { oacc[0][r] += sc * R.o[0][r]; oacc[1][r] += sc * R.o[1][r]; }
    }
    bf16_t* orow = T.ob + (size_t)row * HDM + head * HD;
#pragma unroll
    for (int d0 = 0; d0 < 2; ++d0)
#pragma unroll
        for (int rr = 0; rr < 4; ++rr) { typedef unsigned u32x2 __attribute__((ext_vector_type(2)));
            u32x2 w; w.x = cvtpk(oacc[d0][4 * rr], oacc[d0][4 * rr + 1]); w.y = cvtpk(oacc[d0][4 * rr + 2], oacc[d0][4 * rr + 3]);
            *(u32x2*)(orow + 32 * d0 + 8 * rr + 4 * hi) = w; }
}
__device__ __forceinline__ void phase(const Tensors& T, ldsp lds, int wid, int lane, int cu, int ncu) {
    const unsigned lds0 = (unsigned)(uintptr_t)lds;
    constexpr int NQB = SEQ / 64, NGRP = NQB / 4;
    for (int c = cu; c < BATCH * N_KV * NGRP; c += ncu) {
        const int ng = c / NGRP, s = c % NGRP, n = ng / N_KV, g = ng % N_KV;
        for (int k = 0; k < 4; ++k) { const int j = (k == 0) ? s : (k == 1) ? NQB / 2 - 1 - s : (k == 2) ? NQB / 2 + s : NQB - 1 - s; unit(T, n, j, g, lds, lds0, wid, lane); }
    }
}
}
namespace att {
constexpr int S_STAGE = 16384;
constexpr int S_XM = LDS_RING_C + 1024, S_XL = S_XM + 1024, S_IMP = S_XL + 1024, S_SELM = S_IMP + 8 * 128 * 4, S_END = S_SELM + 8 * 2 * 8;
struct STensors {
    const bf16_t* qn; const bf16_t* qr; const float* kc; const float* vc; const float* cache_kv; const int* page_table; const float* cache_win; const float* out; const float* winrows;
    const float* gates; bf16_t* ob;
};
typedef float f32x4_t __attribute__((ext_vector_type(4)));
__device__ __forceinline__ void stage_kv(ldsp kimg, ldsp vimg, const float* ksrc, const float* vsrc, int stride, int nrows, int lane) {
    typedef unsigned u32x4 __attribute__((ext_vector_type(4)));
    const int c = lane & 7;
#pragma unroll 1
    for (int ib = 0; ib < 8; ib += 4)
#pragma unroll
    for (int it = ib; it < ib + 4; ++it) {
        const int row = 8 * it + (lane >> 3);
        f32x4_t k0 = {0.f, 0.f, 0.f, 0.f}, k1 = k0, v0 = k0, v1 = k0;
        if (row < nrows) { const float* kp = ksrc + (size_t)row * stride + 8 * c; const float* vp = vsrc + (size_t)row * stride + 8 * c;
            k0 = *(const f32x4_t*)kp; k1 = *(const f32x4_t*)(kp + 4); v0 = *(const f32x4_t*)vp; v1 = *(const f32x4_t*)(vp + 4); }
        u32x4 kw, vw; kw.x = cvtpk(k0[0], k0[1]); kw.y = cvtpk(k0[2], k0[3]); kw.z = cvtpk(k1[0], k1[1]); kw.w = cvtpk(k1[2], k1[3]);
        vw.x = cvtpk(v0[0], v0[1]); vw.y = cvtpk(v0[2], v0[3]); vw.z = cvtpk(v1[0], v1[1]); vw.w = cvtpk(v1[2], v1[3]);
        *(__attribute__((address_space(3))) u32x4*)(kimg + c * 1024 + row * 16) = kw;
        *(__attribute__((address_space(3))) u32x4*)(vimg + (c >> 2) * 4096 + (row >> 3) * 512 + (row & 7) * 64 + (c & 3) * 16) = vw;
    }
    asm volatile("s_waitcnt lgkmcnt(0)" ::: "memory");
}
#define ATT_BAR_ALL() asm volatile("s_waitcnt vmcnt(0) lgkmcnt(0)\n\ts_barrier" ::: "memory")
__device__ __forceinline__ float merge_stats(ldsp lds, float m_own, float l_own_half, int wid, int r32, int hi) {
    __attribute__((address_space(3))) float* xm = (__attribute__((address_space(3))) float*)(lds + S_XM); __attribute__((address_space(3))) float* xl = (__attribute__((address_space(3))) float*)(lds + S_XL);
    const float l_own = halfsum(l_own_half);
    if (hi == 0) { xm[wid * 32 + r32] = m_own; xl[wid * 32 + r32] = l_own; }
    ATT_BAR_ALL();
    float M = NEGB;
#pragma unroll
    for (int w = 0; w < 8; ++w) M = fmaxf(M, xm[w * 32 + r32]);
    float L = 0.f;
#pragma unroll
    for (int w = 0; w < 8; ++w) L += __builtin_amdgcn_exp2f(xm[w * 32 + r32] - M) * xl[w * 32 + r32];
    const float wgt = __builtin_amdgcn_exp2f(m_own - M) / fmaxf(L, 1e-30f);
    ATT_BAR_ALL();
    return wgt;
}
__device__ __forceinline__ void sample_unit(const STensors& T, int b, int g, ldsp lds, int wid, int lane) {
    const int r32 = lane & 31, hi = lane >> 5, ql = r32 >> 2, hq = r32 & 3;
    const int row = MP + b * DEC_SEQ + ql, head = g * HPG + hq, seq = BATCH + b;
    ldsp kimg = lds + wid * S_STAGE, vimg = kimg + TILE_B;
    f32x16 oacc[2];
#pragma unroll
    for (int r = 0; r < 16; ++r) { oacc[0][r] = 0.f; oacc[1][r] = 0.f; }
    const float* gt = T.gates + (size_t)row * 3 * N_HEADS + head * 3;
    const float g_c = gt[0], g_s = gt[1], g_w = gt[2];
    bf16x8 qf[4];
    __attribute__((address_space(3))) float* xm = (__attribute__((address_space(3))) float*)(lds + S_XM); __attribute__((address_space(3))) float* xl = (__attribute__((address_space(3))) float*)(lds + S_XL);
    __attribute__((address_space(3))) float* imp = (__attribute__((address_space(3))) float*)(lds + S_IMP);
    __attribute__((address_space(3))) unsigned long long* selw = (__attribute__((address_space(3))) unsigned long long*)(lds + S_SELM);
    {
        load_q(qf, T.qn + (size_t)row * HDM + head * HD, hi);
        constexpr int NTC = NBC_PAST / 64;
        f32x16 p0, p1; const bool mine = wid < NTC;
        float rm = NEGB;
        if (mine) {
            const float* kcp = T.kc + (((size_t)seq * NBC_MAX + 64 * wid) * N_KV + g) * HD; const float* vcp = T.vc + (((size_t)seq * NBC_MAX + 64 * wid) * N_KV + g) * HD;
            stage_kv(kimg, vimg, kcp, vcp, N_KV * HD, 64, lane);
            qk(p0, p1, kimg, qf, 0.f, r32, hi);
#pragma unroll
            for (int r = 0; r < 16; ++r) rm = fmaxf(rm, fmaxf(p0[r], p1[r]));
            rm = halfmax(rm);
        }
        if (hi == 0) xm[wid * 32 + r32] = rm;
        ATT_BAR_ALL();
        float M = NEGB;
#pragma unroll
        for (int w = 0; w < 8; ++w) M = fmaxf(M, xm[w * 32 + r32]);
        float ls = 0.f;
        if (mine) {
#pragma unroll
            for (int r = 0; r < 16; ++r) { p0[r] = __builtin_amdgcn_exp2f(p0[r] - M); p1[r] = __builtin_amdgcn_exp2f(p1[r] - M); ls += p0[r] + p1[r]; }
            ls = halfsum(ls);
        }
        if (hi == 0) xl[wid * 32 + r32] = ls;
        ATT_BAR_ALL();
        float L = 0.f;
#pragma unroll
        for (int w = 0; w < 8; ++w) L += xl[w * 32 + r32];
        const float inv = 1.0f / fmaxf(L, 1e-30f);
        if (mine) {
#pragma unroll
            for (int r = 0; r < 16; ++r) { p0[r] *= inv; p1[r] *= inv; }
#pragma unroll
            for (int r = 0; r < 16; r += 2) { const int bl = crow(r, hi) >> 1;
                float v0 = p0[r] + p0[r + 1], v1 = p1[r] + p1[r + 1];
                v0 += __shfl_xor(v0, 1); v0 += __shfl_xor(v0, 2); v1 += __shfl_xor(v1, 1); v1 += __shfl_xor(v1, 2);
                if (hq == 0) { imp[ql * 128 + 32 * wid + bl] = v0; imp[ql * 128 + 32 * wid + 16 + bl] = v1; } }
            Run Rc;
#pragma unroll
            for (int r = 0; r < 16; ++r) { Rc.o[0][r] = 0.f; Rc.o[1][r] = 0.f; }
            pv(Rc.o, vimg, p0, p1, lane, hi);
#pragma unroll
            for (int r = 0; r < 16; ++r) { oacc[0][r] += g_c * Rc.o[0][r]; oacc[1][r] += g_c * Rc.o[1][r]; }
        }
        ATT_BAR_ALL();
    }
    {
        constexpr int NCAND = NBS_S - 1;
        const float v0 = imp[wid * 128 + lane], v1 = imp[wid * 128 + 64 + lane];
        const unsigned key0 = (lane == 0) ? 0x7f000000u : __float_as_uint(v0) + 1u;
        const unsigned key1 = (lane + 64 == NCAND - 1) ? 0x7f000000u : __float_as_uint(v1) + 1u;
        unsigned Tt = 0u;
        for (int bit = 30; bit >= 0; --bit) { const unsigned cand = Tt | (1u << bit); if (__popcll(__ballot(key0 >= cand)) + __popcll(__ballot(key1 >= cand)) >= N_SEL - 1) Tt = cand; }
        const unsigned long long gt0 = __ballot(key0 > Tt), gt1 = __ballot(key1 > Tt), eq0 = __ballot(key0 == Tt), eq1 = __ballot(key1 == Tt);
        const int need = (N_SEL - 1) - __popcll(gt0) - __popcll(gt1);
        const unsigned long long below = (1ull << lane) - 1ull;
        const bool pick0 = (key0 == Tt) && (__popcll(eq0 & below) < need);
        const bool pick1 = (key1 == Tt) && (__popcll(eq0) + __popcll(eq1 & below) < need);
        const unsigned long long m0 = gt0 | __ballot(pick0), m1 = gt1 | __ballot(pick1);
        if (lane == 0) { selw[wid * 2] = m0; selw[wid * 2 + 1] = m1; }
        ATT_BAR_ALL();
    }
    load_q(qf, T.qr + (size_t)row * HDM + head * HD, hi);
    {
        unsigned long long U0 = 0ull, U1 = 0ull;
#pragma unroll
        for (int q = 0; q < 8; ++q) { U0 |= selw[q * 2]; U1 |= selw[q * 2 + 1]; }
        U0 = __builtin_amdgcn_readfirstlane((unsigned)U0) | ((unsigned long long)__builtin_amdgcn_readfirstlane((unsigned)(U0 >> 32)) << 32);
        U1 = __builtin_amdgcn_readfirstlane((unsigned)U1) | ((unsigned long long)__builtin_amdgcn_readfirstlane((unsigned)(U1 >> 32)) << 32);
        const unsigned long long my0 = selw[ql * 2], my1 = selw[ql * 2 + 1];
        Run R; R.m = NEGB; R.l = 0.f;
#pragma unroll
        for (int r = 0; r < 16; ++r) { R.o[0][r] = 0.f; R.o[1][r] = 0.f; }
        int idx = 0;
        for (int half = 0; half < 2; ++half) {
            unsigned long long U = half ? U1 : U0;
            while (U) {
                const int bit = __builtin_ctzll(U); U &= U - 1ull;
                if ((idx++ & 7) != wid) continue;
                const int blk = 64 * half + bit;
                const int page = T.page_table[b * N_PAGES + (blk * L_SEL) / PAGE_SIZE];
                const float* base = T.cache_kv + (((size_t)page * PAGE_SIZE + (blk * L_SEL) % PAGE_SIZE) * 4) * N_KV * HD + g * HD;
                stage_kv(kimg, vimg, base + 2 * N_KV * HD, base + 3 * N_KV * HD, 4 * N_KV * HD, 64, lane);
                const bool selected = ((half ? my1 : my0) >> bit) & 1ull;
                tile_step<false>(R, kimg, vimg, qf, selected ? 0.f : NEGB, 0, 63, lane, r32, hi);
            }
        }
        if ((idx & 7) == wid) {
            const float* base = T.out + O_KVS + (((size_t)b * DEC_SEQ) * 4) * N_KV * HD + g * HD;
            stage_kv(kimg, vimg, base + 2 * N_KV * HD, base + 3 * N_KV * HD, 4 * N_KV * HD, DEC_SEQ, lane);
            tile_step<true>(R, kimg, vimg, qf, 0.f, 0, ql, lane, r32, hi);
        }
        const float wgt = merge_stats(lds, R.m, R.l, wid, r32, hi) * g_s;
#pragma unroll
        for (int r = 0; r < 16; ++r) { oacc[0][r] += wgt * R.o[0][r]; oacc[1][r] += wgt * R.o[1][r]; }
    }
    {
        Run R; R.m = NEGB; R.l = 0.f;
#pragma unroll
        for (int r = 0; r < 16; ++r) { R.o[0][r] = 0.f; R.o[1][r] = 0.f; }
        for (int t = wid; t < WINDOW / 64; t += 8) {
            const float* base = T.cache_win + (((size_t)b * WINDOW + 64 * t) * 2) * N_KV * HD + g * HD;
            stage_kv(kimg, vimg, base, base + N_KV * HD, 2 * N_KV * HD, 64, lane);
            if (t == 0) tile_step<true>(R, kimg, vimg, qf, 0.f, ql, 63, lane, r32, hi); else tile_step<false>(R, kimg, vimg, qf, 0.f, 0, 63, lane, r32, hi);
        }
        if (wid == 0) {
            const float* base = T.winrows + (((size_t)(MP + b * DEC_SEQ)) * 2) * N_KV * HD + g * HD;
            stage_kv(kimg, vimg, base, base + N_KV * HD, 2 * N_KV * HD, DEC_SEQ, lane);
            tile_step<true>(R, kimg, vimg, qf, 0.f, 0, ql, lane, r32, hi);
        }
        const float wgt = merge_stats(lds, R.m, R.l, wid, r32, hi) * g_w;
#pragma unroll
        for (int r = 0; r < 16; ++r) { oacc[0][r] += wgt * R.o[0][r]; oacc[1][r] += wgt * R.o[1][r]; }
    }
    {
        __attribute__((address_space(3))) float* mine = (__attribute__((address_space(3))) float*)(lds + wid * S_STAGE);
#pragma unroll
        for (int d0 = 0; d0 < 2; ++d0)
#pragma unroll
            for (int rr = 0; rr < 4; ++rr) *(__attribute__((address_space(3))) f32x4_t*)(mine + r32 * 64 + 32 * d0 + 8 * rr + 4 * hi) = (f32x4_t){oacc[d0][4 * rr], oacc[d0][4 * rr + 1], oacc[d0][4 * rr + 2], oacc[d0][4 * rr + 3]};
        ATT_BAR_ALL();
        const int tid = wid * 64 + lane, orow = tid >> 4, oc4 = (tid & 15) * 4;
        f32x4_t s = {0.f, 0.f, 0.f, 0.f};
#pragma unroll
        for (int w = 0; w < 8; ++w) s += *(const __attribute__((address_space(3))) f32x4_t*)((__attribute__((address_space(3))) float*)(lds + w * S_STAGE) + orow * 64 + oc4);
        typedef unsigned u32x2 __attribute__((ext_vector_type(2)));
        u32x2 wv; wv.x = cvtpk(s[0], s[1]); wv.y = cvtpk(s[2], s[3]);
        const int oq = orow >> 2, oh = orow & 3;
        *(u32x2*)(T.ob + (size_t)(MP + b * DEC_SEQ + oq) * HDM + (g * HPG + oh) * HD + oc4) = wv;
        ATT_BAR_ALL();
    }
}
__device__ __forceinline__ void sample_phase(const STensors& T, ldsp lds, int wid, int lane, int cu, int ncu) {
    for (int c = cu; c < DEC_BATCH * N_KV; c += ncu) sample_unit(T, c / N_KV, c % N_KV, lds, wid, lane);
}
}

__device__ __forceinline__ void wconv_tile(int item, const float* src, int Nsrc, const float* gain, bf16_t* dst, int Nd, int K, int kind, int aux, LAS float* scr, int lane) {
    const int nblk = Nd / 32, kb = item / nblk, nb = item % nblk, k0 = 64 * kb, n0 = 32 * nb;
    const int colbase = colmap(kind, n0, aux);
    const int col = colbase + (lane & 31); const bool ok = colbase >= 0 && col < Nsrc;
#pragma unroll 8
    for (int i = 0; i < 32; ++i) { const int kk = 2 * i + (lane >> 5); const float g = gain ? gain[k0 + kk] : 1.f; scr[kk * 33 + (lane & 31)] = ok ? src[(size_t)(k0 + kk) * Nsrc + col] * g : 0.f; }
    asm volatile("s_waitcnt lgkmcnt(0)" ::: "memory");
    const int c = lane & 7;
#pragma unroll
    for (int j = 0; j < 4; ++j) { const int n = (lane >> 3) + 8 * j; const LAS float* sp = scr + (8 * c) * 33 + n;
        typedef unsigned v4u __attribute__((ext_vector_type(4)));
        v4u o; o.x = pg8::cvt_pk_bf16(sp[0 * 33], sp[1 * 33]); o.y = pg8::cvt_pk_bf16(sp[2 * 33], sp[3 * 33]); o.z = pg8::cvt_pk_bf16(sp[4 * 33], sp[5 * 33]); o.w = pg8::cvt_pk_bf16(sp[6 * 33], sp[7 * 33]);
        *(v4u*)(dst + (size_t)(n0 + n) * K + k0 + 8 * c) = o; }
    asm volatile("s_waitcnt lgkmcnt(0)" ::: "memory");
}
__device__ __forceinline__ void hinit_row(int m, const float* xp, const float* xs, float* h, bf16_t* hb, float* rss0, int lane) {
    typedef float f4 __attribute__((ext_vector_type(4))); typedef unsigned u2 __attribute__((ext_vector_type(2)));
    const float* x = m < MP ? xp + (size_t)m * D_MODEL : xs + (size_t)(m - MP) * D_MODEL;
    float s = 0.f;
#pragma unroll
    for (int j = 0; j < D_MODEL / 256; ++j) { const f4 v = *(const f4*)(x + 256 * j + 4 * lane); s += (v[0] * v[0] + v[1] * v[1]) + (v[2] * v[2] + v[3] * v[3]);
        *(f4*)(h + (size_t)m * D_MODEL + 256 * j + 4 * lane) = v; u2 w; w.x = pg8::cvt_pk_bf16(v[0], v[1]); w.y = pg8::cvt_pk_bf16(v[2], v[3]); *(u2*)(hb + (size_t)m * D_MODEL + 256 * j + 4 * lane) = w; }
#pragma unroll
    for (int o = 1; o < 64; o <<= 1) s += __shfl_xor(s, o);
    if (lane == 0) rss0[m] = s;
}
#endif

#ifndef CPU_TEST
__device__ __forceinline__ size_t opaque_gtid(int wave) { int w = wave; asm volatile("" : "+s"(w)); unsigned t = blockIdx.x * NTHREADS + w * 64 + lane_id_v(); return (size_t)t; }
#define ITEM_LOOP(total) for (size_t i = opaque_gtid(wave_id); i < (size_t)(total); i += (size_t)gridDim.x * NTHREADS)
#else
#define ITEM_LOOP(total) _Pragma("omp parallel for schedule(dynamic, 64)") for (long long i = 0; i < (long long)(total); ++i)
#endif

struct Params {
    const float *x_prompt, *x_sample, *cache_kv, *cache_win, *state_conv; const int* page_table;
    const float *ffn_a_norm, *ffn_a_w_in, *ffn_a_w_out, *mix_norm, *ffn_b_norm, *ffn_b_w_in, *ffn_b_w_out, *conv_w_in, *conv_w, *conv_w_out, *kv_norm, *w_kv, *k_norm,
                *cmp_pe, *cmp_w1, *cmp_w2, *nsa_w_qg, *nsa_q_norm, *nsa_w_o;
    float* out; unsigned char* ws;
};
constexpr int LDS_RING = 131072, LDS_BAR_OFF = LDS_RING + 352, LDS_BYTES = 147456;

#ifndef CPU_TEST
typedef const __attribute__((address_space(4))) Params* KParamsPtr;
__device__ __forceinline__ KParamsPtr kparams_ptr() {
#if defined(__HIP_DEVICE_COMPILE__)
    KParamsPtr p = (KParamsPtr)__builtin_amdgcn_kernarg_segment_ptr(); asm volatile("" : "+s"(p)); return p;
#else
    return nullptr;
#endif
}
__device__ __forceinline__ Params load_params() {
#if defined(__HIP_DEVICE_COMPILE__)
    return *kparams_ptr();
#else
    return Params{};
#endif
}
__device__ __forceinline__ unsigned char* load_ws() {
#if defined(__HIP_DEVICE_COMPILE__)
    return kparams_ptr()->ws;
#else
    return nullptr;
#endif
}
#define KP const Params P = load_params()
__device__ __forceinline__ int opaque_s(int v) { asm volatile("" : "+s"(v)); return v; }
#define GRID_SYNC() do { XcdBarrier bar_; bar_.bar = (GU*)load_ws() + 1024; bar_.x = 0; bar_.st = (volatile LAS unsigned*)(lds + LDS_BAR_OFF); xcd_barrier(bar_, wave_id == 0 && lane_id_v() == 0u); } while (0)
__global__ void __launch_bounds__(NTHREADS, 2) mega(Params P_unused)
#else
static Params g_params;
#define KP const Params& P = g_params
#define GRID_SYNC() do {} while (0)
void mega(Params P_unused)
#endif
{
#ifndef CPU_TEST
    extern __shared__ __attribute__((aligned(16))) unsigned char lds[];
    const int wave_id = __builtin_amdgcn_readfirstlane((int)(threadIdx.x >> 6));
    if (threadIdx.x < 4) ((LAS unsigned*)(lds + LDS_BAR_OFF))[threadIdx.x] = 0u;
    __syncthreads();
    (void)xcd_barrier_post((GU*)load_ws() + 1024, (volatile LAS unsigned*)(lds + LDS_BAR_OFF), threadIdx.x == 0);
#define RING ((PG8_LAS unsigned char*)lds)
#else
    g_params = P_unused;
#endif
#define WS_F(f) ((float*)(P.ws + WSM.f))
#define WS_B(f) ((bf16_t*)(P.ws + WSM.f))
#define KVSRC KvSrc{P.cache_kv, P.page_table, P.out}
#define PH(total, call) do { { KP; ITEM_LOOP(total) call; } GRID_SYNC(); } while (0)
#ifdef CPU_TEST
    for (int L = 0; L < DEPTH; ++L) {
        KP;
        ITEM_LOOP((size_t)2 * D_FF * (D_MODEL / 64)) wconv_item(i, P.ffn_a_w_in + (size_t)L * D_MODEL * 2 * D_FF, 2 * D_FF, P.ffn_a_norm + (size_t)L * D_MODEL, WS_B(w_ain) + (size_t)L * 2 * D_FF * D_MODEL, 2 * D_FF, D_MODEL, CM_PAIR, D_FF);
        ITEM_LOOP((size_t)D_MODEL * (D_FF / 64)) wconv_item(i, P.ffn_a_w_out + (size_t)L * D_FF * D_MODEL, D_MODEL, nullptr, WS_B(w_aout) + (size_t)L * D_MODEL * D_FF, D_MODEL, D_FF, CM_PLAIN, 0);
        ITEM_LOOP((size_t)2 * D_FF * (D_MODEL / 64)) wconv_item(i, P.ffn_b_w_in + (size_t)L * D_MODEL * 2 * D_FF, 2 * D_FF, P.ffn_b_norm + (size_t)L * D_MODEL, WS_B(w_bin) + (size_t)L * 2 * D_FF * D_MODEL, 2 * D_FF, D_MODEL, CM_PAIR, D_FF);
        ITEM_LOOP((size_t)D_MODEL * (D_FF / 64)) wconv_item(i, P.ffn_b_w_out + (size_t)L * D_FF * D_MODEL, D_MODEL, nullptr, WS_B(w_bout) + (size_t)L * D_MODEL * D_FF, D_MODEL, D_FF, CM_PLAIN, 0);
    }
    for (int L = 0; L < N_A; ++L) {
        KP;
        ITEM_LOOP((size_t)3 * D_MODEL * (D_MODEL / 64)) wconv_item(i, P.conv_w_in + (size_t)L * D_MODEL * 3 * D_MODEL, 3 * D_MODEL, P.mix_norm + (size_t)L * D_MODEL, WS_B(w_cin) + (size_t)L * 3 * D_MODEL * D_MODEL, 3 * D_MODEL, D_MODEL, CM_CONV, 0);
        ITEM_LOOP((size_t)D_MODEL * (D_MODEL / 64)) wconv_item(i, P.conv_w_out + (size_t)L * D_MODEL * D_MODEL, D_MODEL, nullptr, WS_B(w_cout) + (size_t)L * D_MODEL * D_MODEL, D_MODEL, D_MODEL, CM_PLAIN, 0);
    }
    for (int b = 0; b < N_B; ++b) {
        KP;
        ITEM_LOOP((size_t)QGP * (D_MODEL / 64)) wconv_item(i, P.nsa_w_qg + (size_t)b * D_MODEL * QGW, QGW, P.mix_norm + (size_t)(N_A + b) * D_MODEL, WS_B(w_qg) + (size_t)b * QGP * D_MODEL, QGP, D_MODEL, CM_HEADS, N_HEADS);
        ITEM_LOOP((size_t)D_MODEL * (HDM / 64)) wconv_item(i, P.nsa_w_o + (size_t)b * HDM * D_MODEL, D_MODEL, nullptr, WS_B(w_o) + (size_t)b * D_MODEL * HDM, D_MODEL, HDM, CM_PLAIN, 0);
    }
    { KP; ITEM_LOOP((size_t)KVW * (D_MODEL / 64)) wconv_item(i, P.w_kv, KVW, P.kv_norm, WS_B(w_kv), KVW, D_MODEL, CM_HEADS, 6 * N_KV); }
    { KP; ITEM_LOOP((size_t)NPOS * 8) rope_item(i, WS_F(rope)); }
    { KP; ITEM_LOOP(MT) hinit_item(i, P.x_prompt, P.x_sample, WS_F(h), WS_B(hb), WS_F(rss)); }
#else
#define WAVE_ITEMS(total) for (int it_ = (int)(opaque_s((int)blockIdx.x) * 8 + wave_id); it_ < (int)(total); it_ += (int)gridDim.x * 8)
#define WCONV(srcp, Nsrc_, gainp, dstp, Nd_, K_, kind_, aux_) do { KP; LAS float* scr_ = (LAS float*)(lds + wave_id * 16384); const int lane_ = (int)lane_id_v(); \
        WAVE_ITEMS(((Nd_) / 32) * ((K_) / 64)) wconv_tile(it_, srcp, Nsrc_, gainp, dstp, Nd_, K_, kind_, aux_, scr_, lane_); } while (0)
    for (int L = 0; L < DEPTH; ++L) {
        WCONV(P.ffn_a_w_in + (size_t)L * D_MODEL * 2 * D_FF, 2 * D_FF, P.ffn_a_norm + (size_t)L * D_MODEL, WS_B(w_ain) + (size_t)L * 2 * D_FF * D_MODEL, 2 * D_FF, D_MODEL, CM_PAIR, D_FF);
        WCONV(P.ffn_a_w_out + (size_t)L * D_FF * D_MODEL, D_MODEL, nullptr, WS_B(w_aout) + (size_t)L * D_MODEL * D_FF, D_MODEL, D_FF, CM_PLAIN, 0);
        WCONV(P.ffn_b_w_in + (size_t)L * D_MODEL * 2 * D_FF, 2 * D_FF, P.ffn_b_norm + (size_t)L * D_MODEL, WS_B(w_bin) + (size_t)L * 2 * D_FF * D_MODEL, 2 * D_FF, D_MODEL, CM_PAIR, D_FF);
        WCONV(P.ffn_b_w_out + (size_t)L * D_FF * D_MODEL, D_MODEL, nullptr, WS_B(w_bout) + (size_t)L * D_MODEL * D_FF, D_MODEL, D_FF, CM_PLAIN, 0);
    }
    for (int L = 0; L < N_A; ++L) {
        WCONV(P.conv_w_in + (size_t)L * D_MODEL * 3 * D_MODEL, 3 * D_MODEL, P.mix_norm + (size_t)L * D_MODEL, WS_B(w_cin) + (size_t)L * 3 * D_MODEL * D_MODEL, 3 * D_MODEL, D_MODEL, CM_CONV, 0);
        WCONV(P.conv_w_out + (size_t)L * D_MODEL * D_MODEL, D_MODEL, nullptr, WS_B(w_cout) + (size_t)L * D_MODEL * D_MODEL, D_MODEL, D_MODEL, CM_PLAIN, 0);
    }
    for (int b = 0; b < N_B; ++b) {
        WCONV(P.nsa_w_qg + (size_t)b * D_MODEL * QGW, QGW, P.mix_norm + (size_t)(N_A + b) * D_MODEL, WS_B(w_qg) + (size_t)b * QGP * D_MODEL, QGP, D_MODEL, CM_HEADS, N_HEADS);
        WCONV(P.nsa_w_o + (size_t)b * HDM * D_MODEL, D_MODEL, nullptr, WS_B(w_o) + (size_t)b * D_MODEL * HDM, D_MODEL, HDM, CM_PLAIN, 0);
    }
    WCONV(P.w_kv, KVW, P.kv_norm, WS_B(w_kv), KVW, D_MODEL, CM_HEADS, 6 * N_KV);
    { KP; ITEM_LOOP((size_t)NPOS * 8) rope_item(i, WS_F(rope)); }
    { KP; const int lane_ = (int)lane_id_v(); WAVE_ITEMS(MT) hinit_row(it_, P.x_prompt, P.x_sample, WS_F(h), WS_B(hb), WS_F(rss), lane_); }
#endif
#ifndef CPU_TEST
    for (int e = 0; e < 2; ++e) WCONV(P.cmp_w1 + (size_t)e * L_CMP * HD * CMP_HID, CMP_HID, nullptr, WS_B(w1t) + (size_t)e * CMP_HID * L_CMP * HD, CMP_HID, L_CMP * HD, CM_PLAIN, 0);
    { KP; ITEM_LOOP((size_t)2 * RS_CMP * L_CMP * 8) acmp_sample_item(i, P.cache_kv, P.page_table, P.cmp_pe, WS_B(acs)); }
#endif
    GRID_SYNC();
#ifndef CPU_TEST
    { KP; pg8::Gemm g{WS_B(acs), WS_B(w1t), 2 * RS_CMP, 2 * CMP_HID, L_CMP * HD}; pg8::CmpOrder So{2 * RS_CMP / 256, RS_CMP / 256, opaque_s((int)gridDim.x), opaque_s((int)blockIdx.x)};
      pg8::EpiGelu E{WS_B(hids)}; pg8::gemm_phase<pg8::EpiGelu, pg8::CmpOrder, true, true>(wave_id, RING, g, So, E); }
    GRID_SYNC();
    PH((size_t)2 * RS_CMP, cmp_out_b_item(i, WS_B(hids), RS_CMP, NBC_PAST, BATCH, P.cmp_w2, P.k_norm, WS_F(kc), WS_F(vc)));
#endif

#ifndef CPU_TEST
#define FFN_OPT(wi, wo, v_in, last) do { \
        { KP; pg8::Gemm g{WS_B(hb), WS_B(wi) + (size_t)layer * 2 * D_FF * D_MODEL, MT, 2 * D_FF, D_MODEL}; pg8::StaticOrder So; So.init(MT, 2 * D_FF, opaque_s((int)gridDim.x), opaque_s((int)blockIdx.x)); \
          pg8::EpiSwiglu E{WS_B(act), WS_F(rss) + (size_t)(v_in) * MT}; pg8::gemm_phase<pg8::EpiSwiglu, pg8::StaticOrder, true, true>(wave_id, RING, g, So, E); } \
        GRID_SYNC(); \
        { KP; pg8::Gemm g{WS_B(act), WS_B(wo) + (size_t)layer * D_MODEL * D_FF, MT, D_MODEL, D_FF}; pg8::StaticOrder So; So.init(MT, D_MODEL, opaque_s((int)gridDim.x), opaque_s((int)blockIdx.x)); \
          pg8::EpiResid E{WS_F(h), WS_B(hb), WS_F(rss) + (size_t)((v_in) + 1) * MT, (last) ? P.out + O_YP : nullptr, 0.5f}; pg8::gemm_phase<pg8::EpiResid, pg8::StaticOrder, true, true>(wave_id, RING, g, So, E); } \
        GRID_SYNC(); } while (0)
#else
#define FFN_OPT(wi, wo, v_in, last) do { KP; \
        ITEM_LOOP((size_t)MT * D_FF) ref_ffn_in_item(i, WS_B(hb), WS_F(rss) + (size_t)(v_in) * MT, WS_B(wi) + (size_t)layer * 2 * D_FF * D_MODEL, WS_B(act)); \
        ITEM_LOOP(MT) ref_resid_row_item(i, WS_B(act), D_FF, WS_B(wo) + (size_t)layer * D_MODEL * D_FF, 0.5f, WS_F(h), WS_B(hb), WS_F(rss) + (size_t)((v_in) + 1) * MT, (last) ? P.out + O_YP : nullptr); } while (0)
#endif
#ifndef CPU_TEST
#define GEMM_PH(EpiT, Aptr, Btptr, Nn, Kk, ...) do { { KP; pg8::Gemm g{Aptr, Btptr, MT, Nn, Kk}; pg8::StaticOrder So; So.init(MT, Nn, opaque_s((int)gridDim.x), opaque_s((int)blockIdx.x)); \
        pg8::EpiT E{__VA_ARGS__}; pg8::gemm_phase<pg8::EpiT, pg8::StaticOrder, true, true>(wave_id, RING, g, So, E); } GRID_SYNC(); } while (0)
#endif
    for (int layer = 0; layer < DEPTH; ++layer) {
        FFN_OPT(w_ain, w_aout, 3 * layer, false);
        const int v1 = 3 * layer + 1;
        if (layer < N_A) {
#ifndef CPU_TEST
            GEMM_PH(EpiConvIn, WS_B(hb), WS_B(w_cin) + (size_t)layer * 3 * D_MODEL * D_MODEL, 3 * D_MODEL, D_MODEL, WS_B(ub), WS_B(bb), WS_F(rss) + (size_t)v1 * MT, P.out, layer);
#else
            PH((size_t)MT * D_MODEL, ref_conv_in_item(i, WS_B(hb), WS_F(rss) + (size_t)v1 * MT, WS_B(w_cin) + (size_t)layer * 3 * D_MODEL * D_MODEL, WS_B(ub), WS_B(bb), P.out, layer));
#endif
            PH((size_t)MT * D_MODEL, conv_thin_item(i, WS_B(ub), WS_B(bb), P.state_conv + (size_t)layer * DEC_BATCH * 2 * D_MODEL, P.conv_w + (size_t)layer * 3 * D_MODEL, WS_B(zb)));
#ifndef CPU_TEST
            GEMM_PH(EpiResid, WS_B(zb), WS_B(w_cout) + (size_t)layer * D_MODEL * D_MODEL, D_MODEL, D_MODEL, WS_F(h), WS_B(hb), WS_F(rss) + (size_t)(v1 + 1) * MT, nullptr, 1.0f);
#else
            PH(MT, ref_resid_row_item(i, WS_B(zb), D_MODEL, WS_B(w_cout) + (size_t)layer * D_MODEL * D_MODEL, 1.0f, WS_F(h), WS_B(hb), WS_F(rss) + (size_t)(v1 + 1) * MT, nullptr));
#endif
        } else {
            const int b = layer - N_A;
#ifndef CPU_TEST
            GEMM_PH(EpiQG, WS_B(hb), WS_B(w_qg) + (size_t)b * QGP * D_MODEL, QGP, D_MODEL, WS_F(qn), WS_F(qr), WS_F(gates), WS_F(rss) + (size_t)v1 * MT, P.nsa_q_norm + (size_t)b * HD, WS_F(rope));
#else
            { KP; ITEM_LOOP((size_t)MT * N_HEADS) ref_qg_item(i, WS_B(hb), WS_F(rss) + (size_t)v1 * MT, WS_B(w_qg) + (size_t)b * QGP * D_MODEL, P.nsa_q_norm + (size_t)b * HD, WS_F(rope), WS_F(qn), WS_F(qr)); }
            PH((size_t)MT * 3 * N_HEADS, ref_gates_item(i, WS_B(hb), WS_F(rss) + (size_t)v1 * MT, WS_B(w_qg) + (size_t)b * QGP * D_MODEL, WS_F(gates)));
#endif
#ifndef CPU_TEST
            PH((size_t)MT * HDM, qconv_item(i, WS_F(qn), WS_F(qr), WS_B(qnb), WS_B(qrb)));
            { KP; att::Tensors T{WS_B(qnb), WS_B(qrb), P.ws + WSM.ksel, P.ws + WSM.vsel, P.ws + WSM.kwin, P.ws + WSM.vwin, P.ws + WSM.kci, P.ws + WSM.vci, WS_F(gates), WS_B(ob)};
              int wv = wave_id; asm volatile("" : "+s"(wv));
              att::phase(T, (att::ldsp)lds, wv, (int)lane_id_v(), opaque_s((int)blockIdx.x), opaque_s((int)gridDim.x)); }
            { KP; att::STensors T{WS_B(qnb), WS_B(qrb), WS_F(kc), WS_F(vc), P.cache_kv, P.page_table, P.cache_win, P.out, WS_F(winrows), WS_F(gates), WS_B(ob)};
              int wv = wave_id; asm volatile("" : "+s"(wv));
              att::sample_phase(T, (att::ldsp)lds, wv, (int)lane_id_v(), opaque_s((int)blockIdx.x), opaque_s((int)gridDim.x)); }
            GRID_SYNC();
#else
            PH((size_t)MT * N_HEADS, attn_cmp_item(i, WS_F(qn), WS_F(kc), WS_F(vc), WS_F(pbuf), WS_F(oc)));
            PH((size_t)MT * N_KV, topk_item(i, WS_F(pbuf), (int*)WS_F(sel), WS_F(scorebuf)));
            PH((size_t)MT * N_HEADS, attn_sel_item(i, KVSRC, WS_F(qr), (const int*)WS_F(sel), WS_F(os)));
            PH((size_t)MT * N_HEADS, attn_win_item(i, P.cache_win, WS_F(winrows), WS_F(qr), WS_F(gates), WS_F(oc), WS_F(os), WS_B(ob)));
#endif
#ifndef CPU_TEST
            GEMM_PH(EpiResid, WS_B(ob), WS_B(w_o) + (size_t)b * D_MODEL * HDM, D_MODEL, HDM, WS_F(h), WS_B(hb), WS_F(rss) + (size_t)(v1 + 1) * MT, nullptr, 1.0f);
#else
            PH(MT, ref_resid_row_item(i, WS_B(ob), HDM, WS_B(w_o) + (size_t)b * D_MODEL * HDM, 1.0f, WS_F(h), WS_B(hb), WS_F(rss) + (size_t)(v1 + 1) * MT, nullptr));
#endif
        }
        FFN_OPT(w_bin, w_bout, 3 * layer + 2, layer == DEPTH - 1);
        if (layer == N_A - 1) {
            const int v3 = 3 * layer + 3;
#ifndef CPU_TEST
            { KP; pg8::Gemm g{WS_B(hb), WS_B(w_kv), MT, KVW, D_MODEL}; pg8::StaticOrder So; So.init(MT, KVW, opaque_s((int)gridDim.x), opaque_s((int)blockIdx.x));
              pg8::EpiKV E{P.out, WS_F(winrows), WS_F(rss) + (size_t)v3 * MT, P.k_norm, WS_F(rope)}; pg8::gemm_phase<pg8::EpiKV, pg8::StaticOrder, true, true>(wave_id, RING, g, So, E); }
#else
            { KP; ITEM_LOOP((size_t)MT * 6 * N_KV) ref_kv_item(i, WS_B(hb), WS_F(rss) + (size_t)v3 * MT, WS_B(w_kv), P.k_norm, WS_F(rope), P.out, WS_F(winrows)); }
#endif
            PH((size_t)DEC_BATCH * (WINDOW - DEC_SEQ) * 2 * N_KV * HD, wincopy_item(i, P.cache_win, P.out));
#ifdef CPU_TEST
            PH((size_t)NSEQ * NBC_MAX * 2 * N_KV * CMP_HID, cmp_hid_item(i, KVSRC, P.cmp_pe, P.cmp_w1, WS_F(hid)));
            PH((size_t)NSEQ * NBC_MAX * 2 * N_KV, cmp_out_item(i, WS_F(hid), P.cmp_w2, P.k_norm, WS_F(kc), WS_F(vc)));
#else
            PH((size_t)2 * RP_CMP * L_CMP * 8, acmp_prompt_item(i, P.out, P.cmp_pe, WS_B(acp)));
            { KP; pg8::Gemm g{WS_B(acp), WS_B(w1t), 2 * RP_CMP, 2 * CMP_HID, L_CMP * HD}; pg8::CmpOrder So{2 * RP_CMP / 256, RP_CMP / 256, opaque_s((int)gridDim.x), opaque_s((int)blockIdx.x)};
              pg8::EpiGelu E{WS_B(hidp)}; pg8::gemm_phase<pg8::EpiGelu, pg8::CmpOrder, true, true>(wave_id, RING, g, So, E); }
            GRID_SYNC();
            PH((size_t)2 * RP_CMP, cmp_out_b_item(i, WS_B(hidp), RP_CMP, NBC_P, 0, P.cmp_w2, P.k_norm, WS_F(kc), WS_F(vc)));
            { KP; ITEM_LOOP((size_t)BATCH * N_KV * SEQ * 8) kvimg_item(i, P.out, WS_F(winrows), P.ws + WSM.ksel, P.ws + WSM.vsel, P.ws + WSM.kwin, P.ws + WSM.vwin); }
            PH((size_t)BATCH * N_KV * NBC_P * 8, kcimg_item(i, WS_F(kc), WS_F(vc), P.ws + WSM.kci, P.ws + WSM.vci));
#endif
        }
    }
}

extern "C" void kernel_launch(void* const* d_in, const int* in_sizes, int n_in, void* d_out, int out_size, void* d_ws, size_t ws_size, hipStream_t stream) {
    Params P{};
    P.x_prompt = (const float*)d_in[0]; P.x_sample = (const float*)d_in[1]; P.cache_kv = (const float*)d_in[2]; P.cache_win = (const float*)d_in[3];
    P.state_conv = (const float*)d_in[4]; P.page_table = (const int*)d_in[5]; P.ffn_a_norm = (const float*)d_in[6]; P.ffn_a_w_in = (const float*)d_in[7];
    P.ffn_a_w_out = (const float*)d_in[8]; P.mix_norm = (const float*)d_in[9]; P.ffn_b_norm = (const float*)d_in[10]; P.ffn_b_w_in = (const float*)d_in[11];
    P.ffn_b_w_out = (const float*)d_in[12]; P.conv_w_in = (const float*)d_in[13]; P.conv_w = (const float*)d_in[14]; P.conv_w_out = (const float*)d_in[15];
    P.kv_norm = (const float*)d_in[16]; P.w_kv = (const float*)d_in[17]; P.k_norm = (const float*)d_in[18]; P.cmp_pe = (const float*)d_in[19];
    P.cmp_w1 = (const float*)d_in[20]; P.cmp_w2 = (const float*)d_in[21]; P.nsa_w_qg = (const float*)d_in[22]; P.nsa_q_norm = (const float*)d_in[23];
    P.nsa_w_o = (const float*)d_in[24];
    P.out = (float*)d_out; P.ws = (unsigned char*)d_ws;
#ifndef CPU_TEST
    static int grid = 0;
    if (grid == 0) {
        int dev = 0, cus = 0, per_cu = 0;
        hipGetDevice(&dev); hipDeviceGetAttribute(&cus, hipDeviceAttributeMultiprocessorCount, dev);
        hipFuncSetAttribute((const void*)mega, hipFuncAttributeMaxDynamicSharedMemorySize, LDS_BYTES);
        hipOccupancyMaxActiveBlocksPerMultiprocessor(&per_cu, (const void*)mega, NTHREADS, LDS_BYTES);
        (void)hipGetLastError();
        grid = cus;
    }
    hipMemsetAsync(d_ws, 0, WS_ZERO_BYTES, stream);
    hipLaunchKernelGGL(mega, dim3(grid), dim3(NTHREADS), LDS_BYTES, stream, P);
#else
    memset(d_ws, 0, WS_ZERO_BYTES);
    mega(P);
#endif
}
```

```cpp
#ifdef CPU_TEST
#include "shim.h"
#else
#include <hip/hip_runtime.h>
#endif
#include <cstdint>
#include <cstddef>
#include <cmath>
#include <cstring>
typedef unsigned short bf16_t;
#ifndef CPU_TEST
#define HOSTDEV __host__ __device__
#else
#define HOSTDEV
#endif
HOSTDEV inline bf16_t f2bf(float f) { unsigned u; memcpy(&u, &f, 4); u = (u + 0x7fffu + ((u >> 16) & 1u)) >> 16; return (bf16_t)u; }
HOSTDEV inline float bf2f(bf16_t b) { unsigned u = (unsigned)b << 16; float f; memcpy(&f, &u, 4); return f; }

#ifdef CFG_SMALL
constexpr int D_MODEL = 256, BATCH = 1, SEQ = 2048, DEPTH = 4, DEC_BATCH = 2, DEC_SEQ = 8, PAST_LEN = 2048, PAGE_SIZE = 128, D_FF = 256, N_HEADS = 4, N_KV = 2;
#else
constexpr int D_MODEL = 1024, BATCH = 4, SEQ = 4096, DEPTH = 4, DEC_BATCH = 32, DEC_SEQ = 8, PAST_LEN = 8192, PAGE_SIZE = 128, D_FF = 2816, N_HEADS = 16, N_KV = 4;
#endif
constexpr int N_A = DEPTH / 2, N_B = DEPTH - N_A, HD = 64, HPG = N_HEADS / N_KV, L_CMP = 32, L_SEL = 64, N_SEL = 16, WINDOW = 512, CMP_HID = 4 * HD;
constexpr int MP = BATCH * SEQ, MS = DEC_BATCH * DEC_SEQ, MT = MP + MS, NSEQ = BATCH + DEC_BATCH;
constexpr int N_PAGES = PAST_LEN / PAGE_SIZE;
constexpr int KVW = 6 * N_KV * HD;
constexpr int QGW = N_HEADS * HD + 3 * N_HEADS;
constexpr int HDM = N_HEADS * HD;
constexpr int TPAD_S = ((PAST_LEN + DEC_SEQ + L_SEL - 1) / L_SEL) * L_SEL;
constexpr int NBC_P = SEQ / L_CMP, NBC_S = TPAD_S / L_CMP, NBC_MAX = NBC_S > NBC_P ? NBC_S : NBC_P;
constexpr int NBS_P = SEQ / L_SEL, NBS_S = TPAD_S / L_SEL, NBS_MAX = NBS_S > NBS_P ? NBS_S : NBS_P;
constexpr float EPS = 1e-6f, NEGF = -1e30f, TINYF = 1e-30f, FORCE_SCORE = 1e4f;
__device__ static const float INV_FREQ[8] = {1.0f, 0.1939227432012558f, 0.03760603070259094f, 0.007292664609849453f, 0.0014142135623842478f, 0.00027424818836152554f, 5.3182957344688475e-05f, 1.0313385246263351e-05f};

constexpr size_t O_YP = 0, O_YS = O_YP + (size_t)MP * D_MODEL, O_KVP = O_YS + (size_t)MS * D_MODEL, O_KVS = O_KVP + (size_t)MP * 4 * N_KV * HD,
                 O_WP = O_KVS + (size_t)MS * 4 * N_KV * HD, O_WS = O_WP + (size_t)BATCH * WINDOW * 2 * N_KV * HD, O_CP = O_WS + (size_t)DEC_BATCH * WINDOW * 2 * N_KV * HD,
                 O_CS = O_CP + (size_t)N_A * BATCH * 2 * D_MODEL, O_END = O_CS + (size_t)N_A * DEC_BATCH * 2 * D_MODEL;

struct RowInfo { int seq, t, pos; };
__device__ __host__ inline RowInfo row_info(int m) {
    RowInfo r;
    if (m < MP) { r.seq = m / SEQ; r.t = m % SEQ; r.pos = r.t; }
    else { const int q = m - MP; r.seq = BATCH + q / DEC_SEQ; r.t = q % DEC_SEQ; r.pos = PAST_LEN + r.t; }
    return r;
}
__device__ __host__ inline int seq_row0(int seq) { return seq < BATCH ? seq * SEQ : MP + (seq - BATCH) * DEC_SEQ; }
__device__ __host__ inline int seq_pos0(int seq) { return seq < BATCH ? 0 : PAST_LEN; }
__device__ __host__ inline int seq_len(int seq) { return seq < BATCH ? SEQ : DEC_SEQ; }

__device__ inline void copy_item(size_t i_, const float* a, float* b, size_t n) {
    const size_t i = i_;
    if (i < n) b[i] = a[i];
}
__device__ inline void rmsnorm_item(size_t i_, const float* x, const float* g, float* y, int rows, int d) {
    const int m = (int)i_;
    if (m >= rows) return;
    const float* xr = x + (size_t)m * d; float s = 0.f;
    for (int i = 0; i < d; ++i) s += xr[i] * xr[i];
    const float r = 1.0f / sqrtf(s / d + EPS);
    float* yr = y + (size_t)m * d;
    for (int i = 0; i < d; ++i) yr[i] = xr[i] * r * g[i];
}
__device__ inline void gemm_item(size_t i_, const float* A, int lda, const float* W, float* C, int M, int N, int K) {
    const int nbx = (N + 63) / 64; const int vb = (int)(i_ / 256), t_ = (int)(i_ % 256), tx = t_ % 16, ty = t_ / 16;
    const int c0 = (vb % nbx) * 64 + tx * 4, r0 = (vb / nbx) * 64 + ty * 4;
    if (c0 >= N || r0 >= M) return;
    float acc[4][4];
    for (int i = 0; i < 4; ++i) for (int j = 0; j < 4; ++j) acc[i][j] = 0.f;
    const int nr = (M - r0) < 4 ? (M - r0) : 4;
    for (int k = 0; k < K; k += 4) {
        float a[4][4], w[4][4];
        for (int i = 0; i < 4; ++i) for (int kk = 0; kk < 4; ++kk) a[i][kk] = (i < nr) ? A[(size_t)(r0 + i) * lda + k + kk] : 0.f;
        for (int kk = 0; kk < 4; ++kk) for (int j = 0; j < 4; ++j) w[kk][j] = W[(size_t)(k + kk) * N + c0 + j];
        for (int i = 0; i < 4; ++i) for (int kk = 0; kk < 4; ++kk) for (int j = 0; j < 4; ++j) acc[i][j] += a[i][kk] * w[kk][j];
    }
    for (int i = 0; i < nr; ++i) for (int j = 0; j < 4; ++j) C[(size_t)(r0 + i) * N + c0 + j] = acc[i][j];
}
__device__ inline void swiglu_item(size_t i_, const float* t1, float* act, int rows, int dff) {
    const size_t i = i_;
    if (i >= (size_t)rows * dff) return;
    const int m = (int)(i / dff), j = (int)(i % dff);
    const float g = t1[(size_t)m * 2 * dff + j], u = t1[(size_t)m * 2 * dff + dff + j];
    act[i] = g / (1.0f + expf(-g)) * u;
}
__device__ inline void axpy_item(size_t i_, float* h, const float* y, float coef, size_t n) {
    const size_t i = i_;
    if (i < n) h[i] += coef * y[i];
}
__device__ inline void conv_item(size_t i_, const float* t1, const float* state  , const float* wc  , float* z, float* out, int layer) {
    const size_t i = i_;
    if (i >= (size_t)MT * D_MODEL) return;
    const int m = (int)(i / D_MODEL), ch = (int)(i % D_MODEL);
    const RowInfo ri = row_info(m);
    const float* r = t1 + (size_t)m * 3 * D_MODEL;
    const float b = r[ch], u0 = r[D_MODEL + ch] * r[2 * D_MODEL + ch];
    float u1, u2;
    if (ri.t >= 1) { const float* p = r - 3 * D_MODEL; u1 = p[D_MODEL + ch] * p[2 * D_MODEL + ch]; }
    else u1 = (ri.seq < BATCH) ? 0.f : state[((size_t)(ri.seq - BATCH) * 2 + 1) * D_MODEL + ch];
    if (ri.t >= 2) { const float* p = r - 6 * D_MODEL; u2 = p[D_MODEL + ch] * p[2 * D_MODEL + ch]; }
    else if (ri.seq < BATCH) u2 = 0.f;
    else u2 = (ri.t == 1) ? state[((size_t)(ri.seq - BATCH) * 2 + 1) * D_MODEL + ch] : state[((size_t)(ri.seq - BATCH) * 2 + 0) * D_MODEL + ch];
    z[i] = b * (wc[ch] * u2 + wc[D_MODEL + ch] * u1 + wc[2 * D_MODEL + ch] * u0);
    const int L = seq_len(ri.seq);
    if (ri.t >= L - 2) {
        const int j = ri.t - (L - 2);
        if (ri.seq < BATCH) out[O_CP + (((size_t)layer * BATCH + ri.seq) * 2 + j) * D_MODEL + ch] = u0;
        else out[O_CS + (((size_t)layer * DEC_BATCH + (ri.seq - BATCH)) * 2 + j) * D_MODEL + ch] = u0;
    }
}
__device__ inline void head_norm(float* v, const float* g) {
    float s = 0.f; for (int d = 0; d < HD; ++d) s += v[d] * v[d];
    const float r = 1.0f / sqrtf(s / HD + EPS);
    for (int d = 0; d < HD; ++d) v[d] = v[d] * r * g[d];
}
__device__ inline void rope_cs(float ang, float& c, float& s) {
    const double r = (double)ang * 0.15915494309189535; const float fr = (float)(r - rint(r));
#ifdef CPU_TEST
    c = (float)cos(6.283185307179586 * (double)fr); s = (float)sin(6.283185307179586 * (double)fr);
#else
    c = __builtin_amdgcn_cosf(fr); s = __builtin_amdgcn_sinf(fr);
#endif
}
__device__ inline void head_rope(float* v, int pos) {
    for (int i = 0; i < 8; ++i) {
        const float ang = (float)pos * INV_FREQ[i]; float c, s; rope_cs(ang, c, s);
        const float x1 = v[i], x2 = v[8 + i];
        v[i] = x1 * c - x2 * s; v[8 + i] = x2 * c + x1 * s;
    }
}
__device__ inline void kvprep_item(size_t i_, const float* p, const float* k_norm  , float* out, float* winrows) {
    const int i = (int)i_;
    if (i >= MT * 6 * N_KV) return;
    const int m = i / (6 * N_KV), e = (i / N_KV) % 6, g = i % N_KV;
    const RowInfo ri = row_info(m);
    float v[HD];
    for (int d = 0; d < HD; ++d) v[d] = p[(size_t)m * KVW + (e * N_KV + g) * HD + d];
    if (e == 2) { head_norm(v, k_norm + HD); head_rope(v, ri.pos); }
    if (e == 4) { head_norm(v, k_norm + 2 * HD); head_rope(v, ri.pos); }
    if (e < 4) {
        float* o = (ri.seq < BATCH) ? out + O_KVP + (((size_t)m * 4 + e) * N_KV + g) * HD : out + O_KVS + (((size_t)(m - MP) * 4 + e) * N_KV + g) * HD;
        for (int d = 0; d < HD; ++d) o[d] = v[d];
    } else {
        const int we = e - 4;
        float* w = winrows + (((size_t)m * 2 + we) * N_KV + g) * HD;
        for (int d = 0; d < HD; ++d) w[d] = v[d];
        if (ri.seq < BATCH) { if (ri.t >= SEQ - WINDOW) { float* o = out + O_WP + ((((size_t)ri.seq * WINDOW + (ri.t - (SEQ - WINDOW))) * 2 + we) * N_KV + g) * HD; for (int d = 0; d < HD; ++d) o[d] = v[d]; } }
        else { float* o = out + O_WS + ((((size_t)(ri.seq - BATCH) * WINDOW + (WINDOW - DEC_SEQ + ri.t)) * 2 + we) * N_KV + g) * HD; for (int d = 0; d < HD; ++d) o[d] = v[d]; }
    }
}
__device__ inline void wincopy_item(size_t i_, const float* cache_win, float* out) {
    const size_t i = i_;
    const size_t per = (size_t)(WINDOW - DEC_SEQ) * 2 * N_KV * HD;
    if (i >= (size_t)DEC_BATCH * per) return;
    const size_t b = i / per, r = i % per;
    out[O_WS + b * WINDOW * 2 * N_KV * HD + r] = cache_win[b * WINDOW * 2 * N_KV * HD + (size_t)DEC_SEQ * 2 * N_KV * HD + r];
}
struct KvSrc { const float* cache_kv; const int* page_table; const float* out; };
__device__ inline const float* kv_full_ptr(const KvSrc& S, int seq, int tok, int e, int g) {
    if (seq < BATCH) return S.out + O_KVP + ((((size_t)seq * SEQ + tok) * 4 + e) * N_KV + g) * HD;
    const int b = seq - BATCH;
    if (tok < PAST_LEN) { const int page = S.page_table[b * N_PAGES + tok / PAGE_SIZE]; return S.cache_kv + ((((size_t)page * PAGE_SIZE + tok % PAGE_SIZE) * 4 + e) * N_KV + g) * HD; }
    if (tok < PAST_LEN + DEC_SEQ) return S.out + O_KVS + ((((size_t)b * DEC_SEQ + (tok - PAST_LEN)) * 4 + e) * N_KV + g) * HD;
    return nullptr;
}
__device__ inline int seq_nbc(int seq) { return seq < BATCH ? NBC_P : NBC_S; }
__device__ inline void cmp_hid_item(size_t i_, KvSrc S, const float* pe  , const float* w1  , float* hid) {
    const size_t i = i_;
    if (i >= (size_t)NSEQ * NBC_MAX * 2 * N_KV * CMP_HID) return;
    const int f = (int)(i % CMP_HID), g = (int)((i / CMP_HID) % N_KV), e = (int)((i / ((size_t)CMP_HID * N_KV)) % 2), c = (int)((i / ((size_t)CMP_HID * N_KV * 2)) % NBC_MAX), seq = (int)(i / ((size_t)CMP_HID * N_KV * 2 * NBC_MAX));
    if (c >= seq_nbc(seq)) return;
    float s = 0.f;
    for (int l = 0; l < L_CMP; ++l) {
        const float* r = kv_full_ptr(S, seq, c * L_CMP + l, e, g);
        const float* w = w1 + (((size_t)e * L_CMP + l) * HD) * CMP_HID + f; const float* pp = pe + ((size_t)e * L_CMP + l) * HD;
        for (int d = 0; d < HD; ++d) s += ((r ? r[d] : 0.f) + pp[d]) * w[(size_t)d * CMP_HID];
    }
    const float x = s; const float t = tanhf(0.7978845608028654f * (x + 0.044715f * x * x * x));
    hid[i] = 0.5f * x * (1.0f + t);
}
__device__ inline void cmp_out_item(size_t i_, const float* hid, const float* w2  , const float* k_norm0, float* kc, float* vc) {
    const int i = (int)i_;
    if (i >= NSEQ * NBC_MAX * 2 * N_KV) return;
    const int g = i % N_KV, e = (i / N_KV) % 2, c = (i / (2 * N_KV)) % NBC_MAX, seq = i / (2 * N_KV * NBC_MAX);
    if (c >= seq_nbc(seq)) return;
    const float* hr = hid + (size_t)i * CMP_HID;
    float v[HD];
    for (int d = 0; d < HD; ++d) { float s = 0.f; for (int f = 0; f < CMP_HID; ++f) s += hr[f] * w2[((size_t)e * CMP_HID + f) * HD + d]; v[d] = s; }
    if (e == 0) head_norm(v, k_norm0);
    float* o = (e == 0 ? kc : vc) + (((size_t)seq * NBC_MAX + c) * N_KV + g) * HD;
    for (int d = 0; d < HD; ++d) o[d] = v[d];
}
__device__ inline void qprep_item(size_t i_, const float* qg, const float* q_norm, float* qn, float* qr, float* gates) {
    const int i = (int)i_;
    if (i >= MT * N_HEADS) return;
    const int m = i / N_HEADS, hh = i % N_HEADS;
    const RowInfo ri = row_info(m);
    float v[HD];
    for (int d = 0; d < HD; ++d) v[d] = qg[(size_t)m * QGW + hh * HD + d];
    head_norm(v, q_norm);
    for (int d = 0; d < HD; ++d) qn[(size_t)m * HDM + hh * HD + d] = v[d];
    head_rope(v, ri.pos);
    for (int d = 0; d < HD; ++d) qr[(size_t)m * HDM + hh * HD + d] = v[d];
    for (int j = 0; j < 3; ++j) { const float x = qg[(size_t)m * QGW + HDM + hh * 3 + j]; gates[(size_t)m * 3 * N_HEADS + hh * 3 + j] = 1.0f / (1.0f + expf(-x)); }
}
__device__ inline void attn_cmp_item(size_t i_, const float* qn, const float* kc, const float* vc, float* pbuf, float* oc) {
    const int i = (int)i_;
    if (i >= MT * N_HEADS) return;
    const int m = i / N_HEADS, hh = i % N_HEADS, g = hh / HPG;
    const RowInfo ri = row_info(m);
    const int nbc = seq_nbc(ri.seq);
    const float* q = qn + (size_t)m * HDM + hh * HD;
    float* p = pbuf + (size_t)i * NBC_MAX;
    float mx = NEGF;
    for (int c = 0; c < nbc; ++c) {
        const bool vis = (c + 1) * L_CMP - 1 <= ri.pos;
        float s = 0.f; const float* k = kc + (((size_t)ri.seq * NBC_MAX + c) * N_KV + g) * HD;
        for (int d = 0; d < HD; ++d) s += q[d] * k[d];
        s *= 0.125f; p[c] = s; if (vis && s > mx) mx = s;
    }
    float sum = 0.f;
    for (int c = 0; c < nbc; ++c) { const bool vis = (c + 1) * L_CMP - 1 <= ri.pos; const float e = vis ? expf(p[c] - mx) : 0.f; p[c] = e; sum += e; }
    const float inv = 1.0f / fmaxf(sum, TINYF);
    float o[HD]; for (int d = 0; d < HD; ++d) o[d] = 0.f;
    for (int c = 0; c < nbc; ++c) { p[c] *= inv; if (p[c] != 0.f) { const float* v = vc + (((size_t)ri.seq * NBC_MAX + c) * N_KV + g) * HD; for (int d = 0; d < HD; ++d) o[d] += p[c] * v[d]; } }
    for (int d = 0; d < HD; ++d) oc[(size_t)m * HDM + hh * HD + d] = o[d];
}
__device__ inline void topk_item(size_t i_, const float* pbuf, int* sel, float* scorebuf  ) {
    const int i = (int)i_;
    if (i >= MT * N_KV) return;
    const int m = i / N_KV, g = i % N_KV;
    const RowInfo ri = row_info(m);
    const int nbs = ri.seq < BATCH ? NBS_P : NBS_S, cur = ri.pos / L_SEL;
    float* score = scorebuf + (size_t)i * NBS_MAX;
    for (int b = 0; b < nbs; ++b) {
        float imp = 0.f;
        for (int h = 0; h < HPG; ++h) { const float* p = pbuf + ((size_t)m * N_HEADS + g * HPG + h) * NBC_MAX; imp += p[2 * b]; }
        float imp2 = 0.f;
        for (int h = 0; h < HPG; ++h) { const float* p = pbuf + ((size_t)m * N_HEADS + g * HPG + h) * NBC_MAX; imp2 += p[2 * b + 1]; }
        const bool forced = (b == 0) || (b == cur) || (b == cur - 1), valid = b * L_SEL <= ri.pos;
        score[b] = valid ? (forced ? FORCE_SCORE : imp + imp2) : NEGF;
    }
    const int nsel = N_SEL < nbs ? N_SEL : nbs;
    for (int j = 0; j < N_SEL; ++j) {
        if (j >= nsel) { sel[(size_t)i * N_SEL + j] = -1; continue; }
        int best = -1; float bv = 0.f;
        for (int b = 0; b < nbs; ++b) if (score[b] > -3e38f && (best < 0 || score[b] > bv)) { best = b; bv = score[b]; }
        sel[(size_t)i * N_SEL + j] = best; score[best] = -3.4e38f;
    }
}
__device__ inline void attn_sel_item(size_t i_, KvSrc S, const float* qr, const int* sel, float* os) {
    const int i = (int)i_;
    if (i >= MT * N_HEADS) return;
    const int m = i / N_HEADS, hh = i % N_HEADS, g = hh / HPG;
    const RowInfo ri = row_info(m);
    const float* q = qr + (size_t)m * HDM + hh * HD;
    const int* sl = sel + ((size_t)m * N_KV + g) * N_SEL;
    float mx = NEGF;
    for (int j = 0; j < N_SEL; ++j) { const int b = sl[j]; if (b < 0) continue;
        for (int t = 0; t < L_SEL; ++t) { const int tok = b * L_SEL + t; if (tok > ri.pos) continue;
            const float* k = kv_full_ptr(S, ri.seq, tok, 2, g); float s = 0.f; if (k) for (int d = 0; d < HD; ++d) s += q[d] * k[d];
            s *= 0.125f; if (s > mx) mx = s; } }
    float sum = 0.f, o[HD]; for (int d = 0; d < HD; ++d) o[d] = 0.f;
    for (int j = 0; j < N_SEL; ++j) { const int b = sl[j]; if (b < 0) continue;
        for (int t = 0; t < L_SEL; ++t) { const int tok = b * L_SEL + t; if (tok > ri.pos) continue;
            const float* k = kv_full_ptr(S, ri.seq, tok, 2, g); float s = 0.f; if (k) for (int d = 0; d < HD; ++d) s += q[d] * k[d];
            const float e = expf(s * 0.125f - mx); sum += e;
            const float* v = kv_full_ptr(S, ri.seq, tok, 3, g); if (v) for (int d = 0; d < HD; ++d) o[d] += e * v[d]; } }
    const float inv = 1.0f / fmaxf(sum, TINYF);
    for (int d = 0; d < HD; ++d) os[(size_t)m * HDM + hh * HD + d] = o[d] * inv;
}
__device__ inline const float* win_ptr(const float* cache_win, const float* winrows, int seq, int kp) {
    if (seq < BATCH) return kp >= 0 ? winrows + (size_t)(seq * SEQ + kp) * 2 * N_KV * HD : nullptr;
    const int b = seq - BATCH;
    if (kp >= PAST_LEN) return winrows + (size_t)(MP + b * DEC_SEQ + (kp - PAST_LEN)) * 2 * N_KV * HD;
    const int j = kp - (PAST_LEN - WINDOW);
    return j >= 0 ? cache_win + ((size_t)b * WINDOW + j) * 2 * N_KV * HD : nullptr;
}
__device__ inline void attn_win_item(size_t i_, const float* cache_win, const float* winrows, const float* qr, const float* gates, const float* oc, const float* os, bf16_t* o_out) {
    const int i = (int)i_;
    if (i >= MT * N_HEADS) return;
    const int m = i / N_HEADS, hh = i % N_HEADS, g = hh / HPG;
    const RowInfo ri = row_info(m);
    const float* q = qr + (size_t)m * HDM + hh * HD;
    float mx = NEGF;
    for (int kp = ri.pos - WINDOW; kp <= ri.pos; ++kp) { const float* r = win_ptr(cache_win, winrows, ri.seq, kp); if (!r) continue;
        const float* k = r + (0 * N_KV + g) * HD; float s = 0.f; for (int d = 0; d < HD; ++d) s += q[d] * k[d]; s *= 0.125f; if (s > mx) mx = s; }
    float sum = 0.f, o[HD]; for (int d = 0; d < HD; ++d) o[d] = 0.f;
    for (int kp = ri.pos - WINDOW; kp <= ri.pos; ++kp) { const float* r = win_ptr(cache_win, winrows, ri.seq, kp); if (!r) continue;
        const float* k = r + (0 * N_KV + g) * HD; float s = 0.f; for (int d = 0; d < HD; ++d) s += q[d] * k[d];
        const float e = expf(s * 0.125f - mx); sum += e; const float* v = r + (1 * N_KV + g) * HD; for (int d = 0; d < HD; ++d) o[d] += e * v[d]; }
    const float inv = 1.0f / fmaxf(sum, TINYF);
    const float* gt = gates + (size_t)m * 3 * N_HEADS + hh * 3;
    for (int d = 0; d < HD; ++d) { const size_t x = (size_t)m * HDM + hh * HD + d; o_out[x] = f2bf(gt[0] * oc[x] + gt[1] * os[x] + gt[2] * o[d] * inv); }
}


#ifndef CPU_TEST
__device__ __forceinline__ unsigned lane_id_v() { unsigned l; asm volatile("v_mbcnt_lo_u32_b32 %0, -1, 0\n\tv_mbcnt_hi_u32_b32 %0, -1, %0" : "=v"(l)); return l; }
#endif
constexpr int NTHREADS = 512;
__host__ __device__ inline bf16_t f2bf_(float f) { unsigned u; memcpy(&u, &f, 4); u = (u + 0x7fffu + ((u >> 16) & 1u)) >> 16; return (bf16_t)u; }
__host__ __device__ inline float bf2f_(bf16_t b) { unsigned u = (unsigned)b << 16; float f; memcpy(&f, &u, 4); return f; }
constexpr int NRSS = 3 * DEPTH + 1;
constexpr int NPOS = SEQ + DEC_SEQ;
constexpr int QGP = ((QGW + 255) / 256) * 256;
__host__ __device__ inline int pos_index(int pos) { return pos < SEQ ? pos : SEQ + (pos - PAST_LEN); }

constexpr size_t IMG_SEQ_BYTES = (size_t)BATCH * N_KV * (SEQ / 64) * 8192, IMG_CMP_BYTES = (size_t)BATCH * N_KV * (NBC_P / 64 > 0 ? NBC_P / 64 : 1) * 8192;
struct WsMap {
    size_t ctl, rss, rope, h, hb, act, xn, t2, actf, ub, bb, zb, t1, qn, qr, gates, ob, winrows, hid, kc, vc, pbuf, oc, os, sel, scorebuf,
           w_ain, w_aout, w_bin, w_bout, w_cin, w_cout, w_qg, w_o, w_kv, qnb, qrb, ksel, vsel, kwin, vwin, kci, vci, acs, hids, acp, hidp, w1t, w2t, end;
};
constexpr size_t al256(size_t b) { return (b + 255) / 256 * 256; }
constexpr size_t smax(size_t a, size_t b) { return a > b ? a : b; }
constexpr WsMap make_ws_map() {
    WsMap w{}; size_t off = 0;
#define TAKE(f, bytes) w.f = off; off += al256(bytes)
    TAKE(ctl, 65536); TAKE(rss, (size_t)NRSS * MT * 4);
    TAKE(rope, (size_t)NPOS * 16 * 4);
    TAKE(h, (size_t)MT * D_MODEL * 4); TAKE(hb, (size_t)MT * D_MODEL * 2); TAKE(act, (size_t)MT * D_FF * 2);
    TAKE(xn, (size_t)MT * D_MODEL * 4); TAKE(t2, (size_t)MT * D_MODEL * 4); TAKE(actf, (size_t)MT * D_MODEL * 4);
    TAKE(ub, (size_t)MT * D_MODEL * 2); TAKE(bb, (size_t)MT * D_MODEL * 2); TAKE(zb, (size_t)MT * D_MODEL * 2);
    TAKE(t1, smax((size_t)MT * 3 * D_MODEL * 4, (size_t)MT * KVW * 4));
    TAKE(qn, (size_t)MT * HDM * 4); TAKE(qr, (size_t)MT * HDM * 4); TAKE(gates, (size_t)MT * 3 * N_HEADS * 4); TAKE(ob, (size_t)MT * HDM * 2);
    TAKE(winrows, (size_t)MT * 2 * N_KV * HD * 4); TAKE(hid, (size_t)NSEQ * NBC_MAX * 2 * N_KV * CMP_HID * 4);
    TAKE(kc, (size_t)NSEQ * NBC_MAX * N_KV * HD * 4); TAKE(vc, (size_t)NSEQ * NBC_MAX * N_KV * HD * 4);
    TAKE(pbuf, (size_t)MT * N_HEADS * NBC_MAX * 4); TAKE(oc, (size_t)MT * HDM * 4); TAKE(os, (size_t)MT * HDM * 4);
    TAKE(sel, (size_t)MT * N_KV * N_SEL * 4); TAKE(scorebuf, (size_t)MT * N_KV * NBS_MAX * 4);
    TAKE(w_ain, (size_t)DEPTH * 2 * D_FF * D_MODEL * 2); TAKE(w_aout, (size_t)DEPTH * D_MODEL * D_FF * 2);
    TAKE(w_bin, (size_t)DEPTH * 2 * D_FF * D_MODEL * 2); TAKE(w_bout, (size_t)DEPTH * D_MODEL * D_FF * 2);
    TAKE(w_cin, (size_t)N_A * 3 * D_MODEL * D_MODEL * 2); TAKE(w_cout, (size_t)N_A * D_MODEL * D_MODEL * 2);
    TAKE(w_qg, (size_t)N_B * QGP * D_MODEL * 2); TAKE(w_o, (size_t)N_B * D_MODEL * HDM * 2); TAKE(w_kv, (size_t)KVW * D_MODEL * 2);
    TAKE(qnb, (size_t)MT * HDM * 2); TAKE(qrb, (size_t)MT * HDM * 2); TAKE(ksel, IMG_SEQ_BYTES); TAKE(vsel, IMG_SEQ_BYTES); TAKE(kwin, IMG_SEQ_BYTES); TAKE(vwin, IMG_SEQ_BYTES); TAKE(kci, IMG_CMP_BYTES); TAKE(vci, IMG_CMP_BYTES);
    TAKE(acs, (size_t)2 * DEC_BATCH * (PAST_LEN / L_CMP) * N_KV * L_CMP * HD * 2); TAKE(hids, (size_t)2 * DEC_BATCH * (PAST_LEN / L_CMP) * N_KV * CMP_HID * 2);
    TAKE(acp, (size_t)2 * BATCH * NBC_P * N_KV * L_CMP * HD * 2); TAKE(hidp, (size_t)2 * BATCH * NBC_P * N_KV * CMP_HID * 2); TAKE(w1t, (size_t)2 * CMP_HID * L_CMP * HD * 2); TAKE(w2t, (size_t)2 * HD * CMP_HID * 2);
#undef TAKE
    w.end = off; return w;
}
constexpr WsMap WSM = make_ws_map();
constexpr size_t WS_ZERO_BYTES = 65536 + (((size_t)NRSS * MT * 4 + 255) / 256 * 256);

enum { CM_PLAIN = 0, CM_PAIR = 1, CM_CONV = 2, CM_HEADS = 3 };
__host__ __device__ inline int colmap(int kind, int n, int aux) {
    const int pn = n / 256, c = n % 256;
    if (kind == CM_PLAIN) return n;
    if (kind == CM_PAIR) return (c >= 128 ? aux : 0) + pn * 128 + (c % 128);
    if (kind == CM_CONV) { if (n < 2 * D_MODEL) return (c >= 128 ? 2 * D_MODEL : D_MODEL) + pn * 128 + (c % 128); return n - 2 * D_MODEL; }
    if (n < aux * 64) { const int bj = c / 128, wc = (c % 128) / 32, r = c % 32; return (pn * 4 + wc) * 64 + 32 * bj + r; }
    return n;
}
__device__ inline void wconv_item(size_t i_, const float* src, int Nsrc, const float* gain, bf16_t* dst, int Nd, int K, int kind, int aux) {
    const int n = (int)(i_ % Nd), kb = (int)(i_ / Nd);
    const int col = colmap(kind, n, aux);
    bf16_t* d = dst + (size_t)n * K + (size_t)kb * 64;
    if (col < 0 || col >= Nsrc) { for (int k = 0; k < 64; ++k) d[k] = 0; return; }
    const float* s = src + (size_t)kb * 64 * Nsrc + col;
#pragma unroll 8
    for (int k = 0; k < 64; k += 2) {
        const float g0 = gain ? gain[kb * 64 + k] : 1.f, g1 = gain ? gain[kb * 64 + k + 1] : 1.f;
        const unsigned lo = f2bf(s[(size_t)k * Nsrc] * g0), hi = f2bf(s[(size_t)(k + 1) * Nsrc] * g1);
        *(unsigned*)(d + k) = lo | (hi << 16);
    }
}
__device__ inline void rope_item(size_t i_, float* rope) {
    const int pi = (int)(i_ / 8), f = (int)(i_ % 8);
    const int pos = pi < SEQ ? pi : PAST_LEN + (pi - SEQ);
    float c, s; rope_cs((float)pos * INV_FREQ[f], c, s);
    rope[pi * 16 + f] = c; rope[pi * 16 + 8 + f] = s;
}
__device__ inline void hinit_item(size_t i_, const float* xp, const float* xs, float* h, bf16_t* hb, float* rss0) {
    const int m = (int)i_; const float* x = m < MP ? xp + (size_t)m * D_MODEL : xs + (size_t)(m - MP) * D_MODEL;
    float s = 0.f;
    for (int k = 0; k < D_MODEL; ++k) { const float v = x[k]; s += v * v; h[(size_t)m * D_MODEL + k] = v; hb[(size_t)m * D_MODEL + k] = f2bf(v); }
    rss0[m] = s;
}
__device__ inline void hupd_item(size_t i_, float* h, const float* y, float coef, bf16_t* hb, float* rss) {
    const int m = (int)i_; float s = 0.f;
    for (int k = 0; k < D_MODEL; ++k) { const float v = h[(size_t)m * D_MODEL + k] + coef * y[(size_t)m * D_MODEL + k]; s += v * v; h[(size_t)m * D_MODEL + k] = v; hb[(size_t)m * D_MODEL + k] = f2bf(v); }
    rss[m] = s;
}
__device__ inline float dot_bf(const bf16_t* a, const bf16_t* b, int K) { float s = 0.f; for (int k = 0; k < K; ++k) s += bf2f(a[k]) * bf2f(b[k]); return s; }
__device__ inline float silu_f(float g) { return g / (1.0f + expf(-g)); }
__device__ inline void ref_ffn_in_item(size_t i_, const bf16_t* hb, const float* rss, const bf16_t* Bt, bf16_t* act) {
    const int m = (int)(i_ / D_FF), j = (int)(i_ % D_FF);
    const float rs = 1.0f / sqrtf(rss[m] / D_MODEL + EPS);
    const int ng = (j / 128) * 256 + (j % 128);
    const float g = rs * dot_bf(hb + (size_t)m * D_MODEL, Bt + (size_t)ng * D_MODEL, D_MODEL), u = rs * dot_bf(hb + (size_t)m * D_MODEL, Bt + (size_t)(ng + 128) * D_MODEL, D_MODEL);
    act[i_] = f2bf(silu_f(g) * u);
}
__device__ inline void ref_resid_row_item(size_t i_, const bf16_t* A, int K, const bf16_t* Bt, float coef, float* h, bf16_t* hb, float* rss_next, float* yout) {
    const int m = (int)i_; float s = 0.f;
    for (int c = 0; c < D_MODEL; ++c) {
        const float v = h[(size_t)m * D_MODEL + c] + coef * dot_bf(A + (size_t)m * K, Bt + (size_t)c * K, K);
        if (yout) { yout[(size_t)m * D_MODEL + c] = v; } else { h[(size_t)m * D_MODEL + c] = v; hb[(size_t)m * D_MODEL + c] = f2bf(v); s += v * v; }
    }
    if (!yout) rss_next[m] = s;
}

constexpr float QSCALE_F = 0.125f * 1.4426950408889634f;
__device__ inline void qconv_item(size_t i_, const float* qn, const float* qr, bf16_t* qnb, bf16_t* qrb) { qnb[i_] = f2bf(qn[i_] * QSCALE_F); qrb[i_] = f2bf(qr[i_] * QSCALE_F); }
__host__ __device__ inline size_t kimg_off(int kv, int d0) { return (size_t)(d0 >> 3) * 1024 + (size_t)kv * 16; }
__host__ __device__ inline size_t vimg_off(int kv, int d0) { return (size_t)(d0 >> 5) * 4096 + (size_t)(kv >> 3) * 512 + (size_t)(kv & 7) * 64 + (size_t)((d0 & 31) >> 3) * 16; }
__device__ inline void put_chunk(unsigned char* dst, const float* src) { bf16_t* d = (bf16_t*)dst; for (int k = 0; k < 8; ++k) d[k] = f2bf(src[k]); }
__device__ inline void kvimg_item(size_t i_, const float* out, const float* winrows, unsigned char* ksel, unsigned char* vsel, unsigned char* kwin, unsigned char* vwin) {
    const int c = (int)(i_ % 8), t = (int)((i_ / 8) % SEQ), g = (int)((i_ / (8 * (size_t)SEQ)) % N_KV), n = (int)(i_ / (8 * (size_t)SEQ * N_KV));
    const size_t base = (((size_t)n * N_KV + g) * (SEQ / 64) + t / 64) * 8192; const int kv = t % 64, d0 = 8 * c; const size_t m = (size_t)n * SEQ + t;
    put_chunk(ksel + base + kimg_off(kv, d0), out + O_KVP + ((m * 4 + 2) * N_KV + g) * HD + d0);
    put_chunk(vsel + base + vimg_off(kv, d0), out + O_KVP + ((m * 4 + 3) * N_KV + g) * HD + d0);
    put_chunk(kwin + base + kimg_off(kv, d0), winrows + ((m * 2 + 0) * N_KV + g) * HD + d0);
    put_chunk(vwin + base + vimg_off(kv, d0), winrows + ((m * 2 + 1) * N_KV + g) * HD + d0);
}
__device__ inline void kcimg_item(size_t i_, const float* kc, const float* vc, unsigned char* kci, unsigned char* vci) {
    const int c = (int)(i_ % 8), cb = (int)((i_ / 8) % NBC_P), g = (int)((i_ / (8 * (size_t)NBC_P)) % N_KV), n = (int)(i_ / (8 * (size_t)NBC_P * N_KV));
    const size_t base = (((size_t)n * N_KV + g) * (NBC_P / 64) + cb / 64) * 8192; const int kv = cb % 64, d0 = 8 * c;
    put_chunk(kci + base + kimg_off(kv, d0), kc + (((size_t)n * NBC_MAX + cb) * N_KV + g) * HD + d0);
    put_chunk(vci + base + vimg_off(kv, d0), vc + (((size_t)n * NBC_MAX + cb) * N_KV + g) * HD + d0);
}

constexpr int NBC_PAST = PAST_LEN / L_CMP;
constexpr int RS_CMP = DEC_BATCH * NBC_PAST * N_KV, RP_CMP = BATCH * NBC_P * N_KV;
__device__ inline void acmp_sample_item(size_t i_, const float* cache_kv, const int* page_table, const float* pe, bf16_t* A) {
    const int c8 = (int)(i_ % 8), l = (int)((i_ / 8) % L_CMP); const size_t rr = i_ / (8 * L_CMP); const int r = (int)(rr % RS_CMP), e = (int)(rr / RS_CMP);
    const int g = r % N_KV, c = (r / N_KV) % NBC_PAST, b = r / (N_KV * NBC_PAST), tok = c * L_CMP + l;
    const int page = page_table[b * N_PAGES + tok / PAGE_SIZE];
    const float* src = cache_kv + ((((size_t)page * PAGE_SIZE + tok % PAGE_SIZE) * 4 + e) * N_KV + g) * HD + 8 * c8; const float* pp = pe + ((size_t)e * L_CMP + l) * HD + 8 * c8;
    bf16_t* d = A + ((size_t)e * RS_CMP + r) * (L_CMP * HD) + l * HD + 8 * c8;
#ifndef CPU_TEST
    typedef float f4 __attribute__((ext_vector_type(4))); typedef unsigned u4 __attribute__((ext_vector_type(4)));
    const f4 a0 = __builtin_nontemporal_load((const f4*)src) + *(const f4*)pp, a1 = __builtin_nontemporal_load((const f4*)(src + 4)) + *(const f4*)(pp + 4);
    u4 w; w.x = (unsigned)f2bf(a0[0]) | ((unsigned)f2bf(a0[1]) << 16); w.y = (unsigned)f2bf(a0[2]) | ((unsigned)f2bf(a0[3]) << 16);
    w.z = (unsigned)f2bf(a1[0]) | ((unsigned)f2bf(a1[1]) << 16); w.w = (unsigned)f2bf(a1[2]) | ((unsigned)f2bf(a1[3]) << 16);
    *(u4*)d = w;
#else
    for (int k = 0; k < 8; ++k) d[k] = f2bf(src[k] + pp[k]);
#endif
}
__device__ inline void acmp_prompt_item(size_t i_, const float* out, const float* pe, bf16_t* A) {
    const int c8 = (int)(i_ % 8), l = (int)((i_ / 8) % L_CMP); const size_t rr = i_ / (8 * L_CMP); const int r = (int)(rr % RP_CMP), e = (int)(rr / RP_CMP);
    const int g = r % N_KV, c = (r / N_KV) % NBC_P, n = r / (N_KV * NBC_P), tok = c * L_CMP + l;
    const float* src = out + O_KVP + ((((size_t)n * SEQ + tok) * 4 + e) * N_KV + g) * HD + 8 * c8; const float* pp = pe + ((size_t)e * L_CMP + l) * HD + 8 * c8;
    bf16_t* d = A + ((size_t)e * RP_CMP + r) * (L_CMP * HD) + l * HD + 8 * c8;
    for (int k = 0; k < 8; ++k) d[k] = f2bf(src[k] + pp[k]);
}
__device__ inline void cmp_out_b_item(size_t i_, const bf16_t* hid, int R, int nbc, int seq0, const float* w2, const float* k_norm0, float* kc, float* vc) {
    const int r = (int)(i_ % R), e = (int)(i_ / R); const int g = r % N_KV, c = (r / N_KV) % nbc, sq = r / (N_KV * nbc);
    const bf16_t* hr = hid + ((size_t)e * R + r) * CMP_HID;
    float v[HD];
    for (int d = 0; d < HD; ++d) v[d] = 0.f;
    for (int f = 0; f < CMP_HID; ++f) { const float hf = bf2f(hr[f]); const float* w = w2 + ((size_t)e * CMP_HID + f) * HD; for (int d = 0; d < HD; ++d) v[d] += hf * w[d]; }
    if (e == 0) head_norm(v, k_norm0);
    float* o = (e == 0 ? kc : vc) + (((size_t)(seq0 + sq) * NBC_MAX + c) * N_KV + g) * HD;
    for (int d = 0; d < HD; ++d) o[d] = v[d];
}
__host__ __device__ inline int heads_row(int hidx, int d) { return (hidx / 4) * 256 + 128 * (d / 32) + 32 * (hidx % 4) + (d % 32); }
__device__ inline void conv_state_store(float* out, int layer, int m, int ch, float u) {
    const RowInfo ri = row_info(m); const int L = seq_len(ri.seq);
    if (ri.t >= L - 2) { const int j = ri.t - (L - 2);
        if (ri.seq < BATCH) out[O_CP + (((size_t)layer * BATCH + ri.seq) * 2 + j) * D_MODEL + ch] = u;
        else out[O_CS + (((size_t)layer * DEC_BATCH + (ri.seq - BATCH)) * 2 + j) * D_MODEL + ch] = u; }
}
__device__ inline void ref_conv_in_item(size_t i_, const bf16_t* hb, const float* rss, const bf16_t* Bt, bf16_t* ub, bf16_t* bb, float* out, int layer) {
    const int m = (int)(i_ / D_MODEL), j = (int)(i_ % D_MODEL);
    const float rs = 1.0f / sqrtf(rss[m] / D_MODEL + EPS); const bf16_t* a = hb + (size_t)m * D_MODEL;
    const int nc = (j / 128) * 256 + (j % 128);
    const float c = rs * dot_bf(a, Bt + (size_t)nc * D_MODEL, D_MODEL), x = rs * dot_bf(a, Bt + (size_t)(nc + 128) * D_MODEL, D_MODEL), b = rs * dot_bf(a, Bt + (size_t)(2 * D_MODEL + j) * D_MODEL, D_MODEL);
    const float u = c * x; ub[i_] = f2bf(u); bb[i_] = f2bf(b); conv_state_store(out, layer, m, j, u);
}
__device__ inline void conv_thin_item(size_t i_, const bf16_t* ub, const bf16_t* bb, const float* state  , const float* wc  , bf16_t* zb) {
    const int m = (int)(i_ / D_MODEL), ch = (int)(i_ % D_MODEL);
    const RowInfo ri = row_info(m);
    const float u0 = bf2f(ub[i_]);
    float u1, u2;
    if (ri.t >= 1) u1 = bf2f(ub[i_ - D_MODEL]); else u1 = (ri.seq < BATCH) ? 0.f : state[((size_t)(ri.seq - BATCH) * 2 + 1) * D_MODEL + ch];
    if (ri.t >= 2) u2 = bf2f(ub[i_ - 2 * D_MODEL]); else if (ri.seq < BATCH) u2 = 0.f;
    else u2 = (ri.t == 1) ? state[((size_t)(ri.seq - BATCH) * 2 + 1) * D_MODEL + ch] : state[((size_t)(ri.seq - BATCH) * 2 + 0) * D_MODEL + ch];
    zb[i_] = f2bf(bf2f(bb[i_]) * (wc[ch] * u2 + wc[D_MODEL + ch] * u1 + wc[2 * D_MODEL + ch] * u0));
}
__device__ inline void ref_qg_item(size_t i_, const bf16_t* hb, const float* rss, const bf16_t* Bt, const float* q_norm, const float* rope, float* qn, float* qr) {
    const int m = (int)(i_ / N_HEADS), hh = (int)(i_ % N_HEADS);
    const float rs = 1.0f / sqrtf(rss[m] / D_MODEL + EPS); const bf16_t* a = hb + (size_t)m * D_MODEL;
    float v[HD]; for (int d = 0; d < HD; ++d) v[d] = rs * dot_bf(a, Bt + (size_t)heads_row(hh, d) * D_MODEL, D_MODEL);
    head_norm(v, q_norm);
    for (int d = 0; d < HD; ++d) qn[(size_t)m * HDM + hh * HD + d] = v[d];
    const float* rt = rope + (size_t)pos_index(row_info(m).pos) * 16;
    for (int f = 0; f < 8; ++f) { const float x1 = v[f], x2 = v[8 + f]; v[f] = x1 * rt[f] - x2 * rt[8 + f]; v[8 + f] = x2 * rt[f] + x1 * rt[8 + f]; }
    for (int d = 0; d < HD; ++d) qr[(size_t)m * HDM + hh * HD + d] = v[d];
}
__device__ inline void ref_gates_item(size_t i_, const bf16_t* hb, const float* rss, const bf16_t* Bt, float* gates) {
    const int m = (int)(i_ / (3 * N_HEADS)), j = (int)(i_ % (3 * N_HEADS));
    const float rs = 1.0f / sqrtf(rss[m] / D_MODEL + EPS);
    const float x = rs * dot_bf(hb + (size_t)m * D_MODEL, Bt + (size_t)(HDM + j) * D_MODEL, D_MODEL);
    gates[i_] = 1.0f / (1.0f + expf(-x));
}
__device__ inline void kv_store(float* out, float* winrows, int m, int e, int g, int d, float v) {
    const RowInfo ri = row_info(m);
    if (e < 4) { if (ri.seq < BATCH) out[O_KVP + (((size_t)m * 4 + e) * N_KV + g) * HD + d] = v; else out[O_KVS + (((size_t)(m - MP) * 4 + e) * N_KV + g) * HD + d] = v; }
    else { const int we = e - 4;
        winrows[(((size_t)m * 2 + we) * N_KV + g) * HD + d] = v;
        if (ri.seq < BATCH) { if (ri.t >= SEQ - WINDOW) out[O_WP + ((((size_t)ri.seq * WINDOW + (ri.t - (SEQ - WINDOW))) * 2 + we) * N_KV + g) * HD + d] = v; }
        else out[O_WS + ((((size_t)(ri.seq - BATCH) * WINDOW + (WINDOW - DEC_SEQ + ri.t)) * 2 + we) * N_KV + g) * HD + d] = v; }
}
__device__ inline void ref_kv_item(size_t i_, const bf16_t* hb, const float* rss, const bf16_t* Bt, const float* k_norm, const float* rope, float* out, float* winrows) {
    const int m = (int)(i_ / (6 * N_KV)), hidx = (int)(i_ % (6 * N_KV)), e = hidx / N_KV, g = hidx % N_KV;
    const float rs = 1.0f / sqrtf(rss[m] / D_MODEL + EPS); const bf16_t* a = hb + (size_t)m * D_MODEL;
    float v[HD]; for (int d = 0; d < HD; ++d) v[d] = rs * dot_bf(a, Bt + (size_t)heads_row(hidx, d) * D_MODEL, D_MODEL);
    if (e == 2 || e == 4) { head_norm(v, k_norm + (e == 2 ? 1 : 2) * HD);
        const float* rt = rope + (size_t)pos_index(row_info(m).pos) * 16;
        for (int f = 0; f < 8; ++f) { const float x1 = v[f], x2 = v[8 + f]; v[f] = x1 * rt[f] - x2 * rt[8 + f]; v[8 + f] = x2 * rt[f] + x1 * rt[8 + f]; } }
    for (int d = 0; d < HD; ++d) kv_store(out, winrows, m, e, g, d, v[d]);
}
#ifndef CPU_TEST
#define LAS __attribute__((address_space(3)))
#define XB_TMO      128
#define XB_XCNT(j)  (256  + 64 * (j))
#define XB_XSUB(j)  (1280 + 64 * (j))
#define XB_XGEN(j)  (2304 + 64 * (j))
#define XB_TOP      3328
#define XB_TOPGEN   3392
#define XCD_BAR_WORDS 3456
#define XB_SPIN_CAP (1u << 25)
typedef __attribute__((address_space(1))) unsigned GU;
__device__ __forceinline__ unsigned xb_ld(GU* p)              { return __hip_atomic_load(p, __ATOMIC_RELAXED, __HIP_MEMORY_SCOPE_AGENT); }
__device__ __forceinline__ unsigned xb_add(GU* p, unsigned v) { return __hip_atomic_fetch_add(p, v, __ATOMIC_RELAXED, __HIP_MEMORY_SCOPE_AGENT); }
__device__ __forceinline__ unsigned xb_xcc_id() { return (unsigned)__builtin_amdgcn_s_getreg((3 << 11) | 20) & 0xFu; }
#define XB_SPIN(cond, bar) do { unsigned _sp = 0; while (cond) { __builtin_amdgcn_s_sleep(1); \
    if ((++_sp & 255u) == 0u) { if (xb_ld(&(bar)[XB_TMO])) break; if (_sp > XB_SPIN_CAP) { (void)xb_add(&(bar)[XB_TMO], 1u); break; } } } } while (0)
struct XcdBarrier { GU* bar; unsigned x; volatile LAS unsigned* st; };
__device__ __forceinline__ XcdBarrier xcd_barrier_post(GU* bar, volatile LAS unsigned* st, const bool leader_thread) {
    XcdBarrier b; b.bar = bar; b.x = xb_xcc_id(); b.st = st;
    if (leader_thread) (void)xb_add(&bar[XB_XCNT(b.x)], 1u);
    return b;
}
__device__ __forceinline__ void xcd_barrier_complete(GU* bar, unsigned x, unsigned& nloc, unsigned& nx) {
    const unsigned G = gridDim.x * gridDim.y * gridDim.z;
    unsigned sum, cnt, mine, sp = 0u;
    for (;;) {
        sum = 0u; cnt = 0u; mine = 0u;
#pragma unroll
        for (unsigned j = 0; j < 16; ++j) { const unsigned c = xb_ld(&bar[XB_XCNT(j)]); sum += c; cnt += (c > 0u) ? 1u : 0u; mine = (j == x) ? c : mine; }
        if (sum == G) break;
        __builtin_amdgcn_s_sleep(1);
        if ((++sp & 255u) == 0u) { if (xb_ld(&bar[XB_TMO])) break; if (sp > XB_SPIN_CAP) { (void)xb_add(&bar[XB_TMO], 1u); break; } }
    }
    nloc = mine > 0u ? mine : 1u; nx = cnt > 0u ? cnt : 1u;
}
__device__ __forceinline__ void xcd_barrier(const XcdBarrier& b, const bool leader_thread) {
    asm volatile("s_waitcnt vmcnt(0)" ::: "memory");
    __syncthreads();
    if (leader_thread) {
        GU* bar = b.bar; unsigned bx = xb_xcc_id(); asm volatile("" : "+s"(bx));
        __builtin_amdgcn_s_waitcnt(0);
        unsigned nloc = b.st[0], nx = b.st[1];
        if (nloc == 0u) { xcd_barrier_complete(bar, bx, nloc, nx); b.st[0] = nloc; b.st[1] = nx; }
        const unsigned old = xb_add(&bar[XB_XSUB(bx)], 1u);
        const unsigned gen = old / nloc;
        if (old + 1u == (gen + 1u) * nloc) {
            __builtin_amdgcn_fence(__ATOMIC_RELEASE, "agent");
            asm volatile("s_waitcnt vmcnt(0)" ::: "memory");
            const unsigned og = xb_add(&bar[XB_TOP], 1u);
            const unsigned tg = og / nx;
            if (og + 1u == (tg + 1u) * nx) xb_add(&bar[XB_TOPGEN], 1u);
            else XB_SPIN(xb_ld(&bar[XB_TOPGEN]) == tg, bar);
            __builtin_amdgcn_fence(__ATOMIC_ACQUIRE, "agent");
            xb_add(&bar[XB_XGEN(bx)], 1u);
            asm volatile("s_waitcnt vmcnt(0)" ::: "memory");
        } else {
            XB_SPIN(xb_ld(&bar[XB_XGEN(bx)]) == gen, bar);
            __builtin_amdgcn_fence(__ATOMIC_ACQUIRE, "agent");
            asm volatile("s_waitcnt vmcnt(0)" ::: "memory");
        }
    }
    __syncthreads();
}

namespace pg8 {
#define PG8_LAS __attribute__((address_space(3)))
typedef unsigned short bf16_t;
typedef short bf16x8 __attribute__((ext_vector_type(8)));
typedef float f32x4 __attribute__((ext_vector_type(4)));
typedef unsigned u32x4 __attribute__((ext_vector_type(4)));
constexpr int BM = 256, BK = 64, HALF = 128, HTB = HALF * BK * 2  , STAGE_BYTES = 8 * HTB, NXCD = 8, WGM = 8;

__host__ __device__ __forceinline__ int lds_byte(int r, int c) { const int st = (r >> 4) * 2 + (c >> 5), rr = r & 15, cc = c & 31, ob = rr * 64 + cc * 2; return st * 1024 + (ob ^ (((ob >> 9) & 1) << 5)); }
__host__ __device__ __forceinline__ void stage_rc(int b, int& R, int& C) { const int st = b / 1024, sb = b % 1024, swz = sb ^ (((sb >> 9) & 1) << 5); R = (st >> 1) * 16 + swz / 64; C = (st & 1) * 32 + (swz % 64) / 2; }
__host__ __device__ __forceinline__ int perm32(int rho) { const int n = rho >> 4, i = rho & 15; return 8 * (i >> 2) + 4 * n + (i & 3); }

struct Unit { int pm, pn; };
struct Gemm { const bf16_t* A; const bf16_t* Bt; int M, N, K; };

struct StaticOrder {
    int nM, nN, nwg, G, c;
    __host__ __device__ void init(int M, int N, int G_, int c_) { nM = M / BM; nN = N / BM; nwg = nM * nN; G = G_; c = c_; }
    __host__ __device__ bool next(int i, Unit& u) const {
        const long L = (long)i * G + c; if (L >= nwg) return false;
        int wgid = (int)L; { const int q = nwg / NXCD, r = nwg % NXCD, xcd = wgid % NXCD, off = wgid / NXCD; wgid = (xcd < r ? xcd * (q + 1) : r * (q + 1) + (xcd - r) * q) + off; }
        const int nig = WGM * nN, gid = wgid / nig, fm = gid * WGM, gsz = (nM - fm) < WGM ? (nM - fm) : WGM;
        u.pm = fm + ((wgid % nig) % gsz); u.pn = (wgid % nig) / gsz; return true;
    }
    __device__ __forceinline__ void a_ready(const Unit&) const {}
    __device__ __forceinline__ void done(const Unit&) const {}
};

__device__ __forceinline__ unsigned cvt_pk_bf16(float lo, float hi) { unsigned r; asm volatile("v_cvt_pk_bf16_f32 %0, %1, %2" : "=v"(r) : "v"(lo), "v"(hi)); return r; }
template <class Epi, class Sched, bool ALIGN_EPI = false, bool SP2 = false>
__device__ __forceinline__ void gemm_phase(int wave_id_, PG8_LAS unsigned char* lds, const Gemm g, const Sched& S, const Epi& E) {
    int wid = wave_id_, lane = (int)lane_id_v(); asm volatile("" : "+s"(wid));
    const int tid = wid * 64 + lane, wr = wid >> 2, wc = wid & 3, fr = lane & 15, fq = lane >> 4;
    const int K = g.K, nt = K / BK;
    unsigned voffA[2], voffB[2];
#pragma unroll
    for (int i = 0; i < 2; ++i) { int R, C; stage_rc(tid * 16 + i * 8192, R, C); const int Rb = Epi::PERM ? ((R & ~31) + perm32(R & 31)) : R;
        voffA[i] = (unsigned)(R * K + C) * 2u; voffB[i] = (unsigned)(Rb * K + C) * 2u; }
    const size_t kstep = (size_t)(BK * 2);
    const size_t hstep = (size_t)HALF * K * 2;
    const size_t tstep = 2 * hstep;
    const unsigned ldsw = (unsigned)wid * 1024u;
    const int aoff = lds_byte(wr * 64 + fr, fq * 8), boff = lds_byte(wc * 32 + fr, fq * 8);
#define PG8_SA(b, h) (((b) * 2 + (h)) * HTB)
#define PG8_SB(b, h) ((4 + (b) * 2 + (h)) * HTB)
#define PG8_STAGE(bufoff, gbase, voff) do { _Pragma("unroll") for (int _i = 0; _i < 2; ++_i) \
        __builtin_amdgcn_global_load_lds((const unsigned*)((const char*)(gbase) + (voff)[_i]), (PG8_LAS unsigned*)(lds + (bufoff) + ldsw + _i * 8192), 16, 0, 0); } while (0)
#define PG8_LDA(dst, b, h) do { _Pragma("unroll") for (int m = 0; m < 4; ++m) _Pragma("unroll") for (int k = 0; k < 2; ++k) dst[m][k] = *(const PG8_LAS bf16x8*)(lds + PG8_SA(b, h) + aoff + m * 2048 + k * 1024); } while (0)
#define PG8_LDB(dst, b, h) do { _Pragma("unroll") for (int n = 0; n < 2; ++n) _Pragma("unroll") for (int k = 0; k < 2; ++k) dst[n][k] = *(const PG8_LAS bf16x8*)(lds + PG8_SB(b, h) + boff + n * 2048 + k * 1024); } while (0)
#define PG8_MMA(ai, bj, At, Bt) do { __builtin_amdgcn_s_setprio(1); _Pragma("unroll") for (int m = 0; m < 4; ++m) _Pragma("unroll") for (int n = 0; n < 2; ++n) _Pragma("unroll") for (int k = 0; k < 2; ++k) \
        acc[ai][bj][m][n] = __builtin_amdgcn_mfma_f32_16x16x32_bf16(Bt[n][k], At[m][k], acc[ai][bj][m][n], 0, 0, 0); __builtin_amdgcn_s_setprio(0); } while (0)
#define PG8_WAIT_V(n) asm volatile("s_waitcnt vmcnt(" #n ")" ::: "memory")
#define PG8_WAIT_L(n) asm volatile("s_waitcnt lgkmcnt(" #n ")" ::: "memory")
#define PG8_BAR __builtin_amdgcn_s_barrier()
#define PG8_SCHED __builtin_amdgcn_sched_barrier(0)
    Unit cur, nxt; int ui = 0;
    if (!S.next(0, cur)) return;
    f32x4 acc[2][2][4][2];
#pragma unroll
    for (int a = 0; a < 2; ++a)
#pragma unroll
        for (int b = 0; b < 2; ++b)
#pragma unroll
            for (int m = 0; m < 4; ++m)
#pragma unroll
                for (int n = 0; n < 2; ++n) acc[a][b][m][n] = (f32x4){0.f, 0.f, 0.f, 0.f};
    bf16x8 At[4][2], B0[2][2], B1[2][2];
    const char* cA = (const char*)g.A + (size_t)cur.pm * tstep; const char* cB = (const char*)g.Bt + (size_t)cur.pn * tstep;
    S.a_ready(cur);
    if constexpr (SP2) {
        PG8_STAGE(PG8_SB(0, 0), cB, voffB); PG8_STAGE(PG8_SB(0, 1), cB + hstep, voffB); PG8_STAGE(PG8_SA(0, 0), cA, voffA); PG8_STAGE(PG8_SA(0, 1), cA + hstep, voffA);
        if (wr == 1) PG8_BAR;
        PG8_WAIT_V(2); PG8_BAR;
        PG8_STAGE(PG8_SB(1, 0), cB + kstep, voffB); PG8_STAGE(PG8_SA(1, 0), cA + kstep, voffA); PG8_STAGE(PG8_SB(1, 1), cB + hstep + kstep, voffB);
        PG8_WAIT_V(6); PG8_BAR;
    } else {
        PG8_STAGE(PG8_SB(0, 0), cB, voffB); PG8_STAGE(PG8_SA(0, 0), cA, voffA); PG8_STAGE(PG8_SB(0, 1), cB + hstep, voffB); PG8_STAGE(PG8_SA(0, 1), cA + hstep, voffA);
        if (wr == 1) PG8_BAR;
        PG8_WAIT_V(4); PG8_BAR;
        PG8_STAGE(PG8_SB(1, 0), cB + kstep, voffB); PG8_STAGE(PG8_SA(1, 0), cA + kstep, voffA); PG8_STAGE(PG8_SB(1, 1), cB + hstep + kstep, voffB);
        PG8_WAIT_V(6); PG8_BAR;
    }
    for (;;) {
        const bool has_next = S.next(ui + 1, nxt);
        const char* nA = has_next ? (const char*)g.A + (size_t)nxt.pm * tstep : cA; const char* nB = has_next ? (const char*)g.Bt + (size_t)nxt.pn * tstep : cB;
        for (int t = 0; t < nt; t += 2) {
            const bool last = (t == nt - 2);
            const char* a1 = cA + (size_t)(t + 1) * kstep;
            const char* a2 = last ? nA : cA + (size_t)(t + 2) * kstep; const char* b2 = last ? nB : cB + (size_t)(t + 2) * kstep;
            const char* a3 = a2 + kstep; const char* b3 = b2 + kstep;
            if (last && has_next) S.a_ready(nxt);
            if constexpr (SP2) {
            PG8_LDB(B0, 0, 0); PG8_LDB(B1, 0, 1); PG8_SCHED; PG8_LDA(At, 0, 0); PG8_STAGE(PG8_SA(1, 1), a1 + hstep, voffA);
            PG8_WAIT_V(8); PG8_WAIT_L(0); PG8_BAR; PG8_MMA(0, 0, At, B0); PG8_MMA(0, 1, At, B1); PG8_BAR; PG8_SCHED;
            PG8_LDA(At, 0, 1); PG8_STAGE(PG8_SB(0, 0), b2, voffB); PG8_STAGE(PG8_SB(0, 1), b2 + hstep, voffB); PG8_STAGE(PG8_SA(0, 0), a2, voffA);
            PG8_WAIT_V(8); PG8_WAIT_L(0); PG8_BAR; PG8_MMA(1, 0, At, B0); PG8_MMA(1, 1, At, B1); PG8_BAR; PG8_SCHED;
            PG8_LDB(B0, 1, 0); PG8_LDB(B1, 1, 1); PG8_SCHED; PG8_LDA(At, 1, 0); PG8_STAGE(PG8_SA(0, 1), a2 + hstep, voffA);
            PG8_WAIT_V(8); PG8_WAIT_L(0); PG8_BAR; PG8_MMA(0, 0, At, B0); PG8_MMA(0, 1, At, B1); PG8_BAR; PG8_SCHED;
            PG8_LDA(At, 1, 1); PG8_STAGE(PG8_SB(1, 0), b3, voffB); PG8_STAGE(PG8_SB(1, 1), b3 + hstep, voffB); PG8_STAGE(PG8_SA(1, 0), a3, voffA);
            PG8_WAIT_V(8); PG8_WAIT_L(0); PG8_BAR; PG8_MMA(1, 0, At, B0); PG8_MMA(1, 1, At, B1); PG8_BAR; PG8_SCHED;
            } else {
            PG8_LDB(B0, 0, 0); PG8_SCHED; PG8_LDA(At, 0, 0); PG8_STAGE(PG8_SA(1, 1), a1 + hstep, voffA);
            PG8_WAIT_L(8); PG8_BAR; PG8_WAIT_L(0); PG8_MMA(0, 0, At, B0); PG8_BAR; PG8_SCHED;
            PG8_LDB(B1, 0, 1); PG8_STAGE(PG8_SB(0, 0), b2, voffB);
            PG8_BAR; PG8_WAIT_L(0); PG8_MMA(0, 1, At, B1); PG8_BAR;
            PG8_LDA(At, 0, 1); PG8_STAGE(PG8_SA(0, 0), a2, voffA);
            PG8_BAR; PG8_WAIT_L(0); PG8_MMA(1, 0, At, B0); PG8_BAR; PG8_SCHED;
            PG8_STAGE(PG8_SB(0, 1), b2 + hstep, voffB);
            PG8_WAIT_V(6); PG8_BAR; PG8_MMA(1, 1, At, B1); PG8_BAR;
            PG8_LDB(B0, 1, 0); PG8_SCHED; PG8_LDA(At, 1, 0); PG8_STAGE(PG8_SA(0, 1), a2 + hstep, voffA);
            PG8_WAIT_L(8); PG8_BAR; PG8_WAIT_L(0); PG8_MMA(0, 0, At, B0); PG8_BAR; PG8_SCHED;
            PG8_LDB(B1, 1, 1); PG8_STAGE(PG8_SB(1, 0), b3, voffB);
            PG8_BAR; PG8_WAIT_L(0); PG8_MMA(0, 1, At, B1); PG8_BAR;
            PG8_LDA(At, 1, 1); PG8_STAGE(PG8_SA(1, 0), a3, voffA);
            PG8_BAR; PG8_WAIT_L(0); PG8_MMA(1, 0, At, B0); PG8_BAR; PG8_SCHED;
            PG8_STAGE(PG8_SB(1, 1), b3 + hstep, voffB);
            PG8_WAIT_V(6); PG8_BAR; PG8_MMA(1, 1, At, B1); PG8_BAR;
            }
        }
        if constexpr (ALIGN_EPI) { if (wr == 0) PG8_BAR; }
        if constexpr (!Epi::AFTER_DRAIN) { E(acc, cur, wr, wc, fr, fq); S.done(cur); }
        if (!has_next) break;
#pragma unroll
        for (int a = 0; a < 2; ++a)
#pragma unroll
            for (int b = 0; b < 2; ++b)
#pragma unroll
                for (int m = 0; m < 4; ++m)
#pragma unroll
                    for (int n = 0; n < 2; ++n) acc[a][b][m][n] = (f32x4){0.f, 0.f, 0.f, 0.f};
        cur = nxt; cA = nA; cB = nB; ++ui;
        if constexpr (ALIGN_EPI) { if (wr == 1) PG8_BAR; }
    }
    PG8_WAIT_V(0);
    if constexpr (!ALIGN_EPI) { if (wr == 0) PG8_BAR; }
    PG8_BAR;
    if constexpr (Epi::AFTER_DRAIN) { E.fused(acc, cur, wr, wc, fr, fq, lds, wid, lane); S.done(cur); }
#undef PG8_SA
#undef PG8_SB
#undef PG8_STAGE
#undef PG8_LDA
#undef PG8_LDB
#undef PG8_MMA
#undef PG8_WAIT_V
#undef PG8_WAIT_L
#undef PG8_BAR
#undef PG8_SCHED
}
}

namespace pg8 {
__device__ __forceinline__ float fast_silu(float g) { return g * __builtin_amdgcn_rcpf(1.0f + __expf(-g)); }
__device__ __forceinline__ float row_rs(const float* rss, int row) { return rsqrtf(rss[row] * (1.0f / D_MODEL) + EPS); }
struct EpiSwiglu {
    static constexpr bool PERM = true, AFTER_DRAIN = false;
    bf16_t* act; const float* rss;
    __device__ __forceinline__ void operator()(const f32x4 (&acc)[2][2][4][2], const Unit& u, int wr, int wc, int fr, int fq) const {
        const int row0 = u.pm * BM + wr * 64 + fr, col0 = u.pn * 128 + wc * 32 + 8 * fq;
#pragma unroll
        for (int ai = 0; ai < 2; ++ai)
#pragma unroll
            for (int m = 0; m < 4; ++m) {
                const int row = row0 + ai * HALF + m * 16; const float rs = row_rs(rss, row);
                float a[8];
#pragma unroll
                for (int n = 0; n < 2; ++n)
#pragma unroll
                    for (int i = 0; i < 4; ++i) a[n * 4 + i] = fast_silu(acc[ai][0][m][n][i] * rs) * (acc[ai][1][m][n][i] * rs);
                u32x4 w; w.x = cvt_pk_bf16(a[0], a[1]); w.y = cvt_pk_bf16(a[2], a[3]); w.z = cvt_pk_bf16(a[4], a[5]); w.w = cvt_pk_bf16(a[6], a[7]);
                *(u32x4*)(act + (size_t)row * D_FF + col0) = w;
            }
    }
};
struct EpiResid {
    static constexpr bool PERM = false, AFTER_DRAIN = false;
    float* h; bf16_t* hb; float* rss_next; float* yout; float coef;
    __device__ __forceinline__ void operator()(const f32x4 (&acc)[2][2][4][2], const Unit& u, int wr, int wc, int fr, int fq) const {
        const int row0 = u.pm * BM + wr * 64 + fr, col0 = u.pn * BM + wc * 32 + 4 * fq;
#pragma unroll
        for (int ai = 0; ai < 2; ++ai)
#pragma unroll
            for (int m = 0; m < 4; ++m) {
                const int row = row0 + ai * HALF + m * 16; float s = 0.f;
                float* hr = h + (size_t)row * D_MODEL + col0;
#pragma unroll
                for (int bj = 0; bj < 2; ++bj)
#pragma unroll
                    for (int n = 0; n < 2; ++n) {
                        const int co = bj * HALF + n * 16;
                        const f32x4 v = *(const f32x4*)(hr + co) + acc[ai][bj][m][n] * coef;
                        if (yout) { *(f32x4*)(yout + (size_t)row * D_MODEL + col0 + co) = v; }
                        else {
                            *(f32x4*)(hr + co) = v;
                            typedef unsigned u32x2 __attribute__((ext_vector_type(2)));
                            u32x2 w; w.x = cvt_pk_bf16(v[0], v[1]); w.y = cvt_pk_bf16(v[2], v[3]);
                            *(u32x2*)(hb + (size_t)row * D_MODEL + col0 + co) = w;
                            s += (v[0] * v[0] + v[1] * v[1]) + (v[2] * v[2] + v[3] * v[3]);
                        }
                    }
                if (!yout) { s += __shfl_xor(s, 16); s += __shfl_xor(s, 32); if (fq == 0) (void)__hip_atomic_fetch_add(rss_next + row, s, __ATOMIC_RELAXED, __HIP_MEMORY_SCOPE_AGENT); }
            }
    }
};
}
namespace pg8 {
__device__ __forceinline__ float sum4(f32x4 v) { return (v[0] * v[0] + v[1] * v[1]) + (v[2] * v[2] + v[3] * v[3]); }
struct EpiConvIn {
    static constexpr bool PERM = true, AFTER_DRAIN = false;
    bf16_t* ub; bf16_t* bb; const float* rss; float* out; int layer;
    __device__ __forceinline__ void operator()(const f32x4 (&acc)[2][2][4][2], const Unit& u, int wr, int wc, int fr, int fq) const {
        const int row0 = u.pm * BM + wr * 64 + fr;
        const bool pair = u.pn < D_MODEL / 128;
#pragma unroll
        for (int ai = 0; ai < 2; ++ai)
#pragma unroll
            for (int m = 0; m < 4; ++m) {
                const int row = row0 + ai * HALF + m * 16; const float rs = row_rs(rss, row);
                if (pair) {
                    const int col0 = u.pn * 128 + wc * 32 + 8 * fq; float a[8];
#pragma unroll
                    for (int n = 0; n < 2; ++n)
#pragma unroll
                        for (int i = 0; i < 4; ++i) a[n * 4 + i] = (acc[ai][0][m][n][i] * rs) * (acc[ai][1][m][n][i] * rs);
                    u32x4 w; w.x = cvt_pk_bf16(a[0], a[1]); w.y = cvt_pk_bf16(a[2], a[3]); w.z = cvt_pk_bf16(a[4], a[5]); w.w = cvt_pk_bf16(a[6], a[7]);
                    *(u32x4*)(ub + (size_t)row * D_MODEL + col0) = w;
                    const RowInfo ri = row_info(row); const int jj = ri.t - (seq_len(ri.seq) - 2);
                    if (jj >= 0) {
                        float* cs = (ri.seq < BATCH) ? out + O_CP + (((size_t)layer * BATCH + ri.seq) * 2 + jj) * D_MODEL + col0 : out + O_CS + (((size_t)layer * DEC_BATCH + (ri.seq - BATCH)) * 2 + jj) * D_MODEL + col0;
                        *(f32x4*)(cs) = (f32x4){a[0], a[1], a[2], a[3]}; *(f32x4*)(cs + 4) = (f32x4){a[4], a[5], a[6], a[7]};
                    }
                } else {
#pragma unroll
                    for (int bj = 0; bj < 2; ++bj) {
                        const int col0 = (u.pn - D_MODEL / 128) * 256 + bj * HALF + wc * 32 + 8 * fq;
                        const f32x4 v0 = acc[ai][bj][m][0] * rs, v1 = acc[ai][bj][m][1] * rs;
                        u32x4 w; w.x = cvt_pk_bf16(v0[0], v0[1]); w.y = cvt_pk_bf16(v0[2], v0[3]); w.z = cvt_pk_bf16(v1[0], v1[1]); w.w = cvt_pk_bf16(v1[2], v1[3]);
                        *(u32x4*)(bb + (size_t)row * D_MODEL + col0) = w;
                    }
                }
                asm volatile("" ::: "memory");
            }
    }
};
__device__ __forceinline__ void head_norm_rope(f32x4 (&v)[2][2], const float* gain, const float* rt  , int fq, bool do_norm, bool do_rope, f32x4 (&rot0)[2]) {
    if (do_norm) {
        float ss = (sum4(v[0][0]) + sum4(v[0][1])) + (sum4(v[1][0]) + sum4(v[1][1]));
        ss += __shfl_xor(ss, 16); ss += __shfl_xor(ss, 32);
        const float r = rsqrtf(ss * (1.0f / HD) + EPS);
#pragma unroll
        for (int bj = 0; bj < 2; ++bj)
#pragma unroll
            for (int n = 0; n < 2; ++n) { const f32x4 g = *(const f32x4*)(gain + 32 * bj + 8 * fq + 4 * n); v[bj][n] = v[bj][n] * r * g; }
    }
    rot0[0] = v[0][0]; rot0[1] = v[0][1];
    if (do_rope) {
#pragma unroll
        for (int n = 0; n < 2; ++n) {
            f32x4 p;
#pragma unroll
            for (int i = 0; i < 4; ++i) p[i] = __shfl_xor(v[0][n][i], 16);
            const f32x4 c = *(const f32x4*)(rt + 4 * n), s = *(const f32x4*)(rt + 8 + 4 * n);
            if (fq == 0) rot0[n] = v[0][n] * c - p * s; else if (fq == 1) rot0[n] = v[0][n] * c + p * s;
        }
    }
}
__device__ __forceinline__ u32x4 pack8(const f32x4 a, const f32x4 b, float sc) { u32x4 w; w.x = cvt_pk_bf16(a[0] * sc, a[1] * sc); w.y = cvt_pk_bf16(a[2] * sc, a[3] * sc); w.z = cvt_pk_bf16(b[0] * sc, b[1] * sc); w.w = cvt_pk_bf16(b[2] * sc, b[3] * sc); return w; }
struct EpiQG {
    static constexpr bool PERM = true, AFTER_DRAIN = false;
    bf16_t* qnb; bf16_t* qrb; float* gates; const float* rss; const float* q_norm; const float* rope;
    __device__ __forceinline__ void operator()(const f32x4 (&acc)[2][2][4][2], const Unit& u, int wr, int wc, int fr, int fq) const {
        const int row0 = u.pm * BM + wr * 64 + fr;
#pragma unroll
        for (int ai = 0; ai < 2; ++ai)
#pragma unroll
            for (int m = 0; m < 4; ++m) {
                const int row = row0 + ai * HALF + m * 16; const float rs = row_rs(rss, row);
                if (u.pn < N_HEADS / 4) {
                    const int hh = u.pn * 4 + wc;
                    f32x4 v[2][2] = {{acc[ai][0][m][0] * rs, acc[ai][0][m][1] * rs}, {acc[ai][1][m][0] * rs, acc[ai][1][m][1] * rs}}; f32x4 rot0[2];
                    head_norm_rope(v, q_norm, rope + (size_t)pos_index(row_info(row).pos) * 16, fq, true, true, rot0);
                    const size_t o = (size_t)row * HDM + hh * HD + 8 * fq;
                    const u32x4 hi8 = pack8(v[1][0], v[1][1], QSCALE_F);
                    *(u32x4*)(qnb + o) = pack8(v[0][0], v[0][1], QSCALE_F); *(u32x4*)(qnb + o + 32) = hi8;
                    *(u32x4*)(qrb + o) = pack8(rot0[0], rot0[1], QSCALE_F); *(u32x4*)(qrb + o + 32) = hi8;
                } else {
                    const int c0 = wc * 32 + 8 * fq;
#pragma unroll
                    for (int n = 0; n < 2; ++n)
#pragma unroll
                        for (int i = 0; i < 4; ++i) { const int c = c0 + 4 * n + i; if (c < 3 * N_HEADS) gates[(size_t)row * 3 * N_HEADS + c] = __builtin_amdgcn_rcpf(1.0f + __expf(-(acc[ai][0][m][n][i] * rs))); }
                }
                asm volatile("" ::: "memory");
            }
    }
};
struct EpiKV {
    static constexpr bool PERM = true, AFTER_DRAIN = false;
    float* out; float* winrows; const float* rss; const float* k_norm; const float* rope;
    unsigned char* ksel; unsigned char* vsel; unsigned char* kwin; unsigned char* vwin; bf16_t* acp; const float* pe;
    __device__ __forceinline__ void operator()(const f32x4 (&acc)[2][2][4][2], const Unit& u, int wr, int wc, int fr, int fq) const {
        const int row0 = u.pm * BM + wr * 64 + fr;
        const int hidx = u.pn * 4 + wc, e = hidx / N_KV, g = hidx % N_KV; const bool nr = (e == 2 || e == 4);
#pragma unroll
        for (int ai = 0; ai < 2; ++ai)
#pragma unroll
            for (int m = 0; m < 4; ++m) {
                const int row = row0 + ai * HALF + m * 16; const float rs = row_rs(rss, row);
                const RowInfo ri = row_info(row);
                f32x4 v[2][2] = {{acc[ai][0][m][0] * rs, acc[ai][0][m][1] * rs}, {acc[ai][1][m][0] * rs, acc[ai][1][m][1] * rs}}; f32x4 rot0[2];
                head_norm_rope(v, k_norm + (e == 2 ? 1 : 2) * HD, rope + (size_t)pos_index(ri.pos) * 16, fq, nr, nr, rot0);
                float* d0; float* d1 = nullptr;
                if (e < 4) d0 = (ri.seq < BATCH) ? out + O_KVP + (((size_t)row * 4 + e) * N_KV + g) * HD : out + O_KVS + (((size_t)(row - MP) * 4 + e) * N_KV + g) * HD;
                else { const int we = e - 4; d0 = winrows + (((size_t)row * 2 + we) * N_KV + g) * HD;
                    if (ri.seq < BATCH) { if (ri.t >= SEQ - WINDOW) d1 = out + O_WP + ((((size_t)ri.seq * WINDOW + (ri.t - (SEQ - WINDOW))) * 2 + we) * N_KV + g) * HD; }
                    else d1 = out + O_WS + ((((size_t)(ri.seq - BATCH) * WINDOW + (WINDOW - DEC_SEQ + ri.t)) * 2 + we) * N_KV + g) * HD; }
                d0 += 8 * fq; *(f32x4*)(d0) = rot0[0]; *(f32x4*)(d0 + 4) = rot0[1]; *(f32x4*)(d0 + 32) = v[1][0]; *(f32x4*)(d0 + 36) = v[1][1];
                if (d1) { d1 += 8 * fq; *(f32x4*)(d1) = rot0[0]; *(f32x4*)(d1 + 4) = rot0[1]; *(f32x4*)(d1 + 32) = v[1][0]; *(f32x4*)(d1 + 36) = v[1][1]; }
                if (ri.seq < BATCH) {
                    if (e >= 2) {
                        unsigned char* img = (e == 2 ? ksel : e == 3 ? vsel : e == 4 ? kwin : vwin) + (((size_t)ri.seq * N_KV + g) * (SEQ / 64) + ri.t / 64) * 8192; const int kv = ri.t % 64;
                        const size_t o0 = (e & 1) ? vimg_off(kv, 8 * fq) : kimg_off(kv, 8 * fq), o1 = (e & 1) ? vimg_off(kv, 32 + 8 * fq) : kimg_off(kv, 32 + 8 * fq);
                        *(u32x4*)(img + o0) = pack8(rot0[0], rot0[1], 1.0f); *(u32x4*)(img + o1) = pack8(v[1][0], v[1][1], 1.0f);
                    } else {
                        const int c = ri.t / L_CMP, l = ri.t % L_CMP; const int r = (ri.seq * NBC_P + c) * N_KV + g;
                        bf16_t* ap = acp + ((size_t)e * RP_CMP + r) * (L_CMP * HD) + l * HD + 8 * fq; const float* pp = pe + ((size_t)e * L_CMP + l) * HD + 8 * fq;
                        *(u32x4*)(ap) = pack8(rot0[0] + *(const f32x4*)(pp), rot0[1] + *(const f32x4*)(pp + 4), 1.0f);
                        *(u32x4*)(ap + 32) = pack8(v[1][0] + *(const f32x4*)(pp + 32), v[1][1] + *(const f32x4*)(pp + 36), 1.0f);
                    }
                }
                asm volatile("" ::: "memory");
            }
    }
};
}

namespace pg8 {
struct EpiGelu {
    static constexpr bool PERM = true, AFTER_DRAIN = false;
    bf16_t* hid;
    __device__ __forceinline__ void operator()(const f32x4 (&acc)[2][2][4][2], const Unit& u, int wr, int wc, int fr, int fq) const {
        const int row0 = u.pm * BM + wr * 64 + fr;
#pragma unroll
        for (int ai = 0; ai < 2; ++ai)
#pragma unroll
            for (int m = 0; m < 4; ++m) {
                const int row = row0 + ai * HALF + m * 16;
#pragma unroll
                for (int bj = 0; bj < 2; ++bj) {
                    float a[8];
#pragma unroll
                    for (int n = 0; n < 2; ++n)
#pragma unroll
                        for (int i = 0; i < 4; ++i) { const float x = acc[ai][bj][m][n][i]; a[n * 4 + i] = x * __builtin_amdgcn_rcpf(1.0f + __expf(-1.5957691216057308f * (x + 0.044715f * x * x * x))); }
                    u32x4 w; w.x = cvt_pk_bf16(a[0], a[1]); w.y = cvt_pk_bf16(a[2], a[3]); w.z = cvt_pk_bf16(a[4], a[5]); w.w = cvt_pk_bf16(a[6], a[7]);
                    *(u32x4*)(hid + (size_t)row * CMP_HID + bj * HALF + wc * 32 + 8 * fq) = w;
                }
            }
    }
};
struct CmpOrder {
    int nunits, per_e, G, c;
    __device__ bool next(int i, Unit& u) const { const int L = i * G + c; if (L >= nunits) return false; u.pm = L; u.pn = L / per_e; return true; }
    __device__ __forceinline__ void a_ready(const Unit&) const {}
    __device__ __forceinline__ void done(const Unit&) const {}
};
}
constexpr int LDS_RING_C = 131072;
namespace att {
typedef short bf16x8 __attribute__((ext_vector_type(8)));
typedef short s16x4 __attribute__((ext_vector_type(4)));
typedef float f32x16 __attribute__((ext_vector_type(16)));
typedef __attribute__((address_space(3))) unsigned char* ldsp;
constexpr int TILE_B = 8192;
constexpr int L_KB = 0, L_VB = 2 * TILE_B, L_IMP = 4 * TILE_B, L_SELM = L_IMP + 64 * 64 * 4, L_END = L_SELM + 64 * 8;
constexpr float NEGB = -1e30f;
constexpr float QSCALE = 0.125f * 1.4426950408889634f;
__device__ __forceinline__ int crow(int r, int hi) { return (r & 3) + 8 * (r >> 2) + 4 * hi; }
__device__ __forceinline__ void glds16(const void* gsrc, unsigned lds_dst) { unsigned keep;
    asm volatile("s_mov_b32 %0, m0\n\ts_mov_b32 m0, %2\n\ts_nop 0\n\tglobal_load_lds_dwordx4 %1, off\n\ts_mov_b32 m0, %0" : "=&s"(keep) : "v"(gsrc), "s"(lds_dst) : "memory"); }
__device__ __forceinline__ unsigned cvtpk(float lo, float hi) { unsigned r; asm volatile("v_cvt_pk_bf16_f32 %0, %1, %2" : "=v"(r) : "v"(lo), "v"(hi)); return r; }
__device__ __forceinline__ float halfmax(float m) { auto rr = __builtin_amdgcn_permlane32_swap(__float_as_uint(m), __float_as_uint(m), false, false); return fmaxf(__uint_as_float(rr[0]), __uint_as_float(rr[1])); }
__device__ __forceinline__ float halfsum(float m) { auto rr = __builtin_amdgcn_permlane32_swap(__float_as_uint(m), __float_as_uint(m), false, false); return __uint_as_float(rr[0]) + __uint_as_float(rr[1]); }
__device__ __forceinline__ s16x4 vtr(ldsp p) { typedef short v4i16_t __attribute__((ext_vector_type(4))); return __builtin_bit_cast(s16x4, __builtin_amdgcn_ds_read_tr16_b64_v4i16((__attribute__((address_space(3))) v4i16_t*)p)); }
#define ATT_BAR_L() asm volatile("s_waitcnt lgkmcnt(0)\n\ts_barrier" ::: "memory")
#define ATT_WAIT_BAR(N) asm volatile("s_waitcnt vmcnt(" #N ") lgkmcnt(0)\n\ts_barrier" ::: "memory")
__device__ __forceinline__ void dma_tile(const unsigned char* img, unsigned lds_dst, int wid, int lane) { glds16(img + wid * 1024 + lane * 16, (unsigned)__builtin_amdgcn_readfirstlane(lds_dst + wid * 1024)); }
__device__ __forceinline__ void qk(f32x16& p0, f32x16& p1, ldsp kbuf, const bf16x8 (&qf)[4], float cinit, int r32, int hi) {
    f32x16 c;
#pragma unroll
    for (int r = 0; r < 16; ++r) c[r] = cinit;
    p0 = c; p1 = c;
#pragma unroll
    for (int s = 0; s < 4; ++s) {
        const bf16x8 k0 = *(const __attribute__((address_space(3))) bf16x8*)(kbuf + (2 * s + hi) * 1024 + r32 * 16);
        const bf16x8 k1 = *(const __attribute__((address_space(3))) bf16x8*)(kbuf + (2 * s + hi) * 1024 + r32 * 16 + 512);
        p0 = __builtin_amdgcn_mfma_f32_32x32x16_bf16(k0, qf[s], p0, 0, 0, 0);
        p1 = __builtin_amdgcn_mfma_f32_32x32x16_bf16(k1, qf[s], p1, 0, 0, 0);
    }
}
__device__ __forceinline__ void pv(f32x16 (&o)[2], ldsp vbuf, const f32x16& p0, const f32x16& p1, int lane, int hi) {
    unsigned pk[4][4];
#pragma unroll
    for (int k = 0; k < 4; ++k) { pk[0][k] = cvtpk(p0[2 * k], p0[2 * k + 1]); pk[1][k] = cvtpk(p0[8 + 2 * k], p0[9 + 2 * k]); pk[2][k] = cvtpk(p1[2 * k], p1[2 * k + 1]); pk[3][k] = cvtpk(p1[8 + 2 * k], p1[9 + 2 * k]); }
    const int vp0 = ((lane >> 4) & 1) * 32 + (lane & 3) * 8 + (4 * hi + ((lane & 15) >> 2)) * 64;
#pragma unroll
    for (int d0 = 0; d0 < 2; ++d0)
#pragma unroll
        for (int s = 0; s < 4; ++s) {
            const s16x4 lo = vtr(vbuf + d0 * 4096 + s * 1024 + vp0), hh = vtr(vbuf + d0 * 4096 + s * 1024 + 512 + vp0);
            const bf16x8 vf = (bf16x8){lo[0], lo[1], lo[2], lo[3], hh[0], hh[1], hh[2], hh[3]};
            typedef unsigned u32x4 __attribute__((ext_vector_type(4)));
            const u32x4 pw = (u32x4){pk[s][0], pk[s][1], pk[s][2], pk[s][3]};
            o[d0] = __builtin_amdgcn_mfma_f32_32x32x16_bf16(vf, __builtin_bit_cast(bf16x8, pw), o[d0], 0, 0, 0);
        }
}
struct Run { float m, l; f32x16 o[2]; };
template <bool EMASK> __device__ __forceinline__ void tile_step(Run& R, ldsp kbuf, ldsp vbuf, const bf16x8 (&qf)[4], float cinit, int lo_b_, int hi_b_, int lane, int r32, int hi) {
    int lo_b = lo_b_ - 4 * hi, hi_b = hi_b_ - 4 * hi;
    if (EMASK) asm volatile("" : "+v"(lo_b), "+v"(hi_b));
    f32x16 p0, p1; qk(p0, p1, kbuf, qf, cinit, r32, hi);
    if (EMASK) {
#pragma unroll
        for (int r = 0; r < 16; ++r) { const int kc_ = (r & 3) + 8 * (r >> 2); if (kc_ < lo_b || kc_ > hi_b) p0[r] = NEGB; if (kc_ + 32 < lo_b || kc_ + 32 > hi_b) p1[r] = NEGB; }
    }
    float rm = fmaxf(p0[0], p1[0]);
#pragma unroll
    for (int r = 1; r < 16; ++r) rm = fmaxf(rm, fmaxf(p0[r], p1[r]));
    rm = halfmax(rm);
    const float mn = fmaxf(R.m, rm), alpha = __builtin_amdgcn_exp2f(R.m - mn);
    R.m = mn; R.l *= alpha;
#pragma unroll
    for (int r = 0; r < 16; ++r) { R.o[0][r] *= alpha; R.o[1][r] *= alpha; }
    float ls = 0.f;
#pragma unroll
    for (int r = 0; r < 16; ++r) {
        float e0 = __builtin_amdgcn_exp2f(p0[r] - mn), e1 = __builtin_amdgcn_exp2f(p1[r] - mn);
        if (EMASK) { const int kc_ = (r & 3) + 8 * (r >> 2); if (kc_ < lo_b || kc_ > hi_b) e0 = 0.f; if (kc_ + 32 < lo_b || kc_ + 32 > hi_b) e1 = 0.f; }
        p0[r] = e0; p1[r] = e1; ls += e0 + e1;
    }
    R.l += ls;
    pv(R.o, vbuf, p0, p1, lane, hi);
}
struct Tensors {
    const bf16_t* qn; const bf16_t* qr;
    const unsigned char* ksel; const unsigned char* vsel; const unsigned char* kwin; const unsigned char* vwin;
    const unsigned char* kc; const unsigned char* vc;
    const float* gates; bf16_t* ob;
};
template <bool SEL> __device__ __forceinline__ void branch(Run& R, const unsigned char* kimg, const unsigned char* vimg, int t0, int t1, int jdiag, unsigned long long selm, int iq,
                                                           const bf16x8 (&qf)[4], unsigned lds0, ldsp lds, int wid, int lane, int r32, int hi) {
    R.m = NEGB; R.l = 0.f;
#pragma unroll
    for (int r = 0; r < 16; ++r) { R.o[0][r] = 0.f; R.o[1][r] = 0.f; }
    dma_tile(kimg + (size_t)t0 * TILE_B, lds0 + L_KB, wid, lane); dma_tile(vimg + (size_t)t0 * TILE_B, lds0 + L_VB, wid, lane);
    for (int t = t0; t <= t1; ++t) {
        const int b = (t - t0) & 1;
        if (t < t1) { dma_tile(kimg + (size_t)(t + 1) * TILE_B, lds0 + L_KB + (b ^ 1) * TILE_B, wid, lane); dma_tile(vimg + (size_t)(t + 1) * TILE_B, lds0 + L_VB + (b ^ 1) * TILE_B, wid, lane); ATT_WAIT_BAR(2); }
        else ATT_WAIT_BAR(0);
        const float cinit = (!SEL || ((selm >> t) & 1ull)) ? 0.f : NEGB;
        const bool lowm = !SEL && (t == jdiag - 8);
        if (t == jdiag || lowm) tile_step<true>(R, lds + L_KB + b * TILE_B, lds + L_VB + b * TILE_B, qf, cinit, lowm ? iq : 0, (t == jdiag) ? iq : 63, lane, r32, hi);
        else tile_step<false>(R, lds + L_KB + b * TILE_B, lds + L_VB + b * TILE_B, qf, cinit, 0, 63, lane, r32, hi);
        ATT_BAR_L();
    }
}
__device__ __forceinline__ void load_q(bf16x8 (&qf)[4], const bf16_t* qrow, int hi) {
#pragma unroll
    for (int s = 0; s < 4; ++s) qf[s] = *(const bf16x8*)(qrow + 16 * s + 8 * hi);
}
__device__ __forceinline__ void unit(const Tensors& T, int n, int j, int g, ldsp lds, unsigned lds0, int wid, int lane) {
    const int r32 = lane & 31, hi = lane >> 5, ql = r32 >> 2, hq = r32 & 3, iq = 8 * wid + ql;
    const int row = n * SEQ + 64 * j + iq, head = g * HPG + hq, pos = 64 * j + iq;
    const size_t img_ng = ((size_t)n * N_KV + g);
    f32x16 oacc[2];
#pragma unroll
    for (int r = 0; r < 16; ++r) { oacc[0][r] = 0.f; oacc[1][r] = 0.f; }
    const float* gt = T.gates + (size_t)row * 3 * N_HEADS + head * 3;
    const float g_c = gt[0], g_s = gt[1], g_w = gt[2];
    bf16x8 qf[4];
    unsigned long long selm;
    {
        load_q(qf, T.qn + (size_t)row * HDM + head * HD, hi);
        const int ntc = (2 * j + 2 + 63) / 64;
        const unsigned char* kci = T.kc + img_ng * (NBC_P / 64) * TILE_B; const unsigned char* vci = T.vc + img_ng * (NBC_P / 64) * TILE_B;
        dma_tile(kci, lds0 + L_KB, wid, lane); dma_tile(vci, lds0 + L_VB, wid, lane);
        if (ntc > 1) { dma_tile(kci + TILE_B, lds0 + L_KB + TILE_B, wid, lane); dma_tile(vci + TILE_B, lds0 + L_VB + TILE_B, wid, lane); }
        ATT_WAIT_BAR(0);
        int cmax = ((pos + 1) >> 5) - 1 - 4 * hi;
        asm volatile("" : "+v"(cmax));
        f32x16 s0, s1, s2, s3;
        qk(s0, s1, lds + L_KB, qf, 0.f, r32, hi);
        if (ntc > 1) qk(s2, s3, lds + L_KB + TILE_B, qf, 0.f, r32, hi);
        else {
#pragma unroll
            for (int r = 0; r < 16; ++r) { s2[r] = NEGB; s3[r] = NEGB; }
        }
        float mx = NEGB;
#pragma unroll
        for (int r = 0; r < 16; ++r) { const int kv = (r & 3) + 8 * (r >> 2);
            if (kv > cmax) s0[r] = NEGB; if (kv + 32 > cmax) s1[r] = NEGB; if (kv + 64 > cmax) s2[r] = NEGB; if (kv + 96 > cmax) s3[r] = NEGB;
            mx = fmaxf(fmaxf(mx, fmaxf(s0[r], s1[r])), fmaxf(s2[r], s3[r])); }
        mx = halfmax(mx);
        float ls = 0.f;
#pragma unroll
        for (int r = 0; r < 16; ++r) { const int kv = (r & 3) + 8 * (r >> 2);
            s0[r] = (kv > cmax) ? 0.f : __builtin_amdgcn_exp2f(s0[r] - mx); s1[r] = (kv + 32 > cmax) ? 0.f : __builtin_amdgcn_exp2f(s1[r] - mx);
            s2[r] = (kv + 64 > cmax) ? 0.f : __builtin_amdgcn_exp2f(s2[r] - mx); s3[r] = (kv + 96 > cmax) ? 0.f : __builtin_amdgcn_exp2f(s3[r] - mx);
            ls += (s0[r] + s1[r]) + (s2[r] + s3[r]); }
        ls = halfsum(ls);
        const float inv = 1.0f / fmaxf(ls, 1e-30f);
#pragma unroll
        for (int r = 0; r < 16; ++r) { s0[r] *= inv; s1[r] *= inv; s2[r] *= inv; s3[r] *= inv; }
        __attribute__((address_space(3))) float* imp = (__attribute__((address_space(3))) float*)(lds + L_IMP) + iq * 64;
#pragma unroll
        for (int r = 0; r < 16; r += 2) { const int bl = crow(r, hi) >> 1;
            float v0 = s0[r] + s0[r + 1], v1 = s1[r] + s1[r + 1], v2 = s2[r] + s2[r + 1], v3 = s3[r] + s3[r + 1];
            v0 += __shfl_xor(v0, 1); v0 += __shfl_xor(v0, 2); v1 += __shfl_xor(v1, 1); v1 += __shfl_xor(v1, 2);
            v2 += __shfl_xor(v2, 1); v2 += __shfl_xor(v2, 2); v3 += __shfl_xor(v3, 1); v3 += __shfl_xor(v3, 2);
            if (hq == 0) { imp[bl] = v0; imp[16 + bl] = v1; imp[32 + bl] = v2; imp[48 + bl] = v3; } }
        Run Rc;
#pragma unroll
        for (int r = 0; r < 16; ++r) { Rc.o[0][r] = 0.f; Rc.o[1][r] = 0.f; }
        pv(Rc.o, lds + L_VB, s0, s1, lane, hi);
        if (ntc > 1) pv(Rc.o, lds + L_VB + TILE_B, s2, s3, lane, hi);
#pragma unroll
        for (int r = 0; r < 16; ++r) { oacc[0][r] += g_c * Rc.o[0][r]; oacc[1][r] += g_c * Rc.o[1][r]; }
        asm volatile("s_waitcnt lgkmcnt(0)" ::: "memory");
        __attribute__((address_space(3))) unsigned long long* selw = (__attribute__((address_space(3))) unsigned long long*)(lds + L_SELM);
        for (int qq = 0; qq < 8; ++qq) {
            const float v = ((__attribute__((address_space(3))) float*)(lds + L_IMP))[(8 * wid + qq) * 64 + lane];
            const bool valid = lane <= j, forced = (lane == 0) || (lane == j) || (lane == j - 1);
            const unsigned key = valid ? (forced ? 0x7f000000u : __float_as_uint(v) + 1u) : 0u;
            unsigned long long m;
            if (j + 1 <= N_SEL) m = __ballot(valid);
            else {
                unsigned Tt = 0u;
                for (int bit = 30; bit >= 0; --bit) { const unsigned cand = Tt | (1u << bit); if (__popcll(__ballot(key >= cand)) >= N_SEL) Tt = cand; }
                const unsigned long long gtm = __ballot(key > Tt), eqm = __ballot(key == Tt);
                const int need = N_SEL - __popcll(gtm);
                const bool pick = (key == Tt) && (__popcll(eqm & ((1ull << lane) - 1ull)) < need);
                m = gtm | __ballot(pick);
            }
            if (lane == 0) selw[8 * wid + qq] = m;
        }
        asm volatile("s_waitcnt lgkmcnt(0)" ::: "memory");
        selm = selw[iq];
        ATT_WAIT_BAR(0);
    }
    load_q(qf, T.qr + (size_t)row * HDM + head * HD, hi);
    {
        Run R; branch<true>(R, T.ksel + img_ng * (SEQ / 64) * TILE_B, T.vsel + img_ng * (SEQ / 64) * TILE_B, 0, j, j, selm, iq, qf, lds0, lds, wid, lane, r32, hi);
        const float sc = g_s / fmaxf(halfsum(R.l), 1e-30f);
#pragma unroll
        for (int r = 0; r < 16; ++r) { oacc[0][r] += sc * R.o[0][r]; oacc[1][r] += sc * R.o[1][r]; }
    }
    {
        Run R; branch<false>(R, T.kwin + img_ng * (SEQ / 64) * TILE_B, T.vwin + img_ng * (SEQ / 64) * TILE_B, j > 8 ? j - 8 : 0, j, j, 0ull, iq, qf, lds0, lds, wid, lane, r32, hi);
        const float sc = g_w / fmaxf(halfsum(R.l), 1e-30f);
#pragma unroll
        for (int r = 0; r < 16; ++r) { oacc[0][r] += sc * R.o[0][r]; oacc[1][r] += sc * R.o[1][r]; }
    }
    bf16_t* orow = T.ob + (size_t)row * HDM + head * HD;
#pragma unroll
    for (int d0 = 0; d0 < 2; ++d0)
#pragma unroll
        for (int rr = 0; rr < 4; ++rr) { typedef unsigned u32x2 __attribute__((ext_vector_type(2)));
            u32x2 w; w.x = cvtpk(oacc[d0][4 * rr], oacc[d0][4 * rr + 1]); w.y = cvtpk(oacc[d0][4 * rr + 2], oacc[d0][4 * rr + 3]);
            *(u32x2*)(orow + 32 * d0 + 8 * rr + 4 * hi) = w; }
}
__device__ __forceinline__ void phase(const Tensors& T, ldsp lds, int wid, int lane, int cu, int ncu) {
    const unsigned lds0 = (unsigned)(uintptr_t)lds;
    constexpr int NQB = SEQ / 64, NGRP = NQB / 4;
    for (int c = cu; c < BATCH * N_KV * NGRP; c += ncu) {
        const int ng = c / NGRP, s = c % NGRP, n = ng / N_KV, g = ng % N_KV;
        for (int k = 0; k < 4; ++k) { const int j = (k == 0) ? s : (k == 1) ? NQB / 2 - 1 - s : (k == 2) ? NQB / 2 + s : NQB - 1 - s; unit(T, n, j, g, lds, lds0, wid, lane); }
    }
}
}
namespace att {
constexpr int S_STAGE = 16384;
constexpr int S_XM = LDS_RING_C + 1024, S_XL = S_XM + 1024, S_IMP = S_XL + 1024, S_SELM = S_IMP + 8 * 128 * 4, S_END = S_SELM + 8 * 2 * 8;
struct STensors {
    const bf16_t* qn; const bf16_t* qr; const float* kc; const float* vc; const float* cache_kv; const int* page_table; const float* cache_win; const float* out; const float* winrows;
    const float* gates; bf16_t* ob;
};
typedef float f32x4_t __attribute__((ext_vector_type(4)));
__device__ __forceinline__ void stage_kv(ldsp kimg, ldsp vimg, const float* ksrc, const float* vsrc, int stride, int nrows, int lane) {
    typedef unsigned u32x4 __attribute__((ext_vector_type(4)));
    const int c = lane & 7;
#pragma unroll 1
    for (int ib = 0; ib < 8; ib += 4)
#pragma unroll
    for (int it = ib; it < ib + 4; ++it) {
        const int row = 8 * it + (lane >> 3);
        f32x4_t k0 = {0.f, 0.f, 0.f, 0.f}, k1 = k0, v0 = k0, v1 = k0;
        if (row < nrows) { const float* kp = ksrc + (size_t)row * stride + 8 * c; const float* vp = vsrc + (size_t)row * stride + 8 * c;
            k0 = *(const f32x4_t*)kp; k1 = *(const f32x4_t*)(kp + 4); v0 = *(const f32x4_t*)vp; v1 = *(const f32x4_t*)(vp + 4); }
        u32x4 kw, vw; kw.x = cvtpk(k0[0], k0[1]); kw.y = cvtpk(k0[2], k0[3]); kw.z = cvtpk(k1[0], k1[1]); kw.w = cvtpk(k1[2], k1[3]);
        vw.x = cvtpk(v0[0], v0[1]); vw.y = cvtpk(v0[2], v0[3]); vw.z = cvtpk(v1[0], v1[1]); vw.w = cvtpk(v1[2], v1[3]);
        *(__attribute__((address_space(3))) u32x4*)(kimg + c * 1024 + row * 16) = kw;
        *(__attribute__((address_space(3))) u32x4*)(vimg + (c >> 2) * 4096 + (row >> 3) * 512 + (row & 7) * 64 + (c & 3) * 16) = vw;
    }
    asm volatile("s_waitcnt lgkmcnt(0)" ::: "memory");
}
#define ATT_BAR_ALL() asm volatile("s_waitcnt vmcnt(0) lgkmcnt(0)\n\ts_barrier" ::: "memory")
__device__ __forceinline__ float merge_stats(ldsp lds, float m_own, float l_own_half, int wid, int r32, int hi) {
    __attribute__((address_space(3))) float* xm = (__attribute__((address_space(3))) float*)(lds + S_XM); __attribute__((address_space(3))) float* xl = (__attribute__((address_space(3))) float*)(lds + S_XL);
    const float l_own = halfsum(l_own_half);
    if (hi == 0) { xm[wid * 32 + r32] = m_own; xl[wid * 32 + r32] = l_own; }
    ATT_BAR_ALL();
    float M = NEGB;
#pragma unroll
    for (int w = 0; w < 8; ++w) M = fmaxf(M, xm[w * 32 + r32]);
    float L = 0.f;
#pragma unroll
    for (int w = 0; w < 8; ++w) L += __builtin_amdgcn_exp2f(xm[w * 32 + r32] - M) * xl[w * 32 + r32];
    const float wgt = __builtin_amdgcn_exp2f(m_own - M) / fmaxf(L, 1e-30f);
    ATT_BAR_ALL();
    return wgt;
}
__device__ __forceinline__ void sample_unit(const STensors& T, int b, int g, ldsp lds, int wid, int lane) {
    const int r32 = lane & 31, hi = lane >> 5, ql = r32 >> 2, hq = r32 & 3;
    const int row = MP + b * DEC_SEQ + ql, head = g * HPG + hq, seq = BATCH + b;
    ldsp kimg = lds + wid * S_STAGE, vimg = kimg + TILE_B;
    f32x16 oacc[2];
#pragma unroll
    for (int r = 0; r < 16; ++r) { oacc[0][r] = 0.f; oacc[1][r] = 0.f; }
    const float* gt = T.gates + (size_t)row * 3 * N_HEADS + head * 3;
    const float g_c = gt[0], g_s = gt[1], g_w = gt[2];
    bf16x8 qf[4];
    __attribute__((address_space(3))) float* xm = (__attribute__((address_space(3))) float*)(lds + S_XM); __attribute__((address_space(3))) float* xl = (__attribute__((address_space(3))) float*)(lds + S_XL);
    __attribute__((address_space(3))) float* imp = (__attribute__((address_space(3))) float*)(lds + S_IMP);
    __attribute__((address_space(3))) unsigned long long* selw = (__attribute__((address_space(3))) unsigned long long*)(lds + S_SELM);
    {
        load_q(qf, T.qn + (size_t)row * HDM + head * HD, hi);
        constexpr int NTC = NBC_PAST / 64;
        f32x16 p0, p1; const bool mine = wid < NTC;
        float rm = NEGB;
        if (mine) {
            const float* kcp = T.kc + (((size_t)seq * NBC_MAX + 64 * wid) * N_KV + g) * HD; const float* vcp = T.vc + (((size_t)seq * NBC_MAX + 64 * wid) * N_KV + g) * HD;
            stage_kv(kimg, vimg, kcp, vcp, N_KV * HD, 64, lane);
            qk(p0, p1, kimg, qf, 0.f, r32, hi);
#pragma unroll
            for (int r = 0; r < 16; ++r) rm = fmaxf(rm, fmaxf(p0[r], p1[r]));
            rm = halfmax(rm);
        }
        if (hi == 0) xm[wid * 32 + r32] = rm;
        ATT_BAR_ALL();
        float M = NEGB;
#pragma unroll
        for (int w = 0; w < 8; ++w) M = fmaxf(M, xm[w * 32 + r32]);
        float ls = 0.f;
        if (mine) {
#pragma unroll
            for (int r = 0; r < 16; ++r) { p0[r] = __builtin_amdgcn_exp2f(p0[r] - M); p1[r] = __builtin_amdgcn_exp2f(p1[r] - M); ls += p0[r] + p1[r]; }
            ls = halfsum(ls);
        }
        if (hi == 0) xl[wid * 32 + r32] = ls;
        ATT_BAR_ALL();
        float L = 0.f;
#pragma unroll
        for (int w = 0; w < 8; ++w) L += xl[w * 32 + r32];
        const float inv = 1.0f / fmaxf(L, 1e-30f);
        if (mine) {
#pragma unroll
            for (int r = 0; r < 16; ++r) { p0[r] *= inv; p1[r] *= inv; }
#pragma unroll
            for (int r = 0; r < 16; r += 2) { const int bl = crow(r, hi) >> 1;
                float v0 = p0[r] + p0[r + 1], v1 = p1[r] + p1[r + 1];
                v0 += __shfl_xor(v0, 1); v0 += __shfl_xor(v0, 2); v1 += __shfl_xor(v1, 1); v1 += __shfl_xor(v1, 2);
                if (hq == 0) { imp[ql * 128 + 32 * wid + bl] = v0; imp[ql * 128 + 32 * wid + 16 + bl] = v1; } }
            Run Rc;
#pragma unroll
            for (int r = 0; r < 16; ++r) { Rc.o[0][r] = 0.f; Rc.o[1][r] = 0.f; }
            pv(Rc.o, vimg, p0, p1, lane, hi);
#pragma unroll
            for (int r = 0; r < 16; ++r) { oacc[0][r] += g_c * Rc.o[0][r]; oacc[1][r] += g_c * Rc.o[1][r]; }
        }
        ATT_BAR_ALL();
    }
    {
        constexpr int NCAND = NBS_S - 1;
        const float v0 = imp[wid * 128 + lane], v1 = imp[wid * 128 + 64 + lane];
        const unsigned key0 = (lane == 0) ? 0x7f000000u : __float_as_uint(v0) + 1u;
        const unsigned key1 = (lane + 64 == NCAND - 1) ? 0x7f000000u : __float_as_uint(v1) + 1u;
        unsigned Tt = 0u;
        for (int bit = 30; bit >= 0; --bit) { const unsigned cand = Tt | (1u << bit); if (__popcll(__ballot(key0 >= cand)) + __popcll(__ballot(key1 >= cand)) >= N_SEL - 1) Tt = cand; }
        const unsigned long long gt0 = __ballot(key0 > Tt), gt1 = __ballot(key1 > Tt), eq0 = __ballot(key0 == Tt), eq1 = __ballot(key1 == Tt);
        const int need = (N_SEL - 1) - __popcll(gt0) - __popcll(gt1);
        const unsigned long long below = (1ull << lane) - 1ull;
        const bool pick0 = (key0 == Tt) && (__popcll(eq0 & below) < need);
        const bool pick1 = (key1 == Tt) && (__popcll(eq0) + __popcll(eq1 & below) < need);
        const unsigned long long m0 = gt0 | __ballot(pick0), m1 = gt1 | __ballot(pick1);
        if (lane == 0) { selw[wid * 2] = m0; selw[wid * 2 + 1] = m1; }
        ATT_BAR_ALL();
    }
    load_q(qf, T.qr + (size_t)row * HDM + head * HD, hi);
    {
        unsigned long long U0 = 0ull, U1 = 0ull;
#pragma unroll
        for (int q = 0; q < 8; ++q) { U0 |= selw[q * 2]; U1 |= selw[q * 2 + 1]; }
        U0 = __builtin_amdgcn_readfirstlane((unsigned)U0) | ((unsigned long long)__builtin_amdgcn_readfirstlane((unsigned)(U0 >> 32)) << 32);
        U1 = __builtin_amdgcn_readfirstlane((unsigned)U1) | ((unsigned long long)__builtin_amdgcn_readfirstlane((unsigned)(U1 >> 32)) << 32);
        const unsigned long long my0 = selw[ql * 2], my1 = selw[ql * 2 + 1];
        Run R; R.m = NEGB; R.l = 0.f;
#pragma unroll
        for (int r = 0; r < 16; ++r) { R.o[0][r] = 0.f; R.o[1][r] = 0.f; }
        int idx = 0;
        for (int half = 0; half < 2; ++half) {
            unsigned long long U = half ? U1 : U0;
            while (U) {
                const int bit = __builtin_ctzll(U); U &= U - 1ull;
                if ((idx++ & 7) != wid) continue;
                const int blk = 64 * half + bit;
                const int page = T.page_table[b * N_PAGES + (blk * L_SEL) / PAGE_SIZE];
                const float* base = T.cache_kv + (((size_t)page * PAGE_SIZE + (blk * L_SEL) % PAGE_SIZE) * 4) * N_KV * HD + g * HD;
                stage_kv(kimg, vimg, base + 2 * N_KV * HD, base + 3 * N_KV * HD, 4 * N_KV * HD, 64, lane);
                const bool selected = ((half ? my1 : my0) >> bit) & 1ull;
                tile_step<false>(R, kimg, vimg, qf, selected ? 0.f : NEGB, 0, 63, lane, r32, hi);
            }
        }
        if ((idx & 7) == wid) {
            const float* base = T.out + O_KVS + (((size_t)b * DEC_SEQ) * 4) * N_KV * HD + g * HD;
            stage_kv(kimg, vimg, base + 2 * N_KV * HD, base + 3 * N_KV * HD, 4 * N_KV * HD, DEC_SEQ, lane);
            tile_step<true>(R, kimg, vimg, qf, 0.f, 0, ql, lane, r32, hi);
        }
        const float wgt = merge_stats(lds, R.m, R.l, wid, r32, hi) * g_s;
#pragma unroll
        for (int r = 0; r < 16; ++r) { oacc[0][r] += wgt * R.o[0][r]; oacc[1][r] += wgt * R.o[1][r]; }
    }
    {
        Run R; R.m = NEGB; R.l = 0.f;
#pragma unroll
        for (int r = 0; r < 16; ++r) { R.o[0][r] = 0.f; R.o[1][r] = 0.f; }
        for (int t = wid; t < WINDOW / 64; t += 8) {
            const float* base = T.cache_win + (((size_t)b * WINDOW + 64 * t) * 2) * N_KV * HD + g * HD;
            stage_kv(kimg, vimg, base, base + N_KV * HD, 2 * N_KV * HD, 64, lane);
            if (t == 0) tile_step<true>(R, kimg, vimg, qf, 0.f, ql, 63, lane, r32, hi); else tile_step<false>(R, kimg, vimg, qf, 0.f, 0, 63, lane, r32, hi);
        }
        if (wid == 0) {
            const float* base = T.winrows + (((size_t)(MP + b * DEC_SEQ)) * 2) * N_KV * HD + g * HD;
            stage_kv(kimg, vimg, base, base + N_KV * HD, 2 * N_KV * HD, DEC_SEQ, lane);
            tile_step<true>(R, kimg, vimg, qf, 0.f, 0, ql, lane, r32, hi);
        }
        const float wgt = merge_stats(lds, R.m, R.l, wid, r32, hi) * g_w;
#pragma unroll
        for (int r = 0; r < 16; ++r) { oacc[0][r] += wgt * R.o[0][r]; oacc[1][r] += wgt * R.o[1][r]; }
    }
    {
        __attribute__((address_space(3))) float* mine = (__attribute__((address_space(3))) float*)(lds + wid * S_STAGE);
#pragma unroll
        for (int d0 = 0; d0 < 2; ++d0)
#pragma unroll
            for (int rr = 0; rr < 4; ++rr) *(__attribute__((address_space(3))) f32x4_t*)(mine + r32 * 64 + 32 * d0 + 8 * rr + 4 * hi) = (f32x4_t){oacc[d0][4 * rr], oacc[d0][4 * rr + 1], oacc[d0][4 * rr + 2], oacc[d0][4 * rr + 3]};
        ATT_BAR_ALL();
        const int tid = wid * 64 + lane, orow = tid >> 4, oc4 = (tid & 15) * 4;
        f32x4_t s = {0.f, 0.f, 0.f, 0.f};
#pragma unroll
        for (int w = 0; w < 8; ++w) s += *(const __attribute__((address_space(3))) f32x4_t*)((__attribute__((address_space(3))) float*)(lds + w * S_STAGE) + orow * 64 + oc4);
        typedef unsigned u32x2 __attribute__((ext_vector_type(2)));
        u32x2 wv; wv.x = cvtpk(s[0], s[1]); wv.y = cvtpk(s[2], s[3]);
        const int oq = orow >> 2, oh = orow & 3;
        *(u32x2*)(T.ob + (size_t)(MP + b * DEC_SEQ + oq) * HDM + (g * HPG + oh) * HD + oc4) = wv;
        ATT_BAR_ALL();
    }
}
__device__ __forceinline__ void sample_phase(const STensors& T, ldsp lds, int wid, int lane, int cu, int ncu) {
    for (int c = cu; c < DEC_BATCH * N_KV; c += ncu) sample_unit(T, c / N_KV, c % N_KV, lds, wid, lane);
}
}


namespace att {
__device__ __forceinline__ void cmp_out_wave(int task, const bf16_t* hid, int R, int nbc, int seq0, const bf16_t* w2t, const float* k_norm0, float* kc, float* vc, unsigned char* kci, unsigned char* vci, int lane) {
    const int r32 = lane & 31, hi = lane >> 5;
    const int r0 = task * 32, e = r0 >= R ? 1 : 0, r = r0 - e * R + r32;
    const bf16_t* hrow = hid + ((size_t)e * R + r) * CMP_HID; const bf16_t* wrow = w2t + ((size_t)e * HD + r32) * CMP_HID;
    f32x16 o0, o1;
#pragma unroll
    for (int k = 0; k < 16; ++k) { o0[k] = 0.f; o1[k] = 0.f; }
#pragma unroll 4
    for (int s_ = 0; s_ < CMP_HID / 16; ++s_) {
        const bf16x8 hb_ = *(const bf16x8*)(hrow + 16 * s_ + 8 * hi);
        const bf16x8 w0 = *(const bf16x8*)(wrow + 16 * s_ + 8 * hi), w1 = *(const bf16x8*)(wrow + (size_t)32 * CMP_HID + 16 * s_ + 8 * hi);
        o0 = __builtin_amdgcn_mfma_f32_32x32x16_bf16(w0, hb_, o0, 0, 0, 0); o1 = __builtin_amdgcn_mfma_f32_32x32x16_bf16(w1, hb_, o1, 0, 0, 0);
    }
    if (e == 0) {
        float ss = 0.f;
#pragma unroll
        for (int k = 0; k < 16; ++k) ss += o0[k] * o0[k] + o1[k] * o1[k];
        ss = halfsum(ss);
        const float rn = rsqrtf(ss * (1.0f / HD) + EPS);
#pragma unroll
        for (int k = 0; k < 16; ++k) { o0[k] *= rn * k_norm0[crow(k, hi)]; o1[k] *= rn * k_norm0[32 + crow(k, hi)]; }
    }
    const int g = r % N_KV, c = (r / N_KV) % nbc, sq = r / (N_KV * nbc);
    float* dst = (e == 0 ? kc : vc) + (((size_t)(seq0 + sq) * NBC_MAX + c) * N_KV + g) * HD;
#pragma unroll
    for (int rr = 0; rr < 4; ++rr) { *(f32x4_t*)(dst + 8 * rr + 4 * hi) = (f32x4_t){o0[4 * rr], o0[4 * rr + 1], o0[4 * rr + 2], o0[4 * rr + 3]};
                                      *(f32x4_t*)(dst + 32 + 8 * rr + 4 * hi) = (f32x4_t){o1[4 * rr], o1[4 * rr + 1], o1[4 * rr + 2], o1[4 * rr + 3]}; }
    if (kci) {
        unsigned char* img = (e == 0 ? kci : vci) + (((size_t)sq * N_KV + g) * (NBC_P / 64) + c / 64) * 8192; const int kv = c % 64;
        typedef unsigned u32x2 __attribute__((ext_vector_type(2)));
#pragma unroll
        for (int rr = 0; rr < 4; ++rr) {
            u32x2 a; a.x = cvtpk(o0[4 * rr], o0[4 * rr + 1]); a.y = cvtpk(o0[4 * rr + 2], o0[4 * rr + 3]);
            u32x2 bq; bq.x = cvtpk(o1[4 * rr], o1[4 * rr + 1]); bq.y = cvtpk(o1[4 * rr + 2], o1[4 * rr + 3]);
            const int d0 = 8 * rr, d1 = 32 + 8 * rr;
            *(u32x2*)(img + (e == 0 ? kimg_off(kv, d0) : vimg_off(kv, d0)) + 8 * hi) = a;
            *(u32x2*)(img + (e == 0 ? kimg_off(kv, d1) : vimg_off(kv, d1)) + 8 * hi) = bq;
        }
    }
}
}
__device__ __forceinline__ void conv_thin_vec_item(size_t i_, const bf16_t* ub, const bf16_t* bb, const float* state, const float* wc, bf16_t* zb) {
    typedef unsigned u4 __attribute__((ext_vector_type(4)));
    const int m = (int)(i_ / (D_MODEL / 8)), ch = (int)(i_ % (D_MODEL / 8)) * 8;
    const RowInfo ri = row_info(m);
    const size_t o = (size_t)m * D_MODEL + ch;
    float u0[8], u1[8], u2[8], bv[8];
#define UNPK(w, f) do { f[0] = bf2f((bf16_t)((w).x & 0xffff)); f[1] = bf2f((bf16_t)((w).x >> 16)); f[2] = bf2f((bf16_t)((w).y & 0xffff)); f[3] = bf2f((bf16_t)((w).y >> 16)); \
                        f[4] = bf2f((bf16_t)((w).z & 0xffff)); f[5] = bf2f((bf16_t)((w).z >> 16)); f[6] = bf2f((bf16_t)((w).w & 0xffff)); f[7] = bf2f((bf16_t)((w).w >> 16)); } while (0)
    { const u4 w = *(const u4*)(ub + o); UNPK(w, u0); } { const u4 w = *(const u4*)(bb + o); UNPK(w, bv); }
    const float* st = (ri.seq >= BATCH) ? state + (size_t)(ri.seq - BATCH) * 2 * D_MODEL + ch : nullptr;
    if (ri.t >= 1) { const u4 w = *(const u4*)(ub + o - D_MODEL); UNPK(w, u1); } else { for (int k = 0; k < 8; ++k) u1[k] = st ? st[D_MODEL + k] : 0.f; }
    if (ri.t >= 2) { const u4 w = *(const u4*)(ub + o - 2 * D_MODEL); UNPK(w, u2); } else { for (int k = 0; k < 8; ++k) u2[k] = st ? (ri.t == 1 ? st[D_MODEL + k] : st[k]) : 0.f; }
#undef UNPK
    float z[8];
    for (int k = 0; k < 8; ++k) z[k] = bv[k] * (wc[ch + k] * u2[k] + wc[D_MODEL + ch + k] * u1[k] + wc[2 * D_MODEL + ch + k] * u0[k]);
    u4 w; w.x = (unsigned)f2bf(z[0]) | ((unsigned)f2bf(z[1]) << 16); w.y = (unsigned)f2bf(z[2]) | ((unsigned)f2bf(z[3]) << 16);
    w.z = (unsigned)f2bf(z[4]) | ((unsigned)f2bf(z[5]) << 16); w.w = (unsigned)f2bf(z[6]) | ((unsigned)f2bf(z[7]) << 16);
    *(u4*)(zb + o) = w;
}
__device__ __forceinline__ void wconv_tile(int item, const float* src, int Nsrc, const float* gain, bf16_t* dst, int Nd, int K, int kind, int aux, LAS float* scr, int lane) {
    const int nblk = Nd / 32, kb = item / nblk, nb = item % nblk, k0 = 64 * kb, n0 = 32 * nb;
    const int colbase = colmap(kind, n0, aux);
    const int col = colbase + (lane & 31); const bool ok = colbase >= 0 && col < Nsrc;
#pragma unroll 8
    for (int i = 0; i < 32; ++i) { const int kk = 2 * i + (lane >> 5); const float g = gain ? gain[k0 + kk] : 1.f; scr[kk * 33 + (lane & 31)] = ok ? src[(size_t)(k0 + kk) * Nsrc + col] * g : 0.f; }
    asm volatile("s_waitcnt lgkmcnt(0)" ::: "memory");
    const int c = lane & 7;
#pragma unroll
    for (int j = 0; j < 4; ++j) { const int n = (lane >> 3) + 8 * j; const LAS float* sp = scr + (8 * c) * 33 + n;
        typedef unsigned v4u __attribute__((ext_vector_type(4)));
        v4u o; o.x = pg8::cvt_pk_bf16(sp[0 * 33], sp[1 * 33]); o.y = pg8::cvt_pk_bf16(sp[2 * 33], sp[3 * 33]); o.z = pg8::cvt_pk_bf16(sp[4 * 33], sp[5 * 33]); o.w = pg8::cvt_pk_bf16(sp[6 * 33], sp[7 * 33]);
        *(v4u*)(dst + (size_t)(n0 + n) * K + k0 + 8 * c) = o; }
    asm volatile("s_waitcnt lgkmcnt(0)" ::: "memory");
}
__device__ __forceinline__ void hinit_row(int m, const float* xp, const float* xs, float* h, bf16_t* hb, float* rss0, int lane) {
    typedef float f4 __attribute__((ext_vector_type(4))); typedef unsigned u2 __attribute__((ext_vector_type(2)));
    const float* x = m < MP ? xp + (size_t)m * D_MODEL : xs + (size_t)(m - MP) * D_MODEL;
    float s = 0.f;
#pragma unroll
    for (int j = 0; j < D_MODEL / 256; ++j) { const f4 v = *(const f4*)(x + 256 * j + 4 * lane); s += (v[0] * v[0] + v[1] * v[1]) + (v[2] * v[2] + v[3] * v[3]);
        *(f4*)(h + (size_t)m * D_MODEL + 256 * j + 4 * lane) = v; u2 w; w.x = pg8::cvt_pk_bf16(v[0], v[1]); w.y = pg8::cvt_pk_bf16(v[2], v[3]); *(u2*)(hb + (size_t)m * D_MODEL + 256 * j + 4 * lane) = w; }
#pragma unroll
    for (int o = 1; o < 64; o <<= 1) s += __shfl_xor(s, o);
    if (lane == 0) rss0[m] = s;
}
#endif

#ifndef CPU_TEST
__device__ __forceinline__ size_t opaque_gtid(int wave) { int w = wave; asm volatile("" : "+s"(w)); unsigned t = blockIdx.x * NTHREADS + w * 64 + lane_id_v(); return (size_t)t; }
#define ITEM_LOOP(total) for (size_t i = opaque_gtid(wave_id); i < (size_t)(total); i += (size_t)gridDim.x * NTHREADS)
#else
#define ITEM_LOOP(total) _Pragma("omp parallel for schedule(dynamic, 64)") for (long long i = 0; i < (long long)(total); ++i)
#endif

struct Params {
    const float *x_prompt, *x_sample, *cache_kv, *cache_win, *state_conv; const int* page_table;
    const float *ffn_a_norm, *ffn_a_w_in, *ffn_a_w_out, *mix_norm, *ffn_b_norm, *ffn_b_w_in, *ffn_b_w_out, *conv_w_in, *conv_w, *conv_w_out, *kv_norm, *w_kv, *k_norm,
                *cmp_pe, *cmp_w1, *cmp_w2, *nsa_w_qg, *nsa_q_norm, *nsa_w_o;
    float* out; unsigned char* ws;
};
constexpr int LDS_RING = 131072, LDS_BAR_OFF = LDS_RING + 352, LDS_BYTES = 147456;

#ifndef CPU_TEST
typedef const __attribute__((address_space(4))) Params* KParamsPtr;
__device__ __forceinline__ KParamsPtr kparams_ptr() {
#if defined(__HIP_DEVICE_COMPILE__)
    KParamsPtr p = (KParamsPtr)__builtin_amdgcn_kernarg_segment_ptr(); asm volatile("" : "+s"(p)); return p;
#else
    return nullptr;
#endif
}
__device__ __forceinline__ Params load_params() {
#if defined(__HIP_DEVICE_COMPILE__)
    return *kparams_ptr();
#else
    return Params{};
#endif
}
__device__ __forceinline__ unsigned char* load_ws() {
#if defined(__HIP_DEVICE_COMPILE__)
    return kparams_ptr()->ws;
#else
    return nullptr;
#endif
}
#define KP const Params P = load_params()
__device__ __forceinline__ int opaque_s(int v) { asm volatile("" : "+s"(v)); return v; }
#define GRID_SYNC() do { XcdBarrier bar_; bar_.bar = (GU*)load_ws() + 1024; bar_.x = 0; bar_.st = (volatile LAS unsigned*)(lds + LDS_BAR_OFF); xcd_barrier(bar_, wave_id == 0 && lane_id_v() == 0u); } while (0)
__global__ void __launch_bounds__(NTHREADS, 2) mega(Params P_unused)
#else
static Params g_params;
#define KP const Params& P = g_params
#define GRID_SYNC() do {} while (0)
void mega(Params P_unused)
#endif
{
#ifndef CPU_TEST
    extern __shared__ __attribute__((aligned(16))) unsigned char lds[];
    const int wave_id = __builtin_amdgcn_readfirstlane((int)(threadIdx.x >> 6));
    if (threadIdx.x < 4) ((LAS unsigned*)(lds + LDS_BAR_OFF))[threadIdx.x] = 0u;
    __syncthreads();
    (void)xcd_barrier_post((GU*)load_ws() + 1024, (volatile LAS unsigned*)(lds + LDS_BAR_OFF), threadIdx.x == 0);
#define RING ((PG8_LAS unsigned char*)lds)
#else
    g_params = P_unused;
#endif
#define WS_F(f) ((float*)(P.ws + WSM.f))
#define WS_B(f) ((bf16_t*)(P.ws + WSM.f))
#define KVSRC KvSrc{P.cache_kv, P.page_table, P.out}
#define PH(total, call) do { { KP; ITEM_LOOP(total) call; } GRID_SYNC(); } while (0)
#ifdef CPU_TEST
    for (int L = 0; L < DEPTH; ++L) {
        KP;
        ITEM_LOOP((size_t)2 * D_FF * (D_MODEL / 64)) wconv_item(i, P.ffn_a_w_in + (size_t)L * D_MODEL * 2 * D_FF, 2 * D_FF, P.ffn_a_norm + (size_t)L * D_MODEL, WS_B(w_ain) + (size_t)L * 2 * D_FF * D_MODEL, 2 * D_FF, D_MODEL, CM_PAIR, D_FF);
        ITEM_LOOP((size_t)D_MODEL * (D_FF / 64)) wconv_item(i, P.ffn_a_w_out + (size_t)L * D_FF * D_MODEL, D_MODEL, nullptr, WS_B(w_aout) + (size_t)L * D_MODEL * D_FF, D_MODEL, D_FF, CM_PLAIN, 0);
        ITEM_LOOP((size_t)2 * D_FF * (D_MODEL / 64)) wconv_item(i, P.ffn_b_w_in + (size_t)L * D_MODEL * 2 * D_FF, 2 * D_FF, P.ffn_b_norm + (size_t)L * D_MODEL, WS_B(w_bin) + (size_t)L * 2 * D_FF * D_MODEL, 2 * D_FF, D_MODEL, CM_PAIR, D_FF);
        ITEM_LOOP((size_t)D_MODEL * (D_FF / 64)) wconv_item(i, P.ffn_b_w_out + (size_t)L * D_FF * D_MODEL, D_MODEL, nullptr, WS_B(w_bout) + (size_t)L * D_MODEL * D_FF, D_MODEL, D_FF, CM_PLAIN, 0);
    }
    for (int L = 0; L < N_A; ++L) {
        KP;
        ITEM_LOOP((size_t)3 * D_MODEL * (D_MODEL / 64)) wconv_item(i, P.conv_w_in + (size_t)L * D_MODEL * 3 * D_MODEL, 3 * D_MODEL, P.mix_norm + (size_t)L * D_MODEL, WS_B(w_cin) + (size_t)L * 3 * D_MODEL * D_MODEL, 3 * D_MODEL, D_MODEL, CM_CONV, 0);
        ITEM_LOOP((size_t)D_MODEL * (D_MODEL / 64)) wconv_item(i, P.conv_w_out + (size_t)L * D_MODEL * D_MODEL, D_MODEL, nullptr, WS_B(w_cout) + (size_t)L * D_MODEL * D_MODEL, D_MODEL, D_MODEL, CM_PLAIN, 0);
    }
    for (int b = 0; b < N_B; ++b) {
        KP;
        ITEM_LOOP((size_t)QGP * (D_MODEL / 64)) wconv_item(i, P.nsa_w_qg + (size_t)b * D_MODEL * QGW, QGW, P.mix_norm + (size_t)(N_A + b) * D_MODEL, WS_B(w_qg) + (size_t)b * QGP * D_MODEL, QGP, D_MODEL, CM_HEADS, N_HEADS);
        ITEM_LOOP((size_t)D_MODEL * (HDM / 64)) wconv_item(i, P.nsa_w_o + (size_t)b * HDM * D_MODEL, D_MODEL, nullptr, WS_B(w_o) + (size_t)b * D_MODEL * HDM, D_MODEL, HDM, CM_PLAIN, 0);
    }
    { KP; ITEM_LOOP((size_t)KVW * (D_MODEL / 64)) wconv_item(i, P.w_kv, KVW, P.kv_norm, WS_B(w_kv), KVW, D_MODEL, CM_HEADS, 6 * N_KV); }
    { KP; ITEM_LOOP((size_t)NPOS * 8) rope_item(i, WS_F(rope)); }
    { KP; ITEM_LOOP(MT) hinit_item(i, P.x_prompt, P.x_sample, WS_F(h), WS_B(hb), WS_F(rss)); }
#else
#define WAVE_ITEMS(total) for (int it_ = (int)(opaque_s((int)blockIdx.x) * 8 + wave_id); it_ < (int)(total); it_ += (int)gridDim.x * 8)
#define WCONV(srcp, Nsrc_, gainp, dstp, Nd_, K_, kind_, aux_) do { KP; LAS float* scr_ = (LAS float*)(lds + wave_id * 16384); const int lane_ = (int)lane_id_v(); \
        WAVE_ITEMS(((Nd_) / 32) * ((K_) / 64)) wconv_tile(it_, srcp, Nsrc_, gainp, dstp, Nd_, K_, kind_, aux_, scr_, lane_); } while (0)
    for (int L = 0; L < DEPTH; ++L) {
        WCONV(P.ffn_a_w_in + (size_t)L * D_MODEL * 2 * D_FF, 2 * D_FF, P.ffn_a_norm + (size_t)L * D_MODEL, WS_B(w_ain) + (size_t)L * 2 * D_FF * D_MODEL, 2 * D_FF, D_MODEL, CM_PAIR, D_FF);
        WCONV(P.ffn_a_w_out + (size_t)L * D_FF * D_MODEL, D_MODEL, nullptr, WS_B(w_aout) + (size_t)L * D_MODEL * D_FF, D_MODEL, D_FF, CM_PLAIN, 0);
        WCONV(P.ffn_b_w_in + (size_t)L * D_MODEL * 2 * D_FF, 2 * D_FF, P.ffn_b_norm + (size_t)L * D_MODEL, WS_B(w_bin) + (size_t)L * 2 * D_FF * D_MODEL, 2 * D_FF, D_MODEL, CM_PAIR, D_FF);
        WCONV(P.ffn_b_w_out + (size_t)L * D_FF * D_MODEL, D_MODEL, nullptr, WS_B(w_bout) + (size_t)L * D_MODEL * D_FF, D_MODEL, D_FF, CM_PLAIN, 0);
    }
    for (int L = 0; L < N_A; ++L) {
        WCONV(P.conv_w_in + (size_t)L * D_MODEL * 3 * D_MODEL, 3 * D_MODEL, P.mix_norm + (size_t)L * D_MODEL, WS_B(w_cin) + (size_t)L * 3 * D_MODEL * D_MODEL, 3 * D_MODEL, D_MODEL, CM_CONV, 0);
        WCONV(P.conv_w_out + (size_t)L * D_MODEL * D_MODEL, D_MODEL, nullptr, WS_B(w_cout) + (size_t)L * D_MODEL * D_MODEL, D_MODEL, D_MODEL, CM_PLAIN, 0);
    }
    for (int b = 0; b < N_B; ++b) {
        WCONV(P.nsa_w_qg + (size_t)b * D_MODEL * QGW, QGW, P.mix_norm + (size_t)(N_A + b) * D_MODEL, WS_B(w_qg) + (size_t)b * QGP * D_MODEL, QGP, D_MODEL, CM_HEADS, N_HEADS);
        WCONV(P.nsa_w_o + (size_t)b * HDM * D_MODEL, D_MODEL, nullptr, WS_B(w_o) + (size_t)b * D_MODEL * HDM, D_MODEL, HDM, CM_PLAIN, 0);
    }
    WCONV(P.w_kv, KVW, P.kv_norm, WS_B(w_kv), KVW, D_MODEL, CM_HEADS, 6 * N_KV);
    { KP; ITEM_LOOP((size_t)NPOS * 8) rope_item(i, WS_F(rope)); }
    { KP; const int lane_ = (int)lane_id_v(); WAVE_ITEMS(MT) hinit_row(it_, P.x_prompt, P.x_sample, WS_F(h), WS_B(hb), WS_F(rss), lane_); }
#endif
#ifndef CPU_TEST
    for (int e = 0; e < 2; ++e) WCONV(P.cmp_w1 + (size_t)e * L_CMP * HD * CMP_HID, CMP_HID, nullptr, WS_B(w1t) + (size_t)e * CMP_HID * L_CMP * HD, CMP_HID, L_CMP * HD, CM_PLAIN, 0);
    for (int e = 0; e < 2; ++e) WCONV(P.cmp_w2 + (size_t)e * CMP_HID * HD, HD, nullptr, WS_B(w2t) + (size_t)e * HD * CMP_HID, HD, CMP_HID, CM_PLAIN, 0);
    { KP; ITEM_LOOP((size_t)2 * RS_CMP * L_CMP * 8) acmp_sample_item(i, P.cache_kv, P.page_table, P.cmp_pe, WS_B(acs)); }
#endif
    GRID_SYNC();
#ifndef CPU_TEST
    { KP; pg8::Gemm g{WS_B(acs), WS_B(w1t), 2 * RS_CMP, 2 * CMP_HID, L_CMP * HD}; pg8::CmpOrder So{2 * RS_CMP / 256, RS_CMP / 256, opaque_s((int)gridDim.x), opaque_s((int)blockIdx.x)};
      pg8::EpiGelu E{WS_B(hids)}; pg8::gemm_phase<pg8::EpiGelu, pg8::CmpOrder, true, true>(wave_id, RING, g, So, E); }
    GRID_SYNC();
    { KP; const int lane_ = (int)lane_id_v(); WAVE_ITEMS(2 * RS_CMP / 32) att::cmp_out_wave(it_, WS_B(hids), RS_CMP, NBC_PAST, BATCH, WS_B(w2t), P.k_norm, WS_F(kc), WS_F(vc), nullptr, nullptr, lane_); }
    GRID_SYNC();
#endif

#ifndef CPU_TEST
#define FFN_OPT(wi, wo, v_in, last) do { \
        { KP; pg8::Gemm g{WS_B(hb), WS_B(wi) + (size_t)layer * 2 * D_FF * D_MODEL, MT, 2 * D_FF, D_MODEL}; pg8::StaticOrder So; So.init(MT, 2 * D_FF, opaque_s((int)gridDim.x), opaque_s((int)blockIdx.x)); \
          pg8::EpiSwiglu E{WS_B(act), WS_F(rss) + (size_t)(v_in) * MT}; pg8::gemm_phase<pg8::EpiSwiglu, pg8::StaticOrder, true, true>(wave_id, RING, g, So, E); } \
        GRID_SYNC(); \
        { KP; pg8::Gemm g{WS_B(act), WS_B(wo) + (size_t)layer * D_MODEL * D_FF, MT, D_MODEL, D_FF}; pg8::StaticOrder So; So.init(MT, D_MODEL, opaque_s((int)gridDim.x), opaque_s((int)blockIdx.x)); \
          pg8::EpiResid E{WS_F(h), WS_B(hb), WS_F(rss) + (size_t)((v_in) + 1) * MT, (last) ? P.out + O_YP : nullptr, 0.5f}; pg8::gemm_phase<pg8::EpiResid, pg8::StaticOrder, true, true>(wave_id, RING, g, So, E); } \
        GRID_SYNC(); } while (0)
#else
#define FFN_OPT(wi, wo, v_in, last) do { KP; \
        ITEM_LOOP((size_t)MT * D_FF) ref_ffn_in_item(i, WS_B(hb), WS_F(rss) + (size_t)(v_in) * MT, WS_B(wi) + (size_t)layer * 2 * D_FF * D_MODEL, WS_B(act)); \
        ITEM_LOOP(MT) ref_resid_row_item(i, WS_B(act), D_FF, WS_B(wo) + (size_t)layer * D_MODEL * D_FF, 0.5f, WS_F(h), WS_B(hb), WS_F(rss) + (size_t)((v_in) + 1) * MT, (last) ? P.out + O_YP : nullptr); } while (0)
#endif
#ifndef CPU_TEST
#define GEMM_PH(EpiT, Aptr, Btptr, Nn, Kk, ...) do { { KP; pg8::Gemm g{Aptr, Btptr, MT, Nn, Kk}; pg8::StaticOrder So; So.init(MT, Nn, opaque_s((int)gridDim.x), opaque_s((int)blockIdx.x)); \
        pg8::EpiT E{__VA_ARGS__}; pg8::gemm_phase<pg8::EpiT, pg8::StaticOrder, true, true>(wave_id, RING, g, So, E); } GRID_SYNC(); } while (0)
#endif
    for (int layer = 0; layer < DEPTH; ++layer) {
        FFN_OPT(w_ain, w_aout, 3 * layer, false);
        const int v1 = 3 * layer + 1;
        if (layer < N_A) {
#ifndef CPU_TEST
            GEMM_PH(EpiConvIn, WS_B(hb), WS_B(w_cin) + (size_t)layer * 3 * D_MODEL * D_MODEL, 3 * D_MODEL, D_MODEL, WS_B(ub), WS_B(bb), WS_F(rss) + (size_t)v1 * MT, P.out, layer);
#else
            PH((size_t)MT * D_MODEL, ref_conv_in_item(i, WS_B(hb), WS_F(rss) + (size_t)v1 * MT, WS_B(w_cin) + (size_t)layer * 3 * D_MODEL * D_MODEL, WS_B(ub), WS_B(bb), P.out, layer));
#endif
#ifndef CPU_TEST
            PH((size_t)MT * (D_MODEL / 8), conv_thin_vec_item(i, WS_B(ub), WS_B(bb), P.state_conv + (size_t)layer * DEC_BATCH * 2 * D_MODEL, P.conv_w + (size_t)layer * 3 * D_MODEL, WS_B(zb)));
#else
            PH((size_t)MT * D_MODEL, conv_thin_item(i, WS_B(ub), WS_B(bb), P.state_conv + (size_t)layer * DEC_BATCH * 2 * D_MODEL, P.conv_w + (size_t)layer * 3 * D_MODEL, WS_B(zb)));
#endif
#ifndef CPU_TEST
            GEMM_PH(EpiResid, WS_B(zb), WS_B(w_cout) + (size_t)layer * D_MODEL * D_MODEL, D_MODEL, D_MODEL, WS_F(h), WS_B(hb), WS_F(rss) + (size_t)(v1 + 1) * MT, nullptr, 1.0f);
#else
            PH(MT, ref_resid_row_item(i, WS_B(zb), D_MODEL, WS_B(w_cout) + (size_t)layer * D_MODEL * D_MODEL, 1.0f, WS_F(h), WS_B(hb), WS_F(rss) + (size_t)(v1 + 1) * MT, nullptr));
#endif
        } else {
            const int b = layer - N_A;
#ifndef CPU_TEST
            GEMM_PH(EpiQG, WS_B(hb), WS_B(w_qg) + (size_t)b * QGP * D_MODEL, QGP, D_MODEL, WS_B(qnb), WS_B(qrb), WS_F(gates), WS_F(rss) + (size_t)v1 * MT, P.nsa_q_norm + (size_t)b * HD, WS_F(rope));
#else
            { KP; ITEM_LOOP((size_t)MT * N_HEADS) ref_qg_item(i, WS_B(hb), WS_F(rss) + (size_t)v1 * MT, WS_B(w_qg) + (size_t)b * QGP * D_MODEL, P.nsa_q_norm + (size_t)b * HD, WS_F(rope), WS_F(qn), WS_F(qr)); }
            PH((size_t)MT * 3 * N_HEADS, ref_gates_item(i, WS_B(hb), WS_F(rss) + (size_t)v1 * MT, WS_B(w_qg) + (size_t)b * QGP * D_MODEL, WS_F(gates)));
#endif
#ifndef CPU_TEST
            { KP; att::Tensors T{WS_B(qnb), WS_B(qrb), P.ws + WSM.ksel, P.ws + WSM.vsel, P.ws + WSM.kwin, P.ws + WSM.vwin, P.ws + WSM.kci, P.ws + WSM.vci, WS_F(gates), WS_B(ob)};
              int wv = wave_id; asm volatile("" : "+s"(wv));
              att::phase(T, (att::ldsp)lds, wv, (int)lane_id_v(), opaque_s((int)blockIdx.x), opaque_s((int)gridDim.x)); }
            { KP; att::STensors T{WS_B(qnb), WS_B(qrb), WS_F(kc), WS_F(vc), P.cache_kv, P.page_table, P.cache_win, P.out, WS_F(winrows), WS_F(gates), WS_B(ob)};
              int wv = wave_id; asm volatile("" : "+s"(wv));
              att::sample_phase(T, (att::ldsp)lds, wv, (int)lane_id_v(), opaque_s((int)blockIdx.x), opaque_s((int)gridDim.x)); }
            GRID_SYNC();
#else
            PH((size_t)MT * N_HEADS, attn_cmp_item(i, WS_F(qn), WS_F(kc), WS_F(vc), WS_F(pbuf), WS_F(oc)));
            PH((size_t)MT * N_KV, topk_item(i, WS_F(pbuf), (int*)WS_F(sel), WS_F(scorebuf)));
            PH((size_t)MT * N_HEADS, attn_sel_item(i, KVSRC, WS_F(qr), (const int*)WS_F(sel), WS_F(os)));
            PH((size_t)MT * N_HEADS, attn_win_item(i, P.cache_win, WS_F(winrows), WS_F(qr), WS_F(gates), WS_F(oc), WS_F(os), WS_B(ob)));
#endif
#ifndef CPU_TEST
            GEMM_PH(EpiResid, WS_B(ob), WS_B(w_o) + (size_t)b * D_MODEL * HDM, D_MODEL, HDM, WS_F(h), WS_B(hb), WS_F(rss) + (size_t)(v1 + 1) * MT, nullptr, 1.0f);
#else
            PH(MT, ref_resid_row_item(i, WS_B(ob), HDM, WS_B(w_o) + (size_t)b * D_MODEL * HDM, 1.0f, WS_F(h), WS_B(hb), WS_F(rss) + (size_t)(v1 + 1) * MT, nullptr));
#endif
        }
        FFN_OPT(w_bin, w_bout, 3 * layer + 2, layer == DEPTH - 1);
        if (layer == N_A - 1) {
            const int v3 = 3 * layer + 3;
#ifndef CPU_TEST
            { KP; pg8::Gemm g{WS_B(hb), WS_B(w_kv), MT, KVW, D_MODEL}; pg8::StaticOrder So; So.init(MT, KVW, opaque_s((int)gridDim.x), opaque_s((int)blockIdx.x));
              pg8::EpiKV E{P.out, WS_F(winrows), WS_F(rss) + (size_t)v3 * MT, P.k_norm, WS_F(rope), P.ws + WSM.ksel, P.ws + WSM.vsel, P.ws + WSM.kwin, P.ws + WSM.vwin, WS_B(acp), P.cmp_pe}; pg8::gemm_phase<pg8::EpiKV, pg8::StaticOrder, true, true>(wave_id, RING, g, So, E); }
#else
            { KP; ITEM_LOOP((size_t)MT * 6 * N_KV) ref_kv_item(i, WS_B(hb), WS_F(rss) + (size_t)v3 * MT, WS_B(w_kv), P.k_norm, WS_F(rope), P.out, WS_F(winrows)); }
#endif
            PH((size_t)DEC_BATCH * (WINDOW - DEC_SEQ) * 2 * N_KV * HD, wincopy_item(i, P.cache_win, P.out));
#ifdef CPU_TEST
            PH((size_t)NSEQ * NBC_MAX * 2 * N_KV * CMP_HID, cmp_hid_item(i, KVSRC, P.cmp_pe, P.cmp_w1, WS_F(hid)));
            PH((size_t)NSEQ * NBC_MAX * 2 * N_KV, cmp_out_item(i, WS_F(hid), P.cmp_w2, P.k_norm, WS_F(kc), WS_F(vc)));
#else
            { KP; pg8::Gemm g{WS_B(acp), WS_B(w1t), 2 * RP_CMP, 2 * CMP_HID, L_CMP * HD}; pg8::CmpOrder So{2 * RP_CMP / 256, RP_CMP / 256, opaque_s((int)gridDim.x), opaque_s((int)blockIdx.x)};
              pg8::EpiGelu E{WS_B(hidp)}; pg8::gemm_phase<pg8::EpiGelu, pg8::CmpOrder, true, true>(wave_id, RING, g, So, E); }
            GRID_SYNC();
            { KP; const int lane_ = (int)lane_id_v(); WAVE_ITEMS(2 * RP_CMP / 32) att::cmp_out_wave(it_, WS_B(hidp), RP_CMP, NBC_P, 0, WS_B(w2t), P.k_norm, WS_F(kc), WS_F(vc), P.ws + WSM.kci, P.ws + WSM.vci, lane_); }
            GRID_SYNC();
#endif
        }
    }
}

extern "C" void kernel_launch(void* const* d_in, const int* in_sizes, int n_in, void* d_out, int out_size, void* d_ws, size_t ws_size, hipStream_t stream) {
    Params P{};
    P.x_prompt = (const float*)d_in[0]; P.x_sample = (const float*)d_in[1]; P.cache_kv = (const float*)d_in[2]; P.cache_win = (const float*)d_in[3];
    P.state_conv = (const float*)d_in[4]; P.page_table = (const int*)d_in[5]; P.ffn_a_norm = (const float*)d_in[6]; P.ffn_a_w_in = (const float*)d_in[7];
    P.ffn_a_w_out = (const float*)d_in[8]; P.mix_norm = (const float*)d_in[9]; P.ffn_b_norm = (const float*)d_in[10]; P.ffn_b_w_in = (const float*)d_in[11];
    P.ffn_b_w_out = (const float*)d_in[12]; P.conv_w_in = (const float*)d_in[13]; P.conv_w = (const float*)d_in[14]; P.conv_w_out = (const float*)d_in[15];
    P.kv_norm = (const float*)d_in[16]; P.w_kv = (const float*)d_in[17]; P.k_norm = (const float*)d_in[18]; P.cmp_pe = (const float*)d_in[19];
    P.cmp_w1 = (const float*)d_in[20]; P.cmp_w2 = (const float*)d_in[21]; P.nsa_w_qg = (const float*)d_in[22]; P.nsa_q_norm = (const float*)d_in[23];
    P.nsa_w_o = (const float*)d_in[24];
    P.out = (float*)d_out; P.ws = (unsigned char*)d_ws;
#ifndef CPU_TEST
    static int grid = 0;
    if (grid == 0) {
        int dev = 0, cus = 0, per_cu = 0;
        hipGetDevice(&dev); hipDeviceGetAttribute(&cus, hipDeviceAttributeMultiprocessorCount, dev);
        hipFuncSetAttribute((const void*)mega, hipFuncAttributeMaxDynamicSharedMemorySize, LDS_BYTES);
        hipOccupancyMaxActiveBlocksPerMultiprocessor(&per_cu, (const void*)mega, NTHREADS, LDS_BYTES);
        (void)hipGetLastError();
        grid = cus;
    }
    hipMemsetAsync(d_ws, 0, WS_ZERO_BYTES, stream);
    hipLaunchKernelGGL(mega, dim3(grid), dim3(NTHREADS), LDS_BYTES, stream, P);
#else
    memset(d_ws, 0, WS_ZERO_BYTES);
    mega(P);
#endif
}
```

```cpp
#ifdef CPU_TEST
#include "shim.h"
#else
#include <hip/hip_runtime.h>
#endif
#include <cstdint>
#include <cstddef>
#include <cmath>
#include <cstring>
typedef unsigned short bf16_t;
#ifndef CPU_TEST
#define HOSTDEV __host__ __device__
#else
#define HOSTDEV
#endif
HOSTDEV inline bf16_t f2bf(float f) { unsigned u; memcpy(&u, &f, 4); u = (u + 0x7fffu + ((u >> 16) & 1u)) >> 16; return (bf16_t)u; }
HOSTDEV inline float bf2f(bf16_t b) { unsigned u = (unsigned)b << 16; float f; memcpy(&f, &u, 4); return f; }

#ifdef CFG_SMALL
constexpr int D_MODEL = 256, BATCH = 1, SEQ = 2048, DEPTH = 4, DEC_BATCH = 2, DEC_SEQ = 8, PAST_LEN = 2048, PAGE_SIZE = 128, D_FF = 256, N_HEADS = 4, N_KV = 2;
#else
constexpr int D_MODEL = 1024, BATCH = 4, SEQ = 4096, DEPTH = 4, DEC_BATCH = 32, DEC_SEQ = 8, PAST_LEN = 8192, PAGE_SIZE = 128, D_FF = 2816, N_HEADS = 16, N_KV = 4;
#endif
constexpr int N_A = DEPTH / 2, N_B = DEPTH - N_A, HD = 64, HPG = N_HEADS / N_KV, L_CMP = 32, L_SEL = 64, N_SEL = 16, WINDOW = 512, CMP_HID = 4 * HD;
constexpr int MP = BATCH * SEQ, MS = DEC_BATCH * DEC_SEQ, MT = MP + MS, NSEQ = BATCH + DEC_BATCH;
constexpr int N_PAGES = PAST_LEN / PAGE_SIZE;
constexpr int KVW = 6 * N_KV * HD;
constexpr int QGW = N_HEADS * HD + 3 * N_HEADS;
constexpr int HDM = N_HEADS * HD;
constexpr int TPAD_S = ((PAST_LEN + DEC_SEQ + L_SEL - 1) / L_SEL) * L_SEL;
constexpr int NBC_P = SEQ / L_CMP, NBC_S = TPAD_S / L_CMP, NBC_MAX = NBC_S > NBC_P ? NBC_S : NBC_P;
constexpr int NBS_P = SEQ / L_SEL, NBS_S = TPAD_S / L_SEL, NBS_MAX = NBS_S > NBS_P ? NBS_S : NBS_P;
constexpr float EPS = 1e-6f, NEGF = -1e30f, TINYF = 1e-30f, FORCE_SCORE = 1e4f;
__device__ static const float INV_FREQ[8] = {1.0f, 0.1939227432012558f, 0.03760603070259094f, 0.007292664609849453f, 0.0014142135623842478f, 0.00027424818836152554f, 5.3182957344688475e-05f, 1.0313385246263351e-05f};

constexpr size_t O_YP = 0, O_YS = O_YP + (size_t)MP * D_MODEL, O_KVP = O_YS + (size_t)MS * D_MODEL, O_KVS = O_KVP + (size_t)MP * 4 * N_KV * HD,
                 O_WP = O_KVS + (size_t)MS * 4 * N_KV * HD, O_WS = O_WP + (size_t)BATCH * WINDOW * 2 * N_KV * HD, O_CP = O_WS + (size_t)DEC_BATCH * WINDOW * 2 * N_KV * HD,
                 O_CS = O_CP + (size_t)N_A * BATCH * 2 * D_MODEL, O_END = O_CS + (size_t)N_A * DEC_BATCH * 2 * D_MODEL;

struct RowInfo { int seq, t, pos; };
__device__ __host__ inline RowInfo row_info(int m) {
    RowInfo r;
    if (m < MP) { r.seq = m / SEQ; r.t = m % SEQ; r.pos = r.t; }
    else { const int q = m - MP; r.seq = BATCH + q / DEC_SEQ; r.t = q % DEC_SEQ; r.pos = PAST_LEN + r.t; }
    return r;
}
__device__ __host__ inline int seq_row0(int seq) { return seq < BATCH ? seq * SEQ : MP + (seq - BATCH) * DEC_SEQ; }
__device__ __host__ inline int seq_pos0(int seq) { return seq < BATCH ? 0 : PAST_LEN; }
__device__ __host__ inline int seq_len(int seq) { return seq < BATCH ? SEQ : DEC_SEQ; }

__device__ inline void copy_item(size_t i_, const float* a, float* b, size_t n) {
    const size_t i = i_;
    if (i < n) b[i] = a[i];
}
__device__ inline void rmsnorm_item(size_t i_, const float* x, const float* g, float* y, int rows, int d) {
    const int m = (int)i_;
    if (m >= rows) return;
    const float* xr = x + (size_t)m * d; float s = 0.f;
    for (int i = 0; i < d; ++i) s += xr[i] * xr[i];
    const float r = 1.0f / sqrtf(s / d + EPS);
    float* yr = y + (size_t)m * d;
    for (int i = 0; i < d; ++i) yr[i] = xr[i] * r * g[i];
}
__device__ inline void gemm_item(size_t i_, const float* A, int lda, const float* W, float* C, int M, int N, int K) {
    const int nbx = (N + 63) / 64; const int vb = (int)(i_ / 256), t_ = (int)(i_ % 256), tx = t_ % 16, ty = t_ / 16;
    const int c0 = (vb % nbx) * 64 + tx * 4, r0 = (vb / nbx) * 64 + ty * 4;
    if (c0 >= N || r0 >= M) return;
    float acc[4][4];
    for (int i = 0; i < 4; ++i) for (int j = 0; j < 4; ++j) acc[i][j] = 0.f;
    const int nr = (M - r0) < 4 ? (M - r0) : 4;
    for (int k = 0; k < K; k += 4) {
        float a[4][4], w[4][4];
        for (int i = 0; i < 4; ++i) for (int kk = 0; kk < 4; ++kk) a[i][kk] = (i < nr) ? A[(size_t)(r0 + i) * lda + k + kk] : 0.f;
        for (int kk = 0; kk < 4; ++kk) for (int j = 0; j < 4; ++j) w[kk][j] = W[(size_t)(k + kk) * N + c0 + j];
        for (int i = 0; i < 4; ++i) for (int kk = 0; kk < 4; ++kk) for (int j = 0; j < 4; ++j) acc[i][j] += a[i][kk] * w[kk][j];
    }
    for (int i = 0; i < nr; ++i) for (int j = 0; j < 4; ++j) C[(size_t)(r0 + i) * N + c0 + j] = acc[i][j];
}
__device__ inline void swiglu_item(size_t i_, const float* t1, float* act, int rows, int dff) {
    const size_t i = i_;
    if (i >= (size_t)rows * dff) return;
    const int m = (int)(i / dff), j = (int)(i % dff);
    const float g = t1[(size_t)m * 2 * dff + j], u = t1[(size_t)m * 2 * dff + dff + j];
    act[i] = g / (1.0f + expf(-g)) * u;
}
__device__ inline void axpy_item(size_t i_, float* h, const float* y, float coef, size_t n) {
    const size_t i = i_;
    if (i < n) h[i] += coef * y[i];
}
__device__ inline void conv_item(size_t i_, const float* t1, const float* state  , const float* wc  , float* z, float* out, int layer) {
    const size_t i = i_;
    if (i >= (size_t)MT * D_MODEL) return;
    const int m = (int)(i / D_MODEL), ch = (int)(i % D_MODEL);
    const RowInfo ri = row_info(m);
    const float* r = t1 + (size_t)m * 3 * D_MODEL;
    const float b = r[ch], u0 = r[D_MODEL + ch] * r[2 * D_MODEL + ch];
    float u1, u2;
    if (ri.t >= 1) { const float* p = r - 3 * D_MODEL; u1 = p[D_MODEL + ch] * p[2 * D_MODEL + ch]; }
    else u1 = (ri.seq < BATCH) ? 0.f : state[((size_t)(ri.seq - BATCH) * 2 + 1) * D_MODEL + ch];
    if (ri.t >= 2) { const float* p = r - 6 * D_MODEL; u2 = p[D_MODEL + ch] * p[2 * D_MODEL + ch]; }
    else if (ri.seq < BATCH) u2 = 0.f;
    else u2 = (ri.t == 1) ? state[((size_t)(ri.seq - BATCH) * 2 + 1) * D_MODEL + ch] : state[((size_t)(ri.seq - BATCH) * 2 + 0) * D_MODEL + ch];
    z[i] = b * (wc[ch] * u2 + wc[D_MODEL + ch] * u1 + wc[2 * D_MODEL + ch] * u0);
    const int L = seq_len(ri.seq);
    if (ri.t >= L - 2) {
        const int j = ri.t - (L - 2);
        if (ri.seq < BATCH) out[O_CP + (((size_t)layer * BATCH + ri.seq) * 2 + j) * D_MODEL + ch] = u0;
        else out[O_CS + (((size_t)layer * DEC_BATCH + (ri.seq - BATCH)) * 2 + j) * D_MODEL + ch] = u0;
    }
}
__device__ inline void head_norm(float* v, const float* g) {
    float s = 0.f; for (int d = 0; d < HD; ++d) s += v[d] * v[d];
    const float r = 1.0f / sqrtf(s / HD + EPS);
    for (int d = 0; d < HD; ++d) v[d] = v[d] * r * g[d];
}
__device__ inline void rope_cs(float ang, float& c, float& s) {
    const double r = (double)ang * 0.15915494309189535; const float fr = (float)(r - rint(r));
#ifdef CPU_TEST
    c = (float)cos(6.283185307179586 * (double)fr); s = (float)sin(6.283185307179586 * (double)fr);
#else
    c = __builtin_amdgcn_cosf(fr); s = __builtin_amdgcn_sinf(fr);
#endif
}
__device__ inline void head_rope(float* v, int pos) {
    for (int i = 0; i < 8; ++i) {
        const float ang = (float)pos * INV_FREQ[i]; float c, s; rope_cs(ang, c, s);
        const float x1 = v[i], x2 = v[8 + i];
        v[i] = x1 * c - x2 * s; v[8 + i] = x2 * c + x1 * s;
    }
}
__device__ inline void kvprep_item(size_t i_, const float* p, const float* k_norm  , float* out, float* winrows) {
    const int i = (int)i_;
    if (i >= MT * 6 * N_KV) return;
    const int m = i / (6 * N_KV), e = (i / N_KV) % 6, g = i % N_KV;
    const RowInfo ri = row_info(m);
    float v[HD];
    for (int d = 0; d < HD; ++d) v[d] = p[(size_t)m * KVW + (e * N_KV + g) * HD + d];
    if (e == 2) { head_norm(v, k_norm + HD); head_rope(v, ri.pos); }
    if (e == 4) { head_norm(v, k_norm + 2 * HD); head_rope(v, ri.pos); }
    if (e < 4) {
        float* o = (ri.seq < BATCH) ? out + O_KVP + (((size_t)m * 4 + e) * N_KV + g) * HD : out + O_KVS + (((size_t)(m - MP) * 4 + e) * N_KV + g) * HD;
        for (int d = 0; d < HD; ++d) o[d] = v[d];
    } else {
        const int we = e - 4;
        float* w = winrows + (((size_t)m * 2 + we) * N_KV + g) * HD;
        for (int d = 0; d < HD; ++d) w[d] = v[d];
        if (ri.seq < BATCH) { if (ri.t >= SEQ - WINDOW) { float* o = out + O_WP + ((((size_t)ri.seq * WINDOW + (ri.t - (SEQ - WINDOW))) * 2 + we) * N_KV + g) * HD; for (int d = 0; d < HD; ++d) o[d] = v[d]; } }
        else { float* o = out + O_WS + ((((size_t)(ri.seq - BATCH) * WINDOW + (WINDOW - DEC_SEQ + ri.t)) * 2 + we) * N_KV + g) * HD; for (int d = 0; d < HD; ++d) o[d] = v[d]; }
    }
}
__device__ inline void wincopy_item(size_t i_, const float* cache_win, float* out) {
    const size_t i = i_;
    const size_t per = (size_t)(WINDOW - DEC_SEQ) * 2 * N_KV * HD;
    if (i >= (size_t)DEC_BATCH * per) return;
    const size_t b = i / per, r = i % per;
    out[O_WS + b * WINDOW * 2 * N_KV * HD + r] = cache_win[b * WINDOW * 2 * N_KV * HD + (size_t)DEC_SEQ * 2 * N_KV * HD + r];
}
struct KvSrc { const float* cache_kv; const int* page_table; const float* out; };
__device__ inline const float* kv_full_ptr(const KvSrc& S, int seq, int tok, int e, int g) {
    if (seq < BATCH) return S.out + O_KVP + ((((size_t)seq * SEQ + tok) * 4 + e) * N_KV + g) * HD;
    const int b = seq - BATCH;
    if (tok < PAST_LEN) { const int page = S.page_table[b * N_PAGES + tok / PAGE_SIZE]; return S.cache_kv + ((((size_t)page * PAGE_SIZE + tok % PAGE_SIZE) * 4 + e) * N_KV + g) * HD; }
    if (tok < PAST_LEN + DEC_SEQ) return S.out + O_KVS + ((((size_t)b * DEC_SEQ + (tok - PAST_LEN)) * 4 + e) * N_KV + g) * HD;
    return nullptr;
}
__device__ inline int seq_nbc(int seq) { return seq < BATCH ? NBC_P : NBC_S; }
__device__ inline void cmp_hid_item(size_t i_, KvSrc S, const float* pe  , const float* w1  , float* hid) {
    const size_t i = i_;
    if (i >= (size_t)NSEQ * NBC_MAX * 2 * N_KV * CMP_HID) return;
    const int f = (int)(i % CMP_HID), g = (int)((i / CMP_HID) % N_KV), e = (int)((i / ((size_t)CMP_HID * N_KV)) % 2), c = (int)((i / ((size_t)CMP_HID * N_KV * 2)) % NBC_MAX), seq = (int)(i / ((size_t)CMP_HID * N_KV * 2 * NBC_MAX));
    if (c >= seq_nbc(seq)) return;
    float s = 0.f;
    for (int l = 0; l < L_CMP; ++l) {
        const float* r = kv_full_ptr(S, seq, c * L_CMP + l, e, g);
        const float* w = w1 + (((size_t)e * L_CMP + l) * HD) * CMP_HID + f; const float* pp = pe + ((size_t)e * L_CMP + l) * HD;
        for (int d = 0; d < HD; ++d) s += ((r ? r[d] : 0.f) + pp[d]) * w[(size_t)d * CMP_HID];
    }
    const float x = s; const float t = tanhf(0.7978845608028654f * (x + 0.044715f * x * x * x));
    hid[i] = 0.5f * x * (1.0f + t);
}
__device__ inline void cmp_out_item(size_t i_, const float* hid, const float* w2  , const float* k_norm0, float* kc, float* vc) {
    const int i = (int)i_;
    if (i >= NSEQ * NBC_MAX * 2 * N_KV) return;
    const int g = i % N_KV, e = (i / N_KV) % 2, c = (i / (2 * N_KV)) % NBC_MAX, seq = i / (2 * N_KV * NBC_MAX);
    if (c >= seq_nbc(seq)) return;
    const float* hr = hid + (size_t)i * CMP_HID;
    float v[HD];
    for (int d = 0; d < HD; ++d) { float s = 0.f; for (int f = 0; f < CMP_HID; ++f) s += hr[f] * w2[((size_t)e * CMP_HID + f) * HD + d]; v[d] = s; }
    if (e == 0) head_norm(v, k_norm0);
    float* o = (e == 0 ? kc : vc) + (((size_t)seq * NBC_MAX + c) * N_KV + g) * HD;
    for (int d = 0; d < HD; ++d) o[d] = v[d];
}
__device__ inline void qprep_item(size_t i_, const float* qg, const float* q_norm, float* qn, float* qr, float* gates) {
    const int i = (int)i_;
    if (i >= MT * N_HEADS) return;
    const int m = i / N_HEADS, hh = i % N_HEADS;
    const RowInfo ri = row_info(m);
    float v[HD];
    for (int d = 0; d < HD; ++d) v[d] = qg[(size_t)m * QGW + hh * HD + d];
    head_norm(v, q_norm);
    for (int d = 0; d < HD; ++d) qn[(size_t)m * HDM + hh * HD + d] = v[d];
    head_rope(v, ri.pos);
    for (int d = 0; d < HD; ++d) qr[(size_t)m * HDM + hh * HD + d] = v[d];
    for (int j = 0; j < 3; ++j) { const float x = qg[(size_t)m * QGW + HDM + hh * 3 + j]; gates[(size_t)m * 3 * N_HEADS + hh * 3 + j] = 1.0f / (1.0f + expf(-x)); }
}
__device__ inline void attn_cmp_item(size_t i_, const float* qn, const float* kc, const float* vc, float* pbuf, float* oc) {
    const int i = (int)i_;
    if (i >= MT * N_HEADS) return;
    const int m = i / N_HEADS, hh = i % N_HEADS, g = hh / HPG;
    const RowInfo ri = row_info(m);
    const int nbc = seq_nbc(ri.seq);
    const float* q = qn + (size_t)m * HDM + hh * HD;
    float* p = pbuf + (size_t)i * NBC_MAX;
    float mx = NEGF;
    for (int c = 0; c < nbc; ++c) {
        const bool vis = (c + 1) * L_CMP - 1 <= ri.pos;
        float s = 0.f; const float* k = kc + (((size_t)ri.seq * NBC_MAX + c) * N_KV + g) * HD;
        for (int d = 0; d < HD; ++d) s += q[d] * k[d];
        s *= 0.125f; p[c] = s; if (vis && s > mx) mx = s;
    }
    float sum = 0.f;
    for (int c = 0; c < nbc; ++c) { const bool vis = (c + 1) * L_CMP - 1 <= ri.pos; const float e = vis ? expf(p[c] - mx) : 0.f; p[c] = e; sum += e; }
    const float inv = 1.0f / fmaxf(sum, TINYF);
    float o[HD]; for (int d = 0; d < HD; ++d) o[d] = 0.f;
    for (int c = 0; c < nbc; ++c) { p[c] *= inv; if (p[c] != 0.f) { const float* v = vc + (((size_t)ri.seq * NBC_MAX + c) * N_KV + g) * HD; for (int d = 0; d < HD; ++d) o[d] += p[c] * v[d]; } }
    for (int d = 0; d < HD; ++d) oc[(size_t)m * HDM + hh * HD + d] = o[d];
}
__device__ inline void topk_item(size_t i_, const float* pbuf, int* sel, float* scorebuf  ) {
    const int i = (int)i_;
    if (i >= MT * N_KV) return;
    const int m = i / N_KV, g = i % N_KV;
    const RowInfo ri = row_info(m);
    const int nbs = ri.seq < BATCH ? NBS_P : NBS_S, cur = ri.pos / L_SEL;
    float* score = scorebuf + (size_t)i * NBS_MAX;
    for (int b = 0; b < nbs; ++b) {
        float imp = 0.f;
        for (int h = 0; h < HPG; ++h) { const float* p = pbuf + ((size_t)m * N_HEADS + g * HPG + h) * NBC_MAX; imp += p[2 * b]; }
        float imp2 = 0.f;
        for (int h = 0; h < HPG; ++h) { const float* p = pbuf + ((size_t)m * N_HEADS + g * HPG + h) * NBC_MAX; imp2 += p[2 * b + 1]; }
        const bool forced = (b == 0) || (b == cur) || (b == cur - 1), valid = b * L_SEL <= ri.pos;
        score[b] = valid ? (forced ? FORCE_SCORE : imp + imp2) : NEGF;
    }
    const int nsel = N_SEL < nbs ? N_SEL : nbs;
    for (int j = 0; j < N_SEL; ++j) {
        if (j >= nsel) { sel[(size_t)i * N_SEL + j] = -1; continue; }
        int best = -1; float bv = 0.f;
        for (int b = 0; b < nbs; ++b) if (score[b] > -3e38f && (best < 0 || score[b] > bv)) { best = b; bv = score[b]; }
        sel[(size_t)i * N_SEL + j] = best; score[best] = -3.4e38f;
    }
}
__device__ inline void attn_sel_item(size_t i_, KvSrc S, const float* qr, const int* sel, float* os) {
    const int i = (int)i_;
    if (i >= MT * N_HEADS) return;
    const int m = i / N_HEADS, hh = i % N_HEADS, g = hh / HPG;
    const RowInfo ri = row_info(m);
    const float* q = qr + (size_t)m * HDM + hh * HD;
    const int* sl = sel + ((size_t)m * N_KV + g) * N_SEL;
    float mx = NEGF;
    for (int j = 0; j < N_SEL; ++j) { const int b = sl[j]; if (b < 0) continue;
        for (int t = 0; t < L_SEL; ++t) { const int tok = b * L_SEL + t; if (tok > ri.pos) continue;
            const float* k = kv_full_ptr(S, ri.seq, tok, 2, g); float s = 0.f; if (k) for (int d = 0; d < HD; ++d) s += q[d] * k[d];
            s *= 0.125f; if (s > mx) mx = s; } }
    float sum = 0.f, o[HD]; for (int d = 0; d < HD; ++d) o[d] = 0.f;
    for (int j = 0; j < N_SEL; ++j) { const int b = sl[j]; if (b < 0) continue;
        for (int t = 0; t < L_SEL; ++t) { const int tok = b * L_SEL + t; if (tok > ri.pos) continue;
            const float* k = kv_full_ptr(S, ri.seq, tok, 2, g); float s = 0.f; if (k) for (int d = 0; d < HD; ++d) s += q[d] * k[d];
            const float e = expf(s * 0.125f - mx); sum += e;
            const float* v = kv_full_ptr(S, ri.seq, tok, 3, g); if (v) for (int d = 0; d < HD; ++d) o[d] += e * v[d]; } }
    const float inv = 1.0f / fmaxf(sum, TINYF);
    for (int d = 0; d < HD; ++d) os[(size_t)m * HDM + hh * HD + d] = o[d] * inv;
}
__device__ inline const float* win_ptr(const float* cache_win, const float* winrows, int seq, int kp) {
    if (seq < BATCH) return kp >= 0 ? winrows + (size_t)(seq * SEQ + kp) * 2 * N_KV * HD : nullptr;
    const int b = seq - BATCH;
    if (kp >= PAST_LEN) return winrows + (size_t)(MP + b * DEC_SEQ + (kp - PAST_LEN)) * 2 * N_KV * HD;
    const int j = kp - (PAST_LEN - WINDOW);
    return j >= 0 ? cache_win + ((size_t)b * WINDOW + j) * 2 * N_KV * HD : nullptr;
}
__device__ inline void attn_win_item(size_t i_, const float* cache_win, const float* winrows, const float* qr, const float* gates, const float* oc, const float* os, bf16_t* o_out) {
    const int i = (int)i_;
    if (i >= MT * N_HEADS) return;
    const int m = i / N_HEADS, hh = i % N_HEADS, g = hh / HPG;
    const RowInfo ri = row_info(m);
    const float* q = qr + (size_t)m * HDM + hh * HD;
    float mx = NEGF;
    for (int kp = ri.pos - WINDOW; kp <= ri.pos; ++kp) { const float* r = win_ptr(cache_win, winrows, ri.seq, kp); if (!r) continue;
        const float* k = r + (0 * N_KV + g) * HD; float s = 0.f; for (int d = 0; d < HD; ++d) s += q[d] * k[d]; s *= 0.125f; if (s > mx) mx = s; }
    float sum = 0.f, o[HD]; for (int d = 0; d < HD; ++d) o[d] = 0.f;
    for (int kp = ri.pos - WINDOW; kp <= ri.pos; ++kp) { const float* r = win_ptr(cache_win, winrows, ri.seq, kp); if (!r) continue;
        const float* k = r + (0 * N_KV + g) * HD; float s = 0.f; for (int d = 0; d < HD; ++d) s += q[d] * k[d];
        const float e = expf(s * 0.125f - mx); sum += e; const float* v = r + (1 * N_KV + g) * HD; for (int d = 0; d < HD; ++d) o[d] += e * v[d]; }
    const float inv = 1.0f / fmaxf(sum, TINYF);
    const float* gt = gates + (size_t)m * 3 * N_HEADS + hh * 3;
    for (int d = 0; d < HD; ++d) { const size_t x = (size_t)m * HDM + hh * HD + d; o_out[x] = f2bf(gt[0] * oc[x] + gt[1] * os[x] + gt[2] * o[d] * inv); }
}


#ifndef CPU_TEST
__device__ __forceinline__ unsigned lane_id_v() { unsigned l; asm volatile("v_mbcnt_lo_u32_b32 %0, -1, 0\n\tv_mbcnt_hi_u32_b32 %0, -1, %0" : "=v"(l)); return l; }
#endif
constexpr int NTHREADS = 512;
__host__ __device__ inline bf16_t f2bf_(float f) { unsigned u; memcpy(&u, &f, 4); u = (u + 0x7fffu + ((u >> 16) & 1u)) >> 16; return (bf16_t)u; }
__host__ __device__ inline float bf2f_(bf16_t b) { unsigned u = (unsigned)b << 16; float f; memcpy(&f, &u, 4); return f; }
constexpr int NRSS = 3 * DEPTH + 1;
constexpr int NPOS = SEQ + DEC_SEQ;
constexpr int QGP = ((QGW + 255) / 256) * 256;
__host__ __device__ inline int pos_index(int pos) { return pos < SEQ ? pos : SEQ + (pos - PAST_LEN); }

constexpr size_t IMG_SEQ_BYTES = (size_t)BATCH * N_KV * (SEQ / 64) * 8192, IMG_CMP_BYTES = (size_t)BATCH * N_KV * (NBC_P / 64 > 0 ? NBC_P / 64 : 1) * 8192;
struct WsMap {
    size_t ctl, rss, rope, h, hb, act, xn, t2, actf, ub, bb, zb, t1, qn, qr, gates, ob, winrows, hid, kc, vc, pbuf, oc, os, sel, scorebuf,
           w_ain, w_aout, w_bin, w_bout, w_cin, w_cout, w_qg, w_o, w_kv, qnb, qrb, ksel, vsel, kwin, vwin, kci, vci, acs, hids, acp, hidp, w1t, w2t, part, end;
};
constexpr size_t al256(size_t b) { return (b + 255) / 256 * 256; }
constexpr size_t smax(size_t a, size_t b) { return a > b ? a : b; }
constexpr WsMap make_ws_map() {
    WsMap w{}; size_t off = 0;
#define TAKE(f, bytes) w.f = off; off += al256(bytes)
    TAKE(ctl, 65536); TAKE(rss, (size_t)NRSS * MT * 4);
    TAKE(rope, (size_t)NPOS * 16 * 4);
    TAKE(h, (size_t)MT * D_MODEL * 4); TAKE(hb, (size_t)MT * D_MODEL * 2); TAKE(act, (size_t)MT * D_FF * 2);
    TAKE(xn, (size_t)MT * D_MODEL * 4); TAKE(t2, (size_t)MT * D_MODEL * 4); TAKE(actf, (size_t)MT * D_MODEL * 4);
    TAKE(ub, (size_t)MT * D_MODEL * 2); TAKE(bb, (size_t)MT * D_MODEL * 2); TAKE(zb, (size_t)MT * D_MODEL * 2);
    TAKE(t1, smax((size_t)MT * 3 * D_MODEL * 4, (size_t)MT * KVW * 4));
    TAKE(qn, (size_t)MT * HDM * 4); TAKE(qr, (size_t)MT * HDM * 4); TAKE(gates, (size_t)MT * 3 * N_HEADS * 4); TAKE(ob, (size_t)MT * HDM * 2);
    TAKE(winrows, (size_t)MT * 2 * N_KV * HD * 4); TAKE(hid, (size_t)NSEQ * NBC_MAX * 2 * N_KV * CMP_HID * 4);
    TAKE(kc, (size_t)NSEQ * NBC_MAX * N_KV * HD * 4); TAKE(vc, (size_t)NSEQ * NBC_MAX * N_KV * HD * 4);
    TAKE(pbuf, (size_t)MT * N_HEADS * NBC_MAX * 4); TAKE(oc, (size_t)MT * HDM * 4); TAKE(os, (size_t)MT * HDM * 4);
    TAKE(sel, (size_t)MT * N_KV * N_SEL * 4); TAKE(scorebuf, (size_t)MT * N_KV * NBS_MAX * 4);
    TAKE(w_ain, (size_t)DEPTH * 2 * D_FF * D_MODEL * 2); TAKE(w_aout, (size_t)DEPTH * D_MODEL * D_FF * 2);
    TAKE(w_bin, (size_t)DEPTH * 2 * D_FF * D_MODEL * 2); TAKE(w_bout, (size_t)DEPTH * D_MODEL * D_FF * 2);
    TAKE(w_cin, (size_t)N_A * 3 * D_MODEL * D_MODEL * 2); TAKE(w_cout, (size_t)N_A * D_MODEL * D_MODEL * 2);
    TAKE(w_qg, (size_t)N_B * QGP * D_MODEL * 2); TAKE(w_o, (size_t)N_B * D_MODEL * HDM * 2); TAKE(w_kv, (size_t)KVW * D_MODEL * 2);
    TAKE(qnb, (size_t)MT * HDM * 2); TAKE(qrb, (size_t)MT * HDM * 2); TAKE(ksel, IMG_SEQ_BYTES); TAKE(vsel, IMG_SEQ_BYTES); TAKE(kwin, IMG_SEQ_BYTES); TAKE(vwin, IMG_SEQ_BYTES); TAKE(kci, IMG_CMP_BYTES); TAKE(vci, IMG_CMP_BYTES);
    TAKE(acs, (size_t)2 * DEC_BATCH * (PAST_LEN / L_CMP) * N_KV * L_CMP * HD * 2); TAKE(hids, (size_t)2 * DEC_BATCH * (PAST_LEN / L_CMP) * N_KV * CMP_HID * 2);
    TAKE(acp, (size_t)2 * BATCH * NBC_P * N_KV * L_CMP * HD * 2); TAKE(hidp, (size_t)2 * BATCH * NBC_P * N_KV * CMP_HID * 2); TAKE(w1t, (size_t)2 * CMP_HID * L_CMP * HD * 2); TAKE(w2t, (size_t)2 * HD * CMP_HID * 2); TAKE(part, (size_t)8 * MS * 3 * D_MODEL * 4);
#undef TAKE
    w.end = off; return w;
}
constexpr WsMap WSM = make_ws_map();
constexpr size_t WS_ZERO_BYTES = 65536 + (((size_t)NRSS * MT * 4 + 255) / 256 * 256);

enum { CM_PLAIN = 0, CM_PAIR = 1, CM_CONV = 2, CM_HEADS = 3 };
__host__ __device__ inline int colmap(int kind, int n, int aux) {
    const int pn = n / 256, c = n % 256;
    if (kind == CM_PLAIN) return n;
    if (kind == CM_PAIR) return (c >= 128 ? aux : 0) + pn * 128 + (c % 128);
    if (kind == CM_CONV) { if (n < 2 * D_MODEL) return (c >= 128 ? 2 * D_MODEL : D_MODEL) + pn * 128 + (c % 128); return n - 2 * D_MODEL; }
    if (n < aux * 64) { const int bj = c / 128, wc = (c % 128) / 32, r = c % 32; return (pn * 4 + wc) * 64 + 32 * bj + r; }
    return n;
}
__device__ inline void wconv_item(size_t i_, const float* src, int Nsrc, const float* gain, bf16_t* dst, int Nd, int K, int kind, int aux) {
    const int n = (int)(i_ % Nd), kb = (int)(i_ / Nd);
    const int col = colmap(kind, n, aux);
    bf16_t* d = dst + (size_t)n * K + (size_t)kb * 64;
    if (col < 0 || col >= Nsrc) { for (int k = 0; k < 64; ++k) d[k] = 0; return; }
    const float* s = src + (size_t)kb * 64 * Nsrc + col;
#pragma unroll 8
    for (int k = 0; k < 64; k += 2) {
        const float g0 = gain ? gain[kb * 64 + k] : 1.f, g1 = gain ? gain[kb * 64 + k + 1] : 1.f;
        const unsigned lo = f2bf(s[(size_t)k * Nsrc] * g0), hi = f2bf(s[(size_t)(k + 1) * Nsrc] * g1);
        *(unsigned*)(d + k) = lo | (hi << 16);
    }
}
__device__ inline void rope_item(size_t i_, float* rope) {
    const int pi = (int)(i_ / 8), f = (int)(i_ % 8);
    const int pos = pi < SEQ ? pi : PAST_LEN + (pi - SEQ);
    float c, s; rope_cs((float)pos * INV_FREQ[f], c, s);
    rope[pi * 16 + f] = c; rope[pi * 16 + 8 + f] = s;
}
__device__ inline void hinit_item(size_t i_, const float* xp, const float* xs, float* h, bf16_t* hb, float* rss0) {
    const int m = (int)i_; const float* x = m < MP ? xp + (size_t)m * D_MODEL : xs + (size_t)(m - MP) * D_MODEL;
    float s = 0.f;
    for (int k = 0; k < D_MODEL; ++k) { const float v = x[k]; s += v * v; h[(size_t)m * D_MODEL + k] = v; hb[(size_t)m * D_MODEL + k] = f2bf(v); }
    rss0[m] = s;
}
__device__ inline void hupd_item(size_t i_, float* h, const float* y, float coef, bf16_t* hb, float* rss) {
    const int m = (int)i_; float s = 0.f;
    for (int k = 0; k < D_MODEL; ++k) { const float v = h[(size_t)m * D_MODEL + k] + coef * y[(size_t)m * D_MODEL + k]; s += v * v; h[(size_t)m * D_MODEL + k] = v; hb[(size_t)m * D_MODEL + k] = f2bf(v); }
    rss[m] = s;
}
__device__ inline float dot_bf(const bf16_t* a, const bf16_t* b, int K) { float s = 0.f; for (int k = 0; k < K; ++k) s += bf2f(a[k]) * bf2f(b[k]); return s; }
__device__ inline float silu_f(float g) { return g / (1.0f + expf(-g)); }
__device__ inline void ref_ffn_in_item(size_t i_, const bf16_t* hb, const float* rss, const bf16_t* Bt, bf16_t* act) {
    const int m = (int)(i_ / D_FF), j = (int)(i_ % D_FF);
    const float rs = 1.0f / sqrtf(rss[m] / D_MODEL + EPS);
    const int ng = (j / 128) * 256 + (j % 128);
    const float g = rs * dot_bf(hb + (size_t)m * D_MODEL, Bt + (size_t)ng * D_MODEL, D_MODEL), u = rs * dot_bf(hb + (size_t)m * D_MODEL, Bt + (size_t)(ng + 128) * D_MODEL, D_MODEL);
    act[i_] = f2bf(silu_f(g) * u);
}
__device__ inline void ref_resid_row_item(size_t i_, const bf16_t* A, int K, const bf16_t* Bt, float coef, float* h, bf16_t* hb, float* rss_next, float* yout) {
    const int m = (int)i_; float s = 0.f;
    for (int c = 0; c < D_MODEL; ++c) {
        const float v = h[(size_t)m * D_MODEL + c] + coef * dot_bf(A + (size_t)m * K, Bt + (size_t)c * K, K);
        if (yout) { yout[(size_t)m * D_MODEL + c] = v; } else { h[(size_t)m * D_MODEL + c] = v; hb[(size_t)m * D_MODEL + c] = f2bf(v); s += v * v; }
    }
    if (!yout) rss_next[m] = s;
}

constexpr float QSCALE_F = 0.125f * 1.4426950408889634f;
__device__ inline void qconv_item(size_t i_, const float* qn, const float* qr, bf16_t* qnb, bf16_t* qrb) { qnb[i_] = f2bf(qn[i_] * QSCALE_F); qrb[i_] = f2bf(qr[i_] * QSCALE_F); }
__host__ __device__ inline size_t kimg_off(int kv, int d0) { return (size_t)(d0 >> 3) * 1024 + (size_t)kv * 16; }
__host__ __device__ inline size_t vimg_off(int kv, int d0) { return (size_t)(d0 >> 5) * 4096 + (size_t)(kv >> 3) * 512 + (size_t)(kv & 7) * 64 + (size_t)((d0 & 31) >> 3) * 16; }
__device__ inline void put_chunk(unsigned char* dst, const float* src) { bf16_t* d = (bf16_t*)dst; for (int k = 0; k < 8; ++k) d[k] = f2bf(src[k]); }
__device__ inline void kvimg_item(size_t i_, const float* out, const float* winrows, unsigned char* ksel, unsigned char* vsel, unsigned char* kwin, unsigned char* vwin) {
    const int c = (int)(i_ % 8), t = (int)((i_ / 8) % SEQ), g = (int)((i_ / (8 * (size_t)SEQ)) % N_KV), n = (int)(i_ / (8 * (size_t)SEQ * N_KV));
    const size_t base = (((size_t)n * N_KV + g) * (SEQ / 64) + t / 64) * 8192; const int kv = t % 64, d0 = 8 * c; const size_t m = (size_t)n * SEQ + t;
    put_chunk(ksel + base + kimg_off(kv, d0), out + O_KVP + ((m * 4 + 2) * N_KV + g) * HD + d0);
    put_chunk(vsel + base + vimg_off(kv, d0), out + O_KVP + ((m * 4 + 3) * N_KV + g) * HD + d0);
    put_chunk(kwin + base + kimg_off(kv, d0), winrows + ((m * 2 + 0) * N_KV + g) * HD + d0);
    put_chunk(vwin + base + vimg_off(kv, d0), winrows + ((m * 2 + 1) * N_KV + g) * HD + d0);
}
__device__ inline void kcimg_item(size_t i_, const float* kc, const float* vc, unsigned char* kci, unsigned char* vci) {
    const int c = (int)(i_ % 8), cb = (int)((i_ / 8) % NBC_P), g = (int)((i_ / (8 * (size_t)NBC_P)) % N_KV), n = (int)(i_ / (8 * (size_t)NBC_P * N_KV));
    const size_t base = (((size_t)n * N_KV + g) * (NBC_P / 64) + cb / 64) * 8192; const int kv = cb % 64, d0 = 8 * c;
    put_chunk(kci + base + kimg_off(kv, d0), kc + (((size_t)n * NBC_MAX + cb) * N_KV + g) * HD + d0);
    put_chunk(vci + base + vimg_off(kv, d0), vc + (((size_t)n * NBC_MAX + cb) * N_KV + g) * HD + d0);
}

constexpr int NBC_PAST = PAST_LEN / L_CMP;
constexpr int RS_CMP = DEC_BATCH * NBC_PAST * N_KV, RP_CMP = BATCH * NBC_P * N_KV;
__device__ inline void acmp_sample_item(size_t i_, const float* cache_kv, const int* page_table, const float* pe, bf16_t* A) {
    const int c8 = (int)(i_ % 8), l = (int)((i_ / 8) % L_CMP); const size_t rr = i_ / (8 * L_CMP); const int r = (int)(rr % RS_CMP), e = (int)(rr / RS_CMP);
    const int g = r % N_KV, c = (r / N_KV) % NBC_PAST, b = r / (N_KV * NBC_PAST), tok = c * L_CMP + l;
    const int page = page_table[b * N_PAGES + tok / PAGE_SIZE];
    const float* src = cache_kv + ((((size_t)page * PAGE_SIZE + tok % PAGE_SIZE) * 4 + e) * N_KV + g) * HD + 8 * c8; const float* pp = pe + ((size_t)e * L_CMP + l) * HD + 8 * c8;
    bf16_t* d = A + ((size_t)e * RS_CMP + r) * (L_CMP * HD) + l * HD + 8 * c8;
#ifndef CPU_TEST
    typedef float f4 __attribute__((ext_vector_type(4))); typedef unsigned u4 __attribute__((ext_vector_type(4)));
    const f4 a0 = __builtin_nontemporal_load((const f4*)src) + *(const f4*)pp, a1 = __builtin_nontemporal_load((const f4*)(src + 4)) + *(const f4*)(pp + 4);
    u4 w; w.x = (unsigned)f2bf(a0[0]) | ((unsigned)f2bf(a0[1]) << 16); w.y = (unsigned)f2bf(a0[2]) | ((unsigned)f2bf(a0[3]) << 16);
    w.z = (unsigned)f2bf(a1[0]) | ((unsigned)f2bf(a1[1]) << 16); w.w = (unsigned)f2bf(a1[2]) | ((unsigned)f2bf(a1[3]) << 16);
    *(u4*)d = w;
#else
    for (int k = 0; k < 8; ++k) d[k] = f2bf(src[k] + pp[k]);
#endif
}
__device__ inline void acmp_prompt_item(size_t i_, const float* out, const float* pe, bf16_t* A) {
    const int c8 = (int)(i_ % 8), l = (int)((i_ / 8) % L_CMP); const size_t rr = i_ / (8 * L_CMP); const int r = (int)(rr % RP_CMP), e = (int)(rr / RP_CMP);
    const int g = r % N_KV, c = (r / N_KV) % NBC_P, n = r / (N_KV * NBC_P), tok = c * L_CMP + l;
    const float* src = out + O_KVP + ((((size_t)n * SEQ + tok) * 4 + e) * N_KV + g) * HD + 8 * c8; const float* pp = pe + ((size_t)e * L_CMP + l) * HD + 8 * c8;
    bf16_t* d = A + ((size_t)e * RP_CMP + r) * (L_CMP * HD) + l * HD + 8 * c8;
    for (int k = 0; k < 8; ++k) d[k] = f2bf(src[k] + pp[k]);
}
__device__ inline void cmp_out_b_item(size_t i_, const bf16_t* hid, int R, int nbc, int seq0, const float* w2, const float* k_norm0, float* kc, float* vc) {
    const int r = (int)(i_ % R), e = (int)(i_ / R); const int g = r % N_KV, c = (r / N_KV) % nbc, sq = r / (N_KV * nbc);
    const bf16_t* hr = hid + ((size_t)e * R + r) * CMP_HID;
    float v[HD];
    for (int d = 0; d < HD; ++d) v[d] = 0.f;
    for (int f = 0; f < CMP_HID; ++f) { const float hf = bf2f(hr[f]); const float* w = w2 + ((size_t)e * CMP_HID + f) * HD; for (int d = 0; d < HD; ++d) v[d] += hf * w[d]; }
    if (e == 0) head_norm(v, k_norm0);
    float* o = (e == 0 ? kc : vc) + (((size_t)(seq0 + sq) * NBC_MAX + c) * N_KV + g) * HD;
    for (int d = 0; d < HD; ++d) o[d] = v[d];
}
__host__ __device__ inline int heads_row(int hidx, int d) { return (hidx / 4) * 256 + 128 * (d / 32) + 32 * (hidx % 4) + (d % 32); }
__device__ inline void conv_state_store(float* out, int layer, int m, int ch, float u) {
    const RowInfo ri = row_info(m); const int L = seq_len(ri.seq);
    if (ri.t >= L - 2) { const int j = ri.t - (L - 2);
        if (ri.seq < BATCH) out[O_CP + (((size_t)layer * BATCH + ri.seq) * 2 + j) * D_MODEL + ch] = u;
        else out[O_CS + (((size_t)layer * DEC_BATCH + (ri.seq - BATCH)) * 2 + j) * D_MODEL + ch] = u; }
}
__device__ inline void ref_conv_in_item(size_t i_, const bf16_t* hb, const float* rss, const bf16_t* Bt, bf16_t* ub, bf16_t* bb, float* out, int layer) {
    const int m = (int)(i_ / D_MODEL), j = (int)(i_ % D_MODEL);
    const float rs = 1.0f / sqrtf(rss[m] / D_MODEL + EPS); const bf16_t* a = hb + (size_t)m * D_MODEL;
    const int nc = (j / 128) * 256 + (j % 128);
    const float c = rs * dot_bf(a, Bt + (size_t)nc * D_MODEL, D_MODEL), x = rs * dot_bf(a, Bt + (size_t)(nc + 128) * D_MODEL, D_MODEL), b = rs * dot_bf(a, Bt + (size_t)(2 * D_MODEL + j) * D_MODEL, D_MODEL);
    const float u = c * x; ub[i_] = f2bf(u); bb[i_] = f2bf(b); conv_state_store(out, layer, m, j, u);
}
__device__ inline void conv_thin_item(size_t i_, const bf16_t* ub, const bf16_t* bb, const float* state  , const float* wc  , bf16_t* zb) {
    const int m = (int)(i_ / D_MODEL), ch = (int)(i_ % D_MODEL);
    const RowInfo ri = row_info(m);
    const float u0 = bf2f(ub[i_]);
    float u1, u2;
    if (ri.t >= 1) u1 = bf2f(ub[i_ - D_MODEL]); else u1 = (ri.seq < BATCH) ? 0.f : state[((size_t)(ri.seq - BATCH) * 2 + 1) * D_MODEL + ch];
    if (ri.t >= 2) u2 = bf2f(ub[i_ - 2 * D_MODEL]); else if (ri.seq < BATCH) u2 = 0.f;
    else u2 = (ri.t == 1) ? state[((size_t)(ri.seq - BATCH) * 2 + 1) * D_MODEL + ch] : state[((size_t)(ri.seq - BATCH) * 2 + 0) * D_MODEL + ch];
    zb[i_] = f2bf(bf2f(bb[i_]) * (wc[ch] * u2 + wc[D_MODEL + ch] * u1 + wc[2 * D_MODEL + ch] * u0));
}
__device__ inline void ref_qg_item(size_t i_, const bf16_t* hb, const float* rss, const bf16_t* Bt, const float* q_norm, const float* rope, float* qn, float* qr) {
    const int m = (int)(i_ / N_HEADS), hh = (int)(i_ % N_HEADS);
    const float rs = 1.0f / sqrtf(rss[m] / D_MODEL + EPS); const bf16_t* a = hb + (size_t)m * D_MODEL;
    float v[HD]; for (int d = 0; d < HD; ++d) v[d] = rs * dot_bf(a, Bt + (size_t)heads_row(hh, d) * D_MODEL, D_MODEL);
    head_norm(v, q_norm);
    for (int d = 0; d < HD; ++d) qn[(size_t)m * HDM + hh * HD + d] = v[d];
    const float* rt = rope + (size_t)pos_index(row_info(m).pos) * 16;
    for (int f = 0; f < 8; ++f) { const float x1 = v[f], x2 = v[8 + f]; v[f] = x1 * rt[f] - x2 * rt[8 + f]; v[8 + f] = x2 * rt[f] + x1 * rt[8 + f]; }
    for (int d = 0; d < HD; ++d) qr[(size_t)m * HDM + hh * HD + d] = v[d];
}
__device__ inline void ref_gates_item(size_t i_, const bf16_t* hb, const float* rss, const bf16_t* Bt, float* gates) {
    const int m = (int)(i_ / (3 * N_HEADS)), j = (int)(i_ % (3 * N_HEADS));
    const float rs = 1.0f / sqrtf(rss[m] / D_MODEL + EPS);
    const float x = rs * dot_bf(hb + (size_t)m * D_MODEL, Bt + (size_t)(HDM + j) * D_MODEL, D_MODEL);
    gates[i_] = 1.0f / (1.0f + expf(-x));
}
__device__ inline void kv_store(float* out, float* winrows, int m, int e, int g, int d, float v) {
    const RowInfo ri = row_info(m);
    if (e < 4) { if (ri.seq < BATCH) out[O_KVP + (((size_t)m * 4 + e) * N_KV + g) * HD + d] = v; else out[O_KVS + (((size_t)(m - MP) * 4 + e) * N_KV + g) * HD + d] = v; }
    else { const int we = e - 4;
        winrows[(((size_t)m * 2 + we) * N_KV + g) * HD + d] = v;
        if (ri.seq < BATCH) { if (ri.t >= SEQ - WINDOW) out[O_WP + ((((size_t)ri.seq * WINDOW + (ri.t - (SEQ - WINDOW))) * 2 + we) * N_KV + g) * HD + d] = v; }
        else out[O_WS + ((((size_t)(ri.seq - BATCH) * WINDOW + (WINDOW - DEC_SEQ + ri.t)) * 2 + we) * N_KV + g) * HD + d] = v; }
}
__device__ inline void ref_kv_item(size_t i_, const bf16_t* hb, const float* rss, const bf16_t* Bt, const float* k_norm, const float* rope, float* out, float* winrows) {
    const int m = (int)(i_ / (6 * N_KV)), hidx = (int)(i_ % (6 * N_KV)), e = hidx / N_KV, g = hidx % N_KV;
    const float rs = 1.0f / sqrtf(rss[m] / D_MODEL + EPS); const bf16_t* a = hb + (size_t)m * D_MODEL;
    float v[HD]; for (int d = 0; d < HD; ++d) v[d] = rs * dot_bf(a, Bt + (size_t)heads_row(hidx, d) * D_MODEL, D_MODEL);
    if (e == 2 || e == 4) { head_norm(v, k_norm + (e == 2 ? 1 : 2) * HD);
        const float* rt = rope + (size_t)pos_index(row_info(m).pos) * 16;
        for (int f = 0; f < 8; ++f) { const float x1 = v[f], x2 = v[8 + f]; v[f] = x1 * rt[f] - x2 * rt[8 + f]; v[8 + f] = x2 * rt[f] + x1 * rt[8 + f]; } }
    for (int d = 0; d < HD; ++d) kv_store(out, winrows, m, e, g, d, v[d]);
}
#ifndef CPU_TEST
#define LAS __attribute__((address_space(3)))
#define XB_TMO      128
#define XB_XCNT(j)  (256  + 64 * (j))
#define XB_XSUB(j)  (1280 + 64 * (j))
#define XB_XGEN(j)  (2304 + 64 * (j))
#define XB_TOP      3328
#define XB_TOPGEN   3392
#define XCD_BAR_WORDS 3456
#define XB_SPIN_CAP (1u << 25)
typedef __attribute__((address_space(1))) unsigned GU;
__device__ __forceinline__ unsigned xb_ld(GU* p)              { return __hip_atomic_load(p, __ATOMIC_RELAXED, __HIP_MEMORY_SCOPE_AGENT); }
__device__ __forceinline__ unsigned xb_add(GU* p, unsigned v) { return __hip_atomic_fetch_add(p, v, __ATOMIC_RELAXED, __HIP_MEMORY_SCOPE_AGENT); }
__device__ __forceinline__ unsigned xb_xcc_id() { return (unsigned)__builtin_amdgcn_s_getreg((3 << 11) | 20) & 0xFu; }
#define XB_SPIN(cond, bar) do { unsigned _sp = 0; while (cond) { __builtin_amdgcn_s_sleep(1); \
    if ((++_sp & 255u) == 0u) { if (xb_ld(&(bar)[XB_TMO])) break; if (_sp > XB_SPIN_CAP) { (void)xb_add(&(bar)[XB_TMO], 1u); break; } } } } while (0)
struct XcdBarrier { GU* bar; unsigned x; volatile LAS unsigned* st; };
__device__ __forceinline__ XcdBarrier xcd_barrier_post(GU* bar, volatile LAS unsigned* st, const bool leader_thread) {
    XcdBarrier b; b.bar = bar; b.x = xb_xcc_id(); b.st = st;
    if (leader_thread) (void)xb_add(&bar[XB_XCNT(b.x)], 1u);
    return b;
}
__device__ __forceinline__ void xcd_barrier_complete(GU* bar, unsigned x, unsigned& nloc, unsigned& nx) {
    const unsigned G = gridDim.x * gridDim.y * gridDim.z;
    unsigned sum, cnt, mine, sp = 0u;
    for (;;) {
        sum = 0u; cnt = 0u; mine = 0u;
#pragma unroll
        for (unsigned j = 0; j < 16; ++j) { const unsigned c = xb_ld(&bar[XB_XCNT(j)]); sum += c; cnt += (c > 0u) ? 1u : 0u; mine = (j == x) ? c : mine; }
        if (sum == G) break;
        __builtin_amdgcn_s_sleep(1);
        if ((++sp & 255u) == 0u) { if (xb_ld(&bar[XB_TMO])) break; if (sp > XB_SPIN_CAP) { (void)xb_add(&bar[XB_TMO], 1u); break; } }
    }
    nloc = mine > 0u ? mine : 1u; nx = cnt > 0u ? cnt : 1u;
}
__device__ __forceinline__ void xcd_barrier(const XcdBarrier& b, const bool leader_thread) {
    asm volatile("s_waitcnt vmcnt(0)" ::: "memory");
    __syncthreads();
    if (leader_thread) {
        GU* bar = b.bar; unsigned bx = xb_xcc_id(); asm volatile("" : "+s"(bx));
        __builtin_amdgcn_s_waitcnt(0);
        unsigned nloc = b.st[0], nx = b.st[1];
        if (nloc == 0u) { xcd_barrier_complete(bar, bx, nloc, nx); b.st[0] = nloc; b.st[1] = nx; }
        const unsigned old = xb_add(&bar[XB_XSUB(bx)], 1u);
        const unsigned gen = old / nloc;
        if (old + 1u == (gen + 1u) * nloc) {
            __builtin_amdgcn_fence(__ATOMIC_RELEASE, "agent");
            asm volatile("s_waitcnt vmcnt(0)" ::: "memory");
            const unsigned og = xb_add(&bar[XB_TOP], 1u);
            const unsigned tg = og / nx;
            if (og + 1u == (tg + 1u) * nx) xb_add(&bar[XB_TOPGEN], 1u);
            else XB_SPIN(xb_ld(&bar[XB_TOPGEN]) == tg, bar);
            __builtin_amdgcn_fence(__ATOMIC_ACQUIRE, "agent");
            xb_add(&bar[XB_XGEN(bx)], 1u);
            asm volatile("s_waitcnt vmcnt(0)" ::: "memory");
        } else {
            XB_SPIN(xb_ld(&bar[XB_XGEN(bx)]) == gen, bar);
            __builtin_amdgcn_fence(__ATOMIC_ACQUIRE, "agent");
            asm volatile("s_waitcnt vmcnt(0)" ::: "memory");
        }
    }
    __syncthreads();
}

namespace pg8 {
#define PG8_LAS __attribute__((address_space(3)))
typedef unsigned short bf16_t;
typedef short bf16x8 __attribute__((ext_vector_type(8)));
typedef float f32x4 __attribute__((ext_vector_type(4)));
typedef unsigned u32x4 __attribute__((ext_vector_type(4)));
constexpr int BM = 256, BK = 64, HALF = 128, HTB = HALF * BK * 2  , STAGE_BYTES = 8 * HTB, NXCD = 8, WGM = 8;

__host__ __device__ __forceinline__ int lds_byte(int r, int c) { const int st = (r >> 4) * 2 + (c >> 5), rr = r & 15, cc = c & 31, ob = rr * 64 + cc * 2; return st * 1024 + (ob ^ (((ob >> 9) & 1) << 5)); }
__host__ __device__ __forceinline__ void stage_rc(int b, int& R, int& C) { const int st = b / 1024, sb = b % 1024, swz = sb ^ (((sb >> 9) & 1) << 5); R = (st >> 1) * 16 + swz / 64; C = (st & 1) * 32 + (swz % 64) / 2; }
__host__ __device__ __forceinline__ int perm32(int rho) { const int n = rho >> 4, i = rho & 15; return 8 * (i >> 2) + 4 * n + (i & 3); }

struct Unit { int pm, pn; };
struct Gemm { const bf16_t* A; const bf16_t* Bt; int M, N, K; };

struct StaticOrder {
    int nM, nN, nwg, G, c;
    __host__ __device__ void init(int M, int N, int G_, int c_) { nM = M / BM; nN = N / BM; nwg = nM * nN; G = G_; c = c_; }
    __host__ __device__ bool next(int i, Unit& u) const {
        const long L = (long)i * G + c; if (L >= nwg) return false;
        int wgid = (int)L; { const int q = nwg / NXCD, r = nwg % NXCD, xcd = wgid % NXCD, off = wgid / NXCD; wgid = (xcd < r ? xcd * (q + 1) : r * (q + 1) + (xcd - r) * q) + off; }
        const int nig = WGM * nN, gid = wgid / nig, fm = gid * WGM, gsz = (nM - fm) < WGM ? (nM - fm) : WGM;
        u.pm = fm + ((wgid % nig) % gsz); u.pn = (wgid % nig) / gsz; return true;
    }
    __device__ __forceinline__ void a_ready(const Unit&) const {}
    __device__ __forceinline__ void done(const Unit&) const {}
};

__device__ __forceinline__ unsigned cvt_pk_bf16(float lo, float hi) { unsigned r; asm volatile("v_cvt_pk_bf16_f32 %0, %1, %2" : "=v"(r) : "v"(lo), "v"(hi)); return r; }
template <class Epi, class Sched, bool ALIGN_EPI = false, bool SP2 = false>
__device__ __forceinline__ void gemm_phase(int wave_id_, PG8_LAS unsigned char* lds, const Gemm g, const Sched& S, const Epi& E) {
    int wid = wave_id_, lane = (int)lane_id_v(); asm volatile("" : "+s"(wid));
    const int tid = wid * 64 + lane, wr = wid >> 2, wc = wid & 3, fr = lane & 15, fq = lane >> 4;
    const int K = g.K, nt = K / BK;
    unsigned voffA[2], voffB[2];
#pragma unroll
    for (int i = 0; i < 2; ++i) { int R, C; stage_rc(tid * 16 + i * 8192, R, C); const int Rb = Epi::PERM ? ((R & ~31) + perm32(R & 31)) : R;
        voffA[i] = (unsigned)(R * K + C) * 2u; voffB[i] = (unsigned)(Rb * K + C) * 2u; }
    const size_t kstep = (size_t)(BK * 2);
    const size_t hstep = (size_t)HALF * K * 2;
    const size_t tstep = 2 * hstep;
    const unsigned ldsw = (unsigned)wid * 1024u;
    const int aoff = lds_byte(wr * 64 + fr, fq * 8), boff = lds_byte(wc * 32 + fr, fq * 8);
#define PG8_SA(b, h) (((b) * 2 + (h)) * HTB)
#define PG8_SB(b, h) ((4 + (b) * 2 + (h)) * HTB)
#define PG8_STAGE(bufoff, gbase, voff) do { _Pragma("unroll") for (int _i = 0; _i < 2; ++_i) \
        __builtin_amdgcn_global_load_lds((const unsigned*)((const char*)(gbase) + (voff)[_i]), (PG8_LAS unsigned*)(lds + (bufoff) + ldsw + _i * 8192), 16, 0, 0); } while (0)
#define PG8_LDA(dst, b, h) do { _Pragma("unroll") for (int m = 0; m < 4; ++m) _Pragma("unroll") for (int k = 0; k < 2; ++k) dst[m][k] = *(const PG8_LAS bf16x8*)(lds + PG8_SA(b, h) + aoff + m * 2048 + k * 1024); } while (0)
#define PG8_LDB(dst, b, h) do { _Pragma("unroll") for (int n = 0; n < 2; ++n) _Pragma("unroll") for (int k = 0; k < 2; ++k) dst[n][k] = *(const PG8_LAS bf16x8*)(lds + PG8_SB(b, h) + boff + n * 2048 + k * 1024); } while (0)
#define PG8_MMA(ai, bj, At, Bt) do { __builtin_amdgcn_s_setprio(1); _Pragma("unroll") for (int m = 0; m < 4; ++m) _Pragma("unroll") for (int n = 0; n < 2; ++n) _Pragma("unroll") for (int k = 0; k < 2; ++k) \
        acc[ai][bj][m][n] = __builtin_amdgcn_mfma_f32_16x16x32_bf16(Bt[n][k], At[m][k], acc[ai][bj][m][n], 0, 0, 0); __builtin_amdgcn_s_setprio(0); } while (0)
#define PG8_WAIT_V(n) asm volatile("s_waitcnt vmcnt(" #n ")" ::: "memory")
#define PG8_WAIT_L(n) asm volatile("s_waitcnt lgkmcnt(" #n ")" ::: "memory")
#define PG8_BAR __builtin_amdgcn_s_barrier()
#define PG8_SCHED __builtin_amdgcn_sched_barrier(0)
    Unit cur, nxt; int ui = 0;
    if (!S.next(0, cur)) return;
    f32x4 acc[2][2][4][2];
#pragma unroll
    for (int a = 0; a < 2; ++a)
#pragma unroll
        for (int b = 0; b < 2; ++b)
#pragma unroll
            for (int m = 0; m < 4; ++m)
#pragma unroll
                for (int n = 0; n < 2; ++n) acc[a][b][m][n] = (f32x4){0.f, 0.f, 0.f, 0.f};
    bf16x8 At[4][2], B0[2][2], B1[2][2];
    const char* cA = (const char*)g.A + (size_t)cur.pm * tstep; const char* cB = (const char*)g.Bt + (size_t)cur.pn * tstep;
    S.a_ready(cur);
    if constexpr (SP2) {
        PG8_STAGE(PG8_SB(0, 0), cB, voffB); PG8_STAGE(PG8_SB(0, 1), cB + hstep, voffB); PG8_STAGE(PG8_SA(0, 0), cA, voffA); PG8_STAGE(PG8_SA(0, 1), cA + hstep, voffA);
        if (wr == 1) PG8_BAR;
        PG8_WAIT_V(2); PG8_BAR;
        PG8_STAGE(PG8_SB(1, 0), cB + kstep, voffB); PG8_STAGE(PG8_SA(1, 0), cA + kstep, voffA); PG8_STAGE(PG8_SB(1, 1), cB + hstep + kstep, voffB);
        PG8_WAIT_V(6); PG8_BAR;
    } else {
        PG8_STAGE(PG8_SB(0, 0), cB, voffB); PG8_STAGE(PG8_SA(0, 0), cA, voffA); PG8_STAGE(PG8_SB(0, 1), cB + hstep, voffB); PG8_STAGE(PG8_SA(0, 1), cA + hstep, voffA);
        if (wr == 1) PG8_BAR;
        PG8_WAIT_V(4); PG8_BAR;
        PG8_STAGE(PG8_SB(1, 0), cB + kstep, voffB); PG8_STAGE(PG8_SA(1, 0), cA + kstep, voffA); PG8_STAGE(PG8_SB(1, 1), cB + hstep + kstep, voffB);
        PG8_WAIT_V(6); PG8_BAR;
    }
    for (;;) {
        const bool has_next = S.next(ui + 1, nxt);
        const char* nA = has_next ? (const char*)g.A + (size_t)nxt.pm * tstep : cA; const char* nB = has_next ? (const char*)g.Bt + (size_t)nxt.pn * tstep : cB;
        for (int t = 0; t < nt; t += 2) {
            const bool last = (t == nt - 2);
            const char* a1 = cA + (size_t)(t + 1) * kstep;
            const char* a2 = last ? nA : cA + (size_t)(t + 2) * kstep; const char* b2 = last ? nB : cB + (size_t)(t + 2) * kstep;
            const char* a3 = a2 + kstep; const char* b3 = b2 + kstep;
            if (last && has_next) S.a_ready(nxt);
            if constexpr (SP2) {
            PG8_LDB(B0, 0, 0); PG8_LDB(B1, 0, 1); PG8_SCHED; PG8_LDA(At, 0, 0); PG8_STAGE(PG8_SA(1, 1), a1 + hstep, voffA);
            PG8_WAIT_V(8); PG8_WAIT_L(0); PG8_BAR; PG8_MMA(0, 0, At, B0); PG8_MMA(0, 1, At, B1); PG8_BAR; PG8_SCHED;
            PG8_LDA(At, 0, 1); PG8_STAGE(PG8_SB(0, 0), b2, voffB); PG8_STAGE(PG8_SB(0, 1), b2 + hstep, voffB); PG8_STAGE(PG8_SA(0, 0), a2, voffA);
            PG8_WAIT_V(8); PG8_WAIT_L(0); PG8_BAR; PG8_MMA(1, 0, At, B0); PG8_MMA(1, 1, At, B1); PG8_BAR; PG8_SCHED;
            PG8_LDB(B0, 1, 0); PG8_LDB(B1, 1, 1); PG8_SCHED; PG8_LDA(At, 1, 0); PG8_STAGE(PG8_SA(0, 1), a2 + hstep, voffA);
            PG8_WAIT_V(8); PG8_WAIT_L(0); PG8_BAR; PG8_MMA(0, 0, At, B0); PG8_MMA(0, 1, At, B1); PG8_BAR; PG8_SCHED;
            PG8_LDA(At, 1, 1); PG8_STAGE(PG8_SB(1, 0), b3, voffB); PG8_STAGE(PG8_SB(1, 1), b3 + hstep, voffB); PG8_STAGE(PG8_SA(1, 0), a3, voffA);
            PG8_WAIT_V(8); PG8_WAIT_L(0); PG8_BAR; PG8_MMA(1, 0, At, B0); PG8_MMA(1, 1, At, B1); PG8_BAR; PG8_SCHED;
            } else {
            PG8_LDB(B0, 0, 0); PG8_SCHED; PG8_LDA(At, 0, 0); PG8_STAGE(PG8_SA(1, 1), a1 + hstep, voffA);
            PG8_WAIT_L(8); PG8_BAR; PG8_WAIT_L(0); PG8_MMA(0, 0, At, B0); PG8_BAR; PG8_SCHED;
            PG8_LDB(B1, 0, 1); PG8_STAGE(PG8_SB(0, 0), b2, voffB);
            PG8_BAR; PG8_WAIT_L(0); PG8_MMA(0, 1, At, B1); PG8_BAR;
            PG8_LDA(At, 0, 1); PG8_STAGE(PG8_SA(0, 0), a2, voffA);
            PG8_BAR; PG8_WAIT_L(0); PG8_MMA(1, 0, At, B0); PG8_BAR; PG8_SCHED;
            PG8_STAGE(PG8_SB(0, 1), b2 + hstep, voffB);
            PG8_WAIT_V(6); PG8_BAR; PG8_MMA(1, 1, At, B1); PG8_BAR;
            PG8_LDB(B0, 1, 0); PG8_SCHED; PG8_LDA(At, 1, 0); PG8_STAGE(PG8_SA(0, 1), a2 + hstep, voffA);
            PG8_WAIT_L(8); PG8_BAR; PG8_WAIT_L(0); PG8_MMA(0, 0, At, B0); PG8_BAR; PG8_SCHED;
            PG8_LDB(B1, 1, 1); PG8_STAGE(PG8_SB(1, 0), b3, voffB);
            PG8_BAR; PG8_WAIT_L(0); PG8_MMA(0, 1, At, B1); PG8_BAR;
            PG8_LDA(At, 1, 1); PG8_STAGE(PG8_SA(1, 0), a3, voffA);
            PG8_BAR; PG8_WAIT_L(0); PG8_MMA(1, 0, At, B0); PG8_BAR; PG8_SCHED;
            PG8_STAGE(PG8_SB(1, 1), b3 + hstep, voffB);
            PG8_WAIT_V(6); PG8_BAR; PG8_MMA(1, 1, At, B1); PG8_BAR;
            }
        }
        if constexpr (ALIGN_EPI) { if (wr == 0) PG8_BAR; }
        if constexpr (!Epi::AFTER_DRAIN) { E(acc, cur, wr, wc, fr, fq); S.done(cur); }
        if (!has_next) break;
#pragma unroll
        for (int a = 0; a < 2; ++a)
#pragma unroll
            for (int b = 0; b < 2; ++b)
#pragma unroll
                for (int m = 0; m < 4; ++m)
#pragma unroll
                    for (int n = 0; n < 2; ++n) acc[a][b][m][n] = (f32x4){0.f, 0.f, 0.f, 0.f};
        cur = nxt; cA = nA; cB = nB; ++ui;
        if constexpr (ALIGN_EPI) { if (wr == 1) PG8_BAR; }
    }
    PG8_WAIT_V(0);
    if constexpr (!ALIGN_EPI) { if (wr == 0) PG8_BAR; }
    PG8_BAR;
    if constexpr (Epi::AFTER_DRAIN) { E.fused(acc, cur, wr, wc, fr, fq, lds, wid, lane); S.done(cur); }
#undef PG8_SA
#undef PG8_SB
#undef PG8_STAGE
#undef PG8_LDA
#undef PG8_LDB
#undef PG8_MMA
#undef PG8_WAIT_V
#undef PG8_WAIT_L
#undef PG8_BAR
#undef PG8_SCHED
}
}

namespace pg8 {
__device__ __forceinline__ float fast_silu(float g) { return g * __builtin_amdgcn_rcpf(1.0f + __expf(-g)); }
__device__ __forceinline__ float row_rs(const float* rss, int row) { return rsqrtf(rss[row] * (1.0f / D_MODEL) + EPS); }
struct EpiSwiglu {
    static constexpr bool PERM = true, AFTER_DRAIN = false;
    bf16_t* act; const float* rss;
    __device__ __forceinline__ void operator()(const f32x4 (&acc)[2][2][4][2], const Unit& u, int wr, int wc, int fr, int fq) const {
        const int row0 = u.pm * BM + wr * 64 + fr, col0 = u.pn * 128 + wc * 32 + 8 * fq;
#pragma unroll
        for (int ai = 0; ai < 2; ++ai)
#pragma unroll
            for (int m = 0; m < 4; ++m) {
                const int row = row0 + ai * HALF + m * 16; const float rs = row_rs(rss, row);
                float a[8];
#pragma unroll
                for (int n = 0; n < 2; ++n)
#pragma unroll
                    for (int i = 0; i < 4; ++i) a[n * 4 + i] = fast_silu(acc[ai][0][m][n][i] * rs) * (acc[ai][1][m][n][i] * rs);
                u32x4 w; w.x = cvt_pk_bf16(a[0], a[1]); w.y = cvt_pk_bf16(a[2], a[3]); w.z = cvt_pk_bf16(a[4], a[5]); w.w = cvt_pk_bf16(a[6], a[7]);
                *(u32x4*)(act + (size_t)row * D_FF + col0) = w;
            }
    }
};
struct EpiResid {
    static constexpr bool PERM = false, AFTER_DRAIN = false;
    float* h; bf16_t* hb; float* rss_next; float* yout; float coef;
    __device__ __forceinline__ void operator()(const f32x4 (&acc)[2][2][4][2], const Unit& u, int wr, int wc, int fr, int fq) const {
        const int row0 = u.pm * BM + wr * 64 + fr, col0 = u.pn * BM + wc * 32 + 4 * fq;
#pragma unroll
        for (int ai = 0; ai < 2; ++ai)
#pragma unroll
            for (int m = 0; m < 4; ++m) {
                const int row = row0 + ai * HALF + m * 16; float s = 0.f;
                float* hr = h + (size_t)row * D_MODEL + col0;
#pragma unroll
                for (int bj = 0; bj < 2; ++bj)
#pragma unroll
                    for (int n = 0; n < 2; ++n) {
                        const int co = bj * HALF + n * 16;
                        const f32x4 v = *(const f32x4*)(hr + co) + acc[ai][bj][m][n] * coef;
                        if (yout) { *(f32x4*)(yout + (size_t)row * D_MODEL + col0 + co) = v; }
                        else {
                            *(f32x4*)(hr + co) = v;
                            typedef unsigned u32x2 __attribute__((ext_vector_type(2)));
                            u32x2 w; w.x = cvt_pk_bf16(v[0], v[1]); w.y = cvt_pk_bf16(v[2], v[3]);
                            *(u32x2*)(hb + (size_t)row * D_MODEL + col0 + co) = w;
                            s += (v[0] * v[0] + v[1] * v[1]) + (v[2] * v[2] + v[3] * v[3]);
                        }
                    }
                if (!yout) { s += __shfl_xor(s, 16); s += __shfl_xor(s, 32); if (fq == 0) (void)__hip_atomic_fetch_add(rss_next + row, s, __ATOMIC_RELAXED, __HIP_MEMORY_SCOPE_AGENT); }
            }
    }
};
}
namespace pg8 {
__device__ __forceinline__ float sum4(f32x4 v) { return (v[0] * v[0] + v[1] * v[1]) + (v[2] * v[2] + v[3] * v[3]); }
struct EpiConvIn {
    static constexpr bool PERM = true, AFTER_DRAIN = false;
    bf16_t* ub; bf16_t* bb; const float* rss; float* out; int layer;
    __device__ __forceinline__ void operator()(const f32x4 (&acc)[2][2][4][2], const Unit& u, int wr, int wc, int fr, int fq) const {
        const int row0 = u.pm * BM + wr * 64 + fr;
        const bool pair = u.pn < D_MODEL / 128;
#pragma unroll
        for (int ai = 0; ai < 2; ++ai)
#pragma unroll
            for (int m = 0; m < 4; ++m) {
                const int row = row0 + ai * HALF + m * 16; const float rs = row_rs(rss, row);
                if (pair) {
                    const int col0 = u.pn * 128 + wc * 32 + 8 * fq; float a[8];
#pragma unroll
                    for (int n = 0; n < 2; ++n)
#pragma unroll
                        for (int i = 0; i < 4; ++i) a[n * 4 + i] = (acc[ai][0][m][n][i] * rs) * (acc[ai][1][m][n][i] * rs);
                    u32x4 w; w.x = cvt_pk_bf16(a[0], a[1]); w.y = cvt_pk_bf16(a[2], a[3]); w.z = cvt_pk_bf16(a[4], a[5]); w.w = cvt_pk_bf16(a[6], a[7]);
                    *(u32x4*)(ub + (size_t)row * D_MODEL + col0) = w;
                    const RowInfo ri = row_info(row); const int jj = ri.t - (seq_len(ri.seq) - 2);
                    if (jj >= 0) {
                        float* cs = (ri.seq < BATCH) ? out + O_CP + (((size_t)layer * BATCH + ri.seq) * 2 + jj) * D_MODEL + col0 : out + O_CS + (((size_t)layer * DEC_BATCH + (ri.seq - BATCH)) * 2 + jj) * D_MODEL + col0;
                        *(f32x4*)(cs) = (f32x4){a[0], a[1], a[2], a[3]}; *(f32x4*)(cs + 4) = (f32x4){a[4], a[5], a[6], a[7]};
                    }
                } else {
#pragma unroll
                    for (int bj = 0; bj < 2; ++bj) {
                        const int col0 = (u.pn - D_MODEL / 128) * 256 + bj * HALF + wc * 32 + 8 * fq;
                        const f32x4 v0 = acc[ai][bj][m][0] * rs, v1 = acc[ai][bj][m][1] * rs;
                        u32x4 w; w.x = cvt_pk_bf16(v0[0], v0[1]); w.y = cvt_pk_bf16(v0[2], v0[3]); w.z = cvt_pk_bf16(v1[0], v1[1]); w.w = cvt_pk_bf16(v1[2], v1[3]);
                        *(u32x4*)(bb + (size_t)row * D_MODEL + col0) = w;
                    }
                }
                asm volatile("" ::: "memory");
            }
    }
};
__device__ __forceinline__ void head_norm_rope(f32x4 (&v)[2][2], const float* gain, const float* rt  , int fq, bool do_norm, bool do_rope, f32x4 (&rot0)[2]) {
    if (do_norm) {
        float ss = (sum4(v[0][0]) + sum4(v[0][1])) + (sum4(v[1][0]) + sum4(v[1][1]));
        ss += __shfl_xor(ss, 16); ss += __shfl_xor(ss, 32);
        const float r = rsqrtf(ss * (1.0f / HD) + EPS);
#pragma unroll
        for (int bj = 0; bj < 2; ++bj)
#pragma unroll
            for (int n = 0; n < 2; ++n) { const f32x4 g = *(const f32x4*)(gain + 32 * bj + 8 * fq + 4 * n); v[bj][n] = v[bj][n] * r * g; }
    }
    rot0[0] = v[0][0]; rot0[1] = v[0][1];
    if (do_rope) {
#pragma unroll
        for (int n = 0; n < 2; ++n) {
            f32x4 p;
#pragma unroll
            for (int i = 0; i < 4; ++i) p[i] = __shfl_xor(v[0][n][i], 16);
            const f32x4 c = *(const f32x4*)(rt + 4 * n), s = *(const f32x4*)(rt + 8 + 4 * n);
            if (fq == 0) rot0[n] = v[0][n] * c - p * s; else if (fq == 1) rot0[n] = v[0][n] * c + p * s;
        }
    }
}
__device__ __forceinline__ u32x4 pack8(const f32x4 a, const f32x4 b, float sc) { u32x4 w; w.x = cvt_pk_bf16(a[0] * sc, a[1] * sc); w.y = cvt_pk_bf16(a[2] * sc, a[3] * sc); w.z = cvt_pk_bf16(b[0] * sc, b[1] * sc); w.w = cvt_pk_bf16(b[2] * sc, b[3] * sc); return w; }
struct EpiQG {
    static constexpr bool PERM = true, AFTER_DRAIN = false;
    bf16_t* qnb; bf16_t* qrb; float* gates; const float* rss; const float* q_norm; const float* rope;
    __device__ __forceinline__ void operator()(const f32x4 (&acc)[2][2][4][2], const Unit& u, int wr, int wc, int fr, int fq) const {
        const int row0 = u.pm * BM + wr * 64 + fr;
#pragma unroll
        for (int ai = 0; ai < 2; ++ai)
#pragma unroll
            for (int m = 0; m < 4; ++m) {
                const int row = row0 + ai * HALF + m * 16; const float rs = row_rs(rss, row);
                if (u.pn < N_HEADS / 4) {
                    const int hh = u.pn * 4 + wc;
                    f32x4 v[2][2] = {{acc[ai][0][m][0] * rs, acc[ai][0][m][1] * rs}, {acc[ai][1][m][0] * rs, acc[ai][1][m][1] * rs}}; f32x4 rot0[2];
                    head_norm_rope(v, q_norm, rope + (size_t)pos_index(row_info(row).pos) * 16, fq, true, true, rot0);
                    const size_t o = (size_t)row * HDM + hh * HD + 8 * fq;
                    const u32x4 hi8 = pack8(v[1][0], v[1][1], QSCALE_F);
                    *(u32x4*)(qnb + o) = pack8(v[0][0], v[0][1], QSCALE_F); *(u32x4*)(qnb + o + 32) = hi8;
                    *(u32x4*)(qrb + o) = pack8(rot0[0], rot0[1], QSCALE_F); *(u32x4*)(qrb + o + 32) = hi8;
                } else {
                    const int c0 = wc * 32 + 8 * fq;
#pragma unroll
                    for (int n = 0; n < 2; ++n)
#pragma unroll
                        for (int i = 0; i < 4; ++i) { const int c = c0 + 4 * n + i; if (c < 3 * N_HEADS) gates[(size_t)row * 3 * N_HEADS + c] = __builtin_amdgcn_rcpf(1.0f + __expf(-(acc[ai][0][m][n][i] * rs))); }
                }
                asm volatile("" ::: "memory");
            }
    }
};
struct EpiKV {
    static constexpr bool PERM = true, AFTER_DRAIN = false;
    float* out; float* winrows; const float* rss; const float* k_norm; const float* rope;
    unsigned char* ksel; unsigned char* vsel; unsigned char* kwin; unsigned char* vwin; bf16_t* acp; const float* pe;
    __device__ __forceinline__ void operator()(const f32x4 (&acc)[2][2][4][2], const Unit& u, int wr, int wc, int fr, int fq) const {
        const int row0 = u.pm * BM + wr * 64 + fr;
        const int hidx = u.pn * 4 + wc, e = hidx / N_KV, g = hidx % N_KV; const bool nr = (e == 2 || e == 4);
#pragma unroll
        for (int ai = 0; ai < 2; ++ai)
#pragma unroll
            for (int m = 0; m < 4; ++m) {
                const int row = row0 + ai * HALF + m * 16; const float rs = row_rs(rss, row);
                const RowInfo ri = row_info(row);
                f32x4 v[2][2] = {{acc[ai][0][m][0] * rs, acc[ai][0][m][1] * rs}, {acc[ai][1][m][0] * rs, acc[ai][1][m][1] * rs}}; f32x4 rot0[2];
                head_norm_rope(v, k_norm + (e == 2 ? 1 : 2) * HD, rope + (size_t)pos_index(ri.pos) * 16, fq, nr, nr, rot0);
                float* d0; float* d1 = nullptr;
                if (e < 4) d0 = (ri.seq < BATCH) ? out + O_KVP + (((size_t)row * 4 + e) * N_KV + g) * HD : out + O_KVS + (((size_t)(row - MP) * 4 + e) * N_KV + g) * HD;
                else { const int we = e - 4; d0 = winrows + (((size_t)row * 2 + we) * N_KV + g) * HD;
                    if (ri.seq < BATCH) { if (ri.t >= SEQ - WINDOW) d1 = out + O_WP + ((((size_t)ri.seq * WINDOW + (ri.t - (SEQ - WINDOW))) * 2 + we) * N_KV + g) * HD; }
                    else d1 = out + O_WS + ((((size_t)(ri.seq - BATCH) * WINDOW + (WINDOW - DEC_SEQ + ri.t)) * 2 + we) * N_KV + g) * HD; }
                d0 += 8 * fq; *(f32x4*)(d0) = rot0[0]; *(f32x4*)(d0 + 4) = rot0[1]; *(f32x4*)(d0 + 32) = v[1][0]; *(f32x4*)(d0 + 36) = v[1][1];
                if (d1) { d1 += 8 * fq; *(f32x4*)(d1) = rot0[0]; *(f32x4*)(d1 + 4) = rot0[1]; *(f32x4*)(d1 + 32) = v[1][0]; *(f32x4*)(d1 + 36) = v[1][1]; }
                if (ri.seq < BATCH) {
                    if (e >= 2) {
                        unsigned char* img = (e == 2 ? ksel : e == 3 ? vsel : e == 4 ? kwin : vwin) + (((size_t)ri.seq * N_KV + g) * (SEQ / 64) + ri.t / 64) * 8192; const int kv = ri.t % 64;
                        const size_t o0 = (e & 1) ? vimg_off(kv, 8 * fq) : kimg_off(kv, 8 * fq), o1 = (e & 1) ? vimg_off(kv, 32 + 8 * fq) : kimg_off(kv, 32 + 8 * fq);
                        *(u32x4*)(img + o0) = pack8(rot0[0], rot0[1], 1.0f); *(u32x4*)(img + o1) = pack8(v[1][0], v[1][1], 1.0f);
                    } else {
                        const int c = ri.t / L_CMP, l = ri.t % L_CMP; const int r = (ri.seq * NBC_P + c) * N_KV + g;
                        bf16_t* ap = acp + ((size_t)e * RP_CMP + r) * (L_CMP * HD) + l * HD + 8 * fq; const float* pp = pe + ((size_t)e * L_CMP + l) * HD + 8 * fq;
                        *(u32x4*)(ap) = pack8(rot0[0] + *(const f32x4*)(pp), rot0[1] + *(const f32x4*)(pp + 4), 1.0f);
                        *(u32x4*)(ap + 32) = pack8(v[1][0] + *(const f32x4*)(pp + 32), v[1][1] + *(const f32x4*)(pp + 36), 1.0f);
                    }
                }
                asm volatile("" ::: "memory");
            }
    }
};
}

namespace pg8 {
struct EpiGelu {
    static constexpr bool PERM = true, AFTER_DRAIN = false;
    bf16_t* hid;
    __device__ __forceinline__ void operator()(const f32x4 (&acc)[2][2][4][2], const Unit& u, int wr, int wc, int fr, int fq) const {
        const int row0 = u.pm * BM + wr * 64 + fr;
#pragma unroll
        for (int ai = 0; ai < 2; ++ai)
#pragma unroll
            for (int m = 0; m < 4; ++m) {
                const int row = row0 + ai * HALF + m * 16;
#pragma unroll
                for (int bj = 0; bj < 2; ++bj) {
                    float a[8];
#pragma unroll
                    for (int n = 0; n < 2; ++n)
#pragma unroll
                        for (int i = 0; i < 4; ++i) { const float x = acc[ai][bj][m][n][i]; a[n * 4 + i] = x * __builtin_amdgcn_rcpf(1.0f + __expf(-1.5957691216057308f * (x + 0.044715f * x * x * x))); }
                    u32x4 w; w.x = cvt_pk_bf16(a[0], a[1]); w.y = cvt_pk_bf16(a[2], a[3]); w.z = cvt_pk_bf16(a[4], a[5]); w.w = cvt_pk_bf16(a[6], a[7]);
                    *(u32x4*)(hid + (size_t)row * CMP_HID + bj * HALF + wc * 32 + 8 * fq) = w;
                }
            }
    }
};
struct CmpOrder {
    int nunits, per_e, G, c;
    __device__ bool next(int i, Unit& u) const { const int L = i * G + c; if (L >= nunits) return false; u.pm = L; u.pn = L / per_e; return true; }
    __device__ __forceinline__ void a_ready(const Unit&) const {}
    __device__ __forceinline__ void done(const Unit&) const {}
};
}
constexpr int LDS_RING_C = 131072;
namespace att {
typedef short bf16x8 __attribute__((ext_vector_type(8)));
typedef short s16x4 __attribute__((ext_vector_type(4)));
typedef float f32x16 __attribute__((ext_vector_type(16)));
typedef __attribute__((address_space(3))) unsigned char* ldsp;
constexpr int TILE_B = 8192;
constexpr int L_KB = 0, L_VB = 2 * TILE_B, L_IMP = 4 * TILE_B, L_SELM = L_IMP + 64 * 64 * 4, L_END = L_SELM + 64 * 8;
constexpr float NEGB = -1e30f;
constexpr float QSCALE = 0.125f * 1.4426950408889634f;
__device__ __forceinline__ int crow(int r, int hi) { return (r & 3) + 8 * (r >> 2) + 4 * hi; }
__device__ __forceinline__ void glds16(const void* gsrc, unsigned lds_dst) { unsigned keep;
    asm volatile("s_mov_b32 %0, m0\n\ts_mov_b32 m0, %2\n\ts_nop 0\n\tglobal_load_lds_dwordx4 %1, off\n\ts_mov_b32 m0, %0" : "=&s"(keep) : "v"(gsrc), "s"(lds_dst) : "memory"); }
__device__ __forceinline__ unsigned cvtpk(float lo, float hi) { unsigned r; asm volatile("v_cvt_pk_bf16_f32 %0, %1, %2" : "=v"(r) : "v"(lo), "v"(hi)); return r; }
__device__ __forceinline__ float halfmax(float m) { auto rr = __builtin_amdgcn_permlane32_swap(__float_as_uint(m), __float_as_uint(m), false, false); return fmaxf(__uint_as_float(rr[0]), __uint_as_float(rr[1])); }
__device__ __forceinline__ float halfsum(float m) { auto rr = __builtin_amdgcn_permlane32_swap(__float_as_uint(m), __float_as_uint(m), false, false); return __uint_as_float(rr[0]) + __uint_as_float(rr[1]); }
__device__ __forceinline__ s16x4 vtr(ldsp p) { typedef short v4i16_t __attribute__((ext_vector_type(4))); return __builtin_bit_cast(s16x4, __builtin_amdgcn_ds_read_tr16_b64_v4i16((__attribute__((address_space(3))) v4i16_t*)p)); }
#define ATT_BAR_L() asm volatile("s_waitcnt lgkmcnt(0)\n\ts_barrier" ::: "memory")
#define ATT_WAIT_BAR(N) asm volatile("s_waitcnt vmcnt(" #N ") lgkmcnt(0)\n\ts_barrier" ::: "memory")
__device__ __forceinline__ void dma_tile(const unsigned char* img, unsigned lds_dst, int wid, int lane) { glds16(img + wid * 1024 + lane * 16, (unsigned)__builtin_amdgcn_readfirstlane(lds_dst + wid * 1024)); }
__device__ __forceinline__ void qk(f32x16& p0, f32x16& p1, ldsp kbuf, const bf16x8 (&qf)[4], float cinit, int r32, int hi) {
    f32x16 c;
#pragma unroll
    for (int r = 0; r < 16; ++r) c[r] = cinit;
    p0 = c; p1 = c;
#pragma unroll
    for (int s = 0; s < 4; ++s) {
        const bf16x8 k0 = *(const __attribute__((address_space(3))) bf16x8*)(kbuf + (2 * s + hi) * 1024 + r32 * 16);
        const bf16x8 k1 = *(const __attribute__((address_space(3))) bf16x8*)(kbuf + (2 * s + hi) * 1024 + r32 * 16 + 512);
        p0 = __builtin_amdgcn_mfma_f32_32x32x16_bf16(k0, qf[s], p0, 0, 0, 0);
        p1 = __builtin_amdgcn_mfma_f32_32x32x16_bf16(k1, qf[s], p1, 0, 0, 0);
    }
}
__device__ __forceinline__ void pv(f32x16 (&o)[2], ldsp vbuf, const f32x16& p0, const f32x16& p1, int lane, int hi) {
    unsigned pk[4][4];
#pragma unroll
    for (int k = 0; k < 4; ++k) { pk[0][k] = cvtpk(p0[2 * k], p0[2 * k + 1]); pk[1][k] = cvtpk(p0[8 + 2 * k], p0[9 + 2 * k]); pk[2][k] = cvtpk(p1[2 * k], p1[2 * k + 1]); pk[3][k] = cvtpk(p1[8 + 2 * k], p1[9 + 2 * k]); }
    const int vp0 = ((lane >> 4) & 1) * 32 + (lane & 3) * 8 + (4 * hi + ((lane & 15) >> 2)) * 64;
#pragma unroll
    for (int d0 = 0; d0 < 2; ++d0)
#pragma unroll
        for (int s = 0; s < 4; ++s) {
            const s16x4 lo = vtr(vbuf + d0 * 4096 + s * 1024 + vp0), hh = vtr(vbuf + d0 * 4096 + s * 1024 + 512 + vp0);
            const bf16x8 vf = (bf16x8){lo[0], lo[1], lo[2], lo[3], hh[0], hh[1], hh[2], hh[3]};
            typedef unsigned u32x4 __attribute__((ext_vector_type(4)));
            const u32x4 pw = (u32x4){pk[s][0], pk[s][1], pk[s][2], pk[s][3]};
            o[d0] = __builtin_amdgcn_mfma_f32_32x32x16_bf16(vf, __builtin_bit_cast(bf16x8, pw), o[d0], 0, 0, 0);
        }
}
struct Run { float m, l; f32x16 o[2]; };
template <bool EMASK> __device__ __forceinline__ void tile_step(Run& R, ldsp kbuf, ldsp vbuf, const bf16x8 (&qf)[4], float cinit, int lo_b_, int hi_b_, int lane, int r32, int hi) {
    int lo_b = lo_b_ - 4 * hi, hi_b = hi_b_ - 4 * hi;
    if (EMASK) asm volatile("" : "+v"(lo_b), "+v"(hi_b));
    f32x16 p0, p1; qk(p0, p1, kbuf, qf, cinit, r32, hi);
    if (EMASK) {
#pragma unroll
        for (int r = 0; r < 16; ++r) { const int kc_ = (r & 3) + 8 * (r >> 2); if (kc_ < lo_b || kc_ > hi_b) p0[r] = NEGB; if (kc_ + 32 < lo_b || kc_ + 32 > hi_b) p1[r] = NEGB; }
    }
    float rm = fmaxf(p0[0], p1[0]);
#pragma unroll
    for (int r = 1; r < 16; ++r) rm = fmaxf(rm, fmaxf(p0[r], p1[r]));
    rm = halfmax(rm);
    const float mn = fmaxf(R.m, rm), alpha = __builtin_amdgcn_exp2f(R.m - mn);
    R.m = mn; R.l *= alpha;
#pragma unroll
    for (int r = 0; r < 16; ++r) { R.o[0][r] *= alpha; R.o[1][r] *= alpha; }
    float ls = 0.f;
#pragma unroll
    for (int r = 0; r < 16; ++r) {
        float e0 = __builtin_amdgcn_exp2f(p0[r] - mn), e1 = __builtin_amdgcn_exp2f(p1[r] - mn);
        if (EMASK) { const int kc_ = (r & 3) + 8 * (r >> 2); if (kc_ < lo_b || kc_ > hi_b) e0 = 0.f; if (kc_ + 32 < lo_b || kc_ + 32 > hi_b) e1 = 0.f; }
        p0[r] = e0; p1[r] = e1; ls += e0 + e1;
    }
    R.l += ls;
    pv(R.o, vbuf, p0, p1, lane, hi);
}
struct Tensors {
    const bf16_t* qn; const bf16_t* qr;
    const unsigned char* ksel; const unsigned char* vsel; const unsigned char* kwin; const unsigned char* vwin;
    const unsigned char* kc; const unsigned char* vc;
    const float* gates; bf16_t* ob;
};
template <bool SEL> __device__ __forceinline__ void branch(Run& R, const unsigned char* kimg, const unsigned char* vimg, int t0, int t1, int jdiag, unsigned long long selm, int iq,
                                                           const bf16x8 (&qf)[4], unsigned lds0, ldsp lds, int wid, int lane, int r32, int hi) {
    R.m = NEGB; R.l = 0.f;
#pragma unroll
    for (int r = 0; r < 16; ++r) { R.o[0][r] = 0.f; R.o[1][r] = 0.f; }
    dma_tile(kimg + (size_t)t0 * TILE_B, lds0 + L_KB, wid, lane); dma_tile(vimg + (size_t)t0 * TILE_B, lds0 + L_VB, wid, lane);
    for (int t = t0; t <= t1; ++t) {
        const int b = (t - t0) & 1;
        if (t < t1) { dma_tile(kimg + (size_t)(t + 1) * TILE_B, lds0 + L_KB + (b ^ 1) * TILE_B, wid, lane); dma_tile(vimg + (size_t)(t + 1) * TILE_B, lds0 + L_VB + (b ^ 1) * TILE_B, wid, lane); ATT_WAIT_BAR(2); }
        else ATT_WAIT_BAR(0);
        const float cinit = (!SEL || ((selm >> t) & 1ull)) ? 0.f : NEGB;
        const bool lowm = !SEL && (t == jdiag - 8);
        if (t == jdiag || lowm) tile_step<true>(R, lds + L_KB + b * TILE_B, lds + L_VB + b * TILE_B, qf, cinit, lowm ? iq : 0, (t == jdiag) ? iq : 63, lane, r32, hi);
        else tile_step<false>(R, lds + L_KB + b * TILE_B, lds + L_VB + b * TILE_B, qf, cinit, 0, 63, lane, r32, hi);
        ATT_BAR_L();
    }
}
__device__ __forceinline__ void load_q(bf16x8 (&qf)[4], const bf16_t* qrow, int hi) {
#pragma unroll
    for (int s = 0; s < 4; ++s) qf[s] = *(const bf16x8*)(qrow + 16 * s + 8 * hi);
}
__device__ __forceinline__ void unit(const Tensors& T, int n, int j, int g, ldsp lds, unsigned lds0, int wid, int lane) {
    const int r32 = lane & 31, hi = lane >> 5, ql = r32 >> 2, hq = r32 & 3, iq = 8 * wid + ql;
    const int row = n * SEQ + 64 * j + iq, head = g * HPG + hq, pos = 64 * j + iq;
    const size_t img_ng = ((size_t)n * N_KV + g);
    f32x16 oacc[2];
#pragma unroll
    for (int r = 0; r < 16; ++r) { oacc[0][r] = 0.f; oacc[1][r] = 0.f; }
    const float* gt = T.gates + (size_t)row * 3 * N_HEADS + head * 3;
    const float g_c = gt[0], g_s = gt[1], g_w = gt[2];
    bf16x8 qf[4];
    unsigned long long selm;
    {
        load_q(qf, T.qn + (size_t)row * HDM + head * HD, hi);
        const int ntc = (2 * j + 2 + 63) / 64;
        const unsigned char* kci = T.kc + img_ng * (NBC_P / 64) * TILE_B; const unsigned char* vci = T.vc + img_ng * (NBC_P / 64) * TILE_B;
        dma_tile(kci, lds0 + L_KB, wid, lane); dma_tile(vci, lds0 + L_VB, wid, lane);
        if (ntc > 1) { dma_tile(kci + TILE_B, lds0 + L_KB + TILE_B, wid, lane); dma_tile(vci + TILE_B, lds0 + L_VB + TILE_B, wid, lane); }
        ATT_WAIT_BAR(0);
        int cmax = ((pos + 1) >> 5) - 1 - 4 * hi;
        asm volatile("" : "+v"(cmax));
        f32x16 s0, s1, s2, s3;
        qk(s0, s1, lds + L_KB, qf, 0.f, r32, hi);
        if (ntc > 1) qk(s2, s3, lds + L_KB + TILE_B, qf, 0.f, r32, hi);
        else {
#pragma unroll
            for (int r = 0; r < 16; ++r) { s2[r] = NEGB; s3[r] = NEGB; }
        }
        float mx = NEGB;
#pragma unroll
        for (int r = 0; r < 16; ++r) { const int kv = (r & 3) + 8 * (r >> 2);
            if (kv > cmax) s0[r] = NEGB; if (kv + 32 > cmax) s1[r] = NEGB; if (kv + 64 > cmax) s2[r] = NEGB; if (kv + 96 > cmax) s3[r] = NEGB;
            mx = fmaxf(fmaxf(mx, fmaxf(s0[r], s1[r])), fmaxf(s2[r], s3[r])); }
        mx = halfmax(mx);
        float ls = 0.f;
#pragma unroll
        for (int r = 0; r < 16; ++r) { const int kv = (r & 3) + 8 * (r >> 2);
            s0[r] = (kv > cmax) ? 0.f : __builtin_amdgcn_exp2f(s0[r] - mx); s1[r] = (kv + 32 > cmax) ? 0.f : __builtin_amdgcn_exp2f(s1[r] - mx);
            s2[r] = (kv + 64 > cmax) ? 0.f : __builtin_amdgcn_exp2f(s2[r] - mx); s3[r] = (kv + 96 > cmax) ? 0.f : __builtin_amdgcn_exp2f(s3[r] - mx);
            ls += (s0[r] + s1[r]) + (s2[r] + s3[r]); }
        ls = halfsum(ls);
        const float inv = 1.0f / fmaxf(ls, 1e-30f);
#pragma unroll
        for (int r = 0; r < 16; ++r) { s0[r] *= inv; s1[r] *= inv; s2[r] *= inv; s3[r] *= inv; }
        __attribute__((address_space(3))) float* imp = (__attribute__((address_space(3))) float*)(lds + L_IMP) + iq * 64;
#pragma unroll
        for (int r = 0; r < 16; r += 2) { const int bl = crow(r, hi) >> 1;
            float v0 = s0[r] + s0[r + 1], v1 = s1[r] + s1[r + 1], v2 = s2[r] + s2[r + 1], v3 = s3[r] + s3[r + 1];
            v0 += __shfl_xor(v0, 1); v0 += __shfl_xor(v0, 2); v1 += __shfl_xor(v1, 1); v1 += __shfl_xor(v1, 2);
            v2 += __shfl_xor(v2, 1); v2 += __shfl_xor(v2, 2); v3 += __shfl_xor(v3, 1); v3 += __shfl_xor(v3, 2);
            if (hq == 0) { imp[bl] = v0; imp[16 + bl] = v1; imp[32 + bl] = v2; imp[48 + bl] = v3; } }
        Run Rc;
#pragma unroll
        for (int r = 0; r < 16; ++r) { Rc.o[0][r] = 0.f; Rc.o[1][r] = 0.f; }
        pv(Rc.o, lds + L_VB, s0, s1, lane, hi);
        if (ntc > 1) pv(Rc.o, lds + L_VB + TILE_B, s2, s3, lane, hi);
#pragma unroll
        for (int r = 0; r < 16; ++r) { oacc[0][r] += g_c * Rc.o[0][r]; oacc[1][r] += g_c * Rc.o[1][r]; }
        asm volatile("s_waitcnt lgkmcnt(0)" ::: "memory");
        __attribute__((address_space(3))) unsigned long long* selw = (__attribute__((address_space(3))) unsigned long long*)(lds + L_SELM);
        for (int qq = 0; qq < 8; ++qq) {
            const float v = ((__attribute__((address_space(3))) float*)(lds + L_IMP))[(8 * wid + qq) * 64 + lane];
            const bool valid = lane <= j, forced = (lane == 0) || (lane == j) || (lane == j - 1);
            const unsigned key = valid ? (forced ? 0x7f000000u : __float_as_uint(v) + 1u) : 0u;
            unsigned long long m;
            if (j + 1 <= N_SEL) m = __ballot(valid);
            else {
                unsigned Tt = 0u;
                for (int bit = 30; bit >= 0; --bit) { const unsigned cand = Tt | (1u << bit); if (__popcll(__ballot(key >= cand)) >= N_SEL) Tt = cand; }
                const unsigned long long gtm = __ballot(key > Tt), eqm = __ballot(key == Tt);
                const int need = N_SEL - __popcll(gtm);
                const bool pick = (key == Tt) && (__popcll(eqm & ((1ull << lane) - 1ull)) < need);
                m = gtm | __ballot(pick);
            }
            if (lane == 0) selw[8 * wid + qq] = m;
        }
        asm volatile("s_waitcnt lgkmcnt(0)" ::: "memory");
        selm = selw[iq];
        ATT_WAIT_BAR(0);
    }
    load_q(qf, T.qr + (size_t)row * HDM + head * HD, hi);
    {
        Run R; branch<true>(R, T.ksel + img_ng * (SEQ / 64) * TILE_B, T.vsel + img_ng * (SEQ / 64) * TILE_B, 0, j, j, selm, iq, qf, lds0, lds, wid, lane, r32, hi);
        const float sc = g_s / fmaxf(halfsum(R.l), 1e-30f);
#pragma unroll
        for (int r = 0; r < 16; ++r) { oacc[0][r] += sc * R.o[0][r]; oacc[1][r] += sc * R.o[1][r]; }
    }
    {
        Run R; branch<false>(R, T.kwin + img_ng * (SEQ / 64) * TILE_B, T.vwin + img_ng * (SEQ / 64) * TILE_B, j > 8 ? j - 8 : 0, j, j, 0ull, iq, qf, lds0, lds, wid, lane, r32, hi);
        const float sc = g_w / fmaxf(halfsum(R.l), 1e-30f);
#pragma unroll
        for (int r = 0; r < 16; ++r) { oacc[0][r] += sc * R.o[0][r]; oacc[1][r] += sc * R.o[1][r]; }
    }
    bf16_t* orow = T.ob + (size_t)row * HDM + head * HD;
#pragma unroll
    for (int d0 = 0; d0 < 2; ++d0)
#pragma unroll
        for (int rr = 0; rr < 4; ++rr) { typedef unsigned u32x2 __attribute__((ext_vector_type(2)));
            u32x2 w; w.x = cvtpk(oacc[d0][4 * rr], oacc[d0][4 * rr + 1]); w.y = cvtpk(oacc[d0][4 * rr + 2], oacc[d0][4 * rr + 3]);
            *(u32x2*)(orow + 32 * d0 + 8 * rr + 4 * hi) = w; }
}
__device__ __forceinline__ void phase(const Tensors& T, ldsp lds, int wid, int lane, int cu, int ncu) {
    const unsigned lds0 = (unsigned)(uintptr_t)lds;
    constexpr int NQB = SEQ / 64, NGRP = NQB / 4;
    for (int c = cu; c < BATCH * N_KV * NGRP; c += ncu) {
        const int ng = c / NGRP, s = c % NGRP, n = ng / N_KV, g = ng % N_KV;
        for (int k = 0; k < 4; ++k) { const int j = (k == 0) ? s : (k == 1) ? NQB / 2 - 1 - s : (k == 2) ? NQB / 2 + s : NQB - 1 - s; unit(T, n, j, g, lds, lds0, wid, lane); }
    }
}
}
namespace att {
constexpr int S_STAGE = 16384;
constexpr int S_XM = LDS_RING_C + 1024, S_XL = S_XM + 1024, S_IMP = S_XL + 1024, S_SELM = S_IMP + 8 * 128 * 4, S_END = S_SELM + 8 * 2 * 8;
struct STensors {
    const bf16_t* qn; const bf16_t* qr; const float* kc; const float* vc; const float* cache_kv; const int* page_table; const float* cache_win; const float* out; const float* winrows;
    const float* gates; bf16_t* ob;
};
typedef float f32x4_t __attribute__((ext_vector_type(4)));
__device__ __forceinline__ void stage_kv(ldsp kimg, ldsp vimg, const float* ksrc, const float* vsrc, int stride, int nrows, int lane) {
    typedef unsigned u32x4 __attribute__((ext_vector_type(4)));
    const int c = lane & 7;
#pragma unroll 1
    for (int ib = 0; ib < 8; ib += 4)
#pragma unroll
    for (int it = ib; it < ib + 4; ++it) {
        const int row = 8 * it + (lane >> 3);
        f32x4_t k0 = {0.f, 0.f, 0.f, 0.f}, k1 = k0, v0 = k0, v1 = k0;
        if (row < nrows) { const float* kp = ksrc + (size_t)row * stride + 8 * c; const float* vp = vsrc + (size_t)row * stride + 8 * c;
            k0 = *(const f32x4_t*)kp; k1 = *(const f32x4_t*)(kp + 4); v0 = *(const f32x4_t*)vp; v1 = *(const f32x4_t*)(vp + 4); }
        u32x4 kw, vw; kw.x = cvtpk(k0[0], k0[1]); kw.y = cvtpk(k0[2], k0[3]); kw.z = cvtpk(k1[0], k1[1]); kw.w = cvtpk(k1[2], k1[3]);
        vw.x = cvtpk(v0[0], v0[1]); vw.y = cvtpk(v0[2], v0[3]); vw.z = cvtpk(v1[0], v1[1]); vw.w = cvtpk(v1[2], v1[3]);
        *(__attribute__((address_space(3))) u32x4*)(kimg + c * 1024 + row * 16) = kw;
        *(__attribute__((address_space(3))) u32x4*)(vimg + (c >> 2) * 4096 + (row >> 3) * 512 + (row & 7) * 64 + (c & 3) * 16) = vw;
    }
    asm volatile("s_waitcnt lgkmcnt(0)" ::: "memory");
}
#define ATT_BAR_ALL() asm volatile("s_waitcnt vmcnt(0) lgkmcnt(0)\n\ts_barrier" ::: "memory")
__device__ __forceinline__ float merge_stats(ldsp lds, float m_own, float l_own_half, int wid, int r32, int hi) {
    __attribute__((address_space(3))) float* xm = (__attribute__((address_space(3))) float*)(lds + S_XM); __attribute__((address_space(3))) float* xl = (__attribute__((address_space(3))) float*)(lds + S_XL);
    const float l_own = halfsum(l_own_half);
    if (hi == 0) { xm[wid * 32 + r32] = m_own; xl[wid * 32 + r32] = l_own; }
    ATT_BAR_ALL();
    float M = NEGB;
#pragma unroll
    for (int w = 0; w < 8; ++w) M = fmaxf(M, xm[w * 32 + r32]);
    float L = 0.f;
#pragma unroll
    for (int w = 0; w < 8; ++w) L += __builtin_amdgcn_exp2f(xm[w * 32 + r32] - M) * xl[w * 32 + r32];
    const float wgt = __builtin_amdgcn_exp2f(m_own - M) / fmaxf(L, 1e-30f);
    ATT_BAR_ALL();
    return wgt;
}
__device__ __forceinline__ void sample_unit(const STensors& T, int b, int g, ldsp lds, int wid, int lane) {
    const int r32 = lane & 31, hi = lane >> 5, ql = r32 >> 2, hq = r32 & 3;
    const int row = MP + b * DEC_SEQ + ql, head = g * HPG + hq, seq = BATCH + b;
    ldsp kimg = lds + wid * S_STAGE, vimg = kimg + TILE_B;
    f32x16 oacc[2];
#pragma unroll
    for (int r = 0; r < 16; ++r) { oacc[0][r] = 0.f; oacc[1][r] = 0.f; }
    const float* gt = T.gates + (size_t)row * 3 * N_HEADS + head * 3;
    const float g_c = gt[0], g_s = gt[1], g_w = gt[2];
    bf16x8 qf[4];
    __attribute__((address_space(3))) float* xm = (__attribute__((address_space(3))) float*)(lds + S_XM); __attribute__((address_space(3))) float* xl = (__attribute__((address_space(3))) float*)(lds + S_XL);
    __attribute__((address_space(3))) float* imp = (__attribute__((address_space(3))) float*)(lds + S_IMP);
    __attribute__((address_space(3))) unsigned long long* selw = (__attribute__((address_space(3))) unsigned long long*)(lds + S_SELM);
    {
        load_q(qf, T.qn + (size_t)row * HDM + head * HD, hi);
        constexpr int NTC = NBC_PAST / 64;
        f32x16 p0, p1; const bool mine = wid < NTC;
        float rm = NEGB;
        if (mine) {
            const float* kcp = T.kc + (((size_t)seq * NBC_MAX + 64 * wid) * N_KV + g) * HD; const float* vcp = T.vc + (((size_t)seq * NBC_MAX + 64 * wid) * N_KV + g) * HD;
            stage_kv(kimg, vimg, kcp, vcp, N_KV * HD, 64, lane);
            qk(p0, p1, kimg, qf, 0.f, r32, hi);
#pragma unroll
            for (int r = 0; r < 16; ++r) rm = fmaxf(rm, fmaxf(p0[r], p1[r]));
            rm = halfmax(rm);
        }
        if (hi == 0) xm[wid * 32 + r32] = rm;
        ATT_BAR_ALL();
        float M = NEGB;
#pragma unroll
        for (int w = 0; w < 8; ++w) M = fmaxf(M, xm[w * 32 + r32]);
        float ls = 0.f;
        if (mine) {
#pragma unroll
            for (int r = 0; r < 16; ++r) { p0[r] = __builtin_amdgcn_exp2f(p0[r] - M); p1[r] = __builtin_amdgcn_exp2f(p1[r] - M); ls += p0[r] + p1[r]; }
            ls = halfsum(ls);
        }
        if (hi == 0) xl[wid * 32 + r32] = ls;
        ATT_BAR_ALL();
        float L = 0.f;
#pragma unroll
        for (int w = 0; w < 8; ++w) L += xl[w * 32 + r32];
        const float inv = 1.0f / fmaxf(L, 1e-30f);
        if (mine) {
#pragma unroll
            for (int r = 0; r < 16; ++r) { p0[r] *= inv; p1[r] *= inv; }
#pragma unroll
            for (int r = 0; r < 16; r += 2) { const int bl = crow(r, hi) >> 1;
                float v0 = p0[r] + p0[r + 1], v1 = p1[r] + p1[r + 1];
                v0 += __shfl_xor(v0, 1); v0 += __shfl_xor(v0, 2); v1 += __shfl_xor(v1, 1); v1 += __shfl_xor(v1, 2);
                if (hq == 0) { imp[ql * 128 + 32 * wid + bl] = v0; imp[ql * 128 + 32 * wid + 16 + bl] = v1; } }
            Run Rc;
#pragma unroll
            for (int r = 0; r < 16; ++r) { Rc.o[0][r] = 0.f; Rc.o[1][r] = 0.f; }
            pv(Rc.o, vimg, p0, p1, lane, hi);
#pragma unroll
            for (int r = 0; r < 16; ++r) { oacc[0][r] += g_c * Rc.o[0][r]; oacc[1][r] += g_c * Rc.o[1][r]; }
        }
        ATT_BAR_ALL();
    }
    {
        constexpr int NCAND = NBS_S - 1;
        const float v0 = imp[wid * 128 + lane], v1 = imp[wid * 128 + 64 + lane];
        const unsigned key0 = (lane == 0) ? 0x7f000000u : __float_as_uint(v0) + 1u;
        const unsigned key1 = (lane + 64 == NCAND - 1) ? 0x7f000000u : __float_as_uint(v1) + 1u;
        unsigned Tt = 0u;
        for (int bit = 30; bit >= 0; --bit) { const unsigned cand = Tt | (1u << bit); if (__popcll(__ballot(key0 >= cand)) + __popcll(__ballot(key1 >= cand)) >= N_SEL - 1) Tt = cand; }
        const unsigned long long gt0 = __ballot(key0 > Tt), gt1 = __ballot(key1 > Tt), eq0 = __ballot(key0 == Tt), eq1 = __ballot(key1 == Tt);
        const int need = (N_SEL - 1) - __popcll(gt0) - __popcll(gt1);
        const unsigned long long below = (1ull << lane) - 1ull;
        const bool pick0 = (key0 == Tt) && (__popcll(eq0 & below) < need);
        const bool pick1 = (key1 == Tt) && (__popcll(eq0) + __popcll(eq1 & below) < need);
        const unsigned long long m0 = gt0 | __ballot(pick0), m1 = gt1 | __ballot(pick1);
        if (lane == 0) { selw[wid * 2] = m0; selw[wid * 2 + 1] = m1; }
        ATT_BAR_ALL();
    }
    load_q(qf, T.qr + (size_t)row * HDM + head * HD, hi);
    {
        unsigned long long U0 = 0ull, U1 = 0ull;
#pragma unroll
        for (int q = 0; q < 8; ++q) { U0 |= selw[q * 2]; U1 |= selw[q * 2 + 1]; }
        U0 = __builtin_amdgcn_readfirstlane((unsigned)U0) | ((unsigned long long)__builtin_amdgcn_readfirstlane((unsigned)(U0 >> 32)) << 32);
        U1 = __builtin_amdgcn_readfirstlane((unsigned)U1) | ((unsigned long long)__builtin_amdgcn_readfirstlane((unsigned)(U1 >> 32)) << 32);
        const unsigned long long my0 = selw[ql * 2], my1 = selw[ql * 2 + 1];
        Run R; R.m = NEGB; R.l = 0.f;
#pragma unroll
        for (int r = 0; r < 16; ++r) { R.o[0][r] = 0.f; R.o[1][r] = 0.f; }
        int idx = 0;
        for (int half = 0; half < 2; ++half) {
            unsigned long long U = half ? U1 : U0;
            while (U) {
                const int bit = __builtin_ctzll(U); U &= U - 1ull;
                if ((idx++ & 7) != wid) continue;
                const int blk = 64 * half + bit;
                const int page = T.page_table[b * N_PAGES + (blk * L_SEL) / PAGE_SIZE];
                const float* base = T.cache_kv + (((size_t)page * PAGE_SIZE + (blk * L_SEL) % PAGE_SIZE) * 4) * N_KV * HD + g * HD;
                stage_kv(kimg, vimg, base + 2 * N_KV * HD, base + 3 * N_KV * HD, 4 * N_KV * HD, 64, lane);
                const bool selected = ((half ? my1 : my0) >> bit) & 1ull;
                tile_step<false>(R, kimg, vimg, qf, selected ? 0.f : NEGB, 0, 63, lane, r32, hi);
            }
        }
        if ((idx & 7) == wid) {
            const float* base = T.out + O_KVS + (((size_t)b * DEC_SEQ) * 4) * N_KV * HD + g * HD;
            stage_kv(kimg, vimg, base + 2 * N_KV * HD, base + 3 * N_KV * HD, 4 * N_KV * HD, DEC_SEQ, lane);
            tile_step<true>(R, kimg, vimg, qf, 0.f, 0, ql, lane, r32, hi);
        }
        const float wgt = merge_stats(lds, R.m, R.l, wid, r32, hi) * g_s;
#pragma unroll
        for (int r = 0; r < 16; ++r) { oacc[0][r] += wgt * R.o[0][r]; oacc[1][r] += wgt * R.o[1][r]; }
    }
    {
        Run R; R.m = NEGB; R.l = 0.f;
#pragma unroll
        for (int r = 0; r < 16; ++r) { R.o[0][r] = 0.f; R.o[1][r] = 0.f; }
        for (int t = wid; t < WINDOW / 64; t += 8) {
            const float* base = T.cache_win + (((size_t)b * WINDOW + 64 * t) * 2) * N_KV * HD + g * HD;
            stage_kv(kimg, vimg, base, base + N_KV * HD, 2 * N_KV * HD, 64, lane);
            if (t == 0) tile_step<true>(R, kimg, vimg, qf, 0.f, ql, 63, lane, r32, hi); else tile_step<false>(R, kimg, vimg, qf, 0.f, 0, 63, lane, r32, hi);
        }
        if (wid == 0) {
            const float* base = T.winrows + (((size_t)(MP + b * DEC_SEQ)) * 2) * N_KV * HD + g * HD;
            stage_kv(kimg, vimg, base, base + N_KV * HD, 2 * N_KV * HD, DEC_SEQ, lane);
            tile_step<true>(R, kimg, vimg, qf, 0.f, 0, ql, lane, r32, hi);
        }
        const float wgt = merge_stats(lds, R.m, R.l, wid, r32, hi) * g_w;
#pragma unroll
        for (int r = 0; r < 16; ++r) { oacc[0][r] += wgt * R.o[0][r]; oacc[1][r] += wgt * R.o[1][r]; }
    }
    {
        __attribute__((address_space(3))) float* mine = (__attribute__((address_space(3))) float*)(lds + wid * S_STAGE);
#pragma unroll
        for (int d0 = 0; d0 < 2; ++d0)
#pragma unroll
            for (int rr = 0; rr < 4; ++rr) *(__attribute__((address_space(3))) f32x4_t*)(mine + r32 * 64 + 32 * d0 + 8 * rr + 4 * hi) = (f32x4_t){oacc[d0][4 * rr], oacc[d0][4 * rr + 1], oacc[d0][4 * rr + 2], oacc[d0][4 * rr + 3]};
        ATT_BAR_ALL();
        const int tid = wid * 64 + lane, orow = tid >> 4, oc4 = (tid & 15) * 4;
        f32x4_t s = {0.f, 0.f, 0.f, 0.f};
#pragma unroll
        for (int w = 0; w < 8; ++w) s += *(const __attribute__((address_space(3))) f32x4_t*)((__attribute__((address_space(3))) float*)(lds + w * S_STAGE) + orow * 64 + oc4);
        typedef unsigned u32x2 __attribute__((ext_vector_type(2)));
        u32x2 wv; wv.x = cvtpk(s[0], s[1]); wv.y = cvtpk(s[2], s[3]);
        const int oq = orow >> 2, oh = orow & 3;
        *(u32x2*)(T.ob + (size_t)(MP + b * DEC_SEQ + oq) * HDM + (g * HPG + oh) * HD + oc4) = wv;
        ATT_BAR_ALL();
    }
}
__device__ __forceinline__ void sample_phase(const STensors& T, ldsp lds, int wid, int lane, int cu, int ncu) {
    for (int c = cu; c < DEC_BATCH * N_KV; c += ncu) sample_unit(T, c / N_KV, c % N_KV, lds, wid, lane);
}
}


namespace att {
__device__ __forceinline__ void cmp_out_wave(int task, const bf16_t* hid, int R, int nbc, int seq0, const bf16_t* w2t, const float* k_norm0, float* kc, float* vc, unsigned char* kci, unsigned char* vci, int lane) {
    const int r32 = lane & 31, hi = lane >> 5;
    const int r0 = task * 32, e = r0 >= R ? 1 : 0, r = r0 - e * R + r32;
    const bf16_t* hrow = hid + ((size_t)e * R + r) * CMP_HID; const bf16_t* wrow = w2t + ((size_t)e * HD + r32) * CMP_HID;
    f32x16 o0, o1;
#pragma unroll
    for (int k = 0; k < 16; ++k) { o0[k] = 0.f; o1[k] = 0.f; }
#pragma unroll 4
    for (int s_ = 0; s_ < CMP_HID / 16; ++s_) {
        const bf16x8 hb_ = *(const bf16x8*)(hrow + 16 * s_ + 8 * hi);
        const bf16x8 w0 = *(const bf16x8*)(wrow + 16 * s_ + 8 * hi), w1 = *(const bf16x8*)(wrow + (size_t)32 * CMP_HID + 16 * s_ + 8 * hi);
        o0 = __builtin_amdgcn_mfma_f32_32x32x16_bf16(w0, hb_, o0, 0, 0, 0); o1 = __builtin_amdgcn_mfma_f32_32x32x16_bf16(w1, hb_, o1, 0, 0, 0);
    }
    if (e == 0) {
        float ss = 0.f;
#pragma unroll
        for (int k = 0; k < 16; ++k) ss += o0[k] * o0[k] + o1[k] * o1[k];
        ss = halfsum(ss);
        const float rn = rsqrtf(ss * (1.0f / HD) + EPS);
#pragma unroll
        for (int k = 0; k < 16; ++k) { o0[k] *= rn * k_norm0[crow(k, hi)]; o1[k] *= rn * k_norm0[32 + crow(k, hi)]; }
    }
    const int g = r % N_KV, c = (r / N_KV) % nbc, sq = r / (N_KV * nbc);
    float* dst = (e == 0 ? kc : vc) + (((size_t)(seq0 + sq) * NBC_MAX + c) * N_KV + g) * HD;
#pragma unroll
    for (int rr = 0; rr < 4; ++rr) { *(f32x4_t*)(dst + 8 * rr + 4 * hi) = (f32x4_t){o0[4 * rr], o0[4 * rr + 1], o0[4 * rr + 2], o0[4 * rr + 3]};
                                      *(f32x4_t*)(dst + 32 + 8 * rr + 4 * hi) = (f32x4_t){o1[4 * rr], o1[4 * rr + 1], o1[4 * rr + 2], o1[4 * rr + 3]}; }
    if (kci) {
        unsigned char* img = (e == 0 ? kci : vci) + (((size_t)sq * N_KV + g) * (NBC_P / 64) + c / 64) * 8192; const int kv = c % 64;
        typedef unsigned u32x2 __attribute__((ext_vector_type(2)));
#pragma unroll
        for (int rr = 0; rr < 4; ++rr) {
            u32x2 a; a.x = cvtpk(o0[4 * rr], o0[4 * rr + 1]); a.y = cvtpk(o0[4 * rr + 2], o0[4 * rr + 3]);
            u32x2 bq; bq.x = cvtpk(o1[4 * rr], o1[4 * rr + 1]); bq.y = cvtpk(o1[4 * rr + 2], o1[4 * rr + 3]);
            const int d0 = 8 * rr, d1 = 32 + 8 * rr;
            *(u32x2*)(img + (e == 0 ? kimg_off(kv, d0) : vimg_off(kv, d0)) + 8 * hi) = a;
            *(u32x2*)(img + (e == 0 ? kimg_off(kv, d1) : vimg_off(kv, d1)) + 8 * hi) = bq;
        }
    }
}
}
__device__ __forceinline__ void conv_thin_vec_item(size_t i_, const bf16_t* ub, const bf16_t* bb, const float* state, const float* wc, bf16_t* zb) {
    typedef unsigned u4 __attribute__((ext_vector_type(4)));
    const int m = (int)(i_ / (D_MODEL / 8)), ch = (int)(i_ % (D_MODEL / 8)) * 8;
    const RowInfo ri = row_info(m);
    const size_t o = (size_t)m * D_MODEL + ch;
    float u0[8], u1[8], u2[8], bv[8];
#define UNPK(w, f) do { f[0] = bf2f((bf16_t)((w).x & 0xffff)); f[1] = bf2f((bf16_t)((w).x >> 16)); f[2] = bf2f((bf16_t)((w).y & 0xffff)); f[3] = bf2f((bf16_t)((w).y >> 16)); \
                        f[4] = bf2f((bf16_t)((w).z & 0xffff)); f[5] = bf2f((bf16_t)((w).z >> 16)); f[6] = bf2f((bf16_t)((w).w & 0xffff)); f[7] = bf2f((bf16_t)((w).w >> 16)); } while (0)
    { const u4 w = *(const u4*)(ub + o); UNPK(w, u0); } { const u4 w = *(const u4*)(bb + o); UNPK(w, bv); }
    const float* st = (ri.seq >= BATCH) ? state + (size_t)(ri.seq - BATCH) * 2 * D_MODEL + ch : nullptr;
    if (ri.t >= 1) { const u4 w = *(const u4*)(ub + o - D_MODEL); UNPK(w, u1); } else { for (int k = 0; k < 8; ++k) u1[k] = st ? st[D_MODEL + k] : 0.f; }
    if (ri.t >= 2) { const u4 w = *(const u4*)(ub + o - 2 * D_MODEL); UNPK(w, u2); } else { for (int k = 0; k < 8; ++k) u2[k] = st ? (ri.t == 1 ? st[D_MODEL + k] : st[k]) : 0.f; }
#undef UNPK
    float z[8];
    for (int k = 0; k < 8; ++k) z[k] = bv[k] * (wc[ch + k] * u2[k] + wc[D_MODEL + ch + k] * u1[k] + wc[2 * D_MODEL + ch + k] * u0[k]);
    u4 w; w.x = (unsigned)f2bf(z[0]) | ((unsigned)f2bf(z[1]) << 16); w.y = (unsigned)f2bf(z[2]) | ((unsigned)f2bf(z[3]) << 16);
    w.z = (unsigned)f2bf(z[4]) | ((unsigned)f2bf(z[5]) << 16); w.w = (unsigned)f2bf(z[6]) | ((unsigned)f2bf(z[7]) << 16);
    *(u4*)(zb + o) = w;
}

namespace att {
__device__ __forceinline__ void skinny_task(int task, const bf16_t* A, const bf16_t* Bt, int N, int K, int KS, float* part, int lane) {
    const int r32 = lane & 31, hi = lane >> 5, ncb = N / 32, nrb = MS / 32;
    const int ks = task / (nrb * ncb), rem = task % (nrb * ncb), rb = rem / ncb, cb = rem % ncb, klen = K / KS, k0 = ks * klen;
    const bf16_t* ap = A + (size_t)(rb * 32 + r32) * K + k0 + 8 * hi; const bf16_t* bp = Bt + (size_t)(cb * 32 + r32) * K + k0 + 8 * hi;
    f32x16 acc;
#pragma unroll
    for (int k = 0; k < 16; ++k) acc[k] = 0.f;
#pragma unroll 8
    for (int s_ = 0; s_ < klen / 16; ++s_) acc = __builtin_amdgcn_mfma_f32_32x32x16_bf16(*(const bf16x8*)(bp + 16 * s_), *(const bf16x8*)(ap + 16 * s_), acc, 0, 0, 0);
    float* dst = part + ((size_t)ks * MS + rb * 32 + r32) * N + cb * 32 + 4 * hi;
#pragma unroll
    for (int rr = 0; rr < 4; ++rr) *(f32x4_t*)(dst + 8 * rr) = (f32x4_t){acc[4 * rr], acc[4 * rr + 1], acc[4 * rr + 2], acc[4 * rr + 3]};
}
__device__ __forceinline__ void resid_reduce_row(int rs_, const float* part, int KS, float coef, float* h, bf16_t* hb, float* rss_next, float* yout, int lane) {
    typedef unsigned u2 __attribute__((ext_vector_type(2)));
    const int m = MP + rs_; float ssq = 0.f;
#pragma unroll
    for (int j = 0; j < D_MODEL / 256; ++j) {
        const int col = 256 * j + 4 * lane; f32x4_t a = {0.f, 0.f, 0.f, 0.f};
        for (int ks = 0; ks < KS; ++ks) a += *(const f32x4_t*)(part + ((size_t)ks * MS + rs_) * D_MODEL + col);
        const f32x4_t v = *(const f32x4_t*)(h + (size_t)m * D_MODEL + col) + a * coef;
        if (yout) *(f32x4_t*)(yout + (size_t)m * D_MODEL + col) = v;
        else { *(f32x4_t*)(h + (size_t)m * D_MODEL + col) = v; u2 w; w.x = cvtpk(v[0], v[1]); w.y = cvtpk(v[2], v[3]); *(u2*)(hb + (size_t)m * D_MODEL + col) = w;
               ssq += (v[0] * v[0] + v[1] * v[1]) + (v[2] * v[2] + v[3] * v[3]); }
    }
    if (!yout) {
#pragma unroll
        for (int o = 1; o < 64; o <<= 1) ssq += __shfl_xor(ssq, o);
        if (lane == 0) rss_next[m] = ssq;
    }
}
}
__device__ __forceinline__ void conv_thin_sample_item(size_t i_, const float* part, int KS, const float* rss, const float* state, const float* wc, bf16_t* zb, float* out, int layer) {
    const int rs_ = (int)(i_ / (D_MODEL / 8)), ch = (int)(i_ % (D_MODEL / 8)) * 8, m = MP + rs_;
    const RowInfo ri = row_info(m);
    const int nc = (ch / 128) * 256 + (ch % 128);
    float u[3][8], bv[8];
    for (int back = 0; back < 3; ++back) {
        if (ri.t - back >= 0) {
            const int r2 = rs_ - back; const float rsn = rsqrtf(rss[MP + r2] * (1.0f / D_MODEL) + EPS);
            for (int k = 0; k < 8; ++k) { float c = 0.f, x = 0.f; for (int ks = 0; ks < KS; ++ks) { const float* p = part + ((size_t)ks * MS + r2) * 3 * D_MODEL; c += p[nc + k]; x += p[nc + 128 + k]; } u[back][k] = (c * rsn) * (x * rsn); }
        } else { const float* st = state + (size_t)(ri.seq - BATCH) * 2 * D_MODEL + ch;
            const int srow = 2 - (back - ri.t); for (int k = 0; k < 8; ++k) u[back][k] = st[(size_t)srow * D_MODEL + k]; }
    }
    { const float rsn = rsqrtf(rss[m] * (1.0f / D_MODEL) + EPS);
      for (int k = 0; k < 8; ++k) { float b = 0.f; for (int ks = 0; ks < KS; ++ks) b += part[((size_t)ks * MS + rs_) * 3 * D_MODEL + 2 * D_MODEL + ch + k]; bv[k] = b * rsn; } }
    for (int k = 0; k < 8; ++k) { const float ub0 = bf2f(f2bf(u[0][k])), ub1 = (ri.t >= 1) ? bf2f(f2bf(u[1][k])) : u[1][k], ub2 = (ri.t >= 2) ? bf2f(f2bf(u[2][k])) : u[2][k];
        zb[(size_t)m * D_MODEL + ch + k] = f2bf(bf2f(f2bf(bv[k])) * (wc[ch + k] * ub2 + wc[D_MODEL + ch + k] * ub1 + wc[2 * D_MODEL + ch + k] * ub0));
        if (ri.t >= DEC_SEQ - 2) out[O_CS + (((size_t)layer * DEC_BATCH + (ri.seq - BATCH)) * 2 + (ri.t - (DEC_SEQ - 2))) * D_MODEL + ch + k] = u[0][k]; }
}
__device__ __forceinline__ void wconv_tile(int item, const float* src, int Nsrc, const float* gain, bf16_t* dst, int Nd, int K, int kind, int aux, LAS float* scr, int lane) {
    const int nblk = Nd / 32, kb = item / nblk, nb = item % nblk, k0 = 64 * kb, n0 = 32 * nb;
    const int colbase = colmap(kind, n0, aux);
    const int col = colbase + (lane & 31); const bool ok = colbase >= 0 && col < Nsrc;
#pragma unroll 8
    for (int i = 0; i < 32; ++i) { const int kk = 2 * i + (lane >> 5); const float g = gain ? gain[k0 + kk] : 1.f; scr[kk * 33 + (lane & 31)] = ok ? src[(size_t)(k0 + kk) * Nsrc + col] * g : 0.f; }
    asm volatile("s_waitcnt lgkmcnt(0)" ::: "memory");
    const int c = lane & 7;
#pragma unroll
    for (int j = 0; j < 4; ++j) { const int n = (lane >> 3) + 8 * j; const LAS float* sp = scr + (8 * c) * 33 + n;
        typedef unsigned v4u __attribute__((ext_vector_type(4)));
        v4u o; o.x = pg8::cvt_pk_bf16(sp[0 * 33], sp[1 * 33]); o.y = pg8::cvt_pk_bf16(sp[2 * 33], sp[3 * 33]); o.z = pg8::cvt_pk_bf16(sp[4 * 33], sp[5 * 33]); o.w = pg8::cvt_pk_bf16(sp[6 * 33], sp[7 * 33]);
        *(v4u*)(dst + (size_t)(n0 + n) * K + k0 + 8 * c) = o; }
    asm volatile("s_waitcnt lgkmcnt(0)" ::: "memory");
}
__device__ __forceinline__ void hinit_row(int m, const float* xp, const float* xs, float* h, bf16_t* hb, float* rss0, int lane) {
    typedef float f4 __attribute__((ext_vector_type(4))); typedef unsigned u2 __attribute__((ext_vector_type(2)));
    const float* x = m < MP ? xp + (size_t)m * D_MODEL : xs + (size_t)(m - MP) * D_MODEL;
    float s = 0.f;
#pragma unroll
    for (int j = 0; j < D_MODEL / 256; ++j) { const f4 v = *(const f4*)(x + 256 * j + 4 * lane); s += (v[0] * v[0] + v[1] * v[1]) + (v[2] * v[2] + v[3] * v[3]);
        *(f4*)(h + (size_t)m * D_MODEL + 256 * j + 4 * lane) = v; u2 w; w.x = pg8::cvt_pk_bf16(v[0], v[1]); w.y = pg8::cvt_pk_bf16(v[2], v[3]); *(u2*)(hb + (size_t)m * D_MODEL + 256 * j + 4 * lane) = w; }
#pragma unroll
    for (int o = 1; o < 64; o <<= 1) s += __shfl_xor(s, o);
    if (lane == 0) rss0[m] = s;
}
#endif

#ifndef CPU_TEST
__device__ __forceinline__ size_t opaque_gtid(int wave) { int w = wave; asm volatile("" : "+s"(w)); unsigned t = blockIdx.x * NTHREADS + w * 64 + lane_id_v(); return (size_t)t; }
#define ITEM_LOOP(total) for (size_t i = opaque_gtid(wave_id); i < (size_t)(total); i += (size_t)gridDim.x * NTHREADS)
#else
#define ITEM_LOOP(total) _Pragma("omp parallel for schedule(dynamic, 64)") for (long long i = 0; i < (long long)(total); ++i)
#endif

struct Params {
    const float *x_prompt, *x_sample, *cache_kv, *cache_win, *state_conv; const int* page_table;
    const float *ffn_a_norm, *ffn_a_w_in, *ffn_a_w_out, *mix_norm, *ffn_b_norm, *ffn_b_w_in, *ffn_b_w_out, *conv_w_in, *conv_w, *conv_w_out, *kv_norm, *w_kv, *k_norm,
                *cmp_pe, *cmp_w1, *cmp_w2, *nsa_w_qg, *nsa_q_norm, *nsa_w_o;
    float* out; unsigned char* ws;
};
constexpr int LDS_RING = 131072, LDS_BAR_OFF = LDS_RING + 352, LDS_BYTES = 147456;

#ifndef CPU_TEST
typedef const __attribute__((address_space(4))) Params* KParamsPtr;
__device__ __forceinline__ KParamsPtr kparams_ptr() {
#if defined(__HIP_DEVICE_COMPILE__)
    KParamsPtr p = (KParamsPtr)__builtin_amdgcn_kernarg_segment_ptr(); asm volatile("" : "+s"(p)); return p;
#else
    return nullptr;
#endif
}
__device__ __forceinline__ Params load_params() {
#if defined(__HIP_DEVICE_COMPILE__)
    return *kparams_ptr();
#else
    return Params{};
#endif
}
__device__ __forceinline__ unsigned char* load_ws() {
#if defined(__HIP_DEVICE_COMPILE__)
    return kparams_ptr()->ws;
#else
    return nullptr;
#endif
}
#define KP const Params P = load_params()
__device__ __forceinline__ int opaque_s(int v) { asm volatile("" : "+s"(v)); return v; }
#define GRID_SYNC() do { XcdBarrier bar_; bar_.bar = (GU*)load_ws() + 1024; bar_.x = 0; bar_.st = (volatile LAS unsigned*)(lds + LDS_BAR_OFF); xcd_barrier(bar_, wave_id == 0 && lane_id_v() == 0u); } while (0)
__global__ void __launch_bounds__(NTHREADS, 2) mega(Params P_unused)
#else
static Params g_params;
#define KP const Params& P = g_params
#define GRID_SYNC() do {} while (0)
void mega(Params P_unused)
#endif
{
#ifndef CPU_TEST
    extern __shared__ __attribute__((aligned(16))) unsigned char lds[];
    const int wave_id = __builtin_amdgcn_readfirstlane((int)(threadIdx.x >> 6));
    if (threadIdx.x < 4) ((LAS unsigned*)(lds + LDS_BAR_OFF))[threadIdx.x] = 0u;
    __syncthreads();
    (void)xcd_barrier_post((GU*)load_ws() + 1024, (volatile LAS unsigned*)(lds + LDS_BAR_OFF), threadIdx.x == 0);
#define RING ((PG8_LAS unsigned char*)lds)
#else
    g_params = P_unused;
#endif
#define WS_F(f) ((float*)(P.ws + WSM.f))
#define WS_B(f) ((bf16_t*)(P.ws + WSM.f))
#define KVSRC KvSrc{P.cache_kv, P.page_table, P.out}
#define PH(total, call) do { { KP; ITEM_LOOP(total) call; } GRID_SYNC(); } while (0)
#ifdef CPU_TEST
    for (int L = 0; L < DEPTH; ++L) {
        KP;
        ITEM_LOOP((size_t)2 * D_FF * (D_MODEL / 64)) wconv_item(i, P.ffn_a_w_in + (size_t)L * D_MODEL * 2 * D_FF, 2 * D_FF, P.ffn_a_norm + (size_t)L * D_MODEL, WS_B(w_ain) + (size_t)L * 2 * D_FF * D_MODEL, 2 * D_FF, D_MODEL, CM_PAIR, D_FF);
        ITEM_LOOP((size_t)D_MODEL * (D_FF / 64)) wconv_item(i, P.ffn_a_w_out + (size_t)L * D_FF * D_MODEL, D_MODEL, nullptr, WS_B(w_aout) + (size_t)L * D_MODEL * D_FF, D_MODEL, D_FF, CM_PLAIN, 0);
        ITEM_LOOP((size_t)2 * D_FF * (D_MODEL / 64)) wconv_item(i, P.ffn_b_w_in + (size_t)L * D_MODEL * 2 * D_FF, 2 * D_FF, P.ffn_b_norm + (size_t)L * D_MODEL, WS_B(w_bin) + (size_t)L * 2 * D_FF * D_MODEL, 2 * D_FF, D_MODEL, CM_PAIR, D_FF);
        ITEM_LOOP((size_t)D_MODEL * (D_FF / 64)) wconv_item(i, P.ffn_b_w_out + (size_t)L * D_FF * D_MODEL, D_MODEL, nullptr, WS_B(w_bout) + (size_t)L * D_MODEL * D_FF, D_MODEL, D_FF, CM_PLAIN, 0);
    }
    for (int L = 0; L < N_A; ++L) {
        KP;
        ITEM_LOOP((size_t)3 * D_MODEL * (D_MODEL / 64)) wconv_item(i, P.conv_w_in + (size_t)L * D_MODEL * 3 * D_MODEL, 3 * D_MODEL, P.mix_norm + (size_t)L * D_MODEL, WS_B(w_cin) + (size_t)L * 3 * D_MODEL * D_MODEL, 3 * D_MODEL, D_MODEL, CM_CONV, 0);
        ITEM_LOOP((size_t)D_MODEL * (D_MODEL / 64)) wconv_item(i, P.conv_w_out + (size_t)L * D_MODEL * D_MODEL, D_MODEL, nullptr, WS_B(w_cout) + (size_t)L * D_MODEL * D_MODEL, D_MODEL, D_MODEL, CM_PLAIN, 0);
    }
    for (int b = 0; b < N_B; ++b) {
        KP;
        ITEM_LOOP((size_t)QGP * (D_MODEL / 64)) wconv_item(i, P.nsa_w_qg + (size_t)b * D_MODEL * QGW, QGW, P.mix_norm + (size_t)(N_A + b) * D_MODEL, WS_B(w_qg) + (size_t)b * QGP * D_MODEL, QGP, D_MODEL, CM_HEADS, N_HEADS);
        ITEM_LOOP((size_t)D_MODEL * (HDM / 64)) wconv_item(i, P.nsa_w_o + (size_t)b * HDM * D_MODEL, D_MODEL, nullptr, WS_B(w_o) + (size_t)b * D_MODEL * HDM, D_MODEL, HDM, CM_PLAIN, 0);
    }
    { KP; ITEM_LOOP((size_t)KVW * (D_MODEL / 64)) wconv_item(i, P.w_kv, KVW, P.kv_norm, WS_B(w_kv), KVW, D_MODEL, CM_HEADS, 6 * N_KV); }
    { KP; ITEM_LOOP((size_t)NPOS * 8) rope_item(i, WS_F(rope)); }
    { KP; ITEM_LOOP(MT) hinit_item(i, P.x_prompt, P.x_sample, WS_F(h), WS_B(hb), WS_F(rss)); }
#else
#define WAVE_ITEMS(total) for (int it_ = (int)(opaque_s((int)blockIdx.x) * 8 + wave_id); it_ < (int)(total); it_ += (int)gridDim.x * 8)
#define WCONV(srcp, Nsrc_, gainp, dstp, Nd_, K_, kind_, aux_) do { KP; LAS float* scr_ = (LAS float*)(lds + wave_id * 16384); const int lane_ = (int)lane_id_v(); \
        WAVE_ITEMS(((Nd_) / 32) * ((K_) / 64)) wconv_tile(it_, srcp, Nsrc_, gainp, dstp, Nd_, K_, kind_, aux_, scr_, lane_); } while (0)
    for (int L = 0; L < DEPTH; ++L) {
        WCONV(P.ffn_a_w_in + (size_t)L * D_MODEL * 2 * D_FF, 2 * D_FF, P.ffn_a_norm + (size_t)L * D_MODEL, WS_B(w_ain) + (size_t)L * 2 * D_FF * D_MODEL, 2 * D_FF, D_MODEL, CM_PAIR, D_FF);
        WCONV(P.ffn_a_w_out + (size_t)L * D_FF * D_MODEL, D_MODEL, nullptr, WS_B(w_aout) + (size_t)L * D_MODEL * D_FF, D_MODEL, D_FF, CM_PLAIN, 0);
        WCONV(P.ffn_b_w_in + (size_t)L * D_MODEL * 2 * D_FF, 2 * D_FF, P.ffn_b_norm + (size_t)L * D_MODEL, WS_B(w_bin) + (size_t)L * 2 * D_FF * D_MODEL, 2 * D_FF, D_MODEL, CM_PAIR, D_FF);
        WCONV(P.ffn_b_w_out + (size_t)L * D_FF * D_MODEL, D_MODEL, nullptr, WS_B(w_bout) + (size_t)L * D_MODEL * D_FF, D_MODEL, D_FF, CM_PLAIN, 0);
    }
    for (int L = 0; L < N_A; ++L) {
        WCONV(P.conv_w_in + (size_t)L * D_MODEL * 3 * D_MODEL, 3 * D_MODEL, P.mix_norm + (size_t)L * D_MODEL, WS_B(w_cin) + (size_t)L * 3 * D_MODEL * D_MODEL, 3 * D_MODEL, D_MODEL, CM_CONV, 0);
        WCONV(P.conv_w_out + (size_t)L * D_MODEL * D_MODEL, D_MODEL, nullptr, WS_B(w_cout) + (size_t)L * D_MODEL * D_MODEL, D_MODEL, D_MODEL, CM_PLAIN, 0);
    }
    for (int b = 0; b < N_B; ++b) {
        WCONV(P.nsa_w_qg + (size_t)b * D_MODEL * QGW, QGW, P.mix_norm + (size_t)(N_A + b) * D_MODEL, WS_B(w_qg) + (size_t)b * QGP * D_MODEL, QGP, D_MODEL, CM_HEADS, N_HEADS);
        WCONV(P.nsa_w_o + (size_t)b * HDM * D_MODEL, D_MODEL, nullptr, WS_B(w_o) + (size_t)b * D_MODEL * HDM, D_MODEL, HDM, CM_PLAIN, 0);
    }
    WCONV(P.w_kv, KVW, P.kv_norm, WS_B(w_kv), KVW, D_MODEL, CM_HEADS, 6 * N_KV);
    { KP; ITEM_LOOP((size_t)NPOS * 8) rope_item(i, WS_F(rope)); }
    { KP; const int lane_ = (int)lane_id_v(); WAVE_ITEMS(MT) hinit_row(it_, P.x_prompt, P.x_sample, WS_F(h), WS_B(hb), WS_F(rss), lane_); }
#endif
#ifndef CPU_TEST
    for (int e = 0; e < 2; ++e) WCONV(P.cmp_w1 + (size_t)e * L_CMP * HD * CMP_HID, CMP_HID, nullptr, WS_B(w1t) + (size_t)e * CMP_HID * L_CMP * HD, CMP_HID, L_CMP * HD, CM_PLAIN, 0);
    for (int e = 0; e < 2; ++e) WCONV(P.cmp_w2 + (size_t)e * CMP_HID * HD, HD, nullptr, WS_B(w2t) + (size_t)e * HD * CMP_HID, HD, CMP_HID, CM_PLAIN, 0);
    { KP; ITEM_LOOP((size_t)2 * RS_CMP * L_CMP * 8) acmp_sample_item(i, P.cache_kv, P.page_table, P.cmp_pe, WS_B(acs)); }
#endif
    GRID_SYNC();
#ifndef CPU_TEST
    { KP; pg8::Gemm g{WS_B(acs), WS_B(w1t), 2 * RS_CMP, 2 * CMP_HID, L_CMP * HD}; pg8::CmpOrder So{2 * RS_CMP / 256, RS_CMP / 256, opaque_s((int)gridDim.x), opaque_s((int)blockIdx.x)};
      pg8::EpiGelu E{WS_B(hids)}; pg8::gemm_phase<pg8::EpiGelu, pg8::CmpOrder, true, true>(wave_id, RING, g, So, E); }
    GRID_SYNC();
    { KP; const int lane_ = (int)lane_id_v(); WAVE_ITEMS(2 * RS_CMP / 32) att::cmp_out_wave(it_, WS_B(hids), RS_CMP, NBC_PAST, BATCH, WS_B(w2t), P.k_norm, WS_F(kc), WS_F(vc), nullptr, nullptr, lane_); }
    GRID_SYNC();
#endif

#ifndef CPU_TEST
#define RESID_PH(Aptr, Btptr, Kk, KSn, v_out, coef_, last_) do { \
        { KP; const int lane_ = (int)lane_id_v(); WAVE_ITEMS((MS / 32) * (D_MODEL / 32) * (KSn)) att::skinny_task(it_, (Aptr) + (size_t)MP * (Kk), Btptr, D_MODEL, Kk, KSn, WS_F(part), lane_); } \
        { KP; pg8::Gemm g{Aptr, Btptr, MP, D_MODEL, Kk}; pg8::StaticOrder So; So.init(MP, D_MODEL, opaque_s((int)gridDim.x), opaque_s((int)blockIdx.x)); \
          pg8::EpiResid E{WS_F(h), WS_B(hb), WS_F(rss) + (size_t)(v_out) * MT, (last_) ? P.out + O_YP : nullptr, coef_}; pg8::gemm_phase<pg8::EpiResid, pg8::StaticOrder, true, true>(wave_id, RING, g, So, E); } \
        GRID_SYNC(); \
        { KP; const int lane_ = (int)lane_id_v(); WAVE_ITEMS(MS) att::resid_reduce_row(it_, WS_F(part), KSn, coef_, WS_F(h), WS_B(hb), WS_F(rss) + (size_t)(v_out) * MT, (last_) ? P.out + O_YP : nullptr, lane_); } \
        GRID_SYNC(); } while (0)
#define FFN_OPT(wi, wo, v_in, last) do { \
        { KP; pg8::Gemm g{WS_B(hb), WS_B(wi) + (size_t)layer * 2 * D_FF * D_MODEL, MT, 2 * D_FF, D_MODEL}; pg8::StaticOrder So; So.init(MT, 2 * D_FF, opaque_s((int)gridDim.x), opaque_s((int)blockIdx.x)); \
          pg8::EpiSwiglu E{WS_B(act), WS_F(rss) + (size_t)(v_in) * MT}; pg8::gemm_phase<pg8::EpiSwiglu, pg8::StaticOrder, true, true>(wave_id, RING, g, So, E); } \
        GRID_SYNC(); \
        RESID_PH(WS_B(act), WS_B(wo) + (size_t)layer * D_MODEL * D_FF, D_FF, 8, (v_in) + 1, 0.5f, last); } while (0)
#else
#define FFN_OPT(wi, wo, v_in, last) do { KP; \
        ITEM_LOOP((size_t)MT * D_FF) ref_ffn_in_item(i, WS_B(hb), WS_F(rss) + (size_t)(v_in) * MT, WS_B(wi) + (size_t)layer * 2 * D_FF * D_MODEL, WS_B(act)); \
        ITEM_LOOP(MT) ref_resid_row_item(i, WS_B(act), D_FF, WS_B(wo) + (size_t)layer * D_MODEL * D_FF, 0.5f, WS_F(h), WS_B(hb), WS_F(rss) + (size_t)((v_in) + 1) * MT, (last) ? P.out + O_YP : nullptr); } while (0)
#endif
#ifndef CPU_TEST
#define GEMM_PH(EpiT, Aptr, Btptr, Nn, Kk, ...) do { { KP; pg8::Gemm g{Aptr, Btptr, MT, Nn, Kk}; pg8::StaticOrder So; So.init(MT, Nn, opaque_s((int)gridDim.x), opaque_s((int)blockIdx.x)); \
        pg8::EpiT E{__VA_ARGS__}; pg8::gemm_phase<pg8::EpiT, pg8::StaticOrder, true, true>(wave_id, RING, g, So, E); } GRID_SYNC(); } while (0)
#endif
    for (int layer = 0; layer < DEPTH; ++layer) {
        FFN_OPT(w_ain, w_aout, 3 * layer, false);
        const int v1 = 3 * layer + 1;
        if (layer < N_A) {
#ifndef CPU_TEST
            { KP; const int lane_ = (int)lane_id_v(); WAVE_ITEMS((MS / 32) * (3 * D_MODEL / 32) * 2) att::skinny_task(it_, WS_B(hb) + (size_t)MP * D_MODEL, WS_B(w_cin) + (size_t)layer * 3 * D_MODEL * D_MODEL, 3 * D_MODEL, D_MODEL, 2, WS_F(part), lane_); }
            { KP; pg8::Gemm g{WS_B(hb), WS_B(w_cin) + (size_t)layer * 3 * D_MODEL * D_MODEL, MP, 3 * D_MODEL, D_MODEL}; pg8::StaticOrder So; So.init(MP, 3 * D_MODEL, opaque_s((int)gridDim.x), opaque_s((int)blockIdx.x));
              pg8::EpiConvIn E{WS_B(ub), WS_B(bb), WS_F(rss) + (size_t)v1 * MT, P.out, layer}; pg8::gemm_phase<pg8::EpiConvIn, pg8::StaticOrder, true, true>(wave_id, RING, g, So, E); }
            GRID_SYNC();
#else
            PH((size_t)MT * D_MODEL, ref_conv_in_item(i, WS_B(hb), WS_F(rss) + (size_t)v1 * MT, WS_B(w_cin) + (size_t)layer * 3 * D_MODEL * D_MODEL, WS_B(ub), WS_B(bb), P.out, layer));
#endif
#ifndef CPU_TEST
            { KP; ITEM_LOOP((size_t)MS * (D_MODEL / 8)) conv_thin_sample_item(i, WS_F(part), 2, WS_F(rss) + (size_t)v1 * MT, P.state_conv + (size_t)layer * DEC_BATCH * 2 * D_MODEL, P.conv_w + (size_t)layer * 3 * D_MODEL, WS_B(zb), P.out, layer); }
            PH((size_t)MP * (D_MODEL / 8), conv_thin_vec_item(i, WS_B(ub), WS_B(bb), P.state_conv + (size_t)layer * DEC_BATCH * 2 * D_MODEL, P.conv_w + (size_t)layer * 3 * D_MODEL, WS_B(zb)));
#else
            PH((size_t)MT * D_MODEL, conv_thin_item(i, WS_B(ub), WS_B(bb), P.state_conv + (size_t)layer * DEC_BATCH * 2 * D_MODEL, P.conv_w + (size_t)layer * 3 * D_MODEL, WS_B(zb)));
#endif
#ifndef CPU_TEST
            RESID_PH(WS_B(zb), WS_B(w_cout) + (size_t)layer * D_MODEL * D_MODEL, D_MODEL, 8, v1 + 1, 1.0f, false);
#else
            PH(MT, ref_resid_row_item(i, WS_B(zb), D_MODEL, WS_B(w_cout) + (size_t)layer * D_MODEL * D_MODEL, 1.0f, WS_F(h), WS_B(hb), WS_F(rss) + (size_t)(v1 + 1) * MT, nullptr));
#endif
        } else {
            const int b = layer - N_A;
#ifndef CPU_TEST
            GEMM_PH(EpiQG, WS_B(hb), WS_B(w_qg) + (size_t)b * QGP * D_MODEL, QGP, D_MODEL, WS_B(qnb), WS_B(qrb), WS_F(gates), WS_F(rss) + (size_t)v1 * MT, P.nsa_q_norm + (size_t)b * HD, WS_F(rope));
#else
            { KP; ITEM_LOOP((size_t)MT * N_HEADS) ref_qg_item(i, WS_B(hb), WS_F(rss) + (size_t)v1 * MT, WS_B(w_qg) + (size_t)b * QGP * D_MODEL, P.nsa_q_norm + (size_t)b * HD, WS_F(rope), WS_F(qn), WS_F(qr)); }
            PH((size_t)MT * 3 * N_HEADS, ref_gates_item(i, WS_B(hb), WS_F(rss) + (size_t)v1 * MT, WS_B(w_qg) + (size_t)b * QGP * D_MODEL, WS_F(gates)));
#endif
#ifndef CPU_TEST
            { KP; att::Tensors T{WS_B(qnb), WS_B(qrb), P.ws + WSM.ksel, P.ws + WSM.vsel, P.ws + WSM.kwin, P.ws + WSM.vwin, P.ws + WSM.kci, P.ws + WSM.vci, WS_F(gates), WS_B(ob)};
              int wv = wave_id; asm volatile("" : "+s"(wv));
              att::phase(T, (att::ldsp)lds, wv, (int)lane_id_v(), opaque_s((int)blockIdx.x), opaque_s((int)gridDim.x)); }
            { KP; att::STensors T{WS_B(qnb), WS_B(qrb), WS_F(kc), WS_F(vc), P.cache_kv, P.page_table, P.cache_win, P.out, WS_F(winrows), WS_F(gates), WS_B(ob)};
              int wv = wave_id; asm volatile("" : "+s"(wv));
              att::sample_phase(T, (att::ldsp)lds, wv, (int)lane_id_v(), opaque_s((int)blockIdx.x), opaque_s((int)gridDim.x)); }
            GRID_SYNC();
#else
            PH((size_t)MT * N_HEADS, attn_cmp_item(i, WS_F(qn), WS_F(kc), WS_F(vc), WS_F(pbuf), WS_F(oc)));
            PH((size_t)MT * N_KV, topk_item(i, WS_F(pbuf), (int*)WS_F(sel), WS_F(scorebuf)));
            PH((size_t)MT * N_HEADS, attn_sel_item(i, KVSRC, WS_F(qr), (const int*)WS_F(sel), WS_F(os)));
            PH((size_t)MT * N_HEADS, attn_win_item(i, P.cache_win, WS_F(winrows), WS_F(qr), WS_F(gates), WS_F(oc), WS_F(os), WS_B(ob)));
#endif
#ifndef CPU_TEST
            RESID_PH(WS_B(ob), WS_B(w_o) + (size_t)b * D_MODEL * HDM, HDM, 8, v1 + 1, 1.0f, false);
#else
            PH(MT, ref_resid_row_item(i, WS_B(ob), HDM, WS_B(w_o) + (size_t)b * D_MODEL * HDM, 1.0f, WS_F(h), WS_B(hb), WS_F(rss) + (size_t)(v1 + 1) * MT, nullptr));
#endif
        }
        FFN_OPT(w_bin, w_bout, 3 * layer + 2, layer == DEPTH - 1);
        if (layer == N_A - 1) {
            const int v3 = 3 * layer + 3;
#ifndef CPU_TEST
            { KP; pg8::Gemm g{WS_B(hb), WS_B(w_kv), MT, KVW, D_MODEL}; pg8::StaticOrder So; So.init(MT, KVW, opaque_s((int)gridDim.x), opaque_s((int)blockIdx.x));
              pg8::EpiKV E{P.out, WS_F(winrows), WS_F(rss) + (size_t)v3 * MT, P.k_norm, WS_F(rope), P.ws + WSM.ksel, P.ws + WSM.vsel, P.ws + WSM.kwin, P.ws + WSM.vwin, WS_B(acp), P.cmp_pe}; pg8::gemm_phase<pg8::EpiKV, pg8::StaticOrder, true, true>(wave_id, RING, g, So, E); }
#else
            { KP; ITEM_LOOP((size_t)MT * 6 * N_KV) ref_kv_item(i, WS_B(hb), WS_F(rss) + (size_t)v3 * MT, WS_B(w_kv), P.k_norm, WS_F(rope), P.out, WS_F(winrows)); }
#endif
            PH((size_t)DEC_BATCH * (WINDOW - DEC_SEQ) * 2 * N_KV * HD, wincopy_item(i, P.cache_win, P.out));
#ifdef CPU_TEST
            PH((size_t)NSEQ * NBC_MAX * 2 * N_KV * CMP_HID, cmp_hid_item(i, KVSRC, P.cmp_pe, P.cmp_w1, WS_F(hid)));
            PH((size_t)NSEQ * NBC_MAX * 2 * N_KV, cmp_out_item(i, WS_F(hid), P.cmp_w2, P.k_norm, WS_F(kc), WS_F(vc)));
#else
            { KP; pg8::Gemm g{WS_B(acp), WS_B(w1t), 2 * RP_CMP, 2 * CMP_HID, L_CMP * HD}; pg8::CmpOrder So{2 * RP_CMP / 256, RP_CMP / 256, opaque_s((int)gridDim.x), opaque_s((int)blockIdx.x)};
              pg8::EpiGelu E{WS_B(hidp)}; pg8::gemm_phase<pg8::EpiGelu, pg8::CmpOrder, true, true>(wave_id, RING, g, So, E); }
            GRID_SYNC();
            { KP; const int lane_ = (int)lane_id_v(); WAVE_ITEMS(2 * RP_CMP / 32) att::cmp_out_wave(it_, WS_B(hidp), RP_CMP, NBC_P, 0, WS_B(w2t), P.k_norm, WS_F(kc), WS_F(vc), P.ws + WSM.kci, P.ws + WSM.vci, lane_); }
            GRID_SYNC();
#endif
        }
    }
}

extern "C" void kernel_launch(void* const* d_in, const int* in_sizes, int n_in, void* d_out, int out_size, void* d_ws, size_t ws_size, hipStream_t stream) {
    Params P{};
    P.x_prompt = (const float*)d_in[0]; P.x_sample = (const float*)d_in[1]; P.cache_kv = (const float*)d_in[2]; P.cache_win = (const float*)d_in[3];
    P.state_conv = (const float*)d_in[4]; P.page_table = (const int*)d_in[5]; P.ffn_a_norm = (const float*)d_in[6]; P.ffn_a_w_in = (const float*)d_in[7];
    P.ffn_a_w_out = (const float*)d_in[8]; P.mix_norm = (const float*)d_in[9]; P.ffn_b_norm = (const float*)d_in[10]; P.ffn_b_w_in = (const float*)d_in[11];
    P.ffn_b_w_out = (const float*)d_in[12]; P.conv_w_in = (const float*)d_in[13]; P.conv_w = (const float*)d_in[14]; P.conv_w_out = (const float*)d_in[15];
    P.kv_norm = (const float*)d_in[16]; P.w_kv = (const float*)d_in[17]; P.k_norm = (const float*)d_in[18]; P.cmp_pe = (const float*)d_in[19];
    P.cmp_w1 = (const float*)d_in[20]; P.cmp_w2 = (const float*)d_in[21]; P.nsa_w_qg = (const float*)d_in[22]; P.nsa_q_norm = (const float*)d_in[23];
    P.nsa_w_o = (const float*)d_in[24];
    P.out = (float*)d_out; P.ws = (unsigned char*)d_ws;
#ifndef CPU_TEST
    static int grid = 0;
    if (grid == 0) {
        int dev = 0, cus = 0, per_cu = 0;
        hipGetDevice(&dev); hipDeviceGetAttribute(&cus, hipDeviceAttributeMultiprocessorCount, dev);
        hipFuncSetAttribute((const void*)mega, hipFuncAttributeMaxDynamicSharedMemorySize, LDS_BYTES);
        hipOccupancyMaxActiveBlocksPerMultiprocessor(&per_cu, (const void*)mega, NTHREADS, LDS_BYTES);
        (void)hipGetLastError();
        grid = cus;
    }
    hipMemsetAsync(d_ws, 0, WS_ZERO_BYTES, stream);
    hipLaunchKernelGGL(mega, dim3(grid), dim3(NTHREADS), LDS_BYTES, stream, P);
#else
    memset(d_ws, 0, WS_ZERO_BYTES);
    mega(P);
#endif
}
```

```cpp
#ifdef CPU_TEST
#include "shim.h"
#else
#include <hip/hip_runtime.h>
#endif
#include <cstdint>
#include <cstddef>
#include <cmath>
#include <cstring>
typedef unsigned short bf16_t;
#ifndef CPU_TEST
#define HOSTDEV __host__ __device__
#else
#define HOSTDEV
#endif
HOSTDEV inline bf16_t f2bf(float f) { unsigned u; memcpy(&u, &f, 4); u = (u + 0x7fffu + ((u >> 16) & 1u)) >> 16; return (bf16_t)u; }
HOSTDEV inline float bf2f(bf16_t b) { unsigned u = (unsigned)b << 16; float f; memcpy(&f, &u, 4); return f; }

#ifdef CFG_SMALL
constexpr int D_MODEL = 256, BATCH = 1, SEQ = 2048, DEPTH = 4, DEC_BATCH = 2, DEC_SEQ = 8, PAST_LEN = 2048, PAGE_SIZE = 128, D_FF = 256, N_HEADS = 4, N_KV = 2;
#else
constexpr int D_MODEL = 1024, BATCH = 4, SEQ = 4096, DEPTH = 4, DEC_BATCH = 32, DEC_SEQ = 8, PAST_LEN = 8192, PAGE_SIZE = 128, D_FF = 2816, N_HEADS = 16, N_KV = 4;
#endif
constexpr int N_A = DEPTH / 2, N_B = DEPTH - N_A, HD = 64, HPG = N_HEADS / N_KV, L_CMP = 32, L_SEL = 64, N_SEL = 16, WINDOW = 512, CMP_HID = 4 * HD;
constexpr int MP = BATCH * SEQ, MS = DEC_BATCH * DEC_SEQ, MT = MP + MS, NSEQ = BATCH + DEC_BATCH;
constexpr int N_PAGES = PAST_LEN / PAGE_SIZE;
constexpr int KVW = 6 * N_KV * HD;
constexpr int QGW = N_HEADS * HD + 3 * N_HEADS;
constexpr int HDM = N_HEADS * HD;
constexpr int TPAD_S = ((PAST_LEN + DEC_SEQ + L_SEL - 1) / L_SEL) * L_SEL;
constexpr int NBC_P = SEQ / L_CMP, NBC_S = TPAD_S / L_CMP, NBC_MAX = NBC_S > NBC_P ? NBC_S : NBC_P;
constexpr int NBS_P = SEQ / L_SEL, NBS_S = TPAD_S / L_SEL, NBS_MAX = NBS_S > NBS_P ? NBS_S : NBS_P;
constexpr float EPS = 1e-6f, NEGF = -1e30f, TINYF = 1e-30f, FORCE_SCORE = 1e4f;
__device__ static const float INV_FREQ[8] = {1.0f, 0.1939227432012558f, 0.03760603070259094f, 0.007292664609849453f, 0.0014142135623842478f, 0.00027424818836152554f, 5.3182957344688475e-05f, 1.0313385246263351e-05f};

constexpr size_t O_YP = 0, O_YS = O_YP + (size_t)MP * D_MODEL, O_KVP = O_YS + (size_t)MS * D_MODEL, O_KVS = O_KVP + (size_t)MP * 4 * N_KV * HD,
                 O_WP = O_KVS + (size_t)MS * 4 * N_KV * HD, O_WS = O_WP + (size_t)BATCH * WINDOW * 2 * N_KV * HD, O_CP = O_WS + (size_t)DEC_BATCH * WINDOW * 2 * N_KV * HD,
                 O_CS = O_CP + (size_t)N_A * BATCH * 2 * D_MODEL, O_END = O_CS + (size_t)N_A * DEC_BATCH * 2 * D_MODEL;

struct RowInfo { int seq, t, pos; };
__device__ __host__ inline RowInfo row_info(int m) {
    RowInfo r;
    if (m < MP) { r.seq = m / SEQ; r.t = m % SEQ; r.pos = r.t; }
    else { const int q = m - MP; r.seq = BATCH + q / DEC_SEQ; r.t = q % DEC_SEQ; r.pos = PAST_LEN + r.t; }
    return r;
}
__device__ __host__ inline int seq_row0(int seq) { return seq < BATCH ? seq * SEQ : MP + (seq - BATCH) * DEC_SEQ; }
__device__ __host__ inline int seq_pos0(int seq) { return seq < BATCH ? 0 : PAST_LEN; }
__device__ __host__ inline int seq_len(int seq) { return seq < BATCH ? SEQ : DEC_SEQ; }

__device__ inline void copy_item(size_t i_, const float* a, float* b, size_t n) {
    const size_t i = i_;
    if (i < n) b[i] = a[i];
}
__device__ inline void rmsnorm_item(size_t i_, const float* x, const float* g, float* y, int rows, int d) {
    const int m = (int)i_;
    if (m >= rows) return;
    const float* xr = x + (size_t)m * d; float s = 0.f;
    for (int i = 0; i < d; ++i) s += xr[i] * xr[i];
    const float r = 1.0f / sqrtf(s / d + EPS);
    float* yr = y + (size_t)m * d;
    for (int i = 0; i < d; ++i) yr[i] = xr[i] * r * g[i];
}
__device__ inline void gemm_item(size_t i_, const float* A, int lda, const float* W, float* C, int M, int N, int K) {
    const int nbx = (N + 63) / 64; const int vb = (int)(i_ / 256), t_ = (int)(i_ % 256), tx = t_ % 16, ty = t_ / 16;
    const int c0 = (vb % nbx) * 64 + tx * 4, r0 = (vb / nbx) * 64 + ty * 4;
    if (c0 >= N || r0 >= M) return;
    float acc[4][4];
    for (int i = 0; i < 4; ++i) for (int j = 0; j < 4; ++j) acc[i][j] = 0.f;
    const int nr = (M - r0) < 4 ? (M - r0) : 4;
    for (int k = 0; k < K; k += 4) {
        float a[4][4], w[4][4];
        for (int i = 0; i < 4; ++i) for (int kk = 0; kk < 4; ++kk) a[i][kk] = (i < nr) ? A[(size_t)(r0 + i) * lda + k + kk] : 0.f;
        for (int kk = 0; kk < 4; ++kk) for (int j = 0; j < 4; ++j) w[kk][j] = W[(size_t)(k + kk) * N + c0 + j];
        for (int i = 0; i < 4; ++i) for (int kk = 0; kk < 4; ++kk) for (int j = 0; j < 4; ++j) acc[i][j] += a[i][kk] * w[kk][j];
    }
    for (int i = 0; i < nr; ++i) for (int j = 0; j < 4; ++j) C[(size_t)(r0 + i) * N + c0 + j] = acc[i][j];
}
__device__ inline void swiglu_item(size_t i_, const float* t1, float* act, int rows, int dff) {
    const size_t i = i_;
    if (i >= (size_t)rows * dff) return;
    const int m = (int)(i / dff), j = (int)(i % dff);
    const float g = t1[(size_t)m * 2 * dff + j], u = t1[(size_t)m * 2 * dff + dff + j];
    act[i] = g / (1.0f + expf(-g)) * u;
}
__device__ inline void axpy_item(size_t i_, float* h, const float* y, float coef, size_t n) {
    const size_t i = i_;
    if (i < n) h[i] += coef * y[i];
}
__device__ inline void conv_item(size_t i_, const float* t1, const float* state  , const float* wc  , float* z, float* out, int layer) {
    const size_t i = i_;
    if (i >= (size_t)MT * D_MODEL) return;
    const int m = (int)(i / D_MODEL), ch = (int)(i % D_MODEL);
    const RowInfo ri = row_info(m);
    const float* r = t1 + (size_t)m * 3 * D_MODEL;
    const float b = r[ch], u0 = r[D_MODEL + ch] * r[2 * D_MODEL + ch];
    float u1, u2;
    if (ri.t >= 1) { const float* p = r - 3 * D_MODEL; u1 = p[D_MODEL + ch] * p[2 * D_MODEL + ch]; }
    else u1 = (ri.seq < BATCH) ? 0.f : state[((size_t)(ri.seq - BATCH) * 2 + 1) * D_MODEL + ch];
    if (ri.t >= 2) { const float* p = r - 6 * D_MODEL; u2 = p[D_MODEL + ch] * p[2 * D_MODEL + ch]; }
    else if (ri.seq < BATCH) u2 = 0.f;
    else u2 = (ri.t == 1) ? state[((size_t)(ri.seq - BATCH) * 2 + 1) * D_MODEL + ch] : state[((size_t)(ri.seq - BATCH) * 2 + 0) * D_MODEL + ch];
    z[i] = b * (wc[ch] * u2 + wc[D_MODEL + ch] * u1 + wc[2 * D_MODEL + ch] * u0);
    const int L = seq_len(ri.seq);
    if (ri.t >= L - 2) {
        const int j = ri.t - (L - 2);
        if (ri.seq < BATCH) out[O_CP + (((size_t)layer * BATCH + ri.seq) * 2 + j) * D_MODEL + ch] = u0;
        else out[O_CS + (((size_t)layer * DEC_BATCH + (ri.seq - BATCH)) * 2 + j) * D_MODEL + ch] = u0;
    }
}
__device__ inline void head_norm(float* v, const float* g) {
    float s = 0.f; for (int d = 0; d < HD; ++d) s += v[d] * v[d];
    const float r = 1.0f / sqrtf(s / HD + EPS);
    for (int d = 0; d < HD; ++d) v[d] = v[d] * r * g[d];
}
__device__ inline void rope_cs(float ang, float& c, float& s) {
    const double r = (double)ang * 0.15915494309189535; const float fr = (float)(r - rint(r));
#ifdef CPU_TEST
    c = (float)cos(6.283185307179586 * (double)fr); s = (float)sin(6.283185307179586 * (double)fr);
#else
    c = __builtin_amdgcn_cosf(fr); s = __builtin_amdgcn_sinf(fr);
#endif
}
__device__ inline void head_rope(float* v, int pos) {
    for (int i = 0; i < 8; ++i) {
        const float ang = (float)pos * INV_FREQ[i]; float c, s; rope_cs(ang, c, s);
        const float x1 = v[i], x2 = v[8 + i];
        v[i] = x1 * c - x2 * s; v[8 + i] = x2 * c + x1 * s;
    }
}
__device__ inline void kvprep_item(size_t i_, const float* p, const float* k_norm  , float* out, float* winrows) {
    const int i = (int)i_;
    if (i >= MT * 6 * N_KV) return;
    const int m = i / (6 * N_KV), e = (i / N_KV) % 6, g = i % N_KV;
    const RowInfo ri = row_info(m);
    float v[HD];
    for (int d = 0; d < HD; ++d) v[d] = p[(size_t)m * KVW + (e * N_KV + g) * HD + d];
    if (e == 2) { head_norm(v, k_norm + HD); head_rope(v, ri.pos); }
    if (e == 4) { head_norm(v, k_norm + 2 * HD); head_rope(v, ri.pos); }
    if (e < 4) {
        float* o = (ri.seq < BATCH) ? out + O_KVP + (((size_t)m * 4 + e) * N_KV + g) * HD : out + O_KVS + (((size_t)(m - MP) * 4 + e) * N_KV + g) * HD;
        for (int d = 0; d < HD; ++d) o[d] = v[d];
    } else {
        const int we = e - 4;
        float* w = winrows + (((size_t)m * 2 + we) * N_KV + g) * HD;
        for (int d = 0; d < HD; ++d) w[d] = v[d];
        if (ri.seq < BATCH) { if (ri.t >= SEQ - WINDOW) { float* o = out + O_WP + ((((size_t)ri.seq * WINDOW + (ri.t - (SEQ - WINDOW))) * 2 + we) * N_KV + g) * HD; for (int d = 0; d < HD; ++d) o[d] = v[d]; } }
        else { float* o = out + O_WS + ((((size_t)(ri.seq - BATCH) * WINDOW + (WINDOW - DEC_SEQ + ri.t)) * 2 + we) * N_KV + g) * HD; for (int d = 0; d < HD; ++d) o[d] = v[d]; }
    }
}
__device__ inline void wincopy_item(size_t i_, const float* cache_win, float* out) {
    const size_t i = i_;
    const size_t per = (size_t)(WINDOW - DEC_SEQ) * 2 * N_KV * HD;
    if (i >= (size_t)DEC_BATCH * per) return;
    const size_t b = i / per, r = i % per;
    out[O_WS + b * WINDOW * 2 * N_KV * HD + r] = cache_win[b * WINDOW * 2 * N_KV * HD + (size_t)DEC_SEQ * 2 * N_KV * HD + r];
}
struct KvSrc { const float* cache_kv; const int* page_table; const float* out; };
__device__ inline const float* kv_full_ptr(const KvSrc& S, int seq, int tok, int e, int g) {
    if (seq < BATCH) return S.out + O_KVP + ((((size_t)seq * SEQ + tok) * 4 + e) * N_KV + g) * HD;
    const int b = seq - BATCH;
    if (tok < PAST_LEN) { const int page = S.page_table[b * N_PAGES + tok / PAGE_SIZE]; return S.cache_kv + ((((size_t)page * PAGE_SIZE + tok % PAGE_SIZE) * 4 + e) * N_KV + g) * HD; }
    if (tok < PAST_LEN + DEC_SEQ) return S.out + O_KVS + ((((size_t)b * DEC_SEQ + (tok - PAST_LEN)) * 4 + e) * N_KV + g) * HD;
    return nullptr;
}
__device__ inline int seq_nbc(int seq) { return seq < BATCH ? NBC_P : NBC_S; }
__device__ inline void cmp_hid_item(size_t i_, KvSrc S, const float* pe  , const float* w1  , float* hid) {
    const size_t i = i_;
    if (i >= (size_t)NSEQ * NBC_MAX * 2 * N_KV * CMP_HID) return;
    const int f = (int)(i % CMP_HID), g = (int)((i / CMP_HID) % N_KV), e = (int)((i / ((size_t)CMP_HID * N_KV)) % 2), c = (int)((i / ((size_t)CMP_HID * N_KV * 2)) % NBC_MAX), seq = (int)(i / ((size_t)CMP_HID * N_KV * 2 * NBC_MAX));
    if (c >= seq_nbc(seq)) return;
    float s = 0.f;
    for (int l = 0; l < L_CMP; ++l) {
        const float* r = kv_full_ptr(S, seq, c * L_CMP + l, e, g);
        const float* w = w1 + (((size_t)e * L_CMP + l) * HD) * CMP_HID + f; const float* pp = pe + ((size_t)e * L_CMP + l) * HD;
        for (int d = 0; d < HD; ++d) s += ((r ? r[d] : 0.f) + pp[d]) * w[(size_t)d * CMP_HID];
    }
    const float x = s; const float t = tanhf(0.7978845608028654f * (x + 0.044715f * x * x * x));
    hid[i] = 0.5f * x * (1.0f + t);
}
__device__ inline void cmp_out_item(size_t i_, const float* hid, const float* w2  , const float* k_norm0, float* kc, float* vc) {
    const int i = (int)i_;
    if (i >= NSEQ * NBC_MAX * 2 * N_KV) return;
    const int g = i % N_KV, e = (i / N_KV) % 2, c = (i / (2 * N_KV)) % NBC_MAX, seq = i / (2 * N_KV * NBC_MAX);
    if (c >= seq_nbc(seq)) return;
    const float* hr = hid + (size_t)i * CMP_HID;
    float v[HD];
    for (int d = 0; d < HD; ++d) { float s = 0.f; for (int f = 0; f < CMP_HID; ++f) s += hr[f] * w2[((size_t)e * CMP_HID + f) * HD + d]; v[d] = s; }
    if (e == 0) head_norm(v, k_norm0);
    float* o = (e == 0 ? kc : vc) + (((size_t)seq * NBC_MAX + c) * N_KV + g) * HD;
    for (int d = 0; d < HD; ++d) o[d] = v[d];
}
__device__ inline void qprep_item(size_t i_, const float* qg, const float* q_norm, float* qn, float* qr, float* gates) {
    const int i = (int)i_;
    if (i >= MT * N_HEADS) return;
    const int m = i / N_HEADS, hh = i % N_HEADS;
    const RowInfo ri = row_info(m);
    float v[HD];
    for (int d = 0; d < HD; ++d) v[d] = qg[(size_t)m * QGW + hh * HD + d];
    head_norm(v, q_norm);
    for (int d = 0; d < HD; ++d) qn[(size_t)m * HDM + hh * HD + d] = v[d];
    head_rope(v, ri.pos);
    for (int d = 0; d < HD; ++d) qr[(size_t)m * HDM + hh * HD + d] = v[d];
    for (int j = 0; j < 3; ++j) { const float x = qg[(size_t)m * QGW + HDM + hh * 3 + j]; gates[(size_t)m * 3 * N_HEADS + hh * 3 + j] = 1.0f / (1.0f + expf(-x)); }
}
__device__ inline void attn_cmp_item(size_t i_, const float* qn, const float* kc, const float* vc, float* pbuf, float* oc) {
    const int i = (int)i_;
    if (i >= MT * N_HEADS) return;
    const int m = i / N_HEADS, hh = i % N_HEADS, g = hh / HPG;
    const RowInfo ri = row_info(m);
    const int nbc = seq_nbc(ri.seq);
    const float* q = qn + (size_t)m * HDM + hh * HD;
    float* p = pbuf + (size_t)i * NBC_MAX;
    float mx = NEGF;
    for (int c = 0; c < nbc; ++c) {
        const bool vis = (c + 1) * L_CMP - 1 <= ri.pos;
        float s = 0.f; const float* k = kc + (((size_t)ri.seq * NBC_MAX + c) * N_KV + g) * HD;
        for (int d = 0; d < HD; ++d) s += q[d] * k[d];
        s *= 0.125f; p[c] = s; if (vis && s > mx) mx = s;
    }
    float sum = 0.f;
    for (int c = 0; c < nbc; ++c) { const bool vis = (c + 1) * L_CMP - 1 <= ri.pos; const float e = vis ? expf(p[c] - mx) : 0.f; p[c] = e; sum += e; }
    const float inv = 1.0f / fmaxf(sum, TINYF);
    float o[HD]; for (int d = 0; d < HD; ++d) o[d] = 0.f;
    for (int c = 0; c < nbc; ++c) { p[c] *= inv; if (p[c] != 0.f) { const float* v = vc + (((size_t)ri.seq * NBC_MAX + c) * N_KV + g) * HD; for (int d = 0; d < HD; ++d) o[d] += p[c] * v[d]; } }
    for (int d = 0; d < HD; ++d) oc[(size_t)m * HDM + hh * HD + d] = o[d];
}
__device__ inline void topk_item(size_t i_, const float* pbuf, int* sel, float* scorebuf  ) {
    const int i = (int)i_;
    if (i >= MT * N_KV) return;
    const int m = i / N_KV, g = i % N_KV;
    const RowInfo ri = row_info(m);
    const int nbs = ri.seq < BATCH ? NBS_P : NBS_S, cur = ri.pos / L_SEL;
    float* score = scorebuf + (size_t)i * NBS_MAX;
    for (int b = 0; b < nbs; ++b) {
        float imp = 0.f;
        for (int h = 0; h < HPG; ++h) { const float* p = pbuf + ((size_t)m * N_HEADS + g * HPG + h) * NBC_MAX; imp += p[2 * b]; }
        float imp2 = 0.f;
        for (int h = 0; h < HPG; ++h) { const float* p = pbuf + ((size_t)m * N_HEADS + g * HPG + h) * NBC_MAX; imp2 += p[2 * b + 1]; }
        const bool forced = (b == 0) || (b == cur) || (b == cur - 1), valid = b * L_SEL <= ri.pos;
        score[b] = valid ? (forced ? FORCE_SCORE : imp + imp2) : NEGF;
    }
    const int nsel = N_SEL < nbs ? N_SEL : nbs;
    for (int j = 0; j < N_SEL; ++j) {
        if (j >= nsel) { sel[(size_t)i * N_SEL + j] = -1; continue; }
        int best = -1; float bv = 0.f;
        for (int b = 0; b < nbs; ++b) if (score[b] > -3e38f && (best < 0 || score[b] > bv)) { best = b; bv = score[b]; }
        sel[(size_t)i * N_SEL + j] = best; score[best] = -3.4e38f;
    }
}
__device__ inline void attn_sel_item(size_t i_, KvSrc S, const float* qr, const int* sel, float* os) {
    const int i = (int)i_;
    if (i >= MT * N_HEADS) return;
    const int m = i / N_HEADS, hh = i % N_HEADS, g = hh / HPG;
    const RowInfo ri = row_info(m);
    const float* q = qr + (size_t)m * HDM + hh * HD;
    const int* sl = sel + ((size_t)m * N_KV + g) * N_SEL;
    float mx = NEGF;
    for (int j = 0; j < N_SEL; ++j) { const int b = sl[j]; if (b < 0) continue;
        for (int t = 0; t < L_SEL; ++t) { const int tok = b * L_SEL + t; if (tok > ri.pos) continue;
            const float* k = kv_full_ptr(S, ri.seq, tok, 2, g); float s = 0.f; if (k) for (int d = 0; d < HD; ++d) s += q[d] * k[d];
            s *= 0.125f; if (s > mx) mx = s; } }
    float sum = 0.f, o[HD]; for (int d = 0; d < HD; ++d) o[d] = 0.f;
    for (int j = 0; j < N_SEL; ++j) { const int b = sl[j]; if (b < 0) continue;
        for (int t = 0; t < L_SEL; ++t) { const int tok = b * L_SEL + t; if (tok > ri.pos) continue;
            const float* k = kv_full_ptr(S, ri.seq, tok, 2, g); float s = 0.f; if (k) for (int d = 0; d < HD; ++d) s += q[d] * k[d];
            const float e = expf(s * 0.125f - mx); sum += e;
            const float* v = kv_full_ptr(S, ri.seq, tok, 3, g); if (v) for (int d = 0; d < HD; ++d) o[d] += e * v[d]; } }
    const float inv = 1.0f / fmaxf(sum, TINYF);
    for (int d = 0; d < HD; ++d) os[(size_t)m * HDM + hh * HD + d] = o[d] * inv;
}
__device__ inline const float* win_ptr(const float* cache_win, const float* winrows, int seq, int kp) {
    if (seq < BATCH) return kp >= 0 ? winrows + (size_t)(seq * SEQ + kp) * 2 * N_KV * HD : nullptr;
    const int b = seq - BATCH;
    if (kp >= PAST_LEN) return winrows + (size_t)(MP + b * DEC_SEQ + (kp - PAST_LEN)) * 2 * N_KV * HD;
    const int j = kp - (PAST_LEN - WINDOW);
    return j >= 0 ? cache_win + ((size_t)b * WINDOW + j) * 2 * N_KV * HD : nullptr;
}
__device__ inline void attn_win_item(size_t i_, const float* cache_win, const float* winrows, const float* qr, const float* gates, const float* oc, const float* os, bf16_t* o_out) {
    const int i = (int)i_;
    if (i >= MT * N_HEADS) return;
    const int m = i / N_HEADS, hh = i % N_HEADS, g = hh / HPG;
    const RowInfo ri = row_info(m);
    const float* q = qr + (size_t)m * HDM + hh * HD;
    float mx = NEGF;
    for (int kp = ri.pos - WINDOW; kp <= ri.pos; ++kp) { const float* r = win_ptr(cache_win, winrows, ri.seq, kp); if (!r) continue;
        const float* k = r + (0 * N_KV + g) * HD; float s = 0.f; for (int d = 0; d < HD; ++d) s += q[d] * k[d]; s *= 0.125f; if (s > mx) mx = s; }
    float sum = 0.f, o[HD]; for (int d = 0; d < HD; ++d) o[d] = 0.f;
    for (int kp = ri.pos - WINDOW; kp <= ri.pos; ++kp) { const float* r = win_ptr(cache_win, winrows, ri.seq, kp); if (!r) continue;
        const float* k = r + (0 * N_KV + g) * HD; float s = 0.f; for (int d = 0; d < HD; ++d) s += q[d] * k[d];
        const float e = expf(s * 0.125f - mx); sum += e; const float* v = r + (1 * N_KV + g) * HD; for (int d = 0; d < HD; ++d) o[d] += e * v[d]; }
    const float inv = 1.0f / fmaxf(sum, TINYF);
    const float* gt = gates + (size_t)m * 3 * N_HEADS + hh * 3;
    for (int d = 0; d < HD; ++d) { const size_t x = (size_t)m * HDM + hh * HD + d; o_out[x] = f2bf(gt[0] * oc[x] + gt[1] * os[x] + gt[2] * o[d] * inv); }
}


#ifndef CPU_TEST
__device__ __forceinline__ unsigned lane_id_v() { unsigned l; asm volatile("v_mbcnt_lo_u32_b32 %0, -1, 0\n\tv_mbcnt_hi_u32_b32 %0, -1, %0" : "=v"(l)); return l; }
#endif
constexpr int NTHREADS = 512;
__host__ __device__ inline bf16_t f2bf_(float f) { unsigned u; memcpy(&u, &f, 4); u = (u + 0x7fffu + ((u >> 16) & 1u)) >> 16; return (bf16_t)u; }
__host__ __device__ inline float bf2f_(bf16_t b) { unsigned u = (unsigned)b << 16; float f; memcpy(&f, &u, 4); return f; }
constexpr int NRSS = 3 * DEPTH + 1;
constexpr int NPOS = SEQ + DEC_SEQ;
constexpr int QGP = ((QGW + 255) / 256) * 256;
__host__ __device__ inline int pos_index(int pos) { return pos < SEQ ? pos : SEQ + (pos - PAST_LEN); }

constexpr size_t IMG_SEQ_BYTES = (size_t)BATCH * N_KV * (SEQ / 64) * 8192, IMG_CMP_BYTES = (size_t)BATCH * N_KV * (NBC_P / 64 > 0 ? NBC_P / 64 : 1) * 8192;
struct WsMap {
    size_t ctl, rss, rope, h, hb, act, xn, t2, actf, ub, bb, zb, t1, qn, qr, gates, ob, winrows, hid, kc, vc, pbuf, oc, os, sel, scorebuf,
           w_ain, w_aout, w_bin, w_bout, w_cin, w_cout, w_qg, w_o, w_kv, qnb, qrb, ksel, vsel, kwin, vwin, kci, vci, acs, hids, acp, hidp, w1t, w2t, part, end;
};
constexpr size_t al256(size_t b) { return (b + 255) / 256 * 256; }
constexpr size_t smax(size_t a, size_t b) { return a > b ? a : b; }
constexpr WsMap make_ws_map() {
    WsMap w{}; size_t off = 0;
#define TAKE(f, bytes) w.f = off; off += al256(bytes)
    TAKE(ctl, 65536); TAKE(rss, (size_t)NRSS * MT * 4);
    TAKE(rope, (size_t)NPOS * 16 * 4);
    TAKE(h, (size_t)MT * D_MODEL * 4); TAKE(hb, (size_t)MT * D_MODEL * 2); TAKE(act, (size_t)MT * D_FF * 2);
    TAKE(xn, (size_t)MT * D_MODEL * 4); TAKE(t2, (size_t)MT * D_MODEL * 4); TAKE(actf, (size_t)MT * D_MODEL * 4);
    TAKE(ub, (size_t)MT * D_MODEL * 2); TAKE(bb, (size_t)MT * D_MODEL * 2); TAKE(zb, (size_t)MT * D_MODEL * 2);
    TAKE(t1, smax((size_t)MT * 3 * D_MODEL * 4, (size_t)MT * KVW * 4));
    TAKE(qn, (size_t)MT * HDM * 4); TAKE(qr, (size_t)MT * HDM * 4); TAKE(gates, (size_t)MT * 3 * N_HEADS * 4); TAKE(ob, (size_t)MT * HDM * 2);
    TAKE(winrows, (size_t)MT * 2 * N_KV * HD * 4); TAKE(hid, (size_t)NSEQ * NBC_MAX * 2 * N_KV * CMP_HID * 4);
    TAKE(kc, (size_t)NSEQ * NBC_MAX * N_KV * HD * 4); TAKE(vc, (size_t)NSEQ * NBC_MAX * N_KV * HD * 4);
    TAKE(pbuf, (size_t)MT * N_HEADS * NBC_MAX * 4); TAKE(oc, (size_t)MT * HDM * 4); TAKE(os, (size_t)MT * HDM * 4);
    TAKE(sel, (size_t)MT * N_KV * N_SEL * 4); TAKE(scorebuf, (size_t)MT * N_KV * NBS_MAX * 4);
    TAKE(w_ain, (size_t)DEPTH * 2 * D_FF * D_MODEL * 2); TAKE(w_aout, (size_t)DEPTH * D_MODEL * D_FF * 2);
    TAKE(w_bin, (size_t)DEPTH * 2 * D_FF * D_MODEL * 2); TAKE(w_bout, (size_t)DEPTH * D_MODEL * D_FF * 2);
    TAKE(w_cin, (size_t)N_A * 3 * D_MODEL * D_MODEL * 2); TAKE(w_cout, (size_t)N_A * D_MODEL * D_MODEL * 2);
    TAKE(w_qg, (size_t)N_B * QGP * D_MODEL * 2); TAKE(w_o, (size_t)N_B * D_MODEL * HDM * 2); TAKE(w_kv, (size_t)KVW * D_MODEL * 2);
    TAKE(qnb, (size_t)MT * HDM * 2); TAKE(qrb, (size_t)MT * HDM * 2); TAKE(ksel, IMG_SEQ_BYTES); TAKE(vsel, IMG_SEQ_BYTES); TAKE(kwin, IMG_SEQ_BYTES); TAKE(vwin, IMG_SEQ_BYTES); TAKE(kci, IMG_CMP_BYTES); TAKE(vci, IMG_CMP_BYTES);
    TAKE(acs, (size_t)2 * DEC_BATCH * (PAST_LEN / L_CMP) * N_KV * L_CMP * HD * 2); TAKE(hids, (size_t)2 * DEC_BATCH * (PAST_LEN / L_CMP) * N_KV * CMP_HID * 2);
    TAKE(acp, (size_t)2 * BATCH * NBC_P * N_KV * L_CMP * HD * 2); TAKE(hidp, (size_t)2 * BATCH * NBC_P * N_KV * CMP_HID * 2); TAKE(w1t, (size_t)2 * CMP_HID * L_CMP * HD * 2); TAKE(w2t, (size_t)2 * HD * CMP_HID * 2); TAKE(part, (size_t)8 * MS * 3 * D_MODEL * 4);
#undef TAKE
    w.end = off; return w;
}
constexpr WsMap WSM = make_ws_map();
constexpr size_t WS_ZERO_BYTES = 65536 + (((size_t)NRSS * MT * 4 + 255) / 256 * 256);

enum { CM_PLAIN = 0, CM_PAIR = 1, CM_CONV = 2, CM_HEADS = 3 };
__host__ __device__ inline int colmap(int kind, int n, int aux) {
    const int pn = n / 256, c = n % 256;
    if (kind == CM_PLAIN) return n;
    if (kind == CM_PAIR) return (c >= 128 ? aux : 0) + pn * 128 + (c % 128);
    if (kind == CM_CONV) { if (n < 2 * D_MODEL) return (c >= 128 ? 2 * D_MODEL : D_MODEL) + pn * 128 + (c % 128); return n - 2 * D_MODEL; }
    if (n < aux * 64) { const int bj = c / 128, wc = (c % 128) / 32, r = c % 32; return (pn * 4 + wc) * 64 + 32 * bj + r; }
    return n;
}
__device__ inline void wconv_item(size_t i_, const float* src, int Nsrc, const float* gain, bf16_t* dst, int Nd, int K, int kind, int aux) {
    const int n = (int)(i_ % Nd), kb = (int)(i_ / Nd);
    const int col = colmap(kind, n, aux);
    bf16_t* d = dst + (size_t)n * K + (size_t)kb * 64;
    if (col < 0 || col >= Nsrc) { for (int k = 0; k < 64; ++k) d[k] = 0; return; }
    const float* s = src + (size_t)kb * 64 * Nsrc + col;
#pragma unroll 8
    for (int k = 0; k < 64; k += 2) {
        const float g0 = gain ? gain[kb * 64 + k] : 1.f, g1 = gain ? gain[kb * 64 + k + 1] : 1.f;
        const unsigned lo = f2bf(s[(size_t)k * Nsrc] * g0), hi = f2bf(s[(size_t)(k + 1) * Nsrc] * g1);
        *(unsigned*)(d + k) = lo | (hi << 16);
    }
}
__device__ inline void rope_item(size_t i_, float* rope) {
    const int pi = (int)(i_ / 8), f = (int)(i_ % 8);
    const int pos = pi < SEQ ? pi : PAST_LEN + (pi - SEQ);
    float c, s; rope_cs((float)pos * INV_FREQ[f], c, s);
    rope[pi * 16 + f] = c; rope[pi * 16 + 8 + f] = s;
}
__device__ inline void hinit_item(size_t i_, const float* xp, const float* xs, float* h, bf16_t* hb, float* rss0) {
    const int m = (int)i_; const float* x = m < MP ? xp + (size_t)m * D_MODEL : xs + (size_t)(m - MP) * D_MODEL;
    float s = 0.f;
    for (int k = 0; k < D_MODEL; ++k) { const float v = x[k]; s += v * v; h[(size_t)m * D_MODEL + k] = v; hb[(size_t)m * D_MODEL + k] = f2bf(v); }
    rss0[m] = s;
}
__device__ inline void hupd_item(size_t i_, float* h, const float* y, float coef, bf16_t* hb, float* rss) {
    const int m = (int)i_; float s = 0.f;
    for (int k = 0; k < D_MODEL; ++k) { const float v = h[(size_t)m * D_MODEL + k] + coef * y[(size_t)m * D_MODEL + k]; s += v * v; h[(size_t)m * D_MODEL + k] = v; hb[(size_t)m * D_MODEL + k] = f2bf(v); }
    rss[m] = s;
}
__device__ inline float dot_bf(const bf16_t* a, const bf16_t* b, int K) { float s = 0.f; for (int k = 0; k < K; ++k) s += bf2f(a[k]) * bf2f(b[k]); return s; }
__device__ inline float silu_f(float g) { return g / (1.0f + expf(-g)); }
__device__ inline void ref_ffn_in_item(size_t i_, const bf16_t* hb, const float* rss, const bf16_t* Bt, bf16_t* act) {
    const int m = (int)(i_ / D_FF), j = (int)(i_ % D_FF);
    const float rs = 1.0f / sqrtf(rss[m] / D_MODEL + EPS);
    const int ng = (j / 128) * 256 + (j % 128);
    const float g = rs * dot_bf(hb + (size_t)m * D_MODEL, Bt + (size_t)ng * D_MODEL, D_MODEL), u = rs * dot_bf(hb + (size_t)m * D_MODEL, Bt + (size_t)(ng + 128) * D_MODEL, D_MODEL);
    act[i_] = f2bf(silu_f(g) * u);
}
__device__ inline void ref_resid_row_item(size_t i_, const bf16_t* A, int K, const bf16_t* Bt, float coef, float* h, bf16_t* hb, float* rss_next, float* yout) {
    const int m = (int)i_; float s = 0.f;
    for (int c = 0; c < D_MODEL; ++c) {
        const float v = h[(size_t)m * D_MODEL + c] + coef * dot_bf(A + (size_t)m * K, Bt + (size_t)c * K, K);
        if (yout) { yout[(size_t)m * D_MODEL + c] = v; } else { h[(size_t)m * D_MODEL + c] = v; hb[(size_t)m * D_MODEL + c] = f2bf(v); s += v * v; }
    }
    if (!yout) rss_next[m] = s;
}

constexpr float QSCALE_F = 0.125f * 1.4426950408889634f;
__device__ inline void qconv_item(size_t i_, const float* qn, const float* qr, bf16_t* qnb, bf16_t* qrb) { qnb[i_] = f2bf(qn[i_] * QSCALE_F); qrb[i_] = f2bf(qr[i_] * QSCALE_F); }
__host__ __device__ inline size_t kimg_off(int kv, int d0) { return (size_t)(d0 >> 3) * 1024 + (size_t)kv * 16; }
__host__ __device__ inline size_t vimg_off(int kv, int d0) { return (size_t)(d0 >> 5) * 4096 + (size_t)(kv >> 3) * 512 + (size_t)(kv & 7) * 64 + (size_t)((d0 & 31) >> 3) * 16; }
__device__ inline void put_chunk(unsigned char* dst, const float* src) { bf16_t* d = (bf16_t*)dst; for (int k = 0; k < 8; ++k) d[k] = f2bf(src[k]); }
__device__ inline void kvimg_item(size_t i_, const float* out, const float* winrows, unsigned char* ksel, unsigned char* vsel, unsigned char* kwin, unsigned char* vwin) {
    const int c = (int)(i_ % 8), t = (int)((i_ / 8) % SEQ), g = (int)((i_ / (8 * (size_t)SEQ)) % N_KV), n = (int)(i_ / (8 * (size_t)SEQ * N_KV));
    const size_t base = (((size_t)n * N_KV + g) * (SEQ / 64) + t / 64) * 8192; const int kv = t % 64, d0 = 8 * c; const size_t m = (size_t)n * SEQ + t;
    put_chunk(ksel + base + kimg_off(kv, d0), out + O_KVP + ((m * 4 + 2) * N_KV + g) * HD + d0);
    put_chunk(vsel + base + vimg_off(kv, d0), out + O_KVP + ((m * 4 + 3) * N_KV + g) * HD + d0);
    put_chunk(kwin + base + kimg_off(kv, d0), winrows + ((m * 2 + 0) * N_KV + g) * HD + d0);
    put_chunk(vwin + base + vimg_off(kv, d0), winrows + ((m * 2 + 1) * N_KV + g) * HD + d0);
}
__device__ inline void kcimg_item(size_t i_, const float* kc, const float* vc, unsigned char* kci, unsigned char* vci) {
    const int c = (int)(i_ % 8), cb = (int)((i_ / 8) % NBC_P), g = (int)((i_ / (8 * (size_t)NBC_P)) % N_KV), n = (int)(i_ / (8 * (size_t)NBC_P * N_KV));
    const size_t base = (((size_t)n * N_KV + g) * (NBC_P / 64) + cb / 64) * 8192; const int kv = cb % 64, d0 = 8 * c;
    put_chunk(kci + base + kimg_off(kv, d0), kc + (((size_t)n * NBC_MAX + cb) * N_KV + g) * HD + d0);
    put_chunk(vci + base + vimg_off(kv, d0), vc + (((size_t)n * NBC_MAX + cb) * N_KV + g) * HD + d0);
}

constexpr int NBC_PAST = PAST_LEN / L_CMP;
constexpr int RS_CMP = DEC_BATCH * NBC_PAST * N_KV, RP_CMP = BATCH * NBC_P * N_KV;
__device__ inline void acmp_sample_item(size_t i_, const float* cache_kv, const int* page_table, const float* pe, bf16_t* A) {
    const int c8 = (int)(i_ % 8), l = (int)((i_ / 8) % L_CMP); const size_t rr = i_ / (8 * L_CMP); const int r = (int)(rr % RS_CMP), e = (int)(rr / RS_CMP);
    const int g = r % N_KV, c = (r / N_KV) % NBC_PAST, b = r / (N_KV * NBC_PAST), tok = c * L_CMP + l;
    const int page = page_table[b * N_PAGES + tok / PAGE_SIZE];
    const float* src = cache_kv + ((((size_t)page * PAGE_SIZE + tok % PAGE_SIZE) * 4 + e) * N_KV + g) * HD + 8 * c8; const float* pp = pe + ((size_t)e * L_CMP + l) * HD + 8 * c8;
    bf16_t* d = A + ((size_t)e * RS_CMP + r) * (L_CMP * HD) + l * HD + 8 * c8;
#ifndef CPU_TEST
    typedef float f4 __attribute__((ext_vector_type(4))); typedef unsigned u4 __attribute__((ext_vector_type(4)));
    const f4 a0 = __builtin_nontemporal_load((const f4*)src) + *(const f4*)pp, a1 = __builtin_nontemporal_load((const f4*)(src + 4)) + *(const f4*)(pp + 4);
    u4 w; w.x = (unsigned)f2bf(a0[0]) | ((unsigned)f2bf(a0[1]) << 16); w.y = (unsigned)f2bf(a0[2]) | ((unsigned)f2bf(a0[3]) << 16);
    w.z = (unsigned)f2bf(a1[0]) | ((unsigned)f2bf(a1[1]) << 16); w.w = (unsigned)f2bf(a1[2]) | ((unsigned)f2bf(a1[3]) << 16);
    *(u4*)d = w;
#else
    for (int k = 0; k < 8; ++k) d[k] = f2bf(src[k] + pp[k]);
#endif
}
__device__ inline void acmp_prompt_item(size_t i_, const float* out, const float* pe, bf16_t* A) {
    const int c8 = (int)(i_ % 8), l = (int)((i_ / 8) % L_CMP); const size_t rr = i_ / (8 * L_CMP); const int r = (int)(rr % RP_CMP), e = (int)(rr / RP_CMP);
    const int g = r % N_KV, c = (r / N_KV) % NBC_P, n = r / (N_KV * NBC_P), tok = c * L_CMP + l;
    const float* src = out + O_KVP + ((((size_t)n * SEQ + tok) * 4 + e) * N_KV + g) * HD + 8 * c8; const float* pp = pe + ((size_t)e * L_CMP + l) * HD + 8 * c8;
    bf16_t* d = A + ((size_t)e * RP_CMP + r) * (L_CMP * HD) + l * HD + 8 * c8;
    for (int k = 0; k < 8; ++k) d[k] = f2bf(src[k] + pp[k]);
}
__device__ inline void cmp_out_b_item(size_t i_, const bf16_t* hid, int R, int nbc, int seq0, const float* w2, const float* k_norm0, float* kc, float* vc) {
    const int r = (int)(i_ % R), e = (int)(i_ / R); const int g = r % N_KV, c = (r / N_KV) % nbc, sq = r / (N_KV * nbc);
    const bf16_t* hr = hid + ((size_t)e * R + r) * CMP_HID;
    float v[HD];
    for (int d = 0; d < HD; ++d) v[d] = 0.f;
    for (int f = 0; f < CMP_HID; ++f) { const float hf = bf2f(hr[f]); const float* w = w2 + ((size_t)e * CMP_HID + f) * HD; for (int d = 0; d < HD; ++d) v[d] += hf * w[d]; }
    if (e == 0) head_norm(v, k_norm0);
    float* o = (e == 0 ? kc : vc) + (((size_t)(seq0 + sq) * NBC_MAX + c) * N_KV + g) * HD;
    for (int d = 0; d < HD; ++d) o[d] = v[d];
}
__host__ __device__ inline int heads_row(int hidx, int d) { return (hidx / 4) * 256 + 128 * (d / 32) + 32 * (hidx % 4) + (d % 32); }
__device__ inline void conv_state_store(float* out, int layer, int m, int ch, float u) {
    const RowInfo ri = row_info(m); const int L = seq_len(ri.seq);
    if (ri.t >= L - 2) { const int j = ri.t - (L - 2);
        if (ri.seq < BATCH) out[O_CP + (((size_t)layer * BATCH + ri.seq) * 2 + j) * D_MODEL + ch] = u;
        else out[O_CS + (((size_t)layer * DEC_BATCH + (ri.seq - BATCH)) * 2 + j) * D_MODEL + ch] = u; }
}
__device__ inline void ref_conv_in_item(size_t i_, const bf16_t* hb, const float* rss, const bf16_t* Bt, bf16_t* ub, bf16_t* bb, float* out, int layer) {
    const int m = (int)(i_ / D_MODEL), j = (int)(i_ % D_MODEL);
    const float rs = 1.0f / sqrtf(rss[m] / D_MODEL + EPS); const bf16_t* a = hb + (size_t)m * D_MODEL;
    const int nc = (j / 128) * 256 + (j % 128);
    const float c = rs * dot_bf(a, Bt + (size_t)nc * D_MODEL, D_MODEL), x = rs * dot_bf(a, Bt + (size_t)(nc + 128) * D_MODEL, D_MODEL), b = rs * dot_bf(a, Bt + (size_t)(2 * D_MODEL + j) * D_MODEL, D_MODEL);
    const float u = c * x; ub[i_] = f2bf(u); bb[i_] = f2bf(b); conv_state_store(out, layer, m, j, u);
}
__device__ inline void conv_thin_item(size_t i_, const bf16_t* ub, const bf16_t* bb, const float* state  , const float* wc  , bf16_t* zb) {
    const int m = (int)(i_ / D_MODEL), ch = (int)(i_ % D_MODEL);
    const RowInfo ri = row_info(m);
    const float u0 = bf2f(ub[i_]);
    float u1, u2;
    if (ri.t >= 1) u1 = bf2f(ub[i_ - D_MODEL]); else u1 = (ri.seq < BATCH) ? 0.f : state[((size_t)(ri.seq - BATCH) * 2 + 1) * D_MODEL + ch];
    if (ri.t >= 2) u2 = bf2f(ub[i_ - 2 * D_MODEL]); else if (ri.seq < BATCH) u2 = 0.f;
    else u2 = (ri.t == 1) ? state[((size_t)(ri.seq - BATCH) * 2 + 1) * D_MODEL + ch] : state[((size_t)(ri.seq - BATCH) * 2 + 0) * D_MODEL + ch];
    zb[i_] = f2bf(bf2f(bb[i_]) * (wc[ch] * u2 + wc[D_MODEL + ch] * u1 + wc[2 * D_MODEL + ch] * u0));
}
__device__ inline void ref_qg_item(size_t i_, const bf16_t* hb, const float* rss, const bf16_t* Bt, const float* q_norm, const float* rope, float* qn, float* qr) {
    const int m = (int)(i_ / N_HEADS), hh = (int)(i_ % N_HEADS);
    const float rs = 1.0f / sqrtf(rss[m] / D_MODEL + EPS); const bf16_t* a = hb + (size_t)m * D_MODEL;
    float v[HD]; for (int d = 0; d < HD; ++d) v[d] = rs * dot_bf(a, Bt + (size_t)heads_row(hh, d) * D_MODEL, D_MODEL);
    head_norm(v, q_norm);
    for (int d = 0; d < HD; ++d) qn[(size_t)m * HDM + hh * HD + d] = v[d];
    const float* rt = rope + (size_t)pos_index(row_info(m).pos) * 16;
    for (int f = 0; f < 8; ++f) { const float x1 = v[f], x2 = v[8 + f]; v[f] = x1 * rt[f] - x2 * rt[8 + f]; v[8 + f] = x2 * rt[f] + x1 * rt[8 + f]; }
    for (int d = 0; d < HD; ++d) qr[(size_t)m * HDM + hh * HD + d] = v[d];
}
__device__ inline void ref_gates_item(size_t i_, const bf16_t* hb, const float* rss, const bf16_t* Bt, float* gates) {
    const int m = (int)(i_ / (3 * N_HEADS)), j = (int)(i_ % (3 * N_HEADS));
    const float rs = 1.0f / sqrtf(rss[m] / D_MODEL + EPS);
    const float x = rs * dot_bf(hb + (size_t)m * D_MODEL, Bt + (size_t)(HDM + j) * D_MODEL, D_MODEL);
    gates[i_] = 1.0f / (1.0f + expf(-x));
}
__device__ inline void kv_store(float* out, float* winrows, int m, int e, int g, int d, float v) {
    const RowInfo ri = row_info(m);
    if (e < 4) { if (ri.seq < BATCH) out[O_KVP + (((size_t)m * 4 + e) * N_KV + g) * HD + d] = v; else out[O_KVS + (((size_t)(m - MP) * 4 + e) * N_KV + g) * HD + d] = v; }
    else { const int we = e - 4;
        winrows[(((size_t)m * 2 + we) * N_KV + g) * HD + d] = v;
        if (ri.seq < BATCH) { if (ri.t >= SEQ - WINDOW) out[O_WP + ((((size_t)ri.seq * WINDOW + (ri.t - (SEQ - WINDOW))) * 2 + we) * N_KV + g) * HD + d] = v; }
        else out[O_WS + ((((size_t)(ri.seq - BATCH) * WINDOW + (WINDOW - DEC_SEQ + ri.t)) * 2 + we) * N_KV + g) * HD + d] = v; }
}
__device__ inline void ref_kv_item(size_t i_, const bf16_t* hb, const float* rss, const bf16_t* Bt, const float* k_norm, const float* rope, float* out, float* winrows) {
    const int m = (int)(i_ / (6 * N_KV)), hidx = (int)(i_ % (6 * N_KV)), e = hidx / N_KV, g = hidx % N_KV;
    const float rs = 1.0f / sqrtf(rss[m] / D_MODEL + EPS); const bf16_t* a = hb + (size_t)m * D_MODEL;
    float v[HD]; for (int d = 0; d < HD; ++d) v[d] = rs * dot_bf(a, Bt + (size_t)heads_row(hidx, d) * D_MODEL, D_MODEL);
    if (e == 2 || e == 4) { head_norm(v, k_norm + (e == 2 ? 1 : 2) * HD);
        const float* rt = rope + (size_t)pos_index(row_info(m).pos) * 16;
        for (int f = 0; f < 8; ++f) { const float x1 = v[f], x2 = v[8 + f]; v[f] = x1 * rt[f] - x2 * rt[8 + f]; v[8 + f] = x2 * rt[f] + x1 * rt[8 + f]; } }
    for (int d = 0; d < HD; ++d) kv_store(out, winrows, m, e, g, d, v[d]);
}
#ifndef CPU_TEST
#define LAS __attribute__((address_space(3)))
#define XB_TMO      128
#define XB_XCNT(j)  (256  + 64 * (j))
#define XB_XSUB(j)  (1280 + 64 * (j))
#define XB_XGEN(j)  (2304 + 64 * (j))
#define XB_TOP      3328
#define XB_TOPGEN   3392
#define XCD_BAR_WORDS 3456
#define XB_SPIN_CAP (1u << 25)
typedef __attribute__((address_space(1))) unsigned GU;
__device__ __forceinline__ unsigned xb_ld(GU* p)              { return __hip_atomic_load(p, __ATOMIC_RELAXED, __HIP_MEMORY_SCOPE_AGENT); }
__device__ __forceinline__ unsigned xb_add(GU* p, unsigned v) { return __hip_atomic_fetch_add(p, v, __ATOMIC_RELAXED, __HIP_MEMORY_SCOPE_AGENT); }
__device__ __forceinline__ unsigned xb_xcc_id() { return (unsigned)__builtin_amdgcn_s_getreg((3 << 11) | 20) & 0xFu; }
#define XB_SPIN(cond, bar) do { unsigned _sp = 0; while (cond) { __builtin_amdgcn_s_sleep(1); \
    if ((++_sp & 255u) == 0u) { if (xb_ld(&(bar)[XB_TMO])) break; if (_sp > XB_SPIN_CAP) { (void)xb_add(&(bar)[XB_TMO], 1u); break; } } } } while (0)
struct XcdBarrier { GU* bar; unsigned x; volatile LAS unsigned* st; };
__device__ __forceinline__ XcdBarrier xcd_barrier_post(GU* bar, volatile LAS unsigned* st, const bool leader_thread) {
    XcdBarrier b; b.bar = bar; b.x = xb_xcc_id(); b.st = st;
    if (leader_thread) (void)xb_add(&bar[XB_XCNT(b.x)], 1u);
    return b;
}
__device__ __forceinline__ void xcd_barrier_complete(GU* bar, unsigned x, unsigned& nloc, unsigned& nx) {
    const unsigned G = gridDim.x * gridDim.y * gridDim.z;
    unsigned sum, cnt, mine, sp = 0u;
    for (;;) {
        sum = 0u; cnt = 0u; mine = 0u;
#pragma unroll
        for (unsigned j = 0; j < 16; ++j) { const unsigned c = xb_ld(&bar[XB_XCNT(j)]); sum += c; cnt += (c > 0u) ? 1u : 0u; mine = (j == x) ? c : mine; }
        if (sum == G) break;
        __builtin_amdgcn_s_sleep(1);
        if ((++sp & 255u) == 0u) { if (xb_ld(&bar[XB_TMO])) break; if (sp > XB_SPIN_CAP) { (void)xb_add(&bar[XB_TMO], 1u); break; } }
    }
    nloc = mine > 0u ? mine : 1u; nx = cnt > 0u ? cnt : 1u;
}
__device__ __forceinline__ void xcd_barrier(const XcdBarrier& b, const bool leader_thread) {
    asm volatile("s_waitcnt vmcnt(0)" ::: "memory");
    __syncthreads();
    if (leader_thread) {
        GU* bar = b.bar; unsigned bx = xb_xcc_id(); asm volatile("" : "+s"(bx));
        __builtin_amdgcn_s_waitcnt(0);
        unsigned nloc = b.st[0], nx = b.st[1];
        if (nloc == 0u) { xcd_barrier_complete(bar, bx, nloc, nx); b.st[0] = nloc; b.st[1] = nx; }
        const unsigned old = xb_add(&bar[XB_XSUB(bx)], 1u);
        const unsigned gen = old / nloc;
        if (old + 1u == (gen + 1u) * nloc) {
            __builtin_amdgcn_fence(__ATOMIC_RELEASE, "agent");
            asm volatile("s_waitcnt vmcnt(0)" ::: "memory");
            const unsigned og = xb_add(&bar[XB_TOP], 1u);
            const unsigned tg = og / nx;
            if (og + 1u == (tg + 1u) * nx) xb_add(&bar[XB_TOPGEN], 1u);
            else XB_SPIN(xb_ld(&bar[XB_TOPGEN]) == tg, bar);
            __builtin_amdgcn_fence(__ATOMIC_ACQUIRE, "agent");
            xb_add(&bar[XB_XGEN(bx)], 1u);
            asm volatile("s_waitcnt vmcnt(0)" ::: "memory");
        } else {
            XB_SPIN(xb_ld(&bar[XB_XGEN(bx)]) == gen, bar);
            __builtin_amdgcn_fence(__ATOMIC_ACQUIRE, "agent");
            asm volatile("s_waitcnt vmcnt(0)" ::: "memory");
        }
    }
    __syncthreads();
}

namespace pg8 {
#define PG8_LAS __attribute__((address_space(3)))
typedef unsigned short bf16_t;
typedef short bf16x8 __attribute__((ext_vector_type(8)));
typedef float f32x4 __attribute__((ext_vector_type(4)));
typedef unsigned u32x4 __attribute__((ext_vector_type(4)));
constexpr int BM = 256, BK = 64, HALF = 128, HTB = HALF * BK * 2  , STAGE_BYTES = 8 * HTB, NXCD = 8, WGM = 8;

__host__ __device__ __forceinline__ int lds_byte(int r, int c) { const int st = (r >> 4) * 2 + (c >> 5), rr = r & 15, cc = c & 31, ob = rr * 64 + cc * 2; return st * 1024 + (ob ^ (((ob >> 9) & 1) << 5)); }
__host__ __device__ __forceinline__ void stage_rc(int b, int& R, int& C) { const int st = b / 1024, sb = b % 1024, swz = sb ^ (((sb >> 9) & 1) << 5); R = (st >> 1) * 16 + swz / 64; C = (st & 1) * 32 + (swz % 64) / 2; }
__host__ __device__ __forceinline__ int perm32(int rho) { const int n = rho >> 4, i = rho & 15; return 8 * (i >> 2) + 4 * n + (i & 3); }

struct Unit { int pm, pn; };
struct Gemm { const bf16_t* A; const bf16_t* Bt; int M, N, K; };

struct StaticOrder {
    int nM, nN, nwg, G, c;
    __host__ __device__ void init(int M, int N, int G_, int c_) { nM = M / BM; nN = N / BM; nwg = nM * nN; G = G_; c = c_; }
    __host__ __device__ bool next(int i, Unit& u) const {
        const long L = (long)i * G + c; if (L >= nwg) return false;
        int wgid = (int)L; { const int q = nwg / NXCD, r = nwg % NXCD, xcd = wgid % NXCD, off = wgid / NXCD; wgid = (xcd < r ? xcd * (q + 1) : r * (q + 1) + (xcd - r) * q) + off; }
        const int nig = WGM * nN, gid = wgid / nig, fm = gid * WGM, gsz = (nM - fm) < WGM ? (nM - fm) : WGM;
        u.pm = fm + ((wgid % nig) % gsz); u.pn = (wgid % nig) / gsz; return true;
    }
    __device__ __forceinline__ void a_ready(const Unit&) const {}
    __device__ __forceinline__ void done(const Unit&) const {}
};

__device__ __forceinline__ unsigned cvt_pk_bf16(float lo, float hi) { unsigned r; asm volatile("v_cvt_pk_bf16_f32 %0, %1, %2" : "=v"(r) : "v"(lo), "v"(hi)); return r; }
template <class Epi, class Sched, bool ALIGN_EPI = false, bool SP2 = false>
__device__ __forceinline__ void gemm_phase(int wave_id_, PG8_LAS unsigned char* lds, const Gemm g, const Sched& S, const Epi& E) {
    int wid = wave_id_, lane = (int)lane_id_v(); asm volatile("" : "+s"(wid));
    const int tid = wid * 64 + lane, wr = wid >> 2, wc = wid & 3, fr = lane & 15, fq = lane >> 4;
    const int K = g.K, nt = K / BK;
    unsigned voffA[2], voffB[2];
#pragma unroll
    for (int i = 0; i < 2; ++i) { int R, C; stage_rc(tid * 16 + i * 8192, R, C); const int Rb = Epi::PERM ? ((R & ~31) + perm32(R & 31)) : R;
        voffA[i] = (unsigned)(R * K + C) * 2u; voffB[i] = (unsigned)(Rb * K + C) * 2u; }
    const size_t kstep = (size_t)(BK * 2);
    const size_t hstep = (size_t)HALF * K * 2;
    const size_t tstep = 2 * hstep;
    const unsigned ldsw = (unsigned)wid * 1024u;
    const int aoff = lds_byte(wr * 64 + fr, fq * 8), boff = lds_byte(wc * 32 + fr, fq * 8);
#define PG8_SA(b, h) (((b) * 2 + (h)) * HTB)
#define PG8_SB(b, h) ((4 + (b) * 2 + (h)) * HTB)
#define PG8_STAGE(bufoff, gbase, voff) do { _Pragma("unroll") for (int _i = 0; _i < 2; ++_i) \
        __builtin_amdgcn_global_load_lds((const unsigned*)((const char*)(gbase) + (voff)[_i]), (PG8_LAS unsigned*)(lds + (bufoff) + ldsw + _i * 8192), 16, 0, 0); } while (0)
#define PG8_LDA(dst, b, h) do { _Pragma("unroll") for (int m = 0; m < 4; ++m) _Pragma("unroll") for (int k = 0; k < 2; ++k) dst[m][k] = *(const PG8_LAS bf16x8*)(lds + PG8_SA(b, h) + aoff + m * 2048 + k * 1024); } while (0)
#define PG8_LDB(dst, b, h) do { _Pragma("unroll") for (int n = 0; n < 2; ++n) _Pragma("unroll") for (int k = 0; k < 2; ++k) dst[n][k] = *(const PG8_LAS bf16x8*)(lds + PG8_SB(b, h) + boff + n * 2048 + k * 1024); } while (0)
#define PG8_MMA(ai, bj, At, Bt) do { __builtin_amdgcn_s_setprio(1); _Pragma("unroll") for (int m = 0; m < 4; ++m) _Pragma("unroll") for (int n = 0; n < 2; ++n) _Pragma("unroll") for (int k = 0; k < 2; ++k) \
        acc[ai][bj][m][n] = __builtin_amdgcn_mfma_f32_16x16x32_bf16(Bt[n][k], At[m][k], acc[ai][bj][m][n], 0, 0, 0); __builtin_amdgcn_s_setprio(0); } while (0)
#define PG8_WAIT_V(n) asm volatile("s_waitcnt vmcnt(" #n ")" ::: "memory")
#define PG8_WAIT_L(n) asm volatile("s_waitcnt lgkmcnt(" #n ")" ::: "memory")
#define PG8_BAR __builtin_amdgcn_s_barrier()
#define PG8_SCHED __builtin_amdgcn_sched_barrier(0)
    Unit cur, nxt; int ui = 0;
    if (!S.next(0, cur)) return;
    f32x4 acc[2][2][4][2];
#pragma unroll
    for (int a = 0; a < 2; ++a)
#pragma unroll
        for (int b = 0; b < 2; ++b)
#pragma unroll
            for (int m = 0; m < 4; ++m)
#pragma unroll
                for (int n = 0; n < 2; ++n) acc[a][b][m][n] = (f32x4){0.f, 0.f, 0.f, 0.f};
    bf16x8 At[4][2], B0[2][2], B1[2][2];
    const char* cA = (const char*)g.A + (size_t)cur.pm * tstep; const char* cB = (const char*)g.Bt + (size_t)cur.pn * tstep;
    S.a_ready(cur);
    if constexpr (SP2) {
        PG8_STAGE(PG8_SB(0, 0), cB, voffB); PG8_STAGE(PG8_SB(0, 1), cB + hstep, voffB); PG8_STAGE(PG8_SA(0, 0), cA, voffA); PG8_STAGE(PG8_SA(0, 1), cA + hstep, voffA);
        if (wr == 1) PG8_BAR;
        PG8_WAIT_V(2); PG8_BAR;
        PG8_STAGE(PG8_SB(1, 0), cB + kstep, voffB); PG8_STAGE(PG8_SA(1, 0), cA + kstep, voffA); PG8_STAGE(PG8_SB(1, 1), cB + hstep + kstep, voffB);
        PG8_WAIT_V(6); PG8_BAR;
    } else {
        PG8_STAGE(PG8_SB(0, 0), cB, voffB); PG8_STAGE(PG8_SA(0, 0), cA, voffA); PG8_STAGE(PG8_SB(0, 1), cB + hstep, voffB); PG8_STAGE(PG8_SA(0, 1), cA + hstep, voffA);
        if (wr == 1) PG8_BAR;
        PG8_WAIT_V(4); PG8_BAR;
        PG8_STAGE(PG8_SB(1, 0), cB + kstep, voffB); PG8_STAGE(PG8_SA(1, 0), cA + kstep, voffA); PG8_STAGE(PG8_SB(1, 1), cB + hstep + kstep, voffB);
        PG8_WAIT_V(6); PG8_BAR;
    }
    for (;;) {
        const bool has_next = S.next(ui + 1, nxt);
        const char* nA = has_next ? (const char*)g.A + (size_t)nxt.pm * tstep : cA; const char* nB = has_next ? (const char*)g.Bt + (size_t)nxt.pn * tstep : cB;
        for (int t = 0; t < nt; t += 2) {
            const bool last = (t == nt - 2);
            const char* a1 = cA + (size_t)(t + 1) * kstep;
            const char* a2 = last ? nA : cA + (size_t)(t + 2) * kstep; const char* b2 = last ? nB : cB + (size_t)(t + 2) * kstep;
            const char* a3 = a2 + kstep; const char* b3 = b2 + kstep;
            if (last && has_next) S.a_ready(nxt);
            if constexpr (SP2) {
            PG8_LDB(B0, 0, 0); PG8_LDB(B1, 0, 1); PG8_SCHED; PG8_LDA(At, 0, 0); PG8_STAGE(PG8_SA(1, 1), a1 + hstep, voffA);
            PG8_WAIT_V(8); PG8_WAIT_L(0); PG8_BAR; PG8_MMA(0, 0, At, B0); PG8_MMA(0, 1, At, B1); PG8_BAR; PG8_SCHED;
            PG8_LDA(At, 0, 1); PG8_STAGE(PG8_SB(0, 0), b2, voffB); PG8_STAGE(PG8_SB(0, 1), b2 + hstep, voffB); PG8_STAGE(PG8_SA(0, 0), a2, voffA);
            PG8_WAIT_V(8); PG8_WAIT_L(0); PG8_BAR; PG8_MMA(1, 0, At, B0); PG8_MMA(1, 1, At, B1); PG8_BAR; PG8_SCHED;
            PG8_LDB(B0, 1, 0); PG8_LDB(B1, 1, 1); PG8_SCHED; PG8_LDA(At, 1, 0); PG8_STAGE(PG8_SA(0, 1), a2 + hstep, voffA);
            PG8_WAIT_V(8); PG8_WAIT_L(0); PG8_BAR; PG8_MMA(0, 0, At, B0); PG8_MMA(0, 1, At, B1); PG8_BAR; PG8_SCHED;
            PG8_LDA(At, 1, 1); PG8_STAGE(PG8_SB(1, 0), b3, voffB); PG8_STAGE(PG8_SB(1, 1), b3 + hstep, voffB); PG8_STAGE(PG8_SA(1, 0), a3, voffA);
            PG8_WAIT_V(8); PG8_WAIT_L(0); PG8_BAR; PG8_MMA(1, 0, At, B0); PG8_MMA(1, 1, At, B1); PG8_BAR; PG8_SCHED;
            } else {
            PG8_LDB(B0, 0, 0); PG8_SCHED; PG8_LDA(At, 0, 0); PG8_STAGE(PG8_SA(1, 1), a1 + hstep, voffA);
            PG8_WAIT_L(8); PG8_BAR; PG8_WAIT_L(0); PG8_MMA(0, 0, At, B0); PG8_BAR; PG8_SCHED;
            PG8_LDB(B1, 0, 1); PG8_STAGE(PG8_SB(0, 0), b2, voffB);
            PG8_BAR; PG8_WAIT_L(0); PG8_MMA(0, 1, At, B1); PG8_BAR;
            PG8_LDA(At, 0, 1); PG8_STAGE(PG8_SA(0, 0), a2, voffA);
            PG8_BAR; PG8_WAIT_L(0); PG8_MMA(1, 0, At, B0); PG8_BAR; PG8_SCHED;
            PG8_STAGE(PG8_SB(0, 1), b2 + hstep, voffB);
            PG8_WAIT_V(6); PG8_BAR; PG8_MMA(1, 1, At, B1); PG8_BAR;
            PG8_LDB(B0, 1, 0); PG8_SCHED; PG8_LDA(At, 1, 0); PG8_STAGE(PG8_SA(0, 1), a2 + hstep, voffA);
            PG8_WAIT_L(8); PG8_BAR; PG8_WAIT_L(0); PG8_MMA(0, 0, At, B0); PG8_BAR; PG8_SCHED;
            PG8_LDB(B1, 1, 1); PG8_STAGE(PG8_SB(1, 0), b3, voffB);
            PG8_BAR; PG8_WAIT_L(0); PG8_MMA(0, 1, At, B1); PG8_BAR;
            PG8_LDA(At, 1, 1); PG8_STAGE(PG8_SA(1, 0), a3, voffA);
            PG8_BAR; PG8_WAIT_L(0); PG8_MMA(1, 0, At, B0); PG8_BAR; PG8_SCHED;
            PG8_STAGE(PG8_SB(1, 1), b3 + hstep, voffB);
            PG8_WAIT_V(6); PG8_BAR; PG8_MMA(1, 1, At, B1); PG8_BAR;
            }
        }
        if constexpr (ALIGN_EPI) { if (wr == 0) PG8_BAR; }
        if constexpr (!Epi::AFTER_DRAIN) { E(acc, cur, wr, wc, fr, fq); S.done(cur); }
        if (!has_next) break;
#pragma unroll
        for (int a = 0; a < 2; ++a)
#pragma unroll
            for (int b = 0; b < 2; ++b)
#pragma unroll
                for (int m = 0; m < 4; ++m)
#pragma unroll
                    for (int n = 0; n < 2; ++n) acc[a][b][m][n] = (f32x4){0.f, 0.f, 0.f, 0.f};
        cur = nxt; cA = nA; cB = nB; ++ui;
        if constexpr (ALIGN_EPI) { if (wr == 1) PG8_BAR; }
    }
    PG8_WAIT_V(0);
    if constexpr (!ALIGN_EPI) { if (wr == 0) PG8_BAR; }
    PG8_BAR;
    if constexpr (Epi::AFTER_DRAIN) { E.fused(acc, cur, wr, wc, fr, fq, lds, wid, lane); S.done(cur); }
#undef PG8_SA
#undef PG8_SB
#undef PG8_STAGE
#undef PG8_LDA
#undef PG8_LDB
#undef PG8_MMA
#undef PG8_WAIT_V
#undef PG8_WAIT_L
#undef PG8_BAR
#undef PG8_SCHED
}
}

namespace pg8 {
__device__ __forceinline__ float fast_silu(float g) { return g * __builtin_amdgcn_rcpf(1.0f + __expf(-g)); }
__device__ __forceinline__ float row_rs(const float* rss, int row) { return rsqrtf(rss[row] * (1.0f / D_MODEL) + EPS); }
struct EpiSwiglu {
    static constexpr bool PERM = true, AFTER_DRAIN = false;
    bf16_t* act; const float* rss;
    __device__ __forceinline__ void operator()(const f32x4 (&acc)[2][2][4][2], const Unit& u, int wr, int wc, int fr, int fq) const {
        const int row0 = u.pm * BM + wr * 64 + fr, col0 = u.pn * 128 + wc * 32 + 8 * fq;
#pragma unroll
        for (int ai = 0; ai < 2; ++ai)
#pragma unroll
            for (int m = 0; m < 4; ++m) {
                const int row = row0 + ai * HALF + m * 16; const float rs = row_rs(rss, row);
                float a[8];
#pragma unroll
                for (int n = 0; n < 2; ++n)
#pragma unroll
                    for (int i = 0; i < 4; ++i) a[n * 4 + i] = fast_silu(acc[ai][0][m][n][i] * rs) * (acc[ai][1][m][n][i] * rs);
                u32x4 w; w.x = cvt_pk_bf16(a[0], a[1]); w.y = cvt_pk_bf16(a[2], a[3]); w.z = cvt_pk_bf16(a[4], a[5]); w.w = cvt_pk_bf16(a[6], a[7]);
                *(u32x4*)(act + (size_t)row * D_FF + col0) = w;
            }
    }
};
struct EpiResid {
    static constexpr bool PERM = false, AFTER_DRAIN = false;
    float* h; bf16_t* hb; float* rss_next; float* yout; float coef;
    __device__ __forceinline__ void operator()(const f32x4 (&acc)[2][2][4][2], const Unit& u, int wr, int wc, int fr, int fq) const {
        const int row0 = u.pm * BM + wr * 64 + fr, col0 = u.pn * BM + wc * 32 + 4 * fq;
#pragma unroll
        for (int ai = 0; ai < 2; ++ai)
#pragma unroll
            for (int m = 0; m < 4; ++m) {
                const int row = row0 + ai * HALF + m * 16; float s = 0.f;
                float* hr = h + (size_t)row * D_MODEL + col0;
#pragma unroll
                for (int bj = 0; bj < 2; ++bj)
#pragma unroll
                    for (int n = 0; n < 2; ++n) {
                        const int co = bj * HALF + n * 16;
                        const f32x4 v = *(const f32x4*)(hr + co) + acc[ai][bj][m][n] * coef;
                        if (yout) { *(f32x4*)(yout + (size_t)row * D_MODEL + col0 + co) = v; }
                        else {
                            *(f32x4*)(hr + co) = v;
                            typedef unsigned u32x2 __attribute__((ext_vector_type(2)));
                            u32x2 w; w.x = cvt_pk_bf16(v[0], v[1]); w.y = cvt_pk_bf16(v[2], v[3]);
                            *(u32x2*)(hb + (size_t)row * D_MODEL + col0 + co) = w;
                            s += (v[0] * v[0] + v[1] * v[1]) + (v[2] * v[2] + v[3] * v[3]);
                        }
                    }
                if (!yout) { s += __shfl_xor(s, 16); s += __shfl_xor(s, 32); if (fq == 0) (void)__hip_atomic_fetch_add(rss_next + row, s, __ATOMIC_RELAXED, __HIP_MEMORY_SCOPE_AGENT); }
            }
    }
};
}
namespace pg8 {
__device__ __forceinline__ float sum4(f32x4 v) { return (v[0] * v[0] + v[1] * v[1]) + (v[2] * v[2] + v[3] * v[3]); }
struct EpiConvIn {
    static constexpr bool PERM = true, AFTER_DRAIN = false;
    bf16_t* ub; bf16_t* bb; const float* rss; float* out; int layer;
    __device__ __forceinline__ void operator()(const f32x4 (&acc)[2][2][4][2], const Unit& u, int wr, int wc, int fr, int fq) const {
        const int row0 = u.pm * BM + wr * 64 + fr;
        const bool pair = u.pn < D_MODEL / 128;
#pragma unroll
        for (int ai = 0; ai < 2; ++ai)
#pragma unroll
            for (int m = 0; m < 4; ++m) {
                const int row = row0 + ai * HALF + m * 16; const float rs = row_rs(rss, row);
                if (pair) {
                    const int col0 = u.pn * 128 + wc * 32 + 8 * fq; float a[8];
#pragma unroll
                    for (int n = 0; n < 2; ++n)
#pragma unroll
                        for (int i = 0; i < 4; ++i) a[n * 4 + i] = (acc[ai][0][m][n][i] * rs) * (acc[ai][1][m][n][i] * rs);
                    u32x4 w; w.x = cvt_pk_bf16(a[0], a[1]); w.y = cvt_pk_bf16(a[2], a[3]); w.z = cvt_pk_bf16(a[4], a[5]); w.w = cvt_pk_bf16(a[6], a[7]);
                    *(u32x4*)(ub + (size_t)row * D_MODEL + col0) = w;
                    const RowInfo ri = row_info(row); const int jj = ri.t - (seq_len(ri.seq) - 2);
                    if (jj >= 0) {
                        float* cs = (ri.seq < BATCH) ? out + O_CP + (((size_t)layer * BATCH + ri.seq) * 2 + jj) * D_MODEL + col0 : out + O_CS + (((size_t)layer * DEC_BATCH + (ri.seq - BATCH)) * 2 + jj) * D_MODEL + col0;
                        *(f32x4*)(cs) = (f32x4){a[0], a[1], a[2], a[3]}; *(f32x4*)(cs + 4) = (f32x4){a[4], a[5], a[6], a[7]};
                    }
                } else {
#pragma unroll
                    for (int bj = 0; bj < 2; ++bj) {
                        const int col0 = (u.pn - D_MODEL / 128) * 256 + bj * HALF + wc * 32 + 8 * fq;
                        const f32x4 v0 = acc[ai][bj][m][0] * rs, v1 = acc[ai][bj][m][1] * rs;
                        u32x4 w; w.x = cvt_pk_bf16(v0[0], v0[1]); w.y = cvt_pk_bf16(v0[2], v0[3]); w.z = cvt_pk_bf16(v1[0], v1[1]); w.w = cvt_pk_bf16(v1[2], v1[3]);
                        *(u32x4*)(bb + (size_t)row * D_MODEL + col0) = w;
                    }
                }
                asm volatile("" ::: "memory");
            }
    }
};
__device__ __forceinline__ void head_norm_rope(f32x4 (&v)[2][2], const float* gain, const float* rt  , int fq, bool do_norm, bool do_rope, f32x4 (&rot0)[2]) {
    if (do_norm) {
        float ss = (sum4(v[0][0]) + sum4(v[0][1])) + (sum4(v[1][0]) + sum4(v[1][1]));
        ss += __shfl_xor(ss, 16); ss += __shfl_xor(ss, 32);
        const float r = rsqrtf(ss * (1.0f / HD) + EPS);
#pragma unroll
        for (int bj = 0; bj < 2; ++bj)
#pragma unroll
            for (int n = 0; n < 2; ++n) { const f32x4 g = *(const f32x4*)(gain + 32 * bj + 8 * fq + 4 * n); v[bj][n] = v[bj][n] * r * g; }
    }
    rot0[0] = v[0][0]; rot0[1] = v[0][1];
    if (do_rope) {
#pragma unroll
        for (int n = 0; n < 2; ++n) {
            f32x4 p;
#pragma unroll
            for (int i = 0; i < 4; ++i) p[i] = __shfl_xor(v[0][n][i], 16);
            const f32x4 c = *(const f32x4*)(rt + 4 * n), s = *(const f32x4*)(rt + 8 + 4 * n);
            if (fq == 0) rot0[n] = v[0][n] * c - p * s; else if (fq == 1) rot0[n] = v[0][n] * c + p * s;
        }
    }
}
__device__ __forceinline__ u32x4 pack8(const f32x4 a, const f32x4 b, float sc) { u32x4 w; w.x = cvt_pk_bf16(a[0] * sc, a[1] * sc); w.y = cvt_pk_bf16(a[2] * sc, a[3] * sc); w.z = cvt_pk_bf16(b[0] * sc, b[1] * sc); w.w = cvt_pk_bf16(b[2] * sc, b[3] * sc); return w; }
struct EpiQG {
    static constexpr bool PERM = true, AFTER_DRAIN = false;
    bf16_t* qnb; bf16_t* qrb; float* gates; const float* rss; const float* q_norm; const float* rope;
    __device__ __forceinline__ void operator()(const f32x4 (&acc)[2][2][4][2], const Unit& u, int wr, int wc, int fr, int fq) const {
        const int row0 = u.pm * BM + wr * 64 + fr;
#pragma unroll
        for (int ai = 0; ai < 2; ++ai)
#pragma unroll
            for (int m = 0; m < 4; ++m) {
                const int row = row0 + ai * HALF + m * 16; const float rs = row_rs(rss, row);
                if (u.pn < N_HEADS / 4) {
                    const int hh = u.pn * 4 + wc;
                    f32x4 v[2][2] = {{acc[ai][0][m][0] * rs, acc[ai][0][m][1] * rs}, {acc[ai][1][m][0] * rs, acc[ai][1][m][1] * rs}}; f32x4 rot0[2];
                    head_norm_rope(v, q_norm, rope + (size_t)pos_index(row_info(row).pos) * 16, fq, true, true, rot0);
                    const size_t o = (size_t)row * HDM + hh * HD + 8 * fq;
                    const u32x4 hi8 = pack8(v[1][0], v[1][1], QSCALE_F);
                    *(u32x4*)(qnb + o) = pack8(v[0][0], v[0][1], QSCALE_F); *(u32x4*)(qnb + o + 32) = hi8;
                    *(u32x4*)(qrb + o) = pack8(rot0[0], rot0[1], QSCALE_F); *(u32x4*)(qrb + o + 32) = hi8;
                } else {
                    const int c0 = wc * 32 + 8 * fq;
#pragma unroll
                    for (int n = 0; n < 2; ++n)
#pragma unroll
                        for (int i = 0; i < 4; ++i) { const int c = c0 + 4 * n + i; if (c < 3 * N_HEADS) gates[(size_t)row * 3 * N_HEADS + c] = __builtin_amdgcn_rcpf(1.0f + __expf(-(acc[ai][0][m][n][i] * rs))); }
                }
                asm volatile("" ::: "memory");
            }
    }
};
struct EpiKV {
    static constexpr bool PERM = true, AFTER_DRAIN = false;
    float* out; float* winrows; const float* rss; const float* k_norm; const float* rope;
    unsigned char* ksel; unsigned char* vsel; unsigned char* kwin; unsigned char* vwin; bf16_t* acp; const float* pe;
    __device__ __forceinline__ void operator()(const f32x4 (&acc)[2][2][4][2], const Unit& u, int wr, int wc, int fr, int fq) const {
        const int row0 = u.pm * BM + wr * 64 + fr;
        const int hidx = u.pn * 4 + wc, e = hidx / N_KV, g = hidx % N_KV; const bool nr = (e == 2 || e == 4);
#pragma unroll
        for (int ai = 0; ai < 2; ++ai)
#pragma unroll
            for (int m = 0; m < 4; ++m) {
                const int row = row0 + ai * HALF + m * 16; const float rs = row_rs(rss, row);
                const RowInfo ri = row_info(row);
                f32x4 v[2][2] = {{acc[ai][0][m][0] * rs, acc[ai][0][m][1] * rs}, {acc[ai][1][m][0] * rs, acc[ai][1][m][1] * rs}}; f32x4 rot0[2];
                head_norm_rope(v, k_norm + (e == 2 ? 1 : 2) * HD, rope + (size_t)pos_index(ri.pos) * 16, fq, nr, nr, rot0);
                float* d0; float* d1 = nullptr;
                if (e < 4) d0 = (ri.seq < BATCH) ? out + O_KVP + (((size_t)row * 4 + e) * N_KV + g) * HD : out + O_KVS + (((size_t)(row - MP) * 4 + e) * N_KV + g) * HD;
                else { const int we = e - 4; d0 = winrows + (((size_t)row * 2 + we) * N_KV + g) * HD;
                    if (ri.seq < BATCH) { if (ri.t >= SEQ - WINDOW) d1 = out + O_WP + ((((size_t)ri.seq * WINDOW + (ri.t - (SEQ - WINDOW))) * 2 + we) * N_KV + g) * HD; }
                    else d1 = out + O_WS + ((((size_t)(ri.seq - BATCH) * WINDOW + (WINDOW - DEC_SEQ + ri.t)) * 2 + we) * N_KV + g) * HD; }
                d0 += 8 * fq; *(f32x4*)(d0) = rot0[0]; *(f32x4*)(d0 + 4) = rot0[1]; *(f32x4*)(d0 + 32) = v[1][0]; *(f32x4*)(d0 + 36) = v[1][1];
                if (d1) { d1 += 8 * fq; *(f32x4*)(d1) = rot0[0]; *(f32x4*)(d1 + 4) = rot0[1]; *(f32x4*)(d1 + 32) = v[1][0]; *(f32x4*)(d1 + 36) = v[1][1]; }
                if (ri.seq < BATCH) {
                    if (e >= 2) {
                        unsigned char* img = (e == 2 ? ksel : e == 3 ? vsel : e == 4 ? kwin : vwin) + (((size_t)ri.seq * N_KV + g) * (SEQ / 64) + ri.t / 64) * 8192; const int kv = ri.t % 64;
                        const size_t o0 = (e & 1) ? vimg_off(kv, 8 * fq) : kimg_off(kv, 8 * fq), o1 = (e & 1) ? vimg_off(kv, 32 + 8 * fq) : kimg_off(kv, 32 + 8 * fq);
                        *(u32x4*)(img + o0) = pack8(rot0[0], rot0[1], 1.0f); *(u32x4*)(img + o1) = pack8(v[1][0], v[1][1], 1.0f);
                    } else {
                        const int c = ri.t / L_CMP, l = ri.t % L_CMP; const int r = (ri.seq * NBC_P + c) * N_KV + g;
                        bf16_t* ap = acp + ((size_t)e * RP_CMP + r) * (L_CMP * HD) + l * HD + 8 * fq; const float* pp = pe + ((size_t)e * L_CMP + l) * HD + 8 * fq;
                        *(u32x4*)(ap) = pack8(rot0[0] + *(const f32x4*)(pp), rot0[1] + *(const f32x4*)(pp + 4), 1.0f);
                        *(u32x4*)(ap + 32) = pack8(v[1][0] + *(const f32x4*)(pp + 32), v[1][1] + *(const f32x4*)(pp + 36), 1.0f);
                    }
                }
                asm volatile("" ::: "memory");
            }
    }
};
}

namespace pg8 {
struct EpiGelu {
    static constexpr bool PERM = true, AFTER_DRAIN = false;
    bf16_t* hid;
    __device__ __forceinline__ void operator()(const f32x4 (&acc)[2][2][4][2], const Unit& u, int wr, int wc, int fr, int fq) const {
        const int row0 = u.pm * BM + wr * 64 + fr;
#pragma unroll
        for (int ai = 0; ai < 2; ++ai)
#pragma unroll
            for (int m = 0; m < 4; ++m) {
                const int row = row0 + ai * HALF + m * 16;
#pragma unroll
                for (int bj = 0; bj < 2; ++bj) {
                    float a[8];
#pragma unroll
                    for (int n = 0; n < 2; ++n)
#pragma unroll
                        for (int i = 0; i < 4; ++i) { const float x = acc[ai][bj][m][n][i]; a[n * 4 + i] = x * __builtin_amdgcn_rcpf(1.0f + __expf(-1.5957691216057308f * (x + 0.044715f * x * x * x))); }
                    u32x4 w; w.x = cvt_pk_bf16(a[0], a[1]); w.y = cvt_pk_bf16(a[2], a[3]); w.z = cvt_pk_bf16(a[4], a[5]); w.w = cvt_pk_bf16(a[6], a[7]);
                    *(u32x4*)(hid + (size_t)row * CMP_HID + bj * HALF + wc * 32 + 8 * fq) = w;
                }
            }
    }
};
struct CmpOrder {
    int nunits, per_e, G, c;
    __device__ bool next(int i, Unit& u) const { const int L = i * G + c; if (L >= nunits) return false; u.pm = L; u.pn = L / per_e; return true; }
    __device__ __forceinline__ void a_ready(const Unit&) const {}
    __device__ __forceinline__ void done(const Unit&) const {}
};
}
constexpr int LDS_RING_C = 131072;
namespace att {
typedef short bf16x8 __attribute__((ext_vector_type(8)));
typedef short s16x4 __attribute__((ext_vector_type(4)));
typedef float f32x16 __attribute__((ext_vector_type(16)));
typedef __attribute__((address_space(3))) unsigned char* ldsp;
constexpr int TILE_B = 8192;
constexpr int L_KB = 0, L_VB = 2 * TILE_B, L_IMP = 4 * TILE_B, L_SELM = L_IMP + 64 * 64 * 4, L_END = L_SELM + 64 * 8;
constexpr float NEGB = -1e30f;
constexpr float QSCALE = 0.125f * 1.4426950408889634f;
__device__ __forceinline__ int crow(int r, int hi) { return (r & 3) + 8 * (r >> 2) + 4 * hi; }
__device__ __forceinline__ void glds16(const void* gsrc, unsigned lds_dst) { unsigned keep;
    asm volatile("s_mov_b32 %0, m0\n\ts_mov_b32 m0, %2\n\ts_nop 0\n\tglobal_load_lds_dwordx4 %1, off\n\ts_mov_b32 m0, %0" : "=&s"(keep) : "v"(gsrc), "s"(lds_dst) : "memory"); }
__device__ __forceinline__ unsigned cvtpk(float lo, float hi) { unsigned r; asm volatile("v_cvt_pk_bf16_f32 %0, %1, %2" : "=v"(r) : "v"(lo), "v"(hi)); return r; }
__device__ __forceinline__ float halfmax(float m) { auto rr = __builtin_amdgcn_permlane32_swap(__float_as_uint(m), __float_as_uint(m), false, false); return fmaxf(__uint_as_float(rr[0]), __uint_as_float(rr[1])); }
__device__ __forceinline__ float halfsum(float m) { auto rr = __builtin_amdgcn_permlane32_swap(__float_as_uint(m), __float_as_uint(m), false, false); return __uint_as_float(rr[0]) + __uint_as_float(rr[1]); }
__device__ __forceinline__ s16x4 vtr(ldsp p) { typedef short v4i16_t __attribute__((ext_vector_type(4))); return __builtin_bit_cast(s16x4, __builtin_amdgcn_ds_read_tr16_b64_v4i16((__attribute__((address_space(3))) v4i16_t*)p)); }
#define ATT_BAR_L() asm volatile("s_waitcnt lgkmcnt(0)\n\ts_barrier" ::: "memory")
#define ATT_WAIT_BAR(N) asm volatile("s_waitcnt vmcnt(" #N ") lgkmcnt(0)\n\ts_barrier" ::: "memory")
__device__ __forceinline__ void dma_tile(const unsigned char* img, unsigned lds_dst, int wid, int lane) { glds16(img + wid * 1024 + lane * 16, (unsigned)__builtin_amdgcn_readfirstlane(lds_dst + wid * 1024)); }
__device__ __forceinline__ void qk(f32x16& p0, f32x16& p1, ldsp kbuf, const bf16x8 (&qf)[4], float cinit, int r32, int hi) {
    f32x16 c;
#pragma unroll
    for (int r = 0; r < 16; ++r) c[r] = cinit;
    p0 = c; p1 = c;
#pragma unroll
    for (int s = 0; s < 4; ++s) {
        const bf16x8 k0 = *(const __attribute__((address_space(3))) bf16x8*)(kbuf + (2 * s + hi) * 1024 + r32 * 16);
        const bf16x8 k1 = *(const __attribute__((address_space(3))) bf16x8*)(kbuf + (2 * s + hi) * 1024 + r32 * 16 + 512);
        p0 = __builtin_amdgcn_mfma_f32_32x32x16_bf16(k0, qf[s], p0, 0, 0, 0);
        p1 = __builtin_amdgcn_mfma_f32_32x32x16_bf16(k1, qf[s], p1, 0, 0, 0);
    }
}
__device__ __forceinline__ void pv(f32x16 (&o)[2], ldsp vbuf, const f32x16& p0, const f32x16& p1, int lane, int hi) {
    unsigned pk[4][4];
#pragma unroll
    for (int k = 0; k < 4; ++k) { pk[0][k] = cvtpk(p0[2 * k], p0[2 * k + 1]); pk[1][k] = cvtpk(p0[8 + 2 * k], p0[9 + 2 * k]); pk[2][k] = cvtpk(p1[2 * k], p1[2 * k + 1]); pk[3][k] = cvtpk(p1[8 + 2 * k], p1[9 + 2 * k]); }
    const int vp0 = ((lane >> 4) & 1) * 32 + (lane & 3) * 8 + (4 * hi + ((lane & 15) >> 2)) * 64;
#pragma unroll
    for (int d0 = 0; d0 < 2; ++d0)
#pragma unroll
        for (int s = 0; s < 4; ++s) {
            const s16x4 lo = vtr(vbuf + d0 * 4096 + s * 1024 + vp0), hh = vtr(vbuf + d0 * 4096 + s * 1024 + 512 + vp0);
            const bf16x8 vf = (bf16x8){lo[0], lo[1], lo[2], lo[3], hh[0], hh[1], hh[2], hh[3]};
            typedef unsigned u32x4 __attribute__((ext_vector_type(4)));
            const u32x4 pw = (u32x4){pk[s][0], pk[s][1], pk[s][2], pk[s][3]};
            o[d0] = __builtin_amdgcn_mfma_f32_32x32x16_bf16(vf, __builtin_bit_cast(bf16x8, pw), o[d0], 0, 0, 0);
        }
}
struct Run { float m, l; f32x16 o[2]; };
template <bool EMASK> __device__ __forceinline__ void tile_step(Run& R, ldsp kbuf, ldsp vbuf, const bf16x8 (&qf)[4], float cinit, int lo_b_, int hi_b_, int lane, int r32, int hi) {
    int lo_b = lo_b_ - 4 * hi, hi_b = hi_b_ - 4 * hi;
    if (EMASK) asm volatile("" : "+v"(lo_b), "+v"(hi_b));
    f32x16 p0, p1; qk(p0, p1, kbuf, qf, cinit, r32, hi);
    if (EMASK) {
#pragma unroll
        for (int r = 0; r < 16; ++r) { const int kc_ = (r & 3) + 8 * (r >> 2); if (kc_ < lo_b || kc_ > hi_b) p0[r] = NEGB; if (kc_ + 32 < lo_b || kc_ + 32 > hi_b) p1[r] = NEGB; }
    }
    float rm = fmaxf(p0[0], p1[0]);
#pragma unroll
    for (int r = 1; r < 16; ++r) rm = fmaxf(rm, fmaxf(p0[r], p1[r]));
    rm = halfmax(rm);
    const float mn = fmaxf(R.m, rm), alpha = __builtin_amdgcn_exp2f(R.m - mn);
    R.m = mn; R.l *= alpha;
#pragma unroll
    for (int r = 0; r < 16; ++r) { R.o[0][r] *= alpha; R.o[1][r] *= alpha; }
    float ls = 0.f;
#pragma unroll
    for (int r = 0; r < 16; ++r) {
        float e0 = __builtin_amdgcn_exp2f(p0[r] - mn), e1 = __builtin_amdgcn_exp2f(p1[r] - mn);
        if (EMASK) { const int kc_ = (r & 3) + 8 * (r >> 2); if (kc_ < lo_b || kc_ > hi_b) e0 = 0.f; if (kc_ + 32 < lo_b || kc_ + 32 > hi_b) e1 = 0.f; }
        p0[r] = e0; p1[r] = e1; ls += e0 + e1;
    }
    R.l += ls;
    pv(R.o, vbuf, p0, p1, lane, hi);
}
struct Tensors {
    const bf16_t* qn; const bf16_t* qr;
    const unsigned char* ksel; const unsigned char* vsel; const unsigned char* kwin; const unsigned char* vwin;
    const unsigned char* kc; const unsigned char* vc;
    const float* gates; bf16_t* ob;
};
template <bool SEL> __device__ __forceinline__ void branch(Run& R, const unsigned char* kimg, const unsigned char* vimg, int t0, int t1, int jdiag, unsigned long long selm, int iq,
                                                           const bf16x8 (&qf)[4], unsigned lds0, ldsp lds, int wid, int lane, int r32, int hi) {
    R.m = NEGB; R.l = 0.f;
#pragma unroll
    for (int r = 0; r < 16; ++r) { R.o[0][r] = 0.f; R.o[1][r] = 0.f; }
    dma_tile(kimg + (size_t)t0 * TILE_B, lds0 + L_KB, wid, lane); dma_tile(vimg + (size_t)t0 * TILE_B, lds0 + L_VB, wid, lane);
    for (int t = t0; t <= t1; ++t) {
        const int b = (t - t0) & 1;
        if (t < t1) { dma_tile(kimg + (size_t)(t + 1) * TILE_B, lds0 + L_KB + (b ^ 1) * TILE_B, wid, lane); dma_tile(vimg + (size_t)(t + 1) * TILE_B, lds0 + L_VB + (b ^ 1) * TILE_B, wid, lane); ATT_WAIT_BAR(2); }
        else ATT_WAIT_BAR(0);
        const float cinit = (!SEL || ((selm >> t) & 1ull)) ? 0.f : NEGB;
        const bool lowm = !SEL && (t == jdiag - 8);
        if (t == jdiag || lowm) tile_step<true>(R, lds + L_KB + b * TILE_B, lds + L_VB + b * TILE_B, qf, cinit, lowm ? iq : 0, (t == jdiag) ? iq : 63, lane, r32, hi);
        else tile_step<false>(R, lds + L_KB + b * TILE_B, lds + L_VB + b * TILE_B, qf, cinit, 0, 63, lane, r32, hi);
        ATT_BAR_L();
    }
}
__device__ __forceinline__ void load_q(bf16x8 (&qf)[4], const bf16_t* qrow, int hi) {
#pragma unroll
    for (int s = 0; s < 4; ++s) qf[s] = *(const bf16x8*)(qrow + 16 * s + 8 * hi);
}
__device__ __forceinline__ void unit(const Tensors& T, int n, int j, int g, ldsp lds, unsigned lds0, int wid, int lane) {
    const int r32 = lane & 31, hi = lane >> 5, ql = r32 >> 2, hq = r32 & 3, iq = 8 * wid + ql;
    const int row = n * SEQ + 64 * j + iq, head = g * HPG + hq, pos = 64 * j + iq;
    const size_t img_ng = ((size_t)n * N_KV + g);
    f32x16 oacc[2];
#pragma unroll
    for (int r = 0; r < 16; ++r) { oacc[0][r] = 0.f; oacc[1][r] = 0.f; }
    const float* gt = T.gates + (size_t)row * 3 * N_HEADS + head * 3;
    const float g_c = gt[0], g_s = gt[1], g_w = gt[2];
    bf16x8 qf[4];
    unsigned long long selm;
    {
        load_q(qf, T.qn + (size_t)row * HDM + head * HD, hi);
        const int ntc = (2 * j + 2 + 63) / 64;
        const unsigned char* kci = T.kc + img_ng * (NBC_P / 64) * TILE_B; const unsigned char* vci = T.vc + img_ng * (NBC_P / 64) * TILE_B;
        dma_tile(kci, lds0 + L_KB, wid, lane); dma_tile(vci, lds0 + L_VB, wid, lane);
        if (ntc > 1) { dma_tile(kci + TILE_B, lds0 + L_KB + TILE_B, wid, lane); dma_tile(vci + TILE_B, lds0 + L_VB + TILE_B, wid, lane); }
        ATT_WAIT_BAR(0);
        int cmax = ((pos + 1) >> 5) - 1 - 4 * hi;
        asm volatile("" : "+v"(cmax));
        f32x16 s0, s1, s2, s3;
        qk(s0, s1, lds + L_KB, qf, 0.f, r32, hi);
        if (ntc > 1) qk(s2, s3, lds + L_KB + TILE_B, qf, 0.f, r32, hi);
        else {
#pragma unroll
            for (int r = 0; r < 16; ++r) { s2[r] = NEGB; s3[r] = NEGB; }
        }
        float mx = NEGB;
#pragma unroll
        for (int r = 0; r < 16; ++r) { const int kv = (r & 3) + 8 * (r >> 2);
            if (kv > cmax) s0[r] = NEGB; if (kv + 32 > cmax) s1[r] = NEGB; if (kv + 64 > cmax) s2[r] = NEGB; if (kv + 96 > cmax) s3[r] = NEGB;
            mx = fmaxf(fmaxf(mx, fmaxf(s0[r], s1[r])), fmaxf(s2[r], s3[r])); }
        mx = halfmax(mx);
        float ls = 0.f;
#pragma unroll
        for (int r = 0; r < 16; ++r) { const int kv = (r & 3) + 8 * (r >> 2);
            s0[r] = (kv > cmax) ? 0.f : __builtin_amdgcn_exp2f(s0[r] - mx); s1[r] = (kv + 32 > cmax) ? 0.f : __builtin_amdgcn_exp2f(s1[r] - mx);
            s2[r] = (kv + 64 > cmax) ? 0.f : __builtin_amdgcn_exp2f(s2[r] - mx); s3[r] = (kv + 96 > cmax) ? 0.f : __builtin_amdgcn_exp2f(s3[r] - mx);
            ls += (s0[r] + s1[r]) + (s2[r] + s3[r]); }
        ls = halfsum(ls);
        const float inv = 1.0f / fmaxf(ls, 1e-30f);
#pragma unroll
        for (int r = 0; r < 16; ++r) { s0[r] *= inv; s1[r] *= inv; s2[r] *= inv; s3[r] *= inv; }
        __attribute__((address_space(3))) float* imp = (__attribute__((address_space(3))) float*)(lds + L_IMP) + iq * 64;
#pragma unroll
        for (int r = 0; r < 16; r += 2) { const int bl = crow(r, hi) >> 1;
            float v0 = s0[r] + s0[r + 1], v1 = s1[r] + s1[r + 1], v2 = s2[r] + s2[r + 1], v3 = s3[r] + s3[r + 1];
            v0 += __shfl_xor(v0, 1); v0 += __shfl_xor(v0, 2); v1 += __shfl_xor(v1, 1); v1 += __shfl_xor(v1, 2);
            v2 += __shfl_xor(v2, 1); v2 += __shfl_xor(v2, 2); v3 += __shfl_xor(v3, 1); v3 += __shfl_xor(v3, 2);
            if (hq == 0) { imp[bl] = v0; imp[16 + bl] = v1; imp[32 + bl] = v2; imp[48 + bl] = v3; } }
        Run Rc;
#pragma unroll
        for (int r = 0; r < 16; ++r) { Rc.o[0][r] = 0.f; Rc.o[1][r] = 0.f; }
        pv(Rc.o, lds + L_VB, s0, s1, lane, hi);
        if (ntc > 1) pv(Rc.o, lds + L_VB + TILE_B, s2, s3, lane, hi);
#pragma unroll
        for (int r = 0; r < 16; ++r) { oacc[0][r] += g_c * Rc.o[0][r]; oacc[1][r] += g_c * Rc.o[1][r]; }
        asm volatile("s_waitcnt lgkmcnt(0)" ::: "memory");
        __attribute__((address_space(3))) unsigned long long* selw = (__attribute__((address_space(3))) unsigned long long*)(lds + L_SELM);
        for (int qq = 0; qq < 8; ++qq) {
            const float v = ((__attribute__((address_space(3))) float*)(lds + L_IMP))[(8 * wid + qq) * 64 + lane];
            const bool valid = lane <= j, forced = (lane == 0) || (lane == j) || (lane == j - 1);
            const unsigned key = valid ? (forced ? 0x7f000000u : __float_as_uint(v) + 1u) : 0u;
            unsigned long long m;
            if (j + 1 <= N_SEL) m = __ballot(valid);
            else {
                unsigned Tt = 0u;
                for (int bit = 30; bit >= 0; --bit) { const unsigned cand = Tt | (1u << bit); if (__popcll(__ballot(key >= cand)) >= N_SEL) Tt = cand; }
                const unsigned long long gtm = __ballot(key > Tt), eqm = __ballot(key == Tt);
                const int need = N_SEL - __popcll(gtm);
                const bool pick = (key == Tt) && (__popcll(eqm & ((1ull << lane) - 1ull)) < need);
                m = gtm | __ballot(pick);
            }
            if (lane == 0) selw[8 * wid + qq] = m;
        }
        asm volatile("s_waitcnt lgkmcnt(0)" ::: "memory");
        selm = selw[iq];
        ATT_WAIT_BAR(0);
    }
    load_q(qf, T.qr + (size_t)row * HDM + head * HD, hi);
    {
        Run R; branch<true>(R, T.ksel + img_ng * (SEQ / 64) * TILE_B, T.vsel + img_ng * (SEQ / 64) * TILE_B, 0, j, j, selm, iq, qf, lds0, lds, wid, lane, r32, hi);
        const float sc = g_s / fmaxf(halfsum(R.l), 1e-30f);
#pragma unroll
        for (int r = 0; r < 16; ++r) { oacc[0][r] += sc * R.o[0][r]; oacc[1][r] += sc * R.o[1][r]; }
    }
    {
        Run R; branch<false>(R, T.kwin + img_ng * (SEQ / 64) * TILE_B, T.vwin + img_ng * (SEQ / 64) * TILE_B, j > 8 ? j - 8 : 0, j, j, 0ull, iq, qf, lds0, lds, wid, lane, r32, hi);
        const float sc = g_w / fmaxf(halfsum(R.l), 1e-30f);
#pragma unroll
        for (int r = 0; r < 16; ++r) { oacc[0][r] += sc * R.o[0][r]; oacc[1][r] += sc * R.o[1][r]; }
    }
    bf16_t* orow = T.ob + (size_t)row * HDM + head * HD;
#pragma unroll
    for (int d0 = 0; d0 < 2; ++d0)
#pragma unroll
        for (int rr = 0; rr < 4; ++rr) { typedef unsigned u32x2 __attribute__((ext_vector_type(2)));
            u32x2 w; w.x = cvtpk(oacc[d0][4 * rr], oacc[d0][4 * rr + 1]); w.y = cvtpk(oacc[d0][4 * rr + 2], oacc[d0][4 * rr + 3]);
            *(u32x2*)(orow + 32 * d0 + 8 * rr + 4 * hi) = w; }
}
__device__ __forceinline__ void phase(const Tensors& T, ldsp lds, int wid, int lane, int cu, int ncu) {
    const unsigned lds0 = (unsigned)(uintptr_t)lds;
    constexpr int NQB = SEQ / 64, NGRP = NQB / 4;
    for (int c = cu; c < BATCH * N_KV * NGRP; c += ncu) {
        const int ng = c / NGRP, s = c % NGRP, n = ng / N_KV, g = ng % N_KV;
        for (int k = 0; k < 4; ++k) { const int j = (k == 0) ? s : (k == 1) ? NQB / 2 - 1 - s : (k == 2) ? NQB / 2 + s : NQB - 1 - s; unit(T, n, j, g, lds, lds0, wid, lane); }
    }
}
}
namespace att {
constexpr int S_STAGE = 16384;
constexpr int S_XM = LDS_RING_C + 1024, S_XL = S_XM + 1024, S_IMP = S_XL + 1024, S_SELM = S_IMP + 8 * 128 * 4, S_END = S_SELM + 8 * 2 * 8;
struct STensors {
    const bf16_t* qn; const bf16_t* qr; const float* kc; const float* vc; const float* cache_kv; const int* page_table; const float* cache_win; const float* out; const float* winrows;
    const float* gates; bf16_t* ob;
};
typedef float f32x4_t __attribute__((ext_vector_type(4)));
__device__ __forceinline__ void stage_kv(ldsp kimg, ldsp vimg, const float* ksrc, const float* vsrc, int stride, int nrows, int lane) {
    typedef unsigned u32x4 __attribute__((ext_vector_type(4)));
    const int c = lane & 7;
#pragma unroll 1
    for (int ib = 0; ib < 8; ib += 4)
#pragma unroll
    for (int it = ib; it < ib + 4; ++it) {
        const int row = 8 * it + (lane >> 3);
        f32x4_t k0 = {0.f, 0.f, 0.f, 0.f}, k1 = k0, v0 = k0, v1 = k0;
        if (row < nrows) { const float* kp = ksrc + (size_t)row * stride + 8 * c; const float* vp = vsrc + (size_t)row * stride + 8 * c;
            k0 = *(const f32x4_t*)kp; k1 = *(const f32x4_t*)(kp + 4); v0 = *(const f32x4_t*)vp; v1 = *(const f32x4_t*)(vp + 4); }
        u32x4 kw, vw; kw.x = cvtpk(k0[0], k0[1]); kw.y = cvtpk(k0[2], k0[3]); kw.z = cvtpk(k1[0], k1[1]); kw.w = cvtpk(k1[2], k1[3]);
        vw.x = cvtpk(v0[0], v0[1]); vw.y = cvtpk(v0[2], v0[3]); vw.z = cvtpk(v1[0], v1[1]); vw.w = cvtpk(v1[2], v1[3]);
        *(__attribute__((address_space(3))) u32x4*)(kimg + c * 1024 + row * 16) = kw;
        *(__attribute__((address_space(3))) u32x4*)(vimg + (c >> 2) * 4096 + (row >> 3) * 512 + (row & 7) * 64 + (c & 3) * 16) = vw;
    }
    asm volatile("s_waitcnt lgkmcnt(0)" ::: "memory");
}
#define ATT_BAR_ALL() asm volatile("s_waitcnt vmcnt(0) lgkmcnt(0)\n\ts_barrier" ::: "memory")
__device__ __forceinline__ float merge_stats(ldsp lds, float m_own, float l_own_half, int wid, int r32, int hi) {
    __attribute__((address_space(3))) float* xm = (__attribute__((address_space(3))) float*)(lds + S_XM); __attribute__((address_space(3))) float* xl = (__attribute__((address_space(3))) float*)(lds + S_XL);
    const float l_own = halfsum(l_own_half);
    if (hi == 0) { xm[wid * 32 + r32] = m_own; xl[wid * 32 + r32] = l_own; }
    ATT_BAR_ALL();
    float M = NEGB;
#pragma unroll
    for (int w = 0; w < 8; ++w) M = fmaxf(M, xm[w * 32 + r32]);
    float L = 0.f;
#pragma unroll
    for (int w = 0; w < 8; ++w) L += __builtin_amdgcn_exp2f(xm[w * 32 + r32] - M) * xl[w * 32 + r32];
    const float wgt = __builtin_amdgcn_exp2f(m_own - M) / fmaxf(L, 1e-30f);
    ATT_BAR_ALL();
    return wgt;
}
__device__ __forceinline__ void sample_unit(const STensors& T, int b, int g, ldsp lds, int wid, int lane) {
    const int r32 = lane & 31, hi = lane >> 5, ql = r32 >> 2, hq = r32 & 3;
    const int row = MP + b * DEC_SEQ + ql, head = g * HPG + hq, seq = BATCH + b;
    ldsp kimg = lds + wid * S_STAGE, vimg = kimg + TILE_B;
    f32x16 oacc[2];
#pragma unroll
    for (int r = 0; r < 16; ++r) { oacc[0][r] = 0.f; oacc[1][r] = 0.f; }
    const float* gt = T.gates + (size_t)row * 3 * N_HEADS + head * 3;
    const float g_c = gt[0], g_s = gt[1], g_w = gt[2];
    bf16x8 qf[4];
    __attribute__((address_space(3))) float* xm = (__attribute__((address_space(3))) float*)(lds + S_XM); __attribute__((address_space(3))) float* xl = (__attribute__((address_space(3))) float*)(lds + S_XL);
    __attribute__((address_space(3))) float* imp = (__attribute__((address_space(3))) float*)(lds + S_IMP);
    __attribute__((address_space(3))) unsigned long long* selw = (__attribute__((address_space(3))) unsigned long long*)(lds + S_SELM);
    {
        load_q(qf, T.qn + (size_t)row * HDM + head * HD, hi);
        constexpr int NTC = NBC_PAST / 64;
        f32x16 p0, p1; const bool mine = wid < NTC;
        float rm = NEGB;
        if (mine) {
            const float* kcp = T.kc + (((size_t)seq * NBC_MAX + 64 * wid) * N_KV + g) * HD; const float* vcp = T.vc + (((size_t)seq * NBC_MAX + 64 * wid) * N_KV + g) * HD;
            stage_kv(kimg, vimg, kcp, vcp, N_KV * HD, 64, lane);
            qk(p0, p1, kimg, qf, 0.f, r32, hi);
#pragma unroll
            for (int r = 0; r < 16; ++r) rm = fmaxf(rm, fmaxf(p0[r], p1[r]));
            rm = halfmax(rm);
        }
        if (hi == 0) xm[wid * 32 + r32] = rm;
        ATT_BAR_ALL();
        float M = NEGB;
#pragma unroll
        for (int w = 0; w < 8; ++w) M = fmaxf(M, xm[w * 32 + r32]);
        float ls = 0.f;
        if (mine) {
#pragma unroll
            for (int r = 0; r < 16; ++r) { p0[r] = __builtin_amdgcn_exp2f(p0[r] - M); p1[r] = __builtin_amdgcn_exp2f(p1[r] - M); ls += p0[r] + p1[r]; }
            ls = halfsum(ls);
        }
        if (hi == 0) xl[wid * 32 + r32] = ls;
        ATT_BAR_ALL();
        float L = 0.f;
#pragma unroll
        for (int w = 0; w < 8; ++w) L += xl[w * 32 + r32];
        const float inv = 1.0f / fmaxf(L, 1e-30f);
        if (mine) {
#pragma unroll
            for (int r = 0; r < 16; ++r) { p0[r] *= inv; p1[r] *= inv; }
#pragma unroll
            for (int r = 0; r < 16; r += 2) { const int bl = crow(r, hi) >> 1;
                float v0 = p0[r] + p0[r + 1], v1 = p1[r] + p1[r + 1];
                v0 += __shfl_xor(v0, 1); v0 += __shfl_xor(v0, 2); v1 += __shfl_xor(v1, 1); v1 += __shfl_xor(v1, 2);
                if (hq == 0) { imp[ql * 128 + 32 * wid + bl] = v0; imp[ql * 128 + 32 * wid + 16 + bl] = v1; } }
            Run Rc;
#pragma unroll
            for (int r = 0; r < 16; ++r) { Rc.o[0][r] = 0.f; Rc.o[1][r] = 0.f; }
            pv(Rc.o, vimg, p0, p1, lane, hi);
#pragma unroll
            for (int r = 0; r < 16; ++r) { oacc[0][r] += g_c * Rc.o[0][r]; oacc[1][r] += g_c * Rc.o[1][r]; }
        }
        ATT_BAR_ALL();
    }
    {
        constexpr int NCAND = NBS_S - 1;
        const float v0 = imp[wid * 128 + lane], v1 = imp[wid * 128 + 64 + lane];
        const unsigned key0 = (lane == 0) ? 0x7f000000u : __float_as_uint(v0) + 1u;
        const unsigned key1 = (lane + 64 == NCAND - 1) ? 0x7f000000u : __float_as_uint(v1) + 1u;
        unsigned Tt = 0u;
        for (int bit = 30; bit >= 0; --bit) { const unsigned cand = Tt | (1u << bit); if (__popcll(__ballot(key0 >= cand)) + __popcll(__ballot(key1 >= cand)) >= N_SEL - 1) Tt = cand; }
        const unsigned long long gt0 = __ballot(key0 > Tt), gt1 = __ballot(key1 > Tt), eq0 = __ballot(key0 == Tt), eq1 = __ballot(key1 == Tt);
        const int need = (N_SEL - 1) - __popcll(gt0) - __popcll(gt1);
        const unsigned long long below = (1ull << lane) - 1ull;
        const bool pick0 = (key0 == Tt) && (__popcll(eq0 & below) < need);
        const bool pick1 = (key1 == Tt) && (__popcll(eq0) + __popcll(eq1 & below) < need);
        const unsigned long long m0 = gt0 | __ballot(pick0), m1 = gt1 | __ballot(pick1);
        if (lane == 0) { selw[wid * 2] = m0; selw[wid * 2 + 1] = m1; }
        ATT_BAR_ALL();
    }
    load_q(qf, T.qr + (size_t)row * HDM + head * HD, hi);
    {
        unsigned long long U0 = 0ull, U1 = 0ull;
#pragma unroll
        for (int q = 0; q < 8; ++q) { U0 |= selw[q * 2]; U1 |= selw[q * 2 + 1]; }
        U0 = __builtin_amdgcn_readfirstlane((unsigned)U0) | ((unsigned long long)__builtin_amdgcn_readfirstlane((unsigned)(U0 >> 32)) << 32);
        U1 = __builtin_amdgcn_readfirstlane((unsigned)U1) | ((unsigned long long)__builtin_amdgcn_readfirstlane((unsigned)(U1 >> 32)) << 32);
        const unsigned long long my0 = selw[ql * 2], my1 = selw[ql * 2 + 1];
        Run R; R.m = NEGB; R.l = 0.f;
#pragma unroll
        for (int r = 0; r < 16; ++r) { R.o[0][r] = 0.f; R.o[1][r] = 0.f; }
        int idx = 0;
        for (int half = 0; half < 2; ++half) {
            unsigned long long U = half ? U1 : U0;
            while (U) {
                const int bit = __builtin_ctzll(U); U &= U - 1ull;
                if ((idx++ & 7) != wid) continue;
                const int blk = 64 * half + bit;
                const int page = T.page_table[b * N_PAGES + (blk * L_SEL) / PAGE_SIZE];
                const float* base = T.cache_kv + (((size_t)page * PAGE_SIZE + (blk * L_SEL) % PAGE_SIZE) * 4) * N_KV * HD + g * HD;
                stage_kv(kimg, vimg, base + 2 * N_KV * HD, base + 3 * N_KV * HD, 4 * N_KV * HD, 64, lane);
                const bool selected = ((half ? my1 : my0) >> bit) & 1ull;
                tile_step<false>(R, kimg, vimg, qf, selected ? 0.f : NEGB, 0, 63, lane, r32, hi);
            }
        }
        if ((idx & 7) == wid) {
            const float* base = T.out + O_KVS + (((size_t)b * DEC_SEQ) * 4) * N_KV * HD + g * HD;
            stage_kv(kimg, vimg, base + 2 * N_KV * HD, base + 3 * N_KV * HD, 4 * N_KV * HD, DEC_SEQ, lane);
            tile_step<true>(R, kimg, vimg, qf, 0.f, 0, ql, lane, r32, hi);
        }
        const float wgt = merge_stats(lds, R.m, R.l, wid, r32, hi) * g_s;
#pragma unroll
        for (int r = 0; r < 16; ++r) { oacc[0][r] += wgt * R.o[0][r]; oacc[1][r] += wgt * R.o[1][r]; }
    }
    {
        Run R; R.m = NEGB; R.l = 0.f;
#pragma unroll
        for (int r = 0; r < 16; ++r) { R.o[0][r] = 0.f; R.o[1][r] = 0.f; }
        for (int t = wid; t < WINDOW / 64; t += 8) {
            const float* base = T.cache_win + (((size_t)b * WINDOW + 64 * t) * 2) * N_KV * HD + g * HD;
            stage_kv(kimg, vimg, base, base + N_KV * HD, 2 * N_KV * HD, 64, lane);
            if (t == 0) tile_step<true>(R, kimg, vimg, qf, 0.f, ql, 63, lane, r32, hi); else tile_step<false>(R, kimg, vimg, qf, 0.f, 0, 63, lane, r32, hi);
        }
        if (wid == 0) {
            const float* base = T.winrows + (((size_t)(MP + b * DEC_SEQ)) * 2) * N_KV * HD + g * HD;
            stage_kv(kimg, vimg, base, base + N_KV * HD, 2 * N_KV * HD, DEC_SEQ, lane);
            tile_step<true>(R, kimg, vimg, qf, 0.f, 0, ql, lane, r32, hi);
        }
        const float wgt = merge_stats(lds, R.m, R.l, wid, r32, hi) * g_w;
#pragma unroll
        for (int r = 0; r < 16; ++r) { oacc[0][r] += wgt * R.o[0][r]; oacc[1][r] += wgt * R.o[1][r]; }
    }
    {
        __attribute__((address_space(3))) float* mine = (__attribute__((address_space(3))) float*)(lds + wid * S_STAGE);
#pragma unroll
        for (int d0 = 0; d0 < 2; ++d0)
#pragma unroll
            for (int rr = 0; rr < 4; ++rr) *(__attribute__((address_space(3))) f32x4_t*)(mine + r32 * 64 + 32 * d0 + 8 * rr + 4 * hi) = (f32x4_t){oacc[d0][4 * rr], oacc[d0][4 * rr + 1], oacc[d0][4 * rr + 2], oacc[d0][4 * rr + 3]};
        ATT_BAR_ALL();
        const int tid = wid * 64 + lane, orow = tid >> 4, oc4 = (tid & 15) * 4;
        f32x4_t s = {0.f, 0.f, 0.f, 0.f};
#pragma unroll
        for (int w = 0; w < 8; ++w) s += *(const __attribute__((address_space(3))) f32x4_t*)((__attribute__((address_space(3))) float*)(lds + w * S_STAGE) + orow * 64 + oc4);
        typedef unsigned u32x2 __attribute__((ext_vector_type(2)));
        u32x2 wv; wv.x = cvtpk(s[0], s[1]); wv.y = cvtpk(s[2], s[3]);
        const int oq = orow >> 2, oh = orow & 3;
        *(u32x2*)(T.ob + (size_t)(MP + b * DEC_SEQ + oq) * HDM + (g * HPG + oh) * HD + oc4) = wv;
        ATT_BAR_ALL();
    }
}
__device__ __forceinline__ void sample_phase(const STensors& T, ldsp lds, int wid, int lane, int cu, int ncu) {
    for (int c = cu; c < DEC_BATCH * N_KV; c += ncu) sample_unit(T, c / N_KV, c % N_KV, lds, wid, lane);
}
}


namespace att {
__device__ __forceinline__ void cmp_out_wave(int task, const bf16_t* hid, int R, int nbc, int seq0, const bf16_t* w2t, const float* k_norm0, float* kc, float* vc, unsigned char* kci, unsigned char* vci, int lane) {
    const int r32 = lane & 31, hi = lane >> 5;
    const int r0 = task * 32, e = r0 >= R ? 1 : 0, r = r0 - e * R + r32;
    const bf16_t* hrow = hid + ((size_t)e * R + r) * CMP_HID; const bf16_t* wrow = w2t + ((size_t)e * HD + r32) * CMP_HID;
    f32x16 o0, o1;
#pragma unroll
    for (int k = 0; k < 16; ++k) { o0[k] = 0.f; o1[k] = 0.f; }
#pragma unroll 4
    for (int s_ = 0; s_ < CMP_HID / 16; ++s_) {
        const bf16x8 hb_ = *(const bf16x8*)(hrow + 16 * s_ + 8 * hi);
        const bf16x8 w0 = *(const bf16x8*)(wrow + 16 * s_ + 8 * hi), w1 = *(const bf16x8*)(wrow + (size_t)32 * CMP_HID + 16 * s_ + 8 * hi);
        o0 = __builtin_amdgcn_mfma_f32_32x32x16_bf16(w0, hb_, o0, 0, 0, 0); o1 = __builtin_amdgcn_mfma_f32_32x32x16_bf16(w1, hb_, o1, 0, 0, 0);
    }
    if (e == 0) {
        float ss = 0.f;
#pragma unroll
        for (int k = 0; k < 16; ++k) ss += o0[k] * o0[k] + o1[k] * o1[k];
        ss = halfsum(ss);
        const float rn = rsqrtf(ss * (1.0f / HD) + EPS);
#pragma unroll
        for (int k = 0; k < 16; ++k) { o0[k] *= rn * k_norm0[crow(k, hi)]; o1[k] *= rn * k_norm0[32 + crow(k, hi)]; }
    }
    const int g = r % N_KV, c = (r / N_KV) % nbc, sq = r / (N_KV * nbc);
    float* dst = (e == 0 ? kc : vc) + (((size_t)(seq0 + sq) * NBC_MAX + c) * N_KV + g) * HD;
#pragma unroll
    for (int rr = 0; rr < 4; ++rr) { *(f32x4_t*)(dst + 8 * rr + 4 * hi) = (f32x4_t){o0[4 * rr], o0[4 * rr + 1], o0[4 * rr + 2], o0[4 * rr + 3]};
                                      *(f32x4_t*)(dst + 32 + 8 * rr + 4 * hi) = (f32x4_t){o1[4 * rr], o1[4 * rr + 1], o1[4 * rr + 2], o1[4 * rr + 3]}; }
    if (kci) {
        unsigned char* img = (e == 0 ? kci : vci) + (((size_t)sq * N_KV + g) * (NBC_P / 64) + c / 64) * 8192; const int kv = c % 64;
        typedef unsigned u32x2 __attribute__((ext_vector_type(2)));
#pragma unroll
        for (int rr = 0; rr < 4; ++rr) {
            u32x2 a; a.x = cvtpk(o0[4 * rr], o0[4 * rr + 1]); a.y = cvtpk(o0[4 * rr + 2], o0[4 * rr + 3]);
            u32x2 bq; bq.x = cvtpk(o1[4 * rr], o1[4 * rr + 1]); bq.y = cvtpk(o1[4 * rr + 2], o1[4 * rr + 3]);
            const int d0 = 8 * rr, d1 = 32 + 8 * rr;
            *(u32x2*)(img + (e == 0 ? kimg_off(kv, d0) : vimg_off(kv, d0)) + 8 * hi) = a;
            *(u32x2*)(img + (e == 0 ? kimg_off(kv, d1) : vimg_off(kv, d1)) + 8 * hi) = bq;
        }
    }
}
}
__device__ __forceinline__ void conv_thin_vec_item(size_t i_, const bf16_t* ub, const bf16_t* bb, const float* state, const float* wc, bf16_t* zb) {
    typedef unsigned u4 __attribute__((ext_vector_type(4)));
    const int m = (int)(i_ / (D_MODEL / 8)), ch = (int)(i_ % (D_MODEL / 8)) * 8;
    const RowInfo ri = row_info(m);
    const size_t o = (size_t)m * D_MODEL + ch;
    float u0[8], u1[8], u2[8], bv[8];
#define UNPK(w, f) do { f[0] = bf2f((bf16_t)((w).x & 0xffff)); f[1] = bf2f((bf16_t)((w).x >> 16)); f[2] = bf2f((bf16_t)((w).y & 0xffff)); f[3] = bf2f((bf16_t)((w).y >> 16)); \
                        f[4] = bf2f((bf16_t)((w).z & 0xffff)); f[5] = bf2f((bf16_t)((w).z >> 16)); f[6] = bf2f((bf16_t)((w).w & 0xffff)); f[7] = bf2f((bf16_t)((w).w >> 16)); } while (0)
    { const u4 w = *(const u4*)(ub + o); UNPK(w, u0); } { const u4 w = *(const u4*)(bb + o); UNPK(w, bv); }
    const float* st = (ri.seq >= BATCH) ? state + (size_t)(ri.seq - BATCH) * 2 * D_MODEL + ch : nullptr;
    if (ri.t >= 1) { const u4 w = *(const u4*)(ub + o - D_MODEL); UNPK(w, u1); } else { for (int k = 0; k < 8; ++k) u1[k] = st ? st[D_MODEL + k] : 0.f; }
    if (ri.t >= 2) { const u4 w = *(const u4*)(ub + o - 2 * D_MODEL); UNPK(w, u2); } else { for (int k = 0; k < 8; ++k) u2[k] = st ? (ri.t == 1 ? st[D_MODEL + k] : st[k]) : 0.f; }
#undef UNPK
    float z[8];
    for (int k = 0; k < 8; ++k) z[k] = bv[k] * (wc[ch + k] * u2[k] + wc[D_MODEL + ch + k] * u1[k] + wc[2 * D_MODEL + ch + k] * u0[k]);
    u4 w; w.x = (unsigned)f2bf(z[0]) | ((unsigned)f2bf(z[1]) << 16); w.y = (unsigned)f2bf(z[2]) | ((unsigned)f2bf(z[3]) << 16);
    w.z = (unsigned)f2bf(z[4]) | ((unsigned)f2bf(z[5]) << 16); w.w = (unsigned)f2bf(z[6]) | ((unsigned)f2bf(z[7]) << 16);
    *(u4*)(zb + o) = w;
}

namespace att {
__device__ __forceinline__ void skinny_task(int task, const bf16_t* A, const bf16_t* Bt, int N, int K, int KS, float* part, int lane) {
    const int r32 = lane & 31, hi = lane >> 5, ncb = N / 32, nrb = MS / 32;
    const int ks = task / (nrb * ncb), rem = task % (nrb * ncb), rb = rem / ncb, cb = rem % ncb, klen = K / KS, k0 = ks * klen;
    const bf16_t* ap = A + (size_t)(rb * 32 + r32) * K + k0 + 8 * hi; const bf16_t* bp = Bt + (size_t)(cb * 32 + r32) * K + k0 + 8 * hi;
    f32x16 acc;
#pragma unroll
    for (int k = 0; k < 16; ++k) acc[k] = 0.f;
#pragma unroll 8
    for (int s_ = 0; s_ < klen / 16; ++s_) acc = __builtin_amdgcn_mfma_f32_32x32x16_bf16(*(const bf16x8*)(bp + 16 * s_), *(const bf16x8*)(ap + 16 * s_), acc, 0, 0, 0);
    float* dst = part + ((size_t)ks * MS + rb * 32 + r32) * N + cb * 32 + 4 * hi;
#pragma unroll
    for (int rr = 0; rr < 4; ++rr) *(f32x4_t*)(dst + 8 * rr) = (f32x4_t){acc[4 * rr], acc[4 * rr + 1], acc[4 * rr + 2], acc[4 * rr + 3]};
}
__device__ __forceinline__ void resid_reduce_row(int rs_, const float* part, int KS, float coef, float* h, bf16_t* hb, float* rss_next, float* yout, int lane) {
    typedef unsigned u2 __attribute__((ext_vector_type(2)));
    const int m = MP + rs_; float ssq = 0.f;
#pragma unroll
    for (int j = 0; j < D_MODEL / 256; ++j) {
        const int col = 256 * j + 4 * lane; f32x4_t a = {0.f, 0.f, 0.f, 0.f};
        for (int ks = 0; ks < KS; ++ks) a += *(const f32x4_t*)(part + ((size_t)ks * MS + rs_) * D_MODEL + col);
        const f32x4_t v = *(const f32x4_t*)(h + (size_t)m * D_MODEL + col) + a * coef;
        if (yout) *(f32x4_t*)(yout + (size_t)m * D_MODEL + col) = v;
        else { *(f32x4_t*)(h + (size_t)m * D_MODEL + col) = v; u2 w; w.x = cvtpk(v[0], v[1]); w.y = cvtpk(v[2], v[3]); *(u2*)(hb + (size_t)m * D_MODEL + col) = w;
               ssq += (v[0] * v[0] + v[1] * v[1]) + (v[2] * v[2] + v[3] * v[3]); }
    }
    if (!yout) {
#pragma unroll
        for (int o = 1; o < 64; o <<= 1) ssq += __shfl_xor(ssq, o);
        if (lane == 0) rss_next[m] = ssq;
    }
}
}
__device__ __forceinline__ void conv_thin_sample_item(size_t i_, const float* part, int KS, const float* rss, const float* state, const float* wc, bf16_t* zb, float* out, int layer) {
    const int rs_ = (int)(i_ / (D_MODEL / 8)), ch = (int)(i_ % (D_MODEL / 8)) * 8, m = MP + rs_;
    const RowInfo ri = row_info(m);
    const int nc = (ch / 128) * 256 + (ch % 128);
    float u[3][8], bv[8];
    for (int back = 0; back < 3; ++back) {
        if (ri.t - back >= 0) {
            const int r2 = rs_ - back; const float rsn = rsqrtf(rss[MP + r2] * (1.0f / D_MODEL) + EPS);
            for (int k = 0; k < 8; ++k) { float c = 0.f, x = 0.f; for (int ks = 0; ks < KS; ++ks) { const float* p = part + ((size_t)ks * MS + r2) * 3 * D_MODEL; c += p[nc + k]; x += p[nc + 128 + k]; } u[back][k] = (c * rsn) * (x * rsn); }
        } else { const float* st = state + (size_t)(ri.seq - BATCH) * 2 * D_MODEL + ch;
            const int srow = 2 - (back - ri.t); for (int k = 0; k < 8; ++k) u[back][k] = st[(size_t)srow * D_MODEL + k]; }
    }
    { const float rsn = rsqrtf(rss[m] * (1.0f / D_MODEL) + EPS);
      for (int k = 0; k < 8; ++k) { float b = 0.f; for (int ks = 0; ks < KS; ++ks) b += part[((size_t)ks * MS + rs_) * 3 * D_MODEL + 2 * D_MODEL + ch + k]; bv[k] = b * rsn; } }
    for (int k = 0; k < 8; ++k) { const float ub0 = bf2f(f2bf(u[0][k])), ub1 = (ri.t >= 1) ? bf2f(f2bf(u[1][k])) : u[1][k], ub2 = (ri.t >= 2) ? bf2f(f2bf(u[2][k])) : u[2][k];
        zb[(size_t)m * D_MODEL + ch + k] = f2bf(bf2f(f2bf(bv[k])) * (wc[ch + k] * ub2 + wc[D_MODEL + ch + k] * ub1 + wc[2 * D_MODEL + ch + k] * ub0));
        if (ri.t >= DEC_SEQ - 2) out[O_CS + (((size_t)layer * DEC_BATCH + (ri.seq - BATCH)) * 2 + (ri.t - (DEC_SEQ - 2))) * D_MODEL + ch + k] = u[0][k]; }
}

__device__ __forceinline__ void acmp_sample_wave(int task, const float* cache_kv, const int* page_table, const float* pe, bf16_t* A, int lane) {
    typedef float f4 __attribute__((ext_vector_type(4))); typedef unsigned u4 __attribute__((ext_vector_type(4)));
    const int b = task / NBC_PAST, c = task % NBC_PAST, tok0 = c * L_CMP;
    const int page = page_table[b * N_PAGES + tok0 / PAGE_SIZE];
    const int e = lane >> 5, g = (lane >> 3) & (N_KV - 1), c8 = lane & 7;
    const float* src = cache_kv + ((size_t)page * PAGE_SIZE + tok0 % PAGE_SIZE) * 4 * N_KV * HD + lane * 8;
    const float* pp = pe + (size_t)e * L_CMP * HD + 8 * c8;
    bf16_t* dst = A + ((size_t)e * RS_CMP + ((size_t)b * NBC_PAST + c) * N_KV + g) * (L_CMP * HD) + 8 * c8;
#pragma unroll 8
    for (int l = 0; l < L_CMP; ++l) {
        const f4 a0 = __builtin_nontemporal_load((const f4*)(src + (size_t)l * 4 * N_KV * HD)) + *(const f4*)(pp + l * HD), a1 = __builtin_nontemporal_load((const f4*)(src + (size_t)l * 4 * N_KV * HD + 4)) + *(const f4*)(pp + l * HD + 4);
        u4 w; w.x = att::cvtpk(a0[0], a0[1]); w.y = att::cvtpk(a0[2], a0[3]); w.z = att::cvtpk(a1[0], a1[1]); w.w = att::cvtpk(a1[2], a1[3]);
        *(u4*)(dst + l * HD) = w;
    }
}
__device__ __forceinline__ void wconv_tile(int item, const float* src, int Nsrc, const float* gain, bf16_t* dst, int Nd, int K, int kind, int aux, LAS float* scr, int lane) {
    const int nblk = Nd / 32, kb = item / nblk, nb = item % nblk, k0 = 64 * kb, n0 = 32 * nb;
    const int colbase = colmap(kind, n0, aux);
    const int col = colbase + (lane & 31); const bool ok = colbase >= 0 && col < Nsrc;
    float tv[32];
    const float* sp0 = src + (size_t)(k0 + (lane >> 5)) * Nsrc + (ok ? col : 0);
#pragma unroll
    for (int i = 0; i < 32; ++i) tv[i] = ok ? __builtin_nontemporal_load(sp0 + (size_t)(2 * i) * Nsrc) : 0.f;
#pragma unroll
    for (int i = 0; i < 32; ++i) { const int kk = 2 * i + (lane >> 5); const float g = gain ? gain[k0 + kk] : 1.f; scr[kk * 33 + (lane & 31)] = tv[i] * g; }
    asm volatile("s_waitcnt lgkmcnt(0)" ::: "memory");
    const int c = lane & 7;
#pragma unroll
    for (int j = 0; j < 4; ++j) { const int n = (lane >> 3) + 8 * j; const LAS float* sp = scr + (8 * c) * 33 + n;
        typedef unsigned v4u __attribute__((ext_vector_type(4)));
        v4u o; o.x = pg8::cvt_pk_bf16(sp[0 * 33], sp[1 * 33]); o.y = pg8::cvt_pk_bf16(sp[2 * 33], sp[3 * 33]); o.z = pg8::cvt_pk_bf16(sp[4 * 33], sp[5 * 33]); o.w = pg8::cvt_pk_bf16(sp[6 * 33], sp[7 * 33]);
        *(v4u*)(dst + (size_t)(n0 + n) * K + k0 + 8 * c) = o; }
    asm volatile("s_waitcnt lgkmcnt(0)" ::: "memory");
}
__device__ __forceinline__ void hinit_row(int m, const float* xp, const float* xs, float* h, bf16_t* hb, float* rss0, int lane) {
    typedef float f4 __attribute__((ext_vector_type(4))); typedef unsigned u2 __attribute__((ext_vector_type(2)));
    const float* x = m < MP ? xp + (size_t)m * D_MODEL : xs + (size_t)(m - MP) * D_MODEL;
    float s = 0.f;
#pragma unroll
    for (int j = 0; j < D_MODEL / 256; ++j) { const f4 v = *(const f4*)(x + 256 * j + 4 * lane); s += (v[0] * v[0] + v[1] * v[1]) + (v[2] * v[2] + v[3] * v[3]);
        *(f4*)(h + (size_t)m * D_MODEL + 256 * j + 4 * lane) = v; u2 w; w.x = pg8::cvt_pk_bf16(v[0], v[1]); w.y = pg8::cvt_pk_bf16(v[2], v[3]); *(u2*)(hb + (size_t)m * D_MODEL + 256 * j + 4 * lane) = w; }
#pragma unroll
    for (int o = 1; o < 64; o <<= 1) s += __shfl_xor(s, o);
    if (lane == 0) rss0[m] = s;
}
#endif

#ifndef CPU_TEST
__device__ __forceinline__ size_t opaque_gtid(int wave) { int w = wave; asm volatile("" : "+s"(w)); unsigned t = blockIdx.x * NTHREADS + w * 64 + lane_id_v(); return (size_t)t; }
#define ITEM_LOOP(total) for (size_t i = opaque_gtid(wave_id); i < (size_t)(total); i += (size_t)gridDim.x * NTHREADS)
#else
#define ITEM_LOOP(total) _Pragma("omp parallel for schedule(dynamic, 64)") for (long long i = 0; i < (long long)(total); ++i)
#endif

struct Params {
    const float *x_prompt, *x_sample, *cache_kv, *cache_win, *state_conv; const int* page_table;
    const float *ffn_a_norm, *ffn_a_w_in, *ffn_a_w_out, *mix_norm, *ffn_b_norm, *ffn_b_w_in, *ffn_b_w_out, *conv_w_in, *conv_w, *conv_w_out, *kv_norm, *w_kv, *k_norm,
                *cmp_pe, *cmp_w1, *cmp_w2, *nsa_w_qg, *nsa_q_norm, *nsa_w_o;
    float* out; unsigned char* ws;
};
constexpr int LDS_RING = 131072, LDS_BAR_OFF = LDS_RING + 352, LDS_BYTES = 147456;

#ifndef CPU_TEST
typedef const __attribute__((address_space(4))) Params* KParamsPtr;
__device__ __forceinline__ KParamsPtr kparams_ptr() {
#if defined(__HIP_DEVICE_COMPILE__)
    KParamsPtr p = (KParamsPtr)__builtin_amdgcn_kernarg_segment_ptr(); asm volatile("" : "+s"(p)); return p;
#else
    return nullptr;
#endif
}
__device__ __forceinline__ Params load_params() {
#if defined(__HIP_DEVICE_COMPILE__)
    return *kparams_ptr();
#else
    return Params{};
#endif
}
__device__ __forceinline__ unsigned char* load_ws() {
#if defined(__HIP_DEVICE_COMPILE__)
    return kparams_ptr()->ws;
#else
    return nullptr;
#endif
}
#define KP const Params P = load_params()
__device__ __forceinline__ int opaque_s(int v) { asm volatile("" : "+s"(v)); return v; }
#define GRID_SYNC() do { XcdBarrier bar_; bar_.bar = (GU*)load_ws() + 1024; bar_.x = 0; bar_.st = (volatile LAS unsigned*)(lds + LDS_BAR_OFF); xcd_barrier(bar_, wave_id == 0 && lane_id_v() == 0u); } while (0)
__global__ void __launch_bounds__(NTHREADS, 2) mega(Params P_unused)
#else
static Params g_params;
#define KP const Params& P = g_params
#define GRID_SYNC() do {} while (0)
void mega(Params P_unused)
#endif
{
#ifndef CPU_TEST
    extern __shared__ __attribute__((aligned(16))) unsigned char lds[];
    const int wave_id = __builtin_amdgcn_readfirstlane((int)(threadIdx.x >> 6));
    if (threadIdx.x < 4) ((LAS unsigned*)(lds + LDS_BAR_OFF))[threadIdx.x] = 0u;
    __syncthreads();
    (void)xcd_barrier_post((GU*)load_ws() + 1024, (volatile LAS unsigned*)(lds + LDS_BAR_OFF), threadIdx.x == 0);
#define RING ((PG8_LAS unsigned char*)lds)
#else
    g_params = P_unused;
#endif
#define WS_F(f) ((float*)(P.ws + WSM.f))
#define WS_B(f) ((bf16_t*)(P.ws + WSM.f))
#define KVSRC KvSrc{P.cache_kv, P.page_table, P.out}
#define PH(total, call) do { { KP; ITEM_LOOP(total) call; } GRID_SYNC(); } while (0)
#ifdef CPU_TEST
    for (int L = 0; L < DEPTH; ++L) {
        KP;
        ITEM_LOOP((size_t)2 * D_FF * (D_MODEL / 64)) wconv_item(i, P.ffn_a_w_in + (size_t)L * D_MODEL * 2 * D_FF, 2 * D_FF, P.ffn_a_norm + (size_t)L * D_MODEL, WS_B(w_ain) + (size_t)L * 2 * D_FF * D_MODEL, 2 * D_FF, D_MODEL, CM_PAIR, D_FF);
        ITEM_LOOP((size_t)D_MODEL * (D_FF / 64)) wconv_item(i, P.ffn_a_w_out + (size_t)L * D_FF * D_MODEL, D_MODEL, nullptr, WS_B(w_aout) + (size_t)L * D_MODEL * D_FF, D_MODEL, D_FF, CM_PLAIN, 0);
        ITEM_LOOP((size_t)2 * D_FF * (D_MODEL / 64)) wconv_item(i, P.ffn_b_w_in + (size_t)L * D_MODEL * 2 * D_FF, 2 * D_FF, P.ffn_b_norm + (size_t)L * D_MODEL, WS_B(w_bin) + (size_t)L * 2 * D_FF * D_MODEL, 2 * D_FF, D_MODEL, CM_PAIR, D_FF);
        ITEM_LOOP((size_t)D_MODEL * (D_FF / 64)) wconv_item(i, P.ffn_b_w_out + (size_t)L * D_FF * D_MODEL, D_MODEL, nullptr, WS_B(w_bout) + (size_t)L * D_MODEL * D_FF, D_MODEL, D_FF, CM_PLAIN, 0);
    }
    for (int L = 0; L < N_A; ++L) {
        KP;
        ITEM_LOOP((size_t)3 * D_MODEL * (D_MODEL / 64)) wconv_item(i, P.conv_w_in + (size_t)L * D_MODEL * 3 * D_MODEL, 3 * D_MODEL, P.mix_norm + (size_t)L * D_MODEL, WS_B(w_cin) + (size_t)L * 3 * D_MODEL * D_MODEL, 3 * D_MODEL, D_MODEL, CM_CONV, 0);
        ITEM_LOOP((size_t)D_MODEL * (D_MODEL / 64)) wconv_item(i, P.conv_w_out + (size_t)L * D_MODEL * D_MODEL, D_MODEL, nullptr, WS_B(w_cout) + (size_t)L * D_MODEL * D_MODEL, D_MODEL, D_MODEL, CM_PLAIN, 0);
    }
    for (int b = 0; b < N_B; ++b) {
        KP;
        ITEM_LOOP((size_t)QGP * (D_MODEL / 64)) wconv_item(i, P.nsa_w_qg + (size_t)b * D_MODEL * QGW, QGW, P.mix_norm + (size_t)(N_A + b) * D_MODEL, WS_B(w_qg) + (size_t)b * QGP * D_MODEL, QGP, D_MODEL, CM_HEADS, N_HEADS);
        ITEM_LOOP((size_t)D_MODEL * (HDM / 64)) wconv_item(i, P.nsa_w_o + (size_t)b * HDM * D_MODEL, D_MODEL, nullptr, WS_B(w_o) + (size_t)b * D_MODEL * HDM, D_MODEL, HDM, CM_PLAIN, 0);
    }
    { KP; ITEM_LOOP((size_t)KVW * (D_MODEL / 64)) wconv_item(i, P.w_kv, KVW, P.kv_norm, WS_B(w_kv), KVW, D_MODEL, CM_HEADS, 6 * N_KV); }
    { KP; ITEM_LOOP((size_t)NPOS * 8) rope_item(i, WS_F(rope)); }
    { KP; ITEM_LOOP(MT) hinit_item(i, P.x_prompt, P.x_sample, WS_F(h), WS_B(hb), WS_F(rss)); }
#else
#define WAVE_ITEMS(total) for (int it_ = (int)(opaque_s((int)blockIdx.x) * 8 + wave_id); it_ < (int)(total); it_ += (int)gridDim.x * 8)
#define WCONV(srcp, Nsrc_, gainp, dstp, Nd_, K_, kind_, aux_) do { KP; LAS float* scr_ = (LAS float*)(lds + wave_id * 16384); const int lane_ = (int)lane_id_v(); \
        WAVE_ITEMS(((Nd_) / 32) * ((K_) / 64)) wconv_tile(it_, srcp, Nsrc_, gainp, dstp, Nd_, K_, kind_, aux_, scr_, lane_); } while (0)
    for (int L = 0; L < DEPTH; ++L) {
        WCONV(P.ffn_a_w_in + (size_t)L * D_MODEL * 2 * D_FF, 2 * D_FF, P.ffn_a_norm + (size_t)L * D_MODEL, WS_B(w_ain) + (size_t)L * 2 * D_FF * D_MODEL, 2 * D_FF, D_MODEL, CM_PAIR, D_FF);
        WCONV(P.ffn_a_w_out + (size_t)L * D_FF * D_MODEL, D_MODEL, nullptr, WS_B(w_aout) + (size_t)L * D_MODEL * D_FF, D_MODEL, D_FF, CM_PLAIN, 0);
        WCONV(P.ffn_b_w_in + (size_t)L * D_MODEL * 2 * D_FF, 2 * D_FF, P.ffn_b_norm + (size_t)L * D_MODEL, WS_B(w_bin) + (size_t)L * 2 * D_FF * D_MODEL, 2 * D_FF, D_MODEL, CM_PAIR, D_FF);
        WCONV(P.ffn_b_w_out + (size_t)L * D_FF * D_MODEL, D_MODEL, nullptr, WS_B(w_bout) + (size_t)L * D_MODEL * D_FF, D_MODEL, D_FF, CM_PLAIN, 0);
    }
    for (int L = 0; L < N_A; ++L) {
        WCONV(P.conv_w_in + (size_t)L * D_MODEL * 3 * D_MODEL, 3 * D_MODEL, P.mix_norm + (size_t)L * D_MODEL, WS_B(w_cin) + (size_t)L * 3 * D_MODEL * D_MODEL, 3 * D_MODEL, D_MODEL, CM_CONV, 0);
        WCONV(P.conv_w_out + (size_t)L * D_MODEL * D_MODEL, D_MODEL, nullptr, WS_B(w_cout) + (size_t)L * D_MODEL * D_MODEL, D_MODEL, D_MODEL, CM_PLAIN, 0);
    }
    for (int b = 0; b < N_B; ++b) {
        WCONV(P.nsa_w_qg + (size_t)b * D_MODEL * QGW, QGW, P.mix_norm + (size_t)(N_A + b) * D_MODEL, WS_B(w_qg) + (size_t)b * QGP * D_MODEL, QGP, D_MODEL, CM_HEADS, N_HEADS);
        WCONV(P.nsa_w_o + (size_t)b * HDM * D_MODEL, D_MODEL, nullptr, WS_B(w_o) + (size_t)b * D_MODEL * HDM, D_MODEL, HDM, CM_PLAIN, 0);
    }
    WCONV(P.w_kv, KVW, P.kv_norm, WS_B(w_kv), KVW, D_MODEL, CM_HEADS, 6 * N_KV);
    { KP; ITEM_LOOP((size_t)NPOS * 8) rope_item(i, WS_F(rope)); }
    { KP; const int lane_ = (int)lane_id_v(); WAVE_ITEMS(MT) hinit_row(it_, P.x_prompt, P.x_sample, WS_F(h), WS_B(hb), WS_F(rss), lane_); }
#endif
#ifndef CPU_TEST
    for (int e = 0; e < 2; ++e) WCONV(P.cmp_w1 + (size_t)e * L_CMP * HD * CMP_HID, CMP_HID, nullptr, WS_B(w1t) + (size_t)e * CMP_HID * L_CMP * HD, CMP_HID, L_CMP * HD, CM_PLAIN, 0);
    for (int e = 0; e < 2; ++e) WCONV(P.cmp_w2 + (size_t)e * CMP_HID * HD, HD, nullptr, WS_B(w2t) + (size_t)e * HD * CMP_HID, HD, CMP_HID, CM_PLAIN, 0);
    { KP; const int lane_ = (int)lane_id_v(); static_assert(N_KV == 4 && 2 * N_KV * 8 == 64, "acmp_sample_wave lane map"); WAVE_ITEMS(DEC_BATCH * NBC_PAST) acmp_sample_wave(it_, P.cache_kv, P.page_table, P.cmp_pe, WS_B(acs), lane_); }
#endif
    GRID_SYNC();
#ifndef CPU_TEST
    { KP; pg8::Gemm g{WS_B(acs), WS_B(w1t), 2 * RS_CMP, 2 * CMP_HID, L_CMP * HD}; pg8::CmpOrder So{2 * RS_CMP / 256, RS_CMP / 256, opaque_s((int)gridDim.x), opaque_s((int)blockIdx.x)};
      pg8::EpiGelu E{WS_B(hids)}; pg8::gemm_phase<pg8::EpiGelu, pg8::CmpOrder, true, true>(wave_id, RING, g, So, E); }
    GRID_SYNC();
    { KP; const int lane_ = (int)lane_id_v(); WAVE_ITEMS(2 * RS_CMP / 32) att::cmp_out_wave(it_, WS_B(hids), RS_CMP, NBC_PAST, BATCH, WS_B(w2t), P.k_norm, WS_F(kc), WS_F(vc), nullptr, nullptr, lane_); }
    GRID_SYNC();
#endif

#ifndef CPU_TEST
#define RESID_PH(Aptr, Btptr, Kk, KSn, v_out, coef_, last_) do { \
        { KP; const int lane_ = (int)lane_id_v(); WAVE_ITEMS((MS / 32) * (D_MODEL / 32) * (KSn)) att::skinny_task(it_, (Aptr) + (size_t)MP * (Kk), Btptr, D_MODEL, Kk, KSn, WS_F(part), lane_); } \
        { KP; pg8::Gemm g{Aptr, Btptr, MP, D_MODEL, Kk}; pg8::StaticOrder So; So.init(MP, D_MODEL, opaque_s((int)gridDim.x), opaque_s((int)blockIdx.x)); \
          pg8::EpiResid E{WS_F(h), WS_B(hb), WS_F(rss) + (size_t)(v_out) * MT, (last_) ? P.out + O_YP : nullptr, coef_}; pg8::gemm_phase<pg8::EpiResid, pg8::StaticOrder, true, true>(wave_id, RING, g, So, E); } \
        GRID_SYNC(); \
        { KP; const int lane_ = (int)lane_id_v(); WAVE_ITEMS(MS) att::resid_reduce_row(it_, WS_F(part), KSn, coef_, WS_F(h), WS_B(hb), WS_F(rss) + (size_t)(v_out) * MT, (last_) ? P.out + O_YP : nullptr, lane_); } \
        GRID_SYNC(); } while (0)
#define FFN_OPT(wi, wo, v_in, last) do { \
        { KP; pg8::Gemm g{WS_B(hb), WS_B(wi) + (size_t)layer * 2 * D_FF * D_MODEL, MT, 2 * D_FF, D_MODEL}; pg8::StaticOrder So; So.init(MT, 2 * D_FF, opaque_s((int)gridDim.x), opaque_s((int)blockIdx.x)); \
          pg8::EpiSwiglu E{WS_B(act), WS_F(rss) + (size_t)(v_in) * MT}; pg8::gemm_phase<pg8::EpiSwiglu, pg8::StaticOrder, true, true>(wave_id, RING, g, So, E); } \
        GRID_SYNC(); \
        RESID_PH(WS_B(act), WS_B(wo) + (size_t)layer * D_MODEL * D_FF, D_FF, 8, (v_in) + 1, 0.5f, last); } while (0)
#else
#define FFN_OPT(wi, wo, v_in, last) do { KP; \
        ITEM_LOOP((size_t)MT * D_FF) ref_ffn_in_item(i, WS_B(hb), WS_F(rss) + (size_t)(v_in) * MT, WS_B(wi) + (size_t)layer * 2 * D_FF * D_MODEL, WS_B(act)); \
        ITEM_LOOP(MT) ref_resid_row_item(i, WS_B(act), D_FF, WS_B(wo) + (size_t)layer * D_MODEL * D_FF, 0.5f, WS_F(h), WS_B(hb), WS_F(rss) + (size_t)((v_in) + 1) * MT, (last) ? P.out + O_YP : nullptr); } while (0)
#endif
#ifndef CPU_TEST
#define GEMM_PH(EpiT, Aptr, Btptr, Nn, Kk, ...) do { { KP; pg8::Gemm g{Aptr, Btptr, MT, Nn, Kk}; pg8::StaticOrder So; So.init(MT, Nn, opaque_s((int)gridDim.x), opaque_s((int)blockIdx.x)); \
        pg8::EpiT E{__VA_ARGS__}; pg8::gemm_phase<pg8::EpiT, pg8::StaticOrder, true, true>(wave_id, RING, g, So, E); } GRID_SYNC(); } while (0)
#endif
    for (int layer = 0; layer < DEPTH; ++layer) {
        FFN_OPT(w_ain, w_aout, 3 * layer, false);
        const int v1 = 3 * layer + 1;
        if (layer < N_A) {
#ifndef CPU_TEST
            { KP; const int lane_ = (int)lane_id_v(); WAVE_ITEMS((MS / 32) * (3 * D_MODEL / 32) * 2) att::skinny_task(it_, WS_B(hb) + (size_t)MP * D_MODEL, WS_B(w_cin) + (size_t)layer * 3 * D_MODEL * D_MODEL, 3 * D_MODEL, D_MODEL, 2, WS_F(part), lane_); }
            { KP; pg8::Gemm g{WS_B(hb), WS_B(w_cin) + (size_t)layer * 3 * D_MODEL * D_MODEL, MP, 3 * D_MODEL, D_MODEL}; pg8::StaticOrder So; So.init(MP, 3 * D_MODEL, opaque_s((int)gridDim.x), opaque_s((int)blockIdx.x));
              pg8::EpiConvIn E{WS_B(ub), WS_B(bb), WS_F(rss) + (size_t)v1 * MT, P.out, layer}; pg8::gemm_phase<pg8::EpiConvIn, pg8::StaticOrder, true, true>(wave_id, RING, g, So, E); }
            GRID_SYNC();
#else
            PH((size_t)MT * D_MODEL, ref_conv_in_item(i, WS_B(hb), WS_F(rss) + (size_t)v1 * MT, WS_B(w_cin) + (size_t)layer * 3 * D_MODEL * D_MODEL, WS_B(ub), WS_B(bb), P.out, layer));
#endif
#ifndef CPU_TEST
            { KP; ITEM_LOOP((size_t)MS * (D_MODEL / 8)) conv_thin_sample_item(i, WS_F(part), 2, WS_F(rss) + (size_t)v1 * MT, P.state_conv + (size_t)layer * DEC_BATCH * 2 * D_MODEL, P.conv_w + (size_t)layer * 3 * D_MODEL, WS_B(zb), P.out, layer); }
            PH((size_t)MP * (D_MODEL / 8), conv_thin_vec_item(i, WS_B(ub), WS_B(bb), P.state_conv + (size_t)layer * DEC_BATCH * 2 * D_MODEL, P.conv_w + (size_t)layer * 3 * D_MODEL, WS_B(zb)));
#else
            PH((size_t)MT * D_MODEL, conv_thin_item(i, WS_B(ub), WS_B(bb), P.state_conv + (size_t)layer * DEC_BATCH * 2 * D_MODEL, P.conv_w + (size_t)layer * 3 * D_MODEL, WS_B(zb)));
#endif
#ifndef CPU_TEST
            RESID_PH(WS_B(zb), WS_B(w_cout) + (size_t)layer * D_MODEL * D_MODEL, D_MODEL, 8, v1 + 1, 1.0f, false);
#else
            PH(MT, ref_resid_row_item(i, WS_B(zb), D_MODEL, WS_B(w_cout) + (size_t)layer * D_MODEL * D_MODEL, 1.0f, WS_F(h), WS_B(hb), WS_F(rss) + (size_t)(v1 + 1) * MT, nullptr));
#endif
        } else {
            const int b = layer - N_A;
#ifndef CPU_TEST
            GEMM_PH(EpiQG, WS_B(hb), WS_B(w_qg) + (size_t)b * QGP * D_MODEL, QGP, D_MODEL, WS_B(qnb), WS_B(qrb), WS_F(gates), WS_F(rss) + (size_t)v1 * MT, P.nsa_q_norm + (size_t)b * HD, WS_F(rope));
#else
            { KP; ITEM_LOOP((size_t)MT * N_HEADS) ref_qg_item(i, WS_B(hb), WS_F(rss) + (size_t)v1 * MT, WS_B(w_qg) + (size_t)b * QGP * D_MODEL, P.nsa_q_norm + (size_t)b * HD, WS_F(rope), WS_F(qn), WS_F(qr)); }
            PH((size_t)MT * 3 * N_HEADS, ref_gates_item(i, WS_B(hb), WS_F(rss) + (size_t)v1 * MT, WS_B(w_qg) + (size_t)b * QGP * D_MODEL, WS_F(gates)));
#endif
#ifndef CPU_TEST
            { KP; att::Tensors T{WS_B(qnb), WS_B(qrb), P.ws + WSM.ksel, P.ws + WSM.vsel, P.ws + WSM.kwin, P.ws + WSM.vwin, P.ws + WSM.kci, P.ws + WSM.vci, WS_F(gates), WS_B(ob)};
              int wv = wave_id; asm volatile("" : "+s"(wv));
              att::phase(T, (att::ldsp)lds, wv, (int)lane_id_v(), opaque_s((int)blockIdx.x), opaque_s((int)gridDim.x)); }
            { KP; att::STensors T{WS_B(qnb), WS_B(qrb), WS_F(kc), WS_F(vc), P.cache_kv, P.page_table, P.cache_win, P.out, WS_F(winrows), WS_F(gates), WS_B(ob)};
              int wv = wave_id; asm volatile("" : "+s"(wv));
              att::sample_phase(T, (att::ldsp)lds, wv, (int)lane_id_v(), opaque_s((int)blockIdx.x), opaque_s((int)gridDim.x)); }
            GRID_SYNC();
#else
            PH((size_t)MT * N_HEADS, attn_cmp_item(i, WS_F(qn), WS_F(kc), WS_F(vc), WS_F(pbuf), WS_F(oc)));
            PH((size_t)MT * N_KV, topk_item(i, WS_F(pbuf), (int*)WS_F(sel), WS_F(scorebuf)));
            PH((size_t)MT * N_HEADS, attn_sel_item(i, KVSRC, WS_F(qr), (const int*)WS_F(sel), WS_F(os)));
            PH((size_t)MT * N_HEADS, attn_win_item(i, P.cache_win, WS_F(winrows), WS_F(qr), WS_F(gates), WS_F(oc), WS_F(os), WS_B(ob)));
#endif
#ifndef CPU_TEST
            RESID_PH(WS_B(ob), WS_B(w_o) + (size_t)b * D_MODEL * HDM, HDM, 8, v1 + 1, 1.0f, false);
#else
            PH(MT, ref_resid_row_item(i, WS_B(ob), HDM, WS_B(w_o) + (size_t)b * D_MODEL * HDM, 1.0f, WS_F(h), WS_B(hb), WS_F(rss) + (size_t)(v1 + 1) * MT, nullptr));
#endif
        }
        FFN_OPT(w_bin, w_bout, 3 * layer + 2, layer == DEPTH - 1);
        if (layer == N_A - 1) {
            const int v3 = 3 * layer + 3;
#ifndef CPU_TEST
            { KP; pg8::Gemm g{WS_B(hb), WS_B(w_kv), MT, KVW, D_MODEL}; pg8::StaticOrder So; So.init(MT, KVW, opaque_s((int)gridDim.x), opaque_s((int)blockIdx.x));
              pg8::EpiKV E{P.out, WS_F(winrows), WS_F(rss) + (size_t)v3 * MT, P.k_norm, WS_F(rope), P.ws + WSM.ksel, P.ws + WSM.vsel, P.ws + WSM.kwin, P.ws + WSM.vwin, WS_B(acp), P.cmp_pe}; pg8::gemm_phase<pg8::EpiKV, pg8::StaticOrder, true, true>(wave_id, RING, g, So, E); }
#else
            { KP; ITEM_LOOP((size_t)MT * 6 * N_KV) ref_kv_item(i, WS_B(hb), WS_F(rss) + (size_t)v3 * MT, WS_B(w_kv), P.k_norm, WS_F(rope), P.out, WS_F(winrows)); }
#endif
            PH((size_t)DEC_BATCH * (WINDOW - DEC_SEQ) * 2 * N_KV * HD, wincopy_item(i, P.cache_win, P.out));
#ifdef CPU_TEST
            PH((size_t)NSEQ * NBC_MAX * 2 * N_KV * CMP_HID, cmp_hid_item(i, KVSRC, P.cmp_pe, P.cmp_w1, WS_F(hid)));
            PH((size_t)NSEQ * NBC_MAX * 2 * N_KV, cmp_out_item(i, WS_F(hid), P.cmp_w2, P.k_norm, WS_F(kc), WS_F(vc)));
#else
            { KP; pg8::Gemm g{WS_B(acp), WS_B(w1t), 2 * RP_CMP, 2 * CMP_HID, L_CMP * HD}; pg8::CmpOrder So{2 * RP_CMP / 256, RP_CMP / 256, opaque_s((int)gridDim.x), opaque_s((int)blockIdx.x)};
              pg8::EpiGelu E{WS_B(hidp)}; pg8::gemm_phase<pg8::EpiGelu, pg8::CmpOrder, true, true>(wave_id, RING, g, So, E); }
            GRID_SYNC();
            { KP; const int lane_ = (int)lane_id_v(); WAVE_ITEMS(2 * RP_CMP / 32) att::cmp_out_wave(it_, WS_B(hidp), RP_CMP, NBC_P, 0, WS_B(w2t), P.k_norm, WS_F(kc), WS_F(vc), P.ws + WSM.kci, P.ws + WSM.vci, lane_); }
            GRID_SYNC();
#endif
        }
    }
}

extern "C" void kernel_launch(void* const* d_in, const int* in_sizes, int n_in, void* d_out, int out_size, void* d_ws, size_t ws_size, hipStream_t stream) {
    Params P{};
    P.x_prompt = (const float*)d_in[0]; P.x_sample = (const float*)d_in[1]; P.cache_kv = (const float*)d_in[2]; P.cache_win = (const float*)d_in[3];
    P.state_conv = (const float*)d_in[4]; P.page_table = (const int*)d_in[5]; P.ffn_a_norm = (const float*)d_in[6]; P.ffn_a_w_in = (const float*)d_in[7];
    P.ffn_a_w_out = (const float*)d_in[8]; P.mix_norm = (const float*)d_in[9]; P.ffn_b_norm = (const float*)d_in[10]; P.ffn_b_w_in = (const float*)d_in[11];
    P.ffn_b_w_out = (const float*)d_in[12]; P.conv_w_in = (const float*)d_in[13]; P.conv_w = (const float*)d_in[14]; P.conv_w_out = (const float*)d_in[15];
    P.kv_norm = (const float*)d_in[16]; P.w_kv = (const float*)d_in[17]; P.k_norm = (const float*)d_in[18]; P.cmp_pe = (const float*)d_in[19];
    P.cmp_w1 = (const float*)d_in[20]; P.cmp_w2 = (const float*)d_in[21]; P.nsa_w_qg = (const float*)d_in[22]; P.nsa_q_norm = (const float*)d_in[23];
    P.nsa_w_o = (const float*)d_in[24];
    P.out = (float*)d_out; P.ws = (unsigned char*)d_ws;
#ifndef CPU_TEST
    static int grid = 0;
    if (grid == 0) {
        int dev = 0, cus = 0, per_cu = 0;
        hipGetDevice(&dev); hipDeviceGetAttribute(&cus, hipDeviceAttributeMultiprocessorCount, dev);
        hipFuncSetAttribute((const void*)mega, hipFuncAttributeMaxDynamicSharedMemorySize, LDS_BYTES);
        hipOccupancyMaxActiveBlocksPerMultiprocessor(&per_cu, (const void*)mega, NTHREADS, LDS_BYTES);
        (void)hipGetLastError();
        grid = cus;
    }
    hipMemsetAsync(d_ws, 0, WS_ZERO_BYTES, stream);
    hipLaunchKernelGGL(mega, dim3(grid), dim3(NTHREADS), LDS_BYTES, stream, P);
#else
    memset(d_ws, 0, WS_ZERO_BYTES);
    mega(P);
#endif
}
```

```cpp
#ifdef CPU_TEST
#include "shim.h"
#else
#include <hip/hip_runtime.h>
#endif
#include <cstdint>
#include <cstddef>
#include <cmath>
#include <cstring>
typedef unsigned short bf16_t;
#ifndef CPU_TEST
#define HOSTDEV __host__ __device__
#else
#define HOSTDEV
#endif
HOSTDEV inline bf16_t f2bf(float f) { unsigned u; memcpy(&u, &f, 4); u = (u + 0x7fffu + ((u >> 16) & 1u)) >> 16; return (bf16_t)u; }
HOSTDEV inline float bf2f(bf16_t b) { unsigned u = (unsigned)b << 16; float f; memcpy(&f, &u, 4); return f; }

#ifdef CFG_SMALL
constexpr int D_MODEL = 256, BATCH = 1, SEQ = 2048, DEPTH = 4, DEC_BATCH = 2, DEC_SEQ = 8, PAST_LEN = 2048, PAGE_SIZE = 128, D_FF = 256, N_HEADS = 4, N_KV = 2;
#else
constexpr int D_MODEL = 1024, BATCH = 4, SEQ = 4096, DEPTH = 4, DEC_BATCH = 32, DEC_SEQ = 8, PAST_LEN = 8192, PAGE_SIZE = 128, D_FF = 2816, N_HEADS = 16, N_KV = 4;
#endif
constexpr int N_A = DEPTH / 2, N_B = DEPTH - N_A, HD = 64, HPG = N_HEADS / N_KV, L_CMP = 32, L_SEL = 64, N_SEL = 16, WINDOW = 512, CMP_HID = 4 * HD;
constexpr int MP = BATCH * SEQ, MS = DEC_BATCH * DEC_SEQ, MT = MP + MS, NSEQ = BATCH + DEC_BATCH;
constexpr int N_PAGES = PAST_LEN / PAGE_SIZE;
constexpr int KVW = 6 * N_KV * HD;
constexpr int QGW = N_HEADS * HD + 3 * N_HEADS;
constexpr int HDM = N_HEADS * HD;
constexpr int TPAD_S = ((PAST_LEN + DEC_SEQ + L_SEL - 1) / L_SEL) * L_SEL;
constexpr int NBC_P = SEQ / L_CMP, NBC_S = TPAD_S / L_CMP, NBC_MAX = NBC_S > NBC_P ? NBC_S : NBC_P;
constexpr int NBS_P = SEQ / L_SEL, NBS_S = TPAD_S / L_SEL, NBS_MAX = NBS_S > NBS_P ? NBS_S : NBS_P;
constexpr float EPS = 1e-6f, NEGF = -1e30f, TINYF = 1e-30f, FORCE_SCORE = 1e4f;
__device__ static const float INV_FREQ[8] = {1.0f, 0.1939227432012558f, 0.03760603070259094f, 0.007292664609849453f, 0.0014142135623842478f, 0.00027424818836152554f, 5.3182957344688475e-05f, 1.0313385246263351e-05f};

constexpr size_t O_YP = 0, O_YS = O_YP + (size_t)MP * D_MODEL, O_KVP = O_YS + (size_t)MS * D_MODEL, O_KVS = O_KVP + (size_t)MP * 4 * N_KV * HD,
                 O_WP = O_KVS + (size_t)MS * 4 * N_KV * HD, O_WS = O_WP + (size_t)BATCH * WINDOW * 2 * N_KV * HD, O_CP = O_WS + (size_t)DEC_BATCH * WINDOW * 2 * N_KV * HD,
                 O_CS = O_CP + (size_t)N_A * BATCH * 2 * D_MODEL, O_END = O_CS + (size_t)N_A * DEC_BATCH * 2 * D_MODEL;

struct RowInfo { int seq, t, pos; };
__device__ __host__ inline RowInfo row_info(int m) {
    RowInfo r;
    if (m < MP) { r.seq = m / SEQ; r.t = m % SEQ; r.pos = r.t; }
    else { const int q = m - MP; r.seq = BATCH + q / DEC_SEQ; r.t = q % DEC_SEQ; r.pos = PAST_LEN + r.t; }
    return r;
}
__device__ __host__ inline int seq_row0(int seq) { return seq < BATCH ? seq * SEQ : MP + (seq - BATCH) * DEC_SEQ; }
__device__ __host__ inline int seq_pos0(int seq) { return seq < BATCH ? 0 : PAST_LEN; }
__device__ __host__ inline int seq_len(int seq) { return seq < BATCH ? SEQ : DEC_SEQ; }

__device__ inline void copy_item(size_t i_, const float* a, float* b, size_t n) {
    const size_t i = i_;
    if (i < n) b[i] = a[i];
}
__device__ inline void rmsnorm_item(size_t i_, const float* x, const float* g, float* y, int rows, int d) {
    const int m = (int)i_;
    if (m >= rows) return;
    const float* xr = x + (size_t)m * d; float s = 0.f;
    for (int i = 0; i < d; ++i) s += xr[i] * xr[i];
    const float r = 1.0f / sqrtf(s / d + EPS);
    float* yr = y + (size_t)m * d;
    for (int i = 0; i < d; ++i) yr[i] = xr[i] * r * g[i];
}
__device__ inline void gemm_item(size_t i_, const float* A, int lda, const float* W, float* C, int M, int N, int K) {
    const int nbx = (N + 63) / 64; const int vb = (int)(i_ / 256), t_ = (int)(i_ % 256), tx = t_ % 16, ty = t_ / 16;
    const int c0 = (vb % nbx) * 64 + tx * 4, r0 = (vb / nbx) * 64 + ty * 4;
    if (c0 >= N || r0 >= M) return;
    float acc[4][4];
    for (int i = 0; i < 4; ++i) for (int j = 0; j < 4; ++j) acc[i][j] = 0.f;
    const int nr = (M - r0) < 4 ? (M - r0) : 4;
    for (int k = 0; k < K; k += 4) {
        float a[4][4], w[4][4];
        for (int i = 0; i < 4; ++i) for (int kk = 0; kk < 4; ++kk) a[i][kk] = (i < nr) ? A[(size_t)(r0 + i) * lda + k + kk] : 0.f;
        for (int kk = 0; kk < 4; ++kk) for (int j = 0; j < 4; ++j) w[kk][j] = W[(size_t)(k + kk) * N + c0 + j];
        for (int i = 0; i < 4; ++i) for (int kk = 0; kk < 4; ++kk) for (int j = 0; j < 4; ++j) acc[i][j] += a[i][kk] * w[kk][j];
    }
    for (int i = 0; i < nr; ++i) for (int j = 0; j < 4; ++j) C[(size_t)(r0 + i) * N + c0 + j] = acc[i][j];
}
__device__ inline void swiglu_item(size_t i_, const float* t1, float* act, int rows, int dff) {
    const size_t i = i_;
    if (i >= (size_t)rows * dff) return;
    const int m = (int)(i / dff), j = (int)(i % dff);
    const float g = t1[(size_t)m * 2 * dff + j], u = t1[(size_t)m * 2 * dff + dff + j];
    act[i] = g / (1.0f + expf(-g)) * u;
}
__device__ inline void axpy_item(size_t i_, float* h, const float* y, float coef, size_t n) {
    const size_t i = i_;
    if (i < n) h[i] += coef * y[i];
}
__device__ inline void conv_item(size_t i_, const float* t1, const float* state  , const float* wc  , float* z, float* out, int layer) {
    const size_t i = i_;
    if (i >= (size_t)MT * D_MODEL) return;
    const int m = (int)(i / D_MODEL), ch = (int)(i % D_MODEL);
    const RowInfo ri = row_info(m);
    const float* r = t1 + (size_t)m * 3 * D_MODEL;
    const float b = r[ch], u0 = r[D_MODEL + ch] * r[2 * D_MODEL + ch];
    float u1, u2;
    if (ri.t >= 1) { const float* p = r - 3 * D_MODEL; u1 = p[D_MODEL + ch] * p[2 * D_MODEL + ch]; }
    else u1 = (ri.seq < BATCH) ? 0.f : state[((size_t)(ri.seq - BATCH) * 2 + 1) * D_MODEL + ch];
    if (ri.t >= 2) { const float* p = r - 6 * D_MODEL; u2 = p[D_MODEL + ch] * p[2 * D_MODEL + ch]; }
    else if (ri.seq < BATCH) u2 = 0.f;
    else u2 = (ri.t == 1) ? state[((size_t)(ri.seq - BATCH) * 2 + 1) * D_MODEL + ch] : state[((size_t)(ri.seq - BATCH) * 2 + 0) * D_MODEL + ch];
    z[i] = b * (wc[ch] * u2 + wc[D_MODEL + ch] * u1 + wc[2 * D_MODEL + ch] * u0);
    const int L = seq_len(ri.seq);
    if (ri.t >= L - 2) {
        const int j = ri.t - (L - 2);
        if (ri.seq < BATCH) out[O_CP + (((size_t)layer * BATCH + ri.seq) * 2 + j) * D_MODEL + ch] = u0;
        else out[O_CS + (((size_t)layer * DEC_BATCH + (ri.seq - BATCH)) * 2 + j) * D_MODEL + ch] = u0;
    }
}
__device__ inline void head_norm(float* v, const float* g) {
    float s = 0.f; for (int d = 0; d < HD; ++d) s += v[d] * v[d];
    const float r = 1.0f / sqrtf(s / HD + EPS);
    for (int d = 0; d < HD; ++d) v[d] = v[d] * r * g[d];
}
__device__ inline void rope_cs(float ang, float& c, float& s) {
    const double r = (double)ang * 0.15915494309189535; const float fr = (float)(r - rint(r));
#ifdef CPU_TEST
    c = (float)cos(6.283185307179586 * (double)fr); s = (float)sin(6.283185307179586 * (double)fr);
#else
    c = __builtin_amdgcn_cosf(fr); s = __builtin_amdgcn_sinf(fr);
#endif
}
__device__ inline void head_rope(float* v, int pos) {
    for (int i = 0; i < 8; ++i) {
        const float ang = (float)pos * INV_FREQ[i]; float c, s; rope_cs(ang, c, s);
        const float x1 = v[i], x2 = v[8 + i];
        v[i] = x1 * c - x2 * s; v[8 + i] = x2 * c + x1 * s;
    }
}
__device__ inline void kvprep_item(size_t i_, const float* p, const float* k_norm  , float* out, float* winrows) {
    const int i = (int)i_;
    if (i >= MT * 6 * N_KV) return;
    const int m = i / (6 * N_KV), e = (i / N_KV) % 6, g = i % N_KV;
    const RowInfo ri = row_info(m);
    float v[HD];
    for (int d = 0; d < HD; ++d) v[d] = p[(size_t)m * KVW + (e * N_KV + g) * HD + d];
    if (e == 2) { head_norm(v, k_norm + HD); head_rope(v, ri.pos); }
    if (e == 4) { head_norm(v, k_norm + 2 * HD); head_rope(v, ri.pos); }
    if (e < 4) {
        float* o = (ri.seq < BATCH) ? out + O_KVP + (((size_t)m * 4 + e) * N_KV + g) * HD : out + O_KVS + (((size_t)(m - MP) * 4 + e) * N_KV + g) * HD;
        for (int d = 0; d < HD; ++d) o[d] = v[d];
    } else {
        const int we = e - 4;
        float* w = winrows + (((size_t)m * 2 + we) * N_KV + g) * HD;
        for (int d = 0; d < HD; ++d) w[d] = v[d];
        if (ri.seq < BATCH) { if (ri.t >= SEQ - WINDOW) { float* o = out + O_WP + ((((size_t)ri.seq * WINDOW + (ri.t - (SEQ - WINDOW))) * 2 + we) * N_KV + g) * HD; for (int d = 0; d < HD; ++d) o[d] = v[d]; } }
        else { float* o = out + O_WS + ((((size_t)(ri.seq - BATCH) * WINDOW + (WINDOW - DEC_SEQ + ri.t)) * 2 + we) * N_KV + g) * HD; for (int d = 0; d < HD; ++d) o[d] = v[d]; }
    }
}
__device__ inline void wincopy_item(size_t i_, const float* cache_win, float* out) {
    const size_t i = i_;
    const size_t per = (size_t)(WINDOW - DEC_SEQ) * 2 * N_KV * HD;
    if (i >= (size_t)DEC_BATCH * per) return;
    const size_t b = i / per, r = i % per;
    out[O_WS + b * WINDOW * 2 * N_KV * HD + r] = cache_win[b * WINDOW * 2 * N_KV * HD + (size_t)DEC_SEQ * 2 * N_KV * HD + r];
}
struct KvSrc { const float* cache_kv; const int* page_table; const float* out; };
__device__ inline const float* kv_full_ptr(const KvSrc& S, int seq, int tok, int e, int g) {
    if (seq < BATCH) return S.out + O_KVP + ((((size_t)seq * SEQ + tok) * 4 + e) * N_KV + g) * HD;
    const int b = seq - BATCH;
    if (tok < PAST_LEN) { const int page = S.page_table[b * N_PAGES + tok / PAGE_SIZE]; return S.cache_kv + ((((size_t)page * PAGE_SIZE + tok % PAGE_SIZE) * 4 + e) * N_KV + g) * HD; }
    if (tok < PAST_LEN + DEC_SEQ) return S.out + O_KVS + ((((size_t)b * DEC_SEQ + (tok - PAST_LEN)) * 4 + e) * N_KV + g) * HD;
    return nullptr;
}
__device__ inline int seq_nbc(int seq) { return seq < BATCH ? NBC_P : NBC_S; }
__device__ inline void cmp_hid_item(size_t i_, KvSrc S, const float* pe  , const float* w1  , float* hid) {
    const size_t i = i_;
    if (i >= (size_t)NSEQ * NBC_MAX * 2 * N_KV * CMP_HID) return;
    const int f = (int)(i % CMP_HID), g = (int)((i / CMP_HID) % N_KV), e = (int)((i / ((size_t)CMP_HID * N_KV)) % 2), c = (int)((i / ((size_t)CMP_HID * N_KV * 2)) % NBC_MAX), seq = (int)(i / ((size_t)CMP_HID * N_KV * 2 * NBC_MAX));
    if (c >= seq_nbc(seq)) return;
    float s = 0.f;
    for (int l = 0; l < L_CMP; ++l) {
        const float* r = kv_full_ptr(S, seq, c * L_CMP + l, e, g);
        const float* w = w1 + (((size_t)e * L_CMP + l) * HD) * CMP_HID + f; const float* pp = pe + ((size_t)e * L_CMP + l) * HD;
        for (int d = 0; d < HD; ++d) s += ((r ? r[d] : 0.f) + pp[d]) * w[(size_t)d * CMP_HID];
    }
    const float x = s; const float t = tanhf(0.7978845608028654f * (x + 0.044715f * x * x * x));
    hid[i] = 0.5f * x * (1.0f + t);
}
__device__ inline void cmp_out_item(size_t i_, const float* hid, const float* w2  , const float* k_norm0, float* kc, float* vc) {
    const int i = (int)i_;
    if (i >= NSEQ * NBC_MAX * 2 * N_KV) return;
    const int g = i % N_KV, e = (i / N_KV) % 2, c = (i / (2 * N_KV)) % NBC_MAX, seq = i / (2 * N_KV * NBC_MAX);
    if (c >= seq_nbc(seq)) return;
    const float* hr = hid + (size_t)i * CMP_HID;
    float v[HD];
    for (int d = 0; d < HD; ++d) { float s = 0.f; for (int f = 0; f < CMP_HID; ++f) s += hr[f] * w2[((size_t)e * CMP_HID + f) * HD + d]; v[d] = s; }
    if (e == 0) head_norm(v, k_norm0);
    float* o = (e == 0 ? kc : vc) + (((size_t)seq * NBC_MAX + c) * N_KV + g) * HD;
    for (int d = 0; d < HD; ++d) o[d] = v[d];
}
__device__ inline void qprep_item(size_t i_, const float* qg, const float* q_norm, float* qn, float* qr, float* gates) {
    const int i = (int)i_;
    if (i >= MT * N_HEADS) return;
    const int m = i / N_HEADS, hh = i % N_HEADS;
    const RowInfo ri = row_info(m);
    float v[HD];
    for (int d = 0; d < HD; ++d) v[d] = qg[(size_t)m * QGW + hh * HD + d];
    head_norm(v, q_norm);
    for (int d = 0; d < HD; ++d) qn[(size_t)m * HDM + hh * HD + d] = v[d];
    head_rope(v, ri.pos);
    for (int d = 0; d < HD; ++d) qr[(size_t)m * HDM + hh * HD + d] = v[d];
    for (int j = 0; j < 3; ++j) { const float x = qg[(size_t)m * QGW + HDM + hh * 3 + j]; gates[(size_t)m * 3 * N_HEADS + hh * 3 + j] = 1.0f / (1.0f + expf(-x)); }
}
__device__ inline void attn_cmp_item(size_t i_, const float* qn, const float* kc, const float* vc, float* pbuf, float* oc) {
    const int i = (int)i_;
    if (i >= MT * N_HEADS) return;
    const int m = i / N_HEADS, hh = i % N_HEADS, g = hh / HPG;
    const RowInfo ri = row_info(m);
    const int nbc = seq_nbc(ri.seq);
    const float* q = qn + (size_t)m * HDM + hh * HD;
    float* p = pbuf + (size_t)i * NBC_MAX;
    float mx = NEGF;
    for (int c = 0; c < nbc; ++c) {
        const bool vis = (c + 1) * L_CMP - 1 <= ri.pos;
        float s = 0.f; const float* k = kc + (((size_t)ri.seq * NBC_MAX + c) * N_KV + g) * HD;
        for (int d = 0; d < HD; ++d) s += q[d] * k[d];
        s *= 0.125f; p[c] = s; if (vis && s > mx) mx = s;
    }
    float sum = 0.f;
    for (int c = 0; c < nbc; ++c) { const bool vis = (c + 1) * L_CMP - 1 <= ri.pos; const float e = vis ? expf(p[c] - mx) : 0.f; p[c] = e; sum += e; }
    const float inv = 1.0f / fmaxf(sum, TINYF);
    float o[HD]; for (int d = 0; d < HD; ++d) o[d] = 0.f;
    for (int c = 0; c < nbc; ++c) { p[c] *= inv; if (p[c] != 0.f) { const float* v = vc + (((size_t)ri.seq * NBC_MAX + c) * N_KV + g) * HD; for (int d = 0; d < HD; ++d) o[d] += p[c] * v[d]; } }
    for (int d = 0; d < HD; ++d) oc[(size_t)m * HDM + hh * HD + d] = o[d];
}
__device__ inline void topk_item(size_t i_, const float* pbuf, int* sel, float* scorebuf  ) {
    const int i = (int)i_;
    if (i >= MT * N_KV) return;
    const int m = i / N_KV, g = i % N_KV;
    const RowInfo ri = row_info(m);
    const int nbs = ri.seq < BATCH ? NBS_P : NBS_S, cur = ri.pos / L_SEL;
    float* score = scorebuf + (size_t)i * NBS_MAX;
    for (int b = 0; b < nbs; ++b) {
        float imp = 0.f;
        for (int h = 0; h < HPG; ++h) { const float* p = pbuf + ((size_t)m * N_HEADS + g * HPG + h) * NBC_MAX; imp += p[2 * b]; }
        float imp2 = 0.f;
        for (int h = 0; h < HPG; ++h) { const float* p = pbuf + ((size_t)m * N_HEADS + g * HPG + h) * NBC_MAX; imp2 += p[2 * b + 1]; }
        const bool forced = (b == 0) || (b == cur) || (b == cur - 1), valid = b * L_SEL <= ri.pos;
        score[b] = valid ? (forced ? FORCE_SCORE : imp + imp2) : NEGF;
    }
    const int nsel = N_SEL < nbs ? N_SEL : nbs;
    for (int j = 0; j < N_SEL; ++j) {
        if (j >= nsel) { sel[(size_t)i * N_SEL + j] = -1; continue; }
        int best = -1; float bv = 0.f;
        for (int b = 0; b < nbs; ++b) if (score[b] > -3e38f && (best < 0 || score[b] > bv)) { best = b; bv = score[b]; }
        sel[(size_t)i * N_SEL + j] = best; score[best] = -3.4e38f;
    }
}
__device__ inline void attn_sel_item(size_t i_, KvSrc S, const float* qr, const int* sel, float* os) {
    const int i = (int)i_;
    if (i >= MT * N_HEADS) return;
    const int m = i / N_HEADS, hh = i % N_HEADS, g = hh / HPG;
    const RowInfo ri = row_info(m);
    const float* q = qr + (size_t)m * HDM + hh * HD;
    const int* sl = sel + ((size_t)m * N_KV + g) * N_SEL;
    float mx = NEGF;
    for (int j = 0; j < N_SEL; ++j) { const int b = sl[j]; if (b < 0) continue;
        for (int t = 0; t < L_SEL; ++t) { const int tok = b * L_SEL + t; if (tok > ri.pos) continue;
            const float* k = kv_full_ptr(S, ri.seq, tok, 2, g); float s = 0.f; if (k) for (int d = 0; d < HD; ++d) s += q[d] * k[d];
            s *= 0.125f; if (s > mx) mx = s; } }
    float sum = 0.f, o[HD]; for (int d = 0; d < HD; ++d) o[d] = 0.f;
    for (int j = 0; j < N_SEL; ++j) { const int b = sl[j]; if (b < 0) continue;
        for (int t = 0; t < L_SEL; ++t) { const int tok = b * L_SEL + t; if (tok > ri.pos) continue;
            const float* k = kv_full_ptr(S, ri.seq, tok, 2, g); float s = 0.f; if (k) for (int d = 0; d < HD; ++d) s += q[d] * k[d];
            const float e = expf(s * 0.125f - mx); sum += e;
            const float* v = kv_full_ptr(S, ri.seq, tok, 3, g); if (v) for (int d = 0; d < HD; ++d) o[d] += e * v[d]; } }
    const float inv = 1.0f / fmaxf(sum, TINYF);
    for (int d = 0; d < HD; ++d) os[(size_t)m * HDM + hh * HD + d] = o[d] * inv;
}
__device__ inline const float* win_ptr(const float* cache_win, const float* winrows, int seq, int kp) {
    if (seq < BATCH) return kp >= 0 ? winrows + (size_t)(seq * SEQ + kp) * 2 * N_KV * HD : nullptr;
    const int b = seq - BATCH;
    if (kp >= PAST_LEN) return winrows + (size_t)(MP + b * DEC_SEQ + (kp - PAST_LEN)) * 2 * N_KV * HD;
    const int j = kp - (PAST_LEN - WINDOW);
    return j >= 0 ? cache_win + ((size_t)b * WINDOW + j) * 2 * N_KV * HD : nullptr;
}
__device__ inline void attn_win_item(size_t i_, const float* cache_win, const float* winrows, const float* qr, const float* gates, const float* oc, const float* os, bf16_t* o_out) {
    const int i = (int)i_;
    if (i >= MT * N_HEADS) return;
    const int m = i / N_HEADS, hh = i % N_HEADS, g = hh / HPG;
    const RowInfo ri = row_info(m);
    const float* q = qr + (size_t)m * HDM + hh * HD;
    float mx = NEGF;
    for (int kp = ri.pos - WINDOW; kp <= ri.pos; ++kp) { const float* r = win_ptr(cache_win, winrows, ri.seq, kp); if (!r) continue;
        const float* k = r + (0 * N_KV + g) * HD; float s = 0.f; for (int d = 0; d < HD; ++d) s += q[d] * k[d]; s *= 0.125f; if (s > mx) mx = s; }
    float sum = 0.f, o[HD]; for (int d = 0; d < HD; ++d) o[d] = 0.f;
    for (int kp = ri.pos - WINDOW; kp <= ri.pos; ++kp) { const float* r = win_ptr(cache_win, winrows, ri.seq, kp); if (!r) continue;
        const float* k = r + (0 * N_KV + g) * HD; float s = 0.f; for (int d = 0; d < HD; ++d) s += q[d] * k[d];
        const float e = expf(s * 0.125f - mx); sum += e; const float* v = r + (1 * N_KV + g) * HD; for (int d = 0; d < HD; ++d) o[d] += e * v[d]; }
    const float inv = 1.0f / fmaxf(sum, TINYF);
    const float* gt = gates + (size_t)m * 3 * N_HEADS + hh * 3;
    for (int d = 0; d < HD; ++d) { const size_t x = (size_t)m * HDM + hh * HD + d; o_out[x] = f2bf(gt[0] * oc[x] + gt[1] * os[x] + gt[2] * o[d] * inv); }
}


#ifndef CPU_TEST
__device__ __forceinline__ unsigned lane_id_v() { unsigned l; asm volatile("v_mbcnt_lo_u32_b32 %0, -1, 0\n\tv_mbcnt_hi_u32_b32 %0, -1, %0" : "=v"(l)); return l; }
#endif
constexpr int NTHREADS = 512;
__host__ __device__ inline bf16_t f2bf_(float f) { unsigned u; memcpy(&u, &f, 4); u = (u + 0x7fffu + ((u >> 16) & 1u)) >> 16; return (bf16_t)u; }
__host__ __device__ inline float bf2f_(bf16_t b) { unsigned u = (unsigned)b << 16; float f; memcpy(&f, &u, 4); return f; }
constexpr int NRSS = 3 * DEPTH + 1;
constexpr int NPOS = SEQ + DEC_SEQ;
constexpr int QGP = ((QGW + 255) / 256) * 256;
__host__ __device__ inline int pos_index(int pos) { return pos < SEQ ? pos : SEQ + (pos - PAST_LEN); }

constexpr size_t IMG_SEQ_BYTES = (size_t)BATCH * N_KV * (SEQ / 64) * 8192, IMG_CMP_BYTES = (size_t)BATCH * N_KV * (NBC_P / 64 > 0 ? NBC_P / 64 : 1) * 8192;
struct WsMap {
    size_t ctl, rss, rope, h, hb, act, xn, t2, actf, ub, bb, zb, t1, qn, qr, gates, ob, winrows, hid, kc, vc, pbuf, oc, os, sel, scorebuf,
           w_ain, w_aout, w_bin, w_bout, w_cin, w_cout, w_qg, w_o, w_kv, qnb, qrb, ksel, vsel, kwin, vwin, kci, vci, acs, hids, acp, hidp, w1t, w2t, part, end;
};
constexpr size_t al256(size_t b) { return (b + 255) / 256 * 256; }
constexpr size_t smax(size_t a, size_t b) { return a > b ? a : b; }
constexpr WsMap make_ws_map() {
    WsMap w{}; size_t off = 0;
#define TAKE(f, bytes) w.f = off; off += al256(bytes)
    TAKE(ctl, 65536); TAKE(rss, (size_t)NRSS * MT * 4);
    TAKE(rope, (size_t)NPOS * 16 * 4);
    TAKE(h, (size_t)MT * D_MODEL * 4); TAKE(hb, (size_t)MT * D_MODEL * 2); TAKE(act, (size_t)MT * D_FF * 2);
    TAKE(xn, (size_t)MT * D_MODEL * 4); TAKE(t2, (size_t)MT * D_MODEL * 4); TAKE(actf, (size_t)MT * D_MODEL * 4);
    TAKE(ub, (size_t)MT * D_MODEL * 2); TAKE(bb, (size_t)MT * D_MODEL * 2); TAKE(zb, (size_t)MT * D_MODEL * 2);
    TAKE(t1, smax((size_t)MT * 3 * D_MODEL * 4, (size_t)MT * KVW * 4));
    TAKE(qn, (size_t)MT * HDM * 4); TAKE(qr, (size_t)MT * HDM * 4); TAKE(gates, (size_t)MT * 3 * N_HEADS * 4); TAKE(ob, (size_t)MT * HDM * 2);
    TAKE(winrows, (size_t)MT * 2 * N_KV * HD * 4); TAKE(hid, (size_t)NSEQ * NBC_MAX * 2 * N_KV * CMP_HID * 4);
    TAKE(kc, (size_t)NSEQ * NBC_MAX * N_KV * HD * 4); TAKE(vc, (size_t)NSEQ * NBC_MAX * N_KV * HD * 4);
    TAKE(pbuf, (size_t)MT * N_HEADS * NBC_MAX * 4); TAKE(oc, (size_t)MT * HDM * 4); TAKE(os, (size_t)MT * HDM * 4);
    TAKE(sel, (size_t)MT * N_KV * N_SEL * 4); TAKE(scorebuf, (size_t)MT * N_KV * NBS_MAX * 4);
    TAKE(w_ain, (size_t)DEPTH * 2 * D_FF * D_MODEL * 2); TAKE(w_aout, (size_t)DEPTH * D_MODEL * D_FF * 2);
    TAKE(w_bin, (size_t)DEPTH * 2 * D_FF * D_MODEL * 2); TAKE(w_bout, (size_t)DEPTH * D_MODEL * D_FF * 2);
    TAKE(w_cin, (size_t)N_A * 3 * D_MODEL * D_MODEL * 2); TAKE(w_cout, (size_t)N_A * D_MODEL * D_MODEL * 2);
    TAKE(w_qg, (size_t)N_B * QGP * D_MODEL * 2); TAKE(w_o, (size_t)N_B * D_MODEL * HDM * 2); TAKE(w_kv, (size_t)KVW * D_MODEL * 2);
    TAKE(qnb, (size_t)MT * HDM * 2); TAKE(qrb, (size_t)MT * HDM * 2); TAKE(ksel, IMG_SEQ_BYTES); TAKE(vsel, IMG_SEQ_BYTES); TAKE(kwin, IMG_SEQ_BYTES); TAKE(vwin, IMG_SEQ_BYTES); TAKE(kci, IMG_CMP_BYTES); TAKE(vci, IMG_CMP_BYTES);
    TAKE(acs, (size_t)2 * DEC_BATCH * (PAST_LEN / L_CMP) * N_KV * L_CMP * HD * 2); TAKE(hids, (size_t)2 * DEC_BATCH * (PAST_LEN / L_CMP) * N_KV * CMP_HID * 2);
    TAKE(acp, (size_t)2 * BATCH * NBC_P * N_KV * L_CMP * HD * 2); TAKE(hidp, (size_t)2 * BATCH * NBC_P * N_KV * CMP_HID * 2); TAKE(w1t, (size_t)2 * CMP_HID * L_CMP * HD * 2); TAKE(w2t, (size_t)2 * HD * CMP_HID * 2); TAKE(part, (size_t)8 * MS * 3 * D_MODEL * 4);
#undef TAKE
    w.end = off; return w;
}
constexpr WsMap WSM = make_ws_map();
constexpr size_t WS_ZERO_BYTES = 65536 + (((size_t)NRSS * MT * 4 + 255) / 256 * 256);

enum { CM_PLAIN = 0, CM_PAIR = 1, CM_CONV = 2, CM_HEADS = 3 };
__host__ __device__ inline int colmap(int kind, int n, int aux) {
    const int pn = n / 256, c = n % 256;
    if (kind == CM_PLAIN) return n;
    if (kind == CM_PAIR) return (c >= 128 ? aux : 0) + pn * 128 + (c % 128);
    if (kind == CM_CONV) { if (n < 2 * D_MODEL) return (c >= 128 ? 2 * D_MODEL : D_MODEL) + pn * 128 + (c % 128); return n - 2 * D_MODEL; }
    if (n < aux * 64) { const int bj = c / 128, wc = (c % 128) / 32, r = c % 32; return (pn * 4 + wc) * 64 + 32 * bj + r; }
    return n;
}
__device__ inline void wconv_item(size_t i_, const float* src, int Nsrc, const float* gain, bf16_t* dst, int Nd, int K, int kind, int aux) {
    const int n = (int)(i_ % Nd), kb = (int)(i_ / Nd);
    const int col = colmap(kind, n, aux);
    bf16_t* d = dst + (size_t)n * K + (size_t)kb * 64;
    if (col < 0 || col >= Nsrc) { for (int k = 0; k < 64; ++k) d[k] = 0; return; }
    const float* s = src + (size_t)kb * 64 * Nsrc + col;
#pragma unroll 8
    for (int k = 0; k < 64; k += 2) {
        const float g0 = gain ? gain[kb * 64 + k] : 1.f, g1 = gain ? gain[kb * 64 + k + 1] : 1.f;
        const unsigned lo = f2bf(s[(size_t)k * Nsrc] * g0), hi = f2bf(s[(size_t)(k + 1) * Nsrc] * g1);
        *(unsigned*)(d + k) = lo | (hi << 16);
    }
}
__device__ inline void rope_item(size_t i_, float* rope) {
    const int pi = (int)(i_ / 8), f = (int)(i_ % 8);
    const int pos = pi < SEQ ? pi : PAST_LEN + (pi - SEQ);
    float c, s; rope_cs((float)pos * INV_FREQ[f], c, s);
    rope[pi * 16 + f] = c; rope[pi * 16 + 8 + f] = s;
}
__device__ inline void hinit_item(size_t i_, const float* xp, const float* xs, float* h, bf16_t* hb, float* rss0) {
    const int m = (int)i_; const float* x = m < MP ? xp + (size_t)m * D_MODEL : xs + (size_t)(m - MP) * D_MODEL;
    float s = 0.f;
    for (int k = 0; k < D_MODEL; ++k) { const float v = x[k]; s += v * v; h[(size_t)m * D_MODEL + k] = v; hb[(size_t)m * D_MODEL + k] = f2bf(v); }
    rss0[m] = s;
}
__device__ inline void hupd_item(size_t i_, float* h, const float* y, float coef, bf16_t* hb, float* rss) {
    const int m = (int)i_; float s = 0.f;
    for (int k = 0; k < D_MODEL; ++k) { const float v = h[(size_t)m * D_MODEL + k] + coef * y[(size_t)m * D_MODEL + k]; s += v * v; h[(size_t)m * D_MODEL + k] = v; hb[(size_t)m * D_MODEL + k] = f2bf(v); }
    rss[m] = s;
}
__device__ inline float dot_bf(const bf16_t* a, const bf16_t* b, int K) { float s = 0.f; for (int k = 0; k < K; ++k) s += bf2f(a[k]) * bf2f(b[k]); return s; }
__device__ inline float silu_f(float g) { return g / (1.0f + expf(-g)); }
__device__ inline void ref_ffn_in_item(size_t i_, const bf16_t* hb, const float* rss, const bf16_t* Bt, bf16_t* act) {
    const int m = (int)(i_ / D_FF), j = (int)(i_ % D_FF);
    const float rs = 1.0f / sqrtf(rss[m] / D_MODEL + EPS);
    const int ng = (j / 128) * 256 + (j % 128);
    const float g = rs * dot_bf(hb + (size_t)m * D_MODEL, Bt + (size_t)ng * D_MODEL, D_MODEL), u = rs * dot_bf(hb + (size_t)m * D_MODEL, Bt + (size_t)(ng + 128) * D_MODEL, D_MODEL);
    act[i_] = f2bf(silu_f(g) * u);
}
__device__ inline void ref_resid_row_item(size_t i_, const bf16_t* A, int K, const bf16_t* Bt, float coef, float* h, bf16_t* hb, float* rss_next, float* yout) {
    const int m = (int)i_; float s = 0.f;
    for (int c = 0; c < D_MODEL; ++c) {
        const float v = h[(size_t)m * D_MODEL + c] + coef * dot_bf(A + (size_t)m * K, Bt + (size_t)c * K, K);
        if (yout) { yout[(size_t)m * D_MODEL + c] = v; } else { h[(size_t)m * D_MODEL + c] = v; hb[(size_t)m * D_MODEL + c] = f2bf(v); s += v * v; }
    }
    if (!yout) rss_next[m] = s;
}

constexpr float QSCALE_F = 0.125f * 1.4426950408889634f;
__device__ inline void qconv_item(size_t i_, const float* qn, const float* qr, bf16_t* qnb, bf16_t* qrb) { qnb[i_] = f2bf(qn[i_] * QSCALE_F); qrb[i_] = f2bf(qr[i_] * QSCALE_F); }
__host__ __device__ inline size_t kimg_off(int kv, int d0) { return (size_t)(d0 >> 3) * 1024 + (size_t)kv * 16; }
__host__ __device__ inline size_t vimg_off(int kv, int d0) { return (size_t)(d0 >> 5) * 4096 + (size_t)(kv >> 3) * 512 + (size_t)(kv & 7) * 64 + (size_t)((d0 & 31) >> 3) * 16; }
__device__ inline void put_chunk(unsigned char* dst, const float* src) { bf16_t* d = (bf16_t*)dst; for (int k = 0; k < 8; ++k) d[k] = f2bf(src[k]); }
__device__ inline void kvimg_item(size_t i_, const float* out, const float* winrows, unsigned char* ksel, unsigned char* vsel, unsigned char* kwin, unsigned char* vwin) {
    const int c = (int)(i_ % 8), t = (int)((i_ / 8) % SEQ), g = (int)((i_ / (8 * (size_t)SEQ)) % N_KV), n = (int)(i_ / (8 * (size_t)SEQ * N_KV));
    const size_t base = (((size_t)n * N_KV + g) * (SEQ / 64) + t / 64) * 8192; const int kv = t % 64, d0 = 8 * c; const size_t m = (size_t)n * SEQ + t;
    put_chunk(ksel + base + kimg_off(kv, d0), out + O_KVP + ((m * 4 + 2) * N_KV + g) * HD + d0);
    put_chunk(vsel + base + vimg_off(kv, d0), out + O_KVP + ((m * 4 + 3) * N_KV + g) * HD + d0);
    put_chunk(kwin + base + kimg_off(kv, d0), winrows + ((m * 2 + 0) * N_KV + g) * HD + d0);
    put_chunk(vwin + base + vimg_off(kv, d0), winrows + ((m * 2 + 1) * N_KV + g) * HD + d0);
}
__device__ inline void kcimg_item(size_t i_, const float* kc, const float* vc, unsigned char* kci, unsigned char* vci) {
    const int c = (int)(i_ % 8), cb = (int)((i_ / 8) % NBC_P), g = (int)((i_ / (8 * (size_t)NBC_P)) % N_KV), n = (int)(i_ / (8 * (size_t)NBC_P * N_KV));
    const size_t base = (((size_t)n * N_KV + g) * (NBC_P / 64) + cb / 64) * 8192; const int kv = cb % 64, d0 = 8 * c;
    put_chunk(kci + base + kimg_off(kv, d0), kc + (((size_t)n * NBC_MAX + cb) * N_KV + g) * HD + d0);
    put_chunk(vci + base + vimg_off(kv, d0), vc + (((size_t)n * NBC_MAX + cb) * N_KV + g) * HD + d0);
}

constexpr int NBC_PAST = PAST_LEN / L_CMP;
constexpr int RS_CMP = DEC_BATCH * NBC_PAST * N_KV, RP_CMP = BATCH * NBC_P * N_KV;
__device__ inline void acmp_sample_item(size_t i_, const float* cache_kv, const int* page_table, const float* pe, bf16_t* A) {
    const int c8 = (int)(i_ % 8), l = (int)((i_ / 8) % L_CMP); const size_t rr = i_ / (8 * L_CMP); const int r = (int)(rr % RS_CMP), e = (int)(rr / RS_CMP);
    const int g = r % N_KV, c = (r / N_KV) % NBC_PAST, b = r / (N_KV * NBC_PAST), tok = c * L_CMP + l;
    const int page = page_table[b * N_PAGES + tok / PAGE_SIZE];
    const float* src = cache_kv + ((((size_t)page * PAGE_SIZE + tok % PAGE_SIZE) * 4 + e) * N_KV + g) * HD + 8 * c8; const float* pp = pe + ((size_t)e * L_CMP + l) * HD + 8 * c8;
    bf16_t* d = A + ((size_t)e * RS_CMP + r) * (L_CMP * HD) + l * HD + 8 * c8;
#ifndef CPU_TEST
    typedef float f4 __attribute__((ext_vector_type(4))); typedef unsigned u4 __attribute__((ext_vector_type(4)));
    const f4 a0 = __builtin_nontemporal_load((const f4*)src) + *(const f4*)pp, a1 = __builtin_nontemporal_load((const f4*)(src + 4)) + *(const f4*)(pp + 4);
    u4 w; w.x = (unsigned)f2bf(a0[0]) | ((unsigned)f2bf(a0[1]) << 16); w.y = (unsigned)f2bf(a0[2]) | ((unsigned)f2bf(a0[3]) << 16);
    w.z = (unsigned)f2bf(a1[0]) | ((unsigned)f2bf(a1[1]) << 16); w.w = (unsigned)f2bf(a1[2]) | ((unsigned)f2bf(a1[3]) << 16);
    *(u4*)d = w;
#else
    for (int k = 0; k < 8; ++k) d[k] = f2bf(src[k] + pp[k]);
#endif
}
__device__ inline void acmp_prompt_item(size_t i_, const float* out, const float* pe, bf16_t* A) {
    const int c8 = (int)(i_ % 8), l = (int)((i_ / 8) % L_CMP); const size_t rr = i_ / (8 * L_CMP); const int r = (int)(rr % RP_CMP), e = (int)(rr / RP_CMP);
    const int g = r % N_KV, c = (r / N_KV) % NBC_P, n = r / (N_KV * NBC_P), tok = c * L_CMP + l;
    const float* src = out + O_KVP + ((((size_t)n * SEQ + tok) * 4 + e) * N_KV + g) * HD + 8 * c8; const float* pp = pe + ((size_t)e * L_CMP + l) * HD + 8 * c8;
    bf16_t* d = A + ((size_t)e * RP_CMP + r) * (L_CMP * HD) + l * HD + 8 * c8;
    for (int k = 0; k < 8; ++k) d[k] = f2bf(src[k] + pp[k]);
}
__device__ inline void cmp_out_b_item(size_t i_, const bf16_t* hid, int R, int nbc, int seq0, const float* w2, const float* k_norm0, float* kc, float* vc) {
    const int r = (int)(i_ % R), e = (int)(i_ / R); const int g = r % N_KV, c = (r / N_KV) % nbc, sq = r / (N_KV * nbc);
    const bf16_t* hr = hid + ((size_t)e * R + r) * CMP_HID;
    float v[HD];
    for (int d = 0; d < HD; ++d) v[d] = 0.f;
    for (int f = 0; f < CMP_HID; ++f) { const float hf = bf2f(hr[f]); const float* w = w2 + ((size_t)e * CMP_HID + f) * HD; for (int d = 0; d < HD; ++d) v[d] += hf * w[d]; }
    if (e == 0) head_norm(v, k_norm0);
    float* o = (e == 0 ? kc : vc) + (((size_t)(seq0 + sq) * NBC_MAX + c) * N_KV + g) * HD;
    for (int d = 0; d < HD; ++d) o[d] = v[d];
}
__host__ __device__ inline int heads_row(int hidx, int d) { return (hidx / 4) * 256 + 128 * (d / 32) + 32 * (hidx % 4) + (d % 32); }
__device__ inline void conv_state_store(float* out, int layer, int m, int ch, float u) {
    const RowInfo ri = row_info(m); const int L = seq_len(ri.seq);
    if (ri.t >= L - 2) { const int j = ri.t - (L - 2);
        if (ri.seq < BATCH) out[O_CP + (((size_t)layer * BATCH + ri.seq) * 2 + j) * D_MODEL + ch] = u;
        else out[O_CS + (((size_t)layer * DEC_BATCH + (ri.seq - BATCH)) * 2 + j) * D_MODEL + ch] = u; }
}
__device__ inline void ref_conv_in_item(size_t i_, const bf16_t* hb, const float* rss, const bf16_t* Bt, bf16_t* ub, bf16_t* bb, float* out, int layer) {
    const int m = (int)(i_ / D_MODEL), j = (int)(i_ % D_MODEL);
    const float rs = 1.0f / sqrtf(rss[m] / D_MODEL + EPS); const bf16_t* a = hb + (size_t)m * D_MODEL;
    const int nc = (j / 128) * 256 + (j % 128);
    const float c = rs * dot_bf(a, Bt + (size_t)nc * D_MODEL, D_MODEL), x = rs * dot_bf(a, Bt + (size_t)(nc + 128) * D_MODEL, D_MODEL), b = rs * dot_bf(a, Bt + (size_t)(2 * D_MODEL + j) * D_MODEL, D_MODEL);
    const float u = c * x; ub[i_] = f2bf(u); bb[i_] = f2bf(b); conv_state_store(out, layer, m, j, u);
}
__device__ inline void conv_thin_item(size_t i_, const bf16_t* ub, const bf16_t* bb, const float* state  , const float* wc  , bf16_t* zb) {
    const int m = (int)(i_ / D_MODEL), ch = (int)(i_ % D_MODEL);
    const RowInfo ri = row_info(m);
    const float u0 = bf2f(ub[i_]);
    float u1, u2;
    if (ri.t >= 1) u1 = bf2f(ub[i_ - D_MODEL]); else u1 = (ri.seq < BATCH) ? 0.f : state[((size_t)(ri.seq - BATCH) * 2 + 1) * D_MODEL + ch];
    if (ri.t >= 2) u2 = bf2f(ub[i_ - 2 * D_MODEL]); else if (ri.seq < BATCH) u2 = 0.f;
    else u2 = (ri.t == 1) ? state[((size_t)(ri.seq - BATCH) * 2 + 1) * D_MODEL + ch] : state[((size_t)(ri.seq - BATCH) * 2 + 0) * D_MODEL + ch];
    zb[i_] = f2bf(bf2f(bb[i_]) * (wc[ch] * u2 + wc[D_MODEL + ch] * u1 + wc[2 * D_MODEL + ch] * u0));
}
__device__ inline void ref_qg_item(size_t i_, const bf16_t* hb, const float* rss, const bf16_t* Bt, const float* q_norm, const float* rope, float* qn, float* qr) {
    const int m = (int)(i_ / N_HEADS), hh = (int)(i_ % N_HEADS);
    const float rs = 1.0f / sqrtf(rss[m] / D_MODEL + EPS); const bf16_t* a = hb + (size_t)m * D_MODEL;
    float v[HD]; for (int d = 0; d < HD; ++d) v[d] = rs * dot_bf(a, Bt + (size_t)heads_row(hh, d) * D_MODEL, D_MODEL);
    head_norm(v, q_norm);
    for (int d = 0; d < HD; ++d) qn[(size_t)m * HDM + hh * HD + d] = v[d];
    const float* rt = rope + (size_t)pos_index(row_info(m).pos) * 16;
    for (int f = 0; f < 8; ++f) { const float x1 = v[f], x2 = v[8 + f]; v[f] = x1 * rt[f] - x2 * rt[8 + f]; v[8 + f] = x2 * rt[f] + x1 * rt[8 + f]; }
    for (int d = 0; d < HD; ++d) qr[(size_t)m * HDM + hh * HD + d] = v[d];
}
__device__ inline void ref_gates_item(size_t i_, const bf16_t* hb, const float* rss, const bf16_t* Bt, float* gates) {
    const int m = (int)(i_ / (3 * N_HEADS)), j = (int)(i_ % (3 * N_HEADS));
    const float rs = 1.0f / sqrtf(rss[m] / D_MODEL + EPS);
    const float x = rs * dot_bf(hb + (size_t)m * D_MODEL, Bt + (size_t)(HDM + j) * D_MODEL, D_MODEL);
    gates[i_] = 1.0f / (1.0f + expf(-x));
}
__device__ inline void kv_store(float* out, float* winrows, int m, int e, int g, int d, float v) {
    const RowInfo ri = row_info(m);
    if (e < 4) { if (ri.seq < BATCH) out[O_KVP + (((size_t)m * 4 + e) * N_KV + g) * HD + d] = v; else out[O_KVS + (((size_t)(m - MP) * 4 + e) * N_KV + g) * HD + d] = v; }
    else { const int we = e - 4;
        winrows[(((size_t)m * 2 + we) * N_KV + g) * HD + d] = v;
        if (ri.seq < BATCH) { if (ri.t >= SEQ - WINDOW) out[O_WP + ((((size_t)ri.seq * WINDOW + (ri.t - (SEQ - WINDOW))) * 2 + we) * N_KV + g) * HD + d] = v; }
        else out[O_WS + ((((size_t)(ri.seq - BATCH) * WINDOW + (WINDOW - DEC_SEQ + ri.t)) * 2 + we) * N_KV + g) * HD + d] = v; }
}
__device__ inline void ref_kv_item(size_t i_, const bf16_t* hb, const float* rss, const bf16_t* Bt, const float* k_norm, const float* rope, float* out, float* winrows) {
    const int m = (int)(i_ / (6 * N_KV)), hidx = (int)(i_ % (6 * N_KV)), e = hidx / N_KV, g = hidx % N_KV;
    const float rs = 1.0f / sqrtf(rss[m] / D_MODEL + EPS); const bf16_t* a = hb + (size_t)m * D_MODEL;
    float v[HD]; for (int d = 0; d < HD; ++d) v[d] = rs * dot_bf(a, Bt + (size_t)heads_row(hidx, d) * D_MODEL, D_MODEL);
    if (e == 2 || e == 4) { head_norm(v, k_norm + (e == 2 ? 1 : 2) * HD);
        const float* rt = rope + (size_t)pos_index(row_info(m).pos) * 16;
        for (int f = 0; f < 8; ++f) { const float x1 = v[f], x2 = v[8 + f]; v[f] = x1 * rt[f] - x2 * rt[8 + f]; v[8 + f] = x2 * rt[f] + x1 * rt[8 + f]; } }
    for (int d = 0; d < HD; ++d) kv_store(out, winrows, m, e, g, d, v[d]);
}
#ifndef CPU_TEST
#define LAS __attribute__((address_space(3)))
#define XB_TMO      128
#define XB_XCNT(j)  (256  + 64 * (j))
#define XB_XSUB(j)  (1280 + 64 * (j))
#define XB_XGEN(j)  (2304 + 64 * (j))
#define XB_TOP      3328
#define XB_TOPGEN   3392
#define XCD_BAR_WORDS 3456
#define XB_SPIN_CAP (1u << 25)
typedef __attribute__((address_space(1))) unsigned GU;
__device__ __forceinline__ unsigned xb_ld(GU* p)              { return __hip_atomic_load(p, __ATOMIC_RELAXED, __HIP_MEMORY_SCOPE_AGENT); }
__device__ __forceinline__ unsigned xb_add(GU* p, unsigned v) { return __hip_atomic_fetch_add(p, v, __ATOMIC_RELAXED, __HIP_MEMORY_SCOPE_AGENT); }
__device__ __forceinline__ unsigned xb_xcc_id() { return (unsigned)__builtin_amdgcn_s_getreg((3 << 11) | 20) & 0xFu; }
#define XB_SPIN(cond, bar) do { unsigned _sp = 0; while (cond) { __builtin_amdgcn_s_sleep(1); \
    if ((++_sp & 255u) == 0u) { if (xb_ld(&(bar)[XB_TMO])) break; if (_sp > XB_SPIN_CAP) { (void)xb_add(&(bar)[XB_TMO], 1u); break; } } } } while (0)
struct XcdBarrier { GU* bar; unsigned x; volatile LAS unsigned* st; };
__device__ __forceinline__ XcdBarrier xcd_barrier_post(GU* bar, volatile LAS unsigned* st, const bool leader_thread) {
    XcdBarrier b; b.bar = bar; b.x = xb_xcc_id(); b.st = st;
    if (leader_thread) (void)xb_add(&bar[XB_XCNT(b.x)], 1u);
    return b;
}
__device__ __forceinline__ void xcd_barrier_complete(GU* bar, unsigned x, unsigned& nloc, unsigned& nx) {
    const unsigned G = gridDim.x * gridDim.y * gridDim.z;
    unsigned sum, cnt, mine, sp = 0u;
    for (;;) {
        sum = 0u; cnt = 0u; mine = 0u;
#pragma unroll
        for (unsigned j = 0; j < 16; ++j) { const unsigned c = xb_ld(&bar[XB_XCNT(j)]); sum += c; cnt += (c > 0u) ? 1u : 0u; mine = (j == x) ? c : mine; }
        if (sum == G) break;
        __builtin_amdgcn_s_sleep(1);
        if ((++sp & 255u) == 0u) { if (xb_ld(&bar[XB_TMO])) break; if (sp > XB_SPIN_CAP) { (void)xb_add(&bar[XB_TMO], 1u); break; } }
    }
    nloc = mine > 0u ? mine : 1u; nx = cnt > 0u ? cnt : 1u;
}
__device__ __forceinline__ void xcd_barrier(const XcdBarrier& b, const bool leader_thread) {
    asm volatile("s_waitcnt vmcnt(0)" ::: "memory");
    __syncthreads();
    if (leader_thread) {
        GU* bar = b.bar; unsigned bx = xb_xcc_id(); asm volatile("" : "+s"(bx));
        __builtin_amdgcn_s_waitcnt(0);
        unsigned nloc = b.st[0], nx = b.st[1];
        if (nloc == 0u) { xcd_barrier_complete(bar, bx, nloc, nx); b.st[0] = nloc; b.st[1] = nx; }
        const unsigned old = xb_add(&bar[XB_XSUB(bx)], 1u);
        const unsigned gen = old / nloc;
        if (old + 1u == (gen + 1u) * nloc) {
            __builtin_amdgcn_fence(__ATOMIC_RELEASE, "agent");
            asm volatile("s_waitcnt vmcnt(0)" ::: "memory");
            const unsigned og = xb_add(&bar[XB_TOP], 1u);
            const unsigned tg = og / nx;
            if (og + 1u == (tg + 1u) * nx) xb_add(&bar[XB_TOPGEN], 1u);
            else XB_SPIN(xb_ld(&bar[XB_TOPGEN]) == tg, bar);
            __builtin_amdgcn_fence(__ATOMIC_ACQUIRE, "agent");
            xb_add(&bar[XB_XGEN(bx)], 1u);
            asm volatile("s_waitcnt vmcnt(0)" ::: "memory");
        } else {
            XB_SPIN(xb_ld(&bar[XB_XGEN(bx)]) == gen, bar);
            __builtin_amdgcn_fence(__ATOMIC_ACQUIRE, "agent");
            asm volatile("s_waitcnt vmcnt(0)" ::: "memory");
        }
    }
    __syncthreads();
}

namespace pg8 {
#define PG8_LAS __attribute__((address_space(3)))
typedef unsigned short bf16_t;
typedef short bf16x8 __attribute__((ext_vector_type(8)));
typedef float f32x4 __attribute__((ext_vector_type(4)));
typedef unsigned u32x4 __attribute__((ext_vector_type(4)));
constexpr int BM = 256, BK = 64, HALF = 128, HTB = HALF * BK * 2  , STAGE_BYTES = 8 * HTB, NXCD = 8, WGM = 8;

__host__ __device__ __forceinline__ int lds_byte(int r, int c) { const int st = (r >> 4) * 2 + (c >> 5), rr = r & 15, cc = c & 31, ob = rr * 64 + cc * 2; return st * 1024 + (ob ^ (((ob >> 9) & 1) << 5)); }
__host__ __device__ __forceinline__ void stage_rc(int b, int& R, int& C) { const int st = b / 1024, sb = b % 1024, swz = sb ^ (((sb >> 9) & 1) << 5); R = (st >> 1) * 16 + swz / 64; C = (st & 1) * 32 + (swz % 64) / 2; }
__host__ __device__ __forceinline__ int perm32(int rho) { const int n = rho >> 4, i = rho & 15; return 8 * (i >> 2) + 4 * n + (i & 3); }

struct Unit { int pm, pn; };
struct Gemm { const bf16_t* A; const bf16_t* Bt; int M, N, K; };

struct StaticOrder {
    int nM, nN, nwg, G, c;
    __host__ __device__ void init(int M, int N, int G_, int c_) { nM = M / BM; nN = N / BM; nwg = nM * nN; G = G_; c = c_; }
    __host__ __device__ bool next(int i, Unit& u) const {
        const long L = (long)i * G + c; if (L >= nwg) return false;
        int wgid = (int)L; { const int q = nwg / NXCD, r = nwg % NXCD, xcd = wgid % NXCD, off = wgid / NXCD; wgid = (xcd < r ? xcd * (q + 1) : r * (q + 1) + (xcd - r) * q) + off; }
        const int nig = WGM * nN, gid = wgid / nig, fm = gid * WGM, gsz = (nM - fm) < WGM ? (nM - fm) : WGM;
        u.pm = fm + ((wgid % nig) % gsz); u.pn = (wgid % nig) / gsz; return true;
    }
    __device__ __forceinline__ void a_ready(const Unit&) const {}
    __device__ __forceinline__ void done(const Unit&) const {}
};

__device__ __forceinline__ unsigned cvt_pk_bf16(float lo, float hi) { unsigned r; asm volatile("v_cvt_pk_bf16_f32 %0, %1, %2" : "=v"(r) : "v"(lo), "v"(hi)); return r; }
template <class Epi, class Sched, bool ALIGN_EPI = false, bool SP2 = false>
__device__ __forceinline__ void gemm_phase(int wave_id_, PG8_LAS unsigned char* lds, const Gemm g, const Sched& S, const Epi& E) {
    int wid = wave_id_, lane = (int)lane_id_v(); asm volatile("" : "+s"(wid));
    const int tid = wid * 64 + lane, wr = wid >> 2, wc = wid & 3, fr = lane & 15, fq = lane >> 4;
    const int K = g.K, nt = K / BK;
    unsigned voffA[2], voffB[2];
#pragma unroll
    for (int i = 0; i < 2; ++i) { int R, C; stage_rc(tid * 16 + i * 8192, R, C); const int Rb = Epi::PERM ? ((R & ~31) + perm32(R & 31)) : R;
        voffA[i] = (unsigned)(R * K + C) * 2u; voffB[i] = (unsigned)(Rb * K + C) * 2u; }
    const size_t kstep = (size_t)(BK * 2);
    const size_t hstep = (size_t)HALF * K * 2;
    const size_t tstep = 2 * hstep;
    const unsigned ldsw = (unsigned)wid * 1024u;
    const int aoff = lds_byte(wr * 64 + fr, fq * 8), boff = lds_byte(wc * 32 + fr, fq * 8);
#define PG8_SA(b, h) (((b) * 2 + (h)) * HTB)
#define PG8_SB(b, h) ((4 + (b) * 2 + (h)) * HTB)
#define PG8_STAGE(bufoff, gbase, voff) do { _Pragma("unroll") for (int _i = 0; _i < 2; ++_i) \
        __builtin_amdgcn_global_load_lds((const unsigned*)((const char*)(gbase) + (voff)[_i]), (PG8_LAS unsigned*)(lds + (bufoff) + ldsw + _i * 8192), 16, 0, 0); } while (0)
#define PG8_LDA(dst, b, h) do { _Pragma("unroll") for (int m = 0; m < 4; ++m) _Pragma("unroll") for (int k = 0; k < 2; ++k) dst[m][k] = *(const PG8_LAS bf16x8*)(lds + PG8_SA(b, h) + aoff + m * 2048 + k * 1024); } while (0)
#define PG8_LDB(dst, b, h) do { _Pragma("unroll") for (int n = 0; n < 2; ++n) _Pragma("unroll") for (int k = 0; k < 2; ++k) dst[n][k] = *(const PG8_LAS bf16x8*)(lds + PG8_SB(b, h) + boff + n * 2048 + k * 1024); } while (0)
#define PG8_MMA(ai, bj, At, Bt) do { __builtin_amdgcn_s_setprio(1); _Pragma("unroll") for (int m = 0; m < 4; ++m) _Pragma("unroll") for (int n = 0; n < 2; ++n) _Pragma("unroll") for (int k = 0; k < 2; ++k) \
        acc[ai][bj][m][n] = __builtin_amdgcn_mfma_f32_16x16x32_bf16(Bt[n][k], At[m][k], acc[ai][bj][m][n], 0, 0, 0); __builtin_amdgcn_s_setprio(0); } while (0)
#define PG8_WAIT_V(n) asm volatile("s_waitcnt vmcnt(" #n ")" ::: "memory")
#define PG8_WAIT_L(n) asm volatile("s_waitcnt lgkmcnt(" #n ")" ::: "memory")
#define PG8_BAR __builtin_amdgcn_s_barrier()
#define PG8_SCHED __builtin_amdgcn_sched_barrier(0)
    Unit cur, nxt; int ui = 0;
    if (!S.next(0, cur)) return;
    f32x4 acc[2][2][4][2];
#pragma unroll
    for (int a = 0; a < 2; ++a)
#pragma unroll
        for (int b = 0; b < 2; ++b)
#pragma unroll
            for (int m = 0; m < 4; ++m)
#pragma unroll
                for (int n = 0; n < 2; ++n) acc[a][b][m][n] = (f32x4){0.f, 0.f, 0.f, 0.f};
    bf16x8 At[4][2], B0[2][2], B1[2][2];
    const char* cA = (const char*)g.A + (size_t)cur.pm * tstep; const char* cB = (const char*)g.Bt + (size_t)cur.pn * tstep;
    S.a_ready(cur);
    if constexpr (SP2) {
        PG8_STAGE(PG8_SB(0, 0), cB, voffB); PG8_STAGE(PG8_SB(0, 1), cB + hstep, voffB); PG8_STAGE(PG8_SA(0, 0), cA, voffA); PG8_STAGE(PG8_SA(0, 1), cA + hstep, voffA);
        if (wr == 1) PG8_BAR;
        PG8_WAIT_V(2); PG8_BAR;
        PG8_STAGE(PG8_SB(1, 0), cB + kstep, voffB); PG8_STAGE(PG8_SA(1, 0), cA + kstep, voffA); PG8_STAGE(PG8_SB(1, 1), cB + hstep + kstep, voffB);
        PG8_WAIT_V(6); PG8_BAR;
    } else {
        PG8_STAGE(PG8_SB(0, 0), cB, voffB); PG8_STAGE(PG8_SA(0, 0), cA, voffA); PG8_STAGE(PG8_SB(0, 1), cB + hstep, voffB); PG8_STAGE(PG8_SA(0, 1), cA + hstep, voffA);
        if (wr == 1) PG8_BAR;
        PG8_WAIT_V(4); PG8_BAR;
        PG8_STAGE(PG8_SB(1, 0), cB + kstep, voffB); PG8_STAGE(PG8_SA(1, 0), cA + kstep, voffA); PG8_STAGE(PG8_SB(1, 1), cB + hstep + kstep, voffB);
        PG8_WAIT_V(6); PG8_BAR;
    }
    for (;;) {
        const bool has_next = S.next(ui + 1, nxt);
        const char* nA = has_next ? (const char*)g.A + (size_t)nxt.pm * tstep : cA; const char* nB = has_next ? (const char*)g.Bt + (size_t)nxt.pn * tstep : cB;
        for (int t = 0; t < nt; t += 2) {
            const bool last = (t == nt - 2);
            const char* a1 = cA + (size_t)(t + 1) * kstep;
            const char* a2 = last ? nA : cA + (size_t)(t + 2) * kstep; const char* b2 = last ? nB : cB + (size_t)(t + 2) * kstep;
            const char* a3 = a2 + kstep; const char* b3 = b2 + kstep;
            if (last && has_next) S.a_ready(nxt);
            if constexpr (SP2) {
            PG8_LDB(B0, 0, 0); PG8_LDB(B1, 0, 1); PG8_SCHED; PG8_LDA(At, 0, 0); PG8_STAGE(PG8_SA(1, 1), a1 + hstep, voffA);
            PG8_WAIT_V(8); PG8_WAIT_L(0); PG8_BAR; PG8_MMA(0, 0, At, B0); PG8_MMA(0, 1, At, B1); PG8_BAR; PG8_SCHED;
            PG8_LDA(At, 0, 1); PG8_STAGE(PG8_SB(0, 0), b2, voffB); PG8_STAGE(PG8_SB(0, 1), b2 + hstep, voffB); PG8_STAGE(PG8_SA(0, 0), a2, voffA);
            PG8_WAIT_V(8); PG8_WAIT_L(0); PG8_BAR; PG8_MMA(1, 0, At, B0); PG8_MMA(1, 1, At, B1); PG8_BAR; PG8_SCHED;
            PG8_LDB(B0, 1, 0); PG8_LDB(B1, 1, 1); PG8_SCHED; PG8_LDA(At, 1, 0); PG8_STAGE(PG8_SA(0, 1), a2 + hstep, voffA);
            PG8_WAIT_V(8); PG8_WAIT_L(0); PG8_BAR; PG8_MMA(0, 0, At, B0); PG8_MMA(0, 1, At, B1); PG8_BAR; PG8_SCHED;
            PG8_LDA(At, 1, 1); PG8_STAGE(PG8_SB(1, 0), b3, voffB); PG8_STAGE(PG8_SB(1, 1), b3 + hstep, voffB); PG8_STAGE(PG8_SA(1, 0), a3, voffA);
            PG8_WAIT_V(8); PG8_WAIT_L(0); PG8_BAR; PG8_MMA(1, 0, At, B0); PG8_MMA(1, 1, At, B1); PG8_BAR; PG8_SCHED;
            } else {
            PG8_LDB(B0, 0, 0); PG8_SCHED; PG8_LDA(At, 0, 0); PG8_STAGE(PG8_SA(1, 1), a1 + hstep, voffA);
            PG8_WAIT_L(8); PG8_BAR; PG8_WAIT_L(0); PG8_MMA(0, 0, At, B0); PG8_BAR; PG8_SCHED;
            PG8_LDB(B1, 0, 1); PG8_STAGE(PG8_SB(0, 0), b2, voffB);
            PG8_BAR; PG8_WAIT_L(0); PG8_MMA(0, 1, At, B1); PG8_BAR;
            PG8_LDA(At, 0, 1); PG8_STAGE(PG8_SA(0, 0), a2, voffA);
            PG8_BAR; PG8_WAIT_L(0); PG8_MMA(1, 0, At, B0); PG8_BAR; PG8_SCHED;
            PG8_STAGE(PG8_SB(0, 1), b2 + hstep, voffB);
            PG8_WAIT_V(6); PG8_BAR; PG8_MMA(1, 1, At, B1); PG8_BAR;
            PG8_LDB(B0, 1, 0); PG8_SCHED; PG8_LDA(At, 1, 0); PG8_STAGE(PG8_SA(0, 1), a2 + hstep, voffA);
            PG8_WAIT_L(8); PG8_BAR; PG8_WAIT_L(0); PG8_MMA(0, 0, At, B0); PG8_BAR; PG8_SCHED;
            PG8_LDB(B1, 1, 1); PG8_STAGE(PG8_SB(1, 0), b3, voffB);
            PG8_BAR; PG8_WAIT_L(0); PG8_MMA(0, 1, At, B1); PG8_BAR;
            PG8_LDA(At, 1, 1); PG8_STAGE(PG8_SA(1, 0), a3, voffA);
            PG8_BAR; PG8_WAIT_L(0); PG8_MMA(1, 0, At, B0); PG8_BAR; PG8_SCHED;
            PG8_STAGE(PG8_SB(1, 1), b3 + hstep, voffB);
            PG8_WAIT_V(6); PG8_BAR; PG8_MMA(1, 1, At, B1); PG8_BAR;
            }
        }
        if constexpr (ALIGN_EPI) { if (wr == 0) PG8_BAR; }
        if constexpr (!Epi::AFTER_DRAIN) { E(acc, cur, wr, wc, fr, fq); S.done(cur); }
        if (!has_next) break;
#pragma unroll
        for (int a = 0; a < 2; ++a)
#pragma unroll
            for (int b = 0; b < 2; ++b)
#pragma unroll
                for (int m = 0; m < 4; ++m)
#pragma unroll
                    for (int n = 0; n < 2; ++n) acc[a][b][m][n] = (f32x4){0.f, 0.f, 0.f, 0.f};
        cur = nxt; cA = nA; cB = nB; ++ui;
        if constexpr (ALIGN_EPI) { if (wr == 1) PG8_BAR; }
    }
    PG8_WAIT_V(0);
    if constexpr (!ALIGN_EPI) { if (wr == 0) PG8_BAR; }
    PG8_BAR;
    if constexpr (Epi::AFTER_DRAIN) { E.fused(acc, cur, wr, wc, fr, fq, lds, wid, lane); S.done(cur); }
#undef PG8_SA
#undef PG8_SB
#undef PG8_STAGE
#undef PG8_LDA
#undef PG8_LDB
#undef PG8_MMA
#undef PG8_WAIT_V
#undef PG8_WAIT_L
#undef PG8_BAR
#undef PG8_SCHED
}
}

namespace pg8 {
__device__ __forceinline__ float fast_silu(float g) { return g * __builtin_amdgcn_rcpf(1.0f + __expf(-g)); }
__device__ __forceinline__ float row_rs(const float* rss, int row) { return rsqrtf(rss[row] * (1.0f / D_MODEL) + EPS); }
struct EpiSwiglu {
    static constexpr bool PERM = true, AFTER_DRAIN = false;
    bf16_t* act; const float* rss;
    __device__ __forceinline__ void operator()(const f32x4 (&acc)[2][2][4][2], const Unit& u, int wr, int wc, int fr, int fq) const {
        const int row0 = u.pm * BM + wr * 64 + fr, col0 = u.pn * 128 + wc * 32 + 8 * fq;
#pragma unroll
        for (int ai = 0; ai < 2; ++ai)
#pragma unroll
            for (int m = 0; m < 4; ++m) {
                const int row = row0 + ai * HALF + m * 16; const float rs = row_rs(rss, row);
                float a[8];
#pragma unroll
                for (int n = 0; n < 2; ++n)
#pragma unroll
                    for (int i = 0; i < 4; ++i) a[n * 4 + i] = fast_silu(acc[ai][0][m][n][i] * rs) * (acc[ai][1][m][n][i] * rs);
                u32x4 w; w.x = cvt_pk_bf16(a[0], a[1]); w.y = cvt_pk_bf16(a[2], a[3]); w.z = cvt_pk_bf16(a[4], a[5]); w.w = cvt_pk_bf16(a[6], a[7]);
                *(u32x4*)(act + (size_t)row * D_FF + col0) = w;
            }
    }
};
struct EpiResid {
    static constexpr bool PERM = false, AFTER_DRAIN = false;
    float* h; bf16_t* hb; float* rss_next; float* yout; float coef;
    __device__ __forceinline__ void operator()(const f32x4 (&acc)[2][2][4][2], const Unit& u, int wr, int wc, int fr, int fq) const {
        const int row0 = u.pm * BM + wr * 64 + fr, col0 = u.pn * BM + wc * 32 + 4 * fq;
#pragma unroll
        for (int ai = 0; ai < 2; ++ai)
#pragma unroll
            for (int m = 0; m < 4; ++m) {
                const int row = row0 + ai * HALF + m * 16; float s = 0.f;
                float* hr = h + (size_t)row * D_MODEL + col0;
#pragma unroll
                for (int bj = 0; bj < 2; ++bj)
#pragma unroll
                    for (int n = 0; n < 2; ++n) {
                        const int co = bj * HALF + n * 16;
                        const f32x4 v = *(const f32x4*)(hr + co) + acc[ai][bj][m][n] * coef;
                        if (yout) { *(f32x4*)(yout + (size_t)row * D_MODEL + col0 + co) = v; }
                        else {
                            *(f32x4*)(hr + co) = v;
                            typedef unsigned u32x2 __attribute__((ext_vector_type(2)));
                            u32x2 w; w.x = cvt_pk_bf16(v[0], v[1]); w.y = cvt_pk_bf16(v[2], v[3]);
                            *(u32x2*)(hb + (size_t)row * D_MODEL + col0 + co) = w;
                            s += (v[0] * v[0] + v[1] * v[1]) + (v[2] * v[2] + v[3] * v[3]);
                        }
                    }
                if (!yout) { s += __shfl_xor(s, 16); s += __shfl_xor(s, 32); if (fq == 0) (void)__hip_atomic_fetch_add(rss_next + row, s, __ATOMIC_RELAXED, __HIP_MEMORY_SCOPE_AGENT); }
            }
    }
};
}
namespace pg8 {
__device__ __forceinline__ float sum4(f32x4 v) { return (v[0] * v[0] + v[1] * v[1]) + (v[2] * v[2] + v[3] * v[3]); }
struct EpiConvIn {
    static constexpr bool PERM = true, AFTER_DRAIN = false;
    bf16_t* ub; bf16_t* bb; const float* rss; float* out; int layer;
    __device__ __forceinline__ void operator()(const f32x4 (&acc)[2][2][4][2], const Unit& u, int wr, int wc, int fr, int fq) const {
        const int row0 = u.pm * BM + wr * 64 + fr;
        const bool pair = u.pn < D_MODEL / 128;
#pragma unroll
        for (int ai = 0; ai < 2; ++ai)
#pragma unroll
            for (int m = 0; m < 4; ++m) {
                const int row = row0 + ai * HALF + m * 16; const float rs = row_rs(rss, row);
                if (pair) {
                    const int col0 = u.pn * 128 + wc * 32 + 8 * fq; float a[8];
#pragma unroll
                    for (int n = 0; n < 2; ++n)
#pragma unroll
                        for (int i = 0; i < 4; ++i) a[n * 4 + i] = (acc[ai][0][m][n][i] * rs) * (acc[ai][1][m][n][i] * rs);
                    u32x4 w; w.x = cvt_pk_bf16(a[0], a[1]); w.y = cvt_pk_bf16(a[2], a[3]); w.z = cvt_pk_bf16(a[4], a[5]); w.w = cvt_pk_bf16(a[6], a[7]);
                    *(u32x4*)(ub + (size_t)row * D_MODEL + col0) = w;
                    const RowInfo ri = row_info(row); const int jj = ri.t - (seq_len(ri.seq) - 2);
                    if (jj >= 0) {
                        float* cs = (ri.seq < BATCH) ? out + O_CP + (((size_t)layer * BATCH + ri.seq) * 2 + jj) * D_MODEL + col0 : out + O_CS + (((size_t)layer * DEC_BATCH + (ri.seq - BATCH)) * 2 + jj) * D_MODEL + col0;
                        *(f32x4*)(cs) = (f32x4){a[0], a[1], a[2], a[3]}; *(f32x4*)(cs + 4) = (f32x4){a[4], a[5], a[6], a[7]};
                    }
                } else {
#pragma unroll
                    for (int bj = 0; bj < 2; ++bj) {
                        const int col0 = (u.pn - D_MODEL / 128) * 256 + bj * HALF + wc * 32 + 8 * fq;
                        const f32x4 v0 = acc[ai][bj][m][0] * rs, v1 = acc[ai][bj][m][1] * rs;
                        u32x4 w; w.x = cvt_pk_bf16(v0[0], v0[1]); w.y = cvt_pk_bf16(v0[2], v0[3]); w.z = cvt_pk_bf16(v1[0], v1[1]); w.w = cvt_pk_bf16(v1[2], v1[3]);
                        *(u32x4*)(bb + (size_t)row * D_MODEL + col0) = w;
                    }
                }
                asm volatile("" ::: "memory");
            }
    }
};
__device__ __forceinline__ void head_norm_rope(f32x4 (&v)[2][2], const float* gain, const float* rt  , int fq, bool do_norm, bool do_rope, f32x4 (&rot0)[2]) {
    if (do_norm) {
        float ss = (sum4(v[0][0]) + sum4(v[0][1])) + (sum4(v[1][0]) + sum4(v[1][1]));
        ss += __shfl_xor(ss, 16); ss += __shfl_xor(ss, 32);
        const float r = rsqrtf(ss * (1.0f / HD) + EPS);
#pragma unroll
        for (int bj = 0; bj < 2; ++bj)
#pragma unroll
            for (int n = 0; n < 2; ++n) { const f32x4 g = *(const f32x4*)(gain + 32 * bj + 8 * fq + 4 * n); v[bj][n] = v[bj][n] * r * g; }
    }
    rot0[0] = v[0][0]; rot0[1] = v[0][1];
    if (do_rope) {
#pragma unroll
        for (int n = 0; n < 2; ++n) {
            f32x4 p;
#pragma unroll
            for (int i = 0; i < 4; ++i) p[i] = __shfl_xor(v[0][n][i], 16);
            const f32x4 c = *(const f32x4*)(rt + 4 * n), s = *(const f32x4*)(rt + 8 + 4 * n);
            if (fq == 0) rot0[n] = v[0][n] * c - p * s; else if (fq == 1) rot0[n] = v[0][n] * c + p * s;
        }
    }
}
__device__ __forceinline__ u32x4 pack8(const f32x4 a, const f32x4 b, float sc) { u32x4 w; w.x = cvt_pk_bf16(a[0] * sc, a[1] * sc); w.y = cvt_pk_bf16(a[2] * sc, a[3] * sc); w.z = cvt_pk_bf16(b[0] * sc, b[1] * sc); w.w = cvt_pk_bf16(b[2] * sc, b[3] * sc); return w; }
struct EpiQG {
    static constexpr bool PERM = true, AFTER_DRAIN = false;
    bf16_t* qnb; bf16_t* qrb; float* gates; const float* rss; const float* q_norm; const float* rope;
    __device__ __forceinline__ void operator()(const f32x4 (&acc)[2][2][4][2], const Unit& u, int wr, int wc, int fr, int fq) const {
        const int row0 = u.pm * BM + wr * 64 + fr;
#pragma unroll
        for (int ai = 0; ai < 2; ++ai)
#pragma unroll
            for (int m = 0; m < 4; ++m) {
                const int row = row0 + ai * HALF + m * 16; const float rs = row_rs(rss, row);
                if (u.pn < N_HEADS / 4) {
                    const int hh = u.pn * 4 + wc;
                    f32x4 v[2][2] = {{acc[ai][0][m][0] * rs, acc[ai][0][m][1] * rs}, {acc[ai][1][m][0] * rs, acc[ai][1][m][1] * rs}}; f32x4 rot0[2];
                    head_norm_rope(v, q_norm, rope + (size_t)pos_index(row_info(row).pos) * 16, fq, true, true, rot0);
                    const size_t o = (size_t)row * HDM + hh * HD + 8 * fq;
                    const u32x4 hi8 = pack8(v[1][0], v[1][1], QSCALE_F);
                    *(u32x4*)(qnb + o) = pack8(v[0][0], v[0][1], QSCALE_F); *(u32x4*)(qnb + o + 32) = hi8;
                    *(u32x4*)(qrb + o) = pack8(rot0[0], rot0[1], QSCALE_F); *(u32x4*)(qrb + o + 32) = hi8;
                } else {
                    const int c0 = wc * 32 + 8 * fq;
#pragma unroll
                    for (int n = 0; n < 2; ++n)
#pragma unroll
                        for (int i = 0; i < 4; ++i) { const int c = c0 + 4 * n + i; if (c < 3 * N_HEADS) gates[(size_t)row * 3 * N_HEADS + c] = __builtin_amdgcn_rcpf(1.0f + __expf(-(acc[ai][0][m][n][i] * rs))); }
                }
                asm volatile("" ::: "memory");
            }
    }
};
struct EpiKV {
    static constexpr bool PERM = true, AFTER_DRAIN = false;
    float* out; float* winrows; const float* rss; const float* k_norm; const float* rope;
    unsigned char* ksel; unsigned char* vsel; unsigned char* kwin; unsigned char* vwin; bf16_t* acp; const float* pe;
    __device__ __forceinline__ void operator()(const f32x4 (&acc)[2][2][4][2], const Unit& u, int wr, int wc, int fr, int fq) const {
        const int row0 = u.pm * BM + wr * 64 + fr;
        const int hidx = u.pn * 4 + wc, e = hidx / N_KV, g = hidx % N_KV; const bool nr = (e == 2 || e == 4);
#pragma unroll
        for (int ai = 0; ai < 2; ++ai)
#pragma unroll
            for (int m = 0; m < 4; ++m) {
                const int row = row0 + ai * HALF + m * 16; const float rs = row_rs(rss, row);
                const RowInfo ri = row_info(row);
                f32x4 v[2][2] = {{acc[ai][0][m][0] * rs, acc[ai][0][m][1] * rs}, {acc[ai][1][m][0] * rs, acc[ai][1][m][1] * rs}}; f32x4 rot0[2];
                head_norm_rope(v, k_norm + (e == 2 ? 1 : 2) * HD, rope + (size_t)pos_index(ri.pos) * 16, fq, nr, nr, rot0);
                float* d0; float* d1 = nullptr;
                if (e < 4) d0 = (ri.seq < BATCH) ? out + O_KVP + (((size_t)row * 4 + e) * N_KV + g) * HD : out + O_KVS + (((size_t)(row - MP) * 4 + e) * N_KV + g) * HD;
                else { const int we = e - 4; d0 = winrows + (((size_t)row * 2 + we) * N_KV + g) * HD;
                    if (ri.seq < BATCH) { if (ri.t >= SEQ - WINDOW) d1 = out + O_WP + ((((size_t)ri.seq * WINDOW + (ri.t - (SEQ - WINDOW))) * 2 + we) * N_KV + g) * HD; }
                    else d1 = out + O_WS + ((((size_t)(ri.seq - BATCH) * WINDOW + (WINDOW - DEC_SEQ + ri.t)) * 2 + we) * N_KV + g) * HD; }
                d0 += 8 * fq; *(f32x4*)(d0) = rot0[0]; *(f32x4*)(d0 + 4) = rot0[1]; *(f32x4*)(d0 + 32) = v[1][0]; *(f32x4*)(d0 + 36) = v[1][1];
                if (d1) { d1 += 8 * fq; *(f32x4*)(d1) = rot0[0]; *(f32x4*)(d1 + 4) = rot0[1]; *(f32x4*)(d1 + 32) = v[1][0]; *(f32x4*)(d1 + 36) = v[1][1]; }
                if (ri.seq < BATCH) {
                    if (e >= 2) {
                        unsigned char* img = (e == 2 ? ksel : e == 3 ? vsel : e == 4 ? kwin : vwin) + (((size_t)ri.seq * N_KV + g) * (SEQ / 64) + ri.t / 64) * 8192; const int kv = ri.t % 64;
                        const size_t o0 = (e & 1) ? vimg_off(kv, 8 * fq) : kimg_off(kv, 8 * fq), o1 = (e & 1) ? vimg_off(kv, 32 + 8 * fq) : kimg_off(kv, 32 + 8 * fq);
                        *(u32x4*)(img + o0) = pack8(rot0[0], rot0[1], 1.0f); *(u32x4*)(img + o1) = pack8(v[1][0], v[1][1], 1.0f);
                    } else {
                        const int c = ri.t / L_CMP, l = ri.t % L_CMP; const int r = (ri.seq * NBC_P + c) * N_KV + g;
                        bf16_t* ap = acp + ((size_t)e * RP_CMP + r) * (L_CMP * HD) + l * HD + 8 * fq; const float* pp = pe + ((size_t)e * L_CMP + l) * HD + 8 * fq;
                        *(u32x4*)(ap) = pack8(rot0[0] + *(const f32x4*)(pp), rot0[1] + *(const f32x4*)(pp + 4), 1.0f);
                        *(u32x4*)(ap + 32) = pack8(v[1][0] + *(const f32x4*)(pp + 32), v[1][1] + *(const f32x4*)(pp + 36), 1.0f);
                    }
                }
                asm volatile("" ::: "memory");
            }
    }
};
}

namespace pg8 {
struct EpiGelu {
    static constexpr bool PERM = true, AFTER_DRAIN = false;
    bf16_t* hid;
    __device__ __forceinline__ void operator()(const f32x4 (&acc)[2][2][4][2], const Unit& u, int wr, int wc, int fr, int fq) const {
        const int row0 = u.pm * BM + wr * 64 + fr;
#pragma unroll
        for (int ai = 0; ai < 2; ++ai)
#pragma unroll
            for (int m = 0; m < 4; ++m) {
                const int row = row0 + ai * HALF + m * 16;
#pragma unroll
                for (int bj = 0; bj < 2; ++bj) {
                    float a[8];
#pragma unroll
                    for (int n = 0; n < 2; ++n)
#pragma unroll
                        for (int i = 0; i < 4; ++i) { const float x = acc[ai][bj][m][n][i]; a[n * 4 + i] = x * __builtin_amdgcn_rcpf(1.0f + __expf(-1.5957691216057308f * (x + 0.044715f * x * x * x))); }
                    u32x4 w; w.x = cvt_pk_bf16(a[0], a[1]); w.y = cvt_pk_bf16(a[2], a[3]); w.z = cvt_pk_bf16(a[4], a[5]); w.w = cvt_pk_bf16(a[6], a[7]);
                    *(u32x4*)(hid + (size_t)row * CMP_HID + bj * HALF + wc * 32 + 8 * fq) = w;
                }
            }
    }
};
struct CmpOrder {
    int nunits, per_e, G, c;
    __device__ bool next(int i, Unit& u) const { const int L = i * G + c; if (L >= nunits) return false; u.pm = L; u.pn = L / per_e; return true; }
    __device__ __forceinline__ void a_ready(const Unit&) const {}
    __device__ __forceinline__ void done(const Unit&) const {}
};
}
constexpr int LDS_RING_C = 131072;
namespace att {
typedef short bf16x8 __attribute__((ext_vector_type(8)));
typedef short s16x4 __attribute__((ext_vector_type(4)));
typedef float f32x16 __attribute__((ext_vector_type(16)));
typedef __attribute__((address_space(3))) unsigned char* ldsp;
constexpr int TILE_B = 8192;
constexpr int L_KB = 0, L_VB = 3 * TILE_B, L_IMP = 6 * TILE_B, L_SELM = L_IMP + 64 * 64 * 4, L_END = L_SELM + 64 * 8;
constexpr float NEGB = -1e30f;
constexpr float QSCALE = 0.125f * 1.4426950408889634f;
__device__ __forceinline__ int crow(int r, int hi) { return (r & 3) + 8 * (r >> 2) + 4 * hi; }
__device__ __forceinline__ void glds16(const void* gsrc, unsigned lds_dst) { unsigned keep;
    asm volatile("s_mov_b32 %0, m0\n\ts_mov_b32 m0, %2\n\ts_nop 0\n\tglobal_load_lds_dwordx4 %1, off\n\ts_mov_b32 m0, %0" : "=&s"(keep) : "v"(gsrc), "s"(lds_dst) : "memory"); }
__device__ __forceinline__ unsigned cvtpk(float lo, float hi) { unsigned r; asm volatile("v_cvt_pk_bf16_f32 %0, %1, %2" : "=v"(r) : "v"(lo), "v"(hi)); return r; }
__device__ __forceinline__ float halfmax(float m) { auto rr = __builtin_amdgcn_permlane32_swap(__float_as_uint(m), __float_as_uint(m), false, false); return fmaxf(__uint_as_float(rr[0]), __uint_as_float(rr[1])); }
__device__ __forceinline__ float halfsum(float m) { auto rr = __builtin_amdgcn_permlane32_swap(__float_as_uint(m), __float_as_uint(m), false, false); return __uint_as_float(rr[0]) + __uint_as_float(rr[1]); }
__device__ __forceinline__ s16x4 vtr(ldsp p) { typedef short v4i16_t __attribute__((ext_vector_type(4))); return __builtin_bit_cast(s16x4, __builtin_amdgcn_ds_read_tr16_b64_v4i16((__attribute__((address_space(3))) v4i16_t*)p)); }
#define ATT_BAR_L() asm volatile("s_waitcnt lgkmcnt(0)\n\ts_barrier" ::: "memory")
#define ATT_WAIT_BAR(N) asm volatile("s_waitcnt vmcnt(" #N ") lgkmcnt(0)\n\ts_barrier" ::: "memory")
__device__ __forceinline__ void dma_tile(const unsigned char* img, unsigned lds_dst, int wid, int lane) { unsigned keep; const unsigned voff = (unsigned)(wid * 1024 + lane * 16);
    asm volatile("s_mov_b32 %0, m0\n\ts_mov_b32 m0, %3\n\ts_nop 0\n\tglobal_load_lds_dwordx4 %1, %2\n\ts_mov_b32 m0, %0" : "=&s"(keep) : "v"(voff), "s"(img), "s"((unsigned)__builtin_amdgcn_readfirstlane(lds_dst + wid * 1024)) : "memory"); }
__device__ __forceinline__ void qk(f32x16& p0, f32x16& p1, ldsp kbuf, const bf16x8 (&qf)[4], int r32, int hi) {
    const f32x16 z = {0.f, 0.f, 0.f, 0.f, 0.f, 0.f, 0.f, 0.f, 0.f, 0.f, 0.f, 0.f, 0.f, 0.f, 0.f, 0.f};
#pragma unroll
    for (int s = 0; s < 4; ++s) {
        const bf16x8 k0 = *(const __attribute__((address_space(3))) bf16x8*)(kbuf + (2 * s + hi) * 1024 + r32 * 16);
        const bf16x8 k1 = *(const __attribute__((address_space(3))) bf16x8*)(kbuf + (2 * s + hi) * 1024 + r32 * 16 + 512);
        p0 = __builtin_amdgcn_mfma_f32_32x32x16_bf16(k0, qf[s], s == 0 ? z : p0, 0, 0, 0);
        p1 = __builtin_amdgcn_mfma_f32_32x32x16_bf16(k1, qf[s], s == 0 ? z : p1, 0, 0, 0);
    }
}
__device__ __forceinline__ void pv(f32x16 (&o)[2], ldsp vbuf, const f32x16& p0, const f32x16& p1, int lane, int hi) {
    unsigned pk[4][4];
#pragma unroll
    for (int k = 0; k < 4; ++k) { pk[0][k] = cvtpk(p0[2 * k], p0[2 * k + 1]); pk[1][k] = cvtpk(p0[8 + 2 * k], p0[9 + 2 * k]); pk[2][k] = cvtpk(p1[2 * k], p1[2 * k + 1]); pk[3][k] = cvtpk(p1[8 + 2 * k], p1[9 + 2 * k]); }
    const int vp0 = ((lane >> 4) & 1) * 32 + (lane & 3) * 8 + (4 * hi + ((lane & 15) >> 2)) * 64;
#pragma unroll
    for (int d0 = 0; d0 < 2; ++d0)
#pragma unroll
        for (int s = 0; s < 4; ++s) {
            const s16x4 lo = vtr(vbuf + d0 * 4096 + s * 1024 + vp0), hh = vtr(vbuf + d0 * 4096 + s * 1024 + 512 + vp0);
            const bf16x8 vf = (bf16x8){lo[0], lo[1], lo[2], lo[3], hh[0], hh[1], hh[2], hh[3]};
            typedef unsigned u32x4 __attribute__((ext_vector_type(4)));
            const u32x4 pw = (u32x4){pk[s][0], pk[s][1], pk[s][2], pk[s][3]};
            o[d0] = __builtin_amdgcn_mfma_f32_32x32x16_bf16(vf, __builtin_bit_cast(bf16x8, pw), o[d0], 0, 0, 0);
        }
}
struct Run { float m, l; f32x16 o[2]; };
constexpr float RESC_THR = 6.0f;
template <bool EMASK> __device__ __forceinline__ void tile_step(Run& R, ldsp kbuf, ldsp vbuf, const bf16x8 (&qf)[4], bool row_on, int lo_b_, int hi_b_, int lane, int r32, int hi) {
    int lo_b = lo_b_ - 4 * hi, hi_b = hi_b_ - 4 * hi;
    if (EMASK) asm volatile("" : "+v"(lo_b), "+v"(hi_b));
    f32x16 p0, p1; qk(p0, p1, kbuf, qf, r32, hi);
    if (EMASK) {
#pragma unroll
        for (int r = 0; r < 16; ++r) { const int kc_ = (r & 3) + 8 * (r >> 2); if (kc_ < lo_b || kc_ > hi_b) p0[r] = NEGB; if (kc_ + 32 < lo_b || kc_ + 32 > hi_b) p1[r] = NEGB; }
    }
    float rm = fmaxf(p0[0], p1[0]);
#pragma unroll
    for (int r = 1; r < 16; ++r) rm = fmaxf(rm, fmaxf(p0[r], p1[r]));
    rm = row_on ? halfmax(rm) : NEGB;
    if (__any(rm - R.m > RESC_THR)) {
        const float mn = fmaxf(R.m, rm), alpha = __builtin_amdgcn_exp2f(R.m - mn);
        R.m = mn; R.l *= alpha;
#pragma unroll
        for (int r = 0; r < 16; ++r) { R.o[0][r] *= alpha; R.o[1][r] *= alpha; }
    }
    const float meff = row_on ? R.m : 1e30f;
    float ls = 0.f;
#pragma unroll
    for (int r = 0; r < 16; ++r) { const float e0 = __builtin_amdgcn_exp2f(p0[r] - meff), e1 = __builtin_amdgcn_exp2f(p1[r] - meff); p0[r] = e0; p1[r] = e1; ls += e0 + e1; }
    R.l += ls;
    pv(R.o, vbuf, p0, p1, lane, hi);
}
struct Tensors {
    const bf16_t* qn; const bf16_t* qr;
    const unsigned char* ksel; const unsigned char* vsel; const unsigned char* kwin; const unsigned char* vwin;
    const unsigned char* kc; const unsigned char* vc;
    const float* gates; bf16_t* ob;
};
template <bool SEL> __device__ __forceinline__ void branch(Run& R, const unsigned char* kimg, const unsigned char* vimg, int t0, int t1, int jdiag, unsigned long long selm, int iq,
                                                           const bf16x8 (&qf)[4], unsigned lds0, ldsp lds, int wid, int lane, int r32, int hi) {
    R.m = NEGB; R.l = 0.f;
#pragma unroll
    for (int r = 0; r < 16; ++r) { R.o[0][r] = 0.f; R.o[1][r] = 0.f; }
    dma_tile(kimg + (size_t)t0 * TILE_B, lds0 + L_KB, wid, lane); dma_tile(vimg + (size_t)t0 * TILE_B, lds0 + L_VB, wid, lane);
    if (t0 < t1) { dma_tile(kimg + (size_t)(t0 + 1) * TILE_B, lds0 + L_KB + TILE_B, wid, lane); dma_tile(vimg + (size_t)(t0 + 1) * TILE_B, lds0 + L_VB + TILE_B, wid, lane); }
    int b = 0;
    for (int t = t0; t <= t1; ++t) {
        if (t < t1) ATT_WAIT_BAR(2); else ATT_WAIT_BAR(0);
        if (t + 2 <= t1) { const int b2 = (b >= 1) ? b - 1 : 2; dma_tile(kimg + (size_t)(t + 2) * TILE_B, lds0 + L_KB + b2 * TILE_B, wid, lane); dma_tile(vimg + (size_t)(t + 2) * TILE_B, lds0 + L_VB + b2 * TILE_B, wid, lane); }
        const bool row_on = !SEL || ((selm >> t) & 1ull);
        const bool lowm = !SEL && (t == jdiag - 8);
        if (t == jdiag || lowm) tile_step<true>(R, lds + L_KB + b * TILE_B, lds + L_VB + b * TILE_B, qf, row_on, lowm ? iq : 0, (t == jdiag) ? iq : 63, lane, r32, hi);
        else tile_step<false>(R, lds + L_KB + b * TILE_B, lds + L_VB + b * TILE_B, qf, row_on, 0, 63, lane, r32, hi);
        b = (b == 2) ? 0 : b + 1;
    }
    ATT_BAR_L();
}
__device__ __forceinline__ void load_q(bf16x8 (&qf)[4], const bf16_t* qrow, int hi) {
#pragma unroll
    for (int s = 0; s < 4; ++s) qf[s] = *(const bf16x8*)(qrow + 16 * s + 8 * hi);
}
__device__ __forceinline__ void unit(const Tensors& T, int n, int j, int g, ldsp lds, unsigned lds0, int wid, int lane) {
    const int r32 = lane & 31, hi = lane >> 5, ql = r32 >> 2, hq = r32 & 3, iq = 8 * wid + ql;
    const int row = n * SEQ + 64 * j + iq, head = g * HPG + hq, pos = 64 * j + iq;
    const size_t img_ng = ((size_t)n * N_KV + g);
    f32x16 oacc[2];
#pragma unroll
    for (int r = 0; r < 16; ++r) { oacc[0][r] = 0.f; oacc[1][r] = 0.f; }
    const float* gt = T.gates + (size_t)row * 3 * N_HEADS + head * 3;
    const float g_c = gt[0], g_s = gt[1], g_w = gt[2];
    bf16x8 qf[4];
    unsigned long long selm;
    {
        load_q(qf, T.qn + (size_t)row * HDM + head * HD, hi);
        const int ntc = (2 * j + 2 + 63) / 64;
        const unsigned char* kci = T.kc + img_ng * (NBC_P / 64) * TILE_B; const unsigned char* vci = T.vc + img_ng * (NBC_P / 64) * TILE_B;
        dma_tile(kci, lds0 + L_KB, wid, lane); dma_tile(vci, lds0 + L_VB, wid, lane);
        if (ntc > 1) { dma_tile(kci + TILE_B, lds0 + L_KB + TILE_B, wid, lane); dma_tile(vci + TILE_B, lds0 + L_VB + TILE_B, wid, lane); }
        ATT_WAIT_BAR(0);
        int cmax = ((pos + 1) >> 5) - 1 - 4 * hi;
        asm volatile("" : "+v"(cmax));
        f32x16 s0, s1, s2, s3;
        qk(s0, s1, lds + L_KB, qf, r32, hi);
        if (ntc > 1) qk(s2, s3, lds + L_KB + TILE_B, qf, r32, hi);
        else {
#pragma unroll
            for (int r = 0; r < 16; ++r) { s2[r] = NEGB; s3[r] = NEGB; }
        }
        float mx = NEGB;
#pragma unroll
        for (int r = 0; r < 16; ++r) { const int kv = (r & 3) + 8 * (r >> 2);
            if (kv > cmax) s0[r] = NEGB; if (kv + 32 > cmax) s1[r] = NEGB; if (kv + 64 > cmax) s2[r] = NEGB; if (kv + 96 > cmax) s3[r] = NEGB;
            mx = fmaxf(fmaxf(mx, fmaxf(s0[r], s1[r])), fmaxf(s2[r], s3[r])); }
        mx = halfmax(mx);
        float ls = 0.f;
#pragma unroll
        for (int r = 0; r < 16; ++r) { const int kv = (r & 3) + 8 * (r >> 2);
            s0[r] = (kv > cmax) ? 0.f : __builtin_amdgcn_exp2f(s0[r] - mx); s1[r] = (kv + 32 > cmax) ? 0.f : __builtin_amdgcn_exp2f(s1[r] - mx);
            s2[r] = (kv + 64 > cmax) ? 0.f : __builtin_amdgcn_exp2f(s2[r] - mx); s3[r] = (kv + 96 > cmax) ? 0.f : __builtin_amdgcn_exp2f(s3[r] - mx);
            ls += (s0[r] + s1[r]) + (s2[r] + s3[r]); }
        ls = halfsum(ls);
        const float inv = 1.0f / fmaxf(ls, 1e-30f);
#pragma unroll
        for (int r = 0; r < 16; ++r) { s0[r] *= inv; s1[r] *= inv; s2[r] *= inv; s3[r] *= inv; }
        __attribute__((address_space(3))) float* imp = (__attribute__((address_space(3))) float*)(lds + L_IMP) + iq * 64;
#pragma unroll
        for (int r = 0; r < 16; r += 2) { const int bl = crow(r, hi) >> 1;
            float v0 = s0[r] + s0[r + 1], v1 = s1[r] + s1[r + 1], v2 = s2[r] + s2[r + 1], v3 = s3[r] + s3[r + 1];
            v0 += __shfl_xor(v0, 1); v0 += __shfl_xor(v0, 2); v1 += __shfl_xor(v1, 1); v1 += __shfl_xor(v1, 2);
            v2 += __shfl_xor(v2, 1); v2 += __shfl_xor(v2, 2); v3 += __shfl_xor(v3, 1); v3 += __shfl_xor(v3, 2);
            if (hq == 0) { imp[bl] = v0; imp[16 + bl] = v1; imp[32 + bl] = v2; imp[48 + bl] = v3; } }
        Run Rc;
#pragma unroll
        for (int r = 0; r < 16; ++r) { Rc.o[0][r] = 0.f; Rc.o[1][r] = 0.f; }
        pv(Rc.o, lds + L_VB, s0, s1, lane, hi);
        if (ntc > 1) pv(Rc.o, lds + L_VB + TILE_B, s2, s3, lane, hi);
#pragma unroll
        for (int r = 0; r < 16; ++r) { oacc[0][r] += g_c * Rc.o[0][r]; oacc[1][r] += g_c * Rc.o[1][r]; }
        asm volatile("s_waitcnt lgkmcnt(0)" ::: "memory");
        __attribute__((address_space(3))) unsigned long long* selw = (__attribute__((address_space(3))) unsigned long long*)(lds + L_SELM);
        for (int qq = 0; qq < 8; ++qq) {
            const float v = ((__attribute__((address_space(3))) float*)(lds + L_IMP))[(8 * wid + qq) * 64 + lane];
            const bool valid = lane <= j, forced = (lane == 0) || (lane == j) || (lane == j - 1);
            const unsigned key = valid ? (forced ? 0x7f000000u : __float_as_uint(v) + 1u) : 0u;
            unsigned long long m;
            if (j + 1 <= N_SEL) m = __ballot(valid);
            else {
                unsigned Tt = 0u;
                for (int bit = 30; bit >= 0; --bit) { const unsigned cand = Tt | (1u << bit); if (__popcll(__ballot(key >= cand)) >= N_SEL) Tt = cand; }
                const unsigned long long gtm = __ballot(key > Tt), eqm = __ballot(key == Tt);
                const int need = N_SEL - __popcll(gtm);
                const bool pick = (key == Tt) && (__popcll(eqm & ((1ull << lane) - 1ull)) < need);
                m = gtm | __ballot(pick);
            }
            if (lane == 0) selw[8 * wid + qq] = m;
        }
        asm volatile("s_waitcnt lgkmcnt(0)" ::: "memory");
        selm = selw[iq];
        ATT_WAIT_BAR(0);
    }
    load_q(qf, T.qr + (size_t)row * HDM + head * HD, hi);
    {
        Run R; branch<true>(R, T.ksel + img_ng * (SEQ / 64) * TILE_B, T.vsel + img_ng * (SEQ / 64) * TILE_B, 0, j, j, selm, iq, qf, lds0, lds, wid, lane, r32, hi);
        const float sc = g_s / fmaxf(halfsum(R.l), 1e-30f);
#pragma unroll
        for (int r = 0; r < 16; ++r) { oacc[0][r] += sc * R.o[0][r]; oacc[1][r] += sc * R.o[1][r]; }
    }
    {
        Run R; branch<false>(R, T.kwin + img_ng * (SEQ / 64) * TILE_B, T.vwin + img_ng * (SEQ / 64) * TILE_B, j > 8 ? j - 8 : 0, j, j, 0ull, iq, qf, lds0, lds, wid, lane, r32, hi);
        const float sc = g_w / fmaxf(halfsum(R.l), 1e-30f);
#pragma unroll
        for (int r = 0; r < 16; ++r) { oacc[0][r] += sc * R.o[0][r]; oacc[1][r] += sc * R.o[1][r]; }
    }
    bf16_t* orow = T.ob + (size_t)row * HDM + head * HD;
#pragma unroll
    for (int d0 = 0; d0 < 2; ++d0)
#pragma unroll
        for (int rr = 0; rr < 4; ++rr) { typedef unsigned u32x2 __attribute__((ext_vector_type(2)));
            u32x2 w; w.x = cvtpk(oacc[d0][4 * rr], oacc[d0][4 * rr + 1]); w.y = cvtpk(oacc[d0][4 * rr + 2], oacc[d0][4 * rr + 3]);
            *(u32x2*)(orow + 32 * d0 + 8 * rr + 4 * hi) = w; }
}
__device__ __forceinline__ void phase(const Tensors& T, ldsp lds, int wid, int lane, int cu, int ncu) {
    const unsigned lds0 = (unsigned)(uintptr_t)lds;
    constexpr int NQB = SEQ / 64, NGRP = NQB / 4;
    for (int c = cu; c < BATCH * N_KV * NGRP; c += ncu) {
        const int ng = c / NGRP, s = c % NGRP, n = ng / N_KV, g = ng % N_KV;
        for (int k = 0; k < 4; ++k) { const int j = (k == 0) ? s : (k == 1) ? NQB / 2 - 1 - s : (k == 2) ? NQB / 2 + s : NQB - 1 - s; unit(T, n, j, g, lds, lds0, wid, lane); }
    }
}
}
namespace att {
constexpr int S_STAGE = 16384;
constexpr int S_XM = LDS_RING_C + 1024, S_XL = S_XM + 1024, S_IMP = S_XL + 1024, S_SELM = S_IMP + 8 * 128 * 4, S_END = S_SELM + 8 * 2 * 8;
struct STensors {
    const bf16_t* qn; const bf16_t* qr; const float* kc; const float* vc; const float* cache_kv; const int* page_table; const float* cache_win; const float* out; const float* winrows;
    const float* gates; bf16_t* ob;
};
typedef float f32x4_t __attribute__((ext_vector_type(4)));
__device__ __forceinline__ void stage_kv(ldsp kimg, ldsp vimg, const float* ksrc, const float* vsrc, int stride, int nrows, int lane) {
    typedef unsigned u32x4 __attribute__((ext_vector_type(4)));
    const int c = lane & 7;
#pragma unroll 1
    for (int ib = 0; ib < 8; ib += 4)
#pragma unroll
    for (int it = ib; it < ib + 4; ++it) {
        const int row = 8 * it + (lane >> 3);
        f32x4_t k0 = {0.f, 0.f, 0.f, 0.f}, k1 = k0, v0 = k0, v1 = k0;
        if (row < nrows) { const float* kp = ksrc + (size_t)row * stride + 8 * c; const float* vp = vsrc + (size_t)row * stride + 8 * c;
            k0 = *(const f32x4_t*)kp; k1 = *(const f32x4_t*)(kp + 4); v0 = *(const f32x4_t*)vp; v1 = *(const f32x4_t*)(vp + 4); }
        u32x4 kw, vw; kw.x = cvtpk(k0[0], k0[1]); kw.y = cvtpk(k0[2], k0[3]); kw.z = cvtpk(k1[0], k1[1]); kw.w = cvtpk(k1[2], k1[3]);
        vw.x = cvtpk(v0[0], v0[1]); vw.y = cvtpk(v0[2], v0[3]); vw.z = cvtpk(v1[0], v1[1]); vw.w = cvtpk(v1[2], v1[3]);
        *(__attribute__((address_space(3))) u32x4*)(kimg + c * 1024 + row * 16) = kw;
        *(__attribute__((address_space(3))) u32x4*)(vimg + (c >> 2) * 4096 + (row >> 3) * 512 + (row & 7) * 64 + (c & 3) * 16) = vw;
    }
    asm volatile("s_waitcnt lgkmcnt(0)" ::: "memory");
}
#define ATT_BAR_ALL() asm volatile("s_waitcnt vmcnt(0) lgkmcnt(0)\n\ts_barrier" ::: "memory")
__device__ __forceinline__ float merge_stats(ldsp lds, float m_own, float l_own_half, int wid, int r32, int hi) {
    __attribute__((address_space(3))) float* xm = (__attribute__((address_space(3))) float*)(lds + S_XM); __attribute__((address_space(3))) float* xl = (__attribute__((address_space(3))) float*)(lds + S_XL);
    const float l_own = halfsum(l_own_half);
    if (hi == 0) { xm[wid * 32 + r32] = m_own; xl[wid * 32 + r32] = l_own; }
    ATT_BAR_ALL();
    float M = NEGB;
#pragma unroll
    for (int w = 0; w < 8; ++w) M = fmaxf(M, xm[w * 32 + r32]);
    float L = 0.f;
#pragma unroll
    for (int w = 0; w < 8; ++w) L += __builtin_amdgcn_exp2f(xm[w * 32 + r32] - M) * xl[w * 32 + r32];
    const float wgt = __builtin_amdgcn_exp2f(m_own - M) / fmaxf(L, 1e-30f);
    ATT_BAR_ALL();
    return wgt;
}
__device__ __forceinline__ void sample_unit(const STensors& T, int b, int g, ldsp lds, int wid, int lane) {
    const int r32 = lane & 31, hi = lane >> 5, ql = r32 >> 2, hq = r32 & 3;
    const int row = MP + b * DEC_SEQ + ql, head = g * HPG + hq, seq = BATCH + b;
    ldsp kimg = lds + wid * S_STAGE, vimg = kimg + TILE_B;
    f32x16 oacc[2];
#pragma unroll
    for (int r = 0; r < 16; ++r) { oacc[0][r] = 0.f; oacc[1][r] = 0.f; }
    const float* gt = T.gates + (size_t)row * 3 * N_HEADS + head * 3;
    const float g_c = gt[0], g_s = gt[1], g_w = gt[2];
    bf16x8 qf[4];
    __attribute__((address_space(3))) float* xm = (__attribute__((address_space(3))) float*)(lds + S_XM); __attribute__((address_space(3))) float* xl = (__attribute__((address_space(3))) float*)(lds + S_XL);
    __attribute__((address_space(3))) float* imp = (__attribute__((address_space(3))) float*)(lds + S_IMP);
    __attribute__((address_space(3))) unsigned long long* selw = (__attribute__((address_space(3))) unsigned long long*)(lds + S_SELM);
    {
        load_q(qf, T.qn + (size_t)row * HDM + head * HD, hi);
        constexpr int NTC = NBC_PAST / 64;
        f32x16 p0, p1; const bool mine = wid < NTC;
        float rm = NEGB;
        if (mine) {
            const float* kcp = T.kc + (((size_t)seq * NBC_MAX + 64 * wid) * N_KV + g) * HD; const float* vcp = T.vc + (((size_t)seq * NBC_MAX + 64 * wid) * N_KV + g) * HD;
            stage_kv(kimg, vimg, kcp, vcp, N_KV * HD, 64, lane);
            qk(p0, p1, kimg, qf, r32, hi);
#pragma unroll
            for (int r = 0; r < 16; ++r) rm = fmaxf(rm, fmaxf(p0[r], p1[r]));
            rm = halfmax(rm);
        }
        if (hi == 0) xm[wid * 32 + r32] = rm;
        ATT_BAR_ALL();
        float M = NEGB;
#pragma unroll
        for (int w = 0; w < 8; ++w) M = fmaxf(M, xm[w * 32 + r32]);
        float ls = 0.f;
        if (mine) {
#pragma unroll
            for (int r = 0; r < 16; ++r) { p0[r] = __builtin_amdgcn_exp2f(p0[r] - M); p1[r] = __builtin_amdgcn_exp2f(p1[r] - M); ls += p0[r] + p1[r]; }
            ls = halfsum(ls);
        }
        if (hi == 0) xl[wid * 32 + r32] = ls;
        ATT_BAR_ALL();
        float L = 0.f;
#pragma unroll
        for (int w = 0; w < 8; ++w) L += xl[w * 32 + r32];
        const float inv = 1.0f / fmaxf(L, 1e-30f);
        if (mine) {
#pragma unroll
            for (int r = 0; r < 16; ++r) { p0[r] *= inv; p1[r] *= inv; }
#pragma unroll
            for (int r = 0; r < 16; r += 2) { const int bl = crow(r, hi) >> 1;
                float v0 = p0[r] + p0[r + 1], v1 = p1[r] + p1[r + 1];
                v0 += __shfl_xor(v0, 1); v0 += __shfl_xor(v0, 2); v1 += __shfl_xor(v1, 1); v1 += __shfl_xor(v1, 2);
                if (hq == 0) { imp[ql * 128 + 32 * wid + bl] = v0; imp[ql * 128 + 32 * wid + 16 + bl] = v1; } }
            Run Rc;
#pragma unroll
            for (int r = 0; r < 16; ++r) { Rc.o[0][r] = 0.f; Rc.o[1][r] = 0.f; }
            pv(Rc.o, vimg, p0, p1, lane, hi);
#pragma unroll
            for (int r = 0; r < 16; ++r) { oacc[0][r] += g_c * Rc.o[0][r]; oacc[1][r] += g_c * Rc.o[1][r]; }
        }
        ATT_BAR_ALL();
    }
    {
        constexpr int NCAND = NBS_S - 1;
        const float v0 = imp[wid * 128 + lane], v1 = imp[wid * 128 + 64 + lane];
        const unsigned key0 = (lane == 0) ? 0x7f000000u : __float_as_uint(v0) + 1u;
        const unsigned key1 = (lane + 64 == NCAND - 1) ? 0x7f000000u : __float_as_uint(v1) + 1u;
        unsigned Tt = 0u;
        for (int bit = 30; bit >= 0; --bit) { const unsigned cand = Tt | (1u << bit); if (__popcll(__ballot(key0 >= cand)) + __popcll(__ballot(key1 >= cand)) >= N_SEL - 1) Tt = cand; }
        const unsigned long long gt0 = __ballot(key0 > Tt), gt1 = __ballot(key1 > Tt), eq0 = __ballot(key0 == Tt), eq1 = __ballot(key1 == Tt);
        const int need = (N_SEL - 1) - __popcll(gt0) - __popcll(gt1);
        const unsigned long long below = (1ull << lane) - 1ull;
        const bool pick0 = (key0 == Tt) && (__popcll(eq0 & below) < need);
        const bool pick1 = (key1 == Tt) && (__popcll(eq0) + __popcll(eq1 & below) < need);
        const unsigned long long m0 = gt0 | __ballot(pick0), m1 = gt1 | __ballot(pick1);
        if (lane == 0) { selw[wid * 2] = m0; selw[wid * 2 + 1] = m1; }
        ATT_BAR_ALL();
    }
    load_q(qf, T.qr + (size_t)row * HDM + head * HD, hi);
    {
        unsigned long long U0 = 0ull, U1 = 0ull;
#pragma unroll
        for (int q = 0; q < 8; ++q) { U0 |= selw[q * 2]; U1 |= selw[q * 2 + 1]; }
        U0 = __builtin_amdgcn_readfirstlane((unsigned)U0) | ((unsigned long long)__builtin_amdgcn_readfirstlane((unsigned)(U0 >> 32)) << 32);
        U1 = __builtin_amdgcn_readfirstlane((unsigned)U1) | ((unsigned long long)__builtin_amdgcn_readfirstlane((unsigned)(U1 >> 32)) << 32);
        const unsigned long long my0 = selw[ql * 2], my1 = selw[ql * 2 + 1];
        Run R; R.m = NEGB; R.l = 0.f;
#pragma unroll
        for (int r = 0; r < 16; ++r) { R.o[0][r] = 0.f; R.o[1][r] = 0.f; }
        int idx = 0;
        for (int half = 0; half < 2; ++half) {
            unsigned long long U = half ? U1 : U0;
            while (U) {
                const int bit = __builtin_ctzll(U); U &= U - 1ull;
                if ((idx++ & 7) != wid) continue;
                const int blk = 64 * half + bit;
                const int page = T.page_table[b * N_PAGES + (blk * L_SEL) / PAGE_SIZE];
                const float* base = T.cache_kv + (((size_t)page * PAGE_SIZE + (blk * L_SEL) % PAGE_SIZE) * 4) * N_KV * HD + g * HD;
                stage_kv(kimg, vimg, base + 2 * N_KV * HD, base + 3 * N_KV * HD, 4 * N_KV * HD, 64, lane);
                const bool selected = ((half ? my1 : my0) >> bit) & 1ull;
                tile_step<false>(R, kimg, vimg, qf, selected, 0, 63, lane, r32, hi);
            }
        }
        if ((idx & 7) == wid) {
            const float* base = T.out + O_KVS + (((size_t)b * DEC_SEQ) * 4) * N_KV * HD + g * HD;
            stage_kv(kimg, vimg, base + 2 * N_KV * HD, base + 3 * N_KV * HD, 4 * N_KV * HD, DEC_SEQ, lane);
            tile_step<true>(R, kimg, vimg, qf, true, 0, ql, lane, r32, hi);
        }
        const float wgt = merge_stats(lds, R.m, R.l, wid, r32, hi) * g_s;
#pragma unroll
        for (int r = 0; r < 16; ++r) { oacc[0][r] += wgt * R.o[0][r]; oacc[1][r] += wgt * R.o[1][r]; }
    }
    {
        Run R; R.m = NEGB; R.l = 0.f;
#pragma unroll
        for (int r = 0; r < 16; ++r) { R.o[0][r] = 0.f; R.o[1][r] = 0.f; }
        for (int t = wid; t < WINDOW / 64; t += 8) {
            const float* base = T.cache_win + (((size_t)b * WINDOW + 64 * t) * 2) * N_KV * HD + g * HD;
            stage_kv(kimg, vimg, base, base + N_KV * HD, 2 * N_KV * HD, 64, lane);
            if (t == 0) tile_step<true>(R, kimg, vimg, qf, true, ql, 63, lane, r32, hi); else tile_step<false>(R, kimg, vimg, qf, true, 0, 63, lane, r32, hi);
        }
        if (wid == 0) {
            const float* base = T.winrows + (((size_t)(MP + b * DEC_SEQ)) * 2) * N_KV * HD + g * HD;
            stage_kv(kimg, vimg, base, base + N_KV * HD, 2 * N_KV * HD, DEC_SEQ, lane);
            tile_step<true>(R, kimg, vimg, qf, true, 0, ql, lane, r32, hi);
        }
        const float wgt = merge_stats(lds, R.m, R.l, wid, r32, hi) * g_w;
#pragma unroll
        for (int r = 0; r < 16; ++r) { oacc[0][r] += wgt * R.o[0][r]; oacc[1][r] += wgt * R.o[1][r]; }
    }
    {
        const int lane2 = (int)lane_id_v(), r32 = lane2 & 31, hi = lane2 >> 5;
        __attribute__((address_space(3))) float* mine = (__attribute__((address_space(3))) float*)(lds + wid * S_STAGE);
#pragma unroll
        for (int d0 = 0; d0 < 2; ++d0)
#pragma unroll
            for (int rr = 0; rr < 4; ++rr) *(__attribute__((address_space(3))) f32x4_t*)(mine + r32 * 64 + 32 * d0 + 8 * rr + 4 * hi) = (f32x4_t){oacc[d0][4 * rr], oacc[d0][4 * rr + 1], oacc[d0][4 * rr + 2], oacc[d0][4 * rr + 3]};
        ATT_BAR_ALL();
        const int tid = wid * 64 + (int)lane_id_v(), orow = tid >> 4, oc4 = (tid & 15) * 4;
        f32x4_t s = {0.f, 0.f, 0.f, 0.f};
#pragma unroll
        for (int w = 0; w < 8; ++w) s += *(const __attribute__((address_space(3))) f32x4_t*)((__attribute__((address_space(3))) float*)(lds + w * S_STAGE) + orow * 64 + oc4);
        typedef unsigned u32x2 __attribute__((ext_vector_type(2)));
        u32x2 wv; wv.x = cvtpk(s[0], s[1]); wv.y = cvtpk(s[2], s[3]);
        const int oq = orow >> 2, oh = orow & 3;
        *(u32x2*)(T.ob + (size_t)(MP + b * DEC_SEQ + oq) * HDM + (g * HPG + oh) * HD + oc4) = wv;
        ATT_BAR_ALL();
    }
}
__device__ __forceinline__ void sample_phase(const STensors& T, ldsp lds, int wid, int lane, int cu, int ncu) {
    for (int c = cu; c < DEC_BATCH * N_KV; c += ncu) sample_unit(T, c / N_KV, c % N_KV, lds, wid, lane);
}
}


namespace att {
__device__ __forceinline__ void cmp_out_wave(int task, const bf16_t* hid, int R, int nbc, int seq0, const bf16_t* w2t, const float* k_norm0, float* kc, float* vc, unsigned char* kci, unsigned char* vci, int lane) {
    const int r32 = lane & 31, hi = lane >> 5;
    const int r0 = task * 32, e = r0 >= R ? 1 : 0, r = r0 - e * R + r32;
    const bf16_t* hrow = hid + ((size_t)e * R + r) * CMP_HID; const bf16_t* wrow = w2t + ((size_t)e * HD + r32) * CMP_HID;
    f32x16 o0, o1;
#pragma unroll
    for (int k = 0; k < 16; ++k) { o0[k] = 0.f; o1[k] = 0.f; }
#pragma unroll 4
    for (int s_ = 0; s_ < CMP_HID / 16; ++s_) {
        const bf16x8 hb_ = *(const bf16x8*)(hrow + 16 * s_ + 8 * hi);
        const bf16x8 w0 = *(const bf16x8*)(wrow + 16 * s_ + 8 * hi), w1 = *(const bf16x8*)(wrow + (size_t)32 * CMP_HID + 16 * s_ + 8 * hi);
        o0 = __builtin_amdgcn_mfma_f32_32x32x16_bf16(w0, hb_, o0, 0, 0, 0); o1 = __builtin_amdgcn_mfma_f32_32x32x16_bf16(w1, hb_, o1, 0, 0, 0);
    }
    if (e == 0) {
        float ss = 0.f;
#pragma unroll
        for (int k = 0; k < 16; ++k) ss += o0[k] * o0[k] + o1[k] * o1[k];
        ss = halfsum(ss);
        const float rn = rsqrtf(ss * (1.0f / HD) + EPS);
#pragma unroll
        for (int k = 0; k < 16; ++k) { o0[k] *= rn * k_norm0[crow(k, hi)]; o1[k] *= rn * k_norm0[32 + crow(k, hi)]; }
    }
    const int g = r % N_KV, c = (r / N_KV) % nbc, sq = r / (N_KV * nbc);
    float* dst = (e == 0 ? kc : vc) + (((size_t)(seq0 + sq) * NBC_MAX + c) * N_KV + g) * HD;
#pragma unroll
    for (int rr = 0; rr < 4; ++rr) { *(f32x4_t*)(dst + 8 * rr + 4 * hi) = (f32x4_t){o0[4 * rr], o0[4 * rr + 1], o0[4 * rr + 2], o0[4 * rr + 3]};
                                      *(f32x4_t*)(dst + 32 + 8 * rr + 4 * hi) = (f32x4_t){o1[4 * rr], o1[4 * rr + 1], o1[4 * rr + 2], o1[4 * rr + 3]}; }
    if (kci) {
        unsigned char* img = (e == 0 ? kci : vci) + (((size_t)sq * N_KV + g) * (NBC_P / 64) + c / 64) * 8192; const int kv = c % 64;
        typedef unsigned u32x2 __attribute__((ext_vector_type(2)));
#pragma unroll
        for (int rr = 0; rr < 4; ++rr) {
            u32x2 a; a.x = cvtpk(o0[4 * rr], o0[4 * rr + 1]); a.y = cvtpk(o0[4 * rr + 2], o0[4 * rr + 3]);
            u32x2 bq; bq.x = cvtpk(o1[4 * rr], o1[4 * rr + 1]); bq.y = cvtpk(o1[4 * rr + 2], o1[4 * rr + 3]);
            const int d0 = 8 * rr, d1 = 32 + 8 * rr;
            *(u32x2*)(img + (e == 0 ? kimg_off(kv, d0) : vimg_off(kv, d0)) + 8 * hi) = a;
            *(u32x2*)(img + (e == 0 ? kimg_off(kv, d1) : vimg_off(kv, d1)) + 8 * hi) = bq;
        }
    }
}
}
__device__ __forceinline__ void conv_thin_vec_item(size_t i_, const bf16_t* ub, const bf16_t* bb, const float* state, const float* wc, bf16_t* zb) {
    typedef unsigned u4 __attribute__((ext_vector_type(4)));
    const int m = (int)(i_ / (D_MODEL / 8)), ch = (int)(i_ % (D_MODEL / 8)) * 8;
    const RowInfo ri = row_info(m);
    const size_t o = (size_t)m * D_MODEL + ch;
    float u0[8], u1[8], u2[8], bv[8];
#define UNPK(w, f) do { f[0] = bf2f((bf16_t)((w).x & 0xffff)); f[1] = bf2f((bf16_t)((w).x >> 16)); f[2] = bf2f((bf16_t)((w).y & 0xffff)); f[3] = bf2f((bf16_t)((w).y >> 16)); \
                        f[4] = bf2f((bf16_t)((w).z & 0xffff)); f[5] = bf2f((bf16_t)((w).z >> 16)); f[6] = bf2f((bf16_t)((w).w & 0xffff)); f[7] = bf2f((bf16_t)((w).w >> 16)); } while (0)
    { const u4 w = *(const u4*)(ub + o); UNPK(w, u0); } { const u4 w = *(const u4*)(bb + o); UNPK(w, bv); }
    const float* st = (ri.seq >= BATCH) ? state + (size_t)(ri.seq - BATCH) * 2 * D_MODEL + ch : nullptr;
    if (ri.t >= 1) { const u4 w = *(const u4*)(ub + o - D_MODEL); UNPK(w, u1); } else { for (int k = 0; k < 8; ++k) u1[k] = st ? st[D_MODEL + k] : 0.f; }
    if (ri.t >= 2) { const u4 w = *(const u4*)(ub + o - 2 * D_MODEL); UNPK(w, u2); } else { for (int k = 0; k < 8; ++k) u2[k] = st ? (ri.t == 1 ? st[D_MODEL + k] : st[k]) : 0.f; }
#undef UNPK
    float z[8];
    for (int k = 0; k < 8; ++k) z[k] = bv[k] * (wc[ch + k] * u2[k] + wc[D_MODEL + ch + k] * u1[k] + wc[2 * D_MODEL + ch + k] * u0[k]);
    u4 w; w.x = (unsigned)f2bf(z[0]) | ((unsigned)f2bf(z[1]) << 16); w.y = (unsigned)f2bf(z[2]) | ((unsigned)f2bf(z[3]) << 16);
    w.z = (unsigned)f2bf(z[4]) | ((unsigned)f2bf(z[5]) << 16); w.w = (unsigned)f2bf(z[6]) | ((unsigned)f2bf(z[7]) << 16);
    *(u4*)(zb + o) = w;
}

namespace att {
__device__ __forceinline__ void skinny_task(int task, const bf16_t* A, const bf16_t* Bt, int N, int K, int KS, float* part, int lane) {
    const int r32 = lane & 31, hi = lane >> 5, ncb = N / 32, nrb = MS / 32;
    const int ks = task / (nrb * ncb), rem = task % (nrb * ncb), rb = rem / ncb, cb = rem % ncb, klen = K / KS, k0 = ks * klen;
    const bf16_t* ap = A + (size_t)(rb * 32 + r32) * K + k0 + 8 * hi; const bf16_t* bp = Bt + (size_t)(cb * 32 + r32) * K + k0 + 8 * hi;
    f32x16 acc;
#pragma unroll
    for (int k = 0; k < 16; ++k) acc[k] = 0.f;
#pragma unroll 8
    for (int s_ = 0; s_ < klen / 16; ++s_) acc = __builtin_amdgcn_mfma_f32_32x32x16_bf16(*(const bf16x8*)(bp + 16 * s_), *(const bf16x8*)(ap + 16 * s_), acc, 0, 0, 0);
    float* dst = part + ((size_t)ks * MS + rb * 32 + r32) * N + cb * 32 + 4 * hi;
#pragma unroll
    for (int rr = 0; rr < 4; ++rr) *(f32x4_t*)(dst + 8 * rr) = (f32x4_t){acc[4 * rr], acc[4 * rr + 1], acc[4 * rr + 2], acc[4 * rr + 3]};
}
__device__ __forceinline__ void resid_reduce_row(int rs_, const float* part, int KS, float coef, float* h, bf16_t* hb, float* rss_next, float* yout, int lane) {
    typedef unsigned u2 __attribute__((ext_vector_type(2)));
    const int m = MP + rs_; float ssq = 0.f;
#pragma unroll
    for (int j = 0; j < D_MODEL / 256; ++j) {
        const int col = 256 * j + 4 * lane; f32x4_t a = {0.f, 0.f, 0.f, 0.f};
        for (int ks = 0; ks < KS; ++ks) a += *(const f32x4_t*)(part + ((size_t)ks * MS + rs_) * D_MODEL + col);
        const f32x4_t v = *(const f32x4_t*)(h + (size_t)m * D_MODEL + col) + a * coef;
        if (yout) *(f32x4_t*)(yout + (size_t)m * D_MODEL + col) = v;
        else { *(f32x4_t*)(h + (size_t)m * D_MODEL + col) = v; u2 w; w.x = cvtpk(v[0], v[1]); w.y = cvtpk(v[2], v[3]); *(u2*)(hb + (size_t)m * D_MODEL + col) = w;
               ssq += (v[0] * v[0] + v[1] * v[1]) + (v[2] * v[2] + v[3] * v[3]); }
    }
    if (!yout) {
#pragma unroll
        for (int o = 1; o < 64; o <<= 1) ssq += __shfl_xor(ssq, o);
        if (lane == 0) rss_next[m] = ssq;
    }
}
}
__device__ __forceinline__ void conv_thin_sample_item(size_t i_, const float* part, int KS, const float* rss, const float* state, const float* wc, bf16_t* zb, float* out, int layer) {
    const int rs_ = (int)(i_ / (D_MODEL / 8)), ch = (int)(i_ % (D_MODEL / 8)) * 8, m = MP + rs_;
    const RowInfo ri = row_info(m);
    const int nc = (ch / 128) * 256 + (ch % 128);
    float u[3][8], bv[8];
    for (int back = 0; back < 3; ++back) {
        if (ri.t - back >= 0) {
            const int r2 = rs_ - back; const float rsn = rsqrtf(rss[MP + r2] * (1.0f / D_MODEL) + EPS);
            for (int k = 0; k < 8; ++k) { float c = 0.f, x = 0.f; for (int ks = 0; ks < KS; ++ks) { const float* p = part + ((size_t)ks * MS + r2) * 3 * D_MODEL; c += p[nc + k]; x += p[nc + 128 + k]; } u[back][k] = (c * rsn) * (x * rsn); }
        } else { const float* st = state + (size_t)(ri.seq - BATCH) * 2 * D_MODEL + ch;
            const int srow = 2 - (back - ri.t); for (int k = 0; k < 8; ++k) u[back][k] = st[(size_t)srow * D_MODEL + k]; }
    }
    { const float rsn = rsqrtf(rss[m] * (1.0f / D_MODEL) + EPS);
      for (int k = 0; k < 8; ++k) { float b = 0.f; for (int ks = 0; ks < KS; ++ks) b += part[((size_t)ks * MS + rs_) * 3 * D_MODEL + 2 * D_MODEL + ch + k]; bv[k] = b * rsn; } }
    for (int k = 0; k < 8; ++k) { const float ub0 = bf2f(f2bf(u[0][k])), ub1 = (ri.t >= 1) ? bf2f(f2bf(u[1][k])) : u[1][k], ub2 = (ri.t >= 2) ? bf2f(f2bf(u[2][k])) : u[2][k];
        zb[(size_t)m * D_MODEL + ch + k] = f2bf(bf2f(f2bf(bv[k])) * (wc[ch + k] * ub2 + wc[D_MODEL + ch + k] * ub1 + wc[2 * D_MODEL + ch + k] * ub0));
        if (ri.t >= DEC_SEQ - 2) out[O_CS + (((size_t)layer * DEC_BATCH + (ri.seq - BATCH)) * 2 + (ri.t - (DEC_SEQ - 2))) * D_MODEL + ch + k] = u[0][k]; }
}

__device__ __forceinline__ void acmp_sample_wave(int task, const float* cache_kv, const int* page_table, const float* pe, bf16_t* A, int lane) {
    typedef float f4 __attribute__((ext_vector_type(4))); typedef unsigned u4 __attribute__((ext_vector_type(4)));
    const int b = task / NBC_PAST, c = task % NBC_PAST, tok0 = c * L_CMP;
    const int page = page_table[b * N_PAGES + tok0 / PAGE_SIZE];
    const int e = lane >> 5, g = (lane >> 3) & (N_KV - 1), c8 = lane & 7;
    const float* src = cache_kv + ((size_t)page * PAGE_SIZE + tok0 % PAGE_SIZE) * 4 * N_KV * HD + lane * 8;
    const float* pp = pe + (size_t)e * L_CMP * HD + 8 * c8;
    bf16_t* dst = A + ((size_t)e * RS_CMP + ((size_t)b * NBC_PAST + c) * N_KV + g) * (L_CMP * HD) + 8 * c8;
#pragma unroll 8
    for (int l = 0; l < L_CMP; ++l) {
        const f4 a0 = __builtin_nontemporal_load((const f4*)(src + (size_t)l * 4 * N_KV * HD)) + *(const f4*)(pp + l * HD), a1 = __builtin_nontemporal_load((const f4*)(src + (size_t)l * 4 * N_KV * HD + 4)) + *(const f4*)(pp + l * HD + 4);
        u4 w; w.x = att::cvtpk(a0[0], a0[1]); w.y = att::cvtpk(a0[2], a0[3]); w.z = att::cvtpk(a1[0], a1[1]); w.w = att::cvtpk(a1[2], a1[3]);
        *(u4*)(dst + l * HD) = w;
    }
}
__device__ __forceinline__ void wconv_tile(int item, const float* src, int Nsrc, const float* gain, bf16_t* dst, int Nd, int K, int kind, int aux, LAS float* scr, int lane) {
    const int nblk = Nd / 32, kb = item / nblk, nb = item % nblk, k0 = 64 * kb, n0 = 32 * nb;
    const int colbase = colmap(kind, n0, aux);
    const int col = colbase + (lane & 31); const bool ok = colbase >= 0 && col < Nsrc;
    float tv[32];
    const float* sp0 = src + (size_t)(k0 + (lane >> 5)) * Nsrc + (ok ? col : 0);
#pragma unroll
    for (int i = 0; i < 32; ++i) tv[i] = ok ? __builtin_nontemporal_load(sp0 + (size_t)(2 * i) * Nsrc) : 0.f;
#pragma unroll
    for (int i = 0; i < 32; ++i) { const int kk = 2 * i + (lane >> 5); const float g = gain ? gain[k0 + kk] : 1.f; scr[kk * 33 + (lane & 31)] = tv[i] * g; }
    asm volatile("s_waitcnt lgkmcnt(0)" ::: "memory");
    const int c = lane & 7;
#pragma unroll
    for (int j = 0; j < 4; ++j) { const int n = (lane >> 3) + 8 * j; const LAS float* sp = scr + (8 * c) * 33 + n;
        typedef unsigned v4u __attribute__((ext_vector_type(4)));
        v4u o; o.x = pg8::cvt_pk_bf16(sp[0 * 33], sp[1 * 33]); o.y = pg8::cvt_pk_bf16(sp[2 * 33], sp[3 * 33]); o.z = pg8::cvt_pk_bf16(sp[4 * 33], sp[5 * 33]); o.w = pg8::cvt_pk_bf16(sp[6 * 33], sp[7 * 33]);
        *(v4u*)(dst + (size_t)(n0 + n) * K + k0 + 8 * c) = o; }
    asm volatile("s_waitcnt lgkmcnt(0)" ::: "memory");
}
__device__ __forceinline__ void hinit_row(int m, const float* xp, const float* xs, float* h, bf16_t* hb, float* rss0, int lane) {
    typedef float f4 __attribute__((ext_vector_type(4))); typedef unsigned u2 __attribute__((ext_vector_type(2)));
    const float* x = m < MP ? xp + (size_t)m * D_MODEL : xs + (size_t)(m - MP) * D_MODEL;
    float s = 0.f;
#pragma unroll
    for (int j = 0; j < D_MODEL / 256; ++j) { const f4 v = *(const f4*)(x + 256 * j + 4 * lane); s += (v[0] * v[0] + v[1] * v[1]) + (v[2] * v[2] + v[3] * v[3]);
        *(f4*)(h + (size_t)m * D_MODEL + 256 * j + 4 * lane) = v; u2 w; w.x = pg8::cvt_pk_bf16(v[0], v[1]); w.y = pg8::cvt_pk_bf16(v[2], v[3]); *(u2*)(hb + (size_t)m * D_MODEL + 256 * j + 4 * lane) = w; }
#pragma unroll
    for (int o = 1; o < 64; o <<= 1) s += __shfl_xor(s, o);
    if (lane == 0) rss0[m] = s;
}
#endif

#ifndef CPU_TEST
__device__ __forceinline__ size_t opaque_gtid(int wave) { int w = wave; asm volatile("" : "+s"(w)); unsigned t = blockIdx.x * NTHREADS + w * 64 + lane_id_v(); return (size_t)t; }
#define ITEM_LOOP(total) for (size_t i = opaque_gtid(wave_id); i < (size_t)(total); i += (size_t)gridDim.x * NTHREADS)
#else
#define ITEM_LOOP(total) _Pragma("omp parallel for schedule(dynamic, 64)") for (long long i = 0; i < (long long)(total); ++i)
#endif

struct Params {
    const float *x_prompt, *x_sample, *cache_kv, *cache_win, *state_conv; const int* page_table;
    const float *ffn_a_norm, *ffn_a_w_in, *ffn_a_w_out, *mix_norm, *ffn_b_norm, *ffn_b_w_in, *ffn_b_w_out, *conv_w_in, *conv_w, *conv_w_out, *kv_norm, *w_kv, *k_norm,
                *cmp_pe, *cmp_w1, *cmp_w2, *nsa_w_qg, *nsa_q_norm, *nsa_w_o;
    float* out; unsigned char* ws;
};
constexpr int LDS_RING = 131072, LDS_BAR_OFF = LDS_RING + 352, LDS_BYTES = 147456;

#ifndef CPU_TEST
typedef const __attribute__((address_space(4))) Params* KParamsPtr;
__device__ __forceinline__ KParamsPtr kparams_ptr() {
#if defined(__HIP_DEVICE_COMPILE__)
    KParamsPtr p = (KParamsPtr)__builtin_amdgcn_kernarg_segment_ptr(); asm volatile("" : "+s"(p)); return p;
#else
    return nullptr;
#endif
}
__device__ __forceinline__ Params load_params() {
#if defined(__HIP_DEVICE_COMPILE__)
    return *kparams_ptr();
#else
    return Params{};
#endif
}
__device__ __forceinline__ unsigned char* load_ws() {
#if defined(__HIP_DEVICE_COMPILE__)
    return kparams_ptr()->ws;
#else
    return nullptr;
#endif
}
#define KP const Params P = load_params()
__device__ __forceinline__ int opaque_s(int v) { asm volatile("" : "+s"(v)); return v; }
#define GRID_SYNC() do { XcdBarrier bar_; bar_.bar = (GU*)load_ws() + 1024; bar_.x = 0; bar_.st = (volatile LAS unsigned*)(lds + LDS_BAR_OFF); xcd_barrier(bar_, wave_id == 0 && lane_id_v() == 0u); } while (0)
__global__ void __launch_bounds__(NTHREADS, 2) mega(Params P_unused)
#else
static Params g_params;
#define KP const Params& P = g_params
#define GRID_SYNC() do {} while (0)
void mega(Params P_unused)
#endif
{
#ifndef CPU_TEST
    extern __shared__ __attribute__((aligned(16))) unsigned char lds[];
    const int wave_id = __builtin_amdgcn_readfirstlane((int)(threadIdx.x >> 6));
    if (threadIdx.x < 4) ((LAS unsigned*)(lds + LDS_BAR_OFF))[threadIdx.x] = 0u;
    __syncthreads();
    (void)xcd_barrier_post((GU*)load_ws() + 1024, (volatile LAS unsigned*)(lds + LDS_BAR_OFF), threadIdx.x == 0);
#define RING ((PG8_LAS unsigned char*)lds)
#else
    g_params = P_unused;
#endif
#define WS_F(f) ((float*)(P.ws + WSM.f))
#define WS_B(f) ((bf16_t*)(P.ws + WSM.f))
#define KVSRC KvSrc{P.cache_kv, P.page_table, P.out}
#define PH(total, call) do { { KP; ITEM_LOOP(total) call; } GRID_SYNC(); } while (0)
#ifdef CPU_TEST
    for (int L = 0; L < DEPTH; ++L) {
        KP;
        ITEM_LOOP((size_t)2 * D_FF * (D_MODEL / 64)) wconv_item(i, P.ffn_a_w_in + (size_t)L * D_MODEL * 2 * D_FF, 2 * D_FF, P.ffn_a_norm + (size_t)L * D_MODEL, WS_B(w_ain) + (size_t)L * 2 * D_FF * D_MODEL, 2 * D_FF, D_MODEL, CM_PAIR, D_FF);
        ITEM_LOOP((size_t)D_MODEL * (D_FF / 64)) wconv_item(i, P.ffn_a_w_out + (size_t)L * D_FF * D_MODEL, D_MODEL, nullptr, WS_B(w_aout) + (size_t)L * D_MODEL * D_FF, D_MODEL, D_FF, CM_PLAIN, 0);
        ITEM_LOOP((size_t)2 * D_FF * (D_MODEL / 64)) wconv_item(i, P.ffn_b_w_in + (size_t)L * D_MODEL * 2 * D_FF, 2 * D_FF, P.ffn_b_norm + (size_t)L * D_MODEL, WS_B(w_bin) + (size_t)L * 2 * D_FF * D_MODEL, 2 * D_FF, D_MODEL, CM_PAIR, D_FF);
        ITEM_LOOP((size_t)D_MODEL * (D_FF / 64)) wconv_item(i, P.ffn_b_w_out + (size_t)L * D_FF * D_MODEL, D_MODEL, nullptr, WS_B(w_bout) + (size_t)L * D_MODEL * D_FF, D_MODEL, D_FF, CM_PLAIN, 0);
    }
    for (int L = 0; L < N_A; ++L) {
        KP;
        ITEM_LOOP((size_t)3 * D_MODEL * (D_MODEL / 64)) wconv_item(i, P.conv_w_in + (size_t)L * D_MODEL * 3 * D_MODEL, 3 * D_MODEL, P.mix_norm + (size_t)L * D_MODEL, WS_B(w_cin) + (size_t)L * 3 * D_MODEL * D_MODEL, 3 * D_MODEL, D_MODEL, CM_CONV, 0);
        ITEM_LOOP((size_t)D_MODEL * (D_MODEL / 64)) wconv_item(i, P.conv_w_out + (size_t)L * D_MODEL * D_MODEL, D_MODEL, nullptr, WS_B(w_cout) + (size_t)L * D_MODEL * D_MODEL, D_MODEL, D_MODEL, CM_PLAIN, 0);
    }
    for (int b = 0; b < N_B; ++b) {
        KP;
        ITEM_LOOP((size_t)QGP * (D_MODEL / 64)) wconv_item(i, P.nsa_w_qg + (size_t)b * D_MODEL * QGW, QGW, P.mix_norm + (size_t)(N_A + b) * D_MODEL, WS_B(w_qg) + (size_t)b * QGP * D_MODEL, QGP, D_MODEL, CM_HEADS, N_HEADS);
        ITEM_LOOP((size_t)D_MODEL * (HDM / 64)) wconv_item(i, P.nsa_w_o + (size_t)b * HDM * D_MODEL, D_MODEL, nullptr, WS_B(w_o) + (size_t)b * D_MODEL * HDM, D_MODEL, HDM, CM_PLAIN, 0);
    }
    { KP; ITEM_LOOP((size_t)KVW * (D_MODEL / 64)) wconv_item(i, P.w_kv, KVW, P.kv_norm, WS_B(w_kv), KVW, D_MODEL, CM_HEADS, 6 * N_KV); }
    { KP; ITEM_LOOP((size_t)NPOS * 8) rope_item(i, WS_F(rope)); }
    { KP; ITEM_LOOP(MT) hinit_item(i, P.x_prompt, P.x_sample, WS_F(h), WS_B(hb), WS_F(rss)); }
#else
#define WAVE_ITEMS(total) for (int it_ = (int)(opaque_s((int)blockIdx.x) * 8 + wave_id); it_ < (int)(total); it_ += (int)gridDim.x * 8)
#define WCONV(srcp, Nsrc_, gainp, dstp, Nd_, K_, kind_, aux_) do { KP; LAS float* scr_ = (LAS float*)(lds + wave_id * 16384); const int lane_ = (int)lane_id_v(); \
        WAVE_ITEMS(((Nd_) / 32) * ((K_) / 64)) wconv_tile(it_, srcp, Nsrc_, gainp, dstp, Nd_, K_, kind_, aux_, scr_, lane_); } while (0)
    for (int L = 0; L < DEPTH; ++L) {
        WCONV(P.ffn_a_w_in + (size_t)L * D_MODEL * 2 * D_FF, 2 * D_FF, P.ffn_a_norm + (size_t)L * D_MODEL, WS_B(w_ain) + (size_t)L * 2 * D_FF * D_MODEL, 2 * D_FF, D_MODEL, CM_PAIR, D_FF);
        WCONV(P.ffn_a_w_out + (size_t)L * D_FF * D_MODEL, D_MODEL, nullptr, WS_B(w_aout) + (size_t)L * D_MODEL * D_FF, D_MODEL, D_FF, CM_PLAIN, 0);
        WCONV(P.ffn_b_w_in + (size_t)L * D_MODEL * 2 * D_FF, 2 * D_FF, P.ffn_b_norm + (size_t)L * D_MODEL, WS_B(w_bin) + (size_t)L * 2 * D_FF * D_MODEL, 2 * D_FF, D_MODEL, CM_PAIR, D_FF);
        WCONV(P.ffn_b_w_out + (size_t)L * D_FF * D_MODEL, D_MODEL, nullptr, WS_B(w_bout) + (size_t)L * D_MODEL * D_FF, D_MODEL, D_FF, CM_PLAIN, 0);
    }
    for (int L = 0; L < N_A; ++L) {
        WCONV(P.conv_w_in + (size_t)L * D_MODEL * 3 * D_MODEL, 3 * D_MODEL, P.mix_norm + (size_t)L * D_MODEL, WS_B(w_cin) + (size_t)L * 3 * D_MODEL * D_MODEL, 3 * D_MODEL, D_MODEL, CM_CONV, 0);
        WCONV(P.conv_w_out + (size_t)L * D_MODEL * D_MODEL, D_MODEL, nullptr, WS_B(w_cout) + (size_t)L * D_MODEL * D_MODEL, D_MODEL, D_MODEL, CM_PLAIN, 0);
    }
    for (int b = 0; b < N_B; ++b) {
        WCONV(P.nsa_w_qg + (size_t)b * D_MODEL * QGW, QGW, P.mix_norm + (size_t)(N_A + b) * D_MODEL, WS_B(w_qg) + (size_t)b * QGP * D_MODEL, QGP, D_MODEL, CM_HEADS, N_HEADS);
        WCONV(P.nsa_w_o + (size_t)b * HDM * D_MODEL, D_MODEL, nullptr, WS_B(w_o) + (size_t)b * D_MODEL * HDM, D_MODEL, HDM, CM_PLAIN, 0);
    }
    WCONV(P.w_kv, KVW, P.kv_norm, WS_B(w_kv), KVW, D_MODEL, CM_HEADS, 6 * N_KV);
    { KP; ITEM_LOOP((size_t)NPOS * 8) rope_item(i, WS_F(rope)); }
    { KP; const int lane_ = (int)lane_id_v(); WAVE_ITEMS(MT) hinit_row(it_, P.x_prompt, P.x_sample, WS_F(h), WS_B(hb), WS_F(rss), lane_); }
#endif
#ifndef CPU_TEST
    for (int e = 0; e < 2; ++e) WCONV(P.cmp_w1 + (size_t)e * L_CMP * HD * CMP_HID, CMP_HID, nullptr, WS_B(w1t) + (size_t)e * CMP_HID * L_CMP * HD, CMP_HID, L_CMP * HD, CM_PLAIN, 0);
    for (int e = 0; e < 2; ++e) WCONV(P.cmp_w2 + (size_t)e * CMP_HID * HD, HD, nullptr, WS_B(w2t) + (size_t)e * HD * CMP_HID, HD, CMP_HID, CM_PLAIN, 0);
    { KP; const int lane_ = (int)lane_id_v(); static_assert(N_KV == 4 && 2 * N_KV * 8 == 64, "acmp_sample_wave lane map"); WAVE_ITEMS(DEC_BATCH * NBC_PAST) acmp_sample_wave(it_, P.cache_kv, P.page_table, P.cmp_pe, WS_B(acs), lane_); }
#endif
    GRID_SYNC();
#ifndef CPU_TEST
    { KP; pg8::Gemm g{WS_B(acs), WS_B(w1t), 2 * RS_CMP, 2 * CMP_HID, L_CMP * HD}; pg8::CmpOrder So{2 * RS_CMP / 256, RS_CMP / 256, opaque_s((int)gridDim.x), opaque_s((int)blockIdx.x)};
      pg8::EpiGelu E{WS_B(hids)}; pg8::gemm_phase<pg8::EpiGelu, pg8::CmpOrder, true, true>(wave_id, RING, g, So, E); }
    GRID_SYNC();
    { KP; const int lane_ = (int)lane_id_v(); WAVE_ITEMS(2 * RS_CMP / 32) att::cmp_out_wave(it_, WS_B(hids), RS_CMP, NBC_PAST, BATCH, WS_B(w2t), P.k_norm, WS_F(kc), WS_F(vc), nullptr, nullptr, lane_); }
    GRID_SYNC();
#endif

#ifndef CPU_TEST
#define RESID_PH(Aptr, Btptr, Kk, KSn, v_out, coef_, last_) do { \
        { KP; const int lane_ = (int)lane_id_v(); WAVE_ITEMS((MS / 32) * (D_MODEL / 32) * (KSn)) att::skinny_task(it_, (Aptr) + (size_t)MP * (Kk), Btptr, D_MODEL, Kk, KSn, WS_F(part), lane_); } \
        { KP; pg8::Gemm g{Aptr, Btptr, MP, D_MODEL, Kk}; pg8::StaticOrder So; So.init(MP, D_MODEL, opaque_s((int)gridDim.x), opaque_s((int)blockIdx.x)); \
          pg8::EpiResid E{WS_F(h), WS_B(hb), WS_F(rss) + (size_t)(v_out) * MT, (last_) ? P.out + O_YP : nullptr, coef_}; pg8::gemm_phase<pg8::EpiResid, pg8::StaticOrder, true, true>(wave_id, RING, g, So, E); } \
        GRID_SYNC(); \
        { KP; const int lane_ = (int)lane_id_v(); WAVE_ITEMS(MS) att::resid_reduce_row(it_, WS_F(part), KSn, coef_, WS_F(h), WS_B(hb), WS_F(rss) + (size_t)(v_out) * MT, (last_) ? P.out + O_YP : nullptr, lane_); } \
        GRID_SYNC(); } while (0)
#define FFN_OPT(wi, wo, v_in, last) do { \
        { KP; pg8::Gemm g{WS_B(hb), WS_B(wi) + (size_t)layer * 2 * D_FF * D_MODEL, MT, 2 * D_FF, D_MODEL}; pg8::StaticOrder So; So.init(MT, 2 * D_FF, opaque_s((int)gridDim.x), opaque_s((int)blockIdx.x)); \
          pg8::EpiSwiglu E{WS_B(act), WS_F(rss) + (size_t)(v_in) * MT}; pg8::gemm_phase<pg8::EpiSwiglu, pg8::StaticOrder, true, true>(wave_id, RING, g, So, E); } \
        GRID_SYNC(); \
        RESID_PH(WS_B(act), WS_B(wo) + (size_t)layer * D_MODEL * D_FF, D_FF, 8, (v_in) + 1, 0.5f, last); } while (0)
#else
#define FFN_OPT(wi, wo, v_in, last) do { KP; \
        ITEM_LOOP((size_t)MT * D_FF) ref_ffn_in_item(i, WS_B(hb), WS_F(rss) + (size_t)(v_in) * MT, WS_B(wi) + (size_t)layer * 2 * D_FF * D_MODEL, WS_B(act)); \
        ITEM_LOOP(MT) ref_resid_row_item(i, WS_B(act), D_FF, WS_B(wo) + (size_t)layer * D_MODEL * D_FF, 0.5f, WS_F(h), WS_B(hb), WS_F(rss) + (size_t)((v_in) + 1) * MT, (last) ? P.out + O_YP : nullptr); } while (0)
#endif
#ifndef CPU_TEST
#define GEMM_PH(EpiT, Aptr, Btptr, Nn, Kk, ...) do { { KP; pg8::Gemm g{Aptr, Btptr, MT, Nn, Kk}; pg8::StaticOrder So; So.init(MT, Nn, opaque_s((int)gridDim.x), opaque_s((int)blockIdx.x)); \
        pg8::EpiT E{__VA_ARGS__}; pg8::gemm_phase<pg8::EpiT, pg8::StaticOrder, true, true>(wave_id, RING, g, So, E); } GRID_SYNC(); } while (0)
#endif
    for (int layer = 0; layer < DEPTH; ++layer) {
        FFN_OPT(w_ain, w_aout, 3 * layer, false);
        const int v1 = 3 * layer + 1;
        if (layer < N_A) {
#ifndef CPU_TEST
            { KP; const int lane_ = (int)lane_id_v(); WAVE_ITEMS((MS / 32) * (3 * D_MODEL / 32) * 2) att::skinny_task(it_, WS_B(hb) + (size_t)MP * D_MODEL, WS_B(w_cin) + (size_t)layer * 3 * D_MODEL * D_MODEL, 3 * D_MODEL, D_MODEL, 2, WS_F(part), lane_); }
            { KP; pg8::Gemm g{WS_B(hb), WS_B(w_cin) + (size_t)layer * 3 * D_MODEL * D_MODEL, MP, 3 * D_MODEL, D_MODEL}; pg8::StaticOrder So; So.init(MP, 3 * D_MODEL, opaque_s((int)gridDim.x), opaque_s((int)blockIdx.x));
              pg8::EpiConvIn E{WS_B(ub), WS_B(bb), WS_F(rss) + (size_t)v1 * MT, P.out, layer}; pg8::gemm_phase<pg8::EpiConvIn, pg8::StaticOrder, true, true>(wave_id, RING, g, So, E); }
            GRID_SYNC();
#else
            PH((size_t)MT * D_MODEL, ref_conv_in_item(i, WS_B(hb), WS_F(rss) + (size_t)v1 * MT, WS_B(w_cin) + (size_t)layer * 3 * D_MODEL * D_MODEL, WS_B(ub), WS_B(bb), P.out, layer));
#endif
#ifndef CPU_TEST
            { KP; ITEM_LOOP((size_t)MS * (D_MODEL / 8)) conv_thin_sample_item(i, WS_F(part), 2, WS_F(rss) + (size_t)v1 * MT, P.state_conv + (size_t)layer * DEC_BATCH * 2 * D_MODEL, P.conv_w + (size_t)layer * 3 * D_MODEL, WS_B(zb), P.out, layer); }
            PH((size_t)MP * (D_MODEL / 8), conv_thin_vec_item(i, WS_B(ub), WS_B(bb), P.state_conv + (size_t)layer * DEC_BATCH * 2 * D_MODEL, P.conv_w + (size_t)layer * 3 * D_MODEL, WS_B(zb)));
#else
            PH((size_t)MT * D_MODEL, conv_thin_item(i, WS_B(ub), WS_B(bb), P.state_conv + (size_t)layer * DEC_BATCH * 2 * D_MODEL, P.conv_w + (size_t)layer * 3 * D_MODEL, WS_B(zb)));
#endif
#ifndef CPU_TEST
            RESID_PH(WS_B(zb), WS_B(w_cout) + (size_t)layer * D_MODEL * D_MODEL, D_MODEL, 8, v1 + 1, 1.0f, false);
#else
            PH(MT, ref_resid_row_item(i, WS_B(zb), D_MODEL, WS_B(w_cout) + (size_t)layer * D_MODEL * D_MODEL, 1.0f, WS_F(h), WS_B(hb), WS_F(rss) + (size_t)(v1 + 1) * MT, nullptr));
#endif
        } else {
            const int b = layer - N_A;
#ifndef CPU_TEST
            GEMM_PH(EpiQG, WS_B(hb), WS_B(w_qg) + (size_t)b * QGP * D_MODEL, QGP, D_MODEL, WS_B(qnb), WS_B(qrb), WS_F(gates), WS_F(rss) + (size_t)v1 * MT, P.nsa_q_norm + (size_t)b * HD, WS_F(rope));
#else
            { KP; ITEM_LOOP((size_t)MT * N_HEADS) ref_qg_item(i, WS_B(hb), WS_F(rss) + (size_t)v1 * MT, WS_B(w_qg) + (size_t)b * QGP * D_MODEL, P.nsa_q_norm + (size_t)b * HD, WS_F(rope), WS_F(qn), WS_F(qr)); }
            PH((size_t)MT * 3 * N_HEADS, ref_gates_item(i, WS_B(hb), WS_F(rss) + (size_t)v1 * MT, WS_B(w_qg) + (size_t)b * QGP * D_MODEL, WS_F(gates)));
#endif
#ifndef CPU_TEST
            { KP; att::Tensors T{WS_B(qnb), WS_B(qrb), P.ws + WSM.ksel, P.ws + WSM.vsel, P.ws + WSM.kwin, P.ws + WSM.vwin, P.ws + WSM.kci, P.ws + WSM.vci, WS_F(gates), WS_B(ob)};
              int wv = wave_id; asm volatile("" : "+s"(wv));
              att::phase(T, (att::ldsp)lds, wv, (int)lane_id_v(), opaque_s((int)blockIdx.x), opaque_s((int)gridDim.x)); }
            { KP; att::STensors T{WS_B(qnb), WS_B(qrb), WS_F(kc), WS_F(vc), P.cache_kv, P.page_table, P.cache_win, P.out, WS_F(winrows), WS_F(gates), WS_B(ob)};
              int wv = wave_id; asm volatile("" : "+s"(wv));
              att::sample_phase(T, (att::ldsp)lds, wv, (int)lane_id_v(), opaque_s((int)blockIdx.x), opaque_s((int)gridDim.x)); }
            GRID_SYNC();
#else
            PH((size_t)MT * N_HEADS, attn_cmp_item(i, WS_F(qn), WS_F(kc), WS_F(vc), WS_F(pbuf), WS_F(oc)));
            PH((size_t)MT * N_KV, topk_item(i, WS_F(pbuf), (int*)WS_F(sel), WS_F(scorebuf)));
            PH((size_t)MT * N_HEADS, attn_sel_item(i, KVSRC, WS_F(qr), (const int*)WS_F(sel), WS_F(os)));
            PH((size_t)MT * N_HEADS, attn_win_item(i, P.cache_win, WS_F(winrows), WS_F(qr), WS_F(gates), WS_F(oc), WS_F(os), WS_B(ob)));
#endif
#ifndef CPU_TEST
            RESID_PH(WS_B(ob), WS_B(w_o) + (size_t)b * D_MODEL * HDM, HDM, 8, v1 + 1, 1.0f, false);
#else
            PH(MT, ref_resid_row_item(i, WS_B(ob), HDM, WS_B(w_o) + (size_t)b * D_MODEL * HDM, 1.0f, WS_F(h), WS_B(hb), WS_F(rss) + (size_t)(v1 + 1) * MT, nullptr));
#endif
        }
        FFN_OPT(w_bin, w_bout, 3 * layer + 2, layer == DEPTH - 1);
        if (layer == N_A - 1) {
            const int v3 = 3 * layer + 3;
#ifndef CPU_TEST
            { KP; pg8::Gemm g{WS_B(hb), WS_B(w_kv), MT, KVW, D_MODEL}; pg8::StaticOrder So; So.init(MT, KVW, opaque_s((int)gridDim.x), opaque_s((int)blockIdx.x));
              pg8::EpiKV E{P.out, WS_F(winrows), WS_F(rss) + (size_t)v3 * MT, P.k_norm, WS_F(rope), P.ws + WSM.ksel, P.ws + WSM.vsel, P.ws + WSM.kwin, P.ws + WSM.vwin, WS_B(acp), P.cmp_pe}; pg8::gemm_phase<pg8::EpiKV, pg8::StaticOrder, true, true>(wave_id, RING, g, So, E); }
#else
            { KP; ITEM_LOOP((size_t)MT * 6 * N_KV) ref_kv_item(i, WS_B(hb), WS_F(rss) + (size_t)v3 * MT, WS_B(w_kv), P.k_norm, WS_F(rope), P.out, WS_F(winrows)); }
#endif
            PH((size_t)DEC_BATCH * (WINDOW - DEC_SEQ) * 2 * N_KV * HD, wincopy_item(i, P.cache_win, P.out));
#ifdef CPU_TEST
            PH((size_t)NSEQ * NBC_MAX * 2 * N_KV * CMP_HID, cmp_hid_item(i, KVSRC, P.cmp_pe, P.cmp_w1, WS_F(hid)));
            PH((size_t)NSEQ * NBC_MAX * 2 * N_KV, cmp_out_item(i, WS_F(hid), P.cmp_w2, P.k_norm, WS_F(kc), WS_F(vc)));
#else
            { KP; pg8::Gemm g{WS_B(acp), WS_B(w1t), 2 * RP_CMP, 2 * CMP_HID, L_CMP * HD}; pg8::CmpOrder So{2 * RP_CMP / 256, RP_CMP / 256, opaque_s((int)gridDim.x), opaque_s((int)blockIdx.x)};
              pg8::EpiGelu E{WS_B(hidp)}; pg8::gemm_phase<pg8::EpiGelu, pg8::CmpOrder, true, true>(wave_id, RING, g, So, E); }
            GRID_SYNC();
            { KP; const int lane_ = (int)lane_id_v(); WAVE_ITEMS(2 * RP_CMP / 32) att::cmp_out_wave(it_, WS_B(hidp), RP_CMP, NBC_P, 0, WS_B(w2t), P.k_norm, WS_F(kc), WS_F(vc), P.ws + WSM.kci, P.ws + WSM.vci, lane_); }
            GRID_SYNC();
#endif
        }
    }
}

extern "C" void kernel_launch(void* const* d_in, const int* in_sizes, int n_in, void* d_out, int out_size, void* d_ws, size_t ws_size, hipStream_t stream) {
    Params P{};
    P.x_prompt = (const float*)d_in[0]; P.x_sample = (const float*)d_in[1]; P.cache_kv = (const float*)d_in[2]; P.cache_win = (const float*)d_in[3];
    P.state_conv = (const float*)d_in[4]; P.page_table = (const int*)d_in[5]; P.ffn_a_norm = (const float*)d_in[6]; P.ffn_a_w_in = (const float*)d_in[7];
    P.ffn_a_w_out = (const float*)d_in[8]; P.mix_norm = (const float*)d_in[9]; P.ffn_b_norm = (const float*)d_in[10]; P.ffn_b_w_in = (const float*)d_in[11];
    P.ffn_b_w_out = (const float*)d_in[12]; P.conv_w_in = (const float*)d_in[13]; P.conv_w = (const float*)d_in[14]; P.conv_w_out = (const float*)d_in[15];
    P.kv_norm = (const float*)d_in[16]; P.w_kv = (const float*)d_in[17]; P.k_norm = (const float*)d_in[18]; P.cmp_pe = (const float*)d_in[19];
    P.cmp_w1 = (const float*)d_in[20]; P.cmp_w2 = (const float*)d_in[21]; P.nsa_w_qg = (const float*)d_in[22]; P.nsa_q_norm = (const float*)d_in[23];
    P.nsa_w_o = (const float*)d_in[24];
    P.out = (float*)d_out; P.ws = (unsigned char*)d_ws;
#ifndef CPU_TEST
    static int grid = 0;
    if (grid == 0) {
        int dev = 0, cus = 0, per_cu = 0;
        hipGetDevice(&dev); hipDeviceGetAttribute(&cus, hipDeviceAttributeMultiprocessorCount, dev);
        hipFuncSetAttribute((const void*)mega, hipFuncAttributeMaxDynamicSharedMemorySize, LDS_BYTES);
        hipOccupancyMaxActiveBlocksPerMultiprocessor(&per_cu, (const void*)mega, NTHREADS, LDS_BYTES);
        (void)hipGetLastError();
        grid = cus;
    }
    hipMemsetAsync(d_ws, 0, WS_ZERO_BYTES, stream);
    hipLaunchKernelGGL(mega, dim3(grid), dim3(NTHREADS), LDS_BYTES, stream, P);
#else
    memset(d_ws, 0, WS_ZERO_BYTES);
    mega(P);
#endif
}
```

```cpp
#ifdef CPU_TEST
#include "shim.h"
#else
#include <hip/hip_runtime.h>
#endif
#include <cstdint>
#include <cstddef>
#include <cmath>
#include <cstring>
typedef unsigned short bf16_t;
#ifndef CPU_TEST
#define HOSTDEV __host__ __device__
#else
#define HOSTDEV
#endif
HOSTDEV inline bf16_t f2bf(float f) { unsigned u; memcpy(&u, &f, 4); u = (u + 0x7fffu + ((u >> 16) & 1u)) >> 16; return (bf16_t)u; }
HOSTDEV inline float bf2f(bf16_t b) { unsigned u = (unsigned)b << 16; float f; memcpy(&f, &u, 4); return f; }

#ifdef CFG_SMALL
constexpr int D_MODEL = 256, BATCH = 1, SEQ = 2048, DEPTH = 4, DEC_BATCH = 2, DEC_SEQ = 8, PAST_LEN = 2048, PAGE_SIZE = 128, D_FF = 256, N_HEADS = 4, N_KV = 2;
#else
constexpr int D_MODEL = 1024, BATCH = 4, SEQ = 4096, DEPTH = 4, DEC_BATCH = 32, DEC_SEQ = 8, PAST_LEN = 8192, PAGE_SIZE = 128, D_FF = 2816, N_HEADS = 16, N_KV = 4;
#endif
constexpr int N_A = DEPTH / 2, N_B = DEPTH - N_A, HD = 64, HPG = N_HEADS / N_KV, L_CMP = 32, L_SEL = 64, N_SEL = 16, WINDOW = 512, CMP_HID = 4 * HD;
constexpr int MP = BATCH * SEQ, MS = DEC_BATCH * DEC_SEQ, MT = MP + MS, NSEQ = BATCH + DEC_BATCH;
constexpr int N_PAGES = PAST_LEN / PAGE_SIZE;
constexpr int KVW = 6 * N_KV * HD;
constexpr int QGW = N_HEADS * HD + 3 * N_HEADS;
constexpr int HDM = N_HEADS * HD;
constexpr int TPAD_S = ((PAST_LEN + DEC_SEQ + L_SEL - 1) / L_SEL) * L_SEL;
constexpr int NBC_P = SEQ / L_CMP, NBC_S = TPAD_S / L_CMP, NBC_MAX = NBC_S > NBC_P ? NBC_S : NBC_P;
constexpr int NBS_P = SEQ / L_SEL, NBS_S = TPAD_S / L_SEL, NBS_MAX = NBS_S > NBS_P ? NBS_S : NBS_P;
constexpr float EPS = 1e-6f, NEGF = -1e30f, TINYF = 1e-30f, FORCE_SCORE = 1e4f;
__device__ static const float INV_FREQ[8] = {1.0f, 0.1939227432012558f, 0.03760603070259094f, 0.007292664609849453f, 0.0014142135623842478f, 0.00027424818836152554f, 5.3182957344688475e-05f, 1.0313385246263351e-05f};

constexpr size_t O_YP = 0, O_YS = O_YP + (size_t)MP * D_MODEL, O_KVP = O_YS + (size_t)MS * D_MODEL, O_KVS = O_KVP + (size_t)MP * 4 * N_KV * HD,
                 O_WP = O_KVS + (size_t)MS * 4 * N_KV * HD, O_WS = O_WP + (size_t)BATCH * WINDOW * 2 * N_KV * HD, O_CP = O_WS + (size_t)DEC_BATCH * WINDOW * 2 * N_KV * HD,
                 O_CS = O_CP + (size_t)N_A * BATCH * 2 * D_MODEL, O_END = O_CS + (size_t)N_A * DEC_BATCH * 2 * D_MODEL;

struct RowInfo { int seq, t, pos; };
__device__ __host__ inline RowInfo row_info(int m) {
    RowInfo r;
    if (m < MP) { r.seq = m / SEQ; r.t = m % SEQ; r.pos = r.t; }
    else { const int q = m - MP; r.seq = BATCH + q / DEC_SEQ; r.t = q % DEC_SEQ; r.pos = PAST_LEN + r.t; }
    return r;
}
__device__ __host__ inline int seq_row0(int seq) { return seq < BATCH ? seq * SEQ : MP + (seq - BATCH) * DEC_SEQ; }
__device__ __host__ inline int seq_pos0(int seq) { return seq < BATCH ? 0 : PAST_LEN; }
__device__ __host__ inline int seq_len(int seq) { return seq < BATCH ? SEQ : DEC_SEQ; }

__device__ inline void copy_item(size_t i_, const float* a, float* b, size_t n) {
    const size_t i = i_;
    if (i < n) b[i] = a[i];
}
__device__ inline void rmsnorm_item(size_t i_, const float* x, const float* g, float* y, int rows, int d) {
    const int m = (int)i_;
    if (m >= rows) return;
    const float* xr = x + (size_t)m * d; float s = 0.f;
    for (int i = 0; i < d; ++i) s += xr[i] * xr[i];
    const float r = 1.0f / sqrtf(s / d + EPS);
    float* yr = y + (size_t)m * d;
    for (int i = 0; i < d; ++i) yr[i] = xr[i] * r * g[i];
}
__device__ inline void gemm_item(size_t i_, const float* A, int lda, const float* W, float* C, int M, int N, int K) {
    const int nbx = (N + 63) / 64; const int vb = (int)(i_ / 256), t_ = (int)(i_ % 256), tx = t_ % 16, ty = t_ / 16;
    const int c0 = (vb % nbx) * 64 + tx * 4, r0 = (vb / nbx) * 64 + ty * 4;
    if (c0 >= N || r0 >= M) return;
    float acc[4][4];
    for (int i = 0; i < 4; ++i) for (int j = 0; j < 4; ++j) acc[i][j] = 0.f;
    const int nr = (M - r0) < 4 ? (M - r0) : 4;
    for (int k = 0; k < K; k += 4) {
        float a[4][4], w[4][4];
        for (int i = 0; i < 4; ++i) for (int kk = 0; kk < 4; ++kk) a[i][kk] = (i < nr) ? A[(size_t)(r0 + i) * lda + k + kk] : 0.f;
        for (int kk = 0; kk < 4; ++kk) for (int j = 0; j < 4; ++j) w[kk][j] = W[(size_t)(k + kk) * N + c0 + j];
        for (int i = 0; i < 4; ++i) for (int kk = 0; kk < 4; ++kk) for (int j = 0; j < 4; ++j) acc[i][j] += a[i][kk] * w[kk][j];
    }
    for (int i = 0; i < nr; ++i) for (int j = 0; j < 4; ++j) C[(size_t)(r0 + i) * N + c0 + j] = acc[i][j];
}
__device__ inline void swiglu_item(size_t i_, const float* t1, float* act, int rows, int dff) {
    const size_t i = i_;
    if (i >= (size_t)rows * dff) return;
    const int m = (int)(i / dff), j = (int)(i % dff);
    const float g = t1[(size_t)m * 2 * dff + j], u = t1[(size_t)m * 2 * dff + dff + j];
    act[i] = g / (1.0f + expf(-g)) * u;
}
__device__ inline void axpy_item(size_t i_, float* h, const float* y, float coef, size_t n) {
    const size_t i = i_;
    if (i < n) h[i] += coef * y[i];
}
__device__ inline void conv_item(size_t i_, const float* t1, const float* state  , const float* wc  , float* z, float* out, int layer) {
    const size_t i = i_;
    if (i >= (size_t)MT * D_MODEL) return;
    const int m = (int)(i / D_MODEL), ch = (int)(i % D_MODEL);
    const RowInfo ri = row_info(m);
    const float* r = t1 + (size_t)m * 3 * D_MODEL;
    const float b = r[ch], u0 = r[D_MODEL + ch] * r[2 * D_MODEL + ch];
    float u1, u2;
    if (ri.t >= 1) { const float* p = r - 3 * D_MODEL; u1 = p[D_MODEL + ch] * p[2 * D_MODEL + ch]; }
    else u1 = (ri.seq < BATCH) ? 0.f : state[((size_t)(ri.seq - BATCH) * 2 + 1) * D_MODEL + ch];
    if (ri.t >= 2) { const float* p = r - 6 * D_MODEL; u2 = p[D_MODEL + ch] * p[2 * D_MODEL + ch]; }
    else if (ri.seq < BATCH) u2 = 0.f;
    else u2 = (ri.t == 1) ? state[((size_t)(ri.seq - BATCH) * 2 + 1) * D_MODEL + ch] : state[((size_t)(ri.seq - BATCH) * 2 + 0) * D_MODEL + ch];
    z[i] = b * (wc[ch] * u2 + wc[D_MODEL + ch] * u1 + wc[2 * D_MODEL + ch] * u0);
    const int L = seq_len(ri.seq);
    if (ri.t >= L - 2) {
        const int j = ri.t - (L - 2);
        if (ri.seq < BATCH) out[O_CP + (((size_t)layer * BATCH + ri.seq) * 2 + j) * D_MODEL + ch] = u0;
        else out[O_CS + (((size_t)layer * DEC_BATCH + (ri.seq - BATCH)) * 2 + j) * D_MODEL + ch] = u0;
    }
}
__device__ inline void head_norm(float* v, const float* g) {
    float s = 0.f; for (int d = 0; d < HD; ++d) s += v[d] * v[d];
    const float r = 1.0f / sqrtf(s / HD + EPS);
    for (int d = 0; d < HD; ++d) v[d] = v[d] * r * g[d];
}
__device__ inline void rope_cs(float ang, float& c, float& s) {
    const double r = (double)ang * 0.15915494309189535; const float fr = (float)(r - rint(r));
#ifdef CPU_TEST
    c = (float)cos(6.283185307179586 * (double)fr); s = (float)sin(6.283185307179586 * (double)fr);
#else
    c = __builtin_amdgcn_cosf(fr); s = __builtin_amdgcn_sinf(fr);
#endif
}
__device__ inline void head_rope(float* v, int pos) {
    for (int i = 0; i < 8; ++i) {
        const float ang = (float)pos * INV_FREQ[i]; float c, s; rope_cs(ang, c, s);
        const float x1 = v[i], x2 = v[8 + i];
        v[i] = x1 * c - x2 * s; v[8 + i] = x2 * c + x1 * s;
    }
}
__device__ inline void kvprep_item(size_t i_, const float* p, const float* k_norm  , float* out, float* winrows) {
    const int i = (int)i_;
    if (i >= MT * 6 * N_KV) return;
    const int m = i / (6 * N_KV), e = (i / N_KV) % 6, g = i % N_KV;
    const RowInfo ri = row_info(m);
    float v[HD];
    for (int d = 0; d < HD; ++d) v[d] = p[(size_t)m * KVW + (e * N_KV + g) * HD + d];
    if (e == 2) { head_norm(v, k_norm + HD); head_rope(v, ri.pos); }
    if (e == 4) { head_norm(v, k_norm + 2 * HD); head_rope(v, ri.pos); }
    if (e < 4) {
        float* o = (ri.seq < BATCH) ? out + O_KVP + (((size_t)m * 4 + e) * N_KV + g) * HD : out + O_KVS + (((size_t)(m - MP) * 4 + e) * N_KV + g) * HD;
        for (int d = 0; d < HD; ++d) o[d] = v[d];
    } else {
        const int we = e - 4;
        float* w = winrows + (((size_t)m * 2 + we) * N_KV + g) * HD;
        for (int d = 0; d < HD; ++d) w[d] = v[d];
        if (ri.seq < BATCH) { if (ri.t >= SEQ - WINDOW) { float* o = out + O_WP + ((((size_t)ri.seq * WINDOW + (ri.t - (SEQ - WINDOW))) * 2 + we) * N_KV + g) * HD; for (int d = 0; d < HD; ++d) o[d] = v[d]; } }
        else { float* o = out + O_WS + ((((size_t)(ri.seq - BATCH) * WINDOW + (WINDOW - DEC_SEQ + ri.t)) * 2 + we) * N_KV + g) * HD; for (int d = 0; d < HD; ++d) o[d] = v[d]; }
    }
}
__device__ inline void wincopy_item(size_t i_, const float* cache_win, float* out) {
    const size_t i = i_;
    const size_t per = (size_t)(WINDOW - DEC_SEQ) * 2 * N_KV * HD;
    if (i >= (size_t)DEC_BATCH * per) return;
    const size_t b = i / per, r = i % per;
    out[O_WS + b * WINDOW * 2 * N_KV * HD + r] = cache_win[b * WINDOW * 2 * N_KV * HD + (size_t)DEC_SEQ * 2 * N_KV * HD + r];
}
struct KvSrc { const float* cache_kv; const int* page_table; const float* out; };
__device__ inline const float* kv_full_ptr(const KvSrc& S, int seq, int tok, int e, int g) {
    if (seq < BATCH) return S.out + O_KVP + ((((size_t)seq * SEQ + tok) * 4 + e) * N_KV + g) * HD;
    const int b = seq - BATCH;
    if (tok < PAST_LEN) { const int page = S.page_table[b * N_PAGES + tok / PAGE_SIZE]; return S.cache_kv + ((((size_t)page * PAGE_SIZE + tok % PAGE_SIZE) * 4 + e) * N_KV + g) * HD; }
    if (tok < PAST_LEN + DEC_SEQ) return S.out + O_KVS + ((((size_t)b * DEC_SEQ + (tok - PAST_LEN)) * 4 + e) * N_KV + g) * HD;
    return nullptr;
}
__device__ inline int seq_nbc(int seq) { return seq < BATCH ? NBC_P : NBC_S; }
__device__ inline void cmp_hid_item(size_t i_, KvSrc S, const float* pe  , const float* w1  , float* hid) {
    const size_t i = i_;
    if (i >= (size_t)NSEQ * NBC_MAX * 2 * N_KV * CMP_HID) return;
    const int f = (int)(i % CMP_HID), g = (int)((i / CMP_HID) % N_KV), e = (int)((i / ((size_t)CMP_HID * N_KV)) % 2), c = (int)((i / ((size_t)CMP_HID * N_KV * 2)) % NBC_MAX), seq = (int)(i / ((size_t)CMP_HID * N_KV * 2 * NBC_MAX));
    if (c >= seq_nbc(seq)) return;
    float s = 0.f;
    for (int l = 0; l < L_CMP; ++l) {
        const float* r = kv_full_ptr(S, seq, c * L_CMP + l, e, g);
        const float* w = w1 + (((size_t)e * L_CMP + l) * HD) * CMP_HID + f; const float* pp = pe + ((size_t)e * L_CMP + l) * HD;
        for (int d = 0; d < HD; ++d) s += ((r ? r[d] : 0.f) + pp[d]) * w[(size_t)d * CMP_HID];
    }
    const float x = s; const float t = tanhf(0.7978845608028654f * (x + 0.044715f * x * x * x));
    hid[i] = 0.5f * x * (1.0f + t);
}
__device__ inline void cmp_out_item(size_t i_, const float* hid, const float* w2  , const float* k_norm0, float* kc, float* vc) {
    const int i = (int)i_;
    if (i >= NSEQ * NBC_MAX * 2 * N_KV) return;
    const int g = i % N_KV, e = (i / N_KV) % 2, c = (i / (2 * N_KV)) % NBC_MAX, seq = i / (2 * N_KV * NBC_MAX);
    if (c >= seq_nbc(seq)) return;
    const float* hr = hid + (size_t)i * CMP_HID;
    float v[HD];
    for (int d = 0; d < HD; ++d) { float s = 0.f; for (int f = 0; f < CMP_HID; ++f) s += hr[f] * w2[((size_t)e * CMP_HID + f) * HD + d]; v[d] = s; }
    if (e == 0) head_norm(v, k_norm0);
    float* o = (e == 0 ? kc : vc) + (((size_t)seq * NBC_MAX + c) * N_KV + g) * HD;
    for (int d = 0; d < HD; ++d) o[d] = v[d];
}
__device__ inline void qprep_item(size_t i_, const float* qg, const float* q_norm, float* qn, float* qr, float* gates) {
    const int i = (int)i_;
    if (i >= MT * N_HEADS) return;
    const int m = i / N_HEADS, hh = i % N_HEADS;
    const RowInfo ri = row_info(m);
    float v[HD];
    for (int d = 0; d < HD; ++d) v[d] = qg[(size_t)m * QGW + hh * HD + d];
    head_norm(v, q_norm);
    for (int d = 0; d < HD; ++d) qn[(size_t)m * HDM + hh * HD + d] = v[d];
    head_rope(v, ri.pos);
    for (int d = 0; d < HD; ++d) qr[(size_t)m * HDM + hh * HD + d] = v[d];
    for (int j = 0; j < 3; ++j) { const float x = qg[(size_t)m * QGW + HDM + hh * 3 + j]; gates[(size_t)m * 3 * N_HEADS + hh * 3 + j] = 1.0f / (1.0f + expf(-x)); }
}
__device__ inline void attn_cmp_item(size_t i_, const float* qn, const float* kc, const float* vc, float* pbuf, float* oc) {
    const int i = (int)i_;
    if (i >= MT * N_HEADS) return;
    const int m = i / N_HEADS, hh = i % N_HEADS, g = hh / HPG;
    const RowInfo ri = row_info(m);
    const int nbc = seq_nbc(ri.seq);
    const float* q = qn + (size_t)m * HDM + hh * HD;
    float* p = pbuf + (size_t)i * NBC_MAX;
    float mx = NEGF;
    for (int c = 0; c < nbc; ++c) {
        const bool vis = (c + 1) * L_CMP - 1 <= ri.pos;
        float s = 0.f; const float* k = kc + (((size_t)ri.seq * NBC_MAX + c) * N_KV + g) * HD;
        for (int d = 0; d < HD; ++d) s += q[d] * k[d];
        s *= 0.125f; p[c] = s; if (vis && s > mx) mx = s;
    }
    float sum = 0.f;
    for (int c = 0; c < nbc; ++c) { const bool vis = (c + 1) * L_CMP - 1 <= ri.pos; const float e = vis ? expf(p[c] - mx) : 0.f; p[c] = e; sum += e; }
    const float inv = 1.0f / fmaxf(sum, TINYF);
    float o[HD]; for (int d = 0; d < HD; ++d) o[d] = 0.f;
    for (int c = 0; c < nbc; ++c) { p[c] *= inv; if (p[c] != 0.f) { const float* v = vc + (((size_t)ri.seq * NBC_MAX + c) * N_KV + g) * HD; for (int d = 0; d < HD; ++d) o[d] += p[c] * v[d]; } }
    for (int d = 0; d < HD; ++d) oc[(size_t)m * HDM + hh * HD + d] = o[d];
}
__device__ inline void topk_item(size_t i_, const float* pbuf, int* sel, float* scorebuf  ) {
    const int i = (int)i_;
    if (i >= MT * N_KV) return;
    const int m = i / N_KV, g = i % N_KV;
    const RowInfo ri = row_info(m);
    const int nbs = ri.seq < BATCH ? NBS_P : NBS_S, cur = ri.pos / L_SEL;
    float* score = scorebuf + (size_t)i * NBS_MAX;
    for (int b = 0; b < nbs; ++b) {
        float imp = 0.f;
        for (int h = 0; h < HPG; ++h) { const float* p = pbuf + ((size_t)m * N_HEADS + g * HPG + h) * NBC_MAX; imp += p[2 * b]; }
        float imp2 = 0.f;
        for (int h = 0; h < HPG; ++h) { const float* p = pbuf + ((size_t)m * N_HEADS + g * HPG + h) * NBC_MAX; imp2 += p[2 * b + 1]; }
        const bool forced = (b == 0) || (b == cur) || (b == cur - 1), valid = b * L_SEL <= ri.pos;
        score[b] = valid ? (forced ? FORCE_SCORE : imp + imp2) : NEGF;
    }
    const int nsel = N_SEL < nbs ? N_SEL : nbs;
    for (int j = 0; j < N_SEL; ++j) {
        if (j >= nsel) { sel[(size_t)i * N_SEL + j] = -1; continue; }
        int best = -1; float bv = 0.f;
        for (int b = 0; b < nbs; ++b) if (score[b] > -3e38f && (best < 0 || score[b] > bv)) { best = b; bv = score[b]; }
        sel[(size_t)i * N_SEL + j] = best; score[best] = -3.4e38f;
    }
}
__device__ inline void attn_sel_item(size_t i_, KvSrc S, const float* qr, const int* sel, float* os) {
    const int i = (int)i_;
    if (i >= MT * N_HEADS) return;
    const int m = i / N_HEADS, hh = i % N_HEADS, g = hh / HPG;
    const RowInfo ri = row_info(m);
    const float* q = qr + (size_t)m * HDM + hh * HD;
    const int* sl = sel + ((size_t)m * N_KV + g) * N_SEL;
    float mx = NEGF;
    for (int j = 0; j < N_SEL; ++j) { const int b = sl[j]; if (b < 0) continue;
        for (int t = 0; t < L_SEL; ++t) { const int tok = b * L_SEL + t; if (tok > ri.pos) continue;
            const float* k = kv_full_ptr(S, ri.seq, tok, 2, g); float s = 0.f; if (k) for (int d = 0; d < HD; ++d) s += q[d] * k[d];
            s *= 0.125f; if (s > mx) mx = s; } }
    float sum = 0.f, o[HD]; for (int d = 0; d < HD; ++d) o[d] = 0.f;
    for (int j = 0; j < N_SEL; ++j) { const int b = sl[j]; if (b < 0) continue;
        for (int t = 0; t < L_SEL; ++t) { const int tok = b * L_SEL + t; if (tok > ri.pos) continue;
            const float* k = kv_full_ptr(S, ri.seq, tok, 2, g); float s = 0.f; if (k) for (int d = 0; d < HD; ++d) s += q[d] * k[d];
            const float e = expf(s * 0.125f - mx); sum += e;
            const float* v = kv_full_ptr(S, ri.seq, tok, 3, g); if (v) for (int d = 0; d < HD; ++d) o[d] += e * v[d]; } }
    const float inv = 1.0f / fmaxf(sum, TINYF);
    for (int d = 0; d < HD; ++d) os[(size_t)m * HDM + hh * HD + d] = o[d] * inv;
}
__device__ inline const float* win_ptr(const float* cache_win, const float* winrows, int seq, int kp) {
    if (seq < BATCH) return kp >= 0 ? winrows + (size_t)(seq * SEQ + kp) * 2 * N_KV * HD : nullptr;
    const int b = seq - BATCH;
    if (kp >= PAST_LEN) return winrows + (size_t)(MP + b * DEC_SEQ + (kp - PAST_LEN)) * 2 * N_KV * HD;
    const int j = kp - (PAST_LEN - WINDOW);
    return j >= 0 ? cache_win + ((size_t)b * WINDOW + j) * 2 * N_KV * HD : nullptr;
}
__device__ inline void attn_win_item(size_t i_, const float* cache_win, const float* winrows, const float* qr, const float* gates, const float* oc, const float* os, bf16_t* o_out) {
    const int i = (int)i_;
    if (i >= MT * N_HEADS) return;
    const int m = i / N_HEADS, hh = i % N_HEADS, g = hh / HPG;
    const RowInfo ri = row_info(m);
    const float* q = qr + (size_t)m * HDM + hh * HD;
    float mx = NEGF;
    for (int kp = ri.pos - WINDOW; kp <= ri.pos; ++kp) { const float* r = win_ptr(cache_win, winrows, ri.seq, kp); if (!r) continue;
        const float* k = r + (0 * N_KV + g) * HD; float s = 0.f; for (int d = 0; d < HD; ++d) s += q[d] * k[d]; s *= 0.125f; if (s > mx) mx = s; }
    float sum = 0.f, o[HD]; for (int d = 0; d < HD; ++d) o[d] = 0.f;
    for (int kp = ri.pos - WINDOW; kp <= ri.pos; ++kp) { const float* r = win_ptr(cache_win, winrows, ri.seq, kp); if (!r) continue;
        const float* k = r + (0 * N_KV + g) * HD; float s = 0.f; for (int d = 0; d < HD; ++d) s += q[d] * k[d];
        const float e = expf(s * 0.125f - mx); sum += e; const float* v = r + (1 * N_KV + g) * HD; for (int d = 0; d < HD; ++d) o[d] += e * v[d]; }
    const float inv = 1.0f / fmaxf(sum, TINYF);
    const float* gt = gates + (size_t)m * 3 * N_HEADS + hh * 3;
    for (int d = 0; d < HD; ++d) { const size_t x = (size_t)m * HDM + hh * HD + d; o_out[x] = f2bf(gt[0] * oc[x] + gt[1] * os[x] + gt[2] * o[d] * inv); }
}


#ifndef CPU_TEST
__device__ __forceinline__ unsigned lane_id_v() { unsigned l; asm volatile("v_mbcnt_lo_u32_b32 %0, -1, 0\n\tv_mbcnt_hi_u32_b32 %0, -1, %0" : "=v"(l)); return l; }
#endif
constexpr int NTHREADS = 512;
__host__ __device__ inline bf16_t f2bf_(float f) { unsigned u; memcpy(&u, &f, 4); u = (u + 0x7fffu + ((u >> 16) & 1u)) >> 16; return (bf16_t)u; }
__host__ __device__ inline float bf2f_(bf16_t b) { unsigned u = (unsigned)b << 16; float f; memcpy(&f, &u, 4); return f; }
constexpr int NRSS = 3 * DEPTH + 1;
constexpr int NPOS = SEQ + DEC_SEQ;
constexpr int QGP = ((QGW + 255) / 256) * 256;
__host__ __device__ inline int pos_index(int pos) { return pos < SEQ ? pos : SEQ + (pos - PAST_LEN); }

constexpr size_t IMG_SEQ_BYTES = (size_t)BATCH * N_KV * (SEQ / 64) * 8192, IMG_CMP_BYTES = (size_t)BATCH * N_KV * (NBC_P / 64 > 0 ? NBC_P / 64 : 1) * 8192;
struct WsMap {
    size_t ctl, rss, rope, h, hb, act, xn, t2, actf, ub, bb, zb, t1, qn, qr, gates, ob, winrows, hid, kc, vc, pbuf, oc, os, sel, scorebuf,
           w_ain, w_aout, w_bin, w_bout, w_cin, w_cout, w_qg, w_o, w_kv, qnb, qrb, ksel, vsel, kwin, vwin, kci, vci, acs, hids, acp, hidp, w1t, w2t, part, end;
};
constexpr size_t al256(size_t b) { return (b + 255) / 256 * 256; }
constexpr size_t smax(size_t a, size_t b) { return a > b ? a : b; }
constexpr WsMap make_ws_map() {
    WsMap w{}; size_t off = 0;
#define TAKE(f, bytes) w.f = off; off += al256(bytes)
    TAKE(ctl, 65536); TAKE(rss, (size_t)NRSS * MT * 4);
    TAKE(rope, (size_t)NPOS * 16 * 4);
    TAKE(h, (size_t)MT * D_MODEL * 4); TAKE(hb, (size_t)MT * D_MODEL * 2); TAKE(act, (size_t)MT * D_FF * 2);
    TAKE(xn, (size_t)MT * D_MODEL * 4); TAKE(t2, (size_t)MT * D_MODEL * 4); TAKE(actf, (size_t)MT * D_MODEL * 4);
    TAKE(ub, (size_t)MT * D_MODEL * 2); TAKE(bb, (size_t)MT * D_MODEL * 2); TAKE(zb, (size_t)MT * D_MODEL * 2);
    TAKE(t1, smax((size_t)MT * 3 * D_MODEL * 4, (size_t)MT * KVW * 4));
    TAKE(qn, (size_t)MT * HDM * 4); TAKE(qr, (size_t)MT * HDM * 4); TAKE(gates, (size_t)MT * 3 * N_HEADS * 4); TAKE(ob, (size_t)MT * HDM * 2);
    TAKE(winrows, (size_t)MT * 2 * N_KV * HD * 4); TAKE(hid, (size_t)NSEQ * NBC_MAX * 2 * N_KV * CMP_HID * 4);
    TAKE(kc, (size_t)NSEQ * NBC_MAX * N_KV * HD * 4); TAKE(vc, (size_t)NSEQ * NBC_MAX * N_KV * HD * 4);
    TAKE(pbuf, (size_t)MT * N_HEADS * NBC_MAX * 4); TAKE(oc, (size_t)MT * HDM * 4); TAKE(os, (size_t)MT * HDM * 4);
    TAKE(sel, (size_t)MT * N_KV * N_SEL * 4); TAKE(scorebuf, (size_t)MT * N_KV * NBS_MAX * 4);
    TAKE(w_ain, (size_t)DEPTH * 2 * D_FF * D_MODEL * 2); TAKE(w_aout, (size_t)DEPTH * D_MODEL * D_FF * 2);
    TAKE(w_bin, (size_t)DEPTH * 2 * D_FF * D_MODEL * 2); TAKE(w_bout, (size_t)DEPTH * D_MODEL * D_FF * 2);
    TAKE(w_cin, (size_t)N_A * 3 * D_MODEL * D_MODEL * 2); TAKE(w_cout, (size_t)N_A * D_MODEL * D_MODEL * 2);
    TAKE(w_qg, (size_t)N_B * QGP * D_MODEL * 2); TAKE(w_o, (size_t)N_B * D_MODEL * HDM * 2); TAKE(w_kv, (size_t)KVW * D_MODEL * 2);
    TAKE(qnb, (size_t)MT * HDM * 2); TAKE(qrb, (size_t)MT * HDM * 2); TAKE(ksel, IMG_SEQ_BYTES); TAKE(vsel, IMG_SEQ_BYTES); TAKE(kwin, IMG_SEQ_BYTES); TAKE(vwin, IMG_SEQ_BYTES); TAKE(kci, IMG_CMP_BYTES); TAKE(vci, IMG_CMP_BYTES);
    TAKE(acs, (size_t)2 * DEC_BATCH * (PAST_LEN / L_CMP) * N_KV * L_CMP * HD * 2); TAKE(hids, (size_t)2 * DEC_BATCH * (PAST_LEN / L_CMP) * N_KV * CMP_HID * 2);
    TAKE(acp, (size_t)2 * BATCH * NBC_P * N_KV * L_CMP * HD * 2); TAKE(hidp, (size_t)2 * BATCH * NBC_P * N_KV * CMP_HID * 2); TAKE(w1t, (size_t)2 * CMP_HID * L_CMP * HD * 2); TAKE(w2t, (size_t)2 * HD * CMP_HID * 2); TAKE(part, (size_t)8 * MS * 3 * D_MODEL * 4);
#undef TAKE
    w.end = off; return w;
}
constexpr WsMap WSM = make_ws_map();
constexpr size_t WS_ZERO_BYTES = 65536 + (((size_t)NRSS * MT * 4 + 255) / 256 * 256);

enum { CM_PLAIN = 0, CM_PAIR = 1, CM_CONV = 2, CM_HEADS = 3 };
__host__ __device__ inline int colmap(int kind, int n, int aux) {
    const int pn = n / 256, c = n % 256;
    if (kind == CM_PLAIN) return n;
    if (kind == CM_PAIR) return (c >= 128 ? aux : 0) + pn * 128 + (c % 128);
    if (kind == CM_CONV) { if (n < 2 * D_MODEL) return (c >= 128 ? 2 * D_MODEL : D_MODEL) + pn * 128 + (c % 128); return n - 2 * D_MODEL; }
    if (n < aux * 64) { const int bj = c / 128, wc = (c % 128) / 32, r = c % 32; return (pn * 4 + wc) * 64 + 32 * bj + r; }
    return n;
}
__device__ inline void wconv_item(size_t i_, const float* src, int Nsrc, const float* gain, bf16_t* dst, int Nd, int K, int kind, int aux) {
    const int n = (int)(i_ % Nd), kb = (int)(i_ / Nd);
    const int col = colmap(kind, n, aux);
    bf16_t* d = dst + (size_t)n * K + (size_t)kb * 64;
    if (col < 0 || col >= Nsrc) { for (int k = 0; k < 64; ++k) d[k] = 0; return; }
    const float* s = src + (size_t)kb * 64 * Nsrc + col;
#pragma unroll 8
    for (int k = 0; k < 64; k += 2) {
        const float g0 = gain ? gain[kb * 64 + k] : 1.f, g1 = gain ? gain[kb * 64 + k + 1] : 1.f;
        const unsigned lo = f2bf(s[(size_t)k * Nsrc] * g0), hi = f2bf(s[(size_t)(k + 1) * Nsrc] * g1);
        *(unsigned*)(d + k) = lo | (hi << 16);
    }
}
__device__ inline void rope_item(size_t i_, float* rope) {
    const int pi = (int)(i_ / 8), f = (int)(i_ % 8);
    const int pos = pi < SEQ ? pi : PAST_LEN + (pi - SEQ);
    float c, s; rope_cs((float)pos * INV_FREQ[f], c, s);
    rope[pi * 16 + f] = c; rope[pi * 16 + 8 + f] = s;
}
__device__ inline void hinit_item(size_t i_, const float* xp, const float* xs, float* h, bf16_t* hb, float* rss0) {
    const int m = (int)i_; const float* x = m < MP ? xp + (size_t)m * D_MODEL : xs + (size_t)(m - MP) * D_MODEL;
    float s = 0.f;
    for (int k = 0; k < D_MODEL; ++k) { const float v = x[k]; s += v * v; h[(size_t)m * D_MODEL + k] = v; hb[(size_t)m * D_MODEL + k] = f2bf(v); }
    rss0[m] = s;
}
__device__ inline void hupd_item(size_t i_, float* h, const float* y, float coef, bf16_t* hb, float* rss) {
    const int m = (int)i_; float s = 0.f;
    for (int k = 0; k < D_MODEL; ++k) { const float v = h[(size_t)m * D_MODEL + k] + coef * y[(size_t)m * D_MODEL + k]; s += v * v; h[(size_t)m * D_MODEL + k] = v; hb[(size_t)m * D_MODEL + k] = f2bf(v); }
    rss[m] = s;
}
__device__ inline float dot_bf(const bf16_t* a, const bf16_t* b, int K) { float s = 0.f; for (int k = 0; k < K; ++k) s += bf2f(a[k]) * bf2f(b[k]); return s; }
__device__ inline float silu_f(float g) { return g / (1.0f + expf(-g)); }
__device__ inline void ref_ffn_in_item(size_t i_, const bf16_t* hb, const float* rss, const bf16_t* Bt, bf16_t* act) {
    const int m = (int)(i_ / D_FF), j = (int)(i_ % D_FF);
    const float rs = 1.0f / sqrtf(rss[m] / D_MODEL + EPS);
    const int ng = (j / 128) * 256 + (j % 128);
    const float g = rs * dot_bf(hb + (size_t)m * D_MODEL, Bt + (size_t)ng * D_MODEL, D_MODEL), u = rs * dot_bf(hb + (size_t)m * D_MODEL, Bt + (size_t)(ng + 128) * D_MODEL, D_MODEL);
    act[i_] = f2bf(silu_f(g) * u);
}
__device__ inline void ref_resid_row_item(size_t i_, const bf16_t* A, int K, const bf16_t* Bt, float coef, float* h, bf16_t* hb, float* rss_next, float* yout) {
    const int m = (int)i_; float s = 0.f;
    for (int c = 0; c < D_MODEL; ++c) {
        const float v = h[(size_t)m * D_MODEL + c] + coef * dot_bf(A + (size_t)m * K, Bt + (size_t)c * K, K);
        if (yout) { yout[(size_t)m * D_MODEL + c] = v; } else { h[(size_t)m * D_MODEL + c] = v; hb[(size_t)m * D_MODEL + c] = f2bf(v); s += v * v; }
    }
    if (!yout) rss_next[m] = s;
}

constexpr float QSCALE_F = 0.125f * 1.4426950408889634f;
__device__ inline void qconv_item(size_t i_, const float* qn, const float* qr, bf16_t* qnb, bf16_t* qrb) { qnb[i_] = f2bf(qn[i_] * QSCALE_F); qrb[i_] = f2bf(qr[i_] * QSCALE_F); }
__host__ __device__ inline size_t kimg_off(int kv, int d0) { return (size_t)(d0 >> 3) * 1024 + (size_t)kv * 16; }
__host__ __device__ inline size_t vimg_off(int kv, int d0) { return (size_t)(d0 >> 5) * 4096 + (size_t)(kv >> 3) * 512 + (size_t)(kv & 7) * 64 + (size_t)((d0 & 31) >> 3) * 16; }
__device__ inline void put_chunk(unsigned char* dst, const float* src) { bf16_t* d = (bf16_t*)dst; for (int k = 0; k < 8; ++k) d[k] = f2bf(src[k]); }
__device__ inline void kvimg_item(size_t i_, const float* out, const float* winrows, unsigned char* ksel, unsigned char* vsel, unsigned char* kwin, unsigned char* vwin) {
    const int c = (int)(i_ % 8), t = (int)((i_ / 8) % SEQ), g = (int)((i_ / (8 * (size_t)SEQ)) % N_KV), n = (int)(i_ / (8 * (size_t)SEQ * N_KV));
    const size_t base = (((size_t)n * N_KV + g) * (SEQ / 64) + t / 64) * 8192; const int kv = t % 64, d0 = 8 * c; const size_t m = (size_t)n * SEQ + t;
    put_chunk(ksel + base + kimg_off(kv, d0), out + O_KVP + ((m * 4 + 2) * N_KV + g) * HD + d0);
    put_chunk(vsel + base + vimg_off(kv, d0), out + O_KVP + ((m * 4 + 3) * N_KV + g) * HD + d0);
    put_chunk(kwin + base + kimg_off(kv, d0), winrows + ((m * 2 + 0) * N_KV + g) * HD + d0);
    put_chunk(vwin + base + vimg_off(kv, d0), winrows + ((m * 2 + 1) * N_KV + g) * HD + d0);
}
__device__ inline void kcimg_item(size_t i_, const float* kc, const float* vc, unsigned char* kci, unsigned char* vci) {
    const int c = (int)(i_ % 8), cb = (int)((i_ / 8) % NBC_P), g = (int)((i_ / (8 * (size_t)NBC_P)) % N_KV), n = (int)(i_ / (8 * (size_t)NBC_P * N_KV));
    const size_t base = (((size_t)n * N_KV + g) * (NBC_P / 64) + cb / 64) * 8192; const int kv = cb % 64, d0 = 8 * c;
    put_chunk(kci + base + kimg_off(kv, d0), kc + (((size_t)n * NBC_MAX + cb) * N_KV + g) * HD + d0);
    put_chunk(vci + base + vimg_off(kv, d0), vc + (((size_t)n * NBC_MAX + cb) * N_KV + g) * HD + d0);
}

constexpr int NBC_PAST = PAST_LEN / L_CMP;
constexpr int RS_CMP = DEC_BATCH * NBC_PAST * N_KV, RP_CMP = BATCH * NBC_P * N_KV;
__device__ inline void acmp_sample_item(size_t i_, const float* cache_kv, const int* page_table, const float* pe, bf16_t* A) {
    const int c8 = (int)(i_ % 8), l = (int)((i_ / 8) % L_CMP); const size_t rr = i_ / (8 * L_CMP); const int r = (int)(rr % RS_CMP), e = (int)(rr / RS_CMP);
    const int g = r % N_KV, c = (r / N_KV) % NBC_PAST, b = r / (N_KV * NBC_PAST), tok = c * L_CMP + l;
    const int page = page_table[b * N_PAGES + tok / PAGE_SIZE];
    const float* src = cache_kv + ((((size_t)page * PAGE_SIZE + tok % PAGE_SIZE) * 4 + e) * N_KV + g) * HD + 8 * c8; const float* pp = pe + ((size_t)e * L_CMP + l) * HD + 8 * c8;
    bf16_t* d = A + ((size_t)e * RS_CMP + r) * (L_CMP * HD) + l * HD + 8 * c8;
#ifndef CPU_TEST
    typedef float f4 __attribute__((ext_vector_type(4))); typedef unsigned u4 __attribute__((ext_vector_type(4)));
    const f4 a0 = __builtin_nontemporal_load((const f4*)src) + *(const f4*)pp, a1 = __builtin_nontemporal_load((const f4*)(src + 4)) + *(const f4*)(pp + 4);
    u4 w; w.x = (unsigned)f2bf(a0[0]) | ((unsigned)f2bf(a0[1]) << 16); w.y = (unsigned)f2bf(a0[2]) | ((unsigned)f2bf(a0[3]) << 16);
    w.z = (unsigned)f2bf(a1[0]) | ((unsigned)f2bf(a1[1]) << 16); w.w = (unsigned)f2bf(a1[2]) | ((unsigned)f2bf(a1[3]) << 16);
    *(u4*)d = w;
#else
    for (int k = 0; k < 8; ++k) d[k] = f2bf(src[k] + pp[k]);
#endif
}
__device__ inline void acmp_prompt_item(size_t i_, const float* out, const float* pe, bf16_t* A) {
    const int c8 = (int)(i_ % 8), l = (int)((i_ / 8) % L_CMP); const size_t rr = i_ / (8 * L_CMP); const int r = (int)(rr % RP_CMP), e = (int)(rr / RP_CMP);
    const int g = r % N_KV, c = (r / N_KV) % NBC_P, n = r / (N_KV * NBC_P), tok = c * L_CMP + l;
    const float* src = out + O_KVP + ((((size_t)n * SEQ + tok) * 4 + e) * N_KV + g) * HD + 8 * c8; const float* pp = pe + ((size_t)e * L_CMP + l) * HD + 8 * c8;
    bf16_t* d = A + ((size_t)e * RP_CMP + r) * (L_CMP * HD) + l * HD + 8 * c8;
    for (int k = 0; k < 8; ++k) d[k] = f2bf(src[k] + pp[k]);
}
__device__ inline void cmp_out_b_item(size_t i_, const bf16_t* hid, int R, int nbc, int seq0, const float* w2, const float* k_norm0, float* kc, float* vc) {
    const int r = (int)(i_ % R), e = (int)(i_ / R); const int g = r % N_KV, c = (r / N_KV) % nbc, sq = r / (N_KV * nbc);
    const bf16_t* hr = hid + ((size_t)e * R + r) * CMP_HID;
    float v[HD];
    for (int d = 0; d < HD; ++d) v[d] = 0.f;
    for (int f = 0; f < CMP_HID; ++f) { const float hf = bf2f(hr[f]); const float* w = w2 + ((size_t)e * CMP_HID + f) * HD; for (int d = 0; d < HD; ++d) v[d] += hf * w[d]; }
    if (e == 0) head_norm(v, k_norm0);
    float* o = (e == 0 ? kc : vc) + (((size_t)(seq0 + sq) * NBC_MAX + c) * N_KV + g) * HD;
    for (int d = 0; d < HD; ++d) o[d] = v[d];
}
__host__ __device__ inline int heads_row(int hidx, int d) { return (hidx / 4) * 256 + 128 * (d / 32) + 32 * (hidx % 4) + (d % 32); }
__device__ inline void conv_state_store(float* out, int layer, int m, int ch, float u) {
    const RowInfo ri = row_info(m); const int L = seq_len(ri.seq);
    if (ri.t >= L - 2) { const int j = ri.t - (L - 2);
        if (ri.seq < BATCH) out[O_CP + (((size_t)layer * BATCH + ri.seq) * 2 + j) * D_MODEL + ch] = u;
        else out[O_CS + (((size_t)layer * DEC_BATCH + (ri.seq - BATCH)) * 2 + j) * D_MODEL + ch] = u; }
}
__device__ inline void ref_conv_in_item(size_t i_, const bf16_t* hb, const float* rss, const bf16_t* Bt, bf16_t* ub, bf16_t* bb, float* out, int layer) {
    const int m = (int)(i_ / D_MODEL), j = (int)(i_ % D_MODEL);
    const float rs = 1.0f / sqrtf(rss[m] / D_MODEL + EPS); const bf16_t* a = hb + (size_t)m * D_MODEL;
    const int nc = (j / 128) * 256 + (j % 128);
    const float c = rs * dot_bf(a, Bt + (size_t)nc * D_MODEL, D_MODEL), x = rs * dot_bf(a, Bt + (size_t)(nc + 128) * D_MODEL, D_MODEL), b = rs * dot_bf(a, Bt + (size_t)(2 * D_MODEL + j) * D_MODEL, D_MODEL);
    const float u = c * x; ub[i_] = f2bf(u); bb[i_] = f2bf(b); conv_state_store(out, layer, m, j, u);
}
__device__ inline void conv_thin_item(size_t i_, const bf16_t* ub, const bf16_t* bb, const float* state  , const float* wc  , bf16_t* zb) {
    const int m = (int)(i_ / D_MODEL), ch = (int)(i_ % D_MODEL);
    const RowInfo ri = row_info(m);
    const float u0 = bf2f(ub[i_]);
    float u1, u2;
    if (ri.t >= 1) u1 = bf2f(ub[i_ - D_MODEL]); else u1 = (ri.seq < BATCH) ? 0.f : state[((size_t)(ri.seq - BATCH) * 2 + 1) * D_MODEL + ch];
    if (ri.t >= 2) u2 = bf2f(ub[i_ - 2 * D_MODEL]); else if (ri.seq < BATCH) u2 = 0.f;
    else u2 = (ri.t == 1) ? state[((size_t)(ri.seq - BATCH) * 2 + 1) * D_MODEL + ch] : state[((size_t)(ri.seq - BATCH) * 2 + 0) * D_MODEL + ch];
    zb[i_] = f2bf(bf2f(bb[i_]) * (wc[ch] * u2 + wc[D_MODEL + ch] * u1 + wc[2 * D_MODEL + ch] * u0));
}
__device__ inline void ref_qg_item(size_t i_, const bf16_t* hb, const float* rss, const bf16_t* Bt, const float* q_norm, const float* rope, float* qn, float* qr) {
    const int m = (int)(i_ / N_HEADS), hh = (int)(i_ % N_HEADS);
    const float rs = 1.0f / sqrtf(rss[m] / D_MODEL + EPS); const bf16_t* a = hb + (size_t)m * D_MODEL;
    float v[HD]; for (int d = 0; d < HD; ++d) v[d] = rs * dot_bf(a, Bt + (size_t)heads_row(hh, d) * D_MODEL, D_MODEL);
    head_norm(v, q_norm);
    for (int d = 0; d < HD; ++d) qn[(size_t)m * HDM + hh * HD + d] = v[d];
    const float* rt = rope + (size_t)pos_index(row_info(m).pos) * 16;
    for (int f = 0; f < 8; ++f) { const float x1 = v[f], x2 = v[8 + f]; v[f] = x1 * rt[f] - x2 * rt[8 + f]; v[8 + f] = x2 * rt[f] + x1 * rt[8 + f]; }
    for (int d = 0; d < HD; ++d) qr[(size_t)m * HDM + hh * HD + d] = v[d];
}
__device__ inline void ref_gates_item(size_t i_, const bf16_t* hb, const float* rss, const bf16_t* Bt, float* gates) {
    const int m = (int)(i_ / (3 * N_HEADS)), j = (int)(i_ % (3 * N_HEADS));
    const float rs = 1.0f / sqrtf(rss[m] / D_MODEL + EPS);
    const float x = rs * dot_bf(hb + (size_t)m * D_MODEL, Bt + (size_t)(HDM + j) * D_MODEL, D_MODEL);
    gates[i_] = 1.0f / (1.0f + expf(-x));
}
__device__ inline void kv_store(float* out, float* winrows, int m, int e, int g, int d, float v) {
    const RowInfo ri = row_info(m);
    if (e < 4) { if (ri.seq < BATCH) out[O_KVP + (((size_t)m * 4 + e) * N_KV + g) * HD + d] = v; else out[O_KVS + (((size_t)(m - MP) * 4 + e) * N_KV + g) * HD + d] = v; }
    else { const int we = e - 4;
        winrows[(((size_t)m * 2 + we) * N_KV + g) * HD + d] = v;
        if (ri.seq < BATCH) { if (ri.t >= SEQ - WINDOW) out[O_WP + ((((size_t)ri.seq * WINDOW + (ri.t - (SEQ - WINDOW))) * 2 + we) * N_KV + g) * HD + d] = v; }
        else out[O_WS + ((((size_t)(ri.seq - BATCH) * WINDOW + (WINDOW - DEC_SEQ + ri.t)) * 2 + we) * N_KV + g) * HD + d] = v; }
}
__device__ inline void ref_kv_item(size_t i_, const bf16_t* hb, const float* rss, const bf16_t* Bt, const float* k_norm, const float* rope, float* out, float* winrows) {
    const int m = (int)(i_ / (6 * N_KV)), hidx = (int)(i_ % (6 * N_KV)), e = hidx / N_KV, g = hidx % N_KV;
    const float rs = 1.0f / sqrtf(rss[m] / D_MODEL + EPS); const bf16_t* a = hb + (size_t)m * D_MODEL;
    float v[HD]; for (int d = 0; d < HD; ++d) v[d] = rs * dot_bf(a, Bt + (size_t)heads_row(hidx, d) * D_MODEL, D_MODEL);
    if (e == 2 || e == 4) { head_norm(v, k_norm + (e == 2 ? 1 : 2) * HD);
        const float* rt = rope + (size_t)pos_index(row_info(m).pos) * 16;
        for (int f = 0; f < 8; ++f) { const float x1 = v[f], x2 = v[8 + f]; v[f] = x1 * rt[f] - x2 * rt[8 + f]; v[8 + f] = x2 * rt[f] + x1 * rt[8 + f]; } }
    for (int d = 0; d < HD; ++d) kv_store(out, winrows, m, e, g, d, v[d]);
}
#ifndef CPU_TEST
#define LAS __attribute__((address_space(3)))
#define XB_TMO      128
#define XB_XCNT(j)  (256  + 64 * (j))
#define XB_XSUB(j)  (1280 + 64 * (j))
#define XB_XGEN(j)  (2304 + 64 * (j))
#define XB_TOP      3328
#define XB_TOPGEN   3392
#define XCD_BAR_WORDS 3456
#define XB_SPIN_CAP (1u << 25)
typedef __attribute__((address_space(1))) unsigned GU;
__device__ __forceinline__ unsigned xb_ld(GU* p)              { return __hip_atomic_load(p, __ATOMIC_RELAXED, __HIP_MEMORY_SCOPE_AGENT); }
__device__ __forceinline__ unsigned xb_add(GU* p, unsigned v) { return __hip_atomic_fetch_add(p, v, __ATOMIC_RELAXED, __HIP_MEMORY_SCOPE_AGENT); }
__device__ __forceinline__ unsigned xb_xcc_id() { return (unsigned)__builtin_amdgcn_s_getreg((3 << 11) | 20) & 0xFu; }
#define XB_SPIN(cond, bar) do { unsigned _sp = 0; while (cond) { __builtin_amdgcn_s_sleep(1); \
    if ((++_sp & 255u) == 0u) { if (xb_ld(&(bar)[XB_TMO])) break; if (_sp > XB_SPIN_CAP) { (void)xb_add(&(bar)[XB_TMO], 1u); break; } } } } while (0)
struct XcdBarrier { GU* bar; unsigned x; volatile LAS unsigned* st; };
__device__ __forceinline__ XcdBarrier xcd_barrier_post(GU* bar, volatile LAS unsigned* st, const bool leader_thread) {
    XcdBarrier b; b.bar = bar; b.x = xb_xcc_id(); b.st = st;
    if (leader_thread) (void)xb_add(&bar[XB_XCNT(b.x)], 1u);
    return b;
}
__device__ __forceinline__ void xcd_barrier_complete(GU* bar, unsigned x, unsigned& nloc, unsigned& nx) {
    const unsigned G = gridDim.x * gridDim.y * gridDim.z;
    unsigned sum, cnt, mine, sp = 0u;
    for (;;) {
        sum = 0u; cnt = 0u; mine = 0u;
#pragma unroll
        for (unsigned j = 0; j < 16; ++j) { const unsigned c = xb_ld(&bar[XB_XCNT(j)]); sum += c; cnt += (c > 0u) ? 1u : 0u; mine = (j == x) ? c : mine; }
        if (sum == G) break;
        __builtin_amdgcn_s_sleep(1);
        if ((++sp & 255u) == 0u) { if (xb_ld(&bar[XB_TMO])) break; if (sp > XB_SPIN_CAP) { (void)xb_add(&bar[XB_TMO], 1u); break; } }
    }
    nloc = mine > 0u ? mine : 1u; nx = cnt > 0u ? cnt : 1u;
}
__device__ __forceinline__ void xcd_barrier(const XcdBarrier& b, const bool leader_thread) {
    asm volatile("s_waitcnt vmcnt(0)" ::: "memory");
    __syncthreads();
    if (leader_thread) {
        GU* bar = b.bar; unsigned bx = xb_xcc_id(); asm volatile("" : "+s"(bx));
        __builtin_amdgcn_s_waitcnt(0);
        unsigned nloc = b.st[0], nx = b.st[1];
        if (nloc == 0u) { xcd_barrier_complete(bar, bx, nloc, nx); b.st[0] = nloc; b.st[1] = nx; }
        const unsigned old = xb_add(&bar[XB_XSUB(bx)], 1u);
        const unsigned gen = old / nloc;
        if (old + 1u == (gen + 1u) * nloc) {
            __builtin_amdgcn_fence(__ATOMIC_RELEASE, "agent");
            asm volatile("s_waitcnt vmcnt(0)" ::: "memory");
            const unsigned og = xb_add(&bar[XB_TOP], 1u);
            const unsigned tg = og / nx;
            if (og + 1u == (tg + 1u) * nx) xb_add(&bar[XB_TOPGEN], 1u);
            else XB_SPIN(xb_ld(&bar[XB_TOPGEN]) == tg, bar);
            __builtin_amdgcn_fence(__ATOMIC_ACQUIRE, "agent");
            xb_add(&bar[XB_XGEN(bx)], 1u);
            asm volatile("s_waitcnt vmcnt(0)" ::: "memory");
        } else {
            XB_SPIN(xb_ld(&bar[XB_XGEN(bx)]) == gen, bar);
            __builtin_amdgcn_fence(__ATOMIC_ACQUIRE, "agent");
            asm volatile("s_waitcnt vmcnt(0)" ::: "memory");
        }
    }
    __syncthreads();
}

namespace pg8 {
#define PG8_LAS __attribute__((address_space(3)))
typedef unsigned short bf16_t;
typedef short bf16x8 __attribute__((ext_vector_type(8)));
typedef float f32x4 __attribute__((ext_vector_type(4)));
typedef unsigned u32x4 __attribute__((ext_vector_type(4)));
constexpr int BM = 256, BK = 64, HALF = 128, HTB = HALF * BK * 2  , STAGE_BYTES = 8 * HTB, NXCD = 8, WGM = 8;

__host__ __device__ __forceinline__ int lds_byte(int r, int c) { const int st = (r >> 4) * 2 + (c >> 5), rr = r & 15, cc = c & 31, ob = rr * 64 + cc * 2; return st * 1024 + (ob ^ (((ob >> 9) & 1) << 5)); }
__host__ __device__ __forceinline__ void stage_rc(int b, int& R, int& C) { const int st = b / 1024, sb = b % 1024, swz = sb ^ (((sb >> 9) & 1) << 5); R = (st >> 1) * 16 + swz / 64; C = (st & 1) * 32 + (swz % 64) / 2; }
__host__ __device__ __forceinline__ int perm32(int rho) { const int n = rho >> 4, i = rho & 15; return 8 * (i >> 2) + 4 * n + (i & 3); }

struct Unit { int pm, pn; };
struct Gemm { const bf16_t* A; const bf16_t* Bt; int M, N, K; };

struct StaticOrder {
    int nM, nN, nwg, G, c;
    __host__ __device__ void init(int M, int N, int G_, int c_) { nM = M / BM; nN = N / BM; nwg = nM * nN; G = G_; c = c_; }
    __host__ __device__ bool next(int i, Unit& u) const {
        const long L = (long)i * G + c; if (L >= nwg) return false;
        int wgid = (int)L; { const int q = nwg / NXCD, r = nwg % NXCD, xcd = wgid % NXCD, off = wgid / NXCD; wgid = (xcd < r ? xcd * (q + 1) : r * (q + 1) + (xcd - r) * q) + off; }
        const int nig = WGM * nN, gid = wgid / nig, fm = gid * WGM, gsz = (nM - fm) < WGM ? (nM - fm) : WGM;
        u.pm = fm + ((wgid % nig) % gsz); u.pn = (wgid % nig) / gsz; return true;
    }
    __device__ __forceinline__ void a_ready(const Unit&) const {}
    __device__ __forceinline__ void done(const Unit&) const {}
};

__device__ __forceinline__ unsigned cvt_pk_bf16(float lo, float hi) { unsigned r; asm volatile("v_cvt_pk_bf16_f32 %0, %1, %2" : "=v"(r) : "v"(lo), "v"(hi)); return r; }
template <class Epi, class Sched, bool ALIGN_EPI = false, bool SP2 = false>
__device__ __forceinline__ void gemm_phase(int wave_id_, PG8_LAS unsigned char* lds, const Gemm g, const Sched& S, const Epi& E) {
    int wid = wave_id_, lane = (int)lane_id_v(); asm volatile("" : "+s"(wid));
    const int tid = wid * 64 + lane, wr = wid >> 2, wc = wid & 3, fr = lane & 15, fq = lane >> 4;
    const int K = g.K, nt = K / BK;
    unsigned voffA[2], voffB[2];
#pragma unroll
    for (int i = 0; i < 2; ++i) { int R, C; stage_rc(tid * 16 + i * 8192, R, C); const int Rb = Epi::PERM ? ((R & ~31) + perm32(R & 31)) : R;
        voffA[i] = (unsigned)(R * K + C) * 2u; voffB[i] = (unsigned)(Rb * K + C) * 2u; }
    const size_t kstep = (size_t)(BK * 2);
    const size_t hstep = (size_t)HALF * K * 2;
    const size_t tstep = 2 * hstep;
    const unsigned ldsw = (unsigned)wid * 1024u;
    const int aoff = lds_byte(wr * 64 + fr, fq * 8), boff = lds_byte(wc * 32 + fr, fq * 8);
#define PG8_SA(b, h) (((b) * 2 + (h)) * HTB)
#define PG8_SB(b, h) ((4 + (b) * 2 + (h)) * HTB)
#define PG8_STAGE(bufoff, gbase, voff) do { _Pragma("unroll") for (int _i = 0; _i < 2; ++_i) \
        __builtin_amdgcn_global_load_lds((const unsigned*)((const char*)(gbase) + (voff)[_i]), (PG8_LAS unsigned*)(lds + (bufoff) + ldsw + _i * 8192), 16, 0, 0); } while (0)
#define PG8_LDA(dst, b, h) do { _Pragma("unroll") for (int m = 0; m < 4; ++m) _Pragma("unroll") for (int k = 0; k < 2; ++k) dst[m][k] = *(const PG8_LAS bf16x8*)(lds + PG8_SA(b, h) + aoff + m * 2048 + k * 1024); } while (0)
#define PG8_LDB(dst, b, h) do { _Pragma("unroll") for (int n = 0; n < 2; ++n) _Pragma("unroll") for (int k = 0; k < 2; ++k) dst[n][k] = *(const PG8_LAS bf16x8*)(lds + PG8_SB(b, h) + boff + n * 2048 + k * 1024); } while (0)
#define PG8_MMA(ai, bj, At, Bt) do { __builtin_amdgcn_s_setprio(1); _Pragma("unroll") for (int m = 0; m < 4; ++m) _Pragma("unroll") for (int n = 0; n < 2; ++n) _Pragma("unroll") for (int k = 0; k < 2; ++k) \
        acc[ai][bj][m][n] = __builtin_amdgcn_mfma_f32_16x16x32_bf16(Bt[n][k], At[m][k], acc[ai][bj][m][n], 0, 0, 0); __builtin_amdgcn_s_setprio(0); } while (0)
#define PG8_WAIT_V(n) asm volatile("s_waitcnt vmcnt(" #n ")" ::: "memory")
#define PG8_WAIT_L(n) asm volatile("s_waitcnt lgkmcnt(" #n ")" ::: "memory")
#define PG8_BAR __builtin_amdgcn_s_barrier()
#define PG8_SCHED __builtin_amdgcn_sched_barrier(0)
    Unit cur, nxt; int ui = 0; float rsv[8];
#pragma unroll
    for (int i_ = 0; i_ < 8; ++i_) rsv[i_] = 0.f;
    if (!S.next(0, cur)) return;
    f32x4 acc[2][2][4][2];
#pragma unroll
    for (int a = 0; a < 2; ++a)
#pragma unroll
        for (int b = 0; b < 2; ++b)
#pragma unroll
            for (int m = 0; m < 4; ++m)
#pragma unroll
                for (int n = 0; n < 2; ++n) acc[a][b][m][n] = (f32x4){0.f, 0.f, 0.f, 0.f};
    bf16x8 At[4][2], B0[2][2], B1[2][2];
    const char* cA = (const char*)g.A + (size_t)cur.pm * tstep; const char* cB = (const char*)g.Bt + (size_t)cur.pn * tstep;
    S.a_ready(cur);
    if constexpr (SP2) {
        PG8_STAGE(PG8_SB(0, 0), cB, voffB); PG8_STAGE(PG8_SB(0, 1), cB + hstep, voffB); PG8_STAGE(PG8_SA(0, 0), cA, voffA); PG8_STAGE(PG8_SA(0, 1), cA + hstep, voffA);
        if (wr == 1) PG8_BAR;
        PG8_WAIT_V(2); PG8_BAR;
        PG8_STAGE(PG8_SB(1, 0), cB + kstep, voffB); PG8_STAGE(PG8_SA(1, 0), cA + kstep, voffA); PG8_STAGE(PG8_SB(1, 1), cB + hstep + kstep, voffB);
        PG8_WAIT_V(6); PG8_BAR;
    } else {
        PG8_STAGE(PG8_SB(0, 0), cB, voffB); PG8_STAGE(PG8_SA(0, 0), cA, voffA); PG8_STAGE(PG8_SB(0, 1), cB + hstep, voffB); PG8_STAGE(PG8_SA(0, 1), cA + hstep, voffA);
        if (wr == 1) PG8_BAR;
        PG8_WAIT_V(4); PG8_BAR;
        PG8_STAGE(PG8_SB(1, 0), cB + kstep, voffB); PG8_STAGE(PG8_SA(1, 0), cA + kstep, voffA); PG8_STAGE(PG8_SB(1, 1), cB + hstep + kstep, voffB);
        PG8_WAIT_V(6); PG8_BAR;
    }
    for (;;) {
        const bool has_next = S.next(ui + 1, nxt);
        const char* nA = has_next ? (const char*)g.A + (size_t)nxt.pm * tstep : cA; const char* nB = has_next ? (const char*)g.Bt + (size_t)nxt.pn * tstep : cB;
        for (int t = 0; t < nt; t += 2) {
            const bool last = (t == nt - 2);
            const char* a1 = cA + (size_t)(t + 1) * kstep;
            const char* a2 = last ? nA : cA + (size_t)(t + 2) * kstep; const char* b2 = last ? nB : cB + (size_t)(t + 2) * kstep;
            const char* a3 = a2 + kstep; const char* b3 = b2 + kstep;
            if (last && has_next) S.a_ready(nxt);
            if (last) E.pre(cur, wr, fr, rsv);
            if constexpr (SP2) {
            PG8_LDB(B0, 0, 0); PG8_LDB(B1, 0, 1); PG8_SCHED; PG8_LDA(At, 0, 0); PG8_STAGE(PG8_SA(1, 1), a1 + hstep, voffA);
            PG8_WAIT_V(8); PG8_WAIT_L(0); PG8_BAR; PG8_MMA(0, 0, At, B0); PG8_MMA(0, 1, At, B1); PG8_BAR; PG8_SCHED;
            PG8_LDA(At, 0, 1); PG8_STAGE(PG8_SB(0, 0), b2, voffB); PG8_STAGE(PG8_SB(0, 1), b2 + hstep, voffB); PG8_STAGE(PG8_SA(0, 0), a2, voffA);
            PG8_WAIT_V(8); PG8_WAIT_L(0); PG8_BAR; PG8_MMA(1, 0, At, B0); PG8_MMA(1, 1, At, B1); PG8_BAR; PG8_SCHED;
            PG8_LDB(B0, 1, 0); PG8_LDB(B1, 1, 1); PG8_SCHED; PG8_LDA(At, 1, 0); PG8_STAGE(PG8_SA(0, 1), a2 + hstep, voffA);
            PG8_WAIT_V(8); PG8_WAIT_L(0); PG8_BAR; PG8_MMA(0, 0, At, B0); PG8_MMA(0, 1, At, B1); PG8_BAR; PG8_SCHED;
            PG8_LDA(At, 1, 1); PG8_STAGE(PG8_SB(1, 0), b3, voffB); PG8_STAGE(PG8_SB(1, 1), b3 + hstep, voffB); PG8_STAGE(PG8_SA(1, 0), a3, voffA);
            PG8_WAIT_V(8); PG8_WAIT_L(0); PG8_BAR; PG8_MMA(1, 0, At, B0); PG8_MMA(1, 1, At, B1); PG8_BAR; PG8_SCHED;
            } else {
            PG8_LDB(B0, 0, 0); PG8_SCHED; PG8_LDA(At, 0, 0); PG8_STAGE(PG8_SA(1, 1), a1 + hstep, voffA);
            PG8_WAIT_L(8); PG8_BAR; PG8_WAIT_L(0); PG8_MMA(0, 0, At, B0); PG8_BAR; PG8_SCHED;
            PG8_LDB(B1, 0, 1); PG8_STAGE(PG8_SB(0, 0), b2, voffB);
            PG8_BAR; PG8_WAIT_L(0); PG8_MMA(0, 1, At, B1); PG8_BAR;
            PG8_LDA(At, 0, 1); PG8_STAGE(PG8_SA(0, 0), a2, voffA);
            PG8_BAR; PG8_WAIT_L(0); PG8_MMA(1, 0, At, B0); PG8_BAR; PG8_SCHED;
            PG8_STAGE(PG8_SB(0, 1), b2 + hstep, voffB);
            PG8_WAIT_V(6); PG8_BAR; PG8_MMA(1, 1, At, B1); PG8_BAR;
            PG8_LDB(B0, 1, 0); PG8_SCHED; PG8_LDA(At, 1, 0); PG8_STAGE(PG8_SA(0, 1), a2 + hstep, voffA);
            PG8_WAIT_L(8); PG8_BAR; PG8_WAIT_L(0); PG8_MMA(0, 0, At, B0); PG8_BAR; PG8_SCHED;
            PG8_LDB(B1, 1, 1); PG8_STAGE(PG8_SB(1, 0), b3, voffB);
            PG8_BAR; PG8_WAIT_L(0); PG8_MMA(0, 1, At, B1); PG8_BAR;
            PG8_LDA(At, 1, 1); PG8_STAGE(PG8_SA(1, 0), a3, voffA);
            PG8_BAR; PG8_WAIT_L(0); PG8_MMA(1, 0, At, B0); PG8_BAR; PG8_SCHED;
            PG8_STAGE(PG8_SB(1, 1), b3 + hstep, voffB);
            PG8_WAIT_V(6); PG8_BAR; PG8_MMA(1, 1, At, B1); PG8_BAR;
            }
        }
        if constexpr (ALIGN_EPI) { if (wr == 0) PG8_BAR; }
        if constexpr (!Epi::AFTER_DRAIN) { E(acc, cur, wr, wc, fr, fq, rsv); S.done(cur); }
        if (!has_next) break;
#pragma unroll
        for (int a = 0; a < 2; ++a)
#pragma unroll
            for (int b = 0; b < 2; ++b)
#pragma unroll
                for (int m = 0; m < 4; ++m)
#pragma unroll
                    for (int n = 0; n < 2; ++n) acc[a][b][m][n] = (f32x4){0.f, 0.f, 0.f, 0.f};
        cur = nxt; cA = nA; cB = nB; ++ui;
        if constexpr (ALIGN_EPI) { if (wr == 1) PG8_BAR; }
    }
    PG8_WAIT_V(0);
    if constexpr (!ALIGN_EPI) { if (wr == 0) PG8_BAR; }
    PG8_BAR;
    if constexpr (Epi::AFTER_DRAIN) { E.fused(acc, cur, wr, wc, fr, fq, lds, wid, lane); S.done(cur); }
#undef PG8_SA
#undef PG8_SB
#undef PG8_STAGE
#undef PG8_LDA
#undef PG8_LDB
#undef PG8_MMA
#undef PG8_WAIT_V
#undef PG8_WAIT_L
#undef PG8_BAR
#undef PG8_SCHED
}
}

namespace pg8 {
__device__ __forceinline__ float fast_silu(float g) { return g * __builtin_amdgcn_rcpf(1.0f + __expf(-g)); }
__device__ __forceinline__ float row_rs(const float* rss, int row) { return rsqrtf(rss[row] * (1.0f / D_MODEL) + EPS); }
struct EpiSwiglu {
    static constexpr bool PERM = true, AFTER_DRAIN = false;
    bf16_t* act; const float* rss;
    __device__ __forceinline__ void pre(const Unit& u, int wr, int fr, float (&rsv)[8]) const {
        const __attribute__((address_space(1))) float* rp = (const __attribute__((address_space(1))) float*)rss + u.pm * BM + wr * 64 + fr;
#pragma unroll
        for (int ai = 0; ai < 2; ++ai)
#pragma unroll
            for (int m = 0; m < 4; ++m) rsv[ai * 4 + m] = rp[ai * HALF + m * 16];
    }
    __device__ __forceinline__ void operator()(const f32x4 (&acc)[2][2][4][2], const Unit& u, int wr, int wc, int fr, int fq, const float (&rsv)[8]) const {
        const int row0 = u.pm * BM + wr * 64 + fr, col0 = u.pn * 128 + wc * 32 + 8 * fq;
#pragma unroll
        for (int ai = 0; ai < 2; ++ai)
#pragma unroll
            for (int m = 0; m < 4; ++m) {
                const int row = row0 + ai * HALF + m * 16; const float rs = rsqrtf(rsv[ai * 4 + m] * (1.0f / D_MODEL) + EPS);
                float a[8];
#pragma unroll
                for (int n = 0; n < 2; ++n)
#pragma unroll
                    for (int i = 0; i < 4; ++i) a[n * 4 + i] = fast_silu(acc[ai][0][m][n][i] * rs) * (acc[ai][1][m][n][i] * rs);
                u32x4 w; w.x = cvt_pk_bf16(a[0], a[1]); w.y = cvt_pk_bf16(a[2], a[3]); w.z = cvt_pk_bf16(a[4], a[5]); w.w = cvt_pk_bf16(a[6], a[7]);
                *(u32x4*)(act + (size_t)row * D_FF + col0) = w;
            }
    }
};
struct EpiResid {
    static constexpr bool PERM = false, AFTER_DRAIN = false;
    float* h; bf16_t* hb; float* rss_next; float* yout; float coef;
    __device__ __forceinline__ void pre(const Unit&, int, int, float (&)[8]) const {}
    __device__ __forceinline__ void operator()(const f32x4 (&acc)[2][2][4][2], const Unit& u, int wr, int wc, int fr, int fq, const float (&rsv)[8]) const {
        const int row0 = u.pm * BM + wr * 64 + fr, col0 = u.pn * BM + wc * 32 + 4 * fq;
#pragma unroll
        for (int ai = 0; ai < 2; ++ai)
#pragma unroll
            for (int m = 0; m < 4; ++m) {
                const int row = row0 + ai * HALF + m * 16; float s = 0.f;
                float* hr = h + (size_t)row * D_MODEL + col0;
#pragma unroll
                for (int bj = 0; bj < 2; ++bj)
#pragma unroll
                    for (int n = 0; n < 2; ++n) {
                        const int co = bj * HALF + n * 16;
                        const f32x4 v = *(const f32x4*)(hr + co) + acc[ai][bj][m][n] * coef;
                        if (yout) { *(f32x4*)(yout + (size_t)row * D_MODEL + col0 + co) = v; }
                        else {
                            *(f32x4*)(hr + co) = v;
                            typedef unsigned u32x2 __attribute__((ext_vector_type(2)));
                            u32x2 w; w.x = cvt_pk_bf16(v[0], v[1]); w.y = cvt_pk_bf16(v[2], v[3]);
                            *(u32x2*)(hb + (size_t)row * D_MODEL + col0 + co) = w;
                            s += (v[0] * v[0] + v[1] * v[1]) + (v[2] * v[2] + v[3] * v[3]);
                        }
                    }
                if (!yout) { s += __shfl_xor(s, 16); s += __shfl_xor(s, 32); if (fq == 0) (void)__hip_atomic_fetch_add(rss_next + row, s, __ATOMIC_RELAXED, __HIP_MEMORY_SCOPE_AGENT); }
            }
    }
};
}
namespace pg8 {
__device__ __forceinline__ float sum4(f32x4 v) { return (v[0] * v[0] + v[1] * v[1]) + (v[2] * v[2] + v[3] * v[3]); }
struct EpiConvIn {
    static constexpr bool PERM = true, AFTER_DRAIN = false;
    bf16_t* ub; bf16_t* bb; const float* rss; float* out; int layer;
    __device__ __forceinline__ void pre(const Unit& u, int wr, int fr, float (&rsv)[8]) const {
        const __attribute__((address_space(1))) float* rp = (const __attribute__((address_space(1))) float*)rss + u.pm * BM + wr * 64 + fr;
#pragma unroll
        for (int ai = 0; ai < 2; ++ai)
#pragma unroll
            for (int m = 0; m < 4; ++m) rsv[ai * 4 + m] = rp[ai * HALF + m * 16];
    }
    __device__ __forceinline__ void operator()(const f32x4 (&acc)[2][2][4][2], const Unit& u, int wr, int wc, int fr, int fq, const float (&rsv)[8]) const {
        const int row0 = u.pm * BM + wr * 64 + fr;
        const bool pair = u.pn < D_MODEL / 128;
#pragma unroll
        for (int ai = 0; ai < 2; ++ai)
#pragma unroll
            for (int m = 0; m < 4; ++m) {
                const int row = row0 + ai * HALF + m * 16; const float rs = rsqrtf(rsv[ai * 4 + m] * (1.0f / D_MODEL) + EPS);
                if (pair) {
                    const int col0 = u.pn * 128 + wc * 32 + 8 * fq; float a[8];
#pragma unroll
                    for (int n = 0; n < 2; ++n)
#pragma unroll
                        for (int i = 0; i < 4; ++i) a[n * 4 + i] = (acc[ai][0][m][n][i] * rs) * (acc[ai][1][m][n][i] * rs);
                    u32x4 w; w.x = cvt_pk_bf16(a[0], a[1]); w.y = cvt_pk_bf16(a[2], a[3]); w.z = cvt_pk_bf16(a[4], a[5]); w.w = cvt_pk_bf16(a[6], a[7]);
                    *(u32x4*)(ub + (size_t)row * D_MODEL + col0) = w;
                    const RowInfo ri = row_info(row); const int jj = ri.t - (seq_len(ri.seq) - 2);
                    if (jj >= 0) {
                        float* cs = (ri.seq < BATCH) ? out + O_CP + (((size_t)layer * BATCH + ri.seq) * 2 + jj) * D_MODEL + col0 : out + O_CS + (((size_t)layer * DEC_BATCH + (ri.seq - BATCH)) * 2 + jj) * D_MODEL + col0;
                        *(f32x4*)(cs) = (f32x4){a[0], a[1], a[2], a[3]}; *(f32x4*)(cs + 4) = (f32x4){a[4], a[5], a[6], a[7]};
                    }
                } else {
#pragma unroll
                    for (int bj = 0; bj < 2; ++bj) {
                        const int col0 = (u.pn - D_MODEL / 128) * 256 + bj * HALF + wc * 32 + 8 * fq;
                        const f32x4 v0 = acc[ai][bj][m][0] * rs, v1 = acc[ai][bj][m][1] * rs;
                        u32x4 w; w.x = cvt_pk_bf16(v0[0], v0[1]); w.y = cvt_pk_bf16(v0[2], v0[3]); w.z = cvt_pk_bf16(v1[0], v1[1]); w.w = cvt_pk_bf16(v1[2], v1[3]);
                        *(u32x4*)(bb + (size_t)row * D_MODEL + col0) = w;
                    }
                }
                asm volatile("" ::: "memory");
            }
    }
};
__device__ __forceinline__ void head_norm_rope(f32x4 (&v)[2][2], const float* gain, const float* rt  , int fq, bool do_norm, bool do_rope, f32x4 (&rot0)[2]) {
    if (do_norm) {
        float ss = (sum4(v[0][0]) + sum4(v[0][1])) + (sum4(v[1][0]) + sum4(v[1][1]));
        ss += __shfl_xor(ss, 16); ss += __shfl_xor(ss, 32);
        const float r = rsqrtf(ss * (1.0f / HD) + EPS);
#pragma unroll
        for (int bj = 0; bj < 2; ++bj)
#pragma unroll
            for (int n = 0; n < 2; ++n) { const f32x4 g = *(const f32x4*)(gain + 32 * bj + 8 * fq + 4 * n); v[bj][n] = v[bj][n] * r * g; }
    }
    rot0[0] = v[0][0]; rot0[1] = v[0][1];
    if (do_rope) {
#pragma unroll
        for (int n = 0; n < 2; ++n) {
            f32x4 p;
#pragma unroll
            for (int i = 0; i < 4; ++i) p[i] = __shfl_xor(v[0][n][i], 16);
            const f32x4 c = *(const f32x4*)(rt + 4 * n), s = *(const f32x4*)(rt + 8 + 4 * n);
            if (fq == 0) rot0[n] = v[0][n] * c - p * s; else if (fq == 1) rot0[n] = v[0][n] * c + p * s;
        }
    }
}
__device__ __forceinline__ u32x4 pack8(const f32x4 a, const f32x4 b, float sc) { u32x4 w; w.x = cvt_pk_bf16(a[0] * sc, a[1] * sc); w.y = cvt_pk_bf16(a[2] * sc, a[3] * sc); w.z = cvt_pk_bf16(b[0] * sc, b[1] * sc); w.w = cvt_pk_bf16(b[2] * sc, b[3] * sc); return w; }
struct EpiQG {
    static constexpr bool PERM = true, AFTER_DRAIN = false;
    bf16_t* qnb; bf16_t* qrb; float* gates; const float* rss; const float* q_norm; const float* rope;
    __device__ __forceinline__ void pre(const Unit& u, int wr, int fr, float (&rsv)[8]) const {
        const __attribute__((address_space(1))) float* rp = (const __attribute__((address_space(1))) float*)rss + u.pm * BM + wr * 64 + fr;
#pragma unroll
        for (int ai = 0; ai < 2; ++ai)
#pragma unroll
            for (int m = 0; m < 4; ++m) rsv[ai * 4 + m] = rp[ai * HALF + m * 16];
    }
    __device__ __forceinline__ void operator()(const f32x4 (&acc)[2][2][4][2], const Unit& u, int wr, int wc, int fr, int fq, const float (&rsv)[8]) const {
        const int row0 = u.pm * BM + wr * 64 + fr;
#pragma unroll
        for (int ai = 0; ai < 2; ++ai)
#pragma unroll
            for (int m = 0; m < 4; ++m) {
                const int row = row0 + ai * HALF + m * 16; const float rs = rsqrtf(rsv[ai * 4 + m] * (1.0f / D_MODEL) + EPS);
                if (u.pn < N_HEADS / 4) {
                    const int hh = u.pn * 4 + wc;
                    f32x4 v[2][2] = {{acc[ai][0][m][0] * rs, acc[ai][0][m][1] * rs}, {acc[ai][1][m][0] * rs, acc[ai][1][m][1] * rs}}; f32x4 rot0[2];
                    head_norm_rope(v, q_norm, rope + (size_t)pos_index(row_info(row).pos) * 16, fq, true, true, rot0);
                    const size_t o = (size_t)row * HDM + hh * HD + 8 * fq;
                    const u32x4 hi8 = pack8(v[1][0], v[1][1], QSCALE_F);
                    *(u32x4*)(qnb + o) = pack8(v[0][0], v[0][1], QSCALE_F); *(u32x4*)(qnb + o + 32) = hi8;
                    *(u32x4*)(qrb + o) = pack8(rot0[0], rot0[1], QSCALE_F); *(u32x4*)(qrb + o + 32) = hi8;
                } else {
                    const int c0 = wc * 32 + 8 * fq;
#pragma unroll
                    for (int n = 0; n < 2; ++n)
#pragma unroll
                        for (int i = 0; i < 4; ++i) { const int c = c0 + 4 * n + i; if (c < 3 * N_HEADS) gates[(size_t)row * 3 * N_HEADS + c] = __builtin_amdgcn_rcpf(1.0f + __expf(-(acc[ai][0][m][n][i] * rs))); }
                }
                asm volatile("" ::: "memory");
            }
    }
};
struct EpiKV {
    static constexpr bool PERM = true, AFTER_DRAIN = false;
    float* out; float* winrows; const float* rss; const float* k_norm; const float* rope;
    unsigned char* ksel; unsigned char* vsel; unsigned char* kwin; unsigned char* vwin; bf16_t* acp; const float* pe;
    __device__ __forceinline__ void pre(const Unit&, int, int, float (&)[8]) const {}
    __device__ __forceinline__ void operator()(const f32x4 (&acc)[2][2][4][2], const Unit& u, int wr, int wc, int fr, int fq, const float (&rsv)[8]) const {
        const int row0 = u.pm * BM + wr * 64 + fr;
        const int hidx = u.pn * 4 + wc, e = hidx / N_KV, g = hidx % N_KV; const bool nr = (e == 2 || e == 4);
#pragma unroll
        for (int ai = 0; ai < 2; ++ai)
#pragma unroll
            for (int m = 0; m < 4; ++m) {
                const int row = row0 + ai * HALF + m * 16; const float rs = row_rs(rss, row);
                const RowInfo ri = row_info(row);
                f32x4 v[2][2] = {{acc[ai][0][m][0] * rs, acc[ai][0][m][1] * rs}, {acc[ai][1][m][0] * rs, acc[ai][1][m][1] * rs}}; f32x4 rot0[2];
                head_norm_rope(v, k_norm + (e == 2 ? 1 : 2) * HD, rope + (size_t)pos_index(ri.pos) * 16, fq, nr, nr, rot0);
                float* d0; float* d1 = nullptr;
                if (e < 4) d0 = (ri.seq < BATCH) ? out + O_KVP + (((size_t)row * 4 + e) * N_KV + g) * HD : out + O_KVS + (((size_t)(row - MP) * 4 + e) * N_KV + g) * HD;
                else { const int we = e - 4; d0 = winrows + (((size_t)row * 2 + we) * N_KV + g) * HD;
                    if (ri.seq < BATCH) { if (ri.t >= SEQ - WINDOW) d1 = out + O_WP + ((((size_t)ri.seq * WINDOW + (ri.t - (SEQ - WINDOW))) * 2 + we) * N_KV + g) * HD; }
                    else d1 = out + O_WS + ((((size_t)(ri.seq - BATCH) * WINDOW + (WINDOW - DEC_SEQ + ri.t)) * 2 + we) * N_KV + g) * HD; }
                d0 += 8 * fq; *(f32x4*)(d0) = rot0[0]; *(f32x4*)(d0 + 4) = rot0[1]; *(f32x4*)(d0 + 32) = v[1][0]; *(f32x4*)(d0 + 36) = v[1][1];
                if (d1) { d1 += 8 * fq; *(f32x4*)(d1) = rot0[0]; *(f32x4*)(d1 + 4) = rot0[1]; *(f32x4*)(d1 + 32) = v[1][0]; *(f32x4*)(d1 + 36) = v[1][1]; }
                if (ri.seq < BATCH) {
                    if (e >= 2) {
                        unsigned char* img = (e == 2 ? ksel : e == 3 ? vsel : e == 4 ? kwin : vwin) + (((size_t)ri.seq * N_KV + g) * (SEQ / 64) + ri.t / 64) * 8192; const int kv = ri.t % 64;
                        const size_t o0 = (e & 1) ? vimg_off(kv, 8 * fq) : kimg_off(kv, 8 * fq), o1 = (e & 1) ? vimg_off(kv, 32 + 8 * fq) : kimg_off(kv, 32 + 8 * fq);
                        *(u32x4*)(img + o0) = pack8(rot0[0], rot0[1], 1.0f); *(u32x4*)(img + o1) = pack8(v[1][0], v[1][1], 1.0f);
                    } else {
                        const int c = ri.t / L_CMP, l = ri.t % L_CMP; const int r = (ri.seq * NBC_P + c) * N_KV + g;
                        bf16_t* ap = acp + ((size_t)e * RP_CMP + r) * (L_CMP * HD) + l * HD + 8 * fq; const float* pp = pe + ((size_t)e * L_CMP + l) * HD + 8 * fq;
                        *(u32x4*)(ap) = pack8(rot0[0] + *(const f32x4*)(pp), rot0[1] + *(const f32x4*)(pp + 4), 1.0f);
                        *(u32x4*)(ap + 32) = pack8(v[1][0] + *(const f32x4*)(pp + 32), v[1][1] + *(const f32x4*)(pp + 36), 1.0f);
                    }
                }
                asm volatile("" ::: "memory");
            }
    }
};
}

namespace pg8 {
struct EpiGelu {
    static constexpr bool PERM = true, AFTER_DRAIN = false;
    bf16_t* hid;
    __device__ __forceinline__ void pre(const Unit&, int, int, float (&)[8]) const {}
    __device__ __forceinline__ void operator()(const f32x4 (&acc)[2][2][4][2], const Unit& u, int wr, int wc, int fr, int fq, const float (&rsv)[8]) const {
        const int row0 = u.pm * BM + wr * 64 + fr;
#pragma unroll
        for (int ai = 0; ai < 2; ++ai)
#pragma unroll
            for (int m = 0; m < 4; ++m) {
                const int row = row0 + ai * HALF + m * 16;
#pragma unroll
                for (int bj = 0; bj < 2; ++bj) {
                    float a[8];
#pragma unroll
                    for (int n = 0; n < 2; ++n)
#pragma unroll
                        for (int i = 0; i < 4; ++i) { const float x = acc[ai][bj][m][n][i]; a[n * 4 + i] = x * __builtin_amdgcn_rcpf(1.0f + __expf(-1.5957691216057308f * (x + 0.044715f * x * x * x))); }
                    u32x4 w; w.x = cvt_pk_bf16(a[0], a[1]); w.y = cvt_pk_bf16(a[2], a[3]); w.z = cvt_pk_bf16(a[4], a[5]); w.w = cvt_pk_bf16(a[6], a[7]);
                    *(u32x4*)(hid + (size_t)row * CMP_HID + bj * HALF + wc * 32 + 8 * fq) = w;
                }
            }
    }
};
struct CmpOrder {
    int nunits, per_e, G, c;
    __device__ bool next(int i, Unit& u) const { const int L = i * G + c; if (L >= nunits) return false; u.pm = L; u.pn = L / per_e; return true; }
    __device__ __forceinline__ void a_ready(const Unit&) const {}
    __device__ __forceinline__ void done(const Unit&) const {}
};
}
constexpr int LDS_RING_C = 131072;
namespace att {
typedef short bf16x8 __attribute__((ext_vector_type(8)));
typedef short s16x4 __attribute__((ext_vector_type(4)));
typedef float f32x16 __attribute__((ext_vector_type(16)));
typedef __attribute__((address_space(3))) unsigned char* ldsp;
constexpr int TILE_B = 8192;
constexpr int L_KB = 0, L_VB = 3 * TILE_B, L_IMP = 6 * TILE_B, L_SELM = L_IMP + 64 * 64 * 4, L_END = L_SELM + 64 * 8;
constexpr float NEGB = -1e30f;
constexpr float QSCALE = 0.125f * 1.4426950408889634f;
__device__ __forceinline__ int crow(int r, int hi) { return (r & 3) + 8 * (r >> 2) + 4 * hi; }
__device__ __forceinline__ void glds16(const void* gsrc, unsigned lds_dst) { unsigned keep;
    asm volatile("s_mov_b32 %0, m0\n\ts_mov_b32 m0, %2\n\ts_nop 0\n\tglobal_load_lds_dwordx4 %1, off\n\ts_mov_b32 m0, %0" : "=&s"(keep) : "v"(gsrc), "s"(lds_dst) : "memory"); }
__device__ __forceinline__ unsigned cvtpk(float lo, float hi) { unsigned r; asm volatile("v_cvt_pk_bf16_f32 %0, %1, %2" : "=v"(r) : "v"(lo), "v"(hi)); return r; }
__device__ __forceinline__ float halfmax(float m) { auto rr = __builtin_amdgcn_permlane32_swap(__float_as_uint(m), __float_as_uint(m), false, false); return fmaxf(__uint_as_float(rr[0]), __uint_as_float(rr[1])); }
__device__ __forceinline__ float halfsum(float m) { auto rr = __builtin_amdgcn_permlane32_swap(__float_as_uint(m), __float_as_uint(m), false, false); return __uint_as_float(rr[0]) + __uint_as_float(rr[1]); }
__device__ __forceinline__ s16x4 vtr(ldsp p) { typedef short v4i16_t __attribute__((ext_vector_type(4))); return __builtin_bit_cast(s16x4, __builtin_amdgcn_ds_read_tr16_b64_v4i16((__attribute__((address_space(3))) v4i16_t*)p)); }
#define ATT_BAR_L() asm volatile("s_waitcnt lgkmcnt(0)\n\ts_barrier" ::: "memory")
#define ATT_WAIT_BAR(N) asm volatile("s_waitcnt vmcnt(" #N ") lgkmcnt(0)\n\ts_barrier" ::: "memory")
__device__ __forceinline__ void dma_tile(const unsigned char* img_, unsigned lds_dst, int wid, int lane) { unsigned keep; const unsigned voff = (unsigned)(wid * 1024 + lane * 16);
    const unsigned long long ia_ = (unsigned long long)img_; const unsigned long long img = ((unsigned long long)(unsigned)__builtin_amdgcn_readfirstlane((int)(ia_ >> 32)) << 32) | (unsigned)__builtin_amdgcn_readfirstlane((int)ia_);
    asm volatile("s_mov_b32 %0, m0\n\ts_mov_b32 m0, %3\n\ts_nop 0\n\tglobal_load_lds_dwordx4 %1, %2\n\ts_mov_b32 m0, %0" : "=&s"(keep) : "v"(voff), "s"(img), "s"((unsigned)__builtin_amdgcn_readfirstlane(lds_dst + wid * 1024)) : "memory"); }
__device__ __forceinline__ void qk(f32x16& p0, f32x16& p1, ldsp kbuf, const bf16x8 (&qf)[4], int r32, int hi) {
    const f32x16 z = {0.f, 0.f, 0.f, 0.f, 0.f, 0.f, 0.f, 0.f, 0.f, 0.f, 0.f, 0.f, 0.f, 0.f, 0.f, 0.f};
#pragma unroll
    for (int s = 0; s < 4; ++s) {
        const bf16x8 k0 = *(const __attribute__((address_space(3))) bf16x8*)(kbuf + (2 * s + hi) * 1024 + r32 * 16);
        const bf16x8 k1 = *(const __attribute__((address_space(3))) bf16x8*)(kbuf + (2 * s + hi) * 1024 + r32 * 16 + 512);
        p0 = __builtin_amdgcn_mfma_f32_32x32x16_bf16(k0, qf[s], s == 0 ? z : p0, 0, 0, 0);
        p1 = __builtin_amdgcn_mfma_f32_32x32x16_bf16(k1, qf[s], s == 0 ? z : p1, 0, 0, 0);
    }
}
__device__ __forceinline__ void pv(f32x16 (&o)[2], ldsp vbuf, const f32x16& p0, const f32x16& p1, int lane, int hi) {
    unsigned pk[4][4];
#pragma unroll
    for (int k = 0; k < 4; ++k) { pk[0][k] = cvtpk(p0[2 * k], p0[2 * k + 1]); pk[1][k] = cvtpk(p0[8 + 2 * k], p0[9 + 2 * k]); pk[2][k] = cvtpk(p1[2 * k], p1[2 * k + 1]); pk[3][k] = cvtpk(p1[8 + 2 * k], p1[9 + 2 * k]); }
    const int vp0 = ((lane >> 4) & 1) * 32 + (lane & 3) * 8 + (4 * hi + ((lane & 15) >> 2)) * 64;
#pragma unroll
    for (int d0 = 0; d0 < 2; ++d0)
#pragma unroll
        for (int s = 0; s < 4; ++s) {
            const s16x4 lo = vtr(vbuf + d0 * 4096 + s * 1024 + vp0), hh = vtr(vbuf + d0 * 4096 + s * 1024 + 512 + vp0);
            const bf16x8 vf = (bf16x8){lo[0], lo[1], lo[2], lo[3], hh[0], hh[1], hh[2], hh[3]};
            typedef unsigned u32x4 __attribute__((ext_vector_type(4)));
            const u32x4 pw = (u32x4){pk[s][0], pk[s][1], pk[s][2], pk[s][3]};
            o[d0] = __builtin_amdgcn_mfma_f32_32x32x16_bf16(vf, __builtin_bit_cast(bf16x8, pw), o[d0], 0, 0, 0);
        }
}
struct Run { float m, l; f32x16 o[2]; };
constexpr float RESC_THR = 6.0f;
template <bool EMASK> __device__ __forceinline__ void tile_step(Run& R, ldsp kbuf, ldsp vbuf, const bf16x8 (&qf)[4], bool row_on, int lo_b_, int hi_b_, int lane, int r32, int hi) {
    int lo_b = lo_b_ - 4 * hi, hi_b = hi_b_ - 4 * hi;
    if (EMASK) asm volatile("" : "+v"(lo_b), "+v"(hi_b));
    f32x16 p0, p1; qk(p0, p1, kbuf, qf, r32, hi);
    if (EMASK) {
#pragma unroll
        for (int r = 0; r < 16; ++r) { const int kc_ = (r & 3) + 8 * (r >> 2); if (kc_ < lo_b || kc_ > hi_b) p0[r] = NEGB; if (kc_ + 32 < lo_b || kc_ + 32 > hi_b) p1[r] = NEGB; }
    }
    float rm = fmaxf(p0[0], p1[0]);
#pragma unroll
    for (int r = 1; r < 16; ++r) rm = fmaxf(rm, fmaxf(p0[r], p1[r]));
    rm = row_on ? halfmax(rm) : NEGB;
    if (__any(rm - R.m > RESC_THR)) {
        const float mn = fmaxf(R.m, rm), alpha = __builtin_amdgcn_exp2f(R.m - mn);
        R.m = mn; R.l *= alpha;
#pragma unroll
        for (int r = 0; r < 16; ++r) { R.o[0][r] *= alpha; R.o[1][r] *= alpha; }
    }
    const float meff = row_on ? R.m : 1e30f;
    float ls = 0.f;
#pragma unroll
    for (int r = 0; r < 16; ++r) { const float e0 = __builtin_amdgcn_exp2f(p0[r] - meff), e1 = __builtin_amdgcn_exp2f(p1[r] - meff); p0[r] = e0; p1[r] = e1; ls += e0 + e1; }
    R.l += ls;
    pv(R.o, vbuf, p0, p1, lane, hi);
}
struct Tensors {
    const bf16_t* qn; const bf16_t* qr;
    const unsigned char* ksel; const unsigned char* vsel; const unsigned char* kwin; const unsigned char* vwin;
    const unsigned char* kc; const unsigned char* vc;
    const float* gates; bf16_t* ob;
};
template <bool SEL> __device__ __forceinline__ void branch(Run& R, const unsigned char* kimg, const unsigned char* vimg, int t0, int t1, int jdiag, unsigned long long selm, int iq,
                                                           const bf16x8 (&qf)[4], unsigned lds0, ldsp lds, int wid, int lane, int r32, int hi) {
    R.m = NEGB; R.l = 0.f;
#pragma unroll
    for (int r = 0; r < 16; ++r) { R.o[0][r] = 0.f; R.o[1][r] = 0.f; }
    dma_tile(kimg + (size_t)t0 * TILE_B, lds0 + L_KB, wid, lane); dma_tile(vimg + (size_t)t0 * TILE_B, lds0 + L_VB, wid, lane);
    if (t0 < t1) { dma_tile(kimg + (size_t)(t0 + 1) * TILE_B, lds0 + L_KB + TILE_B, wid, lane); dma_tile(vimg + (size_t)(t0 + 1) * TILE_B, lds0 + L_VB + TILE_B, wid, lane); }
    int b = 0;
    for (int t = t0; t <= t1; ++t) {
        if (t < t1) ATT_WAIT_BAR(2); else ATT_WAIT_BAR(0);
        if (t + 2 <= t1) { const int b2 = (b >= 1) ? b - 1 : 2; dma_tile(kimg + (size_t)(t + 2) * TILE_B, lds0 + L_KB + b2 * TILE_B, wid, lane); dma_tile(vimg + (size_t)(t + 2) * TILE_B, lds0 + L_VB + b2 * TILE_B, wid, lane); }
        const bool row_on = !SEL || ((selm >> t) & 1ull);
        const bool lowm = !SEL && (t == jdiag - 8);
        if (t == jdiag || lowm) tile_step<true>(R, lds + L_KB + b * TILE_B, lds + L_VB + b * TILE_B, qf, row_on, lowm ? iq : 0, (t == jdiag) ? iq : 63, lane, r32, hi);
        else tile_step<false>(R, lds + L_KB + b * TILE_B, lds + L_VB + b * TILE_B, qf, row_on, 0, 63, lane, r32, hi);
        b = (b == 2) ? 0 : b + 1;
    }
    ATT_BAR_L();
}
__device__ __forceinline__ void load_q(bf16x8 (&qf)[4], const bf16_t* qrow, int hi) {
#pragma unroll
    for (int s = 0; s < 4; ++s) qf[s] = *(const bf16x8*)(qrow + 16 * s + 8 * hi);
}
__device__ __forceinline__ void unit(const Tensors& T, int n, int j, int g, ldsp lds, unsigned lds0, int wid, int lane_) {
    const int lane = (int)lane_id_v();
    const int r32 = lane & 31, hi = lane >> 5, ql = r32 >> 2, hq = r32 & 3, iq = 8 * wid + ql;
    const int row = n * SEQ + 64 * j + iq, head = g * HPG + hq, pos = 64 * j + iq;
    const size_t img_ng = ((size_t)n * N_KV + g);
    f32x16 oacc[2];
#pragma unroll
    for (int r = 0; r < 16; ++r) { oacc[0][r] = 0.f; oacc[1][r] = 0.f; }
    const float* gt = T.gates + (size_t)row * 3 * N_HEADS + head * 3;
    const float g_c = gt[0], g_s = gt[1], g_w = gt[2];
    bf16x8 qf[4];
    unsigned long long selm;
    {
        load_q(qf, T.qn + (size_t)row * HDM + head * HD, hi);
        const int ntc = (2 * j + 2 + 63) / 64;
        const unsigned char* kci = T.kc + img_ng * (NBC_P / 64) * TILE_B; const unsigned char* vci = T.vc + img_ng * (NBC_P / 64) * TILE_B;
        dma_tile(kci, lds0 + L_KB, wid, lane); dma_tile(vci, lds0 + L_VB, wid, lane);
        if (ntc > 1) { dma_tile(kci + TILE_B, lds0 + L_KB + TILE_B, wid, lane); dma_tile(vci + TILE_B, lds0 + L_VB + TILE_B, wid, lane); }
        ATT_WAIT_BAR(0);
        int cmax = ((pos + 1) >> 5) - 1 - 4 * hi;
        asm volatile("" : "+v"(cmax));
        f32x16 s0, s1, s2, s3;
        qk(s0, s1, lds + L_KB, qf, r32, hi);
        if (ntc > 1) qk(s2, s3, lds + L_KB + TILE_B, qf, r32, hi);
        else {
#pragma unroll
            for (int r = 0; r < 16; ++r) { s2[r] = NEGB; s3[r] = NEGB; }
        }
        float mx = NEGB;
#pragma unroll
        for (int r = 0; r < 16; ++r) { const int kv = (r & 3) + 8 * (r >> 2);
            if (kv > cmax) s0[r] = NEGB; if (kv + 32 > cmax) s1[r] = NEGB; if (kv + 64 > cmax) s2[r] = NEGB; if (kv + 96 > cmax) s3[r] = NEGB;
            mx = fmaxf(fmaxf(mx, fmaxf(s0[r], s1[r])), fmaxf(s2[r], s3[r])); }
        mx = halfmax(mx);
        float ls = 0.f;
#pragma unroll
        for (int r = 0; r < 16; ++r) { const int kv = (r & 3) + 8 * (r >> 2);
            s0[r] = (kv > cmax) ? 0.f : __builtin_amdgcn_exp2f(s0[r] - mx); s1[r] = (kv + 32 > cmax) ? 0.f : __builtin_amdgcn_exp2f(s1[r] - mx);
            s2[r] = (kv + 64 > cmax) ? 0.f : __builtin_amdgcn_exp2f(s2[r] - mx); s3[r] = (kv + 96 > cmax) ? 0.f : __builtin_amdgcn_exp2f(s3[r] - mx);
            ls += (s0[r] + s1[r]) + (s2[r] + s3[r]); }
        ls = halfsum(ls);
        const float inv = 1.0f / fmaxf(ls, 1e-30f);
#pragma unroll
        for (int r = 0; r < 16; ++r) { s0[r] *= inv; s1[r] *= inv; s2[r] *= inv; s3[r] *= inv; }
        __attribute__((address_space(3))) float* imp = (__attribute__((address_space(3))) float*)(lds + L_IMP) + iq * 64;
#pragma unroll
        for (int r = 0; r < 16; r += 2) { const int bl = crow(r, hi) >> 1;
            float v0 = s0[r] + s0[r + 1], v1 = s1[r] + s1[r + 1], v2 = s2[r] + s2[r + 1], v3 = s3[r] + s3[r + 1];
            v0 += __shfl_xor(v0, 1); v0 += __shfl_xor(v0, 2); v1 += __shfl_xor(v1, 1); v1 += __shfl_xor(v1, 2);
            v2 += __shfl_xor(v2, 1); v2 += __shfl_xor(v2, 2); v3 += __shfl_xor(v3, 1); v3 += __shfl_xor(v3, 2);
            if (hq == 0) { imp[bl] = v0; imp[16 + bl] = v1; imp[32 + bl] = v2; imp[48 + bl] = v3; } }
        Run Rc;
#pragma unroll
        for (int r = 0; r < 16; ++r) { Rc.o[0][r] = 0.f; Rc.o[1][r] = 0.f; }
        pv(Rc.o, lds + L_VB, s0, s1, lane, hi);
        if (ntc > 1) pv(Rc.o, lds + L_VB + TILE_B, s2, s3, lane, hi);
#pragma unroll
        for (int r = 0; r < 16; ++r) { oacc[0][r] += g_c * Rc.o[0][r]; oacc[1][r] += g_c * Rc.o[1][r]; }
        asm volatile("s_waitcnt lgkmcnt(0)" ::: "memory");
        __attribute__((address_space(3))) unsigned long long* selw = (__attribute__((address_space(3))) unsigned long long*)(lds + L_SELM);
        for (int qq = 0; qq < 8; ++qq) {
            const float v = ((__attribute__((address_space(3))) float*)(lds + L_IMP))[(8 * wid + qq) * 64 + lane];
            const bool valid = lane <= j, forced = (lane == 0) || (lane == j) || (lane == j - 1);
            const unsigned key = valid ? (forced ? 0x7f000000u : __float_as_uint(v) + 1u) : 0u;
            unsigned long long m;
            if (j + 1 <= N_SEL) m = __ballot(valid);
            else {
                unsigned Tt = 0u;
                for (int bit = 30; bit >= 0; --bit) { const unsigned cand = Tt | (1u << bit); if (__popcll(__ballot(key >= cand)) >= N_SEL) Tt = cand; }
                const unsigned long long gtm = __ballot(key > Tt), eqm = __ballot(key == Tt);
                const int need = N_SEL - __popcll(gtm);
                const bool pick = (key == Tt) && (__popcll(eqm & ((1ull << lane) - 1ull)) < need);
                m = gtm | __ballot(pick);
            }
            if (lane == 0) selw[8 * wid + qq] = m;
        }
        asm volatile("s_waitcnt lgkmcnt(0)" ::: "memory");
        selm = selw[iq];
        ATT_WAIT_BAR(0);
    }
    load_q(qf, T.qr + (size_t)row * HDM + head * HD, hi);
    {
        Run R; branch<true>(R, T.ksel + img_ng * (SEQ / 64) * TILE_B, T.vsel + img_ng * (SEQ / 64) * TILE_B, 0, j, j, selm, iq, qf, lds0, lds, wid, lane, r32, hi);
        const float sc = g_s / fmaxf(halfsum(R.l), 1e-30f);
#pragma unroll
        for (int r = 0; r < 16; ++r) { oacc[0][r] += sc * R.o[0][r]; oacc[1][r] += sc * R.o[1][r]; }
    }
    {
        Run R; branch<false>(R, T.kwin + img_ng * (SEQ / 64) * TILE_B, T.vwin + img_ng * (SEQ / 64) * TILE_B, j > 8 ? j - 8 : 0, j, j, 0ull, iq, qf, lds0, lds, wid, lane, r32, hi);
        const float sc = g_w / fmaxf(halfsum(R.l), 1e-30f);
#pragma unroll
        for (int r = 0; r < 16; ++r) { oacc[0][r] += sc * R.o[0][r]; oacc[1][r] += sc * R.o[1][r]; }
    }
    bf16_t* orow = T.ob + (size_t)row * HDM + head * HD;
#pragma unroll
    for (int d0 = 0; d0 < 2; ++d0)
#pragma unroll
        for (int rr = 0; rr < 4; ++rr) { typedef unsigned u32x2 __attribute__((ext_vector_type(2)));
            u32x2 w; w.x = cvtpk(oacc[d0][4 * rr], oacc[d0][4 * rr + 1]); w.y = cvtpk(oacc[d0][4 * rr + 2], oacc[d0][4 * rr + 3]);
            *(u32x2*)(orow + 32 * d0 + 8 * rr + 4 * hi) = w; }
}
}
namespace att {
constexpr int S_STAGE = 16384;
constexpr int S_XM = LDS_RING_C + 1024, S_XL = S_XM + 1024, S_IMP = S_XL + 1024, S_SELM = S_IMP + 8 * 128 * 4, S_END = S_SELM + 8 * 2 * 8;
struct STensors {
    const bf16_t* qn; const bf16_t* qr; const float* kc; const float* vc; const float* cache_kv; const int* page_table; const float* cache_win; const float* out; const float* winrows;
    const float* gates; bf16_t* ob;
};
typedef float f32x4_t __attribute__((ext_vector_type(4)));
__device__ __forceinline__ void stage_kv(ldsp kimg, ldsp vimg, const float* ksrc, const float* vsrc, int stride, int nrows, int lane) {
    typedef unsigned u32x4 __attribute__((ext_vector_type(4)));
    const int c = lane & 7;
#pragma unroll 1
    for (int ib = 0; ib < 8; ib += 4)
#pragma unroll
    for (int it = ib; it < ib + 4; ++it) {
        const int row = 8 * it + (lane >> 3);
        f32x4_t k0 = {0.f, 0.f, 0.f, 0.f}, k1 = k0, v0 = k0, v1 = k0;
        if (row < nrows) { const float* kp = ksrc + (size_t)row * stride + 8 * c; const float* vp = vsrc + (size_t)row * stride + 8 * c;
            k0 = *(const f32x4_t*)kp; k1 = *(const f32x4_t*)(kp + 4); v0 = *(const f32x4_t*)vp; v1 = *(const f32x4_t*)(vp + 4); }
        u32x4 kw, vw; kw.x = cvtpk(k0[0], k0[1]); kw.y = cvtpk(k0[2], k0[3]); kw.z = cvtpk(k1[0], k1[1]); kw.w = cvtpk(k1[2], k1[3]);
        vw.x = cvtpk(v0[0], v0[1]); vw.y = cvtpk(v0[2], v0[3]); vw.z = cvtpk(v1[0], v1[1]); vw.w = cvtpk(v1[2], v1[3]);
        *(__attribute__((address_space(3))) u32x4*)(kimg + c * 1024 + row * 16) = kw;
        *(__attribute__((address_space(3))) u32x4*)(vimg + (c >> 2) * 4096 + (row >> 3) * 512 + (row & 7) * 64 + (c & 3) * 16) = vw;
    }
    asm volatile("s_waitcnt lgkmcnt(0)" ::: "memory");
}
#define ATT_BAR_ALL() asm volatile("s_waitcnt vmcnt(0) lgkmcnt(0)\n\ts_barrier" ::: "memory")
__device__ __forceinline__ float merge_stats(ldsp lds, float m_own, float l_own_half, int wid, int r32, int hi) {
    __attribute__((address_space(3))) float* xm = (__attribute__((address_space(3))) float*)(lds + S_XM); __attribute__((address_space(3))) float* xl = (__attribute__((address_space(3))) float*)(lds + S_XL);
    const float l_own = halfsum(l_own_half);
    if (hi == 0) { xm[wid * 32 + r32] = m_own; xl[wid * 32 + r32] = l_own; }
    ATT_BAR_ALL();
    float M = NEGB;
#pragma unroll
    for (int w = 0; w < 8; ++w) M = fmaxf(M, xm[w * 32 + r32]);
    float L = 0.f;
#pragma unroll
    for (int w = 0; w < 8; ++w) L += __builtin_amdgcn_exp2f(xm[w * 32 + r32] - M) * xl[w * 32 + r32];
    const float wgt = __builtin_amdgcn_exp2f(m_own - M) / fmaxf(L, 1e-30f);
    ATT_BAR_ALL();
    return wgt;
}
__device__ __forceinline__ void sample_unit(const STensors& T, int b, int g, ldsp lds, int wid, int lane_) {
    const int lane = (int)lane_id_v();
    const int r32 = lane & 31, hi = lane >> 5, ql = r32 >> 2, hq = r32 & 3;
    const int row = MP + b * DEC_SEQ + ql, head = g * HPG + hq, seq = BATCH + b;
    ldsp kimg = lds + wid * S_STAGE, vimg = kimg + TILE_B;
    f32x16 oacc[2];
#pragma unroll
    for (int r = 0; r < 16; ++r) { oacc[0][r] = 0.f; oacc[1][r] = 0.f; }
    const float* gt = T.gates + (size_t)row * 3 * N_HEADS + head * 3;
    const float g_c = gt[0], g_s = gt[1], g_w = gt[2];
    bf16x8 qf[4];
    __attribute__((address_space(3))) float* xm = (__attribute__((address_space(3))) float*)(lds + S_XM); __attribute__((address_space(3))) float* xl = (__attribute__((address_space(3))) float*)(lds + S_XL);
    __attribute__((address_space(3))) float* imp = (__attribute__((address_space(3))) float*)(lds + S_IMP);
    __attribute__((address_space(3))) unsigned long long* selw = (__attribute__((address_space(3))) unsigned long long*)(lds + S_SELM);
    {
        load_q(qf, T.qn + (size_t)row * HDM + head * HD, hi);
        constexpr int NTC = NBC_PAST / 64;
        f32x16 p0, p1; const bool mine = wid < NTC;
        float rm = NEGB;
        if (mine) {
            const float* kcp = T.kc + (((size_t)seq * NBC_MAX + 64 * wid) * N_KV + g) * HD; const float* vcp = T.vc + (((size_t)seq * NBC_MAX + 64 * wid) * N_KV + g) * HD;
            stage_kv(kimg, vimg, kcp, vcp, N_KV * HD, 64, lane);
            qk(p0, p1, kimg, qf, r32, hi);
#pragma unroll
            for (int r = 0; r < 16; ++r) rm = fmaxf(rm, fmaxf(p0[r], p1[r]));
            rm = halfmax(rm);
        }
        if (hi == 0) xm[wid * 32 + r32] = rm;
        ATT_BAR_ALL();
        float M = NEGB;
#pragma unroll
        for (int w = 0; w < 8; ++w) M = fmaxf(M, xm[w * 32 + r32]);
        float ls = 0.f;
        if (mine) {
#pragma unroll
            for (int r = 0; r < 16; ++r) { p0[r] = __builtin_amdgcn_exp2f(p0[r] - M); p1[r] = __builtin_amdgcn_exp2f(p1[r] - M); ls += p0[r] + p1[r]; }
            ls = halfsum(ls);
        }
        if (hi == 0) xl[wid * 32 + r32] = ls;
        ATT_BAR_ALL();
        float L = 0.f;
#pragma unroll
        for (int w = 0; w < 8; ++w) L += xl[w * 32 + r32];
        const float inv = 1.0f / fmaxf(L, 1e-30f);
        if (mine) {
#pragma unroll
            for (int r = 0; r < 16; ++r) { p0[r] *= inv; p1[r] *= inv; }
#pragma unroll
            for (int r = 0; r < 16; r += 2) { const int bl = crow(r, hi) >> 1;
                float v0 = p0[r] + p0[r + 1], v1 = p1[r] + p1[r + 1];
                v0 += __shfl_xor(v0, 1); v0 += __shfl_xor(v0, 2); v1 += __shfl_xor(v1, 1); v1 += __shfl_xor(v1, 2);
                if (hq == 0) { imp[ql * 128 + 32 * wid + bl] = v0; imp[ql * 128 + 32 * wid + 16 + bl] = v1; } }
            Run Rc;
#pragma unroll
            for (int r = 0; r < 16; ++r) { Rc.o[0][r] = 0.f; Rc.o[1][r] = 0.f; }
            pv(Rc.o, vimg, p0, p1, lane, hi);
#pragma unroll
            for (int r = 0; r < 16; ++r) { oacc[0][r] += g_c * Rc.o[0][r]; oacc[1][r] += g_c * Rc.o[1][r]; }
        }
        ATT_BAR_ALL();
    }
    {
        constexpr int NCAND = NBS_S - 1;
        const float v0 = imp[wid * 128 + lane], v1 = imp[wid * 128 + 64 + lane];
        const unsigned key0 = (lane == 0) ? 0x7f000000u : __float_as_uint(v0) + 1u;
        const unsigned key1 = (lane + 64 == NCAND - 1) ? 0x7f000000u : __float_as_uint(v1) + 1u;
        unsigned Tt = 0u;
        for (int bit = 30; bit >= 0; --bit) { const unsigned cand = Tt | (1u << bit); if (__popcll(__ballot(key0 >= cand)) + __popcll(__ballot(key1 >= cand)) >= N_SEL - 1) Tt = cand; }
        const unsigned long long gt0 = __ballot(key0 > Tt), gt1 = __ballot(key1 > Tt), eq0 = __ballot(key0 == Tt), eq1 = __ballot(key1 == Tt);
        const int need = (N_SEL - 1) - __popcll(gt0) - __popcll(gt1);
        const unsigned long long below = (1ull << lane) - 1ull;
        const bool pick0 = (key0 == Tt) && (__popcll(eq0 & below) < need);
        const bool pick1 = (key1 == Tt) && (__popcll(eq0) + __popcll(eq1 & below) < need);
        const unsigned long long m0 = gt0 | __ballot(pick0), m1 = gt1 | __ballot(pick1);
        if (lane == 0) { selw[wid * 2] = m0; selw[wid * 2 + 1] = m1; }
        ATT_BAR_ALL();
    }
    load_q(qf, T.qr + (size_t)row * HDM + head * HD, hi);
    {
        unsigned long long U0 = 0ull, U1 = 0ull;
#pragma unroll
        for (int q = 0; q < 8; ++q) { U0 |= selw[q * 2]; U1 |= selw[q * 2 + 1]; }
        U0 = __builtin_amdgcn_readfirstlane((unsigned)U0) | ((unsigned long long)__builtin_amdgcn_readfirstlane((unsigned)(U0 >> 32)) << 32);
        U1 = __builtin_amdgcn_readfirstlane((unsigned)U1) | ((unsigned long long)__builtin_amdgcn_readfirstlane((unsigned)(U1 >> 32)) << 32);
        const unsigned long long my0 = selw[ql * 2], my1 = selw[ql * 2 + 1];
        Run R; R.m = NEGB; R.l = 0.f;
#pragma unroll
        for (int r = 0; r < 16; ++r) { R.o[0][r] = 0.f; R.o[1][r] = 0.f; }
        int idx = 0;
        for (int half = 0; half < 2; ++half) {
            unsigned long long U = half ? U1 : U0;
            while (U) {
                const int bit = __builtin_ctzll(U); U &= U - 1ull;
                if ((idx++ & 7) != wid) continue;
                const int blk = 64 * half + bit;
                const int page = T.page_table[b * N_PAGES + (blk * L_SEL) / PAGE_SIZE];
                const float* base = T.cache_kv + (((size_t)page * PAGE_SIZE + (blk * L_SEL) % PAGE_SIZE) * 4) * N_KV * HD + g * HD;
                stage_kv(kimg, vimg, base + 2 * N_KV * HD, base + 3 * N_KV * HD, 4 * N_KV * HD, 64, lane);
                const bool selected = ((half ? my1 : my0) >> bit) & 1ull;
                tile_step<false>(R, kimg, vimg, qf, selected, 0, 63, lane, r32, hi);
            }
        }
        if ((idx & 7) == wid) {
            const float* base = T.out + O_KVS + (((size_t)b * DEC_SEQ) * 4) * N_KV * HD + g * HD;
            stage_kv(kimg, vimg, base + 2 * N_KV * HD, base + 3 * N_KV * HD, 4 * N_KV * HD, DEC_SEQ, lane);
            tile_step<true>(R, kimg, vimg, qf, true, 0, ql, lane, r32, hi);
        }
        const float wgt = merge_stats(lds, R.m, R.l, wid, r32, hi) * g_s;
#pragma unroll
        for (int r = 0; r < 16; ++r) { oacc[0][r] += wgt * R.o[0][r]; oacc[1][r] += wgt * R.o[1][r]; }
    }
    {
        Run R; R.m = NEGB; R.l = 0.f;
#pragma unroll
        for (int r = 0; r < 16; ++r) { R.o[0][r] = 0.f; R.o[1][r] = 0.f; }
        for (int t = wid; t < WINDOW / 64; t += 8) {
            const float* base = T.cache_win + (((size_t)b * WINDOW + 64 * t) * 2) * N_KV * HD + g * HD;
            stage_kv(kimg, vimg, base, base + N_KV * HD, 2 * N_KV * HD, 64, lane);
            if (t == 0) tile_step<true>(R, kimg, vimg, qf, true, ql, 63, lane, r32, hi); else tile_step<false>(R, kimg, vimg, qf, true, 0, 63, lane, r32, hi);
        }
        if (wid == 0) {
            const float* base = T.winrows + (((size_t)(MP + b * DEC_SEQ)) * 2) * N_KV * HD + g * HD;
            stage_kv(kimg, vimg, base, base + N_KV * HD, 2 * N_KV * HD, DEC_SEQ, lane);
            tile_step<true>(R, kimg, vimg, qf, true, 0, ql, lane, r32, hi);
        }
        const float wgt = merge_stats(lds, R.m, R.l, wid, r32, hi) * g_w;
#pragma unroll
        for (int r = 0; r < 16; ++r) { oacc[0][r] += wgt * R.o[0][r]; oacc[1][r] += wgt * R.o[1][r]; }
    }
    {
        const int lane2 = (int)lane_id_v(), r32 = lane2 & 31, hi = lane2 >> 5;
        __attribute__((address_space(3))) float* mine = (__attribute__((address_space(3))) float*)(lds + wid * S_STAGE);
#pragma unroll
        for (int d0 = 0; d0 < 2; ++d0)
#pragma unroll
            for (int rr = 0; rr < 4; ++rr) *(__attribute__((address_space(3))) f32x4_t*)(mine + r32 * 64 + 32 * d0 + 8 * rr + 4 * hi) = (f32x4_t){oacc[d0][4 * rr], oacc[d0][4 * rr + 1], oacc[d0][4 * rr + 2], oacc[d0][4 * rr + 3]};
        ATT_BAR_ALL();
        const int tid = wid * 64 + (int)lane_id_v(), orow = tid >> 4, oc4 = (tid & 15) * 4;
        f32x4_t s = {0.f, 0.f, 0.f, 0.f};
#pragma unroll
        for (int w = 0; w < 8; ++w) s += *(const __attribute__((address_space(3))) f32x4_t*)((__attribute__((address_space(3))) float*)(lds + w * S_STAGE) + orow * 64 + oc4);
        typedef unsigned u32x2 __attribute__((ext_vector_type(2)));
        u32x2 wv; wv.x = cvtpk(s[0], s[1]); wv.y = cvtpk(s[2], s[3]);
        const int oq = orow >> 2, oh = orow & 3;
        *(u32x2*)(T.ob + (size_t)(MP + b * DEC_SEQ + oq) * HDM + (g * HPG + oh) * HD + oc4) = wv;
        ATT_BAR_ALL();
    }
}
constexpr int Q_SAMPLE = DEC_BATCH * N_KV, Q_PROMPT = BATCH * N_KV * (SEQ / 64), Q_TOTAL = Q_SAMPLE + Q_PROMPT;
constexpr int S_QHEAD = S_END;
__device__ __forceinline__ int claim_unit(unsigned* head, ldsp lds, int wid, int lane) {
    __attribute__((address_space(3))) int* qslot = (__attribute__((address_space(3))) int*)(lds + S_QHEAD);
    if (wid == 0 && lane == 0) *qslot = (int)__hip_atomic_fetch_add(head, 1u, __ATOMIC_RELAXED, __HIP_MEMORY_SCOPE_AGENT);
    ATT_BAR_ALL();
    const int u = __builtin_amdgcn_readfirstlane(*qslot);
    ATT_BAR_ALL();
    return u;
}
__device__ __forceinline__ void att_queue_sample(const STensors& TS, unsigned* head, ldsp lds, int wid, int lane) {
    for (;;) { const int u = claim_unit(head, lds, wid, lane); if (u >= Q_SAMPLE) break; sample_unit(TS, u / N_KV, u % N_KV, lds, wid, lane); }
}
__device__ __forceinline__ void att_queue_prompt(const Tensors& T, unsigned* head, ldsp lds, int wid, int lane) {
    const unsigned lds0 = (unsigned)(uintptr_t)lds;
    for (;;) { const int p = claim_unit(head, lds, wid, lane); if (p >= Q_PROMPT) break;
        const int j = (SEQ / 64 - 1) - p / (BATCH * N_KV), ng = p % (BATCH * N_KV); unit(T, ng / N_KV, j, ng % N_KV, lds, lds0, wid, lane); }
}
}


namespace att {
__device__ __forceinline__ void cmp_out_wave(int task, const bf16_t* hid, int R, int nbc, int seq0, const bf16_t* w2t, const float* k_norm0, float* kc, float* vc, unsigned char* kci, unsigned char* vci, int lane) {
    const int r32 = lane & 31, hi = lane >> 5;
    const int r0 = task * 32, e = r0 >= R ? 1 : 0, r = r0 - e * R + r32;
    const bf16_t* hrow = hid + ((size_t)e * R + r) * CMP_HID; const bf16_t* wrow = w2t + ((size_t)e * HD + r32) * CMP_HID;
    f32x16 o0, o1;
#pragma unroll
    for (int k = 0; k < 16; ++k) { o0[k] = 0.f; o1[k] = 0.f; }
#pragma unroll 4
    for (int s_ = 0; s_ < CMP_HID / 16; ++s_) {
        const bf16x8 hb_ = *(const bf16x8*)(hrow + 16 * s_ + 8 * hi);
        const bf16x8 w0 = *(const bf16x8*)(wrow + 16 * s_ + 8 * hi), w1 = *(const bf16x8*)(wrow + (size_t)32 * CMP_HID + 16 * s_ + 8 * hi);
        o0 = __builtin_amdgcn_mfma_f32_32x32x16_bf16(w0, hb_, o0, 0, 0, 0); o1 = __builtin_amdgcn_mfma_f32_32x32x16_bf16(w1, hb_, o1, 0, 0, 0);
    }
    if (e == 0) {
        float ss = 0.f;
#pragma unroll
        for (int k = 0; k < 16; ++k) ss += o0[k] * o0[k] + o1[k] * o1[k];
        ss = halfsum(ss);
        const float rn = rsqrtf(ss * (1.0f / HD) + EPS);
#pragma unroll
        for (int k = 0; k < 16; ++k) { o0[k] *= rn * k_norm0[crow(k, hi)]; o1[k] *= rn * k_norm0[32 + crow(k, hi)]; }
    }
    const int g = r % N_KV, c = (r / N_KV) % nbc, sq = r / (N_KV * nbc);
    float* dst = (e == 0 ? kc : vc) + (((size_t)(seq0 + sq) * NBC_MAX + c) * N_KV + g) * HD;
#pragma unroll
    for (int rr = 0; rr < 4; ++rr) { *(f32x4_t*)(dst + 8 * rr + 4 * hi) = (f32x4_t){o0[4 * rr], o0[4 * rr + 1], o0[4 * rr + 2], o0[4 * rr + 3]};
                                      *(f32x4_t*)(dst + 32 + 8 * rr + 4 * hi) = (f32x4_t){o1[4 * rr], o1[4 * rr + 1], o1[4 * rr + 2], o1[4 * rr + 3]}; }
    if (kci) {
        unsigned char* img = (e == 0 ? kci : vci) + (((size_t)sq * N_KV + g) * (NBC_P / 64) + c / 64) * 8192; const int kv = c % 64;
        typedef unsigned u32x2 __attribute__((ext_vector_type(2)));
#pragma unroll
        for (int rr = 0; rr < 4; ++rr) {
            u32x2 a; a.x = cvtpk(o0[4 * rr], o0[4 * rr + 1]); a.y = cvtpk(o0[4 * rr + 2], o0[4 * rr + 3]);
            u32x2 bq; bq.x = cvtpk(o1[4 * rr], o1[4 * rr + 1]); bq.y = cvtpk(o1[4 * rr + 2], o1[4 * rr + 3]);
            const int d0 = 8 * rr, d1 = 32 + 8 * rr;
            *(u32x2*)(img + (e == 0 ? kimg_off(kv, d0) : vimg_off(kv, d0)) + 8 * hi) = a;
            *(u32x2*)(img + (e == 0 ? kimg_off(kv, d1) : vimg_off(kv, d1)) + 8 * hi) = bq;
        }
    }
}
}
__device__ __forceinline__ void conv_thin_vec_item(size_t i_, const bf16_t* ub, const bf16_t* bb, const float* state, const float* wc, bf16_t* zb) {
    typedef unsigned u4 __attribute__((ext_vector_type(4)));
    const int m = (int)(i_ / (D_MODEL / 8)), ch = (int)(i_ % (D_MODEL / 8)) * 8;
    const RowInfo ri = row_info(m);
    const size_t o = (size_t)m * D_MODEL + ch;
    float u0[8], u1[8], u2[8], bv[8];
#define UNPK(w, f) do { f[0] = bf2f((bf16_t)((w).x & 0xffff)); f[1] = bf2f((bf16_t)((w).x >> 16)); f[2] = bf2f((bf16_t)((w).y & 0xffff)); f[3] = bf2f((bf16_t)((w).y >> 16)); \
                        f[4] = bf2f((bf16_t)((w).z & 0xffff)); f[5] = bf2f((bf16_t)((w).z >> 16)); f[6] = bf2f((bf16_t)((w).w & 0xffff)); f[7] = bf2f((bf16_t)((w).w >> 16)); } while (0)
    { const u4 w = *(const u4*)(ub + o); UNPK(w, u0); } { const u4 w = *(const u4*)(bb + o); UNPK(w, bv); }
    const float* st = (ri.seq >= BATCH) ? state + (size_t)(ri.seq - BATCH) * 2 * D_MODEL + ch : nullptr;
    if (ri.t >= 1) { const u4 w = *(const u4*)(ub + o - D_MODEL); UNPK(w, u1); } else { for (int k = 0; k < 8; ++k) u1[k] = st ? st[D_MODEL + k] : 0.f; }
    if (ri.t >= 2) { const u4 w = *(const u4*)(ub + o - 2 * D_MODEL); UNPK(w, u2); } else { for (int k = 0; k < 8; ++k) u2[k] = st ? (ri.t == 1 ? st[D_MODEL + k] : st[k]) : 0.f; }
#undef UNPK
    float z[8];
    for (int k = 0; k < 8; ++k) z[k] = bv[k] * (wc[ch + k] * u2[k] + wc[D_MODEL + ch + k] * u1[k] + wc[2 * D_MODEL + ch + k] * u0[k]);
    u4 w; w.x = (unsigned)f2bf(z[0]) | ((unsigned)f2bf(z[1]) << 16); w.y = (unsigned)f2bf(z[2]) | ((unsigned)f2bf(z[3]) << 16);
    w.z = (unsigned)f2bf(z[4]) | ((unsigned)f2bf(z[5]) << 16); w.w = (unsigned)f2bf(z[6]) | ((unsigned)f2bf(z[7]) << 16);
    *(u4*)(zb + o) = w;
}

namespace att {
__device__ __forceinline__ void skinny_task(int task, const bf16_t* A, const bf16_t* Bt, int N, int K, int KS, float* part, int lane) {
    const int r32 = lane & 31, hi = lane >> 5, ncb = N / 32, nrb = MS / 32;
    const int ks = task / (nrb * ncb), rem = task % (nrb * ncb), rb = rem / ncb, cb = rem % ncb, klen = K / KS, k0 = ks * klen;
    const bf16_t* ap = A + (size_t)(rb * 32 + r32) * K + k0 + 8 * hi; const bf16_t* bp = Bt + (size_t)(cb * 32 + r32) * K + k0 + 8 * hi;
    f32x16 acc;
#pragma unroll
    for (int k = 0; k < 16; ++k) acc[k] = 0.f;
#pragma unroll 8
    for (int s_ = 0; s_ < klen / 16; ++s_) acc = __builtin_amdgcn_mfma_f32_32x32x16_bf16(*(const bf16x8*)(bp + 16 * s_), *(const bf16x8*)(ap + 16 * s_), acc, 0, 0, 0);
    float* dst = part + ((size_t)ks * MS + rb * 32 + r32) * N + cb * 32 + 4 * hi;
#pragma unroll
    for (int rr = 0; rr < 4; ++rr) *(f32x4_t*)(dst + 8 * rr) = (f32x4_t){acc[4 * rr], acc[4 * rr + 1], acc[4 * rr + 2], acc[4 * rr + 3]};
}
__device__ __forceinline__ void resid_reduce_row(int rs_, const float* part, int KS, float coef, float* h, bf16_t* hb, float* rss_next, float* yout, int lane) {
    typedef unsigned u2 __attribute__((ext_vector_type(2)));
    const int m = MP + rs_; float ssq = 0.f;
#pragma unroll
    for (int j = 0; j < D_MODEL / 256; ++j) {
        const int col = 256 * j + 4 * lane; f32x4_t a = {0.f, 0.f, 0.f, 0.f};
        for (int ks = 0; ks < KS; ++ks) a += *(const f32x4_t*)(part + ((size_t)ks * MS + rs_) * D_MODEL + col);
        const f32x4_t v = *(const f32x4_t*)(h + (size_t)m * D_MODEL + col) + a * coef;
        if (yout) *(f32x4_t*)(yout + (size_t)m * D_MODEL + col) = v;
        else { *(f32x4_t*)(h + (size_t)m * D_MODEL + col) = v; u2 w; w.x = cvtpk(v[0], v[1]); w.y = cvtpk(v[2], v[3]); *(u2*)(hb + (size_t)m * D_MODEL + col) = w;
               ssq += (v[0] * v[0] + v[1] * v[1]) + (v[2] * v[2] + v[3] * v[3]); }
    }
    if (!yout) {
#pragma unroll
        for (int o = 1; o < 64; o <<= 1) ssq += __shfl_xor(ssq, o);
        if (lane == 0) rss_next[m] = ssq;
    }
}
}
__device__ __forceinline__ void conv_thin_sample_item(size_t i_, const float* part, int KS, const float* rss, const float* state, const float* wc, bf16_t* zb, float* out, int layer) {
    const int rs_ = (int)(i_ / (D_MODEL / 8)), ch = (int)(i_ % (D_MODEL / 8)) * 8, m = MP + rs_;
    const RowInfo ri = row_info(m);
    const int nc = (ch / 128) * 256 + (ch % 128);
    float u[3][8], bv[8];
    for (int back = 0; back < 3; ++back) {
        if (ri.t - back >= 0) {
            const int r2 = rs_ - back; const float rsn = rsqrtf(rss[MP + r2] * (1.0f / D_MODEL) + EPS);
            for (int k = 0; k < 8; ++k) { float c = 0.f, x = 0.f; for (int ks = 0; ks < KS; ++ks) { const float* p = part + ((size_t)ks * MS + r2) * 3 * D_MODEL; c += p[nc + k]; x += p[nc + 128 + k]; } u[back][k] = (c * rsn) * (x * rsn); }
        } else { const float* st = state + (size_t)(ri.seq - BATCH) * 2 * D_MODEL + ch;
            const int srow = 2 - (back - ri.t); for (int k = 0; k < 8; ++k) u[back][k] = st[(size_t)srow * D_MODEL + k]; }
    }
    { const float rsn = rsqrtf(rss[m] * (1.0f / D_MODEL) + EPS);
      for (int k = 0; k < 8; ++k) { float b = 0.f; for (int ks = 0; ks < KS; ++ks) b += part[((size_t)ks * MS + rs_) * 3 * D_MODEL + 2 * D_MODEL + ch + k]; bv[k] = b * rsn; } }
    for (int k = 0; k < 8; ++k) { const float ub0 = bf2f(f2bf(u[0][k])), ub1 = (ri.t >= 1) ? bf2f(f2bf(u[1][k])) : u[1][k], ub2 = (ri.t >= 2) ? bf2f(f2bf(u[2][k])) : u[2][k];
        zb[(size_t)m * D_MODEL + ch + k] = f2bf(bf2f(f2bf(bv[k])) * (wc[ch + k] * ub2 + wc[D_MODEL + ch + k] * ub1 + wc[2 * D_MODEL + ch + k] * ub0));
        if (ri.t >= DEC_SEQ - 2) out[O_CS + (((size_t)layer * DEC_BATCH + (ri.seq - BATCH)) * 2 + (ri.t - (DEC_SEQ - 2))) * D_MODEL + ch + k] = u[0][k]; }
}

__device__ __forceinline__ void acmp_sample_wave(int task, const float* cache_kv, const int* page_table, const float* pe, bf16_t* A, int lane) {
    typedef float f4 __attribute__((ext_vector_type(4))); typedef unsigned u4 __attribute__((ext_vector_type(4)));
    const int b = task / NBC_PAST, c = task % NBC_PAST, tok0 = c * L_CMP;
    const int page = page_table[b * N_PAGES + tok0 / PAGE_SIZE];
    const int e = lane >> 5, g = (lane >> 3) & (N_KV - 1), c8 = lane & 7;
    const float* src = cache_kv + ((size_t)page * PAGE_SIZE + tok0 % PAGE_SIZE) * 4 * N_KV * HD + lane * 8;
    const float* pp = pe + (size_t)e * L_CMP * HD + 8 * c8;
    bf16_t* dst = A + ((size_t)e * RS_CMP + ((size_t)b * NBC_PAST + c) * N_KV + g) * (L_CMP * HD) + 8 * c8;
#pragma unroll 8
    for (int l = 0; l < L_CMP; ++l) {
        const f4 a0 = __builtin_nontemporal_load((const f4*)(src + (size_t)l * 4 * N_KV * HD)) + *(const f4*)(pp + l * HD), a1 = __builtin_nontemporal_load((const f4*)(src + (size_t)l * 4 * N_KV * HD + 4)) + *(const f4*)(pp + l * HD + 4);
        u4 w; w.x = att::cvtpk(a0[0], a0[1]); w.y = att::cvtpk(a0[2], a0[3]); w.z = att::cvtpk(a1[0], a1[1]); w.w = att::cvtpk(a1[2], a1[3]);
        *(u4*)(dst + l * HD) = w;
    }
}
__device__ __forceinline__ void wconv_tile(int item, const float* src, int Nsrc, const float* gain, bf16_t* dst, int Nd, int K, int kind, int aux, LAS float* scr, int lane) {
    const int nblk = Nd / 32, kb = item / nblk, nb = item % nblk, k0 = 64 * kb, n0 = 32 * nb;
    const int colbase = colmap(kind, n0, aux);
    const int col = colbase + (lane & 31); const bool ok = colbase >= 0 && col < Nsrc;
    float tv[32];
    const float* sp0 = src + (size_t)(k0 + (lane >> 5)) * Nsrc + (ok ? col : 0);
#pragma unroll
    for (int i = 0; i < 32; ++i) tv[i] = ok ? __builtin_nontemporal_load(sp0 + (size_t)(2 * i) * Nsrc) : 0.f;
#pragma unroll
    for (int i = 0; i < 32; ++i) { const int kk = 2 * i + (lane >> 5); const float g = gain ? gain[k0 + kk] : 1.f; scr[kk * 33 + (lane & 31)] = tv[i] * g; }
    asm volatile("s_waitcnt lgkmcnt(0)" ::: "memory");
    const int c = lane & 7;
#pragma unroll
    for (int j = 0; j < 4; ++j) { const int n = (lane >> 3) + 8 * j; const LAS float* sp = scr + (8 * c) * 33 + n;
        typedef unsigned v4u __attribute__((ext_vector_type(4)));
        v4u o; o.x = pg8::cvt_pk_bf16(sp[0 * 33], sp[1 * 33]); o.y = pg8::cvt_pk_bf16(sp[2 * 33], sp[3 * 33]); o.z = pg8::cvt_pk_bf16(sp[4 * 33], sp[5 * 33]); o.w = pg8::cvt_pk_bf16(sp[6 * 33], sp[7 * 33]);
        *(v4u*)(dst + (size_t)(n0 + n) * K + k0 + 8 * c) = o; }
    asm volatile("s_waitcnt lgkmcnt(0)" ::: "memory");
}
__device__ __forceinline__ void hinit_row(int m, const float* xp, const float* xs, float* h, bf16_t* hb, float* rss0, int lane) {
    typedef float f4 __attribute__((ext_vector_type(4))); typedef unsigned u2 __attribute__((ext_vector_type(2)));
    const float* x = m < MP ? xp + (size_t)m * D_MODEL : xs + (size_t)(m - MP) * D_MODEL;
    float s = 0.f;
#pragma unroll
    for (int j = 0; j < D_MODEL / 256; ++j) { const f4 v = *(const f4*)(x + 256 * j + 4 * lane); s += (v[0] * v[0] + v[1] * v[1]) + (v[2] * v[2] + v[3] * v[3]);
        *(f4*)(h + (size_t)m * D_MODEL + 256 * j + 4 * lane) = v; u2 w; w.x = pg8::cvt_pk_bf16(v[0], v[1]); w.y = pg8::cvt_pk_bf16(v[2], v[3]); *(u2*)(hb + (size_t)m * D_MODEL + 256 * j + 4 * lane) = w; }
#pragma unroll
    for (int o = 1; o < 64; o <<= 1) s += __shfl_xor(s, o);
    if (lane == 0) rss0[m] = s;
}
#endif

#ifndef CPU_TEST
__device__ __forceinline__ size_t opaque_gtid(int wave) { int w = wave; asm volatile("" : "+s"(w)); unsigned t = blockIdx.x * NTHREADS + w * 64 + lane_id_v(); return (size_t)t; }
#define ITEM_LOOP(total) for (size_t i = opaque_gtid(wave_id); i < (size_t)(total); i += (size_t)gridDim.x * NTHREADS)
#else
#define ITEM_LOOP(total) _Pragma("omp parallel for schedule(dynamic, 64)") for (long long i = 0; i < (long long)(total); ++i)
#endif

struct Params {
    const float *x_prompt, *x_sample, *cache_kv, *cache_win, *state_conv; const int* page_table;
    const float *ffn_a_norm, *ffn_a_w_in, *ffn_a_w_out, *mix_norm, *ffn_b_norm, *ffn_b_w_in, *ffn_b_w_out, *conv_w_in, *conv_w, *conv_w_out, *kv_norm, *w_kv, *k_norm,
                *cmp_pe, *cmp_w1, *cmp_w2, *nsa_w_qg, *nsa_q_norm, *nsa_w_o;
    float* out; unsigned char* ws;
};
constexpr int LDS_RING = 131072, LDS_BAR_OFF = LDS_RING + 352, LDS_BYTES = 147456;

#ifndef CPU_TEST
typedef const __attribute__((address_space(4))) Params* KParamsPtr;
__device__ __forceinline__ KParamsPtr kparams_ptr() {
#if defined(__HIP_DEVICE_COMPILE__)
    KParamsPtr p = (KParamsPtr)__builtin_amdgcn_kernarg_segment_ptr(); asm volatile("" : "+s"(p)); return p;
#else
    return nullptr;
#endif
}
__device__ __forceinline__ Params load_params() {
#if defined(__HIP_DEVICE_COMPILE__)
    return *kparams_ptr();
#else
    return Params{};
#endif
}
__device__ __forceinline__ unsigned char* load_ws() {
#if defined(__HIP_DEVICE_COMPILE__)
    return kparams_ptr()->ws;
#else
    return nullptr;
#endif
}
#define KP const Params P = load_params()
__device__ __forceinline__ int opaque_s(int v) { asm volatile("" : "+s"(v)); return v; }
#define GRID_SYNC() do { XcdBarrier bar_; bar_.bar = (GU*)load_ws() + 1024; bar_.x = 0; bar_.st = (volatile LAS unsigned*)(lds + LDS_BAR_OFF); xcd_barrier(bar_, wave_id == 0 && lane_id_v() == 0u); } while (0)
__global__ void __launch_bounds__(NTHREADS, 2) mega(Params P_unused)
#else
static Params g_params;
#define KP const Params& P = g_params
#define GRID_SYNC() do {} while (0)
void mega(Params P_unused)
#endif
{
#ifndef CPU_TEST
    extern __shared__ __attribute__((aligned(16))) unsigned char lds[];
    const int wave_id = __builtin_amdgcn_readfirstlane((int)(threadIdx.x >> 6));
    if (threadIdx.x < 4) ((LAS unsigned*)(lds + LDS_BAR_OFF))[threadIdx.x] = 0u;
    __syncthreads();
    (void)xcd_barrier_post((GU*)load_ws() + 1024, (volatile LAS unsigned*)(lds + LDS_BAR_OFF), threadIdx.x == 0);
#define RING ((PG8_LAS unsigned char*)lds)
#else
    g_params = P_unused;
#endif
#define WS_F(f) ((float*)(P.ws + WSM.f))
#define WS_B(f) ((bf16_t*)(P.ws + WSM.f))
#define KVSRC KvSrc{P.cache_kv, P.page_table, P.out}
#define PH(total, call) do { { KP; ITEM_LOOP(total) call; } GRID_SYNC(); } while (0)
#ifdef CPU_TEST
    for (int L = 0; L < DEPTH; ++L) {
        KP;
        ITEM_LOOP((size_t)2 * D_FF * (D_MODEL / 64)) wconv_item(i, P.ffn_a_w_in + (size_t)L * D_MODEL * 2 * D_FF, 2 * D_FF, P.ffn_a_norm + (size_t)L * D_MODEL, WS_B(w_ain) + (size_t)L * 2 * D_FF * D_MODEL, 2 * D_FF, D_MODEL, CM_PAIR, D_FF);
        ITEM_LOOP((size_t)D_MODEL * (D_FF / 64)) wconv_item(i, P.ffn_a_w_out + (size_t)L * D_FF * D_MODEL, D_MODEL, nullptr, WS_B(w_aout) + (size_t)L * D_MODEL * D_FF, D_MODEL, D_FF, CM_PLAIN, 0);
        ITEM_LOOP((size_t)2 * D_FF * (D_MODEL / 64)) wconv_item(i, P.ffn_b_w_in + (size_t)L * D_MODEL * 2 * D_FF, 2 * D_FF, P.ffn_b_norm + (size_t)L * D_MODEL, WS_B(w_bin) + (size_t)L * 2 * D_FF * D_MODEL, 2 * D_FF, D_MODEL, CM_PAIR, D_FF);
        ITEM_LOOP((size_t)D_MODEL * (D_FF / 64)) wconv_item(i, P.ffn_b_w_out + (size_t)L * D_FF * D_MODEL, D_MODEL, nullptr, WS_B(w_bout) + (size_t)L * D_MODEL * D_FF, D_MODEL, D_FF, CM_PLAIN, 0);
    }
    for (int L = 0; L < N_A; ++L) {
        KP;
        ITEM_LOOP((size_t)3 * D_MODEL * (D_MODEL / 64)) wconv_item(i, P.conv_w_in + (size_t)L * D_MODEL * 3 * D_MODEL, 3 * D_MODEL, P.mix_norm + (size_t)L * D_MODEL, WS_B(w_cin) + (size_t)L * 3 * D_MODEL * D_MODEL, 3 * D_MODEL, D_MODEL, CM_CONV, 0);
        ITEM_LOOP((size_t)D_MODEL * (D_MODEL / 64)) wconv_item(i, P.conv_w_out + (size_t)L * D_MODEL * D_MODEL, D_MODEL, nullptr, WS_B(w_cout) + (size_t)L * D_MODEL * D_MODEL, D_MODEL, D_MODEL, CM_PLAIN, 0);
    }
    for (int b = 0; b < N_B; ++b) {
        KP;
        ITEM_LOOP((size_t)QGP * (D_MODEL / 64)) wconv_item(i, P.nsa_w_qg + (size_t)b * D_MODEL * QGW, QGW, P.mix_norm + (size_t)(N_A + b) * D_MODEL, WS_B(w_qg) + (size_t)b * QGP * D_MODEL, QGP, D_MODEL, CM_HEADS, N_HEADS);
        ITEM_LOOP((size_t)D_MODEL * (HDM / 64)) wconv_item(i, P.nsa_w_o + (size_t)b * HDM * D_MODEL, D_MODEL, nullptr, WS_B(w_o) + (size_t)b * D_MODEL * HDM, D_MODEL, HDM, CM_PLAIN, 0);
    }
    { KP; ITEM_LOOP((size_t)KVW * (D_MODEL / 64)) wconv_item(i, P.w_kv, KVW, P.kv_norm, WS_B(w_kv), KVW, D_MODEL, CM_HEADS, 6 * N_KV); }
    { KP; ITEM_LOOP((size_t)NPOS * 8) rope_item(i, WS_F(rope)); }
    { KP; ITEM_LOOP(MT) hinit_item(i, P.x_prompt, P.x_sample, WS_F(h), WS_B(hb), WS_F(rss)); }
#else
#define WAVE_ITEMS(total) for (int it_ = (int)(opaque_s((int)blockIdx.x) * 8 + wave_id); it_ < (int)(total); it_ += (int)gridDim.x * 8)
#define WCONV(srcp, Nsrc_, gainp, dstp, Nd_, K_, kind_, aux_) do { KP; LAS float* scr_ = (LAS float*)(lds + wave_id * 16384); const int lane_ = (int)lane_id_v(); \
        WAVE_ITEMS(((Nd_) / 32) * ((K_) / 64)) wconv_tile(it_, srcp, Nsrc_, gainp, dstp, Nd_, K_, kind_, aux_, scr_, lane_); } while (0)
    for (int L = 0; L < DEPTH; ++L) {
        WCONV(P.ffn_a_w_in + (size_t)L * D_MODEL * 2 * D_FF, 2 * D_FF, P.ffn_a_norm + (size_t)L * D_MODEL, WS_B(w_ain) + (size_t)L * 2 * D_FF * D_MODEL, 2 * D_FF, D_MODEL, CM_PAIR, D_FF);
        WCONV(P.ffn_a_w_out + (size_t)L * D_FF * D_MODEL, D_MODEL, nullptr, WS_B(w_aout) + (size_t)L * D_MODEL * D_FF, D_MODEL, D_FF, CM_PLAIN, 0);
        WCONV(P.ffn_b_w_in + (size_t)L * D_MODEL * 2 * D_FF, 2 * D_FF, P.ffn_b_norm + (size_t)L * D_MODEL, WS_B(w_bin) + (size_t)L * 2 * D_FF * D_MODEL, 2 * D_FF, D_MODEL, CM_PAIR, D_FF);
        WCONV(P.ffn_b_w_out + (size_t)L * D_FF * D_MODEL, D_MODEL, nullptr, WS_B(w_bout) + (size_t)L * D_MODEL * D_FF, D_MODEL, D_FF, CM_PLAIN, 0);
    }
    for (int L = 0; L < N_A; ++L) {
        WCONV(P.conv_w_in + (size_t)L * D_MODEL * 3 * D_MODEL, 3 * D_MODEL, P.mix_norm + (size_t)L * D_MODEL, WS_B(w_cin) + (size_t)L * 3 * D_MODEL * D_MODEL, 3 * D_MODEL, D_MODEL, CM_CONV, 0);
        WCONV(P.conv_w_out + (size_t)L * D_MODEL * D_MODEL, D_MODEL, nullptr, WS_B(w_cout) + (size_t)L * D_MODEL * D_MODEL, D_MODEL, D_MODEL, CM_PLAIN, 0);
    }
    for (int b = 0; b < N_B; ++b) {
        WCONV(P.nsa_w_qg + (size_t)b * D_MODEL * QGW, QGW, P.mix_norm + (size_t)(N_A + b) * D_MODEL, WS_B(w_qg) + (size_t)b * QGP * D_MODEL, QGP, D_MODEL, CM_HEADS, N_HEADS);
        WCONV(P.nsa_w_o + (size_t)b * HDM * D_MODEL, D_MODEL, nullptr, WS_B(w_o) + (size_t)b * D_MODEL * HDM, D_MODEL, HDM, CM_PLAIN, 0);
    }
    WCONV(P.w_kv, KVW, P.kv_norm, WS_B(w_kv), KVW, D_MODEL, CM_HEADS, 6 * N_KV);
    { KP; ITEM_LOOP((size_t)NPOS * 8) rope_item(i, WS_F(rope)); }
    { KP; const int lane_ = (int)lane_id_v(); WAVE_ITEMS(MT) hinit_row(it_, P.x_prompt, P.x_sample, WS_F(h), WS_B(hb), WS_F(rss), lane_); }
#endif
#ifndef CPU_TEST
    for (int e = 0; e < 2; ++e) WCONV(P.cmp_w1 + (size_t)e * L_CMP * HD * CMP_HID, CMP_HID, nullptr, WS_B(w1t) + (size_t)e * CMP_HID * L_CMP * HD, CMP_HID, L_CMP * HD, CM_PLAIN, 0);
    for (int e = 0; e < 2; ++e) WCONV(P.cmp_w2 + (size_t)e * CMP_HID * HD, HD, nullptr, WS_B(w2t) + (size_t)e * HD * CMP_HID, HD, CMP_HID, CM_PLAIN, 0);
    { KP; const int lane_ = (int)lane_id_v(); static_assert(N_KV == 4 && 2 * N_KV * 8 == 64, "acmp_sample_wave lane map"); WAVE_ITEMS(DEC_BATCH * NBC_PAST) acmp_sample_wave(it_, P.cache_kv, P.page_table, P.cmp_pe, WS_B(acs), lane_); }
#endif
    GRID_SYNC();
#ifndef CPU_TEST
    { KP; pg8::Gemm g{WS_B(acs), WS_B(w1t), 2 * RS_CMP, 2 * CMP_HID, L_CMP * HD}; pg8::CmpOrder So{2 * RS_CMP / 256, RS_CMP / 256, opaque_s((int)gridDim.x), opaque_s((int)blockIdx.x)};
      pg8::EpiGelu E{WS_B(hids)}; pg8::gemm_phase<pg8::EpiGelu, pg8::CmpOrder, true, true>(wave_id, RING, g, So, E); }
    GRID_SYNC();
    { KP; const int lane_ = (int)lane_id_v(); WAVE_ITEMS(2 * RS_CMP / 32) att::cmp_out_wave(it_, WS_B(hids), RS_CMP, NBC_PAST, BATCH, WS_B(w2t), P.k_norm, WS_F(kc), WS_F(vc), nullptr, nullptr, lane_); }
    GRID_SYNC();
#endif

#ifndef CPU_TEST
#define RESID_PH(Aptr, Btptr, Kk, KSn, v_out, coef_, last_) do { \
        { KP; const int lane_ = (int)lane_id_v(); WAVE_ITEMS((MS / 32) * (D_MODEL / 32) * (KSn)) att::skinny_task(it_, (Aptr) + (size_t)MP * (Kk), Btptr, D_MODEL, Kk, KSn, WS_F(part), lane_); } \
        { KP; pg8::Gemm g{Aptr, Btptr, MP, D_MODEL, Kk}; pg8::StaticOrder So; So.init(MP, D_MODEL, opaque_s((int)gridDim.x), opaque_s((int)blockIdx.x)); \
          pg8::EpiResid E{WS_F(h), WS_B(hb), WS_F(rss) + (size_t)(v_out) * MT, (last_) ? P.out + O_YP : nullptr, coef_}; pg8::gemm_phase<pg8::EpiResid, pg8::StaticOrder, true, true>(wave_id, RING, g, So, E); } \
        GRID_SYNC(); \
        { KP; const int lane_ = (int)lane_id_v(); WAVE_ITEMS(MS) att::resid_reduce_row(it_, WS_F(part), KSn, coef_, WS_F(h), WS_B(hb), WS_F(rss) + (size_t)(v_out) * MT, (last_) ? P.out + O_YP : nullptr, lane_); } \
        GRID_SYNC(); } while (0)
#define FFN_OPT(wi, wo, v_in, last) do { \
        { KP; pg8::Gemm g{WS_B(hb), WS_B(wi) + (size_t)layer * 2 * D_FF * D_MODEL, MT, 2 * D_FF, D_MODEL}; pg8::StaticOrder So; So.init(MT, 2 * D_FF, opaque_s((int)gridDim.x), opaque_s((int)blockIdx.x)); \
          pg8::EpiSwiglu E{WS_B(act), WS_F(rss) + (size_t)(v_in) * MT}; pg8::gemm_phase<pg8::EpiSwiglu, pg8::StaticOrder, true, true>(wave_id, RING, g, So, E); } \
        GRID_SYNC(); \
        RESID_PH(WS_B(act), WS_B(wo) + (size_t)layer * D_MODEL * D_FF, D_FF, 8, (v_in) + 1, 0.5f, last); } while (0)
#else
#define FFN_OPT(wi, wo, v_in, last) do { KP; \
        ITEM_LOOP((size_t)MT * D_FF) ref_ffn_in_item(i, WS_B(hb), WS_F(rss) + (size_t)(v_in) * MT, WS_B(wi) + (size_t)layer * 2 * D_FF * D_MODEL, WS_B(act)); \
        ITEM_LOOP(MT) ref_resid_row_item(i, WS_B(act), D_FF, WS_B(wo) + (size_t)layer * D_MODEL * D_FF, 0.5f, WS_F(h), WS_B(hb), WS_F(rss) + (size_t)((v_in) + 1) * MT, (last) ? P.out + O_YP : nullptr); } while (0)
#endif
#ifndef CPU_TEST
#define GEMM_PH(EpiT, Aptr, Btptr, Nn, Kk, ...) do { { KP; pg8::Gemm g{Aptr, Btptr, MT, Nn, Kk}; pg8::StaticOrder So; So.init(MT, Nn, opaque_s((int)gridDim.x), opaque_s((int)blockIdx.x)); \
        pg8::EpiT E{__VA_ARGS__}; pg8::gemm_phase<pg8::EpiT, pg8::StaticOrder, true, true>(wave_id, RING, g, So, E); } GRID_SYNC(); } while (0)
#endif
    for (int layer = 0; layer < DEPTH; ++layer) {
        FFN_OPT(w_ain, w_aout, 3 * layer, false);
        const int v1 = 3 * layer + 1;
        if (layer < N_A) {
#ifndef CPU_TEST
            { KP; const int lane_ = (int)lane_id_v(); WAVE_ITEMS((MS / 32) * (3 * D_MODEL / 32) * 2) att::skinny_task(it_, WS_B(hb) + (size_t)MP * D_MODEL, WS_B(w_cin) + (size_t)layer * 3 * D_MODEL * D_MODEL, 3 * D_MODEL, D_MODEL, 2, WS_F(part), lane_); }
            { KP; pg8::Gemm g{WS_B(hb), WS_B(w_cin) + (size_t)layer * 3 * D_MODEL * D_MODEL, MP, 3 * D_MODEL, D_MODEL}; pg8::StaticOrder So; So.init(MP, 3 * D_MODEL, opaque_s((int)gridDim.x), opaque_s((int)blockIdx.x));
              pg8::EpiConvIn E{WS_B(ub), WS_B(bb), WS_F(rss) + (size_t)v1 * MT, P.out, layer}; pg8::gemm_phase<pg8::EpiConvIn, pg8::StaticOrder, true, true>(wave_id, RING, g, So, E); }
            GRID_SYNC();
#else
            PH((size_t)MT * D_MODEL, ref_conv_in_item(i, WS_B(hb), WS_F(rss) + (size_t)v1 * MT, WS_B(w_cin) + (size_t)layer * 3 * D_MODEL * D_MODEL, WS_B(ub), WS_B(bb), P.out, layer));
#endif
#ifndef CPU_TEST
            { KP; ITEM_LOOP((size_t)MS * (D_MODEL / 8)) conv_thin_sample_item(i, WS_F(part), 2, WS_F(rss) + (size_t)v1 * MT, P.state_conv + (size_t)layer * DEC_BATCH * 2 * D_MODEL, P.conv_w + (size_t)layer * 3 * D_MODEL, WS_B(zb), P.out, layer); }
            PH((size_t)MP * (D_MODEL / 8), conv_thin_vec_item(i, WS_B(ub), WS_B(bb), P.state_conv + (size_t)layer * DEC_BATCH * 2 * D_MODEL, P.conv_w + (size_t)layer * 3 * D_MODEL, WS_B(zb)));
#else
            PH((size_t)MT * D_MODEL, conv_thin_item(i, WS_B(ub), WS_B(bb), P.state_conv + (size_t)layer * DEC_BATCH * 2 * D_MODEL, P.conv_w + (size_t)layer * 3 * D_MODEL, WS_B(zb)));
#endif
#ifndef CPU_TEST
            RESID_PH(WS_B(zb), WS_B(w_cout) + (size_t)layer * D_MODEL * D_MODEL, D_MODEL, 8, v1 + 1, 1.0f, false);
#else
            PH(MT, ref_resid_row_item(i, WS_B(zb), D_MODEL, WS_B(w_cout) + (size_t)layer * D_MODEL * D_MODEL, 1.0f, WS_F(h), WS_B(hb), WS_F(rss) + (size_t)(v1 + 1) * MT, nullptr));
#endif
        } else {
            const int b = layer - N_A;
#ifndef CPU_TEST
            GEMM_PH(EpiQG, WS_B(hb), WS_B(w_qg) + (size_t)b * QGP * D_MODEL, QGP, D_MODEL, WS_B(qnb), WS_B(qrb), WS_F(gates), WS_F(rss) + (size_t)v1 * MT, P.nsa_q_norm + (size_t)b * HD, WS_F(rope));
#else
            { KP; ITEM_LOOP((size_t)MT * N_HEADS) ref_qg_item(i, WS_B(hb), WS_F(rss) + (size_t)v1 * MT, WS_B(w_qg) + (size_t)b * QGP * D_MODEL, P.nsa_q_norm + (size_t)b * HD, WS_F(rope), WS_F(qn), WS_F(qr)); }
            PH((size_t)MT * 3 * N_HEADS, ref_gates_item(i, WS_B(hb), WS_F(rss) + (size_t)v1 * MT, WS_B(w_qg) + (size_t)b * QGP * D_MODEL, WS_F(gates)));
#endif
#ifndef CPU_TEST
            { KP; att::STensors TS{WS_B(qnb), WS_B(qrb), WS_F(kc), WS_F(vc), P.cache_kv, P.page_table, P.cache_win, P.out, WS_F(winrows), WS_F(gates), WS_B(ob)};
              int wv = wave_id; asm volatile("" : "+s"(wv));
              att::att_queue_sample(TS, (unsigned*)P.ws + 8192 + 128 * b, (att::ldsp)lds, wv, (int)lane_id_v()); }
            { KP; att::Tensors T{WS_B(qnb), WS_B(qrb), P.ws + WSM.ksel, P.ws + WSM.vsel, P.ws + WSM.kwin, P.ws + WSM.vwin, P.ws + WSM.kci, P.ws + WSM.vci, WS_F(gates), WS_B(ob)};
              int wv = wave_id; asm volatile("" : "+s"(wv));
              att::att_queue_prompt(T, (unsigned*)P.ws + 8192 + 128 * b + 64, (att::ldsp)lds, wv, (int)lane_id_v()); }
            GRID_SYNC();
#else
            PH((size_t)MT * N_HEADS, attn_cmp_item(i, WS_F(qn), WS_F(kc), WS_F(vc), WS_F(pbuf), WS_F(oc)));
            PH((size_t)MT * N_KV, topk_item(i, WS_F(pbuf), (int*)WS_F(sel), WS_F(scorebuf)));
            PH((size_t)MT * N_HEADS, attn_sel_item(i, KVSRC, WS_F(qr), (const int*)WS_F(sel), WS_F(os)));
            PH((size_t)MT * N_HEADS, attn_win_item(i, P.cache_win, WS_F(winrows), WS_F(qr), WS_F(gates), WS_F(oc), WS_F(os), WS_B(ob)));
#endif
#ifndef CPU_TEST
            RESID_PH(WS_B(ob), WS_B(w_o) + (size_t)b * D_MODEL * HDM, HDM, 8, v1 + 1, 1.0f, false);
#else
            PH(MT, ref_resid_row_item(i, WS_B(ob), HDM, WS_B(w_o) + (size_t)b * D_MODEL * HDM, 1.0f, WS_F(h), WS_B(hb), WS_F(rss) + (size_t)(v1 + 1) * MT, nullptr));
#endif
        }
        FFN_OPT(w_bin, w_bout, 3 * layer + 2, layer == DEPTH - 1);
        if (layer == N_A - 1) {
            const int v3 = 3 * layer + 3;
#ifndef CPU_TEST
            { KP; pg8::Gemm g{WS_B(hb), WS_B(w_kv), MT, KVW, D_MODEL}; pg8::StaticOrder So; So.init(MT, KVW, opaque_s((int)gridDim.x), opaque_s((int)blockIdx.x));
              pg8::EpiKV E{P.out, WS_F(winrows), WS_F(rss) + (size_t)v3 * MT, P.k_norm, WS_F(rope), P.ws + WSM.ksel, P.ws + WSM.vsel, P.ws + WSM.kwin, P.ws + WSM.vwin, WS_B(acp), P.cmp_pe}; pg8::gemm_phase<pg8::EpiKV, pg8::StaticOrder, true, true>(wave_id, RING, g, So, E); }
#else
            { KP; ITEM_LOOP((size_t)MT * 6 * N_KV) ref_kv_item(i, WS_B(hb), WS_F(rss) + (size_t)v3 * MT, WS_B(w_kv), P.k_norm, WS_F(rope), P.out, WS_F(winrows)); }
#endif
            PH((size_t)DEC_BATCH * (WINDOW - DEC_SEQ) * 2 * N_KV * HD, wincopy_item(i, P.cache_win, P.out));
#ifdef CPU_TEST
            PH((size_t)NSEQ * NBC_MAX * 2 * N_KV * CMP_HID, cmp_hid_item(i, KVSRC, P.cmp_pe, P.cmp_w1, WS_F(hid)));
            PH((size_t)NSEQ * NBC_MAX * 2 * N_KV, cmp_out_item(i, WS_F(hid), P.cmp_w2, P.k_norm, WS_F(kc), WS_F(vc)));
#else
            { KP; pg8::Gemm g{WS_B(acp), WS_B(w1t), 2 * RP_CMP, 2 * CMP_HID, L_CMP * HD}; pg8::CmpOrder So{2 * RP_CMP / 256, RP_CMP / 256, opaque_s((int)gridDim.x), opaque_s((int)blockIdx.x)};
              pg8::EpiGelu E{WS_B(hidp)}; pg8::gemm_phase<pg8::EpiGelu, pg8::CmpOrder, true, true>(wave_id, RING, g, So, E); }
            GRID_SYNC();
            { KP; const int lane_ = (int)lane_id_v(); WAVE_ITEMS(2 * RP_CMP / 32) att::cmp_out_wave(it_, WS_B(hidp), RP_CMP, NBC_P, 0, WS_B(w2t), P.k_norm, WS_F(kc), WS_F(vc), P.ws + WSM.kci, P.ws + WSM.vci, lane_); }
            GRID_SYNC();
#endif
        }
    }
}

extern "C" void kernel_launch(void* const* d_in, const int* in_sizes, int n_in, void* d_out, int out_size, void* d_ws, size_t ws_size, hipStream_t stream) {
    Params P{};
    P.x_prompt = (const float*)d_in[0]; P.x_sample = (const float*)d_in[1]; P.cache_kv = (const float*)d_in[2]; P.cache_win = (const float*)d_in[3];
    P.state_conv = (const float*)d_in[4]; P.page_table = (const int*)d_in[5]; P.ffn_a_norm = (const float*)d_in[6]; P.ffn_a_w_in = (const float*)d_in[7];
    P.ffn_a_w_out = (const float*)d_in[8]; P.mix_norm = (const float*)d_in[9]; P.ffn_b_norm = (const float*)d_in[10]; P.ffn_b_w_in = (const float*)d_in[11];
    P.ffn_b_w_out = (const float*)d_in[12]; P.conv_w_in = (const float*)d_in[13]; P.conv_w = (const float*)d_in[14]; P.conv_w_out = (const float*)d_in[15];
    P.kv_norm = (const float*)d_in[16]; P.w_kv = (const float*)d_in[17]; P.k_norm = (const float*)d_in[18]; P.cmp_pe = (const float*)d_in[19];
    P.cmp_w1 = (const float*)d_in[20]; P.cmp_w2 = (const float*)d_in[21]; P.nsa_w_qg = (const float*)d_in[22]; P.nsa_q_norm = (const float*)d_in[23];
    P.nsa_w_o = (const float*)d_in[24];
    P.out = (float*)d_out; P.ws = (unsigned char*)d_ws;
#ifndef CPU_TEST
    static int grid = 0;
    if (grid == 0) {
        int dev = 0, cus = 0, per_cu = 0;
        hipGetDevice(&dev); hipDeviceGetAttribute(&cus, hipDeviceAttributeMultiprocessorCount, dev);
        hipFuncSetAttribute((const void*)mega, hipFuncAttributeMaxDynamicSharedMemorySize, LDS_BYTES);
        hipOccupancyMaxActiveBlocksPerMultiprocessor(&per_cu, (const void*)mega, NTHREADS, LDS_BYTES);
        (void)hipGetLastError();
        grid = cus;
    }
    hipMemsetAsync(d_ws, 0, WS_ZERO_BYTES, stream);
    hipLaunchKernelGGL(mega, dim3(grid), dim3(NTHREADS), LDS_BYTES, stream, P);
#else
    memset(d_ws, 0, WS_ZERO_BYTES);
    mega(P);
#endif
}
```

```cpp
#ifdef CPU_TEST
#include "shim.h"
#else
#include <hip/hip_runtime.h>
#endif
#include <cstdint>
#include <cstddef>
#include <cmath>
#include <cstring>
typedef unsigned short bf16_t;
#ifndef CPU_TEST
#define HOSTDEV __host__ __device__
#else
#define HOSTDEV
#endif
HOSTDEV inline bf16_t f2bf(float f) { unsigned u; memcpy(&u, &f, 4); u = (u + 0x7fffu + ((u >> 16) & 1u)) >> 16; return (bf16_t)u; }
HOSTDEV inline float bf2f(bf16_t b) { unsigned u = (unsigned)b << 16; float f; memcpy(&f, &u, 4); return f; }

#ifdef CFG_SMALL
constexpr int D_MODEL = 256, BATCH = 1, SEQ = 2048, DEPTH = 4, DEC_BATCH = 2, DEC_SEQ = 8, PAST_LEN = 2048, PAGE_SIZE = 128, D_FF = 256, N_HEADS = 4, N_KV = 2;
#else
constexpr int D_MODEL = 1024, BATCH = 4, SEQ = 4096, DEPTH = 4, DEC_BATCH = 32, DEC_SEQ = 8, PAST_LEN = 8192, PAGE_SIZE = 128, D_FF = 2816, N_HEADS = 16, N_KV = 4;
#endif
constexpr int N_A = DEPTH / 2, N_B = DEPTH - N_A, HD = 64, HPG = N_HEADS / N_KV, L_CMP = 32, L_SEL = 64, N_SEL = 16, WINDOW = 512, CMP_HID = 4 * HD;
constexpr int MP = BATCH * SEQ, MS = DEC_BATCH * DEC_SEQ, MT = MP + MS, NSEQ = BATCH + DEC_BATCH;
constexpr int N_PAGES = PAST_LEN / PAGE_SIZE;
constexpr int KVW = 6 * N_KV * HD;
constexpr int QGW = N_HEADS * HD + 3 * N_HEADS;
constexpr int HDM = N_HEADS * HD;
constexpr int TPAD_S = ((PAST_LEN + DEC_SEQ + L_SEL - 1) / L_SEL) * L_SEL;
constexpr int NBC_P = SEQ / L_CMP, NBC_S = TPAD_S / L_CMP, NBC_MAX = NBC_S > NBC_P ? NBC_S : NBC_P;
constexpr int NBS_P = SEQ / L_SEL, NBS_S = TPAD_S / L_SEL, NBS_MAX = NBS_S > NBS_P ? NBS_S : NBS_P;
constexpr float EPS = 1e-6f, NEGF = -1e30f, TINYF = 1e-30f, FORCE_SCORE = 1e4f;
__device__ static const float INV_FREQ[8] = {1.0f, 0.1939227432012558f, 0.03760603070259094f, 0.007292664609849453f, 0.0014142135623842478f, 0.00027424818836152554f, 5.3182957344688475e-05f, 1.0313385246263351e-05f};

constexpr size_t O_YP = 0, O_YS = O_YP + (size_t)MP * D_MODEL, O_KVP = O_YS + (size_t)MS * D_MODEL, O_KVS = O_KVP + (size_t)MP * 4 * N_KV * HD,
                 O_WP = O_KVS + (size_t)MS * 4 * N_KV * HD, O_WS = O_WP + (size_t)BATCH * WINDOW * 2 * N_KV * HD, O_CP = O_WS + (size_t)DEC_BATCH * WINDOW * 2 * N_KV * HD,
                 O_CS = O_CP + (size_t)N_A * BATCH * 2 * D_MODEL, O_END = O_CS + (size_t)N_A * DEC_BATCH * 2 * D_MODEL;

struct RowInfo { int seq, t, pos; };
__device__ __host__ inline RowInfo row_info(int m) {
    RowInfo r;
    if (m < MP) { r.seq = m / SEQ; r.t = m % SEQ; r.pos = r.t; }
    else { const int q = m - MP; r.seq = BATCH + q / DEC_SEQ; r.t = q % DEC_SEQ; r.pos = PAST_LEN + r.t; }
    return r;
}
__device__ __host__ inline int seq_row0(int seq) { return seq < BATCH ? seq * SEQ : MP + (seq - BATCH) * DEC_SEQ; }
__device__ __host__ inline int seq_pos0(int seq) { return seq < BATCH ? 0 : PAST_LEN; }
__device__ __host__ inline int seq_len(int seq) { return seq < BATCH ? SEQ : DEC_SEQ; }

__device__ inline void copy_item(size_t i_, const float* a, float* b, size_t n) {
    const size_t i = i_;
    if (i < n) b[i] = a[i];
}
__device__ inline void rmsnorm_item(size_t i_, const float* x, const float* g, float* y, int rows, int d) {
    const int m = (int)i_;
    if (m >= rows) return;
    const float* xr = x + (size_t)m * d; float s = 0.f;
    for (int i = 0; i < d; ++i) s += xr[i] * xr[i];
    const float r = 1.0f / sqrtf(s / d + EPS);
    float* yr = y + (size_t)m * d;
    for (int i = 0; i < d; ++i) yr[i] = xr[i] * r * g[i];
}
__device__ inline void gemm_item(size_t i_, const float* A, int lda, const float* W, float* C, int M, int N, int K) {
    const int nbx = (N + 63) / 64; const int vb = (int)(i_ / 256), t_ = (int)(i_ % 256), tx = t_ % 16, ty = t_ / 16;
    const int c0 = (vb % nbx) * 64 + tx * 4, r0 = (vb / nbx) * 64 + ty * 4;
    if (c0 >= N || r0 >= M) return;
    float acc[4][4];
    for (int i = 0; i < 4; ++i) for (int j = 0; j < 4; ++j) acc[i][j] = 0.f;
    const int nr = (M - r0) < 4 ? (M - r0) : 4;
    for (int k = 0; k < K; k += 4) {
        float a[4][4], w[4][4];
        for (int i = 0; i < 4; ++i) for (int kk = 0; kk < 4; ++kk) a[i][kk] = (i < nr) ? A[(size_t)(r0 + i) * lda + k + kk] : 0.f;
        for (int kk = 0; kk < 4; ++kk) for (int j = 0; j < 4; ++j) w[kk][j] = W[(size_t)(k + kk) * N + c0 + j];
        for (int i = 0; i < 4; ++i) for (int kk = 0; kk < 4; ++kk) for (int j = 0; j < 4; ++j) acc[i][j] += a[i][kk] * w[kk][j];
    }
    for (int i = 0; i < nr; ++i) for (int j = 0; j < 4; ++j) C[(size_t)(r0 + i) * N + c0 + j] = acc[i][j];
}
__device__ inline void swiglu_item(size_t i_, const float* t1, float* act, int rows, int dff) {
    const size_t i = i_;
    if (i >= (size_t)rows * dff) return;
    const int m = (int)(i / dff), j = (int)(i % dff);
    const float g = t1[(size_t)m * 2 * dff + j], u = t1[(size_t)m * 2 * dff + dff + j];
    act[i] = g / (1.0f + expf(-g)) * u;
}
__device__ inline void axpy_item(size_t i_, float* h, const float* y, float coef, size_t n) {
    const size_t i = i_;
    if (i < n) h[i] += coef * y[i];
}
__device__ inline void conv_item(size_t i_, const float* t1, const float* state  , const float* wc  , float* z, float* out, int layer) {
    const size_t i = i_;
    if (i >= (size_t)MT * D_MODEL) return;
    const int m = (int)(i / D_MODEL), ch = (int)(i % D_MODEL);
    const RowInfo ri = row_info(m);
    const float* r = t1 + (size_t)m * 3 * D_MODEL;
    const float b = r[ch], u0 = r[D_MODEL + ch] * r[2 * D_MODEL + ch];
    float u1, u2;
    if (ri.t >= 1) { const float* p = r - 3 * D_MODEL; u1 = p[D_MODEL + ch] * p[2 * D_MODEL + ch]; }
    else u1 = (ri.seq < BATCH) ? 0.f : state[((size_t)(ri.seq - BATCH) * 2 + 1) * D_MODEL + ch];
    if (ri.t >= 2) { const float* p = r - 6 * D_MODEL; u2 = p[D_MODEL + ch] * p[2 * D_MODEL + ch]; }
    else if (ri.seq < BATCH) u2 = 0.f;
    else u2 = (ri.t == 1) ? state[((size_t)(ri.seq - BATCH) * 2 + 1) * D_MODEL + ch] : state[((size_t)(ri.seq - BATCH) * 2 + 0) * D_MODEL + ch];
    z[i] = b * (wc[ch] * u2 + wc[D_MODEL + ch] * u1 + wc[2 * D_MODEL + ch] * u0);
    const int L = seq_len(ri.seq);
    if (ri.t >= L - 2) {
        const int j = ri.t - (L - 2);
        if (ri.seq < BATCH) out[O_CP + (((size_t)layer * BATCH + ri.seq) * 2 + j) * D_MODEL + ch] = u0;
        else out[O_CS + (((size_t)layer * DEC_BATCH + (ri.seq - BATCH)) * 2 + j) * D_MODEL + ch] = u0;
    }
}
__device__ inline void head_norm(float* v, const float* g) {
    float s = 0.f; for (int d = 0; d < HD; ++d) s += v[d] * v[d];
    const float r = 1.0f / sqrtf(s / HD + EPS);
    for (int d = 0; d < HD; ++d) v[d] = v[d] * r * g[d];
}
__device__ inline void rope_cs(float ang, float& c, float& s) {
    const double r = (double)ang * 0.15915494309189535; const float fr = (float)(r - rint(r));
#ifdef CPU_TEST
    c = (float)cos(6.283185307179586 * (double)fr); s = (float)sin(6.283185307179586 * (double)fr);
#else
    c = __builtin_amdgcn_cosf(fr); s = __builtin_amdgcn_sinf(fr);
#endif
}
__device__ inline void head_rope(float* v, int pos) {
    for (int i = 0; i < 8; ++i) {
        const float ang = (float)pos * INV_FREQ[i]; float c, s; rope_cs(ang, c, s);
        const float x1 = v[i], x2 = v[8 + i];
        v[i] = x1 * c - x2 * s; v[8 + i] = x2 * c + x1 * s;
    }
}
__device__ inline void kvprep_item(size_t i_, const float* p, const float* k_norm  , float* out, float* winrows) {
    const int i = (int)i_;
    if (i >= MT * 6 * N_KV) return;
    const int m = i / (6 * N_KV), e = (i / N_KV) % 6, g = i % N_KV;
    const RowInfo ri = row_info(m);
    float v[HD];
    for (int d = 0; d < HD; ++d) v[d] = p[(size_t)m * KVW + (e * N_KV + g) * HD + d];
    if (e == 2) { head_norm(v, k_norm + HD); head_rope(v, ri.pos); }
    if (e == 4) { head_norm(v, k_norm + 2 * HD); head_rope(v, ri.pos); }
    if (e < 4) {
        float* o = (ri.seq < BATCH) ? out + O_KVP + (((size_t)m * 4 + e) * N_KV + g) * HD : out + O_KVS + (((size_t)(m - MP) * 4 + e) * N_KV + g) * HD;
        for (int d = 0; d < HD; ++d) o[d] = v[d];
    } else {
        const int we = e - 4;
        float* w = winrows + (((size_t)m * 2 + we) * N_KV + g) * HD;
        for (int d = 0; d < HD; ++d) w[d] = v[d];
        if (ri.seq < BATCH) { if (ri.t >= SEQ - WINDOW) { float* o = out + O_WP + ((((size_t)ri.seq * WINDOW + (ri.t - (SEQ - WINDOW))) * 2 + we) * N_KV + g) * HD; for (int d = 0; d < HD; ++d) o[d] = v[d]; } }
        else { float* o = out + O_WS + ((((size_t)(ri.seq - BATCH) * WINDOW + (WINDOW - DEC_SEQ + ri.t)) * 2 + we) * N_KV + g) * HD; for (int d = 0; d < HD; ++d) o[d] = v[d]; }
    }
}
__device__ inline void wincopy_item(size_t i_, const float* cache_win, float* out) {
    const size_t i = i_;
    const size_t per = (size_t)(WINDOW - DEC_SEQ) * 2 * N_KV * HD;
    if (i >= (size_t)DEC_BATCH * per) return;
    const size_t b = i / per, r = i % per;
    out[O_WS + b * WINDOW * 2 * N_KV * HD + r] = cache_win[b * WINDOW * 2 * N_KV * HD + (size_t)DEC_SEQ * 2 * N_KV * HD + r];
}
struct KvSrc { const float* cache_kv; const int* page_table; const float* out; };
__device__ inline const float* kv_full_ptr(const KvSrc& S, int seq, int tok, int e, int g) {
    if (seq < BATCH) return S.out + O_KVP + ((((size_t)seq * SEQ + tok) * 4 + e) * N_KV + g) * HD;
    const int b = seq - BATCH;
    if (tok < PAST_LEN) { const int page = S.page_table[b * N_PAGES + tok / PAGE_SIZE]; return S.cache_kv + ((((size_t)page * PAGE_SIZE + tok % PAGE_SIZE) * 4 + e) * N_KV + g) * HD; }
    if (tok < PAST_LEN + DEC_SEQ) return S.out + O_KVS + ((((size_t)b * DEC_SEQ + (tok - PAST_LEN)) * 4 + e) * N_KV + g) * HD;
    return nullptr;
}
__device__ inline int seq_nbc(int seq) { return seq < BATCH ? NBC_P : NBC_S; }
__device__ inline void cmp_hid_item(size_t i_, KvSrc S, const float* pe  , const float* w1  , float* hid) {
    const size_t i = i_;
    if (i >= (size_t)NSEQ * NBC_MAX * 2 * N_KV * CMP_HID) return;
    const int f = (int)(i % CMP_HID), g = (int)((i / CMP_HID) % N_KV), e = (int)((i / ((size_t)CMP_HID * N_KV)) % 2), c = (int)((i / ((size_t)CMP_HID * N_KV * 2)) % NBC_MAX), seq = (int)(i / ((size_t)CMP_HID * N_KV * 2 * NBC_MAX));
    if (c >= seq_nbc(seq)) return;
    float s = 0.f;
    for (int l = 0; l < L_CMP; ++l) {
        const float* r = kv_full_ptr(S, seq, c * L_CMP + l, e, g);
        const float* w = w1 + (((size_t)e * L_CMP + l) * HD) * CMP_HID + f; const float* pp = pe + ((size_t)e * L_CMP + l) * HD;
        for (int d = 0; d < HD; ++d) s += ((r ? r[d] : 0.f) + pp[d]) * w[(size_t)d * CMP_HID];
    }
    const float x = s; const float t = tanhf(0.7978845608028654f * (x + 0.044715f * x * x * x));
    hid[i] = 0.5f * x * (1.0f + t);
}
__device__ inline void cmp_out_item(size_t i_, const float* hid, const float* w2  , const float* k_norm0, float* kc, float* vc) {
    const int i = (int)i_;
    if (i >= NSEQ * NBC_MAX * 2 * N_KV) return;
    const int g = i % N_KV, e = (i / N_KV) % 2, c = (i / (2 * N_KV)) % NBC_MAX, seq = i / (2 * N_KV * NBC_MAX);
    if (c >= seq_nbc(seq)) return;
    const float* hr = hid + (size_t)i * CMP_HID;
    float v[HD];
    for (int d = 0; d < HD; ++d) { float s = 0.f; for (int f = 0; f < CMP_HID; ++f) s += hr[f] * w2[((size_t)e * CMP_HID + f) * HD + d]; v[d] = s; }
    if (e == 0) head_norm(v, k_norm0);
    float* o = (e == 0 ? kc : vc) + (((size_t)seq * NBC_MAX + c) * N_KV + g) * HD;
    for (int d = 0; d < HD; ++d) o[d] = v[d];
}
__device__ inline void qprep_item(size_t i_, const float* qg, const float* q_norm, float* qn, float* qr, float* gates) {
    const int i = (int)i_;
    if (i >= MT * N_HEADS) return;
    const int m = i / N_HEADS, hh = i % N_HEADS;
    const RowInfo ri = row_info(m);
    float v[HD];
    for (int d = 0; d < HD; ++d) v[d] = qg[(size_t)m * QGW + hh * HD + d];
    head_norm(v, q_norm);
    for (int d = 0; d < HD; ++d) qn[(size_t)m * HDM + hh * HD + d] = v[d];
    head_rope(v, ri.pos);
    for (int d = 0; d < HD; ++d) qr[(size_t)m * HDM + hh * HD + d] = v[d];
    for (int j = 0; j < 3; ++j) { const float x = qg[(size_t)m * QGW + HDM + hh * 3 + j]; gates[(size_t)m * 3 * N_HEADS + hh * 3 + j] = 1.0f / (1.0f + expf(-x)); }
}
__device__ inline void attn_cmp_item(size_t i_, const float* qn, const float* kc, const float* vc, float* pbuf, float* oc) {
    const int i = (int)i_;
    if (i >= MT * N_HEADS) return;
    const int m = i / N_HEADS, hh = i % N_HEADS, g = hh / HPG;
    const RowInfo ri = row_info(m);
    const int nbc = seq_nbc(ri.seq);
    const float* q = qn + (size_t)m * HDM + hh * HD;
    float* p = pbuf + (size_t)i * NBC_MAX;
    float mx = NEGF;
    for (int c = 0; c < nbc; ++c) {
        const bool vis = (c + 1) * L_CMP - 1 <= ri.pos;
        float s = 0.f; const float* k = kc + (((size_t)ri.seq * NBC_MAX + c) * N_KV + g) * HD;
        for (int d = 0; d < HD; ++d) s += q[d] * k[d];
        s *= 0.125f; p[c] = s; if (vis && s > mx) mx = s;
    }
    float sum = 0.f;
    for (int c = 0; c < nbc; ++c) { const bool vis = (c + 1) * L_CMP - 1 <= ri.pos; const float e = vis ? expf(p[c] - mx) : 0.f; p[c] = e; sum += e; }
    const float inv = 1.0f / fmaxf(sum, TINYF);
    float o[HD]; for (int d = 0; d < HD; ++d) o[d] = 0.f;
    for (int c = 0; c < nbc; ++c) { p[c] *= inv; if (p[c] != 0.f) { const float* v = vc + (((size_t)ri.seq * NBC_MAX + c) * N_KV + g) * HD; for (int d = 0; d < HD; ++d) o[d] += p[c] * v[d]; } }
    for (int d = 0; d < HD; ++d) oc[(size_t)m * HDM + hh * HD + d] = o[d];
}
__device__ inline void topk_item(size_t i_, const float* pbuf, int* sel, float* scorebuf  ) {
    const int i = (int)i_;
    if (i >= MT * N_KV) return;
    const int m = i / N_KV, g = i % N_KV;
    const RowInfo ri = row_info(m);
    const int nbs = ri.seq < BATCH ? NBS_P : NBS_S, cur = ri.pos / L_SEL;
    float* score = scorebuf + (size_t)i * NBS_MAX;
    for (int b = 0; b < nbs; ++b) {
        float imp = 0.f;
        for (int h = 0; h < HPG; ++h) { const float* p = pbuf + ((size_t)m * N_HEADS + g * HPG + h) * NBC_MAX; imp += p[2 * b]; }
        float imp2 = 0.f;
        for (int h = 0; h < HPG; ++h) { const float* p = pbuf + ((size_t)m * N_HEADS + g * HPG + h) * NBC_MAX; imp2 += p[2 * b + 1]; }
        const bool forced = (b == 0) || (b == cur) || (b == cur - 1), valid = b * L_SEL <= ri.pos;
        score[b] = valid ? (forced ? FORCE_SCORE : imp + imp2) : NEGF;
    }
    const int nsel = N_SEL < nbs ? N_SEL : nbs;
    for (int j = 0; j < N_SEL; ++j) {
        if (j >= nsel) { sel[(size_t)i * N_SEL + j] = -1; continue; }
        int best = -1; float bv = 0.f;
        for (int b = 0; b < nbs; ++b) if (score[b] > -3e38f && (best < 0 || score[b] > bv)) { best = b; bv = score[b]; }
        sel[(size_t)i * N_SEL + j] = best; score[best] = -3.4e38f;
    }
}
__device__ inline void attn_sel_item(size_t i_, KvSrc S, const float* qr, const int* sel, float* os) {
    const int i = (int)i_;
    if (i >= MT * N_HEADS) return;
    const int m = i / N_HEADS, hh = i % N_HEADS, g = hh / HPG;
    const RowInfo ri = row_info(m);
    const float* q = qr + (size_t)m * HDM + hh * HD;
    const int* sl = sel + ((size_t)m * N_KV + g) * N_SEL;
    float mx = NEGF;
    for (int j = 0; j < N_SEL; ++j) { const int b = sl[j]; if (b < 0) continue;
        for (int t = 0; t < L_SEL; ++t) { const int tok = b * L_SEL + t; if (tok > ri.pos) continue;
            const float* k = kv_full_ptr(S, ri.seq, tok, 2, g); float s = 0.f; if (k) for (int d = 0; d < HD; ++d) s += q[d] * k[d];
            s *= 0.125f; if (s > mx) mx = s; } }
    float sum = 0.f, o[HD]; for (int d = 0; d < HD; ++d) o[d] = 0.f;
    for (int j = 0; j < N_SEL; ++j) { const int b = sl[j]; if (b < 0) continue;
        for (int t = 0; t < L_SEL; ++t) { const int tok = b * L_SEL + t; if (tok > ri.pos) continue;
            const float* k = kv_full_ptr(S, ri.seq, tok, 2, g); float s = 0.f; if (k) for (int d = 0; d < HD; ++d) s += q[d] * k[d];
            const float e = expf(s * 0.125f - mx); sum += e;
            const float* v = kv_full_ptr(S, ri.seq, tok, 3, g); if (v) for (int d = 0; d < HD; ++d) o[d] += e * v[d]; } }
    const float inv = 1.0f / fmaxf(sum, TINYF);
    for (int d = 0; d < HD; ++d) os[(size_t)m * HDM + hh * HD + d] = o[d] * inv;
}
__device__ inline const float* win_ptr(const float* cache_win, const float* winrows, int seq, int kp) {
    if (seq < BATCH) return kp >= 0 ? winrows + (size_t)(seq * SEQ + kp) * 2 * N_KV * HD : nullptr;
    const int b = seq - BATCH;
    if (kp >= PAST_LEN) return winrows + (size_t)(MP + b * DEC_SEQ + (kp - PAST_LEN)) * 2 * N_KV * HD;
    const int j = kp - (PAST_LEN - WINDOW);
    return j >= 0 ? cache_win + ((size_t)b * WINDOW + j) * 2 * N_KV * HD : nullptr;
}
__device__ inline void attn_win_item(size_t i_, const float* cache_win, const float* winrows, const float* qr, const float* gates, const float* oc, const float* os, bf16_t* o_out) {
    const int i = (int)i_;
    if (i >= MT * N_HEADS) return;
    const int m = i / N_HEADS, hh = i % N_HEADS, g = hh / HPG;
    const RowInfo ri = row_info(m);
    const float* q = qr + (size_t)m * HDM + hh * HD;
    float mx = NEGF;
    for (int kp = ri.pos - WINDOW; kp <= ri.pos; ++kp) { const float* r = win_ptr(cache_win, winrows, ri.seq, kp); if (!r) continue;
        const float* k = r + (0 * N_KV + g) * HD; float s = 0.f; for (int d = 0; d < HD; ++d) s += q[d] * k[d]; s *= 0.125f; if (s > mx) mx = s; }
    float sum = 0.f, o[HD]; for (int d = 0; d < HD; ++d) o[d] = 0.f;
    for (int kp = ri.pos - WINDOW; kp <= ri.pos; ++kp) { const float* r = win_ptr(cache_win, winrows, ri.seq, kp); if (!r) continue;
        const float* k = r + (0 * N_KV + g) * HD; float s = 0.f; for (int d = 0; d < HD; ++d) s += q[d] * k[d];
        const float e = expf(s * 0.125f - mx); sum += e; const float* v = r + (1 * N_KV + g) * HD; for (int d = 0; d < HD; ++d) o[d] += e * v[d]; }
    const float inv = 1.0f / fmaxf(sum, TINYF);
    const float* gt = gates + (size_t)m * 3 * N_HEADS + hh * 3;
    for (int d = 0; d < HD; ++d) { const size_t x = (size_t)m * HDM + hh * HD + d; o_out[x] = f2bf(gt[0] * oc[x] + gt[1] * os[x] + gt[2] * o[d] * inv); }
}


#ifndef CPU_TEST
__device__ __forceinline__ unsigned lane_id_v() { unsigned l; asm volatile("v_mbcnt_lo_u32_b32 %0, -1, 0\n\tv_mbcnt_hi_u32_b32 %0, -1, %0" : "=v"(l)); return l; }
#endif
constexpr int NTHREADS = 512;
__host__ __device__ inline bf16_t f2bf_(float f) { unsigned u; memcpy(&u, &f, 4); u = (u + 0x7fffu + ((u >> 16) & 1u)) >> 16; return (bf16_t)u; }
__host__ __device__ inline float bf2f_(bf16_t b) { unsigned u = (unsigned)b << 16; float f; memcpy(&f, &u, 4); return f; }
constexpr int NRSS = 3 * DEPTH + 1;
constexpr int NPOS = SEQ + DEC_SEQ;
constexpr int QGP = ((QGW + 255) / 256) * 256;
__host__ __device__ inline int pos_index(int pos) { return pos < SEQ ? pos : SEQ + (pos - PAST_LEN); }

constexpr size_t IMG_SEQ_BYTES = (size_t)BATCH * N_KV * (SEQ / 64) * 8192, IMG_CMP_BYTES = (size_t)BATCH * N_KV * (NBC_P / 64 > 0 ? NBC_P / 64 : 1) * 8192;
struct WsMap {
    size_t ctl, rss, rope, h, hb, act, xn, t2, actf, ub, bb, zb, t1, qn, qr, gates, ob, winrows, hid, kc, vc, pbuf, oc, os, sel, scorebuf,
           w_ain, w_aout, w_bin, w_bout, w_cin, w_cout, w_qg, w_o, w_kv, qnb, qrb, ksel, vsel, kwin, vwin, kci, vci, acs, hids, acp, hidp, w1t, w2t, part, end;
};
constexpr size_t al256(size_t b) { return (b + 255) / 256 * 256; }
constexpr size_t smax(size_t a, size_t b) { return a > b ? a : b; }
constexpr WsMap make_ws_map() {
    WsMap w{}; size_t off = 0;
#define TAKE(f, bytes) w.f = off; off += al256(bytes)
    TAKE(ctl, 65536); TAKE(rss, (size_t)NRSS * MT * 4);
    TAKE(rope, (size_t)NPOS * 16 * 4);
    TAKE(h, (size_t)MT * D_MODEL * 4); TAKE(hb, (size_t)MT * D_MODEL * 2); TAKE(act, (size_t)MT * D_FF * 2);
    TAKE(xn, (size_t)MT * D_MODEL * 4); TAKE(t2, (size_t)MT * D_MODEL * 4); TAKE(actf, (size_t)MT * D_MODEL * 4);
    TAKE(ub, (size_t)MT * D_MODEL * 2); TAKE(bb, (size_t)MT * D_MODEL * 2); TAKE(zb, (size_t)MT * D_MODEL * 2);
    TAKE(t1, smax((size_t)MT * 3 * D_MODEL * 4, (size_t)MT * KVW * 4));
    TAKE(qn, (size_t)MT * HDM * 4); TAKE(qr, (size_t)MT * HDM * 4); TAKE(gates, (size_t)MT * 3 * N_HEADS * 4); TAKE(ob, (size_t)MT * HDM * 2);
    TAKE(winrows, (size_t)MT * 2 * N_KV * HD * 4); TAKE(hid, (size_t)NSEQ * NBC_MAX * 2 * N_KV * CMP_HID * 4);
    TAKE(kc, (size_t)NSEQ * NBC_MAX * N_KV * HD * 4); TAKE(vc, (size_t)NSEQ * NBC_MAX * N_KV * HD * 4);
    TAKE(pbuf, (size_t)MT * N_HEADS * NBC_MAX * 4); TAKE(oc, (size_t)MT * HDM * 4); TAKE(os, (size_t)MT * HDM * 4);
    TAKE(sel, (size_t)MT * N_KV * N_SEL * 4); TAKE(scorebuf, (size_t)MT * N_KV * NBS_MAX * 4);
    TAKE(w_ain, (size_t)DEPTH * 2 * D_FF * D_MODEL * 2); TAKE(w_aout, (size_t)DEPTH * D_MODEL * D_FF * 2);
    TAKE(w_bin, (size_t)DEPTH * 2 * D_FF * D_MODEL * 2); TAKE(w_bout, (size_t)DEPTH * D_MODEL * D_FF * 2);
    TAKE(w_cin, (size_t)N_A * 3 * D_MODEL * D_MODEL * 2); TAKE(w_cout, (size_t)N_A * D_MODEL * D_MODEL * 2);
    TAKE(w_qg, (size_t)N_B * QGP * D_MODEL * 2); TAKE(w_o, (size_t)N_B * D_MODEL * HDM * 2); TAKE(w_kv, (size_t)KVW * D_MODEL * 2);
    TAKE(qnb, (size_t)MT * HDM * 2); TAKE(qrb, (size_t)MT * HDM * 2); TAKE(ksel, IMG_SEQ_BYTES); TAKE(vsel, IMG_SEQ_BYTES); TAKE(kwin, IMG_SEQ_BYTES); TAKE(vwin, IMG_SEQ_BYTES); TAKE(kci, IMG_CMP_BYTES); TAKE(vci, IMG_CMP_BYTES);
    TAKE(acs, (size_t)2 * DEC_BATCH * (PAST_LEN / L_CMP) * N_KV * L_CMP * HD * 2); TAKE(hids, (size_t)2 * DEC_BATCH * (PAST_LEN / L_CMP) * N_KV * CMP_HID * 2);
    TAKE(acp, (size_t)2 * BATCH * NBC_P * N_KV * L_CMP * HD * 2); TAKE(hidp, (size_t)2 * BATCH * NBC_P * N_KV * CMP_HID * 2); TAKE(w1t, (size_t)2 * CMP_HID * L_CMP * HD * 2); TAKE(w2t, (size_t)2 * HD * CMP_HID * 2); TAKE(part, (size_t)8 * MS * 3 * D_MODEL * 4);
#undef TAKE
    w.end = off; return w;
}
constexpr WsMap WSM = make_ws_map();
constexpr size_t WS_ZERO_BYTES = 65536 + (((size_t)NRSS * MT * 4 + 255) / 256 * 256);

enum { CM_PLAIN = 0, CM_PAIR = 1, CM_CONV = 2, CM_HEADS = 3 };
__host__ __device__ inline int colmap(int kind, int n, int aux) {
    const int pn = n / 256, c = n % 256;
    if (kind == CM_PLAIN) return n;
    if (kind == CM_PAIR) return (c >= 128 ? aux : 0) + pn * 128 + (c % 128);
    if (kind == CM_CONV) { if (n < 2 * D_MODEL) return (c >= 128 ? 2 * D_MODEL : D_MODEL) + pn * 128 + (c % 128); return n - 2 * D_MODEL; }
    if (n < aux * 64) { const int bj = c / 128, wc = (c % 128) / 32, r = c % 32; return (pn * 4 + wc) * 64 + 32 * bj + r; }
    return n;
}
__device__ inline void wconv_item(size_t i_, const float* src, int Nsrc, const float* gain, bf16_t* dst, int Nd, int K, int kind, int aux) {
    const int n = (int)(i_ % Nd), kb = (int)(i_ / Nd);
    const int col = colmap(kind, n, aux);
    bf16_t* d = dst + (size_t)n * K + (size_t)kb * 64;
    if (col < 0 || col >= Nsrc) { for (int k = 0; k < 64; ++k) d[k] = 0; return; }
    const float* s = src + (size_t)kb * 64 * Nsrc + col;
#pragma unroll 8
    for (int k = 0; k < 64; k += 2) {
        const float g0 = gain ? gain[kb * 64 + k] : 1.f, g1 = gain ? gain[kb * 64 + k + 1] : 1.f;
        const unsigned lo = f2bf(s[(size_t)k * Nsrc] * g0), hi = f2bf(s[(size_t)(k + 1) * Nsrc] * g1);
        *(unsigned*)(d + k) = lo | (hi << 16);
    }
}
__device__ inline void rope_item(size_t i_, float* rope) {
    const int pi = (int)(i_ / 8), f = (int)(i_ % 8);
    const int pos = pi < SEQ ? pi : PAST_LEN + (pi - SEQ);
    float c, s; rope_cs((float)pos * INV_FREQ[f], c, s);
    rope[pi * 16 + f] = c; rope[pi * 16 + 8 + f] = s;
}
__device__ inline void hinit_item(size_t i_, const float* xp, const float* xs, float* h, bf16_t* hb, float* rss0) {
    const int m = (int)i_; const float* x = m < MP ? xp + (size_t)m * D_MODEL : xs + (size_t)(m - MP) * D_MODEL;
    float s = 0.f;
    for (int k = 0; k < D_MODEL; ++k) { const float v = x[k]; s += v * v; h[(size_t)m * D_MODEL + k] = v; hb[(size_t)m * D_MODEL + k] = f2bf(v); }
    rss0[m] = s;
}
__device__ inline void hupd_item(size_t i_, float* h, const float* y, float coef, bf16_t* hb, float* rss) {
    const int m = (int)i_; float s = 0.f;
    for (int k = 0; k < D_MODEL; ++k) { const float v = h[(size_t)m * D_MODEL + k] + coef * y[(size_t)m * D_MODEL + k]; s += v * v; h[(size_t)m * D_MODEL + k] = v; hb[(size_t)m * D_MODEL + k] = f2bf(v); }
    rss[m] = s;
}
__device__ inline float dot_bf(const bf16_t* a, const bf16_t* b, int K) { float s = 0.f; for (int k = 0; k < K; ++k) s += bf2f(a[k]) * bf2f(b[k]); return s; }
__device__ inline float silu_f(float g) { return g / (1.0f + expf(-g)); }
__device__ inline void ref_ffn_in_item(size_t i_, const bf16_t* hb, const float* rss, const bf16_t* Bt, bf16_t* act) {
    const int m = (int)(i_ / D_FF), j = (int)(i_ % D_FF);
    const float rs = 1.0f / sqrtf(rss[m] / D_MODEL + EPS);
    const int ng = (j / 128) * 256 + (j % 128);
    const float g = rs * dot_bf(hb + (size_t)m * D_MODEL, Bt + (size_t)ng * D_MODEL, D_MODEL), u = rs * dot_bf(hb + (size_t)m * D_MODEL, Bt + (size_t)(ng + 128) * D_MODEL, D_MODEL);
    act[i_] = f2bf(silu_f(g) * u);
}
__device__ inline void ref_resid_row_item(size_t i_, const bf16_t* A, int K, const bf16_t* Bt, float coef, float* h, bf16_t* hb, float* rss_next, float* yout) {
    const int m = (int)i_; float s = 0.f;
    for (int c = 0; c < D_MODEL; ++c) {
        const float v = h[(size_t)m * D_MODEL + c] + coef * dot_bf(A + (size_t)m * K, Bt + (size_t)c * K, K);
        if (yout) { yout[(size_t)m * D_MODEL + c] = v; } else { h[(size_t)m * D_MODEL + c] = v; hb[(size_t)m * D_MODEL + c] = f2bf(v); s += v * v; }
    }
    if (!yout) rss_next[m] = s;
}

constexpr float QSCALE_F = 0.125f * 1.4426950408889634f;
__device__ inline void qconv_item(size_t i_, const float* qn, const float* qr, bf16_t* qnb, bf16_t* qrb) { qnb[i_] = f2bf(qn[i_] * QSCALE_F); qrb[i_] = f2bf(qr[i_] * QSCALE_F); }
__host__ __device__ inline size_t kimg_off(int kv, int d0) { return (size_t)(d0 >> 3) * 1024 + (size_t)kv * 16; }
__host__ __device__ inline size_t vimg_off(int kv, int d0) { return (size_t)(d0 >> 5) * 4096 + (size_t)(kv >> 3) * 512 + (size_t)(kv & 7) * 64 + (size_t)((d0 & 31) >> 3) * 16; }
__device__ inline void put_chunk(unsigned char* dst, const float* src) { bf16_t* d = (bf16_t*)dst; for (int k = 0; k < 8; ++k) d[k] = f2bf(src[k]); }
__device__ inline void kvimg_item(size_t i_, const float* out, const float* winrows, unsigned char* ksel, unsigned char* vsel, unsigned char* kwin, unsigned char* vwin) {
    const int c = (int)(i_ % 8), t = (int)((i_ / 8) % SEQ), g = (int)((i_ / (8 * (size_t)SEQ)) % N_KV), n = (int)(i_ / (8 * (size_t)SEQ * N_KV));
    const size_t base = (((size_t)n * N_KV + g) * (SEQ / 64) + t / 64) * 8192; const int kv = t % 64, d0 = 8 * c; const size_t m = (size_t)n * SEQ + t;
    put_chunk(ksel + base + kimg_off(kv, d0), out + O_KVP + ((m * 4 + 2) * N_KV + g) * HD + d0);
    put_chunk(vsel + base + vimg_off(kv, d0), out + O_KVP + ((m * 4 + 3) * N_KV + g) * HD + d0);
    put_chunk(kwin + base + kimg_off(kv, d0), winrows + ((m * 2 + 0) * N_KV + g) * HD + d0);
    put_chunk(vwin + base + vimg_off(kv, d0), winrows + ((m * 2 + 1) * N_KV + g) * HD + d0);
}
__device__ inline void kcimg_item(size_t i_, const float* kc, const float* vc, unsigned char* kci, unsigned char* vci) {
    const int c = (int)(i_ % 8), cb = (int)((i_ / 8) % NBC_P), g = (int)((i_ / (8 * (size_t)NBC_P)) % N_KV), n = (int)(i_ / (8 * (size_t)NBC_P * N_KV));
    const size_t base = (((size_t)n * N_KV + g) * (NBC_P / 64) + cb / 64) * 8192; const int kv = cb % 64, d0 = 8 * c;
    put_chunk(kci + base + kimg_off(kv, d0), kc + (((size_t)n * NBC_MAX + cb) * N_KV + g) * HD + d0);
    put_chunk(vci + base + vimg_off(kv, d0), vc + (((size_t)n * NBC_MAX + cb) * N_KV + g) * HD + d0);
}

constexpr int NBC_PAST = PAST_LEN / L_CMP;
constexpr int RS_CMP = DEC_BATCH * NBC_PAST * N_KV, RP_CMP = BATCH * NBC_P * N_KV;
__device__ inline void acmp_sample_item(size_t i_, const float* cache_kv, const int* page_table, const float* pe, bf16_t* A) {
    const int c8 = (int)(i_ % 8), l = (int)((i_ / 8) % L_CMP); const size_t rr = i_ / (8 * L_CMP); const int r = (int)(rr % RS_CMP), e = (int)(rr / RS_CMP);
    const int g = r % N_KV, c = (r / N_KV) % NBC_PAST, b = r / (N_KV * NBC_PAST), tok = c * L_CMP + l;
    const int page = page_table[b * N_PAGES + tok / PAGE_SIZE];
    const float* src = cache_kv + ((((size_t)page * PAGE_SIZE + tok % PAGE_SIZE) * 4 + e) * N_KV + g) * HD + 8 * c8; const float* pp = pe + ((size_t)e * L_CMP + l) * HD + 8 * c8;
    bf16_t* d = A + ((size_t)e * RS_CMP + r) * (L_CMP * HD) + l * HD + 8 * c8;
#ifndef CPU_TEST
    typedef float f4 __attribute__((ext_vector_type(4))); typedef unsigned u4 __attribute__((ext_vector_type(4)));
    const f4 a0 = __builtin_nontemporal_load((const f4*)src) + *(const f4*)pp, a1 = __builtin_nontemporal_load((const f4*)(src + 4)) + *(const f4*)(pp + 4);
    u4 w; w.x = (unsigned)f2bf(a0[0]) | ((unsigned)f2bf(a0[1]) << 16); w.y = (unsigned)f2bf(a0[2]) | ((unsigned)f2bf(a0[3]) << 16);
    w.z = (unsigned)f2bf(a1[0]) | ((unsigned)f2bf(a1[1]) << 16); w.w = (unsigned)f2bf(a1[2]) | ((unsigned)f2bf(a1[3]) << 16);
    *(u4*)d = w;
#else
    for (int k = 0; k < 8; ++k) d[k] = f2bf(src[k] + pp[k]);
#endif
}
__device__ inline void acmp_prompt_item(size_t i_, const float* out, const float* pe, bf16_t* A) {
    const int c8 = (int)(i_ % 8), l = (int)((i_ / 8) % L_CMP); const size_t rr = i_ / (8 * L_CMP); const int r = (int)(rr % RP_CMP), e = (int)(rr / RP_CMP);
    const int g = r % N_KV, c = (r / N_KV) % NBC_P, n = r / (N_KV * NBC_P), tok = c * L_CMP + l;
    const float* src = out + O_KVP + ((((size_t)n * SEQ + tok) * 4 + e) * N_KV + g) * HD + 8 * c8; const float* pp = pe + ((size_t)e * L_CMP + l) * HD + 8 * c8;
    bf16_t* d = A + ((size_t)e * RP_CMP + r) * (L_CMP * HD) + l * HD + 8 * c8;
    for (int k = 0; k < 8; ++k) d[k] = f2bf(src[k] + pp[k]);
}
__device__ inline void cmp_out_b_item(size_t i_, const bf16_t* hid, int R, int nbc, int seq0, const float* w2, const float* k_norm0, float* kc, float* vc) {
    const int r = (int)(i_ % R), e = (int)(i_ / R); const int g = r % N_KV, c = (r / N_KV) % nbc, sq = r / (N_KV * nbc);
    const bf16_t* hr = hid + ((size_t)e * R + r) * CMP_HID;
    float v[HD];
    for (int d = 0; d < HD; ++d) v[d] = 0.f;
    for (int f = 0; f < CMP_HID; ++f) { const float hf = bf2f(hr[f]); const float* w = w2 + ((size_t)e * CMP_HID + f) * HD; for (int d = 0; d < HD; ++d) v[d] += hf * w[d]; }
    if (e == 0) head_norm(v, k_norm0);
    float* o = (e == 0 ? kc : vc) + (((size_t)(seq0 + sq) * NBC_MAX + c) * N_KV + g) * HD;
    for (int d = 0; d < HD; ++d) o[d] = v[d];
}
__host__ __device__ inline int heads_row(int hidx, int d) { return (hidx / 4) * 256 + 128 * (d / 32) + 32 * (hidx % 4) + (d % 32); }
__device__ inline void conv_state_store(float* out, int layer, int m, int ch, float u) {
    const RowInfo ri = row_info(m); const int L = seq_len(ri.seq);
    if (ri.t >= L - 2) { const int j = ri.t - (L - 2);
        if (ri.seq < BATCH) out[O_CP + (((size_t)layer * BATCH + ri.seq) * 2 + j) * D_MODEL + ch] = u;
        else out[O_CS + (((size_t)layer * DEC_BATCH + (ri.seq - BATCH)) * 2 + j) * D_MODEL + ch] = u; }
}
__device__ inline void ref_conv_in_item(size_t i_, const bf16_t* hb, const float* rss, const bf16_t* Bt, bf16_t* ub, bf16_t* bb, float* out, int layer) {
    const int m = (int)(i_ / D_MODEL), j = (int)(i_ % D_MODEL);
    const float rs = 1.0f / sqrtf(rss[m] / D_MODEL + EPS); const bf16_t* a = hb + (size_t)m * D_MODEL;
    const int nc = (j / 128) * 256 + (j % 128);
    const float c = rs * dot_bf(a, Bt + (size_t)nc * D_MODEL, D_MODEL), x = rs * dot_bf(a, Bt + (size_t)(nc + 128) * D_MODEL, D_MODEL), b = rs * dot_bf(a, Bt + (size_t)(2 * D_MODEL + j) * D_MODEL, D_MODEL);
    const float u = c * x; ub[i_] = f2bf(u); bb[i_] = f2bf(b); conv_state_store(out, layer, m, j, u);
}
__device__ inline void conv_thin_item(size_t i_, const bf16_t* ub, const bf16_t* bb, const float* state  , const float* wc  , bf16_t* zb) {
    const int m = (int)(i_ / D_MODEL), ch = (int)(i_ % D_MODEL);
    const RowInfo ri = row_info(m);
    const float u0 = bf2f(ub[i_]);
    float u1, u2;
    if (ri.t >= 1) u1 = bf2f(ub[i_ - D_MODEL]); else u1 = (ri.seq < BATCH) ? 0.f : state[((size_t)(ri.seq - BATCH) * 2 + 1) * D_MODEL + ch];
    if (ri.t >= 2) u2 = bf2f(ub[i_ - 2 * D_MODEL]); else if (ri.seq < BATCH) u2 = 0.f;
    else u2 = (ri.t == 1) ? state[((size_t)(ri.seq - BATCH) * 2 + 1) * D_MODEL + ch] : state[((size_t)(ri.seq - BATCH) * 2 + 0) * D_MODEL + ch];
    zb[i_] = f2bf(bf2f(bb[i_]) * (wc[ch] * u2 + wc[D_MODEL + ch] * u1 + wc[2 * D_MODEL + ch] * u0));
}
__device__ inline void ref_qg_item(size_t i_, const bf16_t* hb, const float* rss, const bf16_t* Bt, const float* q_norm, const float* rope, float* qn, float* qr) {
    const int m = (int)(i_ / N_HEADS), hh = (int)(i_ % N_HEADS);
    const float rs = 1.0f / sqrtf(rss[m] / D_MODEL + EPS); const bf16_t* a = hb + (size_t)m * D_MODEL;
    float v[HD]; for (int d = 0; d < HD; ++d) v[d] = rs * dot_bf(a, Bt + (size_t)heads_row(hh, d) * D_MODEL, D_MODEL);
    head_norm(v, q_norm);
    for (int d = 0; d < HD; ++d) qn[(size_t)m * HDM + hh * HD + d] = v[d];
    const float* rt = rope + (size_t)pos_index(row_info(m).pos) * 16;
    for (int f = 0; f < 8; ++f) { const float x1 = v[f], x2 = v[8 + f]; v[f] = x1 * rt[f] - x2 * rt[8 + f]; v[8 + f] = x2 * rt[f] + x1 * rt[8 + f]; }
    for (int d = 0; d < HD; ++d) qr[(size_t)m * HDM + hh * HD + d] = v[d];
}
__device__ inline void ref_gates_item(size_t i_, const bf16_t* hb, const float* rss, const bf16_t* Bt, float* gates) {
    const int m = (int)(i_ / (3 * N_HEADS)), j = (int)(i_ % (3 * N_HEADS));
    const float rs = 1.0f / sqrtf(rss[m] / D_MODEL + EPS);
    const float x = rs * dot_bf(hb + (size_t)m * D_MODEL, Bt + (size_t)(HDM + j) * D_MODEL, D_MODEL);
    gates[i_] = 1.0f / (1.0f + expf(-x));
}
__device__ inline void kv_store(float* out, float* winrows, int m, int e, int g, int d, float v) {
    const RowInfo ri = row_info(m);
    if (e < 4) { if (ri.seq < BATCH) out[O_KVP + (((size_t)m * 4 + e) * N_KV + g) * HD + d] = v; else out[O_KVS + (((size_t)(m - MP) * 4 + e) * N_KV + g) * HD + d] = v; }
    else { const int we = e - 4;
        winrows[(((size_t)m * 2 + we) * N_KV + g) * HD + d] = v;
        if (ri.seq < BATCH) { if (ri.t >= SEQ - WINDOW) out[O_WP + ((((size_t)ri.seq * WINDOW + (ri.t - (SEQ - WINDOW))) * 2 + we) * N_KV + g) * HD + d] = v; }
        else out[O_WS + ((((size_t)(ri.seq - BATCH) * WINDOW + (WINDOW - DEC_SEQ + ri.t)) * 2 + we) * N_KV + g) * HD + d] = v; }
}
__device__ inline void ref_kv_item(size_t i_, const bf16_t* hb, const float* rss, const bf16_t* Bt, const float* k_norm, const float* rope, float* out, float* winrows) {
    const int m = (int)(i_ / (6 * N_KV)), hidx = (int)(i_ % (6 * N_KV)), e = hidx / N_KV, g = hidx % N_KV;
    const float rs = 1.0f / sqrtf(rss[m] / D_MODEL + EPS); const bf16_t* a = hb + (size_t)m * D_MODEL;
    float v[HD]; for (int d = 0; d < HD; ++d) v[d] = rs * dot_bf(a, Bt + (size_t)heads_row(hidx, d) * D_MODEL, D_MODEL);
    if (e == 2 || e == 4) { head_norm(v, k_norm + (e == 2 ? 1 : 2) * HD);
        const float* rt = rope + (size_t)pos_index(row_info(m).pos) * 16;
        for (int f = 0; f < 8; ++f) { const float x1 = v[f], x2 = v[8 + f]; v[f] = x1 * rt[f] - x2 * rt[8 + f]; v[8 + f] = x2 * rt[f] + x1 * rt[8 + f]; } }
    for (int d = 0; d < HD; ++d) kv_store(out, winrows, m, e, g, d, v[d]);
}
#ifndef CPU_TEST
#define LAS __attribute__((address_space(3)))
#define XB_TMO      128
#define XB_XCNT(j)  (256  + 64 * (j))
#define XB_XSUB(j)  (1280 + 64 * (j))
#define XB_XGEN(j)  (2304 + 64 * (j))
#define XB_TOP      3328
#define XB_TOPGEN   3392
#define XCD_BAR_WORDS 3456
#define XB_SPIN_CAP (1u << 25)
typedef __attribute__((address_space(1))) unsigned GU;
__device__ __forceinline__ unsigned xb_ld(GU* p)              { return __hip_atomic_load(p, __ATOMIC_RELAXED, __HIP_MEMORY_SCOPE_AGENT); }
__device__ __forceinline__ unsigned xb_add(GU* p, unsigned v) { return __hip_atomic_fetch_add(p, v, __ATOMIC_RELAXED, __HIP_MEMORY_SCOPE_AGENT); }
__device__ __forceinline__ unsigned xb_xcc_id() { return (unsigned)__builtin_amdgcn_s_getreg((3 << 11) | 20) & 0xFu; }
#define XB_SPIN(cond, bar) do { unsigned _sp = 0; while (cond) { __builtin_amdgcn_s_sleep(1); \
    if ((++_sp & 255u) == 0u) { if (xb_ld(&(bar)[XB_TMO])) break; if (_sp > XB_SPIN_CAP) { (void)xb_add(&(bar)[XB_TMO], 1u); break; } } } } while (0)
struct XcdBarrier { GU* bar; unsigned x; volatile LAS unsigned* st; };
__device__ __forceinline__ XcdBarrier xcd_barrier_post(GU* bar, volatile LAS unsigned* st, const bool leader_thread) {
    XcdBarrier b; b.bar = bar; b.x = xb_xcc_id(); b.st = st;
    if (leader_thread) (void)xb_add(&bar[XB_XCNT(b.x)], 1u);
    return b;
}
__device__ __forceinline__ void xcd_barrier_complete(GU* bar, unsigned x, unsigned& nloc, unsigned& nx) {
    const unsigned G = gridDim.x * gridDim.y * gridDim.z;
    unsigned sum, cnt, mine, sp = 0u;
    for (;;) {
        sum = 0u; cnt = 0u; mine = 0u;
#pragma unroll
        for (unsigned j = 0; j < 16; ++j) { const unsigned c = xb_ld(&bar[XB_XCNT(j)]); sum += c; cnt += (c > 0u) ? 1u : 0u; mine = (j == x) ? c : mine; }
        if (sum == G) break;
        __builtin_amdgcn_s_sleep(1);
        if ((++sp & 255u) == 0u) { if (xb_ld(&bar[XB_TMO])) break; if (sp > XB_SPIN_CAP) { (void)xb_add(&bar[XB_TMO], 1u); break; } }
    }
    nloc = mine > 0u ? mine : 1u; nx = cnt > 0u ? cnt : 1u;
}
__device__ __forceinline__ void xcd_barrier(const XcdBarrier& b, const bool leader_thread) {
    asm volatile("s_waitcnt vmcnt(0)" ::: "memory");
    __syncthreads();
    if (leader_thread) {
        GU* bar = b.bar; unsigned bx = xb_xcc_id(); asm volatile("" : "+s"(bx));
        __builtin_amdgcn_s_waitcnt(0);
        unsigned nloc = b.st[0], nx = b.st[1];
        if (nloc == 0u) { xcd_barrier_complete(bar, bx, nloc, nx); b.st[0] = nloc; b.st[1] = nx; }
        const unsigned old = xb_add(&bar[XB_XSUB(bx)], 1u);
        const unsigned gen = old / nloc;
        if (old + 1u == (gen + 1u) * nloc) {
            __builtin_amdgcn_fence(__ATOMIC_RELEASE, "agent");
            asm volatile("s_waitcnt vmcnt(0)" ::: "memory");
            const unsigned og = xb_add(&bar[XB_TOP], 1u);
            const unsigned tg = og / nx;
            if (og + 1u == (tg + 1u) * nx) xb_add(&bar[XB_TOPGEN], 1u);
            else XB_SPIN(xb_ld(&bar[XB_TOPGEN]) == tg, bar);
            __builtin_amdgcn_fence(__ATOMIC_ACQUIRE, "agent");
            xb_add(&bar[XB_XGEN(bx)], 1u);
            asm volatile("s_waitcnt vmcnt(0)" ::: "memory");
        } else {
            XB_SPIN(xb_ld(&bar[XB_XGEN(bx)]) == gen, bar);
            __builtin_amdgcn_fence(__ATOMIC_ACQUIRE, "agent");
            asm volatile("s_waitcnt vmcnt(0)" ::: "memory");
        }
    }
    __syncthreads();
}

namespace pg8 {
#define PG8_LAS __attribute__((address_space(3)))
typedef unsigned short bf16_t;
typedef short bf16x8 __attribute__((ext_vector_type(8)));
typedef float f32x4 __attribute__((ext_vector_type(4)));
typedef unsigned u32x4 __attribute__((ext_vector_type(4)));
constexpr int BM = 256, BK = 64, HALF = 128, HTB = HALF * BK * 2  , STAGE_BYTES = 8 * HTB, NXCD = 8, WGM = 8;

__host__ __device__ __forceinline__ int lds_byte(int r, int c) { const int st = (r >> 4) * 2 + (c >> 5), rr = r & 15, cc = c & 31, ob = rr * 64 + cc * 2; return st * 1024 + (ob ^ (((ob >> 9) & 1) << 5)); }
__host__ __device__ __forceinline__ void stage_rc(int b, int& R, int& C) { const int st = b / 1024, sb = b % 1024, swz = sb ^ (((sb >> 9) & 1) << 5); R = (st >> 1) * 16 + swz / 64; C = (st & 1) * 32 + (swz % 64) / 2; }
__host__ __device__ __forceinline__ int perm32(int rho) { const int n = rho >> 4, i = rho & 15; return 8 * (i >> 2) + 4 * n + (i & 3); }

struct Unit { int pm, pn; };
struct Gemm { const bf16_t* A; const bf16_t* Bt; int M, N, K; };

struct StaticOrder {
    int nM, nN, nwg, G, c;
    __host__ __device__ void init(int M, int N, int G_, int c_) { nM = M / BM; nN = N / BM; nwg = nM * nN; G = G_; c = c_; }
    __host__ __device__ bool next(int i, Unit& u) const {
        const long L = (long)i * G + c; if (L >= nwg) return false;
        int wgid = (int)L; { const int q = nwg / NXCD, r = nwg % NXCD, xcd = wgid % NXCD, off = wgid / NXCD; wgid = (xcd < r ? xcd * (q + 1) : r * (q + 1) + (xcd - r) * q) + off; }
        const int nig = WGM * nN, gid = wgid / nig, fm = gid * WGM, gsz = (nM - fm) < WGM ? (nM - fm) : WGM;
        u.pm = fm + ((wgid % nig) % gsz); u.pn = (wgid % nig) / gsz; return true;
    }
    __device__ __forceinline__ void a_ready(const Unit&) const {}
    __device__ __forceinline__ void done(const Unit&) const {}
};

__device__ __forceinline__ unsigned cvt_pk_bf16(float lo, float hi) { unsigned r; asm volatile("v_cvt_pk_bf16_f32 %0, %1, %2" : "=v"(r) : "v"(lo), "v"(hi)); return r; }
template <class Epi, class Sched, bool ALIGN_EPI = false, bool SP2 = false>
__device__ __forceinline__ void gemm_phase(int wave_id_, PG8_LAS unsigned char* lds, const Gemm g, const Sched& S, const Epi& E) {
    int wid = wave_id_, lane = (int)lane_id_v(); asm volatile("" : "+s"(wid));
    const int tid = wid * 64 + lane, wr = wid >> 2, wc = wid & 3, fr = lane & 15, fq = lane >> 4;
    const int K = g.K, nt = K / BK;
    unsigned voffA[2], voffB[2];
#pragma unroll
    for (int i = 0; i < 2; ++i) { int R, C; stage_rc(tid * 16 + i * 8192, R, C); const int Rb = Epi::PERM ? ((R & ~31) + perm32(R & 31)) : R;
        voffA[i] = (unsigned)(R * K + C) * 2u; voffB[i] = (unsigned)(Rb * K + C) * 2u; }
    const size_t kstep = (size_t)(BK * 2);
    const size_t hstep = (size_t)HALF * K * 2;
    const size_t tstep = 2 * hstep;
    const unsigned ldsw = (unsigned)wid * 1024u;
    const int aoff = lds_byte(wr * 64 + fr, fq * 8), boff = lds_byte(wc * 32 + fr, fq * 8);
#define PG8_SA(b, h) (((b) * 2 + (h)) * HTB)
#define PG8_SB(b, h) ((4 + (b) * 2 + (h)) * HTB)
#define PG8_STAGE(bufoff, gbase, voff) do { _Pragma("unroll") for (int _i = 0; _i < 2; ++_i) \
        __builtin_amdgcn_global_load_lds((const unsigned*)((const char*)(gbase) + (voff)[_i]), (PG8_LAS unsigned*)(lds + (bufoff) + ldsw + _i * 8192), 16, 0, 0); } while (0)
#define PG8_LDA(dst, b, h) do { _Pragma("unroll") for (int m = 0; m < 4; ++m) _Pragma("unroll") for (int k = 0; k < 2; ++k) dst[m][k] = *(const PG8_LAS bf16x8*)(lds + PG8_SA(b, h) + aoff + m * 2048 + k * 1024); } while (0)
#define PG8_LDB(dst, b, h) do { _Pragma("unroll") for (int n = 0; n < 2; ++n) _Pragma("unroll") for (int k = 0; k < 2; ++k) dst[n][k] = *(const PG8_LAS bf16x8*)(lds + PG8_SB(b, h) + boff + n * 2048 + k * 1024); } while (0)
#define PG8_MMA(ai, bj, At, Bt) do { __builtin_amdgcn_s_setprio(1); _Pragma("unroll") for (int m = 0; m < 4; ++m) _Pragma("unroll") for (int n = 0; n < 2; ++n) _Pragma("unroll") for (int k = 0; k < 2; ++k) \
        acc[ai][bj][m][n] = __builtin_amdgcn_mfma_f32_16x16x32_bf16(Bt[n][k], At[m][k], acc[ai][bj][m][n], 0, 0, 0); __builtin_amdgcn_s_setprio(0); } while (0)
#define PG8_WAIT_V(n) asm volatile("s_waitcnt vmcnt(" #n ")" ::: "memory")
#define PG8_WAIT_L(n) asm volatile("s_waitcnt lgkmcnt(" #n ")" ::: "memory")
#define PG8_BAR __builtin_amdgcn_s_barrier()
#define PG8_SCHED __builtin_amdgcn_sched_barrier(0)
    Unit cur, nxt; int ui = 0; float rsv[8];
#pragma unroll
    for (int i_ = 0; i_ < 8; ++i_) rsv[i_] = 0.f;
    if (!S.next(0, cur)) return;
    f32x4 acc[2][2][4][2];
#pragma unroll
    for (int a = 0; a < 2; ++a)
#pragma unroll
        for (int b = 0; b < 2; ++b)
#pragma unroll
            for (int m = 0; m < 4; ++m)
#pragma unroll
                for (int n = 0; n < 2; ++n) acc[a][b][m][n] = (f32x4){0.f, 0.f, 0.f, 0.f};
    bf16x8 At[4][2], B0[2][2], B1[2][2];
    const char* cA = (const char*)g.A + (size_t)cur.pm * tstep; const char* cB = (const char*)g.Bt + (size_t)cur.pn * tstep;
    S.a_ready(cur);
    if constexpr (SP2) {
        PG8_STAGE(PG8_SB(0, 0), cB, voffB); PG8_STAGE(PG8_SB(0, 1), cB + hstep, voffB); PG8_STAGE(PG8_SA(0, 0), cA, voffA); PG8_STAGE(PG8_SA(0, 1), cA + hstep, voffA);
        if (wr == 1) PG8_BAR;
        PG8_WAIT_V(2); PG8_BAR;
        PG8_STAGE(PG8_SB(1, 0), cB + kstep, voffB); PG8_STAGE(PG8_SA(1, 0), cA + kstep, voffA); PG8_STAGE(PG8_SB(1, 1), cB + hstep + kstep, voffB);
        PG8_WAIT_V(6); PG8_BAR;
    } else {
        PG8_STAGE(PG8_SB(0, 0), cB, voffB); PG8_STAGE(PG8_SA(0, 0), cA, voffA); PG8_STAGE(PG8_SB(0, 1), cB + hstep, voffB); PG8_STAGE(PG8_SA(0, 1), cA + hstep, voffA);
        if (wr == 1) PG8_BAR;
        PG8_WAIT_V(4); PG8_BAR;
        PG8_STAGE(PG8_SB(1, 0), cB + kstep, voffB); PG8_STAGE(PG8_SA(1, 0), cA + kstep, voffA); PG8_STAGE(PG8_SB(1, 1), cB + hstep + kstep, voffB);
        PG8_WAIT_V(6); PG8_BAR;
    }
    for (;;) {
        const bool has_next = S.next(ui + 1, nxt);
        const char* nA = has_next ? (const char*)g.A + (size_t)nxt.pm * tstep : cA; const char* nB = has_next ? (const char*)g.Bt + (size_t)nxt.pn * tstep : cB;
        for (int t = 0; t < nt; t += 2) {
            const bool last = (t == nt - 2);
            const char* a1 = cA + (size_t)(t + 1) * kstep;
            const char* a2 = last ? nA : cA + (size_t)(t + 2) * kstep; const char* b2 = last ? nB : cB + (size_t)(t + 2) * kstep;
            const char* a3 = a2 + kstep; const char* b3 = b2 + kstep;
            if (last && has_next) S.a_ready(nxt);
            if (last) E.pre(cur, wr, fr, rsv);
            if constexpr (SP2) {
            PG8_LDB(B0, 0, 0); PG8_LDB(B1, 0, 1); PG8_SCHED; PG8_LDA(At, 0, 0); PG8_STAGE(PG8_SA(1, 1), a1 + hstep, voffA);
            PG8_WAIT_V(8); PG8_WAIT_L(0); PG8_BAR; PG8_MMA(0, 0, At, B0); PG8_MMA(0, 1, At, B1); PG8_BAR; PG8_SCHED;
            PG8_LDA(At, 0, 1); PG8_STAGE(PG8_SB(0, 0), b2, voffB); PG8_STAGE(PG8_SB(0, 1), b2 + hstep, voffB); PG8_STAGE(PG8_SA(0, 0), a2, voffA);
            PG8_WAIT_V(8); PG8_WAIT_L(0); PG8_BAR; PG8_MMA(1, 0, At, B0); PG8_MMA(1, 1, At, B1); PG8_BAR; PG8_SCHED;
            PG8_LDB(B0, 1, 0); PG8_LDB(B1, 1, 1); PG8_SCHED; PG8_LDA(At, 1, 0); PG8_STAGE(PG8_SA(0, 1), a2 + hstep, voffA);
            PG8_WAIT_V(8); PG8_WAIT_L(0); PG8_BAR; PG8_MMA(0, 0, At, B0); PG8_MMA(0, 1, At, B1); PG8_BAR; PG8_SCHED;
            PG8_LDA(At, 1, 1); PG8_STAGE(PG8_SB(1, 0), b3, voffB); PG8_STAGE(PG8_SB(1, 1), b3 + hstep, voffB); PG8_STAGE(PG8_SA(1, 0), a3, voffA);
            PG8_WAIT_V(8); PG8_WAIT_L(0); PG8_BAR; PG8_MMA(1, 0, At, B0); PG8_MMA(1, 1, At, B1); PG8_BAR; PG8_SCHED;
            } else {
            PG8_LDB(B0, 0, 0); PG8_SCHED; PG8_LDA(At, 0, 0); PG8_STAGE(PG8_SA(1, 1), a1 + hstep, voffA);
            PG8_WAIT_L(8); PG8_BAR; PG8_WAIT_L(0); PG8_MMA(0, 0, At, B0); PG8_BAR; PG8_SCHED;
            PG8_LDB(B1, 0, 1); PG8_STAGE(PG8_SB(0, 0), b2, voffB);
            PG8_BAR; PG8_WAIT_L(0); PG8_MMA(0, 1, At, B1); PG8_BAR;
            PG8_LDA(At, 0, 1); PG8_STAGE(PG8_SA(0, 0), a2, voffA);
            PG8_BAR; PG8_WAIT_L(0); PG8_MMA(1, 0, At, B0); PG8_BAR; PG8_SCHED;
            PG8_STAGE(PG8_SB(0, 1), b2 + hstep, voffB);
            PG8_WAIT_V(6); PG8_BAR; PG8_MMA(1, 1, At, B1); PG8_BAR;
            PG8_LDB(B0, 1, 0); PG8_SCHED; PG8_LDA(At, 1, 0); PG8_STAGE(PG8_SA(0, 1), a2 + hstep, voffA);
            PG8_WAIT_L(8); PG8_BAR; PG8_WAIT_L(0); PG8_MMA(0, 0, At, B0); PG8_BAR; PG8_SCHED;
            PG8_LDB(B1, 1, 1); PG8_STAGE(PG8_SB(1, 0), b3, voffB);
            PG8_BAR; PG8_WAIT_L(0); PG8_MMA(0, 1, At, B1); PG8_BAR;
            PG8_LDA(At, 1, 1); PG8_STAGE(PG8_SA(1, 0), a3, voffA);
            PG8_BAR; PG8_WAIT_L(0); PG8_MMA(1, 0, At, B0); PG8_BAR; PG8_SCHED;
            PG8_STAGE(PG8_SB(1, 1), b3 + hstep, voffB);
            PG8_WAIT_V(6); PG8_BAR; PG8_MMA(1, 1, At, B1); PG8_BAR;
            }
        }
        if constexpr (ALIGN_EPI) { if (wr == 0) PG8_BAR; }
        if constexpr (!Epi::AFTER_DRAIN) { E(acc, cur, wr, wc, fr, fq, rsv); S.done(cur); }
        if (!has_next) break;
#pragma unroll
        for (int a = 0; a < 2; ++a)
#pragma unroll
            for (int b = 0; b < 2; ++b)
#pragma unroll
                for (int m = 0; m < 4; ++m)
#pragma unroll
                    for (int n = 0; n < 2; ++n) acc[a][b][m][n] = (f32x4){0.f, 0.f, 0.f, 0.f};
        cur = nxt; cA = nA; cB = nB; ++ui;
        if constexpr (ALIGN_EPI) { if (wr == 1) PG8_BAR; }
    }
    PG8_WAIT_V(0);
    if constexpr (!ALIGN_EPI) { if (wr == 0) PG8_BAR; }
    PG8_BAR;
    if constexpr (Epi::AFTER_DRAIN) { E.fused(acc, cur, wr, wc, fr, fq, lds, wid, lane); S.done(cur); }
#undef PG8_SA
#undef PG8_SB
#undef PG8_STAGE
#undef PG8_LDA
#undef PG8_LDB
#undef PG8_MMA
#undef PG8_WAIT_V
#undef PG8_WAIT_L
#undef PG8_BAR
#undef PG8_SCHED
}
}

namespace pg8 {
__device__ __forceinline__ float fast_silu(float g) { return g * __builtin_amdgcn_rcpf(1.0f + __expf(-g)); }
__device__ __forceinline__ float row_rs(const float* rss, int row) { return rsqrtf(rss[row] * (1.0f / D_MODEL) + EPS); }
struct EpiSwiglu {
    static constexpr bool PERM = true, AFTER_DRAIN = false;
    bf16_t* act; const float* rss;
    __device__ __forceinline__ void pre(const Unit& u, int wr, int fr, float (&rsv)[8]) const {
        const __attribute__((address_space(1))) float* rp = (const __attribute__((address_space(1))) float*)rss + u.pm * BM + wr * 64 + fr;
#pragma unroll
        for (int ai = 0; ai < 2; ++ai)
#pragma unroll
            for (int m = 0; m < 4; ++m) rsv[ai * 4 + m] = rp[ai * HALF + m * 16];
    }
    __device__ __forceinline__ void operator()(const f32x4 (&acc)[2][2][4][2], const Unit& u, int wr, int wc, int fr, int fq, const float (&rsv)[8]) const {
        const int row0 = u.pm * BM + wr * 64 + fr, col0 = u.pn * 128 + wc * 32 + 8 * fq;
#pragma unroll
        for (int ai = 0; ai < 2; ++ai)
#pragma unroll
            for (int m = 0; m < 4; ++m) {
                const int row = row0 + ai * HALF + m * 16; const float rs = rsqrtf(rsv[ai * 4 + m] * (1.0f / D_MODEL) + EPS);
                float a[8];
#pragma unroll
                for (int n = 0; n < 2; ++n)
#pragma unroll
                    for (int i = 0; i < 4; ++i) a[n * 4 + i] = fast_silu(acc[ai][0][m][n][i] * rs) * (acc[ai][1][m][n][i] * rs);
                u32x4 w; w.x = cvt_pk_bf16(a[0], a[1]); w.y = cvt_pk_bf16(a[2], a[3]); w.z = cvt_pk_bf16(a[4], a[5]); w.w = cvt_pk_bf16(a[6], a[7]);
                *(u32x4*)(act + (size_t)row * D_FF + col0) = w;
            }
    }
};
struct EpiResid {
    static constexpr bool PERM = false, AFTER_DRAIN = false;
    float* h; bf16_t* hb; float* rss_next; float* yout; float coef;
    __device__ __forceinline__ void pre(const Unit&, int, int, float (&)[8]) const {}
    __device__ __forceinline__ void operator()(const f32x4 (&acc)[2][2][4][2], const Unit& u, int wr, int wc, int fr, int fq, const float (&rsv)[8]) const {
        const int row0 = u.pm * BM + wr * 64 + fr, col0 = u.pn * BM + wc * 32 + 4 * fq;
#pragma unroll
        for (int ai = 0; ai < 2; ++ai)
#pragma unroll
            for (int m = 0; m < 4; ++m) {
                const int row = row0 + ai * HALF + m * 16; float s = 0.f;
                float* hr = h + (size_t)row * D_MODEL + col0;
#pragma unroll
                for (int bj = 0; bj < 2; ++bj)
#pragma unroll
                    for (int n = 0; n < 2; ++n) {
                        const int co = bj * HALF + n * 16;
                        const f32x4 v = *(const f32x4*)(hr + co) + acc[ai][bj][m][n] * coef;
                        if (yout) { *(f32x4*)(yout + (size_t)row * D_MODEL + col0 + co) = v; }
                        else {
                            *(f32x4*)(hr + co) = v;
                            typedef unsigned u32x2 __attribute__((ext_vector_type(2)));
                            u32x2 w; w.x = cvt_pk_bf16(v[0], v[1]); w.y = cvt_pk_bf16(v[2], v[3]);
                            *(u32x2*)(hb + (size_t)row * D_MODEL + col0 + co) = w;
                            s += (v[0] * v[0] + v[1] * v[1]) + (v[2] * v[2] + v[3] * v[3]);
                        }
                    }
                if (!yout) { s += __shfl_xor(s, 16); s += __shfl_xor(s, 32); if (fq == 0) (void)__hip_atomic_fetch_add(rss_next + row, s, __ATOMIC_RELAXED, __HIP_MEMORY_SCOPE_AGENT); }
            }
    }
};
}
namespace pg8 {
__device__ __forceinline__ float sum4(f32x4 v) { return (v[0] * v[0] + v[1] * v[1]) + (v[2] * v[2] + v[3] * v[3]); }
struct EpiConvIn {
    static constexpr bool PERM = true, AFTER_DRAIN = false;
    bf16_t* ub; bf16_t* bb; const float* rss; float* out; int layer;
    __device__ __forceinline__ void pre(const Unit& u, int wr, int fr, float (&rsv)[8]) const {
        const __attribute__((address_space(1))) float* rp = (const __attribute__((address_space(1))) float*)rss + u.pm * BM + wr * 64 + fr;
#pragma unroll
        for (int ai = 0; ai < 2; ++ai)
#pragma unroll
            for (int m = 0; m < 4; ++m) rsv[ai * 4 + m] = rp[ai * HALF + m * 16];
    }
    __device__ __forceinline__ void operator()(const f32x4 (&acc)[2][2][4][2], const Unit& u, int wr, int wc, int fr, int fq, const float (&rsv)[8]) const {
        const int row0 = u.pm * BM + wr * 64 + fr;
        const bool pair = u.pn < D_MODEL / 128;
#pragma unroll
        for (int ai = 0; ai < 2; ++ai)
#pragma unroll
            for (int m = 0; m < 4; ++m) {
                const int row = row0 + ai * HALF + m * 16; const float rs = rsqrtf(rsv[ai * 4 + m] * (1.0f / D_MODEL) + EPS);
                if (pair) {
                    const int col0 = u.pn * 128 + wc * 32 + 8 * fq; float a[8];
#pragma unroll
                    for (int n = 0; n < 2; ++n)
#pragma unroll
                        for (int i = 0; i < 4; ++i) a[n * 4 + i] = (acc[ai][0][m][n][i] * rs) * (acc[ai][1][m][n][i] * rs);
                    u32x4 w; w.x = cvt_pk_bf16(a[0], a[1]); w.y = cvt_pk_bf16(a[2], a[3]); w.z = cvt_pk_bf16(a[4], a[5]); w.w = cvt_pk_bf16(a[6], a[7]);
                    *(u32x4*)(ub + (size_t)row * D_MODEL + col0) = w;
                    const RowInfo ri = row_info(row); const int jj = ri.t - (seq_len(ri.seq) - 2);
                    if (jj >= 0) {
                        float* cs = (ri.seq < BATCH) ? out + O_CP + (((size_t)layer * BATCH + ri.seq) * 2 + jj) * D_MODEL + col0 : out + O_CS + (((size_t)layer * DEC_BATCH + (ri.seq - BATCH)) * 2 + jj) * D_MODEL + col0;
                        *(f32x4*)(cs) = (f32x4){a[0], a[1], a[2], a[3]}; *(f32x4*)(cs + 4) = (f32x4){a[4], a[5], a[6], a[7]};
                    }
                } else {
#pragma unroll
                    for (int bj = 0; bj < 2; ++bj) {
                        const int col0 = (u.pn - D_MODEL / 128) * 256 + bj * HALF + wc * 32 + 8 * fq;
                        const f32x4 v0 = acc[ai][bj][m][0] * rs, v1 = acc[ai][bj][m][1] * rs;
                        u32x4 w; w.x = cvt_pk_bf16(v0[0], v0[1]); w.y = cvt_pk_bf16(v0[2], v0[3]); w.z = cvt_pk_bf16(v1[0], v1[1]); w.w = cvt_pk_bf16(v1[2], v1[3]);
                        *(u32x4*)(bb + (size_t)row * D_MODEL + col0) = w;
                    }
                }
                asm volatile("" ::: "memory");
            }
    }
};
__device__ __forceinline__ void head_norm_rope(f32x4 (&v)[2][2], const float* gain, const float* rt  , int fq, bool do_norm, bool do_rope, f32x4 (&rot0)[2]) {
    if (do_norm) {
        float ss = (sum4(v[0][0]) + sum4(v[0][1])) + (sum4(v[1][0]) + sum4(v[1][1]));
        ss += __shfl_xor(ss, 16); ss += __shfl_xor(ss, 32);
        const float r = rsqrtf(ss * (1.0f / HD) + EPS);
#pragma unroll
        for (int bj = 0; bj < 2; ++bj)
#pragma unroll
            for (int n = 0; n < 2; ++n) { const f32x4 g = *(const f32x4*)(gain + 32 * bj + 8 * fq + 4 * n); v[bj][n] = v[bj][n] * r * g; }
    }
    rot0[0] = v[0][0]; rot0[1] = v[0][1];
    if (do_rope) {
#pragma unroll
        for (int n = 0; n < 2; ++n) {
            f32x4 p;
#pragma unroll
            for (int i = 0; i < 4; ++i) p[i] = __shfl_xor(v[0][n][i], 16);
            const f32x4 c = *(const f32x4*)(rt + 4 * n), s = *(const f32x4*)(rt + 8 + 4 * n);
            if (fq == 0) rot0[n] = v[0][n] * c - p * s; else if (fq == 1) rot0[n] = v[0][n] * c + p * s;
        }
    }
}
__device__ __forceinline__ u32x4 pack8(const f32x4 a, const f32x4 b, float sc) { u32x4 w; w.x = cvt_pk_bf16(a[0] * sc, a[1] * sc); w.y = cvt_pk_bf16(a[2] * sc, a[3] * sc); w.z = cvt_pk_bf16(b[0] * sc, b[1] * sc); w.w = cvt_pk_bf16(b[2] * sc, b[3] * sc); return w; }
struct EpiQG {
    static constexpr bool PERM = true, AFTER_DRAIN = false;
    bf16_t* qnb; bf16_t* qrb; float* gates; const float* rss; const float* q_norm; const float* rope;
    __device__ __forceinline__ void pre(const Unit& u, int wr, int fr, float (&rsv)[8]) const {
        const __attribute__((address_space(1))) float* rp = (const __attribute__((address_space(1))) float*)rss + u.pm * BM + wr * 64 + fr;
#pragma unroll
        for (int ai = 0; ai < 2; ++ai)
#pragma unroll
            for (int m = 0; m < 4; ++m) rsv[ai * 4 + m] = rp[ai * HALF + m * 16];
    }
    __device__ __forceinline__ void operator()(const f32x4 (&acc)[2][2][4][2], const Unit& u, int wr, int wc, int fr, int fq, const float (&rsv)[8]) const {
        const int row0 = u.pm * BM + wr * 64 + fr;
#pragma unroll
        for (int ai = 0; ai < 2; ++ai)
#pragma unroll
            for (int m = 0; m < 4; ++m) {
                const int row = row0 + ai * HALF + m * 16; const float rs = rsqrtf(rsv[ai * 4 + m] * (1.0f / D_MODEL) + EPS);
                if (u.pn < N_HEADS / 4) {
                    const int hh = u.pn * 4 + wc;
                    f32x4 v[2][2] = {{acc[ai][0][m][0] * rs, acc[ai][0][m][1] * rs}, {acc[ai][1][m][0] * rs, acc[ai][1][m][1] * rs}}; f32x4 rot0[2];
                    head_norm_rope(v, q_norm, rope + (size_t)pos_index(row_info(row).pos) * 16, fq, true, true, rot0);
                    const size_t o = (size_t)row * HDM + hh * HD + 8 * fq;
                    const u32x4 hi8 = pack8(v[1][0], v[1][1], QSCALE_F);
                    *(u32x4*)(qnb + o) = pack8(v[0][0], v[0][1], QSCALE_F); *(u32x4*)(qnb + o + 32) = hi8;
                    *(u32x4*)(qrb + o) = pack8(rot0[0], rot0[1], QSCALE_F); *(u32x4*)(qrb + o + 32) = hi8;
                } else {
                    const int c0 = wc * 32 + 8 * fq;
#pragma unroll
                    for (int n = 0; n < 2; ++n)
#pragma unroll
                        for (int i = 0; i < 4; ++i) { const int c = c0 + 4 * n + i; if (c < 3 * N_HEADS) gates[(size_t)row * 3 * N_HEADS + c] = __builtin_amdgcn_rcpf(1.0f + __expf(-(acc[ai][0][m][n][i] * rs))); }
                }
                asm volatile("" ::: "memory");
            }
    }
};
struct EpiKV {
    static constexpr bool PERM = true, AFTER_DRAIN = false;
    float* out; float* winrows; const float* rss; const float* k_norm; const float* rope;
    unsigned char* ksel; unsigned char* vsel; unsigned char* kwin; unsigned char* vwin; bf16_t* acp; const float* pe;
    __device__ __forceinline__ void pre(const Unit&, int, int, float (&)[8]) const {}
    __device__ __forceinline__ void operator()(const f32x4 (&acc)[2][2][4][2], const Unit& u, int wr, int wc, int fr, int fq, const float (&rsv)[8]) const {
        const int row0 = u.pm * BM + wr * 64 + fr;
        const int hidx = u.pn * 4 + wc, e = hidx / N_KV, g = hidx % N_KV; const bool nr = (e == 2 || e == 4);
#pragma unroll
        for (int ai = 0; ai < 2; ++ai)
#pragma unroll
            for (int m = 0; m < 4; ++m) {
                const int row = row0 + ai * HALF + m * 16; const float rs = row_rs(rss, row);
                const RowInfo ri = row_info(row);
                f32x4 v[2][2] = {{acc[ai][0][m][0] * rs, acc[ai][0][m][1] * rs}, {acc[ai][1][m][0] * rs, acc[ai][1][m][1] * rs}}; f32x4 rot0[2];
                head_norm_rope(v, k_norm + (e == 2 ? 1 : 2) * HD, rope + (size_t)pos_index(ri.pos) * 16, fq, nr, nr, rot0);
                float* d0; float* d1 = nullptr;
                if (e < 4) d0 = (ri.seq < BATCH) ? out + O_KVP + (((size_t)row * 4 + e) * N_KV + g) * HD : out + O_KVS + (((size_t)(row - MP) * 4 + e) * N_KV + g) * HD;
                else { const int we = e - 4; d0 = winrows + (((size_t)row * 2 + we) * N_KV + g) * HD;
                    if (ri.seq < BATCH) { if (ri.t >= SEQ - WINDOW) d1 = out + O_WP + ((((size_t)ri.seq * WINDOW + (ri.t - (SEQ - WINDOW))) * 2 + we) * N_KV + g) * HD; }
                    else d1 = out + O_WS + ((((size_t)(ri.seq - BATCH) * WINDOW + (WINDOW - DEC_SEQ + ri.t)) * 2 + we) * N_KV + g) * HD; }
                d0 += 8 * fq; *(f32x4*)(d0) = rot0[0]; *(f32x4*)(d0 + 4) = rot0[1]; *(f32x4*)(d0 + 32) = v[1][0]; *(f32x4*)(d0 + 36) = v[1][1];
                if (d1) { d1 += 8 * fq; *(f32x4*)(d1) = rot0[0]; *(f32x4*)(d1 + 4) = rot0[1]; *(f32x4*)(d1 + 32) = v[1][0]; *(f32x4*)(d1 + 36) = v[1][1]; }
                if (ri.seq < BATCH) {
                    if (e >= 2) {
                        unsigned char* img = (e == 2 ? ksel : e == 3 ? vsel : e == 4 ? kwin : vwin) + (((size_t)ri.seq * N_KV + g) * (SEQ / 64) + ri.t / 64) * 8192; const int kv = ri.t % 64;
                        const size_t o0 = (e & 1) ? vimg_off(kv, 8 * fq) : kimg_off(kv, 8 * fq), o1 = (e & 1) ? vimg_off(kv, 32 + 8 * fq) : kimg_off(kv, 32 + 8 * fq);
                        *(u32x4*)(img + o0) = pack8(rot0[0], rot0[1], 1.0f); *(u32x4*)(img + o1) = pack8(v[1][0], v[1][1], 1.0f);
                    } else {
                        const int c = ri.t / L_CMP, l = ri.t % L_CMP; const int r = (ri.seq * NBC_P + c) * N_KV + g;
                        bf16_t* ap = acp + ((size_t)e * RP_CMP + r) * (L_CMP * HD) + l * HD + 8 * fq; const float* pp = pe + ((size_t)e * L_CMP + l) * HD + 8 * fq;
                        *(u32x4*)(ap) = pack8(rot0[0] + *(const f32x4*)(pp), rot0[1] + *(const f32x4*)(pp + 4), 1.0f);
                        *(u32x4*)(ap + 32) = pack8(v[1][0] + *(const f32x4*)(pp + 32), v[1][1] + *(const f32x4*)(pp + 36), 1.0f);
                    }
                }
                asm volatile("" ::: "memory");
            }
    }
};
}

namespace pg8 {
struct EpiGelu {
    static constexpr bool PERM = true, AFTER_DRAIN = false;
    bf16_t* hid;
    __device__ __forceinline__ void pre(const Unit&, int, int, float (&)[8]) const {}
    __device__ __forceinline__ void operator()(const f32x4 (&acc)[2][2][4][2], const Unit& u, int wr, int wc, int fr, int fq, const float (&rsv)[8]) const {
        const int row0 = u.pm * BM + wr * 64 + fr;
#pragma unroll
        for (int ai = 0; ai < 2; ++ai)
#pragma unroll
            for (int m = 0; m < 4; ++m) {
                const int row = row0 + ai * HALF + m * 16;
#pragma unroll
                for (int bj = 0; bj < 2; ++bj) {
                    float a[8];
#pragma unroll
                    for (int n = 0; n < 2; ++n)
#pragma unroll
                        for (int i = 0; i < 4; ++i) { const float x = acc[ai][bj][m][n][i]; a[n * 4 + i] = x * __builtin_amdgcn_rcpf(1.0f + __expf(-1.5957691216057308f * (x + 0.044715f * x * x * x))); }
                    u32x4 w; w.x = cvt_pk_bf16(a[0], a[1]); w.y = cvt_pk_bf16(a[2], a[3]); w.z = cvt_pk_bf16(a[4], a[5]); w.w = cvt_pk_bf16(a[6], a[7]);
                    *(u32x4*)(hid + (size_t)row * CMP_HID + bj * HALF + wc * 32 + 8 * fq) = w;
                }
            }
    }
};
struct CmpOrder {
    int nunits, per_e, G, c;
    __device__ bool next(int i, Unit& u) const { const int L = i * G + c; if (L >= nunits) return false; u.pm = L; u.pn = L / per_e; return true; }
    __device__ __forceinline__ void a_ready(const Unit&) const {}
    __device__ __forceinline__ void done(const Unit&) const {}
};
}
constexpr int LDS_RING_C = 131072;
namespace att {
typedef short bf16x8 __attribute__((ext_vector_type(8)));
typedef short s16x4 __attribute__((ext_vector_type(4)));
typedef float f32x16 __attribute__((ext_vector_type(16)));
typedef __attribute__((address_space(3))) unsigned char* ldsp;
constexpr int TILE_B = 8192;
constexpr int L_KB = 0, L_VB = 3 * TILE_B, L_IMP = 6 * TILE_B, L_SELM = L_IMP + 64 * 64 * 4, L_END = L_SELM + 64 * 8;
constexpr float NEGB = -1e30f;
constexpr float QSCALE = 0.125f * 1.4426950408889634f;
__device__ __forceinline__ int crow(int r, int hi) { return (r & 3) + 8 * (r >> 2) + 4 * hi; }
__device__ __forceinline__ void glds16(const void* gsrc, unsigned lds_dst) { unsigned keep;
    asm volatile("s_mov_b32 %0, m0\n\ts_mov_b32 m0, %2\n\ts_nop 0\n\tglobal_load_lds_dwordx4 %1, off\n\ts_mov_b32 m0, %0" : "=&s"(keep) : "v"(gsrc), "s"(lds_dst) : "memory"); }
__device__ __forceinline__ unsigned cvtpk(float lo, float hi) { unsigned r; asm volatile("v_cvt_pk_bf16_f32 %0, %1, %2" : "=v"(r) : "v"(lo), "v"(hi)); return r; }
__device__ __forceinline__ float halfmax(float m) { auto rr = __builtin_amdgcn_permlane32_swap(__float_as_uint(m), __float_as_uint(m), false, false); return fmaxf(__uint_as_float(rr[0]), __uint_as_float(rr[1])); }
__device__ __forceinline__ float halfsum(float m) { auto rr = __builtin_amdgcn_permlane32_swap(__float_as_uint(m), __float_as_uint(m), false, false); return __uint_as_float(rr[0]) + __uint_as_float(rr[1]); }
__device__ __forceinline__ s16x4 vtr(ldsp p) { typedef short v4i16_t __attribute__((ext_vector_type(4))); return __builtin_bit_cast(s16x4, __builtin_amdgcn_ds_read_tr16_b64_v4i16((__attribute__((address_space(3))) v4i16_t*)p)); }
#define ATT_BAR_L() asm volatile("s_waitcnt lgkmcnt(0)\n\ts_barrier" ::: "memory")
#define ATT_WAIT_BAR(N) asm volatile("s_waitcnt vmcnt(" #N ") lgkmcnt(0)\n\ts_barrier" ::: "memory")
__device__ __forceinline__ void dma_tile(const unsigned char* img_, unsigned lds_dst, int wid, int lane) { unsigned keep; const unsigned voff = (unsigned)(wid * 1024 + lane * 16);
    const unsigned long long ia_ = (unsigned long long)img_; const unsigned long long img = ((unsigned long long)(unsigned)__builtin_amdgcn_readfirstlane((int)(ia_ >> 32)) << 32) | (unsigned)__builtin_amdgcn_readfirstlane((int)ia_);
    asm volatile("s_mov_b32 %0, m0\n\ts_mov_b32 m0, %3\n\ts_nop 0\n\tglobal_load_lds_dwordx4 %1, %2\n\ts_mov_b32 m0, %0" : "=&s"(keep) : "v"(voff), "s"(img), "s"((unsigned)__builtin_amdgcn_readfirstlane(lds_dst + wid * 1024)) : "memory"); }
__device__ __forceinline__ void qk(f32x16& p0, f32x16& p1, ldsp kbuf, const bf16x8 (&qf)[4], float cinit, int r32, int hi) {
    f32x16 c;
#pragma unroll
    for (int r = 0; r < 16; ++r) c[r] = cinit;
#pragma unroll
    for (int s = 0; s < 4; ++s) {
        const bf16x8 k0 = *(const __attribute__((address_space(3))) bf16x8*)(kbuf + (2 * s + hi) * 1024 + r32 * 16);
        const bf16x8 k1 = *(const __attribute__((address_space(3))) bf16x8*)(kbuf + (2 * s + hi) * 1024 + r32 * 16 + 512);
        p0 = __builtin_amdgcn_mfma_f32_32x32x16_bf16(k0, qf[s], s == 0 ? c : p0, 0, 0, 0);
        p1 = __builtin_amdgcn_mfma_f32_32x32x16_bf16(k1, qf[s], s == 0 ? c : p1, 0, 0, 0);
    }
}
__device__ __forceinline__ void pv(f32x16 (&o)[2], ldsp vbuf, const f32x16& p0, const f32x16& p1, int lane, int hi) {
    unsigned pk[4][4];
#pragma unroll
    for (int k = 0; k < 4; ++k) { pk[0][k] = cvtpk(p0[2 * k], p0[2 * k + 1]); pk[1][k] = cvtpk(p0[8 + 2 * k], p0[9 + 2 * k]); pk[2][k] = cvtpk(p1[2 * k], p1[2 * k + 1]); pk[3][k] = cvtpk(p1[8 + 2 * k], p1[9 + 2 * k]); }
    const int vp0 = ((lane >> 4) & 1) * 32 + (lane & 3) * 8 + (4 * hi + ((lane & 15) >> 2)) * 64;
#pragma unroll
    for (int d0 = 0; d0 < 2; ++d0)
#pragma unroll
        for (int s = 0; s < 4; ++s) {
            const s16x4 lo = vtr(vbuf + d0 * 4096 + s * 1024 + vp0), hh = vtr(vbuf + d0 * 4096 + s * 1024 + 512 + vp0);
            const bf16x8 vf = (bf16x8){lo[0], lo[1], lo[2], lo[3], hh[0], hh[1], hh[2], hh[3]};
            typedef unsigned u32x4 __attribute__((ext_vector_type(4)));
            const u32x4 pw = (u32x4){pk[s][0], pk[s][1], pk[s][2], pk[s][3]};
            o[d0] = __builtin_amdgcn_mfma_f32_32x32x16_bf16(vf, __builtin_bit_cast(bf16x8, pw), o[d0], 0, 0, 0);
        }
}
struct Run { float l; f32x16 o[2]; };
template <bool EMASK> __device__ __forceinline__ void tile_step(Run& R, ldsp kbuf, ldsp vbuf, const bf16x8 (&qf)[4], bool row_on, int lo_b_, int hi_b_, int lane, int r32, int hi) {
    int lo_b = lo_b_ - 4 * hi, hi_b = hi_b_ - 4 * hi;
    if (EMASK) asm volatile("" : "+v"(lo_b), "+v"(hi_b));
    f32x16 p0, p1; qk(p0, p1, kbuf, qf, row_on ? 0.f : NEGB, r32, hi);
    float ls = 0.f;
#pragma unroll
    for (int r = 0; r < 16; ++r) {
        float e0 = __builtin_amdgcn_exp2f(p0[r]), e1 = __builtin_amdgcn_exp2f(p1[r]);
        if (EMASK) { const int kc_ = (r & 3) + 8 * (r >> 2); if (kc_ < lo_b || kc_ > hi_b) e0 = 0.f; if (kc_ + 32 < lo_b || kc_ + 32 > hi_b) e1 = 0.f; }
        p0[r] = e0; p1[r] = e1; ls += e0 + e1;
    }
    R.l += ls;
    pv(R.o, vbuf, p0, p1, lane, hi);
}
struct Tensors {
    const bf16_t* qn; const bf16_t* qr;
    const unsigned char* ksel; const unsigned char* vsel; const unsigned char* kwin; const unsigned char* vwin;
    const unsigned char* kc; const unsigned char* vc;
    const float* gates; bf16_t* ob;
};
template <bool SEL> __device__ __forceinline__ void branch(Run& R, const unsigned char* kimg, const unsigned char* vimg, int t0, int t1, int jdiag, unsigned long long selm, int iq,
                                                           const bf16x8 (&qf)[4], unsigned lds0, ldsp lds, int wid, int lane, int r32, int hi) {
    R.l = 0.f;
#pragma unroll
    for (int r = 0; r < 16; ++r) { R.o[0][r] = 0.f; R.o[1][r] = 0.f; }
    dma_tile(kimg + (size_t)t0 * TILE_B, lds0 + L_KB, wid, lane); dma_tile(vimg + (size_t)t0 * TILE_B, lds0 + L_VB, wid, lane);
    if (t0 < t1) { dma_tile(kimg + (size_t)(t0 + 1) * TILE_B, lds0 + L_KB + TILE_B, wid, lane); dma_tile(vimg + (size_t)(t0 + 1) * TILE_B, lds0 + L_VB + TILE_B, wid, lane); }
    int b = 0;
    for (int t = t0; t <= t1; ++t) {
        if (t < t1) ATT_WAIT_BAR(2); else ATT_WAIT_BAR(0);
        if (t + 2 <= t1) { const int b2 = (b >= 1) ? b - 1 : 2; dma_tile(kimg + (size_t)(t + 2) * TILE_B, lds0 + L_KB + b2 * TILE_B, wid, lane); dma_tile(vimg + (size_t)(t + 2) * TILE_B, lds0 + L_VB + b2 * TILE_B, wid, lane); }
        const bool row_on = !SEL || ((selm >> t) & 1ull);
        const bool lowm = !SEL && (t == jdiag - 8);
        if (t == jdiag || lowm) tile_step<true>(R, lds + L_KB + b * TILE_B, lds + L_VB + b * TILE_B, qf, row_on, lowm ? iq : 0, (t == jdiag) ? iq : 63, lane, r32, hi);
        else tile_step<false>(R, lds + L_KB + b * TILE_B, lds + L_VB + b * TILE_B, qf, row_on, 0, 63, lane, r32, hi);
        b = (b == 2) ? 0 : b + 1;
    }
    ATT_BAR_L();
}
__device__ __forceinline__ void load_q(bf16x8 (&qf)[4], const bf16_t* qrow, int hi) {
#pragma unroll
    for (int s = 0; s < 4; ++s) qf[s] = *(const bf16x8*)(qrow + 16 * s + 8 * hi);
}
__device__ __forceinline__ void unit(const Tensors& T, int n, int j, int g, ldsp lds, unsigned lds0, int wid, int lane_) {
    const int lane = (int)lane_id_v();
    const int r32 = lane & 31, hi = lane >> 5, ql = r32 >> 2, hq = r32 & 3, iq = 8 * wid + ql;
    const int row = n * SEQ + 64 * j + iq, head = g * HPG + hq, pos = 64 * j + iq;
    const size_t img_ng = ((size_t)n * N_KV + g);
    f32x16 oacc[2];
#pragma unroll
    for (int r = 0; r < 16; ++r) { oacc[0][r] = 0.f; oacc[1][r] = 0.f; }
    const float* gt = T.gates + (size_t)row * 3 * N_HEADS + head * 3;
    const float g_c = gt[0], g_s = gt[1], g_w = gt[2];
    bf16x8 qf[4];
    unsigned long long selm;
    {
        load_q(qf, T.qn + (size_t)row * HDM + head * HD, hi);
        const int ntc = (2 * j + 2 + 63) / 64;
        const unsigned char* kci = T.kc + img_ng * (NBC_P / 64) * TILE_B; const unsigned char* vci = T.vc + img_ng * (NBC_P / 64) * TILE_B;
        dma_tile(kci, lds0 + L_KB, wid, lane); dma_tile(vci, lds0 + L_VB, wid, lane);
        if (ntc > 1) { dma_tile(kci + TILE_B, lds0 + L_KB + TILE_B, wid, lane); dma_tile(vci + TILE_B, lds0 + L_VB + TILE_B, wid, lane); }
        ATT_WAIT_BAR(0);
        int cmax = ((pos + 1) >> 5) - 1 - 4 * hi;
        asm volatile("" : "+v"(cmax));
        f32x16 s0, s1, s2, s3;
        qk(s0, s1, lds + L_KB, qf, 0.f, r32, hi);
        if (ntc > 1) qk(s2, s3, lds + L_KB + TILE_B, qf, 0.f, r32, hi);
        else {
#pragma unroll
            for (int r = 0; r < 16; ++r) { s2[r] = NEGB; s3[r] = NEGB; }
        }
        float ls = 0.f;
#pragma unroll
        for (int r = 0; r < 16; ++r) { const int kv = (r & 3) + 8 * (r >> 2);
            s0[r] = (kv > cmax) ? 0.f : __builtin_amdgcn_exp2f(s0[r]); s1[r] = (kv + 32 > cmax) ? 0.f : __builtin_amdgcn_exp2f(s1[r]);
            s2[r] = (kv + 64 > cmax) ? 0.f : __builtin_amdgcn_exp2f(s2[r]); s3[r] = (kv + 96 > cmax) ? 0.f : __builtin_amdgcn_exp2f(s3[r]);
            ls += (s0[r] + s1[r]) + (s2[r] + s3[r]); }
        ls = halfsum(ls);
        const float inv = 1.0f / fmaxf(ls, 1e-30f);
#pragma unroll
        for (int r = 0; r < 16; ++r) { s0[r] *= inv; s1[r] *= inv; s2[r] *= inv; s3[r] *= inv; }
        __attribute__((address_space(3))) float* imp = (__attribute__((address_space(3))) float*)(lds + L_IMP) + iq * 64;
#pragma unroll
        for (int r = 0; r < 16; r += 2) { const int bl = crow(r, hi) >> 1;
            float v0 = s0[r] + s0[r + 1], v1 = s1[r] + s1[r + 1], v2 = s2[r] + s2[r + 1], v3 = s3[r] + s3[r + 1];
            v0 += __shfl_xor(v0, 1); v0 += __shfl_xor(v0, 2); v1 += __shfl_xor(v1, 1); v1 += __shfl_xor(v1, 2);
            v2 += __shfl_xor(v2, 1); v2 += __shfl_xor(v2, 2); v3 += __shfl_xor(v3, 1); v3 += __shfl_xor(v3, 2);
            if (hq == 0) { imp[bl] = v0; imp[16 + bl] = v1; imp[32 + bl] = v2; imp[48 + bl] = v3; } }
        Run Rc;
#pragma unroll
        for (int r = 0; r < 16; ++r) { Rc.o[0][r] = 0.f; Rc.o[1][r] = 0.f; }
        pv(Rc.o, lds + L_VB, s0, s1, lane, hi);
        if (ntc > 1) pv(Rc.o, lds + L_VB + TILE_B, s2, s3, lane, hi);
#pragma unroll
        for (int r = 0; r < 16; ++r) { oacc[0][r] += g_c * Rc.o[0][r]; oacc[1][r] += g_c * Rc.o[1][r]; }
        asm volatile("s_waitcnt lgkmcnt(0)" ::: "memory");
        __attribute__((address_space(3))) unsigned long long* selw = (__attribute__((address_space(3))) unsigned long long*)(lds + L_SELM);
        for (int qq = 0; qq < 8; ++qq) {
            const float v = ((__attribute__((address_space(3))) float*)(lds + L_IMP))[(8 * wid + qq) * 64 + lane];
            const bool valid = lane <= j, forced = (lane == 0) || (lane == j) || (lane == j - 1);
            const unsigned key = valid ? (forced ? 0x7f000000u : __float_as_uint(v) + 1u) : 0u;
            unsigned long long m;
            if (j + 1 <= N_SEL) m = __ballot(valid);
            else {
                unsigned Tt = 0u;
                for (int bit = 30; bit >= 0; --bit) { const unsigned cand = Tt | (1u << bit); if (__popcll(__ballot(key >= cand)) >= N_SEL) Tt = cand; }
                const unsigned long long gtm = __ballot(key > Tt), eqm = __ballot(key == Tt);
                const int need = N_SEL - __popcll(gtm);
                const bool pick = (key == Tt) && (__popcll(eqm & ((1ull << lane) - 1ull)) < need);
                m = gtm | __ballot(pick);
            }
            if (lane == 0) selw[8 * wid + qq] = m;
        }
        asm volatile("s_waitcnt lgkmcnt(0)" ::: "memory");
        selm = selw[iq];
        ATT_WAIT_BAR(0);
    }
    load_q(qf, T.qr + (size_t)row * HDM + head * HD, hi);
    {
        Run R; branch<true>(R, T.ksel + img_ng * (SEQ / 64) * TILE_B, T.vsel + img_ng * (SEQ / 64) * TILE_B, 0, j, j, selm, iq, qf, lds0, lds, wid, lane, r32, hi);
        const float sc = g_s / fmaxf(halfsum(R.l), 1e-30f);
#pragma unroll
        for (int r = 0; r < 16; ++r) { oacc[0][r] += sc * R.o[0][r]; oacc[1][r] += sc * R.o[1][r]; }
    }
    {
        Run R; branch<false>(R, T.kwin + img_ng * (SEQ / 64) * TILE_B, T.vwin + img_ng * (SEQ / 64) * TILE_B, j > 8 ? j - 8 : 0, j, j, 0ull, iq, qf, lds0, lds, wid, lane, r32, hi);
        const float sc = g_w / fmaxf(halfsum(R.l), 1e-30f);
#pragma unroll
        for (int r = 0; r < 16; ++r) { oacc[0][r] += sc * R.o[0][r]; oacc[1][r] += sc * R.o[1][r]; }
    }
    bf16_t* orow = T.ob + (size_t)row * HDM + head * HD;
#pragma unroll
    for (int d0 = 0; d0 < 2; ++d0)
#pragma unroll
        for (int rr = 0; rr < 4; ++rr) { typedef unsigned u32x2 __attribute__((ext_vector_type(2)));
            u32x2 w; w.x = cvtpk(oacc[d0][4 * rr], oacc[d0][4 * rr + 1]); w.y = cvtpk(oacc[d0][4 * rr + 2], oacc[d0][4 * rr + 3]);
            *(u32x2*)(orow + 32 * d0 + 8 * rr + 4 * hi) = w; }
}
}
namespace att {
constexpr int S_STAGE = 16384;
constexpr int S_XM = LDS_RING_C + 1024, S_XL = S_XM + 1024, S_IMP = S_XL + 1024, S_SELM = S_IMP + 8 * 128 * 4, S_END = S_SELM + 8 * 2 * 8;
struct STensors {
    const bf16_t* qn; const bf16_t* qr; const float* kc; const float* vc; const float* cache_kv; const int* page_table; const float* cache_win; const float* out; const float* winrows;
    const float* gates; bf16_t* ob;
};
typedef float f32x4_t __attribute__((ext_vector_type(4)));
__device__ __forceinline__ void stage_kv(ldsp kimg, ldsp vimg, const float* ksrc, const float* vsrc, int stride, int nrows, int lane) {
    typedef unsigned u32x4 __attribute__((ext_vector_type(4)));
    const int c = lane & 7;
#pragma unroll 1
    for (int ib = 0; ib < 8; ib += 4)
#pragma unroll
    for (int it = ib; it < ib + 4; ++it) {
        const int row = 8 * it + (lane >> 3);
        f32x4_t k0 = {0.f, 0.f, 0.f, 0.f}, k1 = k0, v0 = k0, v1 = k0;
        if (row < nrows) { const float* kp = ksrc + (size_t)row * stride + 8 * c; const float* vp = vsrc + (size_t)row * stride + 8 * c;
            k0 = *(const f32x4_t*)kp; k1 = *(const f32x4_t*)(kp + 4); v0 = *(const f32x4_t*)vp; v1 = *(const f32x4_t*)(vp + 4); }
        u32x4 kw, vw; kw.x = cvtpk(k0[0], k0[1]); kw.y = cvtpk(k0[2], k0[3]); kw.z = cvtpk(k1[0], k1[1]); kw.w = cvtpk(k1[2], k1[3]);
        vw.x = cvtpk(v0[0], v0[1]); vw.y = cvtpk(v0[2], v0[3]); vw.z = cvtpk(v1[0], v1[1]); vw.w = cvtpk(v1[2], v1[3]);
        *(__attribute__((address_space(3))) u32x4*)(kimg + c * 1024 + row * 16) = kw;
        *(__attribute__((address_space(3))) u32x4*)(vimg + (c >> 2) * 4096 + (row >> 3) * 512 + (row & 7) * 64 + (c & 3) * 16) = vw;
    }
    asm volatile("s_waitcnt lgkmcnt(0)" ::: "memory");
}
#define ATT_BAR_ALL() asm volatile("s_waitcnt vmcnt(0) lgkmcnt(0)\n\ts_barrier" ::: "memory")
__device__ __forceinline__ float merge_sum(ldsp lds, float l_own_half, int wid, int r32, int hi) {
    __attribute__((address_space(3))) float* xl = (__attribute__((address_space(3))) float*)(lds + S_XL);
    const float l_own = halfsum(l_own_half);
    if (hi == 0) xl[wid * 32 + r32] = l_own;
    ATT_BAR_ALL();
    float L = 0.f;
#pragma unroll
    for (int w = 0; w < 8; ++w) L += xl[w * 32 + r32];
    ATT_BAR_ALL();
    return 1.0f / fmaxf(L, 1e-30f);
}
__device__ __forceinline__ void sample_unit(const STensors& T, int b, int g, ldsp lds, int wid, int lane_) {
    const int lane = (int)lane_id_v();
    const int r32 = lane & 31, hi = lane >> 5, ql = r32 >> 2, hq = r32 & 3;
    const int row = MP + b * DEC_SEQ + ql, head = g * HPG + hq, seq = BATCH + b;
    ldsp kimg = lds + wid * S_STAGE, vimg = kimg + TILE_B;
    f32x16 oacc[2];
#pragma unroll
    for (int r = 0; r < 16; ++r) { oacc[0][r] = 0.f; oacc[1][r] = 0.f; }
    const float* gt = T.gates + (size_t)row * 3 * N_HEADS + head * 3;
    const float g_c = gt[0], g_s = gt[1], g_w = gt[2];
    bf16x8 qf[4];
    __attribute__((address_space(3))) float* xm = (__attribute__((address_space(3))) float*)(lds + S_XM); __attribute__((address_space(3))) float* xl = (__attribute__((address_space(3))) float*)(lds + S_XL);
    __attribute__((address_space(3))) float* imp = (__attribute__((address_space(3))) float*)(lds + S_IMP);
    __attribute__((address_space(3))) unsigned long long* selw = (__attribute__((address_space(3))) unsigned long long*)(lds + S_SELM);
    {
        load_q(qf, T.qn + (size_t)row * HDM + head * HD, hi);
        constexpr int NTC = NBC_PAST / 64;
        f32x16 p0, p1; const bool mine = wid < NTC;
        float ls = 0.f;
        if (mine) {
            const float* kcp = T.kc + (((size_t)seq * NBC_MAX + 64 * wid) * N_KV + g) * HD; const float* vcp = T.vc + (((size_t)seq * NBC_MAX + 64 * wid) * N_KV + g) * HD;
            stage_kv(kimg, vimg, kcp, vcp, N_KV * HD, 64, lane);
            qk(p0, p1, kimg, qf, 0.f, r32, hi);
#pragma unroll
            for (int r = 0; r < 16; ++r) { p0[r] = __builtin_amdgcn_exp2f(p0[r]); p1[r] = __builtin_amdgcn_exp2f(p1[r]); ls += p0[r] + p1[r]; }
            ls = halfsum(ls);
        }
        if (hi == 0) xl[wid * 32 + r32] = ls;
        ATT_BAR_ALL();
        float L = 0.f;
#pragma unroll
        for (int w = 0; w < 8; ++w) L += xl[w * 32 + r32];
        const float inv = 1.0f / fmaxf(L, 1e-30f);
        if (mine) {
#pragma unroll
            for (int r = 0; r < 16; ++r) { p0[r] *= inv; p1[r] *= inv; }
#pragma unroll
            for (int r = 0; r < 16; r += 2) { const int bl = crow(r, hi) >> 1;
                float v0 = p0[r] + p0[r + 1], v1 = p1[r] + p1[r + 1];
                v0 += __shfl_xor(v0, 1); v0 += __shfl_xor(v0, 2); v1 += __shfl_xor(v1, 1); v1 += __shfl_xor(v1, 2);
                if (hq == 0) { imp[ql * 128 + 32 * wid + bl] = v0; imp[ql * 128 + 32 * wid + 16 + bl] = v1; } }
            Run Rc;
#pragma unroll
            for (int r = 0; r < 16; ++r) { Rc.o[0][r] = 0.f; Rc.o[1][r] = 0.f; }
            pv(Rc.o, vimg, p0, p1, lane, hi);
#pragma unroll
            for (int r = 0; r < 16; ++r) { oacc[0][r] += g_c * Rc.o[0][r]; oacc[1][r] += g_c * Rc.o[1][r]; }
        }
        ATT_BAR_ALL();
    }
    {
        constexpr int NCAND = NBS_S - 1;
        const float v0 = imp[wid * 128 + lane], v1 = imp[wid * 128 + 64 + lane];
        const unsigned key0 = (lane == 0) ? 0x7f000000u : __float_as_uint(v0) + 1u;
        const unsigned key1 = (lane + 64 == NCAND - 1) ? 0x7f000000u : __float_as_uint(v1) + 1u;
        unsigned Tt = 0u;
        for (int bit = 30; bit >= 0; --bit) { const unsigned cand = Tt | (1u << bit); if (__popcll(__ballot(key0 >= cand)) + __popcll(__ballot(key1 >= cand)) >= N_SEL - 1) Tt = cand; }
        const unsigned long long gt0 = __ballot(key0 > Tt), gt1 = __ballot(key1 > Tt), eq0 = __ballot(key0 == Tt), eq1 = __ballot(key1 == Tt);
        const int need = (N_SEL - 1) - __popcll(gt0) - __popcll(gt1);
        const unsigned long long below = (1ull << lane) - 1ull;
        const bool pick0 = (key0 == Tt) && (__popcll(eq0 & below) < need);
        const bool pick1 = (key1 == Tt) && (__popcll(eq0) + __popcll(eq1 & below) < need);
        const unsigned long long m0 = gt0 | __ballot(pick0), m1 = gt1 | __ballot(pick1);
        if (lane == 0) { selw[wid * 2] = m0; selw[wid * 2 + 1] = m1; }
        ATT_BAR_ALL();
    }
    load_q(qf, T.qr + (size_t)row * HDM + head * HD, hi);
    {
        unsigned long long U0 = 0ull, U1 = 0ull;
#pragma unroll
        for (int q = 0; q < 8; ++q) { U0 |= selw[q * 2]; U1 |= selw[q * 2 + 1]; }
        U0 = __builtin_amdgcn_readfirstlane((unsigned)U0) | ((unsigned long long)__builtin_amdgcn_readfirstlane((unsigned)(U0 >> 32)) << 32);
        U1 = __builtin_amdgcn_readfirstlane((unsigned)U1) | ((unsigned long long)__builtin_amdgcn_readfirstlane((unsigned)(U1 >> 32)) << 32);
        const unsigned long long my0 = selw[ql * 2], my1 = selw[ql * 2 + 1];
        Run R; R.l = 0.f;
#pragma unroll
        for (int r = 0; r < 16; ++r) { R.o[0][r] = 0.f; R.o[1][r] = 0.f; }
        int idx = 0;
        for (int half = 0; half < 2; ++half) {
            unsigned long long U = half ? U1 : U0;
            while (U) {
                const int bit = __builtin_ctzll(U); U &= U - 1ull;
                if ((idx++ & 7) != wid) continue;
                const int blk = 64 * half + bit;
                const int page = T.page_table[b * N_PAGES + (blk * L_SEL) / PAGE_SIZE];
                const float* base = T.cache_kv + (((size_t)page * PAGE_SIZE + (blk * L_SEL) % PAGE_SIZE) * 4) * N_KV * HD + g * HD;
                stage_kv(kimg, vimg, base + 2 * N_KV * HD, base + 3 * N_KV * HD, 4 * N_KV * HD, 64, lane);
                const bool selected = ((half ? my1 : my0) >> bit) & 1ull;
                tile_step<false>(R, kimg, vimg, qf, selected, 0, 63, lane, r32, hi);
            }
        }
        if ((idx & 7) == wid) {
            const float* base = T.out + O_KVS + (((size_t)b * DEC_SEQ) * 4) * N_KV * HD + g * HD;
            stage_kv(kimg, vimg, base + 2 * N_KV * HD, base + 3 * N_KV * HD, 4 * N_KV * HD, DEC_SEQ, lane);
            tile_step<true>(R, kimg, vimg, qf, true, 0, ql, lane, r32, hi);
        }
        const float wgt = merge_sum(lds, R.l, wid, r32, hi) * g_s;
#pragma unroll
        for (int r = 0; r < 16; ++r) { oacc[0][r] += wgt * R.o[0][r]; oacc[1][r] += wgt * R.o[1][r]; }
    }
    {
        Run R; R.l = 0.f;
#pragma unroll
        for (int r = 0; r < 16; ++r) { R.o[0][r] = 0.f; R.o[1][r] = 0.f; }
        for (int t = wid; t < WINDOW / 64; t += 8) {
            const float* base = T.cache_win + (((size_t)b * WINDOW + 64 * t) * 2) * N_KV * HD + g * HD;
            stage_kv(kimg, vimg, base, base + N_KV * HD, 2 * N_KV * HD, 64, lane);
            if (t == 0) tile_step<true>(R, kimg, vimg, qf, true, ql, 63, lane, r32, hi); else tile_step<false>(R, kimg, vimg, qf, true, 0, 63, lane, r32, hi);
        }
        if (wid == 0) {
            const float* base = T.winrows + (((size_t)(MP + b * DEC_SEQ)) * 2) * N_KV * HD + g * HD;
            stage_kv(kimg, vimg, base, base + N_KV * HD, 2 * N_KV * HD, DEC_SEQ, lane);
            tile_step<true>(R, kimg, vimg, qf, true, 0, ql, lane, r32, hi);
        }
        const float wgt = merge_sum(lds, R.l, wid, r32, hi) * g_w;
#pragma unroll
        for (int r = 0; r < 16; ++r) { oacc[0][r] += wgt * R.o[0][r]; oacc[1][r] += wgt * R.o[1][r]; }
    }
    {
        const int lane2 = (int)lane_id_v(), r32 = lane2 & 31, hi = lane2 >> 5;
        __attribute__((address_space(3))) float* mine = (__attribute__((address_space(3))) float*)(lds + wid * S_STAGE);
#pragma unroll
        for (int d0 = 0; d0 < 2; ++d0)
#pragma unroll
            for (int rr = 0; rr < 4; ++rr) *(__attribute__((address_space(3))) f32x4_t*)(mine + r32 * 64 + 32 * d0 + 8 * rr + 4 * hi) = (f32x4_t){oacc[d0][4 * rr], oacc[d0][4 * rr + 1], oacc[d0][4 * rr + 2], oacc[d0][4 * rr + 3]};
        ATT_BAR_ALL();
        const int tid = wid * 64 + (int)lane_id_v(), orow = tid >> 4, oc4 = (tid & 15) * 4;
        f32x4_t s = {0.f, 0.f, 0.f, 0.f};
#pragma unroll
        for (int w = 0; w < 8; ++w) s += *(const __attribute__((address_space(3))) f32x4_t*)((__attribute__((address_space(3))) float*)(lds + w * S_STAGE) + orow * 64 + oc4);
        typedef unsigned u32x2 __attribute__((ext_vector_type(2)));
        u32x2 wv; wv.x = cvtpk(s[0], s[1]); wv.y = cvtpk(s[2], s[3]);
        const int oq = orow >> 2, oh = orow & 3;
        *(u32x2*)(T.ob + (size_t)(MP + b * DEC_SEQ + oq) * HDM + (g * HPG + oh) * HD + oc4) = wv;
        ATT_BAR_ALL();
    }
}
constexpr int Q_SAMPLE = DEC_BATCH * N_KV, Q_PROMPT = BATCH * N_KV * (SEQ / 64), Q_TOTAL = Q_SAMPLE + Q_PROMPT;
constexpr int S_QHEAD = S_END;
__device__ __forceinline__ int claim_unit(unsigned* head, ldsp lds, int wid, int lane) {
    __attribute__((address_space(3))) int* qslot = (__attribute__((address_space(3))) int*)(lds + S_QHEAD);
    if (wid == 0 && lane == 0) *qslot = (int)__hip_atomic_fetch_add(head, 1u, __ATOMIC_RELAXED, __HIP_MEMORY_SCOPE_AGENT);
    ATT_BAR_ALL();
    const int u = __builtin_amdgcn_readfirstlane(*qslot);
    ATT_BAR_ALL();
    return u;
}
__device__ __forceinline__ void att_queue_sample(const STensors& TS, unsigned* head, ldsp lds, int wid, int lane) {
    for (;;) { const int u = claim_unit(head, lds, wid, lane); if (u >= Q_SAMPLE) break; sample_unit(TS, u / N_KV, u % N_KV, lds, wid, lane); }
}
__device__ __forceinline__ void att_queue_prompt(const Tensors& T, unsigned* head, ldsp lds, int wid, int lane) {
    const unsigned lds0 = (unsigned)(uintptr_t)lds;
    for (;;) { const int p = claim_unit(head, lds, wid, lane); if (p >= Q_PROMPT) break;
        const int j = (SEQ / 64 - 1) - p / (BATCH * N_KV), ng = p % (BATCH * N_KV); unit(T, ng / N_KV, j, ng % N_KV, lds, lds0, wid, lane); }
}
}


namespace att {
__device__ __forceinline__ void cmp_out_wave(int task, const bf16_t* hid, int R, int nbc, int seq0, const bf16_t* w2t, const float* k_norm0, float* kc, float* vc, unsigned char* kci, unsigned char* vci, int lane) {
    const int r32 = lane & 31, hi = lane >> 5;
    const int r0 = task * 32, e = r0 >= R ? 1 : 0, r = r0 - e * R + r32;
    const bf16_t* hrow = hid + ((size_t)e * R + r) * CMP_HID; const bf16_t* wrow = w2t + ((size_t)e * HD + r32) * CMP_HID;
    f32x16 o0, o1;
#pragma unroll
    for (int k = 0; k < 16; ++k) { o0[k] = 0.f; o1[k] = 0.f; }
#pragma unroll 4
    for (int s_ = 0; s_ < CMP_HID / 16; ++s_) {
        const bf16x8 hb_ = *(const bf16x8*)(hrow + 16 * s_ + 8 * hi);
        const bf16x8 w0 = *(const bf16x8*)(wrow + 16 * s_ + 8 * hi), w1 = *(const bf16x8*)(wrow + (size_t)32 * CMP_HID + 16 * s_ + 8 * hi);
        o0 = __builtin_amdgcn_mfma_f32_32x32x16_bf16(w0, hb_, o0, 0, 0, 0); o1 = __builtin_amdgcn_mfma_f32_32x32x16_bf16(w1, hb_, o1, 0, 0, 0);
    }
    if (e == 0) {
        float ss = 0.f;
#pragma unroll
        for (int k = 0; k < 16; ++k) ss += o0[k] * o0[k] + o1[k] * o1[k];
        ss = halfsum(ss);
        const float rn = rsqrtf(ss * (1.0f / HD) + EPS);
#pragma unroll
        for (int k = 0; k < 16; ++k) { o0[k] *= rn * k_norm0[crow(k, hi)]; o1[k] *= rn * k_norm0[32 + crow(k, hi)]; }
    }
    const int g = r % N_KV, c = (r / N_KV) % nbc, sq = r / (N_KV * nbc);
    float* dst = (e == 0 ? kc : vc) + (((size_t)(seq0 + sq) * NBC_MAX + c) * N_KV + g) * HD;
#pragma unroll
    for (int rr = 0; rr < 4; ++rr) { *(f32x4_t*)(dst + 8 * rr + 4 * hi) = (f32x4_t){o0[4 * rr], o0[4 * rr + 1], o0[4 * rr + 2], o0[4 * rr + 3]};
                                      *(f32x4_t*)(dst + 32 + 8 * rr + 4 * hi) = (f32x4_t){o1[4 * rr], o1[4 * rr + 1], o1[4 * rr + 2], o1[4 * rr + 3]}; }
    if (kci) {
        unsigned char* img = (e == 0 ? kci : vci) + (((size_t)sq * N_KV + g) * (NBC_P / 64) + c / 64) * 8192; const int kv = c % 64;
        typedef unsigned u32x2 __attribute__((ext_vector_type(2)));
#pragma unroll
        for (int rr = 0; rr < 4; ++rr) {
            u32x2 a; a.x = cvtpk(o0[4 * rr], o0[4 * rr + 1]); a.y = cvtpk(o0[4 * rr + 2], o0[4 * rr + 3]);
            u32x2 bq; bq.x = cvtpk(o1[4 * rr], o1[4 * rr + 1]); bq.y = cvtpk(o1[4 * rr + 2], o1[4 * rr + 3]);
            const int d0 = 8 * rr, d1 = 32 + 8 * rr;
            *(u32x2*)(img + (e == 0 ? kimg_off(kv, d0) : vimg_off(kv, d0)) + 8 * hi) = a;
            *(u32x2*)(img + (e == 0 ? kimg_off(kv, d1) : vimg_off(kv, d1)) + 8 * hi) = bq;
        }
    }
}
}
__device__ __forceinline__ void conv_thin_vec_item(size_t i_, const bf16_t* ub, const bf16_t* bb, const float* state, const float* wc, bf16_t* zb) {
    typedef unsigned u4 __attribute__((ext_vector_type(4)));
    const int m = (int)(i_ / (D_MODEL / 8)), ch = (int)(i_ % (D_MODEL / 8)) * 8;
    const RowInfo ri = row_info(m);
    const size_t o = (size_t)m * D_MODEL + ch;
    float u0[8], u1[8], u2[8], bv[8];
#define UNPK(w, f) do { f[0] = bf2f((bf16_t)((w).x & 0xffff)); f[1] = bf2f((bf16_t)((w).x >> 16)); f[2] = bf2f((bf16_t)((w).y & 0xffff)); f[3] = bf2f((bf16_t)((w).y >> 16)); \
                        f[4] = bf2f((bf16_t)((w).z & 0xffff)); f[5] = bf2f((bf16_t)((w).z >> 16)); f[6] = bf2f((bf16_t)((w).w & 0xffff)); f[7] = bf2f((bf16_t)((w).w >> 16)); } while (0)
    { const u4 w = *(const u4*)(ub + o); UNPK(w, u0); } { const u4 w = *(const u4*)(bb + o); UNPK(w, bv); }
    const float* st = (ri.seq >= BATCH) ? state + (size_t)(ri.seq - BATCH) * 2 * D_MODEL + ch : nullptr;
    if (ri.t >= 1) { const u4 w = *(const u4*)(ub + o - D_MODEL); UNPK(w, u1); } else { for (int k = 0; k < 8; ++k) u1[k] = st ? st[D_MODEL + k] : 0.f; }
    if (ri.t >= 2) { const u4 w = *(const u4*)(ub + o - 2 * D_MODEL); UNPK(w, u2); } else { for (int k = 0; k < 8; ++k) u2[k] = st ? (ri.t == 1 ? st[D_MODEL + k] : st[k]) : 0.f; }
#undef UNPK
    float z[8];
    for (int k = 0; k < 8; ++k) z[k] = bv[k] * (wc[ch + k] * u2[k] + wc[D_MODEL + ch + k] * u1[k] + wc[2 * D_MODEL + ch + k] * u0[k]);
    u4 w; w.x = (unsigned)f2bf(z[0]) | ((unsigned)f2bf(z[1]) << 16); w.y = (unsigned)f2bf(z[2]) | ((unsigned)f2bf(z[3]) << 16);
    w.z = (unsigned)f2bf(z[4]) | ((unsigned)f2bf(z[5]) << 16); w.w = (unsigned)f2bf(z[6]) | ((unsigned)f2bf(z[7]) << 16);
    *(u4*)(zb + o) = w;
}

namespace att {
__device__ __forceinline__ void skinny_task(int task, const bf16_t* A, const bf16_t* Bt, int N, int K, int KS, float* part, int lane) {
    const int r32 = lane & 31, hi = lane >> 5, ncb = N / 32, nrb = MS / 32;
    const int ks = task / (nrb * ncb), rem = task % (nrb * ncb), rb = rem / ncb, cb = rem % ncb, klen = K / KS, k0 = ks * klen;
    const bf16_t* ap = A + (size_t)(rb * 32 + r32) * K + k0 + 8 * hi; const bf16_t* bp = Bt + (size_t)(cb * 32 + r32) * K + k0 + 8 * hi;
    f32x16 acc;
#pragma unroll
    for (int k = 0; k < 16; ++k) acc[k] = 0.f;
#pragma unroll 8
    for (int s_ = 0; s_ < klen / 16; ++s_) acc = __builtin_amdgcn_mfma_f32_32x32x16_bf16(*(const bf16x8*)(bp + 16 * s_), *(const bf16x8*)(ap + 16 * s_), acc, 0, 0, 0);
    float* dst = part + ((size_t)ks * MS + rb * 32 + r32) * N + cb * 32 + 4 * hi;
#pragma unroll
    for (int rr = 0; rr < 4; ++rr) *(f32x4_t*)(dst + 8 * rr) = (f32x4_t){acc[4 * rr], acc[4 * rr + 1], acc[4 * rr + 2], acc[4 * rr + 3]};
}
__device__ __forceinline__ void resid_reduce_row(int rs_, const float* part, int KS, float coef, float* h, bf16_t* hb, float* rss_next, float* yout, int lane) {
    typedef unsigned u2 __attribute__((ext_vector_type(2)));
    const int m = MP + rs_; float ssq = 0.f;
#pragma unroll
    for (int j = 0; j < D_MODEL / 256; ++j) {
        const int col = 256 * j + 4 * lane; f32x4_t a = {0.f, 0.f, 0.f, 0.f};
        for (int ks = 0; ks < KS; ++ks) a += *(const f32x4_t*)(part + ((size_t)ks * MS + rs_) * D_MODEL + col);
        const f32x4_t v = *(const f32x4_t*)(h + (size_t)m * D_MODEL + col) + a * coef;
        if (yout) *(f32x4_t*)(yout + (size_t)m * D_MODEL + col) = v;
        else { *(f32x4_t*)(h + (size_t)m * D_MODEL + col) = v; u2 w; w.x = cvtpk(v[0], v[1]); w.y = cvtpk(v[2], v[3]); *(u2*)(hb + (size_t)m * D_MODEL + col) = w;
               ssq += (v[0] * v[0] + v[1] * v[1]) + (v[2] * v[2] + v[3] * v[3]); }
    }
    if (!yout) {
#pragma unroll
        for (int o = 1; o < 64; o <<= 1) ssq += __shfl_xor(ssq, o);
        if (lane == 0) rss_next[m] = ssq;
    }
}
}
__device__ __forceinline__ void conv_thin_sample_item(size_t i_, const float* part, int KS, const float* rss, const float* state, const float* wc, bf16_t* zb, float* out, int layer) {
    const int rs_ = (int)(i_ / (D_MODEL / 8)), ch = (int)(i_ % (D_MODEL / 8)) * 8, m = MP + rs_;
    const RowInfo ri = row_info(m);
    const int nc = (ch / 128) * 256 + (ch % 128);
    float u[3][8], bv[8];
    for (int back = 0; back < 3; ++back) {
        if (ri.t - back >= 0) {
            const int r2 = rs_ - back; const float rsn = rsqrtf(rss[MP + r2] * (1.0f / D_MODEL) + EPS);
            for (int k = 0; k < 8; ++k) { float c = 0.f, x = 0.f; for (int ks = 0; ks < KS; ++ks) { const float* p = part + ((size_t)ks * MS + r2) * 3 * D_MODEL; c += p[nc + k]; x += p[nc + 128 + k]; } u[back][k] = (c * rsn) * (x * rsn); }
        } else { const float* st = state + (size_t)(ri.seq - BATCH) * 2 * D_MODEL + ch;
            const int srow = 2 - (back - ri.t); for (int k = 0; k < 8; ++k) u[back][k] = st[(size_t)srow * D_MODEL + k]; }
    }
    { const float rsn = rsqrtf(rss[m] * (1.0f / D_MODEL) + EPS);
      for (int k = 0; k < 8; ++k) { float b = 0.f; for (int ks = 0; ks < KS; ++ks) b += part[((size_t)ks * MS + rs_) * 3 * D_MODEL + 2 * D_MODEL + ch + k]; bv[k] = b * rsn; } }
    for (int k = 0; k < 8; ++k) { const float ub0 = bf2f(f2bf(u[0][k])), ub1 = (ri.t >= 1) ? bf2f(f2bf(u[1][k])) : u[1][k], ub2 = (ri.t >= 2) ? bf2f(f2bf(u[2][k])) : u[2][k];
        zb[(size_t)m * D_MODEL + ch + k] = f2bf(bf2f(f2bf(bv[k])) * (wc[ch + k] * ub2 + wc[D_MODEL + ch + k] * ub1 + wc[2 * D_MODEL + ch + k] * ub0));
        if (ri.t >= DEC_SEQ - 2) out[O_CS + (((size_t)layer * DEC_BATCH + (ri.seq - BATCH)) * 2 + (ri.t - (DEC_SEQ - 2))) * D_MODEL + ch + k] = u[0][k]; }
}

__device__ __forceinline__ void acmp_sample_wave(int task, const float* cache_kv, const int* page_table, const float* pe, bf16_t* A, int lane) {
    typedef float f4 __attribute__((ext_vector_type(4))); typedef unsigned u4 __attribute__((ext_vector_type(4)));
    const int b = task / NBC_PAST, c = task % NBC_PAST, tok0 = c * L_CMP;
    const int page = page_table[b * N_PAGES + tok0 / PAGE_SIZE];
    const int e = lane >> 5, g = (lane >> 3) & (N_KV - 1), c8 = lane & 7;
    const float* src = cache_kv + ((size_t)page * PAGE_SIZE + tok0 % PAGE_SIZE) * 4 * N_KV * HD + lane * 8;
    const float* pp = pe + (size_t)e * L_CMP * HD + 8 * c8;
    bf16_t* dst = A + ((size_t)e * RS_CMP + ((size_t)b * NBC_PAST + c) * N_KV + g) * (L_CMP * HD) + 8 * c8;
#pragma unroll 8
    for (int l = 0; l < L_CMP; ++l) {
        const f4 a0 = __builtin_nontemporal_load((const f4*)(src + (size_t)l * 4 * N_KV * HD)) + *(const f4*)(pp + l * HD), a1 = __builtin_nontemporal_load((const f4*)(src + (size_t)l * 4 * N_KV * HD + 4)) + *(const f4*)(pp + l * HD + 4);
        u4 w; w.x = att::cvtpk(a0[0], a0[1]); w.y = att::cvtpk(a0[2], a0[3]); w.z = att::cvtpk(a1[0], a1[1]); w.w = att::cvtpk(a1[2], a1[3]);
        *(u4*)(dst + l * HD) = w;
    }
}
__device__ __forceinline__ void wconv_tile(int item, const float* src, int Nsrc, const float* gain, bf16_t* dst, int Nd, int K, int kind, int aux, LAS float* scr, int lane) {
    const int nblk = Nd / 32, kb = item / nblk, nb = item % nblk, k0 = 64 * kb, n0 = 32 * nb;
    const int colbase = colmap(kind, n0, aux);
    const int col = colbase + (lane & 31); const bool ok = colbase >= 0 && col < Nsrc;
    float tv[32];
    const float* sp0 = src + (size_t)(k0 + (lane >> 5)) * Nsrc + (ok ? col : 0);
#pragma unroll
    for (int i = 0; i < 32; ++i) tv[i] = ok ? __builtin_nontemporal_load(sp0 + (size_t)(2 * i) * Nsrc) : 0.f;
#pragma unroll
    for (int i = 0; i < 32; ++i) { const int kk = 2 * i + (lane >> 5); const float g = gain ? gain[k0 + kk] : 1.f; scr[kk * 33 + (lane & 31)] = tv[i] * g; }
    asm volatile("s_waitcnt lgkmcnt(0)" ::: "memory");
    const int c = lane & 7;
#pragma unroll
    for (int j = 0; j < 4; ++j) { const int n = (lane >> 3) + 8 * j; const LAS float* sp = scr + (8 * c) * 33 + n;
        typedef unsigned v4u __attribute__((ext_vector_type(4)));
        v4u o; o.x = pg8::cvt_pk_bf16(sp[0 * 33], sp[1 * 33]); o.y = pg8::cvt_pk_bf16(sp[2 * 33], sp[3 * 33]); o.z = pg8::cvt_pk_bf16(sp[4 * 33], sp[5 * 33]); o.w = pg8::cvt_pk_bf16(sp[6 * 33], sp[7 * 33]);
        *(v4u*)(dst + (size_t)(n0 + n) * K + k0 + 8 * c) = o; }
    asm volatile("s_waitcnt lgkmcnt(0)" ::: "memory");
}
__device__ __forceinline__ void hinit_row(int m, const float* xp, const float* xs, float* h, bf16_t* hb, float* rss0, int lane) {
    typedef float f4 __attribute__((ext_vector_type(4))); typedef unsigned u2 __attribute__((ext_vector_type(2)));
    const float* x = m < MP ? xp + (size_t)m * D_MODEL : xs + (size_t)(m - MP) * D_MODEL;
    float s = 0.f;
#pragma unroll
    for (int j = 0; j < D_MODEL / 256; ++j) { const f4 v = *(const f4*)(x + 256 * j + 4 * lane); s += (v[0] * v[0] + v[1] * v[1]) + (v[2] * v[2] + v[3] * v[3]);
        *(f4*)(h + (size_t)m * D_MODEL + 256 * j + 4 * lane) = v; u2 w; w.x = pg8::cvt_pk_bf16(v[0], v[1]); w.y = pg8::cvt_pk_bf16(v[2], v[3]); *(u2*)(hb + (size_t)m * D_MODEL + 256 * j + 4 * lane) = w; }
#pragma unroll
    for (int o = 1; o < 64; o <<= 1) s += __shfl_xor(s, o);
    if (lane == 0) rss0[m] = s;
}
#endif

#ifndef CPU_TEST
__device__ __forceinline__ size_t opaque_gtid(int wave) { int w = wave; asm volatile("" : "+s"(w)); unsigned t = blockIdx.x * NTHREADS + w * 64 + lane_id_v(); return (size_t)t; }
#define ITEM_LOOP(total) for (size_t i = opaque_gtid(wave_id); i < (size_t)(total); i += (size_t)gridDim.x * NTHREADS)
#else
#define ITEM_LOOP(total) _Pragma("omp parallel for schedule(dynamic, 64)") for (long long i = 0; i < (long long)(total); ++i)
#endif

struct Params {
    const float *x_prompt, *x_sample, *cache_kv, *cache_win, *state_conv; const int* page_table;
    const float *ffn_a_norm, *ffn_a_w_in, *ffn_a_w_out, *mix_norm, *ffn_b_norm, *ffn_b_w_in, *ffn_b_w_out, *conv_w_in, *conv_w, *conv_w_out, *kv_norm, *w_kv, *k_norm,
                *cmp_pe, *cmp_w1, *cmp_w2, *nsa_w_qg, *nsa_q_norm, *nsa_w_o;
    float* out; unsigned char* ws;
};
constexpr int LDS_RING = 131072, LDS_BAR_OFF = LDS_RING + 352, LDS_BYTES = 147456;

#ifndef CPU_TEST
typedef const __attribute__((address_space(4))) Params* KParamsPtr;
__device__ __forceinline__ KParamsPtr kparams_ptr() {
#if defined(__HIP_DEVICE_COMPILE__)
    KParamsPtr p = (KParamsPtr)__builtin_amdgcn_kernarg_segment_ptr(); asm volatile("" : "+s"(p)); return p;
#else
    return nullptr;
#endif
}
__device__ __forceinline__ Params load_params() {
#if defined(__HIP_DEVICE_COMPILE__)
    return *kparams_ptr();
#else
    return Params{};
#endif
}
__device__ __forceinline__ unsigned char* load_ws() {
#if defined(__HIP_DEVICE_COMPILE__)
    return kparams_ptr()->ws;
#else
    return nullptr;
#endif
}
#define KP const Params P = load_params()
__device__ __forceinline__ int opaque_s(int v) { asm volatile("" : "+s"(v)); return v; }
#define GRID_SYNC() do { XcdBarrier bar_; bar_.bar = (GU*)load_ws() + 1024; bar_.x = 0; bar_.st = (volatile LAS unsigned*)(lds + LDS_BAR_OFF); xcd_barrier(bar_, wave_id == 0 && lane_id_v() == 0u); } while (0)
__global__ void __launch_bounds__(NTHREADS, 2) mega(Params P_unused)
#else
static Params g_params;
#define KP const Params& P = g_params
#define GRID_SYNC() do {} while (0)
void mega(Params P_unused)
#endif
{
#ifndef CPU_TEST
    extern __shared__ __attribute__((aligned(16))) unsigned char lds[];
    const int wave_id = __builtin_amdgcn_readfirstlane((int)(threadIdx.x >> 6));
    if (threadIdx.x < 4) ((LAS unsigned*)(lds + LDS_BAR_OFF))[threadIdx.x] = 0u;
    __syncthreads();
    (void)xcd_barrier_post((GU*)load_ws() + 1024, (volatile LAS unsigned*)(lds + LDS_BAR_OFF), threadIdx.x == 0);
#define RING ((PG8_LAS unsigned char*)lds)
#else
    g_params = P_unused;
#endif
#define WS_F(f) ((float*)(P.ws + WSM.f))
#define WS_B(f) ((bf16_t*)(P.ws + WSM.f))
#define KVSRC KvSrc{P.cache_kv, P.page_table, P.out}
#define PH(total, call) do { { KP; ITEM_LOOP(total) call; } GRID_SYNC(); } while (0)
#ifdef CPU_TEST
    for (int L = 0; L < DEPTH; ++L) {
        KP;
        ITEM_LOOP((size_t)2 * D_FF * (D_MODEL / 64)) wconv_item(i, P.ffn_a_w_in + (size_t)L * D_MODEL * 2 * D_FF, 2 * D_FF, P.ffn_a_norm + (size_t)L * D_MODEL, WS_B(w_ain) + (size_t)L * 2 * D_FF * D_MODEL, 2 * D_FF, D_MODEL, CM_PAIR, D_FF);
        ITEM_LOOP((size_t)D_MODEL * (D_FF / 64)) wconv_item(i, P.ffn_a_w_out + (size_t)L * D_FF * D_MODEL, D_MODEL, nullptr, WS_B(w_aout) + (size_t)L * D_MODEL * D_FF, D_MODEL, D_FF, CM_PLAIN, 0);
        ITEM_LOOP((size_t)2 * D_FF * (D_MODEL / 64)) wconv_item(i, P.ffn_b_w_in + (size_t)L * D_MODEL * 2 * D_FF, 2 * D_FF, P.ffn_b_norm + (size_t)L * D_MODEL, WS_B(w_bin) + (size_t)L * 2 * D_FF * D_MODEL, 2 * D_FF, D_MODEL, CM_PAIR, D_FF);
        ITEM_LOOP((size_t)D_MODEL * (D_FF / 64)) wconv_item(i, P.ffn_b_w_out + (size_t)L * D_FF * D_MODEL, D_MODEL, nullptr, WS_B(w_bout) + (size_t)L * D_MODEL * D_FF, D_MODEL, D_FF, CM_PLAIN, 0);
    }
    for (int L = 0; L < N_A; ++L) {
        KP;
        ITEM_LOOP((size_t)3 * D_MODEL * (D_MODEL / 64)) wconv_item(i, P.conv_w_in + (size_t)L * D_MODEL * 3 * D_MODEL, 3 * D_MODEL, P.mix_norm + (size_t)L * D_MODEL, WS_B(w_cin) + (size_t)L * 3 * D_MODEL * D_MODEL, 3 * D_MODEL, D_MODEL, CM_CONV, 0);
        ITEM_LOOP((size_t)D_MODEL * (D_MODEL / 64)) wconv_item(i, P.conv_w_out + (size_t)L * D_MODEL * D_MODEL, D_MODEL, nullptr, WS_B(w_cout) + (size_t)L * D_MODEL * D_MODEL, D_MODEL, D_MODEL, CM_PLAIN, 0);
    }
    for (int b = 0; b < N_B; ++b) {
        KP;
        ITEM_LOOP((size_t)QGP * (D_MODEL / 64)) wconv_item(i, P.nsa_w_qg + (size_t)b * D_MODEL * QGW, QGW, P.mix_norm + (size_t)(N_A + b) * D_MODEL, WS_B(w_qg) + (size_t)b * QGP * D_MODEL, QGP, D_MODEL, CM_HEADS, N_HEADS);
        ITEM_LOOP((size_t)D_MODEL * (HDM / 64)) wconv_item(i, P.nsa_w_o + (size_t)b * HDM * D_MODEL, D_MODEL, nullptr, WS_B(w_o) + (size_t)b * D_MODEL * HDM, D_MODEL, HDM, CM_PLAIN, 0);
    }
    { KP; ITEM_LOOP((size_t)KVW * (D_MODEL / 64)) wconv_item(i, P.w_kv, KVW, P.kv_norm, WS_B(w_kv), KVW, D_MODEL, CM_HEADS, 6 * N_KV); }
    { KP; ITEM_LOOP((size_t)NPOS * 8) rope_item(i, WS_F(rope)); }
    { KP; ITEM_LOOP(MT) hinit_item(i, P.x_prompt, P.x_sample, WS_F(h), WS_B(hb), WS_F(rss)); }
#else
#define WAVE_ITEMS(total) for (int it_ = (int)(opaque_s((int)blockIdx.x) * 8 + wave_id); it_ < (int)(total); it_ += (int)gridDim.x * 8)
#define WCONV(srcp, Nsrc_, gainp, dstp, Nd_, K_, kind_, aux_) do { KP; LAS float* scr_ = (LAS float*)(lds + wave_id * 16384); const int lane_ = (int)lane_id_v(); \
        WAVE_ITEMS(((Nd_) / 32) * ((K_) / 64)) wconv_tile(it_, srcp, Nsrc_, gainp, dstp, Nd_, K_, kind_, aux_, scr_, lane_); } while (0)
    for (int L = 0; L < DEPTH; ++L) {
        WCONV(P.ffn_a_w_in + (size_t)L * D_MODEL * 2 * D_FF, 2 * D_FF, P.ffn_a_norm + (size_t)L * D_MODEL, WS_B(w_ain) + (size_t)L * 2 * D_FF * D_MODEL, 2 * D_FF, D_MODEL, CM_PAIR, D_FF);
        WCONV(P.ffn_a_w_out + (size_t)L * D_FF * D_MODEL, D_MODEL, nullptr, WS_B(w_aout) + (size_t)L * D_MODEL * D_FF, D_MODEL, D_FF, CM_PLAIN, 0);
        WCONV(P.ffn_b_w_in + (size_t)L * D_MODEL * 2 * D_FF, 2 * D_FF, P.ffn_b_norm + (size_t)L * D_MODEL, WS_B(w_bin) + (size_t)L * 2 * D_FF * D_MODEL, 2 * D_FF, D_MODEL, CM_PAIR, D_FF);
        WCONV(P.ffn_b_w_out + (size_t)L * D_FF * D_MODEL, D_MODEL, nullptr, WS_B(w_bout) + (size_t)L * D_MODEL * D_FF, D_MODEL, D_FF, CM_PLAIN, 0);
    }
    for (int L = 0; L < N_A; ++L) {
        WCONV(P.conv_w_in + (size_t)L * D_MODEL * 3 * D_MODEL, 3 * D_MODEL, P.mix_norm + (size_t)L * D_MODEL, WS_B(w_cin) + (size_t)L * 3 * D_MODEL * D_MODEL, 3 * D_MODEL, D_MODEL, CM_CONV, 0);
        WCONV(P.conv_w_out + (size_t)L * D_MODEL * D_MODEL, D_MODEL, nullptr, WS_B(w_cout) + (size_t)L * D_MODEL * D_MODEL, D_MODEL, D_MODEL, CM_PLAIN, 0);
    }
    for (int b = 0; b < N_B; ++b) {
        WCONV(P.nsa_w_qg + (size_t)b * D_MODEL * QGW, QGW, P.mix_norm + (size_t)(N_A + b) * D_MODEL, WS_B(w_qg) + (size_t)b * QGP * D_MODEL, QGP, D_MODEL, CM_HEADS, N_HEADS);
        WCONV(P.nsa_w_o + (size_t)b * HDM * D_MODEL, D_MODEL, nullptr, WS_B(w_o) + (size_t)b * D_MODEL * HDM, D_MODEL, HDM, CM_PLAIN, 0);
    }
    WCONV(P.w_kv, KVW, P.kv_norm, WS_B(w_kv), KVW, D_MODEL, CM_HEADS, 6 * N_KV);
    { KP; ITEM_LOOP((size_t)NPOS * 8) rope_item(i, WS_F(rope)); }
    { KP; const int lane_ = (int)lane_id_v(); WAVE_ITEMS(MT) hinit_row(it_, P.x_prompt, P.x_sample, WS_F(h), WS_B(hb), WS_F(rss), lane_); }
#endif
#ifndef CPU_TEST
    for (int e = 0; e < 2; ++e) WCONV(P.cmp_w1 + (size_t)e * L_CMP * HD * CMP_HID, CMP_HID, nullptr, WS_B(w1t) + (size_t)e * CMP_HID * L_CMP * HD, CMP_HID, L_CMP * HD, CM_PLAIN, 0);
    for (int e = 0; e < 2; ++e) WCONV(P.cmp_w2 + (size_t)e * CMP_HID * HD, HD, nullptr, WS_B(w2t) + (size_t)e * HD * CMP_HID, HD, CMP_HID, CM_PLAIN, 0);
    { KP; const int lane_ = (int)lane_id_v(); static_assert(N_KV == 4 && 2 * N_KV * 8 == 64, "acmp_sample_wave lane map"); WAVE_ITEMS(DEC_BATCH * NBC_PAST) acmp_sample_wave(it_, P.cache_kv, P.page_table, P.cmp_pe, WS_B(acs), lane_); }
#endif
    GRID_SYNC();
#ifndef CPU_TEST
    { KP; pg8::Gemm g{WS_B(acs), WS_B(w1t), 2 * RS_CMP, 2 * CMP_HID, L_CMP * HD}; pg8::CmpOrder So{2 * RS_CMP / 256, RS_CMP / 256, opaque_s((int)gridDim.x), opaque_s((int)blockIdx.x)};
      pg8::EpiGelu E{WS_B(hids)}; pg8::gemm_phase<pg8::EpiGelu, pg8::CmpOrder, true, true>(wave_id, RING, g, So, E); }
    GRID_SYNC();
    { KP; const int lane_ = (int)lane_id_v(); WAVE_ITEMS(2 * RS_CMP / 32) att::cmp_out_wave(it_, WS_B(hids), RS_CMP, NBC_PAST, BATCH, WS_B(w2t), P.k_norm, WS_F(kc), WS_F(vc), nullptr, nullptr, lane_); }
    GRID_SYNC();
#endif

#ifndef CPU_TEST
#define RESID_PH(Aptr, Btptr, Kk, KSn, v_out, coef_, last_) do { \
        { KP; const int lane_ = (int)lane_id_v(); WAVE_ITEMS((MS / 32) * (D_MODEL / 32) * (KSn)) att::skinny_task(it_, (Aptr) + (size_t)MP * (Kk), Btptr, D_MODEL, Kk, KSn, WS_F(part), lane_); } \
        { KP; pg8::Gemm g{Aptr, Btptr, MP, D_MODEL, Kk}; pg8::StaticOrder So; So.init(MP, D_MODEL, opaque_s((int)gridDim.x), opaque_s((int)blockIdx.x)); \
          pg8::EpiResid E{WS_F(h), WS_B(hb), WS_F(rss) + (size_t)(v_out) * MT, (last_) ? P.out + O_YP : nullptr, coef_}; pg8::gemm_phase<pg8::EpiResid, pg8::StaticOrder, true, true>(wave_id, RING, g, So, E); } \
        GRID_SYNC(); \
        { KP; const int lane_ = (int)lane_id_v(); WAVE_ITEMS(MS) att::resid_reduce_row(it_, WS_F(part), KSn, coef_, WS_F(h), WS_B(hb), WS_F(rss) + (size_t)(v_out) * MT, (last_) ? P.out + O_YP : nullptr, lane_); } \
        GRID_SYNC(); } while (0)
#define FFN_OPT(wi, wo, v_in, last) do { \
        { KP; pg8::Gemm g{WS_B(hb), WS_B(wi) + (size_t)layer * 2 * D_FF * D_MODEL, MT, 2 * D_FF, D_MODEL}; pg8::StaticOrder So; So.init(MT, 2 * D_FF, opaque_s((int)gridDim.x), opaque_s((int)blockIdx.x)); \
          pg8::EpiSwiglu E{WS_B(act), WS_F(rss) + (size_t)(v_in) * MT}; pg8::gemm_phase<pg8::EpiSwiglu, pg8::StaticOrder, true, true>(wave_id, RING, g, So, E); } \
        GRID_SYNC(); \
        RESID_PH(WS_B(act), WS_B(wo) + (size_t)layer * D_MODEL * D_FF, D_FF, 8, (v_in) + 1, 0.5f, last); } while (0)
#else
#define FFN_OPT(wi, wo, v_in, last) do { KP; \
        ITEM_LOOP((size_t)MT * D_FF) ref_ffn_in_item(i, WS_B(hb), WS_F(rss) + (size_t)(v_in) * MT, WS_B(wi) + (size_t)layer * 2 * D_FF * D_MODEL, WS_B(act)); \
        ITEM_LOOP(MT) ref_resid_row_item(i, WS_B(act), D_FF, WS_B(wo) + (size_t)layer * D_MODEL * D_FF, 0.5f, WS_F(h), WS_B(hb), WS_F(rss) + (size_t)((v_in) + 1) * MT, (last) ? P.out + O_YP : nullptr); } while (0)
#endif
#ifndef CPU_TEST
#define GEMM_PH(EpiT, Aptr, Btptr, Nn, Kk, ...) do { { KP; pg8::Gemm g{Aptr, Btptr, MT, Nn, Kk}; pg8::StaticOrder So; So.init(MT, Nn, opaque_s((int)gridDim.x), opaque_s((int)blockIdx.x)); \
        pg8::EpiT E{__VA_ARGS__}; pg8::gemm_phase<pg8::EpiT, pg8::StaticOrder, true, true>(wave_id, RING, g, So, E); } GRID_SYNC(); } while (0)
#endif
    for (int layer = 0; layer < DEPTH; ++layer) {
        FFN_OPT(w_ain, w_aout, 3 * layer, false);
        const int v1 = 3 * layer + 1;
        if (layer < N_A) {
#ifndef CPU_TEST
            { KP; const int lane_ = (int)lane_id_v(); WAVE_ITEMS((MS / 32) * (3 * D_MODEL / 32) * 2) att::skinny_task(it_, WS_B(hb) + (size_t)MP * D_MODEL, WS_B(w_cin) + (size_t)layer * 3 * D_MODEL * D_MODEL, 3 * D_MODEL, D_MODEL, 2, WS_F(part), lane_); }
            { KP; pg8::Gemm g{WS_B(hb), WS_B(w_cin) + (size_t)layer * 3 * D_MODEL * D_MODEL, MP, 3 * D_MODEL, D_MODEL}; pg8::StaticOrder So; So.init(MP, 3 * D_MODEL, opaque_s((int)gridDim.x), opaque_s((int)blockIdx.x));
              pg8::EpiConvIn E{WS_B(ub), WS_B(bb), WS_F(rss) + (size_t)v1 * MT, P.out, layer}; pg8::gemm_phase<pg8::EpiConvIn, pg8::StaticOrder, true, true>(wave_id, RING, g, So, E); }
            GRID_SYNC();
#else
            PH((size_t)MT * D_MODEL, ref_conv_in_item(i, WS_B(hb), WS_F(rss) + (size_t)v1 * MT, WS_B(w_cin) + (size_t)layer * 3 * D_MODEL * D_MODEL, WS_B(ub), WS_B(bb), P.out, layer));
#endif
#ifndef CPU_TEST
            { KP; ITEM_LOOP((size_t)MS * (D_MODEL / 8)) conv_thin_sample_item(i, WS_F(part), 2, WS_F(rss) + (size_t)v1 * MT, P.state_conv + (size_t)layer * DEC_BATCH * 2 * D_MODEL, P.conv_w + (size_t)layer * 3 * D_MODEL, WS_B(zb), P.out, layer); }
            PH((size_t)MP * (D_MODEL / 8), conv_thin_vec_item(i, WS_B(ub), WS_B(bb), P.state_conv + (size_t)layer * DEC_BATCH * 2 * D_MODEL, P.conv_w + (size_t)layer * 3 * D_MODEL, WS_B(zb)));
#else
            PH((size_t)MT * D_MODEL, conv_thin_item(i, WS_B(ub), WS_B(bb), P.state_conv + (size_t)layer * DEC_BATCH * 2 * D_MODEL, P.conv_w + (size_t)layer * 3 * D_MODEL, WS_B(zb)));
#endif
#ifndef CPU_TEST
            RESID_PH(WS_B(zb), WS_B(w_cout) + (size_t)layer * D_MODEL * D_MODEL, D_MODEL, 8, v1 + 1, 1.0f, false);
#else
            PH(MT, ref_resid_row_item(i, WS_B(zb), D_MODEL, WS_B(w_cout) + (size_t)layer * D_MODEL * D_MODEL, 1.0f, WS_F(h), WS_B(hb), WS_F(rss) + (size_t)(v1 + 1) * MT, nullptr));
#endif
        } else {
            const int b = layer - N_A;
#ifndef CPU_TEST
            GEMM_PH(EpiQG, WS_B(hb), WS_B(w_qg) + (size_t)b * QGP * D_MODEL, QGP, D_MODEL, WS_B(qnb), WS_B(qrb), WS_F(gates), WS_F(rss) + (size_t)v1 * MT, P.nsa_q_norm + (size_t)b * HD, WS_F(rope));
#else
            { KP; ITEM_LOOP((size_t)MT * N_HEADS) ref_qg_item(i, WS_B(hb), WS_F(rss) + (size_t)v1 * MT, WS_B(w_qg) + (size_t)b * QGP * D_MODEL, P.nsa_q_norm + (size_t)b * HD, WS_F(rope), WS_F(qn), WS_F(qr)); }
            PH((size_t)MT * 3 * N_HEADS, ref_gates_item(i, WS_B(hb), WS_F(rss) + (size_t)v1 * MT, WS_B(w_qg) + (size_t)b * QGP * D_MODEL, WS_F(gates)));
#endif
#ifndef CPU_TEST
            { KP; att::STensors TS{WS_B(qnb), WS_B(qrb), WS_F(kc), WS_F(vc), P.cache_kv, P.page_table, P.cache_win, P.out, WS_F(winrows), WS_F(gates), WS_B(ob)};
              int wv = wave_id; asm volatile("" : "+s"(wv));
              att::att_queue_sample(TS, (unsigned*)P.ws + 8192 + 128 * b, (att::ldsp)lds, wv, (int)lane_id_v()); }
            { KP; att::Tensors T{WS_B(qnb), WS_B(qrb), P.ws + WSM.ksel, P.ws + WSM.vsel, P.ws + WSM.kwin, P.ws + WSM.vwin, P.ws + WSM.kci, P.ws + WSM.vci, WS_F(gates), WS_B(ob)};
              int wv = wave_id; asm volatile("" : "+s"(wv));
              att::att_queue_prompt(T, (unsigned*)P.ws + 8192 + 128 * b + 64, (att::ldsp)lds, wv, (int)lane_id_v()); }
            GRID_SYNC();
#else
            PH((size_t)MT * N_HEADS, attn_cmp_item(i, WS_F(qn), WS_F(kc), WS_F(vc), WS_F(pbuf), WS_F(oc)));
            PH((size_t)MT * N_KV, topk_item(i, WS_F(pbuf), (int*)WS_F(sel), WS_F(scorebuf)));
            PH((size_t)MT * N_HEADS, attn_sel_item(i, KVSRC, WS_F(qr), (const int*)WS_F(sel), WS_F(os)));
            PH((size_t)MT * N_HEADS, attn_win_item(i, P.cache_win, WS_F(winrows), WS_F(qr), WS_F(gates), WS_F(oc), WS_F(os), WS_B(ob)));
#endif
#ifndef CPU_TEST
            RESID_PH(WS_B(ob), WS_B(w_o) + (size_t)b * D_MODEL * HDM, HDM, 8, v1 + 1, 1.0f, false);
#else
            PH(MT, ref_resid_row_item(i, WS_B(ob), HDM, WS_B(w_o) + (size_t)b * D_MODEL * HDM, 1.0f, WS_F(h), WS_B(hb), WS_F(rss) + (size_t)(v1 + 1) * MT, nullptr));
#endif
        }
        FFN_OPT(w_bin, w_bout, 3 * layer + 2, layer == DEPTH - 1);
        if (layer == N_A - 1) {
            const int v3 = 3 * layer + 3;
#ifndef CPU_TEST
            { KP; pg8::Gemm g{WS_B(hb), WS_B(w_kv), MT, KVW, D_MODEL}; pg8::StaticOrder So; So.init(MT, KVW, opaque_s((int)gridDim.x), opaque_s((int)blockIdx.x));
              pg8::EpiKV E{P.out, WS_F(winrows), WS_F(rss) + (size_t)v3 * MT, P.k_norm, WS_F(rope), P.ws + WSM.ksel, P.ws + WSM.vsel, P.ws + WSM.kwin, P.ws + WSM.vwin, WS_B(acp), P.cmp_pe}; pg8::gemm_phase<pg8::EpiKV, pg8::StaticOrder, true, true>(wave_id, RING, g, So, E); }
#else
            { KP; ITEM_LOOP((size_t)MT * 6 * N_KV) ref_kv_item(i, WS_B(hb), WS_F(rss) + (size_t)v3 * MT, WS_B(w_kv), P.k_norm, WS_F(rope), P.out, WS_F(winrows)); }
#endif
            PH((size_t)DEC_BATCH * (WINDOW - DEC_SEQ) * 2 * N_KV * HD, wincopy_item(i, P.cache_win, P.out));
#ifdef CPU_TEST
            PH((size_t)NSEQ * NBC_MAX * 2 * N_KV * CMP_HID, cmp_hid_item(i, KVSRC, P.cmp_pe, P.cmp_w1, WS_F(hid)));
            PH((size_t)NSEQ * NBC_MAX * 2 * N_KV, cmp_out_item(i, WS_F(hid), P.cmp_w2, P.k_norm, WS_F(kc), WS_F(vc)));
#else
            { KP; pg8::Gemm g{WS_B(acp), WS_B(w1t), 2 * RP_CMP, 2 * CMP_HID, L_CMP * HD}; pg8::CmpOrder So{2 * RP_CMP / 256, RP_CMP / 256, opaque_s((int)gridDim.x), opaque_s((int)blockIdx.x)};
              pg8::EpiGelu E{WS_B(hidp)}; pg8::gemm_phase<pg8::EpiGelu, pg8::CmpOrder, true, true>(wave_id, RING, g, So, E); }
            GRID_SYNC();
            { KP; const int lane_ = (int)lane_id_v(); WAVE_ITEMS(2 * RP_CMP / 32) att::cmp_out_wave(it_, WS_B(hidp), RP_CMP, NBC_P, 0, WS_B(w2t), P.k_norm, WS_F(kc), WS_F(vc), P.ws + WSM.kci, P.ws + WSM.vci, lane_); }
            GRID_SYNC();
#endif
        }
    }
}

extern "C" void kernel_launch(void* const* d_in, const int* in_sizes, int n_in, void* d_out, int out_size, void* d_ws, size_t ws_size, hipStream_t stream) {
    Params P{};
    P.x_prompt = (const float*)d_in[0]; P.x_sample = (const float*)d_in[1]; P.cache_kv = (const float*)d_in[2]; P.cache_win = (const float*)d_in[3];
    P.state_conv = (const float*)d_in[4]; P.page_table = (const int*)d_in[5]; P.ffn_a_norm = (const float*)d_in[6]; P.ffn_a_w_in = (const float*)d_in[7];
    P.ffn_a_w_out = (const float*)d_in[8]; P.mix_norm = (const float*)d_in[9]; P.ffn_b_norm = (const float*)d_in[10]; P.ffn_b_w_in = (const float*)d_in[11];
    P.ffn_b_w_out = (const float*)d_in[12]; P.conv_w_in = (const float*)d_in[13]; P.conv_w = (const float*)d_in[14]; P.conv_w_out = (const float*)d_in[15];
    P.kv_norm = (const float*)d_in[16]; P.w_kv = (const float*)d_in[17]; P.k_norm = (const float*)d_in[18]; P.cmp_pe = (const float*)d_in[19];
    P.cmp_w1 = (const float*)d_in[20]; P.cmp_w2 = (const float*)d_in[21]; P.nsa_w_qg = (const float*)d_in[22]; P.nsa_q_norm = (const float*)d_in[23];
    P.nsa_w_o = (const float*)d_in[24];
    P.out = (float*)d_out; P.ws = (unsigned char*)d_ws;
#ifndef CPU_TEST
    static int grid = 0;
    if (grid == 0) {
        int dev = 0, cus = 0, per_cu = 0;
        hipGetDevice(&dev); hipDeviceGetAttribute(&cus, hipDeviceAttributeMultiprocessorCount, dev);
        hipFuncSetAttribute((const void*)mega, hipFuncAttributeMaxDynamicSharedMemorySize, LDS_BYTES);
        hipOccupancyMaxActiveBlocksPerMultiprocessor(&per_cu, (const void*)mega, NTHREADS, LDS_BYTES);
        (void)hipGetLastError();
        grid = cus;
    }
    hipMemsetAsync(d_ws, 0, WS_ZERO_BYTES, stream);
    hipLaunchKernelGGL(mega, dim3(grid), dim3(NTHREADS), LDS_BYTES, stream, P);
#else
    memset(d_ws, 0, WS_ZERO_BYTES);
    mega(P);
#endif
}
```

```cpp
#ifdef CPU_TEST
#include "shim.h"
#else
#include <hip/hip_runtime.h>
#endif
#include <cstdint>
#include <cstddef>
#include <cmath>
#include <cstring>
typedef unsigned short bf16_t;
#ifndef CPU_TEST
#define HOSTDEV __host__ __device__
#else
#define HOSTDEV
#endif
HOSTDEV inline bf16_t f2bf(float f) { unsigned u; memcpy(&u, &f, 4); u = (u + 0x7fffu + ((u >> 16) & 1u)) >> 16; return (bf16_t)u; }
HOSTDEV inline float bf2f(bf16_t b) { unsigned u = (unsigned)b << 16; float f; memcpy(&f, &u, 4); return f; }

#ifdef CFG_SMALL
constexpr int D_MODEL = 256, BATCH = 1, SEQ = 2048, DEPTH = 4, DEC_BATCH = 2, DEC_SEQ = 8, PAST_LEN = 2048, PAGE_SIZE = 128, D_FF = 256, N_HEADS = 4, N_KV = 2;
#else
constexpr int D_MODEL = 1024, BATCH = 4, SEQ = 4096, DEPTH = 4, DEC_BATCH = 32, DEC_SEQ = 8, PAST_LEN = 8192, PAGE_SIZE = 128, D_FF = 2816, N_HEADS = 16, N_KV = 4;
#endif
constexpr int N_A = DEPTH / 2, N_B = DEPTH - N_A, HD = 64, HPG = N_HEADS / N_KV, L_CMP = 32, L_SEL = 64, N_SEL = 16, WINDOW = 512, CMP_HID = 4 * HD;
constexpr int MP = BATCH * SEQ, MS = DEC_BATCH * DEC_SEQ, MT = MP + MS, NSEQ = BATCH + DEC_BATCH;
constexpr int N_PAGES = PAST_LEN / PAGE_SIZE;
constexpr int KVW = 6 * N_KV * HD;
constexpr int QGW = N_HEADS * HD + 3 * N_HEADS;
constexpr int HDM = N_HEADS * HD;
constexpr int TPAD_S = ((PAST_LEN + DEC_SEQ + L_SEL - 1) / L_SEL) * L_SEL;
constexpr int NBC_P = SEQ / L_CMP, NBC_S = TPAD_S / L_CMP, NBC_MAX = NBC_S > NBC_P ? NBC_S : NBC_P;
constexpr int NBS_P = SEQ / L_SEL, NBS_S = TPAD_S / L_SEL, NBS_MAX = NBS_S > NBS_P ? NBS_S : NBS_P;
constexpr float EPS = 1e-6f, NEGF = -1e30f, TINYF = 1e-30f, FORCE_SCORE = 1e4f;
__device__ static const float INV_FREQ[8] = {1.0f, 0.1939227432012558f, 0.03760603070259094f, 0.007292664609849453f, 0.0014142135623842478f, 0.00027424818836152554f, 5.3182957344688475e-05f, 1.0313385246263351e-05f};

constexpr size_t O_YP = 0, O_YS = O_YP + (size_t)MP * D_MODEL, O_KVP = O_YS + (size_t)MS * D_MODEL, O_KVS = O_KVP + (size_t)MP * 4 * N_KV * HD,
                 O_WP = O_KVS + (size_t)MS * 4 * N_KV * HD, O_WS = O_WP + (size_t)BATCH * WINDOW * 2 * N_KV * HD, O_CP = O_WS + (size_t)DEC_BATCH * WINDOW * 2 * N_KV * HD,
                 O_CS = O_CP + (size_t)N_A * BATCH * 2 * D_MODEL, O_END = O_CS + (size_t)N_A * DEC_BATCH * 2 * D_MODEL;

struct RowInfo { int seq, t, pos; };
__device__ __host__ inline RowInfo row_info(int m) {
    RowInfo r;
    if (m < MP) { r.seq = m / SEQ; r.t = m % SEQ; r.pos = r.t; }
    else { const int q = m - MP; r.seq = BATCH + q / DEC_SEQ; r.t = q % DEC_SEQ; r.pos = PAST_LEN + r.t; }
    return r;
}
__device__ __host__ inline int seq_row0(int seq) { return seq < BATCH ? seq * SEQ : MP + (seq - BATCH) * DEC_SEQ; }
__device__ __host__ inline int seq_pos0(int seq) { return seq < BATCH ? 0 : PAST_LEN; }
__device__ __host__ inline int seq_len(int seq) { return seq < BATCH ? SEQ : DEC_SEQ; }

__device__ inline void copy_item(size_t i_, const float* a, float* b, size_t n) {
    const size_t i = i_;
    if (i < n) b[i] = a[i];
}
__device__ inline void rmsnorm_item(size_t i_, const float* x, const float* g, float* y, int rows, int d) {
    const int m = (int)i_;
    if (m >= rows) return;
    const float* xr = x + (size_t)m * d; float s = 0.f;
    for (int i = 0; i < d; ++i) s += xr[i] * xr[i];
    const float r = 1.0f / sqrtf(s / d + EPS);
    float* yr = y + (size_t)m * d;
    for (int i = 0; i < d; ++i) yr[i] = xr[i] * r * g[i];
}
__device__ inline void gemm_item(size_t i_, const float* A, int lda, const float* W, float* C, int M, int N, int K) {
    const int nbx = (N + 63) / 64; const int vb = (int)(i_ / 256), t_ = (int)(i_ % 256), tx = t_ % 16, ty = t_ / 16;
    const int c0 = (vb % nbx) * 64 + tx * 4, r0 = (vb / nbx) * 64 + ty * 4;
    if (c0 >= N || r0 >= M) return;
    float acc[4][4];
    for (int i = 0; i < 4; ++i) for (int j = 0; j < 4; ++j) acc[i][j] = 0.f;
    const int nr = (M - r0) < 4 ? (M - r0) : 4;
    for (int k = 0; k < K; k += 4) {
        float a[4][4], w[4][4];
        for (int i = 0; i < 4; ++i) for (int kk = 0; kk < 4; ++kk) a[i][kk] = (i < nr) ? A[(size_t)(r0 + i) * lda + k + kk] : 0.f;
        for (int kk = 0; kk < 4; ++kk) for (int j = 0; j < 4; ++j) w[kk][j] = W[(size_t)(k + kk) * N + c0 + j];
        for (int i = 0; i < 4; ++i) for (int kk = 0; kk < 4; ++kk) for (int j = 0; j < 4; ++j) acc[i][j] += a[i][kk] * w[kk][j];
    }
    for (int i = 0; i < nr; ++i) for (int j = 0; j < 4; ++j) C[(size_t)(r0 + i) * N + c0 + j] = acc[i][j];
}
__device__ inline void swiglu_item(size_t i_, const float* t1, float* act, int rows, int dff) {
    const size_t i = i_;
    if (i >= (size_t)rows * dff) return;
    const int m = (int)(i / dff), j = (int)(i % dff);
    const float g = t1[(size_t)m * 2 * dff + j], u = t1[(size_t)m * 2 * dff + dff + j];
    act[i] = g / (1.0f + expf(-g)) * u;
}
__device__ inline void axpy_item(size_t i_, float* h, const float* y, float coef, size_t n) {
    const size_t i = i_;
    if (i < n) h[i] += coef * y[i];
}
__device__ inline void conv_item(size_t i_, const float* t1, const float* state  , const float* wc  , float* z, float* out, int layer) {
    const size_t i = i_;
    if (i >= (size_t)MT * D_MODEL) return;
    const int m = (int)(i / D_MODEL), ch = (int)(i % D_MODEL);
    const RowInfo ri = row_info(m);
    const float* r = t1 + (size_t)m * 3 * D_MODEL;
    const float b = r[ch], u0 = r[D_MODEL + ch] * r[2 * D_MODEL + ch];
    float u1, u2;
    if (ri.t >= 1) { const float* p = r - 3 * D_MODEL; u1 = p[D_MODEL + ch] * p[2 * D_MODEL + ch]; }
    else u1 = (ri.seq < BATCH) ? 0.f : state[((size_t)(ri.seq - BATCH) * 2 + 1) * D_MODEL + ch];
    if (ri.t >= 2) { const float* p = r - 6 * D_MODEL; u2 = p[D_MODEL + ch] * p[2 * D_MODEL + ch]; }
    else if (ri.seq < BATCH) u2 = 0.f;
    else u2 = (ri.t == 1) ? state[((size_t)(ri.seq - BATCH) * 2 + 1) * D_MODEL + ch] : state[((size_t)(ri.seq - BATCH) * 2 + 0) * D_MODEL + ch];
    z[i] = b * (wc[ch] * u2 + wc[D_MODEL + ch] * u1 + wc[2 * D_MODEL + ch] * u0);
    const int L = seq_len(ri.seq);
    if (ri.t >= L - 2) {
        const int j = ri.t - (L - 2);
        if (ri.seq < BATCH) out[O_CP + (((size_t)layer * BATCH + ri.seq) * 2 + j) * D_MODEL + ch] = u0;
        else out[O_CS + (((size_t)layer * DEC_BATCH + (ri.seq - BATCH)) * 2 + j) * D_MODEL + ch] = u0;
    }
}
__device__ inline void head_norm(float* v, const float* g) {
    float s = 0.f; for (int d = 0; d < HD; ++d) s += v[d] * v[d];
    const float r = 1.0f / sqrtf(s / HD + EPS);
    for (int d = 0; d < HD; ++d) v[d] = v[d] * r * g[d];
}
__device__ inline void rope_cs(float ang, float& c, float& s) {
    const double r = (double)ang * 0.15915494309189535; const float fr = (float)(r - rint(r));
#ifdef CPU_TEST
    c = (float)cos(6.283185307179586 * (double)fr); s = (float)sin(6.283185307179586 * (double)fr);
#else
    c = __builtin_amdgcn_cosf(fr); s = __builtin_amdgcn_sinf(fr);
#endif
}
__device__ inline void head_rope(float* v, int pos) {
    for (int i = 0; i < 8; ++i) {
        const float ang = (float)pos * INV_FREQ[i]; float c, s; rope_cs(ang, c, s);
        const float x1 = v[i], x2 = v[8 + i];
        v[i] = x1 * c - x2 * s; v[8 + i] = x2 * c + x1 * s;
    }
}
__device__ inline void kvprep_item(size_t i_, const float* p, const float* k_norm  , float* out, float* winrows) {
    const int i = (int)i_;
    if (i >= MT * 6 * N_KV) return;
    const int m = i / (6 * N_KV), e = (i / N_KV) % 6, g = i % N_KV;
    const RowInfo ri = row_info(m);
    float v[HD];
    for (int d = 0; d < HD; ++d) v[d] = p[(size_t)m * KVW + (e * N_KV + g) * HD + d];
    if (e == 2) { head_norm(v, k_norm + HD); head_rope(v, ri.pos); }
    if (e == 4) { head_norm(v, k_norm + 2 * HD); head_rope(v, ri.pos); }
    if (e < 4) {
        float* o = (ri.seq < BATCH) ? out + O_KVP + (((size_t)m * 4 + e) * N_KV + g) * HD : out + O_KVS + (((size_t)(m - MP) * 4 + e) * N_KV + g) * HD;
        for (int d = 0; d < HD; ++d) o[d] = v[d];
    } else {
        const int we = e - 4;
        float* w = winrows + (((size_t)m * 2 + we) * N_KV + g) * HD;
        for (int d = 0; d < HD; ++d) w[d] = v[d];
        if (ri.seq < BATCH) { if (ri.t >= SEQ - WINDOW) { float* o = out + O_WP + ((((size_t)ri.seq * WINDOW + (ri.t - (SEQ - WINDOW))) * 2 + we) * N_KV + g) * HD; for (int d = 0; d < HD; ++d) o[d] = v[d]; } }
        else { float* o = out + O_WS + ((((size_t)(ri.seq - BATCH) * WINDOW + (WINDOW - DEC_SEQ + ri.t)) * 2 + we) * N_KV + g) * HD; for (int d = 0; d < HD; ++d) o[d] = v[d]; }
    }
}
__device__ inline void wincopy_item(size_t i_, const float* cache_win, float* out) {
    const size_t i = i_;
    const size_t per = (size_t)(WINDOW - DEC_SEQ) * 2 * N_KV * HD;
    if (i >= (size_t)DEC_BATCH * per) return;
    const size_t b = i / per, r = i % per;
    out[O_WS + b * WINDOW * 2 * N_KV * HD + r] = cache_win[b * WINDOW * 2 * N_KV * HD + (size_t)DEC_SEQ * 2 * N_KV * HD + r];
}
struct KvSrc { const float* cache_kv; const int* page_table; const float* out; };
__device__ inline const float* kv_full_ptr(const KvSrc& S, int seq, int tok, int e, int g) {
    if (seq < BATCH) return S.out + O_KVP + ((((size_t)seq * SEQ + tok) * 4 + e) * N_KV + g) * HD;
    const int b = seq - BATCH;
    if (tok < PAST_LEN) { const int page = S.page_table[b * N_PAGES + tok / PAGE_SIZE]; return S.cache_kv + ((((size_t)page * PAGE_SIZE + tok % PAGE_SIZE) * 4 + e) * N_KV + g) * HD; }
    if (tok < PAST_LEN + DEC_SEQ) return S.out + O_KVS + ((((size_t)b * DEC_SEQ + (tok - PAST_LEN)) * 4 + e) * N_KV + g) * HD;
    return nullptr;
}
__device__ inline int seq_nbc(int seq) { return seq < BATCH ? NBC_P : NBC_S; }
__device__ inline void cmp_hid_item(size_t i_, KvSrc S, const float* pe  , const float* w1  , float* hid) {
    const size_t i = i_;
    if (i >= (size_t)NSEQ * NBC_MAX * 2 * N_KV * CMP_HID) return;
    const int f = (int)(i % CMP_HID), g = (int)((i / CMP_HID) % N_KV), e = (int)((i / ((size_t)CMP_HID * N_KV)) % 2), c = (int)((i / ((size_t)CMP_HID * N_KV * 2)) % NBC_MAX), seq = (int)(i / ((size_t)CMP_HID * N_KV * 2 * NBC_MAX));
    if (c >= seq_nbc(seq)) return;
    float s = 0.f;
    for (int l = 0; l < L_CMP; ++l) {
        const float* r = kv_full_ptr(S, seq, c * L_CMP + l, e, g);
        const float* w = w1 + (((size_t)e * L_CMP + l) * HD) * CMP_HID + f; const float* pp = pe + ((size_t)e * L_CMP + l) * HD;
        for (int d = 0; d < HD; ++d) s += ((r ? r[d] : 0.f) + pp[d]) * w[(size_t)d * CMP_HID];
    }
    const float x = s; const float t = tanhf(0.7978845608028654f * (x + 0.044715f * x * x * x));
    hid[i] = 0.5f * x * (1.0f + t);
}
__device__ inline void cmp_out_item(size_t i_, const float* hid, const float* w2  , const float* k_norm0, float* kc, float* vc) {
    const int i = (int)i_;
    if (i >= NSEQ * NBC_MAX * 2 * N_KV) return;
    const int g = i % N_KV, e = (i / N_KV) % 2, c = (i / (2 * N_KV)) % NBC_MAX, seq = i / (2 * N_KV * NBC_MAX);
    if (c >= seq_nbc(seq)) return;
    const float* hr = hid + (size_t)i * CMP_HID;
    float v[HD];
    for (int d = 0; d < HD; ++d) { float s = 0.f; for (int f = 0; f < CMP_HID; ++f) s += hr[f] * w2[((size_t)e * CMP_HID + f) * HD + d]; v[d] = s; }
    if (e == 0) head_norm(v, k_norm0);
    float* o = (e == 0 ? kc : vc) + (((size_t)seq * NBC_MAX + c) * N_KV + g) * HD;
    for (int d = 0; d < HD; ++d) o[d] = v[d];
}
__device__ inline void qprep_item(size_t i_, const float* qg, const float* q_norm, float* qn, float* qr, float* gates) {
    const int i = (int)i_;
    if (i >= MT * N_HEADS) return;
    const int m = i / N_HEADS, hh = i % N_HEADS;
    const RowInfo ri = row_info(m);
    float v[HD];
    for (int d = 0; d < HD; ++d) v[d] = qg[(size_t)m * QGW + hh * HD + d];
    head_norm(v, q_norm);
    for (int d = 0; d < HD; ++d) qn[(size_t)m * HDM + hh * HD + d] = v[d];
    head_rope(v, ri.pos);
    for (int d = 0; d < HD; ++d) qr[(size_t)m * HDM + hh * HD + d] = v[d];
    for (int j = 0; j < 3; ++j) { const float x = qg[(size_t)m * QGW + HDM + hh * 3 + j]; gates[(size_t)m * 3 * N_HEADS + hh * 3 + j] = 1.0f / (1.0f + expf(-x)); }
}
__device__ inline void attn_cmp_item(size_t i_, const float* qn, const float* kc, const float* vc, float* pbuf, float* oc) {
    const int i = (int)i_;
    if (i >= MT * N_HEADS) return;
    const int m = i / N_HEADS, hh = i % N_HEADS, g = hh / HPG;
    const RowInfo ri = row_info(m);
    const int nbc = seq_nbc(ri.seq);
    const float* q = qn + (size_t)m * HDM + hh * HD;
    float* p = pbuf + (size_t)i * NBC_MAX;
    float mx = NEGF;
    for (int c = 0; c < nbc; ++c) {
        const bool vis = (c + 1) * L_CMP - 1 <= ri.pos;
        float s = 0.f; const float* k = kc + (((size_t)ri.seq * NBC_MAX + c) * N_KV + g) * HD;
        for (int d = 0; d < HD; ++d) s += q[d] * k[d];
        s *= 0.125f; p[c] = s; if (vis && s > mx) mx = s;
    }
    float sum = 0.f;
    for (int c = 0; c < nbc; ++c) { const bool vis = (c + 1) * L_CMP - 1 <= ri.pos; const float e = vis ? expf(p[c] - mx) : 0.f; p[c] = e; sum += e; }
    const float inv = 1.0f / fmaxf(sum, TINYF);
    float o[HD]; for (int d = 0; d < HD; ++d) o[d] = 0.f;
    for (int c = 0; c < nbc; ++c) { p[c] *= inv; if (p[c] != 0.f) { const float* v = vc + (((size_t)ri.seq * NBC_MAX + c) * N_KV + g) * HD; for (int d = 0; d < HD; ++d) o[d] += p[c] * v[d]; } }
    for (int d = 0; d < HD; ++d) oc[(size_t)m * HDM + hh * HD + d] = o[d];
}
__device__ inline void topk_item(size_t i_, const float* pbuf, int* sel, float* scorebuf  ) {
    const int i = (int)i_;
    if (i >= MT * N_KV) return;
    const int m = i / N_KV, g = i % N_KV;
    const RowInfo ri = row_info(m);
    const int nbs = ri.seq < BATCH ? NBS_P : NBS_S, cur = ri.pos / L_SEL;
    float* score = scorebuf + (size_t)i * NBS_MAX;
    for (int b = 0; b < nbs; ++b) {
        float imp = 0.f;
        for (int h = 0; h < HPG; ++h) { const float* p = pbuf + ((size_t)m * N_HEADS + g * HPG + h) * NBC_MAX; imp += p[2 * b]; }
        float imp2 = 0.f;
        for (int h = 0; h < HPG; ++h) { const float* p = pbuf + ((size_t)m * N_HEADS + g * HPG + h) * NBC_MAX; imp2 += p[2 * b + 1]; }
        const bool forced = (b == 0) || (b == cur) || (b == cur - 1), valid = b * L_SEL <= ri.pos;
        score[b] = valid ? (forced ? FORCE_SCORE : imp + imp2) : NEGF;
    }
    const int nsel = N_SEL < nbs ? N_SEL : nbs;
    for (int j = 0; j < N_SEL; ++j) {
        if (j >= nsel) { sel[(size_t)i * N_SEL + j] = -1; continue; }
        int best = -1; float bv = 0.f;
        for (int b = 0; b < nbs; ++b) if (score[b] > -3e38f && (best < 0 || score[b] > bv)) { best = b; bv = score[b]; }
        sel[(size_t)i * N_SEL + j] = best; score[best] = -3.4e38f;
    }
}
__device__ inline void attn_sel_item(size_t i_, KvSrc S, const float* qr, const int* sel, float* os) {
    const int i = (int)i_;
    if (i >= MT * N_HEADS) return;
    const int m = i / N_HEADS, hh = i % N_HEADS, g = hh / HPG;
    const RowInfo ri = row_info(m);
    const float* q = qr + (size_t)m * HDM + hh * HD;
    const int* sl = sel + ((size_t)m * N_KV + g) * N_SEL;
    float mx = NEGF;
    for (int j = 0; j < N_SEL; ++j) { const int b = sl[j]; if (b < 0) continue;
        for (int t = 0; t < L_SEL; ++t) { const int tok = b * L_SEL + t; if (tok > ri.pos) continue;
            const float* k = kv_full_ptr(S, ri.seq, tok, 2, g); float s = 0.f; if (k) for (int d = 0; d < HD; ++d) s += q[d] * k[d];
            s *= 0.125f; if (s > mx) mx = s; } }
    float sum = 0.f, o[HD]; for (int d = 0; d < HD; ++d) o[d] = 0.f;
    for (int j = 0; j < N_SEL; ++j) { const int b = sl[j]; if (b < 0) continue;
        for (int t = 0; t < L_SEL; ++t) { const int tok = b * L_SEL + t; if (tok > ri.pos) continue;
            const float* k = kv_full_ptr(S, ri.seq, tok, 2, g); float s = 0.f; if (k) for (int d = 0; d < HD; ++d) s += q[d] * k[d];
            const float e = expf(s * 0.125f - mx); sum += e;
            const float* v = kv_full_ptr(S, ri.seq, tok, 3, g); if (v) for (int d = 0; d < HD; ++d) o[d] += e * v[d]; } }
    const float inv = 1.0f / fmaxf(sum, TINYF);
    for (int d = 0; d < HD; ++d) os[(size_t)m * HDM + hh * HD + d] = o[d] * inv;
}
__device__ inline const float* win_ptr(const float* cache_win, const float* winrows, int seq, int kp) {
    if (seq < BATCH) return kp >= 0 ? winrows + (size_t)(seq * SEQ + kp) * 2 * N_KV * HD : nullptr;
    const int b = seq - BATCH;
    if (kp >= PAST_LEN) return winrows + (size_t)(MP + b * DEC_SEQ + (kp - PAST_LEN)) * 2 * N_KV * HD;
    const int j = kp - (PAST_LEN - WINDOW);
    return j >= 0 ? cache_win + ((size_t)b * WINDOW + j) * 2 * N_KV * HD : nullptr;
}
__device__ inline void attn_win_item(size_t i_, const float* cache_win, const float* winrows, const float* qr, const float* gates, const float* oc, const float* os, bf16_t* o_out) {
    const int i = (int)i_;
    if (i >= MT * N_HEADS) return;
    const int m = i / N_HEADS, hh = i % N_HEADS, g = hh / HPG;
    const RowInfo ri = row_info(m);
    const float* q = qr + (size_t)m * HDM + hh * HD;
    float mx = NEGF;
    for (int kp = ri.pos - WINDOW; kp <= ri.pos; ++kp) { const float* r = win_ptr(cache_win, winrows, ri.seq, kp); if (!r) continue;
        const float* k = r + (0 * N_KV + g) * HD; float s = 0.f; for (int d = 0; d < HD; ++d) s += q[d] * k[d]; s *= 0.125f; if (s > mx) mx = s; }
    float sum = 0.f, o[HD]; for (int d = 0; d < HD; ++d) o[d] = 0.f;
    for (int kp = ri.pos - WINDOW; kp <= ri.pos; ++kp) { const float* r = win_ptr(cache_win, winrows, ri.seq, kp); if (!r) continue;
        const float* k = r + (0 * N_KV + g) * HD; float s = 0.f; for (int d = 0; d < HD; ++d) s += q[d] * k[d];
        const float e = expf(s * 0.125f - mx); sum += e; const float* v = r + (1 * N_KV + g) * HD; for (int d = 0; d < HD; ++d) o[d] += e * v[d]; }
    const float inv = 1.0f / fmaxf(sum, TINYF);
    const float* gt = gates + (size_t)m * 3 * N_HEADS + hh * 3;
    for (int d = 0; d < HD; ++d) { const size_t x = (size_t)m * HDM + hh * HD + d; o_out[x] = f2bf(gt[0] * oc[x] + gt[1] * os[x] + gt[2] * o[d] * inv); }
}


#ifndef CPU_TEST
__device__ __forceinline__ unsigned lane_id_v() { unsigned l; asm volatile("v_mbcnt_lo_u32_b32 %0, -1, 0\n\tv_mbcnt_hi_u32_b32 %0, -1, %0" : "=v"(l)); return l; }
#endif
#ifndef CPU_TEST
constexpr float RSS_SCALE = 1024.0f;
__device__ __forceinline__ unsigned rss_enc(float s) { return (unsigned)(s * RSS_SCALE + 0.5f); }
__device__ __forceinline__ float rss_dec(float rawbits) { return (float)__float_as_uint(rawbits) * (1.0f / RSS_SCALE); }
#endif
constexpr int NTHREADS = 512;
__host__ __device__ inline bf16_t f2bf_(float f) { unsigned u; memcpy(&u, &f, 4); u = (u + 0x7fffu + ((u >> 16) & 1u)) >> 16; return (bf16_t)u; }
__host__ __device__ inline float bf2f_(bf16_t b) { unsigned u = (unsigned)b << 16; float f; memcpy(&f, &u, 4); return f; }
constexpr int NRSS = 3 * DEPTH + 1;
constexpr int NPOS = SEQ + DEC_SEQ;
constexpr int QGP = ((QGW + 255) / 256) * 256;
__host__ __device__ inline int pos_index(int pos) { return pos < SEQ ? pos : SEQ + (pos - PAST_LEN); }

constexpr size_t IMG_SEQ_BYTES = (size_t)BATCH * N_KV * (SEQ / 64) * 8192, IMG_CMP_BYTES = (size_t)BATCH * N_KV * (NBC_P / 64 > 0 ? NBC_P / 64 : 1) * 8192;
struct WsMap {
    size_t ctl, rss, rope, h, hb, act, xn, t2, actf, ub, bb, zb, t1, qn, qr, gates, ob, winrows, hid, kc, vc, pbuf, oc, os, sel, scorebuf,
           w_ain, w_aout, w_bin, w_bout, w_cin, w_cout, w_qg, w_o, w_kv, qnb, qrb, ksel, vsel, kwin, vwin, kci, vci, acs, hids, acp, hidp, w1t, w2t, part, end;
};
constexpr size_t al256(size_t b) { return (b + 255) / 256 * 256; }
constexpr size_t smax(size_t a, size_t b) { return a > b ? a : b; }
constexpr WsMap make_ws_map() {
    WsMap w{}; size_t off = 0;
#define TAKE(f, bytes) w.f = off; off += al256(bytes)
    TAKE(ctl, 65536); TAKE(rss, (size_t)NRSS * MT * 4);
    TAKE(rope, (size_t)NPOS * 16 * 4);
    TAKE(h, (size_t)MT * D_MODEL * 4); TAKE(hb, (size_t)MT * D_MODEL * 2); TAKE(act, (size_t)MT * D_FF * 2);
    TAKE(xn, (size_t)MT * D_MODEL * 4); TAKE(t2, (size_t)MT * D_MODEL * 4); TAKE(actf, (size_t)MT * D_MODEL * 4);
    TAKE(ub, (size_t)MT * D_MODEL * 2); TAKE(bb, (size_t)MT * D_MODEL * 2); TAKE(zb, (size_t)MT * D_MODEL * 2);
    TAKE(t1, smax((size_t)MT * 3 * D_MODEL * 4, (size_t)MT * KVW * 4));
    TAKE(qn, (size_t)MT * HDM * 4); TAKE(qr, (size_t)MT * HDM * 4); TAKE(gates, (size_t)MT * 3 * N_HEADS * 4); TAKE(ob, (size_t)MT * HDM * 2);
    TAKE(winrows, (size_t)MT * 2 * N_KV * HD * 4); TAKE(hid, (size_t)NSEQ * NBC_MAX * 2 * N_KV * CMP_HID * 4);
    TAKE(kc, (size_t)NSEQ * NBC_MAX * N_KV * HD * 4); TAKE(vc, (size_t)NSEQ * NBC_MAX * N_KV * HD * 4);
    TAKE(pbuf, (size_t)MT * N_HEADS * NBC_MAX * 4); TAKE(oc, (size_t)MT * HDM * 4); TAKE(os, (size_t)MT * HDM * 4);
    TAKE(sel, (size_t)MT * N_KV * N_SEL * 4); TAKE(scorebuf, (size_t)MT * N_KV * NBS_MAX * 4);
    TAKE(w_ain, (size_t)DEPTH * 2 * D_FF * D_MODEL * 2); TAKE(w_aout, (size_t)DEPTH * D_MODEL * D_FF * 2);
    TAKE(w_bin, (size_t)DEPTH * 2 * D_FF * D_MODEL * 2); TAKE(w_bout, (size_t)DEPTH * D_MODEL * D_FF * 2);
    TAKE(w_cin, (size_t)N_A * 3 * D_MODEL * D_MODEL * 2); TAKE(w_cout, (size_t)N_A * D_MODEL * D_MODEL * 2);
    TAKE(w_qg, (size_t)N_B * QGP * D_MODEL * 2); TAKE(w_o, (size_t)N_B * D_MODEL * HDM * 2); TAKE(w_kv, (size_t)KVW * D_MODEL * 2);
    TAKE(qnb, (size_t)MT * HDM * 2); TAKE(qrb, (size_t)MT * HDM * 2); TAKE(ksel, IMG_SEQ_BYTES); TAKE(vsel, IMG_SEQ_BYTES); TAKE(kwin, IMG_SEQ_BYTES); TAKE(vwin, IMG_SEQ_BYTES); TAKE(kci, IMG_CMP_BYTES); TAKE(vci, IMG_CMP_BYTES);
    TAKE(acs, (size_t)2 * DEC_BATCH * (PAST_LEN / L_CMP) * N_KV * L_CMP * HD * 2); TAKE(hids, (size_t)2 * DEC_BATCH * (PAST_LEN / L_CMP) * N_KV * CMP_HID * 2);
    TAKE(acp, (size_t)2 * BATCH * NBC_P * N_KV * L_CMP * HD * 2); TAKE(hidp, (size_t)2 * BATCH * NBC_P * N_KV * CMP_HID * 2); TAKE(w1t, (size_t)2 * CMP_HID * L_CMP * HD * 2); TAKE(w2t, (size_t)2 * HD * CMP_HID * 2); TAKE(part, (size_t)8 * MS * 3 * D_MODEL * 4);
#undef TAKE
    w.end = off; return w;
}
constexpr WsMap WSM = make_ws_map();
constexpr size_t WS_ZERO_BYTES = 65536 + (((size_t)NRSS * MT * 4 + 255) / 256 * 256);

enum { CM_PLAIN = 0, CM_PAIR = 1, CM_CONV = 2, CM_HEADS = 3 };
__host__ __device__ inline int colmap(int kind, int n, int aux) {
    const int pn = n / 256, c = n % 256;
    if (kind == CM_PLAIN) return n;
    if (kind == CM_PAIR) return (c >= 128 ? aux : 0) + pn * 128 + (c % 128);
    if (kind == CM_CONV) { if (n < 2 * D_MODEL) return (c >= 128 ? 2 * D_MODEL : D_MODEL) + pn * 128 + (c % 128); return n - 2 * D_MODEL; }
    if (n < aux * 64) { const int bj = c / 128, wc = (c % 128) / 32, r = c % 32; return (pn * 4 + wc) * 64 + 32 * bj + r; }
    return n;
}
__device__ inline void wconv_item(size_t i_, const float* src, int Nsrc, const float* gain, bf16_t* dst, int Nd, int K, int kind, int aux) {
    const int n = (int)(i_ % Nd), kb = (int)(i_ / Nd);
    const int col = colmap(kind, n, aux);
    bf16_t* d = dst + (size_t)n * K + (size_t)kb * 64;
    if (col < 0 || col >= Nsrc) { for (int k = 0; k < 64; ++k) d[k] = 0; return; }
    const float* s = src + (size_t)kb * 64 * Nsrc + col;
#pragma unroll 8
    for (int k = 0; k < 64; k += 2) {
        const float g0 = gain ? gain[kb * 64 + k] : 1.f, g1 = gain ? gain[kb * 64 + k + 1] : 1.f;
        const unsigned lo = f2bf(s[(size_t)k * Nsrc] * g0), hi = f2bf(s[(size_t)(k + 1) * Nsrc] * g1);
        *(unsigned*)(d + k) = lo | (hi << 16);
    }
}
__device__ inline void rope_item(size_t i_, float* rope) {
    const int pi = (int)(i_ / 8), f = (int)(i_ % 8);
    const int pos = pi < SEQ ? pi : PAST_LEN + (pi - SEQ);
    float c, s; rope_cs((float)pos * INV_FREQ[f], c, s);
    rope[pi * 16 + f] = c; rope[pi * 16 + 8 + f] = s;
}
__device__ inline void hinit_item(size_t i_, const float* xp, const float* xs, float* h, bf16_t* hb, float* rss0) {
    const int m = (int)i_; const float* x = m < MP ? xp + (size_t)m * D_MODEL : xs + (size_t)(m - MP) * D_MODEL;
    float s = 0.f;
    for (int k = 0; k < D_MODEL; ++k) { const float v = x[k]; s += v * v; h[(size_t)m * D_MODEL + k] = v; hb[(size_t)m * D_MODEL + k] = f2bf(v); }
    rss0[m] = s;
}
__device__ inline void hupd_item(size_t i_, float* h, const float* y, float coef, bf16_t* hb, float* rss) {
    const int m = (int)i_; float s = 0.f;
    for (int k = 0; k < D_MODEL; ++k) { const float v = h[(size_t)m * D_MODEL + k] + coef * y[(size_t)m * D_MODEL + k]; s += v * v; h[(size_t)m * D_MODEL + k] = v; hb[(size_t)m * D_MODEL + k] = f2bf(v); }
    rss[m] = s;
}
__device__ inline float dot_bf(const bf16_t* a, const bf16_t* b, int K) { float s = 0.f; for (int k = 0; k < K; ++k) s += bf2f(a[k]) * bf2f(b[k]); return s; }
__device__ inline float silu_f(float g) { return g / (1.0f + expf(-g)); }
__device__ inline void ref_ffn_in_item(size_t i_, const bf16_t* hb, const float* rss, const bf16_t* Bt, bf16_t* act) {
    const int m = (int)(i_ / D_FF), j = (int)(i_ % D_FF);
    const float rs = 1.0f / sqrtf(rss[m] / D_MODEL + EPS);
    const int ng = (j / 128) * 256 + (j % 128);
    const float g = rs * dot_bf(hb + (size_t)m * D_MODEL, Bt + (size_t)ng * D_MODEL, D_MODEL), u = rs * dot_bf(hb + (size_t)m * D_MODEL, Bt + (size_t)(ng + 128) * D_MODEL, D_MODEL);
    act[i_] = f2bf(silu_f(g) * u);
}
__device__ inline void ref_resid_row_item(size_t i_, const bf16_t* A, int K, const bf16_t* Bt, float coef, float* h, bf16_t* hb, float* rss_next, float* yout) {
    const int m = (int)i_; float s = 0.f;
    for (int c = 0; c < D_MODEL; ++c) {
        const float v = h[(size_t)m * D_MODEL + c] + coef * dot_bf(A + (size_t)m * K, Bt + (size_t)c * K, K);
        if (yout) { yout[(size_t)m * D_MODEL + c] = v; } else { h[(size_t)m * D_MODEL + c] = v; hb[(size_t)m * D_MODEL + c] = f2bf(v); s += v * v; }
    }
    if (!yout) rss_next[m] = s;
}

constexpr float QSCALE_F = 0.125f * 1.4426950408889634f;
__device__ inline void qconv_item(size_t i_, const float* qn, const float* qr, bf16_t* qnb, bf16_t* qrb) { qnb[i_] = f2bf(qn[i_] * QSCALE_F); qrb[i_] = f2bf(qr[i_] * QSCALE_F); }
__host__ __device__ inline size_t kimg_off(int kv, int d0) { return (size_t)(d0 >> 3) * 1024 + (size_t)kv * 16; }
__host__ __device__ inline size_t vimg_off(int kv, int d0) { return (size_t)(d0 >> 5) * 4096 + (size_t)(kv >> 3) * 512 + (size_t)(kv & 7) * 64 + (size_t)((d0 & 31) >> 3) * 16; }
__device__ inline void put_chunk(unsigned char* dst, const float* src) { bf16_t* d = (bf16_t*)dst; for (int k = 0; k < 8; ++k) d[k] = f2bf(src[k]); }
__device__ inline void kvimg_item(size_t i_, const float* out, const float* winrows, unsigned char* ksel, unsigned char* vsel, unsigned char* kwin, unsigned char* vwin) {
    const int c = (int)(i_ % 8), t = (int)((i_ / 8) % SEQ), g = (int)((i_ / (8 * (size_t)SEQ)) % N_KV), n = (int)(i_ / (8 * (size_t)SEQ * N_KV));
    const size_t base = (((size_t)n * N_KV + g) * (SEQ / 64) + t / 64) * 8192; const int kv = t % 64, d0 = 8 * c; const size_t m = (size_t)n * SEQ + t;
    put_chunk(ksel + base + kimg_off(kv, d0), out + O_KVP + ((m * 4 + 2) * N_KV + g) * HD + d0);
    put_chunk(vsel + base + vimg_off(kv, d0), out + O_KVP + ((m * 4 + 3) * N_KV + g) * HD + d0);
    put_chunk(kwin + base + kimg_off(kv, d0), winrows + ((m * 2 + 0) * N_KV + g) * HD + d0);
    put_chunk(vwin + base + vimg_off(kv, d0), winrows + ((m * 2 + 1) * N_KV + g) * HD + d0);
}
__device__ inline void kcimg_item(size_t i_, const float* kc, const float* vc, unsigned char* kci, unsigned char* vci) {
    const int c = (int)(i_ % 8), cb = (int)((i_ / 8) % NBC_P), g = (int)((i_ / (8 * (size_t)NBC_P)) % N_KV), n = (int)(i_ / (8 * (size_t)NBC_P * N_KV));
    const size_t base = (((size_t)n * N_KV + g) * (NBC_P / 64) + cb / 64) * 8192; const int kv = cb % 64, d0 = 8 * c;
    put_chunk(kci + base + kimg_off(kv, d0), kc + (((size_t)n * NBC_MAX + cb) * N_KV + g) * HD + d0);
    put_chunk(vci + base + vimg_off(kv, d0), vc + (((size_t)n * NBC_MAX + cb) * N_KV + g) * HD + d0);
}

constexpr int NBC_PAST = PAST_LEN / L_CMP;
constexpr int RS_CMP = DEC_BATCH * NBC_PAST * N_KV, RP_CMP = BATCH * NBC_P * N_KV;
__device__ inline void acmp_sample_item(size_t i_, const float* cache_kv, const int* page_table, const float* pe, bf16_t* A) {
    const int c8 = (int)(i_ % 8), l = (int)((i_ / 8) % L_CMP); const size_t rr = i_ / (8 * L_CMP); const int r = (int)(rr % RS_CMP), e = (int)(rr / RS_CMP);
    const int g = r % N_KV, c = (r / N_KV) % NBC_PAST, b = r / (N_KV * NBC_PAST), tok = c * L_CMP + l;
    const int page = page_table[b * N_PAGES + tok / PAGE_SIZE];
    const float* src = cache_kv + ((((size_t)page * PAGE_SIZE + tok % PAGE_SIZE) * 4 + e) * N_KV + g) * HD + 8 * c8; const float* pp = pe + ((size_t)e * L_CMP + l) * HD + 8 * c8;
    bf16_t* d = A + ((size_t)e * RS_CMP + r) * (L_CMP * HD) + l * HD + 8 * c8;
#ifndef CPU_TEST
    typedef float f4 __attribute__((ext_vector_type(4))); typedef unsigned u4 __attribute__((ext_vector_type(4)));
    const f4 a0 = __builtin_nontemporal_load((const f4*)src) + *(const f4*)pp, a1 = __builtin_nontemporal_load((const f4*)(src + 4)) + *(const f4*)(pp + 4);
    u4 w; w.x = (unsigned)f2bf(a0[0]) | ((unsigned)f2bf(a0[1]) << 16); w.y = (unsigned)f2bf(a0[2]) | ((unsigned)f2bf(a0[3]) << 16);
    w.z = (unsigned)f2bf(a1[0]) | ((unsigned)f2bf(a1[1]) << 16); w.w = (unsigned)f2bf(a1[2]) | ((unsigned)f2bf(a1[3]) << 16);
    *(u4*)d = w;
#else
    for (int k = 0; k < 8; ++k) d[k] = f2bf(src[k] + pp[k]);
#endif
}
__device__ inline void acmp_prompt_item(size_t i_, const float* out, const float* pe, bf16_t* A) {
    const int c8 = (int)(i_ % 8), l = (int)((i_ / 8) % L_CMP); const size_t rr = i_ / (8 * L_CMP); const int r = (int)(rr % RP_CMP), e = (int)(rr / RP_CMP);
    const int g = r % N_KV, c = (r / N_KV) % NBC_P, n = r / (N_KV * NBC_P), tok = c * L_CMP + l;
    const float* src = out + O_KVP + ((((size_t)n * SEQ + tok) * 4 + e) * N_KV + g) * HD + 8 * c8; const float* pp = pe + ((size_t)e * L_CMP + l) * HD + 8 * c8;
    bf16_t* d = A + ((size_t)e * RP_CMP + r) * (L_CMP * HD) + l * HD + 8 * c8;
    for (int k = 0; k < 8; ++k) d[k] = f2bf(src[k] + pp[k]);
}
__device__ inline void cmp_out_b_item(size_t i_, const bf16_t* hid, int R, int nbc, int seq0, const float* w2, const float* k_norm0, float* kc, float* vc) {
    const int r = (int)(i_ % R), e = (int)(i_ / R); const int g = r % N_KV, c = (r / N_KV) % nbc, sq = r / (N_KV * nbc);
    const bf16_t* hr = hid + ((size_t)e * R + r) * CMP_HID;
    float v[HD];
    for (int d = 0; d < HD; ++d) v[d] = 0.f;
    for (int f = 0; f < CMP_HID; ++f) { const float hf = bf2f(hr[f]); const float* w = w2 + ((size_t)e * CMP_HID + f) * HD; for (int d = 0; d < HD; ++d) v[d] += hf * w[d]; }
    if (e == 0) head_norm(v, k_norm0);
    float* o = (e == 0 ? kc : vc) + (((size_t)(seq0 + sq) * NBC_MAX + c) * N_KV + g) * HD;
    for (int d = 0; d < HD; ++d) o[d] = v[d];
}
__host__ __device__ inline int heads_row(int hidx, int d) { return (hidx / 4) * 256 + 128 * (d / 32) + 32 * (hidx % 4) + (d % 32); }
__device__ inline void conv_state_store(float* out, int layer, int m, int ch, float u) {
    const RowInfo ri = row_info(m); const int L = seq_len(ri.seq);
    if (ri.t >= L - 2) { const int j = ri.t - (L - 2);
        if (ri.seq < BATCH) out[O_CP + (((size_t)layer * BATCH + ri.seq) * 2 + j) * D_MODEL + ch] = u;
        else out[O_CS + (((size_t)layer * DEC_BATCH + (ri.seq - BATCH)) * 2 + j) * D_MODEL + ch] = u; }
}
__device__ inline void ref_conv_in_item(size_t i_, const bf16_t* hb, const float* rss, const bf16_t* Bt, bf16_t* ub, bf16_t* bb, float* out, int layer) {
    const int m = (int)(i_ / D_MODEL), j = (int)(i_ % D_MODEL);
    const float rs = 1.0f / sqrtf(rss[m] / D_MODEL + EPS); const bf16_t* a = hb + (size_t)m * D_MODEL;
    const int nc = (j / 128) * 256 + (j % 128);
    const float c = rs * dot_bf(a, Bt + (size_t)nc * D_MODEL, D_MODEL), x = rs * dot_bf(a, Bt + (size_t)(nc + 128) * D_MODEL, D_MODEL), b = rs * dot_bf(a, Bt + (size_t)(2 * D_MODEL + j) * D_MODEL, D_MODEL);
    const float u = c * x; ub[i_] = f2bf(u); bb[i_] = f2bf(b); conv_state_store(out, layer, m, j, u);
}
__device__ inline void conv_thin_item(size_t i_, const bf16_t* ub, const bf16_t* bb, const float* state  , const float* wc  , bf16_t* zb) {
    const int m = (int)(i_ / D_MODEL), ch = (int)(i_ % D_MODEL);
    const RowInfo ri = row_info(m);
    const float u0 = bf2f(ub[i_]);
    float u1, u2;
    if (ri.t >= 1) u1 = bf2f(ub[i_ - D_MODEL]); else u1 = (ri.seq < BATCH) ? 0.f : state[((size_t)(ri.seq - BATCH) * 2 + 1) * D_MODEL + ch];
    if (ri.t >= 2) u2 = bf2f(ub[i_ - 2 * D_MODEL]); else if (ri.seq < BATCH) u2 = 0.f;
    else u2 = (ri.t == 1) ? state[((size_t)(ri.seq - BATCH) * 2 + 1) * D_MODEL + ch] : state[((size_t)(ri.seq - BATCH) * 2 + 0) * D_MODEL + ch];
    zb[i_] = f2bf(bf2f(bb[i_]) * (wc[ch] * u2 + wc[D_MODEL + ch] * u1 + wc[2 * D_MODEL + ch] * u0));
}
__device__ inline void ref_qg_item(size_t i_, const bf16_t* hb, const float* rss, const bf16_t* Bt, const float* q_norm, const float* rope, float* qn, float* qr) {
    const int m = (int)(i_ / N_HEADS), hh = (int)(i_ % N_HEADS);
    const float rs = 1.0f / sqrtf(rss[m] / D_MODEL + EPS); const bf16_t* a = hb + (size_t)m * D_MODEL;
    float v[HD]; for (int d = 0; d < HD; ++d) v[d] = rs * dot_bf(a, Bt + (size_t)heads_row(hh, d) * D_MODEL, D_MODEL);
    head_norm(v, q_norm);
    for (int d = 0; d < HD; ++d) qn[(size_t)m * HDM + hh * HD + d] = v[d];
    const float* rt = rope + (size_t)pos_index(row_info(m).pos) * 16;
    for (int f = 0; f < 8; ++f) { const float x1 = v[f], x2 = v[8 + f]; v[f] = x1 * rt[f] - x2 * rt[8 + f]; v[8 + f] = x2 * rt[f] + x1 * rt[8 + f]; }
    for (int d = 0; d < HD; ++d) qr[(size_t)m * HDM + hh * HD + d] = v[d];
}
__device__ inline void ref_gates_item(size_t i_, const bf16_t* hb, const float* rss, const bf16_t* Bt, float* gates) {
    const int m = (int)(i_ / (3 * N_HEADS)), j = (int)(i_ % (3 * N_HEADS));
    const float rs = 1.0f / sqrtf(rss[m] / D_MODEL + EPS);
    const float x = rs * dot_bf(hb + (size_t)m * D_MODEL, Bt + (size_t)(HDM + j) * D_MODEL, D_MODEL);
    gates[i_] = 1.0f / (1.0f + expf(-x));
}
__device__ inline void kv_store(float* out, float* winrows, int m, int e, int g, int d, float v) {
    const RowInfo ri = row_info(m);
    if (e < 4) { if (ri.seq < BATCH) out[O_KVP + (((size_t)m * 4 + e) * N_KV + g) * HD + d] = v; else out[O_KVS + (((size_t)(m - MP) * 4 + e) * N_KV + g) * HD + d] = v; }
    else { const int we = e - 4;
        winrows[(((size_t)m * 2 + we) * N_KV + g) * HD + d] = v;
        if (ri.seq < BATCH) { if (ri.t >= SEQ - WINDOW) out[O_WP + ((((size_t)ri.seq * WINDOW + (ri.t - (SEQ - WINDOW))) * 2 + we) * N_KV + g) * HD + d] = v; }
        else out[O_WS + ((((size_t)(ri.seq - BATCH) * WINDOW + (WINDOW - DEC_SEQ + ri.t)) * 2 + we) * N_KV + g) * HD + d] = v; }
}
__device__ inline void ref_kv_item(size_t i_, const bf16_t* hb, const float* rss, const bf16_t* Bt, const float* k_norm, const float* rope, float* out, float* winrows) {
    const int m = (int)(i_ / (6 * N_KV)), hidx = (int)(i_ % (6 * N_KV)), e = hidx / N_KV, g = hidx % N_KV;
    const float rs = 1.0f / sqrtf(rss[m] / D_MODEL + EPS); const bf16_t* a = hb + (size_t)m * D_MODEL;
    float v[HD]; for (int d = 0; d < HD; ++d) v[d] = rs * dot_bf(a, Bt + (size_t)heads_row(hidx, d) * D_MODEL, D_MODEL);
    if (e == 2 || e == 4) { head_norm(v, k_norm + (e == 2 ? 1 : 2) * HD);
        const float* rt = rope + (size_t)pos_index(row_info(m).pos) * 16;
        for (int f = 0; f < 8; ++f) { const float x1 = v[f], x2 = v[8 + f]; v[f] = x1 * rt[f] - x2 * rt[8 + f]; v[8 + f] = x2 * rt[f] + x1 * rt[8 + f]; } }
    for (int d = 0; d < HD; ++d) kv_store(out, winrows, m, e, g, d, v[d]);
}
#ifndef CPU_TEST
#define LAS __attribute__((address_space(3)))
#define XB_TMO      128
#define XB_XCNT(j)  (256  + 64 * (j))
#define XB_XSUB(j)  (1280 + 64 * (j))
#define XB_XGEN(j)  (2304 + 64 * (j))
#define XB_TOP      3328
#define XB_TOPGEN   3392
#define XCD_BAR_WORDS 3456
#define XB_SPIN_CAP (1u << 25)
typedef __attribute__((address_space(1))) unsigned GU;
__device__ __forceinline__ unsigned xb_ld(GU* p)              { return __hip_atomic_load(p, __ATOMIC_RELAXED, __HIP_MEMORY_SCOPE_AGENT); }
__device__ __forceinline__ unsigned xb_add(GU* p, unsigned v) { return __hip_atomic_fetch_add(p, v, __ATOMIC_RELAXED, __HIP_MEMORY_SCOPE_AGENT); }
__device__ __forceinline__ unsigned xb_xcc_id() { return (unsigned)__builtin_amdgcn_s_getreg((3 << 11) | 20) & 0xFu; }
#define XB_SPIN(cond, bar) do { unsigned _sp = 0; while (cond) { __builtin_amdgcn_s_sleep(1); \
    if ((++_sp & 255u) == 0u) { if (xb_ld(&(bar)[XB_TMO])) break; if (_sp > XB_SPIN_CAP) { (void)xb_add(&(bar)[XB_TMO], 1u); break; } } } } while (0)
struct XcdBarrier { GU* bar; unsigned x; volatile LAS unsigned* st; };
__device__ __forceinline__ XcdBarrier xcd_barrier_post(GU* bar, volatile LAS unsigned* st, const bool leader_thread) {
    XcdBarrier b; b.bar = bar; b.x = xb_xcc_id(); b.st = st;
    if (leader_thread) (void)xb_add(&bar[XB_XCNT(b.x)], 1u);
    return b;
}
__device__ __forceinline__ void xcd_barrier_complete(GU* bar, unsigned x, unsigned& nloc, unsigned& nx) {
    const unsigned G = gridDim.x * gridDim.y * gridDim.z;
    unsigned sum, cnt, mine, sp = 0u;
    for (;;) {
        sum = 0u; cnt = 0u; mine = 0u;
#pragma unroll
        for (unsigned j = 0; j < 16; ++j) { const unsigned c = xb_ld(&bar[XB_XCNT(j)]); sum += c; cnt += (c > 0u) ? 1u : 0u; mine = (j == x) ? c : mine; }
        if (sum == G) break;
        __builtin_amdgcn_s_sleep(1);
        if ((++sp & 255u) == 0u) { if (xb_ld(&bar[XB_TMO])) break; if (sp > XB_SPIN_CAP) { (void)xb_add(&bar[XB_TMO], 1u); break; } }
    }
    nloc = mine > 0u ? mine : 1u; nx = cnt > 0u ? cnt : 1u;
}
__device__ __forceinline__ void xcd_barrier(const XcdBarrier& b, const bool leader_thread) {
    asm volatile("s_waitcnt vmcnt(0)" ::: "memory");
    __syncthreads();
    if (leader_thread) {
        GU* bar = b.bar; unsigned bx = xb_xcc_id(); asm volatile("" : "+s"(bx));
        __builtin_amdgcn_s_waitcnt(0);
        unsigned nloc = b.st[0], nx = b.st[1];
        if (nloc == 0u) { xcd_barrier_complete(bar, bx, nloc, nx); b.st[0] = nloc; b.st[1] = nx; }
        const unsigned old = xb_add(&bar[XB_XSUB(bx)], 1u);
        const unsigned gen = old / nloc;
        if (old + 1u == (gen + 1u) * nloc) {
            __builtin_amdgcn_fence(__ATOMIC_RELEASE, "agent");
            asm volatile("s_waitcnt vmcnt(0)" ::: "memory");
            const unsigned og = xb_add(&bar[XB_TOP], 1u);
            const unsigned tg = og / nx;
            if (og + 1u == (tg + 1u) * nx) xb_add(&bar[XB_TOPGEN], 1u);
            else XB_SPIN(xb_ld(&bar[XB_TOPGEN]) == tg, bar);
            __builtin_amdgcn_fence(__ATOMIC_ACQUIRE, "agent");
            xb_add(&bar[XB_XGEN(bx)], 1u);
            asm volatile("s_waitcnt vmcnt(0)" ::: "memory");
        } else {
            XB_SPIN(xb_ld(&bar[XB_XGEN(bx)]) == gen, bar);
            __builtin_amdgcn_fence(__ATOMIC_ACQUIRE, "agent");
            asm volatile("s_waitcnt vmcnt(0)" ::: "memory");
        }
    }
    __syncthreads();
}

namespace pg8 {
#define PG8_LAS __attribute__((address_space(3)))
typedef unsigned short bf16_t;
typedef short bf16x8 __attribute__((ext_vector_type(8)));
typedef float f32x4 __attribute__((ext_vector_type(4)));
typedef unsigned u32x4 __attribute__((ext_vector_type(4)));
constexpr int BM = 256, BK = 64, HALF = 128, HTB = HALF * BK * 2  , STAGE_BYTES = 8 * HTB, NXCD = 8, WGM = 8;

__host__ __device__ __forceinline__ int lds_byte(int r, int c) { const int st = (r >> 4) * 2 + (c >> 5), rr = r & 15, cc = c & 31, ob = rr * 64 + cc * 2; return st * 1024 + (ob ^ (((ob >> 9) & 1) << 5)); }
__host__ __device__ __forceinline__ void stage_rc(int b, int& R, int& C) { const int st = b / 1024, sb = b % 1024, swz = sb ^ (((sb >> 9) & 1) << 5); R = (st >> 1) * 16 + swz / 64; C = (st & 1) * 32 + (swz % 64) / 2; }
__host__ __device__ __forceinline__ int perm32(int rho) { const int n = rho >> 4, i = rho & 15; return 8 * (i >> 2) + 4 * n + (i & 3); }

struct Unit { int pm, pn; };
struct Gemm { const bf16_t* A; const bf16_t* Bt; int M, N, K; };

struct StaticOrder {
    int nM, nN, nwg, G, c;
    __host__ __device__ void init(int M, int N, int G_, int c_) { nM = M / BM; nN = N / BM; nwg = nM * nN; G = G_; c = c_; }
    __host__ __device__ bool next(int i, Unit& u) const {
        const long L = (long)i * G + c; if (L >= nwg) return false;
        int wgid = (int)L; { const int q = nwg / NXCD, r = nwg % NXCD, xcd = wgid % NXCD, off = wgid / NXCD; wgid = (xcd < r ? xcd * (q + 1) : r * (q + 1) + (xcd - r) * q) + off; }
        const int nig = WGM * nN, gid = wgid / nig, fm = gid * WGM, gsz = (nM - fm) < WGM ? (nM - fm) : WGM;
        u.pm = fm + ((wgid % nig) % gsz); u.pn = (wgid % nig) / gsz; return true;
    }
    __device__ __forceinline__ void a_ready(const Unit&) const {}
    __device__ __forceinline__ void done(const Unit&) const {}
};

__device__ __forceinline__ unsigned cvt_pk_bf16(float lo, float hi) { unsigned r; asm volatile("v_cvt_pk_bf16_f32 %0, %1, %2" : "=v"(r) : "v"(lo), "v"(hi)); return r; }
template <class Epi, class Sched, bool ALIGN_EPI = false, bool SP2 = false>
__device__ __forceinline__ void gemm_phase(int wave_id_, PG8_LAS unsigned char* lds, const Gemm g, const Sched& S, const Epi& E) {
    int wid = wave_id_, lane = (int)lane_id_v(); asm volatile("" : "+s"(wid));
    const int tid = wid * 64 + lane, wr = wid >> 2, wc = wid & 3, fr = lane & 15, fq = lane >> 4;
    const int K = g.K, nt = K / BK;
    unsigned voffA[2], voffB[2];
#pragma unroll
    for (int i = 0; i < 2; ++i) { int R, C; stage_rc(tid * 16 + i * 8192, R, C); const int Rb = Epi::PERM ? ((R & ~31) + perm32(R & 31)) : R;
        voffA[i] = (unsigned)(R * K + C) * 2u; voffB[i] = (unsigned)(Rb * K + C) * 2u; }
    const size_t kstep = (size_t)(BK * 2);
    const size_t hstep = (size_t)HALF * K * 2;
    const size_t tstep = 2 * hstep;
    const unsigned ldsw = (unsigned)wid * 1024u;
    const int aoff = lds_byte(wr * 64 + fr, fq * 8), boff = lds_byte(wc * 32 + fr, fq * 8);
#define PG8_SA(b, h) (((b) * 2 + (h)) * HTB)
#define PG8_SB(b, h) ((4 + (b) * 2 + (h)) * HTB)
#define PG8_STAGE(bufoff, gbase, voff) do { _Pragma("unroll") for (int _i = 0; _i < 2; ++_i) \
        __builtin_amdgcn_global_load_lds((const unsigned*)((const char*)(gbase) + (voff)[_i]), (PG8_LAS unsigned*)(lds + (bufoff) + ldsw + _i * 8192), 16, 0, 0); } while (0)
#define PG8_LDA(dst, b, h) do { _Pragma("unroll") for (int m = 0; m < 4; ++m) _Pragma("unroll") for (int k = 0; k < 2; ++k) dst[m][k] = *(const PG8_LAS bf16x8*)(lds + PG8_SA(b, h) + aoff + m * 2048 + k * 1024); } while (0)
#define PG8_LDB(dst, b, h) do { _Pragma("unroll") for (int n = 0; n < 2; ++n) _Pragma("unroll") for (int k = 0; k < 2; ++k) dst[n][k] = *(const PG8_LAS bf16x8*)(lds + PG8_SB(b, h) + boff + n * 2048 + k * 1024); } while (0)
#define PG8_MMA(ai, bj, At, Bt) do { __builtin_amdgcn_s_setprio(1); _Pragma("unroll") for (int m = 0; m < 4; ++m) _Pragma("unroll") for (int n = 0; n < 2; ++n) _Pragma("unroll") for (int k = 0; k < 2; ++k) \
        acc[ai][bj][m][n] = __builtin_amdgcn_mfma_f32_16x16x32_bf16(Bt[n][k], At[m][k], acc[ai][bj][m][n], 0, 0, 0); __builtin_amdgcn_s_setprio(0); } while (0)
#define PG8_WAIT_V(n) asm volatile("s_waitcnt vmcnt(" #n ")" ::: "memory")
#define PG8_WAIT_L(n) asm volatile("s_waitcnt lgkmcnt(" #n ")" ::: "memory")
#define PG8_BAR __builtin_amdgcn_s_barrier()
#define PG8_SCHED __builtin_amdgcn_sched_barrier(0)
    Unit cur, nxt; int ui = 0; float rsv[8];
#pragma unroll
    for (int i_ = 0; i_ < 8; ++i_) rsv[i_] = 0.f;
    if (!S.next(0, cur)) return;
    f32x4 acc[2][2][4][2];
    if constexpr (Epi::ACC_INIT) E.init_acc(acc, cur, wr, wc, fr, fq);
    else {
#pragma unroll
    for (int a = 0; a < 2; ++a)
#pragma unroll
        for (int b = 0; b < 2; ++b)
#pragma unroll
            for (int m = 0; m < 4; ++m)
#pragma unroll
                for (int n = 0; n < 2; ++n) acc[a][b][m][n] = (f32x4){0.f, 0.f, 0.f, 0.f};
    }
    bf16x8 At[4][2], B0[2][2], B1[2][2];
    const char* cA = (const char*)g.A + (size_t)cur.pm * tstep; const char* cB = (const char*)g.Bt + (size_t)cur.pn * tstep;
    S.a_ready(cur);
    if constexpr (SP2) {
        PG8_STAGE(PG8_SB(0, 0), cB, voffB); PG8_STAGE(PG8_SB(0, 1), cB + hstep, voffB); PG8_STAGE(PG8_SA(0, 0), cA, voffA); PG8_STAGE(PG8_SA(0, 1), cA + hstep, voffA);
        if (wr == 1) PG8_BAR;
        PG8_WAIT_V(2); PG8_BAR;
        PG8_STAGE(PG8_SB(1, 0), cB + kstep, voffB); PG8_STAGE(PG8_SA(1, 0), cA + kstep, voffA); PG8_STAGE(PG8_SB(1, 1), cB + hstep + kstep, voffB);
        PG8_WAIT_V(6); PG8_BAR;
    } else {
        PG8_STAGE(PG8_SB(0, 0), cB, voffB); PG8_STAGE(PG8_SA(0, 0), cA, voffA); PG8_STAGE(PG8_SB(0, 1), cB + hstep, voffB); PG8_STAGE(PG8_SA(0, 1), cA + hstep, voffA);
        if (wr == 1) PG8_BAR;
        PG8_WAIT_V(4); PG8_BAR;
        PG8_STAGE(PG8_SB(1, 0), cB + kstep, voffB); PG8_STAGE(PG8_SA(1, 0), cA + kstep, voffA); PG8_STAGE(PG8_SB(1, 1), cB + hstep + kstep, voffB);
        PG8_WAIT_V(6); PG8_BAR;
    }
    for (;;) {
        const bool has_next = S.next(ui + 1, nxt);
        const char* nA = has_next ? (const char*)g.A + (size_t)nxt.pm * tstep : cA; const char* nB = has_next ? (const char*)g.Bt + (size_t)nxt.pn * tstep : cB;
        for (int t = 0; t < nt; t += 2) {
            const bool last = (t == nt - 2);
            const char* a1 = cA + (size_t)(t + 1) * kstep;
            const char* a2 = last ? nA : cA + (size_t)(t + 2) * kstep; const char* b2 = last ? nB : cB + (size_t)(t + 2) * kstep;
            const char* a3 = a2 + kstep; const char* b3 = b2 + kstep;
            if (last && has_next) S.a_ready(nxt);
            if (last) E.pre(cur, wr, fr, rsv);
            if constexpr (SP2) {
            PG8_LDB(B0, 0, 0); PG8_LDB(B1, 0, 1); PG8_SCHED; PG8_LDA(At, 0, 0); PG8_STAGE(PG8_SA(1, 1), a1 + hstep, voffA);
            PG8_WAIT_V(8); PG8_WAIT_L(0); PG8_BAR; PG8_MMA(0, 0, At, B0); PG8_MMA(0, 1, At, B1); PG8_BAR; PG8_SCHED;
            PG8_LDA(At, 0, 1); PG8_STAGE(PG8_SB(0, 0), b2, voffB); PG8_STAGE(PG8_SB(0, 1), b2 + hstep, voffB); PG8_STAGE(PG8_SA(0, 0), a2, voffA);
            PG8_WAIT_V(8); PG8_WAIT_L(0); PG8_BAR; PG8_MMA(1, 0, At, B0); PG8_MMA(1, 1, At, B1); PG8_BAR; PG8_SCHED;
            PG8_LDB(B0, 1, 0); PG8_LDB(B1, 1, 1); PG8_SCHED; PG8_LDA(At, 1, 0); PG8_STAGE(PG8_SA(0, 1), a2 + hstep, voffA);
            PG8_WAIT_V(8); PG8_WAIT_L(0); PG8_BAR; PG8_MMA(0, 0, At, B0); PG8_MMA(0, 1, At, B1); PG8_BAR; PG8_SCHED;
            PG8_LDA(At, 1, 1); PG8_STAGE(PG8_SB(1, 0), b3, voffB); PG8_STAGE(PG8_SB(1, 1), b3 + hstep, voffB); PG8_STAGE(PG8_SA(1, 0), a3, voffA);
            PG8_WAIT_V(8); PG8_WAIT_L(0); PG8_BAR; PG8_MMA(1, 0, At, B0); PG8_MMA(1, 1, At, B1); PG8_BAR; PG8_SCHED;
            } else {
            PG8_LDB(B0, 0, 0); PG8_SCHED; PG8_LDA(At, 0, 0); PG8_STAGE(PG8_SA(1, 1), a1 + hstep, voffA);
            PG8_WAIT_L(8); PG8_BAR; PG8_WAIT_L(0); PG8_MMA(0, 0, At, B0); PG8_BAR; PG8_SCHED;
            PG8_LDB(B1, 0, 1); PG8_STAGE(PG8_SB(0, 0), b2, voffB);
            PG8_BAR; PG8_WAIT_L(0); PG8_MMA(0, 1, At, B1); PG8_BAR;
            PG8_LDA(At, 0, 1); PG8_STAGE(PG8_SA(0, 0), a2, voffA);
            PG8_BAR; PG8_WAIT_L(0); PG8_MMA(1, 0, At, B0); PG8_BAR; PG8_SCHED;
            PG8_STAGE(PG8_SB(0, 1), b2 + hstep, voffB);
            PG8_WAIT_V(6); PG8_BAR; PG8_MMA(1, 1, At, B1); PG8_BAR;
            PG8_LDB(B0, 1, 0); PG8_SCHED; PG8_LDA(At, 1, 0); PG8_STAGE(PG8_SA(0, 1), a2 + hstep, voffA);
            PG8_WAIT_L(8); PG8_BAR; PG8_WAIT_L(0); PG8_MMA(0, 0, At, B0); PG8_BAR; PG8_SCHED;
            PG8_LDB(B1, 1, 1); PG8_STAGE(PG8_SB(1, 0), b3, voffB);
            PG8_BAR; PG8_WAIT_L(0); PG8_MMA(0, 1, At, B1); PG8_BAR;
            PG8_LDA(At, 1, 1); PG8_STAGE(PG8_SA(1, 0), a3, voffA);
            PG8_BAR; PG8_WAIT_L(0); PG8_MMA(1, 0, At, B0); PG8_BAR; PG8_SCHED;
            PG8_STAGE(PG8_SB(1, 1), b3 + hstep, voffB);
            PG8_WAIT_V(6); PG8_BAR; PG8_MMA(1, 1, At, B1); PG8_BAR;
            }
        }
        if constexpr (ALIGN_EPI) { if (wr == 0) PG8_BAR; }
        if constexpr (!Epi::AFTER_DRAIN) { E(acc, cur, wr, wc, fr, fq, rsv); S.done(cur); }
        if (!has_next) break;
        if constexpr (Epi::ACC_INIT) E.init_acc(acc, nxt, wr, wc, fr, fq);
        else {
#pragma unroll
        for (int a = 0; a < 2; ++a)
#pragma unroll
            for (int b = 0; b < 2; ++b)
#pragma unroll
                for (int m = 0; m < 4; ++m)
#pragma unroll
                    for (int n = 0; n < 2; ++n) acc[a][b][m][n] = (f32x4){0.f, 0.f, 0.f, 0.f};
        }
        cur = nxt; cA = nA; cB = nB; ++ui;
        if constexpr (ALIGN_EPI) { if (wr == 1) PG8_BAR; }
    }
    PG8_WAIT_V(0);
    if constexpr (!ALIGN_EPI) { if (wr == 0) PG8_BAR; }
    PG8_BAR;
    if constexpr (Epi::AFTER_DRAIN) { E.fused(acc, cur, wr, wc, fr, fq, lds, wid, lane); S.done(cur); }
#undef PG8_SA
#undef PG8_SB
#undef PG8_STAGE
#undef PG8_LDA
#undef PG8_LDB
#undef PG8_MMA
#undef PG8_WAIT_V
#undef PG8_WAIT_L
#undef PG8_BAR
#undef PG8_SCHED
}
}

namespace pg8 {
__device__ __forceinline__ float fast_silu(float g) { return g * __builtin_amdgcn_rcpf(1.0f + __expf(-g)); }
__device__ __forceinline__ float row_rs(const float* rss, int row) { return rsqrtf(rss_dec(rss[row]) * (1.0f / D_MODEL) + EPS); }
struct EpiSwiglu {
    static constexpr bool PERM = true, AFTER_DRAIN = false, ACC_INIT = false;
    bf16_t* act; const float* rss;
    __device__ __forceinline__ void pre(const Unit& u, int wr, int fr, float (&rsv)[8]) const {
        const __attribute__((address_space(1))) float* rp = (const __attribute__((address_space(1))) float*)rss + u.pm * BM + wr * 64 + fr;
#pragma unroll
        for (int ai = 0; ai < 2; ++ai)
#pragma unroll
            for (int m = 0; m < 4; ++m) rsv[ai * 4 + m] = rp[ai * HALF + m * 16];
    }
    __device__ __forceinline__ void operator()(const f32x4 (&acc)[2][2][4][2], const Unit& u, int wr, int wc, int fr, int fq, const float (&rsv)[8]) const {
        const int row0 = u.pm * BM + wr * 64 + fr, col0 = u.pn * 128 + wc * 32 + 8 * fq;
#pragma unroll
        for (int ai = 0; ai < 2; ++ai)
#pragma unroll
            for (int m = 0; m < 4; ++m) {
                const int row = row0 + ai * HALF + m * 16; const float rs = rsqrtf(rss_dec(rsv[ai * 4 + m]) * (1.0f / D_MODEL) + EPS);
                float a[8];
#pragma unroll
                for (int n = 0; n < 2; ++n)
#pragma unroll
                    for (int i = 0; i < 4; ++i) a[n * 4 + i] = fast_silu(acc[ai][0][m][n][i] * rs) * (acc[ai][1][m][n][i] * rs);
                u32x4 w; w.x = cvt_pk_bf16(a[0], a[1]); w.y = cvt_pk_bf16(a[2], a[3]); w.z = cvt_pk_bf16(a[4], a[5]); w.w = cvt_pk_bf16(a[6], a[7]);
                *(u32x4*)(act + (size_t)row * D_FF + col0) = w;
            }
    }
};
struct EpiResid {
    static constexpr bool PERM = true, AFTER_DRAIN = false, ACC_INIT = true;
    bf16_t* hb; float* rss_next; float* yout; float coef;
    __device__ __forceinline__ void pre(const Unit&, int, int, float (&)[8]) const {}
    __device__ __forceinline__ void init_acc(f32x4 (&acc)[2][2][4][2], const Unit& u, int wr, int wc, int fr, int fq) const {
        const __attribute__((address_space(1))) bf16_t* hp = (const __attribute__((address_space(1))) bf16_t*)hb + (size_t)(u.pm * BM + wr * 64 + fr) * D_MODEL + u.pn * BM + wc * 32 + 8 * fq;
        const float ic = 1.0f / coef;
#pragma unroll
        for (int ai = 0; ai < 2; ++ai)
#pragma unroll
            for (int m = 0; m < 4; ++m)
#pragma unroll
                for (int bj = 0; bj < 2; ++bj) {
                    const u32x4 w = *(const __attribute__((address_space(1))) u32x4*)(hp + (size_t)(ai * HALF + m * 16) * D_MODEL + bj * HALF);
                    acc[ai][bj][m][0] = (f32x4){__uint_as_float(w.x << 16), __uint_as_float(w.x & 0xffff0000u), __uint_as_float(w.y << 16), __uint_as_float(w.y & 0xffff0000u)} * ic;
                    acc[ai][bj][m][1] = (f32x4){__uint_as_float(w.z << 16), __uint_as_float(w.z & 0xffff0000u), __uint_as_float(w.w << 16), __uint_as_float(w.w & 0xffff0000u)} * ic;
                }
    }
    __device__ __forceinline__ void operator()(const f32x4 (&acc)[2][2][4][2], const Unit& u, int wr, int wc, int fr, int fq, const float (&rsv)[8]) const {
        const int row0 = u.pm * BM + wr * 64 + fr, col0 = u.pn * BM + wc * 32 + 8 * fq;
#pragma unroll
        for (int ai = 0; ai < 2; ++ai)
#pragma unroll
            for (int m = 0; m < 4; ++m) {
                const int row = row0 + ai * HALF + m * 16; float s = 0.f;
#pragma unroll
                for (int bj = 0; bj < 2; ++bj) {
                    const f32x4 v0 = acc[ai][bj][m][0] * coef, v1 = acc[ai][bj][m][1] * coef;
                    const size_t o = (size_t)row * D_MODEL + col0 + bj * HALF;
                    if (yout) { *(f32x4*)(yout + o) = v0; *(f32x4*)(yout + o + 4) = v1; }
                    else {
                        u32x4 w; w.x = cvt_pk_bf16(v0[0], v0[1]); w.y = cvt_pk_bf16(v0[2], v0[3]); w.z = cvt_pk_bf16(v1[0], v1[1]); w.w = cvt_pk_bf16(v1[2], v1[3]);
                        *(u32x4*)(hb + o) = w;
                        s += ((v0[0] * v0[0] + v0[1] * v0[1]) + (v0[2] * v0[2] + v0[3] * v0[3])) + ((v1[0] * v1[0] + v1[1] * v1[1]) + (v1[2] * v1[2] + v1[3] * v1[3]));
                    }
                }
                if (!yout) { s += __shfl_xor(s, 16); s += __shfl_xor(s, 32); if (fq == 0) (void)__hip_atomic_fetch_add((unsigned*)rss_next + row, rss_enc(s), __ATOMIC_RELAXED, __HIP_MEMORY_SCOPE_AGENT); }
            }
    }
};
}
namespace pg8 {
__device__ __forceinline__ float sum4(f32x4 v) { return (v[0] * v[0] + v[1] * v[1]) + (v[2] * v[2] + v[3] * v[3]); }
struct EpiConvIn {
    static constexpr bool PERM = true, AFTER_DRAIN = false, ACC_INIT = false;
    bf16_t* ub; bf16_t* bb; const float* rss; float* out; int layer;
    __device__ __forceinline__ void pre(const Unit& u, int wr, int fr, float (&rsv)[8]) const {
        const __attribute__((address_space(1))) float* rp = (const __attribute__((address_space(1))) float*)rss + u.pm * BM + wr * 64 + fr;
#pragma unroll
        for (int ai = 0; ai < 2; ++ai)
#pragma unroll
            for (int m = 0; m < 4; ++m) rsv[ai * 4 + m] = rp[ai * HALF + m * 16];
    }
    __device__ __forceinline__ void operator()(const f32x4 (&acc)[2][2][4][2], const Unit& u, int wr, int wc, int fr, int fq, const float (&rsv)[8]) const {
        const int row0 = u.pm * BM + wr * 64 + fr;
        const bool pair = u.pn < D_MODEL / 128;
#pragma unroll
        for (int ai = 0; ai < 2; ++ai)
#pragma unroll
            for (int m = 0; m < 4; ++m) {
                const int row = row0 + ai * HALF + m * 16; const float rs = rsqrtf(rss_dec(rsv[ai * 4 + m]) * (1.0f / D_MODEL) + EPS);
                if (pair) {
                    const int col0 = u.pn * 128 + wc * 32 + 8 * fq; float a[8];
#pragma unroll
                    for (int n = 0; n < 2; ++n)
#pragma unroll
                        for (int i = 0; i < 4; ++i) a[n * 4 + i] = (acc[ai][0][m][n][i] * rs) * (acc[ai][1][m][n][i] * rs);
                    u32x4 w; w.x = cvt_pk_bf16(a[0], a[1]); w.y = cvt_pk_bf16(a[2], a[3]); w.z = cvt_pk_bf16(a[4], a[5]); w.w = cvt_pk_bf16(a[6], a[7]);
                    *(u32x4*)(ub + (size_t)row * D_MODEL + col0) = w;
                    const RowInfo ri = row_info(row); const int jj = ri.t - (seq_len(ri.seq) - 2);
                    if (jj >= 0) {
                        float* cs = (ri.seq < BATCH) ? out + O_CP + (((size_t)layer * BATCH + ri.seq) * 2 + jj) * D_MODEL + col0 : out + O_CS + (((size_t)layer * DEC_BATCH + (ri.seq - BATCH)) * 2 + jj) * D_MODEL + col0;
                        *(f32x4*)(cs) = (f32x4){a[0], a[1], a[2], a[3]}; *(f32x4*)(cs + 4) = (f32x4){a[4], a[5], a[6], a[7]};
                    }
                } else {
#pragma unroll
                    for (int bj = 0; bj < 2; ++bj) {
                        const int col0 = (u.pn - D_MODEL / 128) * 256 + bj * HALF + wc * 32 + 8 * fq;
                        const f32x4 v0 = acc[ai][bj][m][0] * rs, v1 = acc[ai][bj][m][1] * rs;
                        u32x4 w; w.x = cvt_pk_bf16(v0[0], v0[1]); w.y = cvt_pk_bf16(v0[2], v0[3]); w.z = cvt_pk_bf16(v1[0], v1[1]); w.w = cvt_pk_bf16(v1[2], v1[3]);
                        *(u32x4*)(bb + (size_t)row * D_MODEL + col0) = w;
                    }
                }
                asm volatile("" ::: "memory");
            }
    }
};
__device__ __forceinline__ void head_norm_rope(f32x4 (&v)[2][2], const float* gain, const float* rt  , int fq, bool do_norm, bool do_rope, f32x4 (&rot0)[2]) {
    if (do_norm) {
        float ss = (sum4(v[0][0]) + sum4(v[0][1])) + (sum4(v[1][0]) + sum4(v[1][1]));
        ss += __shfl_xor(ss, 16); ss += __shfl_xor(ss, 32);
        const float r = rsqrtf(ss * (1.0f / HD) + EPS);
#pragma unroll
        for (int bj = 0; bj < 2; ++bj)
#pragma unroll
            for (int n = 0; n < 2; ++n) { const f32x4 g = *(const f32x4*)(gain + 32 * bj + 8 * fq + 4 * n); v[bj][n] = v[bj][n] * r * g; }
    }
    rot0[0] = v[0][0]; rot0[1] = v[0][1];
    if (do_rope) {
#pragma unroll
        for (int n = 0; n < 2; ++n) {
            f32x4 p;
#pragma unroll
            for (int i = 0; i < 4; ++i) p[i] = __shfl_xor(v[0][n][i], 16);
            const f32x4 c = *(const f32x4*)(rt + 4 * n), s = *(const f32x4*)(rt + 8 + 4 * n);
            if (fq == 0) rot0[n] = v[0][n] * c - p * s; else if (fq == 1) rot0[n] = v[0][n] * c + p * s;
        }
    }
}
__device__ __forceinline__ u32x4 pack8(const f32x4 a, const f32x4 b, float sc) { u32x4 w; w.x = cvt_pk_bf16(a[0] * sc, a[1] * sc); w.y = cvt_pk_bf16(a[2] * sc, a[3] * sc); w.z = cvt_pk_bf16(b[0] * sc, b[1] * sc); w.w = cvt_pk_bf16(b[2] * sc, b[3] * sc); return w; }
struct EpiQG {
    static constexpr bool PERM = true, AFTER_DRAIN = false, ACC_INIT = false;
    bf16_t* qnb; bf16_t* qrb; float* gates; const float* rss; const float* q_norm; const float* rope;
    __device__ __forceinline__ void pre(const Unit& u, int wr, int fr, float (&rsv)[8]) const {
        const __attribute__((address_space(1))) float* rp = (const __attribute__((address_space(1))) float*)rss + u.pm * BM + wr * 64 + fr;
#pragma unroll
        for (int ai = 0; ai < 2; ++ai)
#pragma unroll
            for (int m = 0; m < 4; ++m) rsv[ai * 4 + m] = rp[ai * HALF + m * 16];
    }
    __device__ __forceinline__ void operator()(const f32x4 (&acc)[2][2][4][2], const Unit& u, int wr, int wc, int fr, int fq, const float (&rsv)[8]) const {
        const int row0 = u.pm * BM + wr * 64 + fr;
#pragma unroll
        for (int ai = 0; ai < 2; ++ai)
#pragma unroll
            for (int m = 0; m < 4; ++m) {
                const int row = row0 + ai * HALF + m * 16; const float rs = rsqrtf(rss_dec(rsv[ai * 4 + m]) * (1.0f / D_MODEL) + EPS);
                if (u.pn < N_HEADS / 4) {
                    const int hh = u.pn * 4 + wc;
                    f32x4 v[2][2] = {{acc[ai][0][m][0] * rs, acc[ai][0][m][1] * rs}, {acc[ai][1][m][0] * rs, acc[ai][1][m][1] * rs}}; f32x4 rot0[2];
                    head_norm_rope(v, q_norm, rope + (size_t)pos_index(row_info(row).pos) * 16, fq, true, true, rot0);
                    const size_t o = (size_t)row * HDM + hh * HD + 8 * fq;
                    const u32x4 hi8 = pack8(v[1][0], v[1][1], QSCALE_F);
                    *(u32x4*)(qnb + o) = pack8(v[0][0], v[0][1], QSCALE_F); *(u32x4*)(qnb + o + 32) = hi8;
                    *(u32x4*)(qrb + o) = pack8(rot0[0], rot0[1], QSCALE_F); *(u32x4*)(qrb + o + 32) = hi8;
                } else {
                    const int c0 = wc * 32 + 8 * fq;
#pragma unroll
                    for (int n = 0; n < 2; ++n)
#pragma unroll
                        for (int i = 0; i < 4; ++i) { const int c = c0 + 4 * n + i; if (c < 3 * N_HEADS) gates[(size_t)row * 3 * N_HEADS + c] = __builtin_amdgcn_rcpf(1.0f + __expf(-(acc[ai][0][m][n][i] * rs))); }
                }
                asm volatile("" ::: "memory");
            }
    }
};
struct EpiKV {
    static constexpr bool PERM = true, AFTER_DRAIN = false, ACC_INIT = false;
    float* out; float* winrows; const float* rss; const float* k_norm; const float* rope;
    unsigned char* ksel; unsigned char* vsel; unsigned char* kwin; unsigned char* vwin; bf16_t* acp; const float* pe;
    __device__ __forceinline__ void pre(const Unit&, int, int, float (&)[8]) const {}
    __device__ __forceinline__ void operator()(const f32x4 (&acc)[2][2][4][2], const Unit& u, int wr, int wc, int fr, int fq, const float (&rsv)[8]) const {
        const int row0 = u.pm * BM + wr * 64 + fr;
        const int hidx = u.pn * 4 + wc, e = hidx / N_KV, g = hidx % N_KV; const bool nr = (e == 2 || e == 4);
#pragma unroll
        for (int ai = 0; ai < 2; ++ai)
#pragma unroll
            for (int m = 0; m < 4; ++m) {
                const int row = row0 + ai * HALF + m * 16; const float rs = row_rs(rss, row);
                const RowInfo ri = row_info(row);
                f32x4 v[2][2] = {{acc[ai][0][m][0] * rs, acc[ai][0][m][1] * rs}, {acc[ai][1][m][0] * rs, acc[ai][1][m][1] * rs}}; f32x4 rot0[2];
                head_norm_rope(v, k_norm + (e == 2 ? 1 : 2) * HD, rope + (size_t)pos_index(ri.pos) * 16, fq, nr, nr, rot0);
                float* d0; float* d1 = nullptr;
                if (e < 4) d0 = (ri.seq < BATCH) ? out + O_KVP + (((size_t)row * 4 + e) * N_KV + g) * HD : out + O_KVS + (((size_t)(row - MP) * 4 + e) * N_KV + g) * HD;
                else { const int we = e - 4; d0 = winrows + (((size_t)row * 2 + we) * N_KV + g) * HD;
                    if (ri.seq < BATCH) { if (ri.t >= SEQ - WINDOW) d1 = out + O_WP + ((((size_t)ri.seq * WINDOW + (ri.t - (SEQ - WINDOW))) * 2 + we) * N_KV + g) * HD; }
                    else d1 = out + O_WS + ((((size_t)(ri.seq - BATCH) * WINDOW + (WINDOW - DEC_SEQ + ri.t)) * 2 + we) * N_KV + g) * HD; }
                d0 += 8 * fq; *(f32x4*)(d0) = rot0[0]; *(f32x4*)(d0 + 4) = rot0[1]; *(f32x4*)(d0 + 32) = v[1][0]; *(f32x4*)(d0 + 36) = v[1][1];
                if (d1) { d1 += 8 * fq; *(f32x4*)(d1) = rot0[0]; *(f32x4*)(d1 + 4) = rot0[1]; *(f32x4*)(d1 + 32) = v[1][0]; *(f32x4*)(d1 + 36) = v[1][1]; }
                if (ri.seq < BATCH) {
                    if (e >= 2) {
                        unsigned char* img = (e == 2 ? ksel : e == 3 ? vsel : e == 4 ? kwin : vwin) + (((size_t)ri.seq * N_KV + g) * (SEQ / 64) + ri.t / 64) * 8192; const int kv = ri.t % 64;
                        const size_t o0 = (e & 1) ? vimg_off(kv, 8 * fq) : kimg_off(kv, 8 * fq), o1 = (e & 1) ? vimg_off(kv, 32 + 8 * fq) : kimg_off(kv, 32 + 8 * fq);
                        *(u32x4*)(img + o0) = pack8(rot0[0], rot0[1], 1.0f); *(u32x4*)(img + o1) = pack8(v[1][0], v[1][1], 1.0f);
                    } else {
                        const int c = ri.t / L_CMP, l = ri.t % L_CMP; const int r = (ri.seq * NBC_P + c) * N_KV + g;
                        bf16_t* ap = acp + ((size_t)e * RP_CMP + r) * (L_CMP * HD) + l * HD + 8 * fq; const float* pp = pe + ((size_t)e * L_CMP + l) * HD + 8 * fq;
                        *(u32x4*)(ap) = pack8(rot0[0] + *(const f32x4*)(pp), rot0[1] + *(const f32x4*)(pp + 4), 1.0f);
                        *(u32x4*)(ap + 32) = pack8(v[1][0] + *(const f32x4*)(pp + 32), v[1][1] + *(const f32x4*)(pp + 36), 1.0f);
                    }
                }
                asm volatile("" ::: "memory");
            }
    }
};
}

namespace pg8 {
struct EpiGelu {
    static constexpr bool PERM = true, AFTER_DRAIN = false, ACC_INIT = false;
    bf16_t* hid;
    __device__ __forceinline__ void pre(const Unit&, int, int, float (&)[8]) const {}
    __device__ __forceinline__ void operator()(const f32x4 (&acc)[2][2][4][2], const Unit& u, int wr, int wc, int fr, int fq, const float (&rsv)[8]) const {
        const int row0 = u.pm * BM + wr * 64 + fr;
#pragma unroll
        for (int ai = 0; ai < 2; ++ai)
#pragma unroll
            for (int m = 0; m < 4; ++m) {
                const int row = row0 + ai * HALF + m * 16;
#pragma unroll
                for (int bj = 0; bj < 2; ++bj) {
                    float a[8];
#pragma unroll
                    for (int n = 0; n < 2; ++n)
#pragma unroll
                        for (int i = 0; i < 4; ++i) { const float x = acc[ai][bj][m][n][i]; a[n * 4 + i] = x * __builtin_amdgcn_rcpf(1.0f + __expf(-1.5957691216057308f * (x + 0.044715f * x * x * x))); }
                    u32x4 w; w.x = cvt_pk_bf16(a[0], a[1]); w.y = cvt_pk_bf16(a[2], a[3]); w.z = cvt_pk_bf16(a[4], a[5]); w.w = cvt_pk_bf16(a[6], a[7]);
                    *(u32x4*)(hid + (size_t)row * CMP_HID + bj * HALF + wc * 32 + 8 * fq) = w;
                }
            }
    }
};
struct CmpOrder {
    int nunits, per_e, G, c;
    __device__ bool next(int i, Unit& u) const { const int L = i * G + c; if (L >= nunits) return false; u.pm = L; u.pn = L / per_e; return true; }
    __device__ __forceinline__ void a_ready(const Unit&) const {}
    __device__ __forceinline__ void done(const Unit&) const {}
};
}
constexpr int LDS_RING_C = 131072;
namespace att {
typedef short bf16x8 __attribute__((ext_vector_type(8)));
typedef short s16x4 __attribute__((ext_vector_type(4)));
typedef float f32x16 __attribute__((ext_vector_type(16)));
typedef __attribute__((address_space(3))) unsigned char* ldsp;
constexpr int TILE_B = 8192;
constexpr int L_KB = 0, L_VB = 3 * TILE_B, L_IMP = 6 * TILE_B, L_SELM = L_IMP + 64 * 64 * 4, L_END = L_SELM + 64 * 8;
constexpr float NEGB = -1e30f;
constexpr float QSCALE = 0.125f * 1.4426950408889634f;
__device__ __forceinline__ int crow(int r, int hi) { return (r & 3) + 8 * (r >> 2) + 4 * hi; }
__device__ __forceinline__ void glds16(const void* gsrc, unsigned lds_dst) { unsigned keep;
    asm volatile("s_mov_b32 %0, m0\n\ts_mov_b32 m0, %2\n\ts_nop 0\n\tglobal_load_lds_dwordx4 %1, off\n\ts_mov_b32 m0, %0" : "=&s"(keep) : "v"(gsrc), "s"(lds_dst) : "memory"); }
__device__ __forceinline__ unsigned cvtpk(float lo, float hi) { unsigned r; asm volatile("v_cvt_pk_bf16_f32 %0, %1, %2" : "=v"(r) : "v"(lo), "v"(hi)); return r; }
__device__ __forceinline__ float halfmax(float m) { auto rr = __builtin_amdgcn_permlane32_swap(__float_as_uint(m), __float_as_uint(m), false, false); return fmaxf(__uint_as_float(rr[0]), __uint_as_float(rr[1])); }
__device__ __forceinline__ float halfsum(float m) { auto rr = __builtin_amdgcn_permlane32_swap(__float_as_uint(m), __float_as_uint(m), false, false); return __uint_as_float(rr[0]) + __uint_as_float(rr[1]); }
__device__ __forceinline__ s16x4 vtr(ldsp p) { typedef short v4i16_t __attribute__((ext_vector_type(4))); return __builtin_bit_cast(s16x4, __builtin_amdgcn_ds_read_tr16_b64_v4i16((__attribute__((address_space(3))) v4i16_t*)p)); }
#define ATT_BAR_L() asm volatile("s_waitcnt lgkmcnt(0)\n\ts_barrier" ::: "memory")
#define ATT_WAIT_BAR(N) asm volatile("s_waitcnt vmcnt(" #N ") lgkmcnt(0)\n\ts_barrier" ::: "memory")
__device__ __forceinline__ void dma_tile(const unsigned char* img_, unsigned lds_dst, int wid, int lane) { unsigned keep; const unsigned voff = (unsigned)(wid * 1024 + lane * 16);
    const unsigned long long ia_ = (unsigned long long)img_; const unsigned long long img = ((unsigned long long)(unsigned)__builtin_amdgcn_readfirstlane((int)(ia_ >> 32)) << 32) | (unsigned)__builtin_amdgcn_readfirstlane((int)ia_);
    asm volatile("s_mov_b32 %0, m0\n\ts_mov_b32 m0, %3\n\ts_nop 0\n\tglobal_load_lds_dwordx4 %1, %2\n\ts_mov_b32 m0, %0" : "=&s"(keep) : "v"(voff), "s"(img), "s"((unsigned)__builtin_amdgcn_readfirstlane(lds_dst + wid * 1024)) : "memory"); }
__device__ __forceinline__ void qk(f32x16& p0, f32x16& p1, ldsp kbuf, const bf16x8 (&qf)[4], float cinit, int r32, int hi) {
    f32x16 c;
#pragma unroll
    for (int r = 0; r < 16; ++r) c[r] = cinit;
#pragma unroll
    for (int s = 0; s < 4; ++s) {
        const bf16x8 k0 = *(const __attribute__((address_space(3))) bf16x8*)(kbuf + (2 * s + hi) * 1024 + r32 * 16);
        const bf16x8 k1 = *(const __attribute__((address_space(3))) bf16x8*)(kbuf + (2 * s + hi) * 1024 + r32 * 16 + 512);
        p0 = __builtin_amdgcn_mfma_f32_32x32x16_bf16(k0, qf[s], s == 0 ? c : p0, 0, 0, 0);
        p1 = __builtin_amdgcn_mfma_f32_32x32x16_bf16(k1, qf[s], s == 0 ? c : p1, 0, 0, 0);
    }
}
__device__ __forceinline__ void pv(f32x16 (&o)[2], ldsp vbuf, const f32x16& p0, const f32x16& p1, int lane, int hi) {
    unsigned pk[4][4];
#pragma unroll
    for (int k = 0; k < 4; ++k) { pk[0][k] = cvtpk(p0[2 * k], p0[2 * k + 1]); pk[1][k] = cvtpk(p0[8 + 2 * k], p0[9 + 2 * k]); pk[2][k] = cvtpk(p1[2 * k], p1[2 * k + 1]); pk[3][k] = cvtpk(p1[8 + 2 * k], p1[9 + 2 * k]); }
    const int vp0 = ((lane >> 4) & 1) * 32 + (lane & 3) * 8 + (4 * hi + ((lane & 15) >> 2)) * 64;
#pragma unroll
    for (int d0 = 0; d0 < 2; ++d0)
#pragma unroll
        for (int s = 0; s < 4; ++s) {
            const s16x4 lo = vtr(vbuf + d0 * 4096 + s * 1024 + vp0), hh = vtr(vbuf + d0 * 4096 + s * 1024 + 512 + vp0);
            const bf16x8 vf = (bf16x8){lo[0], lo[1], lo[2], lo[3], hh[0], hh[1], hh[2], hh[3]};
            typedef unsigned u32x4 __attribute__((ext_vector_type(4)));
            const u32x4 pw = (u32x4){pk[s][0], pk[s][1], pk[s][2], pk[s][3]};
            o[d0] = __builtin_amdgcn_mfma_f32_32x32x16_bf16(vf, __builtin_bit_cast(bf16x8, pw), o[d0], 0, 0, 0);
        }
}
struct Run { float l; f32x16 o[2]; };
template <bool EMASK> __device__ __forceinline__ void tile_step(Run& R, ldsp kbuf, ldsp vbuf, const bf16x8 (&qf)[4], bool row_on, int lo_b_, int hi_b_, int lane, int r32, int hi) {
    int lo_b = lo_b_ - 4 * hi, hi_b = hi_b_ - 4 * hi;
    if (EMASK) asm volatile("" : "+v"(lo_b), "+v"(hi_b));
    f32x16 p0, p1; qk(p0, p1, kbuf, qf, row_on ? 0.f : NEGB, r32, hi);
    float ls = 0.f;
#pragma unroll
    for (int r = 0; r < 16; ++r) {
        float e0 = __builtin_amdgcn_exp2f(p0[r]), e1 = __builtin_amdgcn_exp2f(p1[r]);
        if (EMASK) { const int kc_ = (r & 3) + 8 * (r >> 2); if (kc_ < lo_b || kc_ > hi_b) e0 = 0.f; if (kc_ + 32 < lo_b || kc_ + 32 > hi_b) e1 = 0.f; }
        p0[r] = e0; p1[r] = e1; ls += e0 + e1;
    }
    R.l += ls;
    pv(R.o, vbuf, p0, p1, lane, hi);
}
struct Tensors {
    const bf16_t* qn; const bf16_t* qr;
    const unsigned char* ksel; const unsigned char* vsel; const unsigned char* kwin; const unsigned char* vwin;
    const unsigned char* kc; const unsigned char* vc;
    const float* gates; bf16_t* ob;
};
template <bool SEL> __device__ __forceinline__ void branch(Run& R, const unsigned char* kimg, const unsigned char* vimg, int t0, int t1, int jdiag, unsigned long long selm, int iq,
                                                           const bf16x8 (&qf)[4], unsigned lds0, ldsp lds, int wid, int lane, int r32, int hi) {
    R.l = 0.f;
#pragma unroll
    for (int r = 0; r < 16; ++r) { R.o[0][r] = 0.f; R.o[1][r] = 0.f; }
    dma_tile(kimg + (size_t)t0 * TILE_B, lds0 + L_KB, wid, lane); dma_tile(vimg + (size_t)t0 * TILE_B, lds0 + L_VB, wid, lane);
    if (t0 < t1) { dma_tile(kimg + (size_t)(t0 + 1) * TILE_B, lds0 + L_KB + TILE_B, wid, lane); dma_tile(vimg + (size_t)(t0 + 1) * TILE_B, lds0 + L_VB + TILE_B, wid, lane); }
    int b = 0;
    for (int t = t0; t <= t1; ++t) {
        if (t < t1) ATT_WAIT_BAR(2); else ATT_WAIT_BAR(0);
        if (t + 2 <= t1) { const int b2 = (b >= 1) ? b - 1 : 2; dma_tile(kimg + (size_t)(t + 2) * TILE_B, lds0 + L_KB + b2 * TILE_B, wid, lane); dma_tile(vimg + (size_t)(t + 2) * TILE_B, lds0 + L_VB + b2 * TILE_B, wid, lane); }
        const bool row_on = !SEL || ((selm >> t) & 1ull);
        const bool lowm = !SEL && (t == jdiag - 8);
        if (t == jdiag || lowm) tile_step<true>(R, lds + L_KB + b * TILE_B, lds + L_VB + b * TILE_B, qf, row_on, lowm ? iq : 0, (t == jdiag) ? iq : 63, lane, r32, hi);
        else tile_step<false>(R, lds + L_KB + b * TILE_B, lds + L_VB + b * TILE_B, qf, row_on, 0, 63, lane, r32, hi);
        b = (b == 2) ? 0 : b + 1;
    }
    ATT_BAR_L();
}
__device__ __forceinline__ void load_q(bf16x8 (&qf)[4], const bf16_t* qrow, int hi) {
#pragma unroll
    for (int s = 0; s < 4; ++s) qf[s] = *(const bf16x8*)(qrow + 16 * s + 8 * hi);
}
__device__ __forceinline__ void unit(const Tensors& T, int n, int j, int g, ldsp lds, unsigned lds0, int wid, int lane_) {
    const int lane = (int)lane_id_v();
    const int r32 = lane & 31, hi = lane >> 5, ql = r32 >> 2, hq = r32 & 3, iq = 8 * wid + ql;
    const int row = n * SEQ + 64 * j + iq, head = g * HPG + hq, pos = 64 * j + iq;
    const size_t img_ng = ((size_t)n * N_KV + g);
    f32x16 oacc[2];
#pragma unroll
    for (int r = 0; r < 16; ++r) { oacc[0][r] = 0.f; oacc[1][r] = 0.f; }
    const float* gt = T.gates + (size_t)row * 3 * N_HEADS + head * 3;
    const float g_c = gt[0], g_s = gt[1], g_w = gt[2];
    bf16x8 qf[4];
    unsigned long long selm;
    {
        load_q(qf, T.qn + (size_t)row * HDM + head * HD, hi);
        const int ntc = (2 * j + 2 + 63) / 64;
        const unsigned char* kci = T.kc + img_ng * (NBC_P / 64) * TILE_B; const unsigned char* vci = T.vc + img_ng * (NBC_P / 64) * TILE_B;
        dma_tile(kci, lds0 + L_KB, wid, lane); dma_tile(vci, lds0 + L_VB, wid, lane);
        if (ntc > 1) { dma_tile(kci + TILE_B, lds0 + L_KB + TILE_B, wid, lane); dma_tile(vci + TILE_B, lds0 + L_VB + TILE_B, wid, lane); }
        ATT_WAIT_BAR(0);
        int cmax = ((pos + 1) >> 5) - 1 - 4 * hi;
        asm volatile("" : "+v"(cmax));
        f32x16 s0, s1, s2, s3;
        qk(s0, s1, lds + L_KB, qf, 0.f, r32, hi);
        if (ntc > 1) qk(s2, s3, lds + L_KB + TILE_B, qf, 0.f, r32, hi);
        else {
#pragma unroll
            for (int r = 0; r < 16; ++r) { s2[r] = NEGB; s3[r] = NEGB; }
        }
        float ls = 0.f;
#pragma unroll
        for (int r = 0; r < 16; ++r) { const int kv = (r & 3) + 8 * (r >> 2);
            s0[r] = (kv > cmax) ? 0.f : __builtin_amdgcn_exp2f(s0[r]); s1[r] = (kv + 32 > cmax) ? 0.f : __builtin_amdgcn_exp2f(s1[r]);
            s2[r] = (kv + 64 > cmax) ? 0.f : __builtin_amdgcn_exp2f(s2[r]); s3[r] = (kv + 96 > cmax) ? 0.f : __builtin_amdgcn_exp2f(s3[r]);
            ls += (s0[r] + s1[r]) + (s2[r] + s3[r]); }
        ls = halfsum(ls);
        const float inv = 1.0f / fmaxf(ls, 1e-30f);
#pragma unroll
        for (int r = 0; r < 16; ++r) { s0[r] *= inv; s1[r] *= inv; s2[r] *= inv; s3[r] *= inv; }
        __attribute__((address_space(3))) float* imp = (__attribute__((address_space(3))) float*)(lds + L_IMP) + iq * 64;
#pragma unroll
        for (int r = 0; r < 16; r += 2) { const int bl = crow(r, hi) >> 1;
            float v0 = s0[r] + s0[r + 1], v1 = s1[r] + s1[r + 1], v2 = s2[r] + s2[r + 1], v3 = s3[r] + s3[r + 1];
            v0 += __shfl_xor(v0, 1); v0 += __shfl_xor(v0, 2); v1 += __shfl_xor(v1, 1); v1 += __shfl_xor(v1, 2);
            v2 += __shfl_xor(v2, 1); v2 += __shfl_xor(v2, 2); v3 += __shfl_xor(v3, 1); v3 += __shfl_xor(v3, 2);
            if (hq == 0) { imp[bl] = v0; imp[16 + bl] = v1; imp[32 + bl] = v2; imp[48 + bl] = v3; } }
        Run Rc;
#pragma unroll
        for (int r = 0; r < 16; ++r) { Rc.o[0][r] = 0.f; Rc.o[1][r] = 0.f; }
        pv(Rc.o, lds + L_VB, s0, s1, lane, hi);
        if (ntc > 1) pv(Rc.o, lds + L_VB + TILE_B, s2, s3, lane, hi);
#pragma unroll
        for (int r = 0; r < 16; ++r) { oacc[0][r] += g_c * Rc.o[0][r]; oacc[1][r] += g_c * Rc.o[1][r]; }
        asm volatile("s_waitcnt lgkmcnt(0)" ::: "memory");
        __attribute__((address_space(3))) unsigned long long* selw = (__attribute__((address_space(3))) unsigned long long*)(lds + L_SELM);
        for (int qq = 0; qq < 8; ++qq) {
            const float v = ((__attribute__((address_space(3))) float*)(lds + L_IMP))[(8 * wid + qq) * 64 + lane];
            const bool valid = lane <= j, forced = (lane == 0) || (lane == j) || (lane == j - 1);
            const unsigned key = valid ? (forced ? 0x7f000000u : __float_as_uint(v) + 1u) : 0u;
            unsigned long long m;
            if (j + 1 <= N_SEL) m = __ballot(valid);
            else {
                unsigned Tt = 0u; bool exact = false; unsigned long long mex = 0ull;
                for (int bit = 30; bit >= 0; --bit) { const unsigned cand = Tt | (1u << bit); const unsigned long long ge = __ballot(key >= cand); const int cnt = __popcll(ge);
                    if (cnt == N_SEL) { exact = true; mex = ge; break; }
                    if (cnt > N_SEL) Tt = cand; }
                if (exact) m = mex;
                else {
                    const unsigned long long gtm = __ballot(key > Tt), eqm = __ballot(key == Tt);
                    const int need = N_SEL - __popcll(gtm);
                    const bool pick = (key == Tt) && (__popcll(eqm & ((1ull << lane) - 1ull)) < need);
                    m = gtm | __ballot(pick);
                }
            }
            if (lane == 0) selw[8 * wid + qq] = m;
        }
        asm volatile("s_waitcnt lgkmcnt(0)" ::: "memory");
        selm = selw[iq];
        ATT_WAIT_BAR(0);
    }
    load_q(qf, T.qr + (size_t)row * HDM + head * HD, hi);
    {
        Run R; branch<true>(R, T.ksel + img_ng * (SEQ / 64) * TILE_B, T.vsel + img_ng * (SEQ / 64) * TILE_B, 0, j, j, selm, iq, qf, lds0, lds, wid, lane, r32, hi);
        const float sc = g_s / fmaxf(halfsum(R.l), 1e-30f);
#pragma unroll
        for (int r = 0; r < 16; ++r) { oacc[0][r] += sc * R.o[0][r]; oacc[1][r] += sc * R.o[1][r]; }
    }
    {
        Run R; branch<false>(R, T.kwin + img_ng * (SEQ / 64) * TILE_B, T.vwin + img_ng * (SEQ / 64) * TILE_B, j > 8 ? j - 8 : 0, j, j, 0ull, iq, qf, lds0, lds, wid, lane, r32, hi);
        const float sc = g_w / fmaxf(halfsum(R.l), 1e-30f);
#pragma unroll
        for (int r = 0; r < 16; ++r) { oacc[0][r] += sc * R.o[0][r]; oacc[1][r] += sc * R.o[1][r]; }
    }
    bf16_t* orow = T.ob + (size_t)row * HDM + head * HD;
#pragma unroll
    for (int d0 = 0; d0 < 2; ++d0)
#pragma unroll
        for (int rr = 0; rr < 4; ++rr) { typedef unsigned u32x2 __attribute__((ext_vector_type(2)));
            u32x2 w; w.x = cvtpk(oacc[d0][4 * rr], oacc[d0][4 * rr + 1]); w.y = cvtpk(oacc[d0][4 * rr + 2], oacc[d0][4 * rr + 3]);
            *(u32x2*)(orow + 32 * d0 + 8 * rr + 4 * hi) = w; }
}
}
namespace att {
constexpr int S_STAGE = 16384;
constexpr int S_XM = LDS_RING_C + 1024, S_XL = S_XM + 1024, S_IMP = S_XL + 1024, S_SELM = S_IMP + 8 * 128 * 4, S_END = S_SELM + 8 * 2 * 8;
struct STensors {
    const bf16_t* qn; const bf16_t* qr; const float* kc; const float* vc; const float* cache_kv; const int* page_table; const float* cache_win; const float* out; const float* winrows;
    const float* gates; bf16_t* ob;
};
typedef float f32x4_t __attribute__((ext_vector_type(4)));
__device__ __forceinline__ void stage_kv(ldsp kimg, ldsp vimg, const float* ksrc, const float* vsrc, int stride, int nrows, int lane) {
    typedef unsigned u32x4 __attribute__((ext_vector_type(4)));
    const int c = lane & 7;
#pragma unroll 1
    for (int ib = 0; ib < 8; ib += 4)
#pragma unroll
    for (int it = ib; it < ib + 4; ++it) {
        const int row = 8 * it + (lane >> 3);
        f32x4_t k0 = {0.f, 0.f, 0.f, 0.f}, k1 = k0, v0 = k0, v1 = k0;
        if (row < nrows) { const float* kp = ksrc + (size_t)row * stride + 8 * c; const float* vp = vsrc + (size_t)row * stride + 8 * c;
            k0 = *(const f32x4_t*)kp; k1 = *(const f32x4_t*)(kp + 4); v0 = *(const f32x4_t*)vp; v1 = *(const f32x4_t*)(vp + 4); }
        u32x4 kw, vw; kw.x = cvtpk(k0[0], k0[1]); kw.y = cvtpk(k0[2], k0[3]); kw.z = cvtpk(k1[0], k1[1]); kw.w = cvtpk(k1[2], k1[3]);
        vw.x = cvtpk(v0[0], v0[1]); vw.y = cvtpk(v0[2], v0[3]); vw.z = cvtpk(v1[0], v1[1]); vw.w = cvtpk(v1[2], v1[3]);
        *(__attribute__((address_space(3))) u32x4*)(kimg + c * 1024 + row * 16) = kw;
        *(__attribute__((address_space(3))) u32x4*)(vimg + (c >> 2) * 4096 + (row >> 3) * 512 + (row & 7) * 64 + (c & 3) * 16) = vw;
    }
    asm volatile("s_waitcnt lgkmcnt(0)" ::: "memory");
}
#define ATT_BAR_ALL() asm volatile("s_waitcnt vmcnt(0) lgkmcnt(0)\n\ts_barrier" ::: "memory")
__device__ __forceinline__ float merge_sum(ldsp lds, float l_own_half, int wid, int r32, int hi) {
    __attribute__((address_space(3))) float* xl = (__attribute__((address_space(3))) float*)(lds + S_XL);
    const float l_own = halfsum(l_own_half);
    if (hi == 0) xl[wid * 32 + r32] = l_own;
    ATT_BAR_ALL();
    float L = 0.f;
#pragma unroll
    for (int w = 0; w < 8; ++w) L += xl[w * 32 + r32];
    ATT_BAR_ALL();
    return 1.0f / fmaxf(L, 1e-30f);
}
__device__ __forceinline__ void sample_unit(const STensors& T, int b, int g, ldsp lds, int wid, int lane_) {
    const int lane = (int)lane_id_v();
    const int r32 = lane & 31, hi = lane >> 5, ql = r32 >> 2, hq = r32 & 3;
    const int row = MP + b * DEC_SEQ + ql, head = g * HPG + hq, seq = BATCH + b;
    ldsp kimg = lds + wid * S_STAGE, vimg = kimg + TILE_B;
    f32x16 oacc[2];
#pragma unroll
    for (int r = 0; r < 16; ++r) { oacc[0][r] = 0.f; oacc[1][r] = 0.f; }
    const float* gt = T.gates + (size_t)row * 3 * N_HEADS + head * 3;
    const float g_c = gt[0], g_s = gt[1], g_w = gt[2];
    bf16x8 qf[4];
    __attribute__((address_space(3))) float* xm = (__attribute__((address_space(3))) float*)(lds + S_XM); __attribute__((address_space(3))) float* xl = (__attribute__((address_space(3))) float*)(lds + S_XL);
    __attribute__((address_space(3))) float* imp = (__attribute__((address_space(3))) float*)(lds + S_IMP);
    __attribute__((address_space(3))) unsigned long long* selw = (__attribute__((address_space(3))) unsigned long long*)(lds + S_SELM);
    {
        load_q(qf, T.qn + (size_t)row * HDM + head * HD, hi);
        constexpr int NTC = NBC_PAST / 64;
        f32x16 p0, p1; const bool mine = wid < NTC;
        float ls = 0.f;
        if (mine) {
            const float* kcp = T.kc + (((size_t)seq * NBC_MAX + 64 * wid) * N_KV + g) * HD; const float* vcp = T.vc + (((size_t)seq * NBC_MAX + 64 * wid) * N_KV + g) * HD;
            stage_kv(kimg, vimg, kcp, vcp, N_KV * HD, 64, lane);
            qk(p0, p1, kimg, qf, 0.f, r32, hi);
#pragma unroll
            for (int r = 0; r < 16; ++r) { p0[r] = __builtin_amdgcn_exp2f(p0[r]); p1[r] = __builtin_amdgcn_exp2f(p1[r]); ls += p0[r] + p1[r]; }
            ls = halfsum(ls);
        }
        if (hi == 0) xl[wid * 32 + r32] = ls;
        ATT_BAR_ALL();
        float L = 0.f;
#pragma unroll
        for (int w = 0; w < 8; ++w) L += xl[w * 32 + r32];
        const float inv = 1.0f / fmaxf(L, 1e-30f);
        if (mine) {
#pragma unroll
            for (int r = 0; r < 16; ++r) { p0[r] *= inv; p1[r] *= inv; }
#pragma unroll
            for (int r = 0; r < 16; r += 2) { const int bl = crow(r, hi) >> 1;
                float v0 = p0[r] + p0[r + 1], v1 = p1[r] + p1[r + 1];
                v0 += __shfl_xor(v0, 1); v0 += __shfl_xor(v0, 2); v1 += __shfl_xor(v1, 1); v1 += __shfl_xor(v1, 2);
                if (hq == 0) { imp[ql * 128 + 32 * wid + bl] = v0; imp[ql * 128 + 32 * wid + 16 + bl] = v1; } }
            Run Rc;
#pragma unroll
            for (int r = 0; r < 16; ++r) { Rc.o[0][r] = 0.f; Rc.o[1][r] = 0.f; }
            pv(Rc.o, vimg, p0, p1, lane, hi);
#pragma unroll
            for (int r = 0; r < 16; ++r) { oacc[0][r] += g_c * Rc.o[0][r]; oacc[1][r] += g_c * Rc.o[1][r]; }
        }
        ATT_BAR_ALL();
    }
    {
        constexpr int NCAND = NBS_S - 1;
        const float v0 = imp[wid * 128 + lane], v1 = imp[wid * 128 + 64 + lane];
        const unsigned key0 = (lane == 0) ? 0x7f000000u : __float_as_uint(v0) + 1u;
        const unsigned key1 = (lane + 64 == NCAND - 1) ? 0x7f000000u : __float_as_uint(v1) + 1u;
        unsigned Tt = 0u;
        for (int bit = 30; bit >= 0; --bit) { const unsigned cand = Tt | (1u << bit); if (__popcll(__ballot(key0 >= cand)) + __popcll(__ballot(key1 >= cand)) >= N_SEL - 1) Tt = cand; }
        const unsigned long long gt0 = __ballot(key0 > Tt), gt1 = __ballot(key1 > Tt), eq0 = __ballot(key0 == Tt), eq1 = __ballot(key1 == Tt);
        const int need = (N_SEL - 1) - __popcll(gt0) - __popcll(gt1);
        const unsigned long long below = (1ull << lane) - 1ull;
        const bool pick0 = (key0 == Tt) && (__popcll(eq0 & below) < need);
        const bool pick1 = (key1 == Tt) && (__popcll(eq0) + __popcll(eq1 & below) < need);
        const unsigned long long m0 = gt0 | __ballot(pick0), m1 = gt1 | __ballot(pick1);
        if (lane == 0) { selw[wid * 2] = m0; selw[wid * 2 + 1] = m1; }
        ATT_BAR_ALL();
    }
    load_q(qf, T.qr + (size_t)row * HDM + head * HD, hi);
    {
        unsigned long long U0 = 0ull, U1 = 0ull;
#pragma unroll
        for (int q = 0; q < 8; ++q) { U0 |= selw[q * 2]; U1 |= selw[q * 2 + 1]; }
        U0 = __builtin_amdgcn_readfirstlane((unsigned)U0) | ((unsigned long long)__builtin_amdgcn_readfirstlane((unsigned)(U0 >> 32)) << 32);
        U1 = __builtin_amdgcn_readfirstlane((unsigned)U1) | ((unsigned long long)__builtin_amdgcn_readfirstlane((unsigned)(U1 >> 32)) << 32);
        const unsigned long long my0 = selw[ql * 2], my1 = selw[ql * 2 + 1];
        Run R; R.l = 0.f;
#pragma unroll
        for (int r = 0; r < 16; ++r) { R.o[0][r] = 0.f; R.o[1][r] = 0.f; }
        int idx = 0;
        for (int half = 0; half < 2; ++half) {
            unsigned long long U = half ? U1 : U0;
            while (U) {
                const int bit = __builtin_ctzll(U); U &= U - 1ull;
                if ((idx++ & 7) != wid) continue;
                const int blk = 64 * half + bit;
                const int page = T.page_table[b * N_PAGES + (blk * L_SEL) / PAGE_SIZE];
                const float* base = T.cache_kv + (((size_t)page * PAGE_SIZE + (blk * L_SEL) % PAGE_SIZE) * 4) * N_KV * HD + g * HD;
                stage_kv(kimg, vimg, base + 2 * N_KV * HD, base + 3 * N_KV * HD, 4 * N_KV * HD, 64, lane);
                const bool selected = ((half ? my1 : my0) >> bit) & 1ull;
                tile_step<false>(R, kimg, vimg, qf, selected, 0, 63, lane, r32, hi);
            }
        }
        if ((idx & 7) == wid) {
            const float* base = T.out + O_KVS + (((size_t)b * DEC_SEQ) * 4) * N_KV * HD + g * HD;
            stage_kv(kimg, vimg, base + 2 * N_KV * HD, base + 3 * N_KV * HD, 4 * N_KV * HD, DEC_SEQ, lane);
            tile_step<true>(R, kimg, vimg, qf, true, 0, ql, lane, r32, hi);
        }
        const float wgt = merge_sum(lds, R.l, wid, r32, hi) * g_s;
#pragma unroll
        for (int r = 0; r < 16; ++r) { oacc[0][r] += wgt * R.o[0][r]; oacc[1][r] += wgt * R.o[1][r]; }
    }
    {
        Run R; R.l = 0.f;
#pragma unroll
        for (int r = 0; r < 16; ++r) { R.o[0][r] = 0.f; R.o[1][r] = 0.f; }
        for (int t = wid; t < WINDOW / 64; t += 8) {
            const float* base = T.cache_win + (((size_t)b * WINDOW + 64 * t) * 2) * N_KV * HD + g * HD;
            stage_kv(kimg, vimg, base, base + N_KV * HD, 2 * N_KV * HD, 64, lane);
            if (t == 0) tile_step<true>(R, kimg, vimg, qf, true, ql, 63, lane, r32, hi); else tile_step<false>(R, kimg, vimg, qf, true, 0, 63, lane, r32, hi);
        }
        if (wid == 0) {
            const float* base = T.winrows + (((size_t)(MP + b * DEC_SEQ)) * 2) * N_KV * HD + g * HD;
            stage_kv(kimg, vimg, base, base + N_KV * HD, 2 * N_KV * HD, DEC_SEQ, lane);
            tile_step<true>(R, kimg, vimg, qf, true, 0, ql, lane, r32, hi);
        }
        const float wgt = merge_sum(lds, R.l, wid, r32, hi) * g_w;
#pragma unroll
        for (int r = 0; r < 16; ++r) { oacc[0][r] += wgt * R.o[0][r]; oacc[1][r] += wgt * R.o[1][r]; }
    }
    {
        const int lane2 = (int)lane_id_v(), r32 = lane2 & 31, hi = lane2 >> 5;
        __attribute__((address_space(3))) float* mine = (__attribute__((address_space(3))) float*)(lds + wid * S_STAGE);
#pragma unroll
        for (int d0 = 0; d0 < 2; ++d0)
#pragma unroll
            for (int rr = 0; rr < 4; ++rr) *(__attribute__((address_space(3))) f32x4_t*)(mine + r32 * 64 + 32 * d0 + 8 * rr + 4 * hi) = (f32x4_t){oacc[d0][4 * rr], oacc[d0][4 * rr + 1], oacc[d0][4 * rr + 2], oacc[d0][4 * rr + 3]};
        ATT_BAR_ALL();
        const int tid = wid * 64 + (int)lane_id_v(), orow = tid >> 4, oc4 = (tid & 15) * 4;
        f32x4_t s = {0.f, 0.f, 0.f, 0.f};
#pragma unroll
        for (int w = 0; w < 8; ++w) s += *(const __attribute__((address_space(3))) f32x4_t*)((__attribute__((address_space(3))) float*)(lds + w * S_STAGE) + orow * 64 + oc4);
        typedef unsigned u32x2 __attribute__((ext_vector_type(2)));
        u32x2 wv; wv.x = cvtpk(s[0], s[1]); wv.y = cvtpk(s[2], s[3]);
        const int oq = orow >> 2, oh = orow & 3;
        *(u32x2*)(T.ob + (size_t)(MP + b * DEC_SEQ + oq) * HDM + (g * HPG + oh) * HD + oc4) = wv;
        ATT_BAR_ALL();
    }
}
constexpr int Q_SAMPLE = DEC_BATCH * N_KV, Q_PROMPT = BATCH * N_KV * (SEQ / 64), Q_TOTAL = Q_SAMPLE + Q_PROMPT;
constexpr int S_QHEAD = S_END;
__device__ __forceinline__ int claim_unit(unsigned* head, ldsp lds, int wid, int lane) {
    __attribute__((address_space(3))) int* qslot = (__attribute__((address_space(3))) int*)(lds + S_QHEAD);
    if (wid == 0 && lane == 0) *qslot = (int)__hip_atomic_fetch_add(head, 1u, __ATOMIC_RELAXED, __HIP_MEMORY_SCOPE_AGENT);
    ATT_BAR_ALL();
    const int u = __builtin_amdgcn_readfirstlane(*qslot);
    ATT_BAR_ALL();
    return u;
}
__device__ __forceinline__ void att_queue_sample(const STensors& TS, unsigned* head, ldsp lds, int wid, int lane) {
    for (;;) { const int u = claim_unit(head, lds, wid, lane); if (u >= Q_SAMPLE) break; sample_unit(TS, u / N_KV, u % N_KV, lds, wid, lane); }
}
__device__ __forceinline__ void att_queue_prompt(const Tensors& T, unsigned* head, ldsp lds, int wid, int lane) {
    const unsigned lds0 = (unsigned)(uintptr_t)lds;
    for (;;) { const int p = claim_unit(head, lds, wid, lane); if (p >= Q_PROMPT) break;
        const int j = (SEQ / 64 - 1) - p / (BATCH * N_KV), ng = p % (BATCH * N_KV); unit(T, ng / N_KV, j, ng % N_KV, lds, lds0, wid, lane); }
}
}


namespace att {
__device__ __forceinline__ void cmp_out_wave(int task, const bf16_t* hid, int R, int nbc, int seq0, const bf16_t* w2t, const float* k_norm0, float* kc, float* vc, unsigned char* kci, unsigned char* vci, int lane) {
    const int r32 = lane & 31, hi = lane >> 5;
    const int r0 = task * 32, e = r0 >= R ? 1 : 0, r = r0 - e * R + r32;
    const bf16_t* hrow = hid + ((size_t)e * R + r) * CMP_HID; const bf16_t* wrow = w2t + ((size_t)e * HD + r32) * CMP_HID;
    f32x16 o0, o1;
#pragma unroll
    for (int k = 0; k < 16; ++k) { o0[k] = 0.f; o1[k] = 0.f; }
#pragma unroll 4
    for (int s_ = 0; s_ < CMP_HID / 16; ++s_) {
        const bf16x8 hb_ = *(const bf16x8*)(hrow + 16 * s_ + 8 * hi);
        const bf16x8 w0 = *(const bf16x8*)(wrow + 16 * s_ + 8 * hi), w1 = *(const bf16x8*)(wrow + (size_t)32 * CMP_HID + 16 * s_ + 8 * hi);
        o0 = __builtin_amdgcn_mfma_f32_32x32x16_bf16(w0, hb_, o0, 0, 0, 0); o1 = __builtin_amdgcn_mfma_f32_32x32x16_bf16(w1, hb_, o1, 0, 0, 0);
    }
    if (e == 0) {
        float ss = 0.f;
#pragma unroll
        for (int k = 0; k < 16; ++k) ss += o0[k] * o0[k] + o1[k] * o1[k];
        ss = halfsum(ss);
        const float rn = rsqrtf(ss * (1.0f / HD) + EPS);
#pragma unroll
        for (int k = 0; k < 16; ++k) { o0[k] *= rn * k_norm0[crow(k, hi)]; o1[k] *= rn * k_norm0[32 + crow(k, hi)]; }
    }
    const int g = r % N_KV, c = (r / N_KV) % nbc, sq = r / (N_KV * nbc);
    float* dst = (e == 0 ? kc : vc) + (((size_t)(seq0 + sq) * NBC_MAX + c) * N_KV + g) * HD;
#pragma unroll
    for (int rr = 0; rr < 4; ++rr) { *(f32x4_t*)(dst + 8 * rr + 4 * hi) = (f32x4_t){o0[4 * rr], o0[4 * rr + 1], o0[4 * rr + 2], o0[4 * rr + 3]};
                                      *(f32x4_t*)(dst + 32 + 8 * rr + 4 * hi) = (f32x4_t){o1[4 * rr], o1[4 * rr + 1], o1[4 * rr + 2], o1[4 * rr + 3]}; }
    if (kci) {
        unsigned char* img = (e == 0 ? kci : vci) + (((size_t)sq * N_KV + g) * (NBC_P / 64) + c / 64) * 8192; const int kv = c % 64;
        typedef unsigned u32x2 __attribute__((ext_vector_type(2)));
#pragma unroll
        for (int rr = 0; rr < 4; ++rr) {
            u32x2 a; a.x = cvtpk(o0[4 * rr], o0[4 * rr + 1]); a.y = cvtpk(o0[4 * rr + 2], o0[4 * rr + 3]);
            u32x2 bq; bq.x = cvtpk(o1[4 * rr], o1[4 * rr + 1]); bq.y = cvtpk(o1[4 * rr + 2], o1[4 * rr + 3]);
            const int d0 = 8 * rr, d1 = 32 + 8 * rr;
            *(u32x2*)(img + (e == 0 ? kimg_off(kv, d0) : vimg_off(kv, d0)) + 8 * hi) = a;
            *(u32x2*)(img + (e == 0 ? kimg_off(kv, d1) : vimg_off(kv, d1)) + 8 * hi) = bq;
        }
    }
}
}
__device__ __forceinline__ void conv_thin_vec_item(size_t i_, const bf16_t* ub, const bf16_t* bb, const float* state, const float* wc, bf16_t* zb) {
    typedef unsigned u4 __attribute__((ext_vector_type(4)));
    const int m = (int)(i_ / (D_MODEL / 8)), ch = (int)(i_ % (D_MODEL / 8)) * 8;
    const RowInfo ri = row_info(m);
    const size_t o = (size_t)m * D_MODEL + ch;
    float u0[8], u1[8], u2[8], bv[8];
#define UNPK(w, f) do { f[0] = bf2f((bf16_t)((w).x & 0xffff)); f[1] = bf2f((bf16_t)((w).x >> 16)); f[2] = bf2f((bf16_t)((w).y & 0xffff)); f[3] = bf2f((bf16_t)((w).y >> 16)); \
                        f[4] = bf2f((bf16_t)((w).z & 0xffff)); f[5] = bf2f((bf16_t)((w).z >> 16)); f[6] = bf2f((bf16_t)((w).w & 0xffff)); f[7] = bf2f((bf16_t)((w).w >> 16)); } while (0)
    { const u4 w = *(const u4*)(ub + o); UNPK(w, u0); } { const u4 w = *(const u4*)(bb + o); UNPK(w, bv); }
    const float* st = (ri.seq >= BATCH) ? state + (size_t)(ri.seq - BATCH) * 2 * D_MODEL + ch : nullptr;
    if (ri.t >= 1) { const u4 w = *(const u4*)(ub + o - D_MODEL); UNPK(w, u1); } else { for (int k = 0; k < 8; ++k) u1[k] = st ? st[D_MODEL + k] : 0.f; }
    if (ri.t >= 2) { const u4 w = *(const u4*)(ub + o - 2 * D_MODEL); UNPK(w, u2); } else { for (int k = 0; k < 8; ++k) u2[k] = st ? (ri.t == 1 ? st[D_MODEL + k] : st[k]) : 0.f; }
#undef UNPK
    float z[8];
    for (int k = 0; k < 8; ++k) z[k] = bv[k] * (wc[ch + k] * u2[k] + wc[D_MODEL + ch + k] * u1[k] + wc[2 * D_MODEL + ch + k] * u0[k]);
    u4 w; w.x = (unsigned)f2bf(z[0]) | ((unsigned)f2bf(z[1]) << 16); w.y = (unsigned)f2bf(z[2]) | ((unsigned)f2bf(z[3]) << 16);
    w.z = (unsigned)f2bf(z[4]) | ((unsigned)f2bf(z[5]) << 16); w.w = (unsigned)f2bf(z[6]) | ((unsigned)f2bf(z[7]) << 16);
    *(u4*)(zb + o) = w;
}

namespace att {
__device__ __forceinline__ void skinny_task(int task, const bf16_t* A, const bf16_t* Bt, int N, int K, int KS, float* part, int lane) {
    const int r32 = lane & 31, hi = lane >> 5, ncb = N / 32, nrb = MS / 32;
    const int ks = task / (nrb * ncb), rem = task % (nrb * ncb), rb = rem / ncb, cb = rem % ncb, klen = K / KS, k0 = ks * klen;
    const bf16_t* ap = A + (size_t)(rb * 32 + r32) * K + k0 + 8 * hi; const bf16_t* bp = Bt + (size_t)(cb * 32 + r32) * K + k0 + 8 * hi;
    f32x16 acc;
#pragma unroll
    for (int k = 0; k < 16; ++k) acc[k] = 0.f;
#pragma unroll 8
    for (int s_ = 0; s_ < klen / 16; ++s_) acc = __builtin_amdgcn_mfma_f32_32x32x16_bf16(*(const bf16x8*)(bp + 16 * s_), *(const bf16x8*)(ap + 16 * s_), acc, 0, 0, 0);
    float* dst = part + ((size_t)ks * MS + rb * 32 + r32) * N + cb * 32 + 4 * hi;
#pragma unroll
    for (int rr = 0; rr < 4; ++rr) *(f32x4_t*)(dst + 8 * rr) = (f32x4_t){acc[4 * rr], acc[4 * rr + 1], acc[4 * rr + 2], acc[4 * rr + 3]};
}
__device__ __forceinline__ void resid_reduce_row(int rs_, const float* part, int KS, float coef, bf16_t* hb, float* rss_next, float* yout, int lane) {
    typedef unsigned u2 __attribute__((ext_vector_type(2)));
    const int m = MP + rs_; float ssq = 0.f;
#pragma unroll
    for (int j = 0; j < D_MODEL / 256; ++j) {
        const int col = 256 * j + 4 * lane; f32x4_t a = {0.f, 0.f, 0.f, 0.f};
        for (int ks = 0; ks < KS; ++ks) a += *(const f32x4_t*)(part + ((size_t)ks * MS + rs_) * D_MODEL + col);
        const u2 ho = *(const u2*)(hb + (size_t)m * D_MODEL + col);
        const f32x4_t v = (f32x4_t){__uint_as_float(ho.x << 16), __uint_as_float(ho.x & 0xffff0000u), __uint_as_float(ho.y << 16), __uint_as_float(ho.y & 0xffff0000u)} + a * coef;
        if (yout) *(f32x4_t*)(yout + (size_t)m * D_MODEL + col) = v;
        else { u2 w; w.x = cvtpk(v[0], v[1]); w.y = cvtpk(v[2], v[3]); *(u2*)(hb + (size_t)m * D_MODEL + col) = w;
               ssq += (v[0] * v[0] + v[1] * v[1]) + (v[2] * v[2] + v[3] * v[3]); }
    }
    if (!yout) {
#pragma unroll
        for (int o = 1; o < 64; o <<= 1) ssq += __shfl_xor(ssq, o);
        if (lane == 0) ((unsigned*)rss_next)[m] = rss_enc(ssq);
    }
}
}
__device__ __forceinline__ void conv_thin_sample_item(size_t i_, const float* part, int KS, const float* rss, const float* state, const float* wc, bf16_t* zb, float* out, int layer) {
    const int rs_ = (int)(i_ / (D_MODEL / 8)), ch = (int)(i_ % (D_MODEL / 8)) * 8, m = MP + rs_;
    const RowInfo ri = row_info(m);
    const int nc = (ch / 128) * 256 + (ch % 128);
    float u[3][8], bv[8];
    for (int back = 0; back < 3; ++back) {
        if (ri.t - back >= 0) {
            const int r2 = rs_ - back; const float rsn = rsqrtf(rss_dec(rss[MP + r2]) * (1.0f / D_MODEL) + EPS);
            for (int k = 0; k < 8; ++k) { float c = 0.f, x = 0.f; for (int ks = 0; ks < KS; ++ks) { const float* p = part + ((size_t)ks * MS + r2) * 3 * D_MODEL; c += p[nc + k]; x += p[nc + 128 + k]; } u[back][k] = (c * rsn) * (x * rsn); }
        } else { const float* st = state + (size_t)(ri.seq - BATCH) * 2 * D_MODEL + ch;
            const int srow = 2 - (back - ri.t); for (int k = 0; k < 8; ++k) u[back][k] = st[(size_t)srow * D_MODEL + k]; }
    }
    { const float rsn = rsqrtf(rss_dec(rss[m]) * (1.0f / D_MODEL) + EPS);
      for (int k = 0; k < 8; ++k) { float b = 0.f; for (int ks = 0; ks < KS; ++ks) b += part[((size_t)ks * MS + rs_) * 3 * D_MODEL + 2 * D_MODEL + ch + k]; bv[k] = b * rsn; } }
    for (int k = 0; k < 8; ++k) { const float ub0 = bf2f(f2bf(u[0][k])), ub1 = (ri.t >= 1) ? bf2f(f2bf(u[1][k])) : u[1][k], ub2 = (ri.t >= 2) ? bf2f(f2bf(u[2][k])) : u[2][k];
        zb[(size_t)m * D_MODEL + ch + k] = f2bf(bf2f(f2bf(bv[k])) * (wc[ch + k] * ub2 + wc[D_MODEL + ch + k] * ub1 + wc[2 * D_MODEL + ch + k] * ub0));
        if (ri.t >= DEC_SEQ - 2) out[O_CS + (((size_t)layer * DEC_BATCH + (ri.seq - BATCH)) * 2 + (ri.t - (DEC_SEQ - 2))) * D_MODEL + ch + k] = u[0][k]; }
}

__device__ __forceinline__ void acmp_sample_wave(int task, const float* cache_kv, const int* page_table, const float* pe, bf16_t* A, int lane) {
    typedef float f4 __attribute__((ext_vector_type(4))); typedef unsigned u4 __attribute__((ext_vector_type(4)));
    const int b = task / NBC_PAST, c = task % NBC_PAST, tok0 = c * L_CMP;
    const int page = page_table[b * N_PAGES + tok0 / PAGE_SIZE];
    const int e = lane >> 5, g = (lane >> 3) & (N_KV - 1), c8 = lane & 7;
    const float* src = cache_kv + ((size_t)page * PAGE_SIZE + tok0 % PAGE_SIZE) * 4 * N_KV * HD + lane * 8;
    const float* pp = pe + (size_t)e * L_CMP * HD + 8 * c8;
    bf16_t* dst = A + ((size_t)e * RS_CMP + ((size_t)b * NBC_PAST + c) * N_KV + g) * (L_CMP * HD) + 8 * c8;
#pragma unroll 8
    for (int l = 0; l < L_CMP; ++l) {
        const f4 a0 = __builtin_nontemporal_load((const f4*)(src + (size_t)l * 4 * N_KV * HD)) + *(const f4*)(pp + l * HD), a1 = __builtin_nontemporal_load((const f4*)(src + (size_t)l * 4 * N_KV * HD + 4)) + *(const f4*)(pp + l * HD + 4);
        u4 w; w.x = att::cvtpk(a0[0], a0[1]); w.y = att::cvtpk(a0[2], a0[3]); w.z = att::cvtpk(a1[0], a1[1]); w.w = att::cvtpk(a1[2], a1[3]);
        *(u4*)(dst + l * HD) = w;
    }
}
__device__ __forceinline__ void wconv_tile(int item, const float* src, int Nsrc, const float* gain, bf16_t* dst, int Nd, int K, int kind, int aux, LAS float* scr, int lane) {
    const int nblk = Nd / 32, kb = item / nblk, nb = item % nblk, k0 = 64 * kb, n0 = 32 * nb;
    const int colbase = colmap(kind, n0, aux);
    const int col = colbase + (lane & 31); const bool ok = colbase >= 0 && col < Nsrc;
    float tv[32];
    const float* sp0 = src + (size_t)(k0 + (lane >> 5)) * Nsrc + (ok ? col : 0);
#pragma unroll
    for (int i = 0; i < 32; ++i) tv[i] = ok ? __builtin_nontemporal_load(sp0 + (size_t)(2 * i) * Nsrc) : 0.f;
#pragma unroll
    for (int i = 0; i < 32; ++i) { const int kk = 2 * i + (lane >> 5); const float g = gain ? gain[k0 + kk] : 1.f; scr[kk * 33 + (lane & 31)] = tv[i] * g; }
    asm volatile("s_waitcnt lgkmcnt(0)" ::: "memory");
    const int c = lane & 7;
#pragma unroll
    for (int j = 0; j < 4; ++j) { const int n = (lane >> 3) + 8 * j; const LAS float* sp = scr + (8 * c) * 33 + n;
        typedef unsigned v4u __attribute__((ext_vector_type(4)));
        v4u o; o.x = pg8::cvt_pk_bf16(sp[0 * 33], sp[1 * 33]); o.y = pg8::cvt_pk_bf16(sp[2 * 33], sp[3 * 33]); o.z = pg8::cvt_pk_bf16(sp[4 * 33], sp[5 * 33]); o.w = pg8::cvt_pk_bf16(sp[6 * 33], sp[7 * 33]);
        *(v4u*)(dst + (size_t)(n0 + n) * K + k0 + 8 * c) = o; }
    asm volatile("s_waitcnt lgkmcnt(0)" ::: "memory");
}
__device__ __forceinline__ void hinit_row(int m, const float* xp, const float* xs, float* h, bf16_t* hb, float* rss0, int lane) {
    typedef float f4 __attribute__((ext_vector_type(4))); typedef unsigned u2 __attribute__((ext_vector_type(2)));
    const float* x = m < MP ? xp + (size_t)m * D_MODEL : xs + (size_t)(m - MP) * D_MODEL;
    float s = 0.f;
#pragma unroll
    for (int j = 0; j < D_MODEL / 256; ++j) { const f4 v = *(const f4*)(x + 256 * j + 4 * lane); s += (v[0] * v[0] + v[1] * v[1]) + (v[2] * v[2] + v[3] * v[3]);
        u2 w; w.x = pg8::cvt_pk_bf16(v[0], v[1]); w.y = pg8::cvt_pk_bf16(v[2], v[3]); *(u2*)(hb + (size_t)m * D_MODEL + 256 * j + 4 * lane) = w; }
#pragma unroll
    for (int o = 1; o < 64; o <<= 1) s += __shfl_xor(s, o);
    if (lane == 0) ((unsigned*)rss0)[m] = rss_enc(s);
}
#endif

#ifndef CPU_TEST
__device__ __forceinline__ size_t opaque_gtid(int wave) { int w = wave; asm volatile("" : "+s"(w)); unsigned t = blockIdx.x * NTHREADS + w * 64 + lane_id_v(); return (size_t)t; }
#define ITEM_LOOP(total) for (size_t i = opaque_gtid(wave_id); i < (size_t)(total); i += (size_t)gridDim.x * NTHREADS)
#else
#define ITEM_LOOP(total) _Pragma("omp parallel for schedule(dynamic, 64)") for (long long i = 0; i < (long long)(total); ++i)
#endif

struct Params {
    const float *x_prompt, *x_sample, *cache_kv, *cache_win, *state_conv; const int* page_table;
    const float *ffn_a_norm, *ffn_a_w_in, *ffn_a_w_out, *mix_norm, *ffn_b_norm, *ffn_b_w_in, *ffn_b_w_out, *conv_w_in, *conv_w, *conv_w_out, *kv_norm, *w_kv, *k_norm,
                *cmp_pe, *cmp_w1, *cmp_w2, *nsa_w_qg, *nsa_q_norm, *nsa_w_o;
    float* out; unsigned char* ws;
};
constexpr int LDS_RING = 131072, LDS_BAR_OFF = LDS_RING + 352, LDS_BYTES = 147456;

#ifndef CPU_TEST
typedef const __attribute__((address_space(4))) Params* KParamsPtr;
__device__ __forceinline__ KParamsPtr kparams_ptr() {
#if defined(__HIP_DEVICE_COMPILE__)
    KParamsPtr p = (KParamsPtr)__builtin_amdgcn_kernarg_segment_ptr(); asm volatile("" : "+s"(p)); return p;
#else
    return nullptr;
#endif
}
__device__ __forceinline__ Params load_params() {
#if defined(__HIP_DEVICE_COMPILE__)
    return *kparams_ptr();
#else
    return Params{};
#endif
}
__device__ __forceinline__ unsigned char* load_ws() {
#if defined(__HIP_DEVICE_COMPILE__)
    return kparams_ptr()->ws;
#else
    return nullptr;
#endif
}
#define KP const Params P = load_params()
__device__ __forceinline__ int opaque_s(int v) { asm volatile("" : "+s"(v)); return v; }
#define GRID_SYNC() do { XcdBarrier bar_; bar_.bar = (GU*)load_ws() + 1024; bar_.x = 0; bar_.st = (volatile LAS unsigned*)(lds + LDS_BAR_OFF); xcd_barrier(bar_, wave_id == 0 && lane_id_v() == 0u); } while (0)
__global__ void __launch_bounds__(NTHREADS, 2) mega(Params P_unused)
#else
static Params g_params;
#define KP const Params& P = g_params
#define GRID_SYNC() do {} while (0)
void mega(Params P_unused)
#endif
{
#ifndef CPU_TEST
    extern __shared__ __attribute__((aligned(16))) unsigned char lds[];
    const int wave_id = __builtin_amdgcn_readfirstlane((int)(threadIdx.x >> 6));
    if (threadIdx.x < 4) ((LAS unsigned*)(lds + LDS_BAR_OFF))[threadIdx.x] = 0u;
    __syncthreads();
    (void)xcd_barrier_post((GU*)load_ws() + 1024, (volatile LAS unsigned*)(lds + LDS_BAR_OFF), threadIdx.x == 0);
#define RING ((PG8_LAS unsigned char*)lds)
#else
    g_params = P_unused;
#endif
#define WS_F(f) ((float*)(P.ws + WSM.f))
#define WS_B(f) ((bf16_t*)(P.ws + WSM.f))
#define KVSRC KvSrc{P.cache_kv, P.page_table, P.out}
#define PH(total, call) do { { KP; ITEM_LOOP(total) call; } GRID_SYNC(); } while (0)
#ifdef CPU_TEST
    for (int L = 0; L < DEPTH; ++L) {
        KP;
        ITEM_LOOP((size_t)2 * D_FF * (D_MODEL / 64)) wconv_item(i, P.ffn_a_w_in + (size_t)L * D_MODEL * 2 * D_FF, 2 * D_FF, P.ffn_a_norm + (size_t)L * D_MODEL, WS_B(w_ain) + (size_t)L * 2 * D_FF * D_MODEL, 2 * D_FF, D_MODEL, CM_PAIR, D_FF);
        ITEM_LOOP((size_t)D_MODEL * (D_FF / 64)) wconv_item(i, P.ffn_a_w_out + (size_t)L * D_FF * D_MODEL, D_MODEL, nullptr, WS_B(w_aout) + (size_t)L * D_MODEL * D_FF, D_MODEL, D_FF, CM_PLAIN, 0);
        ITEM_LOOP((size_t)2 * D_FF * (D_MODEL / 64)) wconv_item(i, P.ffn_b_w_in + (size_t)L * D_MODEL * 2 * D_FF, 2 * D_FF, P.ffn_b_norm + (size_t)L * D_MODEL, WS_B(w_bin) + (size_t)L * 2 * D_FF * D_MODEL, 2 * D_FF, D_MODEL, CM_PAIR, D_FF);
        ITEM_LOOP((size_t)D_MODEL * (D_FF / 64)) wconv_item(i, P.ffn_b_w_out + (size_t)L * D_FF * D_MODEL, D_MODEL, nullptr, WS_B(w_bout) + (size_t)L * D_MODEL * D_FF, D_MODEL, D_FF, CM_PLAIN, 0);
    }
    for (int L = 0; L < N_A; ++L) {
        KP;
        ITEM_LOOP((size_t)3 * D_MODEL * (D_MODEL / 64)) wconv_item(i, P.conv_w_in + (size_t)L * D_MODEL * 3 * D_MODEL, 3 * D_MODEL, P.mix_norm + (size_t)L * D_MODEL, WS_B(w_cin) + (size_t)L * 3 * D_MODEL * D_MODEL, 3 * D_MODEL, D_MODEL, CM_CONV, 0);
        ITEM_LOOP((size_t)D_MODEL * (D_MODEL / 64)) wconv_item(i, P.conv_w_out + (size_t)L * D_MODEL * D_MODEL, D_MODEL, nullptr, WS_B(w_cout) + (size_t)L * D_MODEL * D_MODEL, D_MODEL, D_MODEL, CM_PLAIN, 0);
    }
    for (int b = 0; b < N_B; ++b) {
        KP;
        ITEM_LOOP((size_t)QGP * (D_MODEL / 64)) wconv_item(i, P.nsa_w_qg + (size_t)b * D_MODEL * QGW, QGW, P.mix_norm + (size_t)(N_A + b) * D_MODEL, WS_B(w_qg) + (size_t)b * QGP * D_MODEL, QGP, D_MODEL, CM_HEADS, N_HEADS);
        ITEM_LOOP((size_t)D_MODEL * (HDM / 64)) wconv_item(i, P.nsa_w_o + (size_t)b * HDM * D_MODEL, D_MODEL, nullptr, WS_B(w_o) + (size_t)b * D_MODEL * HDM, D_MODEL, HDM, CM_PLAIN, 0);
    }
    { KP; ITEM_LOOP((size_t)KVW * (D_MODEL / 64)) wconv_item(i, P.w_kv, KVW, P.kv_norm, WS_B(w_kv), KVW, D_MODEL, CM_HEADS, 6 * N_KV); }
    { KP; ITEM_LOOP((size_t)NPOS * 8) rope_item(i, WS_F(rope)); }
    { KP; ITEM_LOOP(MT) hinit_item(i, P.x_prompt, P.x_sample, WS_F(h), WS_B(hb), WS_F(rss)); }
#else
#define WAVE_ITEMS(total) for (int it_ = (int)(opaque_s((int)blockIdx.x) * 8 + wave_id); it_ < (int)(total); it_ += (int)gridDim.x * 8)
#define WCONV(srcp, Nsrc_, gainp, dstp, Nd_, K_, kind_, aux_) do { KP; LAS float* scr_ = (LAS float*)(lds + wave_id * 16384); const int lane_ = (int)lane_id_v(); \
        WAVE_ITEMS(((Nd_) / 32) * ((K_) / 64)) wconv_tile(it_, srcp, Nsrc_, gainp, dstp, Nd_, K_, kind_, aux_, scr_, lane_); } while (0)
    for (int L = 0; L < DEPTH; ++L) {
        WCONV(P.ffn_a_w_in + (size_t)L * D_MODEL * 2 * D_FF, 2 * D_FF, P.ffn_a_norm + (size_t)L * D_MODEL, WS_B(w_ain) + (size_t)L * 2 * D_FF * D_MODEL, 2 * D_FF, D_MODEL, CM_PAIR, D_FF);
        WCONV(P.ffn_a_w_out + (size_t)L * D_FF * D_MODEL, D_MODEL, nullptr, WS_B(w_aout) + (size_t)L * D_MODEL * D_FF, D_MODEL, D_FF, CM_PLAIN, 0);
        WCONV(P.ffn_b_w_in + (size_t)L * D_MODEL * 2 * D_FF, 2 * D_FF, P.ffn_b_norm + (size_t)L * D_MODEL, WS_B(w_bin) + (size_t)L * 2 * D_FF * D_MODEL, 2 * D_FF, D_MODEL, CM_PAIR, D_FF);
        WCONV(P.ffn_b_w_out + (size_t)L * D_FF * D_MODEL, D_MODEL, nullptr, WS_B(w_bout) + (size_t)L * D_MODEL * D_FF, D_MODEL, D_FF, CM_PLAIN, 0);
    }
    for (int L = 0; L < N_A; ++L) {
        WCONV(P.conv_w_in + (size_t)L * D_MODEL * 3 * D_MODEL, 3 * D_MODEL, P.mix_norm + (size_t)L * D_MODEL, WS_B(w_cin) + (size_t)L * 3 * D_MODEL * D_MODEL, 3 * D_MODEL, D_MODEL, CM_CONV, 0);
        WCONV(P.conv_w_out + (size_t)L * D_MODEL * D_MODEL, D_MODEL, nullptr, WS_B(w_cout) + (size_t)L * D_MODEL * D_MODEL, D_MODEL, D_MODEL, CM_PLAIN, 0);
    }
    for (int b = 0; b < N_B; ++b) {
        WCONV(P.nsa_w_qg + (size_t)b * D_MODEL * QGW, QGW, P.mix_norm + (size_t)(N_A + b) * D_MODEL, WS_B(w_qg) + (size_t)b * QGP * D_MODEL, QGP, D_MODEL, CM_HEADS, N_HEADS);
        WCONV(P.nsa_w_o + (size_t)b * HDM * D_MODEL, D_MODEL, nullptr, WS_B(w_o) + (size_t)b * D_MODEL * HDM, D_MODEL, HDM, CM_PLAIN, 0);
    }
    WCONV(P.w_kv, KVW, P.kv_norm, WS_B(w_kv), KVW, D_MODEL, CM_HEADS, 6 * N_KV);
    { KP; ITEM_LOOP((size_t)NPOS * 8) rope_item(i, WS_F(rope)); }
    { KP; const int lane_ = (int)lane_id_v(); WAVE_ITEMS(MT) hinit_row(it_, P.x_prompt, P.x_sample, WS_F(h), WS_B(hb), WS_F(rss), lane_); }
#endif
#ifndef CPU_TEST
    for (int e = 0; e < 2; ++e) WCONV(P.cmp_w1 + (size_t)e * L_CMP * HD * CMP_HID, CMP_HID, nullptr, WS_B(w1t) + (size_t)e * CMP_HID * L_CMP * HD, CMP_HID, L_CMP * HD, CM_PLAIN, 0);
    for (int e = 0; e < 2; ++e) WCONV(P.cmp_w2 + (size_t)e * CMP_HID * HD, HD, nullptr, WS_B(w2t) + (size_t)e * HD * CMP_HID, HD, CMP_HID, CM_PLAIN, 0);
    { KP; const int lane_ = (int)lane_id_v(); static_assert(N_KV == 4 && 2 * N_KV * 8 == 64, "acmp_sample_wave lane map"); WAVE_ITEMS(DEC_BATCH * NBC_PAST) acmp_sample_wave(it_, P.cache_kv, P.page_table, P.cmp_pe, WS_B(acs), lane_); }
#endif
    GRID_SYNC();
#ifndef CPU_TEST
    { KP; pg8::Gemm g{WS_B(acs), WS_B(w1t), 2 * RS_CMP, 2 * CMP_HID, L_CMP * HD}; pg8::CmpOrder So{2 * RS_CMP / 256, RS_CMP / 256, opaque_s((int)gridDim.x), opaque_s((int)blockIdx.x)};
      pg8::EpiGelu E{WS_B(hids)}; pg8::gemm_phase<pg8::EpiGelu, pg8::CmpOrder, true, true>(wave_id, RING, g, So, E); }
    GRID_SYNC();
    { KP; const int lane_ = (int)lane_id_v(); WAVE_ITEMS(2 * RS_CMP / 32) att::cmp_out_wave(it_, WS_B(hids), RS_CMP, NBC_PAST, BATCH, WS_B(w2t), P.k_norm, WS_F(kc), WS_F(vc), nullptr, nullptr, lane_); }
    GRID_SYNC();
#endif

#ifndef CPU_TEST
#define RESID_PH(Aptr, Btptr, Kk, KSn, v_out, coef_, last_) do { \
        { KP; const int lane_ = (int)lane_id_v(); WAVE_ITEMS((MS / 32) * (D_MODEL / 32) * (KSn)) att::skinny_task(it_, (Aptr) + (size_t)MP * (Kk), Btptr, D_MODEL, Kk, KSn, WS_F(part), lane_); } \
        { KP; pg8::Gemm g{Aptr, Btptr, MP, D_MODEL, Kk}; pg8::StaticOrder So; So.init(MP, D_MODEL, opaque_s((int)gridDim.x), opaque_s((int)blockIdx.x)); \
          pg8::EpiResid E{WS_B(hb), WS_F(rss) + (size_t)(v_out) * MT, (last_) ? P.out + O_YP : nullptr, coef_}; pg8::gemm_phase<pg8::EpiResid, pg8::StaticOrder, true, true>(wave_id, RING, g, So, E); } \
        GRID_SYNC(); \
        { KP; const int lane_ = (int)lane_id_v(); WAVE_ITEMS(MS) att::resid_reduce_row(it_, WS_F(part), KSn, coef_, WS_B(hb), WS_F(rss) + (size_t)(v_out) * MT, (last_) ? P.out + O_YP : nullptr, lane_); } \
        GRID_SYNC(); } while (0)
#define FFN_OPT(wi, wo, v_in, last) do { \
        { KP; pg8::Gemm g{WS_B(hb), WS_B(wi) + (size_t)layer * 2 * D_FF * D_MODEL, MT, 2 * D_FF, D_MODEL}; pg8::StaticOrder So; So.init(MT, 2 * D_FF, opaque_s((int)gridDim.x), opaque_s((int)blockIdx.x)); \
          pg8::EpiSwiglu E{WS_B(act), WS_F(rss) + (size_t)(v_in) * MT}; pg8::gemm_phase<pg8::EpiSwiglu, pg8::StaticOrder, true, true>(wave_id, RING, g, So, E); } \
        GRID_SYNC(); \
        RESID_PH(WS_B(act), WS_B(wo) + (size_t)layer * D_MODEL * D_FF, D_FF, 8, (v_in) + 1, 0.5f, last); } while (0)
#else
#define FFN_OPT(wi, wo, v_in, last) do { KP; \
        ITEM_LOOP((size_t)MT * D_FF) ref_ffn_in_item(i, WS_B(hb), WS_F(rss) + (size_t)(v_in) * MT, WS_B(wi) + (size_t)layer * 2 * D_FF * D_MODEL, WS_B(act)); \
        ITEM_LOOP(MT) ref_resid_row_item(i, WS_B(act), D_FF, WS_B(wo) + (size_t)layer * D_MODEL * D_FF, 0.5f, WS_F(h), WS_B(hb), WS_F(rss) + (size_t)((v_in) + 1) * MT, (last) ? P.out + O_YP : nullptr); } while (0)
#endif
#ifndef CPU_TEST
#define GEMM_PH(EpiT, Aptr, Btptr, Nn, Kk, ...) do { { KP; pg8::Gemm g{Aptr, Btptr, MT, Nn, Kk}; pg8::StaticOrder So; So.init(MT, Nn, opaque_s((int)gridDim.x), opaque_s((int)blockIdx.x)); \
        pg8::EpiT E{__VA_ARGS__}; pg8::gemm_phase<pg8::EpiT, pg8::StaticOrder, true, true>(wave_id, RING, g, So, E); } GRID_SYNC(); } while (0)
#endif
    for (int layer = 0; layer < DEPTH; ++layer) {
        FFN_OPT(w_ain, w_aout, 3 * layer, false);
        const int v1 = 3 * layer + 1;
        if (layer < N_A) {
#ifndef CPU_TEST
            { KP; const int lane_ = (int)lane_id_v(); WAVE_ITEMS((MS / 32) * (3 * D_MODEL / 32) * 2) att::skinny_task(it_, WS_B(hb) + (size_t)MP * D_MODEL, WS_B(w_cin) + (size_t)layer * 3 * D_MODEL * D_MODEL, 3 * D_MODEL, D_MODEL, 2, WS_F(part), lane_); }
            { KP; pg8::Gemm g{WS_B(hb), WS_B(w_cin) + (size_t)layer * 3 * D_MODEL * D_MODEL, MP, 3 * D_MODEL, D_MODEL}; pg8::StaticOrder So; So.init(MP, 3 * D_MODEL, opaque_s((int)gridDim.x), opaque_s((int)blockIdx.x));
              pg8::EpiConvIn E{WS_B(ub), WS_B(bb), WS_F(rss) + (size_t)v1 * MT, P.out, layer}; pg8::gemm_phase<pg8::EpiConvIn, pg8::StaticOrder, true, true>(wave_id, RING, g, So, E); }
            GRID_SYNC();
#else
            PH((size_t)MT * D_MODEL, ref_conv_in_item(i, WS_B(hb), WS_F(rss) + (size_t)v1 * MT, WS_B(w_cin) + (size_t)layer * 3 * D_MODEL * D_MODEL, WS_B(ub), WS_B(bb), P.out, layer));
#endif
#ifndef CPU_TEST
            { KP; ITEM_LOOP((size_t)MS * (D_MODEL / 8)) conv_thin_sample_item(i, WS_F(part), 2, WS_F(rss) + (size_t)v1 * MT, P.state_conv + (size_t)layer * DEC_BATCH * 2 * D_MODEL, P.conv_w + (size_t)layer * 3 * D_MODEL, WS_B(zb), P.out, layer); }
            PH((size_t)MP * (D_MODEL / 8), conv_thin_vec_item(i, WS_B(ub), WS_B(bb), P.state_conv + (size_t)layer * DEC_BATCH * 2 * D_MODEL, P.conv_w + (size_t)layer * 3 * D_MODEL, WS_B(zb)));
#else
            PH((size_t)MT * D_MODEL, conv_thin_item(i, WS_B(ub), WS_B(bb), P.state_conv + (size_t)layer * DEC_BATCH * 2 * D_MODEL, P.conv_w + (size_t)layer * 3 * D_MODEL, WS_B(zb)));
#endif
#ifndef CPU_TEST
            RESID_PH(WS_B(zb), WS_B(w_cout) + (size_t)layer * D_MODEL * D_MODEL, D_MODEL, 8, v1 + 1, 1.0f, false);
#else
            PH(MT, ref_resid_row_item(i, WS_B(zb), D_MODEL, WS_B(w_cout) + (size_t)layer * D_MODEL * D_MODEL, 1.0f, WS_F(h), WS_B(hb), WS_F(rss) + (size_t)(v1 + 1) * MT, nullptr));
#endif
        } else {
            const int b = layer - N_A;
#ifndef CPU_TEST
            GEMM_PH(EpiQG, WS_B(hb), WS_B(w_qg) + (size_t)b * QGP * D_MODEL, QGP, D_MODEL, WS_B(qnb), WS_B(qrb), WS_F(gates), WS_F(rss) + (size_t)v1 * MT, P.nsa_q_norm + (size_t)b * HD, WS_F(rope));
#else
            { KP; ITEM_LOOP((size_t)MT * N_HEADS) ref_qg_item(i, WS_B(hb), WS_F(rss) + (size_t)v1 * MT, WS_B(w_qg) + (size_t)b * QGP * D_MODEL, P.nsa_q_norm + (size_t)b * HD, WS_F(rope), WS_F(qn), WS_F(qr)); }
            PH((size_t)MT * 3 * N_HEADS, ref_gates_item(i, WS_B(hb), WS_F(rss) + (size_t)v1 * MT, WS_B(w_qg) + (size_t)b * QGP * D_MODEL, WS_F(gates)));
#endif
#ifndef CPU_TEST
            { KP; att::STensors TS{WS_B(qnb), WS_B(qrb), WS_F(kc), WS_F(vc), P.cache_kv, P.page_table, P.cache_win, P.out, WS_F(winrows), WS_F(gates), WS_B(ob)};
              int wv = wave_id; asm volatile("" : "+s"(wv));
              att::att_queue_sample(TS, (unsigned*)P.ws + 8192 + 128 * b, (att::ldsp)lds, wv, (int)lane_id_v()); }
            { KP; att::Tensors T{WS_B(qnb), WS_B(qrb), P.ws + WSM.ksel, P.ws + WSM.vsel, P.ws + WSM.kwin, P.ws + WSM.vwin, P.ws + WSM.kci, P.ws + WSM.vci, WS_F(gates), WS_B(ob)};
              int wv = wave_id; asm volatile("" : "+s"(wv));
              att::att_queue_prompt(T, (unsigned*)P.ws + 8192 + 128 * b + 64, (att::ldsp)lds, wv, (int)lane_id_v()); }
            GRID_SYNC();
#else
            PH((size_t)MT * N_HEADS, attn_cmp_item(i, WS_F(qn), WS_F(kc), WS_F(vc), WS_F(pbuf), WS_F(oc)));
            PH((size_t)MT * N_KV, topk_item(i, WS_F(pbuf), (int*)WS_F(sel), WS_F(scorebuf)));
            PH((size_t)MT * N_HEADS, attn_sel_item(i, KVSRC, WS_F(qr), (const int*)WS_F(sel), WS_F(os)));
            PH((size_t)MT * N_HEADS, attn_win_item(i, P.cache_win, WS_F(winrows), WS_F(qr), WS_F(gates), WS_F(oc), WS_F(os), WS_B(ob)));
#endif
#ifndef CPU_TEST
            RESID_PH(WS_B(ob), WS_B(w_o) + (size_t)b * D_MODEL * HDM, HDM, 8, v1 + 1, 1.0f, false);
#else
            PH(MT, ref_resid_row_item(i, WS_B(ob), HDM, WS_B(w_o) + (size_t)b * D_MODEL * HDM, 1.0f, WS_F(h), WS_B(hb), WS_F(rss) + (size_t)(v1 + 1) * MT, nullptr));
#endif
        }
        FFN_OPT(w_bin, w_bout, 3 * layer + 2, layer == DEPTH - 1);
        if (layer == N_A - 1) {
            const int v3 = 3 * layer + 3;
#ifndef CPU_TEST
            { KP; pg8::Gemm g{WS_B(hb), WS_B(w_kv), MT, KVW, D_MODEL}; pg8::StaticOrder So; So.init(MT, KVW, opaque_s((int)gridDim.x), opaque_s((int)blockIdx.x));
              pg8::EpiKV E{P.out, WS_F(winrows), WS_F(rss) + (size_t)v3 * MT, P.k_norm, WS_F(rope), P.ws + WSM.ksel, P.ws + WSM.vsel, P.ws + WSM.kwin, P.ws + WSM.vwin, WS_B(acp), P.cmp_pe}; pg8::gemm_phase<pg8::EpiKV, pg8::StaticOrder, true, true>(wave_id, RING, g, So, E); }
#else
            { KP; ITEM_LOOP((size_t)MT * 6 * N_KV) ref_kv_item(i, WS_B(hb), WS_F(rss) + (size_t)v3 * MT, WS_B(w_kv), P.k_norm, WS_F(rope), P.out, WS_F(winrows)); }
#endif
            PH((size_t)DEC_BATCH * (WINDOW - DEC_SEQ) * 2 * N_KV * HD, wincopy_item(i, P.cache_win, P.out));
#ifdef CPU_TEST
            PH((size_t)NSEQ * NBC_MAX * 2 * N_KV * CMP_HID, cmp_hid_item(i, KVSRC, P.cmp_pe, P.cmp_w1, WS_F(hid)));
            PH((size_t)NSEQ * NBC_MAX * 2 * N_KV, cmp_out_item(i, WS_F(hid), P.cmp_w2, P.k_norm, WS_F(kc), WS_F(vc)));
#else
            { KP; pg8::Gemm g{WS_B(acp), WS_B(w1t), 2 * RP_CMP, 2 * CMP_HID, L_CMP * HD}; pg8::CmpOrder So{2 * RP_CMP / 256, RP_CMP / 256, opaque_s((int)gridDim.x), opaque_s((int)blockIdx.x)};
              pg8::EpiGelu E{WS_B(hidp)}; pg8::gemm_phase<pg8::EpiGelu, pg8::CmpOrder, true, true>(wave_id, RING, g, So, E); }
            GRID_SYNC();
            { KP; const int lane_ = (int)lane_id_v(); WAVE_ITEMS(2 * RP_CMP / 32) att::cmp_out_wave(it_, WS_B(hidp), RP_CMP, NBC_P, 0, WS_B(w2t), P.k_norm, WS_F(kc), WS_F(vc), P.ws + WSM.kci, P.ws + WSM.vci, lane_); }
            GRID_SYNC();
#endif
        }
    }
}

extern "C" void kernel_launch(void* const* d_in, const int* in_sizes, int n_in, void* d_out, int out_size, void* d_ws, size_t ws_size, hipStream_t stream) {
    Params P{};
    P.x_prompt = (const float*)d_in[0]; P.x_sample = (const float*)d_in[1]; P.cache_kv = (const float*)d_in[2]; P.cache_win = (const float*)d_in[3];
    P.state_conv = (const float*)d_in[4]; P.page_table = (const int*)d_in[5]; P.ffn_a_norm = (const float*)d_in[6]; P.ffn_a_w_in = (const float*)d_in[7];
    P.ffn_a_w_out = (const float*)d_in[8]; P.mix_norm = (const float*)d_in[9]; P.ffn_b_norm = (const float*)d_in[10]; P.ffn_b_w_in = (const float*)d_in[11];
    P.ffn_b_w_out = (const float*)d_in[12]; P.conv_w_in = (const float*)d_in[13]; P.conv_w = (const float*)d_in[14]; P.conv_w_out = (const float*)d_in[15];
    P.kv_norm = (const float*)d_in[16]; P.w_kv = (const float*)d_in[17]; P.k_norm = (const float*)d_in[18]; P.cmp_pe = (const float*)d_in[19];
    P.cmp_w1 = (const float*)d_in[20]; P.cmp_w2 = (const float*)d_in[21]; P.nsa_w_qg = (const float*)d_in[22]; P.nsa_q_norm = (const float*)d_in[23];
    P.nsa_w_o = (const float*)d_in[24];
    P.out = (float*)d_out; P.ws = (unsigned char*)d_ws;
#ifndef CPU_TEST
    static int grid = 0;
    if (grid == 0) {
        int dev = 0, cus = 0, per_cu = 0;
        hipGetDevice(&dev); hipDeviceGetAttribute(&cus, hipDeviceAttributeMultiprocessorCount, dev);
        hipFuncSetAttribute((const void*)mega, hipFuncAttributeMaxDynamicSharedMemorySize, LDS_BYTES);
        hipOccupancyMaxActiveBlocksPerMultiprocessor(&per_cu, (const void*)mega, NTHREADS, LDS_BYTES);
        (void)hipGetLastError();
        grid = cus;
    }
    hipMemsetAsync(d_ws, 0, WS_ZERO_BYTES, stream);
    hipLaunchKernelGGL(mega, dim3(grid), dim3(NTHREADS), LDS_BYTES, stream, P);
#else
    memset(d_ws, 0, WS_ZERO_BYTES);
    mega(P);
#endif
}
```

```cpp
#ifdef CPU_TEST
#include "shim.h"
#else
#include <hip/hip_runtime.h>
#endif
#include <cstdint>
#include <cstddef>
#include <cmath>
#include <cstring>
typedef unsigned short bf16_t;
#ifndef CPU_TEST
#define HOSTDEV __host__ __device__
#else
#define HOSTDEV
#endif
HOSTDEV inline bf16_t f2bf(float f) { unsigned u; memcpy(&u, &f, 4); u = (u + 0x7fffu + ((u >> 16) & 1u)) >> 16; return (bf16_t)u; }
HOSTDEV inline float bf2f(bf16_t b) { unsigned u = (unsigned)b << 16; float f; memcpy(&f, &u, 4); return f; }

#ifdef CFG_SMALL
constexpr int D_MODEL = 256, BATCH = 1, SEQ = 2048, DEPTH = 4, DEC_BATCH = 2, DEC_SEQ = 8, PAST_LEN = 2048, PAGE_SIZE = 128, D_FF = 256, N_HEADS = 4, N_KV = 2;
#else
constexpr int D_MODEL = 1024, BATCH = 4, SEQ = 4096, DEPTH = 4, DEC_BATCH = 32, DEC_SEQ = 8, PAST_LEN = 8192, PAGE_SIZE = 128, D_FF = 2816, N_HEADS = 16, N_KV = 4;
#endif
constexpr int N_A = DEPTH / 2, N_B = DEPTH - N_A, HD = 64, HPG = N_HEADS / N_KV, L_CMP = 32, L_SEL = 64, N_SEL = 16, WINDOW = 512, CMP_HID = 4 * HD;
constexpr int MP = BATCH * SEQ, MS = DEC_BATCH * DEC_SEQ, MT = MP + MS, NSEQ = BATCH + DEC_BATCH;
constexpr int N_PAGES = PAST_LEN / PAGE_SIZE;
constexpr int KVW = 6 * N_KV * HD;
constexpr int QGW = N_HEADS * HD + 3 * N_HEADS;
constexpr int HDM = N_HEADS * HD;
constexpr int TPAD_S = ((PAST_LEN + DEC_SEQ + L_SEL - 1) / L_SEL) * L_SEL;
constexpr int NBC_P = SEQ / L_CMP, NBC_S = TPAD_S / L_CMP, NBC_MAX = NBC_S > NBC_P ? NBC_S : NBC_P;
constexpr int NBS_P = SEQ / L_SEL, NBS_S = TPAD_S / L_SEL, NBS_MAX = NBS_S > NBS_P ? NBS_S : NBS_P;
constexpr float EPS = 1e-6f, NEGF = -1e30f, TINYF = 1e-30f, FORCE_SCORE = 1e4f;
__device__ static const float INV_FREQ[8] = {1.0f, 0.1939227432012558f, 0.03760603070259094f, 0.007292664609849453f, 0.0014142135623842478f, 0.00027424818836152554f, 5.3182957344688475e-05f, 1.0313385246263351e-05f};

constexpr size_t O_YP = 0, O_YS = O_YP + (size_t)MP * D_MODEL, O_KVP = O_YS + (size_t)MS * D_MODEL, O_KVS = O_KVP + (size_t)MP * 4 * N_KV * HD,
                 O_WP = O_KVS + (size_t)MS * 4 * N_KV * HD, O_WS = O_WP + (size_t)BATCH * WINDOW * 2 * N_KV * HD, O_CP = O_WS + (size_t)DEC_BATCH * WINDOW * 2 * N_KV * HD,
                 O_CS = O_CP + (size_t)N_A * BATCH * 2 * D_MODEL, O_END = O_CS + (size_t)N_A * DEC_BATCH * 2 * D_MODEL;

struct RowInfo { int seq, t, pos; };
__device__ __host__ inline RowInfo row_info(int m) {
    RowInfo r;
    if (m < MP) { r.seq = m / SEQ; r.t = m % SEQ; r.pos = r.t; }
    else { const int q = m - MP; r.seq = BATCH + q / DEC_SEQ; r.t = q % DEC_SEQ; r.pos = PAST_LEN + r.t; }
    return r;
}
__device__ __host__ inline int seq_row0(int seq) { return seq < BATCH ? seq * SEQ : MP + (seq - BATCH) * DEC_SEQ; }
__device__ __host__ inline int seq_pos0(int seq) { return seq < BATCH ? 0 : PAST_LEN; }
__device__ __host__ inline int seq_len(int seq) { return seq < BATCH ? SEQ : DEC_SEQ; }

__device__ inline void copy_item(size_t i_, const float* a, float* b, size_t n) {
    const size_t i = i_;
    if (i < n) b[i] = a[i];
}
__device__ inline void rmsnorm_item(size_t i_, const float* x, const float* g, float* y, int rows, int d) {
    const int m = (int)i_;
    if (m >= rows) return;
    const float* xr = x + (size_t)m * d; float s = 0.f;
    for (int i = 0; i < d; ++i) s += xr[i] * xr[i];
    const float r = 1.0f / sqrtf(s / d + EPS);
    float* yr = y + (size_t)m * d;
    for (int i = 0; i < d; ++i) yr[i] = xr[i] * r * g[i];
}
__device__ inline void gemm_item(size_t i_, const float* A, int lda, const float* W, float* C, int M, int N, int K) {
    const int nbx = (N + 63) / 64; const int vb = (int)(i_ / 256), t_ = (int)(i_ % 256), tx = t_ % 16, ty = t_ / 16;
    const int c0 = (vb % nbx) * 64 + tx * 4, r0 = (vb / nbx) * 64 + ty * 4;
    if (c0 >= N || r0 >= M) return;
    float acc[4][4];
    for (int i = 0; i < 4; ++i) for (int j = 0; j < 4; ++j) acc[i][j] = 0.f;
    const int nr = (M - r0) < 4 ? (M - r0) : 4;
    for (int k = 0; k < K; k += 4) {
        float a[4][4], w[4][4];
        for (int i = 0; i < 4; ++i) for (int kk = 0; kk < 4; ++kk) a[i][kk] = (i < nr) ? A[(size_t)(r0 + i) * lda + k + kk] : 0.f;
        for (int kk = 0; kk < 4; ++kk) for (int j = 0; j < 4; ++j) w[kk][j] = W[(size_t)(k + kk) * N + c0 + j];
        for (int i = 0; i < 4; ++i) for (int kk = 0; kk < 4; ++kk) for (int j = 0; j < 4; ++j) acc[i][j] += a[i][kk] * w[kk][j];
    }
    for (int i = 0; i < nr; ++i) for (int j = 0; j < 4; ++j) C[(size_t)(r0 + i) * N + c0 + j] = acc[i][j];
}
__device__ inline void swiglu_item(size_t i_, const float* t1, float* act, int rows, int dff) {
    const size_t i = i_;
    if (i >= (size_t)rows * dff) return;
    const int m = (int)(i / dff), j = (int)(i % dff);
    const float g = t1[(size_t)m * 2 * dff + j], u = t1[(size_t)m * 2 * dff + dff + j];
    act[i] = g / (1.0f + expf(-g)) * u;
}
__device__ inline void axpy_item(size_t i_, float* h, const float* y, float coef, size_t n) {
    const size_t i = i_;
    if (i < n) h[i] += coef * y[i];
}
__device__ inline void conv_item(size_t i_, const float* t1, const float* state  , const float* wc  , float* z, float* out, int layer) {
    const size_t i = i_;
    if (i >= (size_t)MT * D_MODEL) return;
    const int m = (int)(i / D_MODEL), ch = (int)(i % D_MODEL);
    const RowInfo ri = row_info(m);
    const float* r = t1 + (size_t)m * 3 * D_MODEL;
    const float b = r[ch], u0 = r[D_MODEL + ch] * r[2 * D_MODEL + ch];
    float u1, u2;
    if (ri.t >= 1) { const float* p = r - 3 * D_MODEL; u1 = p[D_MODEL + ch] * p[2 * D_MODEL + ch]; }
    else u1 = (ri.seq < BATCH) ? 0.f : state[((size_t)(ri.seq - BATCH) * 2 + 1) * D_MODEL + ch];
    if (ri.t >= 2) { const float* p = r - 6 * D_MODEL; u2 = p[D_MODEL + ch] * p[2 * D_MODEL + ch]; }
    else if (ri.seq < BATCH) u2 = 0.f;
    else u2 = (ri.t == 1) ? state[((size_t)(ri.seq - BATCH) * 2 + 1) * D_MODEL + ch] : state[((size_t)(ri.seq - BATCH) * 2 + 0) * D_MODEL + ch];
    z[i] = b * (wc[ch] * u2 + wc[D_MODEL + ch] * u1 + wc[2 * D_MODEL + ch] * u0);
    const int L = seq_len(ri.seq);
    if (ri.t >= L - 2) {
        const int j = ri.t - (L - 2);
        if (ri.seq < BATCH) out[O_CP + (((size_t)layer * BATCH + ri.seq) * 2 + j) * D_MODEL + ch] = u0;
        else out[O_CS + (((size_t)layer * DEC_BATCH + (ri.seq - BATCH)) * 2 + j) * D_MODEL + ch] = u0;
    }
}
__device__ inline void head_norm(float* v, const float* g) {
    float s = 0.f; for (int d = 0; d < HD; ++d) s += v[d] * v[d];
    const float r = 1.0f / sqrtf(s / HD + EPS);
    for (int d = 0; d < HD; ++d) v[d] = v[d] * r * g[d];
}
__device__ inline void rope_cs(float ang, float& c, float& s) {
    const double r = (double)ang * 0.15915494309189535; const float fr = (float)(r - rint(r));
#ifdef CPU_TEST
    c = (float)cos(6.283185307179586 * (double)fr); s = (float)sin(6.283185307179586 * (double)fr);
#else
    c = __builtin_amdgcn_cosf(fr); s = __builtin_amdgcn_sinf(fr);
#endif
}
__device__ inline void head_rope(float* v, int pos) {
    for (int i = 0; i < 8; ++i) {
        const float ang = (float)pos * INV_FREQ[i]; float c, s; rope_cs(ang, c, s);
        const float x1 = v[i], x2 = v[8 + i];
        v[i] = x1 * c - x2 * s; v[8 + i] = x2 * c + x1 * s;
    }
}
__device__ inline void kvprep_item(size_t i_, const float* p, const float* k_norm  , float* out, float* winrows) {
    const int i = (int)i_;
    if (i >= MT * 6 * N_KV) return;
    const int m = i / (6 * N_KV), e = (i / N_KV) % 6, g = i % N_KV;
    const RowInfo ri = row_info(m);
    float v[HD];
    for (int d = 0; d < HD; ++d) v[d] = p[(size_t)m * KVW + (e * N_KV + g) * HD + d];
    if (e == 2) { head_norm(v, k_norm + HD); head_rope(v, ri.pos); }
    if (e == 4) { head_norm(v, k_norm + 2 * HD); head_rope(v, ri.pos); }
    if (e < 4) {
        float* o = (ri.seq < BATCH) ? out + O_KVP + (((size_t)m * 4 + e) * N_KV + g) * HD : out + O_KVS + (((size_t)(m - MP) * 4 + e) * N_KV + g) * HD;
        for (int d = 0; d < HD; ++d) o[d] = v[d];
    } else {
        const int we = e - 4;
        float* w = winrows + (((size_t)m * 2 + we) * N_KV + g) * HD;
        for (int d = 0; d < HD; ++d) w[d] = v[d];
        if (ri.seq < BATCH) { if (ri.t >= SEQ - WINDOW) { float* o = out + O_WP + ((((size_t)ri.seq * WINDOW + (ri.t - (SEQ - WINDOW))) * 2 + we) * N_KV + g) * HD; for (int d = 0; d < HD; ++d) o[d] = v[d]; } }
        else { float* o = out + O_WS + ((((size_t)(ri.seq - BATCH) * WINDOW + (WINDOW - DEC_SEQ + ri.t)) * 2 + we) * N_KV + g) * HD; for (int d = 0; d < HD; ++d) o[d] = v[d]; }
    }
}
__device__ inline void wincopy_item(size_t i_, const float* cache_win, float* out) {
    const size_t i = i_;
    const size_t per = (size_t)(WINDOW - DEC_SEQ) * 2 * N_KV * HD;
    if (i >= (size_t)DEC_BATCH * per) return;
    const size_t b = i / per, r = i % per;
    out[O_WS + b * WINDOW * 2 * N_KV * HD + r] = cache_win[b * WINDOW * 2 * N_KV * HD + (size_t)DEC_SEQ * 2 * N_KV * HD + r];
}
struct KvSrc { const float* cache_kv; const int* page_table; const float* out; };
__device__ inline const float* kv_full_ptr(const KvSrc& S, int seq, int tok, int e, int g) {
    if (seq < BATCH) return S.out + O_KVP + ((((size_t)seq * SEQ + tok) * 4 + e) * N_KV + g) * HD;
    const int b = seq - BATCH;
    if (tok < PAST_LEN) { const int page = S.page_table[b * N_PAGES + tok / PAGE_SIZE]; return S.cache_kv + ((((size_t)page * PAGE_SIZE + tok % PAGE_SIZE) * 4 + e) * N_KV + g) * HD; }
    if (tok < PAST_LEN + DEC_SEQ) return S.out + O_KVS + ((((size_t)b * DEC_SEQ + (tok - PAST_LEN)) * 4 + e) * N_KV + g) * HD;
    return nullptr;
}
__device__ inline int seq_nbc(int seq) { return seq < BATCH ? NBC_P : NBC_S; }
__device__ inline void cmp_hid_item(size_t i_, KvSrc S, const float* pe  , const float* w1  , float* hid) {
    const size_t i = i_;
    if (i >= (size_t)NSEQ * NBC_MAX * 2 * N_KV * CMP_HID) return;
    const int f = (int)(i % CMP_HID), g = (int)((i / CMP_HID) % N_KV), e = (int)((i / ((size_t)CMP_HID * N_KV)) % 2), c = (int)((i / ((size_t)CMP_HID * N_KV * 2)) % NBC_MAX), seq = (int)(i / ((size_t)CMP_HID * N_KV * 2 * NBC_MAX));
    if (c >= seq_nbc(seq)) return;
    float s = 0.f;
    for (int l = 0; l < L_CMP; ++l) {
        const float* r = kv_full_ptr(S, seq, c * L_CMP + l, e, g);
        const float* w = w1 + (((size_t)e * L_CMP + l) * HD) * CMP_HID + f; const float* pp = pe + ((size_t)e * L_CMP + l) * HD;
        for (int d = 0; d < HD; ++d) s += ((r ? r[d] : 0.f) + pp[d]) * w[(size_t)d * CMP_HID];
    }
    const float x = s; const float t = tanhf(0.7978845608028654f * (x + 0.044715f * x * x * x));
    hid[i] = 0.5f * x * (1.0f + t);
}
__device__ inline void cmp_out_item(size_t i_, const float* hid, const float* w2  , const float* k_norm0, float* kc, float* vc) {
    const int i = (int)i_;
    if (i >= NSEQ * NBC_MAX * 2 * N_KV) return;
    const int g = i % N_KV, e = (i / N_KV) % 2, c = (i / (2 * N_KV)) % NBC_MAX, seq = i / (2 * N_KV * NBC_MAX);
    if (c >= seq_nbc(seq)) return;
    const float* hr = hid + (size_t)i * CMP_HID;
    float v[HD];
    for (int d = 0; d < HD; ++d) { float s = 0.f; for (int f = 0; f < CMP_HID; ++f) s += hr[f] * w2[((size_t)e * CMP_HID + f) * HD + d]; v[d] = s; }
    if (e == 0) head_norm(v, k_norm0);
    float* o = (e == 0 ? kc : vc) + (((size_t)seq * NBC_MAX + c) * N_KV + g) * HD;
    for (int d = 0; d < HD; ++d) o[d] = v[d];
}
__device__ inline void qprep_item(size_t i_, const float* qg, const float* q_norm, float* qn, float* qr, float* gates) {
    const int i = (int)i_;
    if (i >= MT * N_HEADS) return;
    const int m = i / N_HEADS, hh = i % N_HEADS;
    const RowInfo ri = row_info(m);
    float v[HD];
    for (int d = 0; d < HD; ++d) v[d] = qg[(size_t)m * QGW + hh * HD + d];
    head_norm(v, q_norm);
    for (int d = 0; d < HD; ++d) qn[(size_t)m * HDM + hh * HD + d] = v[d];
    head_rope(v, ri.pos);
    for (int d = 0; d < HD; ++d) qr[(size_t)m * HDM + hh * HD + d] = v[d];
    for (int j = 0; j < 3; ++j) { const float x = qg[(size_t)m * QGW + HDM + hh * 3 + j]; gates[(size_t)m * 3 * N_HEADS + hh * 3 + j] = 1.0f / (1.0f + expf(-x)); }
}
__device__ inline void attn_cmp_item(size_t i_, const float* qn, const float* kc, const float* vc, float* pbuf, float* oc) {
    const int i = (int)i_;
    if (i >= MT * N_HEADS) return;
    const int m = i / N_HEADS, hh = i % N_HEADS, g = hh / HPG;
    const RowInfo ri = row_info(m);
    const int nbc = seq_nbc(ri.seq);
    const float* q = qn + (size_t)m * HDM + hh * HD;
    float* p = pbuf + (size_t)i * NBC_MAX;
    float mx = NEGF;
    for (int c = 0; c < nbc; ++c) {
        const bool vis = (c + 1) * L_CMP - 1 <= ri.pos;
        float s = 0.f; const float* k = kc + (((size_t)ri.seq * NBC_MAX + c) * N_KV + g) * HD;
        for (int d = 0; d < HD; ++d) s += q[d] * k[d];
        s *= 0.125f; p[c] = s; if (vis && s > mx) mx = s;
    }
    float sum = 0.f;
    for (int c = 0; c < nbc; ++c) { const bool vis = (c + 1) * L_CMP - 1 <= ri.pos; const float e = vis ? expf(p[c] - mx) : 0.f; p[c] = e; sum += e; }
    const float inv = 1.0f / fmaxf(sum, TINYF);
    float o[HD]; for (int d = 0; d < HD; ++d) o[d] = 0.f;
    for (int c = 0; c < nbc; ++c) { p[c] *= inv; if (p[c] != 0.f) { const float* v = vc + (((size_t)ri.seq * NBC_MAX + c) * N_KV + g) * HD; for (int d = 0; d < HD; ++d) o[d] += p[c] * v[d]; } }
    for (int d = 0; d < HD; ++d) oc[(size_t)m * HDM + hh * HD + d] = o[d];
}
__device__ inline void topk_item(size_t i_, const float* pbuf, int* sel, float* scorebuf  ) {
    const int i = (int)i_;
    if (i >= MT * N_KV) return;
    const int m = i / N_KV, g = i % N_KV;
    const RowInfo ri = row_info(m);
    const int nbs = ri.seq < BATCH ? NBS_P : NBS_S, cur = ri.pos / L_SEL;
    float* score = scorebuf + (size_t)i * NBS_MAX;
    for (int b = 0; b < nbs; ++b) {
        float imp = 0.f;
        for (int h = 0; h < HPG; ++h) { const float* p = pbuf + ((size_t)m * N_HEADS + g * HPG + h) * NBC_MAX; imp += p[2 * b]; }
        float imp2 = 0.f;
        for (int h = 0; h < HPG; ++h) { const float* p = pbuf + ((size_t)m * N_HEADS + g * HPG + h) * NBC_MAX; imp2 += p[2 * b + 1]; }
        const bool forced = (b == 0) || (b == cur) || (b == cur - 1), valid = b * L_SEL <= ri.pos;
        score[b] = valid ? (forced ? FORCE_SCORE : imp + imp2) : NEGF;
    }
    const int nsel = N_SEL < nbs ? N_SEL : nbs;
    for (int j = 0; j < N_SEL; ++j) {
        if (j >= nsel) { sel[(size_t)i * N_SEL + j] = -1; continue; }
        int best = -1; float bv = 0.f;
        for (int b = 0; b < nbs; ++b) if (score[b] > -3e38f && (best < 0 || score[b] > bv)) { best = b; bv = score[b]; }
        sel[(size_t)i * N_SEL + j] = best; score[best] = -3.4e38f;
    }
}
__device__ inline void attn_sel_item(size_t i_, KvSrc S, const float* qr, const int* sel, float* os) {
    const int i = (int)i_;
    if (i >= MT * N_HEADS) return;
    const int m = i / N_HEADS, hh = i % N_HEADS, g = hh / HPG;
    const RowInfo ri = row_info(m);
    const float* q = qr + (size_t)m * HDM + hh * HD;
    const int* sl = sel + ((size_t)m * N_KV + g) * N_SEL;
    float mx = NEGF;
    for (int j = 0; j < N_SEL; ++j) { const int b = sl[j]; if (b < 0) continue;
        for (int t = 0; t < L_SEL; ++t) { const int tok = b * L_SEL + t; if (tok > ri.pos) continue;
            const float* k = kv_full_ptr(S, ri.seq, tok, 2, g); float s = 0.f; if (k) for (int d = 0; d < HD; ++d) s += q[d] * k[d];
            s *= 0.125f; if (s > mx) mx = s; } }
    float sum = 0.f, o[HD]; for (int d = 0; d < HD; ++d) o[d] = 0.f;
    for (int j = 0; j < N_SEL; ++j) { const int b = sl[j]; if (b < 0) continue;
        for (int t = 0; t < L_SEL; ++t) { const int tok = b * L_SEL + t; if (tok > ri.pos) continue;
            const float* k = kv_full_ptr(S, ri.seq, tok, 2, g); float s = 0.f; if (k) for (int d = 0; d < HD; ++d) s += q[d] * k[d];
            const float e = expf(s * 0.125f - mx); sum += e;
            const float* v = kv_full_ptr(S, ri.seq, tok, 3, g); if (v) for (int d = 0; d < HD; ++d) o[d] += e * v[d]; } }
    const float inv = 1.0f / fmaxf(sum, TINYF);
    for (int d = 0; d < HD; ++d) os[(size_t)m * HDM + hh * HD + d] = o[d] * inv;
}
__device__ inline const float* win_ptr(const float* cache_win, const float* winrows, int seq, int kp) {
    if (seq < BATCH) return kp >= 0 ? winrows + (size_t)(seq * SEQ + kp) * 2 * N_KV * HD : nullptr;
    const int b = seq - BATCH;
    if (kp >= PAST_LEN) return winrows + (size_t)(MP + b * DEC_SEQ + (kp - PAST_LEN)) * 2 * N_KV * HD;
    const int j = kp - (PAST_LEN - WINDOW);
    return j >= 0 ? cache_win + ((size_t)b * WINDOW + j) * 2 * N_KV * HD : nullptr;
}
__device__ inline void attn_win_item(size_t i_, const float* cache_win, const float* winrows, const float* qr, const float* gates, const float* oc, const float* os, bf16_t* o_out) {
    const int i = (int)i_;
    if (i >= MT * N_HEADS) return;
    const int m = i / N_HEADS, hh = i % N_HEADS, g = hh / HPG;
    const RowInfo ri = row_info(m);
    const float* q = qr + (size_t)m * HDM + hh * HD;
    float mx = NEGF;
    for (int kp = ri.pos - WINDOW; kp <= ri.pos; ++kp) { const float* r = win_ptr(cache_win, winrows, ri.seq, kp); if (!r) continue;
        const float* k = r + (0 * N_KV + g) * HD; float s = 0.f; for (int d = 0; d < HD; ++d) s += q[d] * k[d]; s *= 0.125f; if (s > mx) mx = s; }
    float sum = 0.f, o[HD]; for (int d = 0; d < HD; ++d) o[d] = 0.f;
    for (int kp = ri.pos - WINDOW; kp <= ri.pos; ++kp) { const float* r = win_ptr(cache_win, winrows, ri.seq, kp); if (!r) continue;
        const float* k = r + (0 * N_KV + g) * HD; float s = 0.f; for (int d = 0; d < HD; ++d) s += q[d] * k[d];
        const float e = expf(s * 0.125f - mx); sum += e; const float* v = r + (1 * N_KV + g) * HD; for (int d = 0; d < HD; ++d) o[d] += e * v[d]; }
    const float inv = 1.0f / fmaxf(sum, TINYF);
    const float* gt = gates + (size_t)m * 3 * N_HEADS + hh * 3;
    for (int d = 0; d < HD; ++d) { const size_t x = (size_t)m * HDM + hh * HD + d; o_out[x] = f2bf(gt[0] * oc[x] + gt[1] * os[x] + gt[2] * o[d] * inv); }
}


#ifndef CPU_TEST
__device__ __forceinline__ unsigned lane_id_v() { unsigned l; asm volatile("v_mbcnt_lo_u32_b32 %0, -1, 0\n\tv_mbcnt_hi_u32_b32 %0, -1, %0" : "=v"(l)); return l; }
#endif
#ifndef CPU_TEST
constexpr float RSS_SCALE = 1024.0f;
__device__ __forceinline__ unsigned rss_enc(float s) { return (unsigned)(s * RSS_SCALE + 0.5f); }
__device__ __forceinline__ float rss_dec(float rawbits) { return (float)__float_as_uint(rawbits) * (1.0f / RSS_SCALE); }
#endif
constexpr int NTHREADS = 512;
__host__ __device__ inline bf16_t f2bf_(float f) { unsigned u; memcpy(&u, &f, 4); u = (u + 0x7fffu + ((u >> 16) & 1u)) >> 16; return (bf16_t)u; }
__host__ __device__ inline float bf2f_(bf16_t b) { unsigned u = (unsigned)b << 16; float f; memcpy(&f, &u, 4); return f; }
constexpr int NRSS = 3 * DEPTH + 1;
constexpr int NPOS = SEQ + DEC_SEQ;
constexpr int QGP = ((QGW + 255) / 256) * 256;
__host__ __device__ inline int pos_index(int pos) { return pos < SEQ ? pos : SEQ + (pos - PAST_LEN); }

constexpr size_t IMG_SEQ_BYTES = (size_t)BATCH * N_KV * (SEQ / 64) * 8192, IMG_CMP_BYTES = (size_t)BATCH * N_KV * (NBC_P / 64 > 0 ? NBC_P / 64 : 1) * 8192;
struct WsMap {
    size_t ctl, rss, rope, h, hb, act, xn, t2, actf, ub, bb, zb, t1, qn, qr, gates, ob, winrows, hid, kc, vc, pbuf, oc, os, sel, scorebuf,
           w_ain, w_aout, w_bin, w_bout, w_cin, w_cout, w_qg, w_o, w_kv, qnb, qrb, ksel, vsel, kwin, vwin, kci, vci, acs, hids, acp, hidp, w1t, w2t, part, end;
};
constexpr size_t al256(size_t b) { return (b + 255) / 256 * 256; }
constexpr size_t smax(size_t a, size_t b) { return a > b ? a : b; }
constexpr WsMap make_ws_map() {
    WsMap w{}; size_t off = 0;
#define TAKE(f, bytes) w.f = off; off += al256(bytes)
    TAKE(ctl, 65536); TAKE(rss, (size_t)NRSS * MT * 4);
    TAKE(rope, (size_t)NPOS * 16 * 4);
    TAKE(h, (size_t)MT * D_MODEL * 4); TAKE(hb, (size_t)MT * D_MODEL * 2); TAKE(act, (size_t)MT * D_FF * 2);
    TAKE(xn, (size_t)MT * D_MODEL * 4); TAKE(t2, (size_t)MT * D_MODEL * 4); TAKE(actf, (size_t)MT * D_MODEL * 4);
    TAKE(ub, (size_t)MT * D_MODEL * 2); TAKE(bb, (size_t)MT * D_MODEL * 2); TAKE(zb, (size_t)MT * D_MODEL * 2);
    TAKE(t1, smax((size_t)MT * 3 * D_MODEL * 4, (size_t)MT * KVW * 4));
    TAKE(qn, (size_t)MT * HDM * 4); TAKE(qr, (size_t)MT * HDM * 4); TAKE(gates, (size_t)MT * 3 * N_HEADS * 4); TAKE(ob, (size_t)MT * HDM * 2);
    TAKE(winrows, (size_t)MT * 2 * N_KV * HD * 4); TAKE(hid, (size_t)NSEQ * NBC_MAX * 2 * N_KV * CMP_HID * 4);
    TAKE(kc, (size_t)NSEQ * NBC_MAX * N_KV * HD * 4); TAKE(vc, (size_t)NSEQ * NBC_MAX * N_KV * HD * 4);
    TAKE(pbuf, (size_t)MT * N_HEADS * NBC_MAX * 4); TAKE(oc, (size_t)MT * HDM * 4); TAKE(os, (size_t)MT * HDM * 4);
    TAKE(sel, (size_t)MT * N_KV * N_SEL * 4); TAKE(scorebuf, (size_t)MT * N_KV * NBS_MAX * 4);
    TAKE(w_ain, (size_t)DEPTH * 2 * D_FF * D_MODEL * 2); TAKE(w_aout, (size_t)DEPTH * D_MODEL * D_FF * 2);
    TAKE(w_bin, (size_t)DEPTH * 2 * D_FF * D_MODEL * 2); TAKE(w_bout, (size_t)DEPTH * D_MODEL * D_FF * 2);
    TAKE(w_cin, (size_t)N_A * 3 * D_MODEL * D_MODEL * 2); TAKE(w_cout, (size_t)N_A * D_MODEL * D_MODEL * 2);
    TAKE(w_qg, (size_t)N_B * QGP * D_MODEL * 2); TAKE(w_o, (size_t)N_B * D_MODEL * HDM * 2); TAKE(w_kv, (size_t)KVW * D_MODEL * 2);
    TAKE(qnb, (size_t)MT * HDM * 2); TAKE(qrb, (size_t)MT * HDM * 2); TAKE(ksel, IMG_SEQ_BYTES); TAKE(vsel, IMG_SEQ_BYTES); TAKE(kwin, IMG_SEQ_BYTES); TAKE(vwin, IMG_SEQ_BYTES); TAKE(kci, IMG_CMP_BYTES); TAKE(vci, IMG_CMP_BYTES);
    TAKE(acs, (size_t)2 * DEC_BATCH * (PAST_LEN / L_CMP) * N_KV * L_CMP * HD * 2); TAKE(hids, (size_t)2 * DEC_BATCH * (PAST_LEN / L_CMP) * N_KV * CMP_HID * 2);
    TAKE(acp, (size_t)2 * BATCH * NBC_P * N_KV * L_CMP * HD * 2); TAKE(hidp, (size_t)2 * BATCH * NBC_P * N_KV * CMP_HID * 2); TAKE(w1t, (size_t)2 * CMP_HID * L_CMP * HD * 2); TAKE(w2t, (size_t)2 * HD * CMP_HID * 2); TAKE(part, (size_t)8 * MS * 3 * D_MODEL * 4);
#undef TAKE
    w.end = off; return w;
}
constexpr WsMap WSM = make_ws_map();
constexpr size_t WS_ZERO_BYTES = 65536 + (((size_t)NRSS * MT * 4 + 255) / 256 * 256);

enum { CM_PLAIN = 0, CM_PAIR = 1, CM_CONV = 2, CM_HEADS = 3 };
__host__ __device__ inline int colmap(int kind, int n, int aux) {
    const int pn = n / 256, c = n % 256;
    if (kind == CM_PLAIN) return n;
    if (kind == CM_PAIR) return (c >= 128 ? aux : 0) + pn * 128 + (c % 128);
    if (kind == CM_CONV) { if (n < 2 * D_MODEL) return (c >= 128 ? 2 * D_MODEL : D_MODEL) + pn * 128 + (c % 128); return n - 2 * D_MODEL; }
    if (n < aux * 64) { const int bj = c / 128, wc = (c % 128) / 32, r = c % 32; return (pn * 4 + wc) * 64 + 32 * bj + r; }
    return n;
}
__device__ inline void wconv_item(size_t i_, const float* src, int Nsrc, const float* gain, bf16_t* dst, int Nd, int K, int kind, int aux) {
    const int n = (int)(i_ % Nd), kb = (int)(i_ / Nd);
    const int col = colmap(kind, n, aux);
    bf16_t* d = dst + (size_t)n * K + (size_t)kb * 64;
    if (col < 0 || col >= Nsrc) { for (int k = 0; k < 64; ++k) d[k] = 0; return; }
    const float* s = src + (size_t)kb * 64 * Nsrc + col;
#pragma unroll 8
    for (int k = 0; k < 64; k += 2) {
        const float g0 = gain ? gain[kb * 64 + k] : 1.f, g1 = gain ? gain[kb * 64 + k + 1] : 1.f;
        const unsigned lo = f2bf(s[(size_t)k * Nsrc] * g0), hi = f2bf(s[(size_t)(k + 1) * Nsrc] * g1);
        *(unsigned*)(d + k) = lo | (hi << 16);
    }
}
__device__ inline void rope_item(size_t i_, float* rope) {
    const int pi = (int)(i_ / 8), f = (int)(i_ % 8);
    const int pos = pi < SEQ ? pi : PAST_LEN + (pi - SEQ);
    float c, s; rope_cs((float)pos * INV_FREQ[f], c, s);
    rope[pi * 16 + f] = c; rope[pi * 16 + 8 + f] = s;
}
__device__ inline void hinit_item(size_t i_, const float* xp, const float* xs, float* h, bf16_t* hb, float* rss0) {
    const int m = (int)i_; const float* x = m < MP ? xp + (size_t)m * D_MODEL : xs + (size_t)(m - MP) * D_MODEL;
    float s = 0.f;
    for (int k = 0; k < D_MODEL; ++k) { const float v = x[k]; s += v * v; h[(size_t)m * D_MODEL + k] = v; hb[(size_t)m * D_MODEL + k] = f2bf(v); }
    rss0[m] = s;
}
__device__ inline void hupd_item(size_t i_, float* h, const float* y, float coef, bf16_t* hb, float* rss) {
    const int m = (int)i_; float s = 0.f;
    for (int k = 0; k < D_MODEL; ++k) { const float v = h[(size_t)m * D_MODEL + k] + coef * y[(size_t)m * D_MODEL + k]; s += v * v; h[(size_t)m * D_MODEL + k] = v; hb[(size_t)m * D_MODEL + k] = f2bf(v); }
    rss[m] = s;
}
__device__ inline float dot_bf(const bf16_t* a, const bf16_t* b, int K) { float s = 0.f; for (int k = 0; k < K; ++k) s += bf2f(a[k]) * bf2f(b[k]); return s; }
__device__ inline float silu_f(float g) { return g / (1.0f + expf(-g)); }
__device__ inline void ref_ffn_in_item(size_t i_, const bf16_t* hb, const float* rss, const bf16_t* Bt, bf16_t* act) {
    const int m = (int)(i_ / D_FF), j = (int)(i_ % D_FF);
    const float rs = 1.0f / sqrtf(rss[m] / D_MODEL + EPS);
    const int ng = (j / 128) * 256 + (j % 128);
    const float g = rs * dot_bf(hb + (size_t)m * D_MODEL, Bt + (size_t)ng * D_MODEL, D_MODEL), u = rs * dot_bf(hb + (size_t)m * D_MODEL, Bt + (size_t)(ng + 128) * D_MODEL, D_MODEL);
    act[i_] = f2bf(silu_f(g) * u);
}
__device__ inline void ref_resid_row_item(size_t i_, const bf16_t* A, int K, const bf16_t* Bt, float coef, float* h, bf16_t* hb, float* rss_next, float* yout) {
    const int m = (int)i_; float s = 0.f;
    for (int c = 0; c < D_MODEL; ++c) {
        const float v = h[(size_t)m * D_MODEL + c] + coef * dot_bf(A + (size_t)m * K, Bt + (size_t)c * K, K);
        if (yout) { yout[(size_t)m * D_MODEL + c] = v; } else { h[(size_t)m * D_MODEL + c] = v; hb[(size_t)m * D_MODEL + c] = f2bf(v); s += v * v; }
    }
    if (!yout) rss_next[m] = s;
}

constexpr float QSCALE_F = 0.125f * 1.4426950408889634f;
__device__ inline void qconv_item(size_t i_, const float* qn, const float* qr, bf16_t* qnb, bf16_t* qrb) { qnb[i_] = f2bf(qn[i_] * QSCALE_F); qrb[i_] = f2bf(qr[i_] * QSCALE_F); }
__host__ __device__ inline size_t kimg_off(int kv, int d0) { return (size_t)(d0 >> 3) * 1024 + (size_t)kv * 16; }
__host__ __device__ inline size_t vimg_off(int kv, int d0) { return (size_t)(d0 >> 5) * 4096 + (size_t)(kv >> 3) * 512 + (size_t)(kv & 7) * 64 + (size_t)((d0 & 31) >> 3) * 16; }
__device__ inline void put_chunk(unsigned char* dst, const float* src) { bf16_t* d = (bf16_t*)dst; for (int k = 0; k < 8; ++k) d[k] = f2bf(src[k]); }
__device__ inline void kvimg_item(size_t i_, const float* out, const float* winrows, unsigned char* ksel, unsigned char* vsel, unsigned char* kwin, unsigned char* vwin) {
    const int c = (int)(i_ % 8), t = (int)((i_ / 8) % SEQ), g = (int)((i_ / (8 * (size_t)SEQ)) % N_KV), n = (int)(i_ / (8 * (size_t)SEQ * N_KV));
    const size_t base = (((size_t)n * N_KV + g) * (SEQ / 64) + t / 64) * 8192; const int kv = t % 64, d0 = 8 * c; const size_t m = (size_t)n * SEQ + t;
    put_chunk(ksel + base + kimg_off(kv, d0), out + O_KVP + ((m * 4 + 2) * N_KV + g) * HD + d0);
    put_chunk(vsel + base + vimg_off(kv, d0), out + O_KVP + ((m * 4 + 3) * N_KV + g) * HD + d0);
    put_chunk(kwin + base + kimg_off(kv, d0), winrows + ((m * 2 + 0) * N_KV + g) * HD + d0);
    put_chunk(vwin + base + vimg_off(kv, d0), winrows + ((m * 2 + 1) * N_KV + g) * HD + d0);
}
__device__ inline void kcimg_item(size_t i_, const float* kc, const float* vc, unsigned char* kci, unsigned char* vci) {
    const int c = (int)(i_ % 8), cb = (int)((i_ / 8) % NBC_P), g = (int)((i_ / (8 * (size_t)NBC_P)) % N_KV), n = (int)(i_ / (8 * (size_t)NBC_P * N_KV));
    const size_t base = (((size_t)n * N_KV + g) * (NBC_P / 64) + cb / 64) * 8192; const int kv = cb % 64, d0 = 8 * c;
    put_chunk(kci + base + kimg_off(kv, d0), kc + (((size_t)n * NBC_MAX + cb) * N_KV + g) * HD + d0);
    put_chunk(vci + base + vimg_off(kv, d0), vc + (((size_t)n * NBC_MAX + cb) * N_KV + g) * HD + d0);
}

constexpr int NBC_PAST = PAST_LEN / L_CMP;
constexpr int RS_CMP = DEC_BATCH * NBC_PAST * N_KV, RP_CMP = BATCH * NBC_P * N_KV;
__device__ inline void acmp_sample_item(size_t i_, const float* cache_kv, const int* page_table, const float* pe, bf16_t* A) {
    const int c8 = (int)(i_ % 8), l = (int)((i_ / 8) % L_CMP); const size_t rr = i_ / (8 * L_CMP); const int r = (int)(rr % RS_CMP), e = (int)(rr / RS_CMP);
    const int g = r % N_KV, c = (r / N_KV) % NBC_PAST, b = r / (N_KV * NBC_PAST), tok = c * L_CMP + l;
    const int page = page_table[b * N_PAGES + tok / PAGE_SIZE];
    const float* src = cache_kv + ((((size_t)page * PAGE_SIZE + tok % PAGE_SIZE) * 4 + e) * N_KV + g) * HD + 8 * c8; const float* pp = pe + ((size_t)e * L_CMP + l) * HD + 8 * c8;
    bf16_t* d = A + ((size_t)e * RS_CMP + r) * (L_CMP * HD) + l * HD + 8 * c8;
#ifndef CPU_TEST
    typedef float f4 __attribute__((ext_vector_type(4))); typedef unsigned u4 __attribute__((ext_vector_type(4)));
    const f4 a0 = __builtin_nontemporal_load((const f4*)src) + *(const f4*)pp, a1 = __builtin_nontemporal_load((const f4*)(src + 4)) + *(const f4*)(pp + 4);
    u4 w; w.x = (unsigned)f2bf(a0[0]) | ((unsigned)f2bf(a0[1]) << 16); w.y = (unsigned)f2bf(a0[2]) | ((unsigned)f2bf(a0[3]) << 16);
    w.z = (unsigned)f2bf(a1[0]) | ((unsigned)f2bf(a1[1]) << 16); w.w = (unsigned)f2bf(a1[2]) | ((unsigned)f2bf(a1[3]) << 16);
    *(u4*)d = w;
#else
    for (int k = 0; k < 8; ++k) d[k] = f2bf(src[k] + pp[k]);
#endif
}
__device__ inline void acmp_prompt_item(size_t i_, const float* out, const float* pe, bf16_t* A) {
    const int c8 = (int)(i_ % 8), l = (int)((i_ / 8) % L_CMP); const size_t rr = i_ / (8 * L_CMP); const int r = (int)(rr % RP_CMP), e = (int)(rr / RP_CMP);
    const int g = r % N_KV, c = (r / N_KV) % NBC_P, n = r / (N_KV * NBC_P), tok = c * L_CMP + l;
    const float* src = out + O_KVP + ((((size_t)n * SEQ + tok) * 4 + e) * N_KV + g) * HD + 8 * c8; const float* pp = pe + ((size_t)e * L_CMP + l) * HD + 8 * c8;
    bf16_t* d = A + ((size_t)e * RP_CMP + r) * (L_CMP * HD) + l * HD + 8 * c8;
    for (int k = 0; k < 8; ++k) d[k] = f2bf(src[k] + pp[k]);
}
__device__ inline void cmp_out_b_item(size_t i_, const bf16_t* hid, int R, int nbc, int seq0, const float* w2, const float* k_norm0, float* kc, float* vc) {
    const int r = (int)(i_ % R), e = (int)(i_ / R); const int g = r % N_KV, c = (r / N_KV) % nbc, sq = r / (N_KV * nbc);
    const bf16_t* hr = hid + ((size_t)e * R + r) * CMP_HID;
    float v[HD];
    for (int d = 0; d < HD; ++d) v[d] = 0.f;
    for (int f = 0; f < CMP_HID; ++f) { const float hf = bf2f(hr[f]); const float* w = w2 + ((size_t)e * CMP_HID + f) * HD; for (int d = 0; d < HD; ++d) v[d] += hf * w[d]; }
    if (e == 0) head_norm(v, k_norm0);
    float* o = (e == 0 ? kc : vc) + (((size_t)(seq0 + sq) * NBC_MAX + c) * N_KV + g) * HD;
    for (int d = 0; d < HD; ++d) o[d] = v[d];
}
__host__ __device__ inline int heads_row(int hidx, int d) { return (hidx / 4) * 256 + 128 * (d / 32) + 32 * (hidx % 4) + (d % 32); }
__device__ inline void conv_state_store(float* out, int layer, int m, int ch, float u) {
    const RowInfo ri = row_info(m); const int L = seq_len(ri.seq);
    if (ri.t >= L - 2) { const int j = ri.t - (L - 2);
        if (ri.seq < BATCH) out[O_CP + (((size_t)layer * BATCH + ri.seq) * 2 + j) * D_MODEL + ch] = u;
        else out[O_CS + (((size_t)layer * DEC_BATCH + (ri.seq - BATCH)) * 2 + j) * D_MODEL + ch] = u; }
}
__device__ inline void ref_conv_in_item(size_t i_, const bf16_t* hb, const float* rss, const bf16_t* Bt, bf16_t* ub, bf16_t* bb, float* out, int layer) {
    const int m = (int)(i_ / D_MODEL), j = (int)(i_ % D_MODEL);
    const float rs = 1.0f / sqrtf(rss[m] / D_MODEL + EPS); const bf16_t* a = hb + (size_t)m * D_MODEL;
    const int nc = (j / 128) * 256 + (j % 128);
    const float c = rs * dot_bf(a, Bt + (size_t)nc * D_MODEL, D_MODEL), x = rs * dot_bf(a, Bt + (size_t)(nc + 128) * D_MODEL, D_MODEL), b = rs * dot_bf(a, Bt + (size_t)(2 * D_MODEL + j) * D_MODEL, D_MODEL);
    const float u = c * x; ub[i_] = f2bf(u); bb[i_] = f2bf(b); conv_state_store(out, layer, m, j, u);
}
__device__ inline void conv_thin_item(size_t i_, const bf16_t* ub, const bf16_t* bb, const float* state  , const float* wc  , bf16_t* zb) {
    const int m = (int)(i_ / D_MODEL), ch = (int)(i_ % D_MODEL);
    const RowInfo ri = row_info(m);
    const float u0 = bf2f(ub[i_]);
    float u1, u2;
    if (ri.t >= 1) u1 = bf2f(ub[i_ - D_MODEL]); else u1 = (ri.seq < BATCH) ? 0.f : state[((size_t)(ri.seq - BATCH) * 2 + 1) * D_MODEL + ch];
    if (ri.t >= 2) u2 = bf2f(ub[i_ - 2 * D_MODEL]); else if (ri.seq < BATCH) u2 = 0.f;
    else u2 = (ri.t == 1) ? state[((size_t)(ri.seq - BATCH) * 2 + 1) * D_MODEL + ch] : state[((size_t)(ri.seq - BATCH) * 2 + 0) * D_MODEL + ch];
    zb[i_] = f2bf(bf2f(bb[i_]) * (wc[ch] * u2 + wc[D_MODEL + ch] * u1 + wc[2 * D_MODEL + ch] * u0));
}
__device__ inline void ref_qg_item(size_t i_, const bf16_t* hb, const float* rss, const bf16_t* Bt, const float* q_norm, const float* rope, float* qn, float* qr) {
    const int m = (int)(i_ / N_HEADS), hh = (int)(i_ % N_HEADS);
    const float rs = 1.0f / sqrtf(rss[m] / D_MODEL + EPS); const bf16_t* a = hb + (size_t)m * D_MODEL;
    float v[HD]; for (int d = 0; d < HD; ++d) v[d] = rs * dot_bf(a, Bt + (size_t)heads_row(hh, d) * D_MODEL, D_MODEL);
    head_norm(v, q_norm);
    for (int d = 0; d < HD; ++d) qn[(size_t)m * HDM + hh * HD + d] = v[d];
    const float* rt = rope + (size_t)pos_index(row_info(m).pos) * 16;
    for (int f = 0; f < 8; ++f) { const float x1 = v[f], x2 = v[8 + f]; v[f] = x1 * rt[f] - x2 * rt[8 + f]; v[8 + f] = x2 * rt[f] + x1 * rt[8 + f]; }
    for (int d = 0; d < HD; ++d) qr[(size_t)m * HDM + hh * HD + d] = v[d];
}
__device__ inline void ref_gates_item(size_t i_, const bf16_t* hb, const float* rss, const bf16_t* Bt, float* gates) {
    const int m = (int)(i_ / (3 * N_HEADS)), j = (int)(i_ % (3 * N_HEADS));
    const float rs = 1.0f / sqrtf(rss[m] / D_MODEL + EPS);
    const float x = rs * dot_bf(hb + (size_t)m * D_MODEL, Bt + (size_t)(HDM + j) * D_MODEL, D_MODEL);
    gates[i_] = 1.0f / (1.0f + expf(-x));
}
__device__ inline void kv_store(float* out, float* winrows, int m, int e, int g, int d, float v) {
    const RowInfo ri = row_info(m);
    if (e < 4) { if (ri.seq < BATCH) out[O_KVP + (((size_t)m * 4 + e) * N_KV + g) * HD + d] = v; else out[O_KVS + (((size_t)(m - MP) * 4 + e) * N_KV + g) * HD + d] = v; }
    else { const int we = e - 4;
        winrows[(((size_t)m * 2 + we) * N_KV + g) * HD + d] = v;
        if (ri.seq < BATCH) { if (ri.t >= SEQ - WINDOW) out[O_WP + ((((size_t)ri.seq * WINDOW + (ri.t - (SEQ - WINDOW))) * 2 + we) * N_KV + g) * HD + d] = v; }
        else out[O_WS + ((((size_t)(ri.seq - BATCH) * WINDOW + (WINDOW - DEC_SEQ + ri.t)) * 2 + we) * N_KV + g) * HD + d] = v; }
}
__device__ inline void ref_kv_item(size_t i_, const bf16_t* hb, const float* rss, const bf16_t* Bt, const float* k_norm, const float* rope, float* out, float* winrows) {
    const int m = (int)(i_ / (6 * N_KV)), hidx = (int)(i_ % (6 * N_KV)), e = hidx / N_KV, g = hidx % N_KV;
    const float rs = 1.0f / sqrtf(rss[m] / D_MODEL + EPS); const bf16_t* a = hb + (size_t)m * D_MODEL;
    float v[HD]; for (int d = 0; d < HD; ++d) v[d] = rs * dot_bf(a, Bt + (size_t)heads_row(hidx, d) * D_MODEL, D_MODEL);
    if (e == 2 || e == 4) { head_norm(v, k_norm + (e == 2 ? 1 : 2) * HD);
        const float* rt = rope + (size_t)pos_index(row_info(m).pos) * 16;
        for (int f = 0; f < 8; ++f) { const float x1 = v[f], x2 = v[8 + f]; v[f] = x1 * rt[f] - x2 * rt[8 + f]; v[8 + f] = x2 * rt[f] + x1 * rt[8 + f]; } }
    for (int d = 0; d < HD; ++d) kv_store(out, winrows, m, e, g, d, v[d]);
}
#ifndef CPU_TEST
#define LAS __attribute__((address_space(3)))
#define XB_TMO      128
#define XB_XCNT(j)  (256  + 64 * (j))
#define XB_XSUB(j)  (1280 + 64 * (j))
#define XB_XGEN(j)  (2304 + 64 * (j))
#define XB_TOP      3328
#define XB_TOPGEN   3392
#define XCD_BAR_WORDS 3456
#define XB_SPIN_CAP (1u << 25)
typedef __attribute__((address_space(1))) unsigned GU;
__device__ __forceinline__ unsigned xb_ld(GU* p)              { return __hip_atomic_load(p, __ATOMIC_RELAXED, __HIP_MEMORY_SCOPE_AGENT); }
__device__ __forceinline__ unsigned xb_add(GU* p, unsigned v) { return __hip_atomic_fetch_add(p, v, __ATOMIC_RELAXED, __HIP_MEMORY_SCOPE_AGENT); }
__device__ __forceinline__ unsigned xb_xcc_id() { return (unsigned)__builtin_amdgcn_s_getreg((3 << 11) | 20) & 0xFu; }
#define XB_SPIN(cond, bar) do { unsigned _sp = 0; while (cond) { __builtin_amdgcn_s_sleep(1); \
    if ((++_sp & 255u) == 0u) { if (xb_ld(&(bar)[XB_TMO])) break; if (_sp > XB_SPIN_CAP) { (void)xb_add(&(bar)[XB_TMO], 1u); break; } } } } while (0)
struct XcdBarrier { GU* bar; unsigned x; volatile LAS unsigned* st; };
__device__ __forceinline__ XcdBarrier xcd_barrier_post(GU* bar, volatile LAS unsigned* st, const bool leader_thread) {
    XcdBarrier b; b.bar = bar; b.x = xb_xcc_id(); b.st = st;
    if (leader_thread) (void)xb_add(&bar[XB_XCNT(b.x)], 1u);
    return b;
}
__device__ __forceinline__ void xcd_barrier_complete(GU* bar, unsigned x, unsigned& nloc, unsigned& nx) {
    const unsigned G = gridDim.x * gridDim.y * gridDim.z;
    unsigned sum, cnt, mine, sp = 0u;
    for (;;) {
        sum = 0u; cnt = 0u; mine = 0u;
#pragma unroll
        for (unsigned j = 0; j < 16; ++j) { const unsigned c = xb_ld(&bar[XB_XCNT(j)]); sum += c; cnt += (c > 0u) ? 1u : 0u; mine = (j == x) ? c : mine; }
        if (sum == G) break;
        __builtin_amdgcn_s_sleep(1);
        if ((++sp & 255u) == 0u) { if (xb_ld(&bar[XB_TMO])) break; if (sp > XB_SPIN_CAP) { (void)xb_add(&bar[XB_TMO], 1u); break; } }
    }
    nloc = mine > 0u ? mine : 1u; nx = cnt > 0u ? cnt : 1u;
}
__device__ __forceinline__ void xcd_barrier(const XcdBarrier& b, const bool leader_thread) {
    asm volatile("s_waitcnt vmcnt(0)" ::: "memory");
    __syncthreads();
    if (leader_thread) {
        GU* bar = b.bar; unsigned bx = xb_xcc_id(); asm volatile("" : "+s"(bx));
        __builtin_amdgcn_s_waitcnt(0);
        unsigned nloc = b.st[0], nx = b.st[1];
        if (nloc == 0u) { xcd_barrier_complete(bar, bx, nloc, nx); b.st[0] = nloc; b.st[1] = nx; }
        const unsigned old = xb_add(&bar[XB_XSUB(bx)], 1u);
        const unsigned gen = old / nloc;
        if (old + 1u == (gen + 1u) * nloc) {
            __builtin_amdgcn_fence(__ATOMIC_RELEASE, "agent");
            asm volatile("s_waitcnt vmcnt(0)" ::: "memory");
            const unsigned og = xb_add(&bar[XB_TOP], 1u);
            const unsigned tg = og / nx;
            if (og + 1u == (tg + 1u) * nx) xb_add(&bar[XB_TOPGEN], 1u);
            else XB_SPIN(xb_ld(&bar[XB_TOPGEN]) == tg, bar);
            __builtin_amdgcn_fence(__ATOMIC_ACQUIRE, "agent");
            xb_add(&bar[XB_XGEN(bx)], 1u);
            asm volatile("s_waitcnt vmcnt(0)" ::: "memory");
        } else {
            XB_SPIN(xb_ld(&bar[XB_XGEN(bx)]) == gen, bar);
            __builtin_amdgcn_fence(__ATOMIC_ACQUIRE, "agent");
            asm volatile("s_waitcnt vmcnt(0)" ::: "memory");
        }
    }
    __syncthreads();
}

namespace pg8 {
#define PG8_LAS __attribute__((address_space(3)))
typedef unsigned short bf16_t;
typedef short bf16x8 __attribute__((ext_vector_type(8)));
typedef float f32x4 __attribute__((ext_vector_type(4)));
typedef unsigned u32x4 __attribute__((ext_vector_type(4)));
constexpr int BM = 256, BK = 64, HALF = 128, HTB = HALF * BK * 2  , STAGE_BYTES = 8 * HTB, NXCD = 8, WGM = 8;

__host__ __device__ __forceinline__ int lds_byte(int r, int c) { const int st = (r >> 4) * 2 + (c >> 5), rr = r & 15, cc = c & 31, ob = rr * 64 + cc * 2; return st * 1024 + (ob ^ (((ob >> 9) & 1) << 5)); }
__host__ __device__ __forceinline__ void stage_rc(int b, int& R, int& C) { const int st = b / 1024, sb = b % 1024, swz = sb ^ (((sb >> 9) & 1) << 5); R = (st >> 1) * 16 + swz / 64; C = (st & 1) * 32 + (swz % 64) / 2; }
__host__ __device__ __forceinline__ int perm32(int rho) { const int n = rho >> 4, i = rho & 15; return 8 * (i >> 2) + 4 * n + (i & 3); }

struct Unit { int pm, pn; };
struct Gemm { const bf16_t* A; const bf16_t* Bt; int M, N, K; };

struct StaticOrder {
    int nM, nN, nwg, G, c;
    __host__ __device__ void init(int M, int N, int G_, int c_) { nM = M / BM; nN = N / BM; nwg = nM * nN; G = G_; c = c_; }
    __host__ __device__ bool next(int i, Unit& u) const {
        const long L = (long)i * G + c; if (L >= nwg) return false;
        int wgid = (int)L; { const int q = nwg / NXCD, r = nwg % NXCD, xcd = wgid % NXCD, off = wgid / NXCD; wgid = (xcd < r ? xcd * (q + 1) : r * (q + 1) + (xcd - r) * q) + off; }
        const int nig = WGM * nN, gid = wgid / nig, fm = gid * WGM, gsz = (nM - fm) < WGM ? (nM - fm) : WGM;
        u.pm = fm + ((wgid % nig) % gsz); u.pn = (wgid % nig) / gsz; return true;
    }
    __device__ __forceinline__ void a_ready(const Unit&) const {}
    __device__ __forceinline__ void done(const Unit&) const {}
};

__device__ __forceinline__ unsigned cvt_pk_bf16(float lo, float hi) { unsigned r; asm volatile("v_cvt_pk_bf16_f32 %0, %1, %2" : "=v"(r) : "v"(lo), "v"(hi)); return r; }
template <class Epi, class Sched, bool ALIGN_EPI = false, bool SP2 = false>
__device__ __forceinline__ void gemm_phase(int wave_id_, PG8_LAS unsigned char* lds, const Gemm g, const Sched& S, const Epi& E) {
    int wid = wave_id_, lane = (int)lane_id_v(); asm volatile("" : "+s"(wid));
    const int tid = wid * 64 + lane, wr = wid >> 2, wc = wid & 3, fr = lane & 15, fq = lane >> 4;
    const int K = g.K, nt = K / BK;
    unsigned voffA[2], voffB[2];
#pragma unroll
    for (int i = 0; i < 2; ++i) { int R, C; stage_rc(tid * 16 + i * 8192, R, C); const int Rb = Epi::PERM ? ((R & ~31) + perm32(R & 31)) : R;
        voffA[i] = (unsigned)(R * K + C) * 2u; voffB[i] = (unsigned)(Rb * K + C) * 2u; }
    const size_t kstep = (size_t)(BK * 2);
    const size_t hstep = (size_t)HALF * K * 2;
    const size_t tstep = 2 * hstep;
    const unsigned ldsw = (unsigned)wid * 1024u;
    const int aoff = lds_byte(wr * 64 + fr, fq * 8), boff = lds_byte(wc * 32 + fr, fq * 8);
#define PG8_SA(b, h) (((b) * 2 + (h)) * HTB)
#define PG8_SB(b, h) ((4 + (b) * 2 + (h)) * HTB)
#define PG8_STAGE(bufoff, gbase, voff) do { _Pragma("unroll") for (int _i = 0; _i < 2; ++_i) \
        __builtin_amdgcn_global_load_lds((const unsigned*)((const char*)(gbase) + (voff)[_i]), (PG8_LAS unsigned*)(lds + (bufoff) + ldsw + _i * 8192), 16, 0, 0); } while (0)
#define PG8_LDA(dst, b, h) do { _Pragma("unroll") for (int m = 0; m < 4; ++m) _Pragma("unroll") for (int k = 0; k < 2; ++k) dst[m][k] = *(const PG8_LAS bf16x8*)(lds + PG8_SA(b, h) + aoff + m * 2048 + k * 1024); } while (0)
#define PG8_LDB(dst, b, h) do { _Pragma("unroll") for (int n = 0; n < 2; ++n) _Pragma("unroll") for (int k = 0; k < 2; ++k) dst[n][k] = *(const PG8_LAS bf16x8*)(lds + PG8_SB(b, h) + boff + n * 2048 + k * 1024); } while (0)
#define PG8_MMA(ai, bj, At, Bt) do { __builtin_amdgcn_s_setprio(1); _Pragma("unroll") for (int m = 0; m < 4; ++m) _Pragma("unroll") for (int n = 0; n < 2; ++n) _Pragma("unroll") for (int k = 0; k < 2; ++k) \
        acc[ai][bj][m][n] = __builtin_amdgcn_mfma_f32_16x16x32_bf16(Bt[n][k], At[m][k], acc[ai][bj][m][n], 0, 0, 0); __builtin_amdgcn_s_setprio(0); } while (0)
#define PG8_WAIT_V(n) asm volatile("s_waitcnt vmcnt(" #n ")" ::: "memory")
#define PG8_WAIT_L(n) asm volatile("s_waitcnt lgkmcnt(" #n ")" ::: "memory")
#define PG8_BAR __builtin_amdgcn_s_barrier()
#define PG8_SCHED __builtin_amdgcn_sched_barrier(0)
    Unit cur, nxt; int ui = 0; float rsv[8];
#pragma unroll
    for (int i_ = 0; i_ < 8; ++i_) rsv[i_] = 0.f;
    if (!S.next(0, cur)) return;
    f32x4 acc[2][2][4][2];
    if constexpr (Epi::ACC_INIT) E.init_acc(acc, cur, wr, wc, fr, fq);
    else {
#pragma unroll
    for (int a = 0; a < 2; ++a)
#pragma unroll
        for (int b = 0; b < 2; ++b)
#pragma unroll
            for (int m = 0; m < 4; ++m)
#pragma unroll
                for (int n = 0; n < 2; ++n) acc[a][b][m][n] = (f32x4){0.f, 0.f, 0.f, 0.f};
    }
    bf16x8 At[4][2], B0[2][2], B1[2][2];
    const char* cA = (const char*)g.A + (size_t)cur.pm * tstep; const char* cB = (const char*)g.Bt + (size_t)cur.pn * tstep;
    S.a_ready(cur);
    if constexpr (SP2) {
        PG8_STAGE(PG8_SB(0, 0), cB, voffB); PG8_STAGE(PG8_SB(0, 1), cB + hstep, voffB); PG8_STAGE(PG8_SA(0, 0), cA, voffA); PG8_STAGE(PG8_SA(0, 1), cA + hstep, voffA);
        if (wr == 1) PG8_BAR;
        PG8_WAIT_V(2); PG8_BAR;
        PG8_STAGE(PG8_SB(1, 0), cB + kstep, voffB); PG8_STAGE(PG8_SA(1, 0), cA + kstep, voffA); PG8_STAGE(PG8_SB(1, 1), cB + hstep + kstep, voffB);
        PG8_WAIT_V(6); PG8_BAR;
    } else {
        PG8_STAGE(PG8_SB(0, 0), cB, voffB); PG8_STAGE(PG8_SA(0, 0), cA, voffA); PG8_STAGE(PG8_SB(0, 1), cB + hstep, voffB); PG8_STAGE(PG8_SA(0, 1), cA + hstep, voffA);
        if (wr == 1) PG8_BAR;
        PG8_WAIT_V(4); PG8_BAR;
        PG8_STAGE(PG8_SB(1, 0), cB + kstep, voffB); PG8_STAGE(PG8_SA(1, 0), cA + kstep, voffA); PG8_STAGE(PG8_SB(1, 1), cB + hstep + kstep, voffB);
        PG8_WAIT_V(6); PG8_BAR;
    }
    for (;;) {
        const bool has_next = S.next(ui + 1, nxt);
        const char* nA = has_next ? (const char*)g.A + (size_t)nxt.pm * tstep : cA; const char* nB = has_next ? (const char*)g.Bt + (size_t)nxt.pn * tstep : cB;
        for (int t = 0; t < nt; t += 2) {
            const bool last = (t == nt - 2);
            const char* a1 = cA + (size_t)(t + 1) * kstep;
            const char* a2 = last ? nA : cA + (size_t)(t + 2) * kstep; const char* b2 = last ? nB : cB + (size_t)(t + 2) * kstep;
            const char* a3 = a2 + kstep; const char* b3 = b2 + kstep;
            if (last && has_next) S.a_ready(nxt);
            if (last) E.pre(cur, wr, fr, rsv);
            if constexpr (SP2) {
            PG8_LDB(B0, 0, 0); PG8_LDB(B1, 0, 1); PG8_SCHED; PG8_LDA(At, 0, 0); PG8_STAGE(PG8_SA(1, 1), a1 + hstep, voffA);
            PG8_WAIT_V(8); PG8_WAIT_L(0); PG8_BAR; PG8_MMA(0, 0, At, B0); PG8_MMA(0, 1, At, B1); PG8_BAR; PG8_SCHED;
            PG8_LDA(At, 0, 1); PG8_STAGE(PG8_SB(0, 0), b2, voffB); PG8_STAGE(PG8_SB(0, 1), b2 + hstep, voffB); PG8_STAGE(PG8_SA(0, 0), a2, voffA);
            PG8_WAIT_V(8); PG8_WAIT_L(0); PG8_BAR; PG8_MMA(1, 0, At, B0); PG8_MMA(1, 1, At, B1); PG8_BAR; PG8_SCHED;
            PG8_LDB(B0, 1, 0); PG8_LDB(B1, 1, 1); PG8_SCHED; PG8_LDA(At, 1, 0); PG8_STAGE(PG8_SA(0, 1), a2 + hstep, voffA);
            PG8_WAIT_V(8); PG8_WAIT_L(0); PG8_BAR; PG8_MMA(0, 0, At, B0); PG8_MMA(0, 1, At, B1); PG8_BAR; PG8_SCHED;
            PG8_LDA(At, 1, 1); PG8_STAGE(PG8_SB(1, 0), b3, voffB); PG8_STAGE(PG8_SB(1, 1), b3 + hstep, voffB); PG8_STAGE(PG8_SA(1, 0), a3, voffA);
            PG8_WAIT_V(8); PG8_WAIT_L(0); PG8_BAR; PG8_MMA(1, 0, At, B0); PG8_MMA(1, 1, At, B1); PG8_BAR; PG8_SCHED;
            } else {
            PG8_LDB(B0, 0, 0); PG8_SCHED; PG8_LDA(At, 0, 0); PG8_STAGE(PG8_SA(1, 1), a1 + hstep, voffA);
            PG8_WAIT_L(8); PG8_BAR; PG8_WAIT_L(0); PG8_MMA(0, 0, At, B0); PG8_BAR; PG8_SCHED;
            PG8_LDB(B1, 0, 1); PG8_STAGE(PG8_SB(0, 0), b2, voffB);
            PG8_BAR; PG8_WAIT_L(0); PG8_MMA(0, 1, At, B1); PG8_BAR;
            PG8_LDA(At, 0, 1); PG8_STAGE(PG8_SA(0, 0), a2, voffA);
            PG8_BAR; PG8_WAIT_L(0); PG8_MMA(1, 0, At, B0); PG8_BAR; PG8_SCHED;
            PG8_STAGE(PG8_SB(0, 1), b2 + hstep, voffB);
            PG8_WAIT_V(6); PG8_BAR; PG8_MMA(1, 1, At, B1); PG8_BAR;
            PG8_LDB(B0, 1, 0); PG8_SCHED; PG8_LDA(At, 1, 0); PG8_STAGE(PG8_SA(0, 1), a2 + hstep, voffA);
            PG8_WAIT_L(8); PG8_BAR; PG8_WAIT_L(0); PG8_MMA(0, 0, At, B0); PG8_BAR; PG8_SCHED;
            PG8_LDB(B1, 1, 1); PG8_STAGE(PG8_SB(1, 0), b3, voffB);
            PG8_BAR; PG8_WAIT_L(0); PG8_MMA(0, 1, At, B1); PG8_BAR;
            PG8_LDA(At, 1, 1); PG8_STAGE(PG8_SA(1, 0), a3, voffA);
            PG8_BAR; PG8_WAIT_L(0); PG8_MMA(1, 0, At, B0); PG8_BAR; PG8_SCHED;
            PG8_STAGE(PG8_SB(1, 1), b3 + hstep, voffB);
            PG8_WAIT_V(6); PG8_BAR; PG8_MMA(1, 1, At, B1); PG8_BAR;
            }
        }
        if constexpr (ALIGN_EPI) { if (wr == 0) PG8_BAR; }
        if constexpr (!Epi::AFTER_DRAIN) { E(acc, cur, wr, wc, fr, fq, rsv); S.done(cur); }
        if (!has_next) break;
        if constexpr (Epi::ACC_INIT) E.init_acc(acc, nxt, wr, wc, fr, fq);
        else {
#pragma unroll
        for (int a = 0; a < 2; ++a)
#pragma unroll
            for (int b = 0; b < 2; ++b)
#pragma unroll
                for (int m = 0; m < 4; ++m)
#pragma unroll
                    for (int n = 0; n < 2; ++n) acc[a][b][m][n] = (f32x4){0.f, 0.f, 0.f, 0.f};
        }
        cur = nxt; cA = nA; cB = nB; ++ui;
        if constexpr (ALIGN_EPI) { if (wr == 1) PG8_BAR; }
    }
    PG8_WAIT_V(0);
    if constexpr (!ALIGN_EPI) { if (wr == 0) PG8_BAR; }
    PG8_BAR;
    if constexpr (Epi::AFTER_DRAIN) { E.fused(acc, cur, wr, wc, fr, fq, lds, wid, lane); S.done(cur); }
#undef PG8_SA
#undef PG8_SB
#undef PG8_STAGE
#undef PG8_LDA
#undef PG8_LDB
#undef PG8_MMA
#undef PG8_WAIT_V
#undef PG8_WAIT_L
#undef PG8_BAR
#undef PG8_SCHED
}
}

namespace pg8 {
__device__ __forceinline__ float fast_silu(float g) { return g * __builtin_amdgcn_rcpf(1.0f + __expf(-g)); }
__device__ __forceinline__ float row_rs(const float* rss, int row) { return rsqrtf(rss_dec(rss[row]) * (1.0f / D_MODEL) + EPS); }
struct EpiSwiglu {
    static constexpr bool PERM = true, AFTER_DRAIN = false, ACC_INIT = false;
    bf16_t* act; const float* rss;
    __device__ __forceinline__ void pre(const Unit& u, int wr, int fr, float (&rsv)[8]) const {
        const __attribute__((address_space(1))) float* rp = (const __attribute__((address_space(1))) float*)rss + u.pm * BM + wr * 64 + fr;
#pragma unroll
        for (int ai = 0; ai < 2; ++ai)
#pragma unroll
            for (int m = 0; m < 4; ++m) rsv[ai * 4 + m] = rp[ai * HALF + m * 16];
    }
    __device__ __forceinline__ void operator()(const f32x4 (&acc)[2][2][4][2], const Unit& u, int wr, int wc, int fr, int fq, const float (&rsv)[8]) const {
        const int row0 = u.pm * BM + wr * 64 + fr, col0 = u.pn * 128 + wc * 32 + 8 * fq;
#pragma unroll
        for (int ai = 0; ai < 2; ++ai)
#pragma unroll
            for (int m = 0; m < 4; ++m) {
                const int row = row0 + ai * HALF + m * 16; const float rs = rsqrtf(rss_dec(rsv[ai * 4 + m]) * (1.0f / D_MODEL) + EPS);
                float a[8];
#pragma unroll
                for (int n = 0; n < 2; ++n)
#pragma unroll
                    for (int i = 0; i < 4; ++i) a[n * 4 + i] = fast_silu(acc[ai][0][m][n][i] * rs) * (acc[ai][1][m][n][i] * rs);
                u32x4 w; w.x = cvt_pk_bf16(a[0], a[1]); w.y = cvt_pk_bf16(a[2], a[3]); w.z = cvt_pk_bf16(a[4], a[5]); w.w = cvt_pk_bf16(a[6], a[7]);
                *(u32x4*)(act + (size_t)row * D_FF + col0) = w;
            }
    }
};
struct EpiResid {
    static constexpr bool PERM = true, AFTER_DRAIN = false, ACC_INIT = true;
    bf16_t* hb; float* rss_next; float* yout; float coef;
    __device__ __forceinline__ void pre(const Unit&, int, int, float (&)[8]) const {}
    __device__ __forceinline__ void init_acc(f32x4 (&acc)[2][2][4][2], const Unit& u, int wr, int wc, int fr, int fq) const {
        const __attribute__((address_space(1))) bf16_t* hp = (const __attribute__((address_space(1))) bf16_t*)hb + (size_t)(u.pm * BM + wr * 64 + fr) * D_MODEL + u.pn * BM + wc * 32 + 8 * fq;
        const float ic = 1.0f / coef;
#pragma unroll
        for (int ai = 0; ai < 2; ++ai)
#pragma unroll
            for (int m = 0; m < 4; ++m)
#pragma unroll
                for (int bj = 0; bj < 2; ++bj) {
                    const u32x4 w = *(const __attribute__((address_space(1))) u32x4*)(hp + (size_t)(ai * HALF + m * 16) * D_MODEL + bj * HALF);
                    acc[ai][bj][m][0] = (f32x4){__uint_as_float(w.x << 16), __uint_as_float(w.x & 0xffff0000u), __uint_as_float(w.y << 16), __uint_as_float(w.y & 0xffff0000u)} * ic;
                    acc[ai][bj][m][1] = (f32x4){__uint_as_float(w.z << 16), __uint_as_float(w.z & 0xffff0000u), __uint_as_float(w.w << 16), __uint_as_float(w.w & 0xffff0000u)} * ic;
                }
    }
    __device__ __forceinline__ void operator()(const f32x4 (&acc)[2][2][4][2], const Unit& u, int wr, int wc, int fr, int fq, const float (&rsv)[8]) const {
        const int row0 = u.pm * BM + wr * 64 + fr, col0 = u.pn * BM + wc * 32 + 8 * fq;
#pragma unroll
        for (int ai = 0; ai < 2; ++ai)
#pragma unroll
            for (int m = 0; m < 4; ++m) {
                const int row = row0 + ai * HALF + m * 16; float s = 0.f;
#pragma unroll
                for (int bj = 0; bj < 2; ++bj) {
                    const f32x4 v0 = acc[ai][bj][m][0] * coef, v1 = acc[ai][bj][m][1] * coef;
                    const size_t o = (size_t)row * D_MODEL + col0 + bj * HALF;
                    if (yout) { *(f32x4*)(yout + o) = v0; *(f32x4*)(yout + o + 4) = v1; }
                    else {
                        u32x4 w; w.x = cvt_pk_bf16(v0[0], v0[1]); w.y = cvt_pk_bf16(v0[2], v0[3]); w.z = cvt_pk_bf16(v1[0], v1[1]); w.w = cvt_pk_bf16(v1[2], v1[3]);
                        *(u32x4*)(hb + o) = w;
                        s += ((v0[0] * v0[0] + v0[1] * v0[1]) + (v0[2] * v0[2] + v0[3] * v0[3])) + ((v1[0] * v1[0] + v1[1] * v1[1]) + (v1[2] * v1[2] + v1[3] * v1[3]));
                    }
                }
                if (!yout) { s += __shfl_xor(s, 16); s += __shfl_xor(s, 32); if (fq == 0) (void)__hip_atomic_fetch_add((unsigned*)rss_next + row, rss_enc(s), __ATOMIC_RELAXED, __HIP_MEMORY_SCOPE_AGENT); }
            }
    }
};
}
namespace pg8 {
__device__ __forceinline__ float sum4(f32x4 v) { return (v[0] * v[0] + v[1] * v[1]) + (v[2] * v[2] + v[3] * v[3]); }
struct EpiConvIn {
    static constexpr bool PERM = true, AFTER_DRAIN = false, ACC_INIT = false;
    bf16_t* ub; bf16_t* bb; const float* rss; float* out; int layer;
    __device__ __forceinline__ void pre(const Unit& u, int wr, int fr, float (&rsv)[8]) const {
        const __attribute__((address_space(1))) float* rp = (const __attribute__((address_space(1))) float*)rss + u.pm * BM + wr * 64 + fr;
#pragma unroll
        for (int ai = 0; ai < 2; ++ai)
#pragma unroll
            for (int m = 0; m < 4; ++m) rsv[ai * 4 + m] = rp[ai * HALF + m * 16];
    }
    __device__ __forceinline__ void operator()(const f32x4 (&acc)[2][2][4][2], const Unit& u, int wr, int wc, int fr, int fq, const float (&rsv)[8]) const {
        const int row0 = u.pm * BM + wr * 64 + fr;
        const bool pair = u.pn < D_MODEL / 128;
#pragma unroll
        for (int ai = 0; ai < 2; ++ai)
#pragma unroll
            for (int m = 0; m < 4; ++m) {
                const int row = row0 + ai * HALF + m * 16; const float rs = rsqrtf(rss_dec(rsv[ai * 4 + m]) * (1.0f / D_MODEL) + EPS);
                if (pair) {
                    const int col0 = u.pn * 128 + wc * 32 + 8 * fq; float a[8];
#pragma unroll
                    for (int n = 0; n < 2; ++n)
#pragma unroll
                        for (int i = 0; i < 4; ++i) a[n * 4 + i] = (acc[ai][0][m][n][i] * rs) * (acc[ai][1][m][n][i] * rs);
                    u32x4 w; w.x = cvt_pk_bf16(a[0], a[1]); w.y = cvt_pk_bf16(a[2], a[3]); w.z = cvt_pk_bf16(a[4], a[5]); w.w = cvt_pk_bf16(a[6], a[7]);
                    *(u32x4*)(ub + (size_t)row * D_MODEL + col0) = w;
                    const RowInfo ri = row_info(row); const int jj = ri.t - (seq_len(ri.seq) - 2);
                    if (jj >= 0) {
                        float* cs = (ri.seq < BATCH) ? out + O_CP + (((size_t)layer * BATCH + ri.seq) * 2 + jj) * D_MODEL + col0 : out + O_CS + (((size_t)layer * DEC_BATCH + (ri.seq - BATCH)) * 2 + jj) * D_MODEL + col0;
                        *(f32x4*)(cs) = (f32x4){a[0], a[1], a[2], a[3]}; *(f32x4*)(cs + 4) = (f32x4){a[4], a[5], a[6], a[7]};
                    }
                } else {
#pragma unroll
                    for (int bj = 0; bj < 2; ++bj) {
                        const int col0 = (u.pn - D_MODEL / 128) * 256 + bj * HALF + wc * 32 + 8 * fq;
                        const f32x4 v0 = acc[ai][bj][m][0] * rs, v1 = acc[ai][bj][m][1] * rs;
                        u32x4 w; w.x = cvt_pk_bf16(v0[0], v0[1]); w.y = cvt_pk_bf16(v0[2], v0[3]); w.z = cvt_pk_bf16(v1[0], v1[1]); w.w = cvt_pk_bf16(v1[2], v1[3]);
                        *(u32x4*)(bb + (size_t)row * D_MODEL + col0) = w;
                    }
                }
                asm volatile("" ::: "memory");
            }
    }
};
__device__ __forceinline__ void head_norm_rope(f32x4 (&v)[2][2], const float* gain, const float* rt  , int fq, bool do_norm, bool do_rope, f32x4 (&rot0)[2]) {
    if (do_norm) {
        float ss = (sum4(v[0][0]) + sum4(v[0][1])) + (sum4(v[1][0]) + sum4(v[1][1]));
        ss += __shfl_xor(ss, 16); ss += __shfl_xor(ss, 32);
        const float r = rsqrtf(ss * (1.0f / HD) + EPS);
#pragma unroll
        for (int bj = 0; bj < 2; ++bj)
#pragma unroll
            for (int n = 0; n < 2; ++n) { const f32x4 g = *(const f32x4*)(gain + 32 * bj + 8 * fq + 4 * n); v[bj][n] = v[bj][n] * r * g; }
    }
    rot0[0] = v[0][0]; rot0[1] = v[0][1];
    if (do_rope) {
#pragma unroll
        for (int n = 0; n < 2; ++n) {
            f32x4 p;
#pragma unroll
            for (int i = 0; i < 4; ++i) p[i] = __shfl_xor(v[0][n][i], 16);
            const f32x4 c = *(const f32x4*)(rt + 4 * n), s = *(const f32x4*)(rt + 8 + 4 * n);
            if (fq == 0) rot0[n] = v[0][n] * c - p * s; else if (fq == 1) rot0[n] = v[0][n] * c + p * s;
        }
    }
}
__device__ __forceinline__ u32x4 pack8(const f32x4 a, const f32x4 b, float sc) { u32x4 w; w.x = cvt_pk_bf16(a[0] * sc, a[1] * sc); w.y = cvt_pk_bf16(a[2] * sc, a[3] * sc); w.z = cvt_pk_bf16(b[0] * sc, b[1] * sc); w.w = cvt_pk_bf16(b[2] * sc, b[3] * sc); return w; }
struct EpiQG {
    static constexpr bool PERM = true, AFTER_DRAIN = false, ACC_INIT = false;
    bf16_t* qnb; bf16_t* qrb; float* gates; const float* rss; const float* q_norm; const float* rope;
    __device__ __forceinline__ void pre(const Unit& u, int wr, int fr, float (&rsv)[8]) const {
        const __attribute__((address_space(1))) float* rp = (const __attribute__((address_space(1))) float*)rss + u.pm * BM + wr * 64 + fr;
#pragma unroll
        for (int ai = 0; ai < 2; ++ai)
#pragma unroll
            for (int m = 0; m < 4; ++m) rsv[ai * 4 + m] = rp[ai * HALF + m * 16];
    }
    __device__ __forceinline__ void operator()(const f32x4 (&acc)[2][2][4][2], const Unit& u, int wr, int wc, int fr, int fq, const float (&rsv)[8]) const {
        const int row0 = u.pm * BM + wr * 64 + fr;
#pragma unroll
        for (int ai = 0; ai < 2; ++ai)
#pragma unroll
            for (int m = 0; m < 4; ++m) {
                const int row = row0 + ai * HALF + m * 16; const float rs = rsqrtf(rss_dec(rsv[ai * 4 + m]) * (1.0f / D_MODEL) + EPS);
                if (u.pn < N_HEADS / 4) {
                    const int hh = u.pn * 4 + wc;
                    f32x4 v[2][2] = {{acc[ai][0][m][0] * rs, acc[ai][0][m][1] * rs}, {acc[ai][1][m][0] * rs, acc[ai][1][m][1] * rs}}; f32x4 rot0[2];
                    head_norm_rope(v, q_norm, rope + (size_t)pos_index(row_info(row).pos) * 16, fq, true, true, rot0);
                    const size_t o = (size_t)row * HDM + hh * HD + 8 * fq;
                    const u32x4 hi8 = pack8(v[1][0], v[1][1], QSCALE_F);
                    *(u32x4*)(qnb + o) = pack8(v[0][0], v[0][1], QSCALE_F); *(u32x4*)(qnb + o + 32) = hi8;
                    *(u32x4*)(qrb + o) = pack8(rot0[0], rot0[1], QSCALE_F); *(u32x4*)(qrb + o + 32) = hi8;
                } else {
                    const int c0 = wc * 32 + 8 * fq;
#pragma unroll
                    for (int n = 0; n < 2; ++n)
#pragma unroll
                        for (int i = 0; i < 4; ++i) { const int c = c0 + 4 * n + i; if (c < 3 * N_HEADS) gates[(size_t)row * 3 * N_HEADS + c] = __builtin_amdgcn_rcpf(1.0f + __expf(-(acc[ai][0][m][n][i] * rs))); }
                }
                asm volatile("" ::: "memory");
            }
    }
};
struct EpiKV {
    static constexpr bool PERM = true, AFTER_DRAIN = false, ACC_INIT = false;
    float* out; float* winrows; const float* rss; const float* k_norm; const float* rope;
    unsigned char* ksel; unsigned char* vsel; unsigned char* kwin; unsigned char* vwin; bf16_t* acp; const float* pe;
    __device__ __forceinline__ void pre(const Unit&, int, int, float (&)[8]) const {}
    __device__ __forceinline__ void operator()(const f32x4 (&acc)[2][2][4][2], const Unit& u, int wr, int wc, int fr, int fq, const float (&rsv)[8]) const {
        const int row0 = u.pm * BM + wr * 64 + fr;
        const int hidx = u.pn * 4 + wc, e = hidx / N_KV, g = hidx % N_KV; const bool nr = (e == 2 || e == 4);
#pragma unroll
        for (int ai = 0; ai < 2; ++ai)
#pragma unroll
            for (int m = 0; m < 4; ++m) {
                const int row = row0 + ai * HALF + m * 16; const float rs = row_rs(rss, row);
                const RowInfo ri = row_info(row);
                f32x4 v[2][2] = {{acc[ai][0][m][0] * rs, acc[ai][0][m][1] * rs}, {acc[ai][1][m][0] * rs, acc[ai][1][m][1] * rs}}; f32x4 rot0[2];
                head_norm_rope(v, k_norm + (e == 2 ? 1 : 2) * HD, rope + (size_t)pos_index(ri.pos) * 16, fq, nr, nr, rot0);
                float* d0; float* d1 = nullptr;
                if (e < 4) d0 = (ri.seq < BATCH) ? out + O_KVP + (((size_t)row * 4 + e) * N_KV + g) * HD : out + O_KVS + (((size_t)(row - MP) * 4 + e) * N_KV + g) * HD;
                else { const int we = e - 4; d0 = winrows + (((size_t)row * 2 + we) * N_KV + g) * HD;
                    if (ri.seq < BATCH) { if (ri.t >= SEQ - WINDOW) d1 = out + O_WP + ((((size_t)ri.seq * WINDOW + (ri.t - (SEQ - WINDOW))) * 2 + we) * N_KV + g) * HD; }
                    else d1 = out + O_WS + ((((size_t)(ri.seq - BATCH) * WINDOW + (WINDOW - DEC_SEQ + ri.t)) * 2 + we) * N_KV + g) * HD; }
                d0 += 8 * fq; *(f32x4*)(d0) = rot0[0]; *(f32x4*)(d0 + 4) = rot0[1]; *(f32x4*)(d0 + 32) = v[1][0]; *(f32x4*)(d0 + 36) = v[1][1];
                if (d1) { d1 += 8 * fq; *(f32x4*)(d1) = rot0[0]; *(f32x4*)(d1 + 4) = rot0[1]; *(f32x4*)(d1 + 32) = v[1][0]; *(f32x4*)(d1 + 36) = v[1][1]; }
                if (ri.seq < BATCH) {
                    if (e >= 2) {
                        unsigned char* img = (e == 2 ? ksel : e == 3 ? vsel : e == 4 ? kwin : vwin) + (((size_t)ri.seq * N_KV + g) * (SEQ / 64) + ri.t / 64) * 8192; const int kv = ri.t % 64;
                        const size_t o0 = (e & 1) ? vimg_off(kv, 8 * fq) : kimg_off(kv, 8 * fq), o1 = (e & 1) ? vimg_off(kv, 32 + 8 * fq) : kimg_off(kv, 32 + 8 * fq);
                        *(u32x4*)(img + o0) = pack8(rot0[0], rot0[1], 1.0f); *(u32x4*)(img + o1) = pack8(v[1][0], v[1][1], 1.0f);
                    } else {
                        const int c = ri.t / L_CMP, l = ri.t % L_CMP; const int r = (ri.seq * NBC_P + c) * N_KV + g;
                        bf16_t* ap = acp + ((size_t)e * RP_CMP + r) * (L_CMP * HD) + l * HD + 8 * fq; const float* pp = pe + ((size_t)e * L_CMP + l) * HD + 8 * fq;
                        *(u32x4*)(ap) = pack8(rot0[0] + *(const f32x4*)(pp), rot0[1] + *(const f32x4*)(pp + 4), 1.0f);
                        *(u32x4*)(ap + 32) = pack8(v[1][0] + *(const f32x4*)(pp + 32), v[1][1] + *(const f32x4*)(pp + 36), 1.0f);
                    }
                }
                asm volatile("" ::: "memory");
            }
    }
};
}

namespace pg8 {
struct EpiGelu {
    static constexpr bool PERM = true, AFTER_DRAIN = false, ACC_INIT = false;
    bf16_t* hid;
    __device__ __forceinline__ void pre(const Unit&, int, int, float (&)[8]) const {}
    __device__ __forceinline__ void operator()(const f32x4 (&acc)[2][2][4][2], const Unit& u, int wr, int wc, int fr, int fq, const float (&rsv)[8]) const {
        const int row0 = u.pm * BM + wr * 64 + fr;
#pragma unroll
        for (int ai = 0; ai < 2; ++ai)
#pragma unroll
            for (int m = 0; m < 4; ++m) {
                const int row = row0 + ai * HALF + m * 16;
#pragma unroll
                for (int bj = 0; bj < 2; ++bj) {
                    float a[8];
#pragma unroll
                    for (int n = 0; n < 2; ++n)
#pragma unroll
                        for (int i = 0; i < 4; ++i) { const float x = acc[ai][bj][m][n][i]; a[n * 4 + i] = x * __builtin_amdgcn_rcpf(1.0f + __expf(-1.5957691216057308f * (x + 0.044715f * x * x * x))); }
                    u32x4 w; w.x = cvt_pk_bf16(a[0], a[1]); w.y = cvt_pk_bf16(a[2], a[3]); w.z = cvt_pk_bf16(a[4], a[5]); w.w = cvt_pk_bf16(a[6], a[7]);
                    *(u32x4*)(hid + (size_t)row * CMP_HID + bj * HALF + wc * 32 + 8 * fq) = w;
                }
            }
    }
};
struct CmpOrder {
    int nunits, per_e, G, c;
    __device__ bool next(int i, Unit& u) const { const int L = i * G + c; if (L >= nunits) return false; u.pm = L; u.pn = L / per_e; return true; }
    __device__ __forceinline__ void a_ready(const Unit&) const {}
    __device__ __forceinline__ void done(const Unit&) const {}
};
}
constexpr int LDS_RING_C = 131072;
namespace att {
typedef short bf16x8 __attribute__((ext_vector_type(8)));
typedef short s16x4 __attribute__((ext_vector_type(4)));
typedef float f32x16 __attribute__((ext_vector_type(16)));
typedef __attribute__((address_space(3))) unsigned char* ldsp;
constexpr int TILE_B = 8192;
constexpr int L_KB = 0, L_VB = 3 * TILE_B, L_IMP = 6 * TILE_B, L_SELM = L_IMP + 64 * 64 * 4, L_END = L_SELM + 64 * 8;
constexpr float NEGB = -1e30f;
constexpr float QSCALE = 0.125f * 1.4426950408889634f;
__device__ __forceinline__ int crow(int r, int hi) { return (r & 3) + 8 * (r >> 2) + 4 * hi; }
__device__ __forceinline__ void glds16(const void* gsrc, unsigned lds_dst) { unsigned keep;
    asm volatile("s_mov_b32 %0, m0\n\ts_mov_b32 m0, %2\n\ts_nop 0\n\tglobal_load_lds_dwordx4 %1, off\n\ts_mov_b32 m0, %0" : "=&s"(keep) : "v"(gsrc), "s"(lds_dst) : "memory"); }
__device__ __forceinline__ unsigned cvtpk(float lo, float hi) { unsigned r; asm volatile("v_cvt_pk_bf16_f32 %0, %1, %2" : "=v"(r) : "v"(lo), "v"(hi)); return r; }
__device__ __forceinline__ float halfmax(float m) { auto rr = __builtin_amdgcn_permlane32_swap(__float_as_uint(m), __float_as_uint(m), false, false); return fmaxf(__uint_as_float(rr[0]), __uint_as_float(rr[1])); }
__device__ __forceinline__ float halfsum(float m) { auto rr = __builtin_amdgcn_permlane32_swap(__float_as_uint(m), __float_as_uint(m), false, false); return __uint_as_float(rr[0]) + __uint_as_float(rr[1]); }
__device__ __forceinline__ s16x4 vtr(ldsp p) { typedef short v4i16_t __attribute__((ext_vector_type(4))); return __builtin_bit_cast(s16x4, __builtin_amdgcn_ds_read_tr16_b64_v4i16((__attribute__((address_space(3))) v4i16_t*)p)); }
#define ATT_BAR_L() asm volatile("s_waitcnt lgkmcnt(0)\n\ts_barrier" ::: "memory")
#define ATT_WAIT_BAR(N) asm volatile("s_waitcnt vmcnt(" #N ") lgkmcnt(0)\n\ts_barrier" ::: "memory")
__device__ __forceinline__ void dma_tile(const unsigned char* img_, unsigned lds_dst, int wid, int lane) { unsigned keep; const unsigned voff = (unsigned)(wid * 1024 + lane * 16);
    const unsigned long long ia_ = (unsigned long long)img_; const unsigned long long img = ((unsigned long long)(unsigned)__builtin_amdgcn_readfirstlane((int)(ia_ >> 32)) << 32) | (unsigned)__builtin_amdgcn_readfirstlane((int)ia_);
    asm volatile("s_mov_b32 %0, m0\n\ts_mov_b32 m0, %3\n\ts_nop 0\n\tglobal_load_lds_dwordx4 %1, %2\n\ts_mov_b32 m0, %0" : "=&s"(keep) : "v"(voff), "s"(img), "s"((unsigned)__builtin_amdgcn_readfirstlane(lds_dst + wid * 1024)) : "memory"); }
__device__ __forceinline__ void qk(f32x16& p0, f32x16& p1, ldsp kbuf, const bf16x8 (&qf)[4], float cinit, int r32, int hi) {
    f32x16 c;
#pragma unroll
    for (int r = 0; r < 16; ++r) c[r] = cinit;
#pragma unroll
    for (int s = 0; s < 4; ++s) {
        const bf16x8 k0 = *(const __attribute__((address_space(3))) bf16x8*)(kbuf + (2 * s + hi) * 1024 + r32 * 16);
        const bf16x8 k1 = *(const __attribute__((address_space(3))) bf16x8*)(kbuf + (2 * s + hi) * 1024 + r32 * 16 + 512);
        p0 = __builtin_amdgcn_mfma_f32_32x32x16_bf16(k0, qf[s], s == 0 ? c : p0, 0, 0, 0);
        p1 = __builtin_amdgcn_mfma_f32_32x32x16_bf16(k1, qf[s], s == 0 ? c : p1, 0, 0, 0);
    }
}
__device__ __forceinline__ void pv(f32x16 (&o)[2], ldsp vbuf, const f32x16& p0, const f32x16& p1, int lane, int hi) {
    unsigned pk[4][4];
#pragma unroll
    for (int k = 0; k < 4; ++k) { pk[0][k] = cvtpk(p0[2 * k], p0[2 * k + 1]); pk[1][k] = cvtpk(p0[8 + 2 * k], p0[9 + 2 * k]); pk[2][k] = cvtpk(p1[2 * k], p1[2 * k + 1]); pk[3][k] = cvtpk(p1[8 + 2 * k], p1[9 + 2 * k]); }
    const int vp0 = ((lane >> 4) & 1) * 32 + (lane & 3) * 8 + (4 * hi + ((lane & 15) >> 2)) * 64;
#pragma unroll
    for (int d0 = 0; d0 < 2; ++d0)
#pragma unroll
        for (int s = 0; s < 4; ++s) {
            const s16x4 lo = vtr(vbuf + d0 * 4096 + s * 1024 + vp0), hh = vtr(vbuf + d0 * 4096 + s * 1024 + 512 + vp0);
            const bf16x8 vf = (bf16x8){lo[0], lo[1], lo[2], lo[3], hh[0], hh[1], hh[2], hh[3]};
            typedef unsigned u32x4 __attribute__((ext_vector_type(4)));
            const u32x4 pw = (u32x4){pk[s][0], pk[s][1], pk[s][2], pk[s][3]};
            o[d0] = __builtin_amdgcn_mfma_f32_32x32x16_bf16(vf, __builtin_bit_cast(bf16x8, pw), o[d0], 0, 0, 0);
        }
}
struct Run { float l; f32x16 o[2]; };
template <bool EMASK> __device__ __forceinline__ void tile_step(Run& R, ldsp kbuf, ldsp vbuf, const bf16x8 (&qf)[4], bool row_on, int lo_b_, int hi_b_, int lane, int r32, int hi) {
    int lo_b = lo_b_ - 4 * hi, hi_b = hi_b_ - 4 * hi;
    if (EMASK) asm volatile("" : "+v"(lo_b), "+v"(hi_b));
    f32x16 p0, p1; qk(p0, p1, kbuf, qf, row_on ? 0.f : NEGB, r32, hi);
    float ls = 0.f;
#pragma unroll
    for (int r = 0; r < 16; ++r) {
        float e0 = __builtin_amdgcn_exp2f(p0[r]), e1 = __builtin_amdgcn_exp2f(p1[r]);
        if (EMASK) { const int kc_ = (r & 3) + 8 * (r >> 2); if (kc_ < lo_b || kc_ > hi_b) e0 = 0.f; if (kc_ + 32 < lo_b || kc_ + 32 > hi_b) e1 = 0.f; }
        p0[r] = e0; p1[r] = e1; ls += e0 + e1;
    }
    R.l += ls;
    pv(R.o, vbuf, p0, p1, lane, hi);
}
struct Tensors {
    const bf16_t* qn; const bf16_t* qr;
    const unsigned char* ksel; const unsigned char* vsel; const unsigned char* kwin; const unsigned char* vwin;
    const unsigned char* kc; const unsigned char* vc;
    const float* gates; bf16_t* ob;
};
template <bool SEL> __device__ __forceinline__ void branch(Run& R, const unsigned char* kimg, const unsigned char* vimg, int t0, int t1, int jdiag, unsigned long long selm, int iq,
                                                           const bf16x8 (&qf)[4], unsigned lds0, ldsp lds, int wid, int lane, int r32, int hi) {
    R.l = 0.f;
#pragma unroll
    for (int r = 0; r < 16; ++r) { R.o[0][r] = 0.f; R.o[1][r] = 0.f; }
    dma_tile(kimg + (size_t)t0 * TILE_B, lds0 + L_KB, wid, lane); dma_tile(vimg + (size_t)t0 * TILE_B, lds0 + L_VB, wid, lane);
    if (t0 < t1) { dma_tile(kimg + (size_t)(t0 + 1) * TILE_B, lds0 + L_KB + TILE_B, wid, lane); dma_tile(vimg + (size_t)(t0 + 1) * TILE_B, lds0 + L_VB + TILE_B, wid, lane); }
    int b = 0;
    for (int t = t0; t <= t1; ++t) {
        if (t < t1) ATT_WAIT_BAR(2); else ATT_WAIT_BAR(0);
        if (t + 2 <= t1) { const int b2 = (b >= 1) ? b - 1 : 2; dma_tile(kimg + (size_t)(t + 2) * TILE_B, lds0 + L_KB + b2 * TILE_B, wid, lane); dma_tile(vimg + (size_t)(t + 2) * TILE_B, lds0 + L_VB + b2 * TILE_B, wid, lane); }
        const bool row_on = !SEL || ((selm >> t) & 1ull);
        const bool lowm = !SEL && (t == jdiag - 8);
        if (t == jdiag || lowm) tile_step<true>(R, lds + L_KB + b * TILE_B, lds + L_VB + b * TILE_B, qf, row_on, lowm ? iq : 0, (t == jdiag) ? iq : 63, lane, r32, hi);
        else tile_step<false>(R, lds + L_KB + b * TILE_B, lds + L_VB + b * TILE_B, qf, row_on, 0, 63, lane, r32, hi);
        b = (b == 2) ? 0 : b + 1;
    }
    ATT_BAR_L();
}
__device__ __forceinline__ void load_q(bf16x8 (&qf)[4], const bf16_t* qrow, int hi) {
#pragma unroll
    for (int s = 0; s < 4; ++s) qf[s] = *(const bf16x8*)(qrow + 16 * s + 8 * hi);
}
__device__ __forceinline__ void unit(const Tensors& T, int n, int j, int g, ldsp lds, unsigned lds0, int wid, int lane_) {
    const int lane = (int)lane_id_v();
    const int r32 = lane & 31, hi = lane >> 5, ql = r32 >> 2, hq = r32 & 3, iq = 8 * wid + ql;
    const int row = n * SEQ + 64 * j + iq, head = g * HPG + hq, pos = 64 * j + iq;
    const size_t img_ng = ((size_t)n * N_KV + g);
    f32x16 oacc[2];
#pragma unroll
    for (int r = 0; r < 16; ++r) { oacc[0][r] = 0.f; oacc[1][r] = 0.f; }
    const float* gt = T.gates + (size_t)row * 3 * N_HEADS + head * 3;
    const float g_c = gt[0], g_s = gt[1], g_w = gt[2];
    bf16x8 qf[4];
    unsigned long long selm;
    {
        load_q(qf, T.qn + (size_t)row * HDM + head * HD, hi);
        const int ntc = (2 * j + 2 + 63) / 64;
        const unsigned char* kci = T.kc + img_ng * (NBC_P / 64) * TILE_B; const unsigned char* vci = T.vc + img_ng * (NBC_P / 64) * TILE_B;
        dma_tile(kci, lds0 + L_KB, wid, lane); dma_tile(vci, lds0 + L_VB, wid, lane);
        if (ntc > 1) { dma_tile(kci + TILE_B, lds0 + L_KB + TILE_B, wid, lane); dma_tile(vci + TILE_B, lds0 + L_VB + TILE_B, wid, lane); }
        ATT_WAIT_BAR(0);
        int cmax = ((pos + 1) >> 5) - 1 - 4 * hi;
        asm volatile("" : "+v"(cmax));
        f32x16 s0, s1, s2, s3;
        qk(s0, s1, lds + L_KB, qf, 0.f, r32, hi);
        if (ntc > 1) qk(s2, s3, lds + L_KB + TILE_B, qf, 0.f, r32, hi);
        else {
#pragma unroll
            for (int r = 0; r < 16; ++r) { s2[r] = NEGB; s3[r] = NEGB; }
        }
        float ls = 0.f;
#pragma unroll
        for (int r = 0; r < 16; ++r) { const int kv = (r & 3) + 8 * (r >> 2);
            s0[r] = (kv > cmax) ? 0.f : __builtin_amdgcn_exp2f(s0[r]); s1[r] = (kv + 32 > cmax) ? 0.f : __builtin_amdgcn_exp2f(s1[r]);
            s2[r] = (kv + 64 > cmax) ? 0.f : __builtin_amdgcn_exp2f(s2[r]); s3[r] = (kv + 96 > cmax) ? 0.f : __builtin_amdgcn_exp2f(s3[r]);
            ls += (s0[r] + s1[r]) + (s2[r] + s3[r]); }
        ls = halfsum(ls);
        const float inv = 1.0f / fmaxf(ls, 1e-30f);
#pragma unroll
        for (int r = 0; r < 16; ++r) { s0[r] *= inv; s1[r] *= inv; s2[r] *= inv; s3[r] *= inv; }
        __attribute__((address_space(3))) float* imp = (__attribute__((address_space(3))) float*)(lds + L_IMP) + iq * 64;
#pragma unroll
        for (int r = 0; r < 16; r += 2) { const int bl = crow(r, hi) >> 1;
            float v0 = s0[r] + s0[r + 1], v1 = s1[r] + s1[r + 1], v2 = s2[r] + s2[r + 1], v3 = s3[r] + s3[r + 1];
            v0 += __shfl_xor(v0, 1); v0 += __shfl_xor(v0, 2); v1 += __shfl_xor(v1, 1); v1 += __shfl_xor(v1, 2);
            v2 += __shfl_xor(v2, 1); v2 += __shfl_xor(v2, 2); v3 += __shfl_xor(v3, 1); v3 += __shfl_xor(v3, 2);
            if (hq == 0) { imp[bl] = v0; imp[16 + bl] = v1; imp[32 + bl] = v2; imp[48 + bl] = v3; } }
        Run Rc;
#pragma unroll
        for (int r = 0; r < 16; ++r) { Rc.o[0][r] = 0.f; Rc.o[1][r] = 0.f; }
        pv(Rc.o, lds + L_VB, s0, s1, lane, hi);
        if (ntc > 1) pv(Rc.o, lds + L_VB + TILE_B, s2, s3, lane, hi);
#pragma unroll
        for (int r = 0; r < 16; ++r) { oacc[0][r] += g_c * Rc.o[0][r]; oacc[1][r] += g_c * Rc.o[1][r]; }
        asm volatile("s_waitcnt lgkmcnt(0)" ::: "memory");
        __attribute__((address_space(3))) unsigned long long* selw = (__attribute__((address_space(3))) unsigned long long*)(lds + L_SELM);
        for (int qq = 0; qq < 8; ++qq) {
            const float v = ((__attribute__((address_space(3))) float*)(lds + L_IMP))[(8 * wid + qq) * 64 + lane];
            const bool valid = lane <= j, forced = (lane == 0) || (lane == j) || (lane == j - 1);
            const unsigned key = valid ? (forced ? 0x7f000000u : __float_as_uint(v) + 1u) : 0u;
            unsigned long long m;
            if (j + 1 <= N_SEL) m = __ballot(valid);
            else {
                unsigned Tt = 0u; bool exact = false; unsigned long long mex = 0ull;
                for (int bit = 30; bit >= 0; --bit) { const unsigned cand = Tt | (1u << bit); const unsigned long long ge = __ballot(key >= cand); const int cnt = __popcll(ge);
                    if (cnt == N_SEL) { exact = true; mex = ge; break; }
                    if (cnt > N_SEL) Tt = cand; }
                if (exact) m = mex;
                else {
                    const unsigned long long gtm = __ballot(key > Tt), eqm = __ballot(key == Tt);
                    const int need = N_SEL - __popcll(gtm);
                    const bool pick = (key == Tt) && (__popcll(eqm & ((1ull << lane) - 1ull)) < need);
                    m = gtm | __ballot(pick);
                }
            }
            if (lane == 0) selw[8 * wid + qq] = m;
        }
        asm volatile("s_waitcnt lgkmcnt(0)" ::: "memory");
        selm = selw[iq];
        ATT_WAIT_BAR(0);
    }
    load_q(qf, T.qr + (size_t)row * HDM + head * HD, hi);
    {
        Run R; branch<true>(R, T.ksel + img_ng * (SEQ / 64) * TILE_B, T.vsel + img_ng * (SEQ / 64) * TILE_B, 0, j, j, selm, iq, qf, lds0, lds, wid, lane, r32, hi);
        const float sc = g_s / fmaxf(halfsum(R.l), 1e-30f);
#pragma unroll
        for (int r = 0; r < 16; ++r) { oacc[0][r] += sc * R.o[0][r]; oacc[1][r] += sc * R.o[1][r]; }
    }
    {
        Run R; branch<false>(R, T.kwin + img_ng * (SEQ / 64) * TILE_B, T.vwin + img_ng * (SEQ / 64) * TILE_B, j > 8 ? j - 8 : 0, j, j, 0ull, iq, qf, lds0, lds, wid, lane, r32, hi);
        const float sc = g_w / fmaxf(halfsum(R.l), 1e-30f);
#pragma unroll
        for (int r = 0; r < 16; ++r) { oacc[0][r] += sc * R.o[0][r]; oacc[1][r] += sc * R.o[1][r]; }
    }
    bf16_t* orow = T.ob + (size_t)row * HDM + head * HD;
#pragma unroll
    for (int d0 = 0; d0 < 2; ++d0)
#pragma unroll
        for (int rr = 0; rr < 4; ++rr) { typedef unsigned u32x2 __attribute__((ext_vector_type(2)));
            u32x2 w; w.x = cvtpk(oacc[d0][4 * rr], oacc[d0][4 * rr + 1]); w.y = cvtpk(oacc[d0][4 * rr + 2], oacc[d0][4 * rr + 3]);
            *(u32x2*)(orow + 32 * d0 + 8 * rr + 4 * hi) = w; }
}
}
namespace att {
constexpr int S_STAGE = 16384;
constexpr int S_XM = LDS_RING_C + 1024, S_XL = S_XM + 1024, S_IMP = S_XL + 1024, S_SELM = S_IMP + 8 * 128 * 4, S_END = S_SELM + 8 * 2 * 8;
struct STensors {
    const bf16_t* qn; const bf16_t* qr; const float* kc; const float* vc; const float* cache_kv; const int* page_table; const float* cache_win; const float* out; const float* winrows;
    const float* gates; bf16_t* ob;
};
typedef float f32x4_t __attribute__((ext_vector_type(4)));
__device__ __forceinline__ void stage_kv(ldsp kimg, ldsp vimg, const float* ksrc, const float* vsrc, int stride, int nrows, int lane) {
    typedef unsigned u32x4 __attribute__((ext_vector_type(4)));
    const int c = lane & 7;
#pragma unroll 1
    for (int ib = 0; ib < 8; ib += 4)
#pragma unroll
    for (int it = ib; it < ib + 4; ++it) {
        const int row = 8 * it + (lane >> 3);
        f32x4_t k0 = {0.f, 0.f, 0.f, 0.f}, k1 = k0, v0 = k0, v1 = k0;
        if (row < nrows) { const float* kp = ksrc + (size_t)row * stride + 8 * c; const float* vp = vsrc + (size_t)row * stride + 8 * c;
            k0 = *(const f32x4_t*)kp; k1 = *(const f32x4_t*)(kp + 4); v0 = *(const f32x4_t*)vp; v1 = *(const f32x4_t*)(vp + 4); }
        u32x4 kw, vw; kw.x = cvtpk(k0[0], k0[1]); kw.y = cvtpk(k0[2], k0[3]); kw.z = cvtpk(k1[0], k1[1]); kw.w = cvtpk(k1[2], k1[3]);
        vw.x = cvtpk(v0[0], v0[1]); vw.y = cvtpk(v0[2], v0[3]); vw.z = cvtpk(v1[0], v1[1]); vw.w = cvtpk(v1[2], v1[3]);
        *(__attribute__((address_space(3))) u32x4*)(kimg + c * 1024 + row * 16) = kw;
        *(__attribute__((address_space(3))) u32x4*)(vimg + (c >> 2) * 4096 + (row >> 3) * 512 + (row & 7) * 64 + (c & 3) * 16) = vw;
    }
    asm volatile("s_waitcnt lgkmcnt(0)" ::: "memory");
}
#define ATT_BAR_ALL() asm volatile("s_waitcnt vmcnt(0) lgkmcnt(0)\n\ts_barrier" ::: "memory")
__device__ __forceinline__ float merge_sum(ldsp lds, float l_own_half, int wid, int r32, int hi) {
    __attribute__((address_space(3))) float* xl = (__attribute__((address_space(3))) float*)(lds + S_XL);
    const float l_own = halfsum(l_own_half);
    if (hi == 0) xl[wid * 32 + r32] = l_own;
    ATT_BAR_ALL();
    float L = 0.f;
#pragma unroll
    for (int w = 0; w < 8; ++w) L += xl[w * 32 + r32];
    ATT_BAR_ALL();
    return 1.0f / fmaxf(L, 1e-30f);
}
__device__ __forceinline__ void sample_unit(const STensors& T, int b, int g, ldsp lds, int wid, int lane_) {
    const int lane = (int)lane_id_v();
    const int r32 = lane & 31, hi = lane >> 5, ql = r32 >> 2, hq = r32 & 3;
    const int row = MP + b * DEC_SEQ + ql, head = g * HPG + hq, seq = BATCH + b;
    ldsp kimg = lds + wid * S_STAGE, vimg = kimg + TILE_B;
    f32x16 oacc[2];
#pragma unroll
    for (int r = 0; r < 16; ++r) { oacc[0][r] = 0.f; oacc[1][r] = 0.f; }
    const float* gt = T.gates + (size_t)row * 3 * N_HEADS + head * 3;
    const float g_c = gt[0], g_s = gt[1], g_w = gt[2];
    bf16x8 qf[4];
    __attribute__((address_space(3))) float* xm = (__attribute__((address_space(3))) float*)(lds + S_XM); __attribute__((address_space(3))) float* xl = (__attribute__((address_space(3))) float*)(lds + S_XL);
    __attribute__((address_space(3))) float* imp = (__attribute__((address_space(3))) float*)(lds + S_IMP);
    __attribute__((address_space(3))) unsigned long long* selw = (__attribute__((address_space(3))) unsigned long long*)(lds + S_SELM);
    {
        load_q(qf, T.qn + (size_t)row * HDM + head * HD, hi);
        constexpr int NTC = NBC_PAST / 64;
        f32x16 p0, p1; const bool mine = wid < NTC;
        float ls = 0.f;
        if (mine) {
            const float* kcp = T.kc + (((size_t)seq * NBC_MAX + 64 * wid) * N_KV + g) * HD; const float* vcp = T.vc + (((size_t)seq * NBC_MAX + 64 * wid) * N_KV + g) * HD;
            stage_kv(kimg, vimg, kcp, vcp, N_KV * HD, 64, lane);
            qk(p0, p1, kimg, qf, 0.f, r32, hi);
#pragma unroll
            for (int r = 0; r < 16; ++r) { p0[r] = __builtin_amdgcn_exp2f(p0[r]); p1[r] = __builtin_amdgcn_exp2f(p1[r]); ls += p0[r] + p1[r]; }
            ls = halfsum(ls);
        }
        if (hi == 0) xl[wid * 32 + r32] = ls;
        ATT_BAR_ALL();
        float L = 0.f;
#pragma unroll
        for (int w = 0; w < 8; ++w) L += xl[w * 32 + r32];
        const float inv = 1.0f / fmaxf(L, 1e-30f);
        if (mine) {
#pragma unroll
            for (int r = 0; r < 16; ++r) { p0[r] *= inv; p1[r] *= inv; }
#pragma unroll
            for (int r = 0; r < 16; r += 2) { const int bl = crow(r, hi) >> 1;
                float v0 = p0[r] + p0[r + 1], v1 = p1[r] + p1[r + 1];
                v0 += __shfl_xor(v0, 1); v0 += __shfl_xor(v0, 2); v1 += __shfl_xor(v1, 1); v1 += __shfl_xor(v1, 2);
                if (hq == 0) { imp[ql * 128 + 32 * wid + bl] = v0; imp[ql * 128 + 32 * wid + 16 + bl] = v1; } }
            Run Rc;
#pragma unroll
            for (int r = 0; r < 16; ++r) { Rc.o[0][r] = 0.f; Rc.o[1][r] = 0.f; }
            pv(Rc.o, vimg, p0, p1, lane, hi);
#pragma unroll
            for (int r = 0; r < 16; ++r) { oacc[0][r] += g_c * Rc.o[0][r]; oacc[1][r] += g_c * Rc.o[1][r]; }
        }
        ATT_BAR_ALL();
    }
    {
        constexpr int NCAND = NBS_S - 1;
        const float v0 = imp[wid * 128 + lane], v1 = imp[wid * 128 + 64 + lane];
        const unsigned key0 = (lane == 0) ? 0x7f000000u : __float_as_uint(v0) + 1u;
        const unsigned key1 = (lane + 64 == NCAND - 1) ? 0x7f000000u : __float_as_uint(v1) + 1u;
        unsigned Tt = 0u;
        for (int bit = 30; bit >= 0; --bit) { const unsigned cand = Tt | (1u << bit); if (__popcll(__ballot(key0 >= cand)) + __popcll(__ballot(key1 >= cand)) >= N_SEL - 1) Tt = cand; }
        const unsigned long long gt0 = __ballot(key0 > Tt), gt1 = __ballot(key1 > Tt), eq0 = __ballot(key0 == Tt), eq1 = __ballot(key1 == Tt);
        const int need = (N_SEL - 1) - __popcll(gt0) - __popcll(gt1);
        const unsigned long long below = (1ull << lane) - 1ull;
        const bool pick0 = (key0 == Tt) && (__popcll(eq0 & below) < need);
        const bool pick1 = (key1 == Tt) && (__popcll(eq0) + __popcll(eq1 & below) < need);
        const unsigned long long m0 = gt0 | __ballot(pick0), m1 = gt1 | __ballot(pick1);
        if (lane == 0) { selw[wid * 2] = m0; selw[wid * 2 + 1] = m1; }
        ATT_BAR_ALL();
    }
    load_q(qf, T.qr + (size_t)row * HDM + head * HD, hi);
    {
        unsigned long long U0 = 0ull, U1 = 0ull;
#pragma unroll
        for (int q = 0; q < 8; ++q) { U0 |= selw[q * 2]; U1 |= selw[q * 2 + 1]; }
        U0 = __builtin_amdgcn_readfirstlane((unsigned)U0) | ((unsigned long long)__builtin_amdgcn_readfirstlane((unsigned)(U0 >> 32)) << 32);
        U1 = __builtin_amdgcn_readfirstlane((unsigned)U1) | ((unsigned long long)__builtin_amdgcn_readfirstlane((unsigned)(U1 >> 32)) << 32);
        const unsigned long long my0 = selw[ql * 2], my1 = selw[ql * 2 + 1];
        Run R; R.l = 0.f;
#pragma unroll
        for (int r = 0; r < 16; ++r) { R.o[0][r] = 0.f; R.o[1][r] = 0.f; }
        int idx = 0;
        for (int half = 0; half < 2; ++half) {
            unsigned long long U = half ? U1 : U0;
            while (U) {
                const int bit = __builtin_ctzll(U); U &= U - 1ull;
                if ((idx++ & 7) != wid) continue;
                const int blk = 64 * half + bit;
                const int page = T.page_table[b * N_PAGES + (blk * L_SEL) / PAGE_SIZE];
                const float* base = T.cache_kv + (((size_t)page * PAGE_SIZE + (blk * L_SEL) % PAGE_SIZE) * 4) * N_KV * HD + g * HD;
                stage_kv(kimg, vimg, base + 2 * N_KV * HD, base + 3 * N_KV * HD, 4 * N_KV * HD, 64, lane);
                const bool selected = ((half ? my1 : my0) >> bit) & 1ull;
                tile_step<false>(R, kimg, vimg, qf, selected, 0, 63, lane, r32, hi);
            }
        }
        if ((idx & 7) == wid) {
            const float* base = T.out + O_KVS + (((size_t)b * DEC_SEQ) * 4) * N_KV * HD + g * HD;
            stage_kv(kimg, vimg, base + 2 * N_KV * HD, base + 3 * N_KV * HD, 4 * N_KV * HD, DEC_SEQ, lane);
            tile_step<true>(R, kimg, vimg, qf, true, 0, ql, lane, r32, hi);
        }
        const float wgt = merge_sum(lds, R.l, wid, r32, hi) * g_s;
#pragma unroll
        for (int r = 0; r < 16; ++r) { oacc[0][r] += wgt * R.o[0][r]; oacc[1][r] += wgt * R.o[1][r]; }
    }
    {
        Run R; R.l = 0.f;
#pragma unroll
        for (int r = 0; r < 16; ++r) { R.o[0][r] = 0.f; R.o[1][r] = 0.f; }
        for (int t = wid; t < WINDOW / 64; t += 8) {
            const float* base = T.cache_win + (((size_t)b * WINDOW + 64 * t) * 2) * N_KV * HD + g * HD;
            stage_kv(kimg, vimg, base, base + N_KV * HD, 2 * N_KV * HD, 64, lane);
            if (t == 0) tile_step<true>(R, kimg, vimg, qf, true, ql, 63, lane, r32, hi); else tile_step<false>(R, kimg, vimg, qf, true, 0, 63, lane, r32, hi);
        }
        if (wid == 0) {
            const float* base = T.winrows + (((size_t)(MP + b * DEC_SEQ)) * 2) * N_KV * HD + g * HD;
            stage_kv(kimg, vimg, base, base + N_KV * HD, 2 * N_KV * HD, DEC_SEQ, lane);
            tile_step<true>(R, kimg, vimg, qf, true, 0, ql, lane, r32, hi);
        }
        const float wgt = merge_sum(lds, R.l, wid, r32, hi) * g_w;
#pragma unroll
        for (int r = 0; r < 16; ++r) { oacc[0][r] += wgt * R.o[0][r]; oacc[1][r] += wgt * R.o[1][r]; }
    }
    {
        const int lane2 = (int)lane_id_v(), r32 = lane2 & 31, hi = lane2 >> 5;
        __attribute__((address_space(3))) float* mine = (__attribute__((address_space(3))) float*)(lds + wid * S_STAGE);
#pragma unroll
        for (int d0 = 0; d0 < 2; ++d0)
#pragma unroll
            for (int rr = 0; rr < 4; ++rr) *(__attribute__((address_space(3))) f32x4_t*)(mine + r32 * 64 + 32 * d0 + 8 * rr + 4 * hi) = (f32x4_t){oacc[d0][4 * rr], oacc[d0][4 * rr + 1], oacc[d0][4 * rr + 2], oacc[d0][4 * rr + 3]};
        ATT_BAR_ALL();
        const int tid = wid * 64 + (int)lane_id_v(), orow = tid >> 4, oc4 = (tid & 15) * 4;
        f32x4_t s = {0.f, 0.f, 0.f, 0.f};
#pragma unroll
        for (int w = 0; w < 8; ++w) s += *(const __attribute__((address_space(3))) f32x4_t*)((__attribute__((address_space(3))) float*)(lds + w * S_STAGE) + orow * 64 + oc4);
        typedef unsigned u32x2 __attribute__((ext_vector_type(2)));
        u32x2 wv; wv.x = cvtpk(s[0], s[1]); wv.y = cvtpk(s[2], s[3]);
        const int oq = orow >> 2, oh = orow & 3;
        *(u32x2*)(T.ob + (size_t)(MP + b * DEC_SEQ + oq) * HDM + (g * HPG + oh) * HD + oc4) = wv;
        ATT_BAR_ALL();
    }
}
constexpr int Q_SAMPLE = DEC_BATCH * N_KV, Q_PROMPT = BATCH * N_KV * (SEQ / 64), Q_TOTAL = Q_SAMPLE + Q_PROMPT;
constexpr int S_QHEAD = S_END;
__device__ __forceinline__ int claim_unit(unsigned* head, ldsp lds, int wid, int lane) {
    __attribute__((address_space(3))) int* qslot = (__attribute__((address_space(3))) int*)(lds + S_QHEAD);
    if (wid == 0 && lane == 0) *qslot = (int)__hip_atomic_fetch_add(head, 1u, __ATOMIC_RELAXED, __HIP_MEMORY_SCOPE_AGENT);
    ATT_BAR_ALL();
    const int u = __builtin_amdgcn_readfirstlane(*qslot);
    ATT_BAR_ALL();
    return u;
}
__device__ __forceinline__ void att_queue_sample(const STensors& TS, unsigned* head, ldsp lds, int wid, int lane) {
    for (;;) { const int u = claim_unit(head, lds, wid, lane); if (u >= Q_SAMPLE) break; sample_unit(TS, u / N_KV, u % N_KV, lds, wid, lane); }
}
__device__ __forceinline__ void att_queue_prompt(const Tensors& T, unsigned* head, ldsp lds, int wid, int lane) {
    const unsigned lds0 = (unsigned)(uintptr_t)lds;
    for (;;) { const int p = claim_unit(head, lds, wid, lane); if (p >= Q_PROMPT) break;
        const int j = (SEQ / 64 - 1) - p / (BATCH * N_KV), ng = p % (BATCH * N_KV); unit(T, ng / N_KV, j, ng % N_KV, lds, lds0, wid, lane); }
}
}


namespace att {
__device__ __forceinline__ void cmp_out_wave(int task, const bf16_t* hid, int R, int nbc, int seq0, const bf16_t* w2t, const float* k_norm0, float* kc, float* vc, unsigned char* kci, unsigned char* vci, int lane) {
    const int r32 = lane & 31, hi = lane >> 5;
    const int r0 = task * 32, e = r0 >= R ? 1 : 0, r = r0 - e * R + r32;
    const bf16_t* hrow = hid + ((size_t)e * R + r) * CMP_HID; const bf16_t* wrow = w2t + ((size_t)e * HD + r32) * CMP_HID;
    f32x16 o0, o1;
#pragma unroll
    for (int k = 0; k < 16; ++k) { o0[k] = 0.f; o1[k] = 0.f; }
#pragma unroll 4
    for (int s_ = 0; s_ < CMP_HID / 16; ++s_) {
        const bf16x8 hb_ = *(const bf16x8*)(hrow + 16 * s_ + 8 * hi);
        const bf16x8 w0 = *(const bf16x8*)(wrow + 16 * s_ + 8 * hi), w1 = *(const bf16x8*)(wrow + (size_t)32 * CMP_HID + 16 * s_ + 8 * hi);
        o0 = __builtin_amdgcn_mfma_f32_32x32x16_bf16(w0, hb_, o0, 0, 0, 0); o1 = __builtin_amdgcn_mfma_f32_32x32x16_bf16(w1, hb_, o1, 0, 0, 0);
    }
    if (e == 0) {
        float ss = 0.f;
#pragma unroll
        for (int k = 0; k < 16; ++k) ss += o0[k] * o0[k] + o1[k] * o1[k];
        ss = halfsum(ss);
        const float rn = rsqrtf(ss * (1.0f / HD) + EPS);
#pragma unroll
        for (int k = 0; k < 16; ++k) { o0[k] *= rn * k_norm0[crow(k, hi)]; o1[k] *= rn * k_norm0[32 + crow(k, hi)]; }
    }
    const int g = r % N_KV, c = (r / N_KV) % nbc, sq = r / (N_KV * nbc);
    float* dst = (e == 0 ? kc : vc) + (((size_t)(seq0 + sq) * NBC_MAX + c) * N_KV + g) * HD;
#pragma unroll
    for (int rr = 0; rr < 4; ++rr) { *(f32x4_t*)(dst + 8 * rr + 4 * hi) = (f32x4_t){o0[4 * rr], o0[4 * rr + 1], o0[4 * rr + 2], o0[4 * rr + 3]};
                                      *(f32x4_t*)(dst + 32 + 8 * rr + 4 * hi) = (f32x4_t){o1[4 * rr], o1[4 * rr + 1], o1[4 * rr + 2], o1[4 * rr + 3]}; }
    if (kci) {
        unsigned char* img = (e == 0 ? kci : vci) + (((size_t)sq * N_KV + g) * (NBC_P / 64) + c / 64) * 8192; const int kv = c % 64;
        typedef unsigned u32x2 __attribute__((ext_vector_type(2)));
#pragma unroll
        for (int rr = 0; rr < 4; ++rr) {
            u32x2 a; a.x = cvtpk(o0[4 * rr], o0[4 * rr + 1]); a.y = cvtpk(o0[4 * rr + 2], o0[4 * rr + 3]);
            u32x2 bq; bq.x = cvtpk(o1[4 * rr], o1[4 * rr + 1]); bq.y = cvtpk(o1[4 * rr + 2], o1[4 * rr + 3]);
            const int d0 = 8 * rr, d1 = 32 + 8 * rr;
            *(u32x2*)(img + (e == 0 ? kimg_off(kv, d0) : vimg_off(kv, d0)) + 8 * hi) = a;
            *(u32x2*)(img + (e == 0 ? kimg_off(kv, d1) : vimg_off(kv, d1)) + 8 * hi) = bq;
        }
    }
}
}
__device__ __forceinline__ void conv_thin_vec_item(size_t i_, const bf16_t* ub, const bf16_t* bb, const float* state, const float* wc, bf16_t* zb) {
    typedef unsigned u4 __attribute__((ext_vector_type(4)));
    const int m = (int)(i_ / (D_MODEL / 8)), ch = (int)(i_ % (D_MODEL / 8)) * 8;
    const RowInfo ri = row_info(m);
    const size_t o = (size_t)m * D_MODEL + ch;
    float u0[8], u1[8], u2[8], bv[8];
#define UNPK(w, f) do { f[0] = bf2f((bf16_t)((w).x & 0xffff)); f[1] = bf2f((bf16_t)((w).x >> 16)); f[2] = bf2f((bf16_t)((w).y & 0xffff)); f[3] = bf2f((bf16_t)((w).y >> 16)); \
                        f[4] = bf2f((bf16_t)((w).z & 0xffff)); f[5] = bf2f((bf16_t)((w).z >> 16)); f[6] = bf2f((bf16_t)((w).w & 0xffff)); f[7] = bf2f((bf16_t)((w).w >> 16)); } while (0)
    { const u4 w = *(const u4*)(ub + o); UNPK(w, u0); } { const u4 w = *(const u4*)(bb + o); UNPK(w, bv); }
    const float* st = (ri.seq >= BATCH) ? state + (size_t)(ri.seq - BATCH) * 2 * D_MODEL + ch : nullptr;
    if (ri.t >= 1) { const u4 w = *(const u4*)(ub + o - D_MODEL); UNPK(w, u1); } else { for (int k = 0; k < 8; ++k) u1[k] = st ? st[D_MODEL + k] : 0.f; }
    if (ri.t >= 2) { const u4 w = *(const u4*)(ub + o - 2 * D_MODEL); UNPK(w, u2); } else { for (int k = 0; k < 8; ++k) u2[k] = st ? (ri.t == 1 ? st[D_MODEL + k] : st[k]) : 0.f; }
#undef UNPK
    float z[8];
    for (int k = 0; k < 8; ++k) z[k] = bv[k] * (wc[ch + k] * u2[k] + wc[D_MODEL + ch + k] * u1[k] + wc[2 * D_MODEL + ch + k] * u0[k]);
    u4 w; w.x = (unsigned)f2bf(z[0]) | ((unsigned)f2bf(z[1]) << 16); w.y = (unsigned)f2bf(z[2]) | ((unsigned)f2bf(z[3]) << 16);
    w.z = (unsigned)f2bf(z[4]) | ((unsigned)f2bf(z[5]) << 16); w.w = (unsigned)f2bf(z[6]) | ((unsigned)f2bf(z[7]) << 16);
    *(u4*)(zb + o) = w;
}

namespace att {
__device__ __forceinline__ void skinny_task(int task, const bf16_t* A, const bf16_t* Bt, int N, int K, int KS, float* part, int lane) {
    const int r32 = lane & 31, hi = lane >> 5, ncb = N / 32, nrb = MS / 32;
    const int ks = task / (nrb * ncb), rem = task % (nrb * ncb), rb = rem / ncb, cb = rem % ncb, klen = K / KS, k0 = ks * klen;
    const bf16_t* ap = A + (size_t)(rb * 32 + r32) * K + k0 + 8 * hi; const bf16_t* bp = Bt + (size_t)(cb * 32 + r32) * K + k0 + 8 * hi;
    f32x16 acc;
#pragma unroll
    for (int k = 0; k < 16; ++k) acc[k] = 0.f;
#pragma unroll 8
    for (int s_ = 0; s_ < klen / 16; ++s_) acc = __builtin_amdgcn_mfma_f32_32x32x16_bf16(*(const bf16x8*)(bp + 16 * s_), *(const bf16x8*)(ap + 16 * s_), acc, 0, 0, 0);
    float* dst = part + ((size_t)ks * MS + rb * 32 + r32) * N + cb * 32 + 4 * hi;
#pragma unroll
    for (int rr = 0; rr < 4; ++rr) *(f32x4_t*)(dst + 8 * rr) = (f32x4_t){acc[4 * rr], acc[4 * rr + 1], acc[4 * rr + 2], acc[4 * rr + 3]};
}
__device__ __forceinline__ void resid_reduce_row(int rs_, const float* part, int KS, float coef, bf16_t* hb, float* rss_next, float* yout, int lane) {
    typedef unsigned u2 __attribute__((ext_vector_type(2)));
    const int m = MP + rs_; float ssq = 0.f;
#pragma unroll
    for (int j = 0; j < D_MODEL / 256; ++j) {
        const int col = 256 * j + 4 * lane; f32x4_t a = {0.f, 0.f, 0.f, 0.f};
        for (int ks = 0; ks < KS; ++ks) a += *(const f32x4_t*)(part + ((size_t)ks * MS + rs_) * D_MODEL + col);
        const u2 ho = *(const u2*)(hb + (size_t)m * D_MODEL + col);
        const f32x4_t v = (f32x4_t){__uint_as_float(ho.x << 16), __uint_as_float(ho.x & 0xffff0000u), __uint_as_float(ho.y << 16), __uint_as_float(ho.y & 0xffff0000u)} + a * coef;
        if (yout) *(f32x4_t*)(yout + (size_t)m * D_MODEL + col) = v;
        else { u2 w; w.x = cvtpk(v[0], v[1]); w.y = cvtpk(v[2], v[3]); *(u2*)(hb + (size_t)m * D_MODEL + col) = w;
               ssq += (v[0] * v[0] + v[1] * v[1]) + (v[2] * v[2] + v[3] * v[3]); }
    }
    if (!yout) {
#pragma unroll
        for (int o = 1; o < 64; o <<= 1) ssq += __shfl_xor(ssq, o);
        if (lane == 0) ((unsigned*)rss_next)[m] = rss_enc(ssq);
    }
}
}
__device__ __forceinline__ void conv_thin_sample_item(size_t i_, const float* part, int KS, const float* rss, const float* state, const float* wc, bf16_t* zb, float* out, int layer) {
    const int rs_ = (int)(i_ / (D_MODEL / 8)), ch = (int)(i_ % (D_MODEL / 8)) * 8, m = MP + rs_;
    const RowInfo ri = row_info(m);
    const int nc = (ch / 128) * 256 + (ch % 128);
    float u[3][8], bv[8];
    for (int back = 0; back < 3; ++back) {
        if (ri.t - back >= 0) {
            const int r2 = rs_ - back; const float rsn = rsqrtf(rss_dec(rss[MP + r2]) * (1.0f / D_MODEL) + EPS);
            for (int k = 0; k < 8; ++k) { float c = 0.f, x = 0.f; for (int ks = 0; ks < KS; ++ks) { const float* p = part + ((size_t)ks * MS + r2) * 3 * D_MODEL; c += p[nc + k]; x += p[nc + 128 + k]; } u[back][k] = (c * rsn) * (x * rsn); }
        } else { const float* st = state + (size_t)(ri.seq - BATCH) * 2 * D_MODEL + ch;
            const int srow = 2 - (back - ri.t); for (int k = 0; k < 8; ++k) u[back][k] = st[(size_t)srow * D_MODEL + k]; }
    }
    { const float rsn = rsqrtf(rss_dec(rss[m]) * (1.0f / D_MODEL) + EPS);
      for (int k = 0; k < 8; ++k) { float b = 0.f; for (int ks = 0; ks < KS; ++ks) b += part[((size_t)ks * MS + rs_) * 3 * D_MODEL + 2 * D_MODEL + ch + k]; bv[k] = b * rsn; } }
    for (int k = 0; k < 8; ++k) { const float ub0 = bf2f(f2bf(u[0][k])), ub1 = (ri.t >= 1) ? bf2f(f2bf(u[1][k])) : u[1][k], ub2 = (ri.t >= 2) ? bf2f(f2bf(u[2][k])) : u[2][k];
        zb[(size_t)m * D_MODEL + ch + k] = f2bf(bf2f(f2bf(bv[k])) * (wc[ch + k] * ub2 + wc[D_MODEL + ch + k] * ub1 + wc[2 * D_MODEL + ch + k] * ub0));
        if (ri.t >= DEC_SEQ - 2) out[O_CS + (((size_t)layer * DEC_BATCH + (ri.seq - BATCH)) * 2 + (ri.t - (DEC_SEQ - 2))) * D_MODEL + ch + k] = u[0][k]; }
}

__device__ __forceinline__ void acmp_sample_wave(int task, const float* cache_kv, const int* page_table, const float* pe, bf16_t* A, int lane) {
    typedef float f4 __attribute__((ext_vector_type(4))); typedef unsigned u4 __attribute__((ext_vector_type(4)));
    const int b = task / NBC_PAST, c = task % NBC_PAST, tok0 = c * L_CMP;
    const int page = page_table[b * N_PAGES + tok0 / PAGE_SIZE];
    const int e = lane >> 5, g = (lane >> 3) & (N_KV - 1), c8 = lane & 7;
    const float* src = cache_kv + ((size_t)page * PAGE_SIZE + tok0 % PAGE_SIZE) * 4 * N_KV * HD + lane * 8;
    const float* pp = pe + (size_t)e * L_CMP * HD + 8 * c8;
    bf16_t* dst = A + ((size_t)e * RS_CMP + ((size_t)b * NBC_PAST + c) * N_KV + g) * (L_CMP * HD) + 8 * c8;
#pragma unroll 8
    for (int l = 0; l < L_CMP; ++l) {
        const f4 a0 = __builtin_nontemporal_load((const f4*)(src + (size_t)l * 4 * N_KV * HD)) + *(const f4*)(pp + l * HD), a1 = __builtin_nontemporal_load((const f4*)(src + (size_t)l * 4 * N_KV * HD + 4)) + *(const f4*)(pp + l * HD + 4);
        u4 w; w.x = att::cvtpk(a0[0], a0[1]); w.y = att::cvtpk(a0[2], a0[3]); w.z = att::cvtpk(a1[0], a1[1]); w.w = att::cvtpk(a1[2], a1[3]);
        *(u4*)(dst + l * HD) = w;
    }
}
__device__ __forceinline__ void wconv_tile(int item, const float* src, int Nsrc, const float* gain, bf16_t* dst, int Nd, int K, int kind, int aux, LAS float* scr, int lane) {
    const int nblk = Nd / 32, kb = item / nblk, nb = item % nblk, k0 = 64 * kb, n0 = 32 * nb;
    const int colbase = colmap(kind, n0, aux);
    const int col = colbase + (lane & 31); const bool ok = colbase >= 0 && col < Nsrc;
    float tv[32];
    const float* sp0 = src + (size_t)(k0 + (lane >> 5)) * Nsrc + (ok ? col : 0);
#pragma unroll
    for (int i = 0; i < 32; ++i) tv[i] = ok ? __builtin_nontemporal_load(sp0 + (size_t)(2 * i) * Nsrc) : 0.f;
#pragma unroll
    for (int i = 0; i < 32; ++i) { const int kk = 2 * i + (lane >> 5); const float g = gain ? gain[k0 + kk] : 1.f; scr[kk * 33 + (lane & 31)] = tv[i] * g; }
    asm volatile("s_waitcnt lgkmcnt(0)" ::: "memory");
    const int c = lane & 7;
#pragma unroll
    for (int j = 0; j < 4; ++j) { const int n = (lane >> 3) + 8 * j; const LAS float* sp = scr + (8 * c) * 33 + n;
        typedef unsigned v4u __attribute__((ext_vector_type(4)));
        v4u o; o.x = pg8::cvt_pk_bf16(sp[0 * 33], sp[1 * 33]); o.y = pg8::cvt_pk_bf16(sp[2 * 33], sp[3 * 33]); o.z = pg8::cvt_pk_bf16(sp[4 * 33], sp[5 * 33]); o.w = pg8::cvt_pk_bf16(sp[6 * 33], sp[7 * 33]);
        *(v4u*)(dst + (size_t)(n0 + n) * K + k0 + 8 * c) = o; }
    asm volatile("s_waitcnt lgkmcnt(0)" ::: "memory");
}
__device__ __forceinline__ void hinit_row(int m, const float* xp, const float* xs, float* h, bf16_t* hb, float* rss0, int lane) {
    typedef float f4 __attribute__((ext_vector_type(4))); typedef unsigned u2 __attribute__((ext_vector_type(2)));
    const float* x = m < MP ? xp + (size_t)m * D_MODEL : xs + (size_t)(m - MP) * D_MODEL;
    float s = 0.f;
#pragma unroll
    for (int j = 0; j < D_MODEL / 256; ++j) { const f4 v = *(const f4*)(x + 256 * j + 4 * lane); s += (v[0] * v[0] + v[1] * v[1]) + (v[2] * v[2] + v[3] * v[3]);
        u2 w; w.x = pg8::cvt_pk_bf16(v[0], v[1]); w.y = pg8::cvt_pk_bf16(v[2], v[3]); *(u2*)(hb + (size_t)m * D_MODEL + 256 * j + 4 * lane) = w; }
#pragma unroll
    for (int o = 1; o < 64; o <<= 1) s += __shfl_xor(s, o);
    if (lane == 0) ((unsigned*)rss0)[m] = rss_enc(s);
}
#endif

#ifndef CPU_TEST
__device__ __forceinline__ size_t opaque_gtid(int wave) { int w = wave; asm volatile("" : "+s"(w)); unsigned t = blockIdx.x * NTHREADS + w * 64 + lane_id_v(); return (size_t)t; }
#define ITEM_LOOP(total) for (size_t i = opaque_gtid(wave_id); i < (size_t)(total); i += (size_t)gridDim.x * NTHREADS)
#else
#define ITEM_LOOP(total) _Pragma("omp parallel for schedule(dynamic, 64)") for (long long i = 0; i < (long long)(total); ++i)
#endif

struct Params {
    const float *x_prompt, *x_sample, *cache_kv, *cache_win, *state_conv; const int* page_table;
    const float *ffn_a_norm, *ffn_a_w_in, *ffn_a_w_out, *mix_norm, *ffn_b_norm, *ffn_b_w_in, *ffn_b_w_out, *conv_w_in, *conv_w, *conv_w_out, *kv_norm, *w_kv, *k_norm,
                *cmp_pe, *cmp_w1, *cmp_w2, *nsa_w_qg, *nsa_q_norm, *nsa_w_o;
    float* out; unsigned char* ws;
};
constexpr int LDS_RING = 131072, LDS_BAR_OFF = LDS_RING + 352, LDS_BYTES = 147456;

#ifndef CPU_TEST
typedef const __attribute__((address_space(4))) Params* KParamsPtr;
__device__ __forceinline__ KParamsPtr kparams_ptr() {
#if defined(__HIP_DEVICE_COMPILE__)
    KParamsPtr p = (KParamsPtr)__builtin_amdgcn_kernarg_segment_ptr(); asm volatile("" : "+s"(p)); return p;
#else
    return nullptr;
#endif
}
__device__ __forceinline__ Params load_params() {
#if defined(__HIP_DEVICE_COMPILE__)
    return *kparams_ptr();
#else
    return Params{};
#endif
}
__device__ __forceinline__ unsigned char* load_ws() {
#if defined(__HIP_DEVICE_COMPILE__)
    return kparams_ptr()->ws;
#else
    return nullptr;
#endif
}
#define KP const Params P = load_params()
__device__ __forceinline__ int opaque_s(int v) { asm volatile("" : "+s"(v)); return v; }
#define GRID_SYNC() do { XcdBarrier bar_; bar_.bar = (GU*)load_ws() + 1024; bar_.x = 0; bar_.st = (volatile LAS unsigned*)(lds + LDS_BAR_OFF); xcd_barrier(bar_, wave_id == 0 && lane_id_v() == 0u); } while (0)
__global__ void __launch_bounds__(NTHREADS, 2) mega(Params P_unused)
#else
static Params g_params;
#define KP const Params& P = g_params
#define GRID_SYNC() do {} while (0)
void mega(Params P_unused)
#endif
{
#ifndef CPU_TEST
    extern __shared__ __attribute__((aligned(16))) unsigned char lds[];
    const int wave_id = __builtin_amdgcn_readfirstlane((int)(threadIdx.x >> 6));
    if (threadIdx.x < 4) ((LAS unsigned*)(lds + LDS_BAR_OFF))[threadIdx.x] = 0u;
    __syncthreads();
    (void)xcd_barrier_post((GU*)load_ws() + 1024, (volatile LAS unsigned*)(lds + LDS_BAR_OFF), threadIdx.x == 0);
#define RING ((PG8_LAS unsigned char*)lds)
#else
    g_params = P_unused;
#endif
#define WS_F(f) ((float*)(P.ws + WSM.f))
#define WS_B(f) ((bf16_t*)(P.ws + WSM.f))
#define KVSRC KvSrc{P.cache_kv, P.page_table, P.out}
#define PH(total, call) do { { KP; ITEM_LOOP(total) call; } GRID_SYNC(); } while (0)
#ifdef CPU_TEST
    for (int L = 0; L < DEPTH; ++L) {
        KP;
        ITEM_LOOP((size_t)2 * D_FF * (D_MODEL / 64)) wconv_item(i, P.ffn_a_w_in + (size_t)L * D_MODEL * 2 * D_FF, 2 * D_FF, P.ffn_a_norm + (size_t)L * D_MODEL, WS_B(w_ain) + (size_t)L * 2 * D_FF * D_MODEL, 2 * D_FF, D_MODEL, CM_PAIR, D_FF);
        ITEM_LOOP((size_t)D_MODEL * (D_FF / 64)) wconv_item(i, P.ffn_a_w_out + (size_t)L * D_FF * D_MODEL, D_MODEL, nullptr, WS_B(w_aout) + (size_t)L * D_MODEL * D_FF, D_MODEL, D_FF, CM_PLAIN, 0);
        ITEM_LOOP((size_t)2 * D_FF * (D_MODEL / 64)) wconv_item(i, P.ffn_b_w_in + (size_t)L * D_MODEL * 2 * D_FF, 2 * D_FF, P.ffn_b_norm + (size_t)L * D_MODEL, WS_B(w_bin) + (size_t)L * 2 * D_FF * D_MODEL, 2 * D_FF, D_MODEL, CM_PAIR, D_FF);
        ITEM_LOOP((size_t)D_MODEL * (D_FF / 64)) wconv_item(i, P.ffn_b_w_out + (size_t)L * D_FF * D_MODEL, D_MODEL, nullptr, WS_B(w_bout) + (size_t)L * D_MODEL * D_FF, D_MODEL, D_FF, CM_PLAIN, 0);
    }
    for (int L = 0; L < N_A; ++L) {
        KP;
        ITEM_LOOP((size_t)3 * D_MODEL * (D_MODEL / 64)) wconv_item(i, P.conv_w_in + (size_t)L * D_MODEL * 3 * D_MODEL, 3 * D_MODEL, P.mix_norm + (size_t)L * D_MODEL, WS_B(w_cin) + (size_t)L * 3 * D_MODEL * D_MODEL, 3 * D_MODEL, D_MODEL, CM_CONV, 0);
        ITEM_LOOP((size_t)D_MODEL * (D_MODEL / 64)) wconv_item(i, P.conv_w_out + (size_t)L * D_MODEL * D_MODEL, D_MODEL, nullptr, WS_B(w_cout) + (size_t)L * D_MODEL * D_MODEL, D_MODEL, D_MODEL, CM_PLAIN, 0);
    }
    for (int b = 0; b < N_B; ++b) {
        KP;
        ITEM_LOOP((size_t)QGP * (D_MODEL / 64)) wconv_item(i, P.nsa_w_qg + (size_t)b * D_MODEL * QGW, QGW, P.mix_norm + (size_t)(N_A + b) * D_MODEL, WS_B(w_qg) + (size_t)b * QGP * D_MODEL, QGP, D_MODEL, CM_HEADS, N_HEADS);
        ITEM_LOOP((size_t)D_MODEL * (HDM / 64)) wconv_item(i, P.nsa_w_o + (size_t)b * HDM * D_MODEL, D_MODEL, nullptr, WS_B(w_o) + (size_t)b * D_MODEL * HDM, D_MODEL, HDM, CM_PLAIN, 0);
    }
    { KP; ITEM_LOOP((size_t)KVW * (D_MODEL / 64)) wconv_item(i, P.w_kv, KVW, P.kv_norm, WS_B(w_kv), KVW, D_MODEL, CM_HEADS, 6 * N_KV); }
    { KP; ITEM_LOOP((size_t)NPOS * 8) rope_item(i, WS_F(rope)); }
    { KP; ITEM_LOOP(MT) hinit_item(i, P.x_prompt, P.x_sample, WS_F(h), WS_B(hb), WS_F(rss)); }
#else
#define WAVE_ITEMS(total) for (int it_ = (int)(opaque_s((int)blockIdx.x) * 8 + wave_id); it_ < (int)(total); it_ += (int)gridDim.x * 8)
#define WCONV_R(cu0_, ncu_, srcp, Nsrc_, gainp, dstp, Nd_, K_, kind_, aux_) do { KP; LAS float* scr_ = (LAS float*)(lds + wave_id * 16384); const int lane_ = (int)lane_id_v(); \
        const int bx_ = opaque_s((int)blockIdx.x) - (cu0_); if (bx_ >= 0 && bx_ < (ncu_)) for (int it_ = bx_ * 8 + wave_id; it_ < ((Nd_) / 32) * ((K_) / 64); it_ += (ncu_) * 8) \
            wconv_tile(it_, srcp, Nsrc_, gainp, dstp, Nd_, K_, kind_, aux_, scr_, lane_); } while (0)
#define WCONV(srcp, Nsrc_, gainp, dstp, Nd_, K_, kind_, aux_) WCONV_R(0, (int)gridDim.x, srcp, Nsrc_, gainp, dstp, Nd_, K_, kind_, aux_)
#define CONV_LAYER_A(L, cu0_, ncu_) do { \
        WCONV_R(cu0_, ncu_, P.ffn_a_w_in + (size_t)(L) * D_MODEL * 2 * D_FF, 2 * D_FF, P.ffn_a_norm + (size_t)(L) * D_MODEL, WS_B(w_ain) + (size_t)(L) * 2 * D_FF * D_MODEL, 2 * D_FF, D_MODEL, CM_PAIR, D_FF); \
        WCONV_R(cu0_, ncu_, P.ffn_a_w_out + (size_t)(L) * D_FF * D_MODEL, D_MODEL, nullptr, WS_B(w_aout) + (size_t)(L) * D_MODEL * D_FF, D_MODEL, D_FF, CM_PLAIN, 0); \
        if ((L) < N_A) { \
            WCONV_R(cu0_, ncu_, P.conv_w_in + (size_t)(L) * D_MODEL * 3 * D_MODEL, 3 * D_MODEL, P.mix_norm + (size_t)(L) * D_MODEL, WS_B(w_cin) + (size_t)(L) * 3 * D_MODEL * D_MODEL, 3 * D_MODEL, D_MODEL, CM_CONV, 0); \
            WCONV_R(cu0_, ncu_, P.conv_w_out + (size_t)(L) * D_MODEL * D_MODEL, D_MODEL, nullptr, WS_B(w_cout) + (size_t)(L) * D_MODEL * D_MODEL, D_MODEL, D_MODEL, CM_PLAIN, 0); \
        } else { const int b_ = (L) - N_A; \
            WCONV_R(cu0_, ncu_, P.nsa_w_qg + (size_t)b_ * D_MODEL * QGW, QGW, P.mix_norm + (size_t)(L) * D_MODEL, WS_B(w_qg) + (size_t)b_ * QGP * D_MODEL, QGP, D_MODEL, CM_HEADS, N_HEADS); \
            WCONV_R(cu0_, ncu_, P.nsa_w_o + (size_t)b_ * HDM * D_MODEL, D_MODEL, nullptr, WS_B(w_o) + (size_t)b_ * D_MODEL * HDM, D_MODEL, HDM, CM_PLAIN, 0); } } while (0)
#define CONV_LAYER_B(L, cu0_, ncu_) do { \
        WCONV_R(cu0_, ncu_, P.ffn_b_w_in + (size_t)(L) * D_MODEL * 2 * D_FF, 2 * D_FF, P.ffn_b_norm + (size_t)(L) * D_MODEL, WS_B(w_bin) + (size_t)(L) * 2 * D_FF * D_MODEL, 2 * D_FF, D_MODEL, CM_PAIR, D_FF); \
        WCONV_R(cu0_, ncu_, P.ffn_b_w_out + (size_t)(L) * D_FF * D_MODEL, D_MODEL, nullptr, WS_B(w_bout) + (size_t)(L) * D_MODEL * D_FF, D_MODEL, D_FF, CM_PLAIN, 0); \
        if ((L) == N_A - 1) WCONV_R(cu0_, ncu_, P.w_kv, KVW, P.kv_norm, WS_B(w_kv), KVW, D_MODEL, CM_HEADS, 6 * N_KV); } while (0)
    CONV_LAYER_A(0, 0, (int)gridDim.x); CONV_LAYER_B(0, 0, (int)gridDim.x);
    { KP; ITEM_LOOP((size_t)NPOS * 8) rope_item(i, WS_F(rope)); }
    { KP; const int lane_ = (int)lane_id_v(); WAVE_ITEMS(MT) hinit_row(it_, P.x_prompt, P.x_sample, WS_F(h), WS_B(hb), WS_F(rss), lane_); }
#endif
#ifndef CPU_TEST
    for (int e = 0; e < 2; ++e) WCONV(P.cmp_w1 + (size_t)e * L_CMP * HD * CMP_HID, CMP_HID, nullptr, WS_B(w1t) + (size_t)e * CMP_HID * L_CMP * HD, CMP_HID, L_CMP * HD, CM_PLAIN, 0);
    for (int e = 0; e < 2; ++e) WCONV(P.cmp_w2 + (size_t)e * CMP_HID * HD, HD, nullptr, WS_B(w2t) + (size_t)e * HD * CMP_HID, HD, CMP_HID, CM_PLAIN, 0);
    { KP; const int lane_ = (int)lane_id_v(); static_assert(N_KV == 4 && 2 * N_KV * 8 == 64, "acmp_sample_wave lane map"); WAVE_ITEMS(DEC_BATCH * NBC_PAST) acmp_sample_wave(it_, P.cache_kv, P.page_table, P.cmp_pe, WS_B(acs), lane_); }
#endif
    GRID_SYNC();
#ifndef CPU_TEST
    { KP; pg8::Gemm g{WS_B(acs), WS_B(w1t), 2 * RS_CMP, 2 * CMP_HID, L_CMP * HD}; pg8::CmpOrder So{2 * RS_CMP / 256, RS_CMP / 256, opaque_s((int)gridDim.x), opaque_s((int)blockIdx.x)};
      pg8::EpiGelu E{WS_B(hids)}; pg8::gemm_phase<pg8::EpiGelu, pg8::CmpOrder, true, true>(wave_id, RING, g, So, E); }
    GRID_SYNC();
    { KP; const int lane_ = (int)lane_id_v(); WAVE_ITEMS(2 * RS_CMP / 32) att::cmp_out_wave(it_, WS_B(hids), RS_CMP, NBC_PAST, BATCH, WS_B(w2t), P.k_norm, WS_F(kc), WS_F(vc), nullptr, nullptr, lane_); }
    GRID_SYNC();
#endif

#ifndef CPU_TEST
#define RESID_PH(Aptr, Btptr, Kk, KSn, v_out, coef_, last_) do { \
        { KP; const int lane_ = (int)lane_id_v(); WAVE_ITEMS((MS / 32) * (D_MODEL / 32) * (KSn)) att::skinny_task(it_, (Aptr) + (size_t)MP * (Kk), Btptr, D_MODEL, Kk, KSn, WS_F(part), lane_); } \
        { KP; pg8::Gemm g{Aptr, Btptr, MP, D_MODEL, Kk}; pg8::StaticOrder So; So.init(MP, D_MODEL, opaque_s((int)gridDim.x), opaque_s((int)blockIdx.x)); \
          pg8::EpiResid E{WS_B(hb), WS_F(rss) + (size_t)(v_out) * MT, (last_) ? P.out + O_YP : nullptr, coef_}; pg8::gemm_phase<pg8::EpiResid, pg8::StaticOrder, true, true>(wave_id, RING, g, So, E); } \
        GRID_SYNC(); \
        { KP; const int lane_ = (int)lane_id_v(); WAVE_ITEMS(MS) att::resid_reduce_row(it_, WS_F(part), KSn, coef_, WS_B(hb), WS_F(rss) + (size_t)(v_out) * MT, (last_) ? P.out + O_YP : nullptr, lane_); } \
        GRID_SYNC(); } while (0)
#define FFN_OPT(wi, wo, v_in, last, is_b) do { \
        { KP; pg8::Gemm g{WS_B(hb), WS_B(wi) + (size_t)layer * 2 * D_FF * D_MODEL, MT, 2 * D_FF, D_MODEL}; pg8::StaticOrder So; So.init(MT, 2 * D_FF, opaque_s((int)gridDim.x), opaque_s((int)blockIdx.x)); \
          pg8::EpiSwiglu E{WS_B(act), WS_F(rss) + (size_t)(v_in) * MT}; pg8::gemm_phase<pg8::EpiSwiglu, pg8::StaticOrder, true, true>(wave_id, RING, g, So, E); } \
        if (layer + 1 < DEPTH) { constexpr int nun_ = (MT / 256) * (2 * D_FF / 256); const int G_ = (int)gridDim.x, rem_ = nun_ % G_;     \
            if (rem_ != 0) { if (is_b) CONV_LAYER_B(layer + 1, rem_, G_ - rem_); else CONV_LAYER_A(layer + 1, rem_, G_ - rem_); } \
            else { if (is_b) CONV_LAYER_B(layer + 1, 0, G_); else CONV_LAYER_A(layer + 1, 0, G_); } } \
        GRID_SYNC(); \
        RESID_PH(WS_B(act), WS_B(wo) + (size_t)layer * D_MODEL * D_FF, D_FF, 8, (v_in) + 1, 0.5f, last); } while (0)
#else
#define FFN_OPT(wi, wo, v_in, last, is_b) do { KP; \
        ITEM_LOOP((size_t)MT * D_FF) ref_ffn_in_item(i, WS_B(hb), WS_F(rss) + (size_t)(v_in) * MT, WS_B(wi) + (size_t)layer * 2 * D_FF * D_MODEL, WS_B(act)); \
        ITEM_LOOP(MT) ref_resid_row_item(i, WS_B(act), D_FF, WS_B(wo) + (size_t)layer * D_MODEL * D_FF, 0.5f, WS_F(h), WS_B(hb), WS_F(rss) + (size_t)((v_in) + 1) * MT, (last) ? P.out + O_YP : nullptr); } while (0)
#endif
#ifndef CPU_TEST
#define GEMM_PH(EpiT, Aptr, Btptr, Nn, Kk, ...) do { { KP; pg8::Gemm g{Aptr, Btptr, MT, Nn, Kk}; pg8::StaticOrder So; So.init(MT, Nn, opaque_s((int)gridDim.x), opaque_s((int)blockIdx.x)); \
        pg8::EpiT E{__VA_ARGS__}; pg8::gemm_phase<pg8::EpiT, pg8::StaticOrder, true, true>(wave_id, RING, g, So, E); } GRID_SYNC(); } while (0)
#endif
    for (int layer = 0; layer < DEPTH; ++layer) {
        FFN_OPT(w_ain, w_aout, 3 * layer, false, false);
        const int v1 = 3 * layer + 1;
        if (layer < N_A) {
#ifndef CPU_TEST
            { KP; const int lane_ = (int)lane_id_v(); WAVE_ITEMS((MS / 32) * (3 * D_MODEL / 32) * 2) att::skinny_task(it_, WS_B(hb) + (size_t)MP * D_MODEL, WS_B(w_cin) + (size_t)layer * 3 * D_MODEL * D_MODEL, 3 * D_MODEL, D_MODEL, 2, WS_F(part), lane_); }
            { KP; pg8::Gemm g{WS_B(hb), WS_B(w_cin) + (size_t)layer * 3 * D_MODEL * D_MODEL, MP, 3 * D_MODEL, D_MODEL}; pg8::StaticOrder So; So.init(MP, 3 * D_MODEL, opaque_s((int)gridDim.x), opaque_s((int)blockIdx.x));
              pg8::EpiConvIn E{WS_B(ub), WS_B(bb), WS_F(rss) + (size_t)v1 * MT, P.out, layer}; pg8::gemm_phase<pg8::EpiConvIn, pg8::StaticOrder, true, true>(wave_id, RING, g, So, E); }
            GRID_SYNC();
#else
            PH((size_t)MT * D_MODEL, ref_conv_in_item(i, WS_B(hb), WS_F(rss) + (size_t)v1 * MT, WS_B(w_cin) + (size_t)layer * 3 * D_MODEL * D_MODEL, WS_B(ub), WS_B(bb), P.out, layer));
#endif
#ifndef CPU_TEST
            { KP; ITEM_LOOP((size_t)MS * (D_MODEL / 8)) conv_thin_sample_item(i, WS_F(part), 2, WS_F(rss) + (size_t)v1 * MT, P.state_conv + (size_t)layer * DEC_BATCH * 2 * D_MODEL, P.conv_w + (size_t)layer * 3 * D_MODEL, WS_B(zb), P.out, layer); }
            PH((size_t)MP * (D_MODEL / 8), conv_thin_vec_item(i, WS_B(ub), WS_B(bb), P.state_conv + (size_t)layer * DEC_BATCH * 2 * D_MODEL, P.conv_w + (size_t)layer * 3 * D_MODEL, WS_B(zb)));
#else
            PH((size_t)MT * D_MODEL, conv_thin_item(i, WS_B(ub), WS_B(bb), P.state_conv + (size_t)layer * DEC_BATCH * 2 * D_MODEL, P.conv_w + (size_t)layer * 3 * D_MODEL, WS_B(zb)));
#endif
#ifndef CPU_TEST
            RESID_PH(WS_B(zb), WS_B(w_cout) + (size_t)layer * D_MODEL * D_MODEL, D_MODEL, 8, v1 + 1, 1.0f, false);
#else
            PH(MT, ref_resid_row_item(i, WS_B(zb), D_MODEL, WS_B(w_cout) + (size_t)layer * D_MODEL * D_MODEL, 1.0f, WS_F(h), WS_B(hb), WS_F(rss) + (size_t)(v1 + 1) * MT, nullptr));
#endif
        } else {
            const int b = layer - N_A;
#ifndef CPU_TEST
            GEMM_PH(EpiQG, WS_B(hb), WS_B(w_qg) + (size_t)b * QGP * D_MODEL, QGP, D_MODEL, WS_B(qnb), WS_B(qrb), WS_F(gates), WS_F(rss) + (size_t)v1 * MT, P.nsa_q_norm + (size_t)b * HD, WS_F(rope));
#else
            { KP; ITEM_LOOP((size_t)MT * N_HEADS) ref_qg_item(i, WS_B(hb), WS_F(rss) + (size_t)v1 * MT, WS_B(w_qg) + (size_t)b * QGP * D_MODEL, P.nsa_q_norm + (size_t)b * HD, WS_F(rope), WS_F(qn), WS_F(qr)); }
            PH((size_t)MT * 3 * N_HEADS, ref_gates_item(i, WS_B(hb), WS_F(rss) + (size_t)v1 * MT, WS_B(w_qg) + (size_t)b * QGP * D_MODEL, WS_F(gates)));
#endif
#ifndef CPU_TEST
            { KP; att::STensors TS{WS_B(qnb), WS_B(qrb), WS_F(kc), WS_F(vc), P.cache_kv, P.page_table, P.cache_win, P.out, WS_F(winrows), WS_F(gates), WS_B(ob)};
              int wv = wave_id; asm volatile("" : "+s"(wv));
              att::att_queue_sample(TS, (unsigned*)P.ws + 8192 + 128 * b, (att::ldsp)lds, wv, (int)lane_id_v()); }
            { KP; att::Tensors T{WS_B(qnb), WS_B(qrb), P.ws + WSM.ksel, P.ws + WSM.vsel, P.ws + WSM.kwin, P.ws + WSM.vwin, P.ws + WSM.kci, P.ws + WSM.vci, WS_F(gates), WS_B(ob)};
              int wv = wave_id; asm volatile("" : "+s"(wv));
              att::att_queue_prompt(T, (unsigned*)P.ws + 8192 + 128 * b + 64, (att::ldsp)lds, wv, (int)lane_id_v()); }
            GRID_SYNC();
#else
            PH((size_t)MT * N_HEADS, attn_cmp_item(i, WS_F(qn), WS_F(kc), WS_F(vc), WS_F(pbuf), WS_F(oc)));
            PH((size_t)MT * N_KV, topk_item(i, WS_F(pbuf), (int*)WS_F(sel), WS_F(scorebuf)));
            PH((size_t)MT * N_HEADS, attn_sel_item(i, KVSRC, WS_F(qr), (const int*)WS_F(sel), WS_F(os)));
            PH((size_t)MT * N_HEADS, attn_win_item(i, P.cache_win, WS_F(winrows), WS_F(qr), WS_F(gates), WS_F(oc), WS_F(os), WS_B(ob)));
#endif
#ifndef CPU_TEST
            RESID_PH(WS_B(ob), WS_B(w_o) + (size_t)b * D_MODEL * HDM, HDM, 8, v1 + 1, 1.0f, false);
#else
            PH(MT, ref_resid_row_item(i, WS_B(ob), HDM, WS_B(w_o) + (size_t)b * D_MODEL * HDM, 1.0f, WS_F(h), WS_B(hb), WS_F(rss) + (size_t)(v1 + 1) * MT, nullptr));
#endif
        }
        FFN_OPT(w_bin, w_bout, 3 * layer + 2, layer == DEPTH - 1, true);
        if (layer == N_A - 1) {
            const int v3 = 3 * layer + 3;
#ifndef CPU_TEST
            { KP; pg8::Gemm g{WS_B(hb), WS_B(w_kv), MT, KVW, D_MODEL}; pg8::StaticOrder So; So.init(MT, KVW, opaque_s((int)gridDim.x), opaque_s((int)blockIdx.x));
              pg8::EpiKV E{P.out, WS_F(winrows), WS_F(rss) + (size_t)v3 * MT, P.k_norm, WS_F(rope), P.ws + WSM.ksel, P.ws + WSM.vsel, P.ws + WSM.kwin, P.ws + WSM.vwin, WS_B(acp), P.cmp_pe}; pg8::gemm_phase<pg8::EpiKV, pg8::StaticOrder, true, true>(wave_id, RING, g, So, E); }
#else
            { KP; ITEM_LOOP((size_t)MT * 6 * N_KV) ref_kv_item(i, WS_B(hb), WS_F(rss) + (size_t)v3 * MT, WS_B(w_kv), P.k_norm, WS_F(rope), P.out, WS_F(winrows)); }
#endif
            PH((size_t)DEC_BATCH * (WINDOW - DEC_SEQ) * 2 * N_KV * HD, wincopy_item(i, P.cache_win, P.out));
#ifdef CPU_TEST
            PH((size_t)NSEQ * NBC_MAX * 2 * N_KV * CMP_HID, cmp_hid_item(i, KVSRC, P.cmp_pe, P.cmp_w1, WS_F(hid)));
            PH((size_t)NSEQ * NBC_MAX * 2 * N_KV, cmp_out_item(i, WS_F(hid), P.cmp_w2, P.k_norm, WS_F(kc), WS_F(vc)));
#else
            { KP; pg8::Gemm g{WS_B(acp), WS_B(w1t), 2 * RP_CMP, 2 * CMP_HID, L_CMP * HD}; pg8::CmpOrder So{2 * RP_CMP / 256, RP_CMP / 256, opaque_s((int)gridDim.x), opaque_s((int)blockIdx.x)};
              pg8::EpiGelu E{WS_B(hidp)}; pg8::gemm_phase<pg8::EpiGelu, pg8::CmpOrder, true, true>(wave_id, RING, g, So, E); }
            GRID_SYNC();
            { KP; const int lane_ = (int)lane_id_v(); WAVE_ITEMS(2 * RP_CMP / 32) att::cmp_out_wave(it_, WS_B(hidp), RP_CMP, NBC_P, 0, WS_B(w2t), P.k_norm, WS_F(kc), WS_F(vc), P.ws + WSM.kci, P.ws + WSM.vci, lane_); }
            GRID_SYNC();
#endif
        }
    }
}

extern "C" void kernel_launch(void* const* d_in, const int* in_sizes, int n_in, void* d_out, int out_size, void* d_ws, size_t ws_size, hipStream_t stream) {
    Params P{};
    P.x_prompt = (const float*)d_in[0]; P.x_sample = (const float*)d_in[1]; P.cache_kv = (const float*)d_in[2]; P.cache_win = (const float*)d_in[3];
    P.state_conv = (const float*)d_in[4]; P.page_table = (const int*)d_in[5]; P.ffn_a_norm = (const float*)d_in[6]; P.ffn_a_w_in = (const float*)d_in[7];
    P.ffn_a_w_out = (const float*)d_in[8]; P.mix_norm = (const float*)d_in[9]; P.ffn_b_norm = (const float*)d_in[10]; P.ffn_b_w_in = (const float*)d_in[11];
    P.ffn_b_w_out = (const float*)d_in[12]; P.conv_w_in = (const float*)d_in[13]; P.conv_w = (const float*)d_in[14]; P.conv_w_out = (const float*)d_in[15];
    P.kv_norm = (const float*)d_in[16]; P.w_kv = (const float*)d_in[17]; P.k_norm = (const float*)d_in[18]; P.cmp_pe = (const float*)d_in[19];
    P.cmp_w1 = (const float*)d_in[20]; P.cmp_w2 = (const float*)d_in[21]; P.nsa_w_qg = (const float*)d_in[22]; P.nsa_q_norm = (const float*)d_in[23];
    P.nsa_w_o = (const float*)d_in[24];
    P.out = (float*)d_out; P.ws = (unsigned char*)d_ws;
#ifndef CPU_TEST
    static int grid = 0;
    if (grid == 0) {
        int dev = 0, cus = 0, per_cu = 0;
        hipGetDevice(&dev); hipDeviceGetAttribute(&cus, hipDeviceAttributeMultiprocessorCount, dev);
        hipFuncSetAttribute((const void*)mega, hipFuncAttributeMaxDynamicSharedMemorySize, LDS_BYTES);
        hipOccupancyMaxActiveBlocksPerMultiprocessor(&per_cu, (const void*)mega, NTHREADS, LDS_BYTES);
        (void)hipGetLastError();
        grid = cus;
    }
    hipMemsetAsync(d_ws, 0, WS_ZERO_BYTES, stream);
    hipLaunchKernelGGL(mega, dim3(grid), dim3(NTHREADS), LDS_BYTES, stream, P);
#else
    memset(d_ws, 0, WS_ZERO_BYTES);
    mega(P);
#endif
}
```

```cpp
#ifdef CPU_TEST
#include "shim.h"
#else
#include <hip/hip_runtime.h>
#endif
#include <cstdint>
#include <cstddef>
#include <cmath>
#include <cstring>
typedef unsigned short bf16_t;
#ifndef CPU_TEST
#define HOSTDEV __host__ __device__
#else
#define HOSTDEV
#endif
HOSTDEV inline bf16_t f2bf(float f) { unsigned u; memcpy(&u, &f, 4); u = (u + 0x7fffu + ((u >> 16) & 1u)) >> 16; return (bf16_t)u; }
HOSTDEV inline float bf2f(bf16_t b) { unsigned u = (unsigned)b << 16; float f; memcpy(&f, &u, 4); return f; }

#ifdef CFG_SMALL
constexpr int D_MODEL = 256, BATCH = 1, SEQ = 2048, DEPTH = 4, DEC_BATCH = 2, DEC_SEQ = 8, PAST_LEN = 2048, PAGE_SIZE = 128, D_FF = 256, N_HEADS = 4, N_KV = 2;
#else
constexpr int D_MODEL = 1024, BATCH = 4, SEQ = 4096, DEPTH = 4, DEC_BATCH = 32, DEC_SEQ = 8, PAST_LEN = 8192, PAGE_SIZE = 128, D_FF = 2816, N_HEADS = 16, N_KV = 4;
#endif
constexpr int N_A = DEPTH / 2, N_B = DEPTH - N_A, HD = 64, HPG = N_HEADS / N_KV, L_CMP = 32, L_SEL = 64, N_SEL = 16, WINDOW = 512, CMP_HID = 4 * HD;
constexpr int MP = BATCH * SEQ, MS = DEC_BATCH * DEC_SEQ, MT = MP + MS, NSEQ = BATCH + DEC_BATCH;
constexpr int N_PAGES = PAST_LEN / PAGE_SIZE;
constexpr int KVW = 6 * N_KV * HD;
constexpr int QGW = N_HEADS * HD + 3 * N_HEADS;
constexpr int HDM = N_HEADS * HD;
constexpr int TPAD_S = ((PAST_LEN + DEC_SEQ + L_SEL - 1) / L_SEL) * L_SEL;
constexpr int NBC_P = SEQ / L_CMP, NBC_S = TPAD_S / L_CMP, NBC_MAX = NBC_S > NBC_P ? NBC_S : NBC_P;
constexpr int NBS_P = SEQ / L_SEL, NBS_S = TPAD_S / L_SEL, NBS_MAX = NBS_S > NBS_P ? NBS_S : NBS_P;
constexpr float EPS = 1e-6f, NEGF = -1e30f, TINYF = 1e-30f, FORCE_SCORE = 1e4f;
__device__ static const float INV_FREQ[8] = {1.0f, 0.1939227432012558f, 0.03760603070259094f, 0.007292664609849453f, 0.0014142135623842478f, 0.00027424818836152554f, 5.3182957344688475e-05f, 1.0313385246263351e-05f};

constexpr size_t O_YP = 0, O_YS = O_YP + (size_t)MP * D_MODEL, O_KVP = O_YS + (size_t)MS * D_MODEL, O_KVS = O_KVP + (size_t)MP * 4 * N_KV * HD,
                 O_WP = O_KVS + (size_t)MS * 4 * N_KV * HD, O_WS = O_WP + (size_t)BATCH * WINDOW * 2 * N_KV * HD, O_CP = O_WS + (size_t)DEC_BATCH * WINDOW * 2 * N_KV * HD,
                 O_CS = O_CP + (size_t)N_A * BATCH * 2 * D_MODEL, O_END = O_CS + (size_t)N_A * DEC_BATCH * 2 * D_MODEL;

struct RowInfo { int seq, t, pos; };
__device__ __host__ inline RowInfo row_info(int m) {
    RowInfo r;
    if (m < MP) { r.seq = m / SEQ; r.t = m % SEQ; r.pos = r.t; }
    else { const int q = m - MP; r.seq = BATCH + q / DEC_SEQ; r.t = q % DEC_SEQ; r.pos = PAST_LEN + r.t; }
    return r;
}
__device__ __host__ inline int seq_row0(int seq) { return seq < BATCH ? seq * SEQ : MP + (seq - BATCH) * DEC_SEQ; }
__device__ __host__ inline int seq_pos0(int seq) { return seq < BATCH ? 0 : PAST_LEN; }
__device__ __host__ inline int seq_len(int seq) { return seq < BATCH ? SEQ : DEC_SEQ; }

__device__ inline void copy_item(size_t i_, const float* a, float* b, size_t n) {
    const size_t i = i_;
    if (i < n) b[i] = a[i];
}
__device__ inline void rmsnorm_item(size_t i_, const float* x, const float* g, float* y, int rows, int d) {
    const int m = (int)i_;
    if (m >= rows) return;
    const float* xr = x + (size_t)m * d; float s = 0.f;
    for (int i = 0; i < d; ++i) s += xr[i] * xr[i];
    const float r = 1.0f / sqrtf(s / d + EPS);
    float* yr = y + (size_t)m * d;
    for (int i = 0; i < d; ++i) yr[i] = xr[i] * r * g[i];
}
__device__ inline void gemm_item(size_t i_, const float* A, int lda, const float* W, float* C, int M, int N, int K) {
    const int nbx = (N + 63) / 64; const int vb = (int)(i_ / 256), t_ = (int)(i_ % 256), tx = t_ % 16, ty = t_ / 16;
    const int c0 = (vb % nbx) * 64 + tx * 4, r0 = (vb / nbx) * 64 + ty * 4;
    if (c0 >= N || r0 >= M) return;
    float acc[4][4];
    for (int i = 0; i < 4; ++i) for (int j = 0; j < 4; ++j) acc[i][j] = 0.f;
    const int nr = (M - r0) < 4 ? (M - r0) : 4;
    for (int k = 0; k < K; k += 4) {
        float a[4][4], w[4][4];
        for (int i = 0; i < 4; ++i) for (int kk = 0; kk < 4; ++kk) a[i][kk] = (i < nr) ? A[(size_t)(r0 + i) * lda + k + kk] : 0.f;
        for (int kk = 0; kk < 4; ++kk) for (int j = 0; j < 4; ++j) w[kk][j] = W[(size_t)(k + kk) * N + c0 + j];
        for (int i = 0; i < 4; ++i) for (int kk = 0; kk < 4; ++kk) for (int j = 0; j < 4; ++j) acc[i][j] += a[i][kk] * w[kk][j];
    }
    for (int i = 0; i < nr; ++i) for (int j = 0; j < 4; ++j) C[(size_t)(r0 + i) * N + c0 + j] = acc[i][j];
}
__device__ inline void swiglu_item(size_t i_, const float* t1, float* act, int rows, int dff) {
    const size_t i = i_;
    if (i >= (size_t)rows * dff) return;
    const int m = (int)(i / dff), j = (int)(i % dff);
    const float g = t1[(size_t)m * 2 * dff + j], u = t1[(size_t)m * 2 * dff + dff + j];
    act[i] = g / (1.0f + expf(-g)) * u;
}
__device__ inline void axpy_item(size_t i_, float* h, const float* y, float coef, size_t n) {
    const size_t i = i_;
    if (i < n) h[i] += coef * y[i];
}
__device__ inline void conv_item(size_t i_, const float* t1, const float* state  , const float* wc  , float* z, float* out, int layer) {
    const size_t i = i_;
    if (i >= (size_t)MT * D_MODEL) return;
    const int m = (int)(i / D_MODEL), ch = (int)(i % D_MODEL);
    const RowInfo ri = row_info(m);
    const float* r = t1 + (size_t)m * 3 * D_MODEL;
    const float b = r[ch], u0 = r[D_MODEL + ch] * r[2 * D_MODEL + ch];
    float u1, u2;
    if (ri.t >= 1) { const float* p = r - 3 * D_MODEL; u1 = p[D_MODEL + ch] * p[2 * D_MODEL + ch]; }
    else u1 = (ri.seq < BATCH) ? 0.f : state[((size_t)(ri.seq - BATCH) * 2 + 1) * D_MODEL + ch];
    if (ri.t >= 2) { const float* p = r - 6 * D_MODEL; u2 = p[D_MODEL + ch] * p[2 * D_MODEL + ch]; }
    else if (ri.seq < BATCH) u2 = 0.f;
    else u2 = (ri.t == 1) ? state[((size_t)(ri.seq - BATCH) * 2 + 1) * D_MODEL + ch] : state[((size_t)(ri.seq - BATCH) * 2 + 0) * D_MODEL + ch];
    z[i] = b * (wc[ch] * u2 + wc[D_MODEL + ch] * u1 + wc[2 * D_MODEL + ch] * u0);
    const int L = seq_len(ri.seq);
    if (ri.t >= L - 2) {
        const int j = ri.t - (L - 2);
        if (ri.seq < BATCH) out[O_CP + (((size_t)layer * BATCH + ri.seq) * 2 + j) * D_MODEL + ch] = u0;
        else out[O_CS + (((size_t)layer * DEC_BATCH + (ri.seq - BATCH)) * 2 + j) * D_MODEL + ch] = u0;
    }
}
__device__ inline void head_norm(float* v, const float* g) {
    float s = 0.f; for (int d = 0; d < HD; ++d) s += v[d] * v[d];
    const float r = 1.0f / sqrtf(s / HD + EPS);
    for (int d = 0; d < HD; ++d) v[d] = v[d] * r * g[d];
}
__device__ inline void rope_cs(float ang, float& c, float& s) {
    const double r = (double)ang * 0.15915494309189535; const float fr = (float)(r - rint(r));
#ifdef CPU_TEST
    c = (float)cos(6.283185307179586 * (double)fr); s = (float)sin(6.283185307179586 * (double)fr);
#else
    c = __builtin_amdgcn_cosf(fr); s = __builtin_amdgcn_sinf(fr);
#endif
}
__device__ inline void head_rope(float* v, int pos) {
    for (int i = 0; i < 8; ++i) {
        const float ang = (float)pos * INV_FREQ[i]; float c, s; rope_cs(ang, c, s);
        const float x1 = v[i], x2 = v[8 + i];
        v[i] = x1 * c - x2 * s; v[8 + i] = x2 * c + x1 * s;
    }
}
__device__ inline void kvprep_item(size_t i_, const float* p, const float* k_norm  , float* out, float* winrows) {
    const int i = (int)i_;
    if (i >= MT * 6 * N_KV) return;
    const int m = i / (6 * N_KV), e = (i / N_KV) % 6, g = i % N_KV;
    const RowInfo ri = row_info(m);
    float v[HD];
    for (int d = 0; d < HD; ++d) v[d] = p[(size_t)m * KVW + (e * N_KV + g) * HD + d];
    if (e == 2) { head_norm(v, k_norm + HD); head_rope(v, ri.pos); }
    if (e == 4) { head_norm(v, k_norm + 2 * HD); head_rope(v, ri.pos); }
    if (e < 4) {
        float* o = (ri.seq < BATCH) ? out + O_KVP + (((size_t)m * 4 + e) * N_KV + g) * HD : out + O_KVS + (((size_t)(m - MP) * 4 + e) * N_KV + g) * HD;
        for (int d = 0; d < HD; ++d) o[d] = v[d];
    } else {
        const int we = e - 4;
        float* w = winrows + (((size_t)m * 2 + we) * N_KV + g) * HD;
        for (int d = 0; d < HD; ++d) w[d] = v[d];
        if (ri.seq < BATCH) { if (ri.t >= SEQ - WINDOW) { float* o = out + O_WP + ((((size_t)ri.seq * WINDOW + (ri.t - (SEQ - WINDOW))) * 2 + we) * N_KV + g) * HD; for (int d = 0; d < HD; ++d) o[d] = v[d]; } }
        else { float* o = out + O_WS + ((((size_t)(ri.seq - BATCH) * WINDOW + (WINDOW - DEC_SEQ + ri.t)) * 2 + we) * N_KV + g) * HD; for (int d = 0; d < HD; ++d) o[d] = v[d]; }
    }
}
__device__ inline void wincopy_item(size_t i_, const float* cache_win, float* out) {
    const size_t i = i_;
    const size_t per = (size_t)(WINDOW - DEC_SEQ) * 2 * N_KV * HD;
    if (i >= (size_t)DEC_BATCH * per) return;
    const size_t b = i / per, r = i % per;
    out[O_WS + b * WINDOW * 2 * N_KV * HD + r] = cache_win[b * WINDOW * 2 * N_KV * HD + (size_t)DEC_SEQ * 2 * N_KV * HD + r];
}
struct KvSrc { const float* cache_kv; const int* page_table; const float* out; };
__device__ inline const float* kv_full_ptr(const KvSrc& S, int seq, int tok, int e, int g) {
    if (seq < BATCH) return S.out + O_KVP + ((((size_t)seq * SEQ + tok) * 4 + e) * N_KV + g) * HD;
    const int b = seq - BATCH;
    if (tok < PAST_LEN) { const int page = S.page_table[b * N_PAGES + tok / PAGE_SIZE]; return S.cache_kv + ((((size_t)page * PAGE_SIZE + tok % PAGE_SIZE) * 4 + e) * N_KV + g) * HD; }
    if (tok < PAST_LEN + DEC_SEQ) return S.out + O_KVS + ((((size_t)b * DEC_SEQ + (tok - PAST_LEN)) * 4 + e) * N_KV + g) * HD;
    return nullptr;
}
__device__ inline int seq_nbc(int seq) { return seq < BATCH ? NBC_P : NBC_S; }
__device__ inline void cmp_hid_item(size_t i_, KvSrc S, const float* pe  , const float* w1  , float* hid) {
    const size_t i = i_;
    if (i >= (size_t)NSEQ * NBC_MAX * 2 * N_KV * CMP_HID) return;
    const int f = (int)(i % CMP_HID), g = (int)((i / CMP_HID) % N_KV), e = (int)((i / ((size_t)CMP_HID * N_KV)) % 2), c = (int)((i / ((size_t)CMP_HID * N_KV * 2)) % NBC_MAX), seq = (int)(i / ((size_t)CMP_HID * N_KV * 2 * NBC_MAX));
    if (c >= seq_nbc(seq)) return;
    float s = 0.f;
    for (int l = 0; l < L_CMP; ++l) {
        const float* r = kv_full_ptr(S, seq, c * L_CMP + l, e, g);
        const float* w = w1 + (((size_t)e * L_CMP + l) * HD) * CMP_HID + f; const float* pp = pe + ((size_t)e * L_CMP + l) * HD;
        for (int d = 0; d < HD; ++d) s += ((r ? r[d] : 0.f) + pp[d]) * w[(size_t)d * CMP_HID];
    }
    const float x = s; const float t = tanhf(0.7978845608028654f * (x + 0.044715f * x * x * x));
    hid[i] = 0.5f * x * (1.0f + t);
}
__device__ inline void cmp_out_item(size_t i_, const float* hid, const float* w2  , const float* k_norm0, float* kc, float* vc) {
    const int i = (int)i_;
    if (i >= NSEQ * NBC_MAX * 2 * N_KV) return;
    const int g = i % N_KV, e = (i / N_KV) % 2, c = (i / (2 * N_KV)) % NBC_MAX, seq = i / (2 * N_KV * NBC_MAX);
    if (c >= seq_nbc(seq)) return;
    const float* hr = hid + (size_t)i * CMP_HID;
    float v[HD];
    for (int d = 0; d < HD; ++d) { float s = 0.f; for (int f = 0; f < CMP_HID; ++f) s += hr[f] * w2[((size_t)e * CMP_HID + f) * HD + d]; v[d] = s; }
    if (e == 0) head_norm(v, k_norm0);
    float* o = (e == 0 ? kc : vc) + (((size_t)seq * NBC_MAX + c) * N_KV + g) * HD;
    for (int d = 0; d < HD; ++d) o[d] = v[d];
}
__device__ inline void qprep_item(size_t i_, const float* qg, const float* q_norm, float* qn, float* qr, float* gates) {
    const int i = (int)i_;
    if (i >= MT * N_HEADS) return;
    const int m = i / N_HEADS, hh = i % N_HEADS;
    const RowInfo ri = row_info(m);
    float v[HD];
    for (int d = 0; d < HD; ++d) v[d] = qg[(size_t)m * QGW + hh * HD + d];
    head_norm(v, q_norm);
    for (int d = 0; d < HD; ++d) qn[(size_t)m * HDM + hh * HD + d] = v[d];
    head_rope(v, ri.pos);
    for (int d = 0; d < HD; ++d) qr[(size_t)m * HDM + hh * HD + d] = v[d];
    for (int j = 0; j < 3; ++j) { const float x = qg[(size_t)m * QGW + HDM + hh * 3 + j]; gates[(size_t)m * 3 * N_HEADS + hh * 3 + j] = 1.0f / (1.0f + expf(-x)); }
}
__device__ inline void attn_cmp_item(size_t i_, const float* qn, const float* kc, const float* vc, float* pbuf, float* oc) {
    const int i = (int)i_;
    if (i >= MT * N_HEADS) return;
    const int m = i / N_HEADS, hh = i % N_HEADS, g = hh / HPG;
    const RowInfo ri = row_info(m);
    const int nbc = seq_nbc(ri.seq);
    const float* q = qn + (size_t)m * HDM + hh * HD;
    float* p = pbuf + (size_t)i * NBC_MAX;
    float mx = NEGF;
    for (int c = 0; c < nbc; ++c) {
        const bool vis = (c + 1) * L_CMP - 1 <= ri.pos;
        float s = 0.f; const float* k = kc + (((size_t)ri.seq * NBC_MAX + c) * N_KV + g) * HD;
        for (int d = 0; d < HD; ++d) s += q[d] * k[d];
        s *= 0.125f; p[c] = s; if (vis && s > mx) mx = s;
    }
    float sum = 0.f;
    for (int c = 0; c < nbc; ++c) { const bool vis = (c + 1) * L_CMP - 1 <= ri.pos; const float e = vis ? expf(p[c] - mx) : 0.f; p[c] = e; sum += e; }
    const float inv = 1.0f / fmaxf(sum, TINYF);
    float o[HD]; for (int d = 0; d < HD; ++d) o[d] = 0.f;
    for (int c = 0; c < nbc; ++c) { p[c] *= inv; if (p[c] != 0.f) { const float* v = vc + (((size_t)ri.seq * NBC_MAX + c) * N_KV + g) * HD; for (int d = 0; d < HD; ++d) o[d] += p[c] * v[d]; } }
    for (int d = 0; d < HD; ++d) oc[(size_t)m * HDM + hh * HD + d] = o[d];
}
__device__ inline void topk_item(size_t i_, const float* pbuf, int* sel, float* scorebuf  ) {
    const int i = (int)i_;
    if (i >= MT * N_KV) return;
    const int m = i / N_KV, g = i % N_KV;
    const RowInfo ri = row_info(m);
    const int nbs = ri.seq < BATCH ? NBS_P : NBS_S, cur = ri.pos / L_SEL;
    float* score = scorebuf + (size_t)i * NBS_MAX;
    for (int b = 0; b < nbs; ++b) {
        float imp = 0.f;
        for (int h = 0; h < HPG; ++h) { const float* p = pbuf + ((size_t)m * N_HEADS + g * HPG + h) * NBC_MAX; imp += p[2 * b]; }
        float imp2 = 0.f;
        for (int h = 0; h < HPG; ++h) { const float* p = pbuf + ((size_t)m * N_HEADS + g * HPG + h) * NBC_MAX; imp2 += p[2 * b + 1]; }
        const bool forced = (b == 0) || (b == cur) || (b == cur - 1), valid = b * L_SEL <= ri.pos;
        score[b] = valid ? (forced ? FORCE_SCORE : imp + imp2) : NEGF;
    }
    const int nsel = N_SEL < nbs ? N_SEL : nbs;
    for (int j = 0; j < N_SEL; ++j) {
        if (j >= nsel) { sel[(size_t)i * N_SEL + j] = -1; continue; }
        int best = -1; float bv = 0.f;
        for (int b = 0; b < nbs; ++b) if (score[b] > -3e38f && (best < 0 || score[b] > bv)) { best = b; bv = score[b]; }
        sel[(size_t)i * N_SEL + j] = best; score[best] = -3.4e38f;
    }
}
__device__ inline void attn_sel_item(size_t i_, KvSrc S, const float* qr, const int* sel, float* os) {
    const int i = (int)i_;
    if (i >= MT * N_HEADS) return;
    const int m = i / N_HEADS, hh = i % N_HEADS, g = hh / HPG;
    const RowInfo ri = row_info(m);
    const float* q = qr + (size_t)m * HDM + hh * HD;
    const int* sl = sel + ((size_t)m * N_KV + g) * N_SEL;
    float mx = NEGF;
    for (int j = 0; j < N_SEL; ++j) { const int b = sl[j]; if (b < 0) continue;
        for (int t = 0; t < L_SEL; ++t) { const int tok = b * L_SEL + t; if (tok > ri.pos) continue;
            const float* k = kv_full_ptr(S, ri.seq, tok, 2, g); float s = 0.f; if (k) for (int d = 0; d < HD; ++d) s += q[d] * k[d];
            s *= 0.125f; if (s > mx) mx = s; } }
    float sum = 0.f, o[HD]; for (int d = 0; d < HD; ++d) o[d] = 0.f;
    for (int j = 0; j < N_SEL; ++j) { const int b = sl[j]; if (b < 0) continue;
        for (int t = 0; t < L_SEL; ++t) { const int tok = b * L_SEL + t; if (tok > ri.pos) continue;
            const float* k = kv_full_ptr(S, ri.seq, tok, 2, g); float s = 0.f; if (k) for (int d = 0; d < HD; ++d) s += q[d] * k[d];
            const float e = expf(s * 0.125f - mx); sum += e;
            const float* v = kv_full_ptr(S, ri.seq, tok, 3, g); if (v) for (int d = 0; d < HD; ++d) o[d] += e * v[d]; } }
    const float inv = 1.0f / fmaxf(sum, TINYF);
    for (int d = 0; d < HD; ++d) os[(size_t)m * HDM + hh * HD + d] = o[d] * inv;
}
__device__ inline const float* win_ptr(const float* cache_win, const float* winrows, int seq, int kp) {
    if (seq < BATCH) return kp >= 0 ? winrows + (size_t)(seq * SEQ + kp) * 2 * N_KV * HD : nullptr;
    const int b = seq - BATCH;
    if (kp >= PAST_LEN) return winrows + (size_t)(MP + b * DEC_SEQ + (kp - PAST_LEN)) * 2 * N_KV * HD;
    const int j = kp - (PAST_LEN - WINDOW);
    return j >= 0 ? cache_win + ((size_t)b * WINDOW + j) * 2 * N_KV * HD : nullptr;
}
__device__ inline void attn_win_item(size_t i_, const float* cache_win, const float* winrows, const float* qr, const float* gates, const float* oc, const float* os, bf16_t* o_out) {
    const int i = (int)i_;
    if (i >= MT * N_HEADS) return;
    const int m = i / N_HEADS, hh = i % N_HEADS, g = hh / HPG;
    const RowInfo ri = row_info(m);
    const float* q = qr + (size_t)m * HDM + hh * HD;
    float mx = NEGF;
    for (int kp = ri.pos - WINDOW; kp <= ri.pos; ++kp) { const float* r = win_ptr(cache_win, winrows, ri.seq, kp); if (!r) continue;
        const float* k = r + (0 * N_KV + g) * HD; float s = 0.f; for (int d = 0; d < HD; ++d) s += q[d] * k[d]; s *= 0.125f; if (s > mx) mx = s; }
    float sum = 0.f, o[HD]; for (int d = 0; d < HD; ++d) o[d] = 0.f;
    for (int kp = ri.pos - WINDOW; kp <= ri.pos; ++kp) { const float* r = win_ptr(cache_win, winrows, ri.seq, kp); if (!r) continue;
        const float* k = r + (0 * N_KV + g) * HD; float s = 0.f; for (int d = 0; d < HD; ++d) s += q[d] * k[d];
        const float e = expf(s * 0.125f - mx); sum += e; const float* v = r + (1 * N_KV + g) * HD; for (int d = 0; d < HD; ++d) o[d] += e * v[d]; }
    const float inv = 1.0f / fmaxf(sum, TINYF);
    const float* gt = gates + (size_t)m * 3 * N_HEADS + hh * 3;
    for (int d = 0; d < HD; ++d) { const size_t x = (size_t)m * HDM + hh * HD + d; o_out[x] = f2bf(gt[0] * oc[x] + gt[1] * os[x] + gt[2] * o[d] * inv); }
}


#ifndef CPU_TEST
__device__ __forceinline__ unsigned lane_id_v() { unsigned l; asm volatile("v_mbcnt_lo_u32_b32 %0, -1, 0\n\tv_mbcnt_hi_u32_b32 %0, -1, %0" : "=v"(l)); return l; }
#endif
#ifndef CPU_TEST
constexpr float RSS_SCALE = 1024.0f;
__device__ __forceinline__ unsigned rss_enc(float s) { return (unsigned)(s * RSS_SCALE + 0.5f); }
__device__ __forceinline__ float rss_dec(float rawbits) { return (float)__float_as_uint(rawbits) * (1.0f / RSS_SCALE); }
#endif
constexpr int NTHREADS = 512;
__host__ __device__ inline bf16_t f2bf_(float f) { unsigned u; memcpy(&u, &f, 4); u = (u + 0x7fffu + ((u >> 16) & 1u)) >> 16; return (bf16_t)u; }
__host__ __device__ inline float bf2f_(bf16_t b) { unsigned u = (unsigned)b << 16; float f; memcpy(&f, &u, 4); return f; }
constexpr int NRSS = 3 * DEPTH + 1;
constexpr int NPOS = SEQ + DEC_SEQ;
constexpr int QGP = ((QGW + 255) / 256) * 256;
__host__ __device__ inline int pos_index(int pos) { return pos < SEQ ? pos : SEQ + (pos - PAST_LEN); }

constexpr size_t IMG_SEQ_BYTES = (size_t)BATCH * N_KV * (SEQ / 64) * 8192, IMG_CMP_BYTES = (size_t)BATCH * N_KV * (NBC_P / 64 > 0 ? NBC_P / 64 : 1) * 8192;
struct WsMap {
    size_t ctl, rss, rope, h, hb, act, xn, t2, actf, ub, bb, zb, t1, qn, qr, gates, ob, winrows, hid, kc, vc, pbuf, oc, os, sel, scorebuf,
           w_ain, w_aout, w_bin, w_bout, w_cin, w_cout, w_qg, w_o, w_kv, qnb, qrb, ksel, vsel, kwin, vwin, kci, vci, acs, hids, acp, hidp, w1t, w2t, part, end;
};
constexpr size_t al256(size_t b) { return (b + 255) / 256 * 256; }
constexpr size_t smax(size_t a, size_t b) { return a > b ? a : b; }
constexpr WsMap make_ws_map() {
    WsMap w{}; size_t off = 0;
#define TAKE(f, bytes) w.f = off; off += al256(bytes)
    TAKE(ctl, 65536); TAKE(rss, (size_t)NRSS * MT * 4);
    TAKE(rope, (size_t)NPOS * 16 * 4);
    TAKE(h, (size_t)MT * D_MODEL * 4); TAKE(hb, (size_t)MT * D_MODEL * 2); TAKE(act, (size_t)MT * D_FF * 2);
    TAKE(xn, (size_t)MT * D_MODEL * 4); TAKE(t2, (size_t)MT * D_MODEL * 4); TAKE(actf, (size_t)MT * D_MODEL * 4);
    TAKE(ub, (size_t)MT * D_MODEL * 2); TAKE(bb, (size_t)MT * D_MODEL * 2); TAKE(zb, (size_t)MT * D_MODEL * 2);
    TAKE(t1, smax((size_t)MT * 3 * D_MODEL * 4, (size_t)MT * KVW * 4));
    TAKE(qn, (size_t)MT * HDM * 4); TAKE(qr, (size_t)MT * HDM * 4); TAKE(gates, (size_t)MT * 3 * N_HEADS * 4); TAKE(ob, (size_t)MT * HDM * 2);
    TAKE(winrows, (size_t)MT * 2 * N_KV * HD * 4); TAKE(hid, (size_t)NSEQ * NBC_MAX * 2 * N_KV * CMP_HID * 4);
    TAKE(kc, (size_t)NSEQ * NBC_MAX * N_KV * HD * 4); TAKE(vc, (size_t)NSEQ * NBC_MAX * N_KV * HD * 4);
    TAKE(pbuf, (size_t)MT * N_HEADS * NBC_MAX * 4); TAKE(oc, (size_t)MT * HDM * 4); TAKE(os, (size_t)MT * HDM * 4);
    TAKE(sel, (size_t)MT * N_KV * N_SEL * 4); TAKE(scorebuf, (size_t)MT * N_KV * NBS_MAX * 4);
    TAKE(w_ain, (size_t)DEPTH * 2 * D_FF * D_MODEL * 2); TAKE(w_aout, (size_t)DEPTH * D_MODEL * D_FF * 2);
    TAKE(w_bin, (size_t)DEPTH * 2 * D_FF * D_MODEL * 2); TAKE(w_bout, (size_t)DEPTH * D_MODEL * D_FF * 2);
    TAKE(w_cin, (size_t)N_A * 3 * D_MODEL * D_MODEL * 2); TAKE(w_cout, (size_t)N_A * D_MODEL * D_MODEL * 2);
    TAKE(w_qg, (size_t)N_B * QGP * D_MODEL * 2); TAKE(w_o, (size_t)N_B * D_MODEL * HDM * 2); TAKE(w_kv, (size_t)KVW * D_MODEL * 2);
    TAKE(qnb, (size_t)MT * HDM * 2); TAKE(qrb, (size_t)MT * HDM * 2); TAKE(ksel, IMG_SEQ_BYTES); TAKE(vsel, IMG_SEQ_BYTES); TAKE(kwin, IMG_SEQ_BYTES); TAKE(vwin, IMG_SEQ_BYTES); TAKE(kci, IMG_CMP_BYTES); TAKE(vci, IMG_CMP_BYTES);
    TAKE(acs, (size_t)2 * DEC_BATCH * (PAST_LEN / L_CMP) * N_KV * L_CMP * HD * 2); TAKE(hids, (size_t)2 * DEC_BATCH * (PAST_LEN / L_CMP) * N_KV * CMP_HID * 2);
    TAKE(acp, (size_t)2 * BATCH * NBC_P * N_KV * L_CMP * HD * 2); TAKE(hidp, (size_t)2 * BATCH * NBC_P * N_KV * CMP_HID * 2); TAKE(w1t, (size_t)2 * CMP_HID * L_CMP * HD * 2); TAKE(w2t, (size_t)2 * HD * CMP_HID * 2); TAKE(part, (size_t)8 * MS * 3 * D_MODEL * 4);
#undef TAKE
    w.end = off; return w;
}
constexpr WsMap WSM = make_ws_map();
constexpr size_t WS_ZERO_BYTES = 65536 + (((size_t)NRSS * MT * 4 + 255) / 256 * 256);

enum { CM_PLAIN = 0, CM_PAIR = 1, CM_CONV = 2, CM_HEADS = 3 };
__host__ __device__ inline int colmap(int kind, int n, int aux) {
    const int pn = n / 256, c = n % 256;
    if (kind == CM_PLAIN) return n;
    if (kind == CM_PAIR) return (c >= 128 ? aux : 0) + pn * 128 + (c % 128);
    if (kind == CM_CONV) { if (n < 2 * D_MODEL) return (c >= 128 ? 2 * D_MODEL : D_MODEL) + pn * 128 + (c % 128); return n - 2 * D_MODEL; }
    if (n < aux * 64) { const int bj = c / 128, wc = (c % 128) / 32, r = c % 32; return (pn * 4 + wc) * 64 + 32 * bj + r; }
    return n;
}
__device__ inline void wconv_item(size_t i_, const float* src, int Nsrc, const float* gain, bf16_t* dst, int Nd, int K, int kind, int aux) {
    const int n = (int)(i_ % Nd), kb = (int)(i_ / Nd);
    const int col = colmap(kind, n, aux);
    bf16_t* d = dst + (size_t)n * K + (size_t)kb * 64;
    if (col < 0 || col >= Nsrc) { for (int k = 0; k < 64; ++k) d[k] = 0; return; }
    const float* s = src + (size_t)kb * 64 * Nsrc + col;
#pragma unroll 8
    for (int k = 0; k < 64; k += 2) {
        const float g0 = gain ? gain[kb * 64 + k] : 1.f, g1 = gain ? gain[kb * 64 + k + 1] : 1.f;
        const unsigned lo = f2bf(s[(size_t)k * Nsrc] * g0), hi = f2bf(s[(size_t)(k + 1) * Nsrc] * g1);
        *(unsigned*)(d + k) = lo | (hi << 16);
    }
}
__device__ inline void rope_item(size_t i_, float* rope) {
    const int pi = (int)(i_ / 8), f = (int)(i_ % 8);
    const int pos = pi < SEQ ? pi : PAST_LEN + (pi - SEQ);
    float c, s; rope_cs((float)pos * INV_FREQ[f], c, s);
    rope[pi * 16 + f] = c; rope[pi * 16 + 8 + f] = s;
}
__device__ inline void hinit_item(size_t i_, const float* xp, const float* xs, float* h, bf16_t* hb, float* rss0) {
    const int m = (int)i_; const float* x = m < MP ? xp + (size_t)m * D_MODEL : xs + (size_t)(m - MP) * D_MODEL;
    float s = 0.f;
    for (int k = 0; k < D_MODEL; ++k) { const float v = x[k]; s += v * v; h[(size_t)m * D_MODEL + k] = v; hb[(size_t)m * D_MODEL + k] = f2bf(v); }
    rss0[m] = s;
}
__device__ inline void hupd_item(size_t i_, float* h, const float* y, float coef, bf16_t* hb, float* rss) {
    const int m = (int)i_; float s = 0.f;
    for (int k = 0; k < D_MODEL; ++k) { const float v = h[(size_t)m * D_MODEL + k] + coef * y[(size_t)m * D_MODEL + k]; s += v * v; h[(size_t)m * D_MODEL + k] = v; hb[(size_t)m * D_MODEL + k] = f2bf(v); }
    rss[m] = s;
}
__device__ inline float dot_bf(const bf16_t* a, const bf16_t* b, int K) { float s = 0.f; for (int k = 0; k < K; ++k) s += bf2f(a[k]) * bf2f(b[k]); return s; }
__device__ inline float silu_f(float g) { return g / (1.0f + expf(-g)); }
__device__ inline void ref_ffn_in_item(size_t i_, const bf16_t* hb, const float* rss, const bf16_t* Bt, bf16_t* act) {
    const int m = (int)(i_ / D_FF), j = (int)(i_ % D_FF);
    const float rs = 1.0f / sqrtf(rss[m] / D_MODEL + EPS);
    const int ng = (j / 128) * 256 + (j % 128);
    const float g = rs * dot_bf(hb + (size_t)m * D_MODEL, Bt + (size_t)ng * D_MODEL, D_MODEL), u = rs * dot_bf(hb + (size_t)m * D_MODEL, Bt + (size_t)(ng + 128) * D_MODEL, D_MODEL);
    act[i_] = f2bf(silu_f(g) * u);
}
__device__ inline void ref_resid_row_item(size_t i_, const bf16_t* A, int K, const bf16_t* Bt, float coef, float* h, bf16_t* hb, float* rss_next, float* yout) {
    const int m = (int)i_; float s = 0.f;
    for (int c = 0; c < D_MODEL; ++c) {
        const float v = h[(size_t)m * D_MODEL + c] + coef * dot_bf(A + (size_t)m * K, Bt + (size_t)c * K, K);
        if (yout) { yout[(size_t)m * D_MODEL + c] = v; } else { h[(size_t)m * D_MODEL + c] = v; hb[(size_t)m * D_MODEL + c] = f2bf(v); s += v * v; }
    }
    if (!yout) rss_next[m] = s;
}

constexpr float QSCALE_F = 0.125f * 1.4426950408889634f;
__device__ inline void qconv_item(size_t i_, const float* qn, const float* qr, bf16_t* qnb, bf16_t* qrb) { qnb[i_] = f2bf(qn[i_] * QSCALE_F); qrb[i_] = f2bf(qr[i_] * QSCALE_F); }
__host__ __device__ inline size_t kimg_off(int kv, int d0) { return (size_t)(d0 >> 3) * 1024 + (size_t)kv * 16; }
__host__ __device__ inline size_t vimg_off(int kv, int d0) { return (size_t)(d0 >> 5) * 4096 + (size_t)(kv >> 3) * 512 + (size_t)(kv & 7) * 64 + (size_t)((d0 & 31) >> 3) * 16; }
__device__ inline void put_chunk(unsigned char* dst, const float* src) { bf16_t* d = (bf16_t*)dst; for (int k = 0; k < 8; ++k) d[k] = f2bf(src[k]); }
__device__ inline void kvimg_item(size_t i_, const float* out, const float* winrows, unsigned char* ksel, unsigned char* vsel, unsigned char* kwin, unsigned char* vwin) {
    const int c = (int)(i_ % 8), t = (int)((i_ / 8) % SEQ), g = (int)((i_ / (8 * (size_t)SEQ)) % N_KV), n = (int)(i_ / (8 * (size_t)SEQ * N_KV));
    const size_t base = (((size_t)n * N_KV + g) * (SEQ / 64) + t / 64) * 8192; const int kv = t % 64, d0 = 8 * c; const size_t m = (size_t)n * SEQ + t;
    put_chunk(ksel + base + kimg_off(kv, d0), out + O_KVP + ((m * 4 + 2) * N_KV + g) * HD + d0);
    put_chunk(vsel + base + vimg_off(kv, d0), out + O_KVP + ((m * 4 + 3) * N_KV + g) * HD + d0);
    put_chunk(kwin + base + kimg_off(kv, d0), winrows + ((m * 2 + 0) * N_KV + g) * HD + d0);
    put_chunk(vwin + base + vimg_off(kv, d0), winrows + ((m * 2 + 1) * N_KV + g) * HD + d0);
}
__device__ inline void kcimg_item(size_t i_, const float* kc, const float* vc, unsigned char* kci, unsigned char* vci) {
    const int c = (int)(i_ % 8), cb = (int)((i_ / 8) % NBC_P), g = (int)((i_ / (8 * (size_t)NBC_P)) % N_KV), n = (int)(i_ / (8 * (size_t)NBC_P * N_KV));
    const size_t base = (((size_t)n * N_KV + g) * (NBC_P / 64) + cb / 64) * 8192; const int kv = cb % 64, d0 = 8 * c;
    put_chunk(kci + base + kimg_off(kv, d0), kc + (((size_t)n * NBC_MAX + cb) * N_KV + g) * HD + d0);
    put_chunk(vci + base + vimg_off(kv, d0), vc + (((size_t)n * NBC_MAX + cb) * N_KV + g) * HD + d0);
}

constexpr int NBC_PAST = PAST_LEN / L_CMP;
constexpr int RS_CMP = DEC_BATCH * NBC_PAST * N_KV, RP_CMP = BATCH * NBC_P * N_KV;
__device__ inline void acmp_sample_item(size_t i_, const float* cache_kv, const int* page_table, const float* pe, bf16_t* A) {
    const int c8 = (int)(i_ % 8), l = (int)((i_ / 8) % L_CMP); const size_t rr = i_ / (8 * L_CMP); const int r = (int)(rr % RS_CMP), e = (int)(rr / RS_CMP);
    const int g = r % N_KV, c = (r / N_KV) % NBC_PAST, b = r / (N_KV * NBC_PAST), tok = c * L_CMP + l;
    const int page = page_table[b * N_PAGES + tok / PAGE_SIZE];
    const float* src = cache_kv + ((((size_t)page * PAGE_SIZE + tok % PAGE_SIZE) * 4 + e) * N_KV + g) * HD + 8 * c8; const float* pp = pe + ((size_t)e * L_CMP + l) * HD + 8 * c8;
    bf16_t* d = A + ((size_t)e * RS_CMP + r) * (L_CMP * HD) + l * HD + 8 * c8;
#ifndef CPU_TEST
    typedef float f4 __attribute__((ext_vector_type(4))); typedef unsigned u4 __attribute__((ext_vector_type(4)));
    const f4 a0 = __builtin_nontemporal_load((const f4*)src) + *(const f4*)pp, a1 = __builtin_nontemporal_load((const f4*)(src + 4)) + *(const f4*)(pp + 4);
    u4 w; w.x = (unsigned)f2bf(a0[0]) | ((unsigned)f2bf(a0[1]) << 16); w.y = (unsigned)f2bf(a0[2]) | ((unsigned)f2bf(a0[3]) << 16);
    w.z = (unsigned)f2bf(a1[0]) | ((unsigned)f2bf(a1[1]) << 16); w.w = (unsigned)f2bf(a1[2]) | ((unsigned)f2bf(a1[3]) << 16);
    *(u4*)d = w;
#else
    for (int k = 0; k < 8; ++k) d[k] = f2bf(src[k] + pp[k]);
#endif
}
__device__ inline void acmp_prompt_item(size_t i_, const float* out, const float* pe, bf16_t* A) {
    const int c8 = (int)(i_ % 8), l = (int)((i_ / 8) % L_CMP); const size_t rr = i_ / (8 * L_CMP); const int r = (int)(rr % RP_CMP), e = (int)(rr / RP_CMP);
    const int g = r % N_KV, c = (r / N_KV) % NBC_P, n = r / (N_KV * NBC_P), tok = c * L_CMP + l;
    const float* src = out + O_KVP + ((((size_t)n * SEQ + tok) * 4 + e) * N_KV + g) * HD + 8 * c8; const float* pp = pe + ((size_t)e * L_CMP + l) * HD + 8 * c8;
    bf16_t* d = A + ((size_t)e * RP_CMP + r) * (L_CMP * HD) + l * HD + 8 * c8;
    for (int k = 0; k < 8; ++k) d[k] = f2bf(src[k] + pp[k]);
}
__device__ inline void cmp_out_b_item(size_t i_, const bf16_t* hid, int R, int nbc, int seq0, const float* w2, const float* k_norm0, float* kc, float* vc) {
    const int r = (int)(i_ % R), e = (int)(i_ / R); const int g = r % N_KV, c = (r / N_KV) % nbc, sq = r / (N_KV * nbc);
    const bf16_t* hr = hid + ((size_t)e * R + r) * CMP_HID;
    float v[HD];
    for (int d = 0; d < HD; ++d) v[d] = 0.f;
    for (int f = 0; f < CMP_HID; ++f) { const float hf = bf2f(hr[f]); const float* w = w2 + ((size_t)e * CMP_HID + f) * HD; for (int d = 0; d < HD; ++d) v[d] += hf * w[d]; }
    if (e == 0) head_norm(v, k_norm0);
    float* o = (e == 0 ? kc : vc) + (((size_t)(seq0 + sq) * NBC_MAX + c) * N_KV + g) * HD;
    for (int d = 0; d < HD; ++d) o[d] = v[d];
}
__host__ __device__ inline int heads_row(int hidx, int d) { return (hidx / 4) * 256 + 128 * (d / 32) + 32 * (hidx % 4) + (d % 32); }
__device__ inline void conv_state_store(float* out, int layer, int m, int ch, float u) {
    const RowInfo ri = row_info(m); const int L = seq_len(ri.seq);
    if (ri.t >= L - 2) { const int j = ri.t - (L - 2);
        if (ri.seq < BATCH) out[O_CP + (((size_t)layer * BATCH + ri.seq) * 2 + j) * D_MODEL + ch] = u;
        else out[O_CS + (((size_t)layer * DEC_BATCH + (ri.seq - BATCH)) * 2 + j) * D_MODEL + ch] = u; }
}
__device__ inline void ref_conv_in_item(size_t i_, const bf16_t* hb, const float* rss, const bf16_t* Bt, bf16_t* ub, bf16_t* bb, float* out, int layer) {
    const int m = (int)(i_ / D_MODEL), j = (int)(i_ % D_MODEL);
    const float rs = 1.0f / sqrtf(rss[m] / D_MODEL + EPS); const bf16_t* a = hb + (size_t)m * D_MODEL;
    const int nc = (j / 128) * 256 + (j % 128);
    const float c = rs * dot_bf(a, Bt + (size_t)nc * D_MODEL, D_MODEL), x = rs * dot_bf(a, Bt + (size_t)(nc + 128) * D_MODEL, D_MODEL), b = rs * dot_bf(a, Bt + (size_t)(2 * D_MODEL + j) * D_MODEL, D_MODEL);
    const float u = c * x; ub[i_] = f2bf(u); bb[i_] = f2bf(b); conv_state_store(out, layer, m, j, u);
}
__device__ inline void conv_thin_item(size_t i_, const bf16_t* ub, const bf16_t* bb, const float* state  , const float* wc  , bf16_t* zb) {
    const int m = (int)(i_ / D_MODEL), ch = (int)(i_ % D_MODEL);
    const RowInfo ri = row_info(m);
    const float u0 = bf2f(ub[i_]);
    float u1, u2;
    if (ri.t >= 1) u1 = bf2f(ub[i_ - D_MODEL]); else u1 = (ri.seq < BATCH) ? 0.f : state[((size_t)(ri.seq - BATCH) * 2 + 1) * D_MODEL + ch];
    if (ri.t >= 2) u2 = bf2f(ub[i_ - 2 * D_MODEL]); else if (ri.seq < BATCH) u2 = 0.f;
    else u2 = (ri.t == 1) ? state[((size_t)(ri.seq - BATCH) * 2 + 1) * D_MODEL + ch] : state[((size_t)(ri.seq - BATCH) * 2 + 0) * D_MODEL + ch];
    zb[i_] = f2bf(bf2f(bb[i_]) * (wc[ch] * u2 + wc[D_MODEL + ch] * u1 + wc[2 * D_MODEL + ch] * u0));
}
__device__ inline void ref_qg_item(size_t i_, const bf16_t* hb, const float* rss, const bf16_t* Bt, const float* q_norm, const float* rope, float* qn, float* qr) {
    const int m = (int)(i_ / N_HEADS), hh = (int)(i_ % N_HEADS);
    const float rs = 1.0f / sqrtf(rss[m] / D_MODEL + EPS); const bf16_t* a = hb + (size_t)m * D_MODEL;
    float v[HD]; for (int d = 0; d < HD; ++d) v[d] = rs * dot_bf(a, Bt + (size_t)heads_row(hh, d) * D_MODEL, D_MODEL);
    head_norm(v, q_norm);
    for (int d = 0; d < HD; ++d) qn[(size_t)m * HDM + hh * HD + d] = v[d];
    const float* rt = rope + (size_t)pos_index(row_info(m).pos) * 16;
    for (int f = 0; f < 8; ++f) { const float x1 = v[f], x2 = v[8 + f]; v[f] = x1 * rt[f] - x2 * rt[8 + f]; v[8 + f] = x2 * rt[f] + x1 * rt[8 + f]; }
    for (int d = 0; d < HD; ++d) qr[(size_t)m * HDM + hh * HD + d] = v[d];
}
__device__ inline void ref_gates_item(size_t i_, const bf16_t* hb, const float* rss, const bf16_t* Bt, float* gates) {
    const int m = (int)(i_ / (3 * N_HEADS)), j = (int)(i_ % (3 * N_HEADS));
    const float rs = 1.0f / sqrtf(rss[m] / D_MODEL + EPS);
    const float x = rs * dot_bf(hb + (size_t)m * D_MODEL, Bt + (size_t)(HDM + j) * D_MODEL, D_MODEL);
    gates[i_] = 1.0f / (1.0f + expf(-x));
}
__device__ inline void kv_store(float* out, float* winrows, int m, int e, int g, int d, float v) {
    const RowInfo ri = row_info(m);
    if (e < 4) { if (ri.seq < BATCH) out[O_KVP + (((size_t)m * 4 + e) * N_KV + g) * HD + d] = v; else out[O_KVS + (((size_t)(m - MP) * 4 + e) * N_KV + g) * HD + d] = v; }
    else { const int we = e - 4;
        winrows[(((size_t)m * 2 + we) * N_KV + g) * HD + d] = v;
        if (ri.seq < BATCH) { if (ri.t >= SEQ - WINDOW) out[O_WP + ((((size_t)ri.seq * WINDOW + (ri.t - (SEQ - WINDOW))) * 2 + we) * N_KV + g) * HD + d] = v; }
        else out[O_WS + ((((size_t)(ri.seq - BATCH) * WINDOW + (WINDOW - DEC_SEQ + ri.t)) * 2 + we) * N_KV + g) * HD + d] = v; }
}
__device__ inline void ref_kv_item(size_t i_, const bf16_t* hb, const float* rss, const bf16_t* Bt, const float* k_norm, const float* rope, float* out, float* winrows) {
    const int m = (int)(i_ / (6 * N_KV)), hidx = (int)(i_ % (6 * N_KV)), e = hidx / N_KV, g = hidx % N_KV;
    const float rs = 1.0f / sqrtf(rss[m] / D_MODEL + EPS); const bf16_t* a = hb + (size_t)m * D_MODEL;
    float v[HD]; for (int d = 0; d < HD; ++d) v[d] = rs * dot_bf(a, Bt + (size_t)heads_row(hidx, d) * D_MODEL, D_MODEL);
    if (e == 2 || e == 4) { head_norm(v, k_norm + (e == 2 ? 1 : 2) * HD);
        const float* rt = rope + (size_t)pos_index(row_info(m).pos) * 16;
        for (int f = 0; f < 8; ++f) { const float x1 = v[f], x2 = v[8 + f]; v[f] = x1 * rt[f] - x2 * rt[8 + f]; v[8 + f] = x2 * rt[f] + x1 * rt[8 + f]; } }
    for (int d = 0; d < HD; ++d) kv_store(out, winrows, m, e, g, d, v[d]);
}
#ifndef CPU_TEST
#define LAS __attribute__((address_space(3)))
#define XB_TMO      128
#define XB_XCNT(j)  (256  + 64 * (j))
#define XB_XSUB(j)  (1280 + 64 * (j))
#define XB_XGEN(j)  (2304 + 64 * (j))
#define XB_TOP      3328
#define XB_TOPGEN   3392
#define XCD_BAR_WORDS 3456
#define XB_SPIN_CAP (1u << 25)
typedef __attribute__((address_space(1))) unsigned GU;
__device__ __forceinline__ unsigned xb_ld(GU* p)              { return __hip_atomic_load(p, __ATOMIC_RELAXED, __HIP_MEMORY_SCOPE_AGENT); }
__device__ __forceinline__ unsigned xb_add(GU* p, unsigned v) { return __hip_atomic_fetch_add(p, v, __ATOMIC_RELAXED, __HIP_MEMORY_SCOPE_AGENT); }
__device__ __forceinline__ unsigned xb_xcc_id() { return (unsigned)__builtin_amdgcn_s_getreg((3 << 11) | 20) & 0xFu; }
#define XB_SPIN(cond, bar) do { unsigned _sp = 0; while (cond) { __builtin_amdgcn_s_sleep(1); \
    if ((++_sp & 255u) == 0u) { if (xb_ld(&(bar)[XB_TMO])) break; if (_sp > XB_SPIN_CAP) { (void)xb_add(&(bar)[XB_TMO], 1u); break; } } } } while (0)
struct XcdBarrier { GU* bar; unsigned x; volatile LAS unsigned* st; };
__device__ __forceinline__ XcdBarrier xcd_barrier_post(GU* bar, volatile LAS unsigned* st, const bool leader_thread) {
    XcdBarrier b; b.bar = bar; b.x = xb_xcc_id(); b.st = st;
    if (leader_thread) (void)xb_add(&bar[XB_XCNT(b.x)], 1u);
    return b;
}
__device__ __forceinline__ void xcd_barrier_complete(GU* bar, unsigned x, unsigned& nloc, unsigned& nx) {
    const unsigned G = gridDim.x * gridDim.y * gridDim.z;
    unsigned sum, cnt, mine, sp = 0u;
    for (;;) {
        sum = 0u; cnt = 0u; mine = 0u;
#pragma unroll
        for (unsigned j = 0; j < 16; ++j) { const unsigned c = xb_ld(&bar[XB_XCNT(j)]); sum += c; cnt += (c > 0u) ? 1u : 0u; mine = (j == x) ? c : mine; }
        if (sum == G) break;
        __builtin_amdgcn_s_sleep(1);
        if ((++sp & 255u) == 0u) { if (xb_ld(&bar[XB_TMO])) break; if (sp > XB_SPIN_CAP) { (void)xb_add(&bar[XB_TMO], 1u); break; } }
    }
    nloc = mine > 0u ? mine : 1u; nx = cnt > 0u ? cnt : 1u;
}
__device__ __forceinline__ void xcd_barrier(const XcdBarrier& b, const bool leader_thread) {
    asm volatile("s_waitcnt vmcnt(0)" ::: "memory");
    __syncthreads();
    if (leader_thread) {
        GU* bar = b.bar; unsigned bx = xb_xcc_id(); asm volatile("" : "+s"(bx));
        __builtin_amdgcn_s_waitcnt(0);
        unsigned nloc = b.st[0], nx = b.st[1];
        if (nloc == 0u) { xcd_barrier_complete(bar, bx, nloc, nx); b.st[0] = nloc; b.st[1] = nx; }
        const unsigned old = xb_add(&bar[XB_XSUB(bx)], 1u);
        const unsigned gen = old / nloc;
        if (old + 1u == (gen + 1u) * nloc) {
            __builtin_amdgcn_fence(__ATOMIC_RELEASE, "agent");
            asm volatile("s_waitcnt vmcnt(0)" ::: "memory");
            const unsigned og = xb_add(&bar[XB_TOP], 1u);
            const unsigned tg = og / nx;
            if (og + 1u == (tg + 1u) * nx) xb_add(&bar[XB_TOPGEN], 1u);
            else XB_SPIN(xb_ld(&bar[XB_TOPGEN]) == tg, bar);
            __builtin_amdgcn_fence(__ATOMIC_ACQUIRE, "agent");
            xb_add(&bar[XB_XGEN(bx)], 1u);
            asm volatile("s_waitcnt vmcnt(0)" ::: "memory");
        } else {
            XB_SPIN(xb_ld(&bar[XB_XGEN(bx)]) == gen, bar);
            __builtin_amdgcn_fence(__ATOMIC_ACQUIRE, "agent");
            asm volatile("s_waitcnt vmcnt(0)" ::: "memory");
        }
    }
    __syncthreads();
}

namespace pg8 {
#define PG8_LAS __attribute__((address_space(3)))
typedef unsigned short bf16_t;
typedef short bf16x8 __attribute__((ext_vector_type(8)));
typedef float f32x4 __attribute__((ext_vector_type(4)));
typedef unsigned u32x4 __attribute__((ext_vector_type(4)));
constexpr int BM = 256, BK = 64, HALF = 128, HTB = HALF * BK * 2  , STAGE_BYTES = 8 * HTB, NXCD = 8, WGM = 8;

__host__ __device__ __forceinline__ int lds_byte(int r, int c) { const int st = (r >> 4) * 2 + (c >> 5), rr = r & 15, cc = c & 31, ob = rr * 64 + cc * 2; return st * 1024 + (ob ^ (((ob >> 9) & 1) << 5)); }
__host__ __device__ __forceinline__ void stage_rc(int b, int& R, int& C) { const int st = b / 1024, sb = b % 1024, swz = sb ^ (((sb >> 9) & 1) << 5); R = (st >> 1) * 16 + swz / 64; C = (st & 1) * 32 + (swz % 64) / 2; }
__host__ __device__ __forceinline__ int perm32(int rho) { const int n = rho >> 4, i = rho & 15; return 8 * (i >> 2) + 4 * n + (i & 3); }

struct Unit { int pm, pn; };
struct Gemm { const bf16_t* A; const bf16_t* Bt; int M, N, K; };

struct StaticOrder {
    int nM, nN, nwg, G, c;
    __host__ __device__ void init(int M, int N, int G_, int c_) { nM = M / BM; nN = N / BM; nwg = nM * nN; G = G_; c = c_; }
    __host__ __device__ bool next(int i, Unit& u) const {
        const long L = (long)i * G + c; if (L >= nwg) return false;
        int wgid = (int)L; { const int q = nwg / NXCD, r = nwg % NXCD, xcd = wgid % NXCD, off = wgid / NXCD; wgid = (xcd < r ? xcd * (q + 1) : r * (q + 1) + (xcd - r) * q) + off; }
        const int nig = WGM * nN, gid = wgid / nig, fm = gid * WGM, gsz = (nM - fm) < WGM ? (nM - fm) : WGM;
        u.pm = fm + ((wgid % nig) % gsz); u.pn = (wgid % nig) / gsz; return true;
    }
    __device__ __forceinline__ void a_ready(const Unit&) const {}
    __device__ __forceinline__ void done(const Unit&) const {}
};

__device__ __forceinline__ unsigned cvt_pk_bf16(float lo, float hi) { unsigned r; asm volatile("v_cvt_pk_bf16_f32 %0, %1, %2" : "=v"(r) : "v"(lo), "v"(hi)); return r; }
template <class Epi, class Sched, bool ALIGN_EPI = false, bool SP2 = false>
__device__ __forceinline__ void gemm_phase(int wave_id_, PG8_LAS unsigned char* lds, const Gemm g, const Sched& S, const Epi& E) {
    int wid = wave_id_, lane = (int)lane_id_v(); asm volatile("" : "+s"(wid));
    const int tid = wid * 64 + lane, wr = wid >> 2, wc = wid & 3, fr = lane & 15, fq = lane >> 4;
    const int K = g.K, nt = K / BK;
    unsigned voffA[2], voffB[2];
#pragma unroll
    for (int i = 0; i < 2; ++i) { int R, C; stage_rc(tid * 16 + i * 8192, R, C); const int Rb = Epi::PERM ? ((R & ~31) + perm32(R & 31)) : R;
        voffA[i] = (unsigned)(R * K + C) * 2u; voffB[i] = (unsigned)(Rb * K + C) * 2u; }
    const size_t kstep = (size_t)(BK * 2);
    const size_t hstep = (size_t)HALF * K * 2;
    const size_t tstep = 2 * hstep;
    const unsigned ldsw = (unsigned)wid * 1024u;
    const int aoff = lds_byte(wr * 64 + fr, fq * 8), boff = lds_byte(wc * 32 + fr, fq * 8);
#define PG8_SA(b, h) (((b) * 2 + (h)) * HTB)
#define PG8_SB(b, h) ((4 + (b) * 2 + (h)) * HTB)
#define PG8_STAGE(bufoff, gbase, voff) do { _Pragma("unroll") for (int _i = 0; _i < 2; ++_i) \
        __builtin_amdgcn_global_load_lds((const unsigned*)((const char*)(gbase) + (voff)[_i]), (PG8_LAS unsigned*)(lds + (bufoff) + ldsw + _i * 8192), 16, 0, 0); } while (0)
#define PG8_LDA(dst, b, h) do { _Pragma("unroll") for (int m = 0; m < 4; ++m) _Pragma("unroll") for (int k = 0; k < 2; ++k) dst[m][k] = *(const PG8_LAS bf16x8*)(lds + PG8_SA(b, h) + aoff + m * 2048 + k * 1024); } while (0)
#define PG8_LDB(dst, b, h) do { _Pragma("unroll") for (int n = 0; n < 2; ++n) _Pragma("unroll") for (int k = 0; k < 2; ++k) dst[n][k] = *(const PG8_LAS bf16x8*)(lds + PG8_SB(b, h) + boff + n * 2048 + k * 1024); } while (0)
#define PG8_MMA(ai, bj, At, Bt) do { __builtin_amdgcn_s_setprio(1); _Pragma("unroll") for (int m = 0; m < 4; ++m) _Pragma("unroll") for (int n = 0; n < 2; ++n) _Pragma("unroll") for (int k = 0; k < 2; ++k) \
        acc[ai][bj][m][n] = __builtin_amdgcn_mfma_f32_16x16x32_bf16(Bt[n][k], At[m][k], acc[ai][bj][m][n], 0, 0, 0); __builtin_amdgcn_s_setprio(0); } while (0)
#define PG8_WAIT_V(n) asm volatile("s_waitcnt vmcnt(" #n ")" ::: "memory")
#define PG8_WAIT_L(n) asm volatile("s_waitcnt lgkmcnt(" #n ")" ::: "memory")
#define PG8_BAR __builtin_amdgcn_s_barrier()
#define PG8_SCHED __builtin_amdgcn_sched_barrier(0)
    Unit cur, nxt; int ui = 0; float rsv[8];
#pragma unroll
    for (int i_ = 0; i_ < 8; ++i_) rsv[i_] = 0.f;
    if (!S.next(0, cur)) return;
    f32x4 acc[2][2][4][2];
    if constexpr (Epi::ACC_INIT) E.init_acc(acc, cur, wr, wc, fr, fq);
    else {
#pragma unroll
    for (int a = 0; a < 2; ++a)
#pragma unroll
        for (int b = 0; b < 2; ++b)
#pragma unroll
            for (int m = 0; m < 4; ++m)
#pragma unroll
                for (int n = 0; n < 2; ++n) acc[a][b][m][n] = (f32x4){0.f, 0.f, 0.f, 0.f};
    }
    bf16x8 At[4][2], B0[2][2], B1[2][2];
    const char* cA = (const char*)g.A + (size_t)cur.pm * tstep; const char* cB = (const char*)g.Bt + (size_t)cur.pn * tstep;
    S.a_ready(cur);
    if constexpr (SP2) {
        PG8_STAGE(PG8_SB(0, 0), cB, voffB); PG8_STAGE(PG8_SB(0, 1), cB + hstep, voffB); PG8_STAGE(PG8_SA(0, 0), cA, voffA); PG8_STAGE(PG8_SA(0, 1), cA + hstep, voffA);
        if (wr == 1) PG8_BAR;
        PG8_WAIT_V(2); PG8_BAR;
        PG8_STAGE(PG8_SB(1, 0), cB + kstep, voffB); PG8_STAGE(PG8_SA(1, 0), cA + kstep, voffA); PG8_STAGE(PG8_SB(1, 1), cB + hstep + kstep, voffB);
        PG8_WAIT_V(6); PG8_BAR;
    } else {
        PG8_STAGE(PG8_SB(0, 0), cB, voffB); PG8_STAGE(PG8_SA(0, 0), cA, voffA); PG8_STAGE(PG8_SB(0, 1), cB + hstep, voffB); PG8_STAGE(PG8_SA(0, 1), cA + hstep, voffA);
        if (wr == 1) PG8_BAR;
        PG8_WAIT_V(4); PG8_BAR;
        PG8_STAGE(PG8_SB(1, 0), cB + kstep, voffB); PG8_STAGE(PG8_SA(1, 0), cA + kstep, voffA); PG8_STAGE(PG8_SB(1, 1), cB + hstep + kstep, voffB);
        PG8_WAIT_V(6); PG8_BAR;
    }
    for (;;) {
        const bool has_next = S.next(ui + 1, nxt);
        const char* nA = has_next ? (const char*)g.A + (size_t)nxt.pm * tstep : cA; const char* nB = has_next ? (const char*)g.Bt + (size_t)nxt.pn * tstep : cB;
        for (int t = 0; t < nt; t += 2) {
            const bool last = (t == nt - 2);
            const char* a1 = cA + (size_t)(t + 1) * kstep;
            const char* a2 = last ? nA : cA + (size_t)(t + 2) * kstep; const char* b2 = last ? nB : cB + (size_t)(t + 2) * kstep;
            const char* a3 = a2 + kstep; const char* b3 = b2 + kstep;
            if (last && has_next) S.a_ready(nxt);
            if (last) E.pre(cur, wr, fr, rsv);
            if constexpr (SP2) {
            PG8_LDB(B0, 0, 0); PG8_LDB(B1, 0, 1); PG8_SCHED; PG8_LDA(At, 0, 0); PG8_STAGE(PG8_SA(1, 1), a1 + hstep, voffA);
            PG8_WAIT_V(8); PG8_WAIT_L(0); PG8_BAR; PG8_MMA(0, 0, At, B0); PG8_MMA(0, 1, At, B1); PG8_BAR; PG8_SCHED;
            PG8_LDA(At, 0, 1); PG8_STAGE(PG8_SB(0, 0), b2, voffB); PG8_STAGE(PG8_SB(0, 1), b2 + hstep, voffB); PG8_STAGE(PG8_SA(0, 0), a2, voffA);
            PG8_WAIT_V(8); PG8_WAIT_L(0); PG8_BAR; PG8_MMA(1, 0, At, B0); PG8_MMA(1, 1, At, B1); PG8_BAR; PG8_SCHED;
            PG8_LDB(B0, 1, 0); PG8_LDB(B1, 1, 1); PG8_SCHED; PG8_LDA(At, 1, 0); PG8_STAGE(PG8_SA(0, 1), a2 + hstep, voffA);
            PG8_WAIT_V(8); PG8_WAIT_L(0); PG8_BAR; PG8_MMA(0, 0, At, B0); PG8_MMA(0, 1, At, B1); PG8_BAR; PG8_SCHED;
            PG8_LDA(At, 1, 1); PG8_STAGE(PG8_SB(1, 0), b3, voffB); PG8_STAGE(PG8_SB(1, 1), b3 + hstep, voffB); PG8_STAGE(PG8_SA(1, 0), a3, voffA);
            PG8_WAIT_V(8); PG8_WAIT_L(0); PG8_BAR; PG8_MMA(1, 0, At, B0); PG8_MMA(1, 1, At, B1); PG8_BAR; PG8_SCHED;
            } else {
            PG8_LDB(B0, 0, 0); PG8_SCHED; PG8_LDA(At, 0, 0); PG8_STAGE(PG8_SA(1, 1), a1 + hstep, voffA);
            PG8_WAIT_L(8); PG8_BAR; PG8_WAIT_L(0); PG8_MMA(0, 0, At, B0); PG8_BAR; PG8_SCHED;
            PG8_LDB(B1, 0, 1); PG8_STAGE(PG8_SB(0, 0), b2, voffB);
            PG8_BAR; PG8_WAIT_L(0); PG8_MMA(0, 1, At, B1); PG8_BAR;
            PG8_LDA(At, 0, 1); PG8_STAGE(PG8_SA(0, 0), a2, voffA);
            PG8_BAR; PG8_WAIT_L(0); PG8_MMA(1, 0, At, B0); PG8_BAR; PG8_SCHED;
            PG8_STAGE(PG8_SB(0, 1), b2 + hstep, voffB);
            PG8_WAIT_V(6); PG8_BAR; PG8_MMA(1, 1, At, B1); PG8_BAR;
            PG8_LDB(B0, 1, 0); PG8_SCHED; PG8_LDA(At, 1, 0); PG8_STAGE(PG8_SA(0, 1), a2 + hstep, voffA);
            PG8_WAIT_L(8); PG8_BAR; PG8_WAIT_L(0); PG8_MMA(0, 0, At, B0); PG8_BAR; PG8_SCHED;
            PG8_LDB(B1, 1, 1); PG8_STAGE(PG8_SB(1, 0), b3, voffB);
            PG8_BAR; PG8_WAIT_L(0); PG8_MMA(0, 1, At, B1); PG8_BAR;
            PG8_LDA(At, 1, 1); PG8_STAGE(PG8_SA(1, 0), a3, voffA);
            PG8_BAR; PG8_WAIT_L(0); PG8_MMA(1, 0, At, B0); PG8_BAR; PG8_SCHED;
            PG8_STAGE(PG8_SB(1, 1), b3 + hstep, voffB);
            PG8_WAIT_V(6); PG8_BAR; PG8_MMA(1, 1, At, B1); PG8_BAR;
            }
        }
        if constexpr (ALIGN_EPI) { if (wr == 0) PG8_BAR; }
        if constexpr (!Epi::AFTER_DRAIN) { E(acc, cur, wr, wc, fr, fq, rsv); S.done(cur); }
        if (!has_next) break;
        if constexpr (Epi::ACC_INIT) E.init_acc(acc, nxt, wr, wc, fr, fq);
        else {
#pragma unroll
        for (int a = 0; a < 2; ++a)
#pragma unroll
            for (int b = 0; b < 2; ++b)
#pragma unroll
                for (int m = 0; m < 4; ++m)
#pragma unroll
                    for (int n = 0; n < 2; ++n) acc[a][b][m][n] = (f32x4){0.f, 0.f, 0.f, 0.f};
        }
        cur = nxt; cA = nA; cB = nB; ++ui;
        if constexpr (ALIGN_EPI) { if (wr == 1) PG8_BAR; }
    }
    PG8_WAIT_V(0);
    if constexpr (!ALIGN_EPI) { if (wr == 0) PG8_BAR; }
    PG8_BAR;
    if constexpr (Epi::AFTER_DRAIN) { E.fused(acc, cur, wr, wc, fr, fq, lds, wid, lane); S.done(cur); }
#undef PG8_SA
#undef PG8_SB
#undef PG8_STAGE
#undef PG8_LDA
#undef PG8_LDB
#undef PG8_MMA
#undef PG8_WAIT_V
#undef PG8_WAIT_L
#undef PG8_BAR
#undef PG8_SCHED
}
}

namespace pg8 {
__device__ __forceinline__ float fast_silu(float g) { return g * __builtin_amdgcn_rcpf(1.0f + __expf(-g)); }
__device__ __forceinline__ float row_rs(const float* rss, int row) { return rsqrtf(rss_dec(rss[row]) * (1.0f / D_MODEL) + EPS); }
struct EpiSwiglu {
    static constexpr bool PERM = true, AFTER_DRAIN = false, ACC_INIT = false;
    bf16_t* act; const float* rss;
    __device__ __forceinline__ void pre(const Unit& u, int wr, int fr, float (&rsv)[8]) const {
        const __attribute__((address_space(1))) float* rp = (const __attribute__((address_space(1))) float*)rss + u.pm * BM + wr * 64 + fr;
#pragma unroll
        for (int ai = 0; ai < 2; ++ai)
#pragma unroll
            for (int m = 0; m < 4; ++m) rsv[ai * 4 + m] = rp[ai * HALF + m * 16];
    }
    __device__ __forceinline__ void operator()(const f32x4 (&acc)[2][2][4][2], const Unit& u, int wr, int wc, int fr, int fq, const float (&rsv)[8]) const {
        const int row0 = u.pm * BM + wr * 64 + fr, col0 = u.pn * 128 + wc * 32 + 8 * fq;
#pragma unroll
        for (int ai = 0; ai < 2; ++ai)
#pragma unroll
            for (int m = 0; m < 4; ++m) {
                const int row = row0 + ai * HALF + m * 16; const float rs = rsqrtf(rss_dec(rsv[ai * 4 + m]) * (1.0f / D_MODEL) + EPS);
                float a[8];
#pragma unroll
                for (int n = 0; n < 2; ++n)
#pragma unroll
                    for (int i = 0; i < 4; ++i) a[n * 4 + i] = fast_silu(acc[ai][0][m][n][i] * rs) * (acc[ai][1][m][n][i] * rs);
                u32x4 w; w.x = cvt_pk_bf16(a[0], a[1]); w.y = cvt_pk_bf16(a[2], a[3]); w.z = cvt_pk_bf16(a[4], a[5]); w.w = cvt_pk_bf16(a[6], a[7]);
                *(u32x4*)(act + (size_t)row * D_FF + col0) = w;
            }
    }
};
struct EpiResid {
    static constexpr bool PERM = true, AFTER_DRAIN = false, ACC_INIT = true;
    bf16_t* hb; float* rss_next; float* yout; float coef;
    __device__ __forceinline__ void pre(const Unit&, int, int, float (&)[8]) const {}
    __device__ __forceinline__ void init_acc(f32x4 (&acc)[2][2][4][2], const Unit& u, int wr, int wc, int fr, int fq) const {
        const __attribute__((address_space(1))) bf16_t* hp = (const __attribute__((address_space(1))) bf16_t*)hb + (size_t)(u.pm * BM + wr * 64 + fr) * D_MODEL + u.pn * BM + wc * 32 + 8 * fq;
        const float ic = 1.0f / coef;
#pragma unroll
        for (int ai = 0; ai < 2; ++ai)
#pragma unroll
            for (int m = 0; m < 4; ++m)
#pragma unroll
                for (int bj = 0; bj < 2; ++bj) {
                    const u32x4 w = *(const __attribute__((address_space(1))) u32x4*)(hp + (size_t)(ai * HALF + m * 16) * D_MODEL + bj * HALF);
                    acc[ai][bj][m][0] = (f32x4){__uint_as_float(w.x << 16), __uint_as_float(w.x & 0xffff0000u), __uint_as_float(w.y << 16), __uint_as_float(w.y & 0xffff0000u)} * ic;
                    acc[ai][bj][m][1] = (f32x4){__uint_as_float(w.z << 16), __uint_as_float(w.z & 0xffff0000u), __uint_as_float(w.w << 16), __uint_as_float(w.w & 0xffff0000u)} * ic;
                }
    }
    __device__ __forceinline__ void operator()(const f32x4 (&acc)[2][2][4][2], const Unit& u, int wr, int wc, int fr, int fq, const float (&rsv)[8]) const {
        const int row0 = u.pm * BM + wr * 64 + fr, col0 = u.pn * BM + wc * 32 + 8 * fq;
#pragma unroll
        for (int ai = 0; ai < 2; ++ai)
#pragma unroll
            for (int m = 0; m < 4; ++m) {
                const int row = row0 + ai * HALF + m * 16; float s = 0.f;
#pragma unroll
                for (int bj = 0; bj < 2; ++bj) {
                    const f32x4 v0 = acc[ai][bj][m][0] * coef, v1 = acc[ai][bj][m][1] * coef;
                    const size_t o = (size_t)row * D_MODEL + col0 + bj * HALF;
                    if (yout) { *(f32x4*)(yout + o) = v0; *(f32x4*)(yout + o + 4) = v1; }
                    else {
                        u32x4 w; w.x = cvt_pk_bf16(v0[0], v0[1]); w.y = cvt_pk_bf16(v0[2], v0[3]); w.z = cvt_pk_bf16(v1[0], v1[1]); w.w = cvt_pk_bf16(v1[2], v1[3]);
                        *(u32x4*)(hb + o) = w;
                        s += ((v0[0] * v0[0] + v0[1] * v0[1]) + (v0[2] * v0[2] + v0[3] * v0[3])) + ((v1[0] * v1[0] + v1[1] * v1[1]) + (v1[2] * v1[2] + v1[3] * v1[3]));
                    }
                }
                if (!yout) { s += __shfl_xor(s, 16); s += __shfl_xor(s, 32); if (fq == 0) (void)__hip_atomic_fetch_add((unsigned*)rss_next + row, rss_enc(s), __ATOMIC_RELAXED, __HIP_MEMORY_SCOPE_AGENT); }
            }
    }
};
}
namespace pg8 {
__device__ __forceinline__ float sum4(f32x4 v) { return (v[0] * v[0] + v[1] * v[1]) + (v[2] * v[2] + v[3] * v[3]); }
struct EpiConvIn {
    static constexpr bool PERM = true, AFTER_DRAIN = false, ACC_INIT = false;
    bf16_t* ub; bf16_t* bb; const float* rss; float* out; int layer;
    __device__ __forceinline__ void pre(const Unit& u, int wr, int fr, float (&rsv)[8]) const {
        const __attribute__((address_space(1))) float* rp = (const __attribute__((address_space(1))) float*)rss + u.pm * BM + wr * 64 + fr;
#pragma unroll
        for (int ai = 0; ai < 2; ++ai)
#pragma unroll
            for (int m = 0; m < 4; ++m) rsv[ai * 4 + m] = rp[ai * HALF + m * 16];
    }
    __device__ __forceinline__ void operator()(const f32x4 (&acc)[2][2][4][2], const Unit& u, int wr, int wc, int fr, int fq, const float (&rsv)[8]) const {
        const int row0 = u.pm * BM + wr * 64 + fr;
        const bool pair = u.pn < D_MODEL / 128;
#pragma unroll
        for (int ai = 0; ai < 2; ++ai)
#pragma unroll
            for (int m = 0; m < 4; ++m) {
                const int row = row0 + ai * HALF + m * 16; const float rs = rsqrtf(rss_dec(rsv[ai * 4 + m]) * (1.0f / D_MODEL) + EPS);
                if (pair) {
                    const int col0 = u.pn * 128 + wc * 32 + 8 * fq; float a[8];
#pragma unroll
                    for (int n = 0; n < 2; ++n)
#pragma unroll
                        for (int i = 0; i < 4; ++i) a[n * 4 + i] = (acc[ai][0][m][n][i] * rs) * (acc[ai][1][m][n][i] * rs);
                    u32x4 w; w.x = cvt_pk_bf16(a[0], a[1]); w.y = cvt_pk_bf16(a[2], a[3]); w.z = cvt_pk_bf16(a[4], a[5]); w.w = cvt_pk_bf16(a[6], a[7]);
                    *(u32x4*)(ub + (size_t)row * D_MODEL + col0) = w;
                    const RowInfo ri = row_info(row); const int jj = ri.t - (seq_len(ri.seq) - 2);
                    if (jj >= 0) {
                        float* cs = (ri.seq < BATCH) ? out + O_CP + (((size_t)layer * BATCH + ri.seq) * 2 + jj) * D_MODEL + col0 : out + O_CS + (((size_t)layer * DEC_BATCH + (ri.seq - BATCH)) * 2 + jj) * D_MODEL + col0;
                        *(f32x4*)(cs) = (f32x4){a[0], a[1], a[2], a[3]}; *(f32x4*)(cs + 4) = (f32x4){a[4], a[5], a[6], a[7]};
                    }
                } else {
#pragma unroll
                    for (int bj = 0; bj < 2; ++bj) {
                        const int col0 = (u.pn - D_MODEL / 128) * 256 + bj * HALF + wc * 32 + 8 * fq;
                        const f32x4 v0 = acc[ai][bj][m][0] * rs, v1 = acc[ai][bj][m][1] * rs;
                        u32x4 w; w.x = cvt_pk_bf16(v0[0], v0[1]); w.y = cvt_pk_bf16(v0[2], v0[3]); w.z = cvt_pk_bf16(v1[0], v1[1]); w.w = cvt_pk_bf16(v1[2], v1[3]);
                        *(u32x4*)(bb + (size_t)row * D_MODEL + col0) = w;
                    }
                }
                asm volatile("" ::: "memory");
            }
    }
};
__device__ __forceinline__ void head_norm_rope(f32x4 (&v)[2][2], const float* gain, const float* rt  , int fq, bool do_norm, bool do_rope, f32x4 (&rot0)[2]) {
    if (do_norm) {
        float ss = (sum4(v[0][0]) + sum4(v[0][1])) + (sum4(v[1][0]) + sum4(v[1][1]));
        ss += __shfl_xor(ss, 16); ss += __shfl_xor(ss, 32);
        const float r = rsqrtf(ss * (1.0f / HD) + EPS);
#pragma unroll
        for (int bj = 0; bj < 2; ++bj)
#pragma unroll
            for (int n = 0; n < 2; ++n) { const f32x4 g = *(const f32x4*)(gain + 32 * bj + 8 * fq + 4 * n); v[bj][n] = v[bj][n] * r * g; }
    }
    rot0[0] = v[0][0]; rot0[1] = v[0][1];
    if (do_rope) {
#pragma unroll
        for (int n = 0; n < 2; ++n) {
            f32x4 p;
#pragma unroll
            for (int i = 0; i < 4; ++i) p[i] = __shfl_xor(v[0][n][i], 16);
            const f32x4 c = *(const f32x4*)(rt + 4 * n), s = *(const f32x4*)(rt + 8 + 4 * n);
            if (fq == 0) rot0[n] = v[0][n] * c - p * s; else if (fq == 1) rot0[n] = v[0][n] * c + p * s;
        }
    }
}
__device__ __forceinline__ u32x4 pack8(const f32x4 a, const f32x4 b, float sc) { u32x4 w; w.x = cvt_pk_bf16(a[0] * sc, a[1] * sc); w.y = cvt_pk_bf16(a[2] * sc, a[3] * sc); w.z = cvt_pk_bf16(b[0] * sc, b[1] * sc); w.w = cvt_pk_bf16(b[2] * sc, b[3] * sc); return w; }
struct EpiQG {
    static constexpr bool PERM = true, AFTER_DRAIN = false, ACC_INIT = false;
    bf16_t* qnb; bf16_t* qrb; float* gates; const float* rss; const float* q_norm; const float* rope;
    __device__ __forceinline__ void pre(const Unit& u, int wr, int fr, float (&rsv)[8]) const {
        const __attribute__((address_space(1))) float* rp = (const __attribute__((address_space(1))) float*)rss + u.pm * BM + wr * 64 + fr;
#pragma unroll
        for (int ai = 0; ai < 2; ++ai)
#pragma unroll
            for (int m = 0; m < 4; ++m) rsv[ai * 4 + m] = rp[ai * HALF + m * 16];
    }
    __device__ __forceinline__ void operator()(const f32x4 (&acc)[2][2][4][2], const Unit& u, int wr, int wc, int fr, int fq, const float (&rsv)[8]) const {
        const int row0 = u.pm * BM + wr * 64 + fr;
#pragma unroll
        for (int ai = 0; ai < 2; ++ai)
#pragma unroll
            for (int m = 0; m < 4; ++m) {
                const int row = row0 + ai * HALF + m * 16; const float rs = rsqrtf(rss_dec(rsv[ai * 4 + m]) * (1.0f / D_MODEL) + EPS);
                if (u.pn < N_HEADS / 4) {
                    const int hh = u.pn * 4 + wc;
                    f32x4 v[2][2] = {{acc[ai][0][m][0] * rs, acc[ai][0][m][1] * rs}, {acc[ai][1][m][0] * rs, acc[ai][1][m][1] * rs}}; f32x4 rot0[2];
                    head_norm_rope(v, q_norm, rope + (size_t)pos_index(row_info(row).pos) * 16, fq, true, true, rot0);
                    const size_t o = (size_t)row * HDM + hh * HD + 8 * fq;
                    const u32x4 hi8 = pack8(v[1][0], v[1][1], QSCALE_F);
                    *(u32x4*)(qnb + o) = pack8(v[0][0], v[0][1], QSCALE_F); *(u32x4*)(qnb + o + 32) = hi8;
                    *(u32x4*)(qrb + o) = pack8(rot0[0], rot0[1], QSCALE_F); *(u32x4*)(qrb + o + 32) = hi8;
                } else {
                    const int c0 = wc * 32 + 8 * fq;
#pragma unroll
                    for (int n = 0; n < 2; ++n)
#pragma unroll
                        for (int i = 0; i < 4; ++i) { const int c = c0 + 4 * n + i; if (c < 3 * N_HEADS) gates[(size_t)row * 3 * N_HEADS + c] = __builtin_amdgcn_rcpf(1.0f + __expf(-(acc[ai][0][m][n][i] * rs))); }
                }
                asm volatile("" ::: "memory");
            }
    }
};
struct EpiKV {
    static constexpr bool PERM = true, AFTER_DRAIN = false, ACC_INIT = false;
    float* out; float* winrows; const float* rss; const float* k_norm; const float* rope;
    unsigned char* ksel; unsigned char* vsel; unsigned char* kwin; unsigned char* vwin; bf16_t* acp; const float* pe;
    __device__ __forceinline__ void pre(const Unit&, int, int, float (&)[8]) const {}
    __device__ __forceinline__ void operator()(const f32x4 (&acc)[2][2][4][2], const Unit& u, int wr, int wc, int fr, int fq, const float (&rsv)[8]) const {
        const int row0 = u.pm * BM + wr * 64 + fr;
        const int hidx = u.pn * 4 + wc, e = hidx / N_KV, g = hidx % N_KV; const bool nr = (e == 2 || e == 4);
#pragma unroll
        for (int ai = 0; ai < 2; ++ai)
#pragma unroll
            for (int m = 0; m < 4; ++m) {
                const int row = row0 + ai * HALF + m * 16; const float rs = row_rs(rss, row);
                const RowInfo ri = row_info(row);
                f32x4 v[2][2] = {{acc[ai][0][m][0] * rs, acc[ai][0][m][1] * rs}, {acc[ai][1][m][0] * rs, acc[ai][1][m][1] * rs}}; f32x4 rot0[2];
                head_norm_rope(v, k_norm + (e == 2 ? 1 : 2) * HD, rope + (size_t)pos_index(ri.pos) * 16, fq, nr, nr, rot0);
                float* d0; float* d1 = nullptr;
                if (e < 4) d0 = (ri.seq < BATCH) ? out + O_KVP + (((size_t)row * 4 + e) * N_KV + g) * HD : out + O_KVS + (((size_t)(row - MP) * 4 + e) * N_KV + g) * HD;
                else { const int we = e - 4; d0 = winrows + (((size_t)row * 2 + we) * N_KV + g) * HD;
                    if (ri.seq < BATCH) { if (ri.t >= SEQ - WINDOW) d1 = out + O_WP + ((((size_t)ri.seq * WINDOW + (ri.t - (SEQ - WINDOW))) * 2 + we) * N_KV + g) * HD; }
                    else d1 = out + O_WS + ((((size_t)(ri.seq - BATCH) * WINDOW + (WINDOW - DEC_SEQ + ri.t)) * 2 + we) * N_KV + g) * HD; }
                d0 += 8 * fq; *(f32x4*)(d0) = rot0[0]; *(f32x4*)(d0 + 4) = rot0[1]; *(f32x4*)(d0 + 32) = v[1][0]; *(f32x4*)(d0 + 36) = v[1][1];
                if (d1) { d1 += 8 * fq; *(f32x4*)(d1) = rot0[0]; *(f32x4*)(d1 + 4) = rot0[1]; *(f32x4*)(d1 + 32) = v[1][0]; *(f32x4*)(d1 + 36) = v[1][1]; }
                if (ri.seq < BATCH) {
                    if (e >= 2) {
                        unsigned char* img = (e == 2 ? ksel : e == 3 ? vsel : e == 4 ? kwin : vwin) + (((size_t)ri.seq * N_KV + g) * (SEQ / 64) + ri.t / 64) * 8192; const int kv = ri.t % 64;
                        const size_t o0 = (e & 1) ? vimg_off(kv, 8 * fq) : kimg_off(kv, 8 * fq), o1 = (e & 1) ? vimg_off(kv, 32 + 8 * fq) : kimg_off(kv, 32 + 8 * fq);
                        *(u32x4*)(img + o0) = pack8(rot0[0], rot0[1], 1.0f); *(u32x4*)(img + o1) = pack8(v[1][0], v[1][1], 1.0f);
                    } else {
                        const int c = ri.t / L_CMP, l = ri.t % L_CMP; const int r = (ri.seq * NBC_P + c) * N_KV + g;
                        bf16_t* ap = acp + ((size_t)e * RP_CMP + r) * (L_CMP * HD) + l * HD + 8 * fq; const float* pp = pe + ((size_t)e * L_CMP + l) * HD + 8 * fq;
                        *(u32x4*)(ap) = pack8(rot0[0] + *(const f32x4*)(pp), rot0[1] + *(const f32x4*)(pp + 4), 1.0f);
                        *(u32x4*)(ap + 32) = pack8(v[1][0] + *(const f32x4*)(pp + 32), v[1][1] + *(const f32x4*)(pp + 36), 1.0f);
                    }
                }
                asm volatile("" ::: "memory");
            }
    }
};
}

namespace pg8 {
struct EpiGelu {
    static constexpr bool PERM = true, AFTER_DRAIN = false, ACC_INIT = false;
    bf16_t* hid;
    __device__ __forceinline__ void pre(const Unit&, int, int, float (&)[8]) const {}
    __device__ __forceinline__ void operator()(const f32x4 (&acc)[2][2][4][2], const Unit& u, int wr, int wc, int fr, int fq, const float (&rsv)[8]) const {
        const int row0 = u.pm * BM + wr * 64 + fr;
#pragma unroll
        for (int ai = 0; ai < 2; ++ai)
#pragma unroll
            for (int m = 0; m < 4; ++m) {
                const int row = row0 + ai * HALF + m * 16;
#pragma unroll
                for (int bj = 0; bj < 2; ++bj) {
                    float a[8];
#pragma unroll
                    for (int n = 0; n < 2; ++n)
#pragma unroll
                        for (int i = 0; i < 4; ++i) { const float x = acc[ai][bj][m][n][i]; a[n * 4 + i] = x * __builtin_amdgcn_rcpf(1.0f + __expf(-1.5957691216057308f * (x + 0.044715f * x * x * x))); }
                    u32x4 w; w.x = cvt_pk_bf16(a[0], a[1]); w.y = cvt_pk_bf16(a[2], a[3]); w.z = cvt_pk_bf16(a[4], a[5]); w.w = cvt_pk_bf16(a[6], a[7]);
                    *(u32x4*)(hid + (size_t)row * CMP_HID + bj * HALF + wc * 32 + 8 * fq) = w;
                }
            }
    }
};
struct CmpOrder {
    int nunits, per_e, G, c;
    __device__ bool next(int i, Unit& u) const { const int L = i * G + c; if (L >= nunits) return false; u.pm = L; u.pn = L / per_e; return true; }
    __device__ __forceinline__ void a_ready(const Unit&) const {}
    __device__ __forceinline__ void done(const Unit&) const {}
};
}
constexpr int LDS_RING_C = 131072;
namespace att {
typedef short bf16x8 __attribute__((ext_vector_type(8)));
typedef short s16x4 __attribute__((ext_vector_type(4)));
typedef float f32x16 __attribute__((ext_vector_type(16)));
typedef __attribute__((address_space(3))) unsigned char* ldsp;
constexpr int TILE_B = 8192;
constexpr int L_KB = 0, L_VB = 3 * TILE_B, L_IMP = 6 * TILE_B, L_SELM = L_IMP + 64 * 64 * 4, L_END = L_SELM + 64 * 8;
constexpr float NEGB = -1e30f;
constexpr float QSCALE = 0.125f * 1.4426950408889634f;
__device__ __forceinline__ int crow(int r, int hi) { return (r & 3) + 8 * (r >> 2) + 4 * hi; }
__device__ __forceinline__ void glds16(const void* gsrc, unsigned lds_dst) { unsigned keep;
    asm volatile("s_mov_b32 %0, m0\n\ts_mov_b32 m0, %2\n\ts_nop 0\n\tglobal_load_lds_dwordx4 %1, off\n\ts_mov_b32 m0, %0" : "=&s"(keep) : "v"(gsrc), "s"(lds_dst) : "memory"); }
__device__ __forceinline__ unsigned cvtpk(float lo, float hi) { unsigned r; asm volatile("v_cvt_pk_bf16_f32 %0, %1, %2" : "=v"(r) : "v"(lo), "v"(hi)); return r; }
__device__ __forceinline__ float halfmax(float m) { auto rr = __builtin_amdgcn_permlane32_swap(__float_as_uint(m), __float_as_uint(m), false, false); return fmaxf(__uint_as_float(rr[0]), __uint_as_float(rr[1])); }
__device__ __forceinline__ float halfsum(float m) { auto rr = __builtin_amdgcn_permlane32_swap(__float_as_uint(m), __float_as_uint(m), false, false); return __uint_as_float(rr[0]) + __uint_as_float(rr[1]); }
__device__ __forceinline__ s16x4 vtr(ldsp p) { typedef short v4i16_t __attribute__((ext_vector_type(4))); return __builtin_bit_cast(s16x4, __builtin_amdgcn_ds_read_tr16_b64_v4i16((__attribute__((address_space(3))) v4i16_t*)p)); }
#define ATT_BAR_L() asm volatile("s_waitcnt lgkmcnt(0)\n\ts_barrier" ::: "memory")
#define ATT_WAIT_BAR(N) asm volatile("s_waitcnt vmcnt(" #N ") lgkmcnt(0)\n\ts_barrier" ::: "memory")
__device__ __forceinline__ void dma_tile(const unsigned char* img_, unsigned lds_dst, int wid, int lane) { unsigned keep; const unsigned voff = (unsigned)(wid * 1024 + lane * 16);
    const unsigned long long ia_ = (unsigned long long)img_; const unsigned long long img = ((unsigned long long)(unsigned)__builtin_amdgcn_readfirstlane((int)(ia_ >> 32)) << 32) | (unsigned)__builtin_amdgcn_readfirstlane((int)ia_);
    asm volatile("s_mov_b32 %0, m0\n\ts_mov_b32 m0, %3\n\ts_nop 0\n\tglobal_load_lds_dwordx4 %1, %2\n\ts_mov_b32 m0, %0" : "=&s"(keep) : "v"(voff), "s"(img), "s"((unsigned)__builtin_amdgcn_readfirstlane(lds_dst + wid * 1024)) : "memory"); }
__device__ __forceinline__ void qk(f32x16& p0, f32x16& p1, ldsp kbuf, const bf16x8 (&qf)[4], float cinit, int r32, int hi) {
    f32x16 c;
#pragma unroll
    for (int r = 0; r < 16; ++r) c[r] = cinit;
#pragma unroll
    for (int s = 0; s < 4; ++s) {
        const bf16x8 k0 = *(const __attribute__((address_space(3))) bf16x8*)(kbuf + (2 * s + hi) * 1024 + r32 * 16);
        const bf16x8 k1 = *(const __attribute__((address_space(3))) bf16x8*)(kbuf + (2 * s + hi) * 1024 + r32 * 16 + 512);
        p0 = __builtin_amdgcn_mfma_f32_32x32x16_bf16(k0, qf[s], s == 0 ? c : p0, 0, 0, 0);
        p1 = __builtin_amdgcn_mfma_f32_32x32x16_bf16(k1, qf[s], s == 0 ? c : p1, 0, 0, 0);
    }
}
__device__ __forceinline__ void pv(f32x16 (&o)[2], ldsp vbuf, const f32x16& p0, const f32x16& p1, int lane, int hi) {
    unsigned pk[4][4];
#pragma unroll
    for (int k = 0; k < 4; ++k) { pk[0][k] = cvtpk(p0[2 * k], p0[2 * k + 1]); pk[1][k] = cvtpk(p0[8 + 2 * k], p0[9 + 2 * k]); pk[2][k] = cvtpk(p1[2 * k], p1[2 * k + 1]); pk[3][k] = cvtpk(p1[8 + 2 * k], p1[9 + 2 * k]); }
    const int vp0 = ((lane >> 4) & 1) * 32 + (lane & 3) * 8 + (4 * hi + ((lane & 15) >> 2)) * 64;
#pragma unroll
    for (int d0 = 0; d0 < 2; ++d0)
#pragma unroll
        for (int s = 0; s < 4; ++s) {
            const s16x4 lo = vtr(vbuf + d0 * 4096 + s * 1024 + vp0), hh = vtr(vbuf + d0 * 4096 + s * 1024 + 512 + vp0);
            const bf16x8 vf = (bf16x8){lo[0], lo[1], lo[2], lo[3], hh[0], hh[1], hh[2], hh[3]};
            typedef unsigned u32x4 __attribute__((ext_vector_type(4)));
            const u32x4 pw = (u32x4){pk[s][0], pk[s][1], pk[s][2], pk[s][3]};
            o[d0] = __builtin_amdgcn_mfma_f32_32x32x16_bf16(vf, __builtin_bit_cast(bf16x8, pw), o[d0], 0, 0, 0);
        }
}
struct Run { float l; f32x16 o[2]; };
template <bool EMASK> __device__ __forceinline__ void tile_step(Run& R, ldsp kbuf, ldsp vbuf, const bf16x8 (&qf)[4], bool row_on, int lo_b_, int hi_b_, int lane, int r32, int hi) {
    int lo_b = lo_b_ - 4 * hi, hi_b = hi_b_ - 4 * hi;
    if (EMASK) asm volatile("" : "+v"(lo_b), "+v"(hi_b));
    f32x16 p0, p1; qk(p0, p1, kbuf, qf, row_on ? 0.f : NEGB, r32, hi);
    float ls = 0.f;
#pragma unroll
    for (int r = 0; r < 16; ++r) {
        float e0 = __builtin_amdgcn_exp2f(p0[r]), e1 = __builtin_amdgcn_exp2f(p1[r]);
        if (EMASK) { const int kc_ = (r & 3) + 8 * (r >> 2); if (kc_ < lo_b || kc_ > hi_b) e0 = 0.f; if (kc_ + 32 < lo_b || kc_ + 32 > hi_b) e1 = 0.f; }
        p0[r] = e0; p1[r] = e1; ls += e0 + e1;
    }
    R.l += ls;
    pv(R.o, vbuf, p0, p1, lane, hi);
}
struct Tensors {
    const bf16_t* qn; const bf16_t* qr;
    const unsigned char* ksel; const unsigned char* vsel; const unsigned char* kwin; const unsigned char* vwin;
    const unsigned char* kc; const unsigned char* vc;
    const float* gates; bf16_t* ob;
};
template <bool SEL> __device__ __forceinline__ void branch(Run& R, const unsigned char* kimg, const unsigned char* vimg, int t0, int t1, int jdiag, unsigned long long selm, int iq,
                                                           const bf16x8 (&qf)[4], unsigned lds0, ldsp lds, int wid, int lane, int r32, int hi) {
    R.l = 0.f;
#pragma unroll
    for (int r = 0; r < 16; ++r) { R.o[0][r] = 0.f; R.o[1][r] = 0.f; }
    dma_tile(kimg + (size_t)t0 * TILE_B, lds0 + L_KB, wid, lane); dma_tile(vimg + (size_t)t0 * TILE_B, lds0 + L_VB, wid, lane);
    if (t0 < t1) { dma_tile(kimg + (size_t)(t0 + 1) * TILE_B, lds0 + L_KB + TILE_B, wid, lane); dma_tile(vimg + (size_t)(t0 + 1) * TILE_B, lds0 + L_VB + TILE_B, wid, lane); }
    int b = 0;
    for (int t = t0; t <= t1; ++t) {
        if (t < t1) ATT_WAIT_BAR(2); else ATT_WAIT_BAR(0);
        if (t + 2 <= t1) { const int b2 = (b >= 1) ? b - 1 : 2; dma_tile(kimg + (size_t)(t + 2) * TILE_B, lds0 + L_KB + b2 * TILE_B, wid, lane); dma_tile(vimg + (size_t)(t + 2) * TILE_B, lds0 + L_VB + b2 * TILE_B, wid, lane); }
        const bool row_on = !SEL || ((selm >> t) & 1ull);
        const bool lowm = !SEL && (t == jdiag - 8);
        if (t == jdiag || lowm) tile_step<true>(R, lds + L_KB + b * TILE_B, lds + L_VB + b * TILE_B, qf, row_on, lowm ? iq : 0, (t == jdiag) ? iq : 63, lane, r32, hi);
        else tile_step<false>(R, lds + L_KB + b * TILE_B, lds + L_VB + b * TILE_B, qf, row_on, 0, 63, lane, r32, hi);
        b = (b == 2) ? 0 : b + 1;
    }
    ATT_BAR_L();
}
__device__ __forceinline__ void load_q(bf16x8 (&qf)[4], const bf16_t* qrow, int hi) {
#pragma unroll
    for (int s = 0; s < 4; ++s) qf[s] = *(const bf16x8*)(qrow + 16 * s + 8 * hi);
}
__device__ __forceinline__ void unit(const Tensors& T, int n, int j, int g, ldsp lds, unsigned lds0, int wid, int lane_) {
    const int lane = (int)lane_id_v();
    const int r32 = lane & 31, hi = lane >> 5, ql = r32 >> 2, hq = r32 & 3, iq = 8 * wid + ql;
    const int row = n * SEQ + 64 * j + iq, head = g * HPG + hq, pos = 64 * j + iq;
    const size_t img_ng = ((size_t)n * N_KV + g);
    f32x16 oacc[2];
#pragma unroll
    for (int r = 0; r < 16; ++r) { oacc[0][r] = 0.f; oacc[1][r] = 0.f; }
    const float* gt = T.gates + (size_t)row * 3 * N_HEADS + head * 3;
    const float g_c = gt[0], g_s = gt[1], g_w = gt[2];
    bf16x8 qf[4];
    unsigned long long selm;
    {
        load_q(qf, T.qn + (size_t)row * HDM + head * HD, hi);
        const int ntc = (2 * j + 2 + 63) / 64;
        const unsigned char* kci = T.kc + img_ng * (NBC_P / 64) * TILE_B; const unsigned char* vci = T.vc + img_ng * (NBC_P / 64) * TILE_B;
        dma_tile(kci, lds0 + L_KB, wid, lane); dma_tile(vci, lds0 + L_VB, wid, lane);
        if (ntc > 1) { dma_tile(kci + TILE_B, lds0 + L_KB + TILE_B, wid, lane); dma_tile(vci + TILE_B, lds0 + L_VB + TILE_B, wid, lane); }
        ATT_WAIT_BAR(0);
        int cmax = ((pos + 1) >> 5) - 1 - 4 * hi;
        asm volatile("" : "+v"(cmax));
        f32x16 s0, s1, s2, s3;
        qk(s0, s1, lds + L_KB, qf, 0.f, r32, hi);
        if (ntc > 1) qk(s2, s3, lds + L_KB + TILE_B, qf, 0.f, r32, hi);
        else {
#pragma unroll
            for (int r = 0; r < 16; ++r) { s2[r] = NEGB; s3[r] = NEGB; }
        }
        float ls = 0.f;
#pragma unroll
        for (int r = 0; r < 16; ++r) { const int kv = (r & 3) + 8 * (r >> 2);
            s0[r] = (kv > cmax) ? 0.f : __builtin_amdgcn_exp2f(s0[r]); s1[r] = (kv + 32 > cmax) ? 0.f : __builtin_amdgcn_exp2f(s1[r]);
            s2[r] = (kv + 64 > cmax) ? 0.f : __builtin_amdgcn_exp2f(s2[r]); s3[r] = (kv + 96 > cmax) ? 0.f : __builtin_amdgcn_exp2f(s3[r]);
            ls += (s0[r] + s1[r]) + (s2[r] + s3[r]); }
        ls = halfsum(ls);
        const float inv = 1.0f / fmaxf(ls, 1e-30f);
#pragma unroll
        for (int r = 0; r < 16; ++r) { s0[r] *= inv; s1[r] *= inv; s2[r] *= inv; s3[r] *= inv; }
        __attribute__((address_space(3))) float* imp = (__attribute__((address_space(3))) float*)(lds + L_IMP) + iq * 64;
#pragma unroll
        for (int r = 0; r < 16; r += 2) { const int bl = crow(r, hi) >> 1;
            float v0 = s0[r] + s0[r + 1], v1 = s1[r] + s1[r + 1], v2 = s2[r] + s2[r + 1], v3 = s3[r] + s3[r + 1];
            v0 += __shfl_xor(v0, 1); v0 += __shfl_xor(v0, 2); v1 += __shfl_xor(v1, 1); v1 += __shfl_xor(v1, 2);
            v2 += __shfl_xor(v2, 1); v2 += __shfl_xor(v2, 2); v3 += __shfl_xor(v3, 1); v3 += __shfl_xor(v3, 2);
            if (hq == 0) { imp[bl] = v0; imp[16 + bl] = v1; imp[32 + bl] = v2; imp[48 + bl] = v3; } }
        Run Rc;
#pragma unroll
        for (int r = 0; r < 16; ++r) { Rc.o[0][r] = 0.f; Rc.o[1][r] = 0.f; }
        pv(Rc.o, lds + L_VB, s0, s1, lane, hi);
        if (ntc > 1) pv(Rc.o, lds + L_VB + TILE_B, s2, s3, lane, hi);
#pragma unroll
        for (int r = 0; r < 16; ++r) { oacc[0][r] += g_c * Rc.o[0][r]; oacc[1][r] += g_c * Rc.o[1][r]; }
        asm volatile("s_waitcnt lgkmcnt(0)" ::: "memory");
        __attribute__((address_space(3))) unsigned long long* selw = (__attribute__((address_space(3))) unsigned long long*)(lds + L_SELM);
        for (int qq = 0; qq < 8; ++qq) {
            const float v = ((__attribute__((address_space(3))) float*)(lds + L_IMP))[(8 * wid + qq) * 64 + lane];
            const bool valid = lane <= j, forced = (lane == 0) || (lane == j) || (lane == j - 1);
            const unsigned key = valid ? (forced ? 0x7f000000u : __float_as_uint(v) + 1u) : 0u;
            unsigned long long m;
            if (j + 1 <= N_SEL) m = __ballot(valid);
            else {
                unsigned Tt = 0u; bool exact = false; unsigned long long mex = 0ull;
                for (int bit = 30; bit >= 0; --bit) { const unsigned cand = Tt | (1u << bit); const unsigned long long ge = __ballot(key >= cand); const int cnt = __popcll(ge);
                    if (cnt == N_SEL) { exact = true; mex = ge; break; }
                    if (cnt > N_SEL) Tt = cand; }
                if (exact) m = mex;
                else {
                    const unsigned long long gtm = __ballot(key > Tt), eqm = __ballot(key == Tt);
                    const int need = N_SEL - __popcll(gtm);
                    const bool pick = (key == Tt) && (__popcll(eqm & ((1ull << lane) - 1ull)) < need);
                    m = gtm | __ballot(pick);
                }
            }
            if (lane == 0) selw[8 * wid + qq] = m;
        }
        asm volatile("s_waitcnt lgkmcnt(0)" ::: "memory");
        selm = selw[iq];
        ATT_WAIT_BAR(0);
    }
    load_q(qf, T.qr + (size_t)row * HDM + head * HD, hi);
    {
        Run R; branch<true>(R, T.ksel + img_ng * (SEQ / 64) * TILE_B, T.vsel + img_ng * (SEQ / 64) * TILE_B, 0, j, j, selm, iq, qf, lds0, lds, wid, lane, r32, hi);
        const float sc = g_s / fmaxf(halfsum(R.l), 1e-30f);
#pragma unroll
        for (int r = 0; r < 16; ++r) { oacc[0][r] += sc * R.o[0][r]; oacc[1][r] += sc * R.o[1][r]; }
    }
    {
        Run R; branch<false>(R, T.kwin + img_ng * (SEQ / 64) * TILE_B, T.vwin + img_ng * (SEQ / 64) * TILE_B, j > 8 ? j - 8 : 0, j, j, 0ull, iq, qf, lds0, lds, wid, lane, r32, hi);
        const float sc = g_w / fmaxf(halfsum(R.l), 1e-30f);
#pragma unroll
        for (int r = 0; r < 16; ++r) { oacc[0][r] += sc * R.o[0][r]; oacc[1][r] += sc * R.o[1][r]; }
    }
    bf16_t* orow = T.ob + (size_t)row * HDM + head * HD;
#pragma unroll
    for (int d0 = 0; d0 < 2; ++d0)
#pragma unroll
        for (int rr = 0; rr < 4; ++rr) { typedef unsigned u32x2 __attribute__((ext_vector_type(2)));
            u32x2 w; w.x = cvtpk(oacc[d0][4 * rr], oacc[d0][4 * rr + 1]); w.y = cvtpk(oacc[d0][4 * rr + 2], oacc[d0][4 * rr + 3]);
            *(u32x2*)(orow + 32 * d0 + 8 * rr + 4 * hi) = w; }
}
}
namespace att {
constexpr int S_STAGE = 16384;
constexpr int S_XM = LDS_RING_C + 1024, S_XL = S_XM + 1024, S_IMP = S_XL + 1024, S_SELM = S_IMP + 8 * 128 * 4, S_END = S_SELM + 8 * 2 * 8;
struct STensors {
    const bf16_t* qn; const bf16_t* qr; const float* kc; const float* vc; const float* cache_kv; const int* page_table; const float* cache_win; const float* out; const float* winrows;
    const float* gates; bf16_t* ob;
};
typedef float f32x4_t __attribute__((ext_vector_type(4)));
__device__ __forceinline__ void stage_kv(ldsp kimg, ldsp vimg, const float* ksrc, const float* vsrc, int stride, int nrows, int lane) {
    typedef unsigned u32x4 __attribute__((ext_vector_type(4)));
    const int c = lane & 7;
#pragma unroll 1
    for (int ib = 0; ib < 8; ib += 4)
#pragma unroll
    for (int it = ib; it < ib + 4; ++it) {
        const int row = 8 * it + (lane >> 3);
        f32x4_t k0 = {0.f, 0.f, 0.f, 0.f}, k1 = k0, v0 = k0, v1 = k0;
        if (row < nrows) { const float* kp = ksrc + (size_t)row * stride + 8 * c; const float* vp = vsrc + (size_t)row * stride + 8 * c;
            k0 = *(const f32x4_t*)kp; k1 = *(const f32x4_t*)(kp + 4); v0 = *(const f32x4_t*)vp; v1 = *(const f32x4_t*)(vp + 4); }
        u32x4 kw, vw; kw.x = cvtpk(k0[0], k0[1]); kw.y = cvtpk(k0[2], k0[3]); kw.z = cvtpk(k1[0], k1[1]); kw.w = cvtpk(k1[2], k1[3]);
        vw.x = cvtpk(v0[0], v0[1]); vw.y = cvtpk(v0[2], v0[3]); vw.z = cvtpk(v1[0], v1[1]); vw.w = cvtpk(v1[2], v1[3]);
        *(__attribute__((address_space(3))) u32x4*)(kimg + c * 1024 + row * 16) = kw;
        *(__attribute__((address_space(3))) u32x4*)(vimg + (c >> 2) * 4096 + (row >> 3) * 512 + (row & 7) * 64 + (c & 3) * 16) = vw;
    }
    asm volatile("s_waitcnt lgkmcnt(0)" ::: "memory");
}
#define ATT_BAR_ALL() asm volatile("s_waitcnt vmcnt(0) lgkmcnt(0)\n\ts_barrier" ::: "memory")
__device__ __forceinline__ float merge_sum(ldsp lds, float l_own_half, int wid, int r32, int hi) {
    __attribute__((address_space(3))) float* xl = (__attribute__((address_space(3))) float*)(lds + S_XL);
    const float l_own = halfsum(l_own_half);
    if (hi == 0) xl[wid * 32 + r32] = l_own;
    ATT_BAR_ALL();
    float L = 0.f;
#pragma unroll
    for (int w = 0; w < 8; ++w) L += xl[w * 32 + r32];
    ATT_BAR_ALL();
    return 1.0f / fmaxf(L, 1e-30f);
}
__device__ __forceinline__ void sample_unit(const STensors& T, int b, int g, ldsp lds, int wid, int lane_) {
    const int lane = (int)lane_id_v();
    const int r32 = lane & 31, hi = lane >> 5, ql = r32 >> 2, hq = r32 & 3;
    const int row = MP + b * DEC_SEQ + ql, head = g * HPG + hq, seq = BATCH + b;
    ldsp kimg = lds + wid * S_STAGE, vimg = kimg + TILE_B;
    f32x16 oacc[2];
#pragma unroll
    for (int r = 0; r < 16; ++r) { oacc[0][r] = 0.f; oacc[1][r] = 0.f; }
    const float* gt = T.gates + (size_t)row * 3 * N_HEADS + head * 3;
    const float g_c = gt[0], g_s = gt[1], g_w = gt[2];
    bf16x8 qf[4];
    __attribute__((address_space(3))) float* xm = (__attribute__((address_space(3))) float*)(lds + S_XM); __attribute__((address_space(3))) float* xl = (__attribute__((address_space(3))) float*)(lds + S_XL);
    __attribute__((address_space(3))) float* imp = (__attribute__((address_space(3))) float*)(lds + S_IMP);
    __attribute__((address_space(3))) unsigned long long* selw = (__attribute__((address_space(3))) unsigned long long*)(lds + S_SELM);
    {
        load_q(qf, T.qn + (size_t)row * HDM + head * HD, hi);
        constexpr int NTC = NBC_PAST / 64;
        f32x16 p0, p1; const bool mine = wid < NTC;
        float ls = 0.f;
        if (mine) {
            const float* kcp = T.kc + (((size_t)seq * NBC_MAX + 64 * wid) * N_KV + g) * HD; const float* vcp = T.vc + (((size_t)seq * NBC_MAX + 64 * wid) * N_KV + g) * HD;
            stage_kv(kimg, vimg, kcp, vcp, N_KV * HD, 64, lane);
            qk(p0, p1, kimg, qf, 0.f, r32, hi);
#pragma unroll
            for (int r = 0; r < 16; ++r) { p0[r] = __builtin_amdgcn_exp2f(p0[r]); p1[r] = __builtin_amdgcn_exp2f(p1[r]); ls += p0[r] + p1[r]; }
            ls = halfsum(ls);
        }
        if (hi == 0) xl[wid * 32 + r32] = ls;
        ATT_BAR_ALL();
        float L = 0.f;
#pragma unroll
        for (int w = 0; w < 8; ++w) L += xl[w * 32 + r32];
        const float inv = 1.0f / fmaxf(L, 1e-30f);
        if (mine) {
#pragma unroll
            for (int r = 0; r < 16; ++r) { p0[r] *= inv; p1[r] *= inv; }
#pragma unroll
            for (int r = 0; r < 16; r += 2) { const int bl = crow(r, hi) >> 1;
                float v0 = p0[r] + p0[r + 1], v1 = p1[r] + p1[r + 1];
                v0 += __shfl_xor(v0, 1); v0 += __shfl_xor(v0, 2); v1 += __shfl_xor(v1, 1); v1 += __shfl_xor(v1, 2);
                if (hq == 0) { imp[ql * 128 + 32 * wid + bl] = v0; imp[ql * 128 + 32 * wid + 16 + bl] = v1; } }
            Run Rc;
#pragma unroll
            for (int r = 0; r < 16; ++r) { Rc.o[0][r] = 0.f; Rc.o[1][r] = 0.f; }
            pv(Rc.o, vimg, p0, p1, lane, hi);
#pragma unroll
            for (int r = 0; r < 16; ++r) { oacc[0][r] += g_c * Rc.o[0][r]; oacc[1][r] += g_c * Rc.o[1][r]; }
        }
        ATT_BAR_ALL();
    }
    {
        constexpr int NCAND = NBS_S - 1;
        const float v0 = imp[wid * 128 + lane], v1 = imp[wid * 128 + 64 + lane];
        const unsigned key0 = (lane == 0) ? 0x7f000000u : __float_as_uint(v0) + 1u;
        const unsigned key1 = (lane + 64 == NCAND - 1) ? 0x7f000000u : __float_as_uint(v1) + 1u;
        unsigned Tt = 0u;
        for (int bit = 30; bit >= 0; --bit) { const unsigned cand = Tt | (1u << bit); if (__popcll(__ballot(key0 >= cand)) + __popcll(__ballot(key1 >= cand)) >= N_SEL - 1) Tt = cand; }
        const unsigned long long gt0 = __ballot(key0 > Tt), gt1 = __ballot(key1 > Tt), eq0 = __ballot(key0 == Tt), eq1 = __ballot(key1 == Tt);
        const int need = (N_SEL - 1) - __popcll(gt0) - __popcll(gt1);
        const unsigned long long below = (1ull << lane) - 1ull;
        const bool pick0 = (key0 == Tt) && (__popcll(eq0 & below) < need);
        const bool pick1 = (key1 == Tt) && (__popcll(eq0) + __popcll(eq1 & below) < need);
        const unsigned long long m0 = gt0 | __ballot(pick0), m1 = gt1 | __ballot(pick1);
        if (lane == 0) { selw[wid * 2] = m0; selw[wid * 2 + 1] = m1; }
        ATT_BAR_ALL();
    }
    load_q(qf, T.qr + (size_t)row * HDM + head * HD, hi);
    {
        unsigned long long U0 = 0ull, U1 = 0ull;
#pragma unroll
        for (int q = 0; q < 8; ++q) { U0 |= selw[q * 2]; U1 |= selw[q * 2 + 1]; }
        U0 = __builtin_amdgcn_readfirstlane((unsigned)U0) | ((unsigned long long)__builtin_amdgcn_readfirstlane((unsigned)(U0 >> 32)) << 32);
        U1 = __builtin_amdgcn_readfirstlane((unsigned)U1) | ((unsigned long long)__builtin_amdgcn_readfirstlane((unsigned)(U1 >> 32)) << 32);
        const unsigned long long my0 = selw[ql * 2], my1 = selw[ql * 2 + 1];
        Run R; R.l = 0.f;
#pragma unroll
        for (int r = 0; r < 16; ++r) { R.o[0][r] = 0.f; R.o[1][r] = 0.f; }
        int idx = 0;
        for (int half = 0; half < 2; ++half) {
            unsigned long long U = half ? U1 : U0;
            while (U) {
                const int bit = __builtin_ctzll(U); U &= U - 1ull;
                if ((idx++ & 7) != wid) continue;
                const int blk = 64 * half + bit;
                const int page = T.page_table[b * N_PAGES + (blk * L_SEL) / PAGE_SIZE];
                const float* base = T.cache_kv + (((size_t)page * PAGE_SIZE + (blk * L_SEL) % PAGE_SIZE) * 4) * N_KV * HD + g * HD;
                stage_kv(kimg, vimg, base + 2 * N_KV * HD, base + 3 * N_KV * HD, 4 * N_KV * HD, 64, lane);
                const bool selected = ((half ? my1 : my0) >> bit) & 1ull;
                tile_step<false>(R, kimg, vimg, qf, selected, 0, 63, lane, r32, hi);
            }
        }
        if ((idx & 7) == wid) {
            const float* base = T.out + O_KVS + (((size_t)b * DEC_SEQ) * 4) * N_KV * HD + g * HD;
            stage_kv(kimg, vimg, base + 2 * N_KV * HD, base + 3 * N_KV * HD, 4 * N_KV * HD, DEC_SEQ, lane);
            tile_step<true>(R, kimg, vimg, qf, true, 0, ql, lane, r32, hi);
        }
        const float wgt = merge_sum(lds, R.l, wid, r32, hi) * g_s;
#pragma unroll
        for (int r = 0; r < 16; ++r) { oacc[0][r] += wgt * R.o[0][r]; oacc[1][r] += wgt * R.o[1][r]; }
    }
    {
        Run R; R.l = 0.f;
#pragma unroll
        for (int r = 0; r < 16; ++r) { R.o[0][r] = 0.f; R.o[1][r] = 0.f; }
        for (int t = wid; t < WINDOW / 64; t += 8) {
            const float* base = T.cache_win + (((size_t)b * WINDOW + 64 * t) * 2) * N_KV * HD + g * HD;
            stage_kv(kimg, vimg, base, base + N_KV * HD, 2 * N_KV * HD, 64, lane);
            if (t == 0) tile_step<true>(R, kimg, vimg, qf, true, ql, 63, lane, r32, hi); else tile_step<false>(R, kimg, vimg, qf, true, 0, 63, lane, r32, hi);
        }
        if (wid == 0) {
            const float* base = T.winrows + (((size_t)(MP + b * DEC_SEQ)) * 2) * N_KV * HD + g * HD;
            stage_kv(kimg, vimg, base, base + N_KV * HD, 2 * N_KV * HD, DEC_SEQ, lane);
            tile_step<true>(R, kimg, vimg, qf, true, 0, ql, lane, r32, hi);
        }
        const float wgt = merge_sum(lds, R.l, wid, r32, hi) * g_w;
#pragma unroll
        for (int r = 0; r < 16; ++r) { oacc[0][r] += wgt * R.o[0][r]; oacc[1][r] += wgt * R.o[1][r]; }
    }
    {
        const int lane2 = (int)lane_id_v(), r32 = lane2 & 31, hi = lane2 >> 5;
        __attribute__((address_space(3))) float* mine = (__attribute__((address_space(3))) float*)(lds + wid * S_STAGE);
#pragma unroll
        for (int d0 = 0; d0 < 2; ++d0)
#pragma unroll
            for (int rr = 0; rr < 4; ++rr) *(__attribute__((address_space(3))) f32x4_t*)(mine + r32 * 64 + 32 * d0 + 8 * rr + 4 * hi) = (f32x4_t){oacc[d0][4 * rr], oacc[d0][4 * rr + 1], oacc[d0][4 * rr + 2], oacc[d0][4 * rr + 3]};
        ATT_BAR_ALL();
        const int tid = wid * 64 + (int)lane_id_v(), orow = tid >> 4, oc4 = (tid & 15) * 4;
        f32x4_t s = {0.f, 0.f, 0.f, 0.f};
#pragma unroll
        for (int w = 0; w < 8; ++w) s += *(const __attribute__((address_space(3))) f32x4_t*)((__attribute__((address_space(3))) float*)(lds + w * S_STAGE) + orow * 64 + oc4);
        typedef unsigned u32x2 __attribute__((ext_vector_type(2)));
        u32x2 wv; wv.x = cvtpk(s[0], s[1]); wv.y = cvtpk(s[2], s[3]);
        const int oq = orow >> 2, oh = orow & 3;
        *(u32x2*)(T.ob + (size_t)(MP + b * DEC_SEQ + oq) * HDM + (g * HPG + oh) * HD + oc4) = wv;
        ATT_BAR_ALL();
    }
}
constexpr int Q_SAMPLE = DEC_BATCH * N_KV, Q_PROMPT = BATCH * N_KV * (SEQ / 64), Q_TOTAL = Q_SAMPLE + Q_PROMPT;
constexpr int S_QHEAD = S_END;
__device__ __forceinline__ int claim_unit(unsigned* head, ldsp lds, int wid, int lane) {
    __attribute__((address_space(3))) int* qslot = (__attribute__((address_space(3))) int*)(lds + S_QHEAD);
    if (wid == 0 && lane == 0) *qslot = (int)__hip_atomic_fetch_add(head, 1u, __ATOMIC_RELAXED, __HIP_MEMORY_SCOPE_AGENT);
    ATT_BAR_ALL();
    const int u = __builtin_amdgcn_readfirstlane(*qslot);
    ATT_BAR_ALL();
    return u;
}
__device__ __forceinline__ void att_queue_sample(const STensors& TS, unsigned* head, ldsp lds, int wid, int lane) {
    for (;;) { const int u = claim_unit(head, lds, wid, lane); if (u >= Q_SAMPLE) break; sample_unit(TS, u / N_KV, u % N_KV, lds, wid, lane); }
}
__device__ __forceinline__ void att_queue_prompt(const Tensors& T, unsigned* head, ldsp lds, int wid, int lane) {
    const unsigned lds0 = (unsigned)(uintptr_t)lds;
    for (;;) { const int p = claim_unit(head, lds, wid, lane); if (p >= Q_PROMPT) break;
        const int j = (SEQ / 64 - 1) - p / (BATCH * N_KV), ng = p % (BATCH * N_KV); unit(T, ng / N_KV, j, ng % N_KV, lds, lds0, wid, lane); }
}
}


namespace att {
template <bool PART> __device__ __forceinline__ void cmp_out_wave(int task, const bf16_t* hid, const float* part, int R, int nbc, int seq0, const bf16_t* w2t, const float* k_norm0, float* kc, float* vc, unsigned char* kci, unsigned char* vci, int lane) {
    const int r32 = lane & 31, hi = lane >> 5;
    const int r0 = task * 32, e = r0 >= R ? 1 : 0, r = r0 - e * R + r32;
    const bf16_t* hrow = hid + ((size_t)e * R + r) * CMP_HID; const bf16_t* wrow = w2t + ((size_t)e * HD + r32) * CMP_HID;
    const float* prow = part + ((size_t)e * R + r) * CMP_HID;
    f32x16 o0, o1;
#pragma unroll
    for (int k = 0; k < 16; ++k) { o0[k] = 0.f; o1[k] = 0.f; }
#pragma unroll 4
    for (int s_ = 0; s_ < CMP_HID / 16; ++s_) {
        bf16x8 hb_;
        if constexpr (!PART) hb_ = *(const bf16x8*)(hrow + 16 * s_ + 8 * hi);
        else { const float* p0 = prow + 16 * s_ + 8 * hi; const float* p1 = p0 + (size_t)2 * R * CMP_HID;
            const f32x4_t a0 = *(const f32x4_t*)p0 + *(const f32x4_t*)p1, a1 = *(const f32x4_t*)(p0 + 4) + *(const f32x4_t*)(p1 + 4);
            float gx[8] = {a0[0], a0[1], a0[2], a0[3], a1[0], a1[1], a1[2], a1[3]};
#pragma unroll
            for (int q_ = 0; q_ < 8; ++q_) { const float x = gx[q_]; gx[q_] = x * __builtin_amdgcn_rcpf(1.0f + __expf(-1.5957691216057308f * (x + 0.044715f * x * x * x))); }
            typedef unsigned u32x4 __attribute__((ext_vector_type(4)));
            const u32x4 w = (u32x4){cvtpk(gx[0], gx[1]), cvtpk(gx[2], gx[3]), cvtpk(gx[4], gx[5]), cvtpk(gx[6], gx[7])}; hb_ = __builtin_bit_cast(bf16x8, w); }
        const bf16x8 w0 = *(const bf16x8*)(wrow + 16 * s_ + 8 * hi), w1 = *(const bf16x8*)(wrow + (size_t)32 * CMP_HID + 16 * s_ + 8 * hi);
        o0 = __builtin_amdgcn_mfma_f32_32x32x16_bf16(w0, hb_, o0, 0, 0, 0); o1 = __builtin_amdgcn_mfma_f32_32x32x16_bf16(w1, hb_, o1, 0, 0, 0);
    }
    if (e == 0) {
        float ss = 0.f;
#pragma unroll
        for (int k = 0; k < 16; ++k) ss += o0[k] * o0[k] + o1[k] * o1[k];
        ss = halfsum(ss);
        const float rn = rsqrtf(ss * (1.0f / HD) + EPS);
#pragma unroll
        for (int k = 0; k < 16; ++k) { o0[k] *= rn * k_norm0[crow(k, hi)]; o1[k] *= rn * k_norm0[32 + crow(k, hi)]; }
    }
    const int g = r % N_KV, c = (r / N_KV) % nbc, sq = r / (N_KV * nbc);
    float* dst = (e == 0 ? kc : vc) + (((size_t)(seq0 + sq) * NBC_MAX + c) * N_KV + g) * HD;
#pragma unroll
    for (int rr = 0; rr < 4; ++rr) { *(f32x4_t*)(dst + 8 * rr + 4 * hi) = (f32x4_t){o0[4 * rr], o0[4 * rr + 1], o0[4 * rr + 2], o0[4 * rr + 3]};
                                      *(f32x4_t*)(dst + 32 + 8 * rr + 4 * hi) = (f32x4_t){o1[4 * rr], o1[4 * rr + 1], o1[4 * rr + 2], o1[4 * rr + 3]}; }
    if (kci) {
        unsigned char* img = (e == 0 ? kci : vci) + (((size_t)sq * N_KV + g) * (NBC_P / 64) + c / 64) * 8192; const int kv = c % 64;
        typedef unsigned u32x2 __attribute__((ext_vector_type(2)));
#pragma unroll
        for (int rr = 0; rr < 4; ++rr) {
            u32x2 a; a.x = cvtpk(o0[4 * rr], o0[4 * rr + 1]); a.y = cvtpk(o0[4 * rr + 2], o0[4 * rr + 3]);
            u32x2 bq; bq.x = cvtpk(o1[4 * rr], o1[4 * rr + 1]); bq.y = cvtpk(o1[4 * rr + 2], o1[4 * rr + 3]);
            const int d0 = 8 * rr, d1 = 32 + 8 * rr;
            *(u32x2*)(img + (e == 0 ? kimg_off(kv, d0) : vimg_off(kv, d0)) + 8 * hi) = a;
            *(u32x2*)(img + (e == 0 ? kimg_off(kv, d1) : vimg_off(kv, d1)) + 8 * hi) = bq;
        }
    }
}
}
__device__ __forceinline__ void conv_thin_vec_item(size_t i_, const bf16_t* ub, const bf16_t* bb, const float* state, const float* wc, bf16_t* zb) {
    typedef unsigned u4 __attribute__((ext_vector_type(4)));
    const int m = (int)(i_ / (D_MODEL / 8)), ch = (int)(i_ % (D_MODEL / 8)) * 8;
    const RowInfo ri = row_info(m);
    const size_t o = (size_t)m * D_MODEL + ch;
    float u0[8], u1[8], u2[8], bv[8];
#define UNPK(w, f) do { f[0] = bf2f((bf16_t)((w).x & 0xffff)); f[1] = bf2f((bf16_t)((w).x >> 16)); f[2] = bf2f((bf16_t)((w).y & 0xffff)); f[3] = bf2f((bf16_t)((w).y >> 16)); \
                        f[4] = bf2f((bf16_t)((w).z & 0xffff)); f[5] = bf2f((bf16_t)((w).z >> 16)); f[6] = bf2f((bf16_t)((w).w & 0xffff)); f[7] = bf2f((bf16_t)((w).w >> 16)); } while (0)
    { const u4 w = *(const u4*)(ub + o); UNPK(w, u0); } { const u4 w = *(const u4*)(bb + o); UNPK(w, bv); }
    const float* st = (ri.seq >= BATCH) ? state + (size_t)(ri.seq - BATCH) * 2 * D_MODEL + ch : nullptr;
    if (ri.t >= 1) { const u4 w = *(const u4*)(ub + o - D_MODEL); UNPK(w, u1); } else { for (int k = 0; k < 8; ++k) u1[k] = st ? st[D_MODEL + k] : 0.f; }
    if (ri.t >= 2) { const u4 w = *(const u4*)(ub + o - 2 * D_MODEL); UNPK(w, u2); } else { for (int k = 0; k < 8; ++k) u2[k] = st ? (ri.t == 1 ? st[D_MODEL + k] : st[k]) : 0.f; }
#undef UNPK
    float z[8];
    for (int k = 0; k < 8; ++k) z[k] = bv[k] * (wc[ch + k] * u2[k] + wc[D_MODEL + ch + k] * u1[k] + wc[2 * D_MODEL + ch + k] * u0[k]);
    u4 w; w.x = (unsigned)f2bf(z[0]) | ((unsigned)f2bf(z[1]) << 16); w.y = (unsigned)f2bf(z[2]) | ((unsigned)f2bf(z[3]) << 16);
    w.z = (unsigned)f2bf(z[4]) | ((unsigned)f2bf(z[5]) << 16); w.w = (unsigned)f2bf(z[6]) | ((unsigned)f2bf(z[7]) << 16);
    *(u4*)(zb + o) = w;
}

namespace att {
__device__ __forceinline__ void skinny_task(int task, const bf16_t* A, const bf16_t* Bt, int N, int K, int KS, float* part, int lane) {
    const int r32 = lane & 31, hi = lane >> 5, ncb = N / 32, nrb = MS / 32;
    const int ks = task / (nrb * ncb), rem = task % (nrb * ncb), rb = rem / ncb, cb = rem % ncb, klen = K / KS, k0 = ks * klen;
    const bf16_t* ap = A + (size_t)(rb * 32 + r32) * K + k0 + 8 * hi; const bf16_t* bp = Bt + (size_t)(cb * 32 + r32) * K + k0 + 8 * hi;
    f32x16 acc;
#pragma unroll
    for (int k = 0; k < 16; ++k) acc[k] = 0.f;
#pragma unroll 8
    for (int s_ = 0; s_ < klen / 16; ++s_) acc = __builtin_amdgcn_mfma_f32_32x32x16_bf16(*(const bf16x8*)(bp + 16 * s_), *(const bf16x8*)(ap + 16 * s_), acc, 0, 0, 0);
    float* dst = part + ((size_t)ks * MS + rb * 32 + r32) * N + cb * 32 + 4 * hi;
#pragma unroll
    for (int rr = 0; rr < 4; ++rr) *(f32x4_t*)(dst + 8 * rr) = (f32x4_t){acc[4 * rr], acc[4 * rr + 1], acc[4 * rr + 2], acc[4 * rr + 3]};
}
__device__ __forceinline__ void skinny_task_g(int task, const bf16_t* A, const bf16_t* Bt, int N, int K, int KS, int rows, float* part, int part_rows, int row_off, int lane) {
    const int r32 = lane & 31, hi = lane >> 5, ncb = N / 32, nrb = rows / 32;
    const int ks = task / (nrb * ncb), rem = task % (nrb * ncb), rb = rem / ncb, cb = rem % ncb, klen = K / KS, k0 = ks * klen;
    const bf16_t* ap = A + (size_t)(rb * 32 + r32) * K + k0 + 8 * hi; const bf16_t* bp = Bt + (size_t)(cb * 32 + r32) * K + k0 + 8 * hi;
    f32x16 acc;
#pragma unroll
    for (int k = 0; k < 16; ++k) acc[k] = 0.f;
#pragma unroll 8
    for (int s_ = 0; s_ < klen / 16; ++s_) acc = __builtin_amdgcn_mfma_f32_32x32x16_bf16(*(const bf16x8*)(bp + 16 * s_), *(const bf16x8*)(ap + 16 * s_), acc, 0, 0, 0);
    float* dst = part + ((size_t)ks * part_rows + row_off + rb * 32 + r32) * N + cb * 32 + 4 * hi;
#pragma unroll
    for (int rr = 0; rr < 4; ++rr) *(f32x4_t*)(dst + 8 * rr) = (f32x4_t){acc[4 * rr], acc[4 * rr + 1], acc[4 * rr + 2], acc[4 * rr + 3]};
}
__device__ __forceinline__ void resid_reduce_row(int rs_, const float* part, int KS, float coef, bf16_t* hb, float* rss_next, float* yout, int lane) {
    typedef unsigned u2 __attribute__((ext_vector_type(2)));
    const int m = MP + rs_; float ssq = 0.f;
#pragma unroll
    for (int j = 0; j < D_MODEL / 256; ++j) {
        const int col = 256 * j + 4 * lane; f32x4_t a = {0.f, 0.f, 0.f, 0.f};
        for (int ks = 0; ks < KS; ++ks) a += *(const f32x4_t*)(part + ((size_t)ks * MS + rs_) * D_MODEL + col);
        const u2 ho = *(const u2*)(hb + (size_t)m * D_MODEL + col);
        const f32x4_t v = (f32x4_t){__uint_as_float(ho.x << 16), __uint_as_float(ho.x & 0xffff0000u), __uint_as_float(ho.y << 16), __uint_as_float(ho.y & 0xffff0000u)} + a * coef;
        if (yout) *(f32x4_t*)(yout + (size_t)m * D_MODEL + col) = v;
        else { u2 w; w.x = cvtpk(v[0], v[1]); w.y = cvtpk(v[2], v[3]); *(u2*)(hb + (size_t)m * D_MODEL + col) = w;
               ssq += (v[0] * v[0] + v[1] * v[1]) + (v[2] * v[2] + v[3] * v[3]); }
    }
    if (!yout) {
#pragma unroll
        for (int o = 1; o < 64; o <<= 1) ssq += __shfl_xor(ssq, o);
        if (lane == 0) ((unsigned*)rss_next)[m] = rss_enc(ssq);
    }
}
}
__device__ __forceinline__ void conv_thin_sample_item(size_t i_, const float* part, int KS, const float* rss, const float* state, const float* wc, bf16_t* zb, float* out, int layer) {
    const int rs_ = (int)(i_ / (D_MODEL / 8)), ch = (int)(i_ % (D_MODEL / 8)) * 8, m = MP + rs_;
    const RowInfo ri = row_info(m);
    const int nc = (ch / 128) * 256 + (ch % 128);
    float u[3][8], bv[8];
    for (int back = 0; back < 3; ++back) {
        if (ri.t - back >= 0) {
            const int r2 = rs_ - back; const float rsn = rsqrtf(rss_dec(rss[MP + r2]) * (1.0f / D_MODEL) + EPS);
            for (int k = 0; k < 8; ++k) { float c = 0.f, x = 0.f; for (int ks = 0; ks < KS; ++ks) { const float* p = part + ((size_t)ks * MS + r2) * 3 * D_MODEL; c += p[nc + k]; x += p[nc + 128 + k]; } u[back][k] = (c * rsn) * (x * rsn); }
        } else { const float* st = state + (size_t)(ri.seq - BATCH) * 2 * D_MODEL + ch;
            const int srow = 2 - (back - ri.t); for (int k = 0; k < 8; ++k) u[back][k] = st[(size_t)srow * D_MODEL + k]; }
    }
    { const float rsn = rsqrtf(rss_dec(rss[m]) * (1.0f / D_MODEL) + EPS);
      for (int k = 0; k < 8; ++k) { float b = 0.f; for (int ks = 0; ks < KS; ++ks) b += part[((size_t)ks * MS + rs_) * 3 * D_MODEL + 2 * D_MODEL + ch + k]; bv[k] = b * rsn; } }
    for (int k = 0; k < 8; ++k) { const float ub0 = bf2f(f2bf(u[0][k])), ub1 = (ri.t >= 1) ? bf2f(f2bf(u[1][k])) : u[1][k], ub2 = (ri.t >= 2) ? bf2f(f2bf(u[2][k])) : u[2][k];
        zb[(size_t)m * D_MODEL + ch + k] = f2bf(bf2f(f2bf(bv[k])) * (wc[ch + k] * ub2 + wc[D_MODEL + ch + k] * ub1 + wc[2 * D_MODEL + ch + k] * ub0));
        if (ri.t >= DEC_SEQ - 2) out[O_CS + (((size_t)layer * DEC_BATCH + (ri.seq - BATCH)) * 2 + (ri.t - (DEC_SEQ - 2))) * D_MODEL + ch + k] = u[0][k]; }
}

__device__ __forceinline__ void acmp_sample_wave(int task, const float* cache_kv, const int* page_table, const float* pe, bf16_t* A, int lane) {
    typedef float f4 __attribute__((ext_vector_type(4))); typedef unsigned u4 __attribute__((ext_vector_type(4)));
    const int b = task / NBC_PAST, c = task % NBC_PAST, tok0 = c * L_CMP;
    const int page = page_table[b * N_PAGES + tok0 / PAGE_SIZE];
    const int e = lane >> 5, g = (lane >> 3) & (N_KV - 1), c8 = lane & 7;
    const float* src = cache_kv + ((size_t)page * PAGE_SIZE + tok0 % PAGE_SIZE) * 4 * N_KV * HD + lane * 8;
    const float* pp = pe + (size_t)e * L_CMP * HD + 8 * c8;
    bf16_t* dst = A + ((size_t)e * RS_CMP + ((size_t)b * NBC_PAST + c) * N_KV + g) * (L_CMP * HD) + 8 * c8;
#pragma unroll 8
    for (int l = 0; l < L_CMP; ++l) {
        const f4 a0 = __builtin_nontemporal_load((const f4*)(src + (size_t)l * 4 * N_KV * HD)) + *(const f4*)(pp + l * HD), a1 = __builtin_nontemporal_load((const f4*)(src + (size_t)l * 4 * N_KV * HD + 4)) + *(const f4*)(pp + l * HD + 4);
        u4 w; w.x = att::cvtpk(a0[0], a0[1]); w.y = att::cvtpk(a0[2], a0[3]); w.z = att::cvtpk(a1[0], a1[1]); w.w = att::cvtpk(a1[2], a1[3]);
        *(u4*)(dst + l * HD) = w;
    }
}
__device__ __forceinline__ void wconv_tile(int item, const float* src, int Nsrc, const float* gain, bf16_t* dst, int Nd, int K, int kind, int aux, LAS float* scr, int lane) {
    const int nblk = Nd / 32, kb = item / nblk, nb = item % nblk, k0 = 64 * kb, n0 = 32 * nb;
    const int colbase = colmap(kind, n0, aux);
    const int col = colbase + (lane & 31); const bool ok = colbase >= 0 && col < Nsrc;
    float tv[32];
    const float* sp0 = src + (size_t)(k0 + (lane >> 5)) * Nsrc + (ok ? col : 0);
#pragma unroll
    for (int i = 0; i < 32; ++i) tv[i] = ok ? __builtin_nontemporal_load(sp0 + (size_t)(2 * i) * Nsrc) : 0.f;
#pragma unroll
    for (int i = 0; i < 32; ++i) { const int kk = 2 * i + (lane >> 5); const float g = gain ? gain[k0 + kk] : 1.f; scr[kk * 33 + (lane & 31)] = tv[i] * g; }
    asm volatile("s_waitcnt lgkmcnt(0)" ::: "memory");
    const int c = lane & 7;
#pragma unroll
    for (int j = 0; j < 4; ++j) { const int n = (lane >> 3) + 8 * j; const LAS float* sp = scr + (8 * c) * 33 + n;
        typedef unsigned v4u __attribute__((ext_vector_type(4)));
        v4u o; o.x = pg8::cvt_pk_bf16(sp[0 * 33], sp[1 * 33]); o.y = pg8::cvt_pk_bf16(sp[2 * 33], sp[3 * 33]); o.z = pg8::cvt_pk_bf16(sp[4 * 33], sp[5 * 33]); o.w = pg8::cvt_pk_bf16(sp[6 * 33], sp[7 * 33]);
        *(v4u*)(dst + (size_t)(n0 + n) * K + k0 + 8 * c) = o; }
    asm volatile("s_waitcnt lgkmcnt(0)" ::: "memory");
}
__device__ __forceinline__ void hinit_row(int m, const float* xp, const float* xs, float* h, bf16_t* hb, float* rss0, int lane) {
    typedef float f4 __attribute__((ext_vector_type(4))); typedef unsigned u2 __attribute__((ext_vector_type(2)));
    const float* x = m < MP ? xp + (size_t)m * D_MODEL : xs + (size_t)(m - MP) * D_MODEL;
    float s = 0.f;
#pragma unroll
    for (int j = 0; j < D_MODEL / 256; ++j) { const f4 v = *(const f4*)(x + 256 * j + 4 * lane); s += (v[0] * v[0] + v[1] * v[1]) + (v[2] * v[2] + v[3] * v[3]);
        u2 w; w.x = pg8::cvt_pk_bf16(v[0], v[1]); w.y = pg8::cvt_pk_bf16(v[2], v[3]); *(u2*)(hb + (size_t)m * D_MODEL + 256 * j + 4 * lane) = w; }
#pragma unroll
    for (int o = 1; o < 64; o <<= 1) s += __shfl_xor(s, o);
    if (lane == 0) ((unsigned*)rss0)[m] = rss_enc(s);
}
#endif

#ifndef CPU_TEST
__device__ __forceinline__ size_t opaque_gtid(int wave) { int w = wave; asm volatile("" : "+s"(w)); unsigned t = blockIdx.x * NTHREADS + w * 64 + lane_id_v(); return (size_t)t; }
#define ITEM_LOOP(total) for (size_t i = opaque_gtid(wave_id); i < (size_t)(total); i += (size_t)gridDim.x * NTHREADS)
#else
#define ITEM_LOOP(total) _Pragma("omp parallel for schedule(dynamic, 64)") for (long long i = 0; i < (long long)(total); ++i)
#endif

struct Params {
    const float *x_prompt, *x_sample, *cache_kv, *cache_win, *state_conv; const int* page_table;
    const float *ffn_a_norm, *ffn_a_w_in, *ffn_a_w_out, *mix_norm, *ffn_b_norm, *ffn_b_w_in, *ffn_b_w_out, *conv_w_in, *conv_w, *conv_w_out, *kv_norm, *w_kv, *k_norm,
                *cmp_pe, *cmp_w1, *cmp_w2, *nsa_w_qg, *nsa_q_norm, *nsa_w_o;
    float* out; unsigned char* ws;
};
constexpr int LDS_RING = 131072, LDS_BAR_OFF = LDS_RING + 352, LDS_BYTES = 147456;

#ifndef CPU_TEST
typedef const __attribute__((address_space(4))) Params* KParamsPtr;
__device__ __forceinline__ KParamsPtr kparams_ptr() {
#if defined(__HIP_DEVICE_COMPILE__)
    KParamsPtr p = (KParamsPtr)__builtin_amdgcn_kernarg_segment_ptr(); asm volatile("" : "+s"(p)); return p;
#else
    return nullptr;
#endif
}
__device__ __forceinline__ Params load_params() {
#if defined(__HIP_DEVICE_COMPILE__)
    return *kparams_ptr();
#else
    return Params{};
#endif
}
__device__ __forceinline__ unsigned char* load_ws() {
#if defined(__HIP_DEVICE_COMPILE__)
    return kparams_ptr()->ws;
#else
    return nullptr;
#endif
}
#define KP const Params P = load_params()
__device__ __forceinline__ int opaque_s(int v) { asm volatile("" : "+s"(v)); return v; }
#define GRID_SYNC() do { XcdBarrier bar_; bar_.bar = (GU*)load_ws() + 1024; bar_.x = 0; bar_.st = (volatile LAS unsigned*)(lds + LDS_BAR_OFF); xcd_barrier(bar_, wave_id == 0 && lane_id_v() == 0u); } while (0)
__global__ void __launch_bounds__(NTHREADS, 2) mega(Params P_unused)
#else
static Params g_params;
#define KP const Params& P = g_params
#define GRID_SYNC() do {} while (0)
void mega(Params P_unused)
#endif
{
#ifndef CPU_TEST
    extern __shared__ __attribute__((aligned(16))) unsigned char lds[];
    const int wave_id = __builtin_amdgcn_readfirstlane((int)(threadIdx.x >> 6));
    if (threadIdx.x < 4) ((LAS unsigned*)(lds + LDS_BAR_OFF))[threadIdx.x] = 0u;
    __syncthreads();
    (void)xcd_barrier_post((GU*)load_ws() + 1024, (volatile LAS unsigned*)(lds + LDS_BAR_OFF), threadIdx.x == 0);
#define RING ((PG8_LAS unsigned char*)lds)
#else
    g_params = P_unused;
#endif
#define WS_F(f) ((float*)(P.ws + WSM.f))
#define WS_B(f) ((bf16_t*)(P.ws + WSM.f))
#define KVSRC KvSrc{P.cache_kv, P.page_table, P.out}
#define PH(total, call) do { { KP; ITEM_LOOP(total) call; } GRID_SYNC(); } while (0)
#ifdef CPU_TEST
    for (int L = 0; L < DEPTH; ++L) {
        KP;
        ITEM_LOOP((size_t)2 * D_FF * (D_MODEL / 64)) wconv_item(i, P.ffn_a_w_in + (size_t)L * D_MODEL * 2 * D_FF, 2 * D_FF, P.ffn_a_norm + (size_t)L * D_MODEL, WS_B(w_ain) + (size_t)L * 2 * D_FF * D_MODEL, 2 * D_FF, D_MODEL, CM_PAIR, D_FF);
        ITEM_LOOP((size_t)D_MODEL * (D_FF / 64)) wconv_item(i, P.ffn_a_w_out + (size_t)L * D_FF * D_MODEL, D_MODEL, nullptr, WS_B(w_aout) + (size_t)L * D_MODEL * D_FF, D_MODEL, D_FF, CM_PLAIN, 0);
        ITEM_LOOP((size_t)2 * D_FF * (D_MODEL / 64)) wconv_item(i, P.ffn_b_w_in + (size_t)L * D_MODEL * 2 * D_FF, 2 * D_FF, P.ffn_b_norm + (size_t)L * D_MODEL, WS_B(w_bin) + (size_t)L * 2 * D_FF * D_MODEL, 2 * D_FF, D_MODEL, CM_PAIR, D_FF);
        ITEM_LOOP((size_t)D_MODEL * (D_FF / 64)) wconv_item(i, P.ffn_b_w_out + (size_t)L * D_FF * D_MODEL, D_MODEL, nullptr, WS_B(w_bout) + (size_t)L * D_MODEL * D_FF, D_MODEL, D_FF, CM_PLAIN, 0);
    }
    for (int L = 0; L < N_A; ++L) {
        KP;
        ITEM_LOOP((size_t)3 * D_MODEL * (D_MODEL / 64)) wconv_item(i, P.conv_w_in + (size_t)L * D_MODEL * 3 * D_MODEL, 3 * D_MODEL, P.mix_norm + (size_t)L * D_MODEL, WS_B(w_cin) + (size_t)L * 3 * D_MODEL * D_MODEL, 3 * D_MODEL, D_MODEL, CM_CONV, 0);
        ITEM_LOOP((size_t)D_MODEL * (D_MODEL / 64)) wconv_item(i, P.conv_w_out + (size_t)L * D_MODEL * D_MODEL, D_MODEL, nullptr, WS_B(w_cout) + (size_t)L * D_MODEL * D_MODEL, D_MODEL, D_MODEL, CM_PLAIN, 0);
    }
    for (int b = 0; b < N_B; ++b) {
        KP;
        ITEM_LOOP((size_t)QGP * (D_MODEL / 64)) wconv_item(i, P.nsa_w_qg + (size_t)b * D_MODEL * QGW, QGW, P.mix_norm + (size_t)(N_A + b) * D_MODEL, WS_B(w_qg) + (size_t)b * QGP * D_MODEL, QGP, D_MODEL, CM_HEADS, N_HEADS);
        ITEM_LOOP((size_t)D_MODEL * (HDM / 64)) wconv_item(i, P.nsa_w_o + (size_t)b * HDM * D_MODEL, D_MODEL, nullptr, WS_B(w_o) + (size_t)b * D_MODEL * HDM, D_MODEL, HDM, CM_PLAIN, 0);
    }
    { KP; ITEM_LOOP((size_t)KVW * (D_MODEL / 64)) wconv_item(i, P.w_kv, KVW, P.kv_norm, WS_B(w_kv), KVW, D_MODEL, CM_HEADS, 6 * N_KV); }
    { KP; ITEM_LOOP((size_t)NPOS * 8) rope_item(i, WS_F(rope)); }
    { KP; ITEM_LOOP(MT) hinit_item(i, P.x_prompt, P.x_sample, WS_F(h), WS_B(hb), WS_F(rss)); }
#else
#define WAVE_ITEMS(total) for (int it_ = (int)(opaque_s((int)blockIdx.x) * 8 + wave_id); it_ < (int)(total); it_ += (int)gridDim.x * 8)
#define WCONV_R(cu0_, ncu_, srcp, Nsrc_, gainp, dstp, Nd_, K_, kind_, aux_) do { KP; LAS float* scr_ = (LAS float*)(lds + wave_id * 16384); const int lane_ = (int)lane_id_v(); \
        const int bx_ = opaque_s((int)blockIdx.x) - (cu0_); if (bx_ >= 0 && bx_ < (ncu_)) for (int it_ = bx_ * 8 + wave_id; it_ < ((Nd_) / 32) * ((K_) / 64); it_ += (ncu_) * 8) \
            wconv_tile(it_, srcp, Nsrc_, gainp, dstp, Nd_, K_, kind_, aux_, scr_, lane_); } while (0)
#define WCONV(srcp, Nsrc_, gainp, dstp, Nd_, K_, kind_, aux_) WCONV_R(0, (int)gridDim.x, srcp, Nsrc_, gainp, dstp, Nd_, K_, kind_, aux_)
#define CONV_LAYER_A(L, cu0_, ncu_) do { \
        WCONV_R(cu0_, ncu_, P.ffn_a_w_in + (size_t)(L) * D_MODEL * 2 * D_FF, 2 * D_FF, P.ffn_a_norm + (size_t)(L) * D_MODEL, WS_B(w_ain) + (size_t)(L) * 2 * D_FF * D_MODEL, 2 * D_FF, D_MODEL, CM_PAIR, D_FF); \
        WCONV_R(cu0_, ncu_, P.ffn_a_w_out + (size_t)(L) * D_FF * D_MODEL, D_MODEL, nullptr, WS_B(w_aout) + (size_t)(L) * D_MODEL * D_FF, D_MODEL, D_FF, CM_PLAIN, 0); \
        if ((L) < N_A) { \
            WCONV_R(cu0_, ncu_, P.conv_w_in + (size_t)(L) * D_MODEL * 3 * D_MODEL, 3 * D_MODEL, P.mix_norm + (size_t)(L) * D_MODEL, WS_B(w_cin) + (size_t)(L) * 3 * D_MODEL * D_MODEL, 3 * D_MODEL, D_MODEL, CM_CONV, 0); \
            WCONV_R(cu0_, ncu_, P.conv_w_out + (size_t)(L) * D_MODEL * D_MODEL, D_MODEL, nullptr, WS_B(w_cout) + (size_t)(L) * D_MODEL * D_MODEL, D_MODEL, D_MODEL, CM_PLAIN, 0); \
        } else { const int b_ = (L) - N_A; \
            WCONV_R(cu0_, ncu_, P.nsa_w_qg + (size_t)b_ * D_MODEL * QGW, QGW, P.mix_norm + (size_t)(L) * D_MODEL, WS_B(w_qg) + (size_t)b_ * QGP * D_MODEL, QGP, D_MODEL, CM_HEADS, N_HEADS); \
            WCONV_R(cu0_, ncu_, P.nsa_w_o + (size_t)b_ * HDM * D_MODEL, D_MODEL, nullptr, WS_B(w_o) + (size_t)b_ * D_MODEL * HDM, D_MODEL, HDM, CM_PLAIN, 0); } } while (0)
#define CONV_LAYER_B(L, cu0_, ncu_) do { \
        WCONV_R(cu0_, ncu_, P.ffn_b_w_in + (size_t)(L) * D_MODEL * 2 * D_FF, 2 * D_FF, P.ffn_b_norm + (size_t)(L) * D_MODEL, WS_B(w_bin) + (size_t)(L) * 2 * D_FF * D_MODEL, 2 * D_FF, D_MODEL, CM_PAIR, D_FF); \
        WCONV_R(cu0_, ncu_, P.ffn_b_w_out + (size_t)(L) * D_FF * D_MODEL, D_MODEL, nullptr, WS_B(w_bout) + (size_t)(L) * D_MODEL * D_FF, D_MODEL, D_FF, CM_PLAIN, 0); \
        if ((L) == N_A - 1) WCONV_R(cu0_, ncu_, P.w_kv, KVW, P.kv_norm, WS_B(w_kv), KVW, D_MODEL, CM_HEADS, 6 * N_KV); } while (0)
    CONV_LAYER_A(0, 0, (int)gridDim.x); CONV_LAYER_B(0, 0, (int)gridDim.x);
    { KP; ITEM_LOOP((size_t)NPOS * 8) rope_item(i, WS_F(rope)); }
    { KP; const int lane_ = (int)lane_id_v(); WAVE_ITEMS(MT) hinit_row(it_, P.x_prompt, P.x_sample, WS_F(h), WS_B(hb), WS_F(rss), lane_); }
#endif
#ifndef CPU_TEST
    for (int e = 0; e < 2; ++e) WCONV(P.cmp_w1 + (size_t)e * L_CMP * HD * CMP_HID, CMP_HID, nullptr, WS_B(w1t) + (size_t)e * CMP_HID * L_CMP * HD, CMP_HID, L_CMP * HD, CM_PLAIN, 0);
    for (int e = 0; e < 2; ++e) WCONV(P.cmp_w2 + (size_t)e * CMP_HID * HD, HD, nullptr, WS_B(w2t) + (size_t)e * HD * CMP_HID, HD, CMP_HID, CM_PLAIN, 0);
    { KP; const int lane_ = (int)lane_id_v(); static_assert(N_KV == 4 && 2 * N_KV * 8 == 64, "acmp_sample_wave lane map"); WAVE_ITEMS(DEC_BATCH * NBC_PAST) acmp_sample_wave(it_, P.cache_kv, P.page_table, P.cmp_pe, WS_B(acs), lane_); }
#endif
    GRID_SYNC();
#ifndef CPU_TEST
    { KP; pg8::Gemm g{WS_B(acs), WS_B(w1t), 2 * RS_CMP, 2 * CMP_HID, L_CMP * HD}; pg8::CmpOrder So{2 * RS_CMP / 256, RS_CMP / 256, opaque_s((int)gridDim.x), opaque_s((int)blockIdx.x)};
      pg8::EpiGelu E{WS_B(hids)}; pg8::gemm_phase<pg8::EpiGelu, pg8::CmpOrder, true, true>(wave_id, RING, g, So, E); }
    GRID_SYNC();
    { KP; const int lane_ = (int)lane_id_v(); WAVE_ITEMS(2 * RS_CMP / 32) att::cmp_out_wave<false>(it_, WS_B(hids), nullptr, RS_CMP, NBC_PAST, BATCH, WS_B(w2t), P.k_norm, WS_F(kc), WS_F(vc), nullptr, nullptr, lane_); }
#endif

#ifndef CPU_TEST
#define RESID_PH(Aptr, Btptr, Kk, KSn, v_out, coef_, last_) do { \
        { KP; const int lane_ = (int)lane_id_v(); WAVE_ITEMS((MS / 32) * (D_MODEL / 32) * (KSn)) att::skinny_task(it_, (Aptr) + (size_t)MP * (Kk), Btptr, D_MODEL, Kk, KSn, WS_F(part), lane_); } \
        { KP; pg8::Gemm g{Aptr, Btptr, MP, D_MODEL, Kk}; pg8::StaticOrder So; So.init(MP, D_MODEL, opaque_s((int)gridDim.x), opaque_s((int)blockIdx.x)); \
          pg8::EpiResid E{WS_B(hb), WS_F(rss) + (size_t)(v_out) * MT, (last_) ? P.out + O_YP : nullptr, coef_}; pg8::gemm_phase<pg8::EpiResid, pg8::StaticOrder, true, true>(wave_id, RING, g, So, E); } \
        GRID_SYNC(); \
        { KP; const int lane_ = (int)lane_id_v(); WAVE_ITEMS(MS) att::resid_reduce_row(it_, WS_F(part), KSn, coef_, WS_B(hb), WS_F(rss) + (size_t)(v_out) * MT, (last_) ? P.out + O_YP : nullptr, lane_); } \
        GRID_SYNC(); } while (0)
#define FFN_OPT(wi, wo, v_in, last, is_b) do { \
        { KP; pg8::Gemm g{WS_B(hb), WS_B(wi) + (size_t)layer * 2 * D_FF * D_MODEL, MT, 2 * D_FF, D_MODEL}; pg8::StaticOrder So; So.init(MT, 2 * D_FF, opaque_s((int)gridDim.x), opaque_s((int)blockIdx.x)); \
          pg8::EpiSwiglu E{WS_B(act), WS_F(rss) + (size_t)(v_in) * MT}; pg8::gemm_phase<pg8::EpiSwiglu, pg8::StaticOrder, true, true>(wave_id, RING, g, So, E); } \
        if (layer + 1 < DEPTH) { constexpr int nun_ = (MT / 256) * (2 * D_FF / 256); const int G_ = (int)gridDim.x, rem_ = nun_ % G_;     \
            if (rem_ != 0) { if (is_b) CONV_LAYER_B(layer + 1, rem_, G_ - rem_); else CONV_LAYER_A(layer + 1, rem_, G_ - rem_); } \
            else { if (is_b) CONV_LAYER_B(layer + 1, 0, G_); else CONV_LAYER_A(layer + 1, 0, G_); } } \
        GRID_SYNC(); \
        RESID_PH(WS_B(act), WS_B(wo) + (size_t)layer * D_MODEL * D_FF, D_FF, 8, (v_in) + 1, 0.5f, last); } while (0)
#else
#define FFN_OPT(wi, wo, v_in, last, is_b) do { KP; \
        ITEM_LOOP((size_t)MT * D_FF) ref_ffn_in_item(i, WS_B(hb), WS_F(rss) + (size_t)(v_in) * MT, WS_B(wi) + (size_t)layer * 2 * D_FF * D_MODEL, WS_B(act)); \
        ITEM_LOOP(MT) ref_resid_row_item(i, WS_B(act), D_FF, WS_B(wo) + (size_t)layer * D_MODEL * D_FF, 0.5f, WS_F(h), WS_B(hb), WS_F(rss) + (size_t)((v_in) + 1) * MT, (last) ? P.out + O_YP : nullptr); } while (0)
#endif
#ifndef CPU_TEST
#define GEMM_PH(EpiT, Aptr, Btptr, Nn, Kk, ...) do { { KP; pg8::Gemm g{Aptr, Btptr, MT, Nn, Kk}; pg8::StaticOrder So; So.init(MT, Nn, opaque_s((int)gridDim.x), opaque_s((int)blockIdx.x)); \
        pg8::EpiT E{__VA_ARGS__}; pg8::gemm_phase<pg8::EpiT, pg8::StaticOrder, true, true>(wave_id, RING, g, So, E); } GRID_SYNC(); } while (0)
#endif
    for (int layer = 0; layer < DEPTH; ++layer) {
        FFN_OPT(w_ain, w_aout, 3 * layer, false, false);
        const int v1 = 3 * layer + 1;
        if (layer < N_A) {
#ifndef CPU_TEST
            { KP; const int lane_ = (int)lane_id_v(); WAVE_ITEMS((MS / 32) * (3 * D_MODEL / 32) * 2) att::skinny_task(it_, WS_B(hb) + (size_t)MP * D_MODEL, WS_B(w_cin) + (size_t)layer * 3 * D_MODEL * D_MODEL, 3 * D_MODEL, D_MODEL, 2, WS_F(part), lane_); }
            { KP; pg8::Gemm g{WS_B(hb), WS_B(w_cin) + (size_t)layer * 3 * D_MODEL * D_MODEL, MP, 3 * D_MODEL, D_MODEL}; pg8::StaticOrder So; So.init(MP, 3 * D_MODEL, opaque_s((int)gridDim.x), opaque_s((int)blockIdx.x));
              pg8::EpiConvIn E{WS_B(ub), WS_B(bb), WS_F(rss) + (size_t)v1 * MT, P.out, layer}; pg8::gemm_phase<pg8::EpiConvIn, pg8::StaticOrder, true, true>(wave_id, RING, g, So, E); }
            GRID_SYNC();
#else
            PH((size_t)MT * D_MODEL, ref_conv_in_item(i, WS_B(hb), WS_F(rss) + (size_t)v1 * MT, WS_B(w_cin) + (size_t)layer * 3 * D_MODEL * D_MODEL, WS_B(ub), WS_B(bb), P.out, layer));
#endif
#ifndef CPU_TEST
            { KP; ITEM_LOOP((size_t)MS * (D_MODEL / 8)) conv_thin_sample_item(i, WS_F(part), 2, WS_F(rss) + (size_t)v1 * MT, P.state_conv + (size_t)layer * DEC_BATCH * 2 * D_MODEL, P.conv_w + (size_t)layer * 3 * D_MODEL, WS_B(zb), P.out, layer); }
            PH((size_t)MP * (D_MODEL / 8), conv_thin_vec_item(i, WS_B(ub), WS_B(bb), P.state_conv + (size_t)layer * DEC_BATCH * 2 * D_MODEL, P.conv_w + (size_t)layer * 3 * D_MODEL, WS_B(zb)));
#else
            PH((size_t)MT * D_MODEL, conv_thin_item(i, WS_B(ub), WS_B(bb), P.state_conv + (size_t)layer * DEC_BATCH * 2 * D_MODEL, P.conv_w + (size_t)layer * 3 * D_MODEL, WS_B(zb)));
#endif
#ifndef CPU_TEST
            RESID_PH(WS_B(zb), WS_B(w_cout) + (size_t)layer * D_MODEL * D_MODEL, D_MODEL, 8, v1 + 1, 1.0f, false);
#else
            PH(MT, ref_resid_row_item(i, WS_B(zb), D_MODEL, WS_B(w_cout) + (size_t)layer * D_MODEL * D_MODEL, 1.0f, WS_F(h), WS_B(hb), WS_F(rss) + (size_t)(v1 + 1) * MT, nullptr));
#endif
        } else {
            const int b = layer - N_A;
#ifndef CPU_TEST
            GEMM_PH(EpiQG, WS_B(hb), WS_B(w_qg) + (size_t)b * QGP * D_MODEL, QGP, D_MODEL, WS_B(qnb), WS_B(qrb), WS_F(gates), WS_F(rss) + (size_t)v1 * MT, P.nsa_q_norm + (size_t)b * HD, WS_F(rope));
#else
            { KP; ITEM_LOOP((size_t)MT * N_HEADS) ref_qg_item(i, WS_B(hb), WS_F(rss) + (size_t)v1 * MT, WS_B(w_qg) + (size_t)b * QGP * D_MODEL, P.nsa_q_norm + (size_t)b * HD, WS_F(rope), WS_F(qn), WS_F(qr)); }
            PH((size_t)MT * 3 * N_HEADS, ref_gates_item(i, WS_B(hb), WS_F(rss) + (size_t)v1 * MT, WS_B(w_qg) + (size_t)b * QGP * D_MODEL, WS_F(gates)));
#endif
#ifndef CPU_TEST
            { KP; att::STensors TS{WS_B(qnb), WS_B(qrb), WS_F(kc), WS_F(vc), P.cache_kv, P.page_table, P.cache_win, P.out, WS_F(winrows), WS_F(gates), WS_B(ob)};
              int wv = wave_id; asm volatile("" : "+s"(wv));
              att::att_queue_sample(TS, (unsigned*)P.ws + 8192 + 128 * b, (att::ldsp)lds, wv, (int)lane_id_v()); }
            { KP; att::Tensors T{WS_B(qnb), WS_B(qrb), P.ws + WSM.ksel, P.ws + WSM.vsel, P.ws + WSM.kwin, P.ws + WSM.vwin, P.ws + WSM.kci, P.ws + WSM.vci, WS_F(gates), WS_B(ob)};
              int wv = wave_id; asm volatile("" : "+s"(wv));
              att::att_queue_prompt(T, (unsigned*)P.ws + 8192 + 128 * b + 64, (att::ldsp)lds, wv, (int)lane_id_v()); }
            GRID_SYNC();
#else
            PH((size_t)MT * N_HEADS, attn_cmp_item(i, WS_F(qn), WS_F(kc), WS_F(vc), WS_F(pbuf), WS_F(oc)));
            PH((size_t)MT * N_KV, topk_item(i, WS_F(pbuf), (int*)WS_F(sel), WS_F(scorebuf)));
            PH((size_t)MT * N_HEADS, attn_sel_item(i, KVSRC, WS_F(qr), (const int*)WS_F(sel), WS_F(os)));
            PH((size_t)MT * N_HEADS, attn_win_item(i, P.cache_win, WS_F(winrows), WS_F(qr), WS_F(gates), WS_F(oc), WS_F(os), WS_B(ob)));
#endif
#ifndef CPU_TEST
            RESID_PH(WS_B(ob), WS_B(w_o) + (size_t)b * D_MODEL * HDM, HDM, 8, v1 + 1, 1.0f, false);
#else
            PH(MT, ref_resid_row_item(i, WS_B(ob), HDM, WS_B(w_o) + (size_t)b * D_MODEL * HDM, 1.0f, WS_F(h), WS_B(hb), WS_F(rss) + (size_t)(v1 + 1) * MT, nullptr));
#endif
        }
        FFN_OPT(w_bin, w_bout, 3 * layer + 2, layer == DEPTH - 1, true);
        if (layer == N_A - 1) {
            const int v3 = 3 * layer + 3;
#ifndef CPU_TEST
            { KP; pg8::Gemm g{WS_B(hb), WS_B(w_kv), MT, KVW, D_MODEL}; pg8::StaticOrder So; So.init(MT, KVW, opaque_s((int)gridDim.x), opaque_s((int)blockIdx.x));
              pg8::EpiKV E{P.out, WS_F(winrows), WS_F(rss) + (size_t)v3 * MT, P.k_norm, WS_F(rope), P.ws + WSM.ksel, P.ws + WSM.vsel, P.ws + WSM.kwin, P.ws + WSM.vwin, WS_B(acp), P.cmp_pe}; pg8::gemm_phase<pg8::EpiKV, pg8::StaticOrder, true, true>(wave_id, RING, g, So, E); }
#else
            { KP; ITEM_LOOP((size_t)MT * 6 * N_KV) ref_kv_item(i, WS_B(hb), WS_F(rss) + (size_t)v3 * MT, WS_B(w_kv), P.k_norm, WS_F(rope), P.out, WS_F(winrows)); }
#endif
            PH((size_t)DEC_BATCH * (WINDOW - DEC_SEQ) * 2 * N_KV * HD, wincopy_item(i, P.cache_win, P.out));
#ifdef CPU_TEST
            PH((size_t)NSEQ * NBC_MAX * 2 * N_KV * CMP_HID, cmp_hid_item(i, KVSRC, P.cmp_pe, P.cmp_w1, WS_F(hid)));
            PH((size_t)NSEQ * NBC_MAX * 2 * N_KV, cmp_out_item(i, WS_F(hid), P.cmp_w2, P.k_norm, WS_F(kc), WS_F(vc)));
#else
            { KP; const int lane_ = (int)lane_id_v();
              WAVE_ITEMS(2 * (RP_CMP / 32) * (CMP_HID / 32) * 2) { const int e_ = it_ / ((RP_CMP / 32) * (CMP_HID / 32) * 2), t_ = it_ % ((RP_CMP / 32) * (CMP_HID / 32) * 2);
                att::skinny_task_g(t_, WS_B(acp) + (size_t)e_ * RP_CMP * (L_CMP * HD), WS_B(w1t) + (size_t)e_ * CMP_HID * (L_CMP * HD), CMP_HID, L_CMP * HD, 2, RP_CMP, WS_F(part), 2 * RP_CMP, e_ * RP_CMP, lane_); } }
            GRID_SYNC();
            { KP; const int lane_ = (int)lane_id_v(); WAVE_ITEMS(2 * RP_CMP / 32) att::cmp_out_wave<true>(it_, nullptr, WS_F(part), RP_CMP, NBC_P, 0, WS_B(w2t), P.k_norm, WS_F(kc), WS_F(vc), P.ws + WSM.kci, P.ws + WSM.vci, lane_); }
#endif
        }
    }
}

extern "C" void kernel_launch(void* const* d_in, const int* in_sizes, int n_in, void* d_out, int out_size, void* d_ws, size_t ws_size, hipStream_t stream) {
    Params P{};
    P.x_prompt = (const float*)d_in[0]; P.x_sample = (const float*)d_in[1]; P.cache_kv = (const float*)d_in[2]; P.cache_win = (const float*)d_in[3];
    P.state_conv = (const float*)d_in[4]; P.page_table = (const int*)d_in[5]; P.ffn_a_norm = (const float*)d_in[6]; P.ffn_a_w_in = (const float*)d_in[7];
    P.ffn_a_w_out = (const float*)d_in[8]; P.mix_norm = (const float*)d_in[9]; P.ffn_b_norm = (const float*)d_in[10]; P.ffn_b_w_in = (const float*)d_in[11];
    P.ffn_b_w_out = (const float*)d_in[12]; P.conv_w_in = (const float*)d_in[13]; P.conv_w = (const float*)d_in[14]; P.conv_w_out = (const float*)d_in[15];
    P.kv_norm = (const float*)d_in[16]; P.w_kv = (const float*)d_in[17]; P.k_norm = (const float*)d_in[18]; P.cmp_pe = (const float*)d_in[19];
    P.cmp_w1 = (const float*)d_in[20]; P.cmp_w2 = (const float*)d_in[21]; P.nsa_w_qg = (const float*)d_in[22]; P.nsa_q_norm = (const float*)d_in[23];
    P.nsa_w_o = (const float*)d_in[24];
    P.out = (float*)d_out; P.ws = (unsigned char*)d_ws;
#ifndef CPU_TEST
    static int grid = 0;
    if (grid == 0) {
        int dev = 0, cus = 0, per_cu = 0;
        hipGetDevice(&dev); hipDeviceGetAttribute(&cus, hipDeviceAttributeMultiprocessorCount, dev);
        hipFuncSetAttribute((const void*)mega, hipFuncAttributeMaxDynamicSharedMemorySize, LDS_BYTES);
        hipOccupancyMaxActiveBlocksPerMultiprocessor(&per_cu, (const void*)mega, NTHREADS, LDS_BYTES);
        (void)hipGetLastError();
        grid = cus;
    }
    hipMemsetAsync(d_ws, 0, WS_ZERO_BYTES, stream);
    hipLaunchKernelGGL(mega, dim3(grid), dim3(NTHREADS), LDS_BYTES, stream, P);
#else
    memset(d_ws, 0, WS_ZERO_BYTES);
    mega(P);
#endif
}
```
